# Optimizing an MI355X kernel written in HIP

```python
import math
import jax
import jax.numpy as jnp
from jax import lax
import numpy as np

D_MODEL = 1024
BATCH = 16
SEQ = 4096
DEPTH = 4

GRID_W = 64
N_MIXERS = 3
HEAD_DIM = 64
MIX_WIDTH = 768
MIX_HEADS = MIX_WIDTH // HEAD_DIM
MEM_LEN = 256
MEM_HEADS = 4
MEM_WIDTH = MEM_HEADS * HEAD_DIM
CAT_WIDTH = MIX_WIDTH + MEM_WIDTH

NA_KH_MAX = 8
NA_KW = 16

KV_HEADS = 4
KV_WIDTH = KV_HEADS * HEAD_DIM
ROPE_THETA = 10000.0
Q_BLOCK = 128
QK_NORM_EPS = 1e-6

HYENA_ORDER = 2
HYENA_BANDS = 16
HYENA_EMB = 2 * HYENA_BANDS + 1
HYENA_FFN = 64
HYENA_WIDTH = (HYENA_ORDER + 1) * MIX_WIDTH
HYENA_DECAY_TARGET = 1e-2
HYENA_FAST_DECAY = 0.3
HYENA_SLOW_DECAY = 1.5

N_EXPERTS = 32
TOP_K = 4
D_EXPERT = D_MODEL
SWIGLU_LIMIT = 7.0
SWIGLU_ALPHA = 1.702

DEEPNORM_ALPHA = (2 * DEPTH) ** 0.25
DEEPNORM_BETA = (8 * DEPTH) ** -0.25
LN_EPS = 1e-5

N_LAYERS_A = len(range(0, DEPTH, N_MIXERS))
N_LAYERS_B = len(range(1, DEPTH, N_MIXERS))
N_LAYERS_C = len(range(2, DEPTH, N_MIXERS))
IN_WIDTH_A = 3 * MIX_WIDTH + MEM_WIDTH
IN_WIDTH_B = MIX_WIDTH + 2 * KV_WIDTH + MEM_WIDTH
IN_WIDTH_C = HYENA_WIDTH + MEM_WIDTH

kernel_name = 'hybrid_na_gqa_hyena_moe_encoder'

F32 = jnp.float32


def layer_norm(x, g, b):
    xf = x.astype(F32)
    mu = jnp.mean(xf, -1, keepdims=True)
    xc = xf - mu
    var = jnp.mean(xc * xc, -1, keepdims=True)
    return (xc * lax.rsqrt(var + LN_EPS) * g.astype(F32) + b.astype(F32)).astype(x.dtype)


def rms_norm(x, g):
    xf = x.astype(F32)
    inv = lax.rsqrt(jnp.mean(xf * xf, -1, keepdims=True) + QK_NORM_EPS)
    return (xf * inv * g.astype(F32)).astype(x.dtype)


def split_heads(t, n_heads):
    return t.reshape(*t.shape[:-1], n_heads, HEAD_DIM)


def neighbourhood_attention(q, k, v, rpb):
    B, L, H, Dh = q.shape
    rows = L // GRID_W
    kh = min(NA_KH_MAX, rows)
    qg = q.reshape(B, rows, GRID_W, H, Dh)
    kg = k.reshape(B, rows, GRID_W, H, Dh)
    vg = v.reshape(B, rows, GRID_W, H, Dh)
    col = np.arange(GRID_W)
    col_start = np.clip(col - NA_KW // 2, 0, GRID_W - NA_KW)
    col_idx = col_start[:, None] + np.arange(NA_KW)[None, :]
    col_off = col_idx - col[:, None] + NA_KW - 1
    rpb_cols = rpb.astype(F32)[:, :, col_off]
    scale = Dh ** -0.5

    def row_block(r):
        r0 = jnp.clip(r - kh // 2, 0, rows - kh)
        k_band = lax.dynamic_slice_in_dim(kg, r0, kh, axis=1)
        v_band = lax.dynamic_slice_in_dim(vg, r0, kh, axis=1)
        k_win = k_band[:, :, col_idx]
        v_win = v_band[:, :, col_idx]
        q_row = lax.dynamic_index_in_dim(qg, r, axis=1, keepdims=False)
        row_off = r0 + jnp.arange(kh) - r + NA_KH_MAX - 1
        bias = jnp.take(rpb_cols, row_off, axis=1).transpose(0, 2, 1, 3)
        s = jnp.einsum('bqhd,biqjhd->bhqij', q_row, k_win).astype(F32) * scale + bias[None]
        p = jax.nn.softmax(s.reshape(B, H, GRID_W, kh * NA_KW), axis=-1)
        p = p.reshape(B, H, GRID_W, kh, NA_KW).astype(v.dtype)
        return jnp.einsum('bhqij,biqjhd->bqhd', p, v_win)

    out = lax.map(row_block, jnp.arange(rows))
    return out.transpose(1, 0, 2, 3, 4).reshape(B, L, H, Dh)


def axial_rope_tables(L):
    pos = jnp.arange(L)
    row = (pos // GRID_W).astype(F32)
    col = (pos % GRID_W).astype(F32)
    axis_dim = HEAD_DIM // 2
    inv_freq = ROPE_THETA ** (-jnp.arange(0, axis_dim, 2, dtype=F32) / axis_dim)
    ang = jnp.concatenate([row[:, None] * inv_freq, col[:, None] * inv_freq], -1)
    return jnp.cos(ang), jnp.sin(ang)


def apply_rope(x, cos, sin):
    xf = x.astype(F32).reshape(*x.shape[:-1], HEAD_DIM // 2, 2)
    x1, x2 = xf[..., 0], xf[..., 1]
    c = cos[None, :, None, :]
    s = sin[None, :, None, :]
    out = jnp.stack([x1 * c - x2 * s, x1 * s + x2 * c], -1).reshape(x.shape)
    return out.astype(x.dtype)


def gqa_blocked(q, k, v):
    B, L, Hq, Dh = q.shape
    G = Hq // KV_HEADS
    nblk = L // Q_BLOCK
    qb = q.reshape(B, nblk, Q_BLOCK, KV_HEADS, G, Dh).transpose(1, 0, 2, 3, 4, 5)
    scale = Dh ** -0.5

    def block(q_blk):
        s = jnp.einsum('bqkgd,bskd->bkgqs', q_blk, k).astype(F32) * scale
        p = jax.nn.softmax(s, axis=-1).astype(v.dtype)
        return jnp.einsum('bkgqs,bskd->bqkgd', p, v)

    out = lax.map(block, qb)
    return out.transpose(1, 0, 2, 3, 4, 5).reshape(B, L, Hq, Dh)


def short_conv_centred(u, w, b):
    up = jnp.pad(u, ((0, 0), (1, 1), (0, 0)))
    return up[:, :-2] * w[0] + up[:, 1:-1] * w[1] + up[:, 2:] * w[2] + b


def hyena_filters(L, w1, b1, w2, b2, w3, b3, w4, b4, freq):
    pos = jnp.arange(L, dtype=F32)
    t = pos / max(L - 1, 1)
    w = 2.0 * math.pi * pos / L
    f = jnp.linspace(1e-4, HYENA_BANDS - 1, HYENA_BANDS, dtype=F32)
    wf = w[:, None] * f[None, :]
    z = jnp.concatenate([t[:, None], jnp.cos(wf), -jnp.sin(wf)], -1)
    fr = freq.astype(F32)
    h = jnp.sin(fr * (z @ w1.astype(F32) + b1.astype(F32)))
    h = jnp.sin(fr * (h @ w2.astype(F32) + b2.astype(F32)))
    h = jnp.sin(fr * (h @ w3.astype(F32) + b3.astype(F32)))
    h = (h @ w4.astype(F32) + b4.astype(F32)).reshape(L, 2, HYENA_ORDER, MIX_WIDTH)
    max_decay = math.log(HYENA_DECAY_TARGET) / HYENA_FAST_DECAY
    min_decay = math.log(HYENA_DECAY_TARGET) / HYENA_SLOW_DECAY
    deltas = jnp.abs(jnp.linspace(min_decay, max_decay, MIX_WIDTH, dtype=F32))
    h = h * jnp.exp(-t[:, None, None, None] * deltas)
    return h / jnp.sum(jnp.abs(h), axis=(0, 1), keepdims=True)


def bidir_long_conv(u, h_fwd, h_bwd, bias):
    L, C = h_fwd.shape
    g = jnp.concatenate([h_fwd, jnp.zeros((1, C), F32), h_bwd[:0:-1]], 0)
    n = 2 * L
    u_f = jnp.fft.rfft(u.astype(F32), n=n, axis=1)
    g_f = jnp.fft.rfft(g, n=n, axis=0)
    y = jnp.fft.irfft(u_f * g_f[None], n=n, axis=1)[:, :L]
    return (y + u.astype(F32) * bias.astype(F32)).astype(u.dtype)


def hyena_mixer(u, conv_w, conv_b, filt, long_bias):
    uc = short_conv_centred(u, conv_w, conv_b)
    parts = jnp.split(uc, HYENA_ORDER + 1, axis=-1)
    z = parts[0]
    for o in range(HYENA_ORDER):
        z = parts[o + 1] * bidir_long_conv(z, filt[:, 0, o], filt[:, 1, o], long_bias[o])
    return z


def memory_attention(q, k, v):
    s = jnp.einsum('blhd,bmhd->bhlm', q, k).astype(F32) * (HEAD_DIM ** -0.5)
    p = jax.nn.softmax(s, axis=-1).astype(v.dtype)
    return jnp.einsum('bhlm,bmhd->blhd', p, v)


def moe(x, router_w, router_b, w1, b1, w2, b2):
    B, L, D = x.shape
    xt = x.reshape(-1, D)
    logits = (xt @ router_w + router_b).astype(F32)
    top_val, top_idx = lax.top_k(logits, TOP_K)
    gate = jax.nn.softmax(top_val, axis=-1)
    comb = jnp.einsum('nk,nke->ne', gate, jax.nn.one_hot(top_idx, N_EXPERTS, dtype=F32)).astype(x.dtype)
    y = jnp.zeros_like(xt)
    for e in range(N_EXPERTS):
        h = xt @ w1[e] + b1[e]
        g = jnp.minimum(h[:, :D_EXPERT], SWIGLU_LIMIT)
        u = jnp.clip(h[:, D_EXPERT:], -SWIGLU_LIMIT, SWIGLU_LIMIT)
        a = (u + 1.0) * (g * jax.nn.sigmoid(SWIGLU_ALPHA * g))
        y = y + comb[:, e:e + 1] * (a @ w2[e] + b2[e])
    return y.reshape(B, L, D)


def setup_inputs(seed: int = 0) -> dict:
    key = jax.random.key(seed)
    ks = iter(jax.random.split(key, 40))

    def nrm(shape, scale):
        return jax.random.normal(next(ks), shape, F32) * scale

    D = D_MODEL
    return {
        'x': nrm((BATCH, SEQ, D), 1.0),
        'mem': nrm((BATCH, MEM_LEN, D), 1.0),
        'w_in_a': nrm((N_LAYERS_A, D, IN_WIDTH_A), D ** -0.5),
        'rpb_a': nrm((N_LAYERS_A, MIX_HEADS, 2 * NA_KH_MAX - 1, 2 * NA_KW - 1), 0.1),
        'w_in_b': nrm((N_LAYERS_B, D, IN_WIDTH_B), D ** -0.5),
        'q_norm_b': 1.0 + nrm((N_LAYERS_B, HEAD_DIM), 0.02),
        'k_norm_b': 1.0 + nrm((N_LAYERS_B, HEAD_DIM), 0.02),
        'w_in_c': nrm((N_LAYERS_C, D, IN_WIDTH_C), D ** -0.5),
        'conv_w_c': nrm((N_LAYERS_C, 3, HYENA_WIDTH), 3 ** -0.5),
        'conv_b_c': nrm((N_LAYERS_C, HYENA_WIDTH), 0.02),
        'filt_w1': nrm((N_LAYERS_C, HYENA_EMB, HYENA_FFN), HYENA_EMB ** -0.5),
        'filt_b1': nrm((N_LAYERS_C, HYENA_FFN), 0.02),
        'filt_w2': nrm((N_LAYERS_C, HYENA_FFN, HYENA_FFN), HYENA_FFN ** -0.5),
        'filt_b2': nrm((N_LAYERS_C, HYENA_FFN), 0.02),
        'filt_w3': nrm((N_LAYERS_C, HYENA_FFN, HYENA_FFN), HYENA_FFN ** -0.5),
        'filt_b3': nrm((N_LAYERS_C, HYENA_FFN), 0.02),
        'filt_w4': nrm((N_LAYERS_C, HYENA_FFN, 2 * HYENA_ORDER * MIX_WIDTH), HYENA_FFN ** -0.5),
        'filt_b4': nrm((N_LAYERS_C, 2 * HYENA_ORDER * MIX_WIDTH), 0.02),
        'filt_freq': 1.0 + nrm((N_LAYERS_C, HYENA_FFN), 0.02),
        'long_bias_c': nrm((N_LAYERS_C, HYENA_ORDER, MIX_WIDTH), 1.0),
        'w_mem_kv': nrm((DEPTH, D, 2 * MEM_WIDTH), D ** -0.5),
        'w_out': nrm((DEPTH, CAT_WIDTH, D), CAT_WIDTH ** -0.5 * DEEPNORM_BETA),
        'ln1_g': 1.0 + nrm((DEPTH, D), 0.02),
        'ln1_b': nrm((DEPTH, D), 0.02),
        'ln2_g': 1.0 + nrm((DEPTH, D), 0.02),
        'ln2_b': nrm((DEPTH, D), 0.02),
        'router_w': nrm((DEPTH, D, N_EXPERTS), D ** -0.5),
        'router_b': nrm((DEPTH, N_EXPERTS), 0.01),
        'moe_w1': nrm((DEPTH, N_EXPERTS, D, 2 * D_EXPERT), D ** -0.5),
        'moe_b1': nrm((DEPTH, N_EXPERTS, 2 * D_EXPERT), 0.02),
        'moe_w2': nrm((DEPTH, N_EXPERTS, D_EXPERT, D), D_EXPERT ** -0.5 * DEEPNORM_BETA),
        'moe_b2': nrm((DEPTH, N_EXPERTS, D), 0.02),
    }


def reference(x, mem, w_in_a, rpb_a, w_in_b, q_norm_b, k_norm_b, w_in_c, conv_w_c, conv_b_c,
              filt_w1, filt_b1, filt_w2, filt_b2, filt_w3, filt_b3, filt_w4, filt_b4, filt_freq,
              long_bias_c, w_mem_kv, w_out, ln1_g, ln1_b, ln2_g, ln2_b, router_w, router_b,
              moe_w1, moe_b1, moe_w2, moe_b2):
    B, L, _ = x.shape
    for i in range(DEPTH):
        kind = i % N_MIXERS
        j = i // N_MIXERS
        if kind == 0:
            proj = x @ w_in_a[j]
            q, k, v, q_mem = jnp.split(proj, [MIX_WIDTH, 2 * MIX_WIDTH, 3 * MIX_WIDTH], axis=-1)
            mix = neighbourhood_attention(split_heads(q, MIX_HEADS), split_heads(k, MIX_HEADS),
                                          split_heads(v, MIX_HEADS), rpb_a[j])
        elif kind == 1:
            proj = x @ w_in_b[j]
            q, k, v, q_mem = jnp.split(proj, [MIX_WIDTH, MIX_WIDTH + KV_WIDTH, MIX_WIDTH + 2 * KV_WIDTH], axis=-1)
            cos, sin = axial_rope_tables(L)
            q = apply_rope(rms_norm(split_heads(q, MIX_HEADS), q_norm_b[j]), cos, sin)
            k = apply_rope(rms_norm(split_heads(k, KV_HEADS), k_norm_b[j]), cos, sin)
            mix = gqa_blocked(q, k, split_heads(v, KV_HEADS))
        else:
            proj = x @ w_in_c[j]
            u, q_mem = jnp.split(proj, [HYENA_WIDTH], axis=-1)
            filt = hyena_filters(L, filt_w1[j], filt_b1[j], filt_w2[j], filt_b2[j], filt_w3[j],
                                 filt_b3[j], filt_w4[j], filt_b4[j], filt_freq[j])
            mix = hyena_mixer(u, conv_w_c[j], conv_b_c[j], filt, long_bias_c[j])
        k_mem, v_mem = jnp.split(mem @ w_mem_kv[i], 2, axis=-1)
        mem_out = memory_attention(split_heads(q_mem, MEM_HEADS), split_heads(k_mem, MEM_HEADS),
                                   split_heads(v_mem, MEM_HEADS))
        cat = jnp.concatenate([mix.reshape(B, L, MIX_WIDTH), mem_out.reshape(B, L, MEM_WIDTH)], axis=-1)
        x = layer_norm(DEEPNORM_ALPHA * x + cat @ w_out[i], ln1_g[i], ln1_b[i])
        y = moe(x, router_w[i], router_b[i], moe_w1[i], moe_b1[i], moe_w2[i], moe_b2[i])
        x = layer_norm(DEEPNORM_ALPHA * x + y, ln2_g[i], ln2_b[i])
    return x
```

```cpp
#include <hip/hip_runtime.h>
#include <hip/hip_bf16.h>
#include <cstdio>
#include <cstdint>

#ifndef MK_MULTI
#define MK_MULTI 0
#endif
#ifndef DBG_CHECK
#define DBG_CHECK 0
#endif
#ifndef DBG_LAST_PHASE
#define DBG_LAST_PHASE 9999
#endif

#ifndef EN_P0
#define EN_P0 1
#define EN_G1 1
#define EN_THIN 1
#define EN_TCONV 1
#define EN_NA 1
#define EN_ATTN 1
#define EN_G2 1
#define EN_LN 1
#define EN_G3 1
#define EN_G4 1
#endif

#ifndef REP_P0
#define REP_P0 1
#endif
#ifndef REP_G1
#define REP_G1 1
#endif
#ifndef REP_NA
#define REP_NA 1
#endif
#ifndef REP_ATTN
#define REP_ATTN 1
#endif
#ifndef REP_TCONV
#define REP_TCONV 1
#endif
#ifndef REP_THIN
#define REP_THIN 1
#endif
#ifndef REP_G3
#define REP_G3 1
#endif
#ifndef REP_G4
#define REP_G4 1
#endif
#ifndef ALIGN_EPI
#define ALIGN_EPI 1
#endif
#ifndef NT_STORE
#define NT_STORE 0
#endif
#ifndef PROBE_ST2
#define PROBE_ST2 0
#endif
#ifndef LN1_HOLD
#define LN1_HOLD 16
#endif
#ifndef DEFER_H
#define DEFER_H 0
#endif
#ifndef STAGGER
#define STAGGER 0
#endif
#ifndef REP_BAR
#define REP_BAR 1
#endif
#ifndef REP_DENSE
#define REP_DENSE 1
#endif
#ifndef REP_G2
#define REP_G2 1
#endif
#ifndef REP_LN1
#define REP_LN1 1
#endif
#ifndef REP_LN2
#define REP_LN2 1
#endif

#define GAS __attribute__((address_space(1)))
#define LAS __attribute__((address_space(3)))
typedef unsigned short bf16_t;
typedef short bf16x8 __attribute__((ext_vector_type(8)));
typedef short s16x4 __attribute__((ext_vector_type(4)));
typedef float f32x4 __attribute__((ext_vector_type(4)));
typedef float f32x2 __attribute__((ext_vector_type(2)));
typedef float f32x16 __attribute__((ext_vector_type(16)));
typedef unsigned u32x4 __attribute__((ext_vector_type(4)));
typedef unsigned u32x2 __attribute__((ext_vector_type(2)));
typedef GAS unsigned gu32;

constexpr int BATCH = 16, SEQ = 4096, DM = 1024, NTOK = BATCH * SEQ, DEPTH = 4;
constexpr int MEMLEN = 256, NMEM = BATCH * MEMLEN;
constexpr int NEXP = 32, NSLOT = NTOK * 4, IDXCAP = NTOK;
constexpr int GRIDW = 64;
constexpr float LN_EPS = 1e-5f;
constexpr float DN_ALPHA = 1.681792830507429f;
constexpr float LOG2E = 1.4426950408889634f;
constexpr float C2 = 0.125f * LOG2E;
__host__ __device__ constexpr int layer_kind(int l) { return l % 3; }
__host__ __device__ constexpr int layer_j(int l) { return l / 3; }
__host__ __device__ constexpr int in_width(int l) { return (l % 3) == 1 ? 1536 : 2560; }

#ifndef MOE_F8
#define MOE_F8 1
#endif
#ifndef INP_F8
#define INP_F8 1
#endif
constexpr int INP_EB = INP_F8 ? 1 : 2;
constexpr float WIN_SCALE = 32.0f;
#ifndef OUTP_F8
#define OUTP_F8 1
#endif
constexpr int OUT_EB = OUTP_F8 ? 1 : 2;
constexpr float WOUT_SCALE = 64.0f;
__device__ __forceinline__ unsigned char f2fp8(float x) { return (unsigned char)(__builtin_amdgcn_cvt_pk_fp8_f32(x, x, 0, false) & 0xff); }
#ifndef TCONV_F8
#define TCONV_F8 1
#endif
#ifndef Y_F8
#define Y_F8 0
#endif
constexpr float Y_SCALE = 64.0f;
constexpr int MOE_EB = MOE_F8 ? 1 : 2;
constexpr float W1_SCALE = 32.0f, W2_SCALE = 64.0f, H_SCALE = 4.0f;

constexpr size_t MiB = 1u << 20;
constexpr size_t WS_CTL = 0, CTL_ZERO_BYTES = 1 * MiB;
constexpr size_t WS_WIN = 2 * MiB;
constexpr size_t WS_WKV = 22 * MiB;
constexpr size_t WS_WOUT = 26 * MiB;
constexpr size_t WS_W1 = 34 * MiB;
constexpr size_t WS_W2 = 546 * MiB;
constexpr size_t WS_XB = 802 * MiB;
constexpr size_t WS_MEMB = 930 * MiB;
constexpr size_t WS_KVM = 938 * MiB;
constexpr size_t WS_PROJ = 954 * MiB;
constexpr size_t WS_CAT = 1274 * MiB;
constexpr size_t WS_H = 1402 * MiB;
constexpr size_t WS_Y = 1914 * MiB;
constexpr size_t WS_HRAWT = 2426 * MiB;
constexpr size_t WS_HPART = 2474 * MiB;
constexpr size_t WS_EXPID = 2478 * MiB;
constexpr size_t WS_GATE = 2479 * MiB;
constexpr size_t WS_IDX = 2480 * MiB;
constexpr size_t WS_SB = 2488 * MiB;
constexpr size_t WS_GIDX = 2616 * MiB;
constexpr size_t WS_END = 2624 * MiB;
constexpr size_t WS_UT3 = WS_H;
constexpr size_t WS_Z1T = WS_H + 288 * MiB;
constexpr size_t WS_Z2T = WS_H + 384 * MiB;
constexpr size_t WS_V8 = WS_Y;
constexpr size_t WS_QKR = WS_Y;
constexpr int CW_BAR = 4096;
constexpr int CW_CNT = 8192;
constexpr int CW_DBG = 12288;

constexpr int MISC_OFF = 150528;
constexpr int LDS_BYTES = 151552;

#define LDS_WAIT() asm volatile("s_waitcnt lgkmcnt(0)" ::: "memory")
#define VM_WAIT() asm volatile("s_waitcnt vmcnt(0)" ::: "memory")
__device__ __forceinline__ unsigned f2bf(float f) { unsigned u = __builtin_bit_cast(unsigned, f); return (u + 0x7fffu + ((u >> 16) & 1u)) >> 16; }
__device__ __forceinline__ unsigned pk2(float lo, float hi) { return f2bf(lo) | (f2bf(hi) << 16); }
__device__ __forceinline__ float bf2f(unsigned short b) { return __builtin_bit_cast(float, ((unsigned)b) << 16); }
__device__ __forceinline__ float bflo(unsigned w) { return __builtin_bit_cast(float, w << 16); }
__device__ __forceinline__ float bfhi(unsigned w) { return __builtin_bit_cast(float, w & 0xffff0000u); }
__device__ __forceinline__ float shflx(float v, int mask, int lane) { int t; asm volatile("v_mov_b32 %0, %1" : "=v"(t) : "v"(__builtin_bit_cast(int, v))); return __builtin_bit_cast(float, __builtin_amdgcn_ds_bpermute((lane ^ mask) << 2, t)); }
__device__ __forceinline__ int shflxi(int v, int mask, int lane) { return __builtin_amdgcn_ds_bpermute((lane ^ mask) << 2, v); }
template <int CTRL> __device__ __forceinline__ float dpp_x(float v) { return __builtin_bit_cast(float, __builtin_amdgcn_update_dpp(0, __builtin_bit_cast(int, v), CTRL, 0xF, 0xF, false)); }
__device__ __forceinline__ float group8_sum(float v) { v += dpp_x<0xB1>(v); v += dpp_x<0x4E>(v); v += dpp_x<0x141>(v); return v; }
__device__ __forceinline__ float wave_sum(float v, int  ) {
    v += dpp_x<0xB1>(v); v += dpp_x<0x4E>(v); v += dpp_x<0x141>(v); v += dpp_x<0x140>(v);
    v += __builtin_bit_cast(float, __builtin_amdgcn_update_dpp(0, __builtin_bit_cast(int, v), 0x142, 0xA, 0xF, false));
    v += __builtin_bit_cast(float, __builtin_amdgcn_update_dpp(0, __builtin_bit_cast(int, v), 0x143, 0xC, 0xF, false));
    return __builtin_bit_cast(float, __builtin_amdgcn_readlane(__builtin_bit_cast(int, v), 63));
}
__device__ __forceinline__ int lane_id_volatile() { int l; asm volatile("v_mbcnt_lo_u32_b32 %0, -1, 0\n\tv_mbcnt_hi_u32_b32 %0, -1, %0" : "=&v"(l)); return l; }
__device__ __forceinline__ int opaque_tid(int wave0) { return wave0 * 64 + lane_id_volatile(); }

#define XB_TMO      128
#define XB_XCNT(j)  (256  + 64 * (j))
#define XB_XSUB(j)  (1280 + 64 * (j))
#define XB_XGEN(j)  (2304 + 64 * (j))
#define XB_TOP      3328
#define XB_TOPGEN   3392
#define XCD_BAR_WORDS 3456
#define XB_SPIN_CAP (1u << 20)

__device__ __forceinline__ unsigned xb_ld(unsigned* p)              { return __hip_atomic_load(p, __ATOMIC_RELAXED, __HIP_MEMORY_SCOPE_AGENT); }
__device__ __forceinline__ unsigned xb_add(unsigned* p, unsigned v) { return __hip_atomic_fetch_add(p, v, __ATOMIC_RELAXED, __HIP_MEMORY_SCOPE_AGENT); }
__device__ __forceinline__ unsigned xb_xcc_id() { return (unsigned)__builtin_amdgcn_s_getreg((3 << 11) | 20) & 0xFu; }
#define XB_SPIN(cond, bar) do { unsigned _sp = 0; while (cond) { __builtin_amdgcn_s_sleep(1); \
    if ((++_sp & 255u) == 0u) { if (xb_ld(&(bar)[XB_TMO])) break; if (_sp > XB_SPIN_CAP) { atomicAdd(&(bar)[XB_TMO], 1u); break; } } } } while (0)

struct XcdBarrier {
    unsigned* bar; unsigned x;
    volatile LAS unsigned* st;
};
__device__ __forceinline__ XcdBarrier xcd_barrier_post(unsigned* bar, volatile LAS unsigned* st) {
    XcdBarrier b; b.bar = bar; b.x = xb_xcc_id(); b.st = st;
    if (threadIdx.x == 0) (void)xb_add(&bar[XB_XCNT(b.x)], 1u);
    return b;
}
__device__ __forceinline__ void xcd_barrier_complete(unsigned* bar, unsigned x, unsigned& nloc, unsigned& nx) {
    const unsigned G = gridDim.x * gridDim.y * gridDim.z;
    unsigned sum, cnt, mine, sp = 0u;
    for (;;) {
        sum = 0u; cnt = 0u; mine = 0u;
#pragma unroll 1
        for (unsigned j = 0; j < 16; ++j) { const unsigned c = xb_ld(&bar[XB_XCNT(j)]); sum += c; cnt += (c > 0u) ? 1u : 0u; mine = (j == x) ? c : mine; }
        if (sum == G) break;
        __builtin_amdgcn_s_sleep(1);
        if ((++sp & 255u) == 0u) { if (xb_ld(&bar[XB_TMO])) break; if (sp > XB_SPIN_CAP) { atomicAdd(&bar[XB_TMO], 1u); break; } }
    }
    nloc = mine > 0u ? mine : 1u; nx = cnt > 0u ? cnt : 1u;
}
__device__ __forceinline__ void xcd_barrier(const XcdBarrier& b, const int wave0) {
    asm volatile("s_waitcnt vmcnt(0)" ::: "memory");
    __syncthreads();
    if (wave0 == 0 && lane_id_volatile() == 0) {
        unsigned* bar = b.bar;
        __builtin_amdgcn_s_waitcnt(0);
        unsigned nloc = b.st[0], nx = b.st[1];
        if (nloc == 0u) { xcd_barrier_complete(bar, b.x, nloc, nx); b.st[0] = nloc; b.st[1] = nx; }
        const unsigned old = xb_add(&bar[XB_XSUB(b.x)], 1u);
        const unsigned gen = old / nloc;
        if (old + 1u == (gen + 1u) * nloc) {
            __builtin_amdgcn_fence(__ATOMIC_RELEASE, "agent");
            asm volatile("s_waitcnt vmcnt(0)" ::: "memory");
            const unsigned og = xb_add(&bar[XB_TOP], 1u);
            const unsigned tg = og / nx;
            if (og + 1u == (tg + 1u) * nx) xb_add(&bar[XB_TOPGEN], 1u);
            else XB_SPIN(xb_ld(&bar[XB_TOPGEN]) == tg, bar);
            __builtin_amdgcn_fence(__ATOMIC_ACQUIRE, "agent");
            xb_add(&bar[XB_XGEN(b.x)], 1u);
            asm volatile("s_waitcnt vmcnt(0)" ::: "memory");
        } else {
            XB_SPIN(xb_ld(&bar[XB_XGEN(b.x)]) == gen, bar);
            __builtin_amdgcn_fence(__ATOMIC_ACQUIRE, "agent");
            asm volatile("s_waitcnt vmcnt(0)" ::: "memory");
        }
    }
    __syncthreads();
}

namespace pg8 {
constexpr int BM = 256, BK = 64, HALF = 128, HTB = HALF * BK * 2  , STAGE_BYTES = 8 * HTB, NXCD = 8, WGM = 8;
__host__ __device__ __forceinline__ int lds_byte(int r, int c) { const int st = (r >> 4) * 2 + (c >> 5), rr = r & 15, cc = c & 31, ob = rr * 64 + cc * 2; return st * 1024 + (ob ^ (((ob >> 9) & 1) << 5)); }
__host__ __device__ __forceinline__ void stage_rc(int b, int& R, int& C) { const int st = b / 1024, sb = b % 1024, swz = sb ^ (((sb >> 9) & 1) << 5); R = (st >> 1) * 16 + swz / 64; C = (st & 1) * 32 + (swz % 64) / 2; }
__host__ __device__ __forceinline__ int perm32(int rho) { const int n = rho >> 4, i = rho & 15; return 8 * (i >> 2) + 4 * n + (i & 3); }

struct Unit { int pm, pn, e, p; };

struct DenseOrder {
    const char* A; const char* Bt; int KB; int nM, nN, nwg, G, c; int rep = 1;
    __device__ __forceinline__ void init(const void* A_, const void* Bt_, int M, int N, int KB_, int G_, int c_) { A = (const char*)A_; Bt = (const char*)Bt_; KB = KB_; nM = M / BM; nN = N / BM; nwg = nM * nN; G = G_; c = c_; }
    __device__ __forceinline__ bool next(int i, Unit& u) const {
        long L = (long)i * G + c; if (L >= (long)nwg * rep) return false;
        if (rep > 1) L %= nwg;
        int wgid = (int)L; { const int q = nwg / NXCD, r = nwg % NXCD, xcd = wgid % NXCD, off = wgid / NXCD; wgid = (xcd < r ? xcd * (q + 1) : r * (q + 1) + (xcd - r) * q) + off; }
        const int nig = WGM * nN, gid = wgid / nig, fm = gid * WGM, gsz = (nM - fm) < WGM ? (nM - fm) : WGM;
        u.pm = __builtin_amdgcn_readfirstlane(fm + ((wgid % nig) % gsz)); u.pn = __builtin_amdgcn_readfirstlane((wgid % nig) / gsz); u.e = 0; u.p = 0; return true;
    }
    __device__ __forceinline__ const char* a_base(const Unit& u) const { return A + (size_t)u.pm * BM * KB; }
    __device__ __forceinline__ const char* b_base(const Unit& u) const { return Bt + (size_t)u.pn * BM * KB; }
    __device__ __forceinline__ const int* idx_src(const Unit&) const { return nullptr; }
    __device__ __forceinline__ int nvalid(const Unit&) const { return BM; }
    static constexpr int ROW_SHIFT = 0;
};
template <int SHIFT  > struct MoeOrder {
    const char* A; const char* Bt; int KB; int nN; int G, c; size_t bstride; const LAS int* pref; const int* cnt; const int* idx;
    __device__ __forceinline__ bool next(int i, Unit& u) const {
        const long L = (long)i * G + c; const int tot = __builtin_amdgcn_readfirstlane(pref[NEXP]);
        if (L >= (long)tot * nN) return false;
        const int pg = __builtin_amdgcn_readfirstlane((int)(L / nN)); u.pn = __builtin_amdgcn_readfirstlane((int)(L % nN));
        int e = 0;
#pragma unroll
        for (int step = 16; step >= 1; step >>= 1) { const int v = __builtin_amdgcn_readfirstlane(pref[e + step]); e += (v <= pg) ? step : 0; }
        u.e = e; u.p = pg - __builtin_amdgcn_readfirstlane(pref[e]); u.pm = 0; return true;
    }
    __device__ __forceinline__ const char* a_base(const Unit&) const { return A; }
    __device__ __forceinline__ const char* b_base(const Unit& u) const { return Bt + (size_t)u.e * bstride + (size_t)u.pn * BM * KB; }
    __device__ __forceinline__ const int* idx_src(const Unit& u) const { return idx + (size_t)u.e * IDXCAP + u.p * BM; }
    __device__ __forceinline__ int nvalid(const Unit& u) const { const int n = __builtin_amdgcn_readfirstlane(pref[40 + u.e]) - u.p * BM; return n < BM ? n : BM; }
    static constexpr int ROW_SHIFT = SHIFT;
};

__device__ __forceinline__ unsigned cvt_pk_bf16(float lo, float hi) { unsigned r; asm volatile("v_cvt_pk_bf16_f32 %0, %1, %2" : "=v"(r) : "v"(lo), "v"(hi)); return r; }

struct EpiBf16s {
    static constexpr bool PERM = true; static constexpr bool HAS_BIAS = false;
    bf16_t* O; int ldc; unsigned smask; float scale; float base;
    __device__ __forceinline__ void operator()(const f32x4 (&acc)[2][2][4][2], const Unit& u, int wr, int wc, int fr, int fq) const {
        const int row0 = u.pm * BM + wr * 64 + fr, col0 = u.pn * BM + wc * 32 + 8 * fq;
        const float sc = (((smask >> u.pn) & 1u) ? scale : 1.f) * base;
#pragma unroll
        for (int ai = 0; ai < 2; ++ai)
#pragma unroll
            for (int m = 0; m < 4; ++m) { bf16_t* rowp = O + (size_t)(row0 + ai * HALF + m * 16) * ldc + col0;
#pragma unroll
                for (int bj = 0; bj < 2; ++bj) { const f32x4 v0 = acc[ai][bj][m][0] * sc, v1 = acc[ai][bj][m][1] * sc;
                    u32x4 w; w.x = cvt_pk_bf16(v0[0], v0[1]); w.y = cvt_pk_bf16(v0[2], v0[3]); w.z = cvt_pk_bf16(v1[0], v1[1]); w.w = cvt_pk_bf16(v1[2], v1[3]);
                    if (NT_STORE) __builtin_nontemporal_store(w, (u32x4*)(rowp + bj * HALF)); else *(u32x4*)(rowp + bj * HALF) = w; }
                asm volatile("" ::: "memory"); }
    }
};
struct EpiResB {
    static constexpr bool PERM = true; static constexpr bool HAS_BIAS = false;
    bf16_t* C; const void* res; int res_f32; int ldc; float alpha; float ascale;
    __device__ __forceinline__ void operator()(const f32x4 (&acc)[2][2][4][2], const Unit& u, int wr, int wc, int fr, int fq) const {
        const int row0 = u.pm * BM + wr * 64 + fr, col0 = u.pn * BM + wc * 32 + 8 * fq;
#pragma unroll
        for (int ai = 0; ai < 2; ++ai)
#pragma unroll
            for (int m = 0; m < 4; ++m) { const size_t off = (size_t)(row0 + ai * HALF + m * 16) * ldc + col0;
#pragma unroll
                for (int bj = 0; bj < 2; ++bj) { f32x4 r0, r1;
                    if (res_f32) { const float* rp = (const float*)res + off + bj * HALF; r0 = *(const f32x4*)rp; r1 = *(const f32x4*)(rp + 4); }
                    else { const u32x4 raw = *(const u32x4*)((const bf16_t*)res + off + bj * HALF); r0 = (f32x4){bflo(raw.x), bfhi(raw.x), bflo(raw.y), bfhi(raw.y)}; r1 = (f32x4){bflo(raw.z), bfhi(raw.z), bflo(raw.w), bfhi(raw.w)}; }
                    const f32x4 v0 = r0 * alpha + acc[ai][bj][m][0] * ascale, v1 = r1 * alpha + acc[ai][bj][m][1] * ascale;
                    u32x4 w; w.x = cvt_pk_bf16(v0[0], v0[1]); w.y = cvt_pk_bf16(v0[2], v0[3]); w.z = cvt_pk_bf16(v1[0], v1[1]); w.w = cvt_pk_bf16(v1[2], v1[3]);
                    *(u32x4*)(C + off + bj * HALF) = w; }
                asm volatile("" ::: "memory"); }
    }
};
struct Pend { u32x2 val[8]; };
struct EpiSwiglu {
    static constexpr bool PERM = true; static constexpr bool HAS_GATE = false; static constexpr bool HAS_BIAS = true;
    __device__ __forceinline__ const unsigned* bias_src(const Unit& u, int i) const { return (const unsigned*)(b1 + (size_t)u.e * 2048 + u.pn * HALF + i + (i >> 7) * 896); }
    bf16_t* H; const float* b1;
    __device__ __forceinline__ void prepare(const f32x4 (&acc)[2][2][4][2], const Unit& u, int wr, int wc, int fr, int fq, Pend& pd, const LAS float* bl) const {
        constexpr float ASC = 1.0f / W1_SCALE, HS = H_SCALE, KK = -1.702f * LOG2E, GA = ASC * KK, UA = ASC * HS / KK, ULO = 8.0f * HS / KK, UHI = -6.0f * HS / KK, GLO = 7.0f * KK;
        const LAS float* bq = bl + wc * 32 + 8 * fq; const f32x4 bp[4] = {*(const LAS f32x4*)bq, *(const LAS f32x4*)(bq + 4), *(const LAS f32x4*)(bq + HALF), *(const LAS f32x4*)(bq + HALF + 4)};
        const f32x4 bg0 = bp[0] * KK, bg1 = bp[1] * KK; f32x4 bu0 = (bp[2] + 1.0f) * (HS / KK), bu1 = (bp[3] + 1.0f) * (HS / KK);
        asm volatile("" : "+v"(bu0), "+v"(bu1));
#pragma unroll
        for (int q8 = 0; q8 < 8; ++q8) { const int ai = q8 >> 2, m = q8 & 3;
            float o[8];
#pragma unroll
            for (int q = 0; q < 8; ++q) { const float gb = (q < 4 ? bg0[q & 3] : bg1[q & 3]), ub = (q < 4 ? bu0[q & 3] : bu1[q & 3]);
                const float gp = fmaxf(__builtin_fmaf(acc[ai][0][m][q >> 2][q & 3], GA, gb), GLO);
                const float us = fminf(fmaxf(__builtin_fmaf(acc[ai][1][m][q >> 2][q & 3], UA, ub), ULO), UHI);
                const float sg = __builtin_amdgcn_rcpf(1.0f + __builtin_amdgcn_exp2f(gp));
                o[q] = us * (gp * sg); }
            int w0 = 0, w1 = 0;
            w0 = __builtin_amdgcn_cvt_pk_fp8_f32(o[0], o[1], w0, false); w0 = __builtin_amdgcn_cvt_pk_fp8_f32(o[2], o[3], w0, true);
            w1 = __builtin_amdgcn_cvt_pk_fp8_f32(o[4], o[5], w1, false); w1 = __builtin_amdgcn_cvt_pk_fp8_f32(o[6], o[7], w1, true);
            pd.val[q8] = (u32x2){(unsigned)w0, (unsigned)w1}; }
    }
    __device__ __forceinline__ void store_one(const u32x2 v, const LAS int* ids, const int r, const int nv, const int j0) const { if (r < nv) { const int slot = ids[r]; *(u32x2*)((unsigned char*)H + (size_t)slot * 1024 + j0) = v; } }
    __device__ __forceinline__ void operator()(const f32x4 (&acc)[2][2][4][2], const Unit& u, int wr, int wc, int fr, int fq, const LAS int* ids, const int nv, const LAS float* bl) const {
        constexpr float ASC = MOE_F8 ? 1.0f / W1_SCALE : 1.0f;
        const LAS float* bq = bl + wc * 32 + 8 * fq; const f32x4 bp[4] = {*(const LAS f32x4*)bq, *(const LAS f32x4*)(bq + 4), *(const LAS f32x4*)(bq + HALF), *(const LAS f32x4*)(bq + HALF + 4)};
        constexpr float HS = MOE_F8 ? H_SCALE : 1.0f, KK = -1.702f * LOG2E, GA = ASC * KK, UA = ASC * HS / KK, ULO = 8.0f * HS / KK, UHI = -6.0f * HS / KK, GLO = 7.0f * KK;
        const int j0 = u.pn * HALF + wc * 32 + 8 * fq;
        const f32x4 bg0 = bp[0] * KK, bg1 = bp[1] * KK; f32x4 bu0 = (bp[2] + 1.0f) * (HS / KK), bu1 = (bp[3] + 1.0f) * (HS / KK);
        asm volatile("" : "+v"(bu0), "+v"(bu1));
        int rb = wr * 64 + fr; asm volatile("" : "+v"(rb));
        const LAS int* idp = ids + rb; int slots[8];
#pragma unroll
        for (int q = 0; q < 8; ++q) slots[q] = idp[(q >> 2) * HALF + (q & 3) * 16];
#pragma unroll
        for (int ai = 0; ai < 2; ++ai)
#pragma unroll
            for (int m = 0; m < 4; ++m) { const int r = ai * HALF + m * 16 + rb;
                if (r < nv) { const int slot = slots[ai * 4 + m];
                    float o[8];
#pragma unroll
                    for (int q = 0; q < 8; ++q) { const float gb = (q < 4 ? bg0[q & 3] : bg1[q & 3]), ub = (q < 4 ? bu0[q & 3] : bu1[q & 3]);
                        const float gp = fmaxf(__builtin_fmaf(acc[ai][0][m][q >> 2][q & 3], GA, gb), GLO);
                        const float us = fminf(fmaxf(__builtin_fmaf(acc[ai][1][m][q >> 2][q & 3], UA, ub), ULO), UHI);
                        const float sg = __builtin_amdgcn_rcpf(1.0f + __builtin_amdgcn_exp2f(gp));
                        o[q] = us * (gp * sg); }
                    if constexpr (MOE_F8) { int w0 = 0, w1 = 0;
                        w0 = __builtin_amdgcn_cvt_pk_fp8_f32(o[0], o[1], w0, false); w0 = __builtin_amdgcn_cvt_pk_fp8_f32(o[2], o[3], w0, true);
                        w1 = __builtin_amdgcn_cvt_pk_fp8_f32(o[4], o[5], w1, false); w1 = __builtin_amdgcn_cvt_pk_fp8_f32(o[6], o[7], w1, true);
                        *(u32x2*)((unsigned char*)H + (size_t)slot * 1024 + j0) = (u32x2){(unsigned)w0, (unsigned)w1};
                    } else { u32x4 w; w.x = cvt_pk_bf16(o[0], o[1]); w.y = cvt_pk_bf16(o[2], o[3]); w.z = cvt_pk_bf16(o[4], o[5]); w.w = cvt_pk_bf16(o[6], o[7]);
                        *(u32x4*)(H + (size_t)slot * 1024 + j0) = w; } } }
    }
};
struct EpiMoeOut {
    static constexpr bool PERM = true; static constexpr bool HAS_GATE = true; static constexpr bool HAS_BIAS = true;
    __device__ __forceinline__ const unsigned* bias_src(const Unit& u, int i) const { return (const unsigned*)(b2 + (size_t)u.e * 1024 + u.pn * BM + i); }
    bf16_t* Y; const float* b2;   const float* gidx;
    __device__ __forceinline__ void operator()(const f32x4 (&acc)[2][2][4][2], const Unit& u, int wr, int wc, int fr, int fq, const LAS int* ids, const int nv, const LAS float* bl) const {
        const LAS float* bq = bl + wc * 32 + 8 * fq; const f32x4 bp[4] = {*(const LAS f32x4*)bq, *(const LAS f32x4*)(bq + 4), *(const LAS f32x4*)(bq + HALF), *(const LAS f32x4*)(bq + HALF + 4)};
        const LAS float* gts = (const LAS float*)(ids + 768);
        constexpr float OSC = MOE_F8 ? 1.0f / (H_SCALE * W2_SCALE) : 1.0f;
        const int c0 = u.pn * BM + wc * 32 + 8 * fq;
        f32x4 bv[2][2]; bv[0][0] = bp[0]; bv[0][1] = bp[1]; bv[1][0] = bp[2]; bv[1][1] = bp[3];
        int rb = wr * 64 + fr; asm volatile("" : "+v"(rb));
        const LAS int* idp = ids + rb; int slots[8];
#pragma unroll
        for (int q = 0; q < 8; ++q) slots[q] = idp[(q >> 2) * HALF + (q & 3) * 16];
#pragma unroll
        for (int ai = 0; ai < 2; ++ai)
#pragma unroll
            for (int m = 0; m < 4; ++m) { const int r = ai * HALF + m * 16 + rb;
                if (r < nv) { const int slot = slots[ai * 4 + m]; const float gt = gts[r];
#pragma unroll
                    for (int bj = 0; bj < 2; ++bj) { const f32x4 v0 = (acc[ai][bj][m][0] * OSC + bv[bj][0]) * gt, v1 = (acc[ai][bj][m][1] * OSC + bv[bj][1]) * gt;
                        if constexpr (Y_F8) { const f32x4 s0 = v0 * Y_SCALE, s1 = v1 * Y_SCALE; int w0 = 0, w1 = 0;
                            w0 = __builtin_amdgcn_cvt_pk_fp8_f32(s0[0], s0[1], w0, false); w0 = __builtin_amdgcn_cvt_pk_fp8_f32(s0[2], s0[3], w0, true); w1 = __builtin_amdgcn_cvt_pk_fp8_f32(s1[0], s1[1], w1, false); w1 = __builtin_amdgcn_cvt_pk_fp8_f32(s1[2], s1[3], w1, true);
                            *(u32x2*)((unsigned char*)Y + (size_t)slot * 1024 + c0 + bj * HALF) = (u32x2){(unsigned)w0, (unsigned)w1}; }
                        else { u32x4 w; w.x = cvt_pk_bf16(v0[0], v0[1]); w.y = cvt_pk_bf16(v0[2], v0[3]); w.z = cvt_pk_bf16(v1[0], v1[1]); w.w = cvt_pk_bf16(v1[2], v1[3]);
                        if (NT_STORE) __builtin_nontemporal_store(w, (u32x4*)(Y + (size_t)slot * 1024 + c0 + bj * HALF)); else *(u32x4*)(Y + (size_t)slot * 1024 + c0 + bj * HALF) = w;
                        if (PROBE_ST2) { asm volatile("" : "+v"(w) :: "memory"); *(u32x4*)(Y + (size_t)slot * 1024 + c0 + bj * HALF) = w; } } } } }
    }
};

__device__ __forceinline__ const char* uni_ptr(const char* p) { const unsigned long long v = (unsigned long long)p; const unsigned lo = __builtin_amdgcn_readfirstlane((unsigned)v), hi = __builtin_amdgcn_readfirstlane((unsigned)(v >> 32)); return (const char*)(((unsigned long long)hi << 32) | lo); }
typedef int v4i_t __attribute__((ext_vector_type(4))); typedef int v8i_t __attribute__((ext_vector_type(8)));
__device__ __forceinline__ v8i_t cat8(const bf16x8 a, const bf16x8 b) { return __builtin_shufflevector(__builtin_bit_cast(v4i_t, a), __builtin_bit_cast(v4i_t, b), 0, 1, 2, 3, 4, 5, 6, 7); }
template <class Epi, class Sched, bool GATHER, bool F8 = false, bool DEFER = false>
__device__ __forceinline__ void gemm_phase(LAS unsigned char* lds, const Sched& S, const Epi& E, const int tid) {
    const int wid = __builtin_amdgcn_readfirstlane(tid >> 6), lane = tid & 63, wr = wid >> 2, wc = wid & 3, fr = lane & 15, fq = lane >> 4;
    const int KB = S.KB, nt = KB / 128;
    unsigned voffA[2], voffB[2];
#pragma unroll
    for (int i = 0; i < 2; ++i) { int R, C; stage_rc(tid * 16 + i * 8192, R, C); const int Rb = Epi::PERM ? ((R & ~31) + perm32(R & 31)) : R;
        voffA[i] = (unsigned)(R * KB + C * 2); voffB[i] = (unsigned)(Rb * KB + C * 2); }
    const size_t kstep = (size_t)(BK * 2);
    const size_t hstep = (size_t)HALF * KB;
    const unsigned ldsw = (unsigned)wid * 1024u;
    const int aoff = lds_byte(wr * 64 + fr, fq * 8), boff = lds_byte(wc * 32 + fr, fq * 8);
#define PG8_SA(b, h) (((b) * 2 + (h)) * HTB)
#define PG8_SB(b, h) ((4 + (b) * 2 + (h)) * HTB)
#define PG8_STAGE(bufoff, gbase, voff) do { const char* _gb = uni_ptr((const char*)(gbase)); _Pragma("unroll") for (int _i = 0; _i < 2; ++_i) \
        __builtin_amdgcn_global_load_lds((const unsigned*)(_gb + (voff)[_i]), (LAS unsigned*)(lds + (bufoff) + ldsw + _i * 8192), 16, 0, 0); } while (0)
#define PG8_STAGE_A(bufoff, kb, h, GO) do { if constexpr (GATHER) { PG8_STAGE(bufoff, kb, (GO)[h]); } else { PG8_STAGE(bufoff, (kb) + (h) * hstep, voffA); } } while (0)
#define PG8_LDA(dst, b, h) do { if constexpr (F8) { _Pragma("unroll") for (int m = 0; m < 4; ++m) dst##8[m] = cat8(*(const LAS bf16x8*)(lds + PG8_SA(b, h) + aoff + m * 2048), *(const LAS bf16x8*)(lds + PG8_SA(b, h) + aoff + m * 2048 + 1024)); } else { \
        _Pragma("unroll") for (int m = 0; m < 4; ++m) _Pragma("unroll") for (int k = 0; k < 2; ++k) dst[m][k] = *(const LAS bf16x8*)(lds + PG8_SA(b, h) + aoff + m * 2048 + k * 1024); } } while (0)
#define PG8_LDB(dst, b, h) do { if constexpr (F8) { _Pragma("unroll") for (int n = 0; n < 2; ++n) dst##8[n] = cat8(*(const LAS bf16x8*)(lds + PG8_SB(b, h) + boff + n * 2048), *(const LAS bf16x8*)(lds + PG8_SB(b, h) + boff + n * 2048 + 1024)); } else { \
        _Pragma("unroll") for (int n = 0; n < 2; ++n) _Pragma("unroll") for (int k = 0; k < 2; ++k) dst[n][k] = *(const LAS bf16x8*)(lds + PG8_SB(b, h) + boff + n * 2048 + k * 1024); } } while (0)
#define PG8_MMA(ai, bj, At, Bt) do { __builtin_amdgcn_s_setprio(1); if constexpr (F8) { _Pragma("unroll") for (int m = 0; m < 4; ++m) _Pragma("unroll") for (int n = 0; n < 2; ++n) \
        acc[ai][bj][m][n] = __builtin_amdgcn_mfma_scale_f32_16x16x128_f8f6f4(Bt##8[n], At##8[m], acc[ai][bj][m][n], 0, 0, 0, 0, 0, 0); } else { \
        _Pragma("unroll") for (int m = 0; m < 4; ++m) _Pragma("unroll") for (int n = 0; n < 2; ++n) _Pragma("unroll") for (int k = 0; k < 2; ++k) \
        acc[ai][bj][m][n] = __builtin_amdgcn_mfma_f32_16x16x32_bf16(Bt[n][k], At[m][k], acc[ai][bj][m][n], 0, 0, 0); } __builtin_amdgcn_s_setprio(0); } while (0)
#define PG8_WAIT_V(n) asm volatile("s_waitcnt vmcnt(" #n ")" ::: "memory")
#define PG8_WAIT_L(n) asm volatile("s_waitcnt lgkmcnt(" #n ")" ::: "memory")
#define PG8_BAR __builtin_amdgcn_s_barrier()
#define PG8_SCHED __builtin_amdgcn_sched_barrier(0)
    LAS int* const ibuf = (LAS int*)(lds + STAGE_BYTES + 512);
#define PG8_IDMA(u, b) do { if constexpr (GATHER) { __builtin_amdgcn_global_load_lds((const unsigned*)(S.idx_src(u) + 64 * (wid & 3) + lane), (LAS unsigned*)(ibuf + (b) * 256 + 64 * (wid & 3)), 4, 0, 0); \
        if constexpr (Epi::HAS_GATE) __builtin_amdgcn_global_load_lds((const unsigned*)(E.gidx + (S.idx_src(u) - S.idx) + 64 * (wid & 3) + lane), (LAS unsigned*)(ibuf + 768 + (b) * 256 + 64 * (wid & 3)), 4, 0, 0); \
        if constexpr (Epi::HAS_BIAS) __builtin_amdgcn_global_load_lds(E.bias_src(u, 64 * (wid & 3) + lane), (LAS unsigned*)(ibuf + 1536 + (b) * 256 + 64 * (wid & 3)), 4, 0, 0); } } while (0)
#define PG8_GOFF(dst, u, b) do { if constexpr (GATHER) { int _t = tid; asm volatile("" : "+v"(_t)); const int _nv = S.nvalid(u); _Pragma("unroll") for (int _i = 0; _i < 2; ++_i) { int _R, _C; stage_rc(_t * 16 + _i * 8192, _R, _C); \
        _Pragma("unroll") for (int _h = 0; _h < 2; ++_h) { const int _r = _R + _h * HALF; const unsigned _s = (unsigned)ibuf[(b) * 256 + (_r < _nv ? _r : 0)]; dst[_h][_i] = (_s >> Sched::ROW_SHIFT) * (unsigned)KB + (unsigned)_C * 2u; } } } } while (0)
    Unit cur, nxt; int ui = 0;
    if (!S.next(0, cur)) return;
    f32x4 acc[2][2][4][2];
#pragma unroll
    for (int a = 0; a < 2; ++a)
#pragma unroll
        for (int b = 0; b < 2; ++b)
#pragma unroll
            for (int m = 0; m < 4; ++m)
#pragma unroll
                for (int n = 0; n < 2; ++n) acc[a][b][m][n] = (f32x4){0.f, 0.f, 0.f, 0.f};
    bf16x8 At[4][2], B0[2][2], B1[2][2];
    v8i_t At8[4], B08[2], B18[2];
    unsigned gA[2][2] = {{0u, 0u}, {0u, 0u}}, gN[2][2] = {{0u, 0u}, {0u, 0u}};
    int bsel = 0;
    Pend pend; int ppn = 0, pnv = 0, pq = 8, pbuf = 0;
    if constexpr (DEFER) {
#pragma unroll
        for (int q = 0; q < 8; ++q) pend.val[q] = (u32x2){0u, 0u}; }
#define PG8_PSTORE() do { if constexpr (DEFER) { const int _l3 = lane_id_volatile(); const int _nv = (pq < 8) ? pnv : 0; \
        E.store_one(pend.val[0], ibuf + pbuf * 256, ((pq >> 2) & 1) * HALF + (pq & 3) * 16 + wr * 64 + (_l3 & 15), _nv, ppn * HALF + wc * 32 + 8 * (_l3 >> 4)); \
        _Pragma("unroll") for (int _q = 0; _q < 7; ++_q) pend.val[_q] = pend.val[_q + 1]; ++pq; } } while (0)
    if constexpr (GATHER) { PG8_IDMA(cur, 0); PG8_WAIT_V(0); PG8_BAR; }
    PG8_GOFF(gA, cur, 0);
    const char* cA = S.a_base(cur); const char* cB = S.b_base(cur);
    PG8_STAGE(PG8_SB(0, 0), cB, voffB); PG8_STAGE(PG8_SB(0, 1), cB + hstep, voffB); PG8_STAGE_A(PG8_SA(0, 0), cA, 0, gA); PG8_STAGE_A(PG8_SA(0, 1), cA, 1, gA);
    if (wr == 1) PG8_BAR;
    PG8_WAIT_V(2); PG8_BAR;
    PG8_STAGE(PG8_SB(1, 0), cB + kstep, voffB); PG8_STAGE_A(PG8_SA(1, 0), cA + kstep, 0, gA); PG8_STAGE(PG8_SB(1, 1), cB + hstep + kstep, voffB);
    PG8_WAIT_V(6); PG8_BAR;
    for (;;) {
        const bool has_next = S.next(ui + 1, nxt);
        const char* nA = has_next ? S.a_base(nxt) : cA; const char* nB = has_next ? S.b_base(nxt) : cB;
        const int bnxt = (bsel == 2) ? 0 : bsel + 1;
        if constexpr (GATHER) { if (has_next) PG8_IDMA(nxt, bnxt); }
        for (int t = 0; t < nt; t += 2) {
            const bool last = (t == nt - 2);
            const char* a1 = cA + (size_t)(t + 1) * kstep;
            const char* a2 = last ? nA : cA + (size_t)(t + 2) * kstep; const char* b2 = last ? nB : cB + (size_t)(t + 2) * kstep;
            const char* a3 = a2 + kstep; const char* b3 = b2 + kstep;
            if constexpr (GATHER) { if (last && has_next) { PG8_GOFF(gN, nxt, bnxt); } }
            PG8_LDB(B0, 0, 0); PG8_LDB(B1, 0, 1); PG8_SCHED; PG8_LDA(At, 0, 0); PG8_STAGE_A(PG8_SA(1, 1), a1, 1, gA);
            if constexpr (GATHER) { if (last && has_next) { gA[0][0] = gN[0][0]; gA[0][1] = gN[0][1]; gA[1][0] = gN[1][0]; gA[1][1] = gN[1][1]; } }
            PG8_WAIT_V(8); PG8_WAIT_L(0); PG8_BAR; PG8_MMA(0, 0, At, B0); PG8_MMA(0, 1, At, B1); PG8_BAR; PG8_SCHED;
            PG8_LDA(At, 0, 1); PG8_STAGE(PG8_SB(0, 0), b2, voffB); PG8_STAGE(PG8_SB(0, 1), b2 + hstep, voffB); PG8_STAGE_A(PG8_SA(0, 0), a2, 0, gA);
            PG8_WAIT_V(8); PG8_WAIT_L(0); PG8_BAR; PG8_MMA(1, 0, At, B0); PG8_MMA(1, 1, At, B1); PG8_BAR; PG8_SCHED;
            PG8_PSTORE();
            PG8_LDB(B0, 1, 0); PG8_LDB(B1, 1, 1); PG8_SCHED; PG8_LDA(At, 1, 0); PG8_STAGE_A(PG8_SA(0, 1), a2, 1, gA);
            PG8_WAIT_V(8); PG8_WAIT_L(0); PG8_BAR; PG8_MMA(0, 0, At, B0); PG8_MMA(0, 1, At, B1); PG8_BAR; PG8_SCHED;
            PG8_LDA(At, 1, 1); PG8_STAGE(PG8_SB(1, 0), b3, voffB); PG8_STAGE(PG8_SB(1, 1), b3 + hstep, voffB); PG8_STAGE_A(PG8_SA(1, 0), a3, 0, gA);
            PG8_WAIT_V(8); PG8_WAIT_L(0); PG8_BAR; PG8_MMA(1, 0, At, B0); PG8_MMA(1, 1, At, B1); PG8_BAR; PG8_SCHED;
            PG8_PSTORE();
        }
        if (ALIGN_EPI) { if (wr == 0) PG8_BAR; }
        { const int l2 = lane_id_volatile(), fr2 = l2 & 15, fq2 = l2 >> 4;
          if constexpr (DEFER) { _Pragma("unroll") for (int _f = 0; _f < 8; ++_f) PG8_PSTORE();
              E.prepare(acc, cur, wr, wc, fr2, fq2, pend, (const LAS float*)(ibuf + 1536 + bsel * 256)); ppn = cur.pn; pnv = S.nvalid(cur); pq = 0; pbuf = bsel; }
          else if constexpr (GATHER) E(acc, cur, wr, wc, fr2, fq2, ibuf + bsel * 256, S.nvalid(cur), (const LAS float*)(ibuf + 1536 + bsel * 256)); else E(acc, cur, wr, wc, fr2, fq2); }
        if (!has_next) break;
#pragma unroll
        for (int a = 0; a < 2; ++a)
#pragma unroll
            for (int b = 0; b < 2; ++b)
#pragma unroll
                for (int m = 0; m < 4; ++m)
#pragma unroll
                    for (int n = 0; n < 2; ++n) acc[a][b][m][n] = (f32x4){0.f, 0.f, 0.f, 0.f};
        cur = nxt; cA = nA; cB = nB; ++ui; bsel = bnxt;
        if (ALIGN_EPI) { if (wr == 1) PG8_BAR; }
    }
    if constexpr (DEFER) { _Pragma("unroll") for (int _f = 0; _f < 8; ++_f) PG8_PSTORE(); }
    PG8_WAIT_V(0);
    if (!ALIGN_EPI) { if (wr == 0) PG8_BAR; }
    PG8_BAR;
#undef PG8_PSTORE
#undef PG8_SA
#undef PG8_SB
#undef PG8_STAGE
#undef PG8_STAGE_A
#undef PG8_LDA
#undef PG8_LDB
#undef PG8_MMA
#undef PG8_WAIT_V
#undef PG8_WAIT_L
#undef PG8_BAR
#undef PG8_SCHED
#undef PG8_GOFF
#undef PG8_IDMA
}
}

namespace attn_body {
using bf16=__hip_bfloat16;
using bf16x8=__attribute__((ext_vector_type(8)))short;
using s16x4=__attribute__((ext_vector_type(4)))short;
using f32x16=__attribute__((ext_vector_type(16)))float;
using u32x4=__attribute__((ext_vector_type(4)))unsigned;
constexpr int D=64;
constexpr int NW=8,QBLK=32,QB=QBLK*NW,KVBLK=64;
constexpr int ATTN_UNIT_ROWS=QB;
__device__ __forceinline__ int crow(int r,int hi){return (r&3)+8*(r>>2)+4*hi;}
#define SBAR() __builtin_amdgcn_sched_barrier(0)
__device__ __forceinline__ void cmask(f32x16&p0,f32x16&p1,int jb,int qrel,int hi){
  const float NEG=-INFINITY; int kb=64*jb+4*hi;
  #pragma unroll
  for(int r=0;r<16;++r){int kv=kb+(r&3)+8*(r>>2); if(kv>qrel)p0[r]=NEG; if(kv+32>qrel)p1[r]=NEG;}
}

constexpr int NSLOT=3, SLOTB=8192;
constexpr int LDS_K=0, LDS_V=NSLOT*SLOTB, LDS_WS=2*NSLOT*SLOTB, LDS_OST=LDS_WS+NW*64*4, LDS_BYTES=LDS_OST+NW*4096;
constexpr float C2=0.125f*1.4426950408889634f;
__device__ __forceinline__ void glds16(const void*gsrc,unsigned lds_dst){unsigned keep;
  asm volatile("s_mov_b32 %0, m0\n\ts_mov_b32 m0, %2\n\ts_nop 0\n\tglobal_load_lds_dwordx4 %1, off\n\ts_mov_b32 m0, %0":"=&s"(keep):"v"(gsrc),"s"(lds_dst):"memory");}
__device__ __forceinline__ float max3f(float a,float b,float c){float r;asm("v_max3_f32 %0, %1, %2, %3":"=v"(r):"v"(a),"v"(b),"v"(c));return r;}
__device__ __forceinline__ float max2f(float a,float b){float r;asm("v_max_f32_e32 %0, %1, %2":"=v"(r):"v"(a),"v"(b));return r;}
__device__ __forceinline__ float fadd_s(float a,float b){float r;asm("v_add_f32_e32 %0, %1, %2":"=v"(r):"v"(a),"v"(b));return r;}
__device__ __forceinline__ float fsub_s(float a,float b){float r;asm("v_sub_f32_e32 %0, %1, %2":"=v"(r):"v"(a),"v"(b));return r;}
typedef float f32x2_t __attribute__((ext_vector_type(2))); typedef __bf16 bf16x2_t __attribute__((ext_vector_type(2)));
__device__ __forceinline__ unsigned cvtpk_s(float lo,float hi){f32x2_t v={lo,hi};bf16x2_t b=__builtin_convertvector(v,bf16x2_t);return __builtin_bit_cast(unsigned,b);}
#define WAIT_BAR(N) asm volatile("s_waitcnt vmcnt(" #N ") lgkmcnt(0)\n\ts_barrier":::"memory")

__device__ __forceinline__ void qkt(f32x16&p0,f32x16&p1,const char*Kslot,const bf16x8*qr,const f32x16&negm,int r32,int hi){
  const char*kb=Kslot+hi*1024+r32*16;
  #pragma unroll
  for(int d0=0;d0<4;++d0){
    const bf16x8 b0=*reinterpret_cast<const bf16x8*>(kb+d0*2048);
    const bf16x8 b1=*reinterpret_cast<const bf16x8*>(kb+d0*2048+512);
    if(d0==0){p0=__builtin_amdgcn_mfma_f32_32x32x16_bf16(b0,qr[0],negm,0,0,0);p1=__builtin_amdgcn_mfma_f32_32x32x16_bf16(b1,qr[0],negm,0,0,0);}
    else{p0=__builtin_amdgcn_mfma_f32_32x32x16_bf16(b0,qr[d0],p0,0,0,0);p1=__builtin_amdgcn_mfma_f32_32x32x16_bf16(b1,qr[d0],p1,0,0,0);}}
}
typedef __attribute__((address_space(3))) const char* lds_cptr;
typedef short v4i16_t __attribute__((ext_vector_type(4)));
__device__ __forceinline__ void kload8(bf16x8*kf,lds_cptr kp){
  kf[0]=*(const __attribute__((address_space(3))) bf16x8*)(kp);      kf[1]=*(const __attribute__((address_space(3))) bf16x8*)(kp+512);
  kf[2]=*(const __attribute__((address_space(3))) bf16x8*)(kp+2048); kf[3]=*(const __attribute__((address_space(3))) bf16x8*)(kp+2560);
  kf[4]=*(const __attribute__((address_space(3))) bf16x8*)(kp+4096); kf[5]=*(const __attribute__((address_space(3))) bf16x8*)(kp+4608);
  kf[6]=*(const __attribute__((address_space(3))) bf16x8*)(kp+6144); kf[7]=*(const __attribute__((address_space(3))) bf16x8*)(kp+6656);
}
__device__ __forceinline__ void kload2(bf16x8*kf,lds_cptr kp,int j){ kf[2*j]=*(const __attribute__((address_space(3))) bf16x8*)(kp+j*2048); kf[2*j+1]=*(const __attribute__((address_space(3))) bf16x8*)(kp+j*2048+512); }
__device__ __forceinline__ s16x4 vtr(lds_cptr p){ return __builtin_bit_cast(s16x4,__builtin_amdgcn_ds_read_tr16_b64_v4i16((__attribute__((address_space(3))) v4i16_t*)p)); }
__device__ __forceinline__ float rowmax(const f32x16&p0,const f32x16&p1){
  float a=max3f(p0[0],p0[1],p1[0]),b=max3f(p0[2],p0[3],p1[1]);a=max3f(a,p1[2],p1[3]);
  #pragma unroll
  for(int r=4;r<16;r+=4){a=max3f(a,p0[r],p0[r+1]);b=max3f(b,p0[r+2],p0[r+3]);a=max3f(a,p1[r],p1[r+1]);b=max3f(b,p1[r+2],p1[r+3]);}
  const float m=max2f(a,b);
  auto rr=__builtin_amdgcn_permlane32_swap(__float_as_uint(m),__float_as_uint(m),false,false);
  return max2f(__uint_as_float(rr[0]),__uint_as_float(rr[1]));
}
__device__ __forceinline__ void pv(f32x16*o,int vb,bf16x8 pa0,bf16x8 pa1,bf16x8 pa2,bf16x8 pa3){
  #pragma unroll
  for(int d0=0;d0<2;++d0){s16x4 lo[4],hi[4];
    #pragma unroll
    for(int ks=0;ks<4;++ks){
      asm volatile("ds_read_b64_tr_b16 %0,%1 offset:%c2":"=&v"(lo[ks]):"v"(vb),"i"(d0*4096+ks*1024):"memory");
      asm volatile("ds_read_b64_tr_b16 %0,%1 offset:%c2":"=&v"(hi[ks]):"v"(vb),"i"(d0*4096+ks*1024+512):"memory");}
    asm volatile("s_waitcnt lgkmcnt(0)":::"memory");SBAR();
    #define PK(k) (bf16x8){lo[k][0],lo[k][1],lo[k][2],lo[k][3],hi[k][0],hi[k][1],hi[k][2],hi[k][3]}
    o[d0]=__builtin_amdgcn_mfma_f32_32x32x16_bf16(pa0,PK(0),o[d0],0,0,0);
    o[d0]=__builtin_amdgcn_mfma_f32_32x32x16_bf16(pa1,PK(1),o[d0],0,0,0);
    o[d0]=__builtin_amdgcn_mfma_f32_32x32x16_bf16(pa2,PK(2),o[d0],0,0,0);
    o[d0]=__builtin_amdgcn_mfma_f32_32x32x16_bf16(pa3,PK(3),o[d0],0,0,0);
    #undef PK
  }
}

#ifndef ATTN_STORE16
#define ATTN_STORE16(p,v) (*(u32x4*)(p)=(v))
#endif
template<int THRL, bool O8 = false> __device__ __forceinline__ void attn_unit(const bf16*Qu,const bf16*__restrict__ Kh,const bf16*__restrict__ Vh,bf16*Ou,const int QP,const int KP,const int VP,const int OP,const int NT,char*shm,const int tid){
  const int lane=tid&63,r32=lane&31,hi=lane>>5; const int wid=__builtin_amdgcn_readfirstlane(tid>>6);
  const bf16*Qw=Qu+(long)(wid*QBLK)*QP;
  const unsigned lds0=(unsigned)(uintptr_t)shm;
  float*wsf=(float*)(shm+LDS_WS)+wid*64;
  const bf16*ksrc=Kh+(long)lane*KP+wid*8;
  const bf16*vsrc=Vh+(long)(16*(wid&3)+(lane>>2))*VP+(wid>>2)*32+(lane&3)*8;
  const unsigned kdst=lds0+LDS_K+wid*1024, vdst=lds0+LDS_V+wid*1024;
  #define DMA_K(t,slot) glds16(ksrc+(long)(t)*KVBLK*KP,(unsigned)__builtin_amdgcn_readfirstlane(kdst+(slot)))
  #define DMA_V(t,slot) glds16(vsrc+(long)(t)*KVBLK*VP,(unsigned)__builtin_amdgcn_readfirstlane(vdst+(slot)))
  const int vb0=(int)(lds0+LDS_V)+((lane>>4)&1)*32+(lane&3)*8+(4*hi+((lane&15)>>2))*64;
  const char*Kbase=shm+LDS_K; bf16x8 kf[8];
  const lds_cptr shm3=(lds_cptr)shm; const lds_cptr kp0=shm3+LDS_K+hi*1024+r32*16; const lds_cptr vp0=shm3+LDS_V+((lane>>4)&1)*32+(lane&3)*8+(4*hi+((lane&15)>>2))*64;
  DMA_K(0,0);DMA_V(0,0);DMA_K(1,SLOTB);
  bf16x8 qr[4];
  #pragma unroll
  for(int d0=0;d0<4;++d0)qr[d0]=*reinterpret_cast<const bf16x8*>(&Qw[(long)r32*QP+d0*16+hi*8]);
  float mhat=0.f,l_reg=0.f;f32x16 o[2];f32x16 negm; { float z_=0.f; asm volatile("":"+v"(z_)); _Pragma("unroll") for(int r=0;r<16;++r){o[0][r]=z_;o[1][r]=z_;negm[r]=z_;} } asm volatile("":"+v"(negm));
  #define CMASK(P0,P1,t) do{}while(0)
  bool resc=false;
  #define START(P0,P1) do{ const float rm=rowmax(P0,P1); resc=false; \
    { const float dl=rm; mhat=fadd_s(mhat,dl); \
      _Pragma("unroll") for(int r=0;r<16;++r){P0[r]=fsub_s(P0[r],dl);P1[r]=fsub_s(P1[r],dl);} \
      _Pragma("unroll") for(int r=0;r<16;++r)negm[r]=-mhat; asm volatile("":"+v"(negm)); } \
    _Pragma("unroll") for(int r=0;r<16;++r)P0[r]=__builtin_amdgcn_exp2f(P0[r]); }while(0)
  #define RESC() do{ if(resc){ asm volatile("s_waitcnt lgkmcnt(0)":::"memory"); \
      _Pragma("unroll") for(int d_=0;d_<2;++d_) _Pragma("unroll") for(int r=0;r<16;++r)o[d_][r]*=wsf[crow(r,hi)]; } }while(0)
  f32x16 pA0,pA1,pB0,pB1;
  int sl_prev=0,sl_cur=0,sl_next=SLOTB;
  #define ROT() do{sl_prev=sl_cur;sl_cur=sl_next;sl_next=(sl_next==(NSLOT-1)*SLOTB)?0:sl_next+SLOTB;}while(0)
  DMA_K(2,2*SLOTB);
  WAIT_BAR(3);
  qkt(pA0,pA1,Kbase,qr,negm,r32,hi);asm volatile("s_nop 15\n\ts_nop 7":"+v"(pA0),"+v"(pA1));CMASK(pA0,pA1,0);
  START(pA0,pA1);
  _Pragma("unroll") for(int r=0;r<16;++r)pA1[r]=__builtin_amdgcn_exp2f(pA1[r]);
  WAIT_BAR(0);
  DMA_K(3,0);DMA_V(1,SLOTB);
  ROT();
  kload8(kf,kp0+sl_cur);
  WAIT_BAR(2);
  s16x4 vlo[8],vhi[8]; u32x4 pw0,pw1,pw2,pw3;
  #define PKW(P,B) cvtpk_s(P[B],P[B+1])
  #define PAF(k) __builtin_bit_cast(bf16x8,pw##k)
  #define VFR(i) (bf16x8){vlo[i][0],vlo[i][1],vlo[i][2],vlo[i][3],vhi[i][0],vhi[i][1],vhi[i][2],vhi[i][3]}
  #define PIN(x) asm volatile("":"+v"(x))
  #define MX3(a,b,c) __builtin_fmaxf(__builtin_fmaxf((a),(b)),(c))
  #define GAPA(MF,A0,A1,A2,A3,W0,W1,PW) do{ MF; sacc+=A0; sacc+=A1; sacc+=A2; sacc+=A3; PIN(sacc); W0; W1; PIN(PW); SBAR(); }while(0)
  #define EX(v) __builtin_amdgcn_exp2f(v)
  #define GAPB(MF,X,B) do{ MF; X[B]=EX(X[B]); X[B+1]=EX(X[B+1]); X[B+2]=EX(X[B+2]); X[B+3]=EX(X[B+3]); PIN(X); SBAR(); }while(0)
  #define VRD(i) do{ vlo[i]=vtr(vp_+(((i)>>2)*4096+((i)&3)*1024)); vhi[i]=vtr(vp_+(((i)>>2)*4096+((i)&3)*1024+512)); }while(0)
  #define KRD(G,j) do{ if(G){ kload2(kf,kp0+sl_next,j); SBAR(); } }while(0)
  #define STEP(C0,C1,P0,P1,t,GK,GV,GL) do{ SBAR(); \
    const lds_cptr vp_=vp0+sl_prev; \
    VRD(0); SBAR(); float sacc=(P0[0]+P0[1]); \
    GAPA(C0=__builtin_amdgcn_mfma_f32_32x32x16_bf16(kf[0],qr[0],negm,0,0,0), P0[2],P0[3],P0[4],P0[5],     pw0[0]=PKW(P0,0), pw0[1]=PKW(P0,2), pw0); \
    VRD(4); SBAR(); GAPA(C1=__builtin_amdgcn_mfma_f32_32x32x16_bf16(kf[1],qr[0],negm,0,0,0), P0[6],P0[7],P0[8],P0[9],     pw0[2]=PKW(P0,4), pw0[3]=PKW(P0,6), pw0); \
    VRD(1); SBAR(); GAPA(C0=__builtin_amdgcn_mfma_f32_32x32x16_bf16(kf[2],qr[1],C0,0,0,0),   P0[10],P0[11],P0[12],P0[13], pw1[0]=PKW(P0,8), pw1[1]=PKW(P0,10), pw1); \
    VRD(5); SBAR(); GAPA(C1=__builtin_amdgcn_mfma_f32_32x32x16_bf16(kf[3],qr[1],C1,0,0,0),   P0[14],P0[15],P1[0],P1[1],   pw1[2]=PKW(P0,12),pw1[3]=PKW(P0,14), pw1); \
    VRD(2); SBAR(); GAPA(C0=__builtin_amdgcn_mfma_f32_32x32x16_bf16(kf[4],qr[2],C0,0,0,0),   P1[2],P1[3],P1[4],P1[5],     pw2[0]=PKW(P1,0), pw2[1]=PKW(P1,2), pw2); \
    VRD(6); SBAR(); GAPA(C1=__builtin_amdgcn_mfma_f32_32x32x16_bf16(kf[5],qr[2],C1,0,0,0),   P1[6],P1[7],P1[8],P1[9],     pw2[2]=PKW(P1,4), pw2[3]=PKW(P1,6), pw2); \
    VRD(3); SBAR(); GAPA(C0=__builtin_amdgcn_mfma_f32_32x32x16_bf16(kf[6],qr[3],C0,0,0,0),   P1[10],P1[11],P1[12],P1[13], pw3[0]=PKW(P1,8), pw3[1]=PKW(P1,10), pw3); \
    VRD(7); SBAR(); GAPA(C1=__builtin_amdgcn_mfma_f32_32x32x16_bf16(kf[7],qr[3],C1,0,0,0),   P1[14],P1[15],0.f,0.f,       pw3[2]=PKW(P1,12),pw3[3]=PKW(P1,14), pw3); \
    l_reg+=sacc; \
    if(GK){DMA_K((t)+3,sl_cur);} if(GV){DMA_V((t)+1,sl_next);} \
    CMASK(C0,C1,t); \
    { float a=MX3(C0[0],C0[1],C1[0]),b=MX3(C0[2],C0[3],C1[1]); a=MX3(a,C1[2],C1[3]); \
      _Pragma("unroll") for(int r=4;r<16;r+=4){a=MX3(a,C0[r],C0[r+1]);b=MX3(b,C0[r+2],C0[r+3]);a=MX3(a,C1[r],C1[r+1]);b=MX3(b,C1[r+2],C1[r+3]);} \
      float rm=__builtin_fmaxf(a,b); { auto rr=__builtin_amdgcn_permlane32_swap(__float_as_uint(rm),__float_as_uint(rm),false,false); rm=__builtin_fmaxf(__uint_as_float(rr[0]),__uint_as_float(rr[1])); } \
      resc=false; \
      if(__builtin_expect(__any(rm>(float)THRL),0)){ const float dl=__builtin_fmaxf(rm,0.f); mhat+=dl; \
        _Pragma("unroll") for(int r=0;r<16;++r){C0[r]-=dl;C1[r]-=dl;} \
        _Pragma("unroll") for(int r=0;r<16;++r)negm[r]=-mhat; asm volatile("":"+v"(negm)); \
        const float f=__builtin_amdgcn_exp2f(-dl); l_reg*=f; if(hi==0)wsf[r32]=f; resc=true; } } \
    SBAR(); \
    GAPB(o[0]=__builtin_amdgcn_mfma_f32_32x32x16_bf16(PAF(0),VFR(0),o[0],0,0,0), C0,0); \
    GAPB(o[1]=__builtin_amdgcn_mfma_f32_32x32x16_bf16(PAF(0),VFR(4),o[1],0,0,0), C0,4); \
    KRD(GL,0); GAPB(o[0]=__builtin_amdgcn_mfma_f32_32x32x16_bf16(PAF(1),VFR(1),o[0],0,0,0), C0,8); \
    KRD(GL,1); GAPB(o[1]=__builtin_amdgcn_mfma_f32_32x32x16_bf16(PAF(1),VFR(5),o[1],0,0,0), C0,12); \
    KRD(GL,2); GAPB(o[0]=__builtin_amdgcn_mfma_f32_32x32x16_bf16(PAF(2),VFR(2),o[0],0,0,0), C1,0); \
    KRD(GL,3); GAPB(o[1]=__builtin_amdgcn_mfma_f32_32x32x16_bf16(PAF(2),VFR(6),o[1],0,0,0), C1,4); \
    GAPB(o[0]=__builtin_amdgcn_mfma_f32_32x32x16_bf16(PAF(3),VFR(3),o[0],0,0,0), C1,8); \
    GAPB(o[1]=__builtin_amdgcn_mfma_f32_32x32x16_bf16(PAF(3),VFR(7),o[1],0,0,0), C1,12); \
    }while(0)
  int t=1;
  #undef CMASK
  #define CMASK(P0,P1,t) do{}while(0)
  for(;t+5<NT;t+=2){
    STEP(pB0,pB1,pA0,pA1,t,true,true,true);     WAIT_BAR(2); RESC(); ROT();
    STEP(pA0,pA1,pB0,pB1,t+1,true,true,true);   WAIT_BAR(2); RESC(); ROT();
  }
  #undef CMASK
  #define CMASK(P0,P1,t) do{}while(0)
  #define ENDW(tt) do{ if((tt)+3<NT){WAIT_BAR(2);} else if((tt)+2<NT){WAIT_BAR(1);} else {WAIT_BAR(0);} }while(0)
  for(;t+1<NT;t+=2){
    STEP(pB0,pB1,pA0,pA1,t,(t+3<NT),(t+1<NT),(t+1<NT));       ENDW(t);   RESC(); ROT();
    STEP(pA0,pA1,pB0,pB1,t+1,(t+4<NT),(t+2<NT),(t+2<NT));     ENDW(t+1); RESC(); ROT();
  }
  STEP(pB0,pB1,pA0,pA1,NT-1,false,false,false); RESC();
  { float sacc=pB0[0]+pB0[1]; _Pragma("unroll") for(int r=2;r<16;++r)sacc+=pB0[r]; _Pragma("unroll") for(int r=0;r<16;++r)sacc+=pB1[r]; l_reg+=sacc;
    pw0=(u32x4){PKW(pB0,0),PKW(pB0,2),PKW(pB0,4),PKW(pB0,6)};pw1=(u32x4){PKW(pB0,8),PKW(pB0,10),PKW(pB0,12),PKW(pB0,14)};pw2=(u32x4){PKW(pB1,0),PKW(pB1,2),PKW(pB1,4),PKW(pB1,6)};pw3=(u32x4){PKW(pB1,8),PKW(pB1,10),PKW(pB1,12),PKW(pB1,14)};
    SBAR(); pv(o,vb0+sl_cur,PAF(0),PAF(1),PAF(2),PAF(3)); }
  #undef PKW
  #undef PAF
  #undef VFR
  #undef PIN
  #undef MX3
  #undef GAPA
  #undef GAPB
  #undef EX
  #undef VRD
  #undef KRD
  #undef STEP
  #undef ENDW
  {auto rr=__builtin_amdgcn_permlane32_swap(__float_as_uint(l_reg),__float_as_uint(l_reg),false,false);l_reg=__uint_as_float(rr[0])+__uint_as_float(rr[1]);}
  if(hi==0)wsf[32+r32]=l_reg;asm volatile("s_waitcnt lgkmcnt(0)":::"memory");
  float rli[16];
  #pragma unroll
  for(int r=0;r<16;++r)rli[r]=__builtin_amdgcn_rcpf(wsf[32+crow(r,hi)]);
  if constexpr (O8) {
    unsigned char*Ow8=(unsigned char*)Ou+(long)(wid*QBLK)*OP; unsigned char*stg8=(unsigned char*)(shm+LDS_OST)+wid*2048;
    #pragma unroll
    for(int r=0;r<16;++r){const int orow=crow(r,hi);
      #pragma unroll
      for(int d0=0;d0<2;++d0)stg8[orow*64+d0*32+r32]=f2fp8(o[d0][r]*rli[r]);}
    asm volatile("s_waitcnt lgkmcnt(0)":::"memory");
    #pragma unroll
    for(int i=0;i<2;++i){const int row=i*16+(lane>>2),ch=lane&3; const u32x4 v=*(const u32x4*)(stg8+row*64+ch*16); ATTN_STORE16(Ow8+(long)row*OP+ch*16,v);}
  } else {
  bf16*Ow=Ou+(long)(wid*QBLK)*OP;
  { bf16*stg=(bf16*)(shm+LDS_OST)+wid*2048;
    #pragma unroll
    for(int r=0;r<16;++r){const int orow=crow(r,hi);
      #pragma unroll
      for(int d0=0;d0<2;++d0)stg[orow*64+d0*32+r32]=__float2bfloat16(o[d0][r]*rli[r]);}
    asm volatile("s_waitcnt lgkmcnt(0)":::"memory");
    #pragma unroll
    for(int i=0;i<4;++i){const int row=i*8+(lane>>3),ch=lane&7; const u32x4 v=*(const u32x4*)(stg+row*64+ch*8); ATTN_STORE16(Ow+(long)row*OP+ch*8,v);} }
  }
  asm volatile("s_waitcnt lgkmcnt(0)\n\ts_barrier":::"memory");
  #undef DMA_K
  #undef DMA_V
  #undef CMASK
  #undef START
  #undef RESC
  #undef ROT
}
constexpr int ATTN_LDS_BYTES=LDS_BYTES;
#undef SBAR
#undef WAIT_BAR
}

struct Args { const float* in[32]; float* out; unsigned char* ws; int ph_lo, ph_hi; };
struct Ctx {
    LAS unsigned char* lds;
    int vcu, G;
    unsigned char* ws;
};
constexpr int PTAB_OFF = MISC_OFF + 256;
__device__ __forceinline__ unsigned long long ptab_get(const Ctx& cx, int k) {
    const LAS unsigned* t = (const LAS unsigned*)(cx.lds + PTAB_OFF) + 2 * k; const unsigned lo = __builtin_amdgcn_readfirstlane(t[0]), hi = __builtin_amdgcn_readfirstlane(t[1]);
    return ((unsigned long long)hi << 32) | lo;
}
#define INP(k) ((const float*)(GAS const float*)ptab_get(cx, (k)))

template <bool F8> __device__ __forceinline__ void p0_transpose64(const float* W, int N, int KB, unsigned char* WT, int k0, int n0, int dst_row0, float scale, LAS float* scr, int lane) {
    f32x4 v[16];
    const float* src = W + (size_t)(k0 + (lane >> 4)) * N + n0 + (lane & 15) * 4;
#pragma unroll
    for (int i = 0; i < 16; ++i) v[i] = *(const f32x4*)(src + (size_t)(4 * i) * N);
#pragma unroll
    for (int i = 0; i < 16; ++i) { LAS float* p = scr + (4 * i + (lane >> 4)) * 65 + (lane & 15) * 4; p[0] = v[i][0]; p[1] = v[i][1]; p[2] = v[i][2]; p[3] = v[i][3]; }
    LDS_WAIT(); asm volatile("" ::: "memory");
    if constexpr (!F8) {
        const int ns = lane >> 3, ch = lane & 7;
#pragma unroll
        for (int r8 = 0; r8 < 8; ++r8) { const int n = r8 * 8 + ns; const LAS float* s = scr + (8 * ch) * 65 + n;
            u32x4 o; o.x = pk2(s[0 * 65], s[1 * 65]); o.y = pk2(s[2 * 65], s[3 * 65]); o.z = pk2(s[4 * 65], s[5 * 65]); o.w = pk2(s[6 * 65], s[7 * 65]);
            *(GAS u32x4*)(WT + (size_t)(dst_row0 + n) * KB + (k0 + 8 * ch) * 2) = o; }
    } else {
        const int ns = lane >> 2, ch = lane & 3;
#pragma unroll
        for (int r4 = 0; r4 < 4; ++r4) { const int n = r4 * 16 + ns; const LAS float* s = scr + (16 * ch) * 65 + n; unsigned w[4];
#pragma unroll
            for (int q = 0; q < 4; ++q) { int r = 0; r = __builtin_amdgcn_cvt_pk_fp8_f32(s[(4 * q) * 65] * scale, s[(4 * q + 1) * 65] * scale, r, false); r = __builtin_amdgcn_cvt_pk_fp8_f32(s[(4 * q + 2) * 65] * scale, s[(4 * q + 3) * 65] * scale, r, true); w[q] = (unsigned)r; }
            *(GAS u32x4*)(WT + (size_t)(dst_row0 + n) * KB + k0 + 16 * ch) = (u32x4){w[0], w[1], w[2], w[3]}; }
    }
    LDS_WAIT(); asm volatile("" ::: "memory");
}
__device__ __forceinline__ void p0_prologue(const Ctx& cx, const int tid) {
    const int lane = tid & 63, wave = __builtin_amdgcn_readfirstlane(tid >> 6);
    LAS float* scr = (LAS float*)(cx.lds + wave * 16896);
    const int gw = cx.vcu * 8 + wave, NGW = cx.G * 8;
    constexpr int I_WIN0 = 16 * 40, I_WIN1 = 16 * 24, I_WKV = 16 * 8, I_WOUT = 16 * 16, I_W1 = 16 * 32, I_W2 = 16 * 16;
    constexpr int T_WIN = 3 * I_WIN0 + I_WIN1, T_WKV = 4 * I_WKV, T_WOUT = 4 * I_WOUT, T_W1 = 128 * I_W1, T_W2 = 128 * I_W2;
    constexpr int NITEMS = T_WIN + T_WKV + T_WOUT + T_W1 + T_W2;
    for (int it = gw; it < NITEMS; it += NGW) {
        int r = it;
        const float* W; unsigned char* WT; int N, nb, kb, dst_row0; bool isout = false;
        if (r < T_W1) {
            const int mi = r / I_W1, q = r % I_W1; N = 2048; kb = q / 32; nb = q % 32;
            W = INP(28) + (size_t)mi * 1024 * 2048; WT = cx.ws + WS_W1 + (size_t)mi * 2048 * 1024 * MOE_EB;
            const int n0 = nb * 64, isu = n0 >= 1024, j = n0 - isu * 1024;
            dst_row0 = (j >> 7) * 256 + isu * 128 + (j & 127);
            p0_transpose64<MOE_F8>(W, N, 1024 * MOE_EB, WT, kb * 64, nb * 64, dst_row0, W1_SCALE, scr, lane); continue;
        } else if ((r -= T_W1) < T_W2) {
            const int mi = r / I_W2, q = r % I_W2; N = 1024; kb = q / 16; nb = q % 16;
            W = INP(30) + (size_t)mi * 1024 * 1024; WT = cx.ws + WS_W2 + (size_t)mi * 1024 * 1024 * MOE_EB; dst_row0 = nb * 64;
            p0_transpose64<MOE_F8>(W, N, 1024 * MOE_EB, WT, kb * 64, nb * 64, dst_row0, W2_SCALE, scr, lane); continue;
        } else if ((r -= T_W2) < T_WIN) {
            int l, q;
            if (r < I_WIN0) { l = 0; q = r; } else if (r < I_WIN0 + I_WIN1) { l = 1; q = r - I_WIN0; } else if (r < 2 * I_WIN0 + I_WIN1) { l = 2; q = r - I_WIN0 - I_WIN1; } else { l = 3; q = r - 2 * I_WIN0 - I_WIN1; }
            N = in_width(l); const int nbn = N / 64; kb = q / nbn; nb = q % nbn;
            const int kind = layer_kind(l), j = layer_j(l);
            W = (kind == 0 ? INP(2) : kind == 1 ? INP(4) : INP(7)) + (size_t)j * 1024 * N;
            WT = cx.ws + WS_WIN + (size_t)l * 5 * MiB; dst_row0 = nb * 64;
        } else if ((r -= T_WIN) < T_WKV) {
            const int l = r / I_WKV, q = r % I_WKV; N = 512; kb = q / 8; nb = q % 8;
            W = INP(20) + (size_t)l * 1024 * 512; WT = cx.ws + WS_WKV; dst_row0 = l * 512 + nb * 64;
        } else {
            r -= T_WKV; const int l = r / I_WOUT, q = r % I_WOUT; N = 1024; kb = q / 16; nb = q % 16;
            W = INP(21) + (size_t)l * 1024 * 1024; WT = cx.ws + WS_WOUT + (size_t)l * 2 * MiB; dst_row0 = nb * 64; isout = true;
        }
        if (isout) p0_transpose64<OUTP_F8 != 0>(W, N, 1024 * OUT_EB, WT, kb * 64, nb * 64, dst_row0, OUTP_F8 ? WOUT_SCALE : 1.0f, scr, lane);
        else p0_transpose64<INP_F8 != 0>(W, N, 1024 * INP_EB, WT, kb * 64, nb * 64, dst_row0, INP_F8 ? WIN_SCALE : 1.0f, scr, lane);
    }
    {
        const size_t gt = (size_t)cx.vcu * 512 + tid, NT_ = (size_t)cx.G * 512;
        for (int which = 0; which < 2; ++which) {
            const f32x4* xs = (const f32x4*)(which == 0 ? INP(0) : INP(1)); unsigned char* xd = cx.ws + (which == 0 ? WS_XB : WS_MEMB); const size_t n8 = (size_t)(which == 0 ? NTOK : NMEM) * DM / 8;
#pragma unroll 4
            for (size_t i = gt; i < n8; i += NT_) { const f32x4 a = xs[2 * i], b = xs[2 * i + 1];
                if constexpr (INP_F8) { int w0 = 0, w1 = 0; w0 = __builtin_amdgcn_cvt_pk_fp8_f32(a[0], a[1], w0, false); w0 = __builtin_amdgcn_cvt_pk_fp8_f32(a[2], a[3], w0, true); w1 = __builtin_amdgcn_cvt_pk_fp8_f32(b[0], b[1], w1, false); w1 = __builtin_amdgcn_cvt_pk_fp8_f32(b[2], b[3], w1, true);
                    *(u32x2*)(xd + i * 8) = (u32x2){(unsigned)w0, (unsigned)w1}; }
                else { u32x4 o; o.x = pk2(a[0], a[1]); o.y = pk2(a[2], a[3]); o.z = pk2(b[0], b[1]); o.w = pk2(b[2], b[3]); *(u32x4*)(xd + i * 16) = o; } }
        }
    }
    {
        const float *fw1 = INP(10), *fb1 = INP(11), *fw2 = INP(12), *fb2 = INP(13), *fw3 = INP(14), *fb3 = INP(15), *fw4 = INP(16), *fb4 = INP(17), *ffr = INP(18);
        LAS float* z = (LAS float*)cx.lds; LAS float* h1 = z + 16 * 33; LAS float* h2 = h1 + 1024; LAS float* h3 = h2 + 1024;
        float* HRAWT = (float*)(cx.ws + WS_HRAWT); float* HPART = (float*)(cx.ws + WS_HPART);
        for (int it = cx.vcu; it < 256; it += cx.G) {
            __syncthreads();
            const int pos0 = it * 16;
            for (int i = tid; i < 16 * 33; i += 512) { const int p = i / 33, f = i % 33; const float pos = (float)(pos0 + p); float v;
                if (f == 0) v = pos / 4095.0f;
                else { const int k = (f - 1) & 15; const float fb = 1e-4f + (float)k * ((15.0f - 1e-4f) / 15.0f); const float ang = (6.283185307179586f * pos / 4096.0f) * fb; v = (f <= 16) ? cosf(ang) : -sinf(ang); }
                z[i] = v; }
            __syncthreads();
            for (int i = tid; i < 1024; i += 512) { const int p = i >> 6, o = i & 63; float a = fb1[o]; for (int f = 0; f < 33; ++f) a += z[p * 33 + f] * fw1[f * 64 + o]; h1[i] = sinf(ffr[o] * a); }
            __syncthreads();
            for (int i = tid; i < 1024; i += 512) { const int p = i >> 6, o = i & 63; float a = fb2[o]; for (int k = 0; k < 64; ++k) a += h1[p * 64 + k] * fw2[k * 64 + o]; h2[i] = sinf(ffr[o] * a); }
            __syncthreads();
            for (int i = tid; i < 1024; i += 512) { const int p = i >> 6, o = i & 63; float a = fb3[o]; for (int k = 0; k < 64; ++k) a += h2[p * 64 + k] * fw3[k * 64 + o]; h3[i] = sinf(ffr[o] * a); }
            __syncthreads();
            for (int col = tid; col < 3072; col += 512) {
                float a[16]; const float bb = fb4[col];
#pragma unroll
                for (int p = 0; p < 16; ++p) a[p] = bb;
                for (int k = 0; k < 64; ++k) { const float w = fw4[(size_t)k * 3072 + col];
#pragma unroll
                    for (int p = 0; p < 16; ++p) a[p] += h3[p * 64 + k] * w; }
                const int c = col % 768; const float mind = -3.0701134573253945f, maxd = -15.350567286626972f;
                const float delta = fabsf(mind + (maxd - mind) * ((float)c / 767.0f)); float asum = 0.f;
#pragma unroll
                for (int p = 0; p < 16; ++p) { const float t = (float)(pos0 + p) / 4095.0f; a[p] *= expf(-t * delta); asum += fabsf(a[p]); }
                f32x4* dst = (f32x4*)(HRAWT + (size_t)col * 4096 + pos0);
#pragma unroll
                for (int q = 0; q < 4; ++q) dst[q] = (f32x4){a[4 * q], a[4 * q + 1], a[4 * q + 2], a[4 * q + 3]};
                HPART[(size_t)it * 3072 + col] = asum;
            }
        }
    }
}

__device__ __forceinline__ s16x4 vtr(const LAS unsigned char* p) { typedef short v4i16_t __attribute__((ext_vector_type(4))); return __builtin_bit_cast(s16x4, __builtin_amdgcn_ds_read_tr16_b64_v4i16((LAS v4i16_t*)p)); }
__device__ __forceinline__ void na_phase(const Ctx& cx, const bf16_t* PROJ, const float* rpb, bf16_t* CAT, const int tid) {
    const int lane = tid & 63, wid = __builtin_amdgcn_readfirstlane(tid >> 6), m16 = lane & 15, q4 = lane >> 4;
    LAS unsigned char* Kb = cx.lds; LAS unsigned char* Vb = cx.lds + 73728; LAS float* biasL = (LAS float*)(cx.lds + 147456);
    constexpr int PW = 2560;
    u32x4 kv[9], vv[9]; float bpre = 0.f;
#define NA_LOAD(unit_) do { const int b_ = __builtin_amdgcn_readfirstlane((unit_) / 384), rem_ = __builtin_amdgcn_readfirstlane((unit_) % 384), h_ = rem_ >> 5, rp_ = rem_ & 31; int bs_ = 2 * rp_ - 4; bs_ = bs_ < 0 ? 0 : (bs_ > 56 ? 56 : bs_); bs_ = __builtin_amdgcn_readfirstlane(bs_); \
        _Pragma("unroll") for (int it = 0; it < 9; ++it) { const int i = tid + it * 512; const int brow = i >> 9, col = (i >> 3) & 63, ch = i & 7; int grow = bs_ + brow; grow = grow > 63 ? 63 : grow; \
            const size_t tok = (size_t)b_ * 4096 + grow * 64 + col; \
            kv[it] = *(const u32x4*)(PROJ + tok * PW + 768 + h_ * 64 + ch * 8); vv[it] = *(const u32x4*)(PROJ + tok * PW + 1536 + h_ * 64 + ch * 8); } \
        if (tid < 465) bpre = rpb[h_ * 465 + tid] * LOG2E; } while (0)
    int u0 = cx.vcu; asm volatile("" : "+s"(u0));
    if (u0 < 6144) NA_LOAD(u0);
    for (int unit = u0; unit < 6144; unit += cx.G) {
        const int b = unit / 384, rem = unit % 384, h = rem >> 5, rp = rem & 31;
        int bs = 2 * rp - 4; bs = bs < 0 ? 0 : (bs > 56 ? 56 : bs);
        __syncthreads();
#pragma unroll
        for (int it = 0; it < 9; ++it) { const int i = tid + it * 512; const int brow = i >> 9, col = (i >> 3) & 63, ch = i & 7;
            *(LAS u32x4*)(Kb + (brow * 64 + col) * 128 + ((ch ^ ((col >> 1) & 7)) << 4)) = kv[it];
            *(LAS u32x4*)(Vb + (brow * 64 + col) * 128 + ((ch ^ (col & 7)) << 4)) = vv[it]; }
        if (tid < 465) biasL[tid] = bpre;
        __syncthreads();
        if (unit + cx.G < 6144) NA_LOAD(unit + cx.G);
        const int r = 2 * rp + (wid >> 2), g = wid & 3;
        const int wc0 = (g == 0) ? 0 : (g == 1) ? 8 : (g == 2) ? 24 : 32;
        int r0 = r - 4; r0 = r0 < 0 ? 0 : (r0 > 56 ? 56 : r0); const int ro = r0 - bs;
        const int c = 16 * g + m16;
        const size_t tq = (size_t)b * 4096 + r * 64 + c;
        bf16x8 qf[2];
#pragma unroll
        for (int kk = 0; kk < 2; ++kk) qf[kk] = *(const bf16x8*)(PROJ + tq * PW + h * 64 + 32 * kk + 8 * q4);
        f32x4 S[16];
#pragma unroll
        for (int i = 0; i < 8; ++i)
#pragma unroll
            for (int ct = 0; ct < 2; ++ct) { const int col = wc0 + 16 * ct + m16; const LAS unsigned char* kp = Kb + ((ro + i) * 64 + col) * 128; const int sw = (col >> 1) & 7;
                f32x4 a = (f32x4){0.f, 0.f, 0.f, 0.f};
#pragma unroll
                for (int kk = 0; kk < 2; ++kk) { const bf16x8 kf = *(const LAS bf16x8*)(kp + (((q4 + 4 * kk) ^ sw) << 4)); a = __builtin_amdgcn_mfma_f32_16x16x32_bf16(kf, qf[kk], a, 0, 0, 0); }
                S[2 * i + ct] = a; }
        int c0 = c - 8; c0 = c0 < 0 ? 0 : (c0 > 48 ? 48 : c0);
        float mx = -INFINITY;
#pragma unroll
        for (int i = 0; i < 8; ++i)
#pragma unroll
            for (int ct = 0; ct < 2; ++ct)
#pragma unroll
                for (int v = 0; v < 4; ++v) { const int kc = wc0 + 16 * ct + 4 * q4 + v; const bool valid = (kc >= c0) && (kc < c0 + 16);
                    const int bidx = valid ? (r0 + i - r + 7) * 31 + (kc - c + 15) : 0;
                    const float s = valid ? S[2 * i + ct][v] + biasL[bidx] : -INFINITY; S[2 * i + ct][v] = s; mx = fmaxf(mx, s); }
        mx = fmaxf(mx, shflx(mx, 16, lane)); mx = fmaxf(mx, shflx(mx, 32, lane));
        float l = 0.f;
#pragma unroll
        for (int t = 0; t < 16; ++t)
#pragma unroll
            for (int v = 0; v < 4; ++v) { const float p = __builtin_amdgcn_exp2f(S[t][v] - mx); S[t][v] = p; l += p; }
        l += shflx(l, 16, lane); l += shflx(l, 32, lane);
        f32x4 O[4];
#pragma unroll
        for (int dt = 0; dt < 4; ++dt) O[dt] = (f32x4){0.f, 0.f, 0.f, 0.f};
        const int qq = m16 >> 2, pp = m16 & 3, col1 = wc0 + 4 * q4 + qq;
#pragma unroll
        for (int i = 0; i < 8; ++i) {
            u32x4 pw; pw.x = pk2(S[2 * i][0], S[2 * i][1]); pw.y = pk2(S[2 * i][2], S[2 * i][3]); pw.z = pk2(S[2 * i + 1][0], S[2 * i + 1][1]); pw.w = pk2(S[2 * i + 1][2], S[2 * i + 1][3]);
            const bf16x8 pb = __builtin_bit_cast(bf16x8, pw);
            const LAS unsigned char* v1 = Vb + ((ro + i) * 64 + col1) * 128 + 8 * (pp & 1);
            const LAS unsigned char* v2 = v1 + 16 * 128;
#pragma unroll
            for (int dt = 0; dt < 4; ++dt) { const int chunk = 2 * dt + (pp >> 1);
                const s16x4 lo = vtr(v1 + ((chunk ^ (col1 & 7)) << 4)), hi = vtr(v2 + ((chunk ^ ((col1 + 16) & 7)) << 4));
                const bf16x8 vf = (bf16x8){lo[0], lo[1], lo[2], lo[3], hi[0], hi[1], hi[2], hi[3]};
                O[dt] = __builtin_amdgcn_mfma_f32_16x16x32_bf16(vf, pb, O[dt], 0, 0, 0); }
        }
        const float inv = 1.0f / l;
#pragma unroll
        for (int dt = 0; dt < 4; ++dt) {
            if constexpr (OUTP_F8) { int w = 0; w = __builtin_amdgcn_cvt_pk_fp8_f32(O[dt][0] * inv, O[dt][1] * inv, w, false); w = __builtin_amdgcn_cvt_pk_fp8_f32(O[dt][2] * inv, O[dt][3] * inv, w, true); *(int*)((unsigned char*)CAT + tq * 1024 + h * 64 + 16 * dt + 4 * q4) = w; }
            else { u32x2 w; w.x = pk2(O[dt][0] * inv, O[dt][1] * inv); w.y = pk2(O[dt][2] * inv, O[dt][3] * inv); *(u32x2*)(CAT + tq * 1024 + h * 64 + 16 * dt + 4 * q4) = w; } }
    }
    __syncthreads();
}

#undef NA_LOAD
__device__ __forceinline__ void rope_phase(const Ctx& cx, const bf16_t* PROJ, const float* qg, const float* kg, bf16_t* QKR, const int tid) {
    const int lane = tid & 63, wave = __builtin_amdgcn_readfirstlane(tid >> 6);
    const int gw = cx.vcu * 8 + wave, NGW = cx.G * 8;
    const int d0 = (lane & 7) * 8;
    float gq[8], gk[8], invf[4];
#pragma unroll
    for (int e = 0; e < 8; ++e) { gq[e] = qg[d0 + e]; gk[e] = kg[d0 + e]; }
#pragma unroll
    for (int p = 0; p < 4; ++p) { const int i = (d0 >> 1) + p, j = i & 15; invf[p] = exp2f(-(float)(2 * j) / 32.0f * 13.287712379549449f); }
    const bool isrow = (d0 >> 1) < 16;
    for (int pos = gw; pos < SEQ; pos += NGW) {
        const float pr = isrow ? (float)(pos >> 6) : (float)(pos & 63);
        float cs[4], sn[4];
#pragma unroll
        for (int p = 0; p < 4; ++p) { const float a = pr * invf[p]; cs[p] = cosf(a); sn[p] = sinf(a); }
#pragma unroll 4
        for (int bb = 0; bb < BATCH; ++bb) { const int tok = bb * SEQ + pos;
#pragma unroll
        for (int half = 0; half < 2; ++half) {
            const int e0 = half * 512 + lane * 8; const int head = e0 >> 6; const bool isq = head < 12;
            const u32x4 raw = *(const u32x4*)(PROJ + (size_t)tok * 1536 + e0);
            float x[8]; x[0] = bflo(raw.x); x[1] = bfhi(raw.x); x[2] = bflo(raw.y); x[3] = bfhi(raw.y); x[4] = bflo(raw.z); x[5] = bfhi(raw.z); x[6] = bflo(raw.w); x[7] = bfhi(raw.w);
            float ss = 0.f;
#pragma unroll
            for (int e = 0; e < 8; ++e) ss += x[e] * x[e];
            ss = group8_sum(ss);
            const float inv = rsqrtf(ss * (1.0f / 64.0f) + 1e-6f);
            float y[8];
#pragma unroll
            for (int e = 0; e < 8; ++e) y[e] = x[e] * inv * (isq ? gq[e] : gk[e]);
            const float sc = isq ? C2 : 1.0f;
            float o[8];
#pragma unroll
            for (int p = 0; p < 4; ++p) { o[2 * p] = (y[2 * p] * cs[p] - y[2 * p + 1] * sn[p]) * sc; o[2 * p + 1] = (y[2 * p] * sn[p] + y[2 * p + 1] * cs[p]) * sc; }
            u32x4 w; w.x = pk2(o[0], o[1]); w.y = pk2(o[2], o[3]); w.z = pk2(o[4], o[5]); w.w = pk2(o[6], o[7]);
            *(u32x4*)(QKR + (size_t)tok * 1024 + e0) = w;
        } }
    }
}

__device__ __forceinline__ void sconv_phase(const Ctx& cx, const bf16_t* PROJ, const float* cw, const float* cb, bf16_t* UT3, unsigned char* V8, const int tid) {
    const int lane = tid & 63, wave = __builtin_amdgcn_readfirstlane(tid >> 6);
    const int gw = cx.vcu * 8 + wave, NGW = cx.G * 8;
    LAS unsigned short* tile = (LAS unsigned short*)(cx.lds + wave * 9216);
    constexpr int PW = 2560;
    for (int it = gw; it < 16 * 64 * 36; it += NGW) {
        const int ct = it % 36, tt = (it / 36) & 63, b = it / (36 * 64);
        const int col = ct * 64 + lane, t0 = tt * 64;
        const float w0 = cw[col], w1 = cw[2304 + col], w2 = cw[4608 + col], bia = cb[col];
        const bf16_t* src = PROJ + ((size_t)b * 4096 + t0) * PW + col;
        unsigned short uu[66];
        uu[0] = (t0 > 0) ? src[-(long)PW] : (unsigned short)0;
#pragma unroll
        for (int k = 0; k < 64; ++k) uu[k + 1] = src[(size_t)k * PW];
        uu[65] = (t0 + 64 < 4096) ? src[(size_t)64 * PW] : (unsigned short)0;
#pragma unroll
        for (int k = 0; k < 64; ++k) { const float v = bf2f(uu[k]) * w0 + bf2f(uu[k + 1]) * w1 + bf2f(uu[k + 2]) * w2 + bia; tile[lane * 72 + k] = (unsigned short)f2bf(v); }
        LDS_WAIT(); asm volatile("" ::: "memory");
        const int part = (ct * 64) / 768, cbase = (ct * 64) % 768;
#pragma unroll
        for (int k = 0; k < 8; ++k) { const int row = k * 8 + (lane >> 3), chn = lane & 7;
            const u32x4 v = *(const LAS u32x4*)((const LAS unsigned char*)tile + row * 144 + chn * 16);
            *(u32x4*)(UT3 + (((size_t)part * 16 + b) * 768 + cbase + row) * 4096 + t0 + chn * 8) = v;
            if (TCONV_F8 && part == 0) { int w0 = 0, w1 = 0;
                w0 = __builtin_amdgcn_cvt_pk_fp8_f32(bflo(v.x), bfhi(v.x), w0, false); w0 = __builtin_amdgcn_cvt_pk_fp8_f32(bflo(v.y), bfhi(v.y), w0, true);
                w1 = __builtin_amdgcn_cvt_pk_fp8_f32(bflo(v.z), bfhi(v.z), w1, false); w1 = __builtin_amdgcn_cvt_pk_fp8_f32(bflo(v.w), bfhi(v.w), w1, true);
                *(u32x2*)(V8 + ((size_t)b * 768 + cbase + row) * 4096 + t0 + chn * 8) = (u32x2){(unsigned)w0, (unsigned)w1}; } }
        LDS_WAIT(); asm volatile("" ::: "memory");
    }
}

constexpr int TZ_CS = 16384 + 64;
__device__ __forceinline__ void tconv_phase(const Ctx& cx, const int o, const bf16_t* UT, const bf16_t* GT, bf16_t* ZT, const float* lbias  , const int tid) {
    const int lane = tid & 63, wid = __builtin_amdgcn_readfirstlane(tid >> 6), m16 = lane & 15, q4 = lane >> 4;
    const float* HRAWT = (const float*)(cx.ws + WS_HRAWT); const float* HPART = (const float*)(cx.ws + WS_HPART);
    LAS unsigned char* cp = cx.lds; LAS float* red = (LAS float*)(cx.lds + 8 * TZ_CS);
    for (int c = cx.vcu; c < 768; c += cx.G) {
        __syncthreads();
        { const int dir = tid >> 8, blk = tid & 255; float v = HPART[(size_t)blk * 3072 + dir * 1536 + o * 768 + c]; v = wave_sum(v, lane); if (lane == 0) red[wid] = v; }
        __syncthreads();
        float nrm = 0.f;
#pragma unroll
        for (int w = 0; w < 8; ++w) nrm += red[w];
        const float inv = 1.0f / nrm;
        const float* hf = HRAWT + (size_t)(o * 768 + c) * 4096; const float* hb = HRAWT + (size_t)(1536 + o * 768 + c) * 4096;
        for (int i = tid; i < 8192; i += 512) { float v; if (i < 4096) v = hf[4095 - i]; else if (i < 8191) v = hb[i - 4095]; else v = 0.f;
            *(LAS unsigned short*)(cp + 2 * i) = (unsigned short)f2bf(v * inv); }
        __syncthreads();
#pragma unroll
        for (int j = 1; j < 8; ++j)
            for (int n = tid; n < 1024; n += 512) {
                const u32x4 lo = *(const LAS u32x4*)(cp + n * 16); u32x4 hi = (u32x4){0u, 0u, 0u, 0u}; if (n + 1 < 1024) hi = *(const LAS u32x4*)(cp + (n + 1) * 16);
                const unsigned w[8] = {lo.x, lo.y, lo.z, lo.w, hi.x, hi.y, hi.z, hi.w}; u32x4 r;
                const int a = j >> 1;
                if (j & 1) { r.x = (w[a] >> 16) | (w[a + 1] << 16); r.y = (w[a + 1] >> 16) | (w[a + 2] << 16); r.z = (w[a + 2] >> 16) | (w[a + 3] << 16); r.w = (w[a + 3] >> 16) | (w[a + 4] << 16); }
                else { r.x = w[a]; r.y = w[a + 1]; r.z = w[a + 2]; r.w = w[a + 3]; }
                *(LAS u32x4*)(cp + j * TZ_CS + n * 16) = r;
            }
        __syncthreads();
        const int j = (7 - m16) & 7;
        const int nbase = (4095 - 512 * wid - m16 - j + 8 * q4) >> 3;
        const LAS unsigned char* ap = cp + j * TZ_CS + (nbase - 62) * 16;
        const bf16_t* up = UT + ((size_t)m16 * 768 + c) * 4096 + 8 * q4;
        f32x4 acc[32];
#pragma unroll
        for (int ti = 0; ti < 32; ++ti) acc[ti] = (f32x4){0.f, 0.f, 0.f, 0.f};
        bf16x8 bcur = *(const bf16x8*)(up);
        bf16x8 afA[8], afB[8];
#pragma unroll
        for (int i = 0; i < 8; ++i) afA[i] = *(const LAS bf16x8*)(ap + (31 - i) * 32);
        for (int ks = 0; ks < 128; ++ks) {
            const bf16x8 bnext = *(const bf16x8*)(up + ((ks + 1) & 127) * 32);
            const LAS unsigned char* a0 = ap + ks * 64;
            const LAS unsigned char* a1 = ap + ((ks + 1) & 127) * 64;
#define TZ_LD(dst, base, g) do { _Pragma("unroll") for (int i = 0; i < 8; ++i) dst[i] = *(const LAS bf16x8*)((base) + (31 - (8 * (g) + i)) * 32); } while (0)
#define TZ_MM(src, g) do { _Pragma("unroll") for (int i = 0; i < 8; ++i) acc[8 * (g) + i] = __builtin_amdgcn_mfma_f32_16x16x32_bf16(src[i], bcur, acc[8 * (g) + i], 0, 0, 0); } while (0)
            TZ_LD(afB, a0, 1); TZ_MM(afA, 0); __builtin_amdgcn_sched_barrier(0);
            TZ_LD(afA, a0, 2); TZ_MM(afB, 1); __builtin_amdgcn_sched_barrier(0);
            TZ_LD(afB, a0, 3); TZ_MM(afA, 2); __builtin_amdgcn_sched_barrier(0);
            TZ_LD(afA, a1, 0); TZ_MM(afB, 3); __builtin_amdgcn_sched_barrier(0);
#undef TZ_LD
#undef TZ_MM
            bcur = bnext;
        }
        const float lb = lbias[c];
        const size_t rowoff = ((size_t)m16 * 768 + c) * 4096 + 512 * wid + 4 * q4;
#pragma unroll
        for (int ti = 0; ti < 32; ++ti) {
            const u32x2 uu = *(const u32x2*)(UT + rowoff + 16 * ti), gg = *(const u32x2*)(GT + rowoff + 16 * ti);
            const float y0 = (acc[ti][0] + lb * bflo(uu.x)) * bflo(gg.x), y1 = (acc[ti][1] + lb * bfhi(uu.x)) * bfhi(gg.x), y2 = (acc[ti][2] + lb * bflo(uu.y)) * bflo(gg.y), y3 = (acc[ti][3] + lb * bfhi(uu.y)) * bfhi(gg.y);
            u32x2 w; w.x = pk2(y0, y1); w.y = pk2(y2, y3);
            *(u32x2*)(ZT + rowoff + 16 * ti) = w;
            if ((ti & 7) == 7) __builtin_amdgcn_sched_barrier(0);
        }
    }
    __syncthreads();
}

constexpr int T8_CS = 8192 + 256;
__host__ __device__ constexpr int t8_sig(int j) { return j < 4 ? 2 * j : (j >= 12 ? 2 * (j - 8) : 2 * (j - 4) + 1); }
__device__ __forceinline__ float wave_max_nn(float v) {
    v = fmaxf(v, dpp_x<0xB1>(v)); v = fmaxf(v, dpp_x<0x4E>(v)); v = fmaxf(v, dpp_x<0x141>(v)); v = fmaxf(v, dpp_x<0x140>(v));
    v = fmaxf(v, __builtin_bit_cast(float, __builtin_amdgcn_update_dpp(0, __builtin_bit_cast(int, v), 0x142, 0xA, 0xF, false)));
    v = fmaxf(v, __builtin_bit_cast(float, __builtin_amdgcn_update_dpp(0, __builtin_bit_cast(int, v), 0x143, 0xC, 0xF, false)));
    return __builtin_bit_cast(float, __builtin_amdgcn_readlane(__builtin_bit_cast(int, v), 63));
}
__device__ __forceinline__ void tconv8_phase(const Ctx& cx, const int o, const bf16_t* UT, const unsigned char* U8, const bf16_t* GT, bf16_t* ZT, unsigned char* Z8  ,
                                             const float* lbias, const int tid) {
    const int lane = tid & 63, wid = __builtin_amdgcn_readfirstlane(tid >> 6), m16 = lane & 15, q4 = lane >> 4;
    const float* HRAWT = (const float*)(cx.ws + WS_HRAWT); const float* HPART = (const float*)(cx.ws + WS_HPART);
    LAS unsigned char* cp = cx.lds; LAS float* red = (LAS float*)(cx.lds + 16 * T8_CS);
    for (int c = cx.vcu; c < 768; c += cx.G) {
        __syncthreads();
        const float* hf = HRAWT + (size_t)(o * 768 + c) * 4096; const float* hb = HRAWT + (size_t)(1536 + o * 768 + c) * 4096;
        float tap[16]; float mx = 0.f;
        int t3 = tid; asm volatile("" : "+v"(t3));
#pragma unroll
        for (int k = 0; k < 16; ++k) { const int i = t3 * 16 + k; float v; if (i < 4096) v = hf[4095 - i]; else if (i < 8191) v = hb[i - 4095]; else v = 0.f; tap[k] = v; mx = fmaxf(mx, fabsf(v)); }
        { const int dir = tid >> 8, blk = tid & 255; float v = HPART[(size_t)blk * 3072 + dir * 1536 + o * 768 + c]; v = wave_sum(v, lane); mx = wave_max_nn(mx); if (lane == 0) { red[wid] = v; red[8 + wid] = mx; } }
        __syncthreads();
        float nrm = 0.f, mall = 0.f;
#pragma unroll
        for (int w = 0; w < 8; ++w) { nrm += red[w]; mall = fmaxf(mall, red[8 + w]); }
        const float inv = 1.0f / nrm;
        int ex; (void)frexpf(fmaxf(mall * inv, 1e-30f), &ex);
        const float fsc = ldexpf(1.0f, 7 - ex), unsc = ldexpf(1.0f, ex - 7), tsc = inv * fsc;
        { unsigned w[4];
#pragma unroll
          for (int q = 0; q < 4; ++q) { int r = 0; r = __builtin_amdgcn_cvt_pk_fp8_f32(tap[4 * q] * tsc, tap[4 * q + 1] * tsc, r, false); r = __builtin_amdgcn_cvt_pk_fp8_f32(tap[4 * q + 2] * tsc, tap[4 * q + 3] * tsc, r, true); w[q] = (unsigned)r; }
          *(LAS u32x4*)(cp + tid * 16) = (u32x4){w[0], w[1], w[2], w[3]}; }
        __syncthreads();
        { const u32x4 lo = *(const LAS u32x4*)(cp + tid * 16); u32x4 hi = (u32x4){0u, 0u, 0u, 0u}; if (tid + 1 < 512) hi = *(const LAS u32x4*)(cp + (tid + 1) * 16);
          const unsigned w[8] = {lo.x, lo.y, lo.z, lo.w, hi.x, hi.y, hi.z, hi.w};
#pragma unroll
          for (int j = 1; j < 16; ++j) { u32x4 r; const int a = j >> 2, sh = j & 3;
              r.x = sh ? __builtin_amdgcn_alignbyte(w[a + 1], w[a], sh) : w[a]; r.y = sh ? __builtin_amdgcn_alignbyte(w[a + 2], w[a + 1], sh) : w[a + 1];
              r.z = sh ? __builtin_amdgcn_alignbyte(w[a + 3], w[a + 2], sh) : w[a + 2]; r.w = sh ? __builtin_amdgcn_alignbyte(w[a + 4], w[a + 3], sh) : w[a + 3];
              *(LAS u32x4*)(cp + j * T8_CS + t8_sig(j) * 16 + tid * 16) = r; } }
        __syncthreads();
        const int jc = 15 - m16;
        const int nbase = 255 - 32 * wid + 2 * q4;
        const LAS unsigned char* ap = cp + jc * T8_CS + t8_sig(jc) * 16 + (nbase - 31) * 16;
        const unsigned char* up = U8 + ((size_t)m16 * 768 + c) * 4096 + 32 * q4;
        f32x4 acc[32];
#pragma unroll
        for (int ti = 0; ti < 32; ++ti) acc[ti] = (f32x4){0.f, 0.f, 0.f, 0.f};
        typedef int v8i_t __attribute__((ext_vector_type(8))); typedef int v4i_t __attribute__((ext_vector_type(4)));
#define T8_FRAG(p) __builtin_shufflevector(*(const LAS v4i_t*)(p), *(const LAS v4i_t*)((p) + 16), 0, 1, 2, 3, 4, 5, 6, 7)
        v8i_t bcur = __builtin_shufflevector(*(const v4i_t*)(up), *(const v4i_t*)(up + 16), 0, 1, 2, 3, 4, 5, 6, 7);
        v8i_t afA[4], afB[4];
#pragma unroll
        for (int i = 0; i < 4; ++i) afA[i] = T8_FRAG(ap + (31 - i) * 16);
        for (int ks = 0; ks < 32; ++ks) {
            const unsigned char* un = up + ((ks + 1) & 31) * 128;
            const v8i_t bnext = __builtin_shufflevector(*(const v4i_t*)(un), *(const v4i_t*)(un + 16), 0, 1, 2, 3, 4, 5, 6, 7);
            const LAS unsigned char* a0 = ap + ks * 128;
            const LAS unsigned char* a1 = ap + ((ks + 1) & 31) * 128;
#define T8_LD(dst, base, g) do { _Pragma("unroll") for (int i = 0; i < 4; ++i) dst[i] = T8_FRAG((base) + (31 - (4 * (g) + i)) * 16); } while (0)
#define T8_MM(src, g) do { _Pragma("unroll") for (int i = 0; i < 4; ++i) acc[4 * (g) + i] = __builtin_amdgcn_mfma_scale_f32_16x16x128_f8f6f4(src[i], bcur, acc[4 * (g) + i], 0, 0, 0, 0, 0, 0); } while (0)
            T8_LD(afB, a0, 1); T8_MM(afA, 0); __builtin_amdgcn_sched_barrier(0);
            T8_LD(afA, a0, 2); T8_MM(afB, 1); __builtin_amdgcn_sched_barrier(0);
            T8_LD(afB, a0, 3); T8_MM(afA, 2); __builtin_amdgcn_sched_barrier(0);
            T8_LD(afA, a0, 4); T8_MM(afB, 3); __builtin_amdgcn_sched_barrier(0);
            T8_LD(afB, a0, 5); T8_MM(afA, 4); __builtin_amdgcn_sched_barrier(0);
            T8_LD(afA, a0, 6); T8_MM(afB, 5); __builtin_amdgcn_sched_barrier(0);
            T8_LD(afB, a0, 7); T8_MM(afA, 6); __builtin_amdgcn_sched_barrier(0);
            T8_LD(afA, a1, 0); T8_MM(afB, 7); __builtin_amdgcn_sched_barrier(0);
#undef T8_LD
#undef T8_MM
            bcur = bnext;
        }
#undef T8_FRAG
        const float lb = lbias[c];
        const size_t rowoff = ((size_t)m16 * 768 + c) * 4096 + 512 * wid + 4 * q4;
#pragma unroll
        for (int ti = 0; ti < 32; ++ti) {
            const u32x2 uu = *(const u32x2*)(UT + rowoff + 16 * ti), gg = *(const u32x2*)(GT + rowoff + 16 * ti);
            const float y0 = (acc[ti][0] * unsc + lb * bflo(uu.x)) * bflo(gg.x), y1 = (acc[ti][1] * unsc + lb * bfhi(uu.x)) * bfhi(gg.x), y2 = (acc[ti][2] * unsc + lb * bflo(uu.y)) * bflo(gg.y), y3 = (acc[ti][3] * unsc + lb * bfhi(uu.y)) * bfhi(gg.y);
            u32x2 w; w.x = pk2(y0, y1); w.y = pk2(y2, y3);
            *(u32x2*)(ZT + rowoff + 16 * ti) = w;
            if (Z8) { int w8 = 0; w8 = __builtin_amdgcn_cvt_pk_fp8_f32(fminf(fmaxf(y0, -440.f), 440.f), fminf(fmaxf(y1, -440.f), 440.f), w8, false); w8 = __builtin_amdgcn_cvt_pk_fp8_f32(fminf(fmaxf(y2, -440.f), 440.f), fminf(fmaxf(y3, -440.f), 440.f), w8, true);
                *(int*)(Z8 + rowoff + 16 * ti) = w8; }
            if ((ti & 7) == 7) __builtin_amdgcn_sched_barrier(0);
        }
    }
    __syncthreads();
}

__device__ __forceinline__ void tback_phase(const Ctx& cx, const bf16_t* ZT, bf16_t* CAT, const int tid) {
    const int lane = tid & 63, wave = __builtin_amdgcn_readfirstlane(tid >> 6);
    const int gw = cx.vcu * 8 + wave, NGW = cx.G * 8;
    LAS unsigned char* tile = cx.lds + wave * 9216;
    for (int it = gw; it < 16 * 12 * 64; it += NGW) {
        const int tt = it & 63, ct = (it >> 6) % 12, b = it / (64 * 12);
        const int c0 = ct * 64, t0 = tt * 64;
#pragma unroll
        for (int k = 0; k < 8; ++k) { const int row = k * 8 + (lane >> 3), chn = lane & 7;
            const u32x4 v = *(const u32x4*)(ZT + ((size_t)b * 768 + c0 + row) * 4096 + t0 + chn * 8);
            *(LAS u32x4*)(tile + row * 144 + chn * 16) = v; }
        LDS_WAIT(); asm volatile("" ::: "memory");
        if constexpr (OUTP_F8) { unsigned char* dst = (unsigned char*)CAT + ((size_t)b * 4096 + t0) * 1024 + c0 + lane;
#pragma unroll 8
            for (int k = 0; k < 64; ++k) { const float v = bf2f(*(const LAS unsigned short*)(tile + lane * 144 + k * 2)); dst[(size_t)k * 1024] = f2fp8(fminf(fmaxf(v, -440.0f), 440.0f)); }
        } else { bf16_t* dst = CAT + ((size_t)b * 4096 + t0) * 1024 + c0 + lane;
#pragma unroll 8
            for (int k = 0; k < 64; ++k) dst[(size_t)k * 1024] = *(const LAS unsigned short*)(tile + lane * 144 + k * 2); }
        LDS_WAIT(); asm volatile("" ::: "memory");
    }
}

__device__ __forceinline__ void ln1_group(const int bt, const int chunk, const int wave, const int lane, const int r16, const int q4, const bf16_t* XI, bf16_t* XO, bf16_t* XB, const float* g, const float* bta,
                                          const LAS unsigned char* Wh, const LAS unsigned char* Wl, LAS float* lg, LAS int* lcnt, const float rb0, const float rb1, float* gate, unsigned (&pk)[2], unsigned (&gp)[2]) {
    constexpr int WP = 2064;
            const size_t rowU = (size_t)chunk * 256 + wave * 32 + bt * 16;
            unsigned loff = (unsigned)(r16 * 1024 + 8 * q4); asm volatile("" : "+v"(loff));
            const GAS bf16_t* src = (const GAS bf16_t*)XI + rowU * 1024 + loff;
            constexpr int HOLD = LN1_HOLD;
            u32x4 raw[HOLD > 0 ? HOLD : 1], rawt[32 - HOLD]; float s = 0.f, ss = 0.f;
#pragma unroll
            for (int i = 0; i < 32; ++i) { if (i < HOLD) raw[i] = *(const GAS u32x4*)(src + 32 * i); else rawt[i - HOLD] = *(const GAS u32x4*)(src + 32 * i); }
#pragma unroll
            for (int i = 0; i < 32; ++i) { const u32x4 rr = (i < HOLD) ? raw[i < HOLD ? i : 0] : rawt[i < HOLD ? 0 : i - HOLD]; const float x0 = bflo(rr.x), x1 = bfhi(rr.x), x2 = bflo(rr.y), x3 = bfhi(rr.y), x4 = bflo(rr.z), x5 = bfhi(rr.z), x6 = bflo(rr.w), x7 = bfhi(rr.w);
                s += ((x0 + x1) + (x2 + x3)) + ((x4 + x5) + (x6 + x7)); ss += ((x0 * x0 + x1 * x1) + (x2 * x2 + x3 * x3)) + ((x4 * x4 + x5 * x5) + (x6 * x6 + x7 * x7)); }
            lg[2 * lane] = s; lg[2 * lane + 1] = ss; LDS_WAIT(); asm volatile("" ::: "memory");
            s = (lg[2 * r16] + lg[2 * (r16 + 16)]) + (lg[2 * (r16 + 32)] + lg[2 * (r16 + 48)]); ss = (lg[2 * r16 + 1] + lg[2 * (r16 + 16) + 1]) + (lg[2 * (r16 + 32) + 1] + lg[2 * (r16 + 48) + 1]);
            LDS_WAIT(); asm volatile("" ::: "memory");
            const float mean = s * (1.0f / 1024.0f), rstd = rsqrtf(fmaxf(ss * (1.0f / 1024.0f) - mean * mean, 0.f) + LN_EPS);
            f32x4 a0 = (f32x4){0.f, 0.f, 0.f, 0.f}, a1 = (f32x4){0.f, 0.f, 0.f, 0.f};
            const LAS unsigned char* wh0 = Wh + r16 * WP + 16 * q4; const LAS unsigned char* wl0 = Wl + r16 * WP + 16 * q4;
            GAS bf16_t* dsto = (GAS bf16_t*)XO + rowU * 1024 + loff; GAS unsigned char* dst8 = (GAS unsigned char*)XB + rowU * 1024 + loff;
#pragma unroll
            for (int i = 0; i < 32; ++i) {
                const GAS float* gp_ = (const GAS float*)g + 32 * i + 8 * q4; const GAS float* bp_ = (const GAS float*)bta + 32 * i + 8 * q4;
                const f32x4 g0 = *(const GAS f32x4*)gp_, g1 = *(const GAS f32x4*)(gp_ + 4), b0 = *(const GAS f32x4*)bp_, b1 = *(const GAS f32x4*)(bp_ + 4);
                u32x4 rw_; if (i < HOLD) rw_ = raw[i < HOLD ? i : 0]; else rw_ = *(const GAS u32x4*)(src + 32 * i); asm volatile("" : "+v"(rw_));
                float y[8]; y[0] = bflo(rw_.x); y[1] = bfhi(rw_.x); y[2] = bflo(rw_.y); y[3] = bfhi(rw_.y); y[4] = bflo(rw_.z); y[5] = bfhi(rw_.z); y[6] = bflo(rw_.w); y[7] = bfhi(rw_.w);
#pragma unroll
                for (int q = 0; q < 8; ++q) y[q] = (y[q] - mean) * rstd * (q < 4 ? g0[q & 3] : g1[q & 3]) + (q < 4 ? b0[q & 3] : b1[q & 3]);
                u32x4 hi; hi.x = pk2(y[0], y[1]); hi.y = pk2(y[2], y[3]); hi.z = pk2(y[4], y[5]); hi.w = pk2(y[6], y[7]);
                *(GAS u32x4*)(dsto + 32 * i) = hi;
                if constexpr (MOE_F8) { int w0 = 0, w1 = 0; w0 = __builtin_amdgcn_cvt_pk_fp8_f32(y[0], y[1], w0, false); w0 = __builtin_amdgcn_cvt_pk_fp8_f32(y[2], y[3], w0, true); w1 = __builtin_amdgcn_cvt_pk_fp8_f32(y[4], y[5], w1, false); w1 = __builtin_amdgcn_cvt_pk_fp8_f32(y[6], y[7], w1, true);
                    *(GAS u32x2*)(dst8 + 32 * i) = (u32x2){(unsigned)w0, (unsigned)w1}; }
                else { *(u32x4*)((bf16_t*)XB + rowU * 1024 + loff + 32 * i) = hi; }
                u32x4 lo; lo.x = pk2(y[0] - bflo(hi.x), y[1] - bfhi(hi.x)); lo.y = pk2(y[2] - bflo(hi.y), y[3] - bfhi(hi.y)); lo.z = pk2(y[4] - bflo(hi.z), y[5] - bfhi(hi.z)); lo.w = pk2(y[6] - bflo(hi.w), y[7] - bfhi(hi.w));
                const bf16x8 ah = __builtin_bit_cast(bf16x8, hi), al = __builtin_bit_cast(bf16x8, lo);
                const bf16x8 wh_0 = *(const LAS bf16x8*)(wh0 + 64 * i), wh_1 = *(const LAS bf16x8*)(wh0 + 16 * WP + 64 * i), wl_0 = *(const LAS bf16x8*)(wl0 + 64 * i), wl_1 = *(const LAS bf16x8*)(wl0 + 16 * WP + 64 * i);
                a0 = __builtin_amdgcn_mfma_f32_16x16x32_bf16(ah, wh_0, a0, 0, 0, 0); a1 = __builtin_amdgcn_mfma_f32_16x16x32_bf16(ah, wh_1, a1, 0, 0, 0);
                a0 = __builtin_amdgcn_mfma_f32_16x16x32_bf16(al, wh_0, a0, 0, 0, 0); a1 = __builtin_amdgcn_mfma_f32_16x16x32_bf16(al, wh_1, a1, 0, 0, 0);
                a0 = __builtin_amdgcn_mfma_f32_16x16x32_bf16(ah, wl_0, a0, 0, 0, 0); a1 = __builtin_amdgcn_mfma_f32_16x16x32_bf16(ah, wl_1, a1, 0, 0, 0);
                asm volatile("" :: "v"(ah), "v"(al), "v"(wh_0), "v"(wh_1), "v"(wl_0), "v"(wl_1));
                __builtin_amdgcn_sched_barrier(0);
            }
#pragma unroll
            for (int v = 0; v < 4; ++v) { lg[(4 * q4 + v) * 33 + r16] = a0[v] + rb0; lg[(4 * q4 + v) * 33 + r16 + 16] = a1[v] + rb1; }
            LDS_WAIT(); asm volatile("" ::: "memory");
            if (lane < 16) {
                const LAS float* myl = lg + lane * 33; const size_t rowt = (size_t)chunk * 256 + wave * 32 + bt * 16 + lane;
                float tv[4]; int te[4]; int t0 = -1, t1 = -1, t2 = -1;
#pragma unroll
                for (int k = 0; k < 4; ++k) { float best = -INFINITY; int bi = 0;
                    for (int e = 0; e < 32; ++e) { const float v = myl[e]; const bool ok = (e != t0) && (e != t1) && (e != t2); if (ok && v > best) { best = v; bi = e; } }
                    tv[k] = best; te[k] = bi; if (k == 0) t0 = bi; else if (k == 1) t1 = bi; else if (k == 2) t2 = bi; }
                const float e1 = __expf(tv[1] - tv[0]), e2 = __expf(tv[2] - tv[0]), e3 = __expf(tv[3] - tv[0]); const float isum = 1.0f / (1.0f + e1 + e2 + e3);
                const float gk[4] = {isum, e1 * isum, e2 * isum, e3 * isum};
                pk[0] = 0u; pk[1] = 0u;
#pragma unroll
                for (int k = 0; k < 4; ++k) { const int rk = __hip_atomic_fetch_add(lcnt + te[k], 1, __ATOMIC_RELAXED, __HIP_MEMORY_SCOPE_WORKGROUP); pk[k >> 1] |= (unsigned)((te[k] << 11) | rk) << (16 * (k & 1)); }
                gp[0] = pk2(gk[0], gk[1]); gp[1] = pk2(gk[2], gk[3]); (void)rowt; (void)gate;
            }
            LDS_WAIT(); asm volatile("" ::: "memory");
}
__device__ __forceinline__ void ln1_router_phase(const Ctx& cx, const bf16_t* XI, bf16_t* XO, bf16_t* XB, const float* g, const float* bta, const float* rw, const float* rb,
                                                 unsigned* cnt, int* expid, float* gate, int* idx, float* gidx, const int tid) {
    const int lane = tid & 63, wave = __builtin_amdgcn_readfirstlane(tid >> 6), r16 = lane & 15, q4 = lane >> 4;
    constexpr int WP = 2064;
    LAS unsigned char* Wh = cx.lds; LAS unsigned char* Wl = cx.lds + 32 * WP; LAS int* lcnt = (LAS int*)(cx.lds + 64 * WP); LAS int* lbase = lcnt + 32; LAS float* lg = (LAS float*)(cx.lds + 64 * WP + 256 + wave * 2112);
    __syncthreads();
    for (int i = tid; i < 32768; i += 512) { const int k = i >> 5, e = i & 31; const float w = rw[i]; const unsigned hi = f2bf(w); const float wl = w - bf2f((unsigned short)hi);
        *(LAS unsigned short*)(Wh + e * WP + 2 * k) = (unsigned short)hi; *(LAS unsigned short*)(Wl + e * WP + 2 * k) = (unsigned short)f2bf(wl); }
    if (tid < 32) lcnt[tid] = 0;
    const float rb0 = rb[r16], rb1 = rb[r16 + 16];
    __syncthreads();
    for (int chunk = cx.vcu; chunk < NTOK / 256; chunk += cx.G) {
        unsigned pk0[2] = {0u, 0u}, pk1[2] = {0u, 0u}, gp0[2] = {0u, 0u}, gp1[2] = {0u, 0u};
        ln1_group(0, chunk, wave, lane, r16, q4, XI, XO, XB, g, bta, Wh, Wl, lg, lcnt, rb0, rb1, gate, pk0, gp0);
        ln1_group(1, chunk, wave, lane, r16, q4, XI, XO, XB, g, bta, Wh, Wl, lg, lcnt, rb0, rb1, gate, pk1, gp1);
        __syncthreads();
        { int t2 = tid; asm volatile("" : "+v"(t2));
          if (t2 < 32) { lbase[t2] = (int)__hip_atomic_fetch_add(cnt + t2, (unsigned)lcnt[t2], __ATOMIC_RELAXED, __HIP_MEMORY_SCOPE_AGENT); } }
        __syncthreads();
        const int ln_ = lane_id_volatile();
        if (ln_ < 16) {
            { const int slot0 = (chunk * 256 + wave * 32 + ln_) * 4;
#pragma unroll
                for (int k = 0; k < 4; ++k) { const unsigned p = (pk0[k >> 1] >> (16 * (k & 1))) & 0xffffu; const int e = (int)(p >> 11), rk = (int)(p & 0x7ffu); const size_t o_ = (size_t)e * IDXCAP + lbase[e] + rk; idx[o_] = slot0 + k; gidx[o_] = (k & 1) ? bfhi(gp0[k >> 1]) : bflo(gp0[k >> 1]); } }
            { const int slot0 = (chunk * 256 + wave * 32 + 16 + ln_) * 4;
#pragma unroll
                for (int k = 0; k < 4; ++k) { const unsigned p = (pk1[k >> 1] >> (16 * (k & 1))) & 0xffffu; const int e = (int)(p >> 11), rk = (int)(p & 0x7ffu); const size_t o_ = (size_t)e * IDXCAP + lbase[e] + rk; idx[o_] = slot0 + k; gidx[o_] = (k & 1) ? bfhi(gp1[k >> 1]) : bflo(gp1[k >> 1]); } }
        }
        __syncthreads();
        if (tid < 32) lcnt[tid] = 0;
        __syncthreads();
    }
}

__device__ __forceinline__ void ln2_phase(const Ctx& cx, const bf16_t* X1, const bf16_t* Y, bf16_t* XO, bf16_t* XB, float* OUT, const float* g, const float* bta, const int tid) {
    const int lane = tid & 63, wave = __builtin_amdgcn_readfirstlane(tid >> 6);
    const int gw = cx.vcu * 8 + wave, NGW = cx.G * 8;
    for (int rp = gw; rp < NTOK / 2; rp += NGW) {
        f32x4 v[2][4]; float s[2] = {0.f, 0.f};
#pragma unroll
        for (int r = 0; r < 2; ++r) { const size_t row = (size_t)rp * 2 + r;
#pragma unroll
            for (int j = 0; j < 4; ++j) { const u32x2 a = *(const u32x2*)(X1 + row * 1024 + 4 * lane + 256 * j); v[r][j] = (f32x4){bflo(a.x), bfhi(a.x), bflo(a.y), bfhi(a.y)} * DN_ALPHA;
#pragma unroll
                for (int k = 0; k < 4; ++k) {
                    if constexpr (Y_F8) { const int y8 = *(const int*)((const unsigned char*)Y + (row * 4 + k) * 1024 + 4 * lane + 256 * j); const f32x2 lo = __builtin_amdgcn_cvt_pk_f32_fp8(y8, false), hi = __builtin_amdgcn_cvt_pk_f32_fp8(y8, true);
                        v[r][j][0] += lo[0] * (1.0f / Y_SCALE); v[r][j][1] += lo[1] * (1.0f / Y_SCALE); v[r][j][2] += hi[0] * (1.0f / Y_SCALE); v[r][j][3] += hi[1] * (1.0f / Y_SCALE); }
                    else { const u32x2 y = *(const u32x2*)(Y + (row * 4 + k) * 1024 + 4 * lane + 256 * j); v[r][j][0] += bflo(y.x); v[r][j][1] += bfhi(y.x); v[r][j][2] += bflo(y.y); v[r][j][3] += bfhi(y.y); } }
                s[r] += (v[r][j][0] + v[r][j][1]) + (v[r][j][2] + v[r][j][3]); } }
        const float mean0 = wave_sum(s[0], lane) * (1.0f / 1024.0f), mean1 = wave_sum(s[1], lane) * (1.0f / 1024.0f); float q[2] = {0.f, 0.f};
#pragma unroll
        for (int r = 0; r < 2; ++r)
#pragma unroll
            for (int j = 0; j < 4; ++j) { v[r][j] = v[r][j] - (r == 0 ? mean0 : mean1); q[r] += (v[r][j][0] * v[r][j][0] + v[r][j][1] * v[r][j][1]) + (v[r][j][2] * v[r][j][2] + v[r][j][3] * v[r][j][3]); }
        const float rstd0 = rsqrtf(wave_sum(q[0], lane) * (1.0f / 1024.0f) + LN_EPS), rstd1 = rsqrtf(wave_sum(q[1], lane) * (1.0f / 1024.0f) + LN_EPS);
#pragma unroll
        for (int j = 0; j < 4; ++j) { const f32x4 gvj = *(const f32x4*)(g + 4 * lane + 256 * j), bvj = *(const f32x4*)(bta + 4 * lane + 256 * j);
#pragma unroll
            for (int r = 0; r < 2; ++r) { const size_t row = (size_t)rp * 2 + r; const f32x4 o = v[r][j] * (r == 0 ? rstd0 : rstd1) * gvj + bvj;
                if (OUT) *(f32x4*)(OUT + row * 1024 + 4 * lane + 256 * j) = o;
                else { u32x2 w; w.x = pk2(o[0], o[1]); w.y = pk2(o[2], o[3]); *(u32x2*)(XO + row * 1024 + 4 * lane + 256 * j) = w;
                    if constexpr (INP_F8) { int w8 = 0; w8 = __builtin_amdgcn_cvt_pk_fp8_f32(o[0], o[1], w8, false); w8 = __builtin_amdgcn_cvt_pk_fp8_f32(o[2], o[3], w8, true); *(int*)((unsigned char*)XB + row * 1024 + 4 * lane + 256 * j) = w8; }
                    else { *(u32x2*)(XB + row * 1024 + 4 * lane + 256 * j) = w; } } } }
    }
}

constexpr int PH_PER_LAYER = 10, N_PHASES = 2 + PH_PER_LAYER * DEPTH;
__host__ __device__ constexpr bool phase_active(int p) {
    if (p < 2) return true;
    const int l = (p - 2) / PH_PER_LAYER, k = (p - 2) % PH_PER_LAYER, kind = l % 3;
    if (k == 1) return kind != 0;
    if (k == 3 || k == 4) return kind == 2;
    return true;
}

__global__ void __launch_bounds__(512, 2) fwd(Args args) {
    extern __shared__ __attribute__((aligned(16))) unsigned char lds_raw[];
    const int wave0 = __builtin_amdgcn_readfirstlane((int)threadIdx.x >> 6);
    Ctx cx; cx.lds = (LAS unsigned char*)lds_raw; cx.G = gridDim.x; { const int bx = blockIdx.x; cx.vcu = (cx.G % 8 == 0) ? (bx % 8) * (cx.G / 8) + bx / 8 : bx; } cx.ws = args.ws;
    volatile LAS unsigned* MISC = (volatile LAS unsigned*)(cx.lds + MISC_OFF);
    for (int u = threadIdx.x; u < (LDS_BYTES - MISC_OFF) / 4; u += 512) MISC[u] = 0u;
    __syncthreads();
    if (threadIdx.x == 0) { LAS unsigned long long* t = (LAS unsigned long long*)(cx.lds + PTAB_OFF);
#pragma unroll
        for (int k = 0; k < 32; ++k) t[k] = (unsigned long long)args.in[k];
        t[32] = (unsigned long long)args.out; t[33] = (unsigned long long)args.ws; }
    __syncthreads();
    const int lo = args.ph_lo, hi = args.ph_hi;
    XcdBarrier bar; bar.bar = (unsigned*)((gu32*)(args.ws + WS_CTL) + CW_BAR); bar.x = 0; bar.st = nullptr;
    if (hi - lo > 1) bar = xcd_barrier_post((unsigned*)((gu32*)(args.ws + WS_CTL) + CW_BAR), MISC + 8);
    int ran = 0;
#define XB ((bf16_t*)(ws + WS_XB))
#define PROJ ((bf16_t*)(ws + WS_PROJ))
#define CAT ((bf16_t*)(ws + WS_CAT))
#define KVM ((bf16_t*)(ws + WS_KVM))
#define HB ((bf16_t*)(ws + WS_H))
#define YB ((bf16_t*)(ws + WS_Y))
#define QKR ((bf16_t*)(ws + WS_QKR))
#define EXPID ((int*)(ws + WS_EXPID))
#define GATE ((float*)(ws + WS_GATE))
#define IDX ((int*)(ws + WS_IDX))
#define XF ((float*)(GAS float*)ptab_get(cx, 32))
#define SB ((bf16_t*)(ws + WS_SB))
#define SB2 ((bf16_t*)(ws + WS_PROJ))
#define TP_BAR_BEGIN() do {} while (0)
#define TP_BAR_END() do {} while (0)
#define TP_PH_BEGIN(p) do {} while (0)
#define TP_PH_END(p) do {} while (0)
#define PH_BEGIN(p) if (lo <= (p) && (p) < hi) { const int ph_ = (p); if (ran) { TP_BAR_BEGIN(); for (int rb_ = 0; rb_ < REP_BAR; ++rb_) xcd_barrier(bar, wave0); TP_BAR_END(); } ran = 1; const int tid = opaque_tid(wave0); (void)tid; unsigned char* const ws = (unsigned char*)(GAS unsigned char*)ptab_get(cx, 33); cx.ws = ws; TP_PH_BEGIN(ph_);
#define PH_END TP_PH_END(ph_); }

#if EN_P0
    PH_BEGIN(0) for (int rep_ = 0; rep_ < REP_P0; ++rep_) { p0_prologue(cx, tid); } PH_END
#endif

    for (int l = -1; l < DEPTH; ++l) {
        const int kind = (l < 0) ? 0 : l % 3, jj = (l < 0) ? 0 : l / 3, pw = (l < 0) ? 2048 : ((l % 3) == 1 ? 1536 : 2560), base = 2 + PH_PER_LAYER * l;
        PH_BEGIN(l < 0 ? 1 : base) {
            pg8::DenseOrder S;
            if (l < 0) S.init(ws + WS_MEMB, ws + WS_WKV, NMEM, 2048, 1024 * INP_EB, cx.G, cx.vcu);
            else S.init(XB, ws + WS_WIN + (size_t)l * 5 * MiB, NTOK, pw, 1024 * INP_EB, cx.G, cx.vcu);
            S.rep = REP_DENSE;
            const unsigned smask = (l < 0) ? 0u : (kind == 0 ? 0x207u : kind == 1 ? 0x20u : 0x200u);
            pg8::EpiBf16s E{l < 0 ? KVM : PROJ, pw, smask, C2, INP_F8 ? 1.0f / WIN_SCALE : 1.0f};
#if EN_G1
            pg8::gemm_phase<pg8::EpiBf16s, pg8::DenseOrder, false, INP_F8 != 0>(cx.lds, S, E, tid);
#endif
        } PH_END
        if (l < 0) continue;
#if EN_THIN
        if (kind == 1) { PH_BEGIN(base + 1) for (int rep_ = 0; rep_ < REP_THIN; ++rep_) { rope_phase(cx, PROJ, INP(5) + jj * 64, INP(6) + jj * 64, QKR, tid); } PH_END }
        if (kind == 2) { PH_BEGIN(base + 1) for (int rep_ = 0; rep_ < REP_THIN; ++rep_) { sconv_phase(cx, PROJ, INP(8) + (size_t)jj * 3 * 2304, INP(9) + (size_t)jj * 2304, (bf16_t*)(ws + WS_UT3), ws + WS_V8, tid); } PH_END }
#endif
        for (int o = 0; o < 2; ++o) {
            if (o == 1 && kind != 2) break;
            PH_BEGIN(base + 2 + o) {
                if (kind == 2) {
                    const bf16_t* UT3 = (const bf16_t*)(ws + WS_UT3); constexpr size_t PS = (size_t)16 * 768 * 4096;
#if EN_TCONV
                    for (int rep_ = 0; rep_ < REP_TCONV; ++rep_) {
#if TCONV_F8
                    tconv8_phase(cx, o, o == 0 ? UT3 : (const bf16_t*)(ws + WS_Z1T), ws + WS_V8 + (size_t)o * 48 * MiB, UT3 + (size_t)(1 + o) * PS, (bf16_t*)(ws + (o == 0 ? WS_Z1T : WS_Z2T)), o == 0 ? ws + WS_V8 + 48 * MiB : (unsigned char*)nullptr, INP(19) + (size_t)(jj * 2 + o) * 768, tid);
#else
                    tconv_phase(cx, o, o == 0 ? UT3 : (const bf16_t*)(ws + WS_Z1T), UT3 + (size_t)(1 + o) * PS, (bf16_t*)(ws + (o == 0 ? WS_Z1T : WS_Z2T)), INP(19) + (size_t)(jj * 2 + o) * 768, tid);
#endif
                    }
#endif
                }
                if (o == 0) {
#if EN_NA
                    for (int rep_ = 0; rep_ < REP_NA; ++rep_) { if (kind == 0) na_phase(cx, PROJ, INP(3) + (size_t)jj * 12 * 465, CAT, tid); }
#endif
                    const int ngqa = (kind == 1) ? 3072 : 0;
                    for (int rep_ = 0; rep_ < REP_ATTN; ++rep_)
                    for (int u = cx.vcu; u < ngqa + 1024; u += cx.G) {
                        const attn_body::bf16 *Q, *K, *V; attn_body::bf16* O; int QP, KP, VP, NT;
                        if (u < ngqa) { const int qb = u & 15, hq = (u >> 4) % 12, b = u / 192, kvh = hq / 3;
                            Q = (const attn_body::bf16*)QKR + ((size_t)b * 4096 + qb * 256) * 1024 + hq * 64; QP = 1024;
                            K = (const attn_body::bf16*)QKR + (size_t)b * 4096 * 1024 + 768 + kvh * 64; KP = 1024;
                            V = (const attn_body::bf16*)PROJ + (size_t)b * 4096 * 1536 + 1024 + kvh * 64; VP = 1536;
                            O = (attn_body::bf16*)((unsigned char*)CAT + (((size_t)b * 4096 + qb * 256) * 1024 + hq * 64) * OUT_EB); NT = 64;
                        } else { const int v = u - ngqa, qb = v & 15, h = (v >> 4) & 3, b = v >> 6;
                            Q = (const attn_body::bf16*)PROJ + ((size_t)b * 4096 + qb * 256) * pw + (pw - 256) + h * 64; QP = pw;
                            K = (const attn_body::bf16*)KVM + (size_t)b * 256 * 2048 + 512 * l + h * 64; KP = 2048;
                            V = K + 256; VP = 2048;
                            O = (attn_body::bf16*)((unsigned char*)CAT + (((size_t)b * 4096 + qb * 256) * 1024 + 768 + h * 64) * OUT_EB); NT = 4;
                        }
#if EN_ATTN
                        attn_body::attn_unit<8, OUTP_F8 != 0>(Q, K, V, O, QP, KP, VP, 1024, NT, (char*)lds_raw, tid);
#endif
                    }
                }
            } PH_END
        }
#if EN_THIN
        if (kind == 2) { PH_BEGIN(base + 4) for (int rep_ = 0; rep_ < REP_THIN; ++rep_) { tback_phase(cx, (const bf16_t*)(ws + WS_Z2T), CAT, tid); } PH_END }
#endif
        PH_BEGIN(base + 5) {
            pg8::DenseOrder S; S.init(CAT, ws + WS_WOUT + (size_t)l * 2 * MiB, NTOK, 1024, 1024 * OUT_EB, cx.G, cx.vcu);
            pg8::EpiResB E{SB, l == 0 ? (const void*)INP(0) : (const void*)SB, l == 0 ? 1 : 0, 1024, DN_ALPHA, OUTP_F8 ? 1.0f / WOUT_SCALE : 1.0f};
#if EN_G2
            pg8::gemm_phase<pg8::EpiResB, pg8::DenseOrder, false, OUTP_F8 != 0>(cx.lds, S, E, tid);
#endif
        } PH_END
#if EN_LN
#if REP_LN1 > 1
        PH_BEGIN(base + 6) ln1_router_phase(cx, SB, (bf16_t*)(ws + WS_PROJ), CAT, INP(22) + l * 1024, INP(23) + l * 1024, INP(26) + (size_t)l * 1024 * 32, INP(27) + l * 32, (unsigned*)((gu32*)(ws + WS_CTL) + CW_DBG), EXPID, GATE, IDX, (float*)(ws + WS_GIDX), tid); PH_END
#endif
        PH_BEGIN(base + 6) ln1_router_phase(cx, SB, SB2, XB, INP(22) + l * 1024, INP(23) + l * 1024, INP(26) + (size_t)l * 1024 * 32, INP(27) + l * 32, (unsigned*)((gu32*)(ws + WS_CTL) + CW_CNT + 32 * l), EXPID, GATE, IDX, (float*)(ws + WS_GIDX), tid); PH_END
#endif
        for (int half = 0; half < 2; ++half) {
            PH_BEGIN(base + 7 + half) {
                LAS int* pref = (LAS int*)(cx.lds + pg8::STAGE_BYTES); const unsigned* cntw = (const unsigned*)((gu32*)(ws + WS_CTL) + CW_CNT + 32 * l);
                __syncthreads();
                if (tid == 0) { int a = 0;
#pragma unroll 1
                    for (int e = 0; e < NEXP; ++e) { const int c = (int)__hip_atomic_load(cntw + e, __ATOMIC_RELAXED, __HIP_MEMORY_SCOPE_AGENT); pref[e] = a; pref[40 + e] = c; a += (c + 255) >> 8; } pref[NEXP] = a; }
                __syncthreads();
#if STAGGER
                if (cx.vcu & 1) { for (int s_ = 0; s_ < STAGGER; ++s_) __builtin_amdgcn_s_sleep(127); }
#endif
                if (half == 0) {
                    pg8::MoeOrder<2> S{(const char*)XB, (const char*)(ws + WS_W1 + (size_t)l * 32 * 2048 * 1024 * MOE_EB), 1024 * MOE_EB, 8, cx.G, cx.vcu, (size_t)2048 * 1024 * MOE_EB, pref, (const int*)cntw, IDX};
                    pg8::EpiSwiglu E{HB, INP(29) + (size_t)l * 32 * 2048};
#if EN_G3
                    for (int rep_ = 0; rep_ < REP_G3; ++rep_) { pg8::gemm_phase<pg8::EpiSwiglu, pg8::MoeOrder<2>, true, MOE_F8 != 0, (MOE_F8 != 0) && (DEFER_H != 0)>(cx.lds, S, E, tid); }
#endif
                } else {
                    pg8::MoeOrder<0> S{(const char*)HB, (const char*)(ws + WS_W2 + (size_t)l * 32 * 1024 * 1024 * MOE_EB), 1024 * MOE_EB, 4, cx.G, cx.vcu, (size_t)1024 * 1024 * MOE_EB, pref, (const int*)cntw, IDX};
                    pg8::EpiMoeOut E{YB, INP(31) + (size_t)l * 32 * 1024, (const float*)(ws + WS_GIDX)};
#if EN_G4
                    for (int rep_ = 0; rep_ < REP_G4; ++rep_) { pg8::gemm_phase<pg8::EpiMoeOut, pg8::MoeOrder<0>, true, MOE_F8 != 0>(cx.lds, S, E, tid); }
#endif
                }
            } PH_END
        }
#if EN_LN
#if REP_LN2 > 1
        PH_BEGIN(base + 9) ln2_phase(cx, SB, YB, (bf16_t*)(ws + WS_PROJ), CAT, (float*)nullptr, INP(24) + l * 1024, INP(25) + l * 1024, tid); PH_END
#endif
        PH_BEGIN(base + 9) ln2_phase(cx, SB2, YB, SB, XB, l == DEPTH - 1 ? XF : (float*)nullptr, INP(24) + l * 1024, INP(25) + l * 1024, tid); PH_END

#endif
    }
#undef PH_BEGIN
#undef PH_END
#undef XB
#undef PROJ
#undef CAT
#undef KVM
#undef HB
#undef YB
#undef QKR
#undef EXPID
#undef GATE
#undef IDX
#undef XF
#undef SB
#undef SB2
}

extern "C" void kernel_launch(void* const* d_in, const int* in_sizes, int n_in, void* d_out, int out_size, void* d_ws, size_t ws_size, hipStream_t stream) {
    static int grid = 0;
    if (grid == 0) {
        if (n_in != 32 || in_sizes[0] != NTOK * DM || out_size != NTOK * DM || ws_size < WS_END) { fprintf(stderr, "kernel_launch: unexpected problem (n_in %d, in0 %d, out %d, ws %zu < %zu); nothing launched\n", n_in, n_in > 0 ? in_sizes[0] : -1, out_size, ws_size, (size_t)WS_END); grid = -1; return; }
        int dev = 0, cus = 0, per_cu = 0;
        if (hipGetDevice(&dev) != hipSuccess || hipDeviceGetAttribute(&cus, hipDeviceAttributeMultiprocessorCount, dev) != hipSuccess) { fprintf(stderr, "kernel_launch: device query failed\n"); grid = -1; return; }
        if (hipFuncSetAttribute((const void*)fwd, hipFuncAttributeMaxDynamicSharedMemorySize, LDS_BYTES) != hipSuccess) { fprintf(stderr, "kernel_launch: hipFuncSetAttribute failed\n"); grid = -1; return; }
        if (hipOccupancyMaxActiveBlocksPerMultiprocessor(&per_cu, (const void*)fwd, 512, LDS_BYTES) != hipSuccess || per_cu < 1) fprintf(stderr, "kernel_launch: occupancy query reports %d blocks per CU\n", per_cu);
        (void)hipGetLastError();
        grid = cus;
    }
    if (grid < 0) return;
    if (hipMemsetAsync((char*)d_ws + WS_CTL, 0, CTL_ZERO_BYTES, stream) != hipSuccess) { fprintf(stderr, "kernel_launch: memset failed\n"); return; }
    Args a{};
    for (int i = 0; i < 32; ++i) a.in[i] = (const float*)d_in[i];
    a.out = (float*)d_out; a.ws = (unsigned char*)d_ws;
#if MK_MULTI
    for (int p = 0; p < N_PHASES && p <= DBG_LAST_PHASE; ++p) {
        if (!phase_active(p)) continue;
        a.ph_lo = p; a.ph_hi = p + 1;
        hipLaunchKernelGGL(fwd, dim3(grid), dim3(512), LDS_BYTES, stream, a);
#if DBG_CHECK
        dbg_after_phase(p, a, stream);
#endif
    }
#if DBG_CHECK
    hipLaunchKernelGGL(dbg_report, dim3(1024), dim3(256), 0, stream, (unsigned*)((char*)d_ws + WS_CTL) + CW_DBG, (float*)d_out);
#endif
#else
    a.ph_lo = 0; a.ph_hi = N_PHASES;
    hipLaunchKernelGGL(fwd, dim3(grid), dim3(512), LDS_BYTES, stream, a);
#endif
    const hipError_t le = hipPeekAtLastError();
    if (le != hipSuccess) fprintf(stderr, "kernel_launch: launch failed: %s\n", hipGetErrorName(le));
}
```

```cpp
#define Y_F8 1
#include <hip/hip_runtime.h>
#include <hip/hip_bf16.h>
#include <cstdio>
#include <cstdint>

#ifndef MK_MULTI
#define MK_MULTI 0
#endif
#ifndef DBG_CHECK
#define DBG_CHECK 0
#endif
#ifndef DBG_LAST_PHASE
#define DBG_LAST_PHASE 9999
#endif

#ifndef EN_P0
#define EN_P0 1
#define EN_G1 1
#define EN_THIN 1
#define EN_TCONV 1
#define EN_NA 1
#define EN_ATTN 1
#define EN_G2 1
#define EN_LN 1
#define EN_G3 1
#define EN_G4 1
#endif

#ifndef REP_P0
#define REP_P0 1
#endif
#ifndef REP_G1
#define REP_G1 1
#endif
#ifndef REP_NA
#define REP_NA 1
#endif
#ifndef REP_ATTN
#define REP_ATTN 1
#endif
#ifndef REP_TCONV
#define REP_TCONV 1
#endif
#ifndef REP_THIN
#define REP_THIN 1
#endif
#ifndef REP_G3
#define REP_G3 1
#endif
#ifndef REP_G4
#define REP_G4 1
#endif
#ifndef ALIGN_EPI
#define ALIGN_EPI 1
#endif
#ifndef NT_STORE
#define NT_STORE 0
#endif
#ifndef LN1_HOLD
#define LN1_HOLD 16
#endif
#ifndef DEFER_H
#define DEFER_H 0
#endif
#ifndef STAGGER
#define STAGGER 0
#endif
#ifndef REP_BAR
#define REP_BAR 1
#endif
#ifndef REP_DENSE
#define REP_DENSE 1
#endif
#ifndef REP_G2
#define REP_G2 1
#endif
#ifndef REP_LN1
#define REP_LN1 1
#endif
#ifndef REP_LN2
#define REP_LN2 1
#endif

#define GAS __attribute__((address_space(1)))
#define LAS __attribute__((address_space(3)))
typedef unsigned short bf16_t;
typedef short bf16x8 __attribute__((ext_vector_type(8)));
typedef short s16x4 __attribute__((ext_vector_type(4)));
typedef float f32x4 __attribute__((ext_vector_type(4)));
typedef float f32x2 __attribute__((ext_vector_type(2)));
typedef float f32x16 __attribute__((ext_vector_type(16)));
typedef unsigned u32x4 __attribute__((ext_vector_type(4)));
typedef unsigned u32x2 __attribute__((ext_vector_type(2)));
typedef GAS unsigned gu32;

constexpr int BATCH = 16, SEQ = 4096, DM = 1024, NTOK = BATCH * SEQ, DEPTH = 4;
constexpr int MEMLEN = 256, NMEM = BATCH * MEMLEN;
constexpr int NEXP = 32, NSLOT = NTOK * 4, IDXCAP = NTOK;
constexpr int GRIDW = 64;
constexpr float LN_EPS = 1e-5f;
constexpr float DN_ALPHA = 1.681792830507429f;
constexpr float LOG2E = 1.4426950408889634f;
constexpr float C2 = 0.125f * LOG2E;
__host__ __device__ constexpr int layer_kind(int l) { return l % 3; }
__host__ __device__ constexpr int layer_j(int l) { return l / 3; }
__host__ __device__ constexpr int in_width(int l) { return (l % 3) == 1 ? 1536 : 2560; }

#ifndef MOE_F8
#define MOE_F8 1
#endif
#ifndef INP_F8
#define INP_F8 1
#endif
constexpr int INP_EB = INP_F8 ? 1 : 2;
constexpr float WIN_SCALE = 32.0f;
#ifndef OUTP_F8
#define OUTP_F8 1
#endif
constexpr int OUT_EB = OUTP_F8 ? 1 : 2;
constexpr float WOUT_SCALE = 64.0f;
__device__ __forceinline__ unsigned char f2fp8(float x) { return (unsigned char)(__builtin_amdgcn_cvt_pk_fp8_f32(x, x, 0, false) & 0xff); }
#ifndef TCONV_F8
#define TCONV_F8 1
#endif
#ifndef Y_F8
#define Y_F8 0
#endif
constexpr float Y_SCALE = 64.0f;
constexpr int MOE_EB = MOE_F8 ? 1 : 2;
constexpr float W1_SCALE = 32.0f, W2_SCALE = 64.0f, H_SCALE = 4.0f;

constexpr size_t MiB = 1u << 20;
constexpr size_t WS_CTL = 0, CTL_ZERO_BYTES = 1 * MiB;
constexpr size_t WS_WIN = 2 * MiB;
constexpr size_t WS_WKV = 22 * MiB;
constexpr size_t WS_WOUT = 26 * MiB;
constexpr size_t WS_W1 = 34 * MiB;
constexpr size_t WS_W2 = 546 * MiB;
constexpr size_t WS_XB = 802 * MiB;
constexpr size_t WS_MEMB = 930 * MiB;
constexpr size_t WS_KVM = 938 * MiB;
constexpr size_t WS_PROJ = 954 * MiB;
constexpr size_t WS_CAT = 1274 * MiB;
constexpr size_t WS_H = 1402 * MiB;
constexpr size_t WS_Y = 1914 * MiB;
constexpr size_t WS_HRAWT = 2426 * MiB;
constexpr size_t WS_HPART = 2474 * MiB;
constexpr size_t WS_EXPID = 2478 * MiB;
constexpr size_t WS_GATE = 2479 * MiB;
constexpr size_t WS_IDX = 2480 * MiB;
constexpr size_t WS_SB = 2488 * MiB;
constexpr size_t WS_GIDX = 2616 * MiB;
constexpr size_t WS_END = 2624 * MiB;
constexpr size_t WS_UT3 = WS_H;
constexpr size_t WS_Z1T = WS_H + 288 * MiB;
constexpr size_t WS_Z2T = WS_H + 384 * MiB;
constexpr size_t WS_V8 = WS_Y;
constexpr size_t WS_QKR = WS_Y;
constexpr int CW_BAR = 4096;
constexpr int CW_CNT = 8192;
constexpr int CW_DBG = 12288;

constexpr int MISC_OFF = 150528;
constexpr int LDS_BYTES = 151552;

#define LDS_WAIT() asm volatile("s_waitcnt lgkmcnt(0)" ::: "memory")
#define VM_WAIT() asm volatile("s_waitcnt vmcnt(0)" ::: "memory")
__device__ __forceinline__ unsigned f2bf(float f) { unsigned u = __builtin_bit_cast(unsigned, f); return (u + 0x7fffu + ((u >> 16) & 1u)) >> 16; }
__device__ __forceinline__ unsigned pk2(float lo, float hi) { return f2bf(lo) | (f2bf(hi) << 16); }
__device__ __forceinline__ float bf2f(unsigned short b) { return __builtin_bit_cast(float, ((unsigned)b) << 16); }
__device__ __forceinline__ float bflo(unsigned w) { return __builtin_bit_cast(float, w << 16); }
__device__ __forceinline__ float bfhi(unsigned w) { return __builtin_bit_cast(float, w & 0xffff0000u); }
__device__ __forceinline__ float shflx(float v, int mask, int lane) { int t; asm volatile("v_mov_b32 %0, %1" : "=v"(t) : "v"(__builtin_bit_cast(int, v))); return __builtin_bit_cast(float, __builtin_amdgcn_ds_bpermute((lane ^ mask) << 2, t)); }
__device__ __forceinline__ int shflxi(int v, int mask, int lane) { return __builtin_amdgcn_ds_bpermute((lane ^ mask) << 2, v); }
template <int CTRL> __device__ __forceinline__ float dpp_x(float v) { return __builtin_bit_cast(float, __builtin_amdgcn_update_dpp(0, __builtin_bit_cast(int, v), CTRL, 0xF, 0xF, false)); }
__device__ __forceinline__ float group8_sum(float v) { v += dpp_x<0xB1>(v); v += dpp_x<0x4E>(v); v += dpp_x<0x141>(v); return v; }
__device__ __forceinline__ float wave_sum(float v, int  ) {
    v += dpp_x<0xB1>(v); v += dpp_x<0x4E>(v); v += dpp_x<0x141>(v); v += dpp_x<0x140>(v);
    v += __builtin_bit_cast(float, __builtin_amdgcn_update_dpp(0, __builtin_bit_cast(int, v), 0x142, 0xA, 0xF, false));
    v += __builtin_bit_cast(float, __builtin_amdgcn_update_dpp(0, __builtin_bit_cast(int, v), 0x143, 0xC, 0xF, false));
    return __builtin_bit_cast(float, __builtin_amdgcn_readlane(__builtin_bit_cast(int, v), 63));
}
__device__ __forceinline__ int lane_id_volatile() { int l; asm volatile("v_mbcnt_lo_u32_b32 %0, -1, 0\n\tv_mbcnt_hi_u32_b32 %0, -1, %0" : "=&v"(l)); return l; }
__device__ __forceinline__ int opaque_tid(int wave0) { return wave0 * 64 + lane_id_volatile(); }

#define XB_TMO      128
#define XB_XCNT(j)  (256  + 64 * (j))
#define XB_XSUB(j)  (1280 + 64 * (j))
#define XB_XGEN(j)  (2304 + 64 * (j))
#define XB_TOP      3328
#define XB_TOPGEN   3392
#define XCD_BAR_WORDS 3456
#define XB_SPIN_CAP (1u << 20)

__device__ __forceinline__ unsigned xb_ld(unsigned* p)              { return __hip_atomic_load(p, __ATOMIC_RELAXED, __HIP_MEMORY_SCOPE_AGENT); }
__device__ __forceinline__ unsigned xb_add(unsigned* p, unsigned v) { return __hip_atomic_fetch_add(p, v, __ATOMIC_RELAXED, __HIP_MEMORY_SCOPE_AGENT); }
__device__ __forceinline__ unsigned xb_xcc_id() { return (unsigned)__builtin_amdgcn_s_getreg((3 << 11) | 20) & 0xFu; }
#define XB_SPIN(cond, bar) do { unsigned _sp = 0; while (cond) { __builtin_amdgcn_s_sleep(1); \
    if ((++_sp & 255u) == 0u) { if (xb_ld(&(bar)[XB_TMO])) break; if (_sp > XB_SPIN_CAP) { atomicAdd(&(bar)[XB_TMO], 1u); break; } } } } while (0)

struct XcdBarrier {
    unsigned* bar; unsigned x;
    volatile LAS unsigned* st;
};
__device__ __forceinline__ XcdBarrier xcd_barrier_post(unsigned* bar, volatile LAS unsigned* st) {
    XcdBarrier b; b.bar = bar; b.x = xb_xcc_id(); b.st = st;
    if (threadIdx.x == 0) (void)xb_add(&bar[XB_XCNT(b.x)], 1u);
    return b;
}
__device__ __forceinline__ void xcd_barrier_complete(unsigned* bar, unsigned x, unsigned& nloc, unsigned& nx) {
    const unsigned G = gridDim.x * gridDim.y * gridDim.z;
    unsigned sum, cnt, mine, sp = 0u;
    for (;;) {
        sum = 0u; cnt = 0u; mine = 0u;
#pragma unroll 1
        for (unsigned j = 0; j < 16; ++j) { const unsigned c = xb_ld(&bar[XB_XCNT(j)]); sum += c; cnt += (c > 0u) ? 1u : 0u; mine = (j == x) ? c : mine; }
        if (sum == G) break;
        __builtin_amdgcn_s_sleep(1);
        if ((++sp & 255u) == 0u) { if (xb_ld(&bar[XB_TMO])) break; if (sp > XB_SPIN_CAP) { atomicAdd(&bar[XB_TMO], 1u); break; } }
    }
    nloc = mine > 0u ? mine : 1u; nx = cnt > 0u ? cnt : 1u;
}
__device__ __forceinline__ void xcd_barrier(const XcdBarrier& b, const int wave0) {
    asm volatile("s_waitcnt vmcnt(0)" ::: "memory");
    __syncthreads();
    if (wave0 == 0 && lane_id_volatile() == 0) {
        unsigned* bar = b.bar;
        __builtin_amdgcn_s_waitcnt(0);
        unsigned nloc = b.st[0], nx = b.st[1];
        if (nloc == 0u) { xcd_barrier_complete(bar, b.x, nloc, nx); b.st[0] = nloc; b.st[1] = nx; }
        const unsigned old = xb_add(&bar[XB_XSUB(b.x)], 1u);
        const unsigned gen = old / nloc;
        if (old + 1u == (gen + 1u) * nloc) {
            __builtin_amdgcn_fence(__ATOMIC_RELEASE, "agent");
            asm volatile("s_waitcnt vmcnt(0)" ::: "memory");
            const unsigned og = xb_add(&bar[XB_TOP], 1u);
            const unsigned tg = og / nx;
            if (og + 1u == (tg + 1u) * nx) xb_add(&bar[XB_TOPGEN], 1u);
            else XB_SPIN(xb_ld(&bar[XB_TOPGEN]) == tg, bar);
            __builtin_amdgcn_fence(__ATOMIC_ACQUIRE, "agent");
            xb_add(&bar[XB_XGEN(b.x)], 1u);
            asm volatile("s_waitcnt vmcnt(0)" ::: "memory");
        } else {
            XB_SPIN(xb_ld(&bar[XB_XGEN(b.x)]) == gen, bar);
            __builtin_amdgcn_fence(__ATOMIC_ACQUIRE, "agent");
            asm volatile("s_waitcnt vmcnt(0)" ::: "memory");
        }
    }
    __syncthreads();
}

namespace pg8 {
constexpr int BM = 256, BK = 64, HALF = 128, HTB = HALF * BK * 2  , STAGE_BYTES = 8 * HTB, NXCD = 8, WGM = 8;
__host__ __device__ __forceinline__ int lds_byte(int r, int c) { const int st = (r >> 4) * 2 + (c >> 5), rr = r & 15, cc = c & 31, ob = rr * 64 + cc * 2; return st * 1024 + (ob ^ (((ob >> 9) & 1) << 5)); }
__host__ __device__ __forceinline__ void stage_rc(int b, int& R, int& C) { const int st = b / 1024, sb = b % 1024, swz = sb ^ (((sb >> 9) & 1) << 5); R = (st >> 1) * 16 + swz / 64; C = (st & 1) * 32 + (swz % 64) / 2; }
__host__ __device__ __forceinline__ int perm32(int rho) { const int n = rho >> 4, i = rho & 15; return 8 * (i >> 2) + 4 * n + (i & 3); }

struct Unit { int pm, pn, e, p; };

struct DenseOrder {
    const char* A; const char* Bt; int KB; int nM, nN, nwg, G, c; int rep = 1;
    __device__ __forceinline__ void init(const void* A_, const void* Bt_, int M, int N, int KB_, int G_, int c_) { A = (const char*)A_; Bt = (const char*)Bt_; KB = KB_; nM = M / BM; nN = N / BM; nwg = nM * nN; G = G_; c = c_; }
    __device__ __forceinline__ bool next(int i, Unit& u) const {
        long L = (long)i * G + c; if (L >= (long)nwg * rep) return false;
        if (rep > 1) L %= nwg;
        int wgid = (int)L; { const int q = nwg / NXCD, r = nwg % NXCD, xcd = wgid % NXCD, off = wgid / NXCD; wgid = (xcd < r ? xcd * (q + 1) : r * (q + 1) + (xcd - r) * q) + off; }
        const int nig = WGM * nN, gid = wgid / nig, fm = gid * WGM, gsz = (nM - fm) < WGM ? (nM - fm) : WGM;
        u.pm = __builtin_amdgcn_readfirstlane(fm + ((wgid % nig) % gsz)); u.pn = __builtin_amdgcn_readfirstlane((wgid % nig) / gsz); u.e = 0; u.p = 0; return true;
    }
    __device__ __forceinline__ const char* a_base(const Unit& u) const { return A + (size_t)u.pm * BM * KB; }
    __device__ __forceinline__ const char* b_base(const Unit& u) const { return Bt + (size_t)u.pn * BM * KB; }
    __device__ __forceinline__ const int* idx_src(const Unit&) const { return nullptr; }
    __device__ __forceinline__ int nvalid(const Unit&) const { return BM; }
    static constexpr int ROW_SHIFT = 0;
};
template <int SHIFT  > struct MoeOrder {
    const char* A; const char* Bt; int KB; int nN; int G, c; size_t bstride; const LAS int* pref; const int* cnt; const int* idx;
    __device__ __forceinline__ bool next(int i, Unit& u) const {
        const long L = (long)i * G + c; const int tot = __builtin_amdgcn_readfirstlane(pref[NEXP]);
        if (L >= (long)tot * nN) return false;
        const int pg = __builtin_amdgcn_readfirstlane((int)(L / nN)); u.pn = __builtin_amdgcn_readfirstlane((int)(L % nN));
        int e = 0;
#pragma unroll
        for (int step = 16; step >= 1; step >>= 1) { const int v = __builtin_amdgcn_readfirstlane(pref[e + step]); e += (v <= pg) ? step : 0; }
        u.e = e; u.p = pg - __builtin_amdgcn_readfirstlane(pref[e]); u.pm = 0; return true;
    }
    __device__ __forceinline__ const char* a_base(const Unit&) const { return A; }
    __device__ __forceinline__ const char* b_base(const Unit& u) const { return Bt + (size_t)u.e * bstride + (size_t)u.pn * BM * KB; }
    __device__ __forceinline__ const int* idx_src(const Unit& u) const { return idx + (size_t)u.e * IDXCAP + u.p * BM; }
    __device__ __forceinline__ int nvalid(const Unit& u) const { const int n = __builtin_amdgcn_readfirstlane(pref[40 + u.e]) - u.p * BM; return n < BM ? n : BM; }
    static constexpr int ROW_SHIFT = SHIFT;
};

__device__ __forceinline__ unsigned cvt_pk_bf16(float lo, float hi) { unsigned r; asm volatile("v_cvt_pk_bf16_f32 %0, %1, %2" : "=v"(r) : "v"(lo), "v"(hi)); return r; }

struct EpiBf16s {
    static constexpr bool PERM = true; static constexpr bool HAS_BIAS = false;
    bf16_t* O; int ldc; unsigned smask; float scale; float base;
    __device__ __forceinline__ void operator()(const f32x4 (&acc)[2][2][4][2], const Unit& u, int wr, int wc, int fr, int fq) const {
        const int row0 = u.pm * BM + wr * 64 + fr, col0 = u.pn * BM + wc * 32 + 8 * fq;
        const float sc = (((smask >> u.pn) & 1u) ? scale : 1.f) * base;
#pragma unroll
        for (int ai = 0; ai < 2; ++ai)
#pragma unroll
            for (int m = 0; m < 4; ++m) { bf16_t* rowp = O + (size_t)(row0 + ai * HALF + m * 16) * ldc + col0;
#pragma unroll
                for (int bj = 0; bj < 2; ++bj) { const f32x4 v0 = acc[ai][bj][m][0] * sc, v1 = acc[ai][bj][m][1] * sc;
                    u32x4 w; w.x = cvt_pk_bf16(v0[0], v0[1]); w.y = cvt_pk_bf16(v0[2], v0[3]); w.z = cvt_pk_bf16(v1[0], v1[1]); w.w = cvt_pk_bf16(v1[2], v1[3]);
                    if (NT_STORE) __builtin_nontemporal_store(w, (u32x4*)(rowp + bj * HALF)); else *(u32x4*)(rowp + bj * HALF) = w; }
                asm volatile("" ::: "memory"); }
    }
};
struct EpiResB {
    static constexpr bool PERM = true; static constexpr bool HAS_BIAS = false;
    bf16_t* C; const void* res; int res_f32; int ldc; float alpha; float ascale;
    __device__ __forceinline__ void operator()(const f32x4 (&acc)[2][2][4][2], const Unit& u, int wr, int wc, int fr, int fq) const {
        const int row0 = u.pm * BM + wr * 64 + fr, col0 = u.pn * BM + wc * 32 + 8 * fq;
#pragma unroll
        for (int ai = 0; ai < 2; ++ai)
#pragma unroll
            for (int m = 0; m < 4; ++m) { const size_t off = (size_t)(row0 + ai * HALF + m * 16) * ldc + col0;
#pragma unroll
                for (int bj = 0; bj < 2; ++bj) { f32x4 r0, r1;
                    if (res_f32) { const float* rp = (const float*)res + off + bj * HALF; r0 = *(const f32x4*)rp; r1 = *(const f32x4*)(rp + 4); }
                    else { const u32x4 raw = *(const u32x4*)((const bf16_t*)res + off + bj * HALF); r0 = (f32x4){bflo(raw.x), bfhi(raw.x), bflo(raw.y), bfhi(raw.y)}; r1 = (f32x4){bflo(raw.z), bfhi(raw.z), bflo(raw.w), bfhi(raw.w)}; }
                    const f32x4 v0 = r0 * alpha + acc[ai][bj][m][0] * ascale, v1 = r1 * alpha + acc[ai][bj][m][1] * ascale;
                    u32x4 w; w.x = cvt_pk_bf16(v0[0], v0[1]); w.y = cvt_pk_bf16(v0[2], v0[3]); w.z = cvt_pk_bf16(v1[0], v1[1]); w.w = cvt_pk_bf16(v1[2], v1[3]);
                    *(u32x4*)(C + off + bj * HALF) = w; }
                asm volatile("" ::: "memory"); }
    }
};
struct Pend { u32x2 val[8]; };
struct EpiSwiglu {
    static constexpr bool PERM = true; static constexpr bool HAS_GATE = false; static constexpr bool HAS_BIAS = true;
    __device__ __forceinline__ void load_bias(const Unit& u, int wc, int fq, f32x4 (&bp)[4]) const { const float* bg = b1 + (size_t)u.e * 2048 + u.pn * HALF + wc * 32 + 8 * fq; bp[0] = *(const f32x4*)bg; bp[1] = *(const f32x4*)(bg + 4); bp[2] = *(const f32x4*)(bg + 1024); bp[3] = *(const f32x4*)(bg + 1028); }
    bf16_t* H; const float* b1;
    __device__ __forceinline__ void prepare(const f32x4 (&acc)[2][2][4][2], const Unit& u, int wr, int wc, int fr, int fq, Pend& pd) const {
        constexpr float ASC = 1.0f / W1_SCALE;
        const int j0 = u.pn * HALF + wc * 32 + 8 * fq; const float* bg = b1 + (size_t)u.e * 2048 + j0; const float* bu = bg + 1024;
        const f32x4 bg0 = *(const f32x4*)bg, bg1 = *(const f32x4*)(bg + 4), bu0 = *(const f32x4*)bu, bu1 = *(const f32x4*)(bu + 4);
#pragma unroll
        for (int q8 = 0; q8 < 8; ++q8) { const int ai = q8 >> 2, m = q8 & 3;
            float o[8];
#pragma unroll
            for (int q = 0; q < 8; ++q) { const float gb = (q < 4 ? bg0[q & 3] : bg1[q & 3]), ub = (q < 4 ? bu0[q & 3] : bu1[q & 3]);
                float g = acc[ai][0][m][q >> 2][q & 3] * ASC + gb, uu = acc[ai][1][m][q >> 2][q & 3] * ASC + ub;
                g = fminf(g, 7.0f); uu = fminf(fmaxf(uu, -7.0f), 7.0f);
                const float sg = __builtin_amdgcn_rcpf(1.0f + __builtin_amdgcn_exp2f(-1.702f * LOG2E * g));
                o[q] = (uu + 1.0f) * (g * sg); }
            int w0 = 0, w1 = 0;
            w0 = __builtin_amdgcn_cvt_pk_fp8_f32(o[0] * H_SCALE, o[1] * H_SCALE, w0, false); w0 = __builtin_amdgcn_cvt_pk_fp8_f32(o[2] * H_SCALE, o[3] * H_SCALE, w0, true);
            w1 = __builtin_amdgcn_cvt_pk_fp8_f32(o[4] * H_SCALE, o[5] * H_SCALE, w1, false); w1 = __builtin_amdgcn_cvt_pk_fp8_f32(o[6] * H_SCALE, o[7] * H_SCALE, w1, true);
            pd.val[q8] = (u32x2){(unsigned)w0, (unsigned)w1}; }
    }
    __device__ __forceinline__ void store_one(const u32x2 v, const LAS int* ids, const int r, const int nv, const int j0) const { if (r < nv) { const int slot = ids[r]; *(u32x2*)((unsigned char*)H + (size_t)slot * 1024 + j0) = v; } }
    __device__ __forceinline__ void operator()(const f32x4 (&acc)[2][2][4][2], const Unit& u, int wr, int wc, int fr, int fq, const LAS int* ids, const int nv, const f32x4 (&bp)[4]) const {
        constexpr float ASC = MOE_F8 ? 1.0f / W1_SCALE : 1.0f;
        constexpr float HS = MOE_F8 ? H_SCALE : 1.0f, KK = -1.702f * LOG2E, GA = ASC * KK, UA = ASC * HS / KK, ULO = 8.0f * HS / KK, UHI = -6.0f * HS / KK, GLO = 7.0f * KK;
        const int j0 = u.pn * HALF + wc * 32 + 8 * fq;
        const f32x4 bg0 = bp[0] * KK, bg1 = bp[1] * KK; f32x4 bu0 = (bp[2] + 1.0f) * (HS / KK), bu1 = (bp[3] + 1.0f) * (HS / KK);
        asm volatile("" : "+v"(bu0), "+v"(bu1));
        int rb = wr * 64 + fr; asm volatile("" : "+v"(rb));
        const LAS int* idp = ids + rb; int slots[8];
#pragma unroll
        for (int q = 0; q < 8; ++q) slots[q] = idp[(q >> 2) * HALF + (q & 3) * 16];
#pragma unroll
        for (int ai = 0; ai < 2; ++ai)
#pragma unroll
            for (int m = 0; m < 4; ++m) { const int r = ai * HALF + m * 16 + rb;
                if (r < nv) { const int slot = slots[ai * 4 + m];
                    float o[8];
#pragma unroll
                    for (int q = 0; q < 8; ++q) { const float gb = (q < 4 ? bg0[q & 3] : bg1[q & 3]), ub = (q < 4 ? bu0[q & 3] : bu1[q & 3]);
                        const float gp = fmaxf(__builtin_fmaf(acc[ai][0][m][q >> 2][q & 3], GA, gb), GLO);
                        const float us = fminf(fmaxf(__builtin_fmaf(acc[ai][1][m][q >> 2][q & 3], UA, ub), ULO), UHI);
                        const float sg = __builtin_amdgcn_rcpf(1.0f + __builtin_amdgcn_exp2f(gp));
                        o[q] = us * (gp * sg); }
                    if constexpr (MOE_F8) { int w0 = 0, w1 = 0;
                        w0 = __builtin_amdgcn_cvt_pk_fp8_f32(o[0], o[1], w0, false); w0 = __builtin_amdgcn_cvt_pk_fp8_f32(o[2], o[3], w0, true);
                        w1 = __builtin_amdgcn_cvt_pk_fp8_f32(o[4], o[5], w1, false); w1 = __builtin_amdgcn_cvt_pk_fp8_f32(o[6], o[7], w1, true);
                        *(u32x2*)((unsigned char*)H + (size_t)slot * 1024 + j0) = (u32x2){(unsigned)w0, (unsigned)w1};
                    } else { u32x4 w; w.x = cvt_pk_bf16(o[0], o[1]); w.y = cvt_pk_bf16(o[2], o[3]); w.z = cvt_pk_bf16(o[4], o[5]); w.w = cvt_pk_bf16(o[6], o[7]);
                        *(u32x4*)(H + (size_t)slot * 1024 + j0) = w; } } }
    }
};
struct EpiMoeOut {
    static constexpr bool PERM = true; static constexpr bool HAS_GATE = true; static constexpr bool HAS_BIAS = true;
    __device__ __forceinline__ void load_bias(const Unit& u, int wc, int fq, f32x4 (&bp)[4]) const { const float* bb = b2 + (size_t)u.e * 1024 + u.pn * BM + wc * 32 + 8 * fq; bp[0] = *(const f32x4*)bb; bp[1] = *(const f32x4*)(bb + 4); bp[2] = *(const f32x4*)(bb + HALF); bp[3] = *(const f32x4*)(bb + HALF + 4); }
    bf16_t* Y; const float* b2;   const float* gidx;
    __device__ __forceinline__ void operator()(const f32x4 (&acc)[2][2][4][2], const Unit& u, int wr, int wc, int fr, int fq, const LAS int* ids, const int nv, const f32x4 (&bp)[4]) const {
        const LAS float* gts = (const LAS float*)(ids + 768);
        constexpr float OSC = MOE_F8 ? 1.0f / (H_SCALE * W2_SCALE) : 1.0f;
        const int c0 = u.pn * BM + wc * 32 + 8 * fq;
        f32x4 bv[2][2]; bv[0][0] = bp[0]; bv[0][1] = bp[1]; bv[1][0] = bp[2]; bv[1][1] = bp[3];
        int rb = wr * 64 + fr; asm volatile("" : "+v"(rb));
        const LAS int* idp = ids + rb; int slots[8];
#pragma unroll
        for (int q = 0; q < 8; ++q) slots[q] = idp[(q >> 2) * HALF + (q & 3) * 16];
#pragma unroll
        for (int ai = 0; ai < 2; ++ai)
#pragma unroll
            for (int m = 0; m < 4; ++m) { const int r = ai * HALF + m * 16 + rb;
                if (r < nv) { const int slot = slots[ai * 4 + m]; const float gt = gts[r];
                    if constexpr (Y_F8) {
                        unsigned pk[2][2];
#pragma unroll
                        for (int bj = 0; bj < 2; ++bj) { const f32x4 s0 = (acc[ai][bj][m][0] * OSC + bv[bj][0]) * (gt * Y_SCALE), s1 = (acc[ai][bj][m][1] * OSC + bv[bj][1]) * (gt * Y_SCALE); int w0 = 0, w1 = 0;
                            w0 = __builtin_amdgcn_cvt_pk_fp8_f32(s0[0], s0[1], w0, false); w0 = __builtin_amdgcn_cvt_pk_fp8_f32(s0[2], s0[3], w0, true); w1 = __builtin_amdgcn_cvt_pk_fp8_f32(s1[0], s1[1], w1, false); w1 = __builtin_amdgcn_cvt_pk_fp8_f32(s1[2], s1[3], w1, true);
                            pk[bj][0] = (unsigned)w0; pk[bj][1] = (unsigned)w1; }
                        const auto x0 = __builtin_amdgcn_permlane16_swap(pk[0][0], pk[1][0], false, false), x1 = __builtin_amdgcn_permlane16_swap(pk[0][1], pk[1][1], false, false);
                        *(u32x4*)((unsigned char*)Y + (size_t)slot * 1024 + c0 + ((fq & 1) ? 120 : 0)) = (u32x4){x0[0], x1[0], x0[1], x1[1]};
                    } else {
#pragma unroll
                    for (int bj = 0; bj < 2; ++bj) { const f32x4 v0 = (acc[ai][bj][m][0] * OSC + bv[bj][0]) * gt, v1 = (acc[ai][bj][m][1] * OSC + bv[bj][1]) * gt;
                        u32x4 w; w.x = cvt_pk_bf16(v0[0], v0[1]); w.y = cvt_pk_bf16(v0[2], v0[3]); w.z = cvt_pk_bf16(v1[0], v1[1]); w.w = cvt_pk_bf16(v1[2], v1[3]);
                        if (NT_STORE) __builtin_nontemporal_store(w, (u32x4*)(Y + (size_t)slot * 1024 + c0 + bj * HALF)); else *(u32x4*)(Y + (size_t)slot * 1024 + c0 + bj * HALF) = w; } } } }
    }
};

__device__ __forceinline__ const char* uni_ptr(const char* p) { const unsigned long long v = (unsigned long long)p; const unsigned lo = __builtin_amdgcn_readfirstlane((unsigned)v), hi = __builtin_amdgcn_readfirstlane((unsigned)(v >> 32)); return (const char*)(((unsigned long long)hi << 32) | lo); }
typedef int v4i_t __attribute__((ext_vector_type(4))); typedef int v8i_t __attribute__((ext_vector_type(8)));
__device__ __forceinline__ v8i_t cat8(const bf16x8 a, const bf16x8 b) { return __builtin_shufflevector(__builtin_bit_cast(v4i_t, a), __builtin_bit_cast(v4i_t, b), 0, 1, 2, 3, 4, 5, 6, 7); }
template <class Epi, class Sched, bool GATHER, bool F8 = false, bool DEFER = false>
__device__ __forceinline__ void gemm_phase(LAS unsigned char* lds, const Sched& S, const Epi& E, const int tid) {
    const int wid = __builtin_amdgcn_readfirstlane(tid >> 6), lane = tid & 63, wr = wid >> 2, wc = wid & 3, fr = lane & 15, fq = lane >> 4;
    const int KB = S.KB, nt = KB / 128;
    unsigned voffA[2], voffB[2];
#pragma unroll
    for (int i = 0; i < 2; ++i) { int R, C; stage_rc(tid * 16 + i * 8192, R, C); const int Rb = Epi::PERM ? ((R & ~31) + perm32(R & 31)) : R;
        voffA[i] = (unsigned)(R * KB + C * 2); voffB[i] = (unsigned)(Rb * KB + C * 2); }
    const size_t kstep = (size_t)(BK * 2);
    const size_t hstep = (size_t)HALF * KB;
    const unsigned ldsw = (unsigned)wid * 1024u;
    const int aoff = lds_byte(wr * 64 + fr, fq * 8), boff = lds_byte(wc * 32 + fr, fq * 8);
#define PG8_SA(b, h) (((b) * 2 + (h)) * HTB)
#define PG8_SB(b, h) ((4 + (b) * 2 + (h)) * HTB)
#define PG8_STAGE(bufoff, gbase, voff) do { const char* _gb = uni_ptr((const char*)(gbase)); _Pragma("unroll") for (int _i = 0; _i < 2; ++_i) \
        __builtin_amdgcn_global_load_lds((const unsigned*)(_gb + (voff)[_i]), (LAS unsigned*)(lds + (bufoff) + ldsw + _i * 8192), 16, 0, 0); } while (0)
#define PG8_STAGE_A(bufoff, kb, h, GO) do { if constexpr (GATHER) { PG8_STAGE(bufoff, kb, (GO)[h]); } else { PG8_STAGE(bufoff, (kb) + (h) * hstep, voffA); } } while (0)
#define PG8_LDA(dst, b, h) do { if constexpr (F8) { _Pragma("unroll") for (int m = 0; m < 4; ++m) dst##8[m] = cat8(*(const LAS bf16x8*)(lds + PG8_SA(b, h) + aoff + m * 2048), *(const LAS bf16x8*)(lds + PG8_SA(b, h) + aoff + m * 2048 + 1024)); } else { \
        _Pragma("unroll") for (int m = 0; m < 4; ++m) _Pragma("unroll") for (int k = 0; k < 2; ++k) dst[m][k] = *(const LAS bf16x8*)(lds + PG8_SA(b, h) + aoff + m * 2048 + k * 1024); } } while (0)
#define PG8_LDB(dst, b, h) do { if constexpr (F8) { _Pragma("unroll") for (int n = 0; n < 2; ++n) dst##8[n] = cat8(*(const LAS bf16x8*)(lds + PG8_SB(b, h) + boff + n * 2048), *(const LAS bf16x8*)(lds + PG8_SB(b, h) + boff + n * 2048 + 1024)); } else { \
        _Pragma("unroll") for (int n = 0; n < 2; ++n) _Pragma("unroll") for (int k = 0; k < 2; ++k) dst[n][k] = *(const LAS bf16x8*)(lds + PG8_SB(b, h) + boff + n * 2048 + k * 1024); } } while (0)
#define PG8_MMA(ai, bj, At, Bt) do { __builtin_amdgcn_s_setprio(1); if constexpr (F8) { _Pragma("unroll") for (int m = 0; m < 4; ++m) _Pragma("unroll") for (int n = 0; n < 2; ++n) \
        acc[ai][bj][m][n] = __builtin_amdgcn_mfma_scale_f32_16x16x128_f8f6f4(Bt##8[n], At##8[m], acc[ai][bj][m][n], 0, 0, 0, 0, 0, 0); } else { \
        _Pragma("unroll") for (int m = 0; m < 4; ++m) _Pragma("unroll") for (int n = 0; n < 2; ++n) _Pragma("unroll") for (int k = 0; k < 2; ++k) \
        acc[ai][bj][m][n] = __builtin_amdgcn_mfma_f32_16x16x32_bf16(Bt[n][k], At[m][k], acc[ai][bj][m][n], 0, 0, 0); } __builtin_amdgcn_s_setprio(0); } while (0)
#define PG8_WAIT_V(n) asm volatile("s_waitcnt vmcnt(" #n ")" ::: "memory")
#define PG8_WAIT_L(n) asm volatile("s_waitcnt lgkmcnt(" #n ")" ::: "memory")
#define PG8_BAR __builtin_amdgcn_s_barrier()
#define PG8_SCHED __builtin_amdgcn_sched_barrier(0)
    LAS int* const ibuf = (LAS int*)(lds + STAGE_BYTES + 512);
#define PG8_IDMA(u, b) do { if constexpr (GATHER) { __builtin_amdgcn_global_load_lds((const unsigned*)(S.idx_src(u) + 64 * (wid & 3) + lane), (LAS unsigned*)(ibuf + (b) * 256 + 64 * (wid & 3)), 4, 0, 0); \
        if constexpr (Epi::HAS_GATE) __builtin_amdgcn_global_load_lds((const unsigned*)(E.gidx + (S.idx_src(u) - S.idx) + 64 * (wid & 3) + lane), (LAS unsigned*)(ibuf + 768 + (b) * 256 + 64 * (wid & 3)), 4, 0, 0); } } while (0)
#define PG8_GOFF(dst, u, b) do { if constexpr (GATHER) { int _t = tid; asm volatile("" : "+v"(_t)); const int _nv = S.nvalid(u); _Pragma("unroll") for (int _i = 0; _i < 2; ++_i) { int _R, _C; stage_rc(_t * 16 + _i * 8192, _R, _C); \
        _Pragma("unroll") for (int _h = 0; _h < 2; ++_h) { const int _r = _R + _h * HALF; const unsigned _s = (unsigned)ibuf[(b) * 256 + (_r < _nv ? _r : 0)]; dst[_h][_i] = (_s >> Sched::ROW_SHIFT) * (unsigned)KB + (unsigned)_C * 2u; } } } } while (0)
    Unit cur, nxt; int ui = 0;
    if (!S.next(0, cur)) return;
    f32x4 acc[2][2][4][2];
#pragma unroll
    for (int a = 0; a < 2; ++a)
#pragma unroll
        for (int b = 0; b < 2; ++b)
#pragma unroll
            for (int m = 0; m < 4; ++m)
#pragma unroll
                for (int n = 0; n < 2; ++n) acc[a][b][m][n] = (f32x4){0.f, 0.f, 0.f, 0.f};
    bf16x8 At[4][2], B0[2][2], B1[2][2];
    v8i_t At8[4], B08[2], B18[2];
    unsigned gA[2][2] = {{0u, 0u}, {0u, 0u}}, gN[2][2] = {{0u, 0u}, {0u, 0u}};
    int bsel = 0;
    f32x4 bpre[4] = {(f32x4){0.f, 0.f, 0.f, 0.f}, (f32x4){0.f, 0.f, 0.f, 0.f}, (f32x4){0.f, 0.f, 0.f, 0.f}, (f32x4){0.f, 0.f, 0.f, 0.f}};
    Pend pend; int ppn = 0, pnv = 0, pq = 8, pbuf = 0;
    if constexpr (DEFER) {
#pragma unroll
        for (int q = 0; q < 8; ++q) pend.val[q] = (u32x2){0u, 0u}; }
#define PG8_PSTORE() do { if constexpr (DEFER) { const int _l3 = lane_id_volatile(); const int _nv = (pq < 8) ? pnv : 0; \
        E.store_one(pend.val[0], ibuf + pbuf * 256, ((pq >> 2) & 1) * HALF + (pq & 3) * 16 + wr * 64 + (_l3 & 15), _nv, ppn * HALF + wc * 32 + 8 * (_l3 >> 4)); \
        _Pragma("unroll") for (int _q = 0; _q < 7; ++_q) pend.val[_q] = pend.val[_q + 1]; ++pq; } } while (0)
    if constexpr (GATHER) { PG8_IDMA(cur, 0); PG8_WAIT_V(0); PG8_BAR; }
    PG8_GOFF(gA, cur, 0);
    const char* cA = S.a_base(cur); const char* cB = S.b_base(cur);
    PG8_STAGE(PG8_SB(0, 0), cB, voffB); PG8_STAGE(PG8_SB(0, 1), cB + hstep, voffB); PG8_STAGE_A(PG8_SA(0, 0), cA, 0, gA); PG8_STAGE_A(PG8_SA(0, 1), cA, 1, gA);
    if (wr == 1) PG8_BAR;
    PG8_WAIT_V(2); PG8_BAR;
    PG8_STAGE(PG8_SB(1, 0), cB + kstep, voffB); PG8_STAGE_A(PG8_SA(1, 0), cA + kstep, 0, gA); PG8_STAGE(PG8_SB(1, 1), cB + hstep + kstep, voffB);
    PG8_WAIT_V(6); PG8_BAR;
    for (;;) {
        const bool has_next = S.next(ui + 1, nxt);
        const char* nA = has_next ? S.a_base(nxt) : cA; const char* nB = has_next ? S.b_base(nxt) : cB;
        const int bnxt = (bsel == 2) ? 0 : bsel + 1;
        if constexpr (GATHER) { if (has_next) PG8_IDMA(nxt, bnxt); }
        for (int t = 0; t < nt; t += 2) {
            const bool last = (t == nt - 2);
            const char* a1 = cA + (size_t)(t + 1) * kstep;
            const char* a2 = last ? nA : cA + (size_t)(t + 2) * kstep; const char* b2 = last ? nB : cB + (size_t)(t + 2) * kstep;
            const char* a3 = a2 + kstep; const char* b3 = b2 + kstep;
            if constexpr (GATHER) { if (last && has_next) { PG8_GOFF(gN, nxt, bnxt); } }
            if constexpr (Epi::HAS_BIAS) { if (last) E.load_bias(cur, wc, lane_id_volatile() >> 4, bpre); }
            PG8_LDB(B0, 0, 0); PG8_LDB(B1, 0, 1); PG8_SCHED; PG8_LDA(At, 0, 0); PG8_STAGE_A(PG8_SA(1, 1), a1, 1, gA);
            if constexpr (GATHER) { if (last && has_next) { gA[0][0] = gN[0][0]; gA[0][1] = gN[0][1]; gA[1][0] = gN[1][0]; gA[1][1] = gN[1][1]; } }
            PG8_WAIT_V(8); PG8_WAIT_L(0); PG8_BAR; PG8_MMA(0, 0, At, B0); PG8_MMA(0, 1, At, B1); PG8_BAR; PG8_SCHED;
            PG8_LDA(At, 0, 1); PG8_STAGE(PG8_SB(0, 0), b2, voffB); PG8_STAGE(PG8_SB(0, 1), b2 + hstep, voffB); PG8_STAGE_A(PG8_SA(0, 0), a2, 0, gA);
            PG8_WAIT_V(8); PG8_WAIT_L(0); PG8_BAR; PG8_MMA(1, 0, At, B0); PG8_MMA(1, 1, At, B1); PG8_BAR; PG8_SCHED;
            PG8_PSTORE();
            PG8_LDB(B0, 1, 0); PG8_LDB(B1, 1, 1); PG8_SCHED; PG8_LDA(At, 1, 0); PG8_STAGE_A(PG8_SA(0, 1), a2, 1, gA);
            PG8_WAIT_V(8); PG8_WAIT_L(0); PG8_BAR; PG8_MMA(0, 0, At, B0); PG8_MMA(0, 1, At, B1); PG8_BAR; PG8_SCHED;
            PG8_LDA(At, 1, 1); PG8_STAGE(PG8_SB(1, 0), b3, voffB); PG8_STAGE(PG8_SB(1, 1), b3 + hstep, voffB); PG8_STAGE_A(PG8_SA(1, 0), a3, 0, gA);
            PG8_WAIT_V(8); PG8_WAIT_L(0); PG8_BAR; PG8_MMA(1, 0, At, B0); PG8_MMA(1, 1, At, B1); PG8_BAR; PG8_SCHED;
            PG8_PSTORE();
        }
        if (ALIGN_EPI) { if (wr == 0) PG8_BAR; }
        { const int l2 = lane_id_volatile(), fr2 = l2 & 15, fq2 = l2 >> 4;
          if constexpr (DEFER) { _Pragma("unroll") for (int _f = 0; _f < 8; ++_f) PG8_PSTORE();
              E.prepare(acc, cur, wr, wc, fr2, fq2, pend); ppn = cur.pn; pnv = S.nvalid(cur); pq = 0; pbuf = bsel; }
          else if constexpr (GATHER) E(acc, cur, wr, wc, fr2, fq2, ibuf + bsel * 256, S.nvalid(cur), bpre); else E(acc, cur, wr, wc, fr2, fq2); }
        if (!has_next) break;
#pragma unroll
        for (int a = 0; a < 2; ++a)
#pragma unroll
            for (int b = 0; b < 2; ++b)
#pragma unroll
                for (int m = 0; m < 4; ++m)
#pragma unroll
                    for (int n = 0; n < 2; ++n) acc[a][b][m][n] = (f32x4){0.f, 0.f, 0.f, 0.f};
        cur = nxt; cA = nA; cB = nB; ++ui; bsel = bnxt;
        if (ALIGN_EPI) { if (wr == 1) PG8_BAR; }
    }
    if constexpr (DEFER) { _Pragma("unroll") for (int _f = 0; _f < 8; ++_f) PG8_PSTORE(); }
    PG8_WAIT_V(0);
    if (!ALIGN_EPI) { if (wr == 0) PG8_BAR; }
    PG8_BAR;
#undef PG8_PSTORE
#undef PG8_SA
#undef PG8_SB
#undef PG8_STAGE
#undef PG8_STAGE_A
#undef PG8_LDA
#undef PG8_LDB
#undef PG8_MMA
#undef PG8_WAIT_V
#undef PG8_WAIT_L
#undef PG8_BAR
#undef PG8_SCHED
#undef PG8_GOFF
#undef PG8_IDMA
}
}

namespace attn_body {
using bf16=__hip_bfloat16;
using bf16x8=__attribute__((ext_vector_type(8)))short;
using s16x4=__attribute__((ext_vector_type(4)))short;
using f32x16=__attribute__((ext_vector_type(16)))float;
using u32x4=__attribute__((ext_vector_type(4)))unsigned;
constexpr int D=64;
constexpr int NW=8,QBLK=32,QB=QBLK*NW,KVBLK=64;
constexpr int ATTN_UNIT_ROWS=QB;
__device__ __forceinline__ int crow(int r,int hi){return (r&3)+8*(r>>2)+4*hi;}
#define SBAR() __builtin_amdgcn_sched_barrier(0)
__device__ __forceinline__ void cmask(f32x16&p0,f32x16&p1,int jb,int qrel,int hi){
  const float NEG=-INFINITY; int kb=64*jb+4*hi;
  #pragma unroll
  for(int r=0;r<16;++r){int kv=kb+(r&3)+8*(r>>2); if(kv>qrel)p0[r]=NEG; if(kv+32>qrel)p1[r]=NEG;}
}

constexpr int NSLOT=3, SLOTB=8192;
constexpr int LDS_K=0, LDS_V=NSLOT*SLOTB, LDS_WS=2*NSLOT*SLOTB, LDS_OST=LDS_WS+NW*64*4, LDS_BYTES=LDS_OST+NW*4096;
constexpr float C2=0.125f*1.4426950408889634f;
__device__ __forceinline__ void glds16(const void*gsrc,unsigned lds_dst){unsigned keep;
  asm volatile("s_mov_b32 %0, m0\n\ts_mov_b32 m0, %2\n\ts_nop 0\n\tglobal_load_lds_dwordx4 %1, off\n\ts_mov_b32 m0, %0":"=&s"(keep):"v"(gsrc),"s"(lds_dst):"memory");}
__device__ __forceinline__ float max3f(float a,float b,float c){float r;asm("v_max3_f32 %0, %1, %2, %3":"=v"(r):"v"(a),"v"(b),"v"(c));return r;}
__device__ __forceinline__ float max2f(float a,float b){float r;asm("v_max_f32_e32 %0, %1, %2":"=v"(r):"v"(a),"v"(b));return r;}
__device__ __forceinline__ float fadd_s(float a,float b){float r;asm("v_add_f32_e32 %0, %1, %2":"=v"(r):"v"(a),"v"(b));return r;}
__device__ __forceinline__ float fsub_s(float a,float b){float r;asm("v_sub_f32_e32 %0, %1, %2":"=v"(r):"v"(a),"v"(b));return r;}
typedef float f32x2_t __attribute__((ext_vector_type(2))); typedef __bf16 bf16x2_t __attribute__((ext_vector_type(2)));
__device__ __forceinline__ unsigned cvtpk_s(float lo,float hi){f32x2_t v={lo,hi};bf16x2_t b=__builtin_convertvector(v,bf16x2_t);return __builtin_bit_cast(unsigned,b);}
#define WAIT_BAR(N) asm volatile("s_waitcnt vmcnt(" #N ") lgkmcnt(0)\n\ts_barrier":::"memory")

__device__ __forceinline__ void qkt(f32x16&p0,f32x16&p1,const char*Kslot,const bf16x8*qr,const f32x16&negm,int r32,int hi){
  const char*kb=Kslot+hi*1024+r32*16;
  #pragma unroll
  for(int d0=0;d0<4;++d0){
    const bf16x8 b0=*reinterpret_cast<const bf16x8*>(kb+d0*2048);
    const bf16x8 b1=*reinterpret_cast<const bf16x8*>(kb+d0*2048+512);
    if(d0==0){p0=__builtin_amdgcn_mfma_f32_32x32x16_bf16(b0,qr[0],negm,0,0,0);p1=__builtin_amdgcn_mfma_f32_32x32x16_bf16(b1,qr[0],negm,0,0,0);}
    else{p0=__builtin_amdgcn_mfma_f32_32x32x16_bf16(b0,qr[d0],p0,0,0,0);p1=__builtin_amdgcn_mfma_f32_32x32x16_bf16(b1,qr[d0],p1,0,0,0);}}
}
typedef __attribute__((address_space(3))) const char* lds_cptr;
typedef short v4i16_t __attribute__((ext_vector_type(4)));
__device__ __forceinline__ void kload8(bf16x8*kf,lds_cptr kp){
  kf[0]=*(const __attribute__((address_space(3))) bf16x8*)(kp);      kf[1]=*(const __attribute__((address_space(3))) bf16x8*)(kp+512);
  kf[2]=*(const __attribute__((address_space(3))) bf16x8*)(kp+2048); kf[3]=*(const __attribute__((address_space(3))) bf16x8*)(kp+2560);
  kf[4]=*(const __attribute__((address_space(3))) bf16x8*)(kp+4096); kf[5]=*(const __attribute__((address_space(3))) bf16x8*)(kp+4608);
  kf[6]=*(const __attribute__((address_space(3))) bf16x8*)(kp+6144); kf[7]=*(const __attribute__((address_space(3))) bf16x8*)(kp+6656);
}
__device__ __forceinline__ void kload2(bf16x8*kf,lds_cptr kp,int j){ kf[2*j]=*(const __attribute__((address_space(3))) bf16x8*)(kp+j*2048); kf[2*j+1]=*(const __attribute__((address_space(3))) bf16x8*)(kp+j*2048+512); }
__device__ __forceinline__ s16x4 vtr(lds_cptr p){ return __builtin_bit_cast(s16x4,__builtin_amdgcn_ds_read_tr16_b64_v4i16((__attribute__((address_space(3))) v4i16_t*)p)); }
__device__ __forceinline__ float rowmax(const f32x16&p0,const f32x16&p1){
  float a=max3f(p0[0],p0[1],p1[0]),b=max3f(p0[2],p0[3],p1[1]);a=max3f(a,p1[2],p1[3]);
  #pragma unroll
  for(int r=4;r<16;r+=4){a=max3f(a,p0[r],p0[r+1]);b=max3f(b,p0[r+2],p0[r+3]);a=max3f(a,p1[r],p1[r+1]);b=max3f(b,p1[r+2],p1[r+3]);}
  const float m=max2f(a,b);
  auto rr=__builtin_amdgcn_permlane32_swap(__float_as_uint(m),__float_as_uint(m),false,false);
  return max2f(__uint_as_float(rr[0]),__uint_as_float(rr[1]));
}
__device__ __forceinline__ void pv(f32x16*o,int vb,bf16x8 pa0,bf16x8 pa1,bf16x8 pa2,bf16x8 pa3){
  #pragma unroll
  for(int d0=0;d0<2;++d0){s16x4 lo[4],hi[4];
    #pragma unroll
    for(int ks=0;ks<4;++ks){
      asm volatile("ds_read_b64_tr_b16 %0,%1 offset:%c2":"=&v"(lo[ks]):"v"(vb),"i"(d0*4096+ks*1024):"memory");
      asm volatile("ds_read_b64_tr_b16 %0,%1 offset:%c2":"=&v"(hi[ks]):"v"(vb),"i"(d0*4096+ks*1024+512):"memory");}
    asm volatile("s_waitcnt lgkmcnt(0)":::"memory");SBAR();
    #define PK(k) (bf16x8){lo[k][0],lo[k][1],lo[k][2],lo[k][3],hi[k][0],hi[k][1],hi[k][2],hi[k][3]}
    o[d0]=__builtin_amdgcn_mfma_f32_32x32x16_bf16(pa0,PK(0),o[d0],0,0,0);
    o[d0]=__builtin_amdgcn_mfma_f32_32x32x16_bf16(pa1,PK(1),o[d0],0,0,0);
    o[d0]=__builtin_amdgcn_mfma_f32_32x32x16_bf16(pa2,PK(2),o[d0],0,0,0);
    o[d0]=__builtin_amdgcn_mfma_f32_32x32x16_bf16(pa3,PK(3),o[d0],0,0,0);
    #undef PK
  }
}

#ifndef ATTN_STORE16
#define ATTN_STORE16(p,v) (*(u32x4*)(p)=(v))
#endif
template<int THRL, bool O8 = false> __device__ __forceinline__ void attn_unit(const bf16*Qu,const bf16*__restrict__ Kh,const bf16*__restrict__ Vh,bf16*Ou,const int QP,const int KP,const int VP,const int OP,const int NT,char*shm,const int tid){
  const int lane=tid&63,r32=lane&31,hi=lane>>5; const int wid=__builtin_amdgcn_readfirstlane(tid>>6);
  const bf16*Qw=Qu+(long)(wid*QBLK)*QP;
  const unsigned lds0=(unsigned)(uintptr_t)shm;
  float*wsf=(float*)(shm+LDS_WS)+wid*64;
  const bf16*ksrc=Kh+(long)lane*KP+wid*8;
  const bf16*vsrc=Vh+(long)(16*(wid&3)+(lane>>2))*VP+(wid>>2)*32+(lane&3)*8;
  const unsigned kdst=lds0+LDS_K+wid*1024, vdst=lds0+LDS_V+wid*1024;
  #define DMA_K(t,slot) glds16(ksrc+(long)(t)*KVBLK*KP,(unsigned)__builtin_amdgcn_readfirstlane(kdst+(slot)))
  #define DMA_V(t,slot) glds16(vsrc+(long)(t)*KVBLK*VP,(unsigned)__builtin_amdgcn_readfirstlane(vdst+(slot)))
  const int vb0=(int)(lds0+LDS_V)+((lane>>4)&1)*32+(lane&3)*8+(4*hi+((lane&15)>>2))*64;
  const char*Kbase=shm+LDS_K; bf16x8 kf[8];
  const lds_cptr shm3=(lds_cptr)shm; const lds_cptr kp0=shm3+LDS_K+hi*1024+r32*16; const lds_cptr vp0=shm3+LDS_V+((lane>>4)&1)*32+(lane&3)*8+(4*hi+((lane&15)>>2))*64;
  DMA_K(0,0);DMA_V(0,0);DMA_K(1,SLOTB);
  bf16x8 qr[4];
  #pragma unroll
  for(int d0=0;d0<4;++d0)qr[d0]=*reinterpret_cast<const bf16x8*>(&Qw[(long)r32*QP+d0*16+hi*8]);
  float mhat=0.f,l_reg=0.f;f32x16 o[2];f32x16 negm; { float z_=0.f; asm volatile("":"+v"(z_)); _Pragma("unroll") for(int r=0;r<16;++r){o[0][r]=z_;o[1][r]=z_;negm[r]=z_;} } asm volatile("":"+v"(negm));
  #define CMASK(P0,P1,t) do{}while(0)
  bool resc=false;
  #define START(P0,P1) do{ const float rm=rowmax(P0,P1); resc=false; \
    { const float dl=rm; mhat=fadd_s(mhat,dl); \
      _Pragma("unroll") for(int r=0;r<16;++r){P0[r]=fsub_s(P0[r],dl);P1[r]=fsub_s(P1[r],dl);} \
      _Pragma("unroll") for(int r=0;r<16;++r)negm[r]=-mhat; asm volatile("":"+v"(negm)); } \
    _Pragma("unroll") for(int r=0;r<16;++r)P0[r]=__builtin_amdgcn_exp2f(P0[r]); }while(0)
  #define RESC() do{ if(resc){ asm volatile("s_waitcnt lgkmcnt(0)":::"memory"); \
      _Pragma("unroll") for(int d_=0;d_<2;++d_) _Pragma("unroll") for(int r=0;r<16;++r)o[d_][r]*=wsf[crow(r,hi)]; } }while(0)
  f32x16 pA0,pA1,pB0,pB1;
  int sl_prev=0,sl_cur=0,sl_next=SLOTB;
  #define ROT() do{sl_prev=sl_cur;sl_cur=sl_next;sl_next=(sl_next==(NSLOT-1)*SLOTB)?0:sl_next+SLOTB;}while(0)
  DMA_K(2,2*SLOTB);
  WAIT_BAR(3);
  qkt(pA0,pA1,Kbase,qr,negm,r32,hi);asm volatile("s_nop 15\n\ts_nop 7":"+v"(pA0),"+v"(pA1));CMASK(pA0,pA1,0);
  START(pA0,pA1);
  _Pragma("unroll") for(int r=0;r<16;++r)pA1[r]=__builtin_amdgcn_exp2f(pA1[r]);
  WAIT_BAR(0);
  DMA_K(3,0);DMA_V(1,SLOTB);
  ROT();
  kload8(kf,kp0+sl_cur);
  WAIT_BAR(2);
  s16x4 vlo[8],vhi[8]; u32x4 pw0,pw1,pw2,pw3;
  #define PKW(P,B) cvtpk_s(P[B],P[B+1])
  #define PAF(k) __builtin_bit_cast(bf16x8,pw##k)
  #define VFR(i) (bf16x8){vlo[i][0],vlo[i][1],vlo[i][2],vlo[i][3],vhi[i][0],vhi[i][1],vhi[i][2],vhi[i][3]}
  #define PIN(x) asm volatile("":"+v"(x))
  #define MX3(a,b,c) __builtin_fmaxf(__builtin_fmaxf((a),(b)),(c))
  #define GAPA(MF,A0,A1,A2,A3,W0,W1,PW) do{ MF; sacc+=A0; sacc+=A1; sacc+=A2; sacc+=A3; PIN(sacc); W0; W1; PIN(PW); SBAR(); }while(0)
  #define EX(v) __builtin_amdgcn_exp2f(v)
  #define GAPB(MF,X,B) do{ MF; X[B]=EX(X[B]); X[B+1]=EX(X[B+1]); X[B+2]=EX(X[B+2]); X[B+3]=EX(X[B+3]); PIN(X); SBAR(); }while(0)
  #define VRD(i) do{ vlo[i]=vtr(vp_+(((i)>>2)*4096+((i)&3)*1024)); vhi[i]=vtr(vp_+(((i)>>2)*4096+((i)&3)*1024+512)); }while(0)
  #define KRD(G,j) do{ if(G){ kload2(kf,kp0+sl_next,j); SBAR(); } }while(0)
  #define STEP(C0,C1,P0,P1,t,GK,GV,GL) do{ SBAR(); \
    const lds_cptr vp_=vp0+sl_prev; \
    VRD(0); SBAR(); float sacc=(P0[0]+P0[1]); \
    GAPA(C0=__builtin_amdgcn_mfma_f32_32x32x16_bf16(kf[0],qr[0],negm,0,0,0), P0[2],P0[3],P0[4],P0[5],     pw0[0]=PKW(P0,0), pw0[1]=PKW(P0,2), pw0); \
    VRD(4); SBAR(); GAPA(C1=__builtin_amdgcn_mfma_f32_32x32x16_bf16(kf[1],qr[0],negm,0,0,0), P0[6],P0[7],P0[8],P0[9],     pw0[2]=PKW(P0,4), pw0[3]=PKW(P0,6), pw0); \
    VRD(1); SBAR(); GAPA(C0=__builtin_amdgcn_mfma_f32_32x32x16_bf16(kf[2],qr[1],C0,0,0,0),   P0[10],P0[11],P0[12],P0[13], pw1[0]=PKW(P0,8), pw1[1]=PKW(P0,10), pw1); \
    VRD(5); SBAR(); GAPA(C1=__builtin_amdgcn_mfma_f32_32x32x16_bf16(kf[3],qr[1],C1,0,0,0),   P0[14],P0[15],P1[0],P1[1],   pw1[2]=PKW(P0,12),pw1[3]=PKW(P0,14), pw1); \
    VRD(2); SBAR(); GAPA(C0=__builtin_amdgcn_mfma_f32_32x32x16_bf16(kf[4],qr[2],C0,0,0,0),   P1[2],P1[3],P1[4],P1[5],     pw2[0]=PKW(P1,0), pw2[1]=PKW(P1,2), pw2); \
    VRD(6); SBAR(); GAPA(C1=__builtin_amdgcn_mfma_f32_32x32x16_bf16(kf[5],qr[2],C1,0,0,0),   P1[6],P1[7],P1[8],P1[9],     pw2[2]=PKW(P1,4), pw2[3]=PKW(P1,6), pw2); \
    VRD(3); SBAR(); GAPA(C0=__builtin_amdgcn_mfma_f32_32x32x16_bf16(kf[6],qr[3],C0,0,0,0),   P1[10],P1[11],P1[12],P1[13], pw3[0]=PKW(P1,8), pw3[1]=PKW(P1,10), pw3); \
    VRD(7); SBAR(); GAPA(C1=__builtin_amdgcn_mfma_f32_32x32x16_bf16(kf[7],qr[3],C1,0,0,0),   P1[14],P1[15],0.f,0.f,       pw3[2]=PKW(P1,12),pw3[3]=PKW(P1,14), pw3); \
    l_reg+=sacc; \
    if(GK){DMA_K((t)+3,sl_cur);} if(GV){DMA_V((t)+1,sl_next);} \
    CMASK(C0,C1,t); \
    { float a=MX3(C0[0],C0[1],C1[0]),b=MX3(C0[2],C0[3],C1[1]); a=MX3(a,C1[2],C1[3]); \
      _Pragma("unroll") for(int r=4;r<16;r+=4){a=MX3(a,C0[r],C0[r+1]);b=MX3(b,C0[r+2],C0[r+3]);a=MX3(a,C1[r],C1[r+1]);b=MX3(b,C1[r+2],C1[r+3]);} \
      float rm=__builtin_fmaxf(a,b); { auto rr=__builtin_amdgcn_permlane32_swap(__float_as_uint(rm),__float_as_uint(rm),false,false); rm=__builtin_fmaxf(__uint_as_float(rr[0]),__uint_as_float(rr[1])); } \
      resc=false; \
      if(__builtin_expect(__any(rm>(float)THRL),0)){ const float dl=__builtin_fmaxf(rm,0.f); mhat+=dl; \
        _Pragma("unroll") for(int r=0;r<16;++r){C0[r]-=dl;C1[r]-=dl;} \
        _Pragma("unroll") for(int r=0;r<16;++r)negm[r]=-mhat; asm volatile("":"+v"(negm)); \
        const float f=__builtin_amdgcn_exp2f(-dl); l_reg*=f; if(hi==0)wsf[r32]=f; resc=true; } } \
    SBAR(); \
    GAPB(o[0]=__builtin_amdgcn_mfma_f32_32x32x16_bf16(PAF(0),VFR(0),o[0],0,0,0), C0,0); \
    GAPB(o[1]=__builtin_amdgcn_mfma_f32_32x32x16_bf16(PAF(0),VFR(4),o[1],0,0,0), C0,4); \
    KRD(GL,0); GAPB(o[0]=__builtin_amdgcn_mfma_f32_32x32x16_bf16(PAF(1),VFR(1),o[0],0,0,0), C0,8); \
    KRD(GL,1); GAPB(o[1]=__builtin_amdgcn_mfma_f32_32x32x16_bf16(PAF(1),VFR(5),o[1],0,0,0), C0,12); \
    KRD(GL,2); GAPB(o[0]=__builtin_amdgcn_mfma_f32_32x32x16_bf16(PAF(2),VFR(2),o[0],0,0,0), C1,0); \
    KRD(GL,3); GAPB(o[1]=__builtin_amdgcn_mfma_f32_32x32x16_bf16(PAF(2),VFR(6),o[1],0,0,0), C1,4); \
    GAPB(o[0]=__builtin_amdgcn_mfma_f32_32x32x16_bf16(PAF(3),VFR(3),o[0],0,0,0), C1,8); \
    GAPB(o[1]=__builtin_amdgcn_mfma_f32_32x32x16_bf16(PAF(3),VFR(7),o[1],0,0,0), C1,12); \
    }while(0)
  int t=1;
  #undef CMASK
  #define CMASK(P0,P1,t) do{}while(0)
  for(;t+5<NT;t+=2){
    STEP(pB0,pB1,pA0,pA1,t,true,true,true);     WAIT_BAR(2); RESC(); ROT();
    STEP(pA0,pA1,pB0,pB1,t+1,true,true,true);   WAIT_BAR(2); RESC(); ROT();
  }
  #undef CMASK
  #define CMASK(P0,P1,t) do{}while(0)
  #define ENDW(tt) do{ if((tt)+3<NT){WAIT_BAR(2);} else if((tt)+2<NT){WAIT_BAR(1);} else {WAIT_BAR(0);} }while(0)
  for(;t+1<NT;t+=2){
    STEP(pB0,pB1,pA0,pA1,t,(t+3<NT),(t+1<NT),(t+1<NT));       ENDW(t);   RESC(); ROT();
    STEP(pA0,pA1,pB0,pB1,t+1,(t+4<NT),(t+2<NT),(t+2<NT));     ENDW(t+1); RESC(); ROT();
  }
  STEP(pB0,pB1,pA0,pA1,NT-1,false,false,false); RESC();
  { float sacc=pB0[0]+pB0[1]; _Pragma("unroll") for(int r=2;r<16;++r)sacc+=pB0[r]; _Pragma("unroll") for(int r=0;r<16;++r)sacc+=pB1[r]; l_reg+=sacc;
    pw0=(u32x4){PKW(pB0,0),PKW(pB0,2),PKW(pB0,4),PKW(pB0,6)};pw1=(u32x4){PKW(pB0,8),PKW(pB0,10),PKW(pB0,12),PKW(pB0,14)};pw2=(u32x4){PKW(pB1,0),PKW(pB1,2),PKW(pB1,4),PKW(pB1,6)};pw3=(u32x4){PKW(pB1,8),PKW(pB1,10),PKW(pB1,12),PKW(pB1,14)};
    SBAR(); pv(o,vb0+sl_cur,PAF(0),PAF(1),PAF(2),PAF(3)); }
  #undef PKW
  #undef PAF
  #undef VFR
  #undef PIN
  #undef MX3
  #undef GAPA
  #undef GAPB
  #undef EX
  #undef VRD
  #undef KRD
  #undef STEP
  #undef ENDW
  {auto rr=__builtin_amdgcn_permlane32_swap(__float_as_uint(l_reg),__float_as_uint(l_reg),false,false);l_reg=__uint_as_float(rr[0])+__uint_as_float(rr[1]);}
  if(hi==0)wsf[32+r32]=l_reg;asm volatile("s_waitcnt lgkmcnt(0)":::"memory");
  float rli[16];
  #pragma unroll
  for(int r=0;r<16;++r)rli[r]=__builtin_amdgcn_rcpf(wsf[32+crow(r,hi)]);
  if constexpr (O8) {
    unsigned char*Ow8=(unsigned char*)Ou+(long)(wid*QBLK)*OP; unsigned char*stg8=(unsigned char*)(shm+LDS_OST)+wid*2048;
    #pragma unroll
    for(int r=0;r<16;++r){const int orow=crow(r,hi);
      #pragma unroll
      for(int d0=0;d0<2;++d0)stg8[orow*64+d0*32+r32]=f2fp8(o[d0][r]*rli[r]);}
    asm volatile("s_waitcnt lgkmcnt(0)":::"memory");
    #pragma unroll
    for(int i=0;i<2;++i){const int row=i*16+(lane>>2),ch=lane&3; const u32x4 v=*(const u32x4*)(stg8+row*64+ch*16); ATTN_STORE16(Ow8+(long)row*OP+ch*16,v);}
  } else {
  bf16*Ow=Ou+(long)(wid*QBLK)*OP;
  { bf16*stg=(bf16*)(shm+LDS_OST)+wid*2048;
    #pragma unroll
    for(int r=0;r<16;++r){const int orow=crow(r,hi);
      #pragma unroll
      for(int d0=0;d0<2;++d0)stg[orow*64+d0*32+r32]=__float2bfloat16(o[d0][r]*rli[r]);}
    asm volatile("s_waitcnt lgkmcnt(0)":::"memory");
    #pragma unroll
    for(int i=0;i<4;++i){const int row=i*8+(lane>>3),ch=lane&7; const u32x4 v=*(const u32x4*)(stg+row*64+ch*8); ATTN_STORE16(Ow+(long)row*OP+ch*8,v);} }
  }
  asm volatile("s_waitcnt lgkmcnt(0)\n\ts_barrier":::"memory");
  #undef DMA_K
  #undef DMA_V
  #undef CMASK
  #undef START
  #undef RESC
  #undef ROT
}
constexpr int ATTN_LDS_BYTES=LDS_BYTES;
#undef SBAR
#undef WAIT_BAR
}

struct Args { const float* in[32]; float* out; unsigned char* ws; int ph_lo, ph_hi; };
struct Ctx {
    LAS unsigned char* lds;
    int vcu, G;
    unsigned char* ws;
};
constexpr int PTAB_OFF = MISC_OFF + 256;
__device__ __forceinline__ unsigned long long ptab_get(const Ctx& cx, int k) {
    const LAS unsigned* t = (const LAS unsigned*)(cx.lds + PTAB_OFF) + 2 * k; const unsigned lo = __builtin_amdgcn_readfirstlane(t[0]), hi = __builtin_amdgcn_readfirstlane(t[1]);
    return ((unsigned long long)hi << 32) | lo;
}
#define INP(k) ((const float*)(GAS const float*)ptab_get(cx, (k)))

template <bool F8> __device__ __forceinline__ void p0_transpose64(const float* W, int N, int KB, unsigned char* WT, int k0, int n0, int dst_row0, float scale, LAS float* scr, int lane) {
    f32x4 v[16];
    const float* src = W + (size_t)(k0 + (lane >> 4)) * N + n0 + (lane & 15) * 4;
#pragma unroll
    for (int i = 0; i < 16; ++i) v[i] = *(const f32x4*)(src + (size_t)(4 * i) * N);
#pragma unroll
    for (int i = 0; i < 16; ++i) { LAS float* p = scr + (4 * i + (lane >> 4)) * 65 + (lane & 15) * 4; p[0] = v[i][0]; p[1] = v[i][1]; p[2] = v[i][2]; p[3] = v[i][3]; }
    LDS_WAIT(); asm volatile("" ::: "memory");
    if constexpr (!F8) {
        const int ns = lane >> 3, ch = lane & 7;
#pragma unroll
        for (int r8 = 0; r8 < 8; ++r8) { const int n = r8 * 8 + ns; const LAS float* s = scr + (8 * ch) * 65 + n;
            u32x4 o; o.x = pk2(s[0 * 65], s[1 * 65]); o.y = pk2(s[2 * 65], s[3 * 65]); o.z = pk2(s[4 * 65], s[5 * 65]); o.w = pk2(s[6 * 65], s[7 * 65]);
            *(GAS u32x4*)(WT + (size_t)(dst_row0 + n) * KB + (k0 + 8 * ch) * 2) = o; }
    } else {
        const int ns = lane >> 2, ch = lane & 3;
#pragma unroll
        for (int r4 = 0; r4 < 4; ++r4) { const int n = r4 * 16 + ns; const LAS float* s = scr + (16 * ch) * 65 + n; unsigned w[4];
#pragma unroll
            for (int q = 0; q < 4; ++q) { int r = 0; r = __builtin_amdgcn_cvt_pk_fp8_f32(s[(4 * q) * 65] * scale, s[(4 * q + 1) * 65] * scale, r, false); r = __builtin_amdgcn_cvt_pk_fp8_f32(s[(4 * q + 2) * 65] * scale, s[(4 * q + 3) * 65] * scale, r, true); w[q] = (unsigned)r; }
            *(GAS u32x4*)(WT + (size_t)(dst_row0 + n) * KB + k0 + 16 * ch) = (u32x4){w[0], w[1], w[2], w[3]}; }
    }
    LDS_WAIT(); asm volatile("" ::: "memory");
}
__device__ __forceinline__ void p0_prologue(const Ctx& cx, const int tid) {
    const int lane = tid & 63, wave = __builtin_amdgcn_readfirstlane(tid >> 6);
    LAS float* scr = (LAS float*)(cx.lds + wave * 16896);
    const int gw = cx.vcu * 8 + wave, NGW = cx.G * 8;
    constexpr int I_WIN0 = 16 * 40, I_WIN1 = 16 * 24, I_WKV = 16 * 8, I_WOUT = 16 * 16, I_W1 = 16 * 32, I_W2 = 16 * 16;
    constexpr int T_WIN = 3 * I_WIN0 + I_WIN1, T_WKV = 4 * I_WKV, T_WOUT = 4 * I_WOUT, T_W1 = 128 * I_W1, T_W2 = 128 * I_W2;
    constexpr int NITEMS = T_WIN + T_WKV + T_WOUT + T_W1 + T_W2;
    for (int it = gw; it < NITEMS; it += NGW) {
        int r = it;
        const float* W; unsigned char* WT; int N, nb, kb, dst_row0; bool isout = false;
        if (r < T_W1) {
            const int mi = r / I_W1, q = r % I_W1; N = 2048; kb = q / 32; nb = q % 32;
            W = INP(28) + (size_t)mi * 1024 * 2048; WT = cx.ws + WS_W1 + (size_t)mi * 2048 * 1024 * MOE_EB;
            const int n0 = nb * 64, isu = n0 >= 1024, j = n0 - isu * 1024;
            dst_row0 = (j >> 7) * 256 + isu * 128 + (j & 127);
            p0_transpose64<MOE_F8>(W, N, 1024 * MOE_EB, WT, kb * 64, nb * 64, dst_row0, W1_SCALE, scr, lane); continue;
        } else if ((r -= T_W1) < T_W2) {
            const int mi = r / I_W2, q = r % I_W2; N = 1024; kb = q / 16; nb = q % 16;
            W = INP(30) + (size_t)mi * 1024 * 1024; WT = cx.ws + WS_W2 + (size_t)mi * 1024 * 1024 * MOE_EB; dst_row0 = nb * 64;
            p0_transpose64<MOE_F8>(W, N, 1024 * MOE_EB, WT, kb * 64, nb * 64, dst_row0, W2_SCALE, scr, lane); continue;
        } else if ((r -= T_W2) < T_WIN) {
            int l, q;
            if (r < I_WIN0) { l = 0; q = r; } else if (r < I_WIN0 + I_WIN1) { l = 1; q = r - I_WIN0; } else if (r < 2 * I_WIN0 + I_WIN1) { l = 2; q = r - I_WIN0 - I_WIN1; } else { l = 3; q = r - 2 * I_WIN0 - I_WIN1; }
            N = in_width(l); const int nbn = N / 64; kb = q / nbn; nb = q % nbn;
            const int kind = layer_kind(l), j = layer_j(l);
            W = (kind == 0 ? INP(2) : kind == 1 ? INP(4) : INP(7)) + (size_t)j * 1024 * N;
            WT = cx.ws + WS_WIN + (size_t)l * 5 * MiB; dst_row0 = nb * 64;
        } else if ((r -= T_WIN) < T_WKV) {
            const int l = r / I_WKV, q = r % I_WKV; N = 512; kb = q / 8; nb = q % 8;
            W = INP(20) + (size_t)l * 1024 * 512; WT = cx.ws + WS_WKV; dst_row0 = l * 512 + nb * 64;
        } else {
            r -= T_WKV; const int l = r / I_WOUT, q = r % I_WOUT; N = 1024; kb = q / 16; nb = q % 16;
            W = INP(21) + (size_t)l * 1024 * 1024; WT = cx.ws + WS_WOUT + (size_t)l * 2 * MiB; dst_row0 = nb * 64; isout = true;
        }
        if (isout) p0_transpose64<OUTP_F8 != 0>(W, N, 1024 * OUT_EB, WT, kb * 64, nb * 64, dst_row0, OUTP_F8 ? WOUT_SCALE : 1.0f, scr, lane);
        else p0_transpose64<INP_F8 != 0>(W, N, 1024 * INP_EB, WT, kb * 64, nb * 64, dst_row0, INP_F8 ? WIN_SCALE : 1.0f, scr, lane);
    }
    {
        const size_t gt = (size_t)cx.vcu * 512 + tid, NT_ = (size_t)cx.G * 512;
        for (int which = 0; which < 2; ++which) {
            const f32x4* xs = (const f32x4*)(which == 0 ? INP(0) : INP(1)); unsigned char* xd = cx.ws + (which == 0 ? WS_XB : WS_MEMB); const size_t n8 = (size_t)(which == 0 ? NTOK : NMEM) * DM / 8;
#pragma unroll 4
            for (size_t i = gt; i < n8; i += NT_) { const f32x4 a = xs[2 * i], b = xs[2 * i + 1];
                if constexpr (INP_F8) { int w0 = 0, w1 = 0; w0 = __builtin_amdgcn_cvt_pk_fp8_f32(a[0], a[1], w0, false); w0 = __builtin_amdgcn_cvt_pk_fp8_f32(a[2], a[3], w0, true); w1 = __builtin_amdgcn_cvt_pk_fp8_f32(b[0], b[1], w1, false); w1 = __builtin_amdgcn_cvt_pk_fp8_f32(b[2], b[3], w1, true);
                    *(u32x2*)(xd + i * 8) = (u32x2){(unsigned)w0, (unsigned)w1}; }
                else { u32x4 o; o.x = pk2(a[0], a[1]); o.y = pk2(a[2], a[3]); o.z = pk2(b[0], b[1]); o.w = pk2(b[2], b[3]); *(u32x4*)(xd + i * 16) = o; } }
        }
    }
    {
        const float *fw1 = INP(10), *fb1 = INP(11), *fw2 = INP(12), *fb2 = INP(13), *fw3 = INP(14), *fb3 = INP(15), *fw4 = INP(16), *fb4 = INP(17), *ffr = INP(18);
        LAS float* z = (LAS float*)cx.lds; LAS float* h1 = z + 16 * 33; LAS float* h2 = h1 + 1024; LAS float* h3 = h2 + 1024;
        float* HRAWT = (float*)(cx.ws + WS_HRAWT); float* HPART = (float*)(cx.ws + WS_HPART);
        for (int it = cx.vcu; it < 256; it += cx.G) {
            __syncthreads();
            const int pos0 = it * 16;
            for (int i = tid; i < 16 * 33; i += 512) { const int p = i / 33, f = i % 33; const float pos = (float)(pos0 + p); float v;
                if (f == 0) v = pos / 4095.0f;
                else { const int k = (f - 1) & 15; const float fb = 1e-4f + (float)k * ((15.0f - 1e-4f) / 15.0f); const float ang = (6.283185307179586f * pos / 4096.0f) * fb; v = (f <= 16) ? cosf(ang) : -sinf(ang); }
                z[i] = v; }
            __syncthreads();
            for (int i = tid; i < 1024; i += 512) { const int p = i >> 6, o = i & 63; float a = fb1[o]; for (int f = 0; f < 33; ++f) a += z[p * 33 + f] * fw1[f * 64 + o]; h1[i] = sinf(ffr[o] * a); }
            __syncthreads();
            for (int i = tid; i < 1024; i += 512) { const int p = i >> 6, o = i & 63; float a = fb2[o]; for (int k = 0; k < 64; ++k) a += h1[p * 64 + k] * fw2[k * 64 + o]; h2[i] = sinf(ffr[o] * a); }
            __syncthreads();
            for (int i = tid; i < 1024; i += 512) { const int p = i >> 6, o = i & 63; float a = fb3[o]; for (int k = 0; k < 64; ++k) a += h2[p * 64 + k] * fw3[k * 64 + o]; h3[i] = sinf(ffr[o] * a); }
            __syncthreads();
            for (int col = tid; col < 3072; col += 512) {
                float a[16]; const float bb = fb4[col];
#pragma unroll
                for (int p = 0; p < 16; ++p) a[p] = bb;
                for (int k = 0; k < 64; ++k) { const float w = fw4[(size_t)k * 3072 + col];
#pragma unroll
                    for (int p = 0; p < 16; ++p) a[p] += h3[p * 64 + k] * w; }
                const int c = col % 768; const float mind = -3.0701134573253945f, maxd = -15.350567286626972f;
                const float delta = fabsf(mind + (maxd - mind) * ((float)c / 767.0f)); float asum = 0.f;
#pragma unroll
                for (int p = 0; p < 16; ++p) { const float t = (float)(pos0 + p) / 4095.0f; a[p] *= expf(-t * delta); asum += fabsf(a[p]); }
                f32x4* dst = (f32x4*)(HRAWT + (size_t)col * 4096 + pos0);
#pragma unroll
                for (int q = 0; q < 4; ++q) dst[q] = (f32x4){a[4 * q], a[4 * q + 1], a[4 * q + 2], a[4 * q + 3]};
                HPART[(size_t)it * 3072 + col] = asum;
            }
        }
    }
}

__device__ __forceinline__ s16x4 vtr(const LAS unsigned char* p) { typedef short v4i16_t __attribute__((ext_vector_type(4))); return __builtin_bit_cast(s16x4, __builtin_amdgcn_ds_read_tr16_b64_v4i16((LAS v4i16_t*)p)); }
__device__ __forceinline__ void na_phase(const Ctx& cx, const bf16_t* PROJ, const float* rpb, bf16_t* CAT, const int tid) {
    const int lane = tid & 63, wid = __builtin_amdgcn_readfirstlane(tid >> 6), m16 = lane & 15, q4 = lane >> 4;
    LAS unsigned char* Kb = cx.lds; LAS unsigned char* Vb = cx.lds + 73728; LAS float* biasL = (LAS float*)(cx.lds + 147456);
    constexpr int PW = 2560;
    u32x4 kv[9], vv[9]; float bpre = 0.f;
#define NA_LOAD(unit_) do { const int b_ = __builtin_amdgcn_readfirstlane((unit_) / 384), rem_ = __builtin_amdgcn_readfirstlane((unit_) % 384), h_ = rem_ >> 5, rp_ = rem_ & 31; int bs_ = 2 * rp_ - 4; bs_ = bs_ < 0 ? 0 : (bs_ > 56 ? 56 : bs_); bs_ = __builtin_amdgcn_readfirstlane(bs_); \
        _Pragma("unroll") for (int it = 0; it < 9; ++it) { const int i = tid + it * 512; const int brow = i >> 9, col = (i >> 3) & 63, ch = i & 7; int grow = bs_ + brow; grow = grow > 63 ? 63 : grow; \
            const size_t tok = (size_t)b_ * 4096 + grow * 64 + col; \
            kv[it] = *(const u32x4*)(PROJ + tok * PW + 768 + h_ * 64 + ch * 8); vv[it] = *(const u32x4*)(PROJ + tok * PW + 1536 + h_ * 64 + ch * 8); } \
        if (tid < 465) bpre = rpb[h_ * 465 + tid] * LOG2E; } while (0)
    int u0 = cx.vcu; asm volatile("" : "+s"(u0));
    if (u0 < 6144) NA_LOAD(u0);
    for (int unit = u0; unit < 6144; unit += cx.G) {
        const int b = unit / 384, rem = unit % 384, h = rem >> 5, rp = rem & 31;
        int bs = 2 * rp - 4; bs = bs < 0 ? 0 : (bs > 56 ? 56 : bs);
        __syncthreads();
#pragma unroll
        for (int it = 0; it < 9; ++it) { const int i = tid + it * 512; const int brow = i >> 9, col = (i >> 3) & 63, ch = i & 7;
            *(LAS u32x4*)(Kb + (brow * 64 + col) * 128 + ((ch ^ ((col >> 1) & 7)) << 4)) = kv[it];
            *(LAS u32x4*)(Vb + (brow * 64 + col) * 128 + ((ch ^ (col & 7)) << 4)) = vv[it]; }
        if (tid < 465) biasL[tid] = bpre;
        __syncthreads();
        if (unit + cx.G < 6144) NA_LOAD(unit + cx.G);
        const int r = 2 * rp + (wid >> 2), g = wid & 3;
        const int wc0 = (g == 0) ? 0 : (g == 1) ? 8 : (g == 2) ? 24 : 32;
        int r0 = r - 4; r0 = r0 < 0 ? 0 : (r0 > 56 ? 56 : r0); const int ro = r0 - bs;
        const int c = 16 * g + m16;
        const size_t tq = (size_t)b * 4096 + r * 64 + c;
        bf16x8 qf[2];
#pragma unroll
        for (int kk = 0; kk < 2; ++kk) qf[kk] = *(const bf16x8*)(PROJ + tq * PW + h * 64 + 32 * kk + 8 * q4);
        f32x4 S[16];
#pragma unroll
        for (int i = 0; i < 8; ++i)
#pragma unroll
            for (int ct = 0; ct < 2; ++ct) { const int col = wc0 + 16 * ct + m16; const LAS unsigned char* kp = Kb + ((ro + i) * 64 + col) * 128; const int sw = (col >> 1) & 7;
                f32x4 a = (f32x4){0.f, 0.f, 0.f, 0.f};
#pragma unroll
                for (int kk = 0; kk < 2; ++kk) { const bf16x8 kf = *(const LAS bf16x8*)(kp + (((q4 + 4 * kk) ^ sw) << 4)); a = __builtin_amdgcn_mfma_f32_16x16x32_bf16(kf, qf[kk], a, 0, 0, 0); }
                S[2 * i + ct] = a; }
        int c0 = c - 8; c0 = c0 < 0 ? 0 : (c0 > 48 ? 48 : c0);
        float mx = -INFINITY;
#pragma unroll
        for (int i = 0; i < 8; ++i)
#pragma unroll
            for (int ct = 0; ct < 2; ++ct)
#pragma unroll
                for (int v = 0; v < 4; ++v) { const int kc = wc0 + 16 * ct + 4 * q4 + v; const bool valid = (kc >= c0) && (kc < c0 + 16);
                    const int bidx = valid ? (r0 + i - r + 7) * 31 + (kc - c + 15) : 0;
                    const float s = valid ? S[2 * i + ct][v] + biasL[bidx] : -INFINITY; S[2 * i + ct][v] = s; mx = fmaxf(mx, s); }
        mx = fmaxf(mx, shflx(mx, 16, lane)); mx = fmaxf(mx, shflx(mx, 32, lane));
        float l = 0.f;
#pragma unroll
        for (int t = 0; t < 16; ++t)
#pragma unroll
            for (int v = 0; v < 4; ++v) { const float p = __builtin_amdgcn_exp2f(S[t][v] - mx); S[t][v] = p; l += p; }
        l += shflx(l, 16, lane); l += shflx(l, 32, lane);
        f32x4 O[4];
#pragma unroll
        for (int dt = 0; dt < 4; ++dt) O[dt] = (f32x4){0.f, 0.f, 0.f, 0.f};
        const int qq = m16 >> 2, pp = m16 & 3, col1 = wc0 + 4 * q4 + qq;
#pragma unroll
        for (int i = 0; i < 8; ++i) {
            u32x4 pw; pw.x = pk2(S[2 * i][0], S[2 * i][1]); pw.y = pk2(S[2 * i][2], S[2 * i][3]); pw.z = pk2(S[2 * i + 1][0], S[2 * i + 1][1]); pw.w = pk2(S[2 * i + 1][2], S[2 * i + 1][3]);
            const bf16x8 pb = __builtin_bit_cast(bf16x8, pw);
            const LAS unsigned char* v1 = Vb + ((ro + i) * 64 + col1) * 128 + 8 * (pp & 1);
            const LAS unsigned char* v2 = v1 + 16 * 128;
#pragma unroll
            for (int dt = 0; dt < 4; ++dt) { const int chunk = 2 * dt + (pp >> 1);
                const s16x4 lo = vtr(v1 + ((chunk ^ (col1 & 7)) << 4)), hi = vtr(v2 + ((chunk ^ ((col1 + 16) & 7)) << 4));
                const bf16x8 vf = (bf16x8){lo[0], lo[1], lo[2], lo[3], hi[0], hi[1], hi[2], hi[3]};
                O[dt] = __builtin_amdgcn_mfma_f32_16x16x32_bf16(vf, pb, O[dt], 0, 0, 0); }
        }
        const float inv = 1.0f / l;
#pragma unroll
        for (int dt = 0; dt < 4; ++dt) {
            if constexpr (OUTP_F8) { int w = 0; w = __builtin_amdgcn_cvt_pk_fp8_f32(O[dt][0] * inv, O[dt][1] * inv, w, false); w = __builtin_amdgcn_cvt_pk_fp8_f32(O[dt][2] * inv, O[dt][3] * inv, w, true); *(int*)((unsigned char*)CAT + tq * 1024 + h * 64 + 16 * dt + 4 * q4) = w; }
            else { u32x2 w; w.x = pk2(O[dt][0] * inv, O[dt][1] * inv); w.y = pk2(O[dt][2] * inv, O[dt][3] * inv); *(u32x2*)(CAT + tq * 1024 + h * 64 + 16 * dt + 4 * q4) = w; } }
    }
    __syncthreads();
}

#undef NA_LOAD
__device__ __forceinline__ void rope_phase(const Ctx& cx, const bf16_t* PROJ, const float* qg, const float* kg, bf16_t* QKR, const int tid) {
    const int lane = tid & 63, wave = __builtin_amdgcn_readfirstlane(tid >> 6);
    const int gw = cx.vcu * 8 + wave, NGW = cx.G * 8;
    const int d0 = (lane & 7) * 8;
    float gq[8], gk[8], invf[4];
#pragma unroll
    for (int e = 0; e < 8; ++e) { gq[e] = qg[d0 + e]; gk[e] = kg[d0 + e]; }
#pragma unroll
    for (int p = 0; p < 4; ++p) { const int i = (d0 >> 1) + p, j = i & 15; invf[p] = exp2f(-(float)(2 * j) / 32.0f * 13.287712379549449f); }
    const bool isrow = (d0 >> 1) < 16;
    for (int pos = gw; pos < SEQ; pos += NGW) {
        const float pr = isrow ? (float)(pos >> 6) : (float)(pos & 63);
        float cs[4], sn[4];
#pragma unroll
        for (int p = 0; p < 4; ++p) { const float a = pr * invf[p]; cs[p] = cosf(a); sn[p] = sinf(a); }
#pragma unroll 4
        for (int bb = 0; bb < BATCH; ++bb) { const int tok = bb * SEQ + pos;
#pragma unroll
        for (int half = 0; half < 2; ++half) {
            const int e0 = half * 512 + lane * 8; const int head = e0 >> 6; const bool isq = head < 12;
            const u32x4 raw = *(const u32x4*)(PROJ + (size_t)tok * 1536 + e0);
            float x[8]; x[0] = bflo(raw.x); x[1] = bfhi(raw.x); x[2] = bflo(raw.y); x[3] = bfhi(raw.y); x[4] = bflo(raw.z); x[5] = bfhi(raw.z); x[6] = bflo(raw.w); x[7] = bfhi(raw.w);
            float ss = 0.f;
#pragma unroll
            for (int e = 0; e < 8; ++e) ss += x[e] * x[e];
            ss = group8_sum(ss);
            const float inv = rsqrtf(ss * (1.0f / 64.0f) + 1e-6f);
            float y[8];
#pragma unroll
            for (int e = 0; e < 8; ++e) y[e] = x[e] * inv * (isq ? gq[e] : gk[e]);
            const float sc = isq ? C2 : 1.0f;
            float o[8];
#pragma unroll
            for (int p = 0; p < 4; ++p) { o[2 * p] = (y[2 * p] * cs[p] - y[2 * p + 1] * sn[p]) * sc; o[2 * p + 1] = (y[2 * p] * sn[p] + y[2 * p + 1] * cs[p]) * sc; }
            u32x4 w; w.x = pk2(o[0], o[1]); w.y = pk2(o[2], o[3]); w.z = pk2(o[4], o[5]); w.w = pk2(o[6], o[7]);
            *(u32x4*)(QKR + (size_t)tok * 1024 + e0) = w;
        } }
    }
}

__device__ __forceinline__ void sconv_phase(const Ctx& cx, const bf16_t* PROJ, const float* cw, const float* cb, bf16_t* UT3, unsigned char* V8, const int tid) {
    const int lane = tid & 63, wave = __builtin_amdgcn_readfirstlane(tid >> 6);
    const int gw = cx.vcu * 8 + wave, NGW = cx.G * 8;
    LAS unsigned short* tile = (LAS unsigned short*)(cx.lds + wave * 9216);
    constexpr int PW = 2560;
    for (int it = gw; it < 16 * 64 * 36; it += NGW) {
        const int ct = it % 36, tt = (it / 36) & 63, b = it / (36 * 64);
        const int col = ct * 64 + lane, t0 = tt * 64;
        const float w0 = cw[col], w1 = cw[2304 + col], w2 = cw[4608 + col], bia = cb[col];
        const bf16_t* src = PROJ + ((size_t)b * 4096 + t0) * PW + col;
        unsigned short uu[66];
        uu[0] = (t0 > 0) ? src[-(long)PW] : (unsigned short)0;
#pragma unroll
        for (int k = 0; k < 64; ++k) uu[k + 1] = src[(size_t)k * PW];
        uu[65] = (t0 + 64 < 4096) ? src[(size_t)64 * PW] : (unsigned short)0;
#pragma unroll
        for (int k = 0; k < 64; ++k) { const float v = bf2f(uu[k]) * w0 + bf2f(uu[k + 1]) * w1 + bf2f(uu[k + 2]) * w2 + bia; tile[lane * 72 + k] = (unsigned short)f2bf(v); }
        LDS_WAIT(); asm volatile("" ::: "memory");
        const int part = (ct * 64) / 768, cbase = (ct * 64) % 768;
#pragma unroll
        for (int k = 0; k < 8; ++k) { const int row = k * 8 + (lane >> 3), chn = lane & 7;
            const u32x4 v = *(const LAS u32x4*)((const LAS unsigned char*)tile + row * 144 + chn * 16);
            *(u32x4*)(UT3 + (((size_t)part * 16 + b) * 768 + cbase + row) * 4096 + t0 + chn * 8) = v;
            if (TCONV_F8 && part == 0) { int w0 = 0, w1 = 0;
                w0 = __builtin_amdgcn_cvt_pk_fp8_f32(bflo(v.x), bfhi(v.x), w0, false); w0 = __builtin_amdgcn_cvt_pk_fp8_f32(bflo(v.y), bfhi(v.y), w0, true);
                w1 = __builtin_amdgcn_cvt_pk_fp8_f32(bflo(v.z), bfhi(v.z), w1, false); w1 = __builtin_amdgcn_cvt_pk_fp8_f32(bflo(v.w), bfhi(v.w), w1, true);
                *(u32x2*)(V8 + ((size_t)b * 768 + cbase + row) * 4096 + t0 + chn * 8) = (u32x2){(unsigned)w0, (unsigned)w1}; } }
        LDS_WAIT(); asm volatile("" ::: "memory");
    }
}

constexpr int TZ_CS = 16384 + 64;
__device__ __forceinline__ void tconv_phase(const Ctx& cx, const int o, const bf16_t* UT, const bf16_t* GT, bf16_t* ZT, const float* lbias  , const int tid) {
    const int lane = tid & 63, wid = __builtin_amdgcn_readfirstlane(tid >> 6), m16 = lane & 15, q4 = lane >> 4;
    const float* HRAWT = (const float*)(cx.ws + WS_HRAWT); const float* HPART = (const float*)(cx.ws + WS_HPART);
    LAS unsigned char* cp = cx.lds; LAS float* red = (LAS float*)(cx.lds + 8 * TZ_CS);
    for (int c = cx.vcu; c < 768; c += cx.G) {
        __syncthreads();
        { const int dir = tid >> 8, blk = tid & 255; float v = HPART[(size_t)blk * 3072 + dir * 1536 + o * 768 + c]; v = wave_sum(v, lane); if (lane == 0) red[wid] = v; }
        __syncthreads();
        float nrm = 0.f;
#pragma unroll
        for (int w = 0; w < 8; ++w) nrm += red[w];
        const float inv = 1.0f / nrm;
        const float* hf = HRAWT + (size_t)(o * 768 + c) * 4096; const float* hb = HRAWT + (size_t)(1536 + o * 768 + c) * 4096;
        for (int i = tid; i < 8192; i += 512) { float v; if (i < 4096) v = hf[4095 - i]; else if (i < 8191) v = hb[i - 4095]; else v = 0.f;
            *(LAS unsigned short*)(cp + 2 * i) = (unsigned short)f2bf(v * inv); }
        __syncthreads();
#pragma unroll
        for (int j = 1; j < 8; ++j)
            for (int n = tid; n < 1024; n += 512) {
                const u32x4 lo = *(const LAS u32x4*)(cp + n * 16); u32x4 hi = (u32x4){0u, 0u, 0u, 0u}; if (n + 1 < 1024) hi = *(const LAS u32x4*)(cp + (n + 1) * 16);
                const unsigned w[8] = {lo.x, lo.y, lo.z, lo.w, hi.x, hi.y, hi.z, hi.w}; u32x4 r;
                const int a = j >> 1;
                if (j & 1) { r.x = (w[a] >> 16) | (w[a + 1] << 16); r.y = (w[a + 1] >> 16) | (w[a + 2] << 16); r.z = (w[a + 2] >> 16) | (w[a + 3] << 16); r.w = (w[a + 3] >> 16) | (w[a + 4] << 16); }
                else { r.x = w[a]; r.y = w[a + 1]; r.z = w[a + 2]; r.w = w[a + 3]; }
                *(LAS u32x4*)(cp + j * TZ_CS + n * 16) = r;
            }
        __syncthreads();
        const int j = (7 - m16) & 7;
        const int nbase = (4095 - 512 * wid - m16 - j + 8 * q4) >> 3;
        const LAS unsigned char* ap = cp + j * TZ_CS + (nbase - 62) * 16;
        const bf16_t* up = UT + ((size_t)m16 * 768 + c) * 4096 + 8 * q4;
        f32x4 acc[32];
#pragma unroll
        for (int ti = 0; ti < 32; ++ti) acc[ti] = (f32x4){0.f, 0.f, 0.f, 0.f};
        bf16x8 bcur = *(const bf16x8*)(up);
        bf16x8 afA[8], afB[8];
#pragma unroll
        for (int i = 0; i < 8; ++i) afA[i] = *(const LAS bf16x8*)(ap + (31 - i) * 32);
        for (int ks = 0; ks < 128; ++ks) {
            const bf16x8 bnext = *(const bf16x8*)(up + ((ks + 1) & 127) * 32);
            const LAS unsigned char* a0 = ap + ks * 64;
            const LAS unsigned char* a1 = ap + ((ks + 1) & 127) * 64;
#define TZ_LD(dst, base, g) do { _Pragma("unroll") for (int i = 0; i < 8; ++i) dst[i] = *(const LAS bf16x8*)((base) + (31 - (8 * (g) + i)) * 32); } while (0)
#define TZ_MM(src, g) do { _Pragma("unroll") for (int i = 0; i < 8; ++i) acc[8 * (g) + i] = __builtin_amdgcn_mfma_f32_16x16x32_bf16(src[i], bcur, acc[8 * (g) + i], 0, 0, 0); } while (0)
            TZ_LD(afB, a0, 1); TZ_MM(afA, 0); __builtin_amdgcn_sched_barrier(0);
            TZ_LD(afA, a0, 2); TZ_MM(afB, 1); __builtin_amdgcn_sched_barrier(0);
            TZ_LD(afB, a0, 3); TZ_MM(afA, 2); __builtin_amdgcn_sched_barrier(0);
            TZ_LD(afA, a1, 0); TZ_MM(afB, 3); __builtin_amdgcn_sched_barrier(0);
#undef TZ_LD
#undef TZ_MM
            bcur = bnext;
        }
        const float lb = lbias[c];
        const size_t rowoff = ((size_t)m16 * 768 + c) * 4096 + 512 * wid + 4 * q4;
#pragma unroll
        for (int ti = 0; ti < 32; ++ti) {
            const u32x2 uu = *(const u32x2*)(UT + rowoff + 16 * ti), gg = *(const u32x2*)(GT + rowoff + 16 * ti);
            const float y0 = (acc[ti][0] + lb * bflo(uu.x)) * bflo(gg.x), y1 = (acc[ti][1] + lb * bfhi(uu.x)) * bfhi(gg.x), y2 = (acc[ti][2] + lb * bflo(uu.y)) * bflo(gg.y), y3 = (acc[ti][3] + lb * bfhi(uu.y)) * bfhi(gg.y);
            u32x2 w; w.x = pk2(y0, y1); w.y = pk2(y2, y3);
            *(u32x2*)(ZT + rowoff + 16 * ti) = w;
            if ((ti & 7) == 7) __builtin_amdgcn_sched_barrier(0);
        }
    }
    __syncthreads();
}

constexpr int T8_CS = 8192 + 256;
__host__ __device__ constexpr int t8_sig(int j) { return j < 4 ? 2 * j : (j >= 12 ? 2 * (j - 8) : 2 * (j - 4) + 1); }
__device__ __forceinline__ float wave_max_nn(float v) {
    v = fmaxf(v, dpp_x<0xB1>(v)); v = fmaxf(v, dpp_x<0x4E>(v)); v = fmaxf(v, dpp_x<0x141>(v)); v = fmaxf(v, dpp_x<0x140>(v));
    v = fmaxf(v, __builtin_bit_cast(float, __builtin_amdgcn_update_dpp(0, __builtin_bit_cast(int, v), 0x142, 0xA, 0xF, false)));
    v = fmaxf(v, __builtin_bit_cast(float, __builtin_amdgcn_update_dpp(0, __builtin_bit_cast(int, v), 0x143, 0xC, 0xF, false)));
    return __builtin_bit_cast(float, __builtin_amdgcn_readlane(__builtin_bit_cast(int, v), 63));
}
__device__ __forceinline__ void tconv8_phase(const Ctx& cx, const int o, const bf16_t* UT, const unsigned char* U8, const bf16_t* GT, bf16_t* ZT, unsigned char* Z8  ,
                                             const float* lbias, const int tid) {
    const int lane = tid & 63, wid = __builtin_amdgcn_readfirstlane(tid >> 6), m16 = lane & 15, q4 = lane >> 4;
    const float* HRAWT = (const float*)(cx.ws + WS_HRAWT); const float* HPART = (const float*)(cx.ws + WS_HPART);
    LAS unsigned char* cp = cx.lds; LAS float* red = (LAS float*)(cx.lds + 16 * T8_CS);
    for (int c = cx.vcu; c < 768; c += cx.G) {
        __syncthreads();
        const float* hf = HRAWT + (size_t)(o * 768 + c) * 4096; const float* hb = HRAWT + (size_t)(1536 + o * 768 + c) * 4096;
        float tap[16]; float mx = 0.f;
        int t3 = tid; asm volatile("" : "+v"(t3));
#pragma unroll
        for (int k = 0; k < 16; ++k) { const int i = t3 * 16 + k; float v; if (i < 4096) v = hf[4095 - i]; else if (i < 8191) v = hb[i - 4095]; else v = 0.f; tap[k] = v; mx = fmaxf(mx, fabsf(v)); }
        { const int dir = tid >> 8, blk = tid & 255; float v = HPART[(size_t)blk * 3072 + dir * 1536 + o * 768 + c]; v = wave_sum(v, lane); mx = wave_max_nn(mx); if (lane == 0) { red[wid] = v; red[8 + wid] = mx; } }
        __syncthreads();
        float nrm = 0.f, mall = 0.f;
#pragma unroll
        for (int w = 0; w < 8; ++w) { nrm += red[w]; mall = fmaxf(mall, red[8 + w]); }
        const float inv = 1.0f / nrm;
        int ex; (void)frexpf(fmaxf(mall * inv, 1e-30f), &ex);
        const float fsc = ldexpf(1.0f, 7 - ex), unsc = ldexpf(1.0f, ex - 7), tsc = inv * fsc;
        { unsigned w[4];
#pragma unroll
          for (int q = 0; q < 4; ++q) { int r = 0; r = __builtin_amdgcn_cvt_pk_fp8_f32(tap[4 * q] * tsc, tap[4 * q + 1] * tsc, r, false); r = __builtin_amdgcn_cvt_pk_fp8_f32(tap[4 * q + 2] * tsc, tap[4 * q + 3] * tsc, r, true); w[q] = (unsigned)r; }
          *(LAS u32x4*)(cp + tid * 16) = (u32x4){w[0], w[1], w[2], w[3]}; }
        __syncthreads();
        { const u32x4 lo = *(const LAS u32x4*)(cp + tid * 16); u32x4 hi = (u32x4){0u, 0u, 0u, 0u}; if (tid + 1 < 512) hi = *(const LAS u32x4*)(cp + (tid + 1) * 16);
          const unsigned w[8] = {lo.x, lo.y, lo.z, lo.w, hi.x, hi.y, hi.z, hi.w};
#pragma unroll
          for (int j = 1; j < 16; ++j) { u32x4 r; const int a = j >> 2, sh = j & 3;
              r.x = sh ? __builtin_amdgcn_alignbyte(w[a + 1], w[a], sh) : w[a]; r.y = sh ? __builtin_amdgcn_alignbyte(w[a + 2], w[a + 1], sh) : w[a + 1];
              r.z = sh ? __builtin_amdgcn_alignbyte(w[a + 3], w[a + 2], sh) : w[a + 2]; r.w = sh ? __builtin_amdgcn_alignbyte(w[a + 4], w[a + 3], sh) : w[a + 3];
              *(LAS u32x4*)(cp + j * T8_CS + t8_sig(j) * 16 + tid * 16) = r; } }
        __syncthreads();
        const int jc = 15 - m16;
        const int nbase = 255 - 32 * wid + 2 * q4;
        const LAS unsigned char* ap = cp + jc * T8_CS + t8_sig(jc) * 16 + (nbase - 31) * 16;
        const unsigned char* up = U8 + ((size_t)m16 * 768 + c) * 4096 + 32 * q4;
        f32x4 acc[32];
#pragma unroll
        for (int ti = 0; ti < 32; ++ti) acc[ti] = (f32x4){0.f, 0.f, 0.f, 0.f};
        typedef int v8i_t __attribute__((ext_vector_type(8))); typedef int v4i_t __attribute__((ext_vector_type(4)));
#define T8_FRAG(p) __builtin_shufflevector(*(const LAS v4i_t*)(p), *(const LAS v4i_t*)((p) + 16), 0, 1, 2, 3, 4, 5, 6, 7)
        v8i_t bcur = __builtin_shufflevector(*(const v4i_t*)(up), *(const v4i_t*)(up + 16), 0, 1, 2, 3, 4, 5, 6, 7);
        v8i_t afA[4], afB[4];
#pragma unroll
        for (int i = 0; i < 4; ++i) afA[i] = T8_FRAG(ap + (31 - i) * 16);
        for (int ks = 0; ks < 32; ++ks) {
            const unsigned char* un = up + ((ks + 1) & 31) * 128;
            const v8i_t bnext = __builtin_shufflevector(*(const v4i_t*)(un), *(const v4i_t*)(un + 16), 0, 1, 2, 3, 4, 5, 6, 7);
            const LAS unsigned char* a0 = ap + ks * 128;
            const LAS unsigned char* a1 = ap + ((ks + 1) & 31) * 128;
#define T8_LD(dst, base, g) do { _Pragma("unroll") for (int i = 0; i < 4; ++i) dst[i] = T8_FRAG((base) + (31 - (4 * (g) + i)) * 16); } while (0)
#define T8_MM(src, g) do { _Pragma("unroll") for (int i = 0; i < 4; ++i) acc[4 * (g) + i] = __builtin_amdgcn_mfma_scale_f32_16x16x128_f8f6f4(src[i], bcur, acc[4 * (g) + i], 0, 0, 0, 0, 0, 0); } while (0)
            T8_LD(afB, a0, 1); T8_MM(afA, 0); __builtin_amdgcn_sched_barrier(0);
            T8_LD(afA, a0, 2); T8_MM(afB, 1); __builtin_amdgcn_sched_barrier(0);
            T8_LD(afB, a0, 3); T8_MM(afA, 2); __builtin_amdgcn_sched_barrier(0);
            T8_LD(afA, a0, 4); T8_MM(afB, 3); __builtin_amdgcn_sched_barrier(0);
            T8_LD(afB, a0, 5); T8_MM(afA, 4); __builtin_amdgcn_sched_barrier(0);
            T8_LD(afA, a0, 6); T8_MM(afB, 5); __builtin_amdgcn_sched_barrier(0);
            T8_LD(afB, a0, 7); T8_MM(afA, 6); __builtin_amdgcn_sched_barrier(0);
            T8_LD(afA, a1, 0); T8_MM(afB, 7); __builtin_amdgcn_sched_barrier(0);
#undef T8_LD
#undef T8_MM
            bcur = bnext;
        }
#undef T8_FRAG
        const float lb = lbias[c];
        const size_t rowoff = ((size_t)m16 * 768 + c) * 4096 + 512 * wid + 4 * q4;
#pragma unroll
        for (int ti = 0; ti < 32; ++ti) {
            const u32x2 uu = *(const u32x2*)(UT + rowoff + 16 * ti), gg = *(const u32x2*)(GT + rowoff + 16 * ti);
            const float y0 = (acc[ti][0] * unsc + lb * bflo(uu.x)) * bflo(gg.x), y1 = (acc[ti][1] * unsc + lb * bfhi(uu.x)) * bfhi(gg.x), y2 = (acc[ti][2] * unsc + lb * bflo(uu.y)) * bflo(gg.y), y3 = (acc[ti][3] * unsc + lb * bfhi(uu.y)) * bfhi(gg.y);
            u32x2 w; w.x = pk2(y0, y1); w.y = pk2(y2, y3);
            *(u32x2*)(ZT + rowoff + 16 * ti) = w;
            if (Z8) { int w8 = 0; w8 = __builtin_amdgcn_cvt_pk_fp8_f32(fminf(fmaxf(y0, -440.f), 440.f), fminf(fmaxf(y1, -440.f), 440.f), w8, false); w8 = __builtin_amdgcn_cvt_pk_fp8_f32(fminf(fmaxf(y2, -440.f), 440.f), fminf(fmaxf(y3, -440.f), 440.f), w8, true);
                *(int*)(Z8 + rowoff + 16 * ti) = w8; }
            if ((ti & 7) == 7) __builtin_amdgcn_sched_barrier(0);
        }
    }
    __syncthreads();
}

__device__ __forceinline__ void tback_phase(const Ctx& cx, const bf16_t* ZT, bf16_t* CAT, const int tid) {
    const int lane = tid & 63, wave = __builtin_amdgcn_readfirstlane(tid >> 6);
    const int gw = cx.vcu * 8 + wave, NGW = cx.G * 8;
    LAS unsigned char* tile = cx.lds + wave * 9216;
    for (int it = gw; it < 16 * 12 * 64; it += NGW) {
        const int tt = it & 63, ct = (it >> 6) % 12, b = it / (64 * 12);
        const int c0 = ct * 64, t0 = tt * 64;
#pragma unroll
        for (int k = 0; k < 8; ++k) { const int row = k * 8 + (lane >> 3), chn = lane & 7;
            const u32x4 v = *(const u32x4*)(ZT + ((size_t)b * 768 + c0 + row) * 4096 + t0 + chn * 8);
            *(LAS u32x4*)(tile + row * 144 + chn * 16) = v; }
        LDS_WAIT(); asm volatile("" ::: "memory");
        if constexpr (OUTP_F8) { unsigned char* dst = (unsigned char*)CAT + ((size_t)b * 4096 + t0) * 1024 + c0 + lane;
#pragma unroll 8
            for (int k = 0; k < 64; ++k) { const float v = bf2f(*(const LAS unsigned short*)(tile + lane * 144 + k * 2)); dst[(size_t)k * 1024] = f2fp8(fminf(fmaxf(v, -440.0f), 440.0f)); }
        } else { bf16_t* dst = CAT + ((size_t)b * 4096 + t0) * 1024 + c0 + lane;
#pragma unroll 8
            for (int k = 0; k < 64; ++k) dst[(size_t)k * 1024] = *(const LAS unsigned short*)(tile + lane * 144 + k * 2); }
        LDS_WAIT(); asm volatile("" ::: "memory");
    }
}

__device__ __forceinline__ void ln1_group(const int bt, const int chunk, const int wave, const int lane, const int r16, const int q4, const bf16_t* XI, bf16_t* XO, bf16_t* XB, const float* g, const float* bta,
                                          const LAS unsigned char* Wh, const LAS unsigned char* Wl, LAS float* lg, LAS int* lcnt, const float rb0, const float rb1, float* gate, unsigned (&pk)[2], unsigned (&gp)[2]) {
    constexpr int WP = 2064;
            const size_t rowU = (size_t)chunk * 256 + wave * 32 + bt * 16;
            unsigned loff = (unsigned)(r16 * 1024 + 8 * q4); asm volatile("" : "+v"(loff));
            const GAS bf16_t* src = (const GAS bf16_t*)XI + rowU * 1024 + loff;
            constexpr int HOLD = LN1_HOLD;
            u32x4 raw[HOLD > 0 ? HOLD : 1], rawt[32 - HOLD]; float s = 0.f, ss = 0.f;
#pragma unroll
            for (int i = 0; i < 32; ++i) { if (i < HOLD) raw[i] = *(const GAS u32x4*)(src + 32 * i); else rawt[i - HOLD] = *(const GAS u32x4*)(src + 32 * i); }
#pragma unroll
            for (int i = 0; i < 32; ++i) { const u32x4 rr = (i < HOLD) ? raw[i < HOLD ? i : 0] : rawt[i < HOLD ? 0 : i - HOLD]; const float x0 = bflo(rr.x), x1 = bfhi(rr.x), x2 = bflo(rr.y), x3 = bfhi(rr.y), x4 = bflo(rr.z), x5 = bfhi(rr.z), x6 = bflo(rr.w), x7 = bfhi(rr.w);
                s += ((x0 + x1) + (x2 + x3)) + ((x4 + x5) + (x6 + x7)); ss += ((x0 * x0 + x1 * x1) + (x2 * x2 + x3 * x3)) + ((x4 * x4 + x5 * x5) + (x6 * x6 + x7 * x7)); }
            lg[2 * lane] = s; lg[2 * lane + 1] = ss; LDS_WAIT(); asm volatile("" ::: "memory");
            s = (lg[2 * r16] + lg[2 * (r16 + 16)]) + (lg[2 * (r16 + 32)] + lg[2 * (r16 + 48)]); ss = (lg[2 * r16 + 1] + lg[2 * (r16 + 16) + 1]) + (lg[2 * (r16 + 32) + 1] + lg[2 * (r16 + 48) + 1]);
            LDS_WAIT(); asm volatile("" ::: "memory");
            const float mean = s * (1.0f / 1024.0f), rstd = rsqrtf(fmaxf(ss * (1.0f / 1024.0f) - mean * mean, 0.f) + LN_EPS);
            f32x4 a0 = (f32x4){0.f, 0.f, 0.f, 0.f}, a1 = (f32x4){0.f, 0.f, 0.f, 0.f};
            const LAS unsigned char* wh0 = Wh + r16 * WP + 16 * q4; const LAS unsigned char* wl0 = Wl + r16 * WP + 16 * q4;
            GAS bf16_t* dsto = (GAS bf16_t*)XO + rowU * 1024 + loff; GAS unsigned char* dst8 = (GAS unsigned char*)XB + rowU * 1024 + loff;
#pragma unroll
            for (int i = 0; i < 32; ++i) {
                const GAS float* gp_ = (const GAS float*)g + 32 * i + 8 * q4; const GAS float* bp_ = (const GAS float*)bta + 32 * i + 8 * q4;
                const f32x4 g0 = *(const GAS f32x4*)gp_, g1 = *(const GAS f32x4*)(gp_ + 4), b0 = *(const GAS f32x4*)bp_, b1 = *(const GAS f32x4*)(bp_ + 4);
                u32x4 rw_; if (i < HOLD) rw_ = raw[i < HOLD ? i : 0]; else rw_ = *(const GAS u32x4*)(src + 32 * i); asm volatile("" : "+v"(rw_));
                float y[8]; y[0] = bflo(rw_.x); y[1] = bfhi(rw_.x); y[2] = bflo(rw_.y); y[3] = bfhi(rw_.y); y[4] = bflo(rw_.z); y[5] = bfhi(rw_.z); y[6] = bflo(rw_.w); y[7] = bfhi(rw_.w);
#pragma unroll
                for (int q = 0; q < 8; ++q) y[q] = (y[q] - mean) * rstd * (q < 4 ? g0[q & 3] : g1[q & 3]) + (q < 4 ? b0[q & 3] : b1[q & 3]);
                u32x4 hi; hi.x = pk2(y[0], y[1]); hi.y = pk2(y[2], y[3]); hi.z = pk2(y[4], y[5]); hi.w = pk2(y[6], y[7]);
                *(GAS u32x4*)(dsto + 32 * i) = hi;
                if constexpr (MOE_F8) { int w0 = 0, w1 = 0; w0 = __builtin_amdgcn_cvt_pk_fp8_f32(y[0], y[1], w0, false); w0 = __builtin_amdgcn_cvt_pk_fp8_f32(y[2], y[3], w0, true); w1 = __builtin_amdgcn_cvt_pk_fp8_f32(y[4], y[5], w1, false); w1 = __builtin_amdgcn_cvt_pk_fp8_f32(y[6], y[7], w1, true);
                    *(GAS u32x2*)(dst8 + 32 * i) = (u32x2){(unsigned)w0, (unsigned)w1}; }
                else { *(u32x4*)((bf16_t*)XB + rowU * 1024 + loff + 32 * i) = hi; }
                u32x4 lo; lo.x = pk2(y[0] - bflo(hi.x), y[1] - bfhi(hi.x)); lo.y = pk2(y[2] - bflo(hi.y), y[3] - bfhi(hi.y)); lo.z = pk2(y[4] - bflo(hi.z), y[5] - bfhi(hi.z)); lo.w = pk2(y[6] - bflo(hi.w), y[7] - bfhi(hi.w));
                const bf16x8 ah = __builtin_bit_cast(bf16x8, hi), al = __builtin_bit_cast(bf16x8, lo);
                const bf16x8 wh_0 = *(const LAS bf16x8*)(wh0 + 64 * i), wh_1 = *(const LAS bf16x8*)(wh0 + 16 * WP + 64 * i), wl_0 = *(const LAS bf16x8*)(wl0 + 64 * i), wl_1 = *(const LAS bf16x8*)(wl0 + 16 * WP + 64 * i);
                a0 = __builtin_amdgcn_mfma_f32_16x16x32_bf16(ah, wh_0, a0, 0, 0, 0); a1 = __builtin_amdgcn_mfma_f32_16x16x32_bf16(ah, wh_1, a1, 0, 0, 0);
                a0 = __builtin_amdgcn_mfma_f32_16x16x32_bf16(al, wh_0, a0, 0, 0, 0); a1 = __builtin_amdgcn_mfma_f32_16x16x32_bf16(al, wh_1, a1, 0, 0, 0);
                a0 = __builtin_amdgcn_mfma_f32_16x16x32_bf16(ah, wl_0, a0, 0, 0, 0); a1 = __builtin_amdgcn_mfma_f32_16x16x32_bf16(ah, wl_1, a1, 0, 0, 0);
                asm volatile("" :: "v"(ah), "v"(al), "v"(wh_0), "v"(wh_1), "v"(wl_0), "v"(wl_1));
                __builtin_amdgcn_sched_barrier(0);
            }
#pragma unroll
            for (int v = 0; v < 4; ++v) { lg[(4 * q4 + v) * 33 + r16] = a0[v] + rb0; lg[(4 * q4 + v) * 33 + r16 + 16] = a1[v] + rb1; }
            LDS_WAIT(); asm volatile("" ::: "memory");
            if (lane < 16) {
                const LAS float* myl = lg + lane * 33; const size_t rowt = (size_t)chunk * 256 + wave * 32 + bt * 16 + lane;
                float tv[4]; int te[4]; int t0 = -1, t1 = -1, t2 = -1;
#pragma unroll
                for (int k = 0; k < 4; ++k) { float best = -INFINITY; int bi = 0;
                    for (int e = 0; e < 32; ++e) { const float v = myl[e]; const bool ok = (e != t0) && (e != t1) && (e != t2); if (ok && v > best) { best = v; bi = e; } }
                    tv[k] = best; te[k] = bi; if (k == 0) t0 = bi; else if (k == 1) t1 = bi; else if (k == 2) t2 = bi; }
                const float e1 = __expf(tv[1] - tv[0]), e2 = __expf(tv[2] - tv[0]), e3 = __expf(tv[3] - tv[0]); const float isum = 1.0f / (1.0f + e1 + e2 + e3);
                const float gk[4] = {isum, e1 * isum, e2 * isum, e3 * isum};
                pk[0] = 0u; pk[1] = 0u;
#pragma unroll
                for (int k = 0; k < 4; ++k) { const int rk = __hip_atomic_fetch_add(lcnt + te[k], 1, __ATOMIC_RELAXED, __HIP_MEMORY_SCOPE_WORKGROUP); pk[k >> 1] |= (unsigned)((te[k] << 11) | rk) << (16 * (k & 1)); }
                gp[0] = pk2(gk[0], gk[1]); gp[1] = pk2(gk[2], gk[3]); (void)rowt; (void)gate;
            }
            LDS_WAIT(); asm volatile("" ::: "memory");
}
__device__ __forceinline__ void ln1_router_phase(const Ctx& cx, const bf16_t* XI, bf16_t* XO, bf16_t* XB, const float* g, const float* bta, const float* rw, const float* rb,
                                                 unsigned* cnt, int* expid, float* gate, int* idx, float* gidx, const int tid) {
    const int lane = tid & 63, wave = __builtin_amdgcn_readfirstlane(tid >> 6), r16 = lane & 15, q4 = lane >> 4;
    constexpr int WP = 2064;
    LAS unsigned char* Wh = cx.lds; LAS unsigned char* Wl = cx.lds + 32 * WP; LAS int* lcnt = (LAS int*)(cx.lds + 64 * WP); LAS int* lbase = lcnt + 32; LAS float* lg = (LAS float*)(cx.lds + 64 * WP + 256 + wave * 2112);
    __syncthreads();
    for (int i = tid; i < 32768; i += 512) { const int k = i >> 5, e = i & 31; const float w = rw[i]; const unsigned hi = f2bf(w); const float wl = w - bf2f((unsigned short)hi);
        *(LAS unsigned short*)(Wh + e * WP + 2 * k) = (unsigned short)hi; *(LAS unsigned short*)(Wl + e * WP + 2 * k) = (unsigned short)f2bf(wl); }
    if (tid < 32) lcnt[tid] = 0;
    const float rb0 = rb[r16], rb1 = rb[r16 + 16];
    __syncthreads();
    for (int chunk = cx.vcu; chunk < NTOK / 256; chunk += cx.G) {
        unsigned pk0[2] = {0u, 0u}, pk1[2] = {0u, 0u}, gp0[2] = {0u, 0u}, gp1[2] = {0u, 0u};
        ln1_group(0, chunk, wave, lane, r16, q4, XI, XO, XB, g, bta, Wh, Wl, lg, lcnt, rb0, rb1, gate, pk0, gp0);
        ln1_group(1, chunk, wave, lane, r16, q4, XI, XO, XB, g, bta, Wh, Wl, lg, lcnt, rb0, rb1, gate, pk1, gp1);
        __syncthreads();
        { int t2 = tid; asm volatile("" : "+v"(t2));
          if (t2 < 32) { lbase[t2] = (int)__hip_atomic_fetch_add(cnt + t2, (unsigned)lcnt[t2], __ATOMIC_RELAXED, __HIP_MEMORY_SCOPE_AGENT); } }
        __syncthreads();
        const int ln_ = lane_id_volatile();
        if (ln_ < 16) {
            { const int slot0 = (chunk * 256 + wave * 32 + ln_) * 4;
#pragma unroll
                for (int k = 0; k < 4; ++k) { const unsigned p = (pk0[k >> 1] >> (16 * (k & 1))) & 0xffffu; const int e = (int)(p >> 11), rk = (int)(p & 0x7ffu); const size_t o_ = (size_t)e * IDXCAP + lbase[e] + rk; idx[o_] = slot0 + k; gidx[o_] = (k & 1) ? bfhi(gp0[k >> 1]) : bflo(gp0[k >> 1]); } }
            { const int slot0 = (chunk * 256 + wave * 32 + 16 + ln_) * 4;
#pragma unroll
                for (int k = 0; k < 4; ++k) { const unsigned p = (pk1[k >> 1] >> (16 * (k & 1))) & 0xffffu; const int e = (int)(p >> 11), rk = (int)(p & 0x7ffu); const size_t o_ = (size_t)e * IDXCAP + lbase[e] + rk; idx[o_] = slot0 + k; gidx[o_] = (k & 1) ? bfhi(gp1[k >> 1]) : bflo(gp1[k >> 1]); } }
        }
        __syncthreads();
        if (tid < 32) lcnt[tid] = 0;
        __syncthreads();
    }
}

__device__ __forceinline__ void ln2_phase(const Ctx& cx, const bf16_t* X1, const bf16_t* Y, bf16_t* XO, bf16_t* XB, float* OUT, const float* g, const float* bta, const int tid) {
    const int lane = tid & 63, wave = __builtin_amdgcn_readfirstlane(tid >> 6);
    const int gw = cx.vcu * 8 + wave, NGW = cx.G * 8;
    if constexpr (Y_F8) {
        for (int rp = gw; rp < NTOK / 2; rp += NGW) {
            u32x4 xa[2][2], ya[2][4];
#pragma unroll
            for (int r = 0; r < 2; ++r) { const size_t row = (size_t)rp * 2 + r;
                xa[r][0] = *(const u32x4*)(X1 + row * 1024 + 16 * lane); xa[r][1] = *(const u32x4*)(X1 + row * 1024 + 16 * lane + 8);
#pragma unroll
                for (int k = 0; k < 4; ++k) ya[r][k] = *(const u32x4*)((const unsigned char*)Y + (row * 4 + k) * 1024 + 16 * lane); }
            float v[2][16]; float s[2] = {0.f, 0.f};
#pragma unroll
            for (int r = 0; r < 2; ++r) {
#pragma unroll
                for (int i = 0; i < 4; ++i) { f32x2 lo = __builtin_amdgcn_cvt_pk_f32_fp8((int)ya[r][0][i], false), hi = __builtin_amdgcn_cvt_pk_f32_fp8((int)ya[r][0][i], true);
#pragma unroll
                    for (int k = 1; k < 4; ++k) { lo += __builtin_amdgcn_cvt_pk_f32_fp8((int)ya[r][k][i], false); hi += __builtin_amdgcn_cvt_pk_f32_fp8((int)ya[r][k][i], true); }
                    const unsigned xlo = xa[r][i >> 1][(i & 1) * 2], xhi = xa[r][i >> 1][(i & 1) * 2 + 1];
                    v[r][4 * i + 0] = bflo(xlo) * DN_ALPHA + lo[0] * (1.0f / Y_SCALE); v[r][4 * i + 1] = bfhi(xlo) * DN_ALPHA + lo[1] * (1.0f / Y_SCALE);
                    v[r][4 * i + 2] = bflo(xhi) * DN_ALPHA + hi[0] * (1.0f / Y_SCALE); v[r][4 * i + 3] = bfhi(xhi) * DN_ALPHA + hi[1] * (1.0f / Y_SCALE);
                    s[r] += (v[r][4 * i] + v[r][4 * i + 1]) + (v[r][4 * i + 2] + v[r][4 * i + 3]); } }
            const float mean0 = wave_sum(s[0], lane) * (1.0f / 1024.0f), mean1 = wave_sum(s[1], lane) * (1.0f / 1024.0f); float q[2] = {0.f, 0.f};
#pragma unroll
            for (int r = 0; r < 2; ++r)
#pragma unroll
                for (int e = 0; e < 16; ++e) { v[r][e] -= (r == 0 ? mean0 : mean1); q[r] += v[r][e] * v[r][e]; }
            const float rstd0 = rsqrtf(wave_sum(q[0], lane) * (1.0f / 1024.0f) + LN_EPS), rstd1 = rsqrtf(wave_sum(q[1], lane) * (1.0f / 1024.0f) + LN_EPS);
            unsigned wb[2][8]; unsigned w8[2][4];
#pragma unroll
            for (int j = 0; j < 4; ++j) { const f32x4 gvj = *(const f32x4*)(g + 16 * lane + 4 * j), bvj = *(const f32x4*)(bta + 16 * lane + 4 * j);
#pragma unroll
                for (int r = 0; r < 2; ++r) { const size_t row = (size_t)rp * 2 + r; const float rs = (r == 0 ? rstd0 : rstd1);
                    const f32x4 o = (f32x4){v[r][4 * j], v[r][4 * j + 1], v[r][4 * j + 2], v[r][4 * j + 3]} * rs * gvj + bvj;
                    if (OUT) *(f32x4*)(OUT + row * 1024 + 16 * lane + 4 * j) = o;
                    else { wb[r][2 * j] = pk2(o[0], o[1]); wb[r][2 * j + 1] = pk2(o[2], o[3]);
                        int t8 = 0; t8 = __builtin_amdgcn_cvt_pk_fp8_f32(o[0], o[1], t8, false); t8 = __builtin_amdgcn_cvt_pk_fp8_f32(o[2], o[3], t8, true); w8[r][j] = (unsigned)t8; } } }
            if (!OUT) {
#pragma unroll
                for (int r = 0; r < 2; ++r) { const size_t row = (size_t)rp * 2 + r;
                    *(u32x4*)(XO + row * 1024 + 16 * lane) = (u32x4){wb[r][0], wb[r][1], wb[r][2], wb[r][3]}; *(u32x4*)(XO + row * 1024 + 16 * lane + 8) = (u32x4){wb[r][4], wb[r][5], wb[r][6], wb[r][7]};
                    if constexpr (INP_F8) *(u32x4*)((unsigned char*)XB + row * 1024 + 16 * lane) = (u32x4){w8[r][0], w8[r][1], w8[r][2], w8[r][3]};
                    else { *(u32x4*)(XB + row * 1024 + 16 * lane) = (u32x4){wb[r][0], wb[r][1], wb[r][2], wb[r][3]}; *(u32x4*)(XB + row * 1024 + 16 * lane + 8) = (u32x4){wb[r][4], wb[r][5], wb[r][6], wb[r][7]}; } } }
        }
        return;
    }
    for (int rp = gw; rp < NTOK / 2; rp += NGW) {
        f32x4 v[2][4]; float s[2] = {0.f, 0.f};
#pragma unroll
        for (int r = 0; r < 2; ++r) { const size_t row = (size_t)rp * 2 + r;
#pragma unroll
            for (int j = 0; j < 4; ++j) { const u32x2 a = *(const u32x2*)(X1 + row * 1024 + 4 * lane + 256 * j); v[r][j] = (f32x4){bflo(a.x), bfhi(a.x), bflo(a.y), bfhi(a.y)} * DN_ALPHA;
#pragma unroll
                for (int k = 0; k < 4; ++k) {
                    if constexpr (Y_F8) { const int y8 = *(const int*)((const unsigned char*)Y + (row * 4 + k) * 1024 + 4 * lane + 256 * j); const f32x2 lo = __builtin_amdgcn_cvt_pk_f32_fp8(y8, false), hi = __builtin_amdgcn_cvt_pk_f32_fp8(y8, true);
                        v[r][j][0] += lo[0] * (1.0f / Y_SCALE); v[r][j][1] += lo[1] * (1.0f / Y_SCALE); v[r][j][2] += hi[0] * (1.0f / Y_SCALE); v[r][j][3] += hi[1] * (1.0f / Y_SCALE); }
                    else { const u32x2 y = *(const u32x2*)(Y + (row * 4 + k) * 1024 + 4 * lane + 256 * j); v[r][j][0] += bflo(y.x); v[r][j][1] += bfhi(y.x); v[r][j][2] += bflo(y.y); v[r][j][3] += bfhi(y.y); } }
                s[r] += (v[r][j][0] + v[r][j][1]) + (v[r][j][2] + v[r][j][3]); } }
        const float mean0 = wave_sum(s[0], lane) * (1.0f / 1024.0f), mean1 = wave_sum(s[1], lane) * (1.0f / 1024.0f); float q[2] = {0.f, 0.f};
#pragma unroll
        for (int r = 0; r < 2; ++r)
#pragma unroll
            for (int j = 0; j < 4; ++j) { v[r][j] = v[r][j] - (r == 0 ? mean0 : mean1); q[r] += (v[r][j][0] * v[r][j][0] + v[r][j][1] * v[r][j][1]) + (v[r][j][2] * v[r][j][2] + v[r][j][3] * v[r][j][3]); }
        const float rstd0 = rsqrtf(wave_sum(q[0], lane) * (1.0f / 1024.0f) + LN_EPS), rstd1 = rsqrtf(wave_sum(q[1], lane) * (1.0f / 1024.0f) + LN_EPS);
#pragma unroll
        for (int j = 0; j < 4; ++j) { const f32x4 gvj = *(const f32x4*)(g + 4 * lane + 256 * j), bvj = *(const f32x4*)(bta + 4 * lane + 256 * j);
#pragma unroll
            for (int r = 0; r < 2; ++r) { const size_t row = (size_t)rp * 2 + r; const f32x4 o = v[r][j] * (r == 0 ? rstd0 : rstd1) * gvj + bvj;
                if (OUT) *(f32x4*)(OUT + row * 1024 + 4 * lane + 256 * j) = o;
                else { u32x2 w; w.x = pk2(o[0], o[1]); w.y = pk2(o[2], o[3]); *(u32x2*)(XO + row * 1024 + 4 * lane + 256 * j) = w;
                    if constexpr (INP_F8) { int w8 = 0; w8 = __builtin_amdgcn_cvt_pk_fp8_f32(o[0], o[1], w8, false); w8 = __builtin_amdgcn_cvt_pk_fp8_f32(o[2], o[3], w8, true); *(int*)((unsigned char*)XB + row * 1024 + 4 * lane + 256 * j) = w8; }
                    else { *(u32x2*)(XB + row * 1024 + 4 * lane + 256 * j) = w; } } } }
    }
}

constexpr int PH_PER_LAYER = 10, N_PHASES = 2 + PH_PER_LAYER * DEPTH;
__host__ __device__ constexpr bool phase_active(int p) {
    if (p < 2) return true;
    const int l = (p - 2) / PH_PER_LAYER, k = (p - 2) % PH_PER_LAYER, kind = l % 3;
    if (k == 1) return kind != 0;
    if (k == 3 || k == 4) return kind == 2;
    return true;
}

__global__ void __launch_bounds__(512, 2) fwd(Args args) {
    extern __shared__ __attribute__((aligned(16))) unsigned char lds_raw[];
    const int wave0 = __builtin_amdgcn_readfirstlane((int)threadIdx.x >> 6);
    Ctx cx; cx.lds = (LAS unsigned char*)lds_raw; cx.G = gridDim.x; { const int bx = blockIdx.x; cx.vcu = (cx.G % 8 == 0) ? (bx % 8) * (cx.G / 8) + bx / 8 : bx; } cx.ws = args.ws;
    volatile LAS unsigned* MISC = (volatile LAS unsigned*)(cx.lds + MISC_OFF);
    for (int u = threadIdx.x; u < (LDS_BYTES - MISC_OFF) / 4; u += 512) MISC[u] = 0u;
    __syncthreads();
    if (threadIdx.x == 0) { LAS unsigned long long* t = (LAS unsigned long long*)(cx.lds + PTAB_OFF);
#pragma unroll
        for (int k = 0; k < 32; ++k) t[k] = (unsigned long long)args.in[k];
        t[32] = (unsigned long long)args.out; t[33] = (unsigned long long)args.ws; }
    __syncthreads();
    const int lo = args.ph_lo, hi = args.ph_hi;
    XcdBarrier bar; bar.bar = (unsigned*)((gu32*)(args.ws + WS_CTL) + CW_BAR); bar.x = 0; bar.st = nullptr;
    if (hi - lo > 1) bar = xcd_barrier_post((unsigned*)((gu32*)(args.ws + WS_CTL) + CW_BAR), MISC + 8);
    int ran = 0;
#define XB ((bf16_t*)(ws + WS_XB))
#define PROJ ((bf16_t*)(ws + WS_PROJ))
#define CAT ((bf16_t*)(ws + WS_CAT))
#define KVM ((bf16_t*)(ws + WS_KVM))
#define HB ((bf16_t*)(ws + WS_H))
#define YB ((bf16_t*)(ws + WS_Y))
#define QKR ((bf16_t*)(ws + WS_QKR))
#define EXPID ((int*)(ws + WS_EXPID))
#define GATE ((float*)(ws + WS_GATE))
#define IDX ((int*)(ws + WS_IDX))
#define XF ((float*)(GAS float*)ptab_get(cx, 32))
#define SB ((bf16_t*)(ws + WS_SB))
#define SB2 ((bf16_t*)(ws + WS_PROJ))
#define TP_BAR_BEGIN() do {} while (0)
#define TP_BAR_END() do {} while (0)
#define TP_PH_BEGIN(p) do {} while (0)
#define TP_PH_END(p) do {} while (0)
#define PH_BEGIN(p) if (lo <= (p) && (p) < hi) { const int ph_ = (p); if (ran) { TP_BAR_BEGIN(); for (int rb_ = 0; rb_ < REP_BAR; ++rb_) xcd_barrier(bar, wave0); TP_BAR_END(); } ran = 1; const int tid = opaque_tid(wave0); (void)tid; unsigned char* const ws = (unsigned char*)(GAS unsigned char*)ptab_get(cx, 33); cx.ws = ws; TP_PH_BEGIN(ph_);
#define PH_END TP_PH_END(ph_); }

#if EN_P0
    PH_BEGIN(0) for (int rep_ = 0; rep_ < REP_P0; ++rep_) { p0_prologue(cx, tid); } PH_END
#endif

    for (int l = -1; l < DEPTH; ++l) {
        const int kind = (l < 0) ? 0 : l % 3, jj = (l < 0) ? 0 : l / 3, pw = (l < 0) ? 2048 : ((l % 3) == 1 ? 1536 : 2560), base = 2 + PH_PER_LAYER * l;
        PH_BEGIN(l < 0 ? 1 : base) {
            pg8::DenseOrder S;
            if (l < 0) S.init(ws + WS_MEMB, ws + WS_WKV, NMEM, 2048, 1024 * INP_EB, cx.G, cx.vcu);
            else S.init(XB, ws + WS_WIN + (size_t)l * 5 * MiB, NTOK, pw, 1024 * INP_EB, cx.G, cx.vcu);
            S.rep = REP_DENSE;
            const unsigned smask = (l < 0) ? 0u : (kind == 0 ? 0x207u : kind == 1 ? 0x20u : 0x200u);
            pg8::EpiBf16s E{l < 0 ? KVM : PROJ, pw, smask, C2, INP_F8 ? 1.0f / WIN_SCALE : 1.0f};
#if EN_G1
            pg8::gemm_phase<pg8::EpiBf16s, pg8::DenseOrder, false, INP_F8 != 0>(cx.lds, S, E, tid);
#endif
        } PH_END
        if (l < 0) continue;
#if EN_THIN
        if (kind == 1) { PH_BEGIN(base + 1) for (int rep_ = 0; rep_ < REP_THIN; ++rep_) { rope_phase(cx, PROJ, INP(5) + jj * 64, INP(6) + jj * 64, QKR, tid); } PH_END }
        if (kind == 2) { PH_BEGIN(base + 1) for (int rep_ = 0; rep_ < REP_THIN; ++rep_) { sconv_phase(cx, PROJ, INP(8) + (size_t)jj * 3 * 2304, INP(9) + (size_t)jj * 2304, (bf16_t*)(ws + WS_UT3), ws + WS_V8, tid); } PH_END }
#endif
        for (int o = 0; o < 2; ++o) {
            if (o == 1 && kind != 2) break;
            PH_BEGIN(base + 2 + o) {
                if (kind == 2) {
                    const bf16_t* UT3 = (const bf16_t*)(ws + WS_UT3); constexpr size_t PS = (size_t)16 * 768 * 4096;
#if EN_TCONV
                    for (int rep_ = 0; rep_ < REP_TCONV; ++rep_) {
#if TCONV_F8
                    tconv8_phase(cx, o, o == 0 ? UT3 : (const bf16_t*)(ws + WS_Z1T), ws + WS_V8 + (size_t)o * 48 * MiB, UT3 + (size_t)(1 + o) * PS, (bf16_t*)(ws + (o == 0 ? WS_Z1T : WS_Z2T)), o == 0 ? ws + WS_V8 + 48 * MiB : (unsigned char*)nullptr, INP(19) + (size_t)(jj * 2 + o) * 768, tid);
#else
                    tconv_phase(cx, o, o == 0 ? UT3 : (const bf16_t*)(ws + WS_Z1T), UT3 + (size_t)(1 + o) * PS, (bf16_t*)(ws + (o == 0 ? WS_Z1T : WS_Z2T)), INP(19) + (size_t)(jj * 2 + o) * 768, tid);
#endif
                    }
#endif
                }
                if (o == 0) {
#if EN_NA
                    for (int rep_ = 0; rep_ < REP_NA; ++rep_) { if (kind == 0) na_phase(cx, PROJ, INP(3) + (size_t)jj * 12 * 465, CAT, tid); }
#endif
                    const int ngqa = (kind == 1) ? 3072 : 0;
                    for (int rep_ = 0; rep_ < REP_ATTN; ++rep_)
                    for (int u = cx.vcu; u < ngqa + 1024; u += cx.G) {
                        const attn_body::bf16 *Q, *K, *V; attn_body::bf16* O; int QP, KP, VP, NT;
                        if (u < ngqa) { const int qb = u & 15, hq = (u >> 4) % 12, b = u / 192, kvh = hq / 3;
                            Q = (const attn_body::bf16*)QKR + ((size_t)b * 4096 + qb * 256) * 1024 + hq * 64; QP = 1024;
                            K = (const attn_body::bf16*)QKR + (size_t)b * 4096 * 1024 + 768 + kvh * 64; KP = 1024;
                            V = (const attn_body::bf16*)PROJ + (size_t)b * 4096 * 1536 + 1024 + kvh * 64; VP = 1536;
                            O = (attn_body::bf16*)((unsigned char*)CAT + (((size_t)b * 4096 + qb * 256) * 1024 + hq * 64) * OUT_EB); NT = 64;
                        } else { const int v = u - ngqa, qb = v & 15, h = (v >> 4) & 3, b = v >> 6;
                            Q = (const attn_body::bf16*)PROJ + ((size_t)b * 4096 + qb * 256) * pw + (pw - 256) + h * 64; QP = pw;
                            K = (const attn_body::bf16*)KVM + (size_t)b * 256 * 2048 + 512 * l + h * 64; KP = 2048;
                            V = K + 256; VP = 2048;
                            O = (attn_body::bf16*)((unsigned char*)CAT + (((size_t)b * 4096 + qb * 256) * 1024 + 768 + h * 64) * OUT_EB); NT = 4;
                        }
#if EN_ATTN
                        attn_body::attn_unit<8, OUTP_F8 != 0>(Q, K, V, O, QP, KP, VP, 1024, NT, (char*)lds_raw, tid);
#endif
                    }
                }
            } PH_END
        }
#if EN_THIN
        if (kind == 2) { PH_BEGIN(base + 4) for (int rep_ = 0; rep_ < REP_THIN; ++rep_) { tback_phase(cx, (const bf16_t*)(ws + WS_Z2T), CAT, tid); } PH_END }
#endif
        PH_BEGIN(base + 5) {
            pg8::DenseOrder S; S.init(CAT, ws + WS_WOUT + (size_t)l * 2 * MiB, NTOK, 1024, 1024 * OUT_EB, cx.G, cx.vcu);
            pg8::EpiResB E{SB, l == 0 ? (const void*)INP(0) : (const void*)SB, l == 0 ? 1 : 0, 1024, DN_ALPHA, OUTP_F8 ? 1.0f / WOUT_SCALE : 1.0f};
#if EN_G2
            pg8::gemm_phase<pg8::EpiResB, pg8::DenseOrder, false, OUTP_F8 != 0>(cx.lds, S, E, tid);
#endif
        } PH_END
#if EN_LN
#if REP_LN1 > 1
        PH_BEGIN(base + 6) ln1_router_phase(cx, SB, (bf16_t*)(ws + WS_PROJ), CAT, INP(22) + l * 1024, INP(23) + l * 1024, INP(26) + (size_t)l * 1024 * 32, INP(27) + l * 32, (unsigned*)((gu32*)(ws + WS_CTL) + CW_DBG), EXPID, GATE, IDX, (float*)(ws + WS_GIDX), tid); PH_END
#endif
        PH_BEGIN(base + 6) ln1_router_phase(cx, SB, SB2, XB, INP(22) + l * 1024, INP(23) + l * 1024, INP(26) + (size_t)l * 1024 * 32, INP(27) + l * 32, (unsigned*)((gu32*)(ws + WS_CTL) + CW_CNT + 32 * l), EXPID, GATE, IDX, (float*)(ws + WS_GIDX), tid); PH_END
#endif
        for (int half = 0; half < 2; ++half) {
            PH_BEGIN(base + 7 + half) {
                LAS int* pref = (LAS int*)(cx.lds + pg8::STAGE_BYTES); const unsigned* cntw = (const unsigned*)((gu32*)(ws + WS_CTL) + CW_CNT + 32 * l);
                __syncthreads();
                if (tid == 0) { int a = 0;
#pragma unroll 1
                    for (int e = 0; e < NEXP; ++e) { const int c = (int)__hip_atomic_load(cntw + e, __ATOMIC_RELAXED, __HIP_MEMORY_SCOPE_AGENT); pref[e] = a; pref[40 + e] = c; a += (c + 255) >> 8; } pref[NEXP] = a; }
                __syncthreads();
#if STAGGER
                if (cx.vcu & 1) { for (int s_ = 0; s_ < STAGGER; ++s_) __builtin_amdgcn_s_sleep(127); }
#endif
                if (half == 0) {
                    pg8::MoeOrder<2> S{(const char*)XB, (const char*)(ws + WS_W1 + (size_t)l * 32 * 2048 * 1024 * MOE_EB), 1024 * MOE_EB, 8, cx.G, cx.vcu, (size_t)2048 * 1024 * MOE_EB, pref, (const int*)cntw, IDX};
                    pg8::EpiSwiglu E{HB, INP(29) + (size_t)l * 32 * 2048};
#if EN_G3
                    for (int rep_ = 0; rep_ < REP_G3; ++rep_) { pg8::gemm_phase<pg8::EpiSwiglu, pg8::MoeOrder<2>, true, MOE_F8 != 0, (MOE_F8 != 0) && (DEFER_H != 0)>(cx.lds, S, E, tid); }
#endif
                } else {
                    pg8::MoeOrder<0> S{(const char*)HB, (const char*)(ws + WS_W2 + (size_t)l * 32 * 1024 * 1024 * MOE_EB), 1024 * MOE_EB, 4, cx.G, cx.vcu, (size_t)1024 * 1024 * MOE_EB, pref, (const int*)cntw, IDX};
                    pg8::EpiMoeOut E{YB, INP(31) + (size_t)l * 32 * 1024, (const float*)(ws + WS_GIDX)};
#if EN_G4
                    for (int rep_ = 0; rep_ < REP_G4; ++rep_) { pg8::gemm_phase<pg8::EpiMoeOut, pg8::MoeOrder<0>, true, MOE_F8 != 0>(cx.lds, S, E, tid); }
#endif
                }
            } PH_END
        }
#if EN_LN
#if REP_LN2 > 1
        PH_BEGIN(base + 9) ln2_phase(cx, SB, YB, (bf16_t*)(ws + WS_PROJ), CAT, (float*)nullptr, INP(24) + l * 1024, INP(25) + l * 1024, tid); PH_END
#endif
        PH_BEGIN(base + 9) ln2_phase(cx, SB2, YB, SB, XB, l == DEPTH - 1 ? XF : (float*)nullptr, INP(24) + l * 1024, INP(25) + l * 1024, tid); PH_END

#endif
    }
#undef PH_BEGIN
#undef PH_END
#undef XB
#undef PROJ
#undef CAT
#undef KVM
#undef HB
#undef YB
#undef QKR
#undef EXPID
#undef GATE
#undef IDX
#undef XF
#undef SB
#undef SB2
}

extern "C" void kernel_launch(void* const* d_in, const int* in_sizes, int n_in, void* d_out, int out_size, void* d_ws, size_t ws_size, hipStream_t stream) {
    static int grid = 0;
    if (grid == 0) {
        if (n_in != 32 || in_sizes[0] != NTOK * DM || out_size != NTOK * DM || ws_size < WS_END) { fprintf(stderr, "kernel_launch: unexpected problem (n_in %d, in0 %d, out %d, ws %zu < %zu); nothing launched\n", n_in, n_in > 0 ? in_sizes[0] : -1, out_size, ws_size, (size_t)WS_END); grid = -1; return; }
        int dev = 0, cus = 0, per_cu = 0;
        if (hipGetDevice(&dev) != hipSuccess || hipDeviceGetAttribute(&cus, hipDeviceAttributeMultiprocessorCount, dev) != hipSuccess) { fprintf(stderr, "kernel_launch: device query failed\n"); grid = -1; return; }
        if (hipFuncSetAttribute((const void*)fwd, hipFuncAttributeMaxDynamicSharedMemorySize, LDS_BYTES) != hipSuccess) { fprintf(stderr, "kernel_launch: hipFuncSetAttribute failed\n"); grid = -1; return; }
        if (hipOccupancyMaxActiveBlocksPerMultiprocessor(&per_cu, (const void*)fwd, 512, LDS_BYTES) != hipSuccess || per_cu < 1) fprintf(stderr, "kernel_launch: occupancy query reports %d blocks per CU\n", per_cu);
        (void)hipGetLastError();
        grid = cus;
    }
    if (grid < 0) return;
    if (hipMemsetAsync((char*)d_ws + WS_CTL, 0, CTL_ZERO_BYTES, stream) != hipSuccess) { fprintf(stderr, "kernel_launch: memset failed\n"); return; }
    Args a{};
    for (int i = 0; i < 32; ++i) a.in[i] = (const float*)d_in[i];
    a.out = (float*)d_out; a.ws = (unsigned char*)d_ws;
#if MK_MULTI
    for (int p = 0; p < N_PHASES && p <= DBG_LAST_PHASE; ++p) {
        if (!phase_active(p)) continue;
        a.ph_lo = p; a.ph_hi = p + 1;
        hipLaunchKernelGGL(fwd, dim3(grid), dim3(512), LDS_BYTES, stream, a);
#if DBG_CHECK
        dbg_after_phase(p, a, stream);
#endif
    }
#if DBG_CHECK
    hipLaunchKernelGGL(dbg_report, dim3(1024), dim3(256), 0, stream, (unsigned*)((char*)d_ws + WS_CTL) + CW_DBG, (float*)d_out);
#endif
#else
    a.ph_lo = 0; a.ph_hi = N_PHASES;
    hipLaunchKernelGGL(fwd, dim3(grid), dim3(512), LDS_BYTES, stream, a);
#endif
    const hipError_t le = hipPeekAtLastError();
    if (le != hipSuccess) fprintf(stderr, "kernel_launch: launch failed: %s\n", hipGetErrorName(le));
}
```

```cpp
#include <hip/hip_runtime.h>
#include <hip/hip_bf16.h>
#include <cstdio>
#include <cstdint>

#ifndef MK_MULTI
#define MK_MULTI 0
#endif
#ifndef DBG_CHECK
#define DBG_CHECK 0
#endif
#ifndef DBG_LAST_PHASE
#define DBG_LAST_PHASE 9999
#endif

#ifndef EN_P0
#define EN_P0 1
#define EN_G1 1
#define EN_THIN 1
#define EN_TCONV 1
#define EN_NA 1
#define EN_ATTN 1
#define EN_G2 1
#define EN_LN 1
#define EN_G3 1
#define EN_G4 1
#endif

#ifndef REP_P0
#define REP_P0 1
#endif
#ifndef REP_G1
#define REP_G1 1
#endif
#ifndef REP_NA
#define REP_NA 1
#endif
#ifndef REP_ATTN
#define REP_ATTN 1
#endif
#ifndef REP_TCONV
#define REP_TCONV 1
#endif
#ifndef REP_THIN
#define REP_THIN 1
#endif
#ifndef REP_G3
#define REP_G3 1
#endif
#ifndef REP_G4
#define REP_G4 1
#endif
#ifndef ALIGN_EPI
#define ALIGN_EPI 1
#endif
#ifndef NT_STORE
#define NT_STORE 0
#endif
#ifndef LN1_HOLD
#define LN1_HOLD 16
#endif
#ifndef DEFER_H
#define DEFER_H 0
#endif
#ifndef STAGGER
#define STAGGER 0
#endif
#ifndef REP_BAR
#define REP_BAR 1
#endif
#ifndef REP_DENSE
#define REP_DENSE 1
#endif
#ifndef REP_G2
#define REP_G2 1
#endif
#ifndef REP_LN1
#define REP_LN1 1
#endif
#ifndef REP_LN2
#define REP_LN2 1
#endif

#define GAS __attribute__((address_space(1)))
#define LAS __attribute__((address_space(3)))
typedef unsigned short bf16_t;
typedef short bf16x8 __attribute__((ext_vector_type(8)));
typedef short s16x4 __attribute__((ext_vector_type(4)));
typedef float f32x4 __attribute__((ext_vector_type(4)));
typedef float f32x2 __attribute__((ext_vector_type(2)));
typedef float f32x16 __attribute__((ext_vector_type(16)));
typedef unsigned u32x4 __attribute__((ext_vector_type(4)));
typedef unsigned u32x2 __attribute__((ext_vector_type(2)));
typedef GAS unsigned gu32;

constexpr int BATCH = 16, SEQ = 4096, DM = 1024, NTOK = BATCH * SEQ, DEPTH = 4;
constexpr int MEMLEN = 256, NMEM = BATCH * MEMLEN;
constexpr int NEXP = 32, NSLOT = NTOK * 4, IDXCAP = NTOK;
constexpr int GRIDW = 64;
constexpr float LN_EPS = 1e-5f;
constexpr float DN_ALPHA = 1.681792830507429f;
constexpr float LOG2E = 1.4426950408889634f;
constexpr float C2 = 0.125f * LOG2E;
__host__ __device__ constexpr int layer_kind(int l) { return l % 3; }
__host__ __device__ constexpr int layer_j(int l) { return l / 3; }
__host__ __device__ constexpr int in_width(int l) { return (l % 3) == 1 ? 1536 : 2560; }

#ifndef MOE_F8
#define MOE_F8 1
#endif
#ifndef INP_F8
#define INP_F8 1
#endif
constexpr int INP_EB = INP_F8 ? 1 : 2;
constexpr float WIN_SCALE = 32.0f;
#ifndef OUTP_F8
#define OUTP_F8 1
#endif
constexpr int OUT_EB = OUTP_F8 ? 1 : 2;
constexpr float WOUT_SCALE = 64.0f;
__device__ __forceinline__ unsigned char f2fp8(float x) { return (unsigned char)(__builtin_amdgcn_cvt_pk_fp8_f32(x, x, 0, false) & 0xff); }
#ifndef TCONV_F8
#define TCONV_F8 1
#endif
#ifndef Y_F8
#define Y_F8 1
#endif
constexpr float Y_SCALE = 64.0f;
constexpr int MOE_EB = MOE_F8 ? 1 : 2;
constexpr float W1_SCALE = 32.0f, W2_SCALE = 64.0f, H_SCALE = 4.0f;

constexpr size_t MiB = 1u << 20;
constexpr size_t WS_CTL = 0, CTL_ZERO_BYTES = 1 * MiB;
constexpr size_t WS_WIN = 2 * MiB;
constexpr size_t WS_WKV = 22 * MiB;
constexpr size_t WS_WOUT = 26 * MiB;
constexpr size_t WS_W1 = 34 * MiB;
constexpr size_t WS_W2 = 546 * MiB;
constexpr size_t WS_XB = 802 * MiB;
constexpr size_t WS_MEMB = 930 * MiB;
constexpr size_t WS_KVM = 938 * MiB;
constexpr size_t WS_PROJ = 954 * MiB;
constexpr size_t WS_CAT = 1274 * MiB;
constexpr size_t WS_H = 1402 * MiB;
constexpr size_t WS_Y = 1914 * MiB;
constexpr size_t WS_HRAWT = 2426 * MiB;
constexpr size_t WS_HPART = 2474 * MiB;
constexpr size_t WS_EXPID = 2478 * MiB;
constexpr size_t WS_GATE = 2479 * MiB;
constexpr size_t WS_IDX = 2480 * MiB;
constexpr size_t WS_SB = 2488 * MiB;
constexpr size_t WS_GIDX = 2616 * MiB;
constexpr size_t WS_END = 2624 * MiB;
constexpr size_t WS_UT3 = WS_H;
constexpr size_t WS_Z1T = WS_H + 288 * MiB;
constexpr size_t WS_Z2T = WS_H + 384 * MiB;
constexpr size_t WS_V8 = WS_Y;
constexpr size_t WS_QKR = WS_Y;
constexpr int CW_BAR = 4096;
constexpr int CW_CNT = 8192;
constexpr int CW_DBG = 12288;

constexpr int MISC_OFF = 150528;
constexpr int LDS_BYTES = 151552;

#define LDS_WAIT() asm volatile("s_waitcnt lgkmcnt(0)" ::: "memory")
#define VM_WAIT() asm volatile("s_waitcnt vmcnt(0)" ::: "memory")
__device__ __forceinline__ unsigned f2bf(float f) { unsigned u = __builtin_bit_cast(unsigned, f); return (u + 0x7fffu + ((u >> 16) & 1u)) >> 16; }
__device__ __forceinline__ unsigned pk2(float lo, float hi) { return f2bf(lo) | (f2bf(hi) << 16); }
__device__ __forceinline__ float bf2f(unsigned short b) { return __builtin_bit_cast(float, ((unsigned)b) << 16); }
__device__ __forceinline__ float bflo(unsigned w) { return __builtin_bit_cast(float, w << 16); }
__device__ __forceinline__ float bfhi(unsigned w) { return __builtin_bit_cast(float, w & 0xffff0000u); }
__device__ __forceinline__ float shflx(float v, int mask, int lane) { int t; asm volatile("v_mov_b32 %0, %1" : "=v"(t) : "v"(__builtin_bit_cast(int, v))); return __builtin_bit_cast(float, __builtin_amdgcn_ds_bpermute((lane ^ mask) << 2, t)); }
__device__ __forceinline__ int shflxi(int v, int mask, int lane) { return __builtin_amdgcn_ds_bpermute((lane ^ mask) << 2, v); }
template <int CTRL> __device__ __forceinline__ float dpp_x(float v) { return __builtin_bit_cast(float, __builtin_amdgcn_update_dpp(0, __builtin_bit_cast(int, v), CTRL, 0xF, 0xF, false)); }
__device__ __forceinline__ float group8_sum(float v) { v += dpp_x<0xB1>(v); v += dpp_x<0x4E>(v); v += dpp_x<0x141>(v); return v; }
__device__ __forceinline__ float wave_sum(float v, int  ) {
    v += dpp_x<0xB1>(v); v += dpp_x<0x4E>(v); v += dpp_x<0x141>(v); v += dpp_x<0x140>(v);
    v += __builtin_bit_cast(float, __builtin_amdgcn_update_dpp(0, __builtin_bit_cast(int, v), 0x142, 0xA, 0xF, false));
    v += __builtin_bit_cast(float, __builtin_amdgcn_update_dpp(0, __builtin_bit_cast(int, v), 0x143, 0xC, 0xF, false));
    return __builtin_bit_cast(float, __builtin_amdgcn_readlane(__builtin_bit_cast(int, v), 63));
}
__device__ __forceinline__ int lane_id_volatile() { int l; asm volatile("v_mbcnt_lo_u32_b32 %0, -1, 0\n\tv_mbcnt_hi_u32_b32 %0, -1, %0" : "=&v"(l)); return l; }
__device__ __forceinline__ int opaque_tid(int wave0) { return wave0 * 64 + lane_id_volatile(); }

#define XB_TMO      128
#define XB_XCNT(j)  (256  + 64 * (j))
#define XB_XSUB(j)  (1280 + 64 * (j))
#define XB_XGEN(j)  (2304 + 64 * (j))
#define XB_TOP      3328
#define XB_TOPGEN   3392
#define XCD_BAR_WORDS 3456
#define XB_SPIN_CAP (1u << 20)

__device__ __forceinline__ unsigned xb_ld(unsigned* p)              { return __hip_atomic_load(p, __ATOMIC_RELAXED, __HIP_MEMORY_SCOPE_AGENT); }
__device__ __forceinline__ unsigned xb_add(unsigned* p, unsigned v) { return __hip_atomic_fetch_add(p, v, __ATOMIC_RELAXED, __HIP_MEMORY_SCOPE_AGENT); }
__device__ __forceinline__ unsigned xb_xcc_id() { return (unsigned)__builtin_amdgcn_s_getreg((3 << 11) | 20) & 0xFu; }
#define XB_SPIN(cond, bar) do { unsigned _sp = 0; while (cond) { __builtin_amdgcn_s_sleep(1); \
    if ((++_sp & 255u) == 0u) { if (xb_ld(&(bar)[XB_TMO])) break; if (_sp > XB_SPIN_CAP) { atomicAdd(&(bar)[XB_TMO], 1u); break; } } } } while (0)

struct XcdBarrier {
    unsigned* bar; unsigned x;
    volatile LAS unsigned* st;
};
__device__ __forceinline__ XcdBarrier xcd_barrier_post(unsigned* bar, volatile LAS unsigned* st) {
    XcdBarrier b; b.bar = bar; b.x = xb_xcc_id(); b.st = st;
    if (threadIdx.x == 0) (void)xb_add(&bar[XB_XCNT(b.x)], 1u);
    return b;
}
__device__ __forceinline__ void xcd_barrier_complete(unsigned* bar, unsigned x, unsigned& nloc, unsigned& nx) {
    const unsigned G = gridDim.x * gridDim.y * gridDim.z;
    unsigned sum, cnt, mine, sp = 0u;
    for (;;) {
        sum = 0u; cnt = 0u; mine = 0u;
#pragma unroll 1
        for (unsigned j = 0; j < 16; ++j) { const unsigned c = xb_ld(&bar[XB_XCNT(j)]); sum += c; cnt += (c > 0u) ? 1u : 0u; mine = (j == x) ? c : mine; }
        if (sum == G) break;
        __builtin_amdgcn_s_sleep(1);
        if ((++sp & 255u) == 0u) { if (xb_ld(&bar[XB_TMO])) break; if (sp > XB_SPIN_CAP) { atomicAdd(&bar[XB_TMO], 1u); break; } }
    }
    nloc = mine > 0u ? mine : 1u; nx = cnt > 0u ? cnt : 1u;
}
__device__ __forceinline__ void xcd_barrier(const XcdBarrier& b, const int wave0) {
    asm volatile("s_waitcnt vmcnt(0)" ::: "memory");
    __syncthreads();
    if (wave0 == 0 && lane_id_volatile() == 0) {
        unsigned* bar = b.bar;
        __builtin_amdgcn_s_waitcnt(0);
        unsigned nloc = b.st[0], nx = b.st[1];
        if (nloc == 0u) { xcd_barrier_complete(bar, b.x, nloc, nx); b.st[0] = nloc; b.st[1] = nx; }
        const unsigned old = xb_add(&bar[XB_XSUB(b.x)], 1u);
        const unsigned gen = old / nloc;
        if (old + 1u == (gen + 1u) * nloc) {
            __builtin_amdgcn_fence(__ATOMIC_RELEASE, "agent");
            asm volatile("s_waitcnt vmcnt(0)" ::: "memory");
            const unsigned og = xb_add(&bar[XB_TOP], 1u);
            const unsigned tg = og / nx;
            if (og + 1u == (tg + 1u) * nx) xb_add(&bar[XB_TOPGEN], 1u);
            else XB_SPIN(xb_ld(&bar[XB_TOPGEN]) == tg, bar);
            __builtin_amdgcn_fence(__ATOMIC_ACQUIRE, "agent");
            xb_add(&bar[XB_XGEN(b.x)], 1u);
            asm volatile("s_waitcnt vmcnt(0)" ::: "memory");
        } else {
            XB_SPIN(xb_ld(&bar[XB_XGEN(b.x)]) == gen, bar);
            __builtin_amdgcn_fence(__ATOMIC_ACQUIRE, "agent");
            asm volatile("s_waitcnt vmcnt(0)" ::: "memory");
        }
    }
    __syncthreads();
}

namespace pg8 {
constexpr int BM = 256, BK = 64, HALF = 128, HTB = HALF * BK * 2  , STAGE_BYTES = 8 * HTB, NXCD = 8, WGM = 8;
__host__ __device__ __forceinline__ int lds_byte(int r, int c) { const int st = (r >> 4) * 2 + (c >> 5), rr = r & 15, cc = c & 31, ob = rr * 64 + cc * 2; return st * 1024 + (ob ^ (((ob >> 9) & 1) << 5)); }
__host__ __device__ __forceinline__ void stage_rc(int b, int& R, int& C) { const int st = b / 1024, sb = b % 1024, swz = sb ^ (((sb >> 9) & 1) << 5); R = (st >> 1) * 16 + swz / 64; C = (st & 1) * 32 + (swz % 64) / 2; }
__host__ __device__ __forceinline__ int perm32(int rho) { const int n = rho >> 4, i = rho & 15; return 8 * (i >> 2) + 4 * n + (i & 3); }

struct Unit { int pm, pn, e, p; };

struct DenseOrder {
    const char* A; const char* Bt; int KB; int nM, nN, nwg, G, c; int rep = 1;
    __device__ __forceinline__ void init(const void* A_, const void* Bt_, int M, int N, int KB_, int G_, int c_) { A = (const char*)A_; Bt = (const char*)Bt_; KB = KB_; nM = M / BM; nN = N / BM; nwg = nM * nN; G = G_; c = c_; }
    __device__ __forceinline__ bool next(int i, Unit& u) const {
        long L = (long)i * G + c; if (L >= (long)nwg * rep) return false;
        if (rep > 1) L %= nwg;
        int wgid = (int)L; { const int q = nwg / NXCD, r = nwg % NXCD, xcd = wgid % NXCD, off = wgid / NXCD; wgid = (xcd < r ? xcd * (q + 1) : r * (q + 1) + (xcd - r) * q) + off; }
        const int nig = WGM * nN, gid = wgid / nig, fm = gid * WGM, gsz = (nM - fm) < WGM ? (nM - fm) : WGM;
        u.pm = __builtin_amdgcn_readfirstlane(fm + ((wgid % nig) % gsz)); u.pn = __builtin_amdgcn_readfirstlane((wgid % nig) / gsz); u.e = 0; u.p = 0; return true;
    }
    __device__ __forceinline__ const char* a_base(const Unit& u) const { return A + (size_t)u.pm * BM * KB; }
    __device__ __forceinline__ const char* b_base(const Unit& u) const { return Bt + (size_t)u.pn * BM * KB; }
    __device__ __forceinline__ const int* idx_src(const Unit&) const { return nullptr; }
    __device__ __forceinline__ int nvalid(const Unit&) const { return BM; }
    static constexpr int ROW_SHIFT = 0;
};
template <int SHIFT  > struct MoeOrder {
    const char* A; const char* Bt; int KB; int nN; int G, c; size_t bstride; const LAS int* pref; const int* cnt; const int* idx;
    __device__ __forceinline__ bool next(int i, Unit& u) const {
        const long L = (long)i * G + c; const int tot = __builtin_amdgcn_readfirstlane(pref[NEXP]);
        if (L >= (long)tot * nN) return false;
        const int pg = __builtin_amdgcn_readfirstlane((int)(L / nN)); u.pn = __builtin_amdgcn_readfirstlane((int)(L % nN));
        int e = 0;
#pragma unroll
        for (int step = 16; step >= 1; step >>= 1) { const int v = __builtin_amdgcn_readfirstlane(pref[e + step]); e += (v <= pg) ? step : 0; }
        u.e = e; u.p = pg - __builtin_amdgcn_readfirstlane(pref[e]); u.pm = 0; return true;
    }
    __device__ __forceinline__ const char* a_base(const Unit&) const { return A; }
    __device__ __forceinline__ const char* b_base(const Unit& u) const { return Bt + (size_t)u.e * bstride + (size_t)u.pn * BM * KB; }
    __device__ __forceinline__ const int* idx_src(const Unit& u) const { return idx + (size_t)u.e * IDXCAP + u.p * BM; }
    __device__ __forceinline__ int nvalid(const Unit& u) const { const int n = __builtin_amdgcn_readfirstlane(pref[40 + u.e]) - u.p * BM; return n < BM ? n : BM; }
    static constexpr int ROW_SHIFT = SHIFT;
};

__device__ __forceinline__ unsigned cvt_pk_bf16(float lo, float hi) { unsigned r; asm volatile("v_cvt_pk_bf16_f32 %0, %1, %2" : "=v"(r) : "v"(lo), "v"(hi)); return r; }

struct EpiBf16s {
    static constexpr bool PERM = true; static constexpr bool HAS_BIAS = false;
    bf16_t* O; int ldc; unsigned smask; float scale; float base;
    __device__ __forceinline__ void operator()(const f32x4 (&acc)[2][2][4][2], const Unit& u, int wr, int wc, int fr, int fq) const {
        const int row0 = u.pm * BM + wr * 64 + fr, col0 = u.pn * BM + wc * 32 + 8 * fq;
        const float sc = (((smask >> u.pn) & 1u) ? scale : 1.f) * base;
#pragma unroll
        for (int ai = 0; ai < 2; ++ai)
#pragma unroll
            for (int m = 0; m < 4; ++m) { bf16_t* rowp = O + (size_t)(row0 + ai * HALF + m * 16) * ldc + col0;
#pragma unroll
                for (int bj = 0; bj < 2; ++bj) { const f32x4 v0 = acc[ai][bj][m][0] * sc, v1 = acc[ai][bj][m][1] * sc;
                    u32x4 w; w.x = cvt_pk_bf16(v0[0], v0[1]); w.y = cvt_pk_bf16(v0[2], v0[3]); w.z = cvt_pk_bf16(v1[0], v1[1]); w.w = cvt_pk_bf16(v1[2], v1[3]);
                    if (NT_STORE) __builtin_nontemporal_store(w, (u32x4*)(rowp + bj * HALF)); else *(u32x4*)(rowp + bj * HALF) = w; }
                asm volatile("" ::: "memory"); }
    }
};
struct EpiResB {
    static constexpr bool PERM = true; static constexpr bool HAS_BIAS = false;
    bf16_t* C; const void* res; int res_f32; int ldc; float alpha; float ascale;
    __device__ __forceinline__ void operator()(const f32x4 (&acc)[2][2][4][2], const Unit& u, int wr, int wc, int fr, int fq) const {
        const int row0 = u.pm * BM + wr * 64 + fr, col0 = u.pn * BM + wc * 32 + 8 * fq;
#pragma unroll
        for (int ai = 0; ai < 2; ++ai)
#pragma unroll
            for (int m = 0; m < 4; ++m) { const size_t off = (size_t)(row0 + ai * HALF + m * 16) * ldc + col0;
#pragma unroll
                for (int bj = 0; bj < 2; ++bj) { f32x4 r0, r1;
                    if (res_f32) { const float* rp = (const float*)res + off + bj * HALF; r0 = *(const f32x4*)rp; r1 = *(const f32x4*)(rp + 4); }
                    else { const u32x4 raw = *(const u32x4*)((const bf16_t*)res + off + bj * HALF); r0 = (f32x4){bflo(raw.x), bfhi(raw.x), bflo(raw.y), bfhi(raw.y)}; r1 = (f32x4){bflo(raw.z), bfhi(raw.z), bflo(raw.w), bfhi(raw.w)}; }
                    const f32x4 v0 = r0 * alpha + acc[ai][bj][m][0] * ascale, v1 = r1 * alpha + acc[ai][bj][m][1] * ascale;
                    u32x4 w; w.x = cvt_pk_bf16(v0[0], v0[1]); w.y = cvt_pk_bf16(v0[2], v0[3]); w.z = cvt_pk_bf16(v1[0], v1[1]); w.w = cvt_pk_bf16(v1[2], v1[3]);
                    *(u32x4*)(C + off + bj * HALF) = w; }
                asm volatile("" ::: "memory"); }
    }
};
struct Pend { u32x2 val[8]; };
struct EpiSwiglu {
    static constexpr bool PERM = true; static constexpr bool HAS_GATE = false; static constexpr bool HAS_BIAS = true;
    __device__ __forceinline__ void load_bias(const Unit& u, int wc, int fq, f32x4 (&bp)[4]) const { const float* bg = b1 + (size_t)u.e * 2048 + u.pn * HALF + wc * 32 + 8 * fq; bp[0] = *(const f32x4*)bg; bp[1] = *(const f32x4*)(bg + 4); bp[2] = *(const f32x4*)(bg + 1024); bp[3] = *(const f32x4*)(bg + 1028); }
    bf16_t* H; const float* b1;
    __device__ __forceinline__ void prepare(const f32x4 (&acc)[2][2][4][2], const Unit& u, int wr, int wc, int fr, int fq, Pend& pd) const {
        constexpr float ASC = 1.0f / W1_SCALE;
        const int j0 = u.pn * HALF + wc * 32 + 8 * fq; const float* bg = b1 + (size_t)u.e * 2048 + j0; const float* bu = bg + 1024;
        const f32x4 bg0 = *(const f32x4*)bg, bg1 = *(const f32x4*)(bg + 4), bu0 = *(const f32x4*)bu, bu1 = *(const f32x4*)(bu + 4);
#pragma unroll
        for (int q8 = 0; q8 < 8; ++q8) { const int ai = q8 >> 2, m = q8 & 3;
            float o[8];
#pragma unroll
            for (int q = 0; q < 8; ++q) { const float gb = (q < 4 ? bg0[q & 3] : bg1[q & 3]), ub = (q < 4 ? bu0[q & 3] : bu1[q & 3]);
                float g = acc[ai][0][m][q >> 2][q & 3] * ASC + gb, uu = acc[ai][1][m][q >> 2][q & 3] * ASC + ub;
                g = fminf(g, 7.0f); uu = fminf(fmaxf(uu, -7.0f), 7.0f);
                const float sg = __builtin_amdgcn_rcpf(1.0f + __builtin_amdgcn_exp2f(-1.702f * LOG2E * g));
                o[q] = (uu + 1.0f) * (g * sg); }
            int w0 = 0, w1 = 0;
            w0 = __builtin_amdgcn_cvt_pk_fp8_f32(o[0] * H_SCALE, o[1] * H_SCALE, w0, false); w0 = __builtin_amdgcn_cvt_pk_fp8_f32(o[2] * H_SCALE, o[3] * H_SCALE, w0, true);
            w1 = __builtin_amdgcn_cvt_pk_fp8_f32(o[4] * H_SCALE, o[5] * H_SCALE, w1, false); w1 = __builtin_amdgcn_cvt_pk_fp8_f32(o[6] * H_SCALE, o[7] * H_SCALE, w1, true);
            pd.val[q8] = (u32x2){(unsigned)w0, (unsigned)w1}; }
    }
    __device__ __forceinline__ void store_one(const u32x2 v, const LAS int* ids, const int r, const int nv, const int j0) const { if (r < nv) { const int slot = ids[r]; *(u32x2*)((unsigned char*)H + (size_t)slot * 1024 + j0) = v; } }
    __device__ __forceinline__ void operator()(const f32x4 (&acc)[2][2][4][2], const Unit& u, int wr, int wc, int fr, int fq, const LAS int* ids, const int nv, const f32x4 (&bp)[4]) const {
        constexpr float ASC = MOE_F8 ? 1.0f / W1_SCALE : 1.0f;
        constexpr float HS = MOE_F8 ? H_SCALE : 1.0f, KK = -1.702f * LOG2E, GA = ASC * KK, UA = ASC * HS / KK, ULO = 8.0f * HS / KK, UHI = -6.0f * HS / KK, GLO = 7.0f * KK;
        const int j0 = u.pn * HALF + wc * 32 + 8 * fq;
        const f32x4 bg0 = bp[0] * KK, bg1 = bp[1] * KK; f32x4 bu0 = (bp[2] + 1.0f) * (HS / KK), bu1 = (bp[3] + 1.0f) * (HS / KK);
        asm volatile("" : "+v"(bu0), "+v"(bu1));
        int rb = wr * 64 + fr; asm volatile("" : "+v"(rb));
        const LAS int* idp = ids + rb; int slots[8];
#pragma unroll
        for (int q = 0; q < 8; ++q) slots[q] = idp[(q >> 2) * HALF + (q & 3) * 16];
#pragma unroll
        for (int ai = 0; ai < 2; ++ai)
#pragma unroll
            for (int m = 0; m < 4; ++m) { const int r = ai * HALF + m * 16 + rb;
                if (r < nv) { const int slot = slots[ai * 4 + m];
                    float o[8];
#pragma unroll
                    for (int q = 0; q < 8; ++q) { const float gb = (q < 4 ? bg0[q & 3] : bg1[q & 3]), ub = (q < 4 ? bu0[q & 3] : bu1[q & 3]);
                        const float gp = fmaxf(__builtin_fmaf(acc[ai][0][m][q >> 2][q & 3], GA, gb), GLO);
                        const float us = fminf(fmaxf(__builtin_fmaf(acc[ai][1][m][q >> 2][q & 3], UA, ub), ULO), UHI);
                        const float sg = __builtin_amdgcn_rcpf(1.0f + __builtin_amdgcn_exp2f(gp));
                        o[q] = us * (gp * sg); }
                    if constexpr (MOE_F8) { int w0 = 0, w1 = 0;
                        w0 = __builtin_amdgcn_cvt_pk_fp8_f32(o[0], o[1], w0, false); w0 = __builtin_amdgcn_cvt_pk_fp8_f32(o[2], o[3], w0, true);
                        w1 = __builtin_amdgcn_cvt_pk_fp8_f32(o[4], o[5], w1, false); w1 = __builtin_amdgcn_cvt_pk_fp8_f32(o[6], o[7], w1, true);
                        *(u32x2*)((unsigned char*)H + (size_t)slot * 1024 + j0) = (u32x2){(unsigned)w0, (unsigned)w1};
                    } else { u32x4 w; w.x = cvt_pk_bf16(o[0], o[1]); w.y = cvt_pk_bf16(o[2], o[3]); w.z = cvt_pk_bf16(o[4], o[5]); w.w = cvt_pk_bf16(o[6], o[7]);
                        *(u32x4*)(H + (size_t)slot * 1024 + j0) = w; } } }
    }
};
struct EpiMoeOut {
    static constexpr bool PERM = true; static constexpr bool HAS_GATE = true; static constexpr bool HAS_BIAS = true;
    __device__ __forceinline__ void load_bias(const Unit& u, int wc, int fq, f32x4 (&bp)[4]) const { const float* bb = b2 + (size_t)u.e * 1024 + u.pn * BM + wc * 32 + 8 * fq; bp[0] = *(const f32x4*)bb; bp[1] = *(const f32x4*)(bb + 4); bp[2] = *(const f32x4*)(bb + HALF); bp[3] = *(const f32x4*)(bb + HALF + 4); }
    bf16_t* Y; const float* b2;   const float* gidx;
    __device__ __forceinline__ void operator()(const f32x4 (&acc)[2][2][4][2], const Unit& u, int wr, int wc, int fr, int fq, const LAS int* ids, const int nv, const f32x4 (&bp)[4]) const {
        const LAS float* gts = (const LAS float*)(ids + 768);
        constexpr float OSC = MOE_F8 ? 1.0f / (H_SCALE * W2_SCALE) : 1.0f;
        const int c0 = u.pn * BM + wc * 32 + 8 * fq;
        f32x4 bv[2][2]; bv[0][0] = bp[0]; bv[0][1] = bp[1]; bv[1][0] = bp[2]; bv[1][1] = bp[3];
        int rb = wr * 64 + fr; asm volatile("" : "+v"(rb));
        const LAS int* idp = ids + rb; int slots[8];
#pragma unroll
        for (int q = 0; q < 8; ++q) slots[q] = idp[(q >> 2) * HALF + (q & 3) * 16];
#pragma unroll
        for (int ai = 0; ai < 2; ++ai)
#pragma unroll
            for (int m = 0; m < 4; ++m) { const int r = ai * HALF + m * 16 + rb;
                if (r < nv) { const int slot = slots[ai * 4 + m]; const float gt = gts[r];
                    if constexpr (Y_F8) {
                        unsigned pk[2][2];
#pragma unroll
                        for (int bj = 0; bj < 2; ++bj) { const f32x4 s0 = (acc[ai][bj][m][0] * OSC + bv[bj][0]) * (gt * Y_SCALE), s1 = (acc[ai][bj][m][1] * OSC + bv[bj][1]) * (gt * Y_SCALE); int w0 = 0, w1 = 0;
                            w0 = __builtin_amdgcn_cvt_pk_fp8_f32(s0[0], s0[1], w0, false); w0 = __builtin_amdgcn_cvt_pk_fp8_f32(s0[2], s0[3], w0, true); w1 = __builtin_amdgcn_cvt_pk_fp8_f32(s1[0], s1[1], w1, false); w1 = __builtin_amdgcn_cvt_pk_fp8_f32(s1[2], s1[3], w1, true);
                            pk[bj][0] = (unsigned)w0; pk[bj][1] = (unsigned)w1; }
                        const auto x0 = __builtin_amdgcn_permlane16_swap(pk[0][0], pk[1][0], false, false), x1 = __builtin_amdgcn_permlane16_swap(pk[0][1], pk[1][1], false, false);
                        *(u32x4*)((unsigned char*)Y + (size_t)slot * 1024 + c0 + ((fq & 1) ? 120 : 0)) = (u32x4){x0[0], x1[0], x0[1], x1[1]};
                    } else {
#pragma unroll
                    for (int bj = 0; bj < 2; ++bj) { const f32x4 v0 = (acc[ai][bj][m][0] * OSC + bv[bj][0]) * gt, v1 = (acc[ai][bj][m][1] * OSC + bv[bj][1]) * gt;
                        u32x4 w; w.x = cvt_pk_bf16(v0[0], v0[1]); w.y = cvt_pk_bf16(v0[2], v0[3]); w.z = cvt_pk_bf16(v1[0], v1[1]); w.w = cvt_pk_bf16(v1[2], v1[3]);
                        if (NT_STORE) __builtin_nontemporal_store(w, (u32x4*)(Y + (size_t)slot * 1024 + c0 + bj * HALF)); else *(u32x4*)(Y + (size_t)slot * 1024 + c0 + bj * HALF) = w; } } } }
    }
};

__device__ __forceinline__ const char* uni_ptr(const char* p) { const unsigned long long v = (unsigned long long)p; const unsigned lo = __builtin_amdgcn_readfirstlane((unsigned)v), hi = __builtin_amdgcn_readfirstlane((unsigned)(v >> 32)); return (const char*)(((unsigned long long)hi << 32) | lo); }
typedef int v4i_t __attribute__((ext_vector_type(4))); typedef int v8i_t __attribute__((ext_vector_type(8)));
__device__ __forceinline__ v8i_t cat8(const bf16x8 a, const bf16x8 b) { return __builtin_shufflevector(__builtin_bit_cast(v4i_t, a), __builtin_bit_cast(v4i_t, b), 0, 1, 2, 3, 4, 5, 6, 7); }
template <class Epi, class Sched, bool GATHER, bool F8 = false, bool DEFER = false>
__device__ __forceinline__ void gemm_phase(LAS unsigned char* lds, const Sched& S, const Epi& E, const int tid) {
    const int wid = __builtin_amdgcn_readfirstlane(tid >> 6), lane = tid & 63, wr = wid >> 2, wc = wid & 3, fr = lane & 15, fq = lane >> 4;
    const int KB = S.KB, nt = KB / 128;
    unsigned voffA[2], voffB[2];
#pragma unroll
    for (int i = 0; i < 2; ++i) { int R, C; stage_rc(tid * 16 + i * 8192, R, C); const int Rb = Epi::PERM ? ((R & ~31) + perm32(R & 31)) : R;
        voffA[i] = (unsigned)(R * KB + C * 2); voffB[i] = (unsigned)(Rb * KB + C * 2); }
    const size_t kstep = (size_t)(BK * 2);
    const size_t hstep = (size_t)HALF * KB;
    const unsigned ldsw = (unsigned)wid * 1024u;
    const int aoff = lds_byte(wr * 64 + fr, fq * 8), boff = lds_byte(wc * 32 + fr, fq * 8);
#define PG8_SA(b, h) (((b) * 2 + (h)) * HTB)
#define PG8_SB(b, h) ((4 + (b) * 2 + (h)) * HTB)
#define PG8_STAGE(bufoff, gbase, voff) do { const char* _gb = uni_ptr((const char*)(gbase)); _Pragma("unroll") for (int _i = 0; _i < 2; ++_i) \
        __builtin_amdgcn_global_load_lds((const unsigned*)(_gb + (voff)[_i]), (LAS unsigned*)(lds + (bufoff) + ldsw + _i * 8192), 16, 0, 0); } while (0)
#define PG8_STAGE_A(bufoff, kb, h, GO) do { if constexpr (GATHER) { PG8_STAGE(bufoff, kb, (GO)[h]); } else { PG8_STAGE(bufoff, (kb) + (h) * hstep, voffA); } } while (0)
#define PG8_LDA(dst, b, h) do { if constexpr (F8) { _Pragma("unroll") for (int m = 0; m < 4; ++m) dst##8[m] = cat8(*(const LAS bf16x8*)(lds + PG8_SA(b, h) + aoff + m * 2048), *(const LAS bf16x8*)(lds + PG8_SA(b, h) + aoff + m * 2048 + 1024)); } else { \
        _Pragma("unroll") for (int m = 0; m < 4; ++m) _Pragma("unroll") for (int k = 0; k < 2; ++k) dst[m][k] = *(const LAS bf16x8*)(lds + PG8_SA(b, h) + aoff + m * 2048 + k * 1024); } } while (0)
#define PG8_LDB(dst, b, h) do { if constexpr (F8) { _Pragma("unroll") for (int n = 0; n < 2; ++n) dst##8[n] = cat8(*(const LAS bf16x8*)(lds + PG8_SB(b, h) + boff + n * 2048), *(const LAS bf16x8*)(lds + PG8_SB(b, h) + boff + n * 2048 + 1024)); } else { \
        _Pragma("unroll") for (int n = 0; n < 2; ++n) _Pragma("unroll") for (int k = 0; k < 2; ++k) dst[n][k] = *(const LAS bf16x8*)(lds + PG8_SB(b, h) + boff + n * 2048 + k * 1024); } } while (0)
#define PG8_MMA(ai, bj, At, Bt) do { __builtin_amdgcn_s_setprio(1); if constexpr (F8) { _Pragma("unroll") for (int m = 0; m < 4; ++m) _Pragma("unroll") for (int n = 0; n < 2; ++n) \
        acc[ai][bj][m][n] = __builtin_amdgcn_mfma_scale_f32_16x16x128_f8f6f4(Bt##8[n], At##8[m], acc[ai][bj][m][n], 0, 0, 0, 0, 0, 0); } else { \
        _Pragma("unroll") for (int m = 0; m < 4; ++m) _Pragma("unroll") for (int n = 0; n < 2; ++n) _Pragma("unroll") for (int k = 0; k < 2; ++k) \
        acc[ai][bj][m][n] = __builtin_amdgcn_mfma_f32_16x16x32_bf16(Bt[n][k], At[m][k], acc[ai][bj][m][n], 0, 0, 0); } __builtin_amdgcn_s_setprio(0); } while (0)
#define PG8_WAIT_V(n) asm volatile("s_waitcnt vmcnt(" #n ")" ::: "memory")
#define PG8_WAIT_L(n) asm volatile("s_waitcnt lgkmcnt(" #n ")" ::: "memory")
#define PG8_BAR __builtin_amdgcn_s_barrier()
#define PG8_SCHED __builtin_amdgcn_sched_barrier(0)
    LAS int* const ibuf = (LAS int*)(lds + STAGE_BYTES + 512);
#define PG8_IDMA(u, b) do { if constexpr (GATHER) { __builtin_amdgcn_global_load_lds((const unsigned*)(S.idx_src(u) + 64 * (wid & 3) + lane), (LAS unsigned*)(ibuf + (b) * 256 + 64 * (wid & 3)), 4, 0, 0); \
        if constexpr (Epi::HAS_GATE) __builtin_amdgcn_global_load_lds((const unsigned*)(E.gidx + (S.idx_src(u) - S.idx) + 64 * (wid & 3) + lane), (LAS unsigned*)(ibuf + 768 + (b) * 256 + 64 * (wid & 3)), 4, 0, 0); } } while (0)
#define PG8_GOFF(dst, u, b) do { if constexpr (GATHER) { int _t = tid; asm volatile("" : "+v"(_t)); const int _nv = S.nvalid(u); _Pragma("unroll") for (int _i = 0; _i < 2; ++_i) { int _R, _C; stage_rc(_t * 16 + _i * 8192, _R, _C); \
        _Pragma("unroll") for (int _h = 0; _h < 2; ++_h) { const int _r = _R + _h * HALF; const unsigned _s = (unsigned)ibuf[(b) * 256 + (_r < _nv ? _r : 0)]; dst[_h][_i] = (_s >> Sched::ROW_SHIFT) * (unsigned)KB + (unsigned)_C * 2u; } } } } while (0)
    Unit cur, nxt; int ui = 0;
    if (!S.next(0, cur)) return;
    f32x4 acc[2][2][4][2];
#pragma unroll
    for (int a = 0; a < 2; ++a)
#pragma unroll
        for (int b = 0; b < 2; ++b)
#pragma unroll
            for (int m = 0; m < 4; ++m)
#pragma unroll
                for (int n = 0; n < 2; ++n) acc[a][b][m][n] = (f32x4){0.f, 0.f, 0.f, 0.f};
    bf16x8 At[4][2], B0[2][2], B1[2][2];
    v8i_t At8[4], B08[2], B18[2];
    unsigned gA[2][2] = {{0u, 0u}, {0u, 0u}}, gN[2][2] = {{0u, 0u}, {0u, 0u}};
    int bsel = 0;
    f32x4 bpre[4] = {(f32x4){0.f, 0.f, 0.f, 0.f}, (f32x4){0.f, 0.f, 0.f, 0.f}, (f32x4){0.f, 0.f, 0.f, 0.f}, (f32x4){0.f, 0.f, 0.f, 0.f}};
    Pend pend; int ppn = 0, pnv = 0, pq = 8, pbuf = 0;
    if constexpr (DEFER) {
#pragma unroll
        for (int q = 0; q < 8; ++q) pend.val[q] = (u32x2){0u, 0u}; }
#define PG8_PSTORE() do { if constexpr (DEFER) { const int _l3 = lane_id_volatile(); const int _nv = (pq < 8) ? pnv : 0; \
        E.store_one(pend.val[0], ibuf + pbuf * 256, ((pq >> 2) & 1) * HALF + (pq & 3) * 16 + wr * 64 + (_l3 & 15), _nv, ppn * HALF + wc * 32 + 8 * (_l3 >> 4)); \
        _Pragma("unroll") for (int _q = 0; _q < 7; ++_q) pend.val[_q] = pend.val[_q + 1]; ++pq; } } while (0)
    if constexpr (GATHER) { PG8_IDMA(cur, 0); PG8_WAIT_V(0); PG8_BAR; }
    PG8_GOFF(gA, cur, 0);
    const char* cA = S.a_base(cur); const char* cB = S.b_base(cur);
    PG8_STAGE(PG8_SB(0, 0), cB, voffB); PG8_STAGE(PG8_SB(0, 1), cB + hstep, voffB); PG8_STAGE_A(PG8_SA(0, 0), cA, 0, gA); PG8_STAGE_A(PG8_SA(0, 1), cA, 1, gA);
    if (wr == 1) PG8_BAR;
    PG8_WAIT_V(2); PG8_BAR;
    PG8_STAGE(PG8_SB(1, 0), cB + kstep, voffB); PG8_STAGE_A(PG8_SA(1, 0), cA + kstep, 0, gA); PG8_STAGE(PG8_SB(1, 1), cB + hstep + kstep, voffB);
    PG8_WAIT_V(6); PG8_BAR;
    for (;;) {
        const bool has_next = S.next(ui + 1, nxt);
        const char* nA = has_next ? S.a_base(nxt) : cA; const char* nB = has_next ? S.b_base(nxt) : cB;
        const int bnxt = (bsel == 2) ? 0 : bsel + 1;
        if constexpr (GATHER) { if (has_next) PG8_IDMA(nxt, bnxt); }
        for (int t = 0; t < nt; t += 2) {
            const bool last = (t == nt - 2);
            const char* a1 = cA + (size_t)(t + 1) * kstep;
            const char* a2 = last ? nA : cA + (size_t)(t + 2) * kstep; const char* b2 = last ? nB : cB + (size_t)(t + 2) * kstep;
            const char* a3 = a2 + kstep; const char* b3 = b2 + kstep;
            if constexpr (GATHER) { if (last && has_next) { PG8_GOFF(gN, nxt, bnxt); } }
            if constexpr (Epi::HAS_BIAS) { if (last) E.load_bias(cur, wc, lane_id_volatile() >> 4, bpre); }
            PG8_LDB(B0, 0, 0); PG8_LDB(B1, 0, 1); PG8_SCHED; PG8_LDA(At, 0, 0); PG8_STAGE_A(PG8_SA(1, 1), a1, 1, gA);
            if constexpr (GATHER) { if (last && has_next) { gA[0][0] = gN[0][0]; gA[0][1] = gN[0][1]; gA[1][0] = gN[1][0]; gA[1][1] = gN[1][1]; } }
            PG8_WAIT_V(8); PG8_WAIT_L(0); PG8_BAR; PG8_MMA(0, 0, At, B0); PG8_MMA(0, 1, At, B1); PG8_BAR; PG8_SCHED;
            PG8_LDA(At, 0, 1); PG8_STAGE(PG8_SB(0, 0), b2, voffB); PG8_STAGE(PG8_SB(0, 1), b2 + hstep, voffB); PG8_STAGE_A(PG8_SA(0, 0), a2, 0, gA);
            PG8_WAIT_V(8); PG8_WAIT_L(0); PG8_BAR; PG8_MMA(1, 0, At, B0); PG8_MMA(1, 1, At, B1); PG8_BAR; PG8_SCHED;
            PG8_PSTORE();
            PG8_LDB(B0, 1, 0); PG8_LDB(B1, 1, 1); PG8_SCHED; PG8_LDA(At, 1, 0); PG8_STAGE_A(PG8_SA(0, 1), a2, 1, gA);
            PG8_WAIT_V(8); PG8_WAIT_L(0); PG8_BAR; PG8_MMA(0, 0, At, B0); PG8_MMA(0, 1, At, B1); PG8_BAR; PG8_SCHED;
            PG8_LDA(At, 1, 1); PG8_STAGE(PG8_SB(1, 0), b3, voffB); PG8_STAGE(PG8_SB(1, 1), b3 + hstep, voffB); PG8_STAGE_A(PG8_SA(1, 0), a3, 0, gA);
            PG8_WAIT_V(8); PG8_WAIT_L(0); PG8_BAR; PG8_MMA(1, 0, At, B0); PG8_MMA(1, 1, At, B1); PG8_BAR; PG8_SCHED;
            PG8_PSTORE();
        }
        if (ALIGN_EPI) { if (wr == 0) PG8_BAR; }
        { const int l2 = lane_id_volatile(), fr2 = l2 & 15, fq2 = l2 >> 4;
          if constexpr (DEFER) { _Pragma("unroll") for (int _f = 0; _f < 8; ++_f) PG8_PSTORE();
              E.prepare(acc, cur, wr, wc, fr2, fq2, pend); ppn = cur.pn; pnv = S.nvalid(cur); pq = 0; pbuf = bsel; }
          else if constexpr (GATHER) E(acc, cur, wr, wc, fr2, fq2, ibuf + bsel * 256, S.nvalid(cur), bpre); else E(acc, cur, wr, wc, fr2, fq2); }
        if (!has_next) break;
#pragma unroll
        for (int a = 0; a < 2; ++a)
#pragma unroll
            for (int b = 0; b < 2; ++b)
#pragma unroll
                for (int m = 0; m < 4; ++m)
#pragma unroll
                    for (int n = 0; n < 2; ++n) acc[a][b][m][n] = (f32x4){0.f, 0.f, 0.f, 0.f};
        cur = nxt; cA = nA; cB = nB; ++ui; bsel = bnxt;
        if (ALIGN_EPI) { if (wr == 1) PG8_BAR; }
    }
    if constexpr (DEFER) { _Pragma("unroll") for (int _f = 0; _f < 8; ++_f) PG8_PSTORE(); }
    PG8_WAIT_V(0);
    if (!ALIGN_EPI) { if (wr == 0) PG8_BAR; }
    PG8_BAR;
#undef PG8_PSTORE
#undef PG8_SA
#undef PG8_SB
#undef PG8_STAGE
#undef PG8_STAGE_A
#undef PG8_LDA
#undef PG8_LDB
#undef PG8_MMA
#undef PG8_WAIT_V
#undef PG8_WAIT_L
#undef PG8_BAR
#undef PG8_SCHED
#undef PG8_GOFF
#undef PG8_IDMA
}
}

namespace attn_body {
using bf16=__hip_bfloat16;
using bf16x8=__attribute__((ext_vector_type(8)))short;
using s16x4=__attribute__((ext_vector_type(4)))short;
using f32x16=__attribute__((ext_vector_type(16)))float;
using u32x4=__attribute__((ext_vector_type(4)))unsigned;
constexpr int D=64;
constexpr int NW=8,QBLK=32,QB=QBLK*NW,KVBLK=64;
constexpr int ATTN_UNIT_ROWS=QB;
__device__ __forceinline__ int crow(int r,int hi){return (r&3)+8*(r>>2)+4*hi;}
#define SBAR() __builtin_amdgcn_sched_barrier(0)
__device__ __forceinline__ void cmask(f32x16&p0,f32x16&p1,int jb,int qrel,int hi){
  const float NEG=-INFINITY; int kb=64*jb+4*hi;
  #pragma unroll
  for(int r=0;r<16;++r){int kv=kb+(r&3)+8*(r>>2); if(kv>qrel)p0[r]=NEG; if(kv+32>qrel)p1[r]=NEG;}
}

constexpr int NSLOT=3, SLOTB=8192;
constexpr int LDS_K=0, LDS_V=NSLOT*SLOTB, LDS_WS=2*NSLOT*SLOTB, LDS_OST=LDS_WS+NW*64*4, LDS_BYTES=LDS_OST+NW*4096;
constexpr float C2=0.125f*1.4426950408889634f;
__device__ __forceinline__ void glds16(const void*gsrc,unsigned lds_dst){unsigned keep;
  asm volatile("s_mov_b32 %0, m0\n\ts_mov_b32 m0, %2\n\ts_nop 0\n\tglobal_load_lds_dwordx4 %1, off\n\ts_mov_b32 m0, %0":"=&s"(keep):"v"(gsrc),"s"(lds_dst):"memory");}
__device__ __forceinline__ float max3f(float a,float b,float c){float r;asm("v_max3_f32 %0, %1, %2, %3":"=v"(r):"v"(a),"v"(b),"v"(c));return r;}
__device__ __forceinline__ float max2f(float a,float b){float r;asm("v_max_f32_e32 %0, %1, %2":"=v"(r):"v"(a),"v"(b));return r;}
__device__ __forceinline__ float fadd_s(float a,float b){float r;asm("v_add_f32_e32 %0, %1, %2":"=v"(r):"v"(a),"v"(b));return r;}
__device__ __forceinline__ float fsub_s(float a,float b){float r;asm("v_sub_f32_e32 %0, %1, %2":"=v"(r):"v"(a),"v"(b));return r;}
typedef float f32x2_t __attribute__((ext_vector_type(2))); typedef __bf16 bf16x2_t __attribute__((ext_vector_type(2)));
__device__ __forceinline__ unsigned cvtpk_s(float lo,float hi){f32x2_t v={lo,hi};bf16x2_t b=__builtin_convertvector(v,bf16x2_t);return __builtin_bit_cast(unsigned,b);}
#define WAIT_BAR(N) asm volatile("s_waitcnt vmcnt(" #N ") lgkmcnt(0)\n\ts_barrier":::"memory")

__device__ __forceinline__ void qkt(f32x16&p0,f32x16&p1,const char*Kslot,const bf16x8*qr,const f32x16&negm,int r32,int hi){
  const char*kb=Kslot+hi*1024+r32*16;
  #pragma unroll
  for(int d0=0;d0<4;++d0){
    const bf16x8 b0=*reinterpret_cast<const bf16x8*>(kb+d0*2048);
    const bf16x8 b1=*reinterpret_cast<const bf16x8*>(kb+d0*2048+512);
    if(d0==0){p0=__builtin_amdgcn_mfma_f32_32x32x16_bf16(b0,qr[0],negm,0,0,0);p1=__builtin_amdgcn_mfma_f32_32x32x16_bf16(b1,qr[0],negm,0,0,0);}
    else{p0=__builtin_amdgcn_mfma_f32_32x32x16_bf16(b0,qr[d0],p0,0,0,0);p1=__builtin_amdgcn_mfma_f32_32x32x16_bf16(b1,qr[d0],p1,0,0,0);}}
}
typedef __attribute__((address_space(3))) const char* lds_cptr;
typedef short v4i16_t __attribute__((ext_vector_type(4)));
__device__ __forceinline__ void kload8(bf16x8*kf,lds_cptr kp){
  kf[0]=*(const __attribute__((address_space(3))) bf16x8*)(kp);      kf[1]=*(const __attribute__((address_space(3))) bf16x8*)(kp+512);
  kf[2]=*(const __attribute__((address_space(3))) bf16x8*)(kp+2048); kf[3]=*(const __attribute__((address_space(3))) bf16x8*)(kp+2560);
  kf[4]=*(const __attribute__((address_space(3))) bf16x8*)(kp+4096); kf[5]=*(const __attribute__((address_space(3))) bf16x8*)(kp+4608);
  kf[6]=*(const __attribute__((address_space(3))) bf16x8*)(kp+6144); kf[7]=*(const __attribute__((address_space(3))) bf16x8*)(kp+6656);
}
__device__ __forceinline__ void kload2(bf16x8*kf,lds_cptr kp,int j){ kf[2*j]=*(const __attribute__((address_space(3))) bf16x8*)(kp+j*2048); kf[2*j+1]=*(const __attribute__((address_space(3))) bf16x8*)(kp+j*2048+512); }
__device__ __forceinline__ s16x4 vtr(lds_cptr p){ return __builtin_bit_cast(s16x4,__builtin_amdgcn_ds_read_tr16_b64_v4i16((__attribute__((address_space(3))) v4i16_t*)p)); }
__device__ __forceinline__ float rowmax(const f32x16&p0,const f32x16&p1){
  float a=max3f(p0[0],p0[1],p1[0]),b=max3f(p0[2],p0[3],p1[1]);a=max3f(a,p1[2],p1[3]);
  #pragma unroll
  for(int r=4;r<16;r+=4){a=max3f(a,p0[r],p0[r+1]);b=max3f(b,p0[r+2],p0[r+3]);a=max3f(a,p1[r],p1[r+1]);b=max3f(b,p1[r+2],p1[r+3]);}
  const float m=max2f(a,b);
  auto rr=__builtin_amdgcn_permlane32_swap(__float_as_uint(m),__float_as_uint(m),false,false);
  return max2f(__uint_as_float(rr[0]),__uint_as_float(rr[1]));
}
__device__ __forceinline__ void pv(f32x16*o,int vb,bf16x8 pa0,bf16x8 pa1,bf16x8 pa2,bf16x8 pa3){
  #pragma unroll
  for(int d0=0;d0<2;++d0){s16x4 lo[4],hi[4];
    #pragma unroll
    for(int ks=0;ks<4;++ks){
      asm volatile("ds_read_b64_tr_b16 %0,%1 offset:%c2":"=&v"(lo[ks]):"v"(vb),"i"(d0*4096+ks*1024):"memory");
      asm volatile("ds_read_b64_tr_b16 %0,%1 offset:%c2":"=&v"(hi[ks]):"v"(vb),"i"(d0*4096+ks*1024+512):"memory");}
    asm volatile("s_waitcnt lgkmcnt(0)":::"memory");SBAR();
    #define PK(k) (bf16x8){lo[k][0],lo[k][1],lo[k][2],lo[k][3],hi[k][0],hi[k][1],hi[k][2],hi[k][3]}
    o[d0]=__builtin_amdgcn_mfma_f32_32x32x16_bf16(pa0,PK(0),o[d0],0,0,0);
    o[d0]=__builtin_amdgcn_mfma_f32_32x32x16_bf16(pa1,PK(1),o[d0],0,0,0);
    o[d0]=__builtin_amdgcn_mfma_f32_32x32x16_bf16(pa2,PK(2),o[d0],0,0,0);
    o[d0]=__builtin_amdgcn_mfma_f32_32x32x16_bf16(pa3,PK(3),o[d0],0,0,0);
    #undef PK
  }
}

#ifndef ATTN_STORE16
#define ATTN_STORE16(p,v) (*(u32x4*)(p)=(v))
#endif
template<int THRL, bool O8 = false> __device__ __forceinline__ void attn_unit(const bf16*Qu,const bf16*__restrict__ Kh,const bf16*__restrict__ Vh,bf16*Ou,const int QP,const int KP,const int VP,const int OP,const int NT,char*shm,const int tid){
  const int lane=tid&63,r32=lane&31,hi=lane>>5; const int wid=__builtin_amdgcn_readfirstlane(tid>>6);
  const bf16*Qw=Qu+(long)(wid*QBLK)*QP;
  const unsigned lds0=(unsigned)(uintptr_t)shm;
  float*wsf=(float*)(shm+LDS_WS)+wid*64;
  const bf16*ksrc=Kh+(long)lane*KP+wid*8;
  const bf16*vsrc=Vh+(long)(16*(wid&3)+(lane>>2))*VP+(wid>>2)*32+(lane&3)*8;
  const unsigned kdst=lds0+LDS_K+wid*1024, vdst=lds0+LDS_V+wid*1024;
  #define DMA_K(t,slot) glds16(ksrc+(long)(t)*KVBLK*KP,(unsigned)__builtin_amdgcn_readfirstlane(kdst+(slot)))
  #define DMA_V(t,slot) glds16(vsrc+(long)(t)*KVBLK*VP,(unsigned)__builtin_amdgcn_readfirstlane(vdst+(slot)))
  const int vb0=(int)(lds0+LDS_V)+((lane>>4)&1)*32+(lane&3)*8+(4*hi+((lane&15)>>2))*64;
  const char*Kbase=shm+LDS_K; bf16x8 kf[8];
  const lds_cptr shm3=(lds_cptr)shm; const lds_cptr kp0=shm3+LDS_K+hi*1024+r32*16; const lds_cptr vp0=shm3+LDS_V+((lane>>4)&1)*32+(lane&3)*8+(4*hi+((lane&15)>>2))*64;
  DMA_K(0,0);DMA_V(0,0);DMA_K(1,SLOTB);
  bf16x8 qr[4];
  #pragma unroll
  for(int d0=0;d0<4;++d0)qr[d0]=*reinterpret_cast<const bf16x8*>(&Qw[(long)r32*QP+d0*16+hi*8]);
  float mhat=0.f,l_reg=0.f;f32x16 o[2];f32x16 negm; { float z_=0.f; asm volatile("":"+v"(z_)); _Pragma("unroll") for(int r=0;r<16;++r){o[0][r]=z_;o[1][r]=z_;negm[r]=z_;} } asm volatile("":"+v"(negm));
  #define CMASK(P0,P1,t) do{}while(0)
  bool resc=false;
  #define START(P0,P1) do{ const float rm=rowmax(P0,P1); resc=false; \
    { const float dl=rm; mhat=fadd_s(mhat,dl); \
      _Pragma("unroll") for(int r=0;r<16;++r){P0[r]=fsub_s(P0[r],dl);P1[r]=fsub_s(P1[r],dl);} \
      _Pragma("unroll") for(int r=0;r<16;++r)negm[r]=-mhat; asm volatile("":"+v"(negm)); } \
    _Pragma("unroll") for(int r=0;r<16;++r)P0[r]=__builtin_amdgcn_exp2f(P0[r]); }while(0)
  #define RESC() do{ if(resc){ asm volatile("s_waitcnt lgkmcnt(0)":::"memory"); \
      _Pragma("unroll") for(int d_=0;d_<2;++d_) _Pragma("unroll") for(int r=0;r<16;++r)o[d_][r]*=wsf[crow(r,hi)]; } }while(0)
  f32x16 pA0,pA1,pB0,pB1;
  int sl_prev=0,sl_cur=0,sl_next=SLOTB;
  #define ROT() do{sl_prev=sl_cur;sl_cur=sl_next;sl_next=(sl_next==(NSLOT-1)*SLOTB)?0:sl_next+SLOTB;}while(0)
  DMA_K(2,2*SLOTB);
  WAIT_BAR(3);
  qkt(pA0,pA1,Kbase,qr,negm,r32,hi);asm volatile("s_nop 15\n\ts_nop 7":"+v"(pA0),"+v"(pA1));CMASK(pA0,pA1,0);
  START(pA0,pA1);
  _Pragma("unroll") for(int r=0;r<16;++r)pA1[r]=__builtin_amdgcn_exp2f(pA1[r]);
  WAIT_BAR(0);
  DMA_K(3,0);DMA_V(1,SLOTB);
  ROT();
  kload8(kf,kp0+sl_cur);
  WAIT_BAR(2);
  s16x4 vlo[8],vhi[8]; u32x4 pw0,pw1,pw2,pw3;
  #define PKW(P,B) cvtpk_s(P[B],P[B+1])
  #define PAF(k) __builtin_bit_cast(bf16x8,pw##k)
  #define VFR(i) (bf16x8){vlo[i][0],vlo[i][1],vlo[i][2],vlo[i][3],vhi[i][0],vhi[i][1],vhi[i][2],vhi[i][3]}
  #define PIN(x) asm volatile("":"+v"(x))
  #define MX3(a,b,c) __builtin_fmaxf(__builtin_fmaxf((a),(b)),(c))
  #define GAPA(MF,A0,A1,A2,A3,W0,W1,PW) do{ MF; sacc+=A0; sacc+=A1; sacc+=A2; sacc+=A3; PIN(sacc); W0; W1; PIN(PW); SBAR(); }while(0)
  #define EX(v) __builtin_amdgcn_exp2f(v)
  #define GAPB(MF,X,B) do{ MF; X[B]=EX(X[B]); X[B+1]=EX(X[B+1]); X[B+2]=EX(X[B+2]); X[B+3]=EX(X[B+3]); PIN(X); SBAR(); }while(0)
  #define VRD(i) do{ vlo[i]=vtr(vp_+(((i)>>2)*4096+((i)&3)*1024)); vhi[i]=vtr(vp_+(((i)>>2)*4096+((i)&3)*1024+512)); }while(0)
  #define KRD(G,j) do{ if(G){ kload2(kf,kp0+sl_next,j); SBAR(); } }while(0)
  #define STEP(C0,C1,P0,P1,t,GK,GV,GL) do{ SBAR(); \
    const lds_cptr vp_=vp0+sl_prev; \
    VRD(0); SBAR(); float sacc=(P0[0]+P0[1]); \
    GAPA(C0=__builtin_amdgcn_mfma_f32_32x32x16_bf16(kf[0],qr[0],negm,0,0,0), P0[2],P0[3],P0[4],P0[5],     pw0[0]=PKW(P0,0), pw0[1]=PKW(P0,2), pw0); \
    VRD(4); SBAR(); GAPA(C1=__builtin_amdgcn_mfma_f32_32x32x16_bf16(kf[1],qr[0],negm,0,0,0), P0[6],P0[7],P0[8],P0[9],     pw0[2]=PKW(P0,4), pw0[3]=PKW(P0,6), pw0); \
    VRD(1); SBAR(); GAPA(C0=__builtin_amdgcn_mfma_f32_32x32x16_bf16(kf[2],qr[1],C0,0,0,0),   P0[10],P0[11],P0[12],P0[13], pw1[0]=PKW(P0,8), pw1[1]=PKW(P0,10), pw1); \
    VRD(5); SBAR(); GAPA(C1=__builtin_amdgcn_mfma_f32_32x32x16_bf16(kf[3],qr[1],C1,0,0,0),   P0[14],P0[15],P1[0],P1[1],   pw1[2]=PKW(P0,12),pw1[3]=PKW(P0,14), pw1); \
    VRD(2); SBAR(); GAPA(C0=__builtin_amdgcn_mfma_f32_32x32x16_bf16(kf[4],qr[2],C0,0,0,0),   P1[2],P1[3],P1[4],P1[5],     pw2[0]=PKW(P1,0), pw2[1]=PKW(P1,2), pw2); \
    VRD(6); SBAR(); GAPA(C1=__builtin_amdgcn_mfma_f32_32x32x16_bf16(kf[5],qr[2],C1,0,0,0),   P1[6],P1[7],P1[8],P1[9],     pw2[2]=PKW(P1,4), pw2[3]=PKW(P1,6), pw2); \
    VRD(3); SBAR(); GAPA(C0=__builtin_amdgcn_mfma_f32_32x32x16_bf16(kf[6],qr[3],C0,0,0,0),   P1[10],P1[11],P1[12],P1[13], pw3[0]=PKW(P1,8), pw3[1]=PKW(P1,10), pw3); \
    VRD(7); SBAR(); GAPA(C1=__builtin_amdgcn_mfma_f32_32x32x16_bf16(kf[7],qr[3],C1,0,0,0),   P1[14],P1[15],0.f,0.f,       pw3[2]=PKW(P1,12),pw3[3]=PKW(P1,14), pw3); \
    l_reg+=sacc; \
    if(GK){DMA_K((t)+3,sl_cur);} if(GV){DMA_V((t)+1,sl_next);} \
    CMASK(C0,C1,t); \
    { float a=MX3(C0[0],C0[1],C1[0]),b=MX3(C0[2],C0[3],C1[1]); a=MX3(a,C1[2],C1[3]); \
      _Pragma("unroll") for(int r=4;r<16;r+=4){a=MX3(a,C0[r],C0[r+1]);b=MX3(b,C0[r+2],C0[r+3]);a=MX3(a,C1[r],C1[r+1]);b=MX3(b,C1[r+2],C1[r+3]);} \
      float rm=__builtin_fmaxf(a,b); { auto rr=__builtin_amdgcn_permlane32_swap(__float_as_uint(rm),__float_as_uint(rm),false,false); rm=__builtin_fmaxf(__uint_as_float(rr[0]),__uint_as_float(rr[1])); } \
      resc=false; \
      if(__builtin_expect(__any(rm>(float)THRL),0)){ const float dl=__builtin_fmaxf(rm,0.f); mhat+=dl; \
        _Pragma("unroll") for(int r=0;r<16;++r){C0[r]-=dl;C1[r]-=dl;} \
        _Pragma("unroll") for(int r=0;r<16;++r)negm[r]=-mhat; asm volatile("":"+v"(negm)); \
        const float f=__builtin_amdgcn_exp2f(-dl); l_reg*=f; if(hi==0)wsf[r32]=f; resc=true; } } \
    SBAR(); \
    GAPB(o[0]=__builtin_amdgcn_mfma_f32_32x32x16_bf16(PAF(0),VFR(0),o[0],0,0,0), C0,0); \
    GAPB(o[1]=__builtin_amdgcn_mfma_f32_32x32x16_bf16(PAF(0),VFR(4),o[1],0,0,0), C0,4); \
    KRD(GL,0); GAPB(o[0]=__builtin_amdgcn_mfma_f32_32x32x16_bf16(PAF(1),VFR(1),o[0],0,0,0), C0,8); \
    KRD(GL,1); GAPB(o[1]=__builtin_amdgcn_mfma_f32_32x32x16_bf16(PAF(1),VFR(5),o[1],0,0,0), C0,12); \
    KRD(GL,2); GAPB(o[0]=__builtin_amdgcn_mfma_f32_32x32x16_bf16(PAF(2),VFR(2),o[0],0,0,0), C1,0); \
    KRD(GL,3); GAPB(o[1]=__builtin_amdgcn_mfma_f32_32x32x16_bf16(PAF(2),VFR(6),o[1],0,0,0), C1,4); \
    GAPB(o[0]=__builtin_amdgcn_mfma_f32_32x32x16_bf16(PAF(3),VFR(3),o[0],0,0,0), C1,8); \
    GAPB(o[1]=__builtin_amdgcn_mfma_f32_32x32x16_bf16(PAF(3),VFR(7),o[1],0,0,0), C1,12); \
    }while(0)
  int t=1;
  #undef CMASK
  #define CMASK(P0,P1,t) do{}while(0)
  for(;t+5<NT;t+=2){
    STEP(pB0,pB1,pA0,pA1,t,true,true,true);     WAIT_BAR(2); RESC(); ROT();
    STEP(pA0,pA1,pB0,pB1,t+1,true,true,true);   WAIT_BAR(2); RESC(); ROT();
  }
  #undef CMASK
  #define CMASK(P0,P1,t) do{}while(0)
  #define ENDW(tt) do{ if((tt)+3<NT){WAIT_BAR(2);} else if((tt)+2<NT){WAIT_BAR(1);} else {WAIT_BAR(0);} }while(0)
  for(;t+1<NT;t+=2){
    STEP(pB0,pB1,pA0,pA1,t,(t+3<NT),(t+1<NT),(t+1<NT));       ENDW(t);   RESC(); ROT();
    STEP(pA0,pA1,pB0,pB1,t+1,(t+4<NT),(t+2<NT),(t+2<NT));     ENDW(t+1); RESC(); ROT();
  }
  STEP(pB0,pB1,pA0,pA1,NT-1,false,false,false); RESC();
  { float sacc=pB0[0]+pB0[1]; _Pragma("unroll") for(int r=2;r<16;++r)sacc+=pB0[r]; _Pragma("unroll") for(int r=0;r<16;++r)sacc+=pB1[r]; l_reg+=sacc;
    pw0=(u32x4){PKW(pB0,0),PKW(pB0,2),PKW(pB0,4),PKW(pB0,6)};pw1=(u32x4){PKW(pB0,8),PKW(pB0,10),PKW(pB0,12),PKW(pB0,14)};pw2=(u32x4){PKW(pB1,0),PKW(pB1,2),PKW(pB1,4),PKW(pB1,6)};pw3=(u32x4){PKW(pB1,8),PKW(pB1,10),PKW(pB1,12),PKW(pB1,14)};
    SBAR(); pv(o,vb0+sl_cur,PAF(0),PAF(1),PAF(2),PAF(3)); }
  #undef PKW
  #undef PAF
  #undef VFR
  #undef PIN
  #undef MX3
  #undef GAPA
  #undef GAPB
  #undef EX
  #undef VRD
  #undef KRD
  #undef STEP
  #undef ENDW
  {auto rr=__builtin_amdgcn_permlane32_swap(__float_as_uint(l_reg),__float_as_uint(l_reg),false,false);l_reg=__uint_as_float(rr[0])+__uint_as_float(rr[1]);}
  if(hi==0)wsf[32+r32]=l_reg;asm volatile("s_waitcnt lgkmcnt(0)":::"memory");
  float rli[16];
  #pragma unroll
  for(int r=0;r<16;++r)rli[r]=__builtin_amdgcn_rcpf(wsf[32+crow(r,hi)]);
  if constexpr (O8) {
    unsigned char*Ow8=(unsigned char*)Ou+(long)(wid*QBLK)*OP; unsigned char*stg8=(unsigned char*)(shm+LDS_OST)+wid*2048;
    #pragma unroll
    for(int r=0;r<16;++r){const int orow=crow(r,hi);
      #pragma unroll
      for(int d0=0;d0<2;++d0)stg8[orow*64+d0*32+r32]=f2fp8(o[d0][r]*rli[r]);}
    asm volatile("s_waitcnt lgkmcnt(0)":::"memory");
    #pragma unroll
    for(int i=0;i<2;++i){const int row=i*16+(lane>>2),ch=lane&3; const u32x4 v=*(const u32x4*)(stg8+row*64+ch*16); ATTN_STORE16(Ow8+(long)row*OP+ch*16,v);}
  } else {
  bf16*Ow=Ou+(long)(wid*QBLK)*OP;
  { bf16*stg=(bf16*)(shm+LDS_OST)+wid*2048;
    #pragma unroll
    for(int r=0;r<16;++r){const int orow=crow(r,hi);
      #pragma unroll
      for(int d0=0;d0<2;++d0)stg[orow*64+d0*32+r32]=__float2bfloat16(o[d0][r]*rli[r]);}
    asm volatile("s_waitcnt lgkmcnt(0)":::"memory");
    #pragma unroll
    for(int i=0;i<4;++i){const int row=i*8+(lane>>3),ch=lane&7; const u32x4 v=*(const u32x4*)(stg+row*64+ch*8); ATTN_STORE16(Ow+(long)row*OP+ch*8,v);} }
  }
  asm volatile("s_waitcnt lgkmcnt(0)\n\ts_barrier":::"memory");
  #undef DMA_K
  #undef DMA_V
  #undef CMASK
  #undef START
  #undef RESC
  #undef ROT
}
constexpr int ATTN_LDS_BYTES=LDS_BYTES;
#undef SBAR
#undef WAIT_BAR
}

struct Args { const float* in[32]; float* out; unsigned char* ws; int ph_lo, ph_hi; };
struct Ctx {
    LAS unsigned char* lds;
    int vcu, G;
    unsigned char* ws;
};
constexpr int PTAB_OFF = MISC_OFF + 256;
__device__ __forceinline__ unsigned long long ptab_get(const Ctx& cx, int k) {
    const LAS unsigned* t = (const LAS unsigned*)(cx.lds + PTAB_OFF) + 2 * k; const unsigned lo = __builtin_amdgcn_readfirstlane(t[0]), hi = __builtin_amdgcn_readfirstlane(t[1]);
    return ((unsigned long long)hi << 32) | lo;
}
#define INP(k) ((const float*)(GAS const float*)ptab_get(cx, (k)))

template <bool F8> __device__ __forceinline__ void p0_transpose64(const float* W, int N, int KB, unsigned char* WT, int k0, int n0, int dst_row0, float scale, LAS float* scr, int lane) {
    f32x4 v[16];
    const float* src = W + (size_t)(k0 + (lane >> 4)) * N + n0 + (lane & 15) * 4;
#pragma unroll
    for (int i = 0; i < 16; ++i) v[i] = *(const f32x4*)(src + (size_t)(4 * i) * N);
#pragma unroll
    for (int i = 0; i < 16; ++i) { LAS float* p = scr + (4 * i + (lane >> 4)) * 65 + (lane & 15) * 4; p[0] = v[i][0]; p[1] = v[i][1]; p[2] = v[i][2]; p[3] = v[i][3]; }
    LDS_WAIT(); asm volatile("" ::: "memory");
    if constexpr (!F8) {
        const int ns = lane >> 3, ch = lane & 7;
#pragma unroll
        for (int r8 = 0; r8 < 8; ++r8) { const int n = r8 * 8 + ns; const LAS float* s = scr + (8 * ch) * 65 + n;
            u32x4 o; o.x = pk2(s[0 * 65], s[1 * 65]); o.y = pk2(s[2 * 65], s[3 * 65]); o.z = pk2(s[4 * 65], s[5 * 65]); o.w = pk2(s[6 * 65], s[7 * 65]);
            *(GAS u32x4*)(WT + (size_t)(dst_row0 + n) * KB + (k0 + 8 * ch) * 2) = o; }
    } else {
        const int ns = lane >> 2, ch = lane & 3;
#pragma unroll
        for (int r4 = 0; r4 < 4; ++r4) { const int n = r4 * 16 + ns; const LAS float* s = scr + (16 * ch) * 65 + n; unsigned w[4];
#pragma unroll
            for (int q = 0; q < 4; ++q) { int r = 0; r = __builtin_amdgcn_cvt_pk_fp8_f32(s[(4 * q) * 65] * scale, s[(4 * q + 1) * 65] * scale, r, false); r = __builtin_amdgcn_cvt_pk_fp8_f32(s[(4 * q + 2) * 65] * scale, s[(4 * q + 3) * 65] * scale, r, true); w[q] = (unsigned)r; }
            *(GAS u32x4*)(WT + (size_t)(dst_row0 + n) * KB + k0 + 16 * ch) = (u32x4){w[0], w[1], w[2], w[3]}; }
    }
    LDS_WAIT(); asm volatile("" ::: "memory");
}
__device__ __forceinline__ void p0_prologue(const Ctx& cx, const int tid) {
    const int lane = tid & 63, wave = __builtin_amdgcn_readfirstlane(tid >> 6);
    LAS float* scr = (LAS float*)(cx.lds + wave * 16896);
    const int gw = cx.vcu * 8 + wave, NGW = cx.G * 8;
    constexpr int I_WIN0 = 16 * 40, I_WIN1 = 16 * 24, I_WKV = 16 * 8, I_WOUT = 16 * 16, I_W1 = 16 * 32, I_W2 = 16 * 16;
    constexpr int T_WIN = 3 * I_WIN0 + I_WIN1, T_WKV = 4 * I_WKV, T_WOUT = 4 * I_WOUT, T_W1 = 128 * I_W1, T_W2 = 128 * I_W2;
    constexpr int NITEMS = T_WIN + T_WKV + T_WOUT + T_W1 + T_W2;
    for (int it = gw; it < NITEMS; it += NGW) {
        int r = it;
        const float* W; unsigned char* WT; int N, nb, kb, dst_row0; bool isout = false;
        if (r < T_W1) {
            const int mi = r / I_W1, q = r % I_W1; N = 2048; kb = q / 32; nb = q % 32;
            W = INP(28) + (size_t)mi * 1024 * 2048; WT = cx.ws + WS_W1 + (size_t)mi * 2048 * 1024 * MOE_EB;
            const int n0 = nb * 64, isu = n0 >= 1024, j = n0 - isu * 1024;
            dst_row0 = (j >> 7) * 256 + isu * 128 + (j & 127);
            p0_transpose64<MOE_F8>(W, N, 1024 * MOE_EB, WT, kb * 64, nb * 64, dst_row0, W1_SCALE, scr, lane); continue;
        } else if ((r -= T_W1) < T_W2) {
            const int mi = r / I_W2, q = r % I_W2; N = 1024; kb = q / 16; nb = q % 16;
            W = INP(30) + (size_t)mi * 1024 * 1024; WT = cx.ws + WS_W2 + (size_t)mi * 1024 * 1024 * MOE_EB; dst_row0 = nb * 64;
            p0_transpose64<MOE_F8>(W, N, 1024 * MOE_EB, WT, kb * 64, nb * 64, dst_row0, W2_SCALE, scr, lane); continue;
        } else if ((r -= T_W2) < T_WIN) {
            int l, q;
            if (r < I_WIN0) { l = 0; q = r; } else if (r < I_WIN0 + I_WIN1) { l = 1; q = r - I_WIN0; } else if (r < 2 * I_WIN0 + I_WIN1) { l = 2; q = r - I_WIN0 - I_WIN1; } else { l = 3; q = r - 2 * I_WIN0 - I_WIN1; }
            N = in_width(l); const int nbn = N / 64; kb = q / nbn; nb = q % nbn;
            const int kind = layer_kind(l), j = layer_j(l);
            W = (kind == 0 ? INP(2) : kind == 1 ? INP(4) : INP(7)) + (size_t)j * 1024 * N;
            WT = cx.ws + WS_WIN + (size_t)l * 5 * MiB; dst_row0 = nb * 64;
        } else if ((r -= T_WIN) < T_WKV) {
            const int l = r / I_WKV, q = r % I_WKV; N = 512; kb = q / 8; nb = q % 8;
            W = INP(20) + (size_t)l * 1024 * 512; WT = cx.ws + WS_WKV; dst_row0 = l * 512 + nb * 64;
        } else {
            r -= T_WKV; const int l = r / I_WOUT, q = r % I_WOUT; N = 1024; kb = q / 16; nb = q % 16;
            W = INP(21) + (size_t)l * 1024 * 1024; WT = cx.ws + WS_WOUT + (size_t)l * 2 * MiB; dst_row0 = nb * 64; isout = true;
        }
        if (isout) p0_transpose64<OUTP_F8 != 0>(W, N, 1024 * OUT_EB, WT, kb * 64, nb * 64, dst_row0, OUTP_F8 ? WOUT_SCALE : 1.0f, scr, lane);
        else p0_transpose64<INP_F8 != 0>(W, N, 1024 * INP_EB, WT, kb * 64, nb * 64, dst_row0, INP_F8 ? WIN_SCALE : 1.0f, scr, lane);
    }
    {
        const size_t gt = (size_t)cx.vcu * 512 + tid, NT_ = (size_t)cx.G * 512;
        for (int which = 0; which < 2; ++which) {
            const f32x4* xs = (const f32x4*)(which == 0 ? INP(0) : INP(1)); unsigned char* xd = cx.ws + (which == 0 ? WS_XB : WS_MEMB); const size_t n8 = (size_t)(which == 0 ? NTOK : NMEM) * DM / 8;
#pragma unroll 4
            for (size_t i = gt; i < n8; i += NT_) { const f32x4 a = xs[2 * i], b = xs[2 * i + 1];
                if constexpr (INP_F8) { int w0 = 0, w1 = 0; w0 = __builtin_amdgcn_cvt_pk_fp8_f32(a[0], a[1], w0, false); w0 = __builtin_amdgcn_cvt_pk_fp8_f32(a[2], a[3], w0, true); w1 = __builtin_amdgcn_cvt_pk_fp8_f32(b[0], b[1], w1, false); w1 = __builtin_amdgcn_cvt_pk_fp8_f32(b[2], b[3], w1, true);
                    *(u32x2*)(xd + i * 8) = (u32x2){(unsigned)w0, (unsigned)w1}; }
                else { u32x4 o; o.x = pk2(a[0], a[1]); o.y = pk2(a[2], a[3]); o.z = pk2(b[0], b[1]); o.w = pk2(b[2], b[3]); *(u32x4*)(xd + i * 16) = o; } }
        }
    }
    {
        const float *fw1 = INP(10), *fb1 = INP(11), *fw2 = INP(12), *fb2 = INP(13), *fw3 = INP(14), *fb3 = INP(15), *fw4 = INP(16), *fb4 = INP(17), *ffr = INP(18);
        LAS float* z = (LAS float*)cx.lds; LAS float* h1 = z + 16 * 33; LAS float* h2 = h1 + 1024; LAS float* h3 = h2 + 1024;
        float* HRAWT = (float*)(cx.ws + WS_HRAWT); float* HPART = (float*)(cx.ws + WS_HPART);
        for (int it = cx.vcu; it < 256; it += cx.G) {
            __syncthreads();
            const int pos0 = it * 16;
            for (int i = tid; i < 16 * 33; i += 512) { const int p = i / 33, f = i % 33; const float pos = (float)(pos0 + p); float v;
                if (f == 0) v = pos / 4095.0f;
                else { const int k = (f - 1) & 15; const float fb = 1e-4f + (float)k * ((15.0f - 1e-4f) / 15.0f); const float ang = (6.283185307179586f * pos / 4096.0f) * fb; v = (f <= 16) ? cosf(ang) : -sinf(ang); }
                z[i] = v; }
            __syncthreads();
            for (int i = tid; i < 1024; i += 512) { const int p = i >> 6, o = i & 63; float a = fb1[o]; for (int f = 0; f < 33; ++f) a += z[p * 33 + f] * fw1[f * 64 + o]; h1[i] = sinf(ffr[o] * a); }
            __syncthreads();
            for (int i = tid; i < 1024; i += 512) { const int p = i >> 6, o = i & 63; float a = fb2[o]; for (int k = 0; k < 64; ++k) a += h1[p * 64 + k] * fw2[k * 64 + o]; h2[i] = sinf(ffr[o] * a); }
            __syncthreads();
            for (int i = tid; i < 1024; i += 512) { const int p = i >> 6, o = i & 63; float a = fb3[o]; for (int k = 0; k < 64; ++k) a += h2[p * 64 + k] * fw3[k * 64 + o]; h3[i] = sinf(ffr[o] * a); }
            __syncthreads();
            for (int col = tid; col < 3072; col += 512) {
                float a[16]; const float bb = fb4[col];
#pragma unroll
                for (int p = 0; p < 16; ++p) a[p] = bb;
                for (int k = 0; k < 64; ++k) { const float w = fw4[(size_t)k * 3072 + col];
#pragma unroll
                    for (int p = 0; p < 16; ++p) a[p] += h3[p * 64 + k] * w; }
                const int c = col % 768; const float mind = -3.0701134573253945f, maxd = -15.350567286626972f;
                const float delta = fabsf(mind + (maxd - mind) * ((float)c / 767.0f)); float asum = 0.f;
#pragma unroll
                for (int p = 0; p < 16; ++p) { const float t = (float)(pos0 + p) / 4095.0f; a[p] *= expf(-t * delta); asum += fabsf(a[p]); }
                f32x4* dst = (f32x4*)(HRAWT + (size_t)col * 4096 + pos0);
#pragma unroll
                for (int q = 0; q < 4; ++q) dst[q] = (f32x4){a[4 * q], a[4 * q + 1], a[4 * q + 2], a[4 * q + 3]};
                HPART[(size_t)it * 3072 + col] = asum;
            }
        }
    }
}

__device__ __forceinline__ s16x4 vtr(const LAS unsigned char* p) { typedef short v4i16_t __attribute__((ext_vector_type(4))); return __builtin_bit_cast(s16x4, __builtin_amdgcn_ds_read_tr16_b64_v4i16((LAS v4i16_t*)p)); }
__device__ __forceinline__ void na_phase(const Ctx& cx, const bf16_t* PROJ, const float* rpb, bf16_t* CAT, const int tid) {
    const int lane = tid & 63, wid = __builtin_amdgcn_readfirstlane(tid >> 6), m16 = lane & 15, q4 = lane >> 4;
    LAS unsigned char* Kb = cx.lds; LAS unsigned char* Vb = cx.lds + 73728; LAS float* biasL = (LAS float*)(cx.lds + 147456);
    constexpr int PW = 2560;
    u32x4 kv[9], vv[9]; float bpre = 0.f;
#define NA_LOAD(unit_) do { const int b_ = __builtin_amdgcn_readfirstlane((unit_) / 384), rem_ = __builtin_amdgcn_readfirstlane((unit_) % 384), h_ = rem_ >> 5, rp_ = rem_ & 31; int bs_ = 2 * rp_ - 4; bs_ = bs_ < 0 ? 0 : (bs_ > 56 ? 56 : bs_); bs_ = __builtin_amdgcn_readfirstlane(bs_); \
        _Pragma("unroll") for (int it = 0; it < 9; ++it) { const int i = tid + it * 512; const int brow = i >> 9, col = (i >> 3) & 63, ch = i & 7; int grow = bs_ + brow; grow = grow > 63 ? 63 : grow; \
            const size_t tok = (size_t)b_ * 4096 + grow * 64 + col; \
            kv[it] = *(const u32x4*)(PROJ + tok * PW + 768 + h_ * 64 + ch * 8); vv[it] = *(const u32x4*)(PROJ + tok * PW + 1536 + h_ * 64 + ch * 8); } \
        if (tid < 465) bpre = rpb[h_ * 465 + tid] * LOG2E; } while (0)
    int u0 = cx.vcu; asm volatile("" : "+s"(u0));
    if (u0 < 6144) NA_LOAD(u0);
    for (int unit = u0; unit < 6144; unit += cx.G) {
        const int b = unit / 384, rem = unit % 384, h = rem >> 5, rp = rem & 31;
        int bs = 2 * rp - 4; bs = bs < 0 ? 0 : (bs > 56 ? 56 : bs);
        __syncthreads();
#pragma unroll
        for (int it = 0; it < 9; ++it) { const int i = tid + it * 512; const int brow = i >> 9, col = (i >> 3) & 63, ch = i & 7;
            *(LAS u32x4*)(Kb + (brow * 64 + col) * 128 + ((ch ^ ((col >> 1) & 7)) << 4)) = kv[it];
            *(LAS u32x4*)(Vb + (brow * 64 + col) * 128 + ((ch ^ (col & 7)) << 4)) = vv[it]; }
        if (tid < 465) biasL[tid] = bpre;
        __syncthreads();
        if (unit + cx.G < 6144) NA_LOAD(unit + cx.G);
        const int r = 2 * rp + (wid >> 2), g = wid & 3;
        const int wc0 = (g == 0) ? 0 : (g == 1) ? 8 : (g == 2) ? 24 : 32;
        int r0 = r - 4; r0 = r0 < 0 ? 0 : (r0 > 56 ? 56 : r0); const int ro = r0 - bs;
        const int c = 16 * g + m16;
        const size_t tq = (size_t)b * 4096 + r * 64 + c;
        bf16x8 qf[2];
#pragma unroll
        for (int kk = 0; kk < 2; ++kk) qf[kk] = *(const bf16x8*)(PROJ + tq * PW + h * 64 + 32 * kk + 8 * q4);
        f32x4 S[16];
#pragma unroll
        for (int i = 0; i < 8; ++i)
#pragma unroll
            for (int ct = 0; ct < 2; ++ct) { const int col = wc0 + 16 * ct + m16; const LAS unsigned char* kp = Kb + ((ro + i) * 64 + col) * 128; const int sw = (col >> 1) & 7;
                f32x4 a = (f32x4){0.f, 0.f, 0.f, 0.f};
#pragma unroll
                for (int kk = 0; kk < 2; ++kk) { const bf16x8 kf = *(const LAS bf16x8*)(kp + (((q4 + 4 * kk) ^ sw) << 4)); a = __builtin_amdgcn_mfma_f32_16x16x32_bf16(kf, qf[kk], a, 0, 0, 0); }
                S[2 * i + ct] = a; }
        int c0 = c - 8; c0 = c0 < 0 ? 0 : (c0 > 48 ? 48 : c0);
        float mx = -INFINITY;
#pragma unroll
        for (int i = 0; i < 8; ++i)
#pragma unroll
            for (int ct = 0; ct < 2; ++ct)
#pragma unroll
                for (int v = 0; v < 4; ++v) { const int kc = wc0 + 16 * ct + 4 * q4 + v; const bool valid = (kc >= c0) && (kc < c0 + 16);
                    const int bidx = valid ? (r0 + i - r + 7) * 31 + (kc - c + 15) : 0;
                    const float s = valid ? S[2 * i + ct][v] + biasL[bidx] : -INFINITY; S[2 * i + ct][v] = s; mx = fmaxf(mx, s); }
        mx = fmaxf(mx, shflx(mx, 16, lane)); mx = fmaxf(mx, shflx(mx, 32, lane));
        float l = 0.f;
#pragma unroll
        for (int t = 0; t < 16; ++t)
#pragma unroll
            for (int v = 0; v < 4; ++v) { const float p = __builtin_amdgcn_exp2f(S[t][v] - mx); S[t][v] = p; l += p; }
        l += shflx(l, 16, lane); l += shflx(l, 32, lane);
        f32x4 O[4];
#pragma unroll
        for (int dt = 0; dt < 4; ++dt) O[dt] = (f32x4){0.f, 0.f, 0.f, 0.f};
        const int qq = m16 >> 2, pp = m16 & 3, col1 = wc0 + 4 * q4 + qq;
#pragma unroll
        for (int i = 0; i < 8; ++i) {
            u32x4 pw; pw.x = pk2(S[2 * i][0], S[2 * i][1]); pw.y = pk2(S[2 * i][2], S[2 * i][3]); pw.z = pk2(S[2 * i + 1][0], S[2 * i + 1][1]); pw.w = pk2(S[2 * i + 1][2], S[2 * i + 1][3]);
            const bf16x8 pb = __builtin_bit_cast(bf16x8, pw);
            const LAS unsigned char* v1 = Vb + ((ro + i) * 64 + col1) * 128 + 8 * (pp & 1);
            const LAS unsigned char* v2 = v1 + 16 * 128;
#pragma unroll
            for (int dt = 0; dt < 4; ++dt) { const int chunk = 2 * dt + (pp >> 1);
                const s16x4 lo = vtr(v1 + ((chunk ^ (col1 & 7)) << 4)), hi = vtr(v2 + ((chunk ^ ((col1 + 16) & 7)) << 4));
                const bf16x8 vf = (bf16x8){lo[0], lo[1], lo[2], lo[3], hi[0], hi[1], hi[2], hi[3]};
                O[dt] = __builtin_amdgcn_mfma_f32_16x16x32_bf16(vf, pb, O[dt], 0, 0, 0); }
        }
        const float inv = 1.0f / l;
#pragma unroll
        for (int dt = 0; dt < 4; ++dt) {
            if constexpr (OUTP_F8) { int w = 0; w = __builtin_amdgcn_cvt_pk_fp8_f32(O[dt][0] * inv, O[dt][1] * inv, w, false); w = __builtin_amdgcn_cvt_pk_fp8_f32(O[dt][2] * inv, O[dt][3] * inv, w, true); *(int*)((unsigned char*)CAT + tq * 1024 + h * 64 + 16 * dt + 4 * q4) = w; }
            else { u32x2 w; w.x = pk2(O[dt][0] * inv, O[dt][1] * inv); w.y = pk2(O[dt][2] * inv, O[dt][3] * inv); *(u32x2*)(CAT + tq * 1024 + h * 64 + 16 * dt + 4 * q4) = w; } }
    }
    __syncthreads();
}

#undef NA_LOAD
__device__ __forceinline__ void rope_phase(const Ctx& cx, const bf16_t* PROJ, const float* qg, const float* kg, bf16_t* QKR, const int tid) {
    const int lane = tid & 63, wave = __builtin_amdgcn_readfirstlane(tid >> 6);
    const int gw = cx.vcu * 8 + wave, NGW = cx.G * 8;
    const int d0 = (lane & 7) * 8;
    float gq[8], gk[8], invf[4];
#pragma unroll
    for (int e = 0; e < 8; ++e) { gq[e] = qg[d0 + e]; gk[e] = kg[d0 + e]; }
#pragma unroll
    for (int p = 0; p < 4; ++p) { const int i = (d0 >> 1) + p, j = i & 15; invf[p] = exp2f(-(float)(2 * j) / 32.0f * 13.287712379549449f); }
    const bool isrow = (d0 >> 1) < 16;
    for (int pos = gw; pos < SEQ; pos += NGW) {
        const float pr = isrow ? (float)(pos >> 6) : (float)(pos & 63);
        float cs[4], sn[4];
#pragma unroll
        for (int p = 0; p < 4; ++p) { const float a = pr * invf[p]; cs[p] = cosf(a); sn[p] = sinf(a); }
#pragma unroll 4
        for (int bb = 0; bb < BATCH; ++bb) { const int tok = bb * SEQ + pos;
#pragma unroll
        for (int half = 0; half < 2; ++half) {
            const int e0 = half * 512 + lane * 8; const int head = e0 >> 6; const bool isq = head < 12;
            const u32x4 raw = *(const u32x4*)(PROJ + (size_t)tok * 1536 + e0);
            float x[8]; x[0] = bflo(raw.x); x[1] = bfhi(raw.x); x[2] = bflo(raw.y); x[3] = bfhi(raw.y); x[4] = bflo(raw.z); x[5] = bfhi(raw.z); x[6] = bflo(raw.w); x[7] = bfhi(raw.w);
            float ss = 0.f;
#pragma unroll
            for (int e = 0; e < 8; ++e) ss += x[e] * x[e];
            ss = group8_sum(ss);
            const float inv = rsqrtf(ss * (1.0f / 64.0f) + 1e-6f);
            float y[8];
#pragma unroll
            for (int e = 0; e < 8; ++e) y[e] = x[e] * inv * (isq ? gq[e] : gk[e]);
            const float sc = isq ? C2 : 1.0f;
            float o[8];
#pragma unroll
            for (int p = 0; p < 4; ++p) { o[2 * p] = (y[2 * p] * cs[p] - y[2 * p + 1] * sn[p]) * sc; o[2 * p + 1] = (y[2 * p] * sn[p] + y[2 * p + 1] * cs[p]) * sc; }
            u32x4 w; w.x = pk2(o[0], o[1]); w.y = pk2(o[2], o[3]); w.z = pk2(o[4], o[5]); w.w = pk2(o[6], o[7]);
            *(u32x4*)(QKR + (size_t)tok * 1024 + e0) = w;
        } }
    }
}

__device__ __forceinline__ void sconv_phase(const Ctx& cx, const bf16_t* PROJ, const float* cw, const float* cb, bf16_t* UT3, unsigned char* V8, const int tid) {
    const int lane = tid & 63, wave = __builtin_amdgcn_readfirstlane(tid >> 6);
    const int gw = cx.vcu * 8 + wave, NGW = cx.G * 8;
    LAS unsigned short* tile = (LAS unsigned short*)(cx.lds + wave * 9216);
    constexpr int PW = 2560;
    for (int it = gw; it < 16 * 64 * 36; it += NGW) {
        const int ct = it % 36, tt = (it / 36) & 63, b = it / (36 * 64);
        const int col = ct * 64 + lane, t0 = tt * 64;
        const float w0 = cw[col], w1 = cw[2304 + col], w2 = cw[4608 + col], bia = cb[col];
        const bf16_t* src = PROJ + ((size_t)b * 4096 + t0) * PW + col;
        unsigned short uu[66];
        uu[0] = (t0 > 0) ? src[-(long)PW] : (unsigned short)0;
#pragma unroll
        for (int k = 0; k < 64; ++k) uu[k + 1] = src[(size_t)k * PW];
        uu[65] = (t0 + 64 < 4096) ? src[(size_t)64 * PW] : (unsigned short)0;
#pragma unroll
        for (int k = 0; k < 64; ++k) { const float v = bf2f(uu[k]) * w0 + bf2f(uu[k + 1]) * w1 + bf2f(uu[k + 2]) * w2 + bia; tile[lane * 72 + k] = (unsigned short)f2bf(v); }
        LDS_WAIT(); asm volatile("" ::: "memory");
        const int part = (ct * 64) / 768, cbase = (ct * 64) % 768;
#pragma unroll
        for (int k = 0; k < 8; ++k) { const int row = k * 8 + (lane >> 3), chn = lane & 7;
            const u32x4 v = *(const LAS u32x4*)((const LAS unsigned char*)tile + row * 144 + chn * 16);
            *(u32x4*)(UT3 + (((size_t)part * 16 + b) * 768 + cbase + row) * 4096 + t0 + chn * 8) = v;
            if (TCONV_F8 && part == 0) { int w0 = 0, w1 = 0;
                w0 = __builtin_amdgcn_cvt_pk_fp8_f32(bflo(v.x), bfhi(v.x), w0, false); w0 = __builtin_amdgcn_cvt_pk_fp8_f32(bflo(v.y), bfhi(v.y), w0, true);
                w1 = __builtin_amdgcn_cvt_pk_fp8_f32(bflo(v.z), bfhi(v.z), w1, false); w1 = __builtin_amdgcn_cvt_pk_fp8_f32(bflo(v.w), bfhi(v.w), w1, true);
                *(u32x2*)(V8 + ((size_t)b * 768 + cbase + row) * 4096 + t0 + chn * 8) = (u32x2){(unsigned)w0, (unsigned)w1}; } }
        LDS_WAIT(); asm volatile("" ::: "memory");
    }
}

constexpr int TZ_CS = 16384 + 64;
__device__ __forceinline__ void tconv_phase(const Ctx& cx, const int o, const bf16_t* UT, const bf16_t* GT, bf16_t* ZT, const float* lbias  , const int tid) {
    const int lane = tid & 63, wid = __builtin_amdgcn_readfirstlane(tid >> 6), m16 = lane & 15, q4 = lane >> 4;
    const float* HRAWT = (const float*)(cx.ws + WS_HRAWT); const float* HPART = (const float*)(cx.ws + WS_HPART);
    LAS unsigned char* cp = cx.lds; LAS float* red = (LAS float*)(cx.lds + 8 * TZ_CS);
    for (int c = cx.vcu; c < 768; c += cx.G) {
        __syncthreads();
        { const int dir = tid >> 8, blk = tid & 255; float v = HPART[(size_t)blk * 3072 + dir * 1536 + o * 768 + c]; v = wave_sum(v, lane); if (lane == 0) red[wid] = v; }
        __syncthreads();
        float nrm = 0.f;
#pragma unroll
        for (int w = 0; w < 8; ++w) nrm += red[w];
        const float inv = 1.0f / nrm;
        const float* hf = HRAWT + (size_t)(o * 768 + c) * 4096; const float* hb = HRAWT + (size_t)(1536 + o * 768 + c) * 4096;
        for (int i = tid; i < 8192; i += 512) { float v; if (i < 4096) v = hf[4095 - i]; else if (i < 8191) v = hb[i - 4095]; else v = 0.f;
            *(LAS unsigned short*)(cp + 2 * i) = (unsigned short)f2bf(v * inv); }
        __syncthreads();
#pragma unroll
        for (int j = 1; j < 8; ++j)
            for (int n = tid; n < 1024; n += 512) {
                const u32x4 lo = *(const LAS u32x4*)(cp + n * 16); u32x4 hi = (u32x4){0u, 0u, 0u, 0u}; if (n + 1 < 1024) hi = *(const LAS u32x4*)(cp + (n + 1) * 16);
                const unsigned w[8] = {lo.x, lo.y, lo.z, lo.w, hi.x, hi.y, hi.z, hi.w}; u32x4 r;
                const int a = j >> 1;
                if (j & 1) { r.x = (w[a] >> 16) | (w[a + 1] << 16); r.y = (w[a + 1] >> 16) | (w[a + 2] << 16); r.z = (w[a + 2] >> 16) | (w[a + 3] << 16); r.w = (w[a + 3] >> 16) | (w[a + 4] << 16); }
                else { r.x = w[a]; r.y = w[a + 1]; r.z = w[a + 2]; r.w = w[a + 3]; }
                *(LAS u32x4*)(cp + j * TZ_CS + n * 16) = r;
            }
        __syncthreads();
        const int j = (7 - m16) & 7;
        const int nbase = (4095 - 512 * wid - m16 - j + 8 * q4) >> 3;
        const LAS unsigned char* ap = cp + j * TZ_CS + (nbase - 62) * 16;
        const bf16_t* up = UT + ((size_t)m16 * 768 + c) * 4096 + 8 * q4;
        f32x4 acc[32];
#pragma unroll
        for (int ti = 0; ti < 32; ++ti) acc[ti] = (f32x4){0.f, 0.f, 0.f, 0.f};
        bf16x8 bcur = *(const bf16x8*)(up);
        bf16x8 afA[8], afB[8];
#pragma unroll
        for (int i = 0; i < 8; ++i) afA[i] = *(const LAS bf16x8*)(ap + (31 - i) * 32);
        for (int ks = 0; ks < 128; ++ks) {
            const bf16x8 bnext = *(const bf16x8*)(up + ((ks + 1) & 127) * 32);
            const LAS unsigned char* a0 = ap + ks * 64;
            const LAS unsigned char* a1 = ap + ((ks + 1) & 127) * 64;
#define TZ_LD(dst, base, g) do { _Pragma("unroll") for (int i = 0; i < 8; ++i) dst[i] = *(const LAS bf16x8*)((base) + (31 - (8 * (g) + i)) * 32); } while (0)
#define TZ_MM(src, g) do { _Pragma("unroll") for (int i = 0; i < 8; ++i) acc[8 * (g) + i] = __builtin_amdgcn_mfma_f32_16x16x32_bf16(src[i], bcur, acc[8 * (g) + i], 0, 0, 0); } while (0)
            TZ_LD(afB, a0, 1); TZ_MM(afA, 0); __builtin_amdgcn_sched_barrier(0);
            TZ_LD(afA, a0, 2); TZ_MM(afB, 1); __builtin_amdgcn_sched_barrier(0);
            TZ_LD(afB, a0, 3); TZ_MM(afA, 2); __builtin_amdgcn_sched_barrier(0);
            TZ_LD(afA, a1, 0); TZ_MM(afB, 3); __builtin_amdgcn_sched_barrier(0);
#undef TZ_LD
#undef TZ_MM
            bcur = bnext;
        }
        const float lb = lbias[c];
        const size_t rowoff = ((size_t)m16 * 768 + c) * 4096 + 512 * wid + 4 * q4;
#pragma unroll
        for (int ti = 0; ti < 32; ++ti) {
            const u32x2 uu = *(const u32x2*)(UT + rowoff + 16 * ti), gg = *(const u32x2*)(GT + rowoff + 16 * ti);
            const float y0 = (acc[ti][0] + lb * bflo(uu.x)) * bflo(gg.x), y1 = (acc[ti][1] + lb * bfhi(uu.x)) * bfhi(gg.x), y2 = (acc[ti][2] + lb * bflo(uu.y)) * bflo(gg.y), y3 = (acc[ti][3] + lb * bfhi(uu.y)) * bfhi(gg.y);
            u32x2 w; w.x = pk2(y0, y1); w.y = pk2(y2, y3);
            *(u32x2*)(ZT + rowoff + 16 * ti) = w;
            if ((ti & 7) == 7) __builtin_amdgcn_sched_barrier(0);
        }
    }
    __syncthreads();
}

constexpr int T8_CS = 8192 + 256;
__host__ __device__ constexpr int t8_sig(int j) { return j < 4 ? 2 * j : (j >= 12 ? 2 * (j - 8) : 2 * (j - 4) + 1); }
__device__ __forceinline__ float wave_max_nn(float v) {
    v = fmaxf(v, dpp_x<0xB1>(v)); v = fmaxf(v, dpp_x<0x4E>(v)); v = fmaxf(v, dpp_x<0x141>(v)); v = fmaxf(v, dpp_x<0x140>(v));
    v = fmaxf(v, __builtin_bit_cast(float, __builtin_amdgcn_update_dpp(0, __builtin_bit_cast(int, v), 0x142, 0xA, 0xF, false)));
    v = fmaxf(v, __builtin_bit_cast(float, __builtin_amdgcn_update_dpp(0, __builtin_bit_cast(int, v), 0x143, 0xC, 0xF, false)));
    return __builtin_bit_cast(float, __builtin_amdgcn_readlane(__builtin_bit_cast(int, v), 63));
}
__device__ __forceinline__ void tconv8_phase(const Ctx& cx, const int o, const bf16_t* UT, const unsigned char* U8, const bf16_t* GT, bf16_t* ZT, unsigned char* Z8  ,
                                             const float* lbias, const int tid) {
    const int lane = tid & 63, wid = __builtin_amdgcn_readfirstlane(tid >> 6), m16 = lane & 15, q4 = lane >> 4;
    const float* HRAWT = (const float*)(cx.ws + WS_HRAWT); const float* HPART = (const float*)(cx.ws + WS_HPART);
    LAS unsigned char* cp = cx.lds; LAS float* red = (LAS float*)(cx.lds + 16 * T8_CS);
    for (int c = cx.vcu; c < 768; c += cx.G) {
        __syncthreads();
        const float* hf = HRAWT + (size_t)(o * 768 + c) * 4096; const float* hb = HRAWT + (size_t)(1536 + o * 768 + c) * 4096;
        float tap[16]; float mx = 0.f;
        int t3 = tid; asm volatile("" : "+v"(t3));
#pragma unroll
        for (int k = 0; k < 16; ++k) { const int i = t3 * 16 + k; float v; if (i < 4096) v = hf[4095 - i]; else if (i < 8191) v = hb[i - 4095]; else v = 0.f; tap[k] = v; mx = fmaxf(mx, fabsf(v)); }
        { const int dir = tid >> 8, blk = tid & 255; float v = HPART[(size_t)blk * 3072 + dir * 1536 + o * 768 + c]; v = wave_sum(v, lane); mx = wave_max_nn(mx); if (lane == 0) { red[wid] = v; red[8 + wid] = mx; } }
        __syncthreads();
        float nrm = 0.f, mall = 0.f;
#pragma unroll
        for (int w = 0; w < 8; ++w) { nrm += red[w]; mall = fmaxf(mall, red[8 + w]); }
        const float inv = 1.0f / nrm;
        int ex; (void)frexpf(fmaxf(mall * inv, 1e-30f), &ex);
        const float fsc = ldexpf(1.0f, 7 - ex), unsc = ldexpf(1.0f, ex - 7), tsc = inv * fsc;
        { unsigned w[4];
#pragma unroll
          for (int q = 0; q < 4; ++q) { int r = 0; r = __builtin_amdgcn_cvt_pk_fp8_f32(tap[4 * q] * tsc, tap[4 * q + 1] * tsc, r, false); r = __builtin_amdgcn_cvt_pk_fp8_f32(tap[4 * q + 2] * tsc, tap[4 * q + 3] * tsc, r, true); w[q] = (unsigned)r; }
          *(LAS u32x4*)(cp + tid * 16) = (u32x4){w[0], w[1], w[2], w[3]}; }
        __syncthreads();
        { const u32x4 lo = *(const LAS u32x4*)(cp + tid * 16); u32x4 hi = (u32x4){0u, 0u, 0u, 0u}; if (tid + 1 < 512) hi = *(const LAS u32x4*)(cp + (tid + 1) * 16);
          const unsigned w[8] = {lo.x, lo.y, lo.z, lo.w, hi.x, hi.y, hi.z, hi.w};
#pragma unroll
          for (int j = 1; j < 16; ++j) { u32x4 r; const int a = j >> 2, sh = j & 3;
              r.x = sh ? __builtin_amdgcn_alignbyte(w[a + 1], w[a], sh) : w[a]; r.y = sh ? __builtin_amdgcn_alignbyte(w[a + 2], w[a + 1], sh) : w[a + 1];
              r.z = sh ? __builtin_amdgcn_alignbyte(w[a + 3], w[a + 2], sh) : w[a + 2]; r.w = sh ? __builtin_amdgcn_alignbyte(w[a + 4], w[a + 3], sh) : w[a + 3];
              *(LAS u32x4*)(cp + j * T8_CS + t8_sig(j) * 16 + tid * 16) = r; } }
        __syncthreads();
        const int jc = 15 - m16;
        const int nbase = 255 - 32 * wid + 2 * q4;
        const LAS unsigned char* ap = cp + jc * T8_CS + t8_sig(jc) * 16 + (nbase - 31) * 16;
        const unsigned char* up = U8 + ((size_t)m16 * 768 + c) * 4096 + 32 * q4;
        f32x4 acc[32];
#pragma unroll
        for (int ti = 0; ti < 32; ++ti) acc[ti] = (f32x4){0.f, 0.f, 0.f, 0.f};
        typedef int v8i_t __attribute__((ext_vector_type(8))); typedef int v4i_t __attribute__((ext_vector_type(4)));
#define T8_FRAG(p) __builtin_shufflevector(*(const LAS v4i_t*)(p), *(const LAS v4i_t*)((p) + 16), 0, 1, 2, 3, 4, 5, 6, 7)
        v8i_t bcur = __builtin_shufflevector(*(const v4i_t*)(up), *(const v4i_t*)(up + 16), 0, 1, 2, 3, 4, 5, 6, 7);
        v8i_t afA[4], afB[4];
#pragma unroll
        for (int i = 0; i < 4; ++i) afA[i] = T8_FRAG(ap + (31 - i) * 16);
        for (int ks = 0; ks < 32; ++ks) {
            const unsigned char* un = up + ((ks + 1) & 31) * 128;
            const v8i_t bnext = __builtin_shufflevector(*(const v4i_t*)(un), *(const v4i_t*)(un + 16), 0, 1, 2, 3, 4, 5, 6, 7);
            const LAS unsigned char* a0 = ap + ks * 128;
            const LAS unsigned char* a1 = ap + ((ks + 1) & 31) * 128;
#define T8_LD(dst, base, g) do { _Pragma("unroll") for (int i = 0; i < 4; ++i) dst[i] = T8_FRAG((base) + (31 - (4 * (g) + i)) * 16); } while (0)
#define T8_MM(src, g) do { _Pragma("unroll") for (int i = 0; i < 4; ++i) acc[4 * (g) + i] = __builtin_amdgcn_mfma_scale_f32_16x16x128_f8f6f4(src[i], bcur, acc[4 * (g) + i], 0, 0, 0, 0, 0, 0); } while (0)
            T8_LD(afB, a0, 1); T8_MM(afA, 0); __builtin_amdgcn_sched_barrier(0);
            T8_LD(afA, a0, 2); T8_MM(afB, 1); __builtin_amdgcn_sched_barrier(0);
            T8_LD(afB, a0, 3); T8_MM(afA, 2); __builtin_amdgcn_sched_barrier(0);
            T8_LD(afA, a0, 4); T8_MM(afB, 3); __builtin_amdgcn_sched_barrier(0);
            T8_LD(afB, a0, 5); T8_MM(afA, 4); __builtin_amdgcn_sched_barrier(0);
            T8_LD(afA, a0, 6); T8_MM(afB, 5); __builtin_amdgcn_sched_barrier(0);
            T8_LD(afB, a0, 7); T8_MM(afA, 6); __builtin_amdgcn_sched_barrier(0);
            T8_LD(afA, a1, 0); T8_MM(afB, 7); __builtin_amdgcn_sched_barrier(0);
#undef T8_LD
#undef T8_MM
            bcur = bnext;
        }
#undef T8_FRAG
        const float lb = lbias[c];
        const size_t rowoff = ((size_t)m16 * 768 + c) * 4096 + 512 * wid + 4 * q4;
#pragma unroll
        for (int ti = 0; ti < 32; ++ti) {
            const u32x2 uu = *(const u32x2*)(UT + rowoff + 16 * ti), gg = *(const u32x2*)(GT + rowoff + 16 * ti);
            const float y0 = (acc[ti][0] * unsc + lb * bflo(uu.x)) * bflo(gg.x), y1 = (acc[ti][1] * unsc + lb * bfhi(uu.x)) * bfhi(gg.x), y2 = (acc[ti][2] * unsc + lb * bflo(uu.y)) * bflo(gg.y), y3 = (acc[ti][3] * unsc + lb * bfhi(uu.y)) * bfhi(gg.y);
            u32x2 w; w.x = pk2(y0, y1); w.y = pk2(y2, y3);
            *(u32x2*)(ZT + rowoff + 16 * ti) = w;
            if (Z8) { int w8 = 0; w8 = __builtin_amdgcn_cvt_pk_fp8_f32(fminf(fmaxf(y0, -440.f), 440.f), fminf(fmaxf(y1, -440.f), 440.f), w8, false); w8 = __builtin_amdgcn_cvt_pk_fp8_f32(fminf(fmaxf(y2, -440.f), 440.f), fminf(fmaxf(y3, -440.f), 440.f), w8, true);
                *(int*)(Z8 + rowoff + 16 * ti) = w8; }
            if ((ti & 7) == 7) __builtin_amdgcn_sched_barrier(0);
        }
    }
    __syncthreads();
}

__device__ __forceinline__ void tback_phase(const Ctx& cx, const bf16_t* ZT, bf16_t* CAT, const int tid) {
    const int lane = tid & 63, wave = __builtin_amdgcn_readfirstlane(tid >> 6);
    const int gw = cx.vcu * 8 + wave, NGW = cx.G * 8;
    LAS unsigned char* tile = cx.lds + wave * 9216;
    for (int it = gw; it < 16 * 12 * 64; it += NGW) {
        const int tt = it & 63, ct = (it >> 6) % 12, b = it / (64 * 12);
        const int c0 = ct * 64, t0 = tt * 64;
#pragma unroll
        for (int k = 0; k < 8; ++k) { const int row = k * 8 + (lane >> 3), chn = lane & 7;
            const u32x4 v = *(const u32x4*)(ZT + ((size_t)b * 768 + c0 + row) * 4096 + t0 + chn * 8);
            *(LAS u32x4*)(tile + row * 144 + chn * 16) = v; }
        LDS_WAIT(); asm volatile("" ::: "memory");
        if constexpr (OUTP_F8) { unsigned char* dst = (unsigned char*)CAT + ((size_t)b * 4096 + t0) * 1024 + c0 + lane;
#pragma unroll 8
            for (int k = 0; k < 64; ++k) { const float v = bf2f(*(const LAS unsigned short*)(tile + lane * 144 + k * 2)); dst[(size_t)k * 1024] = f2fp8(fminf(fmaxf(v, -440.0f), 440.0f)); }
        } else { bf16_t* dst = CAT + ((size_t)b * 4096 + t0) * 1024 + c0 + lane;
#pragma unroll 8
            for (int k = 0; k < 64; ++k) dst[(size_t)k * 1024] = *(const LAS unsigned short*)(tile + lane * 144 + k * 2); }
        LDS_WAIT(); asm volatile("" ::: "memory");
    }
}

__device__ __forceinline__ void ln1_group(const int bt, const int chunk, const int wave, const int lane, const int r16, const int q4, const bf16_t* XI, bf16_t* XO, bf16_t* XB, const float* g, const float* bta,
                                          const LAS unsigned char* Wh, const LAS unsigned char* Wl, LAS float* lg, LAS int* lcnt, const float rb0, const float rb1, float* gate, unsigned (&pk)[2], unsigned (&gp)[2]) {
    constexpr int WP = 2064;
            const size_t rowU = (size_t)chunk * 256 + wave * 32 + bt * 16;
            unsigned loff = (unsigned)(r16 * 1024 + 8 * q4); asm volatile("" : "+v"(loff));
            const GAS bf16_t* src = (const GAS bf16_t*)XI + rowU * 1024 + loff;
            constexpr int HOLD = LN1_HOLD;
            u32x4 raw[HOLD > 0 ? HOLD : 1], rawt[32 - HOLD]; float s = 0.f, ss = 0.f;
#pragma unroll
            for (int i = 0; i < 32; ++i) { if (i < HOLD) raw[i] = *(const GAS u32x4*)(src + 32 * i); else rawt[i - HOLD] = *(const GAS u32x4*)(src + 32 * i); }
#pragma unroll
            for (int i = 0; i < 32; ++i) { const u32x4 rr = (i < HOLD) ? raw[i < HOLD ? i : 0] : rawt[i < HOLD ? 0 : i - HOLD]; const float x0 = bflo(rr.x), x1 = bfhi(rr.x), x2 = bflo(rr.y), x3 = bfhi(rr.y), x4 = bflo(rr.z), x5 = bfhi(rr.z), x6 = bflo(rr.w), x7 = bfhi(rr.w);
                s += ((x0 + x1) + (x2 + x3)) + ((x4 + x5) + (x6 + x7)); ss += ((x0 * x0 + x1 * x1) + (x2 * x2 + x3 * x3)) + ((x4 * x4 + x5 * x5) + (x6 * x6 + x7 * x7)); }
            lg[2 * lane] = s; lg[2 * lane + 1] = ss; LDS_WAIT(); asm volatile("" ::: "memory");
            s = (lg[2 * r16] + lg[2 * (r16 + 16)]) + (lg[2 * (r16 + 32)] + lg[2 * (r16 + 48)]); ss = (lg[2 * r16 + 1] + lg[2 * (r16 + 16) + 1]) + (lg[2 * (r16 + 32) + 1] + lg[2 * (r16 + 48) + 1]);
            LDS_WAIT(); asm volatile("" ::: "memory");
            const float mean = s * (1.0f / 1024.0f), rstd = rsqrtf(fmaxf(ss * (1.0f / 1024.0f) - mean * mean, 0.f) + LN_EPS);
            f32x4 a0 = (f32x4){0.f, 0.f, 0.f, 0.f}, a1 = (f32x4){0.f, 0.f, 0.f, 0.f};
            const LAS unsigned char* wh0 = Wh + r16 * WP + 16 * q4; const LAS unsigned char* wl0 = Wl + r16 * WP + 16 * q4;
            GAS bf16_t* dsto = (GAS bf16_t*)XO + rowU * 1024 + loff; GAS unsigned char* dst8 = (GAS unsigned char*)XB + rowU * 1024 + loff;
#pragma unroll
            for (int i = 0; i < 32; ++i) {
                const GAS float* gp_ = (const GAS float*)g + 32 * i + 8 * q4; const GAS float* bp_ = (const GAS float*)bta + 32 * i + 8 * q4;
                const f32x4 g0 = *(const GAS f32x4*)gp_, g1 = *(const GAS f32x4*)(gp_ + 4), b0 = *(const GAS f32x4*)bp_, b1 = *(const GAS f32x4*)(bp_ + 4);
                u32x4 rw_; if (i < HOLD) rw_ = raw[i < HOLD ? i : 0]; else rw_ = *(const GAS u32x4*)(src + 32 * i); asm volatile("" : "+v"(rw_));
                float y[8]; y[0] = bflo(rw_.x); y[1] = bfhi(rw_.x); y[2] = bflo(rw_.y); y[3] = bfhi(rw_.y); y[4] = bflo(rw_.z); y[5] = bfhi(rw_.z); y[6] = bflo(rw_.w); y[7] = bfhi(rw_.w);
#pragma unroll
                for (int q = 0; q < 8; ++q) y[q] = (y[q] - mean) * rstd * (q < 4 ? g0[q & 3] : g1[q & 3]) + (q < 4 ? b0[q & 3] : b1[q & 3]);
                u32x4 hi; hi.x = pk2(y[0], y[1]); hi.y = pk2(y[2], y[3]); hi.z = pk2(y[4], y[5]); hi.w = pk2(y[6], y[7]);
                *(GAS u32x4*)(dsto + 32 * i) = hi;
                if constexpr (MOE_F8) { int w0 = 0, w1 = 0; w0 = __builtin_amdgcn_cvt_pk_fp8_f32(y[0], y[1], w0, false); w0 = __builtin_amdgcn_cvt_pk_fp8_f32(y[2], y[3], w0, true); w1 = __builtin_amdgcn_cvt_pk_fp8_f32(y[4], y[5], w1, false); w1 = __builtin_amdgcn_cvt_pk_fp8_f32(y[6], y[7], w1, true);
                    *(GAS u32x2*)(dst8 + 32 * i) = (u32x2){(unsigned)w0, (unsigned)w1}; }
                else { *(u32x4*)((bf16_t*)XB + rowU * 1024 + loff + 32 * i) = hi; }
                u32x4 lo; lo.x = pk2(y[0] - bflo(hi.x), y[1] - bfhi(hi.x)); lo.y = pk2(y[2] - bflo(hi.y), y[3] - bfhi(hi.y)); lo.z = pk2(y[4] - bflo(hi.z), y[5] - bfhi(hi.z)); lo.w = pk2(y[6] - bflo(hi.w), y[7] - bfhi(hi.w));
                const bf16x8 ah = __builtin_bit_cast(bf16x8, hi), al = __builtin_bit_cast(bf16x8, lo);
                const bf16x8 wh_0 = *(const LAS bf16x8*)(wh0 + 64 * i), wh_1 = *(const LAS bf16x8*)(wh0 + 16 * WP + 64 * i), wl_0 = *(const LAS bf16x8*)(wl0 + 64 * i), wl_1 = *(const LAS bf16x8*)(wl0 + 16 * WP + 64 * i);
                a0 = __builtin_amdgcn_mfma_f32_16x16x32_bf16(ah, wh_0, a0, 0, 0, 0); a1 = __builtin_amdgcn_mfma_f32_16x16x32_bf16(ah, wh_1, a1, 0, 0, 0);
                a0 = __builtin_amdgcn_mfma_f32_16x16x32_bf16(al, wh_0, a0, 0, 0, 0); a1 = __builtin_amdgcn_mfma_f32_16x16x32_bf16(al, wh_1, a1, 0, 0, 0);
                a0 = __builtin_amdgcn_mfma_f32_16x16x32_bf16(ah, wl_0, a0, 0, 0, 0); a1 = __builtin_amdgcn_mfma_f32_16x16x32_bf16(ah, wl_1, a1, 0, 0, 0);
                asm volatile("" :: "v"(ah), "v"(al), "v"(wh_0), "v"(wh_1), "v"(wl_0), "v"(wl_1));
                __builtin_amdgcn_sched_barrier(0);
            }
#pragma unroll
            for (int v = 0; v < 4; ++v) { lg[(4 * q4 + v) * 33 + r16] = a0[v] + rb0; lg[(4 * q4 + v) * 33 + r16 + 16] = a1[v] + rb1; }
            LDS_WAIT(); asm volatile("" ::: "memory");
            if (lane < 16) {
                const LAS float* myl = lg + lane * 33; const size_t rowt = (size_t)chunk * 256 + wave * 32 + bt * 16 + lane;
                float tv[4]; int te[4]; int t0 = -1, t1 = -1, t2 = -1;
#pragma unroll
                for (int k = 0; k < 4; ++k) { float best = -INFINITY; int bi = 0;
                    for (int e = 0; e < 32; ++e) { const float v = myl[e]; const bool ok = (e != t0) && (e != t1) && (e != t2); if (ok && v > best) { best = v; bi = e; } }
                    tv[k] = best; te[k] = bi; if (k == 0) t0 = bi; else if (k == 1) t1 = bi; else if (k == 2) t2 = bi; }
                const float e1 = __expf(tv[1] - tv[0]), e2 = __expf(tv[2] - tv[0]), e3 = __expf(tv[3] - tv[0]); const float isum = 1.0f / (1.0f + e1 + e2 + e3);
                const float gk[4] = {isum, e1 * isum, e2 * isum, e3 * isum};
                pk[0] = 0u; pk[1] = 0u;
#pragma unroll
                for (int k = 0; k < 4; ++k) { const int rk = __hip_atomic_fetch_add(lcnt + te[k], 1, __ATOMIC_RELAXED, __HIP_MEMORY_SCOPE_WORKGROUP); pk[k >> 1] |= (unsigned)((te[k] << 11) | rk) << (16 * (k & 1)); }
                gp[0] = pk2(gk[0], gk[1]); gp[1] = pk2(gk[2], gk[3]); (void)rowt; (void)gate;
            }
            LDS_WAIT(); asm volatile("" ::: "memory");
}
__device__ __forceinline__ void ln1_router_phase(const Ctx& cx, const bf16_t* XI, bf16_t* XO, bf16_t* XB, const float* g, const float* bta, const float* rw, const float* rb,
                                                 unsigned* cnt, int* expid, float* gate, int* idx, float* gidx, const int tid) {
    const int lane = tid & 63, wave = __builtin_amdgcn_readfirstlane(tid >> 6), r16 = lane & 15, q4 = lane >> 4;
    constexpr int WP = 2064;
    LAS unsigned char* Wh = cx.lds; LAS unsigned char* Wl = cx.lds + 32 * WP; LAS int* lcnt = (LAS int*)(cx.lds + 64 * WP); LAS int* lbase = lcnt + 32; LAS float* lg = (LAS float*)(cx.lds + 64 * WP + 256 + wave * 2112);
    __syncthreads();
    for (int i = tid; i < 32768; i += 512) { const int k = i >> 5, e = i & 31; const float w = rw[i]; const unsigned hi = f2bf(w); const float wl = w - bf2f((unsigned short)hi);
        *(LAS unsigned short*)(Wh + e * WP + 2 * k) = (unsigned short)hi; *(LAS unsigned short*)(Wl + e * WP + 2 * k) = (unsigned short)f2bf(wl); }
    if (tid < 32) lcnt[tid] = 0;
    const float rb0 = rb[r16], rb1 = rb[r16 + 16];
    __syncthreads();
    for (int chunk = cx.vcu; chunk < NTOK / 256; chunk += cx.G) {
        unsigned pk0[2] = {0u, 0u}, pk1[2] = {0u, 0u}, gp0[2] = {0u, 0u}, gp1[2] = {0u, 0u};
        ln1_group(0, chunk, wave, lane, r16, q4, XI, XO, XB, g, bta, Wh, Wl, lg, lcnt, rb0, rb1, gate, pk0, gp0);
        ln1_group(1, chunk, wave, lane, r16, q4, XI, XO, XB, g, bta, Wh, Wl, lg, lcnt, rb0, rb1, gate, pk1, gp1);
        __syncthreads();
        { int t2 = tid; asm volatile("" : "+v"(t2));
          if (t2 < 32) { lbase[t2] = (int)__hip_atomic_fetch_add(cnt + t2, (unsigned)lcnt[t2], __ATOMIC_RELAXED, __HIP_MEMORY_SCOPE_AGENT); } }
        __syncthreads();
        const int ln_ = lane_id_volatile();
        if (ln_ < 16) {
            { const int slot0 = (chunk * 256 + wave * 32 + ln_) * 4;
#pragma unroll
                for (int k = 0; k < 4; ++k) { const unsigned p = (pk0[k >> 1] >> (16 * (k & 1))) & 0xffffu; const int e = (int)(p >> 11), rk = (int)(p & 0x7ffu); const size_t o_ = (size_t)e * IDXCAP + lbase[e] + rk; idx[o_] = slot0 + k; gidx[o_] = (k & 1) ? bfhi(gp0[k >> 1]) : bflo(gp0[k >> 1]); } }
            { const int slot0 = (chunk * 256 + wave * 32 + 16 + ln_) * 4;
#pragma unroll
                for (int k = 0; k < 4; ++k) { const unsigned p = (pk1[k >> 1] >> (16 * (k & 1))) & 0xffffu; const int e = (int)(p >> 11), rk = (int)(p & 0x7ffu); const size_t o_ = (size_t)e * IDXCAP + lbase[e] + rk; idx[o_] = slot0 + k; gidx[o_] = (k & 1) ? bfhi(gp1[k >> 1]) : bflo(gp1[k >> 1]); } }
        }
        __syncthreads();
        if (tid < 32) lcnt[tid] = 0;
        __syncthreads();
    }
}

__device__ __forceinline__ void ln2_phase(const Ctx& cx, const bf16_t* X1, const bf16_t* Y, bf16_t* XO, bf16_t* XB, float* OUT, const float* g, const float* bta, const int tid) {
    const int lane = tid & 63, wave = __builtin_amdgcn_readfirstlane(tid >> 6);
    const int gw = cx.vcu * 8 + wave, NGW = cx.G * 8;
    if constexpr (Y_F8) {
        for (int rp = gw; rp < NTOK / 2; rp += NGW) {
            u32x4 xa[2][2], ya[2][4];
#pragma unroll
            for (int r = 0; r < 2; ++r) { const size_t row = (size_t)rp * 2 + r;
                xa[r][0] = *(const u32x4*)(X1 + row * 1024 + 16 * lane); xa[r][1] = *(const u32x4*)(X1 + row * 1024 + 16 * lane + 8);
#pragma unroll
                for (int k = 0; k < 4; ++k) ya[r][k] = *(const u32x4*)((const unsigned char*)Y + (row * 4 + k) * 1024 + 16 * lane); }
            float v[2][16]; float s[2] = {0.f, 0.f};
#pragma unroll
            for (int r = 0; r < 2; ++r) {
#pragma unroll
                for (int i = 0; i < 4; ++i) { f32x2 lo = __builtin_amdgcn_cvt_pk_f32_fp8((int)ya[r][0][i], false), hi = __builtin_amdgcn_cvt_pk_f32_fp8((int)ya[r][0][i], true);
#pragma unroll
                    for (int k = 1; k < 4; ++k) { lo += __builtin_amdgcn_cvt_pk_f32_fp8((int)ya[r][k][i], false); hi += __builtin_amdgcn_cvt_pk_f32_fp8((int)ya[r][k][i], true); }
                    const unsigned xlo = xa[r][i >> 1][(i & 1) * 2], xhi = xa[r][i >> 1][(i & 1) * 2 + 1];
                    v[r][4 * i + 0] = bflo(xlo) * DN_ALPHA + lo[0] * (1.0f / Y_SCALE); v[r][4 * i + 1] = bfhi(xlo) * DN_ALPHA + lo[1] * (1.0f / Y_SCALE);
                    v[r][4 * i + 2] = bflo(xhi) * DN_ALPHA + hi[0] * (1.0f / Y_SCALE); v[r][4 * i + 3] = bfhi(xhi) * DN_ALPHA + hi[1] * (1.0f / Y_SCALE);
                    s[r] += (v[r][4 * i] + v[r][4 * i + 1]) + (v[r][4 * i + 2] + v[r][4 * i + 3]); } }
            const float mean0 = wave_sum(s[0], lane) * (1.0f / 1024.0f), mean1 = wave_sum(s[1], lane) * (1.0f / 1024.0f); float q[2] = {0.f, 0.f};
#pragma unroll
            for (int r = 0; r < 2; ++r)
#pragma unroll
                for (int e = 0; e < 16; ++e) { v[r][e] -= (r == 0 ? mean0 : mean1); q[r] += v[r][e] * v[r][e]; }
            const float rstd0 = rsqrtf(wave_sum(q[0], lane) * (1.0f / 1024.0f) + LN_EPS), rstd1 = rsqrtf(wave_sum(q[1], lane) * (1.0f / 1024.0f) + LN_EPS);
            unsigned wb[2][8]; unsigned w8[2][4];
#pragma unroll
            for (int j = 0; j < 4; ++j) { const f32x4 gvj = *(const f32x4*)(g + 16 * lane + 4 * j), bvj = *(const f32x4*)(bta + 16 * lane + 4 * j);
#pragma unroll
                for (int r = 0; r < 2; ++r) { const size_t row = (size_t)rp * 2 + r; const float rs = (r == 0 ? rstd0 : rstd1);
                    const f32x4 o = (f32x4){v[r][4 * j], v[r][4 * j + 1], v[r][4 * j + 2], v[r][4 * j + 3]} * rs * gvj + bvj;
                    if (OUT) *(f32x4*)(OUT + row * 1024 + 16 * lane + 4 * j) = o;
                    else { wb[r][2 * j] = pk2(o[0], o[1]); wb[r][2 * j + 1] = pk2(o[2], o[3]);
                        int t8 = 0; t8 = __builtin_amdgcn_cvt_pk_fp8_f32(o[0], o[1], t8, false); t8 = __builtin_amdgcn_cvt_pk_fp8_f32(o[2], o[3], t8, true); w8[r][j] = (unsigned)t8; } } }
            if (!OUT) {
#pragma unroll
                for (int r = 0; r < 2; ++r) { const size_t row = (size_t)rp * 2 + r;
                    *(u32x4*)(XO + row * 1024 + 16 * lane) = (u32x4){wb[r][0], wb[r][1], wb[r][2], wb[r][3]}; *(u32x4*)(XO + row * 1024 + 16 * lane + 8) = (u32x4){wb[r][4], wb[r][5], wb[r][6], wb[r][7]};
                    if constexpr (INP_F8) *(u32x4*)((unsigned char*)XB + row * 1024 + 16 * lane) = (u32x4){w8[r][0], w8[r][1], w8[r][2], w8[r][3]};
                    else { *(u32x4*)(XB + row * 1024 + 16 * lane) = (u32x4){wb[r][0], wb[r][1], wb[r][2], wb[r][3]}; *(u32x4*)(XB + row * 1024 + 16 * lane + 8) = (u32x4){wb[r][4], wb[r][5], wb[r][6], wb[r][7]}; } } }
        }
        return;
    }
    for (int rp = gw; rp < NTOK / 2; rp += NGW) {
        f32x4 v[2][4]; float s[2] = {0.f, 0.f};
#pragma unroll
        for (int r = 0; r < 2; ++r) { const size_t row = (size_t)rp * 2 + r;
#pragma unroll
            for (int j = 0; j < 4; ++j) { const u32x2 a = *(const u32x2*)(X1 + row * 1024 + 4 * lane + 256 * j); v[r][j] = (f32x4){bflo(a.x), bfhi(a.x), bflo(a.y), bfhi(a.y)} * DN_ALPHA;
#pragma unroll
                for (int k = 0; k < 4; ++k) {
                    if constexpr (Y_F8) { const int y8 = *(const int*)((const unsigned char*)Y + (row * 4 + k) * 1024 + 4 * lane + 256 * j); const f32x2 lo = __builtin_amdgcn_cvt_pk_f32_fp8(y8, false), hi = __builtin_amdgcn_cvt_pk_f32_fp8(y8, true);
                        v[r][j][0] += lo[0] * (1.0f / Y_SCALE); v[r][j][1] += lo[1] * (1.0f / Y_SCALE); v[r][j][2] += hi[0] * (1.0f / Y_SCALE); v[r][j][3] += hi[1] * (1.0f / Y_SCALE); }
                    else { const u32x2 y = *(const u32x2*)(Y + (row * 4 + k) * 1024 + 4 * lane + 256 * j); v[r][j][0] += bflo(y.x); v[r][j][1] += bfhi(y.x); v[r][j][2] += bflo(y.y); v[r][j][3] += bfhi(y.y); } }
                s[r] += (v[r][j][0] + v[r][j][1]) + (v[r][j][2] + v[r][j][3]); } }
        const float mean0 = wave_sum(s[0], lane) * (1.0f / 1024.0f), mean1 = wave_sum(s[1], lane) * (1.0f / 1024.0f); float q[2] = {0.f, 0.f};
#pragma unroll
        for (int r = 0; r < 2; ++r)
#pragma unroll
            for (int j = 0; j < 4; ++j) { v[r][j] = v[r][j] - (r == 0 ? mean0 : mean1); q[r] += (v[r][j][0] * v[r][j][0] + v[r][j][1] * v[r][j][1]) + (v[r][j][2] * v[r][j][2] + v[r][j][3] * v[r][j][3]); }
        const float rstd0 = rsqrtf(wave_sum(q[0], lane) * (1.0f / 1024.0f) + LN_EPS), rstd1 = rsqrtf(wave_sum(q[1], lane) * (1.0f / 1024.0f) + LN_EPS);
#pragma unroll
        for (int j = 0; j < 4; ++j) { const f32x4 gvj = *(const f32x4*)(g + 4 * lane + 256 * j), bvj = *(const f32x4*)(bta + 4 * lane + 256 * j);
#pragma unroll
            for (int r = 0; r < 2; ++r) { const size_t row = (size_t)rp * 2 + r; const f32x4 o = v[r][j] * (r == 0 ? rstd0 : rstd1) * gvj + bvj;
                if (OUT) *(f32x4*)(OUT + row * 1024 + 4 * lane + 256 * j) = o;
                else { u32x2 w; w.x = pk2(o[0], o[1]); w.y = pk2(o[2], o[3]); *(u32x2*)(XO + row * 1024 + 4 * lane + 256 * j) = w;
                    if constexpr (INP_F8) { int w8 = 0; w8 = __builtin_amdgcn_cvt_pk_fp8_f32(o[0], o[1], w8, false); w8 = __builtin_amdgcn_cvt_pk_fp8_f32(o[2], o[3], w8, true); *(int*)((unsigned char*)XB + row * 1024 + 4 * lane + 256 * j) = w8; }
                    else { *(u32x2*)(XB + row * 1024 + 4 * lane + 256 * j) = w; } } } }
    }
}

constexpr int PH_PER_LAYER = 10, N_PHASES = 2 + PH_PER_LAYER * DEPTH;
__host__ __device__ constexpr bool phase_active(int p) {
    if (p < 2) return true;
    const int l = (p - 2) / PH_PER_LAYER, k = (p - 2) % PH_PER_LAYER, kind = l % 3;
    if (k == 1) return kind != 0;
    if (k == 3 || k == 4) return kind == 2;
    return true;
}

__global__ void __launch_bounds__(512, 2) fwd(Args args) {
    extern __shared__ __attribute__((aligned(16))) unsigned char lds_raw[];
    const int wave0 = __builtin_amdgcn_readfirstlane((int)threadIdx.x >> 6);
    Ctx cx; cx.lds = (LAS unsigned char*)lds_raw; cx.G = gridDim.x; { const int bx = blockIdx.x; cx.vcu = (cx.G % 8 == 0) ? (bx % 8) * (cx.G / 8) + bx / 8 : bx; } cx.ws = args.ws;
    volatile LAS unsigned* MISC = (volatile LAS unsigned*)(cx.lds + MISC_OFF);
    for (int u = threadIdx.x; u < (LDS_BYTES - MISC_OFF) / 4; u += 512) MISC[u] = 0u;
    __syncthreads();
    if (threadIdx.x == 0) { LAS unsigned long long* t = (LAS unsigned long long*)(cx.lds + PTAB_OFF);
#pragma unroll
        for (int k = 0; k < 32; ++k) t[k] = (unsigned long long)args.in[k];
        t[32] = (unsigned long long)args.out; t[33] = (unsigned long long)args.ws; }
    __syncthreads();
    const int lo = args.ph_lo, hi = args.ph_hi;
    XcdBarrier bar; bar.bar = (unsigned*)((gu32*)(args.ws + WS_CTL) + CW_BAR); bar.x = 0; bar.st = nullptr;
    if (hi - lo > 1) bar = xcd_barrier_post((unsigned*)((gu32*)(args.ws + WS_CTL) + CW_BAR), MISC + 8);
    int ran = 0;
#define XB ((bf16_t*)(ws + WS_XB))
#define PROJ ((bf16_t*)(ws + WS_PROJ))
#define CAT ((bf16_t*)(ws + WS_CAT))
#define KVM ((bf16_t*)(ws + WS_KVM))
#define HB ((bf16_t*)(ws + WS_H))
#define YB ((bf16_t*)(ws + WS_Y))
#define QKR ((bf16_t*)(ws + WS_QKR))
#define EXPID ((int*)(ws + WS_EXPID))
#define GATE ((float*)(ws + WS_GATE))
#define IDX ((int*)(ws + WS_IDX))
#define XF ((float*)(GAS float*)ptab_get(cx, 32))
#define SB ((bf16_t*)(ws + WS_SB))
#define SB2 ((bf16_t*)(ws + WS_PROJ))
#define TP_BAR_BEGIN() do {} while (0)
#define TP_BAR_END() do {} while (0)
#define TP_PH_BEGIN(p) do {} while (0)
#define TP_PH_END(p) do {} while (0)
#define PH_BEGIN(p) if (lo <= (p) && (p) < hi) { const int ph_ = (p); if (ran) { TP_BAR_BEGIN(); for (int rb_ = 0; rb_ < REP_BAR; ++rb_) xcd_barrier(bar, wave0); TP_BAR_END(); } ran = 1; const int tid = opaque_tid(wave0); (void)tid; unsigned char* const ws = (unsigned char*)(GAS unsigned char*)ptab_get(cx, 33); cx.ws = ws; TP_PH_BEGIN(ph_);
#define PH_END TP_PH_END(ph_); }

#if EN_P0
    PH_BEGIN(0) for (int rep_ = 0; rep_ < REP_P0; ++rep_) { p0_prologue(cx, tid); } PH_END
#endif

    for (int l = -1; l < DEPTH; ++l) {
        const int kind = (l < 0) ? 0 : l % 3, jj = (l < 0) ? 0 : l / 3, pw = (l < 0) ? 2048 : ((l % 3) == 1 ? 1536 : 2560), base = 2 + PH_PER_LAYER * l;
        PH_BEGIN(l < 0 ? 1 : base) {
            pg8::DenseOrder S;
            if (l < 0) S.init(ws + WS_MEMB, ws + WS_WKV, NMEM, 2048, 1024 * INP_EB, cx.G, cx.vcu);
            else S.init(XB, ws + WS_WIN + (size_t)l * 5 * MiB, NTOK, pw, 1024 * INP_EB, cx.G, cx.vcu);
            S.rep = REP_DENSE;
            const unsigned smask = (l < 0) ? 0u : (kind == 0 ? 0x207u : kind == 1 ? 0x20u : 0x200u);
            pg8::EpiBf16s E{l < 0 ? KVM : PROJ, pw, smask, C2, INP_F8 ? 1.0f / WIN_SCALE : 1.0f};
#if EN_G1
            pg8::gemm_phase<pg8::EpiBf16s, pg8::DenseOrder, false, INP_F8 != 0>(cx.lds, S, E, tid);
#endif
        } PH_END
        if (l < 0) continue;
#if EN_THIN
        if (kind == 1) { PH_BEGIN(base + 1) for (int rep_ = 0; rep_ < REP_THIN; ++rep_) { rope_phase(cx, PROJ, INP(5) + jj * 64, INP(6) + jj * 64, QKR, tid); } PH_END }
        if (kind == 2) { PH_BEGIN(base + 1) for (int rep_ = 0; rep_ < REP_THIN; ++rep_) { sconv_phase(cx, PROJ, INP(8) + (size_t)jj * 3 * 2304, INP(9) + (size_t)jj * 2304, (bf16_t*)(ws + WS_UT3), ws + WS_V8, tid); } PH_END }
#endif
        for (int o = 0; o < 2; ++o) {
            if (o == 1 && kind != 2) break;
            PH_BEGIN(base + 2 + o) {
                if (kind == 2) {
                    const bf16_t* UT3 = (const bf16_t*)(ws + WS_UT3); constexpr size_t PS = (size_t)16 * 768 * 4096;
#if EN_TCONV
                    for (int rep_ = 0; rep_ < REP_TCONV; ++rep_) {
#if TCONV_F8
                    tconv8_phase(cx, o, o == 0 ? UT3 : (const bf16_t*)(ws + WS_Z1T), ws + WS_V8 + (size_t)o * 48 * MiB, UT3 + (size_t)(1 + o) * PS, (bf16_t*)(ws + (o == 0 ? WS_Z1T : WS_Z2T)), o == 0 ? ws + WS_V8 + 48 * MiB : (unsigned char*)nullptr, INP(19) + (size_t)(jj * 2 + o) * 768, tid);
#else
                    tconv_phase(cx, o, o == 0 ? UT3 : (const bf16_t*)(ws + WS_Z1T), UT3 + (size_t)(1 + o) * PS, (bf16_t*)(ws + (o == 0 ? WS_Z1T : WS_Z2T)), INP(19) + (size_t)(jj * 2 + o) * 768, tid);
#endif
                    }
#endif
                }
                if (o == 0) {
#if EN_NA
                    for (int rep_ = 0; rep_ < REP_NA; ++rep_) { if (kind == 0) na_phase(cx, PROJ, INP(3) + (size_t)jj * 12 * 465, CAT, tid); }
#endif
                    const int ngqa = (kind == 1) ? 3072 : 0;
                    for (int rep_ = 0; rep_ < REP_ATTN; ++rep_)
                    for (int u = cx.vcu; u < ngqa + 1024; u += cx.G) {
                        const attn_body::bf16 *Q, *K, *V; attn_body::bf16* O; int QP, KP, VP, NT;
                        if (u < ngqa) { const int qb = u & 15, hq = (u >> 4) % 12, b = u / 192, kvh = hq / 3;
                            Q = (const attn_body::bf16*)QKR + ((size_t)b * 4096 + qb * 256) * 1024 + hq * 64; QP = 1024;
                            K = (const attn_body::bf16*)QKR + (size_t)b * 4096 * 1024 + 768 + kvh * 64; KP = 1024;
                            V = (const attn_body::bf16*)PROJ + (size_t)b * 4096 * 1536 + 1024 + kvh * 64; VP = 1536;
                            O = (attn_body::bf16*)((unsigned char*)CAT + (((size_t)b * 4096 + qb * 256) * 1024 + hq * 64) * OUT_EB); NT = 64;
                        } else { const int v = u - ngqa, qb = v & 15, h = (v >> 4) & 3, b = v >> 6;
                            Q = (const attn_body::bf16*)PROJ + ((size_t)b * 4096 + qb * 256) * pw + (pw - 256) + h * 64; QP = pw;
                            K = (const attn_body::bf16*)KVM + (size_t)b * 256 * 2048 + 512 * l + h * 64; KP = 2048;
                            V = K + 256; VP = 2048;
                            O = (attn_body::bf16*)((unsigned char*)CAT + (((size_t)b * 4096 + qb * 256) * 1024 + 768 + h * 64) * OUT_EB); NT = 4;
                        }
#if EN_ATTN
                        attn_body::attn_unit<8, OUTP_F8 != 0>(Q, K, V, O, QP, KP, VP, 1024, NT, (char*)lds_raw, tid);
#endif
                    }
                }
            } PH_END
        }
#if EN_THIN
        if (kind == 2) { PH_BEGIN(base + 4) for (int rep_ = 0; rep_ < REP_THIN; ++rep_) { tback_phase(cx, (const bf16_t*)(ws + WS_Z2T), CAT, tid); } PH_END }
#endif
        PH_BEGIN(base + 5) {
            pg8::DenseOrder S; S.init(CAT, ws + WS_WOUT + (size_t)l * 2 * MiB, NTOK, 1024, 1024 * OUT_EB, cx.G, cx.vcu);
            pg8::EpiResB E{SB, l == 0 ? (const void*)INP(0) : (const void*)SB, l == 0 ? 1 : 0, 1024, DN_ALPHA, OUTP_F8 ? 1.0f / WOUT_SCALE : 1.0f};
#if EN_G2
            pg8::gemm_phase<pg8::EpiResB, pg8::DenseOrder, false, OUTP_F8 != 0>(cx.lds, S, E, tid);
#endif
        } PH_END
#if EN_LN
#if REP_LN1 > 1
        PH_BEGIN(base + 6) ln1_router_phase(cx, SB, (bf16_t*)(ws + WS_PROJ), CAT, INP(22) + l * 1024, INP(23) + l * 1024, INP(26) + (size_t)l * 1024 * 32, INP(27) + l * 32, (unsigned*)((gu32*)(ws + WS_CTL) + CW_DBG), EXPID, GATE, IDX, (float*)(ws + WS_GIDX), tid); PH_END
#endif
        PH_BEGIN(base + 6) ln1_router_phase(cx, SB, SB2, XB, INP(22) + l * 1024, INP(23) + l * 1024, INP(26) + (size_t)l * 1024 * 32, INP(27) + l * 32, (unsigned*)((gu32*)(ws + WS_CTL) + CW_CNT + 32 * l), EXPID, GATE, IDX, (float*)(ws + WS_GIDX), tid); PH_END
#endif
        for (int half = 0; half < 2; ++half) {
            PH_BEGIN(base + 7 + half) {
                LAS int* pref = (LAS int*)(cx.lds + pg8::STAGE_BYTES); const unsigned* cntw = (const unsigned*)((gu32*)(ws + WS_CTL) + CW_CNT + 32 * l);
                __syncthreads();
                if (tid == 0) { int a = 0;
#pragma unroll 1
                    for (int e = 0; e < NEXP; ++e) { const int c = (int)__hip_atomic_load(cntw + e, __ATOMIC_RELAXED, __HIP_MEMORY_SCOPE_AGENT); pref[e] = a; pref[40 + e] = c; a += (c + 255) >> 8; } pref[NEXP] = a; }
                __syncthreads();
#if STAGGER
                if (cx.vcu & 1) { for (int s_ = 0; s_ < STAGGER; ++s_) __builtin_amdgcn_s_sleep(127); }
#endif
                if (half == 0) {
                    pg8::MoeOrder<2> S{(const char*)XB, (const char*)(ws + WS_W1 + (size_t)l * 32 * 2048 * 1024 * MOE_EB), 1024 * MOE_EB, 8, cx.G, cx.vcu, (size_t)2048 * 1024 * MOE_EB, pref, (const int*)cntw, IDX};
                    pg8::EpiSwiglu E{HB, INP(29) + (size_t)l * 32 * 2048};
#if EN_G3
                    for (int rep_ = 0; rep_ < REP_G3; ++rep_) { pg8::gemm_phase<pg8::EpiSwiglu, pg8::MoeOrder<2>, true, MOE_F8 != 0, (MOE_F8 != 0) && (DEFER_H != 0)>(cx.lds, S, E, tid); }
#endif
                } else {
                    pg8::MoeOrder<0> S{(const char*)HB, (const char*)(ws + WS_W2 + (size_t)l * 32 * 1024 * 1024 * MOE_EB), 1024 * MOE_EB, 4, cx.G, cx.vcu, (size_t)1024 * 1024 * MOE_EB, pref, (const int*)cntw, IDX};
                    pg8::EpiMoeOut E{YB, INP(31) + (size_t)l * 32 * 1024, (const float*)(ws + WS_GIDX)};
#if EN_G4
                    for (int rep_ = 0; rep_ < REP_G4; ++rep_) { pg8::gemm_phase<pg8::EpiMoeOut, pg8::MoeOrder<0>, true, MOE_F8 != 0>(cx.lds, S, E, tid); }
#endif
                }
            } PH_END
        }
#if EN_LN
#if REP_LN2 > 1
        PH_BEGIN(base + 9) ln2_phase(cx, SB, YB, (bf16_t*)(ws + WS_PROJ), CAT, (float*)nullptr, INP(24) + l * 1024, INP(25) + l * 1024, tid); PH_END
#endif
        PH_BEGIN(base + 9) ln2_phase(cx, SB2, YB, SB, XB, l == DEPTH - 1 ? XF : (float*)nullptr, INP(24) + l * 1024, INP(25) + l * 1024, tid); PH_END

#endif
    }
#undef PH_BEGIN
#undef PH_END
#undef XB
#undef PROJ
#undef CAT
#undef KVM
#undef HB
#undef YB
#undef QKR
#undef EXPID
#undef GATE
#undef IDX
#undef XF
#undef SB
#undef SB2
}

extern "C" void kernel_launch(void* const* d_in, const int* in_sizes, int n_in, void* d_out, int out_size, void* d_ws, size_t ws_size, hipStream_t stream) {
    static int grid = 0;
    if (grid == 0) {
        if (n_in != 32 || in_sizes[0] != NTOK * DM || out_size != NTOK * DM || ws_size < WS_END) { fprintf(stderr, "kernel_launch: unexpected problem (n_in %d, in0 %d, out %d, ws %zu < %zu); nothing launched\n", n_in, n_in > 0 ? in_sizes[0] : -1, out_size, ws_size, (size_t)WS_END); grid = -1; return; }
        int dev = 0, cus = 0, per_cu = 0;
        if (hipGetDevice(&dev) != hipSuccess || hipDeviceGetAttribute(&cus, hipDeviceAttributeMultiprocessorCount, dev) != hipSuccess) { fprintf(stderr, "kernel_launch: device query failed\n"); grid = -1; return; }
        if (hipFuncSetAttribute((const void*)fwd, hipFuncAttributeMaxDynamicSharedMemorySize, LDS_BYTES) != hipSuccess) { fprintf(stderr, "kernel_launch: hipFuncSetAttribute failed\n"); grid = -1; return; }
        if (hipOccupancyMaxActiveBlocksPerMultiprocessor(&per_cu, (const void*)fwd, 512, LDS_BYTES) != hipSuccess || per_cu < 1) fprintf(stderr, "kernel_launch: occupancy query reports %d blocks per CU\n", per_cu);
        (void)hipGetLastError();
        grid = cus;
    }
    if (grid < 0) return;
    if (hipMemsetAsync((char*)d_ws + WS_CTL, 0, CTL_ZERO_BYTES, stream) != hipSuccess) { fprintf(stderr, "kernel_launch: memset failed\n"); return; }
    Args a{};
    for (int i = 0; i < 32; ++i) a.in[i] = (const float*)d_in[i];
    a.out = (float*)d_out; a.ws = (unsigned char*)d_ws;
#if MK_MULTI
    for (int p = 0; p < N_PHASES && p <= DBG_LAST_PHASE; ++p) {
        if (!phase_active(p)) continue;
        a.ph_lo = p; a.ph_hi = p + 1;
        hipLaunchKernelGGL(fwd, dim3(grid), dim3(512), LDS_BYTES, stream, a);
#if DBG_CHECK
        dbg_after_phase(p, a, stream);
#endif
    }
#if DBG_CHECK
    hipLaunchKernelGGL(dbg_report, dim3(1024), dim3(256), 0, stream, (unsigned*)((char*)d_ws + WS_CTL) + CW_DBG, (float*)d_out);
#endif
#else
    a.ph_lo = 0; a.ph_hi = N_PHASES;
    hipLaunchKernelGGL(fwd, dim3(grid), dim3(512), LDS_BYTES, stream, a);
#endif
    const hipError_t le = hipPeekAtLastError();
    if (le != hipSuccess) fprintf(stderr, "kernel_launch: launch failed: %s\n", hipGetErrorName(le));
}
```

```cpp
#include <hip/hip_runtime.h>
#include <hip/hip_bf16.h>
#include <cstdio>
#include <cstdint>

#ifndef MK_MULTI
#define MK_MULTI 0
#endif
#ifndef DBG_CHECK
#define DBG_CHECK 0
#endif
#ifndef DBG_LAST_PHASE
#define DBG_LAST_PHASE 9999
#endif

#ifndef EN_P0
#define EN_P0 1
#define EN_G1 1
#define EN_THIN 1
#define EN_TCONV 1
#define EN_NA 1
#define EN_ATTN 1
#define EN_G2 1
#define EN_LN 1
#define EN_G3 1
#define EN_G4 1
#endif

#ifndef REP_P0
#define REP_P0 1
#endif
#ifndef REP_G1
#define REP_G1 1
#endif
#ifndef REP_NA
#define REP_NA 1
#endif
#ifndef REP_ATTN
#define REP_ATTN 1
#endif
#ifndef REP_TCONV
#define REP_TCONV 1
#endif
#ifndef REP_THIN
#define REP_THIN 1
#endif
#ifndef REP_G3
#define REP_G3 1
#endif
#ifndef REP_G4
#define REP_G4 1
#endif
#ifndef ALIGN_EPI
#define ALIGN_EPI 1
#endif
#ifndef NT_STORE
#define NT_STORE 0
#endif
#ifndef LN1_HOLD
#define LN1_HOLD 16
#endif
#ifndef DEFER_H
#define DEFER_H 0
#endif
#ifndef STAGGER
#define STAGGER 0
#endif
#ifndef REP_BAR
#define REP_BAR 1
#endif
#ifndef REP_DENSE
#define REP_DENSE 1
#endif
#ifndef REP_G2
#define REP_G2 1
#endif
#ifndef REP_LN1
#define REP_LN1 1
#endif
#ifndef REP_LN2
#define REP_LN2 1
#endif

#define GAS __attribute__((address_space(1)))
#define LAS __attribute__((address_space(3)))
typedef unsigned short bf16_t;
typedef short bf16x8 __attribute__((ext_vector_type(8)));
typedef short s16x4 __attribute__((ext_vector_type(4)));
typedef float f32x4 __attribute__((ext_vector_type(4)));
typedef float f32x2 __attribute__((ext_vector_type(2)));
typedef float f32x16 __attribute__((ext_vector_type(16)));
typedef unsigned u32x4 __attribute__((ext_vector_type(4)));
typedef unsigned u32x2 __attribute__((ext_vector_type(2)));
typedef GAS unsigned gu32;

constexpr int BATCH = 16, SEQ = 4096, DM = 1024, NTOK = BATCH * SEQ, DEPTH = 4;
constexpr int MEMLEN = 256, NMEM = BATCH * MEMLEN;
constexpr int NEXP = 32, NSLOT = NTOK * 4, IDXCAP = NTOK;
constexpr int GRIDW = 64;
constexpr float LN_EPS = 1e-5f;
constexpr float DN_ALPHA = 1.681792830507429f;
constexpr float LOG2E = 1.4426950408889634f;
constexpr float C2 = 0.125f * LOG2E;
__host__ __device__ constexpr int layer_kind(int l) { return l % 3; }
__host__ __device__ constexpr int layer_j(int l) { return l / 3; }
__host__ __device__ constexpr int in_width(int l) { return (l % 3) == 1 ? 1536 : 2560; }

#ifndef MOE_F8
#define MOE_F8 1
#endif
#ifndef INP_F8
#define INP_F8 1
#endif
constexpr int INP_EB = INP_F8 ? 1 : 2;
constexpr float WIN_SCALE = 32.0f;
#ifndef OUTP_F8
#define OUTP_F8 1
#endif
constexpr int OUT_EB = OUTP_F8 ? 1 : 2;
constexpr float WOUT_SCALE = 64.0f;
__device__ __forceinline__ unsigned char f2fp8(float x) { return (unsigned char)(__builtin_amdgcn_cvt_pk_fp8_f32(x, x, 0, false) & 0xff); }
#ifndef TCONV_F8
#define TCONV_F8 1
#endif
#ifndef Y_F8
#define Y_F8 1
#endif
constexpr float Y_SCALE = 64.0f;
constexpr int MOE_EB = MOE_F8 ? 1 : 2;
constexpr float W1_SCALE = 32.0f, W2_SCALE = 64.0f, H_SCALE = 4.0f;

constexpr size_t MiB = 1u << 20;
constexpr size_t WS_CTL = 0, CTL_ZERO_BYTES = 1 * MiB;
constexpr size_t WS_WIN = 2 * MiB;
constexpr size_t WS_WKV = 22 * MiB;
constexpr size_t WS_WOUT = 26 * MiB;
constexpr size_t WS_W1 = 34 * MiB;
constexpr size_t WS_W2 = 546 * MiB;
constexpr size_t WS_XB = 802 * MiB;
constexpr size_t WS_MEMB = 930 * MiB;
constexpr size_t WS_KVM = 938 * MiB;
constexpr size_t WS_PROJ = 954 * MiB;
constexpr size_t WS_CAT = 1274 * MiB;
constexpr size_t WS_H = 1402 * MiB;
constexpr size_t WS_Y = 1914 * MiB;
constexpr size_t WS_HRAWT = 2426 * MiB;
constexpr size_t WS_HPART = 2474 * MiB;
constexpr size_t WS_EXPID = 2478 * MiB;
constexpr size_t WS_GATE = 2479 * MiB;
constexpr size_t WS_IDX = 2480 * MiB;
constexpr size_t WS_SB = 2488 * MiB;
constexpr size_t WS_GIDX = 2616 * MiB;
constexpr size_t WS_END = 2624 * MiB;
constexpr size_t WS_UT3 = WS_H;
constexpr size_t WS_Z1T = WS_H + 288 * MiB;
constexpr size_t WS_Z2T = WS_H + 384 * MiB;
constexpr size_t WS_V8 = WS_Y;
constexpr size_t WS_QKR = WS_Y;
constexpr int CW_BAR = 4096;
constexpr int CW_CNT = 8192;
constexpr int CW_DBG = 12288;

constexpr int MISC_OFF = 150528;
constexpr int LDS_BYTES = 151552;

#define LDS_WAIT() asm volatile("s_waitcnt lgkmcnt(0)" ::: "memory")
#define VM_WAIT() asm volatile("s_waitcnt vmcnt(0)" ::: "memory")
__device__ __forceinline__ unsigned f2bf(float f) { unsigned u = __builtin_bit_cast(unsigned, f); return (u + 0x7fffu + ((u >> 16) & 1u)) >> 16; }
__device__ __forceinline__ unsigned pk2(float lo, float hi) { return f2bf(lo) | (f2bf(hi) << 16); }
__device__ __forceinline__ float bf2f(unsigned short b) { return __builtin_bit_cast(float, ((unsigned)b) << 16); }
__device__ __forceinline__ float bflo(unsigned w) { return __builtin_bit_cast(float, w << 16); }
__device__ __forceinline__ float bfhi(unsigned w) { return __builtin_bit_cast(float, w & 0xffff0000u); }
__device__ __forceinline__ float shflx(float v, int mask, int lane) { int t; asm volatile("v_mov_b32 %0, %1" : "=v"(t) : "v"(__builtin_bit_cast(int, v))); return __builtin_bit_cast(float, __builtin_amdgcn_ds_bpermute((lane ^ mask) << 2, t)); }
__device__ __forceinline__ int shflxi(int v, int mask, int lane) { return __builtin_amdgcn_ds_bpermute((lane ^ mask) << 2, v); }
template <int CTRL> __device__ __forceinline__ float dpp_x(float v) { return __builtin_bit_cast(float, __builtin_amdgcn_update_dpp(0, __builtin_bit_cast(int, v), CTRL, 0xF, 0xF, false)); }
__device__ __forceinline__ float group8_sum(float v) { v += dpp_x<0xB1>(v); v += dpp_x<0x4E>(v); v += dpp_x<0x141>(v); return v; }
__device__ __forceinline__ float wave_sum(float v, int  ) {
    v += dpp_x<0xB1>(v); v += dpp_x<0x4E>(v); v += dpp_x<0x141>(v); v += dpp_x<0x140>(v);
    v += __builtin_bit_cast(float, __builtin_amdgcn_update_dpp(0, __builtin_bit_cast(int, v), 0x142, 0xA, 0xF, false));
    v += __builtin_bit_cast(float, __builtin_amdgcn_update_dpp(0, __builtin_bit_cast(int, v), 0x143, 0xC, 0xF, false));
    return __builtin_bit_cast(float, __builtin_amdgcn_readlane(__builtin_bit_cast(int, v), 63));
}
__device__ __forceinline__ int lane_id_volatile() { int l; asm volatile("v_mbcnt_lo_u32_b32 %0, -1, 0\n\tv_mbcnt_hi_u32_b32 %0, -1, %0" : "=&v"(l)); return l; }
__device__ __forceinline__ int opaque_tid(int wave0) { return wave0 * 64 + lane_id_volatile(); }

#define XB_TMO      128
#define XB_XCNT(j)  (256  + 64 * (j))
#define XB_XSUB(j)  (1280 + 64 * (j))
#define XB_XGEN(j)  (2304 + 64 * (j))
#define XB_TOP      3328
#define XB_TOPGEN   3392
#define XCD_BAR_WORDS 3456
#define XB_SPIN_CAP (1u << 20)

__device__ __forceinline__ unsigned xb_ld(unsigned* p)              { return __hip_atomic_load(p, __ATOMIC_RELAXED, __HIP_MEMORY_SCOPE_AGENT); }
__device__ __forceinline__ unsigned xb_add(unsigned* p, unsigned v) { return __hip_atomic_fetch_add(p, v, __ATOMIC_RELAXED, __HIP_MEMORY_SCOPE_AGENT); }
__device__ __forceinline__ unsigned xb_xcc_id() { return (unsigned)__builtin_amdgcn_s_getreg((3 << 11) | 20) & 0xFu; }
#define XB_SPIN(cond, bar) do { unsigned _sp = 0; while (cond) { __builtin_amdgcn_s_sleep(1); \
    if ((++_sp & 255u) == 0u) { if (xb_ld(&(bar)[XB_TMO])) break; if (_sp > XB_SPIN_CAP) { atomicAdd(&(bar)[XB_TMO], 1u); break; } } } } while (0)

struct XcdBarrier {
    unsigned* bar; unsigned x;
    volatile LAS unsigned* st;
};
__device__ __forceinline__ XcdBarrier xcd_barrier_post(unsigned* bar, volatile LAS unsigned* st) {
    XcdBarrier b; b.bar = bar; b.x = xb_xcc_id(); b.st = st;
    if (threadIdx.x == 0) (void)xb_add(&bar[XB_XCNT(b.x)], 1u);
    return b;
}
__device__ __forceinline__ void xcd_barrier_complete(unsigned* bar, unsigned x, unsigned& nloc, unsigned& nx) {
    const unsigned G = gridDim.x * gridDim.y * gridDim.z;
    unsigned sum, cnt, mine, sp = 0u;
    for (;;) {
        sum = 0u; cnt = 0u; mine = 0u;
#pragma unroll 1
        for (unsigned j = 0; j < 16; ++j) { const unsigned c = xb_ld(&bar[XB_XCNT(j)]); sum += c; cnt += (c > 0u) ? 1u : 0u; mine = (j == x) ? c : mine; }
        if (sum == G) break;
        __builtin_amdgcn_s_sleep(1);
        if ((++sp & 255u) == 0u) { if (xb_ld(&bar[XB_TMO])) break; if (sp > XB_SPIN_CAP) { atomicAdd(&bar[XB_TMO], 1u); break; } }
    }
    nloc = mine > 0u ? mine : 1u; nx = cnt > 0u ? cnt : 1u;
}
__device__ __forceinline__ void xcd_barrier(const XcdBarrier& b, const int wave0) {
    asm volatile("s_waitcnt vmcnt(0)" ::: "memory");
    __syncthreads();
    if (wave0 == 0 && lane_id_volatile() == 0) {
        unsigned* bar = b.bar;
        __builtin_amdgcn_s_waitcnt(0);
        unsigned nloc = b.st[0], nx = b.st[1];
        if (nloc == 0u) { xcd_barrier_complete(bar, b.x, nloc, nx); b.st[0] = nloc; b.st[1] = nx; }
        const unsigned old = xb_add(&bar[XB_XSUB(b.x)], 1u);
        const unsigned gen = old / nloc;
        if (old + 1u == (gen + 1u) * nloc) {
            __builtin_amdgcn_fence(__ATOMIC_RELEASE, "agent");
            asm volatile("s_waitcnt vmcnt(0)" ::: "memory");
            const unsigned og = xb_add(&bar[XB_TOP], 1u);
            const unsigned tg = og / nx;
            if (og + 1u == (tg + 1u) * nx) xb_add(&bar[XB_TOPGEN], 1u);
            else XB_SPIN(xb_ld(&bar[XB_TOPGEN]) == tg, bar);
            __builtin_amdgcn_fence(__ATOMIC_ACQUIRE, "agent");
            xb_add(&bar[XB_XGEN(b.x)], 1u);
            asm volatile("s_waitcnt vmcnt(0)" ::: "memory");
        } else {
            XB_SPIN(xb_ld(&bar[XB_XGEN(b.x)]) == gen, bar);
            __builtin_amdgcn_fence(__ATOMIC_ACQUIRE, "agent");
            asm volatile("s_waitcnt vmcnt(0)" ::: "memory");
        }
    }
    __syncthreads();
}

namespace pg8 {
constexpr int BM = 256, BK = 64, HALF = 128, HTB = HALF * BK * 2  , STAGE_BYTES = 8 * HTB, NXCD = 8, WGM = 8;
__host__ __device__ __forceinline__ int lds_byte(int r, int c) { const int st = (r >> 4) * 2 + (c >> 5), rr = r & 15, cc = c & 31, ob = rr * 64 + cc * 2; return st * 1024 + (ob ^ (((ob >> 9) & 1) << 5)); }
__host__ __device__ __forceinline__ void stage_rc(int b, int& R, int& C) { const int st = b / 1024, sb = b % 1024, swz = sb ^ (((sb >> 9) & 1) << 5); R = (st >> 1) * 16 + swz / 64; C = (st & 1) * 32 + (swz % 64) / 2; }
__host__ __device__ __forceinline__ int perm32(int rho) { const int n = rho >> 4, i = rho & 15; return 8 * (i >> 2) + 4 * n + (i & 3); }

struct Unit { int pm, pn, e, p; };

struct DenseOrder {
    const char* A; const char* Bt; int KB; int nM, nN, nwg, G, c; int rep = 1;
    __device__ __forceinline__ void init(const void* A_, const void* Bt_, int M, int N, int KB_, int G_, int c_) { A = (const char*)A_; Bt = (const char*)Bt_; KB = KB_; nM = M / BM; nN = N / BM; nwg = nM * nN; G = G_; c = c_; }
    __device__ __forceinline__ bool next(int i, Unit& u) const {
        long L = (long)i * G + c; if (L >= (long)nwg * rep) return false;
        if (rep > 1) L %= nwg;
        int wgid = (int)L; { const int q = nwg / NXCD, r = nwg % NXCD, xcd = wgid % NXCD, off = wgid / NXCD; wgid = (xcd < r ? xcd * (q + 1) : r * (q + 1) + (xcd - r) * q) + off; }
        const int nig = WGM * nN, gid = wgid / nig, fm = gid * WGM, gsz = (nM - fm) < WGM ? (nM - fm) : WGM;
        u.pm = __builtin_amdgcn_readfirstlane(fm + ((wgid % nig) % gsz)); u.pn = __builtin_amdgcn_readfirstlane((wgid % nig) / gsz); u.e = 0; u.p = 0; return true;
    }
    __device__ __forceinline__ const char* a_base(const Unit& u) const { return A + (size_t)u.pm * BM * KB; }
    __device__ __forceinline__ const char* b_base(const Unit& u) const { return Bt + (size_t)u.pn * BM * KB; }
    __device__ __forceinline__ const int* idx_src(const Unit&) const { return nullptr; }
    __device__ __forceinline__ int nvalid(const Unit&) const { return BM; }
    static constexpr int ROW_SHIFT = 0;
};
template <int SHIFT  > struct MoeOrder {
    const char* A; const char* Bt; int KB; int nN; int G, c; size_t bstride; const LAS int* pref; const int* cnt; const int* idx;
    __device__ __forceinline__ bool next(int i, Unit& u) const {
        const long L = (long)i * G + c; const int tot = __builtin_amdgcn_readfirstlane(pref[NEXP]);
        if (L >= (long)tot * nN) return false;
        const int pg = __builtin_amdgcn_readfirstlane((int)(L / nN)); u.pn = __builtin_amdgcn_readfirstlane((int)(L % nN));
        int e = 0;
#pragma unroll
        for (int step = 16; step >= 1; step >>= 1) { const int v = __builtin_amdgcn_readfirstlane(pref[e + step]); e += (v <= pg) ? step : 0; }
        u.e = e; u.p = pg - __builtin_amdgcn_readfirstlane(pref[e]); u.pm = 0; return true;
    }
    __device__ __forceinline__ const char* a_base(const Unit&) const { return A; }
    __device__ __forceinline__ const char* b_base(const Unit& u) const { return Bt + (size_t)u.e * bstride + (size_t)u.pn * BM * KB; }
    __device__ __forceinline__ const int* idx_src(const Unit& u) const { return idx + (size_t)u.e * IDXCAP + u.p * BM; }
    __device__ __forceinline__ int nvalid(const Unit& u) const { const int n = __builtin_amdgcn_readfirstlane(pref[40 + u.e]) - u.p * BM; return n < BM ? n : BM; }
    static constexpr int ROW_SHIFT = SHIFT;
};

__device__ __forceinline__ unsigned cvt_pk_bf16(float lo, float hi) { unsigned r; asm volatile("v_cvt_pk_bf16_f32 %0, %1, %2" : "=v"(r) : "v"(lo), "v"(hi)); return r; }

struct EpiBf16s {
    static constexpr bool PERM = true; static constexpr bool HAS_BIAS = false;
    bf16_t* O; int ldc; unsigned smask; float scale; float base;
    __device__ __forceinline__ void operator()(const f32x4 (&acc)[2][2][4][2], const Unit& u, int wr, int wc, int fr, int fq) const {
        const int row0 = u.pm * BM + wr * 64 + fr, col0 = u.pn * BM + wc * 32 + 8 * fq;
        const float sc = (((smask >> u.pn) & 1u) ? scale : 1.f) * base;
#pragma unroll
        for (int ai = 0; ai < 2; ++ai)
#pragma unroll
            for (int m = 0; m < 4; ++m) { bf16_t* rowp = O + (size_t)(row0 + ai * HALF + m * 16) * ldc + col0;
#pragma unroll
                for (int bj = 0; bj < 2; ++bj) { const f32x4 v0 = acc[ai][bj][m][0] * sc, v1 = acc[ai][bj][m][1] * sc;
                    u32x4 w; w.x = cvt_pk_bf16(v0[0], v0[1]); w.y = cvt_pk_bf16(v0[2], v0[3]); w.z = cvt_pk_bf16(v1[0], v1[1]); w.w = cvt_pk_bf16(v1[2], v1[3]);
                    if (NT_STORE) __builtin_nontemporal_store(w, (u32x4*)(rowp + bj * HALF)); else *(u32x4*)(rowp + bj * HALF) = w; }
                asm volatile("" ::: "memory"); }
    }
};
struct EpiResB {
    static constexpr bool PERM = true; static constexpr bool HAS_BIAS = false;
    bf16_t* C; const void* res; int res_f32; int ldc; float alpha; float ascale;
    __device__ __forceinline__ void operator()(const f32x4 (&acc)[2][2][4][2], const Unit& u, int wr, int wc, int fr, int fq) const {
        const int row0 = u.pm * BM + wr * 64 + fr, col0 = u.pn * BM + wc * 32 + 8 * fq;
#pragma unroll
        for (int ai = 0; ai < 2; ++ai)
#pragma unroll
            for (int m = 0; m < 4; ++m) { const size_t off = (size_t)(row0 + ai * HALF + m * 16) * ldc + col0;
#pragma unroll
                for (int bj = 0; bj < 2; ++bj) { f32x4 r0, r1;
                    if (res_f32) { const float* rp = (const float*)res + off + bj * HALF; r0 = *(const f32x4*)rp; r1 = *(const f32x4*)(rp + 4); }
                    else { const u32x4 raw = *(const u32x4*)((const bf16_t*)res + off + bj * HALF); r0 = (f32x4){bflo(raw.x), bfhi(raw.x), bflo(raw.y), bfhi(raw.y)}; r1 = (f32x4){bflo(raw.z), bfhi(raw.z), bflo(raw.w), bfhi(raw.w)}; }
                    const f32x4 v0 = r0 * alpha + acc[ai][bj][m][0] * ascale, v1 = r1 * alpha + acc[ai][bj][m][1] * ascale;
                    u32x4 w; w.x = cvt_pk_bf16(v0[0], v0[1]); w.y = cvt_pk_bf16(v0[2], v0[3]); w.z = cvt_pk_bf16(v1[0], v1[1]); w.w = cvt_pk_bf16(v1[2], v1[3]);
                    *(u32x4*)(C + off + bj * HALF) = w; }
                asm volatile("" ::: "memory"); }
    }
};
struct Pend { u32x2 val[8]; };
struct EpiSwiglu {
    static constexpr bool PERM = true; static constexpr bool HAS_GATE = false; static constexpr bool HAS_BIAS = true;
    __device__ __forceinline__ void load_bias(const Unit& u, int wc, int fq, f32x4 (&bp)[4]) const { const float* bg = b1 + (size_t)u.e * 2048 + u.pn * HALF + wc * 32 + 8 * fq; bp[0] = *(const f32x4*)bg; bp[1] = *(const f32x4*)(bg + 4); bp[2] = *(const f32x4*)(bg + 1024); bp[3] = *(const f32x4*)(bg + 1028); }
    bf16_t* H; const float* b1;
    __device__ __forceinline__ void prepare(const f32x4 (&acc)[2][2][4][2], const Unit& u, int wr, int wc, int fr, int fq, Pend& pd) const {
        constexpr float ASC = 1.0f / W1_SCALE;
        const int j0 = u.pn * HALF + wc * 32 + 8 * fq; const float* bg = b1 + (size_t)u.e * 2048 + j0; const float* bu = bg + 1024;
        const f32x4 bg0 = *(const f32x4*)bg, bg1 = *(const f32x4*)(bg + 4), bu0 = *(const f32x4*)bu, bu1 = *(const f32x4*)(bu + 4);
#pragma unroll
        for (int q8 = 0; q8 < 8; ++q8) { const int ai = q8 >> 2, m = q8 & 3;
            float o[8];
#pragma unroll
            for (int q = 0; q < 8; ++q) { const float gb = (q < 4 ? bg0[q & 3] : bg1[q & 3]), ub = (q < 4 ? bu0[q & 3] : bu1[q & 3]);
                float g = acc[ai][0][m][q >> 2][q & 3] * ASC + gb, uu = acc[ai][1][m][q >> 2][q & 3] * ASC + ub;
                g = fminf(g, 7.0f); uu = fminf(fmaxf(uu, -7.0f), 7.0f);
                const float sg = __builtin_amdgcn_rcpf(1.0f + __builtin_amdgcn_exp2f(-1.702f * LOG2E * g));
                o[q] = (uu + 1.0f) * (g * sg); }
            int w0 = 0, w1 = 0;
            w0 = __builtin_amdgcn_cvt_pk_fp8_f32(o[0] * H_SCALE, o[1] * H_SCALE, w0, false); w0 = __builtin_amdgcn_cvt_pk_fp8_f32(o[2] * H_SCALE, o[3] * H_SCALE, w0, true);
            w1 = __builtin_amdgcn_cvt_pk_fp8_f32(o[4] * H_SCALE, o[5] * H_SCALE, w1, false); w1 = __builtin_amdgcn_cvt_pk_fp8_f32(o[6] * H_SCALE, o[7] * H_SCALE, w1, true);
            pd.val[q8] = (u32x2){(unsigned)w0, (unsigned)w1}; }
    }
    __device__ __forceinline__ void store_one(const u32x2 v, const LAS int* ids, const int r, const int nv, const int j0) const { if (r < nv) { const int slot = ids[r]; *(u32x2*)((unsigned char*)H + (size_t)slot * 1024 + j0) = v; } }
    __device__ __forceinline__ void operator()(const f32x4 (&acc)[2][2][4][2], const Unit& u, int wr, int wc, int fr, int fq, const LAS int* ids, const int nv, const f32x4 (&bp)[4]) const {
        constexpr float ASC = MOE_F8 ? 1.0f / W1_SCALE : 1.0f;
        constexpr float HS = MOE_F8 ? H_SCALE : 1.0f, KK = -1.702f * LOG2E, GA = ASC * KK, UA = ASC * HS / KK, ULO = 8.0f * HS / KK, UHI = -6.0f * HS / KK, GLO = 7.0f * KK;
        const int j0 = u.pn * HALF + wc * 32 + 8 * fq;
        const f32x4 bg0 = bp[0] * KK, bg1 = bp[1] * KK; f32x4 bu0 = (bp[2] + 1.0f) * (HS / KK), bu1 = (bp[3] + 1.0f) * (HS / KK);
        asm volatile("" : "+v"(bu0), "+v"(bu1));
        int rb = wr * 64 + fr; asm volatile("" : "+v"(rb));
        const LAS int* idp = ids + rb; int slots[8];
#pragma unroll
        for (int q = 0; q < 8; ++q) slots[q] = idp[(q >> 2) * HALF + (q & 3) * 16];
#pragma unroll
        for (int ai = 0; ai < 2; ++ai)
#pragma unroll
            for (int m = 0; m < 4; ++m) { const int r = ai * HALF + m * 16 + rb;
                if (r < nv) { const int slot = slots[ai * 4 + m];
                    float o[8];
#pragma unroll
                    for (int q = 0; q < 8; ++q) { const float gb = (q < 4 ? bg0[q & 3] : bg1[q & 3]), ub = (q < 4 ? bu0[q & 3] : bu1[q & 3]);
                        const float gp = fmaxf(__builtin_fmaf(acc[ai][0][m][q >> 2][q & 3], GA, gb), GLO);
                        const float us = fminf(fmaxf(__builtin_fmaf(acc[ai][1][m][q >> 2][q & 3], UA, ub), ULO), UHI);
                        const float sg = __builtin_amdgcn_rcpf(1.0f + __builtin_amdgcn_exp2f(gp));
                        o[q] = us * (gp * sg); }
                    if constexpr (MOE_F8) { int w0 = 0, w1 = 0;
                        w0 = __builtin_amdgcn_cvt_pk_fp8_f32(o[0], o[1], w0, false); w0 = __builtin_amdgcn_cvt_pk_fp8_f32(o[2], o[3], w0, true);
                        w1 = __builtin_amdgcn_cvt_pk_fp8_f32(o[4], o[5], w1, false); w1 = __builtin_amdgcn_cvt_pk_fp8_f32(o[6], o[7], w1, true);
                        *(u32x2*)((unsigned char*)H + (size_t)slot * 1024 + j0) = (u32x2){(unsigned)w0, (unsigned)w1};
                    } else { u32x4 w; w.x = cvt_pk_bf16(o[0], o[1]); w.y = cvt_pk_bf16(o[2], o[3]); w.z = cvt_pk_bf16(o[4], o[5]); w.w = cvt_pk_bf16(o[6], o[7]);
                        *(u32x4*)(H + (size_t)slot * 1024 + j0) = w; } } }
    }
};
struct EpiMoeOut {
    static constexpr bool PERM = true; static constexpr bool HAS_GATE = true; static constexpr bool HAS_BIAS = true;
    __device__ __forceinline__ void load_bias(const Unit& u, int wc, int fq, f32x4 (&bp)[4]) const { const float* bb = b2 + (size_t)u.e * 1024 + u.pn * BM + wc * 32 + 8 * fq; bp[0] = *(const f32x4*)bb; bp[1] = *(const f32x4*)(bb + 4); bp[2] = *(const f32x4*)(bb + HALF); bp[3] = *(const f32x4*)(bb + HALF + 4); }
    bf16_t* Y; const float* b2;   const float* gidx;
    __device__ __forceinline__ void operator()(const f32x4 (&acc)[2][2][4][2], const Unit& u, int wr, int wc, int fr, int fq, const LAS int* ids, const int nv, const f32x4 (&bp)[4]) const {
        const LAS float* gts = (const LAS float*)(ids + 768);
        constexpr float OSC = MOE_F8 ? 1.0f / (H_SCALE * W2_SCALE) : 1.0f;
        const int c0 = u.pn * BM + wc * 32 + 8 * fq;
        f32x4 bv[2][2]; bv[0][0] = bp[0]; bv[0][1] = bp[1]; bv[1][0] = bp[2]; bv[1][1] = bp[3];
        int rb = wr * 64 + fr; asm volatile("" : "+v"(rb));
        const LAS int* idp = ids + rb; int slots[8];
#pragma unroll
        for (int q = 0; q < 8; ++q) slots[q] = idp[(q >> 2) * HALF + (q & 3) * 16];
#pragma unroll
        for (int ai = 0; ai < 2; ++ai)
#pragma unroll
            for (int m = 0; m < 4; ++m) { const int r = ai * HALF + m * 16 + rb;
                if (r < nv) { const int slot = slots[ai * 4 + m]; const float gt = gts[r];
                    if constexpr (Y_F8) {
                        unsigned pk[2][2];
#pragma unroll
                        for (int bj = 0; bj < 2; ++bj) { const f32x4 s0 = (acc[ai][bj][m][0] * OSC + bv[bj][0]) * (gt * Y_SCALE), s1 = (acc[ai][bj][m][1] * OSC + bv[bj][1]) * (gt * Y_SCALE); int w0 = 0, w1 = 0;
                            w0 = __builtin_amdgcn_cvt_pk_fp8_f32(s0[0], s0[1], w0, false); w0 = __builtin_amdgcn_cvt_pk_fp8_f32(s0[2], s0[3], w0, true); w1 = __builtin_amdgcn_cvt_pk_fp8_f32(s1[0], s1[1], w1, false); w1 = __builtin_amdgcn_cvt_pk_fp8_f32(s1[2], s1[3], w1, true);
                            pk[bj][0] = (unsigned)w0; pk[bj][1] = (unsigned)w1; }
                        const auto x0 = __builtin_amdgcn_permlane16_swap(pk[0][0], pk[1][0], false, false), x1 = __builtin_amdgcn_permlane16_swap(pk[0][1], pk[1][1], false, false);
                        *(u32x4*)((unsigned char*)Y + (size_t)slot * 1024 + c0 + ((fq & 1) ? 120 : 0)) = (u32x4){x0[0], x1[0], x0[1], x1[1]};
                    } else {
#pragma unroll
                    for (int bj = 0; bj < 2; ++bj) { const f32x4 v0 = (acc[ai][bj][m][0] * OSC + bv[bj][0]) * gt, v1 = (acc[ai][bj][m][1] * OSC + bv[bj][1]) * gt;
                        u32x4 w; w.x = cvt_pk_bf16(v0[0], v0[1]); w.y = cvt_pk_bf16(v0[2], v0[3]); w.z = cvt_pk_bf16(v1[0], v1[1]); w.w = cvt_pk_bf16(v1[2], v1[3]);
                        if (NT_STORE) __builtin_nontemporal_store(w, (u32x4*)(Y + (size_t)slot * 1024 + c0 + bj * HALF)); else *(u32x4*)(Y + (size_t)slot * 1024 + c0 + bj * HALF) = w; } } } }
    }
};

__device__ __forceinline__ const char* uni_ptr(const char* p) { const unsigned long long v = (unsigned long long)p; const unsigned lo = __builtin_amdgcn_readfirstlane((unsigned)v), hi = __builtin_amdgcn_readfirstlane((unsigned)(v >> 32)); return (const char*)(((unsigned long long)hi << 32) | lo); }
typedef int v4i_t __attribute__((ext_vector_type(4))); typedef int v8i_t __attribute__((ext_vector_type(8)));
__device__ __forceinline__ v8i_t cat8(const bf16x8 a, const bf16x8 b) { return __builtin_shufflevector(__builtin_bit_cast(v4i_t, a), __builtin_bit_cast(v4i_t, b), 0, 1, 2, 3, 4, 5, 6, 7); }
template <class Epi, class Sched, bool GATHER, bool F8 = false, bool DEFER = false>
__device__ __forceinline__ void gemm_phase(LAS unsigned char* lds, const Sched& S, const Epi& E, const int tid) {
    const int wid = __builtin_amdgcn_readfirstlane(tid >> 6), lane = tid & 63, wr = wid >> 2, wc = wid & 3, fr = lane & 15, fq = lane >> 4;
    const int KB = S.KB, nt = KB / 128;
    unsigned voffA[2], voffB[2];
#pragma unroll
    for (int i = 0; i < 2; ++i) { int R, C; stage_rc(tid * 16 + i * 8192, R, C); const int Rb = Epi::PERM ? ((R & ~31) + perm32(R & 31)) : R;
        voffA[i] = (unsigned)(R * KB + C * 2); voffB[i] = (unsigned)(Rb * KB + C * 2); }
    const size_t kstep = (size_t)(BK * 2);
    const size_t hstep = (size_t)HALF * KB;
    const unsigned ldsw = (unsigned)wid * 1024u;
    const int aoff = lds_byte(wr * 64 + fr, fq * 8), boff = lds_byte(wc * 32 + fr, fq * 8);
#define PG8_SA(b, h) (((b) * 2 + (h)) * HTB)
#define PG8_SB(b, h) ((4 + (b) * 2 + (h)) * HTB)
#define PG8_STAGE(bufoff, gbase, voff) do { const char* _gb = uni_ptr((const char*)(gbase)); _Pragma("unroll") for (int _i = 0; _i < 2; ++_i) \
        __builtin_amdgcn_global_load_lds((const unsigned*)(_gb + (voff)[_i]), (LAS unsigned*)(lds + (bufoff) + ldsw + _i * 8192), 16, 0, 0); } while (0)
#define PG8_STAGE_A(bufoff, kb, h, GO) do { if constexpr (GATHER) { PG8_STAGE(bufoff, kb, (GO)[h]); } else { PG8_STAGE(bufoff, (kb) + (h) * hstep, voffA); } } while (0)
#define PG8_LDA(dst, b, h) do { if constexpr (F8) { _Pragma("unroll") for (int m = 0; m < 4; ++m) dst##8[m] = cat8(*(const LAS bf16x8*)(lds + PG8_SA(b, h) + aoff + m * 2048), *(const LAS bf16x8*)(lds + PG8_SA(b, h) + aoff + m * 2048 + 1024)); } else { \
        _Pragma("unroll") for (int m = 0; m < 4; ++m) _Pragma("unroll") for (int k = 0; k < 2; ++k) dst[m][k] = *(const LAS bf16x8*)(lds + PG8_SA(b, h) + aoff + m * 2048 + k * 1024); } } while (0)
#define PG8_LDB(dst, b, h) do { if constexpr (F8) { _Pragma("unroll") for (int n = 0; n < 2; ++n) dst##8[n] = cat8(*(const LAS bf16x8*)(lds + PG8_SB(b, h) + boff + n * 2048), *(const LAS bf16x8*)(lds + PG8_SB(b, h) + boff + n * 2048 + 1024)); } else { \
        _Pragma("unroll") for (int n = 0; n < 2; ++n) _Pragma("unroll") for (int k = 0; k < 2; ++k) dst[n][k] = *(const LAS bf16x8*)(lds + PG8_SB(b, h) + boff + n * 2048 + k * 1024); } } while (0)
#define PG8_MMA(ai, bj, At, Bt) do { __builtin_amdgcn_s_setprio(1); if constexpr (F8) { _Pragma("unroll") for (int m = 0; m < 4; ++m) _Pragma("unroll") for (int n = 0; n < 2; ++n) \
        acc[ai][bj][m][n] = __builtin_amdgcn_mfma_scale_f32_16x16x128_f8f6f4(Bt##8[n], At##8[m], acc[ai][bj][m][n], 0, 0, 0, 0, 0, 0); } else { \
        _Pragma("unroll") for (int m = 0; m < 4; ++m) _Pragma("unroll") for (int n = 0; n < 2; ++n) _Pragma("unroll") for (int k = 0; k < 2; ++k) \
        acc[ai][bj][m][n] = __builtin_amdgcn_mfma_f32_16x16x32_bf16(Bt[n][k], At[m][k], acc[ai][bj][m][n], 0, 0, 0); } __builtin_amdgcn_s_setprio(0); } while (0)
#define PG8_WAIT_V(n) asm volatile("s_waitcnt vmcnt(" #n ")" ::: "memory")
#define PG8_WAIT_L(n) asm volatile("s_waitcnt lgkmcnt(" #n ")" ::: "memory")
#define PG8_BAR __builtin_amdgcn_s_barrier()
#define PG8_SCHED __builtin_amdgcn_sched_barrier(0)
    LAS int* const ibuf = (LAS int*)(lds + STAGE_BYTES + 512);
#define PG8_IDMA(u, b) do { if constexpr (GATHER) { __builtin_amdgcn_global_load_lds((const unsigned*)(S.idx_src(u) + 64 * (wid & 3) + lane), (LAS unsigned*)(ibuf + (b) * 256 + 64 * (wid & 3)), 4, 0, 0); \
        if constexpr (Epi::HAS_GATE) __builtin_amdgcn_global_load_lds((const unsigned*)(E.gidx + (S.idx_src(u) - S.idx) + 64 * (wid & 3) + lane), (LAS unsigned*)(ibuf + 768 + (b) * 256 + 64 * (wid & 3)), 4, 0, 0); } } while (0)
#define PG8_GOFF(dst, u, b) do { if constexpr (GATHER) { int _t = tid; asm volatile("" : "+v"(_t)); const int _nv = S.nvalid(u); _Pragma("unroll") for (int _i = 0; _i < 2; ++_i) { int _R, _C; stage_rc(_t * 16 + _i * 8192, _R, _C); \
        _Pragma("unroll") for (int _h = 0; _h < 2; ++_h) { const int _r = _R + _h * HALF; const unsigned _s = (unsigned)ibuf[(b) * 256 + (_r < _nv ? _r : 0)]; dst[_h][_i] = (_s >> Sched::ROW_SHIFT) * (unsigned)KB + (unsigned)_C * 2u; } } } } while (0)
    Unit cur, nxt; int ui = 0;
    if (!S.next(0, cur)) return;
    f32x4 acc[2][2][4][2];
#pragma unroll
    for (int a = 0; a < 2; ++a)
#pragma unroll
        for (int b = 0; b < 2; ++b)
#pragma unroll
            for (int m = 0; m < 4; ++m)
#pragma unroll
                for (int n = 0; n < 2; ++n) acc[a][b][m][n] = (f32x4){0.f, 0.f, 0.f, 0.f};
    bf16x8 At[4][2], B0[2][2], B1[2][2];
    v8i_t At8[4], B08[2], B18[2];
    unsigned gA[2][2] = {{0u, 0u}, {0u, 0u}}, gN[2][2] = {{0u, 0u}, {0u, 0u}};
    int bsel = 0;
    f32x4 bpre[4] = {(f32x4){0.f, 0.f, 0.f, 0.f}, (f32x4){0.f, 0.f, 0.f, 0.f}, (f32x4){0.f, 0.f, 0.f, 0.f}, (f32x4){0.f, 0.f, 0.f, 0.f}};
    Pend pend; int ppn = 0, pnv = 0, pq = 8, pbuf = 0;
    if constexpr (DEFER) {
#pragma unroll
        for (int q = 0; q < 8; ++q) pend.val[q] = (u32x2){0u, 0u}; }
#define PG8_PSTORE() do { if constexpr (DEFER) { const int _l3 = lane_id_volatile(); const int _nv = (pq < 8) ? pnv : 0; \
        E.store_one(pend.val[0], ibuf + pbuf * 256, ((pq >> 2) & 1) * HALF + (pq & 3) * 16 + wr * 64 + (_l3 & 15), _nv, ppn * HALF + wc * 32 + 8 * (_l3 >> 4)); \
        _Pragma("unroll") for (int _q = 0; _q < 7; ++_q) pend.val[_q] = pend.val[_q + 1]; ++pq; } } while (0)
    if constexpr (GATHER) { PG8_IDMA(cur, 0); PG8_WAIT_V(0); PG8_BAR; }
    PG8_GOFF(gA, cur, 0);
    const char* cA = S.a_base(cur); const char* cB = S.b_base(cur);
    PG8_STAGE(PG8_SB(0, 0), cB, voffB); PG8_STAGE(PG8_SB(0, 1), cB + hstep, voffB); PG8_STAGE_A(PG8_SA(0, 0), cA, 0, gA); PG8_STAGE_A(PG8_SA(0, 1), cA, 1, gA);
    if (wr == 1) PG8_BAR;
    PG8_WAIT_V(2); PG8_BAR;
    PG8_STAGE(PG8_SB(1, 0), cB + kstep, voffB); PG8_STAGE_A(PG8_SA(1, 0), cA + kstep, 0, gA); PG8_STAGE(PG8_SB(1, 1), cB + hstep + kstep, voffB);
    PG8_WAIT_V(6); PG8_BAR;
    for (;;) {
        const bool has_next = S.next(ui + 1, nxt);
        const char* nA = has_next ? S.a_base(nxt) : cA; const char* nB = has_next ? S.b_base(nxt) : cB;
        const int bnxt = (bsel == 2) ? 0 : bsel + 1;
        if constexpr (GATHER) { if (has_next) PG8_IDMA(nxt, bnxt); }
        for (int t = 0; t < nt; t += 2) {
            const bool last = (t == nt - 2);
            const char* a1 = cA + (size_t)(t + 1) * kstep;
            const char* a2 = last ? nA : cA + (size_t)(t + 2) * kstep; const char* b2 = last ? nB : cB + (size_t)(t + 2) * kstep;
            const char* a3 = a2 + kstep; const char* b3 = b2 + kstep;
            if constexpr (GATHER) { if (last && has_next) { PG8_GOFF(gN, nxt, bnxt); } }
            if constexpr (Epi::HAS_BIAS) { if (last) E.load_bias(cur, wc, lane_id_volatile() >> 4, bpre); }
            PG8_LDB(B0, 0, 0); PG8_LDB(B1, 0, 1); PG8_SCHED; PG8_LDA(At, 0, 0); PG8_STAGE_A(PG8_SA(1, 1), a1, 1, gA);
            if constexpr (GATHER) { if (last && has_next) { gA[0][0] = gN[0][0]; gA[0][1] = gN[0][1]; gA[1][0] = gN[1][0]; gA[1][1] = gN[1][1]; } }
            PG8_WAIT_V(8); PG8_WAIT_L(0); PG8_BAR; PG8_MMA(0, 0, At, B0); PG8_MMA(0, 1, At, B1); PG8_BAR; PG8_SCHED;
            PG8_LDA(At, 0, 1); PG8_STAGE(PG8_SB(0, 0), b2, voffB); PG8_STAGE(PG8_SB(0, 1), b2 + hstep, voffB); PG8_STAGE_A(PG8_SA(0, 0), a2, 0, gA);
            PG8_WAIT_V(8); PG8_WAIT_L(0); PG8_BAR; PG8_MMA(1, 0, At, B0); PG8_MMA(1, 1, At, B1); PG8_BAR; PG8_SCHED;
            PG8_PSTORE();
            PG8_LDB(B0, 1, 0); PG8_LDB(B1, 1, 1); PG8_SCHED; PG8_LDA(At, 1, 0); PG8_STAGE_A(PG8_SA(0, 1), a2, 1, gA);
            PG8_WAIT_V(8); PG8_WAIT_L(0); PG8_BAR; PG8_MMA(0, 0, At, B0); PG8_MMA(0, 1, At, B1); PG8_BAR; PG8_SCHED;
            PG8_LDA(At, 1, 1); PG8_STAGE(PG8_SB(1, 0), b3, voffB); PG8_STAGE(PG8_SB(1, 1), b3 + hstep, voffB); PG8_STAGE_A(PG8_SA(1, 0), a3, 0, gA);
            PG8_WAIT_V(8); PG8_WAIT_L(0); PG8_BAR; PG8_MMA(1, 0, At, B0); PG8_MMA(1, 1, At, B1); PG8_BAR; PG8_SCHED;
            PG8_PSTORE();
        }
        if (ALIGN_EPI) { if (wr == 0) PG8_BAR; }
        { const int l2 = lane_id_volatile(), fr2 = l2 & 15, fq2 = l2 >> 4;
          if constexpr (DEFER) { _Pragma("unroll") for (int _f = 0; _f < 8; ++_f) PG8_PSTORE();
              E.prepare(acc, cur, wr, wc, fr2, fq2, pend); ppn = cur.pn; pnv = S.nvalid(cur); pq = 0; pbuf = bsel; }
          else if constexpr (GATHER) E(acc, cur, wr, wc, fr2, fq2, ibuf + bsel * 256, S.nvalid(cur), bpre); else E(acc, cur, wr, wc, fr2, fq2); }
        if (!has_next) break;
#pragma unroll
        for (int a = 0; a < 2; ++a)
#pragma unroll
            for (int b = 0; b < 2; ++b)
#pragma unroll
                for (int m = 0; m < 4; ++m)
#pragma unroll
                    for (int n = 0; n < 2; ++n) acc[a][b][m][n] = (f32x4){0.f, 0.f, 0.f, 0.f};
        cur = nxt; cA = nA; cB = nB; ++ui; bsel = bnxt;
        if (ALIGN_EPI) { if (wr == 1) PG8_BAR; }
    }
    if constexpr (DEFER) { _Pragma("unroll") for (int _f = 0; _f < 8; ++_f) PG8_PSTORE(); }
    PG8_WAIT_V(0);
    if (!ALIGN_EPI) { if (wr == 0) PG8_BAR; }
    PG8_BAR;
#undef PG8_PSTORE
#undef PG8_SA
#undef PG8_SB
#undef PG8_STAGE
#undef PG8_STAGE_A
#undef PG8_LDA
#undef PG8_LDB
#undef PG8_MMA
#undef PG8_WAIT_V
#undef PG8_WAIT_L
#undef PG8_BAR
#undef PG8_SCHED
#undef PG8_GOFF
#undef PG8_IDMA
}
}

namespace attn_body {
using bf16=__hip_bfloat16;
using bf16x8=__attribute__((ext_vector_type(8)))short;
using s16x4=__attribute__((ext_vector_type(4)))short;
using f32x16=__attribute__((ext_vector_type(16)))float;
using u32x4=__attribute__((ext_vector_type(4)))unsigned;
constexpr int D=64;
constexpr int NW=8,QBLK=32,QB=QBLK*NW,KVBLK=64;
constexpr int ATTN_UNIT_ROWS=QB;
__device__ __forceinline__ int crow(int r,int hi){return (r&3)+8*(r>>2)+4*hi;}
#define SBAR() __builtin_amdgcn_sched_barrier(0)
__device__ __forceinline__ void cmask(f32x16&p0,f32x16&p1,int jb,int qrel,int hi){
  const float NEG=-INFINITY; int kb=64*jb+4*hi;
  #pragma unroll
  for(int r=0;r<16;++r){int kv=kb+(r&3)+8*(r>>2); if(kv>qrel)p0[r]=NEG; if(kv+32>qrel)p1[r]=NEG;}
}

constexpr int NSLOT=3, SLOTB=8192;
constexpr int LDS_K=0, LDS_V=NSLOT*SLOTB, LDS_WS=2*NSLOT*SLOTB, LDS_OST=LDS_WS+NW*64*4, LDS_BYTES=LDS_OST+NW*4096;
constexpr float C2=0.125f*1.4426950408889634f;
__device__ __forceinline__ void glds16(const void*gsrc,unsigned lds_dst){unsigned keep;
  asm volatile("s_mov_b32 %0, m0\n\ts_mov_b32 m0, %2\n\ts_nop 0\n\tglobal_load_lds_dwordx4 %1, off\n\ts_mov_b32 m0, %0":"=&s"(keep):"v"(gsrc),"s"(lds_dst):"memory");}
__device__ __forceinline__ float max3f(float a,float b,float c){float r;asm("v_max3_f32 %0, %1, %2, %3":"=v"(r):"v"(a),"v"(b),"v"(c));return r;}
__device__ __forceinline__ float max2f(float a,float b){float r;asm("v_max_f32_e32 %0, %1, %2":"=v"(r):"v"(a),"v"(b));return r;}
__device__ __forceinline__ float fadd_s(float a,float b){float r;asm("v_add_f32_e32 %0, %1, %2":"=v"(r):"v"(a),"v"(b));return r;}
__device__ __forceinline__ float fsub_s(float a,float b){float r;asm("v_sub_f32_e32 %0, %1, %2":"=v"(r):"v"(a),"v"(b));return r;}
typedef float f32x2_t __attribute__((ext_vector_type(2))); typedef __bf16 bf16x2_t __attribute__((ext_vector_type(2)));
__device__ __forceinline__ unsigned cvtpk_s(float lo,float hi){f32x2_t v={lo,hi};bf16x2_t b=__builtin_convertvector(v,bf16x2_t);return __builtin_bit_cast(unsigned,b);}
#define WAIT_BAR(N) asm volatile("s_waitcnt vmcnt(" #N ") lgkmcnt(0)\n\ts_barrier":::"memory")

__device__ __forceinline__ void qkt(f32x16&p0,f32x16&p1,const char*Kslot,const bf16x8*qr,const f32x16&negm,int r32,int hi){
  const char*kb=Kslot+hi*1024+r32*16;
  #pragma unroll
  for(int d0=0;d0<4;++d0){
    const bf16x8 b0=*reinterpret_cast<const bf16x8*>(kb+d0*2048);
    const bf16x8 b1=*reinterpret_cast<const bf16x8*>(kb+d0*2048+512);
    if(d0==0){p0=__builtin_amdgcn_mfma_f32_32x32x16_bf16(b0,qr[0],negm,0,0,0);p1=__builtin_amdgcn_mfma_f32_32x32x16_bf16(b1,qr[0],negm,0,0,0);}
    else{p0=__builtin_amdgcn_mfma_f32_32x32x16_bf16(b0,qr[d0],p0,0,0,0);p1=__builtin_amdgcn_mfma_f32_32x32x16_bf16(b1,qr[d0],p1,0,0,0);}}
}
typedef __attribute__((address_space(3))) const char* lds_cptr;
typedef short v4i16_t __attribute__((ext_vector_type(4)));
__device__ __forceinline__ void kload8(bf16x8*kf,lds_cptr kp){
  kf[0]=*(const __attribute__((address_space(3))) bf16x8*)(kp);      kf[1]=*(const __attribute__((address_space(3))) bf16x8*)(kp+512);
  kf[2]=*(const __attribute__((address_space(3))) bf16x8*)(kp+2048); kf[3]=*(const __attribute__((address_space(3))) bf16x8*)(kp+2560);
  kf[4]=*(const __attribute__((address_space(3))) bf16x8*)(kp+4096); kf[5]=*(const __attribute__((address_space(3))) bf16x8*)(kp+4608);
  kf[6]=*(const __attribute__((address_space(3))) bf16x8*)(kp+6144); kf[7]=*(const __attribute__((address_space(3))) bf16x8*)(kp+6656);
}
__device__ __forceinline__ void kload2(bf16x8*kf,lds_cptr kp,int j){ kf[2*j]=*(const __attribute__((address_space(3))) bf16x8*)(kp+j*2048); kf[2*j+1]=*(const __attribute__((address_space(3))) bf16x8*)(kp+j*2048+512); }
__device__ __forceinline__ s16x4 vtr(lds_cptr p){ return __builtin_bit_cast(s16x4,__builtin_amdgcn_ds_read_tr16_b64_v4i16((__attribute__((address_space(3))) v4i16_t*)p)); }
__device__ __forceinline__ float rowmax(const f32x16&p0,const f32x16&p1){
  float a=max3f(p0[0],p0[1],p1[0]),b=max3f(p0[2],p0[3],p1[1]);a=max3f(a,p1[2],p1[3]);
  #pragma unroll
  for(int r=4;r<16;r+=4){a=max3f(a,p0[r],p0[r+1]);b=max3f(b,p0[r+2],p0[r+3]);a=max3f(a,p1[r],p1[r+1]);b=max3f(b,p1[r+2],p1[r+3]);}
  const float m=max2f(a,b);
  auto rr=__builtin_amdgcn_permlane32_swap(__float_as_uint(m),__float_as_uint(m),false,false);
  return max2f(__uint_as_float(rr[0]),__uint_as_float(rr[1]));
}
__device__ __forceinline__ void pv(f32x16*o,int vb,bf16x8 pa0,bf16x8 pa1,bf16x8 pa2,bf16x8 pa3){
  #pragma unroll
  for(int d0=0;d0<2;++d0){s16x4 lo[4],hi[4];
    #pragma unroll
    for(int ks=0;ks<4;++ks){
      asm volatile("ds_read_b64_tr_b16 %0,%1 offset:%c2":"=&v"(lo[ks]):"v"(vb),"i"(d0*4096+ks*1024):"memory");
      asm volatile("ds_read_b64_tr_b16 %0,%1 offset:%c2":"=&v"(hi[ks]):"v"(vb),"i"(d0*4096+ks*1024+512):"memory");}
    asm volatile("s_waitcnt lgkmcnt(0)":::"memory");SBAR();
    #define PK(k) (bf16x8){lo[k][0],lo[k][1],lo[k][2],lo[k][3],hi[k][0],hi[k][1],hi[k][2],hi[k][3]}
    o[d0]=__builtin_amdgcn_mfma_f32_32x32x16_bf16(pa0,PK(0),o[d0],0,0,0);
    o[d0]=__builtin_amdgcn_mfma_f32_32x32x16_bf16(pa1,PK(1),o[d0],0,0,0);
    o[d0]=__builtin_amdgcn_mfma_f32_32x32x16_bf16(pa2,PK(2),o[d0],0,0,0);
    o[d0]=__builtin_amdgcn_mfma_f32_32x32x16_bf16(pa3,PK(3),o[d0],0,0,0);
    #undef PK
  }
}

#ifndef ATTN_STORE16
#define ATTN_STORE16(p,v) (*(u32x4*)(p)=(v))
#endif
template<int THRL, bool O8 = false> __device__ __forceinline__ void attn_unit(const bf16*Qu,const bf16*__restrict__ Kh,const bf16*__restrict__ Vh,bf16*Ou,const int QP,const int KP,const int VP,const int OP,const int NT,char*shm,const int tid){
  const int lane=tid&63,r32=lane&31,hi=lane>>5; const int wid=__builtin_amdgcn_readfirstlane(tid>>6);
  const bf16*Qw=Qu+(long)(wid*QBLK)*QP;
  const unsigned lds0=(unsigned)(uintptr_t)shm;
  float*wsf=(float*)(shm+LDS_WS)+wid*64;
  const bf16*ksrc=Kh+(long)lane*KP+wid*8;
  const bf16*vsrc=Vh+(long)(16*(wid&3)+(lane>>2))*VP+(wid>>2)*32+(lane&3)*8;
  const unsigned kdst=lds0+LDS_K+wid*1024, vdst=lds0+LDS_V+wid*1024;
  #define DMA_K(t,slot) glds16(ksrc+(long)(t)*KVBLK*KP,(unsigned)__builtin_amdgcn_readfirstlane(kdst+(slot)))
  #define DMA_V(t,slot) glds16(vsrc+(long)(t)*KVBLK*VP,(unsigned)__builtin_amdgcn_readfirstlane(vdst+(slot)))
  const int vb0=(int)(lds0+LDS_V)+((lane>>4)&1)*32+(lane&3)*8+(4*hi+((lane&15)>>2))*64;
  const char*Kbase=shm+LDS_K; bf16x8 kf[8];
  const lds_cptr shm3=(lds_cptr)shm; const lds_cptr kp0=shm3+LDS_K+hi*1024+r32*16; const lds_cptr vp0=shm3+LDS_V+((lane>>4)&1)*32+(lane&3)*8+(4*hi+((lane&15)>>2))*64;
  DMA_K(0,0);DMA_V(0,0);DMA_K(1,SLOTB);
  bf16x8 qr[4];
  #pragma unroll
  for(int d0=0;d0<4;++d0)qr[d0]=*reinterpret_cast<const bf16x8*>(&Qw[(long)r32*QP+d0*16+hi*8]);
  float mhat=0.f,l_reg=0.f;f32x16 o[2];f32x16 negm; { float z_=0.f; asm volatile("":"+v"(z_)); _Pragma("unroll") for(int r=0;r<16;++r){o[0][r]=z_;o[1][r]=z_;negm[r]=z_;} } asm volatile("":"+v"(negm));
  #define CMASK(P0,P1,t) do{}while(0)
  bool resc=false;
  #define START(P0,P1) do{ const float rm=rowmax(P0,P1); resc=false; \
    { const float dl=rm; mhat=fadd_s(mhat,dl); \
      _Pragma("unroll") for(int r=0;r<16;++r){P0[r]=fsub_s(P0[r],dl);P1[r]=fsub_s(P1[r],dl);} \
      _Pragma("unroll") for(int r=0;r<16;++r)negm[r]=-mhat; asm volatile("":"+v"(negm)); } \
    _Pragma("unroll") for(int r=0;r<16;++r)P0[r]=__builtin_amdgcn_exp2f(P0[r]); }while(0)
  #define RESC() do{ if(resc){ asm volatile("s_waitcnt lgkmcnt(0)":::"memory"); \
      _Pragma("unroll") for(int d_=0;d_<2;++d_) _Pragma("unroll") for(int r=0;r<16;++r)o[d_][r]*=wsf[crow(r,hi)]; } }while(0)
  f32x16 pA0,pA1,pB0,pB1;
  int sl_prev=0,sl_cur=0,sl_next=SLOTB;
  #define ROT() do{sl_prev=sl_cur;sl_cur=sl_next;sl_next=(sl_next==(NSLOT-1)*SLOTB)?0:sl_next+SLOTB;}while(0)
  DMA_K(2,2*SLOTB);
  WAIT_BAR(3);
  qkt(pA0,pA1,Kbase,qr,negm,r32,hi);asm volatile("s_nop 15\n\ts_nop 7":"+v"(pA0),"+v"(pA1));CMASK(pA0,pA1,0);
  START(pA0,pA1);
  _Pragma("unroll") for(int r=0;r<16;++r)pA1[r]=__builtin_amdgcn_exp2f(pA1[r]);
  WAIT_BAR(0);
  DMA_K(3,0);DMA_V(1,SLOTB);
  ROT();
  kload8(kf,kp0+sl_cur);
  WAIT_BAR(2);
  s16x4 vlo[8],vhi[8]; u32x4 pw0,pw1,pw2,pw3;
  #define PKW(P,B) cvtpk_s(P[B],P[B+1])
  #define PAF(k) __builtin_bit_cast(bf16x8,pw##k)
  #define VFR(i) (bf16x8){vlo[i][0],vlo[i][1],vlo[i][2],vlo[i][3],vhi[i][0],vhi[i][1],vhi[i][2],vhi[i][3]}
  #define PIN(x) asm volatile("":"+v"(x))
  #define MX3(a,b,c) __builtin_fmaxf(__builtin_fmaxf((a),(b)),(c))
  #define GAPA(MF,A0,A1,A2,A3,W0,W1,PW) do{ MF; sacc+=A0; sacc+=A1; sacc+=A2; sacc+=A3; PIN(sacc); W0; W1; PIN(PW); SBAR(); }while(0)
  #define EX(v) __builtin_amdgcn_exp2f(v)
  #define GAPB(MF,X,B) do{ MF; X[B]=EX(X[B]); X[B+1]=EX(X[B+1]); X[B+2]=EX(X[B+2]); X[B+3]=EX(X[B+3]); PIN(X); SBAR(); }while(0)
  #define VRD(i) do{ vlo[i]=vtr(vp_+(((i)>>2)*4096+((i)&3)*1024)); vhi[i]=vtr(vp_+(((i)>>2)*4096+((i)&3)*1024+512)); }while(0)
  #define KRD(G,j) do{ if(G){ kload2(kf,kp0+sl_next,j); SBAR(); } }while(0)
  #define STEP(C0,C1,P0,P1,t,GK,GV,GL) do{ SBAR(); \
    const lds_cptr vp_=vp0+sl_prev; \
    VRD(0); SBAR(); float sacc=(P0[0]+P0[1]); \
    GAPA(C0=__builtin_amdgcn_mfma_f32_32x32x16_bf16(kf[0],qr[0],negm,0,0,0), P0[2],P0[3],P0[4],P0[5],     pw0[0]=PKW(P0,0), pw0[1]=PKW(P0,2), pw0); \
    VRD(4); SBAR(); GAPA(C1=__builtin_amdgcn_mfma_f32_32x32x16_bf16(kf[1],qr[0],negm,0,0,0), P0[6],P0[7],P0[8],P0[9],     pw0[2]=PKW(P0,4), pw0[3]=PKW(P0,6), pw0); \
    VRD(1); SBAR(); GAPA(C0=__builtin_amdgcn_mfma_f32_32x32x16_bf16(kf[2],qr[1],C0,0,0,0),   P0[10],P0[11],P0[12],P0[13], pw1[0]=PKW(P0,8), pw1[1]=PKW(P0,10), pw1); \
    VRD(5); SBAR(); GAPA(C1=__builtin_amdgcn_mfma_f32_32x32x16_bf16(kf[3],qr[1],C1,0,0,0),   P0[14],P0[15],P1[0],P1[1],   pw1[2]=PKW(P0,12),pw1[3]=PKW(P0,14), pw1); \
    VRD(2); SBAR(); GAPA(C0=__builtin_amdgcn_mfma_f32_32x32x16_bf16(kf[4],qr[2],C0,0,0,0),   P1[2],P1[3],P1[4],P1[5],     pw2[0]=PKW(P1,0), pw2[1]=PKW(P1,2), pw2); \
    VRD(6); SBAR(); GAPA(C1=__builtin_amdgcn_mfma_f32_32x32x16_bf16(kf[5],qr[2],C1,0,0,0),   P1[6],P1[7],P1[8],P1[9],     pw2[2]=PKW(P1,4), pw2[3]=PKW(P1,6), pw2); \
    VRD(3); SBAR(); GAPA(C0=__builtin_amdgcn_mfma_f32_32x32x16_bf16(kf[6],qr[3],C0,0,0,0),   P1[10],P1[11],P1[12],P1[13], pw3[0]=PKW(P1,8), pw3[1]=PKW(P1,10), pw3); \
    VRD(7); SBAR(); GAPA(C1=__builtin_amdgcn_mfma_f32_32x32x16_bf16(kf[7],qr[3],C1,0,0,0),   P1[14],P1[15],0.f,0.f,       pw3[2]=PKW(P1,12),pw3[3]=PKW(P1,14), pw3); \
    l_reg+=sacc; \
    if(GK){DMA_K((t)+3,sl_cur);} if(GV){DMA_V((t)+1,sl_next);} \
    CMASK(C0,C1,t); \
    { float a=MX3(C0[0],C0[1],C1[0]),b=MX3(C0[2],C0[3],C1[1]); a=MX3(a,C1[2],C1[3]); \
      _Pragma("unroll") for(int r=4;r<16;r+=4){a=MX3(a,C0[r],C0[r+1]);b=MX3(b,C0[r+2],C0[r+3]);a=MX3(a,C1[r],C1[r+1]);b=MX3(b,C1[r+2],C1[r+3]);} \
      float rm=__builtin_fmaxf(a,b); { auto rr=__builtin_amdgcn_permlane32_swap(__float_as_uint(rm),__float_as_uint(rm),false,false); rm=__builtin_fmaxf(__uint_as_float(rr[0]),__uint_as_float(rr[1])); } \
      resc=false; \
      if(__builtin_expect(__any(rm>(float)THRL),0)){ const float dl=__builtin_fmaxf(rm,0.f); mhat+=dl; \
        _Pragma("unroll") for(int r=0;r<16;++r){C0[r]-=dl;C1[r]-=dl;} \
        _Pragma("unroll") for(int r=0;r<16;++r)negm[r]=-mhat; asm volatile("":"+v"(negm)); \
        const float f=__builtin_amdgcn_exp2f(-dl); l_reg*=f; if(hi==0)wsf[r32]=f; resc=true; } } \
    SBAR(); \
    GAPB(o[0]=__builtin_amdgcn_mfma_f32_32x32x16_bf16(PAF(0),VFR(0),o[0],0,0,0), C0,0); \
    GAPB(o[1]=__builtin_amdgcn_mfma_f32_32x32x16_bf16(PAF(0),VFR(4),o[1],0,0,0), C0,4); \
    KRD(GL,0); GAPB(o[0]=__builtin_amdgcn_mfma_f32_32x32x16_bf16(PAF(1),VFR(1),o[0],0,0,0), C0,8); \
    KRD(GL,1); GAPB(o[1]=__builtin_amdgcn_mfma_f32_32x32x16_bf16(PAF(1),VFR(5),o[1],0,0,0), C0,12); \
    KRD(GL,2); GAPB(o[0]=__builtin_amdgcn_mfma_f32_32x32x16_bf16(PAF(2),VFR(2),o[0],0,0,0), C1,0); \
    KRD(GL,3); GAPB(o[1]=__builtin_amdgcn_mfma_f32_32x32x16_bf16(PAF(2),VFR(6),o[1],0,0,0), C1,4); \
    GAPB(o[0]=__builtin_amdgcn_mfma_f32_32x32x16_bf16(PAF(3),VFR(3),o[0],0,0,0), C1,8); \
    GAPB(o[1]=__builtin_amdgcn_mfma_f32_32x32x16_bf16(PAF(3),VFR(7),o[1],0,0,0), C1,12); \
    }while(0)
  int t=1;
  #undef CMASK
  #define CMASK(P0,P1,t) do{}while(0)
  for(;t+5<NT;t+=2){
    STEP(pB0,pB1,pA0,pA1,t,true,true,true);     WAIT_BAR(2); RESC(); ROT();
    STEP(pA0,pA1,pB0,pB1,t+1,true,true,true);   WAIT_BAR(2); RESC(); ROT();
  }
  #undef CMASK
  #define CMASK(P0,P1,t) do{}while(0)
  #define ENDW(tt) do{ if((tt)+3<NT){WAIT_BAR(2);} else if((tt)+2<NT){WAIT_BAR(1);} else {WAIT_BAR(0);} }while(0)
  for(;t+1<NT;t+=2){
    STEP(pB0,pB1,pA0,pA1,t,(t+3<NT),(t+1<NT),(t+1<NT));       ENDW(t);   RESC(); ROT();
    STEP(pA0,pA1,pB0,pB1,t+1,(t+4<NT),(t+2<NT),(t+2<NT));     ENDW(t+1); RESC(); ROT();
  }
  STEP(pB0,pB1,pA0,pA1,NT-1,false,false,false); RESC();
  { float sacc=pB0[0]+pB0[1]; _Pragma("unroll") for(int r=2;r<16;++r)sacc+=pB0[r]; _Pragma("unroll") for(int r=0;r<16;++r)sacc+=pB1[r]; l_reg+=sacc;
    pw0=(u32x4){PKW(pB0,0),PKW(pB0,2),PKW(pB0,4),PKW(pB0,6)};pw1=(u32x4){PKW(pB0,8),PKW(pB0,10),PKW(pB0,12),PKW(pB0,14)};pw2=(u32x4){PKW(pB1,0),PKW(pB1,2),PKW(pB1,4),PKW(pB1,6)};pw3=(u32x4){PKW(pB1,8),PKW(pB1,10),PKW(pB1,12),PKW(pB1,14)};
    SBAR(); pv(o,vb0+sl_cur,PAF(0),PAF(1),PAF(2),PAF(3)); }
  #undef PKW
  #undef PAF
  #undef VFR
  #undef PIN
  #undef MX3
  #undef GAPA
  #undef GAPB
  #undef EX
  #undef VRD
  #undef KRD
  #undef STEP
  #undef ENDW
  {auto rr=__builtin_amdgcn_permlane32_swap(__float_as_uint(l_reg),__float_as_uint(l_reg),false,false);l_reg=__uint_as_float(rr[0])+__uint_as_float(rr[1]);}
  if(hi==0)wsf[32+r32]=l_reg;asm volatile("s_waitcnt lgkmcnt(0)":::"memory");
  float rli[16];
  #pragma unroll
  for(int r=0;r<16;++r)rli[r]=__builtin_amdgcn_rcpf(wsf[32+crow(r,hi)]);
  if constexpr (O8) {
    unsigned char*Ow8=(unsigned char*)Ou+(long)(wid*QBLK)*OP; unsigned char*stg8=(unsigned char*)(shm+LDS_OST)+wid*2048;
    #pragma unroll
    for(int r=0;r<16;++r){const int orow=crow(r,hi);
      #pragma unroll
      for(int d0=0;d0<2;++d0)stg8[orow*64+d0*32+r32]=f2fp8(o[d0][r]*rli[r]);}
    asm volatile("s_waitcnt lgkmcnt(0)":::"memory");
    #pragma unroll
    for(int i=0;i<2;++i){const int row=i*16+(lane>>2),ch=lane&3; const u32x4 v=*(const u32x4*)(stg8+row*64+ch*16); ATTN_STORE16(Ow8+(long)row*OP+ch*16,v);}
  } else {
  bf16*Ow=Ou+(long)(wid*QBLK)*OP;
  { bf16*stg=(bf16*)(shm+LDS_OST)+wid*2048;
    #pragma unroll
    for(int r=0;r<16;++r){const int orow=crow(r,hi);
      #pragma unroll
      for(int d0=0;d0<2;++d0)stg[orow*64+d0*32+r32]=__float2bfloat16(o[d0][r]*rli[r]);}
    asm volatile("s_waitcnt lgkmcnt(0)":::"memory");
    #pragma unroll
    for(int i=0;i<4;++i){const int row=i*8+(lane>>3),ch=lane&7; const u32x4 v=*(const u32x4*)(stg+row*64+ch*8); ATTN_STORE16(Ow+(long)row*OP+ch*8,v);} }
  }
  asm volatile("s_waitcnt lgkmcnt(0)\n\ts_barrier":::"memory");
  #undef DMA_K
  #undef DMA_V
  #undef CMASK
  #undef START
  #undef RESC
  #undef ROT
}
constexpr int ATTN_LDS_BYTES=LDS_BYTES;
#undef SBAR
#undef WAIT_BAR
}

struct Args { const float* in[32]; float* out; unsigned char* ws; int ph_lo, ph_hi; };
struct Ctx {
    LAS unsigned char* lds;
    int vcu, G;
    unsigned char* ws;
};
constexpr int PTAB_OFF = MISC_OFF + 256;
__device__ __forceinline__ unsigned long long ptab_get(const Ctx& cx, int k) {
    const LAS unsigned* t = (const LAS unsigned*)(cx.lds + PTAB_OFF) + 2 * k; const unsigned lo = __builtin_amdgcn_readfirstlane(t[0]), hi = __builtin_amdgcn_readfirstlane(t[1]);
    return ((unsigned long long)hi << 32) | lo;
}
#define INP(k) ((const float*)(GAS const float*)ptab_get(cx, (k)))

template <bool F8> __device__ __forceinline__ void p0_transpose64(const float* W, int N, int KB, unsigned char* WT, int k0, int n0, int dst_row0, float scale, LAS float* scr, int lane) {
    f32x4 v[16];
    const float* src = W + (size_t)(k0 + (lane >> 4)) * N + n0 + (lane & 15) * 4;
#pragma unroll
    for (int i = 0; i < 16; ++i) v[i] = *(const f32x4*)(src + (size_t)(4 * i) * N);
#pragma unroll
    for (int i = 0; i < 16; ++i) { LAS float* p = scr + (4 * i + (lane >> 4)) * 65 + (lane & 15) * 4; p[0] = v[i][0]; p[1] = v[i][1]; p[2] = v[i][2]; p[3] = v[i][3]; }
    LDS_WAIT(); asm volatile("" ::: "memory");
    if constexpr (!F8) {
        const int ns = lane >> 3, ch = lane & 7;
#pragma unroll
        for (int r8 = 0; r8 < 8; ++r8) { const int n = r8 * 8 + ns; const LAS float* s = scr + (8 * ch) * 65 + n;
            u32x4 o; o.x = pk2(s[0 * 65], s[1 * 65]); o.y = pk2(s[2 * 65], s[3 * 65]); o.z = pk2(s[4 * 65], s[5 * 65]); o.w = pk2(s[6 * 65], s[7 * 65]);
            *(GAS u32x4*)(WT + (size_t)(dst_row0 + n) * KB + (k0 + 8 * ch) * 2) = o; }
    } else {
        const int ns = lane >> 2, ch = lane & 3;
#pragma unroll
        for (int r4 = 0; r4 < 4; ++r4) { const int n = r4 * 16 + ns; const LAS float* s = scr + (16 * ch) * 65 + n; unsigned w[4];
#pragma unroll
            for (int q = 0; q < 4; ++q) { int r = 0; r = __builtin_amdgcn_cvt_pk_fp8_f32(s[(4 * q) * 65] * scale, s[(4 * q + 1) * 65] * scale, r, false); r = __builtin_amdgcn_cvt_pk_fp8_f32(s[(4 * q + 2) * 65] * scale, s[(4 * q + 3) * 65] * scale, r, true); w[q] = (unsigned)r; }
            *(GAS u32x4*)(WT + (size_t)(dst_row0 + n) * KB + k0 + 16 * ch) = (u32x4){w[0], w[1], w[2], w[3]}; }
    }
    LDS_WAIT(); asm volatile("" ::: "memory");
}
__device__ __forceinline__ void p0_prologue(const Ctx& cx, const int tid) {
    const int lane = tid & 63, wave = __builtin_amdgcn_readfirstlane(tid >> 6);
    LAS float* scr = (LAS float*)(cx.lds + wave * 16896);
    const int gw = cx.vcu * 8 + wave, NGW = cx.G * 8;
    constexpr int I_WIN0 = 16 * 40, I_WIN1 = 16 * 24, I_WKV = 16 * 8, I_WOUT = 16 * 16, I_W1 = 16 * 32, I_W2 = 16 * 16;
    constexpr int T_WIN = 3 * I_WIN0 + I_WIN1, T_WKV = 4 * I_WKV, T_WOUT = 4 * I_WOUT, T_W1 = 128 * I_W1, T_W2 = 128 * I_W2;
    constexpr int NITEMS = T_WIN + T_WKV + T_WOUT + T_W1 + T_W2;
    for (int it = gw; it < NITEMS; it += NGW) {
        int r = it;
        const float* W; unsigned char* WT; int N, nb, kb, dst_row0; bool isout = false;
        if (r < T_W1) {
            const int mi = r / I_W1, q = r % I_W1; N = 2048; kb = q / 32; nb = q % 32;
            W = INP(28) + (size_t)mi * 1024 * 2048; WT = cx.ws + WS_W1 + (size_t)mi * 2048 * 1024 * MOE_EB;
            const int n0 = nb * 64, isu = n0 >= 1024, j = n0 - isu * 1024;
            dst_row0 = (j >> 7) * 256 + isu * 128 + (j & 127);
            p0_transpose64<MOE_F8>(W, N, 1024 * MOE_EB, WT, kb * 64, nb * 64, dst_row0, W1_SCALE, scr, lane); continue;
        } else if ((r -= T_W1) < T_W2) {
            const int mi = r / I_W2, q = r % I_W2; N = 1024; kb = q / 16; nb = q % 16;
            W = INP(30) + (size_t)mi * 1024 * 1024; WT = cx.ws + WS_W2 + (size_t)mi * 1024 * 1024 * MOE_EB; dst_row0 = nb * 64;
            p0_transpose64<MOE_F8>(W, N, 1024 * MOE_EB, WT, kb * 64, nb * 64, dst_row0, W2_SCALE, scr, lane); continue;
        } else if ((r -= T_W2) < T_WIN) {
            int l, q;
            if (r < I_WIN0) { l = 0; q = r; } else if (r < I_WIN0 + I_WIN1) { l = 1; q = r - I_WIN0; } else if (r < 2 * I_WIN0 + I_WIN1) { l = 2; q = r - I_WIN0 - I_WIN1; } else { l = 3; q = r - 2 * I_WIN0 - I_WIN1; }
            N = in_width(l); const int nbn = N / 64; kb = q / nbn; nb = q % nbn;
            const int kind = layer_kind(l), j = layer_j(l);
            W = (kind == 0 ? INP(2) : kind == 1 ? INP(4) : INP(7)) + (size_t)j * 1024 * N;
            WT = cx.ws + WS_WIN + (size_t)l * 5 * MiB; dst_row0 = nb * 64;
        } else if ((r -= T_WIN) < T_WKV) {
            const int l = r / I_WKV, q = r % I_WKV; N = 512; kb = q / 8; nb = q % 8;
            W = INP(20) + (size_t)l * 1024 * 512; WT = cx.ws + WS_WKV; dst_row0 = l * 512 + nb * 64;
        } else {
            r -= T_WKV; const int l = r / I_WOUT, q = r % I_WOUT; N = 1024; kb = q / 16; nb = q % 16;
            W = INP(21) + (size_t)l * 1024 * 1024; WT = cx.ws + WS_WOUT + (size_t)l * 2 * MiB; dst_row0 = nb * 64; isout = true;
        }
        if (isout) p0_transpose64<OUTP_F8 != 0>(W, N, 1024 * OUT_EB, WT, kb * 64, nb * 64, dst_row0, OUTP_F8 ? WOUT_SCALE : 1.0f, scr, lane);
        else p0_transpose64<INP_F8 != 0>(W, N, 1024 * INP_EB, WT, kb * 64, nb * 64, dst_row0, INP_F8 ? WIN_SCALE : 1.0f, scr, lane);
    }
    {
        const size_t gt = (size_t)cx.vcu * 512 + tid, NT_ = (size_t)cx.G * 512;
        for (int which = 0; which < 2; ++which) {
            const f32x4* xs = (const f32x4*)(which == 0 ? INP(0) : INP(1)); unsigned char* xd = cx.ws + (which == 0 ? WS_XB : WS_MEMB); const size_t n8 = (size_t)(which == 0 ? NTOK : NMEM) * DM / 8;
#pragma unroll 4
            for (size_t i = gt; i < n8; i += NT_) { const f32x4 a = xs[2 * i], b = xs[2 * i + 1];
                if constexpr (INP_F8) { int w0 = 0, w1 = 0; w0 = __builtin_amdgcn_cvt_pk_fp8_f32(a[0], a[1], w0, false); w0 = __builtin_amdgcn_cvt_pk_fp8_f32(a[2], a[3], w0, true); w1 = __builtin_amdgcn_cvt_pk_fp8_f32(b[0], b[1], w1, false); w1 = __builtin_amdgcn_cvt_pk_fp8_f32(b[2], b[3], w1, true);
                    *(u32x2*)(xd + i * 8) = (u32x2){(unsigned)w0, (unsigned)w1}; }
                else { u32x4 o; o.x = pk2(a[0], a[1]); o.y = pk2(a[2], a[3]); o.z = pk2(b[0], b[1]); o.w = pk2(b[2], b[3]); *(u32x4*)(xd + i * 16) = o; } }
        }
    }
    {
        const float *fw1 = INP(10), *fb1 = INP(11), *fw2 = INP(12), *fb2 = INP(13), *fw3 = INP(14), *fb3 = INP(15), *fw4 = INP(16), *fb4 = INP(17), *ffr = INP(18);
        LAS float* z = (LAS float*)cx.lds; LAS float* h1 = z + 16 * 33; LAS float* h2 = h1 + 1024; LAS float* h3 = h2 + 1024;
        float* HRAWT = (float*)(cx.ws + WS_HRAWT); float* HPART = (float*)(cx.ws + WS_HPART);
        for (int it = cx.vcu; it < 256; it += cx.G) {
            __syncthreads();
            const int pos0 = it * 16;
            for (int i = tid; i < 16 * 33; i += 512) { const int p = i / 33, f = i % 33; const float pos = (float)(pos0 + p); float v;
                if (f == 0) v = pos / 4095.0f;
                else { const int k = (f - 1) & 15; const float fb = 1e-4f + (float)k * ((15.0f - 1e-4f) / 15.0f); const float ang = (6.283185307179586f * pos / 4096.0f) * fb; v = (f <= 16) ? cosf(ang) : -sinf(ang); }
                z[i] = v; }
            __syncthreads();
            for (int i = tid; i < 1024; i += 512) { const int p = i >> 6, o = i & 63; float a = fb1[o]; for (int f = 0; f < 33; ++f) a += z[p * 33 + f] * fw1[f * 64 + o]; h1[i] = sinf(ffr[o] * a); }
            __syncthreads();
            for (int i = tid; i < 1024; i += 512) { const int p = i >> 6, o = i & 63; float a = fb2[o]; for (int k = 0; k < 64; ++k) a += h1[p * 64 + k] * fw2[k * 64 + o]; h2[i] = sinf(ffr[o] * a); }
            __syncthreads();
            for (int i = tid; i < 1024; i += 512) { const int p = i >> 6, o = i & 63; float a = fb3[o]; for (int k = 0; k < 64; ++k) a += h2[p * 64 + k] * fw3[k * 64 + o]; h3[i] = sinf(ffr[o] * a); }
            __syncthreads();
            for (int col = tid; col < 3072; col += 512) {
                float a[16]; const float bb = fb4[col];
#pragma unroll
                for (int p = 0; p < 16; ++p) a[p] = bb;
                for (int k = 0; k < 64; ++k) { const float w = fw4[(size_t)k * 3072 + col];
#pragma unroll
                    for (int p = 0; p < 16; ++p) a[p] += h3[p * 64 + k] * w; }
                const int c = col % 768; const float mind = -3.0701134573253945f, maxd = -15.350567286626972f;
                const float delta = fabsf(mind + (maxd - mind) * ((float)c / 767.0f)); float asum = 0.f;
#pragma unroll
                for (int p = 0; p < 16; ++p) { const float t = (float)(pos0 + p) / 4095.0f; a[p] *= expf(-t * delta); asum += fabsf(a[p]); }
                f32x4* dst = (f32x4*)(HRAWT + (size_t)col * 4096 + pos0);
#pragma unroll
                for (int q = 0; q < 4; ++q) dst[q] = (f32x4){a[4 * q], a[4 * q + 1], a[4 * q + 2], a[4 * q + 3]};
                HPART[(size_t)it * 3072 + col] = asum;
            }
        }
    }
}

__device__ __forceinline__ s16x4 vtr(const LAS unsigned char* p) { typedef short v4i16_t __attribute__((ext_vector_type(4))); return __builtin_bit_cast(s16x4, __builtin_amdgcn_ds_read_tr16_b64_v4i16((LAS v4i16_t*)p)); }
__device__ __forceinline__ void na_phase(const Ctx& cx, const bf16_t* PROJ, const float* rpb, bf16_t* CAT, const int tid) {
    const int lane = tid & 63, wid = __builtin_amdgcn_readfirstlane(tid >> 6), m16 = lane & 15, q4 = lane >> 4;
    LAS unsigned char* Kb = cx.lds; LAS unsigned char* Vb = cx.lds + 73728; LAS float* biasL = (LAS float*)(cx.lds + 147456);
    constexpr int PW = 2560;
    u32x4 kv[9], vv[9]; float bpre = 0.f;
#define NA_LOAD(unit_) do { const int b_ = __builtin_amdgcn_readfirstlane((unit_) / 384), rem_ = __builtin_amdgcn_readfirstlane((unit_) % 384), h_ = rem_ >> 5, rp_ = rem_ & 31; int bs_ = 2 * rp_ - 4; bs_ = bs_ < 0 ? 0 : (bs_ > 56 ? 56 : bs_); bs_ = __builtin_amdgcn_readfirstlane(bs_); \
        _Pragma("unroll") for (int it = 0; it < 9; ++it) { const int i = tid + it * 512; const int brow = i >> 9, col = (i >> 3) & 63, ch = i & 7; int grow = bs_ + brow; grow = grow > 63 ? 63 : grow; \
            const size_t tok = (size_t)b_ * 4096 + grow * 64 + col; \
            kv[it] = *(const u32x4*)(PROJ + tok * PW + 768 + h_ * 64 + ch * 8); vv[it] = *(const u32x4*)(PROJ + tok * PW + 1536 + h_ * 64 + ch * 8); } \
        if (tid < 465) bpre = rpb[h_ * 465 + tid] * LOG2E; } while (0)
    int u0 = cx.vcu; asm volatile("" : "+s"(u0));
    if (u0 < 6144) NA_LOAD(u0);
    for (int unit = u0; unit < 6144; unit += cx.G) {
        const int b = unit / 384, rem = unit % 384, h = rem >> 5, rp = rem & 31;
        int bs = 2 * rp - 4; bs = bs < 0 ? 0 : (bs > 56 ? 56 : bs);
        __syncthreads();
#pragma unroll
        for (int it = 0; it < 9; ++it) { const int i = tid + it * 512; const int brow = i >> 9, col = (i >> 3) & 63, ch = i & 7;
            *(LAS u32x4*)(Kb + (brow * 64 + col) * 128 + ((ch ^ ((col >> 1) & 7)) << 4)) = kv[it];
            *(LAS u32x4*)(Vb + (brow * 64 + col) * 128 + ((ch ^ (col & 7)) << 4)) = vv[it]; }
        if (tid < 465) biasL[tid] = bpre;
        __syncthreads();
        if (unit + cx.G < 6144) NA_LOAD(unit + cx.G);
        const int r = 2 * rp + (wid >> 2), g = wid & 3;
        const int wc0 = (g == 0) ? 0 : (g == 1) ? 8 : (g == 2) ? 24 : 32;
        int r0 = r - 4; r0 = r0 < 0 ? 0 : (r0 > 56 ? 56 : r0); const int ro = r0 - bs;
        const int c = 16 * g + m16;
        const size_t tq = (size_t)b * 4096 + r * 64 + c;
        bf16x8 qf[2];
#pragma unroll
        for (int kk = 0; kk < 2; ++kk) qf[kk] = *(const bf16x8*)(PROJ + tq * PW + h * 64 + 32 * kk + 8 * q4);
        f32x4 S[16];
#pragma unroll
        for (int i = 0; i < 8; ++i)
#pragma unroll
            for (int ct = 0; ct < 2; ++ct) { const int col = wc0 + 16 * ct + m16; const LAS unsigned char* kp = Kb + ((ro + i) * 64 + col) * 128; const int sw = (col >> 1) & 7;
                f32x4 a = (f32x4){0.f, 0.f, 0.f, 0.f};
#pragma unroll
                for (int kk = 0; kk < 2; ++kk) { const bf16x8 kf = *(const LAS bf16x8*)(kp + (((q4 + 4 * kk) ^ sw) << 4)); a = __builtin_amdgcn_mfma_f32_16x16x32_bf16(kf, qf[kk], a, 0, 0, 0); }
                S[2 * i + ct] = a; }
        int c0 = c - 8; c0 = c0 < 0 ? 0 : (c0 > 48 ? 48 : c0);
        float mx = -INFINITY;
#pragma unroll
        for (int i = 0; i < 8; ++i)
#pragma unroll
            for (int ct = 0; ct < 2; ++ct)
#pragma unroll
                for (int v = 0; v < 4; ++v) { const int kc = wc0 + 16 * ct + 4 * q4 + v; const bool valid = (kc >= c0) && (kc < c0 + 16);
                    const int bidx = valid ? (r0 + i - r + 7) * 31 + (kc - c + 15) : 0;
                    const float s = valid ? S[2 * i + ct][v] + biasL[bidx] : -INFINITY; S[2 * i + ct][v] = s; mx = fmaxf(mx, s); }
        mx = fmaxf(mx, shflx(mx, 16, lane)); mx = fmaxf(mx, shflx(mx, 32, lane));
        float l = 0.f;
#pragma unroll
        for (int t = 0; t < 16; ++t)
#pragma unroll
            for (int v = 0; v < 4; ++v) { const float p = __builtin_amdgcn_exp2f(S[t][v] - mx); S[t][v] = p; l += p; }
        l += shflx(l, 16, lane); l += shflx(l, 32, lane);
        f32x4 O[4];
#pragma unroll
        for (int dt = 0; dt < 4; ++dt) O[dt] = (f32x4){0.f, 0.f, 0.f, 0.f};
        const int qq = m16 >> 2, pp = m16 & 3, col1 = wc0 + 4 * q4 + qq;
#pragma unroll
        for (int i = 0; i < 8; ++i) {
            u32x4 pw; pw.x = pk2(S[2 * i][0], S[2 * i][1]); pw.y = pk2(S[2 * i][2], S[2 * i][3]); pw.z = pk2(S[2 * i + 1][0], S[2 * i + 1][1]); pw.w = pk2(S[2 * i + 1][2], S[2 * i + 1][3]);
            const bf16x8 pb = __builtin_bit_cast(bf16x8, pw);
            const LAS unsigned char* v1 = Vb + ((ro + i) * 64 + col1) * 128 + 8 * (pp & 1);
            const LAS unsigned char* v2 = v1 + 16 * 128;
#pragma unroll
            for (int dt = 0; dt < 4; ++dt) { const int chunk = 2 * dt + (pp >> 1);
                const s16x4 lo = vtr(v1 + ((chunk ^ (col1 & 7)) << 4)), hi = vtr(v2 + ((chunk ^ ((col1 + 16) & 7)) << 4));
                const bf16x8 vf = (bf16x8){lo[0], lo[1], lo[2], lo[3], hi[0], hi[1], hi[2], hi[3]};
                O[dt] = __builtin_amdgcn_mfma_f32_16x16x32_bf16(vf, pb, O[dt], 0, 0, 0); }
        }
        const float inv = 1.0f / l;
#pragma unroll
        for (int dt = 0; dt < 4; ++dt) {
            if constexpr (OUTP_F8) { int w = 0; w = __builtin_amdgcn_cvt_pk_fp8_f32(O[dt][0] * inv, O[dt][1] * inv, w, false); w = __builtin_amdgcn_cvt_pk_fp8_f32(O[dt][2] * inv, O[dt][3] * inv, w, true); *(int*)((unsigned char*)CAT + tq * 1024 + h * 64 + 16 * dt + 4 * q4) = w; }
            else { u32x2 w; w.x = pk2(O[dt][0] * inv, O[dt][1] * inv); w.y = pk2(O[dt][2] * inv, O[dt][3] * inv); *(u32x2*)(CAT + tq * 1024 + h * 64 + 16 * dt + 4 * q4) = w; } }
    }
    __syncthreads();
}

#undef NA_LOAD
__device__ __forceinline__ void rope_phase(const Ctx& cx, const bf16_t* PROJ, const float* qg, const float* kg, bf16_t* QKR, const int tid) {
    const int lane = tid & 63, wave = __builtin_amdgcn_readfirstlane(tid >> 6);
    const int gw = cx.vcu * 8 + wave, NGW = cx.G * 8;
    const int d0 = (lane & 7) * 8;
    float gq[8], gk[8], invf[4];
#pragma unroll
    for (int e = 0; e < 8; ++e) { gq[e] = qg[d0 + e]; gk[e] = kg[d0 + e]; }
#pragma unroll
    for (int p = 0; p < 4; ++p) { const int i = (d0 >> 1) + p, j = i & 15; invf[p] = exp2f(-(float)(2 * j) / 32.0f * 13.287712379549449f); }
    const bool isrow = (d0 >> 1) < 16;
    for (int pos = gw; pos < SEQ; pos += NGW) {
        const float pr = isrow ? (float)(pos >> 6) : (float)(pos & 63);
        float cs[4], sn[4];
#pragma unroll
        for (int p = 0; p < 4; ++p) { const float a = pr * invf[p]; cs[p] = cosf(a); sn[p] = sinf(a); }
#pragma unroll 4
        for (int bb = 0; bb < BATCH; ++bb) { const int tok = bb * SEQ + pos;
#pragma unroll
        for (int half = 0; half < 2; ++half) {
            const int e0 = half * 512 + lane * 8; const int head = e0 >> 6; const bool isq = head < 12;
            const u32x4 raw = *(const u32x4*)(PROJ + (size_t)tok * 1536 + e0);
            float x[8]; x[0] = bflo(raw.x); x[1] = bfhi(raw.x); x[2] = bflo(raw.y); x[3] = bfhi(raw.y); x[4] = bflo(raw.z); x[5] = bfhi(raw.z); x[6] = bflo(raw.w); x[7] = bfhi(raw.w);
            float ss = 0.f;
#pragma unroll
            for (int e = 0; e < 8; ++e) ss += x[e] * x[e];
            ss = group8_sum(ss);
            const float inv = rsqrtf(ss * (1.0f / 64.0f) + 1e-6f);
            float y[8];
#pragma unroll
            for (int e = 0; e < 8; ++e) y[e] = x[e] * inv * (isq ? gq[e] : gk[e]);
            const float sc = isq ? C2 : 1.0f;
            float o[8];
#pragma unroll
            for (int p = 0; p < 4; ++p) { o[2 * p] = (y[2 * p] * cs[p] - y[2 * p + 1] * sn[p]) * sc; o[2 * p + 1] = (y[2 * p] * sn[p] + y[2 * p + 1] * cs[p]) * sc; }
            u32x4 w; w.x = pk2(o[0], o[1]); w.y = pk2(o[2], o[3]); w.z = pk2(o[4], o[5]); w.w = pk2(o[6], o[7]);
            *(u32x4*)(QKR + (size_t)tok * 1024 + e0) = w;
        } }
    }
}

__device__ __forceinline__ void sconv_phase(const Ctx& cx, const bf16_t* PROJ, const float* cw, const float* cb, bf16_t* UT3, unsigned char* V8, const int tid) {
    const int lane = tid & 63, wave = __builtin_amdgcn_readfirstlane(tid >> 6);
    const int gw = cx.vcu * 8 + wave, NGW = cx.G * 8;
    LAS unsigned short* tile = (LAS unsigned short*)(cx.lds + wave * 9216);
    constexpr int PW = 2560;
    for (int it = gw; it < 16 * 64 * 36; it += NGW) {
        const int ct = it % 36, tt = (it / 36) & 63, b = it / (36 * 64);
        const int col = ct * 64 + lane, t0 = tt * 64;
        const float w0 = cw[col], w1 = cw[2304 + col], w2 = cw[4608 + col], bia = cb[col];
        const bf16_t* src = PROJ + ((size_t)b * 4096 + t0) * PW + col;
        unsigned short uu[66];
        uu[0] = (t0 > 0) ? src[-(long)PW] : (unsigned short)0;
#pragma unroll
        for (int k = 0; k < 64; ++k) uu[k + 1] = src[(size_t)k * PW];
        uu[65] = (t0 + 64 < 4096) ? src[(size_t)64 * PW] : (unsigned short)0;
#pragma unroll
        for (int k = 0; k < 64; ++k) { const float v = bf2f(uu[k]) * w0 + bf2f(uu[k + 1]) * w1 + bf2f(uu[k + 2]) * w2 + bia; tile[lane * 72 + k] = (unsigned short)f2bf(v); }
        LDS_WAIT(); asm volatile("" ::: "memory");
        const int part = (ct * 64) / 768, cbase = (ct * 64) % 768;
#pragma unroll
        for (int k = 0; k < 8; ++k) { const int row = k * 8 + (lane >> 3), chn = lane & 7;
            const u32x4 v = *(const LAS u32x4*)((const LAS unsigned char*)tile + row * 144 + chn * 16);
            *(u32x4*)(UT3 + (((size_t)part * 16 + b) * 768 + cbase + row) * 4096 + t0 + chn * 8) = v;
            if (TCONV_F8 && part == 0) { int w0 = 0, w1 = 0;
                w0 = __builtin_amdgcn_cvt_pk_fp8_f32(bflo(v.x), bfhi(v.x), w0, false); w0 = __builtin_amdgcn_cvt_pk_fp8_f32(bflo(v.y), bfhi(v.y), w0, true);
                w1 = __builtin_amdgcn_cvt_pk_fp8_f32(bflo(v.z), bfhi(v.z), w1, false); w1 = __builtin_amdgcn_cvt_pk_fp8_f32(bflo(v.w), bfhi(v.w), w1, true);
                *(u32x2*)(V8 + ((size_t)b * 768 + cbase + row) * 4096 + t0 + chn * 8) = (u32x2){(unsigned)w0, (unsigned)w1}; } }
        LDS_WAIT(); asm volatile("" ::: "memory");
    }
}

constexpr int TZ_CS = 16384 + 64;
__device__ __forceinline__ void tconv_phase(const Ctx& cx, const int o, const bf16_t* UT, const bf16_t* GT, bf16_t* ZT, const float* lbias  , const int tid) {
    const int lane = tid & 63, wid = __builtin_amdgcn_readfirstlane(tid >> 6), m16 = lane & 15, q4 = lane >> 4;
    const float* HRAWT = (const float*)(cx.ws + WS_HRAWT); const float* HPART = (const float*)(cx.ws + WS_HPART);
    LAS unsigned char* cp = cx.lds; LAS float* red = (LAS float*)(cx.lds + 8 * TZ_CS);
    for (int c = cx.vcu; c < 768; c += cx.G) {
        __syncthreads();
        { const int dir = tid >> 8, blk = tid & 255; float v = HPART[(size_t)blk * 3072 + dir * 1536 + o * 768 + c]; v = wave_sum(v, lane); if (lane == 0) red[wid] = v; }
        __syncthreads();
        float nrm = 0.f;
#pragma unroll
        for (int w = 0; w < 8; ++w) nrm += red[w];
        const float inv = 1.0f / nrm;
        const float* hf = HRAWT + (size_t)(o * 768 + c) * 4096; const float* hb = HRAWT + (size_t)(1536 + o * 768 + c) * 4096;
        for (int i = tid; i < 8192; i += 512) { float v; if (i < 4096) v = hf[4095 - i]; else if (i < 8191) v = hb[i - 4095]; else v = 0.f;
            *(LAS unsigned short*)(cp + 2 * i) = (unsigned short)f2bf(v * inv); }
        __syncthreads();
#pragma unroll
        for (int j = 1; j < 8; ++j)
            for (int n = tid; n < 1024; n += 512) {
                const u32x4 lo = *(const LAS u32x4*)(cp + n * 16); u32x4 hi = (u32x4){0u, 0u, 0u, 0u}; if (n + 1 < 1024) hi = *(const LAS u32x4*)(cp + (n + 1) * 16);
                const unsigned w[8] = {lo.x, lo.y, lo.z, lo.w, hi.x, hi.y, hi.z, hi.w}; u32x4 r;
                const int a = j >> 1;
                if (j & 1) { r.x = (w[a] >> 16) | (w[a + 1] << 16); r.y = (w[a + 1] >> 16) | (w[a + 2] << 16); r.z = (w[a + 2] >> 16) | (w[a + 3] << 16); r.w = (w[a + 3] >> 16) | (w[a + 4] << 16); }
                else { r.x = w[a]; r.y = w[a + 1]; r.z = w[a + 2]; r.w = w[a + 3]; }
                *(LAS u32x4*)(cp + j * TZ_CS + n * 16) = r;
            }
        __syncthreads();
        const int j = (7 - m16) & 7;
        const int nbase = (4095 - 512 * wid - m16 - j + 8 * q4) >> 3;
        const LAS unsigned char* ap = cp + j * TZ_CS + (nbase - 62) * 16;
        const bf16_t* up = UT + ((size_t)m16 * 768 + c) * 4096 + 8 * q4;
        f32x4 acc[32];
#pragma unroll
        for (int ti = 0; ti < 32; ++ti) acc[ti] = (f32x4){0.f, 0.f, 0.f, 0.f};
        bf16x8 bcur = *(const bf16x8*)(up);
        bf16x8 afA[8], afB[8];
#pragma unroll
        for (int i = 0; i < 8; ++i) afA[i] = *(const LAS bf16x8*)(ap + (31 - i) * 32);
        for (int ks = 0; ks < 128; ++ks) {
            const bf16x8 bnext = *(const bf16x8*)(up + ((ks + 1) & 127) * 32);
            const LAS unsigned char* a0 = ap + ks * 64;
            const LAS unsigned char* a1 = ap + ((ks + 1) & 127) * 64;
#define TZ_LD(dst, base, g) do { _Pragma("unroll") for (int i = 0; i < 8; ++i) dst[i] = *(const LAS bf16x8*)((base) + (31 - (8 * (g) + i)) * 32); } while (0)
#define TZ_MM(src, g) do { _Pragma("unroll") for (int i = 0; i < 8; ++i) acc[8 * (g) + i] = __builtin_amdgcn_mfma_f32_16x16x32_bf16(src[i], bcur, acc[8 * (g) + i], 0, 0, 0); } while (0)
            TZ_LD(afB, a0, 1); TZ_MM(afA, 0); __builtin_amdgcn_sched_barrier(0);
            TZ_LD(afA, a0, 2); TZ_MM(afB, 1); __builtin_amdgcn_sched_barrier(0);
            TZ_LD(afB, a0, 3); TZ_MM(afA, 2); __builtin_amdgcn_sched_barrier(0);
            TZ_LD(afA, a1, 0); TZ_MM(afB, 3); __builtin_amdgcn_sched_barrier(0);
#undef TZ_LD
#undef TZ_MM
            bcur = bnext;
        }
        const float lb = lbias[c];
        const size_t rowoff = ((size_t)m16 * 768 + c) * 4096 + 512 * wid + 4 * q4;
#pragma unroll
        for (int ti = 0; ti < 32; ++ti) {
            const u32x2 uu = *(const u32x2*)(UT + rowoff + 16 * ti), gg = *(const u32x2*)(GT + rowoff + 16 * ti);
            const float y0 = (acc[ti][0] + lb * bflo(uu.x)) * bflo(gg.x), y1 = (acc[ti][1] + lb * bfhi(uu.x)) * bfhi(gg.x), y2 = (acc[ti][2] + lb * bflo(uu.y)) * bflo(gg.y), y3 = (acc[ti][3] + lb * bfhi(uu.y)) * bfhi(gg.y);
            u32x2 w; w.x = pk2(y0, y1); w.y = pk2(y2, y3);
            *(u32x2*)(ZT + rowoff + 16 * ti) = w;
            if ((ti & 7) == 7) __builtin_amdgcn_sched_barrier(0);
        }
    }
    __syncthreads();
}

constexpr int T8_CS = 8192 + 256;
__host__ __device__ constexpr int t8_sig(int j) { return j < 4 ? 2 * j : (j >= 12 ? 2 * (j - 8) : 2 * (j - 4) + 1); }
__device__ __forceinline__ float wave_max_nn(float v) {
    v = fmaxf(v, dpp_x<0xB1>(v)); v = fmaxf(v, dpp_x<0x4E>(v)); v = fmaxf(v, dpp_x<0x141>(v)); v = fmaxf(v, dpp_x<0x140>(v));
    v = fmaxf(v, __builtin_bit_cast(float, __builtin_amdgcn_update_dpp(0, __builtin_bit_cast(int, v), 0x142, 0xA, 0xF, false)));
    v = fmaxf(v, __builtin_bit_cast(float, __builtin_amdgcn_update_dpp(0, __builtin_bit_cast(int, v), 0x143, 0xC, 0xF, false)));
    return __builtin_bit_cast(float, __builtin_amdgcn_readlane(__builtin_bit_cast(int, v), 63));
}
__device__ __forceinline__ void tconv8_phase(const Ctx& cx, const int o, const bf16_t* UT, const unsigned char* U8, const bf16_t* GT, bf16_t* ZT, unsigned char* Z8  ,
                                             const float* lbias, const int tid) {
    const int lane = tid & 63, wid = __builtin_amdgcn_readfirstlane(tid >> 6), m16 = lane & 15, q4 = lane >> 4;
    const float* HRAWT = (const float*)(cx.ws + WS_HRAWT); const float* HPART = (const float*)(cx.ws + WS_HPART);
    LAS unsigned char* cp = cx.lds; LAS float* red = (LAS float*)(cx.lds + 16 * T8_CS);
    for (int c = cx.vcu; c < 768; c += cx.G) {
        __syncthreads();
        const float* hf = HRAWT + (size_t)(o * 768 + c) * 4096; const float* hb = HRAWT + (size_t)(1536 + o * 768 + c) * 4096;
        float tap[16]; float mx = 0.f;
        int t3 = tid; asm volatile("" : "+v"(t3));
#pragma unroll
        for (int k = 0; k < 16; ++k) { const int i = t3 * 16 + k; float v; if (i < 4096) v = hf[4095 - i]; else if (i < 8191) v = hb[i - 4095]; else v = 0.f; tap[k] = v; mx = fmaxf(mx, fabsf(v)); }
        { const int dir = tid >> 8, blk = tid & 255; float v = HPART[(size_t)blk * 3072 + dir * 1536 + o * 768 + c]; v = wave_sum(v, lane); mx = wave_max_nn(mx); if (lane == 0) { red[wid] = v; red[8 + wid] = mx; } }
        __syncthreads();
        float nrm = 0.f, mall = 0.f;
#pragma unroll
        for (int w = 0; w < 8; ++w) { nrm += red[w]; mall = fmaxf(mall, red[8 + w]); }
        const float inv = 1.0f / nrm;
        int ex; (void)frexpf(fmaxf(mall * inv, 1e-30f), &ex);
        const float fsc = ldexpf(1.0f, 7 - ex), unsc = ldexpf(1.0f, ex - 7), tsc = inv * fsc;
        { unsigned w[4];
#pragma unroll
          for (int q = 0; q < 4; ++q) { int r = 0; r = __builtin_amdgcn_cvt_pk_fp8_f32(tap[4 * q] * tsc, tap[4 * q + 1] * tsc, r, false); r = __builtin_amdgcn_cvt_pk_fp8_f32(tap[4 * q + 2] * tsc, tap[4 * q + 3] * tsc, r, true); w[q] = (unsigned)r; }
          *(LAS u32x4*)(cp + tid * 16) = (u32x4){w[0], w[1], w[2], w[3]}; }
        __syncthreads();
        { const u32x4 lo = *(const LAS u32x4*)(cp + tid * 16); u32x4 hi = (u32x4){0u, 0u, 0u, 0u}; if (tid + 1 < 512) hi = *(const LAS u32x4*)(cp + (tid + 1) * 16);
          const unsigned w[8] = {lo.x, lo.y, lo.z, lo.w, hi.x, hi.y, hi.z, hi.w};
#pragma unroll
          for (int j = 1; j < 16; ++j) { u32x4 r; const int a = j >> 2, sh = j & 3;
              r.x = sh ? __builtin_amdgcn_alignbyte(w[a + 1], w[a], sh) : w[a]; r.y = sh ? __builtin_amdgcn_alignbyte(w[a + 2], w[a + 1], sh) : w[a + 1];
              r.z = sh ? __builtin_amdgcn_alignbyte(w[a + 3], w[a + 2], sh) : w[a + 2]; r.w = sh ? __builtin_amdgcn_alignbyte(w[a + 4], w[a + 3], sh) : w[a + 3];
              *(LAS u32x4*)(cp + j * T8_CS + t8_sig(j) * 16 + tid * 16) = r; } }
        __syncthreads();
        const int jc = 15 - m16;
        const int nbase = 255 - 32 * wid + 2 * q4;
        const LAS unsigned char* ap = cp + jc * T8_CS + t8_sig(jc) * 16 + (nbase - 31) * 16;
        const unsigned char* up = U8 + ((size_t)m16 * 768 + c) * 4096 + 32 * q4;
        f32x4 acc[32];
#pragma unroll
        for (int ti = 0; ti < 32; ++ti) acc[ti] = (f32x4){0.f, 0.f, 0.f, 0.f};
        typedef int v8i_t __attribute__((ext_vector_type(8))); typedef int v4i_t __attribute__((ext_vector_type(4)));
#define T8_FRAG(p) __builtin_shufflevector(*(const LAS v4i_t*)(p), *(const LAS v4i_t*)((p) + 16), 0, 1, 2, 3, 4, 5, 6, 7)
        v8i_t bcur = __builtin_shufflevector(*(const v4i_t*)(up), *(const v4i_t*)(up + 16), 0, 1, 2, 3, 4, 5, 6, 7);
        v8i_t afA[4], afB[4];
#pragma unroll
        for (int i = 0; i < 4; ++i) afA[i] = T8_FRAG(ap + (31 - i) * 16);
        for (int ks = 0; ks < 32; ++ks) {
            const unsigned char* un = up + ((ks + 1) & 31) * 128;
            const v8i_t bnext = __builtin_shufflevector(*(const v4i_t*)(un), *(const v4i_t*)(un + 16), 0, 1, 2, 3, 4, 5, 6, 7);
            const LAS unsigned char* a0 = ap + ks * 128;
            const LAS unsigned char* a1 = ap + ((ks + 1) & 31) * 128;
#define T8_LD(dst, base, g) do { _Pragma("unroll") for (int i = 0; i < 4; ++i) dst[i] = T8_FRAG((base) + (31 - (4 * (g) + i)) * 16); } while (0)
#define T8_MM(src, g) do { _Pragma("unroll") for (int i = 0; i < 4; ++i) acc[4 * (g) + i] = __builtin_amdgcn_mfma_scale_f32_16x16x128_f8f6f4(src[i], bcur, acc[4 * (g) + i], 0, 0, 0, 0, 0, 0); } while (0)
            T8_LD(afB, a0, 1); T8_MM(afA, 0); __builtin_amdgcn_sched_barrier(0);
            T8_LD(afA, a0, 2); T8_MM(afB, 1); __builtin_amdgcn_sched_barrier(0);
            T8_LD(afB, a0, 3); T8_MM(afA, 2); __builtin_amdgcn_sched_barrier(0);
            T8_LD(afA, a0, 4); T8_MM(afB, 3); __builtin_amdgcn_sched_barrier(0);
            T8_LD(afB, a0, 5); T8_MM(afA, 4); __builtin_amdgcn_sched_barrier(0);
            T8_LD(afA, a0, 6); T8_MM(afB, 5); __builtin_amdgcn_sched_barrier(0);
            T8_LD(afB, a0, 7); T8_MM(afA, 6); __builtin_amdgcn_sched_barrier(0);
            T8_LD(afA, a1, 0); T8_MM(afB, 7); __builtin_amdgcn_sched_barrier(0);
#undef T8_LD
#undef T8_MM
            bcur = bnext;
        }
#undef T8_FRAG
        const float lb = lbias[c];
        const size_t rowoff = ((size_t)m16 * 768 + c) * 4096 + 512 * wid + 4 * q4;
#pragma unroll
        for (int ti = 0; ti < 32; ++ti) {
            const u32x2 uu = *(const u32x2*)(UT + rowoff + 16 * ti), gg = *(const u32x2*)(GT + rowoff + 16 * ti);
            const float y0 = (acc[ti][0] * unsc + lb * bflo(uu.x)) * bflo(gg.x), y1 = (acc[ti][1] * unsc + lb * bfhi(uu.x)) * bfhi(gg.x), y2 = (acc[ti][2] * unsc + lb * bflo(uu.y)) * bflo(gg.y), y3 = (acc[ti][3] * unsc + lb * bfhi(uu.y)) * bfhi(gg.y);
            u32x2 w; w.x = pk2(y0, y1); w.y = pk2(y2, y3);
            *(u32x2*)(ZT + rowoff + 16 * ti) = w;
            if (Z8) { int w8 = 0; w8 = __builtin_amdgcn_cvt_pk_fp8_f32(fminf(fmaxf(y0, -440.f), 440.f), fminf(fmaxf(y1, -440.f), 440.f), w8, false); w8 = __builtin_amdgcn_cvt_pk_fp8_f32(fminf(fmaxf(y2, -440.f), 440.f), fminf(fmaxf(y3, -440.f), 440.f), w8, true);
                *(int*)(Z8 + rowoff + 16 * ti) = w8; }
            if ((ti & 7) == 7) __builtin_amdgcn_sched_barrier(0);
        }
    }
    __syncthreads();
}

__device__ __forceinline__ void tback_phase(const Ctx& cx, const bf16_t* ZT, bf16_t* CAT, const int tid) {
    const int lane = tid & 63, wave = __builtin_amdgcn_readfirstlane(tid >> 6);
    const int gw = cx.vcu * 8 + wave, NGW = cx.G * 8;
    LAS unsigned char* tile = cx.lds + wave * 9216;
    for (int it = gw; it < 16 * 12 * 64; it += NGW) {
        const int tt = it & 63, ct = (it >> 6) % 12, b = it / (64 * 12);
        const int c0 = ct * 64, t0 = tt * 64;
#pragma unroll
        for (int k = 0; k < 8; ++k) { const int row = k * 8 + (lane >> 3), chn = lane & 7;
            const u32x4 v = *(const u32x4*)(ZT + ((size_t)b * 768 + c0 + row) * 4096 + t0 + chn * 8);
            *(LAS u32x4*)(tile + row * 144 + chn * 16) = v; }
        LDS_WAIT(); asm volatile("" ::: "memory");
        if constexpr (OUTP_F8) { unsigned char* dst = (unsigned char*)CAT + ((size_t)b * 4096 + t0) * 1024 + c0 + lane;
#pragma unroll 8
            for (int k = 0; k < 64; ++k) { const float v = bf2f(*(const LAS unsigned short*)(tile + lane * 144 + k * 2)); dst[(size_t)k * 1024] = f2fp8(fminf(fmaxf(v, -440.0f), 440.0f)); }
        } else { bf16_t* dst = CAT + ((size_t)b * 4096 + t0) * 1024 + c0 + lane;
#pragma unroll 8
            for (int k = 0; k < 64; ++k) dst[(size_t)k * 1024] = *(const LAS unsigned short*)(tile + lane * 144 + k * 2); }
        LDS_WAIT(); asm volatile("" ::: "memory");
    }
}

__device__ __forceinline__ void ln1_group(const int bt, const int chunk, const int wave, const int lane, const int r16, const int q4, const bf16_t* XI, bf16_t* XO, bf16_t* XB, const float* g, const float* bta,
                                          const LAS unsigned char* Wh, const LAS unsigned char* Wl, LAS float* lg, LAS int* lcnt, const float rb0, const float rb1, float* gate, unsigned (&pk)[2], unsigned (&gp)[2]) {
    constexpr int WP = 2064;
            const size_t rowU = (size_t)chunk * 256 + wave * 32 + bt * 16;
            unsigned loff = (unsigned)(r16 * 1024 + 8 * q4); asm volatile("" : "+v"(loff));
            const GAS bf16_t* src = (const GAS bf16_t*)XI + rowU * 1024 + loff;
            constexpr int HOLD = LN1_HOLD;
            u32x4 raw[HOLD > 0 ? HOLD : 1], rawt[32 - HOLD]; float s = 0.f, ss = 0.f;
#pragma unroll
            for (int i = 0; i < 32; ++i) { if (i < HOLD) raw[i] = *(const GAS u32x4*)(src + 32 * i); else rawt[i - HOLD] = *(const GAS u32x4*)(src + 32 * i); }
#pragma unroll
            for (int i = 0; i < 32; ++i) { const u32x4 rr = (i < HOLD) ? raw[i < HOLD ? i : 0] : rawt[i < HOLD ? 0 : i - HOLD]; const float x0 = bflo(rr.x), x1 = bfhi(rr.x), x2 = bflo(rr.y), x3 = bfhi(rr.y), x4 = bflo(rr.z), x5 = bfhi(rr.z), x6 = bflo(rr.w), x7 = bfhi(rr.w);
                s += ((x0 + x1) + (x2 + x3)) + ((x4 + x5) + (x6 + x7)); ss += ((x0 * x0 + x1 * x1) + (x2 * x2 + x3 * x3)) + ((x4 * x4 + x5 * x5) + (x6 * x6 + x7 * x7)); }
            lg[2 * lane] = s; lg[2 * lane + 1] = ss; LDS_WAIT(); asm volatile("" ::: "memory");
            s = (lg[2 * r16] + lg[2 * (r16 + 16)]) + (lg[2 * (r16 + 32)] + lg[2 * (r16 + 48)]); ss = (lg[2 * r16 + 1] + lg[2 * (r16 + 16) + 1]) + (lg[2 * (r16 + 32) + 1] + lg[2 * (r16 + 48) + 1]);
            LDS_WAIT(); asm volatile("" ::: "memory");
            const float mean = s * (1.0f / 1024.0f), rstd = rsqrtf(fmaxf(ss * (1.0f / 1024.0f) - mean * mean, 0.f) + LN_EPS);
            f32x4 a0 = (f32x4){0.f, 0.f, 0.f, 0.f}, a1 = (f32x4){0.f, 0.f, 0.f, 0.f};
            const LAS unsigned char* wh0 = Wh + r16 * WP + 16 * q4; const LAS unsigned char* wl0 = Wl + r16 * WP + 16 * q4;
            GAS bf16_t* dsto = (GAS bf16_t*)XO + rowU * 1024 + loff; GAS unsigned char* dst8 = (GAS unsigned char*)XB + rowU * 1024 + loff;
#pragma unroll
            for (int i = 0; i < 32; ++i) {
                const GAS float* gp_ = (const GAS float*)g + 32 * i + 8 * q4; const GAS float* bp_ = (const GAS float*)bta + 32 * i + 8 * q4;
                const f32x4 g0 = *(const GAS f32x4*)gp_, g1 = *(const GAS f32x4*)(gp_ + 4), b0 = *(const GAS f32x4*)bp_, b1 = *(const GAS f32x4*)(bp_ + 4);
                u32x4 rw_; if (i < HOLD) rw_ = raw[i < HOLD ? i : 0]; else rw_ = *(const GAS u32x4*)(src + 32 * i); asm volatile("" : "+v"(rw_));
                float y[8]; y[0] = bflo(rw_.x); y[1] = bfhi(rw_.x); y[2] = bflo(rw_.y); y[3] = bfhi(rw_.y); y[4] = bflo(rw_.z); y[5] = bfhi(rw_.z); y[6] = bflo(rw_.w); y[7] = bfhi(rw_.w);
#pragma unroll
                for (int q = 0; q < 8; ++q) y[q] = (y[q] - mean) * rstd * (q < 4 ? g0[q & 3] : g1[q & 3]) + (q < 4 ? b0[q & 3] : b1[q & 3]);
                u32x4 hi; hi.x = pk2(y[0], y[1]); hi.y = pk2(y[2], y[3]); hi.z = pk2(y[4], y[5]); hi.w = pk2(y[6], y[7]);
                *(GAS u32x4*)(dsto + 32 * i) = hi;
                if constexpr (MOE_F8) { int w0 = 0, w1 = 0; w0 = __builtin_amdgcn_cvt_pk_fp8_f32(y[0], y[1], w0, false); w0 = __builtin_amdgcn_cvt_pk_fp8_f32(y[2], y[3], w0, true); w1 = __builtin_amdgcn_cvt_pk_fp8_f32(y[4], y[5], w1, false); w1 = __builtin_amdgcn_cvt_pk_fp8_f32(y[6], y[7], w1, true);
                    *(GAS u32x2*)(dst8 + 32 * i) = (u32x2){(unsigned)w0, (unsigned)w1}; }
                else { *(u32x4*)((bf16_t*)XB + rowU * 1024 + loff + 32 * i) = hi; }
                u32x4 lo; lo.x = pk2(y[0] - bflo(hi.x), y[1] - bfhi(hi.x)); lo.y = pk2(y[2] - bflo(hi.y), y[3] - bfhi(hi.y)); lo.z = pk2(y[4] - bflo(hi.z), y[5] - bfhi(hi.z)); lo.w = pk2(y[6] - bflo(hi.w), y[7] - bfhi(hi.w));
                const bf16x8 ah = __builtin_bit_cast(bf16x8, hi), al = __builtin_bit_cast(bf16x8, lo);
                const bf16x8 wh_0 = *(const LAS bf16x8*)(wh0 + 64 * i), wh_1 = *(const LAS bf16x8*)(wh0 + 16 * WP + 64 * i), wl_0 = *(const LAS bf16x8*)(wl0 + 64 * i), wl_1 = *(const LAS bf16x8*)(wl0 + 16 * WP + 64 * i);
                a0 = __builtin_amdgcn_mfma_f32_16x16x32_bf16(ah, wh_0, a0, 0, 0, 0); a1 = __builtin_amdgcn_mfma_f32_16x16x32_bf16(ah, wh_1, a1, 0, 0, 0);
                a0 = __builtin_amdgcn_mfma_f32_16x16x32_bf16(al, wh_0, a0, 0, 0, 0); a1 = __builtin_amdgcn_mfma_f32_16x16x32_bf16(al, wh_1, a1, 0, 0, 0);
                a0 = __builtin_amdgcn_mfma_f32_16x16x32_bf16(ah, wl_0, a0, 0, 0, 0); a1 = __builtin_amdgcn_mfma_f32_16x16x32_bf16(ah, wl_1, a1, 0, 0, 0);
                asm volatile("" :: "v"(ah), "v"(al), "v"(wh_0), "v"(wh_1), "v"(wl_0), "v"(wl_1));
                __builtin_amdgcn_sched_barrier(0);
            }
#pragma unroll
            for (int v = 0; v < 4; ++v) { lg[(4 * q4 + v) * 33 + r16] = a0[v] + rb0; lg[(4 * q4 + v) * 33 + r16 + 16] = a1[v] + rb1; }
            LDS_WAIT(); asm volatile("" ::: "memory");
            if (lane < 16) {
                const LAS float* myl = lg + lane * 33; const size_t rowt = (size_t)chunk * 256 + wave * 32 + bt * 16 + lane;
                float tv[4]; int te[4]; int t0 = -1, t1 = -1, t2 = -1;
#pragma unroll
                for (int k = 0; k < 4; ++k) { float best = -INFINITY; int bi = 0;
                    for (int e = 0; e < 32; ++e) { const float v = myl[e]; const bool ok = (e != t0) && (e != t1) && (e != t2); if (ok && v > best) { best = v; bi = e; } }
                    tv[k] = best; te[k] = bi; if (k == 0) t0 = bi; else if (k == 1) t1 = bi; else if (k == 2) t2 = bi; }
                const float e1 = __expf(tv[1] - tv[0]), e2 = __expf(tv[2] - tv[0]), e3 = __expf(tv[3] - tv[0]); const float isum = 1.0f / (1.0f + e1 + e2 + e3);
                const float gk[4] = {isum, e1 * isum, e2 * isum, e3 * isum};
                pk[0] = 0u; pk[1] = 0u;
#pragma unroll
                for (int k = 0; k < 4; ++k) { const int rk = __hip_atomic_fetch_add(lcnt + te[k], 1, __ATOMIC_RELAXED, __HIP_MEMORY_SCOPE_WORKGROUP); pk[k >> 1] |= (unsigned)((te[k] << 11) | rk) << (16 * (k & 1)); }
                gp[0] = pk2(gk[0], gk[1]); gp[1] = pk2(gk[2], gk[3]); (void)rowt; (void)gate;
            }
            LDS_WAIT(); asm volatile("" ::: "memory");
}
__device__ __forceinline__ void ln1_router_phase(const Ctx& cx, const bf16_t* XI, bf16_t* XO, bf16_t* XB, const float* g, const float* bta, const float* rw, const float* rb,
                                                 unsigned* cnt, int* expid, float* gate, int* idx, float* gidx, const int tid) {
    const int lane = tid & 63, wave = __builtin_amdgcn_readfirstlane(tid >> 6), r16 = lane & 15, q4 = lane >> 4;
    constexpr int WP = 2064;
    LAS unsigned char* Wh = cx.lds; LAS unsigned char* Wl = cx.lds + 32 * WP; LAS int* lcnt = (LAS int*)(cx.lds + 64 * WP); LAS int* lbase = lcnt + 32; LAS float* lg = (LAS float*)(cx.lds + 64 * WP + 256 + wave * 2112);
    __syncthreads();
    for (int i = tid; i < 32768; i += 512) { const int k = i >> 5, e = i & 31; const float w = rw[i]; const unsigned hi = f2bf(w); const float wl = w - bf2f((unsigned short)hi);
        *(LAS unsigned short*)(Wh + e * WP + 2 * k) = (unsigned short)hi; *(LAS unsigned short*)(Wl + e * WP + 2 * k) = (unsigned short)f2bf(wl); }
    if (tid < 32) lcnt[tid] = 0;
    const float rb0 = rb[r16], rb1 = rb[r16 + 16];
    __syncthreads();
    for (int chunk = cx.vcu; chunk < NTOK / 256; chunk += cx.G) {
        unsigned pk0[2] = {0u, 0u}, pk1[2] = {0u, 0u}, gp0[2] = {0u, 0u}, gp1[2] = {0u, 0u};
        ln1_group(0, chunk, wave, lane, r16, q4, XI, XO, XB, g, bta, Wh, Wl, lg, lcnt, rb0, rb1, gate, pk0, gp0);
        ln1_group(1, chunk, wave, lane, r16, q4, XI, XO, XB, g, bta, Wh, Wl, lg, lcnt, rb0, rb1, gate, pk1, gp1);
        __syncthreads();
        { int t2 = tid; asm volatile("" : "+v"(t2));
          if (t2 < 32) { lbase[t2] = (int)__hip_atomic_fetch_add(cnt + t2, (unsigned)lcnt[t2], __ATOMIC_RELAXED, __HIP_MEMORY_SCOPE_AGENT); } }
        __syncthreads();
        const int ln_ = lane_id_volatile();
        if (ln_ < 16) {
            { const int slot0 = (chunk * 256 + wave * 32 + ln_) * 4;
#pragma unroll
                for (int k = 0; k < 4; ++k) { const unsigned p = (pk0[k >> 1] >> (16 * (k & 1))) & 0xffffu; const int e = (int)(p >> 11), rk = (int)(p & 0x7ffu); const size_t o_ = (size_t)e * IDXCAP + lbase[e] + rk; idx[o_] = slot0 + k; gidx[o_] = (k & 1) ? bfhi(gp0[k >> 1]) : bflo(gp0[k >> 1]); } }
            { const int slot0 = (chunk * 256 + wave * 32 + 16 + ln_) * 4;
#pragma unroll
                for (int k = 0; k < 4; ++k) { const unsigned p = (pk1[k >> 1] >> (16 * (k & 1))) & 0xffffu; const int e = (int)(p >> 11), rk = (int)(p & 0x7ffu); const size_t o_ = (size_t)e * IDXCAP + lbase[e] + rk; idx[o_] = slot0 + k; gidx[o_] = (k & 1) ? bfhi(gp1[k >> 1]) : bflo(gp1[k >> 1]); } }
        }
        __syncthreads();
        if (tid < 32) lcnt[tid] = 0;
        __syncthreads();
    }
}

__device__ __forceinline__ void ln2_phase(const Ctx& cx, const bf16_t* X1, const bf16_t* Y, bf16_t* XO, bf16_t* XB, float* OUT, const float* g, const float* bta, const int tid) {
    const int lane = tid & 63, wave = __builtin_amdgcn_readfirstlane(tid >> 6);
    const int gw = cx.vcu * 8 + wave, NGW = cx.G * 8;
    if constexpr (Y_F8) {
        for (int rp = gw; rp < NTOK / 2; rp += NGW) {
            u32x4 xa[2][2], ya[2][4];
#pragma unroll
            for (int r = 0; r < 2; ++r) { const size_t row = (size_t)rp * 2 + r;
                xa[r][0] = *(const u32x4*)(X1 + row * 1024 + 16 * lane); xa[r][1] = *(const u32x4*)(X1 + row * 1024 + 16 * lane + 8);
#pragma unroll
                for (int k = 0; k < 4; ++k) ya[r][k] = *(const u32x4*)((const unsigned char*)Y + (row * 4 + k) * 1024 + 16 * lane); }
            float v[2][16]; float s[2] = {0.f, 0.f};
#pragma unroll
            for (int r = 0; r < 2; ++r) {
#pragma unroll
                for (int i = 0; i < 4; ++i) { f32x2 lo = __builtin_amdgcn_cvt_pk_f32_fp8((int)ya[r][0][i], false), hi = __builtin_amdgcn_cvt_pk_f32_fp8((int)ya[r][0][i], true);
#pragma unroll
                    for (int k = 1; k < 4; ++k) { lo += __builtin_amdgcn_cvt_pk_f32_fp8((int)ya[r][k][i], false); hi += __builtin_amdgcn_cvt_pk_f32_fp8((int)ya[r][k][i], true); }
                    const unsigned xlo = xa[r][i >> 1][(i & 1) * 2], xhi = xa[r][i >> 1][(i & 1) * 2 + 1];
                    v[r][4 * i + 0] = bflo(xlo) * DN_ALPHA + lo[0] * (1.0f / Y_SCALE); v[r][4 * i + 1] = bfhi(xlo) * DN_ALPHA + lo[1] * (1.0f / Y_SCALE);
                    v[r][4 * i + 2] = bflo(xhi) * DN_ALPHA + hi[0] * (1.0f / Y_SCALE); v[r][4 * i + 3] = bfhi(xhi) * DN_ALPHA + hi[1] * (1.0f / Y_SCALE);
                    s[r] += (v[r][4 * i] + v[r][4 * i + 1]) + (v[r][4 * i + 2] + v[r][4 * i + 3]); } }
            const float mean0 = wave_sum(s[0], lane) * (1.0f / 1024.0f), mean1 = wave_sum(s[1], lane) * (1.0f / 1024.0f); float q[2] = {0.f, 0.f};
#pragma unroll
            for (int r = 0; r < 2; ++r)
#pragma unroll
                for (int e = 0; e < 16; ++e) { v[r][e] -= (r == 0 ? mean0 : mean1); q[r] += v[r][e] * v[r][e]; }
            const float rstd0 = rsqrtf(wave_sum(q[0], lane) * (1.0f / 1024.0f) + LN_EPS), rstd1 = rsqrtf(wave_sum(q[1], lane) * (1.0f / 1024.0f) + LN_EPS);
            unsigned wb[2][8]; unsigned w8[2][4];
#pragma unroll
            for (int j = 0; j < 4; ++j) { const f32x4 gvj = *(const f32x4*)(g + 16 * lane + 4 * j), bvj = *(const f32x4*)(bta + 16 * lane + 4 * j);
#pragma unroll
                for (int r = 0; r < 2; ++r) { const size_t row = (size_t)rp * 2 + r; const float rs = (r == 0 ? rstd0 : rstd1);
                    const f32x4 o = (f32x4){v[r][4 * j], v[r][4 * j + 1], v[r][4 * j + 2], v[r][4 * j + 3]} * rs * gvj + bvj;
                    if (OUT) *(f32x4*)(OUT + row * 1024 + 16 * lane + 4 * j) = o;
                    else { wb[r][2 * j] = pk2(o[0], o[1]); wb[r][2 * j + 1] = pk2(o[2], o[3]);
                        int t8 = 0; t8 = __builtin_amdgcn_cvt_pk_fp8_f32(o[0], o[1], t8, false); t8 = __builtin_amdgcn_cvt_pk_fp8_f32(o[2], o[3], t8, true); w8[r][j] = (unsigned)t8; } } }
            if (!OUT) {
#pragma unroll
                for (int r = 0; r < 2; ++r) { const size_t row = (size_t)rp * 2 + r;
                    *(u32x4*)(XO + row * 1024 + 16 * lane) = (u32x4){wb[r][0], wb[r][1], wb[r][2], wb[r][3]}; *(u32x4*)(XO + row * 1024 + 16 * lane + 8) = (u32x4){wb[r][4], wb[r][5], wb[r][6], wb[r][7]};
                    if constexpr (INP_F8) *(u32x4*)((unsigned char*)XB + row * 1024 + 16 * lane) = (u32x4){w8[r][0], w8[r][1], w8[r][2], w8[r][3]};
                    else { *(u32x4*)(XB + row * 1024 + 16 * lane) = (u32x4){wb[r][0], wb[r][1], wb[r][2], wb[r][3]}; *(u32x4*)(XB + row * 1024 + 16 * lane + 8) = (u32x4){wb[r][4], wb[r][5], wb[r][6], wb[r][7]}; } } }
        }
        return;
    }
    for (int rp = gw; rp < NTOK / 2; rp += NGW) {
        f32x4 v[2][4]; float s[2] = {0.f, 0.f};
#pragma unroll
        for (int r = 0; r < 2; ++r) { const size_t row = (size_t)rp * 2 + r;
#pragma unroll
            for (int j = 0; j < 4; ++j) { const u32x2 a = *(const u32x2*)(X1 + row * 1024 + 4 * lane + 256 * j); v[r][j] = (f32x4){bflo(a.x), bfhi(a.x), bflo(a.y), bfhi(a.y)} * DN_ALPHA;
#pragma unroll
                for (int k = 0; k < 4; ++k) {
                    if constexpr (Y_F8) { const int y8 = *(const int*)((const unsigned char*)Y + (row * 4 + k) * 1024 + 4 * lane + 256 * j); const f32x2 lo = __builtin_amdgcn_cvt_pk_f32_fp8(y8, false), hi = __builtin_amdgcn_cvt_pk_f32_fp8(y8, true);
                        v[r][j][0] += lo[0] * (1.0f / Y_SCALE); v[r][j][1] += lo[1] * (1.0f / Y_SCALE); v[r][j][2] += hi[0] * (1.0f / Y_SCALE); v[r][j][3] += hi[1] * (1.0f / Y_SCALE); }
                    else { const u32x2 y = *(const u32x2*)(Y + (row * 4 + k) * 1024 + 4 * lane + 256 * j); v[r][j][0] += bflo(y.x); v[r][j][1] += bfhi(y.x); v[r][j][2] += bflo(y.y); v[r][j][3] += bfhi(y.y); } }
                s[r] += (v[r][j][0] + v[r][j][1]) + (v[r][j][2] + v[r][j][3]); } }
        const float mean0 = wave_sum(s[0], lane) * (1.0f / 1024.0f), mean1 = wave_sum(s[1], lane) * (1.0f / 1024.0f); float q[2] = {0.f, 0.f};
#pragma unroll
        for (int r = 0; r < 2; ++r)
#pragma unroll
            for (int j = 0; j < 4; ++j) { v[r][j] = v[r][j] - (r == 0 ? mean0 : mean1); q[r] += (v[r][j][0] * v[r][j][0] + v[r][j][1] * v[r][j][1]) + (v[r][j][2] * v[r][j][2] + v[r][j][3] * v[r][j][3]); }
        const float rstd0 = rsqrtf(wave_sum(q[0], lane) * (1.0f / 1024.0f) + LN_EPS), rstd1 = rsqrtf(wave_sum(q[1], lane) * (1.0f / 1024.0f) + LN_EPS);
#pragma unroll
        for (int j = 0; j < 4; ++j) { const f32x4 gvj = *(const f32x4*)(g + 4 * lane + 256 * j), bvj = *(const f32x4*)(bta + 4 * lane + 256 * j);
#pragma unroll
            for (int r = 0; r < 2; ++r) { const size_t row = (size_t)rp * 2 + r; const f32x4 o = v[r][j] * (r == 0 ? rstd0 : rstd1) * gvj + bvj;
                if (OUT) *(f32x4*)(OUT + row * 1024 + 4 * lane + 256 * j) = o;
                else { u32x2 w; w.x = pk2(o[0], o[1]); w.y = pk2(o[2], o[3]); *(u32x2*)(XO + row * 1024 + 4 * lane + 256 * j) = w;
                    if constexpr (INP_F8) { int w8 = 0; w8 = __builtin_amdgcn_cvt_pk_fp8_f32(o[0], o[1], w8, false); w8 = __builtin_amdgcn_cvt_pk_fp8_f32(o[2], o[3], w8, true); *(int*)((unsigned char*)XB + row * 1024 + 4 * lane + 256 * j) = w8; }
                    else { *(u32x2*)(XB + row * 1024 + 4 * lane + 256 * j) = w; } } } }
    }
}

constexpr int PH_PER_LAYER = 10, N_PHASES = 2 + PH_PER_LAYER * DEPTH;
__host__ __device__ constexpr bool phase_active(int p) {
    if (p < 2) return true;
    const int l = (p - 2) / PH_PER_LAYER, k = (p - 2) % PH_PER_LAYER, kind = l % 3;
    if (k == 1) return kind != 0;
    if (k == 3 || k == 4) return kind == 2;
    return true;
}

__global__ void __launch_bounds__(512, 2) fwd(Args args) {
    extern __shared__ __attribute__((aligned(16))) unsigned char lds_raw[];
    const int wave0 = __builtin_amdgcn_readfirstlane((int)threadIdx.x >> 6);
    Ctx cx; cx.lds = (LAS unsigned char*)lds_raw; cx.G = gridDim.x; { const int bx = blockIdx.x; cx.vcu = (cx.G % 8 == 0) ? (bx % 8) * (cx.G / 8) + bx / 8 : bx; } cx.ws = args.ws;
    volatile LAS unsigned* MISC = (volatile LAS unsigned*)(cx.lds + MISC_OFF);
    for (int u = threadIdx.x; u < (LDS_BYTES - MISC_OFF) / 4; u += 512) MISC[u] = 0u;
    __syncthreads();
    if (threadIdx.x == 0) { LAS unsigned long long* t = (LAS unsigned long long*)(cx.lds + PTAB_OFF);
#pragma unroll
        for (int k = 0; k < 32; ++k) t[k] = (unsigned long long)args.in[k];
        t[32] = (unsigned long long)args.out; t[33] = (unsigned long long)args.ws; }
    __syncthreads();
    const int lo = args.ph_lo, hi = args.ph_hi;
    XcdBarrier bar; bar.bar = (unsigned*)((gu32*)(args.ws + WS_CTL) + CW_BAR); bar.x = 0; bar.st = nullptr;
    if (hi - lo > 1) bar = xcd_barrier_post((unsigned*)((gu32*)(args.ws + WS_CTL) + CW_BAR), MISC + 8);
    int ran = 0;
#define XB ((bf16_t*)(ws + WS_XB))
#define PROJ ((bf16_t*)(ws + WS_PROJ))
#define CAT ((bf16_t*)(ws + WS_CAT))
#define KVM ((bf16_t*)(ws + WS_KVM))
#define HB ((bf16_t*)(ws + WS_H))
#define YB ((bf16_t*)(ws + WS_Y))
#define QKR ((bf16_t*)(ws + WS_QKR))
#define EXPID ((int*)(ws + WS_EXPID))
#define GATE ((float*)(ws + WS_GATE))
#define IDX ((int*)(ws + WS_IDX))
#define XF ((float*)(GAS float*)ptab_get(cx, 32))
#define SB ((bf16_t*)(ws + WS_SB))
#define SB2 ((bf16_t*)(ws + WS_PROJ))
#define TP_BAR_BEGIN() do {} while (0)
#define TP_BAR_END() do {} while (0)
#define TP_PH_BEGIN(p) do {} while (0)
#define TP_PH_END(p) do {} while (0)
#define PH_BEGIN(p) if (lo <= (p) && (p) < hi) { const int ph_ = (p); if (ran) { TP_BAR_BEGIN(); for (int rb_ = 0; rb_ < REP_BAR; ++rb_) xcd_barrier(bar, wave0); TP_BAR_END(); } ran = 1; const int tid = opaque_tid(wave0); (void)tid; unsigned char* const ws = (unsigned char*)(GAS unsigned char*)ptab_get(cx, 33); cx.ws = ws; TP_PH_BEGIN(ph_);
#define PH_END TP_PH_END(ph_); }

#if EN_P0
    PH_BEGIN(0) for (int rep_ = 0; rep_ < REP_P0; ++rep_) { p0_prologue(cx, tid); } PH_END
#endif

    for (int l = -1; l < DEPTH; ++l) {
        const int kind = (l < 0) ? 0 : l % 3, jj = (l < 0) ? 0 : l / 3, pw = (l < 0) ? 2048 : ((l % 3) == 1 ? 1536 : 2560), base = 2 + PH_PER_LAYER * l;
        PH_BEGIN(l < 0 ? 1 : base) {
            pg8::DenseOrder S;
            if (l < 0) S.init(ws + WS_MEMB, ws + WS_WKV, NMEM, 2048, 1024 * INP_EB, cx.G, (int)blockIdx.x);
            else S.init(XB, ws + WS_WIN + (size_t)l * 5 * MiB, NTOK, pw, 1024 * INP_EB, cx.G, (int)blockIdx.x);
            S.rep = REP_DENSE;
            const unsigned smask = (l < 0) ? 0u : (kind == 0 ? 0x207u : kind == 1 ? 0x20u : 0x200u);
            pg8::EpiBf16s E{l < 0 ? KVM : PROJ, pw, smask, C2, INP_F8 ? 1.0f / WIN_SCALE : 1.0f};
#if EN_G1
            pg8::gemm_phase<pg8::EpiBf16s, pg8::DenseOrder, false, INP_F8 != 0>(cx.lds, S, E, tid);
#endif
        } PH_END
        if (l < 0) continue;
#if EN_THIN
        if (kind == 1) { PH_BEGIN(base + 1) for (int rep_ = 0; rep_ < REP_THIN; ++rep_) { rope_phase(cx, PROJ, INP(5) + jj * 64, INP(6) + jj * 64, QKR, tid); } PH_END }
        if (kind == 2) { PH_BEGIN(base + 1) for (int rep_ = 0; rep_ < REP_THIN; ++rep_) { sconv_phase(cx, PROJ, INP(8) + (size_t)jj * 3 * 2304, INP(9) + (size_t)jj * 2304, (bf16_t*)(ws + WS_UT3), ws + WS_V8, tid); } PH_END }
#endif
        for (int o = 0; o < 2; ++o) {
            if (o == 1 && kind != 2) break;
            PH_BEGIN(base + 2 + o) {
                if (kind == 2) {
                    const bf16_t* UT3 = (const bf16_t*)(ws + WS_UT3); constexpr size_t PS = (size_t)16 * 768 * 4096;
#if EN_TCONV
                    for (int rep_ = 0; rep_ < REP_TCONV; ++rep_) {
#if TCONV_F8
                    tconv8_phase(cx, o, o == 0 ? UT3 : (const bf16_t*)(ws + WS_Z1T), ws + WS_V8 + (size_t)o * 48 * MiB, UT3 + (size_t)(1 + o) * PS, (bf16_t*)(ws + (o == 0 ? WS_Z1T : WS_Z2T)), o == 0 ? ws + WS_V8 + 48 * MiB : (unsigned char*)nullptr, INP(19) + (size_t)(jj * 2 + o) * 768, tid);
#else
                    tconv_phase(cx, o, o == 0 ? UT3 : (const bf16_t*)(ws + WS_Z1T), UT3 + (size_t)(1 + o) * PS, (bf16_t*)(ws + (o == 0 ? WS_Z1T : WS_Z2T)), INP(19) + (size_t)(jj * 2 + o) * 768, tid);
#endif
                    }
#endif
                }
                if (o == 0) {
#if EN_NA
                    for (int rep_ = 0; rep_ < REP_NA; ++rep_) { if (kind == 0) na_phase(cx, PROJ, INP(3) + (size_t)jj * 12 * 465, CAT, tid); }
#endif
                    const int ngqa = (kind == 1) ? 3072 : 0;
                    for (int rep_ = 0; rep_ < REP_ATTN; ++rep_)
                    for (int u = cx.vcu; u < ngqa + 1024; u += cx.G) {
                        const attn_body::bf16 *Q, *K, *V; attn_body::bf16* O; int QP, KP, VP, NT;
                        if (u < ngqa) { const int qb = u & 15, hq = (u >> 4) % 12, b = u / 192, kvh = hq / 3;
                            Q = (const attn_body::bf16*)QKR + ((size_t)b * 4096 + qb * 256) * 1024 + hq * 64; QP = 1024;
                            K = (const attn_body::bf16*)QKR + (size_t)b * 4096 * 1024 + 768 + kvh * 64; KP = 1024;
                            V = (const attn_body::bf16*)PROJ + (size_t)b * 4096 * 1536 + 1024 + kvh * 64; VP = 1536;
                            O = (attn_body::bf16*)((unsigned char*)CAT + (((size_t)b * 4096 + qb * 256) * 1024 + hq * 64) * OUT_EB); NT = 64;
                        } else { const int v = u - ngqa, qb = v & 15, h = (v >> 4) & 3, b = v >> 6;
                            Q = (const attn_body::bf16*)PROJ + ((size_t)b * 4096 + qb * 256) * pw + (pw - 256) + h * 64; QP = pw;
                            K = (const attn_body::bf16*)KVM + (size_t)b * 256 * 2048 + 512 * l + h * 64; KP = 2048;
                            V = K + 256; VP = 2048;
                            O = (attn_body::bf16*)((unsigned char*)CAT + (((size_t)b * 4096 + qb * 256) * 1024 + 768 + h * 64) * OUT_EB); NT = 4;
                        }
#if EN_ATTN
                        attn_body::attn_unit<8, OUTP_F8 != 0>(Q, K, V, O, QP, KP, VP, 1024, NT, (char*)lds_raw, tid);
#endif
                    }
                }
            } PH_END
        }
#if EN_THIN
        if (kind == 2) { PH_BEGIN(base + 4) for (int rep_ = 0; rep_ < REP_THIN; ++rep_) { tback_phase(cx, (const bf16_t*)(ws + WS_Z2T), CAT, tid); } PH_END }
#endif
        PH_BEGIN(base + 5) {
            pg8::DenseOrder S; S.init(CAT, ws + WS_WOUT + (size_t)l * 2 * MiB, NTOK, 1024, 1024 * OUT_EB, cx.G, (int)blockIdx.x);
            pg8::EpiResB E{SB, l == 0 ? (const void*)INP(0) : (const void*)SB, l == 0 ? 1 : 0, 1024, DN_ALPHA, OUTP_F8 ? 1.0f / WOUT_SCALE : 1.0f};
#if EN_G2
            pg8::gemm_phase<pg8::EpiResB, pg8::DenseOrder, false, OUTP_F8 != 0>(cx.lds, S, E, tid);
#endif
        } PH_END
#if EN_LN
#if REP_LN1 > 1
        PH_BEGIN(base + 6) ln1_router_phase(cx, SB, (bf16_t*)(ws + WS_PROJ), CAT, INP(22) + l * 1024, INP(23) + l * 1024, INP(26) + (size_t)l * 1024 * 32, INP(27) + l * 32, (unsigned*)((gu32*)(ws + WS_CTL) + CW_DBG), EXPID, GATE, IDX, (float*)(ws + WS_GIDX), tid); PH_END
#endif
        PH_BEGIN(base + 6) ln1_router_phase(cx, SB, SB2, XB, INP(22) + l * 1024, INP(23) + l * 1024, INP(26) + (size_t)l * 1024 * 32, INP(27) + l * 32, (unsigned*)((gu32*)(ws + WS_CTL) + CW_CNT + 32 * l), EXPID, GATE, IDX, (float*)(ws + WS_GIDX), tid); PH_END
#endif
        for (int half = 0; half < 2; ++half) {
            PH_BEGIN(base + 7 + half) {
                LAS int* pref = (LAS int*)(cx.lds + pg8::STAGE_BYTES); const unsigned* cntw = (const unsigned*)((gu32*)(ws + WS_CTL) + CW_CNT + 32 * l);
                __syncthreads();
                if (tid == 0) { int a = 0;
#pragma unroll 1
                    for (int e = 0; e < NEXP; ++e) { const int c = (int)__hip_atomic_load(cntw + e, __ATOMIC_RELAXED, __HIP_MEMORY_SCOPE_AGENT); pref[e] = a; pref[40 + e] = c; a += (c + 255) >> 8; } pref[NEXP] = a; }
                __syncthreads();
#if STAGGER
                if (cx.vcu & 1) { for (int s_ = 0; s_ < STAGGER; ++s_) __builtin_amdgcn_s_sleep(127); }
#endif
                if (half == 0) {
                    pg8::MoeOrder<2> S{(const char*)XB, (const char*)(ws + WS_W1 + (size_t)l * 32 * 2048 * 1024 * MOE_EB), 1024 * MOE_EB, 8, cx.G, cx.vcu, (size_t)2048 * 1024 * MOE_EB, pref, (const int*)cntw, IDX};
                    pg8::EpiSwiglu E{HB, INP(29) + (size_t)l * 32 * 2048};
#if EN_G3
                    for (int rep_ = 0; rep_ < REP_G3; ++rep_) { pg8::gemm_phase<pg8::EpiSwiglu, pg8::MoeOrder<2>, true, MOE_F8 != 0, (MOE_F8 != 0) && (DEFER_H != 0)>(cx.lds, S, E, tid); }
#endif
                } else {
                    pg8::MoeOrder<0> S{(const char*)HB, (const char*)(ws + WS_W2 + (size_t)l * 32 * 1024 * 1024 * MOE_EB), 1024 * MOE_EB, 4, cx.G, cx.vcu, (size_t)1024 * 1024 * MOE_EB, pref, (const int*)cntw, IDX};
                    pg8::EpiMoeOut E{YB, INP(31) + (size_t)l * 32 * 1024, (const float*)(ws + WS_GIDX)};
#if EN_G4
                    for (int rep_ = 0; rep_ < REP_G4; ++rep_) { pg8::gemm_phase<pg8::EpiMoeOut, pg8::MoeOrder<0>, true, MOE_F8 != 0>(cx.lds, S, E, tid); }
#endif
                }
            } PH_END
        }
#if EN_LN
#if REP_LN2 > 1
        PH_BEGIN(base + 9) ln2_phase(cx, SB, YB, (bf16_t*)(ws + WS_PROJ), CAT, (float*)nullptr, INP(24) + l * 1024, INP(25) + l * 1024, tid); PH_END
#endif
        PH_BEGIN(base + 9) ln2_phase(cx, SB2, YB, SB, XB, l == DEPTH - 1 ? XF : (float*)nullptr, INP(24) + l * 1024, INP(25) + l * 1024, tid); PH_END

#endif
    }
#undef PH_BEGIN
#undef PH_END
#undef XB
#undef PROJ
#undef CAT
#undef KVM
#undef HB
#undef YB
#undef QKR
#undef EXPID
#undef GATE
#undef IDX
#undef XF
#undef SB
#undef SB2
}

extern "C" void kernel_launch(void* const* d_in, const int* in_sizes, int n_in, void* d_out, int out_size, void* d_ws, size_t ws_size, hipStream_t stream) {
    static int grid = 0;
    if (grid == 0) {
        if (n_in != 32 || in_sizes[0] != NTOK * DM || out_size != NTOK * DM || ws_size < WS_END) { fprintf(stderr, "kernel_launch: unexpected problem (n_in %d, in0 %d, out %d, ws %zu < %zu); nothing launched\n", n_in, n_in > 0 ? in_sizes[0] : -1, out_size, ws_size, (size_t)WS_END); grid = -1; return; }
        int dev = 0, cus = 0, per_cu = 0;
        if (hipGetDevice(&dev) != hipSuccess || hipDeviceGetAttribute(&cus, hipDeviceAttributeMultiprocessorCount, dev) != hipSuccess) { fprintf(stderr, "kernel_launch: device query failed\n"); grid = -1; return; }
        if (hipFuncSetAttribute((const void*)fwd, hipFuncAttributeMaxDynamicSharedMemorySize, LDS_BYTES) != hipSuccess) { fprintf(stderr, "kernel_launch: hipFuncSetAttribute failed\n"); grid = -1; return; }
        if (hipOccupancyMaxActiveBlocksPerMultiprocessor(&per_cu, (const void*)fwd, 512, LDS_BYTES) != hipSuccess || per_cu < 1) fprintf(stderr, "kernel_launch: occupancy query reports %d blocks per CU\n", per_cu);
        (void)hipGetLastError();
        grid = cus;
    }
    if (grid < 0) return;
    if (hipMemsetAsync((char*)d_ws + WS_CTL, 0, CTL_ZERO_BYTES, stream) != hipSuccess) { fprintf(stderr, "kernel_launch: memset failed\n"); return; }
    Args a{};
    for (int i = 0; i < 32; ++i) a.in[i] = (const float*)d_in[i];
    a.out = (float*)d_out; a.ws = (unsigned char*)d_ws;
#if MK_MULTI
    for (int p = 0; p < N_PHASES && p <= DBG_LAST_PHASE; ++p) {
        if (!phase_active(p)) continue;
        a.ph_lo = p; a.ph_hi = p + 1;
        hipLaunchKernelGGL(fwd, dim3(grid), dim3(512), LDS_BYTES, stream, a);
#if DBG_CHECK
        dbg_after_phase(p, a, stream);
#endif
    }
#if DBG_CHECK
    hipLaunchKernelGGL(dbg_report, dim3(1024), dim3(256), 0, stream, (unsigned*)((char*)d_ws + WS_CTL) + CW_DBG, (float*)d_out);
#endif
#else
    a.ph_lo = 0; a.ph_hi = N_PHASES;
    hipLaunchKernelGGL(fwd, dim3(grid), dim3(512), LDS_BYTES, stream, a);
#endif
    const hipError_t le = hipPeekAtLastError();
    if (le != hipSuccess) fprintf(stderr, "kernel_launch: launch failed: %s\n", hipGetErrorName(le));
}
```

```cpp
#include <hip/hip_runtime.h>
#include <hip/hip_bf16.h>
#include <cstdio>
#include <cstdint>

#ifndef MK_MULTI
#define MK_MULTI 0
#endif
#ifndef DBG_CHECK
#define DBG_CHECK 0
#endif
#ifndef DBG_LAST_PHASE
#define DBG_LAST_PHASE 9999
#endif

#ifndef EN_P0
#define EN_P0 1
#define EN_G1 1
#define EN_THIN 1
#define EN_TCONV 1
#define EN_NA 1
#define EN_ATTN 1
#define EN_G2 1
#define EN_LN 1
#define EN_G3 1
#define EN_G4 1
#endif

#ifndef REP_P0
#define REP_P0 1
#endif
#ifndef REP_G1
#define REP_G1 1
#endif
#ifndef REP_NA
#define REP_NA 1
#endif
#ifndef REP_ATTN
#define REP_ATTN 1
#endif
#ifndef REP_TCONV
#define REP_TCONV 1
#endif
#ifndef REP_THIN
#define REP_THIN 1
#endif
#ifndef REP_G3
#define REP_G3 1
#endif
#ifndef REP_G4
#define REP_G4 1
#endif
#ifndef ALIGN_EPI
#define ALIGN_EPI 1
#endif
#ifndef NT_STORE
#define NT_STORE 0
#endif
#ifndef LN1_HOLD
#define LN1_HOLD 16
#endif
#ifndef DEFER_H
#define DEFER_H 0
#endif
#ifndef STAGGER
#define STAGGER 0
#endif
#ifndef REP_BAR
#define REP_BAR 1
#endif
#ifndef REP_DENSE
#define REP_DENSE 1
#endif
#ifndef REP_G2
#define REP_G2 1
#endif
#ifndef REP_LN1
#define REP_LN1 1
#endif
#ifndef REP_LN2
#define REP_LN2 1
#endif

#define GAS __attribute__((address_space(1)))
#define LAS __attribute__((address_space(3)))
typedef unsigned short bf16_t;
typedef short bf16x8 __attribute__((ext_vector_type(8)));
typedef short s16x4 __attribute__((ext_vector_type(4)));
typedef float f32x4 __attribute__((ext_vector_type(4)));
typedef float f32x2 __attribute__((ext_vector_type(2)));
typedef float f32x16 __attribute__((ext_vector_type(16)));
typedef unsigned u32x4 __attribute__((ext_vector_type(4)));
typedef unsigned u32x2 __attribute__((ext_vector_type(2)));
typedef GAS unsigned gu32;

constexpr int BATCH = 16, SEQ = 4096, DM = 1024, NTOK = BATCH * SEQ, DEPTH = 4;
constexpr int MEMLEN = 256, NMEM = BATCH * MEMLEN;
constexpr int NEXP = 32, NSLOT = NTOK * 4, IDXCAP = NTOK;
constexpr int GRIDW = 64;
constexpr float LN_EPS = 1e-5f;
constexpr float DN_ALPHA = 1.681792830507429f;
constexpr float LOG2E = 1.4426950408889634f;
constexpr float C2 = 0.125f * LOG2E;
__host__ __device__ constexpr int layer_kind(int l) { return l % 3; }
__host__ __device__ constexpr int layer_j(int l) { return l / 3; }
__host__ __device__ constexpr int in_width(int l) { return (l % 3) == 1 ? 1536 : 2560; }

#ifndef MOE_F8
#define MOE_F8 1
#endif
#ifndef INP_F8
#define INP_F8 1
#endif
constexpr int INP_EB = INP_F8 ? 1 : 2;
constexpr float WIN_SCALE = 32.0f;
#ifndef OUTP_F8
#define OUTP_F8 1
#endif
constexpr int OUT_EB = OUTP_F8 ? 1 : 2;
constexpr float WOUT_SCALE = 64.0f;
__device__ __forceinline__ unsigned char f2fp8(float x) { return (unsigned char)(__builtin_amdgcn_cvt_pk_fp8_f32(x, x, 0, false) & 0xff); }
#ifndef TCONV_F8
#define TCONV_F8 1
#endif
#ifndef Y_F8
#define Y_F8 1
#endif
constexpr float Y_SCALE = 64.0f;
constexpr int MOE_EB = MOE_F8 ? 1 : 2;
constexpr float W1_SCALE = 32.0f, W2_SCALE = 64.0f, H_SCALE = 4.0f;

constexpr size_t MiB = 1u << 20;
constexpr size_t WS_CTL = 0, CTL_ZERO_BYTES = 1 * MiB;
constexpr size_t WS_WIN = 2 * MiB;
constexpr size_t WS_WKV = 22 * MiB;
constexpr size_t WS_WOUT = 26 * MiB;
constexpr size_t WS_W1 = 34 * MiB;
constexpr size_t WS_W2 = 546 * MiB;
constexpr size_t WS_XB = 802 * MiB;
constexpr size_t WS_MEMB = 930 * MiB;
constexpr size_t WS_KVM = 938 * MiB;
constexpr size_t WS_PROJ = 954 * MiB;
constexpr size_t WS_CAT = 1274 * MiB;
constexpr size_t WS_H = 1402 * MiB;
constexpr size_t WS_Y = 1914 * MiB;
constexpr size_t WS_HRAWT = 2426 * MiB;
constexpr size_t WS_HPART = 2474 * MiB;
constexpr size_t WS_EXPID = 2478 * MiB;
constexpr size_t WS_GATE = 2479 * MiB;
constexpr size_t WS_IDX = 2480 * MiB;
constexpr size_t WS_SB = 2488 * MiB;
constexpr size_t WS_GIDX = 2616 * MiB;
constexpr size_t WS_END = 2624 * MiB;
constexpr size_t WS_UT3 = WS_H;
constexpr size_t WS_Z1T = WS_H + 288 * MiB;
constexpr size_t WS_Z2T = WS_H + 384 * MiB;
constexpr size_t WS_V8 = WS_Y;
constexpr size_t WS_QKR = WS_Y;
constexpr int CW_BAR = 4096;
constexpr int CW_CNT = 8192;
constexpr int CW_DBG = 12288;

constexpr int MISC_OFF = 150528;
constexpr int LDS_BYTES = 163840;

#define LDS_WAIT() asm volatile("s_waitcnt lgkmcnt(0)" ::: "memory")
#define VM_WAIT() asm volatile("s_waitcnt vmcnt(0)" ::: "memory")
__device__ __forceinline__ unsigned f2bf(float f) { unsigned u = __builtin_bit_cast(unsigned, f); return (u + 0x7fffu + ((u >> 16) & 1u)) >> 16; }
__device__ __forceinline__ unsigned pk2(float lo, float hi) { return f2bf(lo) | (f2bf(hi) << 16); }
__device__ __forceinline__ float bf2f(unsigned short b) { return __builtin_bit_cast(float, ((unsigned)b) << 16); }
__device__ __forceinline__ float bflo(unsigned w) { return __builtin_bit_cast(float, w << 16); }
__device__ __forceinline__ float bfhi(unsigned w) { return __builtin_bit_cast(float, w & 0xffff0000u); }
__device__ __forceinline__ float shflx(float v, int mask, int lane) { int t; asm volatile("v_mov_b32 %0, %1" : "=v"(t) : "v"(__builtin_bit_cast(int, v))); return __builtin_bit_cast(float, __builtin_amdgcn_ds_bpermute((lane ^ mask) << 2, t)); }
__device__ __forceinline__ int shflxi(int v, int mask, int lane) { return __builtin_amdgcn_ds_bpermute((lane ^ mask) << 2, v); }
template <int CTRL> __device__ __forceinline__ float dpp_x(float v) { return __builtin_bit_cast(float, __builtin_amdgcn_update_dpp(0, __builtin_bit_cast(int, v), CTRL, 0xF, 0xF, false)); }
__device__ __forceinline__ float group8_sum(float v) { v += dpp_x<0xB1>(v); v += dpp_x<0x4E>(v); v += dpp_x<0x141>(v); return v; }
__device__ __forceinline__ float wave_sum(float v, int  ) {
    v += dpp_x<0xB1>(v); v += dpp_x<0x4E>(v); v += dpp_x<0x141>(v); v += dpp_x<0x140>(v);
    v += __builtin_bit_cast(float, __builtin_amdgcn_update_dpp(0, __builtin_bit_cast(int, v), 0x142, 0xA, 0xF, false));
    v += __builtin_bit_cast(float, __builtin_amdgcn_update_dpp(0, __builtin_bit_cast(int, v), 0x143, 0xC, 0xF, false));
    return __builtin_bit_cast(float, __builtin_amdgcn_readlane(__builtin_bit_cast(int, v), 63));
}
__device__ __forceinline__ int lane_id_volatile() { int l; asm volatile("v_mbcnt_lo_u32_b32 %0, -1, 0\n\tv_mbcnt_hi_u32_b32 %0, -1, %0" : "=&v"(l)); return l; }
__device__ __forceinline__ int opaque_tid(int wave0) { return wave0 * 64 + lane_id_volatile(); }

#define XB_TMO      128
#define XB_XCNT(j)  (256  + 64 * (j))
#define XB_XSUB(j)  (1280 + 64 * (j))
#define XB_XGEN(j)  (2304 + 64 * (j))
#define XB_TOP      3328
#define XB_TOPGEN   3392
#define XCD_BAR_WORDS 3456
#define XB_SPIN_CAP (1u << 20)

__device__ __forceinline__ unsigned xb_ld(unsigned* p)              { return __hip_atomic_load(p, __ATOMIC_RELAXED, __HIP_MEMORY_SCOPE_AGENT); }
__device__ __forceinline__ unsigned xb_add(unsigned* p, unsigned v) { return __hip_atomic_fetch_add(p, v, __ATOMIC_RELAXED, __HIP_MEMORY_SCOPE_AGENT); }
__device__ __forceinline__ unsigned xb_xcc_id() { return (unsigned)__builtin_amdgcn_s_getreg((3 << 11) | 20) & 0xFu; }
#define XB_SPIN(cond, bar) do { unsigned _sp = 0; while (cond) { __builtin_amdgcn_s_sleep(1); \
    if ((++_sp & 255u) == 0u) { if (xb_ld(&(bar)[XB_TMO])) break; if (_sp > XB_SPIN_CAP) { atomicAdd(&(bar)[XB_TMO], 1u); break; } } } } while (0)

struct XcdBarrier {
    unsigned* bar; unsigned x;
    volatile LAS unsigned* st;
};
__device__ __forceinline__ XcdBarrier xcd_barrier_post(unsigned* bar, volatile LAS unsigned* st) {
    XcdBarrier b; b.bar = bar; b.x = xb_xcc_id(); b.st = st;
    if (threadIdx.x == 0) (void)xb_add(&bar[XB_XCNT(b.x)], 1u);
    return b;
}
__device__ __forceinline__ void xcd_barrier_complete(unsigned* bar, unsigned x, unsigned& nloc, unsigned& nx) {
    const unsigned G = gridDim.x * gridDim.y * gridDim.z;
    unsigned sum, cnt, mine, sp = 0u;
    for (;;) {
        sum = 0u; cnt = 0u; mine = 0u;
#pragma unroll 1
        for (unsigned j = 0; j < 16; ++j) { const unsigned c = xb_ld(&bar[XB_XCNT(j)]); sum += c; cnt += (c > 0u) ? 1u : 0u; mine = (j == x) ? c : mine; }
        if (sum == G) break;
        __builtin_amdgcn_s_sleep(1);
        if ((++sp & 255u) == 0u) { if (xb_ld(&bar[XB_TMO])) break; if (sp > XB_SPIN_CAP) { atomicAdd(&bar[XB_TMO], 1u); break; } }
    }
    nloc = mine > 0u ? mine : 1u; nx = cnt > 0u ? cnt : 1u;
}
__device__ __forceinline__ void xcd_barrier(const XcdBarrier& b, const int wave0) {
    asm volatile("s_waitcnt vmcnt(0)" ::: "memory");
    __syncthreads();
    if (wave0 == 0 && lane_id_volatile() == 0) {
        unsigned* bar = b.bar;
        __builtin_amdgcn_s_waitcnt(0);
        unsigned nloc = b.st[0], nx = b.st[1];
        if (nloc == 0u) { xcd_barrier_complete(bar, b.x, nloc, nx); b.st[0] = nloc; b.st[1] = nx; }
        const unsigned old = xb_add(&bar[XB_XSUB(b.x)], 1u);
        const unsigned gen = old / nloc;
        if (old + 1u == (gen + 1u) * nloc) {
            __builtin_amdgcn_fence(__ATOMIC_RELEASE, "agent");
            asm volatile("s_waitcnt vmcnt(0)" ::: "memory");
            const unsigned og = xb_add(&bar[XB_TOP], 1u);
            const unsigned tg = og / nx;
            if (og + 1u == (tg + 1u) * nx) xb_add(&bar[XB_TOPGEN], 1u);
            else XB_SPIN(xb_ld(&bar[XB_TOPGEN]) == tg, bar);
            __builtin_amdgcn_fence(__ATOMIC_ACQUIRE, "agent");
            xb_add(&bar[XB_XGEN(b.x)], 1u);
            asm volatile("s_waitcnt vmcnt(0)" ::: "memory");
        } else {
            XB_SPIN(xb_ld(&bar[XB_XGEN(b.x)]) == gen, bar);
            __builtin_amdgcn_fence(__ATOMIC_ACQUIRE, "agent");
            asm volatile("s_waitcnt vmcnt(0)" ::: "memory");
        }
    }
    __syncthreads();
}

namespace pg8 {
constexpr int BM = 256, BK = 64, HALF = 128, HTB = HALF * BK * 2  , STAGE_BYTES = 8 * HTB, NXCD = 8, WGM = 8;
__host__ __device__ __forceinline__ int lds_byte(int r, int c) { const int st = (r >> 4) * 2 + (c >> 5), rr = r & 15, cc = c & 31, ob = rr * 64 + cc * 2; return st * 1024 + (ob ^ (((ob >> 9) & 1) << 5)); }
__host__ __device__ __forceinline__ void stage_rc(int b, int& R, int& C) { const int st = b / 1024, sb = b % 1024, swz = sb ^ (((sb >> 9) & 1) << 5); R = (st >> 1) * 16 + swz / 64; C = (st & 1) * 32 + (swz % 64) / 2; }
__host__ __device__ __forceinline__ int perm32(int rho) { const int n = rho >> 4, i = rho & 15; return 8 * (i >> 2) + 4 * n + (i & 3); }

struct Unit { int pm, pn, e, p; };

struct DenseOrder {
    const char* A; const char* Bt; int KB; int nM, nN, nwg, G, c; int rep = 1;
    __device__ __forceinline__ void init(const void* A_, const void* Bt_, int M, int N, int KB_, int G_, int c_) { A = (const char*)A_; Bt = (const char*)Bt_; KB = KB_; nM = M / BM; nN = N / BM; nwg = nM * nN; G = G_; c = c_; }
    __device__ __forceinline__ bool next(int i, Unit& u) const {
        long L = (long)i * G + c; if (L >= (long)nwg * rep) return false;
        if (rep > 1) L %= nwg;
        int wgid = (int)L; { const int q = nwg / NXCD, r = nwg % NXCD, xcd = wgid % NXCD, off = wgid / NXCD; wgid = (xcd < r ? xcd * (q + 1) : r * (q + 1) + (xcd - r) * q) + off; }
        const int nig = WGM * nN, gid = wgid / nig, fm = gid * WGM, gsz = (nM - fm) < WGM ? (nM - fm) : WGM;
        u.pm = __builtin_amdgcn_readfirstlane(fm + ((wgid % nig) % gsz)); u.pn = __builtin_amdgcn_readfirstlane((wgid % nig) / gsz); u.e = 0; u.p = 0; return true;
    }
    __device__ __forceinline__ const char* a_base(const Unit& u) const { return A + (size_t)u.pm * BM * KB; }
    __device__ __forceinline__ const char* b_base(const Unit& u) const { return Bt + (size_t)u.pn * BM * KB; }
    __device__ __forceinline__ const int* idx_src(const Unit&) const { return nullptr; }
    __device__ __forceinline__ int nvalid(const Unit&) const { return BM; }
    static constexpr int ROW_SHIFT = 0;
};
template <int SHIFT  > struct MoeOrder {
    const char* A; const char* Bt; int KB; int nN; int G, c; size_t bstride; const LAS int* pref; const int* cnt; const int* idx;
    __device__ __forceinline__ bool next(int i, Unit& u) const {
        const long L = (long)i * G + c; const int tot = __builtin_amdgcn_readfirstlane(pref[NEXP]);
        if (L >= (long)tot * nN) return false;
        const int pg = __builtin_amdgcn_readfirstlane((int)(L / nN)); u.pn = __builtin_amdgcn_readfirstlane((int)(L % nN));
        int e = 0;
#pragma unroll
        for (int step = 16; step >= 1; step >>= 1) { const int v = __builtin_amdgcn_readfirstlane(pref[e + step]); e += (v <= pg) ? step : 0; }
        u.e = e; u.p = pg - __builtin_amdgcn_readfirstlane(pref[e]); u.pm = 0; return true;
    }
    __device__ __forceinline__ const char* a_base(const Unit&) const { return A; }
    __device__ __forceinline__ const char* b_base(const Unit& u) const { return Bt + (size_t)u.e * bstride + (size_t)u.pn * BM * KB; }
    __device__ __forceinline__ const int* idx_src(const Unit& u) const { return idx + (size_t)u.e * IDXCAP + u.p * BM; }
    __device__ __forceinline__ int nvalid(const Unit& u) const { const int n = __builtin_amdgcn_readfirstlane(pref[40 + u.e]) - u.p * BM; return n < BM ? n : BM; }
    static constexpr int ROW_SHIFT = SHIFT;
};

__device__ __forceinline__ unsigned cvt_pk_bf16(float lo, float hi) { unsigned r; asm volatile("v_cvt_pk_bf16_f32 %0, %1, %2" : "=v"(r) : "v"(lo), "v"(hi)); return r; }

struct EpiBf16s {
    static constexpr bool PERM = true; static constexpr bool HAS_BIAS = false;
    bf16_t* O; int ldc; unsigned smask; float scale; float base;
    __device__ __forceinline__ void operator()(const f32x4 (&acc)[2][2][4][2], const Unit& u, int wr, int wc, int fr, int fq) const {
        const int row0 = u.pm * BM + wr * 64 + fr, col0 = u.pn * BM + wc * 32 + 8 * fq;
        const float sc = (((smask >> u.pn) & 1u) ? scale : 1.f) * base;
#pragma unroll
        for (int ai = 0; ai < 2; ++ai)
#pragma unroll
            for (int m = 0; m < 4; ++m) { bf16_t* rowp = O + (size_t)(row0 + ai * HALF + m * 16) * ldc + col0;
#pragma unroll
                for (int bj = 0; bj < 2; ++bj) { const f32x4 v0 = acc[ai][bj][m][0] * sc, v1 = acc[ai][bj][m][1] * sc;
                    u32x4 w; w.x = cvt_pk_bf16(v0[0], v0[1]); w.y = cvt_pk_bf16(v0[2], v0[3]); w.z = cvt_pk_bf16(v1[0], v1[1]); w.w = cvt_pk_bf16(v1[2], v1[3]);
                    if (NT_STORE) __builtin_nontemporal_store(w, (u32x4*)(rowp + bj * HALF)); else *(u32x4*)(rowp + bj * HALF) = w; }
                asm volatile("" ::: "memory"); }
    }
};
struct EpiResB {
    static constexpr bool PERM = true; static constexpr bool HAS_BIAS = false;
    bf16_t* C; const void* res; int res_f32; int ldc; float alpha; float ascale;
    __device__ __forceinline__ void operator()(const f32x4 (&acc)[2][2][4][2], const Unit& u, int wr, int wc, int fr, int fq) const {
        const int row0 = u.pm * BM + wr * 64 + fr, col0 = u.pn * BM + wc * 32 + 8 * fq;
        if (res_f32) {
#pragma unroll
            for (int ai = 0; ai < 2; ++ai) { f32x4 r[4][2][2];
#pragma unroll
                for (int m = 0; m < 4; ++m)
#pragma unroll
                    for (int bj = 0; bj < 2; ++bj) { const float* rp = (const float*)res + (size_t)(row0 + ai * HALF + m * 16) * ldc + col0 + bj * HALF; r[m][bj][0] = *(const f32x4*)rp; r[m][bj][1] = *(const f32x4*)(rp + 4); }
#pragma unroll
                for (int m = 0; m < 4; ++m)
#pragma unroll
                    for (int bj = 0; bj < 2; ++bj) { const size_t off = (size_t)(row0 + ai * HALF + m * 16) * ldc + col0 + bj * HALF;
                        const f32x4 v0 = r[m][bj][0] * alpha + acc[ai][bj][m][0] * ascale, v1 = r[m][bj][1] * alpha + acc[ai][bj][m][1] * ascale;
                        u32x4 w; w.x = cvt_pk_bf16(v0[0], v0[1]); w.y = cvt_pk_bf16(v0[2], v0[3]); w.z = cvt_pk_bf16(v1[0], v1[1]); w.w = cvt_pk_bf16(v1[2], v1[3]);
                        *(u32x4*)(C + off) = w; }
                asm volatile("" ::: "memory"); }
        } else { u32x4 raw[2][4][2];
#pragma unroll
            for (int ai = 0; ai < 2; ++ai)
#pragma unroll
                for (int m = 0; m < 4; ++m)
#pragma unroll
                    for (int bj = 0; bj < 2; ++bj) raw[ai][m][bj] = *(const u32x4*)((const bf16_t*)res + (size_t)(row0 + ai * HALF + m * 16) * ldc + col0 + bj * HALF);
#pragma unroll
            for (int ai = 0; ai < 2; ++ai)
#pragma unroll
                for (int m = 0; m < 4; ++m)
#pragma unroll
                    for (int bj = 0; bj < 2; ++bj) { const size_t off = (size_t)(row0 + ai * HALF + m * 16) * ldc + col0 + bj * HALF; const u32x4 rw = raw[ai][m][bj];
                        const f32x4 r0 = (f32x4){bflo(rw.x), bfhi(rw.x), bflo(rw.y), bfhi(rw.y)}, r1 = (f32x4){bflo(rw.z), bfhi(rw.z), bflo(rw.w), bfhi(rw.w)};
                        const f32x4 v0 = r0 * alpha + acc[ai][bj][m][0] * ascale, v1 = r1 * alpha + acc[ai][bj][m][1] * ascale;
                        u32x4 w; w.x = cvt_pk_bf16(v0[0], v0[1]); w.y = cvt_pk_bf16(v0[2], v0[3]); w.z = cvt_pk_bf16(v1[0], v1[1]); w.w = cvt_pk_bf16(v1[2], v1[3]);
                        *(u32x4*)(C + off) = w; }
        }
    }
};
struct Pend { u32x2 val[8]; };
struct EpiSwiglu {
    static constexpr bool PERM = true; static constexpr bool HAS_GATE = false; static constexpr bool HAS_BIAS = true;
    __device__ __forceinline__ void load_bias(const Unit& u, int wc, int fq, f32x4 (&bp)[4]) const { const float* bg = b1 + (size_t)u.e * 2048 + u.pn * HALF + wc * 32 + 8 * fq; bp[0] = *(const f32x4*)bg; bp[1] = *(const f32x4*)(bg + 4); bp[2] = *(const f32x4*)(bg + 1024); bp[3] = *(const f32x4*)(bg + 1028); }
    bf16_t* H; const float* b1;
    __device__ __forceinline__ void prepare(const f32x4 (&acc)[2][2][4][2], const Unit& u, int wr, int wc, int fr, int fq, Pend& pd) const {
        constexpr float ASC = 1.0f / W1_SCALE;
        const int j0 = u.pn * HALF + wc * 32 + 8 * fq; const float* bg = b1 + (size_t)u.e * 2048 + j0; const float* bu = bg + 1024;
        const f32x4 bg0 = *(const f32x4*)bg, bg1 = *(const f32x4*)(bg + 4), bu0 = *(const f32x4*)bu, bu1 = *(const f32x4*)(bu + 4);
#pragma unroll
        for (int q8 = 0; q8 < 8; ++q8) { const int ai = q8 >> 2, m = q8 & 3;
            float o[8];
#pragma unroll
            for (int q = 0; q < 8; ++q) { const float gb = (q < 4 ? bg0[q & 3] : bg1[q & 3]), ub = (q < 4 ? bu0[q & 3] : bu1[q & 3]);
                float g = acc[ai][0][m][q >> 2][q & 3] * ASC + gb, uu = acc[ai][1][m][q >> 2][q & 3] * ASC + ub;
                g = fminf(g, 7.0f); uu = fminf(fmaxf(uu, -7.0f), 7.0f);
                const float sg = __builtin_amdgcn_rcpf(1.0f + __builtin_amdgcn_exp2f(-1.702f * LOG2E * g));
                o[q] = (uu + 1.0f) * (g * sg); }
            int w0 = 0, w1 = 0;
            w0 = __builtin_amdgcn_cvt_pk_fp8_f32(o[0] * H_SCALE, o[1] * H_SCALE, w0, false); w0 = __builtin_amdgcn_cvt_pk_fp8_f32(o[2] * H_SCALE, o[3] * H_SCALE, w0, true);
            w1 = __builtin_amdgcn_cvt_pk_fp8_f32(o[4] * H_SCALE, o[5] * H_SCALE, w1, false); w1 = __builtin_amdgcn_cvt_pk_fp8_f32(o[6] * H_SCALE, o[7] * H_SCALE, w1, true);
            pd.val[q8] = (u32x2){(unsigned)w0, (unsigned)w1}; }
    }
    __device__ __forceinline__ void store_one(const u32x2 v, const LAS int* ids, const int r, const int nv, const int j0) const { if (r < nv) { const int slot = ids[r]; *(u32x2*)((unsigned char*)H + (size_t)slot * 1024 + j0) = v; } }
    __device__ __forceinline__ void operator()(const f32x4 (&acc)[2][2][4][2], const Unit& u, int wr, int wc, int fr, int fq, const LAS int* ids, const int nv, const f32x4 (&bp)[4]) const {
        constexpr float ASC = MOE_F8 ? 1.0f / W1_SCALE : 1.0f;
        constexpr float HS = MOE_F8 ? H_SCALE : 1.0f, KK = -1.702f * LOG2E, GA = ASC * KK, UA = ASC * HS / KK, ULO = 8.0f * HS / KK, UHI = -6.0f * HS / KK, GLO = 7.0f * KK;
        const int j0 = u.pn * HALF + wc * 32 + 8 * fq;
        const f32x4 bg0 = bp[0] * KK, bg1 = bp[1] * KK; f32x4 bu0 = (bp[2] + 1.0f) * (HS / KK), bu1 = (bp[3] + 1.0f) * (HS / KK);
        asm volatile("" : "+v"(bu0), "+v"(bu1));
        int rb = wr * 64 + fr; asm volatile("" : "+v"(rb));
        const LAS int* idp = ids + rb; int slots[8];
#pragma unroll
        for (int q = 0; q < 8; ++q) slots[q] = idp[(q >> 2) * HALF + (q & 3) * 16];
#pragma unroll
        for (int ai = 0; ai < 2; ++ai)
#pragma unroll
            for (int m = 0; m < 4; ++m) { const int r = ai * HALF + m * 16 + rb;
                if (r < nv) { const int slot = slots[ai * 4 + m];
                    float o[8];
#pragma unroll
                    for (int q = 0; q < 8; ++q) { const float gb = (q < 4 ? bg0[q & 3] : bg1[q & 3]), ub = (q < 4 ? bu0[q & 3] : bu1[q & 3]);
                        const float gp = fmaxf(__builtin_fmaf(acc[ai][0][m][q >> 2][q & 3], GA, gb), GLO);
                        const float us = fminf(fmaxf(__builtin_fmaf(acc[ai][1][m][q >> 2][q & 3], UA, ub), ULO), UHI);
                        const float sg = __builtin_amdgcn_rcpf(1.0f + __builtin_amdgcn_exp2f(gp));
                        o[q] = us * (gp * sg); }
                    if constexpr (MOE_F8) { int w0 = 0, w1 = 0;
                        w0 = __builtin_amdgcn_cvt_pk_fp8_f32(o[0], o[1], w0, false); w0 = __builtin_amdgcn_cvt_pk_fp8_f32(o[2], o[3], w0, true);
                        w1 = __builtin_amdgcn_cvt_pk_fp8_f32(o[4], o[5], w1, false); w1 = __builtin_amdgcn_cvt_pk_fp8_f32(o[6], o[7], w1, true);
                        *(u32x2*)((unsigned char*)H + (size_t)slot * 1024 + j0) = (u32x2){(unsigned)w0, (unsigned)w1};
                    } else { u32x4 w; w.x = cvt_pk_bf16(o[0], o[1]); w.y = cvt_pk_bf16(o[2], o[3]); w.z = cvt_pk_bf16(o[4], o[5]); w.w = cvt_pk_bf16(o[6], o[7]);
                        *(u32x4*)(H + (size_t)slot * 1024 + j0) = w; } } }
    }
};
struct EpiMoeOut {
    static constexpr bool PERM = true; static constexpr bool HAS_GATE = true; static constexpr bool HAS_BIAS = true;
    __device__ __forceinline__ void load_bias(const Unit& u, int wc, int fq, f32x4 (&bp)[4]) const { const float* bb = b2 + (size_t)u.e * 1024 + u.pn * BM + wc * 32 + 8 * fq; bp[0] = *(const f32x4*)bb; bp[1] = *(const f32x4*)(bb + 4); bp[2] = *(const f32x4*)(bb + HALF); bp[3] = *(const f32x4*)(bb + HALF + 4); }
    bf16_t* Y; const float* b2;   const float* gidx;
    __device__ __forceinline__ void operator()(const f32x4 (&acc)[2][2][4][2], const Unit& u, int wr, int wc, int fr, int fq, const LAS int* ids, const int nv, const f32x4 (&bp)[4]) const {
        const LAS float* gts = (const LAS float*)(ids + 768);
        constexpr float OSC = MOE_F8 ? 1.0f / (H_SCALE * W2_SCALE) : 1.0f;
        const int c0 = u.pn * BM + wc * 32 + 8 * fq;
        f32x4 bv[2][2]; bv[0][0] = bp[0]; bv[0][1] = bp[1]; bv[1][0] = bp[2]; bv[1][1] = bp[3];
        int rb = wr * 64 + fr; asm volatile("" : "+v"(rb));
        const LAS int* idp = ids + rb; int slots[8];
#pragma unroll
        for (int q = 0; q < 8; ++q) slots[q] = idp[(q >> 2) * HALF + (q & 3) * 16];
#pragma unroll
        for (int ai = 0; ai < 2; ++ai)
#pragma unroll
            for (int m = 0; m < 4; ++m) { const int r = ai * HALF + m * 16 + rb;
                if (r < nv) { const int slot = slots[ai * 4 + m]; const float gt = gts[r];
                    if constexpr (Y_F8) {
                        unsigned pk[2][2];
#pragma unroll
                        for (int bj = 0; bj < 2; ++bj) { const f32x4 s0 = (acc[ai][bj][m][0] * OSC + bv[bj][0]) * (gt * Y_SCALE), s1 = (acc[ai][bj][m][1] * OSC + bv[bj][1]) * (gt * Y_SCALE); int w0 = 0, w1 = 0;
                            w0 = __builtin_amdgcn_cvt_pk_fp8_f32(s0[0], s0[1], w0, false); w0 = __builtin_amdgcn_cvt_pk_fp8_f32(s0[2], s0[3], w0, true); w1 = __builtin_amdgcn_cvt_pk_fp8_f32(s1[0], s1[1], w1, false); w1 = __builtin_amdgcn_cvt_pk_fp8_f32(s1[2], s1[3], w1, true);
                            pk[bj][0] = (unsigned)w0; pk[bj][1] = (unsigned)w1; }
                        const auto x0 = __builtin_amdgcn_permlane16_swap(pk[0][0], pk[1][0], false, false), x1 = __builtin_amdgcn_permlane16_swap(pk[0][1], pk[1][1], false, false);
                        *(u32x4*)((unsigned char*)Y + (size_t)slot * 1024 + c0 + ((fq & 1) ? 120 : 0)) = (u32x4){x0[0], x1[0], x0[1], x1[1]};
                    } else {
#pragma unroll
                    for (int bj = 0; bj < 2; ++bj) { const f32x4 v0 = (acc[ai][bj][m][0] * OSC + bv[bj][0]) * gt, v1 = (acc[ai][bj][m][1] * OSC + bv[bj][1]) * gt;
                        u32x4 w; w.x = cvt_pk_bf16(v0[0], v0[1]); w.y = cvt_pk_bf16(v0[2], v0[3]); w.z = cvt_pk_bf16(v1[0], v1[1]); w.w = cvt_pk_bf16(v1[2], v1[3]);
                        if (NT_STORE) __builtin_nontemporal_store(w, (u32x4*)(Y + (size_t)slot * 1024 + c0 + bj * HALF)); else *(u32x4*)(Y + (size_t)slot * 1024 + c0 + bj * HALF) = w; } } } }
    }
};

__device__ __forceinline__ const char* uni_ptr(const char* p) { const unsigned long long v = (unsigned long long)p; const unsigned lo = __builtin_amdgcn_readfirstlane((unsigned)v), hi = __builtin_amdgcn_readfirstlane((unsigned)(v >> 32)); return (const char*)(((unsigned long long)hi << 32) | lo); }
typedef int v4i_t __attribute__((ext_vector_type(4))); typedef int v8i_t __attribute__((ext_vector_type(8)));
__device__ __forceinline__ v8i_t cat8(const bf16x8 a, const bf16x8 b) { return __builtin_shufflevector(__builtin_bit_cast(v4i_t, a), __builtin_bit_cast(v4i_t, b), 0, 1, 2, 3, 4, 5, 6, 7); }
template <class Epi, class Sched, bool GATHER, bool F8 = false, bool DEFER = false>
__device__ __forceinline__ void gemm_phase(LAS unsigned char* lds, const Sched& S, const Epi& E, const int tid) {
    const int wid = __builtin_amdgcn_readfirstlane(tid >> 6), lane = tid & 63, wr = wid >> 2, wc = wid & 3, fr = lane & 15, fq = lane >> 4;
    const int KB = S.KB, nt = KB / 128;
    unsigned voffA[2], voffB[2];
#pragma unroll
    for (int i = 0; i < 2; ++i) { int R, C; stage_rc(tid * 16 + i * 8192, R, C); const int Rb = Epi::PERM ? ((R & ~31) + perm32(R & 31)) : R;
        voffA[i] = (unsigned)(R * KB + C * 2); voffB[i] = (unsigned)(Rb * KB + C * 2); }
    const size_t kstep = (size_t)(BK * 2);
    const size_t hstep = (size_t)HALF * KB;
    const unsigned ldsw = (unsigned)wid * 1024u;
    const int aoff = lds_byte(wr * 64 + fr, fq * 8), boff = lds_byte(wc * 32 + fr, fq * 8);
#define PG8_SA(b, h) (((b) * 2 + (h)) * HTB)
#define PG8_SB(b, h) ((4 + (b) * 2 + (h)) * HTB)
#define PG8_STAGE(bufoff, gbase, voff) do { const char* _gb = uni_ptr((const char*)(gbase)); _Pragma("unroll") for (int _i = 0; _i < 2; ++_i) \
        __builtin_amdgcn_global_load_lds((const unsigned*)(_gb + (voff)[_i]), (LAS unsigned*)(lds + (bufoff) + ldsw + _i * 8192), 16, 0, 0); } while (0)
#define PG8_STAGE_A(bufoff, kb, h, GO) do { if constexpr (GATHER) { PG8_STAGE(bufoff, kb, (GO)[h]); } else { PG8_STAGE(bufoff, (kb) + (h) * hstep, voffA); } } while (0)
#define PG8_LDA(dst, b, h) do { if constexpr (F8) { _Pragma("unroll") for (int m = 0; m < 4; ++m) dst##8[m] = cat8(*(const LAS bf16x8*)(lds + PG8_SA(b, h) + aoff + m * 2048), *(const LAS bf16x8*)(lds + PG8_SA(b, h) + aoff + m * 2048 + 1024)); } else { \
        _Pragma("unroll") for (int m = 0; m < 4; ++m) _Pragma("unroll") for (int k = 0; k < 2; ++k) dst[m][k] = *(const LAS bf16x8*)(lds + PG8_SA(b, h) + aoff + m * 2048 + k * 1024); } } while (0)
#define PG8_LDB(dst, b, h) do { if constexpr (F8) { _Pragma("unroll") for (int n = 0; n < 2; ++n) dst##8[n] = cat8(*(const LAS bf16x8*)(lds + PG8_SB(b, h) + boff + n * 2048), *(const LAS bf16x8*)(lds + PG8_SB(b, h) + boff + n * 2048 + 1024)); } else { \
        _Pragma("unroll") for (int n = 0; n < 2; ++n) _Pragma("unroll") for (int k = 0; k < 2; ++k) dst[n][k] = *(const LAS bf16x8*)(lds + PG8_SB(b, h) + boff + n * 2048 + k * 1024); } } while (0)
#define PG8_MMA(ai, bj, At, Bt) do { __builtin_amdgcn_s_setprio(1); if constexpr (F8) { _Pragma("unroll") for (int m = 0; m < 4; ++m) _Pragma("unroll") for (int n = 0; n < 2; ++n) \
        acc[ai][bj][m][n] = __builtin_amdgcn_mfma_scale_f32_16x16x128_f8f6f4(Bt##8[n], At##8[m], acc[ai][bj][m][n], 0, 0, 0, 0, 0, 0); } else { \
        _Pragma("unroll") for (int m = 0; m < 4; ++m) _Pragma("unroll") for (int n = 0; n < 2; ++n) _Pragma("unroll") for (int k = 0; k < 2; ++k) \
        acc[ai][bj][m][n] = __builtin_amdgcn_mfma_f32_16x16x32_bf16(Bt[n][k], At[m][k], acc[ai][bj][m][n], 0, 0, 0); } __builtin_amdgcn_s_setprio(0); } while (0)
#define PG8_WAIT_V(n) asm volatile("s_waitcnt vmcnt(" #n ")" ::: "memory")
#define PG8_WAIT_L(n) asm volatile("s_waitcnt lgkmcnt(" #n ")" ::: "memory")
#define PG8_BAR __builtin_amdgcn_s_barrier()
#define PG8_SCHED __builtin_amdgcn_sched_barrier(0)
    LAS int* const ibuf = (LAS int*)(lds + STAGE_BYTES + 512);
#define PG8_IDMA(u, b) do { if constexpr (GATHER) { __builtin_amdgcn_global_load_lds((const unsigned*)(S.idx_src(u) + 64 * (wid & 3) + lane), (LAS unsigned*)(ibuf + (b) * 256 + 64 * (wid & 3)), 4, 0, 0); \
        if constexpr (Epi::HAS_GATE) __builtin_amdgcn_global_load_lds((const unsigned*)(E.gidx + (S.idx_src(u) - S.idx) + 64 * (wid & 3) + lane), (LAS unsigned*)(ibuf + 768 + (b) * 256 + 64 * (wid & 3)), 4, 0, 0); } } while (0)
#define PG8_GOFF(dst, u, b) do { if constexpr (GATHER) { int _t = tid; asm volatile("" : "+v"(_t)); const int _nv = S.nvalid(u); _Pragma("unroll") for (int _i = 0; _i < 2; ++_i) { int _R, _C; stage_rc(_t * 16 + _i * 8192, _R, _C); \
        _Pragma("unroll") for (int _h = 0; _h < 2; ++_h) { const int _r = _R + _h * HALF; const unsigned _s = (unsigned)ibuf[(b) * 256 + (_r < _nv ? _r : 0)]; dst[_h][_i] = (_s >> Sched::ROW_SHIFT) * (unsigned)KB + (unsigned)_C * 2u; } } } } while (0)
    Unit cur, nxt; int ui = 0;
    if (!S.next(0, cur)) return;
    f32x4 acc[2][2][4][2];
#pragma unroll
    for (int a = 0; a < 2; ++a)
#pragma unroll
        for (int b = 0; b < 2; ++b)
#pragma unroll
            for (int m = 0; m < 4; ++m)
#pragma unroll
                for (int n = 0; n < 2; ++n) acc[a][b][m][n] = (f32x4){0.f, 0.f, 0.f, 0.f};
    bf16x8 At[4][2], B0[2][2], B1[2][2];
    v8i_t At8[4], B08[2], B18[2];
    unsigned gA[2][2] = {{0u, 0u}, {0u, 0u}}, gN[2][2] = {{0u, 0u}, {0u, 0u}};
    int bsel = 0;
    f32x4 bpre[4] = {(f32x4){0.f, 0.f, 0.f, 0.f}, (f32x4){0.f, 0.f, 0.f, 0.f}, (f32x4){0.f, 0.f, 0.f, 0.f}, (f32x4){0.f, 0.f, 0.f, 0.f}};
    Pend pend; int ppn = 0, pnv = 0, pq = 8, pbuf = 0;
    if constexpr (DEFER) {
#pragma unroll
        for (int q = 0; q < 8; ++q) pend.val[q] = (u32x2){0u, 0u}; }
#define PG8_PSTORE() do { if constexpr (DEFER) { const int _l3 = lane_id_volatile(); const int _nv = (pq < 8) ? pnv : 0; \
        E.store_one(pend.val[0], ibuf + pbuf * 256, ((pq >> 2) & 1) * HALF + (pq & 3) * 16 + wr * 64 + (_l3 & 15), _nv, ppn * HALF + wc * 32 + 8 * (_l3 >> 4)); \
        _Pragma("unroll") for (int _q = 0; _q < 7; ++_q) pend.val[_q] = pend.val[_q + 1]; ++pq; } } while (0)
    if constexpr (GATHER) { PG8_IDMA(cur, 0); PG8_WAIT_V(0); PG8_BAR; }
    PG8_GOFF(gA, cur, 0);
    const char* cA = S.a_base(cur); const char* cB = S.b_base(cur);
    PG8_STAGE(PG8_SB(0, 0), cB, voffB); PG8_STAGE(PG8_SB(0, 1), cB + hstep, voffB); PG8_STAGE_A(PG8_SA(0, 0), cA, 0, gA); PG8_STAGE_A(PG8_SA(0, 1), cA, 1, gA);
    if (wr == 1) PG8_BAR;
    PG8_WAIT_V(2); PG8_BAR;
    PG8_STAGE(PG8_SB(1, 0), cB + kstep, voffB); PG8_STAGE_A(PG8_SA(1, 0), cA + kstep, 0, gA); PG8_STAGE(PG8_SB(1, 1), cB + hstep + kstep, voffB);
    PG8_WAIT_V(6); PG8_BAR;
    for (;;) {
        const bool has_next = S.next(ui + 1, nxt);
        const char* nA = has_next ? S.a_base(nxt) : cA; const char* nB = has_next ? S.b_base(nxt) : cB;
        const int bnxt = (bsel == 2) ? 0 : bsel + 1;
        if constexpr (GATHER) { if (has_next) PG8_IDMA(nxt, bnxt); }
        for (int t = 0; t < nt; t += 2) {
            const bool last = (t == nt - 2);
            const char* a1 = cA + (size_t)(t + 1) * kstep;
            const char* a2 = last ? nA : cA + (size_t)(t + 2) * kstep; const char* b2 = last ? nB : cB + (size_t)(t + 2) * kstep;
            const char* a3 = a2 + kstep; const char* b3 = b2 + kstep;
            if constexpr (GATHER) { if (last && has_next) { PG8_GOFF(gN, nxt, bnxt); } }
            if constexpr (Epi::HAS_BIAS) { if (last) E.load_bias(cur, wc, lane_id_volatile() >> 4, bpre); }
            PG8_LDB(B0, 0, 0); PG8_LDB(B1, 0, 1); PG8_SCHED; PG8_LDA(At, 0, 0); PG8_STAGE_A(PG8_SA(1, 1), a1, 1, gA);
            if constexpr (GATHER) { if (last && has_next) { gA[0][0] = gN[0][0]; gA[0][1] = gN[0][1]; gA[1][0] = gN[1][0]; gA[1][1] = gN[1][1]; } }
            PG8_WAIT_V(8); PG8_WAIT_L(0); PG8_BAR; PG8_MMA(0, 0, At, B0); PG8_MMA(0, 1, At, B1); PG8_BAR; PG8_SCHED;
            PG8_LDA(At, 0, 1); PG8_STAGE(PG8_SB(0, 0), b2, voffB); PG8_STAGE(PG8_SB(0, 1), b2 + hstep, voffB); PG8_STAGE_A(PG8_SA(0, 0), a2, 0, gA);
            PG8_WAIT_V(8); PG8_WAIT_L(0); PG8_BAR; PG8_MMA(1, 0, At, B0); PG8_MMA(1, 1, At, B1); PG8_BAR; PG8_SCHED;
            PG8_PSTORE();
            PG8_LDB(B0, 1, 0); PG8_LDB(B1, 1, 1); PG8_SCHED; PG8_LDA(At, 1, 0); PG8_STAGE_A(PG8_SA(0, 1), a2, 1, gA);
            PG8_WAIT_V(8); PG8_WAIT_L(0); PG8_BAR; PG8_MMA(0, 0, At, B0); PG8_MMA(0, 1, At, B1); PG8_BAR; PG8_SCHED;
            PG8_LDA(At, 1, 1); PG8_STAGE(PG8_SB(1, 0), b3, voffB); PG8_STAGE(PG8_SB(1, 1), b3 + hstep, voffB); PG8_STAGE_A(PG8_SA(1, 0), a3, 0, gA);
            PG8_WAIT_V(8); PG8_WAIT_L(0); PG8_BAR; PG8_MMA(1, 0, At, B0); PG8_MMA(1, 1, At, B1); PG8_BAR; PG8_SCHED;
            PG8_PSTORE();
        }
        if (ALIGN_EPI) { if (wr == 0) PG8_BAR; }
        { const int l2 = lane_id_volatile(), fr2 = l2 & 15, fq2 = l2 >> 4;
          if constexpr (DEFER) { _Pragma("unroll") for (int _f = 0; _f < 8; ++_f) PG8_PSTORE();
              E.prepare(acc, cur, wr, wc, fr2, fq2, pend); ppn = cur.pn; pnv = S.nvalid(cur); pq = 0; pbuf = bsel; }
          else if constexpr (GATHER) E(acc, cur, wr, wc, fr2, fq2, ibuf + bsel * 256, S.nvalid(cur), bpre); else E(acc, cur, wr, wc, fr2, fq2); }
        if (!has_next) break;
#pragma unroll
        for (int a = 0; a < 2; ++a)
#pragma unroll
            for (int b = 0; b < 2; ++b)
#pragma unroll
                for (int m = 0; m < 4; ++m)
#pragma unroll
                    for (int n = 0; n < 2; ++n) acc[a][b][m][n] = (f32x4){0.f, 0.f, 0.f, 0.f};
        cur = nxt; cA = nA; cB = nB; ++ui; bsel = bnxt;
        if (ALIGN_EPI) { if (wr == 1) PG8_BAR; }
    }
    if constexpr (DEFER) { _Pragma("unroll") for (int _f = 0; _f < 8; ++_f) PG8_PSTORE(); }
    PG8_WAIT_V(0);
    if (!ALIGN_EPI) { if (wr == 0) PG8_BAR; }
    PG8_BAR;
#undef PG8_PSTORE
#undef PG8_SA
#undef PG8_SB
#undef PG8_STAGE
#undef PG8_STAGE_A
#undef PG8_LDA
#undef PG8_LDB
#undef PG8_MMA
#undef PG8_WAIT_V
#undef PG8_WAIT_L
#undef PG8_BAR
#undef PG8_SCHED
#undef PG8_GOFF
#undef PG8_IDMA
}
}

namespace attn_body {
using bf16=__hip_bfloat16;
using bf16x8=__attribute__((ext_vector_type(8)))short;
using s16x4=__attribute__((ext_vector_type(4)))short;
using f32x16=__attribute__((ext_vector_type(16)))float;
using u32x4=__attribute__((ext_vector_type(4)))unsigned;
constexpr int D=64;
constexpr int NW=8,QBLK=32,QB=QBLK*NW,KVBLK=64;
constexpr int ATTN_UNIT_ROWS=QB;
__device__ __forceinline__ int crow(int r,int hi){return (r&3)+8*(r>>2)+4*hi;}
#define SBAR() __builtin_amdgcn_sched_barrier(0)
__device__ __forceinline__ void cmask(f32x16&p0,f32x16&p1,int jb,int qrel,int hi){
  const float NEG=-INFINITY; int kb=64*jb+4*hi;
  #pragma unroll
  for(int r=0;r<16;++r){int kv=kb+(r&3)+8*(r>>2); if(kv>qrel)p0[r]=NEG; if(kv+32>qrel)p1[r]=NEG;}
}

constexpr int NSLOT=3, SLOTB=8192;
constexpr int LDS_K=0, LDS_V=NSLOT*SLOTB, LDS_WS=2*NSLOT*SLOTB, LDS_OST=LDS_WS+NW*64*4, LDS_BYTES=LDS_OST+NW*4096;
constexpr float C2=0.125f*1.4426950408889634f;
__device__ __forceinline__ void glds16(const void*gsrc,unsigned lds_dst){unsigned keep;
  asm volatile("s_mov_b32 %0, m0\n\ts_mov_b32 m0, %2\n\ts_nop 0\n\tglobal_load_lds_dwordx4 %1, off\n\ts_mov_b32 m0, %0":"=&s"(keep):"v"(gsrc),"s"(lds_dst):"memory");}
__device__ __forceinline__ float max3f(float a,float b,float c){float r;asm("v_max3_f32 %0, %1, %2, %3":"=v"(r):"v"(a),"v"(b),"v"(c));return r;}
__device__ __forceinline__ float max2f(float a,float b){float r;asm("v_max_f32_e32 %0, %1, %2":"=v"(r):"v"(a),"v"(b));return r;}
__device__ __forceinline__ float fadd_s(float a,float b){float r;asm("v_add_f32_e32 %0, %1, %2":"=v"(r):"v"(a),"v"(b));return r;}
__device__ __forceinline__ float fsub_s(float a,float b){float r;asm("v_sub_f32_e32 %0, %1, %2":"=v"(r):"v"(a),"v"(b));return r;}
typedef float f32x2_t __attribute__((ext_vector_type(2))); typedef __bf16 bf16x2_t __attribute__((ext_vector_type(2)));
__device__ __forceinline__ unsigned cvtpk_s(float lo,float hi){f32x2_t v={lo,hi};bf16x2_t b=__builtin_convertvector(v,bf16x2_t);return __builtin_bit_cast(unsigned,b);}
#define WAIT_BAR(N) asm volatile("s_waitcnt vmcnt(" #N ") lgkmcnt(0)\n\ts_barrier":::"memory")

__device__ __forceinline__ void qkt(f32x16&p0,f32x16&p1,const char*Kslot,const bf16x8*qr,const f32x16&negm,int r32,int hi){
  const char*kb=Kslot+hi*1024+r32*16;
  #pragma unroll
  for(int d0=0;d0<4;++d0){
    const bf16x8 b0=*reinterpret_cast<const bf16x8*>(kb+d0*2048);
    const bf16x8 b1=*reinterpret_cast<const bf16x8*>(kb+d0*2048+512);
    if(d0==0){p0=__builtin_amdgcn_mfma_f32_32x32x16_bf16(b0,qr[0],negm,0,0,0);p1=__builtin_amdgcn_mfma_f32_32x32x16_bf16(b1,qr[0],negm,0,0,0);}
    else{p0=__builtin_amdgcn_mfma_f32_32x32x16_bf16(b0,qr[d0],p0,0,0,0);p1=__builtin_amdgcn_mfma_f32_32x32x16_bf16(b1,qr[d0],p1,0,0,0);}}
}
typedef __attribute__((address_space(3))) const char* lds_cptr;
typedef short v4i16_t __attribute__((ext_vector_type(4)));
__device__ __forceinline__ void kload8(bf16x8*kf,lds_cptr kp){
  kf[0]=*(const __attribute__((address_space(3))) bf16x8*)(kp);      kf[1]=*(const __attribute__((address_space(3))) bf16x8*)(kp+512);
  kf[2]=*(const __attribute__((address_space(3))) bf16x8*)(kp+2048); kf[3]=*(const __attribute__((address_space(3))) bf16x8*)(kp+2560);
  kf[4]=*(const __attribute__((address_space(3))) bf16x8*)(kp+4096); kf[5]=*(const __attribute__((address_space(3))) bf16x8*)(kp+4608);
  kf[6]=*(const __attribute__((address_space(3))) bf16x8*)(kp+6144); kf[7]=*(const __attribute__((address_space(3))) bf16x8*)(kp+6656);
}
__device__ __forceinline__ void kload2(bf16x8*kf,lds_cptr kp,int j){ kf[2*j]=*(const __attribute__((address_space(3))) bf16x8*)(kp+j*2048); kf[2*j+1]=*(const __attribute__((address_space(3))) bf16x8*)(kp+j*2048+512); }
__device__ __forceinline__ s16x4 vtr(lds_cptr p){ return __builtin_bit_cast(s16x4,__builtin_amdgcn_ds_read_tr16_b64_v4i16((__attribute__((address_space(3))) v4i16_t*)p)); }
__device__ __forceinline__ float rowmax(const f32x16&p0,const f32x16&p1){
  float a=max3f(p0[0],p0[1],p1[0]),b=max3f(p0[2],p0[3],p1[1]);a=max3f(a,p1[2],p1[3]);
  #pragma unroll
  for(int r=4;r<16;r+=4){a=max3f(a,p0[r],p0[r+1]);b=max3f(b,p0[r+2],p0[r+3]);a=max3f(a,p1[r],p1[r+1]);b=max3f(b,p1[r+2],p1[r+3]);}
  const float m=max2f(a,b);
  auto rr=__builtin_amdgcn_permlane32_swap(__float_as_uint(m),__float_as_uint(m),false,false);
  return max2f(__uint_as_float(rr[0]),__uint_as_float(rr[1]));
}
__device__ __forceinline__ void pv(f32x16*o,int vb,bf16x8 pa0,bf16x8 pa1,bf16x8 pa2,bf16x8 pa3){
  #pragma unroll
  for(int d0=0;d0<2;++d0){s16x4 lo[4],hi[4];
    #pragma unroll
    for(int ks=0;ks<4;++ks){
      asm volatile("ds_read_b64_tr_b16 %0,%1 offset:%c2":"=&v"(lo[ks]):"v"(vb),"i"(d0*4096+ks*1024):"memory");
      asm volatile("ds_read_b64_tr_b16 %0,%1 offset:%c2":"=&v"(hi[ks]):"v"(vb),"i"(d0*4096+ks*1024+512):"memory");}
    asm volatile("s_waitcnt lgkmcnt(0)":::"memory");SBAR();
    #define PK(k) (bf16x8){lo[k][0],lo[k][1],lo[k][2],lo[k][3],hi[k][0],hi[k][1],hi[k][2],hi[k][3]}
    o[d0]=__builtin_amdgcn_mfma_f32_32x32x16_bf16(pa0,PK(0),o[d0],0,0,0);
    o[d0]=__builtin_amdgcn_mfma_f32_32x32x16_bf16(pa1,PK(1),o[d0],0,0,0);
    o[d0]=__builtin_amdgcn_mfma_f32_32x32x16_bf16(pa2,PK(2),o[d0],0,0,0);
    o[d0]=__builtin_amdgcn_mfma_f32_32x32x16_bf16(pa3,PK(3),o[d0],0,0,0);
    #undef PK
  }
}

#ifndef ATTN_STORE16
#define ATTN_STORE16(p,v) (*(u32x4*)(p)=(v))
#endif
template<int THRL, bool O8 = false> __device__ __forceinline__ void attn_unit(const bf16*Qu,const bf16*__restrict__ Kh,const bf16*__restrict__ Vh,bf16*Ou,const int QP,const int KP,const int VP,const int OP,const int NT,char*shm,const int tid){
  const int lane=tid&63,r32=lane&31,hi=lane>>5; const int wid=__builtin_amdgcn_readfirstlane(tid>>6);
  const bf16*Qw=Qu+(long)(wid*QBLK)*QP;
  const unsigned lds0=(unsigned)(uintptr_t)shm;
  float*wsf=(float*)(shm+LDS_WS)+wid*64;
  const bf16*ksrc=Kh+(long)lane*KP+wid*8;
  const bf16*vsrc=Vh+(long)(16*(wid&3)+(lane>>2))*VP+(wid>>2)*32+(lane&3)*8;
  const unsigned kdst=lds0+LDS_K+wid*1024, vdst=lds0+LDS_V+wid*1024;
  #define DMA_K(t,slot) glds16(ksrc+(long)(t)*KVBLK*KP,(unsigned)__builtin_amdgcn_readfirstlane(kdst+(slot)))
  #define DMA_V(t,slot) glds16(vsrc+(long)(t)*KVBLK*VP,(unsigned)__builtin_amdgcn_readfirstlane(vdst+(slot)))
  const int vb0=(int)(lds0+LDS_V)+((lane>>4)&1)*32+(lane&3)*8+(4*hi+((lane&15)>>2))*64;
  const char*Kbase=shm+LDS_K; bf16x8 kf[8];
  const lds_cptr shm3=(lds_cptr)shm; const lds_cptr kp0=shm3+LDS_K+hi*1024+r32*16; const lds_cptr vp0=shm3+LDS_V+((lane>>4)&1)*32+(lane&3)*8+(4*hi+((lane&15)>>2))*64;
  DMA_K(0,0);DMA_V(0,0);DMA_K(1,SLOTB);
  bf16x8 qr[4];
  #pragma unroll
  for(int d0=0;d0<4;++d0)qr[d0]=*reinterpret_cast<const bf16x8*>(&Qw[(long)r32*QP+d0*16+hi*8]);
  float mhat=0.f,l_reg=0.f;f32x16 o[2];f32x16 negm; { float z_=0.f; asm volatile("":"+v"(z_)); _Pragma("unroll") for(int r=0;r<16;++r){o[0][r]=z_;o[1][r]=z_;negm[r]=z_;} } asm volatile("":"+v"(negm));
  #define CMASK(P0,P1,t) do{}while(0)
  bool resc=false;
  #define START(P0,P1) do{ const float rm=rowmax(P0,P1); resc=false; \
    { const float dl=rm; mhat=fadd_s(mhat,dl); \
      _Pragma("unroll") for(int r=0;r<16;++r){P0[r]=fsub_s(P0[r],dl);P1[r]=fsub_s(P1[r],dl);} \
      _Pragma("unroll") for(int r=0;r<16;++r)negm[r]=-mhat; asm volatile("":"+v"(negm)); } \
    _Pragma("unroll") for(int r=0;r<16;++r)P0[r]=__builtin_amdgcn_exp2f(P0[r]); }while(0)
  #define RESC() do{ if(resc){ asm volatile("s_waitcnt lgkmcnt(0)":::"memory"); \
      _Pragma("unroll") for(int d_=0;d_<2;++d_) _Pragma("unroll") for(int r=0;r<16;++r)o[d_][r]*=wsf[crow(r,hi)]; } }while(0)
  f32x16 pA0,pA1,pB0,pB1;
  int sl_prev=0,sl_cur=0,sl_next=SLOTB;
  #define ROT() do{sl_prev=sl_cur;sl_cur=sl_next;sl_next=(sl_next==(NSLOT-1)*SLOTB)?0:sl_next+SLOTB;}while(0)
  DMA_K(2,2*SLOTB);
  WAIT_BAR(3);
  qkt(pA0,pA1,Kbase,qr,negm,r32,hi);asm volatile("s_nop 15\n\ts_nop 7":"+v"(pA0),"+v"(pA1));CMASK(pA0,pA1,0);
  START(pA0,pA1);
  _Pragma("unroll") for(int r=0;r<16;++r)pA1[r]=__builtin_amdgcn_exp2f(pA1[r]);
  WAIT_BAR(0);
  DMA_K(3,0);DMA_V(1,SLOTB);
  ROT();
  kload8(kf,kp0+sl_cur);
  WAIT_BAR(2);
  s16x4 vlo[8],vhi[8]; u32x4 pw0,pw1,pw2,pw3;
  #define PKW(P,B) cvtpk_s(P[B],P[B+1])
  #define PAF(k) __builtin_bit_cast(bf16x8,pw##k)
  #define VFR(i) (bf16x8){vlo[i][0],vlo[i][1],vlo[i][2],vlo[i][3],vhi[i][0],vhi[i][1],vhi[i][2],vhi[i][3]}
  #define PIN(x) asm volatile("":"+v"(x))
  #define MX3(a,b,c) __builtin_fmaxf(__builtin_fmaxf((a),(b)),(c))
  #define GAPA(MF,A0,A1,A2,A3,W0,W1,PW) do{ MF; sacc+=A0; sacc+=A1; sacc+=A2; sacc+=A3; PIN(sacc); W0; W1; PIN(PW); SBAR(); }while(0)
  #define EX(v) __builtin_amdgcn_exp2f(v)
  #define GAPB(MF,X,B) do{ MF; X[B]=EX(X[B]); X[B+1]=EX(X[B+1]); X[B+2]=EX(X[B+2]); X[B+3]=EX(X[B+3]); PIN(X); SBAR(); }while(0)
  #define VRD(i) do{ vlo[i]=vtr(vp_+(((i)>>2)*4096+((i)&3)*1024)); vhi[i]=vtr(vp_+(((i)>>2)*4096+((i)&3)*1024+512)); }while(0)
  #define KRD(G,j) do{ if(G){ kload2(kf,kp0+sl_next,j); SBAR(); } }while(0)
  #define STEP(C0,C1,P0,P1,t,GK,GV,GL) do{ SBAR(); \
    const lds_cptr vp_=vp0+sl_prev; \
    VRD(0); SBAR(); float sacc=(P0[0]+P0[1]); \
    GAPA(C0=__builtin_amdgcn_mfma_f32_32x32x16_bf16(kf[0],qr[0],negm,0,0,0), P0[2],P0[3],P0[4],P0[5],     pw0[0]=PKW(P0,0), pw0[1]=PKW(P0,2), pw0); \
    VRD(4); SBAR(); GAPA(C1=__builtin_amdgcn_mfma_f32_32x32x16_bf16(kf[1],qr[0],negm,0,0,0), P0[6],P0[7],P0[8],P0[9],     pw0[2]=PKW(P0,4), pw0[3]=PKW(P0,6), pw0); \
    VRD(1); SBAR(); GAPA(C0=__builtin_amdgcn_mfma_f32_32x32x16_bf16(kf[2],qr[1],C0,0,0,0),   P0[10],P0[11],P0[12],P0[13], pw1[0]=PKW(P0,8), pw1[1]=PKW(P0,10), pw1); \
    VRD(5); SBAR(); GAPA(C1=__builtin_amdgcn_mfma_f32_32x32x16_bf16(kf[3],qr[1],C1,0,0,0),   P0[14],P0[15],P1[0],P1[1],   pw1[2]=PKW(P0,12),pw1[3]=PKW(P0,14), pw1); \
    VRD(2); SBAR(); GAPA(C0=__builtin_amdgcn_mfma_f32_32x32x16_bf16(kf[4],qr[2],C0,0,0,0),   P1[2],P1[3],P1[4],P1[5],     pw2[0]=PKW(P1,0), pw2[1]=PKW(P1,2), pw2); \
    VRD(6); SBAR(); GAPA(C1=__builtin_amdgcn_mfma_f32_32x32x16_bf16(kf[5],qr[2],C1,0,0,0),   P1[6],P1[7],P1[8],P1[9],     pw2[2]=PKW(P1,4), pw2[3]=PKW(P1,6), pw2); \
    VRD(3); SBAR(); GAPA(C0=__builtin_amdgcn_mfma_f32_32x32x16_bf16(kf[6],qr[3],C0,0,0,0),   P1[10],P1[11],P1[12],P1[13], pw3[0]=PKW(P1,8), pw3[1]=PKW(P1,10), pw3); \
    VRD(7); SBAR(); GAPA(C1=__builtin_amdgcn_mfma_f32_32x32x16_bf16(kf[7],qr[3],C1,0,0,0),   P1[14],P1[15],0.f,0.f,       pw3[2]=PKW(P1,12),pw3[3]=PKW(P1,14), pw3); \
    l_reg+=sacc; \
    if(GK){DMA_K((t)+3,sl_cur);} if(GV){DMA_V((t)+1,sl_next);} \
    CMASK(C0,C1,t); \
    { float a=MX3(C0[0],C0[1],C1[0]),b=MX3(C0[2],C0[3],C1[1]); a=MX3(a,C1[2],C1[3]); \
      _Pragma("unroll") for(int r=4;r<16;r+=4){a=MX3(a,C0[r],C0[r+1]);b=MX3(b,C0[r+2],C0[r+3]);a=MX3(a,C1[r],C1[r+1]);b=MX3(b,C1[r+2],C1[r+3]);} \
      float rm=__builtin_fmaxf(a,b); { auto rr=__builtin_amdgcn_permlane32_swap(__float_as_uint(rm),__float_as_uint(rm),false,false); rm=__builtin_fmaxf(__uint_as_float(rr[0]),__uint_as_float(rr[1])); } \
      resc=false; \
      if(__builtin_expect(__any(rm>(float)THRL),0)){ const float dl=__builtin_fmaxf(rm,0.f); mhat+=dl; \
        _Pragma("unroll") for(int r=0;r<16;++r){C0[r]-=dl;C1[r]-=dl;} \
        _Pragma("unroll") for(int r=0;r<16;++r)negm[r]=-mhat; asm volatile("":"+v"(negm)); \
        const float f=__builtin_amdgcn_exp2f(-dl); l_reg*=f; if(hi==0)wsf[r32]=f; resc=true; } } \
    SBAR(); \
    GAPB(o[0]=__builtin_amdgcn_mfma_f32_32x32x16_bf16(PAF(0),VFR(0),o[0],0,0,0), C0,0); \
    GAPB(o[1]=__builtin_amdgcn_mfma_f32_32x32x16_bf16(PAF(0),VFR(4),o[1],0,0,0), C0,4); \
    KRD(GL,0); GAPB(o[0]=__builtin_amdgcn_mfma_f32_32x32x16_bf16(PAF(1),VFR(1),o[0],0,0,0), C0,8); \
    KRD(GL,1); GAPB(o[1]=__builtin_amdgcn_mfma_f32_32x32x16_bf16(PAF(1),VFR(5),o[1],0,0,0), C0,12); \
    KRD(GL,2); GAPB(o[0]=__builtin_amdgcn_mfma_f32_32x32x16_bf16(PAF(2),VFR(2),o[0],0,0,0), C1,0); \
    KRD(GL,3); GAPB(o[1]=__builtin_amdgcn_mfma_f32_32x32x16_bf16(PAF(2),VFR(6),o[1],0,0,0), C1,4); \
    GAPB(o[0]=__builtin_amdgcn_mfma_f32_32x32x16_bf16(PAF(3),VFR(3),o[0],0,0,0), C1,8); \
    GAPB(o[1]=__builtin_amdgcn_mfma_f32_32x32x16_bf16(PAF(3),VFR(7),o[1],0,0,0), C1,12); \
    }while(0)
  int t=1;
  #undef CMASK
  #define CMASK(P0,P1,t) do{}while(0)
  for(;t+5<NT;t+=2){
    STEP(pB0,pB1,pA0,pA1,t,true,true,true);     WAIT_BAR(2); RESC(); ROT();
    STEP(pA0,pA1,pB0,pB1,t+1,true,true,true);   WAIT_BAR(2); RESC(); ROT();
  }
  #undef CMASK
  #define CMASK(P0,P1,t) do{}while(0)
  #define ENDW(tt) do{ if((tt)+3<NT){WAIT_BAR(2);} else if((tt)+2<NT){WAIT_BAR(1);} else {WAIT_BAR(0);} }while(0)
  for(;t+1<NT;t+=2){
    STEP(pB0,pB1,pA0,pA1,t,(t+3<NT),(t+1<NT),(t+1<NT));       ENDW(t);   RESC(); ROT();
    STEP(pA0,pA1,pB0,pB1,t+1,(t+4<NT),(t+2<NT),(t+2<NT));     ENDW(t+1); RESC(); ROT();
  }
  STEP(pB0,pB1,pA0,pA1,NT-1,false,false,false); RESC();
  { float sacc=pB0[0]+pB0[1]; _Pragma("unroll") for(int r=2;r<16;++r)sacc+=pB0[r]; _Pragma("unroll") for(int r=0;r<16;++r)sacc+=pB1[r]; l_reg+=sacc;
    pw0=(u32x4){PKW(pB0,0),PKW(pB0,2),PKW(pB0,4),PKW(pB0,6)};pw1=(u32x4){PKW(pB0,8),PKW(pB0,10),PKW(pB0,12),PKW(pB0,14)};pw2=(u32x4){PKW(pB1,0),PKW(pB1,2),PKW(pB1,4),PKW(pB1,6)};pw3=(u32x4){PKW(pB1,8),PKW(pB1,10),PKW(pB1,12),PKW(pB1,14)};
    SBAR(); pv(o,vb0+sl_cur,PAF(0),PAF(1),PAF(2),PAF(3)); }
  #undef PKW
  #undef PAF
  #undef VFR
  #undef PIN
  #undef MX3
  #undef GAPA
  #undef GAPB
  #undef EX
  #undef VRD
  #undef KRD
  #undef STEP
  #undef ENDW
  {auto rr=__builtin_amdgcn_permlane32_swap(__float_as_uint(l_reg),__float_as_uint(l_reg),false,false);l_reg=__uint_as_float(rr[0])+__uint_as_float(rr[1]);}
  if(hi==0)wsf[32+r32]=l_reg;asm volatile("s_waitcnt lgkmcnt(0)":::"memory");
  float rli[16];
  #pragma unroll
  for(int r=0;r<16;++r)rli[r]=__builtin_amdgcn_rcpf(wsf[32+crow(r,hi)]);
  if constexpr (O8) {
    unsigned char*Ow8=(unsigned char*)Ou+(long)(wid*QBLK)*OP; unsigned char*stg8=(unsigned char*)(shm+LDS_OST)+wid*2048;
    #pragma unroll
    for(int r=0;r<16;++r){const int orow=crow(r,hi);
      #pragma unroll
      for(int d0=0;d0<2;++d0)stg8[orow*64+d0*32+r32]=f2fp8(o[d0][r]*rli[r]);}
    asm volatile("s_waitcnt lgkmcnt(0)":::"memory");
    #pragma unroll
    for(int i=0;i<2;++i){const int row=i*16+(lane>>2),ch=lane&3; const u32x4 v=*(const u32x4*)(stg8+row*64+ch*16); ATTN_STORE16(Ow8+(long)row*OP+ch*16,v);}
  } else {
  bf16*Ow=Ou+(long)(wid*QBLK)*OP;
  { bf16*stg=(bf16*)(shm+LDS_OST)+wid*2048;
    #pragma unroll
    for(int r=0;r<16;++r){const int orow=crow(r,hi);
      #pragma unroll
      for(int d0=0;d0<2;++d0)stg[orow*64+d0*32+r32]=__float2bfloat16(o[d0][r]*rli[r]);}
    asm volatile("s_waitcnt lgkmcnt(0)":::"memory");
    #pragma unroll
    for(int i=0;i<4;++i){const int row=i*8+(lane>>3),ch=lane&7; const u32x4 v=*(const u32x4*)(stg+row*64+ch*8); ATTN_STORE16(Ow+(long)row*OP+ch*8,v);} }
  }
  asm volatile("s_waitcnt lgkmcnt(0)\n\ts_barrier":::"memory");
  #undef DMA_K
  #undef DMA_V
  #undef CMASK
  #undef START
  #undef RESC
  #undef ROT
}
constexpr int ATTN_LDS_BYTES=LDS_BYTES;
#undef SBAR
#undef WAIT_BAR
}

struct Args { const float* in[32]; float* out; unsigned char* ws; int ph_lo, ph_hi; };
struct Ctx {
    LAS unsigned char* lds;
    int vcu, G;
    unsigned char* ws;
};
constexpr int PTAB_OFF = MISC_OFF + 256;
__device__ __forceinline__ unsigned long long ptab_get(const Ctx& cx, int k) {
    const LAS unsigned* t = (const LAS unsigned*)(cx.lds + PTAB_OFF) + 2 * k; const unsigned lo = __builtin_amdgcn_readfirstlane(t[0]), hi = __builtin_amdgcn_readfirstlane(t[1]);
    return ((unsigned long long)hi << 32) | lo;
}
#define INP(k) ((const float*)(GAS const float*)ptab_get(cx, (k)))

template <bool F8> __device__ __forceinline__ void p0_transpose64(const float* W, int N, int KB, unsigned char* WT, int k0, int n0, int dst_row0, float scale, LAS float* scr, int lane) {
    f32x4 v[16];
    const float* src = W + (size_t)(k0 + (lane >> 4)) * N + n0 + (lane & 15) * 4;
#pragma unroll
    for (int i = 0; i < 16; ++i) v[i] = *(const f32x4*)(src + (size_t)(4 * i) * N);
#pragma unroll
    for (int i = 0; i < 16; ++i) { LAS float* p = scr + (4 * i + (lane >> 4)) * 65 + (lane & 15) * 4; p[0] = v[i][0]; p[1] = v[i][1]; p[2] = v[i][2]; p[3] = v[i][3]; }
    LDS_WAIT(); asm volatile("" ::: "memory");
    if constexpr (!F8) {
        const int ns = lane >> 3, ch = lane & 7;
#pragma unroll
        for (int r8 = 0; r8 < 8; ++r8) { const int n = r8 * 8 + ns; const LAS float* s = scr + (8 * ch) * 65 + n;
            u32x4 o; o.x = pk2(s[0 * 65], s[1 * 65]); o.y = pk2(s[2 * 65], s[3 * 65]); o.z = pk2(s[4 * 65], s[5 * 65]); o.w = pk2(s[6 * 65], s[7 * 65]);
            *(GAS u32x4*)(WT + (size_t)(dst_row0 + n) * KB + (k0 + 8 * ch) * 2) = o; }
    } else {
        const int ns = lane >> 2, ch = lane & 3;
#pragma unroll
        for (int r4 = 0; r4 < 4; ++r4) { const int n = r4 * 16 + ns; const LAS float* s = scr + (16 * ch) * 65 + n; unsigned w[4];
#pragma unroll
            for (int q = 0; q < 4; ++q) { int r = 0; r = __builtin_amdgcn_cvt_pk_fp8_f32(s[(4 * q) * 65] * scale, s[(4 * q + 1) * 65] * scale, r, false); r = __builtin_amdgcn_cvt_pk_fp8_f32(s[(4 * q + 2) * 65] * scale, s[(4 * q + 3) * 65] * scale, r, true); w[q] = (unsigned)r; }
            *(GAS u32x4*)(WT + (size_t)(dst_row0 + n) * KB + k0 + 16 * ch) = (u32x4){w[0], w[1], w[2], w[3]}; }
    }
    LDS_WAIT(); asm volatile("" ::: "memory");
}
__device__ __forceinline__ void p0_prologue(const Ctx& cx, const int tid) {
    const int lane = tid & 63, wave = __builtin_amdgcn_readfirstlane(tid >> 6);
    LAS float* scr = (LAS float*)(cx.lds + wave * 16896);
    const int gw = cx.vcu * 8 + wave, NGW = cx.G * 8;
    constexpr int I_WIN0 = 16 * 40, I_WIN1 = 16 * 24, I_WKV = 16 * 8, I_WOUT = 16 * 16, I_W1 = 16 * 32, I_W2 = 16 * 16;
    constexpr int T_WIN = 3 * I_WIN0 + I_WIN1, T_WKV = 4 * I_WKV, T_WOUT = 4 * I_WOUT, T_W1 = 128 * I_W1, T_W2 = 128 * I_W2;
    constexpr int NITEMS = T_WIN + T_WKV + T_WOUT + T_W1 + T_W2;
    for (int it = gw; it < NITEMS; it += NGW) {
        int r = it;
        const float* W; unsigned char* WT; int N, nb, kb, dst_row0; bool isout = false;
        if (r < T_W1) {
            const int mi = r / I_W1, q = r % I_W1; N = 2048; kb = q / 32; nb = q % 32;
            W = INP(28) + (size_t)mi * 1024 * 2048; WT = cx.ws + WS_W1 + (size_t)mi * 2048 * 1024 * MOE_EB;
            const int n0 = nb * 64, isu = n0 >= 1024, j = n0 - isu * 1024;
            dst_row0 = (j >> 7) * 256 + isu * 128 + (j & 127);
            p0_transpose64<MOE_F8>(W, N, 1024 * MOE_EB, WT, kb * 64, nb * 64, dst_row0, W1_SCALE, scr, lane); continue;
        } else if ((r -= T_W1) < T_W2) {
            const int mi = r / I_W2, q = r % I_W2; N = 1024; kb = q / 16; nb = q % 16;
            W = INP(30) + (size_t)mi * 1024 * 1024; WT = cx.ws + WS_W2 + (size_t)mi * 1024 * 1024 * MOE_EB; dst_row0 = nb * 64;
            p0_transpose64<MOE_F8>(W, N, 1024 * MOE_EB, WT, kb * 64, nb * 64, dst_row0, W2_SCALE, scr, lane); continue;
        } else if ((r -= T_W2) < T_WIN) {
            int l, q;
            if (r < I_WIN0) { l = 0; q = r; } else if (r < I_WIN0 + I_WIN1) { l = 1; q = r - I_WIN0; } else if (r < 2 * I_WIN0 + I_WIN1) { l = 2; q = r - I_WIN0 - I_WIN1; } else { l = 3; q = r - 2 * I_WIN0 - I_WIN1; }
            N = in_width(l); const int nbn = N / 64; kb = q / nbn; nb = q % nbn;
            const int kind = layer_kind(l), j = layer_j(l);
            W = (kind == 0 ? INP(2) : kind == 1 ? INP(4) : INP(7)) + (size_t)j * 1024 * N;
            WT = cx.ws + WS_WIN + (size_t)l * 5 * MiB; dst_row0 = nb * 64;
        } else if ((r -= T_WIN) < T_WKV) {
            const int l = r / I_WKV, q = r % I_WKV; N = 512; kb = q / 8; nb = q % 8;
            W = INP(20) + (size_t)l * 1024 * 512; WT = cx.ws + WS_WKV; dst_row0 = l * 512 + nb * 64;
        } else {
            r -= T_WKV; const int l = r / I_WOUT, q = r % I_WOUT; N = 1024; kb = q / 16; nb = q % 16;
            W = INP(21) + (size_t)l * 1024 * 1024; WT = cx.ws + WS_WOUT + (size_t)l * 2 * MiB; dst_row0 = nb * 64; isout = true;
        }
        if (isout) p0_transpose64<OUTP_F8 != 0>(W, N, 1024 * OUT_EB, WT, kb * 64, nb * 64, dst_row0, OUTP_F8 ? WOUT_SCALE : 1.0f, scr, lane);
        else p0_transpose64<INP_F8 != 0>(W, N, 1024 * INP_EB, WT, kb * 64, nb * 64, dst_row0, INP_F8 ? WIN_SCALE : 1.0f, scr, lane);
    }
    {
        const size_t gt = (size_t)cx.vcu * 512 + tid, NT_ = (size_t)cx.G * 512;
        for (int which = 0; which < 2; ++which) {
            const f32x4* xs = (const f32x4*)(which == 0 ? INP(0) : INP(1)); unsigned char* xd = cx.ws + (which == 0 ? WS_XB : WS_MEMB); const size_t n8 = (size_t)(which == 0 ? NTOK : NMEM) * DM / 8;
#pragma unroll 4
            for (size_t i = gt; i < n8; i += NT_) { const f32x4 a = xs[2 * i], b = xs[2 * i + 1];
                if constexpr (INP_F8) { int w0 = 0, w1 = 0; w0 = __builtin_amdgcn_cvt_pk_fp8_f32(a[0], a[1], w0, false); w0 = __builtin_amdgcn_cvt_pk_fp8_f32(a[2], a[3], w0, true); w1 = __builtin_amdgcn_cvt_pk_fp8_f32(b[0], b[1], w1, false); w1 = __builtin_amdgcn_cvt_pk_fp8_f32(b[2], b[3], w1, true);
                    *(u32x2*)(xd + i * 8) = (u32x2){(unsigned)w0, (unsigned)w1}; }
                else { u32x4 o; o.x = pk2(a[0], a[1]); o.y = pk2(a[2], a[3]); o.z = pk2(b[0], b[1]); o.w = pk2(b[2], b[3]); *(u32x4*)(xd + i * 16) = o; } }
        }
    }
    {
        const float *fw1 = INP(10), *fb1 = INP(11), *fw2 = INP(12), *fb2 = INP(13), *fw3 = INP(14), *fb3 = INP(15), *fw4 = INP(16), *fb4 = INP(17), *ffr = INP(18);
        LAS float* z = (LAS float*)cx.lds; LAS float* h1 = z + 16 * 33; LAS float* h2 = h1 + 1024; LAS float* h3 = h2 + 1024;
        float* HRAWT = (float*)(cx.ws + WS_HRAWT); float* HPART = (float*)(cx.ws + WS_HPART);
        for (int it = cx.vcu; it < 256; it += cx.G) {
            __syncthreads();
            const int pos0 = it * 16;
            for (int i = tid; i < 16 * 33; i += 512) { const int p = i / 33, f = i % 33; const float pos = (float)(pos0 + p); float v;
                if (f == 0) v = pos / 4095.0f;
                else { const int k = (f - 1) & 15; const float fb = 1e-4f + (float)k * ((15.0f - 1e-4f) / 15.0f); const float ang = (6.283185307179586f * pos / 4096.0f) * fb; v = (f <= 16) ? cosf(ang) : -sinf(ang); }
                z[i] = v; }
            __syncthreads();
            for (int i = tid; i < 1024; i += 512) { const int p = i >> 6, o = i & 63; float a = fb1[o]; for (int f = 0; f < 33; ++f) a += z[p * 33 + f] * fw1[f * 64 + o]; h1[i] = sinf(ffr[o] * a); }
            __syncthreads();
            for (int i = tid; i < 1024; i += 512) { const int p = i >> 6, o = i & 63; float a = fb2[o]; for (int k = 0; k < 64; ++k) a += h1[p * 64 + k] * fw2[k * 64 + o]; h2[i] = sinf(ffr[o] * a); }
            __syncthreads();
            for (int i = tid; i < 1024; i += 512) { const int p = i >> 6, o = i & 63; float a = fb3[o]; for (int k = 0; k < 64; ++k) a += h2[p * 64 + k] * fw3[k * 64 + o]; h3[i] = sinf(ffr[o] * a); }
            __syncthreads();
            for (int col = tid; col < 3072; col += 512) {
                float a[16]; const float bb = fb4[col];
#pragma unroll
                for (int p = 0; p < 16; ++p) a[p] = bb;
                for (int k = 0; k < 64; ++k) { const float w = fw4[(size_t)k * 3072 + col];
#pragma unroll
                    for (int p = 0; p < 16; ++p) a[p] += h3[p * 64 + k] * w; }
                const int c = col % 768; const float mind = -3.0701134573253945f, maxd = -15.350567286626972f;
                const float delta = fabsf(mind + (maxd - mind) * ((float)c / 767.0f)); float asum = 0.f;
#pragma unroll
                for (int p = 0; p < 16; ++p) { const float t = (float)(pos0 + p) / 4095.0f; a[p] *= expf(-t * delta); asum += fabsf(a[p]); }
                f32x4* dst = (f32x4*)(HRAWT + (size_t)col * 4096 + pos0);
#pragma unroll
                for (int q = 0; q < 4; ++q) dst[q] = (f32x4){a[4 * q], a[4 * q + 1], a[4 * q + 2], a[4 * q + 3]};
                HPART[(size_t)it * 3072 + col] = asum;
            }
        }
    }
}

__device__ __forceinline__ s16x4 vtr(const LAS unsigned char* p) { typedef short v4i16_t __attribute__((ext_vector_type(4))); return __builtin_bit_cast(s16x4, __builtin_amdgcn_ds_read_tr16_b64_v4i16((LAS v4i16_t*)p)); }
__device__ __forceinline__ void na_phase(const Ctx& cx, const bf16_t* PROJ, const float* rpb, bf16_t* CAT, const int tid) {
    const int lane = tid & 63, wid = __builtin_amdgcn_readfirstlane(tid >> 6), m16 = lane & 15, q4 = lane >> 4;
    LAS unsigned char* Kb = cx.lds; LAS unsigned char* Vb = cx.lds + 73728; LAS float* biasL = (LAS float*)(cx.lds + 147456);
    constexpr int PW = 2560;
    u32x4 kv[9], vv[9]; float bpre = 0.f;
#define NA_LOAD(unit_) do { const int b_ = __builtin_amdgcn_readfirstlane((unit_) / 384), rem_ = __builtin_amdgcn_readfirstlane((unit_) % 384), h_ = rem_ >> 5, rp_ = rem_ & 31; int bs_ = 2 * rp_ - 4; bs_ = bs_ < 0 ? 0 : (bs_ > 56 ? 56 : bs_); bs_ = __builtin_amdgcn_readfirstlane(bs_); \
        _Pragma("unroll") for (int it = 0; it < 9; ++it) { const int i = tid + it * 512; const int brow = i >> 9, col = (i >> 3) & 63, ch = i & 7; int grow = bs_ + brow; grow = grow > 63 ? 63 : grow; \
            const size_t tok = (size_t)b_ * 4096 + grow * 64 + col; \
            kv[it] = *(const u32x4*)(PROJ + tok * PW + 768 + h_ * 64 + ch * 8); vv[it] = *(const u32x4*)(PROJ + tok * PW + 1536 + h_ * 64 + ch * 8); } \
        if (tid < 465) bpre = rpb[h_ * 465 + tid] * LOG2E; } while (0)
    int u0 = cx.vcu; asm volatile("" : "+s"(u0));
    if (u0 < 6144) NA_LOAD(u0);
    for (int unit = u0; unit < 6144; unit += cx.G) {
        const int b = unit / 384, rem = unit % 384, h = rem >> 5, rp = rem & 31;
        int bs = 2 * rp - 4; bs = bs < 0 ? 0 : (bs > 56 ? 56 : bs);
        __syncthreads();
#pragma unroll
        for (int it = 0; it < 9; ++it) { const int i = tid + it * 512; const int brow = i >> 9, col = (i >> 3) & 63, ch = i & 7;
            *(LAS u32x4*)(Kb + (brow * 64 + col) * 128 + ((ch ^ ((col >> 1) & 7)) << 4)) = kv[it];
            *(LAS u32x4*)(Vb + (brow * 64 + col) * 128 + ((ch ^ (col & 7)) << 4)) = vv[it]; }
        if (tid < 465) biasL[tid] = bpre;
        __syncthreads();
        if (unit + cx.G < 6144) NA_LOAD(unit + cx.G);
        const int r = 2 * rp + (wid >> 2), g = wid & 3;
        const int wc0 = (g == 0) ? 0 : (g == 1) ? 8 : (g == 2) ? 24 : 32;
        int r0 = r - 4; r0 = r0 < 0 ? 0 : (r0 > 56 ? 56 : r0); const int ro = r0 - bs;
        const int c = 16 * g + m16;
        const size_t tq = (size_t)b * 4096 + r * 64 + c;
        bf16x8 qf[2];
#pragma unroll
        for (int kk = 0; kk < 2; ++kk) qf[kk] = *(const bf16x8*)(PROJ + tq * PW + h * 64 + 32 * kk + 8 * q4);
        f32x4 S[16];
#pragma unroll
        for (int i = 0; i < 8; ++i)
#pragma unroll
            for (int ct = 0; ct < 2; ++ct) { const int col = wc0 + 16 * ct + m16; const LAS unsigned char* kp = Kb + ((ro + i) * 64 + col) * 128; const int sw = (col >> 1) & 7;
                f32x4 a = (f32x4){0.f, 0.f, 0.f, 0.f};
#pragma unroll
                for (int kk = 0; kk < 2; ++kk) { const bf16x8 kf = *(const LAS bf16x8*)(kp + (((q4 + 4 * kk) ^ sw) << 4)); a = __builtin_amdgcn_mfma_f32_16x16x32_bf16(kf, qf[kk], a, 0, 0, 0); }
                S[2 * i + ct] = a; }
        int c0 = c - 8; c0 = c0 < 0 ? 0 : (c0 > 48 ? 48 : c0);
        float mx = -INFINITY;
#pragma unroll
        for (int i = 0; i < 8; ++i)
#pragma unroll
            for (int ct = 0; ct < 2; ++ct)
#pragma unroll
                for (int v = 0; v < 4; ++v) { const int kc = wc0 + 16 * ct + 4 * q4 + v; const bool valid = (kc >= c0) && (kc < c0 + 16);
                    const int bidx = valid ? (r0 + i - r + 7) * 31 + (kc - c + 15) : 0;
                    const float s = valid ? S[2 * i + ct][v] + biasL[bidx] : -INFINITY; S[2 * i + ct][v] = s; mx = fmaxf(mx, s); }
        mx = fmaxf(mx, shflx(mx, 16, lane)); mx = fmaxf(mx, shflx(mx, 32, lane));
        float l = 0.f;
#pragma unroll
        for (int t = 0; t < 16; ++t)
#pragma unroll
            for (int v = 0; v < 4; ++v) { const float p = __builtin_amdgcn_exp2f(S[t][v] - mx); S[t][v] = p; l += p; }
        l += shflx(l, 16, lane); l += shflx(l, 32, lane);
        f32x4 O[4];
#pragma unroll
        for (int dt = 0; dt < 4; ++dt) O[dt] = (f32x4){0.f, 0.f, 0.f, 0.f};
        const int qq = m16 >> 2, pp = m16 & 3, col1 = wc0 + 4 * q4 + qq;
#pragma unroll
        for (int i = 0; i < 8; ++i) {
            u32x4 pw; pw.x = pk2(S[2 * i][0], S[2 * i][1]); pw.y = pk2(S[2 * i][2], S[2 * i][3]); pw.z = pk2(S[2 * i + 1][0], S[2 * i + 1][1]); pw.w = pk2(S[2 * i + 1][2], S[2 * i + 1][3]);
            const bf16x8 pb = __builtin_bit_cast(bf16x8, pw);
            const LAS unsigned char* v1 = Vb + ((ro + i) * 64 + col1) * 128 + 8 * (pp & 1);
            const LAS unsigned char* v2 = v1 + 16 * 128;
#pragma unroll
            for (int dt = 0; dt < 4; ++dt) { const int chunk = 2 * dt + (pp >> 1);
                const s16x4 lo = vtr(v1 + ((chunk ^ (col1 & 7)) << 4)), hi = vtr(v2 + ((chunk ^ ((col1 + 16) & 7)) << 4));
                const bf16x8 vf = (bf16x8){lo[0], lo[1], lo[2], lo[3], hi[0], hi[1], hi[2], hi[3]};
                O[dt] = __builtin_amdgcn_mfma_f32_16x16x32_bf16(vf, pb, O[dt], 0, 0, 0); }
        }
        const float inv = 1.0f / l;
#pragma unroll
        for (int dt = 0; dt < 4; ++dt) {
            if constexpr (OUTP_F8) { int w = 0; w = __builtin_amdgcn_cvt_pk_fp8_f32(O[dt][0] * inv, O[dt][1] * inv, w, false); w = __builtin_amdgcn_cvt_pk_fp8_f32(O[dt][2] * inv, O[dt][3] * inv, w, true); *(int*)((unsigned char*)CAT + tq * 1024 + h * 64 + 16 * dt + 4 * q4) = w; }
            else { u32x2 w; w.x = pk2(O[dt][0] * inv, O[dt][1] * inv); w.y = pk2(O[dt][2] * inv, O[dt][3] * inv); *(u32x2*)(CAT + tq * 1024 + h * 64 + 16 * dt + 4 * q4) = w; } }
    }
    __syncthreads();
}

#undef NA_LOAD
__device__ __forceinline__ void rope_phase(const Ctx& cx, const bf16_t* PROJ, const float* qg, const float* kg, bf16_t* QKR, const int tid) {
    const int lane = tid & 63, wave = __builtin_amdgcn_readfirstlane(tid >> 6);
    const int gw = cx.vcu * 8 + wave, NGW = cx.G * 8;
    const int d0 = (lane & 7) * 8;
    float gq[8], gk[8], invf[4];
#pragma unroll
    for (int e = 0; e < 8; ++e) { gq[e] = qg[d0 + e]; gk[e] = kg[d0 + e]; }
#pragma unroll
    for (int p = 0; p < 4; ++p) { const int i = (d0 >> 1) + p, j = i & 15; invf[p] = exp2f(-(float)(2 * j) / 32.0f * 13.287712379549449f); }
    const bool isrow = (d0 >> 1) < 16;
    for (int pos = gw; pos < SEQ; pos += NGW) {
        const float pr = isrow ? (float)(pos >> 6) : (float)(pos & 63);
        float cs[4], sn[4];
#pragma unroll
        for (int p = 0; p < 4; ++p) { const float a = pr * invf[p]; cs[p] = cosf(a); sn[p] = sinf(a); }
#pragma unroll 4
        for (int bb = 0; bb < BATCH; ++bb) { const int tok = bb * SEQ + pos;
#pragma unroll
        for (int half = 0; half < 2; ++half) {
            const int e0 = half * 512 + lane * 8; const int head = e0 >> 6; const bool isq = head < 12;
            const u32x4 raw = *(const u32x4*)(PROJ + (size_t)tok * 1536 + e0);
            float x[8]; x[0] = bflo(raw.x); x[1] = bfhi(raw.x); x[2] = bflo(raw.y); x[3] = bfhi(raw.y); x[4] = bflo(raw.z); x[5] = bfhi(raw.z); x[6] = bflo(raw.w); x[7] = bfhi(raw.w);
            float ss = 0.f;
#pragma unroll
            for (int e = 0; e < 8; ++e) ss += x[e] * x[e];
            ss = group8_sum(ss);
            const float inv = rsqrtf(ss * (1.0f / 64.0f) + 1e-6f);
            float y[8];
#pragma unroll
            for (int e = 0; e < 8; ++e) y[e] = x[e] * inv * (isq ? gq[e] : gk[e]);
            const float sc = isq ? C2 : 1.0f;
            float o[8];
#pragma unroll
            for (int p = 0; p < 4; ++p) { o[2 * p] = (y[2 * p] * cs[p] - y[2 * p + 1] * sn[p]) * sc; o[2 * p + 1] = (y[2 * p] * sn[p] + y[2 * p + 1] * cs[p]) * sc; }
            u32x4 w; w.x = pk2(o[0], o[1]); w.y = pk2(o[2], o[3]); w.z = pk2(o[4], o[5]); w.w = pk2(o[6], o[7]);
            *(u32x4*)(QKR + (size_t)tok * 1024 + e0) = w;
        } }
    }
}

__device__ __forceinline__ void sconv_phase(const Ctx& cx, const bf16_t* PROJ, const float* cw, const float* cb, bf16_t* UT3, unsigned char* V8, const int tid) {
    const int lane = tid & 63, wave = __builtin_amdgcn_readfirstlane(tid >> 6);
    const int gw = cx.vcu * 8 + wave, NGW = cx.G * 8;
    LAS unsigned short* tile = (LAS unsigned short*)(cx.lds + wave * 9216);
    constexpr int PW = 2560;
    for (int it = gw; it < 16 * 64 * 36; it += NGW) {
        const int ct = it % 36, tt = (it / 36) & 63, b = it / (36 * 64);
        const int col = ct * 64 + lane, t0 = tt * 64;
        const float w0 = cw[col], w1 = cw[2304 + col], w2 = cw[4608 + col], bia = cb[col];
        const bf16_t* src = PROJ + ((size_t)b * 4096 + t0) * PW + col;
        unsigned short uu[66];
        uu[0] = (t0 > 0) ? src[-(long)PW] : (unsigned short)0;
#pragma unroll
        for (int k = 0; k < 64; ++k) uu[k + 1] = src[(size_t)k * PW];
        uu[65] = (t0 + 64 < 4096) ? src[(size_t)64 * PW] : (unsigned short)0;
#pragma unroll
        for (int k = 0; k < 64; ++k) { const float v = bf2f(uu[k]) * w0 + bf2f(uu[k + 1]) * w1 + bf2f(uu[k + 2]) * w2 + bia; tile[lane * 72 + k] = (unsigned short)f2bf(v); }
        LDS_WAIT(); asm volatile("" ::: "memory");
        const int part = (ct * 64) / 768, cbase = (ct * 64) % 768;
#pragma unroll
        for (int k = 0; k < 8; ++k) { const int row = k * 8 + (lane >> 3), chn = lane & 7;
            const u32x4 v = *(const LAS u32x4*)((const LAS unsigned char*)tile + row * 144 + chn * 16);
            *(u32x4*)(UT3 + (((size_t)part * 16 + b) * 768 + cbase + row) * 4096 + t0 + chn * 8) = v;
            if (TCONV_F8 && part == 0) { int w0 = 0, w1 = 0;
                w0 = __builtin_amdgcn_cvt_pk_fp8_f32(bflo(v.x), bfhi(v.x), w0, false); w0 = __builtin_amdgcn_cvt_pk_fp8_f32(bflo(v.y), bfhi(v.y), w0, true);
                w1 = __builtin_amdgcn_cvt_pk_fp8_f32(bflo(v.z), bfhi(v.z), w1, false); w1 = __builtin_amdgcn_cvt_pk_fp8_f32(bflo(v.w), bfhi(v.w), w1, true);
                *(u32x2*)(V8 + ((size_t)b * 768 + cbase + row) * 4096 + t0 + chn * 8) = (u32x2){(unsigned)w0, (unsigned)w1}; } }
        LDS_WAIT(); asm volatile("" ::: "memory");
    }
}

constexpr int TZ_CS = 16384 + 64;
__device__ __forceinline__ void tconv_phase(const Ctx& cx, const int o, const bf16_t* UT, const bf16_t* GT, bf16_t* ZT, const float* lbias  , const int tid) {
    const int lane = tid & 63, wid = __builtin_amdgcn_readfirstlane(tid >> 6), m16 = lane & 15, q4 = lane >> 4;
    const float* HRAWT = (const float*)(cx.ws + WS_HRAWT); const float* HPART = (const float*)(cx.ws + WS_HPART);
    LAS unsigned char* cp = cx.lds; LAS float* red = (LAS float*)(cx.lds + 8 * TZ_CS);
    for (int c = cx.vcu; c < 768; c += cx.G) {
        __syncthreads();
        { const int dir = tid >> 8, blk = tid & 255; float v = HPART[(size_t)blk * 3072 + dir * 1536 + o * 768 + c]; v = wave_sum(v, lane); if (lane == 0) red[wid] = v; }
        __syncthreads();
        float nrm = 0.f;
#pragma unroll
        for (int w = 0; w < 8; ++w) nrm += red[w];
        const float inv = 1.0f / nrm;
        const float* hf = HRAWT + (size_t)(o * 768 + c) * 4096; const float* hb = HRAWT + (size_t)(1536 + o * 768 + c) * 4096;
        for (int i = tid; i < 8192; i += 512) { float v; if (i < 4096) v = hf[4095 - i]; else if (i < 8191) v = hb[i - 4095]; else v = 0.f;
            *(LAS unsigned short*)(cp + 2 * i) = (unsigned short)f2bf(v * inv); }
        __syncthreads();
#pragma unroll
        for (int j = 1; j < 8; ++j)
            for (int n = tid; n < 1024; n += 512) {
                const u32x4 lo = *(const LAS u32x4*)(cp + n * 16); u32x4 hi = (u32x4){0u, 0u, 0u, 0u}; if (n + 1 < 1024) hi = *(const LAS u32x4*)(cp + (n + 1) * 16);
                const unsigned w[8] = {lo.x, lo.y, lo.z, lo.w, hi.x, hi.y, hi.z, hi.w}; u32x4 r;
                const int a = j >> 1;
                if (j & 1) { r.x = (w[a] >> 16) | (w[a + 1] << 16); r.y = (w[a + 1] >> 16) | (w[a + 2] << 16); r.z = (w[a + 2] >> 16) | (w[a + 3] << 16); r.w = (w[a + 3] >> 16) | (w[a + 4] << 16); }
                else { r.x = w[a]; r.y = w[a + 1]; r.z = w[a + 2]; r.w = w[a + 3]; }
                *(LAS u32x4*)(cp + j * TZ_CS + n * 16) = r;
            }
        __syncthreads();
        const int j = (7 - m16) & 7;
        const int nbase = (4095 - 512 * wid - m16 - j + 8 * q4) >> 3;
        const LAS unsigned char* ap = cp + j * TZ_CS + (nbase - 62) * 16;
        const bf16_t* up = UT + ((size_t)m16 * 768 + c) * 4096 + 8 * q4;
        f32x4 acc[32];
#pragma unroll
        for (int ti = 0; ti < 32; ++ti) acc[ti] = (f32x4){0.f, 0.f, 0.f, 0.f};
        bf16x8 bcur = *(const bf16x8*)(up);
        bf16x8 afA[8], afB[8];
#pragma unroll
        for (int i = 0; i < 8; ++i) afA[i] = *(const LAS bf16x8*)(ap + (31 - i) * 32);
        for (int ks = 0; ks < 128; ++ks) {
            const bf16x8 bnext = *(const bf16x8*)(up + ((ks + 1) & 127) * 32);
            const LAS unsigned char* a0 = ap + ks * 64;
            const LAS unsigned char* a1 = ap + ((ks + 1) & 127) * 64;
#define TZ_LD(dst, base, g) do { _Pragma("unroll") for (int i = 0; i < 8; ++i) dst[i] = *(const LAS bf16x8*)((base) + (31 - (8 * (g) + i)) * 32); } while (0)
#define TZ_MM(src, g) do { _Pragma("unroll") for (int i = 0; i < 8; ++i) acc[8 * (g) + i] = __builtin_amdgcn_mfma_f32_16x16x32_bf16(src[i], bcur, acc[8 * (g) + i], 0, 0, 0); } while (0)
            TZ_LD(afB, a0, 1); TZ_MM(afA, 0); __builtin_amdgcn_sched_barrier(0);
            TZ_LD(afA, a0, 2); TZ_MM(afB, 1); __builtin_amdgcn_sched_barrier(0);
            TZ_LD(afB, a0, 3); TZ_MM(afA, 2); __builtin_amdgcn_sched_barrier(0);
            TZ_LD(afA, a1, 0); TZ_MM(afB, 3); __builtin_amdgcn_sched_barrier(0);
#undef TZ_LD
#undef TZ_MM
            bcur = bnext;
        }
        const float lb = lbias[c];
        const size_t rowoff = ((size_t)m16 * 768 + c) * 4096 + 512 * wid + 4 * q4;
#pragma unroll
        for (int ti = 0; ti < 32; ++ti) {
            const u32x2 uu = *(const u32x2*)(UT + rowoff + 16 * ti), gg = *(const u32x2*)(GT + rowoff + 16 * ti);
            const float y0 = (acc[ti][0] + lb * bflo(uu.x)) * bflo(gg.x), y1 = (acc[ti][1] + lb * bfhi(uu.x)) * bfhi(gg.x), y2 = (acc[ti][2] + lb * bflo(uu.y)) * bflo(gg.y), y3 = (acc[ti][3] + lb * bfhi(uu.y)) * bfhi(gg.y);
            u32x2 w; w.x = pk2(y0, y1); w.y = pk2(y2, y3);
            *(u32x2*)(ZT + rowoff + 16 * ti) = w;
            if ((ti & 7) == 7) __builtin_amdgcn_sched_barrier(0);
        }
    }
    __syncthreads();
}

constexpr int T8_CS = 8192 + 256;
__host__ __device__ constexpr int t8_sig(int j) { return j < 4 ? 2 * j : (j >= 12 ? 2 * (j - 8) : 2 * (j - 4) + 1); }
__device__ __forceinline__ float wave_max_nn(float v) {
    v = fmaxf(v, dpp_x<0xB1>(v)); v = fmaxf(v, dpp_x<0x4E>(v)); v = fmaxf(v, dpp_x<0x141>(v)); v = fmaxf(v, dpp_x<0x140>(v));
    v = fmaxf(v, __builtin_bit_cast(float, __builtin_amdgcn_update_dpp(0, __builtin_bit_cast(int, v), 0x142, 0xA, 0xF, false)));
    v = fmaxf(v, __builtin_bit_cast(float, __builtin_amdgcn_update_dpp(0, __builtin_bit_cast(int, v), 0x143, 0xC, 0xF, false)));
    return __builtin_bit_cast(float, __builtin_amdgcn_readlane(__builtin_bit_cast(int, v), 63));
}
__device__ __forceinline__ void tconv8_phase(const Ctx& cx, const int o, const bf16_t* UT, const unsigned char* U8, const bf16_t* GT, bf16_t* ZT, unsigned char* Z8  ,
                                             const float* lbias, const int tid) {
    const int lane = tid & 63, wid = __builtin_amdgcn_readfirstlane(tid >> 6), m16 = lane & 15, q4 = lane >> 4;
    const float* HRAWT = (const float*)(cx.ws + WS_HRAWT); const float* HPART = (const float*)(cx.ws + WS_HPART);
    LAS unsigned char* cp = cx.lds; LAS float* red = (LAS float*)(cx.lds + 16 * T8_CS);
    for (int c = cx.vcu; c < 768; c += cx.G) {
        __syncthreads();
        const float* hf = HRAWT + (size_t)(o * 768 + c) * 4096; const float* hb = HRAWT + (size_t)(1536 + o * 768 + c) * 4096;
        float tap[16]; float mx = 0.f;
        int t3 = tid; asm volatile("" : "+v"(t3));
#pragma unroll
        for (int k = 0; k < 16; ++k) { const int i = t3 * 16 + k; float v; if (i < 4096) v = hf[4095 - i]; else if (i < 8191) v = hb[i - 4095]; else v = 0.f; tap[k] = v; mx = fmaxf(mx, fabsf(v)); }
        { const int dir = tid >> 8, blk = tid & 255; float v = HPART[(size_t)blk * 3072 + dir * 1536 + o * 768 + c]; v = wave_sum(v, lane); mx = wave_max_nn(mx); if (lane == 0) { red[wid] = v; red[8 + wid] = mx; } }
        __syncthreads();
        float nrm = 0.f, mall = 0.f;
#pragma unroll
        for (int w = 0; w < 8; ++w) { nrm += red[w]; mall = fmaxf(mall, red[8 + w]); }
        const float inv = 1.0f / nrm;
        int ex; (void)frexpf(fmaxf(mall * inv, 1e-30f), &ex);
        const float fsc = ldexpf(1.0f, 7 - ex), unsc = ldexpf(1.0f, ex - 7), tsc = inv * fsc;
        { unsigned w[4];
#pragma unroll
          for (int q = 0; q < 4; ++q) { int r = 0; r = __builtin_amdgcn_cvt_pk_fp8_f32(tap[4 * q] * tsc, tap[4 * q + 1] * tsc, r, false); r = __builtin_amdgcn_cvt_pk_fp8_f32(tap[4 * q + 2] * tsc, tap[4 * q + 3] * tsc, r, true); w[q] = (unsigned)r; }
          *(LAS u32x4*)(cp + tid * 16) = (u32x4){w[0], w[1], w[2], w[3]}; }
        __syncthreads();
        { const u32x4 lo = *(const LAS u32x4*)(cp + tid * 16); u32x4 hi = (u32x4){0u, 0u, 0u, 0u}; if (tid + 1 < 512) hi = *(const LAS u32x4*)(cp + (tid + 1) * 16);
          const unsigned w[8] = {lo.x, lo.y, lo.z, lo.w, hi.x, hi.y, hi.z, hi.w};
#pragma unroll
          for (int j = 1; j < 16; ++j) { u32x4 r; const int a = j >> 2, sh = j & 3;
              r.x = sh ? __builtin_amdgcn_alignbyte(w[a + 1], w[a], sh) : w[a]; r.y = sh ? __builtin_amdgcn_alignbyte(w[a + 2], w[a + 1], sh) : w[a + 1];
              r.z = sh ? __builtin_amdgcn_alignbyte(w[a + 3], w[a + 2], sh) : w[a + 2]; r.w = sh ? __builtin_amdgcn_alignbyte(w[a + 4], w[a + 3], sh) : w[a + 3];
              *(LAS u32x4*)(cp + j * T8_CS + t8_sig(j) * 16 + tid * 16) = r; } }
        __syncthreads();
        const int jc = 15 - m16;
        const int nbase = 255 - 32 * wid + 2 * q4;
        const LAS unsigned char* ap = cp + jc * T8_CS + t8_sig(jc) * 16 + (nbase - 31) * 16;
        const unsigned char* up = U8 + ((size_t)m16 * 768 + c) * 4096 + 32 * q4;
        f32x4 acc[32];
#pragma unroll
        for (int ti = 0; ti < 32; ++ti) acc[ti] = (f32x4){0.f, 0.f, 0.f, 0.f};
        typedef int v8i_t __attribute__((ext_vector_type(8))); typedef int v4i_t __attribute__((ext_vector_type(4)));
#define T8_FRAG(p) __builtin_shufflevector(*(const LAS v4i_t*)(p), *(const LAS v4i_t*)((p) + 16), 0, 1, 2, 3, 4, 5, 6, 7)
        v8i_t bcur = __builtin_shufflevector(*(const v4i_t*)(up), *(const v4i_t*)(up + 16), 0, 1, 2, 3, 4, 5, 6, 7);
        v8i_t afA[4], afB[4];
#pragma unroll
        for (int i = 0; i < 4; ++i) afA[i] = T8_FRAG(ap + (31 - i) * 16);
        for (int ks = 0; ks < 32; ++ks) {
            const unsigned char* un = up + ((ks + 1) & 31) * 128;
            const v8i_t bnext = __builtin_shufflevector(*(const v4i_t*)(un), *(const v4i_t*)(un + 16), 0, 1, 2, 3, 4, 5, 6, 7);
            const LAS unsigned char* a0 = ap + ks * 128;
            const LAS unsigned char* a1 = ap + ((ks + 1) & 31) * 128;
#define T8_LD(dst, base, g) do { _Pragma("unroll") for (int i = 0; i < 4; ++i) dst[i] = T8_FRAG((base) + (31 - (4 * (g) + i)) * 16); } while (0)
#define T8_MM(src, g) do { _Pragma("unroll") for (int i = 0; i < 4; ++i) acc[4 * (g) + i] = __builtin_amdgcn_mfma_scale_f32_16x16x128_f8f6f4(src[i], bcur, acc[4 * (g) + i], 0, 0, 0, 0, 0, 0); } while (0)
            T8_LD(afB, a0, 1); T8_MM(afA, 0); __builtin_amdgcn_sched_barrier(0);
            T8_LD(afA, a0, 2); T8_MM(afB, 1); __builtin_amdgcn_sched_barrier(0);
            T8_LD(afB, a0, 3); T8_MM(afA, 2); __builtin_amdgcn_sched_barrier(0);
            T8_LD(afA, a0, 4); T8_MM(afB, 3); __builtin_amdgcn_sched_barrier(0);
            T8_LD(afB, a0, 5); T8_MM(afA, 4); __builtin_amdgcn_sched_barrier(0);
            T8_LD(afA, a0, 6); T8_MM(afB, 5); __builtin_amdgcn_sched_barrier(0);
            T8_LD(afB, a0, 7); T8_MM(afA, 6); __builtin_amdgcn_sched_barrier(0);
            T8_LD(afA, a1, 0); T8_MM(afB, 7); __builtin_amdgcn_sched_barrier(0);
#undef T8_LD
#undef T8_MM
            bcur = bnext;
        }
#undef T8_FRAG
        const float lb = lbias[c];
        const size_t rowoff = ((size_t)m16 * 768 + c) * 4096 + 512 * wid + 4 * q4;
#pragma unroll
        for (int ti = 0; ti < 32; ++ti) {
            const u32x2 uu = *(const u32x2*)(UT + rowoff + 16 * ti), gg = *(const u32x2*)(GT + rowoff + 16 * ti);
            const float y0 = (acc[ti][0] * unsc + lb * bflo(uu.x)) * bflo(gg.x), y1 = (acc[ti][1] * unsc + lb * bfhi(uu.x)) * bfhi(gg.x), y2 = (acc[ti][2] * unsc + lb * bflo(uu.y)) * bflo(gg.y), y3 = (acc[ti][3] * unsc + lb * bfhi(uu.y)) * bfhi(gg.y);
            u32x2 w; w.x = pk2(y0, y1); w.y = pk2(y2, y3);
            *(u32x2*)(ZT + rowoff + 16 * ti) = w;
            if (Z8) { int w8 = 0; w8 = __builtin_amdgcn_cvt_pk_fp8_f32(fminf(fmaxf(y0, -440.f), 440.f), fminf(fmaxf(y1, -440.f), 440.f), w8, false); w8 = __builtin_amdgcn_cvt_pk_fp8_f32(fminf(fmaxf(y2, -440.f), 440.f), fminf(fmaxf(y3, -440.f), 440.f), w8, true);
                *(int*)(Z8 + rowoff + 16 * ti) = w8; }
            if ((ti & 7) == 7) __builtin_amdgcn_sched_barrier(0);
        }
    }
    __syncthreads();
}

__device__ __forceinline__ void tback_phase(const Ctx& cx, const bf16_t* ZT, bf16_t* CAT, const int tid) {
    const int lane = tid & 63, wave = __builtin_amdgcn_readfirstlane(tid >> 6);
    const int gw = cx.vcu * 8 + wave, NGW = cx.G * 8;
    LAS unsigned char* tile = cx.lds + wave * 9216;
    for (int it = gw; it < 16 * 12 * 64; it += NGW) {
        const int tt = it & 63, ct = (it >> 6) % 12, b = it / (64 * 12);
        const int c0 = ct * 64, t0 = tt * 64;
#pragma unroll
        for (int k = 0; k < 8; ++k) { const int row = k * 8 + (lane >> 3), chn = lane & 7;
            const u32x4 v = *(const u32x4*)(ZT + ((size_t)b * 768 + c0 + row) * 4096 + t0 + chn * 8);
            *(LAS u32x4*)(tile + row * 144 + chn * 16) = v; }
        LDS_WAIT(); asm volatile("" ::: "memory");
        if constexpr (OUTP_F8) { unsigned char* dst = (unsigned char*)CAT + ((size_t)b * 4096 + t0) * 1024 + c0 + lane;
#pragma unroll 8
            for (int k = 0; k < 64; ++k) { const float v = bf2f(*(const LAS unsigned short*)(tile + lane * 144 + k * 2)); dst[(size_t)k * 1024] = f2fp8(fminf(fmaxf(v, -440.0f), 440.0f)); }
        } else { bf16_t* dst = CAT + ((size_t)b * 4096 + t0) * 1024 + c0 + lane;
#pragma unroll 8
            for (int k = 0; k < 64; ++k) dst[(size_t)k * 1024] = *(const LAS unsigned short*)(tile + lane * 144 + k * 2); }
        LDS_WAIT(); asm volatile("" ::: "memory");
    }
}

__device__ __forceinline__ void ln1_group(const int bt, const int chunk, const int wave, const int lane, const int r16, const int q4, const bf16_t* XI, bf16_t* XO, bf16_t* XB, const float* g, const float* bta,
                                          const LAS unsigned char* Wh, const LAS unsigned char* Wl, LAS float* lg, LAS int* lcnt, const float rb0, const float rb1, float* gate, unsigned (&pk)[2], unsigned (&gp)[2], const LAS float* gl) {
    constexpr int WP = 2064;
            const size_t rowU = (size_t)chunk * 256 + wave * 32 + bt * 16;
            unsigned loff = (unsigned)(r16 * 1024 + 8 * q4); asm volatile("" : "+v"(loff));
            const GAS bf16_t* src = (const GAS bf16_t*)XI + rowU * 1024 + loff;
            constexpr int HOLD = LN1_HOLD;
            u32x4 raw[HOLD > 0 ? HOLD : 1], rawt[32 - HOLD]; float s = 0.f, ss = 0.f;
#pragma unroll
            for (int i = 0; i < 32; ++i) { if (i < HOLD) raw[i] = *(const GAS u32x4*)(src + 32 * i); else rawt[i - HOLD] = *(const GAS u32x4*)(src + 32 * i); }
#pragma unroll
            for (int i = 0; i < 32; ++i) { const u32x4 rr = (i < HOLD) ? raw[i < HOLD ? i : 0] : rawt[i < HOLD ? 0 : i - HOLD]; const float x0 = bflo(rr.x), x1 = bfhi(rr.x), x2 = bflo(rr.y), x3 = bfhi(rr.y), x4 = bflo(rr.z), x5 = bfhi(rr.z), x6 = bflo(rr.w), x7 = bfhi(rr.w);
                s += ((x0 + x1) + (x2 + x3)) + ((x4 + x5) + (x6 + x7)); ss += ((x0 * x0 + x1 * x1) + (x2 * x2 + x3 * x3)) + ((x4 * x4 + x5 * x5) + (x6 * x6 + x7 * x7)); }
            lg[2 * lane] = s; lg[2 * lane + 1] = ss; LDS_WAIT(); asm volatile("" ::: "memory");
            s = (lg[2 * r16] + lg[2 * (r16 + 16)]) + (lg[2 * (r16 + 32)] + lg[2 * (r16 + 48)]); ss = (lg[2 * r16 + 1] + lg[2 * (r16 + 16) + 1]) + (lg[2 * (r16 + 32) + 1] + lg[2 * (r16 + 48) + 1]);
            LDS_WAIT(); asm volatile("" ::: "memory");
            const float mean = s * (1.0f / 1024.0f), rstd = rsqrtf(fmaxf(ss * (1.0f / 1024.0f) - mean * mean, 0.f) + LN_EPS);
            f32x4 a0 = (f32x4){0.f, 0.f, 0.f, 0.f}, a1 = (f32x4){0.f, 0.f, 0.f, 0.f};
            const LAS unsigned char* wh0 = Wh + r16 * WP + 16 * q4; const LAS unsigned char* wl0 = Wl + r16 * WP + 16 * q4;
            GAS bf16_t* dsto = (GAS bf16_t*)XO + rowU * 1024 + loff; GAS unsigned char* dst8 = (GAS unsigned char*)XB + rowU * 1024 + loff;
            const LAS float* glq = gl + 8 * q4;
            u32x4 nx_ = (u32x4){0u, 0u, 0u, 0u}; if (HOLD == 0) nx_ = *(const GAS u32x4*)(src);
#pragma unroll
            for (int i = 0; i < 32; ++i) {
                u32x4 rw_; if (i < HOLD) rw_ = raw[i < HOLD ? i : 0]; else rw_ = nx_;
                if (i + 1 < 32 && i + 1 >= HOLD) nx_ = *(const GAS u32x4*)(src + 32 * (i + 1));
                asm volatile("" : "+v"(rw_));
                const f32x4 g0 = *(const LAS f32x4*)(glq + 32 * i), g1 = *(const LAS f32x4*)(glq + 32 * i + 4), b0 = *(const LAS f32x4*)(glq + 1024 + 32 * i), b1 = *(const LAS f32x4*)(glq + 1024 + 32 * i + 4);
                float y[8]; y[0] = bflo(rw_.x); y[1] = bfhi(rw_.x); y[2] = bflo(rw_.y); y[3] = bfhi(rw_.y); y[4] = bflo(rw_.z); y[5] = bfhi(rw_.z); y[6] = bflo(rw_.w); y[7] = bfhi(rw_.w);
#pragma unroll
                for (int q = 0; q < 8; ++q) y[q] = (y[q] - mean) * rstd * (q < 4 ? g0[q & 3] : g1[q & 3]) + (q < 4 ? b0[q & 3] : b1[q & 3]);
                u32x4 hi; hi.x = pk2(y[0], y[1]); hi.y = pk2(y[2], y[3]); hi.z = pk2(y[4], y[5]); hi.w = pk2(y[6], y[7]);
                *(GAS u32x4*)(dsto + 32 * i) = hi;
                if constexpr (MOE_F8) { int w0 = 0, w1 = 0; w0 = __builtin_amdgcn_cvt_pk_fp8_f32(y[0], y[1], w0, false); w0 = __builtin_amdgcn_cvt_pk_fp8_f32(y[2], y[3], w0, true); w1 = __builtin_amdgcn_cvt_pk_fp8_f32(y[4], y[5], w1, false); w1 = __builtin_amdgcn_cvt_pk_fp8_f32(y[6], y[7], w1, true);
                    *(GAS u32x2*)(dst8 + 32 * i) = (u32x2){(unsigned)w0, (unsigned)w1}; }
                else { *(u32x4*)((bf16_t*)XB + rowU * 1024 + loff + 32 * i) = hi; }
                u32x4 lo; lo.x = pk2(y[0] - bflo(hi.x), y[1] - bfhi(hi.x)); lo.y = pk2(y[2] - bflo(hi.y), y[3] - bfhi(hi.y)); lo.z = pk2(y[4] - bflo(hi.z), y[5] - bfhi(hi.z)); lo.w = pk2(y[6] - bflo(hi.w), y[7] - bfhi(hi.w));
                const bf16x8 ah = __builtin_bit_cast(bf16x8, hi), al = __builtin_bit_cast(bf16x8, lo);
                const bf16x8 wh_0 = *(const LAS bf16x8*)(wh0 + 64 * i), wh_1 = *(const LAS bf16x8*)(wh0 + 16 * WP + 64 * i), wl_0 = *(const LAS bf16x8*)(wl0 + 64 * i), wl_1 = *(const LAS bf16x8*)(wl0 + 16 * WP + 64 * i);
                a0 = __builtin_amdgcn_mfma_f32_16x16x32_bf16(ah, wh_0, a0, 0, 0, 0); a1 = __builtin_amdgcn_mfma_f32_16x16x32_bf16(ah, wh_1, a1, 0, 0, 0);
                a0 = __builtin_amdgcn_mfma_f32_16x16x32_bf16(al, wh_0, a0, 0, 0, 0); a1 = __builtin_amdgcn_mfma_f32_16x16x32_bf16(al, wh_1, a1, 0, 0, 0);
                a0 = __builtin_amdgcn_mfma_f32_16x16x32_bf16(ah, wl_0, a0, 0, 0, 0); a1 = __builtin_amdgcn_mfma_f32_16x16x32_bf16(ah, wl_1, a1, 0, 0, 0);
                asm volatile("" :: "v"(ah), "v"(al), "v"(wh_0), "v"(wh_1), "v"(wl_0), "v"(wl_1));
                __builtin_amdgcn_sched_barrier(0);
            }
#pragma unroll
            for (int v = 0; v < 4; ++v) { lg[(4 * q4 + v) * 33 + r16] = a0[v] + rb0; lg[(4 * q4 + v) * 33 + r16 + 16] = a1[v] + rb1; }
            LDS_WAIT(); asm volatile("" ::: "memory");
            if (lane < 16) {
                const LAS float* myl = lg + lane * 33; const size_t rowt = (size_t)chunk * 256 + wave * 32 + bt * 16 + lane;
                float tv[4]; int te[4]; int t0 = -1, t1 = -1, t2 = -1;
#pragma unroll
                for (int k = 0; k < 4; ++k) { float best = -INFINITY; int bi = 0;
                    for (int e = 0; e < 32; ++e) { const float v = myl[e]; const bool ok = (e != t0) && (e != t1) && (e != t2); if (ok && v > best) { best = v; bi = e; } }
                    tv[k] = best; te[k] = bi; if (k == 0) t0 = bi; else if (k == 1) t1 = bi; else if (k == 2) t2 = bi; }
                const float e1 = __expf(tv[1] - tv[0]), e2 = __expf(tv[2] - tv[0]), e3 = __expf(tv[3] - tv[0]); const float isum = 1.0f / (1.0f + e1 + e2 + e3);
                const float gk[4] = {isum, e1 * isum, e2 * isum, e3 * isum};
                pk[0] = 0u; pk[1] = 0u;
#pragma unroll
                for (int k = 0; k < 4; ++k) { const int rk = __hip_atomic_fetch_add(lcnt + te[k], 1, __ATOMIC_RELAXED, __HIP_MEMORY_SCOPE_WORKGROUP); pk[k >> 1] |= (unsigned)((te[k] << 11) | rk) << (16 * (k & 1)); }
                gp[0] = pk2(gk[0], gk[1]); gp[1] = pk2(gk[2], gk[3]); (void)rowt; (void)gate;
            }
            LDS_WAIT(); asm volatile("" ::: "memory");
}
__device__ __forceinline__ void ln1_router_phase(const Ctx& cx, const bf16_t* XI, bf16_t* XO, bf16_t* XB, const float* g, const float* bta, const float* rw, const float* rb,
                                                 unsigned* cnt, int* expid, float* gate, int* idx, float* gidx, const int tid) {
    const int lane = tid & 63, wave = __builtin_amdgcn_readfirstlane(tid >> 6), r16 = lane & 15, q4 = lane >> 4;
    constexpr int WP = 2064;
    LAS unsigned char* Wh = cx.lds; LAS unsigned char* Wl = cx.lds + 32 * WP; LAS int* lcnt = (LAS int*)(cx.lds + 64 * WP); LAS int* lbase = lcnt + 32; LAS float* lg = (LAS float*)(cx.lds + 64 * WP + 256 + wave * 2112);
    __syncthreads();
#pragma unroll 1
    for (int jb = 0; jb < 16; jb += 8) { f32x4 wv[8];
#pragma unroll
        for (int u = 0; u < 8; ++u) wv[u] = *(const f32x4*)(rw + 4 * (tid + 512 * (jb + u)));
#pragma unroll
        for (int u = 0; u < 8; ++u) { const int i = 4 * (tid + 512 * (jb + u)), k = i >> 5, e = i & 31;
#pragma unroll
            for (int q = 0; q < 4; ++q) { const float w = wv[u][q]; const unsigned hi = f2bf(w); const float wl = w - bf2f((unsigned short)hi);
                *(LAS unsigned short*)(Wh + (e + q) * WP + 2 * k) = (unsigned short)hi; *(LAS unsigned short*)(Wl + (e + q) * WP + 2 * k) = (unsigned short)f2bf(wl); } } }
    if (tid < 256) { LAS float* gf = (LAS float*)(cx.lds + 151552); *(LAS f32x4*)(gf + 4 * tid) = *(const f32x4*)(g + 4 * tid); *(LAS f32x4*)(gf + 1024 + 4 * tid) = *(const f32x4*)(bta + 4 * tid); }
    if (tid < 32) lcnt[tid] = 0;
    LAS float* gl = (LAS float*)(cx.lds + 151552);
    const float rb0 = rb[r16], rb1 = rb[r16 + 16];
    __syncthreads();
    for (int chunk = cx.vcu; chunk < NTOK / 256; chunk += cx.G) {
        unsigned pk0[2] = {0u, 0u}, pk1[2] = {0u, 0u}, gp0[2] = {0u, 0u}, gp1[2] = {0u, 0u};
        ln1_group(0, chunk, wave, lane, r16, q4, XI, XO, XB, g, bta, Wh, Wl, lg, lcnt, rb0, rb1, gate, pk0, gp0, gl);
        ln1_group(1, chunk, wave, lane, r16, q4, XI, XO, XB, g, bta, Wh, Wl, lg, lcnt, rb0, rb1, gate, pk1, gp1, gl);
        __syncthreads();
        { const int t2 = wave * 64 + lane_id_volatile();
          if (t2 < 32) { lbase[t2] = (int)__hip_atomic_fetch_add(cnt + t2, (unsigned)lcnt[t2], __ATOMIC_RELAXED, __HIP_MEMORY_SCOPE_AGENT); } }
        __syncthreads();
        const int ln_ = lane_id_volatile();
        if (ln_ < 16) {
            { const int slot0 = (chunk * 256 + wave * 32 + ln_) * 4;
#pragma unroll
                for (int k = 0; k < 4; ++k) { const unsigned p = (pk0[k >> 1] >> (16 * (k & 1))) & 0xffffu; const int e = (int)(p >> 11), rk = (int)(p & 0x7ffu); const size_t o_ = (size_t)e * IDXCAP + lbase[e] + rk; idx[o_] = slot0 + k; gidx[o_] = (k & 1) ? bfhi(gp0[k >> 1]) : bflo(gp0[k >> 1]); } }
            { const int slot0 = (chunk * 256 + wave * 32 + 16 + ln_) * 4;
#pragma unroll
                for (int k = 0; k < 4; ++k) { const unsigned p = (pk1[k >> 1] >> (16 * (k & 1))) & 0xffffu; const int e = (int)(p >> 11), rk = (int)(p & 0x7ffu); const size_t o_ = (size_t)e * IDXCAP + lbase[e] + rk; idx[o_] = slot0 + k; gidx[o_] = (k & 1) ? bfhi(gp1[k >> 1]) : bflo(gp1[k >> 1]); } }
        }
        __syncthreads();
        { const int t3 = wave * 64 + lane_id_volatile(); if (t3 < 32) lcnt[t3] = 0; }
        __syncthreads();
    }
}

__device__ __forceinline__ void ln2_phase(const Ctx& cx, const bf16_t* X1, const bf16_t* Y, bf16_t* XO, bf16_t* XB, float* OUT, const float* g, const float* bta, const int tid) {
    const int lane = tid & 63, wave = __builtin_amdgcn_readfirstlane(tid >> 6);
    const int gw = cx.vcu * 8 + wave, NGW = cx.G * 8;
    if constexpr (Y_F8) {
        for (int rp = gw; rp < NTOK / 2; rp += NGW) {
            u32x4 xa[2][2], ya[2][4];
#pragma unroll
            for (int r = 0; r < 2; ++r) { const size_t row = (size_t)rp * 2 + r;
                xa[r][0] = *(const u32x4*)(X1 + row * 1024 + 16 * lane); xa[r][1] = *(const u32x4*)(X1 + row * 1024 + 16 * lane + 8);
#pragma unroll
                for (int k = 0; k < 4; ++k) ya[r][k] = *(const u32x4*)((const unsigned char*)Y + (row * 4 + k) * 1024 + 16 * lane); }
            float v[2][16]; float s[2] = {0.f, 0.f};
#pragma unroll
            for (int r = 0; r < 2; ++r) {
#pragma unroll
                for (int i = 0; i < 4; ++i) { f32x2 lo = __builtin_amdgcn_cvt_pk_f32_fp8((int)ya[r][0][i], false), hi = __builtin_amdgcn_cvt_pk_f32_fp8((int)ya[r][0][i], true);
#pragma unroll
                    for (int k = 1; k < 4; ++k) { lo += __builtin_amdgcn_cvt_pk_f32_fp8((int)ya[r][k][i], false); hi += __builtin_amdgcn_cvt_pk_f32_fp8((int)ya[r][k][i], true); }
                    const unsigned xlo = xa[r][i >> 1][(i & 1) * 2], xhi = xa[r][i >> 1][(i & 1) * 2 + 1];
                    v[r][4 * i + 0] = bflo(xlo) * DN_ALPHA + lo[0] * (1.0f / Y_SCALE); v[r][4 * i + 1] = bfhi(xlo) * DN_ALPHA + lo[1] * (1.0f / Y_SCALE);
                    v[r][4 * i + 2] = bflo(xhi) * DN_ALPHA + hi[0] * (1.0f / Y_SCALE); v[r][4 * i + 3] = bfhi(xhi) * DN_ALPHA + hi[1] * (1.0f / Y_SCALE);
                    s[r] += (v[r][4 * i] + v[r][4 * i + 1]) + (v[r][4 * i + 2] + v[r][4 * i + 3]); } }
            const float mean0 = wave_sum(s[0], lane) * (1.0f / 1024.0f), mean1 = wave_sum(s[1], lane) * (1.0f / 1024.0f); float q[2] = {0.f, 0.f};
#pragma unroll
            for (int r = 0; r < 2; ++r)
#pragma unroll
                for (int e = 0; e < 16; ++e) { v[r][e] -= (r == 0 ? mean0 : mean1); q[r] += v[r][e] * v[r][e]; }
            const float rstd0 = rsqrtf(wave_sum(q[0], lane) * (1.0f / 1024.0f) + LN_EPS), rstd1 = rsqrtf(wave_sum(q[1], lane) * (1.0f / 1024.0f) + LN_EPS);
            unsigned wb[2][8]; unsigned w8[2][4];
#pragma unroll
            for (int j = 0; j < 4; ++j) { const f32x4 gvj = *(const f32x4*)(g + 16 * lane + 4 * j), bvj = *(const f32x4*)(bta + 16 * lane + 4 * j);
#pragma unroll
                for (int r = 0; r < 2; ++r) { const size_t row = (size_t)rp * 2 + r; const float rs = (r == 0 ? rstd0 : rstd1);
                    const f32x4 o = (f32x4){v[r][4 * j], v[r][4 * j + 1], v[r][4 * j + 2], v[r][4 * j + 3]} * rs * gvj + bvj;
                    if (OUT) *(f32x4*)(OUT + row * 1024 + 16 * lane + 4 * j) = o;
                    else { wb[r][2 * j] = pk2(o[0], o[1]); wb[r][2 * j + 1] = pk2(o[2], o[3]);
                        int t8 = 0; t8 = __builtin_amdgcn_cvt_pk_fp8_f32(o[0], o[1], t8, false); t8 = __builtin_amdgcn_cvt_pk_fp8_f32(o[2], o[3], t8, true); w8[r][j] = (unsigned)t8; } } }
            if (!OUT) {
#pragma unroll
                for (int r = 0; r < 2; ++r) { const size_t row = (size_t)rp * 2 + r;
                    *(u32x4*)(XO + row * 1024 + 16 * lane) = (u32x4){wb[r][0], wb[r][1], wb[r][2], wb[r][3]}; *(u32x4*)(XO + row * 1024 + 16 * lane + 8) = (u32x4){wb[r][4], wb[r][5], wb[r][6], wb[r][7]};
                    if constexpr (INP_F8) *(u32x4*)((unsigned char*)XB + row * 1024 + 16 * lane) = (u32x4){w8[r][0], w8[r][1], w8[r][2], w8[r][3]};
                    else { *(u32x4*)(XB + row * 1024 + 16 * lane) = (u32x4){wb[r][0], wb[r][1], wb[r][2], wb[r][3]}; *(u32x4*)(XB + row * 1024 + 16 * lane + 8) = (u32x4){wb[r][4], wb[r][5], wb[r][6], wb[r][7]}; } } }
        }
        return;
    }
    for (int rp = gw; rp < NTOK / 2; rp += NGW) {
        f32x4 v[2][4]; float s[2] = {0.f, 0.f};
#pragma unroll
        for (int r = 0; r < 2; ++r) { const size_t row = (size_t)rp * 2 + r;
#pragma unroll
            for (int j = 0; j < 4; ++j) { const u32x2 a = *(const u32x2*)(X1 + row * 1024 + 4 * lane + 256 * j); v[r][j] = (f32x4){bflo(a.x), bfhi(a.x), bflo(a.y), bfhi(a.y)} * DN_ALPHA;
#pragma unroll
                for (int k = 0; k < 4; ++k) {
                    if constexpr (Y_F8) { const int y8 = *(const int*)((const unsigned char*)Y + (row * 4 + k) * 1024 + 4 * lane + 256 * j); const f32x2 lo = __builtin_amdgcn_cvt_pk_f32_fp8(y8, false), hi = __builtin_amdgcn_cvt_pk_f32_fp8(y8, true);
                        v[r][j][0] += lo[0] * (1.0f / Y_SCALE); v[r][j][1] += lo[1] * (1.0f / Y_SCALE); v[r][j][2] += hi[0] * (1.0f / Y_SCALE); v[r][j][3] += hi[1] * (1.0f / Y_SCALE); }
                    else { const u32x2 y = *(const u32x2*)(Y + (row * 4 + k) * 1024 + 4 * lane + 256 * j); v[r][j][0] += bflo(y.x); v[r][j][1] += bfhi(y.x); v[r][j][2] += bflo(y.y); v[r][j][3] += bfhi(y.y); } }
                s[r] += (v[r][j][0] + v[r][j][1]) + (v[r][j][2] + v[r][j][3]); } }
        const float mean0 = wave_sum(s[0], lane) * (1.0f / 1024.0f), mean1 = wave_sum(s[1], lane) * (1.0f / 1024.0f); float q[2] = {0.f, 0.f};
#pragma unroll
        for (int r = 0; r < 2; ++r)
#pragma unroll
            for (int j = 0; j < 4; ++j) { v[r][j] = v[r][j] - (r == 0 ? mean0 : mean1); q[r] += (v[r][j][0] * v[r][j][0] + v[r][j][1] * v[r][j][1]) + (v[r][j][2] * v[r][j][2] + v[r][j][3] * v[r][j][3]); }
        const float rstd0 = rsqrtf(wave_sum(q[0], lane) * (1.0f / 1024.0f) + LN_EPS), rstd1 = rsqrtf(wave_sum(q[1], lane) * (1.0f / 1024.0f) + LN_EPS);
#pragma unroll
        for (int j = 0; j < 4; ++j) { const f32x4 gvj = *(const f32x4*)(g + 4 * lane + 256 * j), bvj = *(const f32x4*)(bta + 4 * lane + 256 * j);
#pragma unroll
            for (int r = 0; r < 2; ++r) { const size_t row = (size_t)rp * 2 + r; const f32x4 o = v[r][j] * (r == 0 ? rstd0 : rstd1) * gvj + bvj;
                if (OUT) *(f32x4*)(OUT + row * 1024 + 4 * lane + 256 * j) = o;
                else { u32x2 w; w.x = pk2(o[0], o[1]); w.y = pk2(o[2], o[3]); *(u32x2*)(XO + row * 1024 + 4 * lane + 256 * j) = w;
                    if constexpr (INP_F8) { int w8 = 0; w8 = __builtin_amdgcn_cvt_pk_fp8_f32(o[0], o[1], w8, false); w8 = __builtin_amdgcn_cvt_pk_fp8_f32(o[2], o[3], w8, true); *(int*)((unsigned char*)XB + row * 1024 + 4 * lane + 256 * j) = w8; }
                    else { *(u32x2*)(XB + row * 1024 + 4 * lane + 256 * j) = w; } } } }
    }
}

constexpr int PH_PER_LAYER = 10, N_PHASES = 2 + PH_PER_LAYER * DEPTH;
__host__ __device__ constexpr bool phase_active(int p) {
    if (p < 2) return true;
    const int l = (p - 2) / PH_PER_LAYER, k = (p - 2) % PH_PER_LAYER, kind = l % 3;
    if (k == 1) return kind != 0;
    if (k == 3 || k == 4) return kind == 2;
    return true;
}

__global__ void __launch_bounds__(512, 2) fwd(Args args) {
    extern __shared__ __attribute__((aligned(16))) unsigned char lds_raw[];
    const int wave0 = __builtin_amdgcn_readfirstlane((int)threadIdx.x >> 6);
    Ctx cx; cx.lds = (LAS unsigned char*)lds_raw; cx.G = gridDim.x; { const int bx = blockIdx.x; cx.vcu = (cx.G % 8 == 0) ? (bx % 8) * (cx.G / 8) + bx / 8 : bx; } cx.ws = args.ws;
    volatile LAS unsigned* MISC = (volatile LAS unsigned*)(cx.lds + MISC_OFF);
    for (int u = threadIdx.x; u < (LDS_BYTES - MISC_OFF) / 4; u += 512) MISC[u] = 0u;
    __syncthreads();
    if (threadIdx.x == 0) { LAS unsigned long long* t = (LAS unsigned long long*)(cx.lds + PTAB_OFF);
#pragma unroll
        for (int k = 0; k < 32; ++k) t[k] = (unsigned long long)args.in[k];
        t[32] = (unsigned long long)args.out; t[33] = (unsigned long long)args.ws; }
    __syncthreads();
    const int lo = args.ph_lo, hi = args.ph_hi;
    XcdBarrier bar; bar.bar = (unsigned*)((gu32*)(args.ws + WS_CTL) + CW_BAR); bar.x = 0; bar.st = nullptr;
    if (hi - lo > 1) bar = xcd_barrier_post((unsigned*)((gu32*)(args.ws + WS_CTL) + CW_BAR), MISC + 8);
    int ran = 0;
#define XB ((bf16_t*)(ws + WS_XB))
#define PROJ ((bf16_t*)(ws + WS_PROJ))
#define CAT ((bf16_t*)(ws + WS_CAT))
#define KVM ((bf16_t*)(ws + WS_KVM))
#define HB ((bf16_t*)(ws + WS_H))
#define YB ((bf16_t*)(ws + WS_Y))
#define QKR ((bf16_t*)(ws + WS_QKR))
#define EXPID ((int*)(ws + WS_EXPID))
#define GATE ((float*)(ws + WS_GATE))
#define IDX ((int*)(ws + WS_IDX))
#define XF ((float*)(GAS float*)ptab_get(cx, 32))
#define SB ((bf16_t*)(ws + WS_SB))
#define SB2 ((bf16_t*)(ws + WS_PROJ))
#define TP_BAR_BEGIN() do {} while (0)
#define TP_BAR_END() do {} while (0)
#define TP_PH_BEGIN(p) do {} while (0)
#define TP_PH_END(p) do {} while (0)
#define PH_BEGIN(p) if (lo <= (p) && (p) < hi) { const int ph_ = (p); if (ran) { TP_BAR_BEGIN(); for (int rb_ = 0; rb_ < REP_BAR; ++rb_) xcd_barrier(bar, wave0); TP_BAR_END(); } ran = 1; const int tid = opaque_tid(wave0); (void)tid; unsigned char* const ws = (unsigned char*)(GAS unsigned char*)ptab_get(cx, 33); cx.ws = ws; TP_PH_BEGIN(ph_);
#define PH_END TP_PH_END(ph_); }

#if EN_P0
    PH_BEGIN(0) for (int rep_ = 0; rep_ < REP_P0; ++rep_) { p0_prologue(cx, tid); } PH_END
#endif

    for (int l = -1; l < DEPTH; ++l) {
        const int kind = (l < 0) ? 0 : l % 3, jj = (l < 0) ? 0 : l / 3, pw = (l < 0) ? 2048 : ((l % 3) == 1 ? 1536 : 2560), base = 2 + PH_PER_LAYER * l;
        PH_BEGIN(l < 0 ? 1 : base) {
            pg8::DenseOrder S;
            if (l < 0) S.init(ws + WS_MEMB, ws + WS_WKV, NMEM, 2048, 1024 * INP_EB, cx.G, (int)blockIdx.x);
            else S.init(XB, ws + WS_WIN + (size_t)l * 5 * MiB, NTOK, pw, 1024 * INP_EB, cx.G, (int)blockIdx.x);
            S.rep = REP_DENSE;
            const unsigned smask = (l < 0) ? 0u : (kind == 0 ? 0x207u : kind == 1 ? 0x20u : 0x200u);
            pg8::EpiBf16s E{l < 0 ? KVM : PROJ, pw, smask, C2, INP_F8 ? 1.0f / WIN_SCALE : 1.0f};
#if EN_G1
            pg8::gemm_phase<pg8::EpiBf16s, pg8::DenseOrder, false, INP_F8 != 0>(cx.lds, S, E, tid);
#endif
        } PH_END
        if (l < 0) continue;
#if EN_THIN
        if (kind == 1) { PH_BEGIN(base + 1) for (int rep_ = 0; rep_ < REP_THIN; ++rep_) { rope_phase(cx, PROJ, INP(5) + jj * 64, INP(6) + jj * 64, QKR, tid); } PH_END }
        if (kind == 2) { PH_BEGIN(base + 1) for (int rep_ = 0; rep_ < REP_THIN; ++rep_) { sconv_phase(cx, PROJ, INP(8) + (size_t)jj * 3 * 2304, INP(9) + (size_t)jj * 2304, (bf16_t*)(ws + WS_UT3), ws + WS_V8, tid); } PH_END }
#endif
        for (int o = 0; o < 2; ++o) {
            if (o == 1 && kind != 2) break;
            PH_BEGIN(base + 2 + o) {
                if (kind == 2) {
                    const bf16_t* UT3 = (const bf16_t*)(ws + WS_UT3); constexpr size_t PS = (size_t)16 * 768 * 4096;
#if EN_TCONV
                    for (int rep_ = 0; rep_ < REP_TCONV; ++rep_) {
#if TCONV_F8
                    tconv8_phase(cx, o, o == 0 ? UT3 : (const bf16_t*)(ws + WS_Z1T), ws + WS_V8 + (size_t)o * 48 * MiB, UT3 + (size_t)(1 + o) * PS, (bf16_t*)(ws + (o == 0 ? WS_Z1T : WS_Z2T)), o == 0 ? ws + WS_V8 + 48 * MiB : (unsigned char*)nullptr, INP(19) + (size_t)(jj * 2 + o) * 768, tid);
#else
                    tconv_phase(cx, o, o == 0 ? UT3 : (const bf16_t*)(ws + WS_Z1T), UT3 + (size_t)(1 + o) * PS, (bf16_t*)(ws + (o == 0 ? WS_Z1T : WS_Z2T)), INP(19) + (size_t)(jj * 2 + o) * 768, tid);
#endif
                    }
#endif
                }
                if (o == 0) {
#if EN_NA
                    for (int rep_ = 0; rep_ < REP_NA; ++rep_) { if (kind == 0) na_phase(cx, PROJ, INP(3) + (size_t)jj * 12 * 465, CAT, tid); }
#endif
                    const int ngqa = (kind == 1) ? 3072 : 0;
                    for (int rep_ = 0; rep_ < REP_ATTN; ++rep_)
                    for (int u = cx.vcu; u < ngqa + 1024; u += cx.G) {
                        const attn_body::bf16 *Q, *K, *V; attn_body::bf16* O; int QP, KP, VP, NT;
                        if (u < ngqa) { const int qb = u & 15, hq = (u >> 4) % 12, b = u / 192, kvh = hq / 3;
                            Q = (const attn_body::bf16*)QKR + ((size_t)b * 4096 + qb * 256) * 1024 + hq * 64; QP = 1024;
                            K = (const attn_body::bf16*)QKR + (size_t)b * 4096 * 1024 + 768 + kvh * 64; KP = 1024;
                            V = (const attn_body::bf16*)PROJ + (size_t)b * 4096 * 1536 + 1024 + kvh * 64; VP = 1536;
                            O = (attn_body::bf16*)((unsigned char*)CAT + (((size_t)b * 4096 + qb * 256) * 1024 + hq * 64) * OUT_EB); NT = 64;
                        } else { const int v = u - ngqa, qb = v & 15, h = (v >> 4) & 3, b = v >> 6;
                            Q = (const attn_body::bf16*)PROJ + ((size_t)b * 4096 + qb * 256) * pw + (pw - 256) + h * 64; QP = pw;
                            K = (const attn_body::bf16*)KVM + (size_t)b * 256 * 2048 + 512 * l + h * 64; KP = 2048;
                            V = K + 256; VP = 2048;
                            O = (attn_body::bf16*)((unsigned char*)CAT + (((size_t)b * 4096 + qb * 256) * 1024 + 768 + h * 64) * OUT_EB); NT = 4;
                        }
#if EN_ATTN
                        attn_body::attn_unit<8, OUTP_F8 != 0>(Q, K, V, O, QP, KP, VP, 1024, NT, (char*)lds_raw, tid);
#endif
                    }
                }
            } PH_END
        }
#if EN_THIN
        if (kind == 2) { PH_BEGIN(base + 4) for (int rep_ = 0; rep_ < REP_THIN; ++rep_) { tback_phase(cx, (const bf16_t*)(ws + WS_Z2T), CAT, tid); } PH_END }
#endif
        PH_BEGIN(base + 5) {
            pg8::DenseOrder S; S.init(CAT, ws + WS_WOUT + (size_t)l * 2 * MiB, NTOK, 1024, 1024 * OUT_EB, cx.G, (int)blockIdx.x);
            pg8::EpiResB E{SB, l == 0 ? (const void*)INP(0) : (const void*)SB, l == 0 ? 1 : 0, 1024, DN_ALPHA, OUTP_F8 ? 1.0f / WOUT_SCALE : 1.0f};
#if EN_G2
            pg8::gemm_phase<pg8::EpiResB, pg8::DenseOrder, false, OUTP_F8 != 0>(cx.lds, S, E, tid);
#endif
        } PH_END
#if EN_LN
#if REP_LN1 > 1
        PH_BEGIN(base + 6) ln1_router_phase(cx, SB, (bf16_t*)(ws + WS_PROJ), CAT, INP(22) + l * 1024, INP(23) + l * 1024, INP(26) + (size_t)l * 1024 * 32, INP(27) + l * 32, (unsigned*)((gu32*)(ws + WS_CTL) + CW_DBG), EXPID, GATE, IDX, (float*)(ws + WS_GIDX), tid); PH_END
#endif
        PH_BEGIN(base + 6) ln1_router_phase(cx, SB, SB2, XB, INP(22) + l * 1024, INP(23) + l * 1024, INP(26) + (size_t)l * 1024 * 32, INP(27) + l * 32, (unsigned*)((gu32*)(ws + WS_CTL) + CW_CNT + 32 * l), EXPID, GATE, IDX, (float*)(ws + WS_GIDX), tid); PH_END
#endif
        for (int half = 0; half < 2; ++half) {
            PH_BEGIN(base + 7 + half) {
                LAS int* pref = (LAS int*)(cx.lds + pg8::STAGE_BYTES); const unsigned* cntw = (const unsigned*)((gu32*)(ws + WS_CTL) + CW_CNT + 32 * l);
                __syncthreads();
                if (tid < NEXP) { const int c = (int)__hip_atomic_load(cntw + tid, __ATOMIC_RELAXED, __HIP_MEMORY_SCOPE_AGENT); pref[40 + tid] = c; pref[72 + tid] = (c + 255) >> 8; }
                __syncthreads();
                if (tid == 0) { int a = 0;
#pragma unroll 1
                    for (int e = 0; e < NEXP; ++e) { pref[e] = a; a += pref[72 + e]; } pref[NEXP] = a; }
                __syncthreads();
#if STAGGER
                if (cx.vcu & 1) { for (int s_ = 0; s_ < STAGGER; ++s_) __builtin_amdgcn_s_sleep(127); }
#endif
                if (half == 0) {
                    pg8::MoeOrder<2> S{(const char*)XB, (const char*)(ws + WS_W1 + (size_t)l * 32 * 2048 * 1024 * MOE_EB), 1024 * MOE_EB, 8, cx.G, cx.vcu, (size_t)2048 * 1024 * MOE_EB, pref, (const int*)cntw, IDX};
                    pg8::EpiSwiglu E{HB, INP(29) + (size_t)l * 32 * 2048};
#if EN_G3
                    for (int rep_ = 0; rep_ < REP_G3; ++rep_) { pg8::gemm_phase<pg8::EpiSwiglu, pg8::MoeOrder<2>, true, MOE_F8 != 0, (MOE_F8 != 0) && (DEFER_H != 0)>(cx.lds, S, E, tid); }
#endif
                } else {
                    pg8::MoeOrder<0> S{(const char*)HB, (const char*)(ws + WS_W2 + (size_t)l * 32 * 1024 * 1024 * MOE_EB), 1024 * MOE_EB, 4, cx.G, cx.vcu, (size_t)1024 * 1024 * MOE_EB, pref, (const int*)cntw, IDX};
                    pg8::EpiMoeOut E{YB, INP(31) + (size_t)l * 32 * 1024, (const float*)(ws + WS_GIDX)};
#if EN_G4
                    for (int rep_ = 0; rep_ < REP_G4; ++rep_) { pg8::gemm_phase<pg8::EpiMoeOut, pg8::MoeOrder<0>, true, MOE_F8 != 0>(cx.lds, S, E, tid); }
#endif
                }
            } PH_END
        }
#if EN_LN
#if REP_LN2 > 1
        PH_BEGIN(base + 9) ln2_phase(cx, SB, YB, (bf16_t*)(ws + WS_PROJ), CAT, (float*)nullptr, INP(24) + l * 1024, INP(25) + l * 1024, tid); PH_END
#endif
        PH_BEGIN(base + 9) ln2_phase(cx, SB2, YB, SB, XB, l == DEPTH - 1 ? XF : (float*)nullptr, INP(24) + l * 1024, INP(25) + l * 1024, tid); PH_END

#endif
    }
#undef PH_BEGIN
#undef PH_END
#undef XB
#undef PROJ
#undef CAT
#undef KVM
#undef HB
#undef YB
#undef QKR
#undef EXPID
#undef GATE
#undef IDX
#undef XF
#undef SB
#undef SB2
}

extern "C" void kernel_launch(void* const* d_in, const int* in_sizes, int n_in, void* d_out, int out_size, void* d_ws, size_t ws_size, hipStream_t stream) {
    static int grid = 0;
    if (grid == 0) {
        if (n_in != 32 || in_sizes[0] != NTOK * DM || out_size != NTOK * DM || ws_size < WS_END) { fprintf(stderr, "kernel_launch: unexpected problem (n_in %d, in0 %d, out %d, ws %zu < %zu); nothing launched\n", n_in, n_in > 0 ? in_sizes[0] : -1, out_size, ws_size, (size_t)WS_END); grid = -1; return; }
        int dev = 0, cus = 0, per_cu = 0;
        if (hipGetDevice(&dev) != hipSuccess || hipDeviceGetAttribute(&cus, hipDeviceAttributeMultiprocessorCount, dev) != hipSuccess) { fprintf(stderr, "kernel_launch: device query failed\n"); grid = -1; return; }
        if (hipFuncSetAttribute((const void*)fwd, hipFuncAttributeMaxDynamicSharedMemorySize, LDS_BYTES) != hipSuccess) { fprintf(stderr, "kernel_launch: hipFuncSetAttribute failed\n"); grid = -1; return; }
        if (hipOccupancyMaxActiveBlocksPerMultiprocessor(&per_cu, (const void*)fwd, 512, LDS_BYTES) != hipSuccess || per_cu < 1) fprintf(stderr, "kernel_launch: occupancy query reports %d blocks per CU\n", per_cu);
        (void)hipGetLastError();
        grid = cus;
    }
    if (grid < 0) return;
    if (hipMemsetAsync((char*)d_ws + WS_CTL, 0, CTL_ZERO_BYTES, stream) != hipSuccess) { fprintf(stderr, "kernel_launch: memset failed\n"); return; }
    Args a{};
    for (int i = 0; i < 32; ++i) a.in[i] = (const float*)d_in[i];
    a.out = (float*)d_out; a.ws = (unsigned char*)d_ws;
#if MK_MULTI
    for (int p = 0; p < N_PHASES && p <= DBG_LAST_PHASE; ++p) {
        if (!phase_active(p)) continue;
        a.ph_lo = p; a.ph_hi = p + 1;
        hipLaunchKernelGGL(fwd, dim3(grid), dim3(512), LDS_BYTES, stream, a);
#if DBG_CHECK
        dbg_after_phase(p, a, stream);
#endif
    }
#if DBG_CHECK
    hipLaunchKernelGGL(dbg_report, dim3(1024), dim3(256), 0, stream, (unsigned*)((char*)d_ws + WS_CTL) + CW_DBG, (float*)d_out);
#endif
#else
    a.ph_lo = 0; a.ph_hi = N_PHASES;
    hipLaunchKernelGGL(fwd, dim3(grid), dim3(512), LDS_BYTES, stream, a);
#endif
    const hipError_t le = hipPeekAtLastError();
    if (le != hipSuccess) fprintf(stderr, "kernel_launch: launch failed: %s\n", hipGetErrorName(le));
}
```

```cpp
#include <hip/hip_runtime.h>
#include <hip/hip_bf16.h>
#include <cstdio>
#include <cstdint>

#ifndef MK_MULTI
#define MK_MULTI 0
#endif
#ifndef DBG_CHECK
#define DBG_CHECK 0
#endif
#ifndef DBG_LAST_PHASE
#define DBG_LAST_PHASE 9999
#endif

#ifndef EN_P0
#define EN_P0 1
#define EN_G1 1
#define EN_THIN 1
#define EN_TCONV 1
#define EN_NA 1
#define EN_ATTN 1
#define EN_G2 1
#define EN_LN 1
#define EN_G3 1
#define EN_G4 1
#endif

#ifndef REP_P0
#define REP_P0 1
#endif
#ifndef REP_G1
#define REP_G1 1
#endif
#ifndef REP_NA
#define REP_NA 1
#endif
#ifndef REP_ATTN
#define REP_ATTN 1
#endif
#ifndef REP_TCONV
#define REP_TCONV 1
#endif
#ifndef REP_THIN
#define REP_THIN 1
#endif
#ifndef REP_G3
#define REP_G3 1
#endif
#ifndef REP_G4
#define REP_G4 1
#endif
#ifndef ALIGN_EPI
#define ALIGN_EPI 1
#endif
#ifndef NT_STORE
#define NT_STORE 0
#endif
#ifndef LN1_HOLD
#define LN1_HOLD 16
#endif
#ifndef DEFER_H
#define DEFER_H 0
#endif
#ifndef STAGGER
#define STAGGER 0
#endif
#ifndef REP_BAR
#define REP_BAR 1
#endif
#ifndef REP_DENSE
#define REP_DENSE 1
#endif
#ifndef REP_G2
#define REP_G2 1
#endif
#ifndef REP_LN1
#define REP_LN1 1
#endif
#ifndef REP_LN2
#define REP_LN2 1
#endif

#define GAS __attribute__((address_space(1)))
#define LAS __attribute__((address_space(3)))
typedef unsigned short bf16_t;
typedef short bf16x8 __attribute__((ext_vector_type(8)));
typedef short s16x4 __attribute__((ext_vector_type(4)));
typedef float f32x4 __attribute__((ext_vector_type(4)));
typedef float f32x2 __attribute__((ext_vector_type(2)));
typedef float f32x16 __attribute__((ext_vector_type(16)));
typedef unsigned u32x4 __attribute__((ext_vector_type(4)));
typedef unsigned u32x2 __attribute__((ext_vector_type(2)));
typedef GAS unsigned gu32;

constexpr int BATCH = 16, SEQ = 4096, DM = 1024, NTOK = BATCH * SEQ, DEPTH = 4;
constexpr int MEMLEN = 256, NMEM = BATCH * MEMLEN;
constexpr int NEXP = 32, NSLOT = NTOK * 4, IDXCAP = NTOK;
constexpr int GRIDW = 64;
constexpr float LN_EPS = 1e-5f;
constexpr float DN_ALPHA = 1.681792830507429f;
constexpr float LOG2E = 1.4426950408889634f;
constexpr float C2 = 0.125f * LOG2E;
__host__ __device__ constexpr int layer_kind(int l) { return l % 3; }
__host__ __device__ constexpr int layer_j(int l) { return l / 3; }
__host__ __device__ constexpr int in_width(int l) { return (l % 3) == 1 ? 1536 : 2560; }

#ifndef MOE_F8
#define MOE_F8 1
#endif
#ifndef INP_F8
#define INP_F8 1
#endif
constexpr int INP_EB = INP_F8 ? 1 : 2;
constexpr float WIN_SCALE = 32.0f;
#ifndef OUTP_F8
#define OUTP_F8 1
#endif
constexpr int OUT_EB = OUTP_F8 ? 1 : 2;
constexpr float WOUT_SCALE = 64.0f;
__device__ __forceinline__ unsigned char f2fp8(float x) { return (unsigned char)(__builtin_amdgcn_cvt_pk_fp8_f32(x, x, 0, false) & 0xff); }
#ifndef TCONV_F8
#define TCONV_F8 1
#endif
#ifndef Y_F8
#define Y_F8 1
#endif
constexpr float Y_SCALE = 64.0f;
constexpr int MOE_EB = MOE_F8 ? 1 : 2;
constexpr float W1_SCALE = 32.0f, W2_SCALE = 64.0f, H_SCALE = 4.0f;

constexpr size_t MiB = 1u << 20;
constexpr size_t WS_CTL = 0, CTL_ZERO_BYTES = 1 * MiB;
constexpr size_t WS_RW = 1 * MiB;
constexpr size_t WS_WIN = 2 * MiB;
constexpr size_t WS_WKV = 22 * MiB;
constexpr size_t WS_WOUT = 26 * MiB;
constexpr size_t WS_W1 = 34 * MiB;
constexpr size_t WS_W2 = 546 * MiB;
constexpr size_t WS_XB = 802 * MiB;
constexpr size_t WS_MEMB = 930 * MiB;
constexpr size_t WS_KVM = 938 * MiB;
constexpr size_t WS_PROJ = 954 * MiB;
constexpr size_t WS_CAT = 1274 * MiB;
constexpr size_t WS_H = 1402 * MiB;
constexpr size_t WS_Y = 1914 * MiB;
constexpr size_t WS_HRAWT = 2426 * MiB;
constexpr size_t WS_HPART = 2474 * MiB;
constexpr size_t WS_EXPID = 2478 * MiB;
constexpr size_t WS_GATE = 2479 * MiB;
constexpr size_t WS_IDX = 2480 * MiB;
constexpr size_t WS_SB = 2488 * MiB;
constexpr size_t WS_GIDX = 2616 * MiB;
constexpr size_t WS_END = 2624 * MiB;
constexpr size_t WS_UT3 = WS_H;
constexpr size_t WS_Z1T = WS_H + 288 * MiB;
constexpr size_t WS_Z2T = WS_H + 384 * MiB;
constexpr size_t WS_V8 = WS_Y;
constexpr size_t WS_QKR = WS_Y;
constexpr int CW_BAR = 4096;
constexpr int CW_CNT = 8192;
constexpr int CW_DBG = 12288;

constexpr int MISC_OFF = 150528;
constexpr int LDS_BYTES = 163840;

#define LDS_WAIT() asm volatile("s_waitcnt lgkmcnt(0)" ::: "memory")
#define VM_WAIT() asm volatile("s_waitcnt vmcnt(0)" ::: "memory")
__device__ __forceinline__ unsigned f2bf(float f) { unsigned u = __builtin_bit_cast(unsigned, f); return (u + 0x7fffu + ((u >> 16) & 1u)) >> 16; }
__device__ __forceinline__ unsigned pk2(float lo, float hi) { return f2bf(lo) | (f2bf(hi) << 16); }
__device__ __forceinline__ float bf2f(unsigned short b) { return __builtin_bit_cast(float, ((unsigned)b) << 16); }
__device__ __forceinline__ float bflo(unsigned w) { return __builtin_bit_cast(float, w << 16); }
__device__ __forceinline__ float bfhi(unsigned w) { return __builtin_bit_cast(float, w & 0xffff0000u); }
__device__ __forceinline__ float shflx(float v, int mask, int lane) { int t; asm volatile("v_mov_b32 %0, %1" : "=v"(t) : "v"(__builtin_bit_cast(int, v))); return __builtin_bit_cast(float, __builtin_amdgcn_ds_bpermute((lane ^ mask) << 2, t)); }
__device__ __forceinline__ int shflxi(int v, int mask, int lane) { return __builtin_amdgcn_ds_bpermute((lane ^ mask) << 2, v); }
template <int CTRL> __device__ __forceinline__ float dpp_x(float v) { return __builtin_bit_cast(float, __builtin_amdgcn_update_dpp(0, __builtin_bit_cast(int, v), CTRL, 0xF, 0xF, false)); }
__device__ __forceinline__ float group8_sum(float v) { v += dpp_x<0xB1>(v); v += dpp_x<0x4E>(v); v += dpp_x<0x141>(v); return v; }
__device__ __forceinline__ float wave_sum(float v, int  ) {
    v += dpp_x<0xB1>(v); v += dpp_x<0x4E>(v); v += dpp_x<0x141>(v); v += dpp_x<0x140>(v);
    v += __builtin_bit_cast(float, __builtin_amdgcn_update_dpp(0, __builtin_bit_cast(int, v), 0x142, 0xA, 0xF, false));
    v += __builtin_bit_cast(float, __builtin_amdgcn_update_dpp(0, __builtin_bit_cast(int, v), 0x143, 0xC, 0xF, false));
    return __builtin_bit_cast(float, __builtin_amdgcn_readlane(__builtin_bit_cast(int, v), 63));
}
__device__ __forceinline__ int lane_id_volatile() { int l; asm volatile("v_mbcnt_lo_u32_b32 %0, -1, 0\n\tv_mbcnt_hi_u32_b32 %0, -1, %0" : "=&v"(l)); return l; }
__device__ __forceinline__ int opaque_tid(int wave0) { return wave0 * 64 + lane_id_volatile(); }

#define XB_TMO      128
#define XB_XCNT(j)  (256  + 64 * (j))
#define XB_XSUB(j)  (1280 + 64 * (j))
#define XB_XGEN(j)  (2304 + 64 * (j))
#define XB_TOP      3328
#define XB_TOPGEN   3392
#define XCD_BAR_WORDS 3456
#define XB_SPIN_CAP (1u << 20)

__device__ __forceinline__ unsigned xb_ld(unsigned* p)              { return __hip_atomic_load(p, __ATOMIC_RELAXED, __HIP_MEMORY_SCOPE_AGENT); }
__device__ __forceinline__ unsigned xb_add(unsigned* p, unsigned v) { return __hip_atomic_fetch_add(p, v, __ATOMIC_RELAXED, __HIP_MEMORY_SCOPE_AGENT); }
__device__ __forceinline__ unsigned xb_xcc_id() { return (unsigned)__builtin_amdgcn_s_getreg((3 << 11) | 20) & 0xFu; }
#define XB_SPIN(cond, bar) do { unsigned _sp = 0; while (cond) { __builtin_amdgcn_s_sleep(1); \
    if ((++_sp & 255u) == 0u) { if (xb_ld(&(bar)[XB_TMO])) break; if (_sp > XB_SPIN_CAP) { atomicAdd(&(bar)[XB_TMO], 1u); break; } } } } while (0)

struct XcdBarrier {
    unsigned* bar; unsigned x;
    volatile LAS unsigned* st;
};
__device__ __forceinline__ XcdBarrier xcd_barrier_post(unsigned* bar, volatile LAS unsigned* st) {
    XcdBarrier b; b.bar = bar; b.x = xb_xcc_id(); b.st = st;
    if (threadIdx.x == 0) (void)xb_add(&bar[XB_XCNT(b.x)], 1u);
    return b;
}
__device__ __forceinline__ void xcd_barrier_complete(unsigned* bar, unsigned x, unsigned& nloc, unsigned& nx) {
    const unsigned G = gridDim.x * gridDim.y * gridDim.z;
    unsigned sum, cnt, mine, sp = 0u;
    for (;;) {
        sum = 0u; cnt = 0u; mine = 0u;
#pragma unroll 1
        for (unsigned j = 0; j < 16; ++j) { const unsigned c = xb_ld(&bar[XB_XCNT(j)]); sum += c; cnt += (c > 0u) ? 1u : 0u; mine = (j == x) ? c : mine; }
        if (sum == G) break;
        __builtin_amdgcn_s_sleep(1);
        if ((++sp & 255u) == 0u) { if (xb_ld(&bar[XB_TMO])) break; if (sp > XB_SPIN_CAP) { atomicAdd(&bar[XB_TMO], 1u); break; } }
    }
    nloc = mine > 0u ? mine : 1u; nx = cnt > 0u ? cnt : 1u;
}
__device__ __forceinline__ void xcd_barrier(const XcdBarrier& b, const int wave0) {
    asm volatile("s_waitcnt vmcnt(0)" ::: "memory");
    __syncthreads();
    if (wave0 == 0 && lane_id_volatile() == 0) {
        unsigned* bar = b.bar;
        __builtin_amdgcn_s_waitcnt(0);
        unsigned nloc = b.st[0], nx = b.st[1];
        if (nloc == 0u) { xcd_barrier_complete(bar, b.x, nloc, nx); b.st[0] = nloc; b.st[1] = nx; }
        const unsigned old = xb_add(&bar[XB_XSUB(b.x)], 1u);
        const unsigned gen = old / nloc;
        if (old + 1u == (gen + 1u) * nloc) {
            __builtin_amdgcn_fence(__ATOMIC_RELEASE, "agent");
            asm volatile("s_waitcnt vmcnt(0)" ::: "memory");
            const unsigned og = xb_add(&bar[XB_TOP], 1u);
            const unsigned tg = og / nx;
            if (og + 1u == (tg + 1u) * nx) xb_add(&bar[XB_TOPGEN], 1u);
            else XB_SPIN(xb_ld(&bar[XB_TOPGEN]) == tg, bar);
            __builtin_amdgcn_fence(__ATOMIC_ACQUIRE, "agent");
            xb_add(&bar[XB_XGEN(b.x)], 1u);
            asm volatile("s_waitcnt vmcnt(0)" ::: "memory");
        } else {
            XB_SPIN(xb_ld(&bar[XB_XGEN(b.x)]) == gen, bar);
            __builtin_amdgcn_fence(__ATOMIC_ACQUIRE, "agent");
            asm volatile("s_waitcnt vmcnt(0)" ::: "memory");
        }
    }
    __syncthreads();
}

namespace pg8 {
constexpr int BM = 256, BK = 64, HALF = 128, HTB = HALF * BK * 2  , STAGE_BYTES = 8 * HTB, NXCD = 8, WGM = 8;
__host__ __device__ __forceinline__ int lds_byte(int r, int c) { const int st = (r >> 4) * 2 + (c >> 5), rr = r & 15, cc = c & 31, ob = rr * 64 + cc * 2; return st * 1024 + (ob ^ (((ob >> 9) & 1) << 5)); }
__host__ __device__ __forceinline__ void stage_rc(int b, int& R, int& C) { const int st = b / 1024, sb = b % 1024, swz = sb ^ (((sb >> 9) & 1) << 5); R = (st >> 1) * 16 + swz / 64; C = (st & 1) * 32 + (swz % 64) / 2; }
__host__ __device__ __forceinline__ int perm32(int rho) { const int n = rho >> 4, i = rho & 15; return 8 * (i >> 2) + 4 * n + (i & 3); }

struct Unit { int pm, pn, e, p; };

struct DenseOrder {
    const char* A; const char* Bt; int KB; int nM, nN, nwg, G, c; int rep = 1;
    __device__ __forceinline__ void init(const void* A_, const void* Bt_, int M, int N, int KB_, int G_, int c_) { A = (const char*)A_; Bt = (const char*)Bt_; KB = KB_; nM = M / BM; nN = N / BM; nwg = nM * nN; G = G_; c = c_; }
    __device__ __forceinline__ bool next(int i, Unit& u) const {
        long L = (long)i * G + c; if (L >= (long)nwg * rep) return false;
        if (rep > 1) L %= nwg;
        int wgid = (int)L; { const int q = nwg / NXCD, r = nwg % NXCD, xcd = wgid % NXCD, off = wgid / NXCD; wgid = (xcd < r ? xcd * (q + 1) : r * (q + 1) + (xcd - r) * q) + off; }
        const int nig = WGM * nN, gid = wgid / nig, fm = gid * WGM, gsz = (nM - fm) < WGM ? (nM - fm) : WGM;
        u.pm = __builtin_amdgcn_readfirstlane(fm + ((wgid % nig) % gsz)); u.pn = __builtin_amdgcn_readfirstlane((wgid % nig) / gsz); u.e = 0; u.p = 0; return true;
    }
    __device__ __forceinline__ const char* a_base(const Unit& u) const { return A + (size_t)u.pm * BM * KB; }
    __device__ __forceinline__ const char* b_base(const Unit& u) const { return Bt + (size_t)u.pn * BM * KB; }
    __device__ __forceinline__ const int* idx_src(const Unit&) const { return nullptr; }
    __device__ __forceinline__ int nvalid(const Unit&) const { return BM; }
    static constexpr int ROW_SHIFT = 0;
};
template <int SHIFT  > struct MoeOrder {
    const char* A; const char* Bt; int KB; int nN; int G, c; size_t bstride; const LAS int* pref; const int* cnt; const int* idx;
    __device__ __forceinline__ bool next(int i, Unit& u) const {
        const long L = (long)i * G + c; const int tot = __builtin_amdgcn_readfirstlane(pref[NEXP]);
        if (L >= (long)tot * nN) return false;
        const int pg = __builtin_amdgcn_readfirstlane((int)(L / nN)); u.pn = __builtin_amdgcn_readfirstlane((int)(L % nN));
        int e = 0;
#pragma unroll
        for (int step = 16; step >= 1; step >>= 1) { const int v = __builtin_amdgcn_readfirstlane(pref[e + step]); e += (v <= pg) ? step : 0; }
        u.e = e; u.p = pg - __builtin_amdgcn_readfirstlane(pref[e]); u.pm = 0; return true;
    }
    __device__ __forceinline__ const char* a_base(const Unit&) const { return A; }
    __device__ __forceinline__ const char* b_base(const Unit& u) const { return Bt + (size_t)u.e * bstride + (size_t)u.pn * BM * KB; }
    __device__ __forceinline__ const int* idx_src(const Unit& u) const { return idx + (size_t)u.e * IDXCAP + u.p * BM; }
    __device__ __forceinline__ int nvalid(const Unit& u) const { const int n = __builtin_amdgcn_readfirstlane(pref[40 + u.e]) - u.p * BM; return n < BM ? n : BM; }
    static constexpr int ROW_SHIFT = SHIFT;
};

__device__ __forceinline__ unsigned cvt_pk_bf16(float lo, float hi) { unsigned r; asm volatile("v_cvt_pk_bf16_f32 %0, %1, %2" : "=v"(r) : "v"(lo), "v"(hi)); return r; }

struct EpiBf16s {
    static constexpr bool PERM = true; static constexpr bool HAS_BIAS = false;
    bf16_t* O; int ldc; unsigned smask; float scale; float base;
    __device__ __forceinline__ void operator()(const f32x4 (&acc)[2][2][4][2], const Unit& u, int wr, int wc, int fr, int fq) const {
        const int row0 = u.pm * BM + wr * 64 + fr, col0 = u.pn * BM + wc * 32 + 8 * fq;
        const float sc = (((smask >> u.pn) & 1u) ? scale : 1.f) * base;
#pragma unroll
        for (int ai = 0; ai < 2; ++ai)
#pragma unroll
            for (int m = 0; m < 4; ++m) { bf16_t* rowp = O + (size_t)(row0 + ai * HALF + m * 16) * ldc + col0;
#pragma unroll
                for (int bj = 0; bj < 2; ++bj) { const f32x4 v0 = acc[ai][bj][m][0] * sc, v1 = acc[ai][bj][m][1] * sc;
                    u32x4 w; w.x = cvt_pk_bf16(v0[0], v0[1]); w.y = cvt_pk_bf16(v0[2], v0[3]); w.z = cvt_pk_bf16(v1[0], v1[1]); w.w = cvt_pk_bf16(v1[2], v1[3]);
                    if (NT_STORE) __builtin_nontemporal_store(w, (u32x4*)(rowp + bj * HALF)); else *(u32x4*)(rowp + bj * HALF) = w; }
                asm volatile("" ::: "memory"); }
    }
};
struct EpiResB {
    static constexpr bool PERM = true; static constexpr bool HAS_BIAS = false;
    bf16_t* C; const void* res; int res_f32; int ldc; float alpha; float ascale;
    __device__ __forceinline__ void operator()(const f32x4 (&acc)[2][2][4][2], const Unit& u, int wr, int wc, int fr, int fq) const {
        const int row0 = u.pm * BM + wr * 64 + fr, col0 = u.pn * BM + wc * 32 + 8 * fq;
        if (res_f32) {
#pragma unroll
            for (int ai = 0; ai < 2; ++ai) { f32x4 r[4][2][2];
#pragma unroll
                for (int m = 0; m < 4; ++m)
#pragma unroll
                    for (int bj = 0; bj < 2; ++bj) { const float* rp = (const float*)res + (size_t)(row0 + ai * HALF + m * 16) * ldc + col0 + bj * HALF; r[m][bj][0] = *(const f32x4*)rp; r[m][bj][1] = *(const f32x4*)(rp + 4); }
#pragma unroll
                for (int m = 0; m < 4; ++m)
#pragma unroll
                    for (int bj = 0; bj < 2; ++bj) { const size_t off = (size_t)(row0 + ai * HALF + m * 16) * ldc + col0 + bj * HALF;
                        const f32x4 v0 = r[m][bj][0] * alpha + acc[ai][bj][m][0] * ascale, v1 = r[m][bj][1] * alpha + acc[ai][bj][m][1] * ascale;
                        u32x4 w; w.x = cvt_pk_bf16(v0[0], v0[1]); w.y = cvt_pk_bf16(v0[2], v0[3]); w.z = cvt_pk_bf16(v1[0], v1[1]); w.w = cvt_pk_bf16(v1[2], v1[3]);
                        *(u32x4*)(C + off) = w; }
                asm volatile("" ::: "memory"); }
        } else { u32x4 raw[2][4][2];
#pragma unroll
            for (int ai = 0; ai < 2; ++ai)
#pragma unroll
                for (int m = 0; m < 4; ++m)
#pragma unroll
                    for (int bj = 0; bj < 2; ++bj) raw[ai][m][bj] = *(const u32x4*)((const bf16_t*)res + (size_t)(row0 + ai * HALF + m * 16) * ldc + col0 + bj * HALF);
#pragma unroll
            for (int ai = 0; ai < 2; ++ai)
#pragma unroll
                for (int m = 0; m < 4; ++m)
#pragma unroll
                    for (int bj = 0; bj < 2; ++bj) { const size_t off = (size_t)(row0 + ai * HALF + m * 16) * ldc + col0 + bj * HALF; const u32x4 rw = raw[ai][m][bj];
                        const f32x4 r0 = (f32x4){bflo(rw.x), bfhi(rw.x), bflo(rw.y), bfhi(rw.y)}, r1 = (f32x4){bflo(rw.z), bfhi(rw.z), bflo(rw.w), bfhi(rw.w)};
                        const f32x4 v0 = r0 * alpha + acc[ai][bj][m][0] * ascale, v1 = r1 * alpha + acc[ai][bj][m][1] * ascale;
                        u32x4 w; w.x = cvt_pk_bf16(v0[0], v0[1]); w.y = cvt_pk_bf16(v0[2], v0[3]); w.z = cvt_pk_bf16(v1[0], v1[1]); w.w = cvt_pk_bf16(v1[2], v1[3]);
                        *(u32x4*)(C + off) = w; }
        }
    }
};
struct Pend { u32x2 val[8]; };
struct EpiSwiglu {
    static constexpr bool PERM = true; static constexpr bool HAS_GATE = false; static constexpr bool HAS_BIAS = true;
    __device__ __forceinline__ void load_bias(const Unit& u, int wc, int fq, f32x4 (&bp)[4]) const { const float* bg = b1 + (size_t)u.e * 2048 + u.pn * HALF + wc * 32 + 8 * fq; bp[0] = *(const f32x4*)bg; bp[1] = *(const f32x4*)(bg + 4); bp[2] = *(const f32x4*)(bg + 1024); bp[3] = *(const f32x4*)(bg + 1028); }
    bf16_t* H; const float* b1;
    __device__ __forceinline__ void prepare(const f32x4 (&acc)[2][2][4][2], const Unit& u, int wr, int wc, int fr, int fq, Pend& pd) const {
        constexpr float ASC = 1.0f / W1_SCALE;
        const int j0 = u.pn * HALF + wc * 32 + 8 * fq; const float* bg = b1 + (size_t)u.e * 2048 + j0; const float* bu = bg + 1024;
        const f32x4 bg0 = *(const f32x4*)bg, bg1 = *(const f32x4*)(bg + 4), bu0 = *(const f32x4*)bu, bu1 = *(const f32x4*)(bu + 4);
#pragma unroll
        for (int q8 = 0; q8 < 8; ++q8) { const int ai = q8 >> 2, m = q8 & 3;
            float o[8];
#pragma unroll
            for (int q = 0; q < 8; ++q) { const float gb = (q < 4 ? bg0[q & 3] : bg1[q & 3]), ub = (q < 4 ? bu0[q & 3] : bu1[q & 3]);
                float g = acc[ai][0][m][q >> 2][q & 3] * ASC + gb, uu = acc[ai][1][m][q >> 2][q & 3] * ASC + ub;
                g = fminf(g, 7.0f); uu = fminf(fmaxf(uu, -7.0f), 7.0f);
                const float sg = __builtin_amdgcn_rcpf(1.0f + __builtin_amdgcn_exp2f(-1.702f * LOG2E * g));
                o[q] = (uu + 1.0f) * (g * sg); }
            int w0 = 0, w1 = 0;
            w0 = __builtin_amdgcn_cvt_pk_fp8_f32(o[0] * H_SCALE, o[1] * H_SCALE, w0, false); w0 = __builtin_amdgcn_cvt_pk_fp8_f32(o[2] * H_SCALE, o[3] * H_SCALE, w0, true);
            w1 = __builtin_amdgcn_cvt_pk_fp8_f32(o[4] * H_SCALE, o[5] * H_SCALE, w1, false); w1 = __builtin_amdgcn_cvt_pk_fp8_f32(o[6] * H_SCALE, o[7] * H_SCALE, w1, true);
            pd.val[q8] = (u32x2){(unsigned)w0, (unsigned)w1}; }
    }
    __device__ __forceinline__ void store_one(const u32x2 v, const LAS int* ids, const int r, const int nv, const int j0) const { if (r < nv) { const int slot = ids[r]; *(u32x2*)((unsigned char*)H + (size_t)slot * 1024 + j0) = v; } }
    __device__ __forceinline__ void operator()(const f32x4 (&acc)[2][2][4][2], const Unit& u, int wr, int wc, int fr, int fq, const LAS int* ids, const int nv, const f32x4 (&bp)[4]) const {
        constexpr float ASC = MOE_F8 ? 1.0f / W1_SCALE : 1.0f;
        constexpr float HS = MOE_F8 ? H_SCALE : 1.0f, KK = -1.702f * LOG2E, GA = ASC * KK, UA = ASC * HS / KK, ULO = 8.0f * HS / KK, UHI = -6.0f * HS / KK, GLO = 7.0f * KK;
        const int j0 = u.pn * HALF + wc * 32 + 8 * fq;
        const f32x4 bg0 = bp[0] * KK, bg1 = bp[1] * KK; f32x4 bu0 = (bp[2] + 1.0f) * (HS / KK), bu1 = (bp[3] + 1.0f) * (HS / KK);
        asm volatile("" : "+v"(bu0), "+v"(bu1));
        int rb = wr * 64 + fr; asm volatile("" : "+v"(rb));
        const LAS int* idp = ids + rb; int slots[8];
#pragma unroll
        for (int q = 0; q < 8; ++q) slots[q] = idp[(q >> 2) * HALF + (q & 3) * 16];
#pragma unroll
        for (int ai = 0; ai < 2; ++ai)
#pragma unroll
            for (int m = 0; m < 4; ++m) { const int r = ai * HALF + m * 16 + rb;
                if (r < nv) { const int slot = slots[ai * 4 + m];
                    float o[8];
#pragma unroll
                    for (int q = 0; q < 8; ++q) { const float gb = (q < 4 ? bg0[q & 3] : bg1[q & 3]), ub = (q < 4 ? bu0[q & 3] : bu1[q & 3]);
                        const float gp = fmaxf(__builtin_fmaf(acc[ai][0][m][q >> 2][q & 3], GA, gb), GLO);
                        const float us = fminf(fmaxf(__builtin_fmaf(acc[ai][1][m][q >> 2][q & 3], UA, ub), ULO), UHI);
                        const float sg = __builtin_amdgcn_rcpf(1.0f + __builtin_amdgcn_exp2f(gp));
                        o[q] = us * (gp * sg); }
                    if constexpr (MOE_F8) { int w0 = 0, w1 = 0;
                        w0 = __builtin_amdgcn_cvt_pk_fp8_f32(o[0], o[1], w0, false); w0 = __builtin_amdgcn_cvt_pk_fp8_f32(o[2], o[3], w0, true);
                        w1 = __builtin_amdgcn_cvt_pk_fp8_f32(o[4], o[5], w1, false); w1 = __builtin_amdgcn_cvt_pk_fp8_f32(o[6], o[7], w1, true);
                        *(u32x2*)((unsigned char*)H + (size_t)slot * 1024 + j0) = (u32x2){(unsigned)w0, (unsigned)w1};
                    } else { u32x4 w; w.x = cvt_pk_bf16(o[0], o[1]); w.y = cvt_pk_bf16(o[2], o[3]); w.z = cvt_pk_bf16(o[4], o[5]); w.w = cvt_pk_bf16(o[6], o[7]);
                        *(u32x4*)(H + (size_t)slot * 1024 + j0) = w; } } }
    }
};
struct EpiMoeOut {
    static constexpr bool PERM = true; static constexpr bool HAS_GATE = true; static constexpr bool HAS_BIAS = true;
    __device__ __forceinline__ void load_bias(const Unit& u, int wc, int fq, f32x4 (&bp)[4]) const { const float* bb = b2 + (size_t)u.e * 1024 + u.pn * BM + wc * 32 + 8 * fq; bp[0] = *(const f32x4*)bb; bp[1] = *(const f32x4*)(bb + 4); bp[2] = *(const f32x4*)(bb + HALF); bp[3] = *(const f32x4*)(bb + HALF + 4); }
    bf16_t* Y; const float* b2;   const float* gidx;
    __device__ __forceinline__ void operator()(const f32x4 (&acc)[2][2][4][2], const Unit& u, int wr, int wc, int fr, int fq, const LAS int* ids, const int nv, const f32x4 (&bp)[4]) const {
        const LAS float* gts = (const LAS float*)(ids + 768);
        constexpr float OSC = MOE_F8 ? 1.0f / (H_SCALE * W2_SCALE) : 1.0f;
        const int c0 = u.pn * BM + wc * 32 + 8 * fq;
        f32x4 bv[2][2]; bv[0][0] = bp[0]; bv[0][1] = bp[1]; bv[1][0] = bp[2]; bv[1][1] = bp[3];
        int rb = wr * 64 + fr; asm volatile("" : "+v"(rb));
        const LAS int* idp = ids + rb; int slots[8];
#pragma unroll
        for (int q = 0; q < 8; ++q) slots[q] = idp[(q >> 2) * HALF + (q & 3) * 16];
#pragma unroll
        for (int ai = 0; ai < 2; ++ai)
#pragma unroll
            for (int m = 0; m < 4; ++m) { const int r = ai * HALF + m * 16 + rb;
                if (r < nv) { const int slot = slots[ai * 4 + m]; const float gt = gts[r];
                    if constexpr (Y_F8) {
                        unsigned pk[2][2];
#pragma unroll
                        for (int bj = 0; bj < 2; ++bj) { const f32x4 s0 = (acc[ai][bj][m][0] * OSC + bv[bj][0]) * (gt * Y_SCALE), s1 = (acc[ai][bj][m][1] * OSC + bv[bj][1]) * (gt * Y_SCALE); int w0 = 0, w1 = 0;
                            w0 = __builtin_amdgcn_cvt_pk_fp8_f32(s0[0], s0[1], w0, false); w0 = __builtin_amdgcn_cvt_pk_fp8_f32(s0[2], s0[3], w0, true); w1 = __builtin_amdgcn_cvt_pk_fp8_f32(s1[0], s1[1], w1, false); w1 = __builtin_amdgcn_cvt_pk_fp8_f32(s1[2], s1[3], w1, true);
                            pk[bj][0] = (unsigned)w0; pk[bj][1] = (unsigned)w1; }
                        const auto x0 = __builtin_amdgcn_permlane16_swap(pk[0][0], pk[1][0], false, false), x1 = __builtin_amdgcn_permlane16_swap(pk[0][1], pk[1][1], false, false);
                        *(u32x4*)((unsigned char*)Y + (size_t)slot * 1024 + c0 + ((fq & 1) ? 120 : 0)) = (u32x4){x0[0], x1[0], x0[1], x1[1]};
                    } else {
#pragma unroll
                    for (int bj = 0; bj < 2; ++bj) { const f32x4 v0 = (acc[ai][bj][m][0] * OSC + bv[bj][0]) * gt, v1 = (acc[ai][bj][m][1] * OSC + bv[bj][1]) * gt;
                        u32x4 w; w.x = cvt_pk_bf16(v0[0], v0[1]); w.y = cvt_pk_bf16(v0[2], v0[3]); w.z = cvt_pk_bf16(v1[0], v1[1]); w.w = cvt_pk_bf16(v1[2], v1[3]);
                        if (NT_STORE) __builtin_nontemporal_store(w, (u32x4*)(Y + (size_t)slot * 1024 + c0 + bj * HALF)); else *(u32x4*)(Y + (size_t)slot * 1024 + c0 + bj * HALF) = w; } } } }
    }
};

__device__ __forceinline__ const char* uni_ptr(const char* p) { const unsigned long long v = (unsigned long long)p; const unsigned lo = __builtin_amdgcn_readfirstlane((unsigned)v), hi = __builtin_amdgcn_readfirstlane((unsigned)(v >> 32)); return (const char*)(((unsigned long long)hi << 32) | lo); }
typedef int v4i_t __attribute__((ext_vector_type(4))); typedef int v8i_t __attribute__((ext_vector_type(8)));
__device__ __forceinline__ v8i_t cat8(const bf16x8 a, const bf16x8 b) { return __builtin_shufflevector(__builtin_bit_cast(v4i_t, a), __builtin_bit_cast(v4i_t, b), 0, 1, 2, 3, 4, 5, 6, 7); }
template <class Epi, class Sched, bool GATHER, bool F8 = false, bool DEFER = false>
__device__ __forceinline__ void gemm_phase(LAS unsigned char* lds, const Sched& S, const Epi& E, const int tid) {
    const int wid = __builtin_amdgcn_readfirstlane(tid >> 6), lane = tid & 63, wr = wid >> 2, wc = wid & 3, fr = lane & 15, fq = lane >> 4;
    const int KB = S.KB, nt = KB / 128;
    unsigned voffA[2], voffB[2];
#pragma unroll
    for (int i = 0; i < 2; ++i) { int R, C; stage_rc(tid * 16 + i * 8192, R, C); const int Rb = Epi::PERM ? ((R & ~31) + perm32(R & 31)) : R;
        voffA[i] = (unsigned)(R * KB + C * 2); voffB[i] = (unsigned)(Rb * KB + C * 2); }
    const size_t kstep = (size_t)(BK * 2);
    const size_t hstep = (size_t)HALF * KB;
    const unsigned ldsw = (unsigned)wid * 1024u;
    const int aoff = lds_byte(wr * 64 + fr, fq * 8), boff = lds_byte(wc * 32 + fr, fq * 8);
#define PG8_SA(b, h) (((b) * 2 + (h)) * HTB)
#define PG8_SB(b, h) ((4 + (b) * 2 + (h)) * HTB)
#define PG8_STAGE(bufoff, gbase, voff) do { const char* _gb = uni_ptr((const char*)(gbase)); _Pragma("unroll") for (int _i = 0; _i < 2; ++_i) \
        __builtin_amdgcn_global_load_lds((const unsigned*)(_gb + (voff)[_i]), (LAS unsigned*)(lds + (bufoff) + ldsw + _i * 8192), 16, 0, 0); } while (0)
#define PG8_STAGE_A(bufoff, kb, h, GO) do { if constexpr (GATHER) { PG8_STAGE(bufoff, kb, (GO)[h]); } else { PG8_STAGE(bufoff, (kb) + (h) * hstep, voffA); } } while (0)
#define PG8_LDA(dst, b, h) do { if constexpr (F8) { _Pragma("unroll") for (int m = 0; m < 4; ++m) dst##8[m] = cat8(*(const LAS bf16x8*)(lds + PG8_SA(b, h) + aoff + m * 2048), *(const LAS bf16x8*)(lds + PG8_SA(b, h) + aoff + m * 2048 + 1024)); } else { \
        _Pragma("unroll") for (int m = 0; m < 4; ++m) _Pragma("unroll") for (int k = 0; k < 2; ++k) dst[m][k] = *(const LAS bf16x8*)(lds + PG8_SA(b, h) + aoff + m * 2048 + k * 1024); } } while (0)
#define PG8_LDB(dst, b, h) do { if constexpr (F8) { _Pragma("unroll") for (int n = 0; n < 2; ++n) dst##8[n] = cat8(*(const LAS bf16x8*)(lds + PG8_SB(b, h) + boff + n * 2048), *(const LAS bf16x8*)(lds + PG8_SB(b, h) + boff + n * 2048 + 1024)); } else { \
        _Pragma("unroll") for (int n = 0; n < 2; ++n) _Pragma("unroll") for (int k = 0; k < 2; ++k) dst[n][k] = *(const LAS bf16x8*)(lds + PG8_SB(b, h) + boff + n * 2048 + k * 1024); } } while (0)
#define PG8_MMA(ai, bj, At, Bt) do { __builtin_amdgcn_s_setprio(1); if constexpr (F8) { _Pragma("unroll") for (int m = 0; m < 4; ++m) _Pragma("unroll") for (int n = 0; n < 2; ++n) \
        acc[ai][bj][m][n] = __builtin_amdgcn_mfma_scale_f32_16x16x128_f8f6f4(Bt##8[n], At##8[m], acc[ai][bj][m][n], 0, 0, 0, 0, 0, 0); } else { \
        _Pragma("unroll") for (int m = 0; m < 4; ++m) _Pragma("unroll") for (int n = 0; n < 2; ++n) _Pragma("unroll") for (int k = 0; k < 2; ++k) \
        acc[ai][bj][m][n] = __builtin_amdgcn_mfma_f32_16x16x32_bf16(Bt[n][k], At[m][k], acc[ai][bj][m][n], 0, 0, 0); } __builtin_amdgcn_s_setprio(0); } while (0)
#define PG8_WAIT_V(n) asm volatile("s_waitcnt vmcnt(" #n ")" ::: "memory")
#define PG8_WAIT_L(n) asm volatile("s_waitcnt lgkmcnt(" #n ")" ::: "memory")
#define PG8_BAR __builtin_amdgcn_s_barrier()
#define PG8_SCHED __builtin_amdgcn_sched_barrier(0)
    LAS int* const ibuf = (LAS int*)(lds + STAGE_BYTES + 512);
#define PG8_IDMA(u, b) do { if constexpr (GATHER) { __builtin_amdgcn_global_load_lds((const unsigned*)(S.idx_src(u) + 64 * (wid & 3) + lane), (LAS unsigned*)(ibuf + (b) * 256 + 64 * (wid & 3)), 4, 0, 0); \
        if constexpr (Epi::HAS_GATE) __builtin_amdgcn_global_load_lds((const unsigned*)(E.gidx + (S.idx_src(u) - S.idx) + 64 * (wid & 3) + lane), (LAS unsigned*)(ibuf + 768 + (b) * 256 + 64 * (wid & 3)), 4, 0, 0); } } while (0)
#define PG8_GOFF(dst, u, b) do { if constexpr (GATHER) { int _t = tid; asm volatile("" : "+v"(_t)); const int _nv = S.nvalid(u); _Pragma("unroll") for (int _i = 0; _i < 2; ++_i) { int _R, _C; stage_rc(_t * 16 + _i * 8192, _R, _C); \
        _Pragma("unroll") for (int _h = 0; _h < 2; ++_h) { const int _r = _R + _h * HALF; const unsigned _s = (unsigned)ibuf[(b) * 256 + (_r < _nv ? _r : 0)]; dst[_h][_i] = (_s >> Sched::ROW_SHIFT) * (unsigned)KB + (unsigned)_C * 2u; } } } } while (0)
    Unit cur, nxt; int ui = 0;
    if (!S.next(0, cur)) return;
    f32x4 acc[2][2][4][2];
#pragma unroll
    for (int a = 0; a < 2; ++a)
#pragma unroll
        for (int b = 0; b < 2; ++b)
#pragma unroll
            for (int m = 0; m < 4; ++m)
#pragma unroll
                for (int n = 0; n < 2; ++n) acc[a][b][m][n] = (f32x4){0.f, 0.f, 0.f, 0.f};
    bf16x8 At[4][2], B0[2][2], B1[2][2];
    v8i_t At8[4], B08[2], B18[2];
    unsigned gA[2][2] = {{0u, 0u}, {0u, 0u}}, gN[2][2] = {{0u, 0u}, {0u, 0u}};
    int bsel = 0;
    f32x4 bpre[4] = {(f32x4){0.f, 0.f, 0.f, 0.f}, (f32x4){0.f, 0.f, 0.f, 0.f}, (f32x4){0.f, 0.f, 0.f, 0.f}, (f32x4){0.f, 0.f, 0.f, 0.f}};
    Pend pend; int ppn = 0, pnv = 0, pq = 8, pbuf = 0;
    if constexpr (DEFER) {
#pragma unroll
        for (int q = 0; q < 8; ++q) pend.val[q] = (u32x2){0u, 0u}; }
#define PG8_PSTORE() do { if constexpr (DEFER) { const int _l3 = lane_id_volatile(); const int _nv = (pq < 8) ? pnv : 0; \
        E.store_one(pend.val[0], ibuf + pbuf * 256, ((pq >> 2) & 1) * HALF + (pq & 3) * 16 + wr * 64 + (_l3 & 15), _nv, ppn * HALF + wc * 32 + 8 * (_l3 >> 4)); \
        _Pragma("unroll") for (int _q = 0; _q < 7; ++_q) pend.val[_q] = pend.val[_q + 1]; ++pq; } } while (0)
    if constexpr (GATHER) { PG8_IDMA(cur, 0); PG8_WAIT_V(0); PG8_BAR; }
    PG8_GOFF(gA, cur, 0);
    const char* cA = S.a_base(cur); const char* cB = S.b_base(cur);
    PG8_STAGE(PG8_SB(0, 0), cB, voffB); PG8_STAGE(PG8_SB(0, 1), cB + hstep, voffB); PG8_STAGE_A(PG8_SA(0, 0), cA, 0, gA); PG8_STAGE_A(PG8_SA(0, 1), cA, 1, gA);
    if (wr == 1) PG8_BAR;
    PG8_WAIT_V(2); PG8_BAR;
    PG8_STAGE(PG8_SB(1, 0), cB + kstep, voffB); PG8_STAGE_A(PG8_SA(1, 0), cA + kstep, 0, gA); PG8_STAGE(PG8_SB(1, 1), cB + hstep + kstep, voffB);
    PG8_WAIT_V(6); PG8_BAR;
    for (;;) {
        const bool has_next = S.next(ui + 1, nxt);
        const char* nA = has_next ? S.a_base(nxt) : cA; const char* nB = has_next ? S.b_base(nxt) : cB;
        const int bnxt = (bsel == 2) ? 0 : bsel + 1;
        if constexpr (GATHER) { if (has_next) PG8_IDMA(nxt, bnxt); }
        for (int t = 0; t < nt; t += 2) {
            const bool last = (t == nt - 2);
            const char* a1 = cA + (size_t)(t + 1) * kstep;
            const char* a2 = last ? nA : cA + (size_t)(t + 2) * kstep; const char* b2 = last ? nB : cB + (size_t)(t + 2) * kstep;
            const char* a3 = a2 + kstep; const char* b3 = b2 + kstep;
            if constexpr (GATHER) { if (last && has_next) { PG8_GOFF(gN, nxt, bnxt); } }
            if constexpr (Epi::HAS_BIAS) { if (last) E.load_bias(cur, wc, lane_id_volatile() >> 4, bpre); }
            PG8_LDB(B0, 0, 0); PG8_LDB(B1, 0, 1); PG8_SCHED; PG8_LDA(At, 0, 0); PG8_STAGE_A(PG8_SA(1, 1), a1, 1, gA);
            if constexpr (GATHER) { if (last && has_next) { gA[0][0] = gN[0][0]; gA[0][1] = gN[0][1]; gA[1][0] = gN[1][0]; gA[1][1] = gN[1][1]; } }
            PG8_WAIT_V(8); PG8_WAIT_L(0); PG8_BAR; PG8_MMA(0, 0, At, B0); PG8_MMA(0, 1, At, B1); PG8_BAR; PG8_SCHED;
            PG8_LDA(At, 0, 1); PG8_STAGE(PG8_SB(0, 0), b2, voffB); PG8_STAGE(PG8_SB(0, 1), b2 + hstep, voffB); PG8_STAGE_A(PG8_SA(0, 0), a2, 0, gA);
            PG8_WAIT_V(8); PG8_WAIT_L(0); PG8_BAR; PG8_MMA(1, 0, At, B0); PG8_MMA(1, 1, At, B1); PG8_BAR; PG8_SCHED;
            PG8_PSTORE();
            PG8_LDB(B0, 1, 0); PG8_LDB(B1, 1, 1); PG8_SCHED; PG8_LDA(At, 1, 0); PG8_STAGE_A(PG8_SA(0, 1), a2, 1, gA);
            PG8_WAIT_V(8); PG8_WAIT_L(0); PG8_BAR; PG8_MMA(0, 0, At, B0); PG8_MMA(0, 1, At, B1); PG8_BAR; PG8_SCHED;
            PG8_LDA(At, 1, 1); PG8_STAGE(PG8_SB(1, 0), b3, voffB); PG8_STAGE(PG8_SB(1, 1), b3 + hstep, voffB); PG8_STAGE_A(PG8_SA(1, 0), a3, 0, gA);
            PG8_WAIT_V(8); PG8_WAIT_L(0); PG8_BAR; PG8_MMA(1, 0, At, B0); PG8_MMA(1, 1, At, B1); PG8_BAR; PG8_SCHED;
            PG8_PSTORE();
        }
        if (ALIGN_EPI) { if (wr == 0) PG8_BAR; }
        { const int l2 = lane_id_volatile(), fr2 = l2 & 15, fq2 = l2 >> 4;
          if constexpr (DEFER) { _Pragma("unroll") for (int _f = 0; _f < 8; ++_f) PG8_PSTORE();
              E.prepare(acc, cur, wr, wc, fr2, fq2, pend); ppn = cur.pn; pnv = S.nvalid(cur); pq = 0; pbuf = bsel; }
          else if constexpr (GATHER) E(acc, cur, wr, wc, fr2, fq2, ibuf + bsel * 256, S.nvalid(cur), bpre); else E(acc, cur, wr, wc, fr2, fq2); }
        if (!has_next) break;
#pragma unroll
        for (int a = 0; a < 2; ++a)
#pragma unroll
            for (int b = 0; b < 2; ++b)
#pragma unroll
                for (int m = 0; m < 4; ++m)
#pragma unroll
                    for (int n = 0; n < 2; ++n) acc[a][b][m][n] = (f32x4){0.f, 0.f, 0.f, 0.f};
        cur = nxt; cA = nA; cB = nB; ++ui; bsel = bnxt;
        if (ALIGN_EPI) { if (wr == 1) PG8_BAR; }
    }
    if constexpr (DEFER) { _Pragma("unroll") for (int _f = 0; _f < 8; ++_f) PG8_PSTORE(); }
    PG8_WAIT_V(0);
    if (!ALIGN_EPI) { if (wr == 0) PG8_BAR; }
    PG8_BAR;
#undef PG8_PSTORE
#undef PG8_SA
#undef PG8_SB
#undef PG8_STAGE
#undef PG8_STAGE_A
#undef PG8_LDA
#undef PG8_LDB
#undef PG8_MMA
#undef PG8_WAIT_V
#undef PG8_WAIT_L
#undef PG8_BAR
#undef PG8_SCHED
#undef PG8_GOFF
#undef PG8_IDMA
}
}

namespace attn_body {
using bf16=__hip_bfloat16;
using bf16x8=__attribute__((ext_vector_type(8)))short;
using s16x4=__attribute__((ext_vector_type(4)))short;
using f32x16=__attribute__((ext_vector_type(16)))float;
using u32x4=__attribute__((ext_vector_type(4)))unsigned;
constexpr int D=64;
constexpr int NW=8,QBLK=32,QB=QBLK*NW,KVBLK=64;
constexpr int ATTN_UNIT_ROWS=QB;
__device__ __forceinline__ int crow(int r,int hi){return (r&3)+8*(r>>2)+4*hi;}
#define SBAR() __builtin_amdgcn_sched_barrier(0)
__device__ __forceinline__ void cmask(f32x16&p0,f32x16&p1,int jb,int qrel,int hi){
  const float NEG=-INFINITY; int kb=64*jb+4*hi;
  #pragma unroll
  for(int r=0;r<16;++r){int kv=kb+(r&3)+8*(r>>2); if(kv>qrel)p0[r]=NEG; if(kv+32>qrel)p1[r]=NEG;}
}

constexpr int NSLOT=3, SLOTB=8192;
constexpr int LDS_K=0, LDS_V=NSLOT*SLOTB, LDS_WS=2*NSLOT*SLOTB, LDS_OST=LDS_WS+NW*64*4, LDS_BYTES=LDS_OST+NW*4096;
constexpr float C2=0.125f*1.4426950408889634f;
__device__ __forceinline__ void glds16(const void*gsrc,unsigned lds_dst){unsigned keep;
  asm volatile("s_mov_b32 %0, m0\n\ts_mov_b32 m0, %2\n\ts_nop 0\n\tglobal_load_lds_dwordx4 %1, off\n\ts_mov_b32 m0, %0":"=&s"(keep):"v"(gsrc),"s"(lds_dst):"memory");}
__device__ __forceinline__ float max3f(float a,float b,float c){float r;asm("v_max3_f32 %0, %1, %2, %3":"=v"(r):"v"(a),"v"(b),"v"(c));return r;}
__device__ __forceinline__ float max2f(float a,float b){float r;asm("v_max_f32_e32 %0, %1, %2":"=v"(r):"v"(a),"v"(b));return r;}
__device__ __forceinline__ float fadd_s(float a,float b){float r;asm("v_add_f32_e32 %0, %1, %2":"=v"(r):"v"(a),"v"(b));return r;}
__device__ __forceinline__ float fsub_s(float a,float b){float r;asm("v_sub_f32_e32 %0, %1, %2":"=v"(r):"v"(a),"v"(b));return r;}
typedef float f32x2_t __attribute__((ext_vector_type(2))); typedef __bf16 bf16x2_t __attribute__((ext_vector_type(2)));
__device__ __forceinline__ unsigned cvtpk_s(float lo,float hi){f32x2_t v={lo,hi};bf16x2_t b=__builtin_convertvector(v,bf16x2_t);return __builtin_bit_cast(unsigned,b);}
#define WAIT_BAR(N) asm volatile("s_waitcnt vmcnt(" #N ") lgkmcnt(0)\n\ts_barrier":::"memory")

__device__ __forceinline__ void qkt(f32x16&p0,f32x16&p1,const char*Kslot,const bf16x8*qr,const f32x16&negm,int r32,int hi){
  const char*kb=Kslot+hi*1024+r32*16;
  #pragma unroll
  for(int d0=0;d0<4;++d0){
    const bf16x8 b0=*reinterpret_cast<const bf16x8*>(kb+d0*2048);
    const bf16x8 b1=*reinterpret_cast<const bf16x8*>(kb+d0*2048+512);
    if(d0==0){p0=__builtin_amdgcn_mfma_f32_32x32x16_bf16(b0,qr[0],negm,0,0,0);p1=__builtin_amdgcn_mfma_f32_32x32x16_bf16(b1,qr[0],negm,0,0,0);}
    else{p0=__builtin_amdgcn_mfma_f32_32x32x16_bf16(b0,qr[d0],p0,0,0,0);p1=__builtin_amdgcn_mfma_f32_32x32x16_bf16(b1,qr[d0],p1,0,0,0);}}
}
typedef __attribute__((address_space(3))) const char* lds_cptr;
typedef short v4i16_t __attribute__((ext_vector_type(4)));
__device__ __forceinline__ void kload8(bf16x8*kf,lds_cptr kp){
  kf[0]=*(const __attribute__((address_space(3))) bf16x8*)(kp);      kf[1]=*(const __attribute__((address_space(3))) bf16x8*)(kp+512);
  kf[2]=*(const __attribute__((address_space(3))) bf16x8*)(kp+2048); kf[3]=*(const __attribute__((address_space(3))) bf16x8*)(kp+2560);
  kf[4]=*(const __attribute__((address_space(3))) bf16x8*)(kp+4096); kf[5]=*(const __attribute__((address_space(3))) bf16x8*)(kp+4608);
  kf[6]=*(const __attribute__((address_space(3))) bf16x8*)(kp+6144); kf[7]=*(const __attribute__((address_space(3))) bf16x8*)(kp+6656);
}
__device__ __forceinline__ void kload2(bf16x8*kf,lds_cptr kp,int j){ kf[2*j]=*(const __attribute__((address_space(3))) bf16x8*)(kp+j*2048); kf[2*j+1]=*(const __attribute__((address_space(3))) bf16x8*)(kp+j*2048+512); }
__device__ __forceinline__ s16x4 vtr(lds_cptr p){ return __builtin_bit_cast(s16x4,__builtin_amdgcn_ds_read_tr16_b64_v4i16((__attribute__((address_space(3))) v4i16_t*)p)); }
__device__ __forceinline__ float rowmax(const f32x16&p0,const f32x16&p1){
  float a=max3f(p0[0],p0[1],p1[0]),b=max3f(p0[2],p0[3],p1[1]);a=max3f(a,p1[2],p1[3]);
  #pragma unroll
  for(int r=4;r<16;r+=4){a=max3f(a,p0[r],p0[r+1]);b=max3f(b,p0[r+2],p0[r+3]);a=max3f(a,p1[r],p1[r+1]);b=max3f(b,p1[r+2],p1[r+3]);}
  const float m=max2f(a,b);
  auto rr=__builtin_amdgcn_permlane32_swap(__float_as_uint(m),__float_as_uint(m),false,false);
  return max2f(__uint_as_float(rr[0]),__uint_as_float(rr[1]));
}
__device__ __forceinline__ void pv(f32x16*o,int vb,bf16x8 pa0,bf16x8 pa1,bf16x8 pa2,bf16x8 pa3){
  #pragma unroll
  for(int d0=0;d0<2;++d0){s16x4 lo[4],hi[4];
    #pragma unroll
    for(int ks=0;ks<4;++ks){
      asm volatile("ds_read_b64_tr_b16 %0,%1 offset:%c2":"=&v"(lo[ks]):"v"(vb),"i"(d0*4096+ks*1024):"memory");
      asm volatile("ds_read_b64_tr_b16 %0,%1 offset:%c2":"=&v"(hi[ks]):"v"(vb),"i"(d0*4096+ks*1024+512):"memory");}
    asm volatile("s_waitcnt lgkmcnt(0)":::"memory");SBAR();
    #define PK(k) (bf16x8){lo[k][0],lo[k][1],lo[k][2],lo[k][3],hi[k][0],hi[k][1],hi[k][2],hi[k][3]}
    o[d0]=__builtin_amdgcn_mfma_f32_32x32x16_bf16(pa0,PK(0),o[d0],0,0,0);
    o[d0]=__builtin_amdgcn_mfma_f32_32x32x16_bf16(pa1,PK(1),o[d0],0,0,0);
    o[d0]=__builtin_amdgcn_mfma_f32_32x32x16_bf16(pa2,PK(2),o[d0],0,0,0);
    o[d0]=__builtin_amdgcn_mfma_f32_32x32x16_bf16(pa3,PK(3),o[d0],0,0,0);
    #undef PK
  }
}

#ifndef ATTN_STORE16
#define ATTN_STORE16(p,v) (*(u32x4*)(p)=(v))
#endif
template<int THRL, bool O8 = false> __device__ __forceinline__ void attn_unit(const bf16*Qu,const bf16*__restrict__ Kh,const bf16*__restrict__ Vh,bf16*Ou,const int QP,const int KP,const int VP,const int OP,const int NT,char*shm,const int tid){
  const int lane=tid&63,r32=lane&31,hi=lane>>5; const int wid=__builtin_amdgcn_readfirstlane(tid>>6);
  const bf16*Qw=Qu+(long)(wid*QBLK)*QP;
  const unsigned lds0=(unsigned)(uintptr_t)shm;
  float*wsf=(float*)(shm+LDS_WS)+wid*64;
  const bf16*ksrc=Kh+(long)lane*KP+wid*8;
  const bf16*vsrc=Vh+(long)(16*(wid&3)+(lane>>2))*VP+(wid>>2)*32+(lane&3)*8;
  const unsigned kdst=lds0+LDS_K+wid*1024, vdst=lds0+LDS_V+wid*1024;
  #define DMA_K(t,slot) glds16(ksrc+(long)(t)*KVBLK*KP,(unsigned)__builtin_amdgcn_readfirstlane(kdst+(slot)))
  #define DMA_V(t,slot) glds16(vsrc+(long)(t)*KVBLK*VP,(unsigned)__builtin_amdgcn_readfirstlane(vdst+(slot)))
  const int vb0=(int)(lds0+LDS_V)+((lane>>4)&1)*32+(lane&3)*8+(4*hi+((lane&15)>>2))*64;
  const char*Kbase=shm+LDS_K; bf16x8 kf[8];
  const lds_cptr shm3=(lds_cptr)shm; const lds_cptr kp0=shm3+LDS_K+hi*1024+r32*16; const lds_cptr vp0=shm3+LDS_V+((lane>>4)&1)*32+(lane&3)*8+(4*hi+((lane&15)>>2))*64;
  DMA_K(0,0);DMA_V(0,0);DMA_K(1,SLOTB);
  bf16x8 qr[4];
  #pragma unroll
  for(int d0=0;d0<4;++d0)qr[d0]=*reinterpret_cast<const bf16x8*>(&Qw[(long)r32*QP+d0*16+hi*8]);
  float mhat=0.f,l_reg=0.f;f32x16 o[2];f32x16 negm; { float z_=0.f; asm volatile("":"+v"(z_)); _Pragma("unroll") for(int r=0;r<16;++r){o[0][r]=z_;o[1][r]=z_;negm[r]=z_;} } asm volatile("":"+v"(negm));
  #define CMASK(P0,P1,t) do{}while(0)
  bool resc=false;
  #define START(P0,P1) do{ const float rm=rowmax(P0,P1); resc=false; \
    { const float dl=rm; mhat=fadd_s(mhat,dl); \
      _Pragma("unroll") for(int r=0;r<16;++r){P0[r]=fsub_s(P0[r],dl);P1[r]=fsub_s(P1[r],dl);} \
      _Pragma("unroll") for(int r=0;r<16;++r)negm[r]=-mhat; asm volatile("":"+v"(negm)); } \
    _Pragma("unroll") for(int r=0;r<16;++r)P0[r]=__builtin_amdgcn_exp2f(P0[r]); }while(0)
  #define RESC() do{ if(resc){ asm volatile("s_waitcnt lgkmcnt(0)":::"memory"); \
      _Pragma("unroll") for(int d_=0;d_<2;++d_) _Pragma("unroll") for(int r=0;r<16;++r)o[d_][r]*=wsf[crow(r,hi)]; } }while(0)
  f32x16 pA0,pA1,pB0,pB1;
  int sl_prev=0,sl_cur=0,sl_next=SLOTB;
  #define ROT() do{sl_prev=sl_cur;sl_cur=sl_next;sl_next=(sl_next==(NSLOT-1)*SLOTB)?0:sl_next+SLOTB;}while(0)
  DMA_K(2,2*SLOTB);
  WAIT_BAR(3);
  qkt(pA0,pA1,Kbase,qr,negm,r32,hi);asm volatile("s_nop 15\n\ts_nop 7":"+v"(pA0),"+v"(pA1));CMASK(pA0,pA1,0);
  START(pA0,pA1);
  _Pragma("unroll") for(int r=0;r<16;++r)pA1[r]=__builtin_amdgcn_exp2f(pA1[r]);
  WAIT_BAR(0);
  DMA_K(3,0);DMA_V(1,SLOTB);
  ROT();
  kload8(kf,kp0+sl_cur);
  WAIT_BAR(2);
  s16x4 vlo[8],vhi[8]; u32x4 pw0,pw1,pw2,pw3;
  #define PKW(P,B) cvtpk_s(P[B],P[B+1])
  #define PAF(k) __builtin_bit_cast(bf16x8,pw##k)
  #define VFR(i) (bf16x8){vlo[i][0],vlo[i][1],vlo[i][2],vlo[i][3],vhi[i][0],vhi[i][1],vhi[i][2],vhi[i][3]}
  #define PIN(x) asm volatile("":"+v"(x))
  #define MX3(a,b,c) __builtin_fmaxf(__builtin_fmaxf((a),(b)),(c))
  #define GAPA(MF,A0,A1,A2,A3,W0,W1,PW) do{ MF; sacc+=A0; sacc+=A1; sacc+=A2; sacc+=A3; PIN(sacc); W0; W1; PIN(PW); SBAR(); }while(0)
  #define EX(v) __builtin_amdgcn_exp2f(v)
  #define GAPB(MF,X,B) do{ MF; X[B]=EX(X[B]); X[B+1]=EX(X[B+1]); X[B+2]=EX(X[B+2]); X[B+3]=EX(X[B+3]); PIN(X); SBAR(); }while(0)
  #define VRD(i) do{ vlo[i]=vtr(vp_+(((i)>>2)*4096+((i)&3)*1024)); vhi[i]=vtr(vp_+(((i)>>2)*4096+((i)&3)*1024+512)); }while(0)
  #define KRD(G,j) do{ if(G){ kload2(kf,kp0+sl_next,j); SBAR(); } }while(0)
  #define STEP(C0,C1,P0,P1,t,GK,GV,GL) do{ SBAR(); \
    const lds_cptr vp_=vp0+sl_prev; \
    VRD(0); SBAR(); float sacc=(P0[0]+P0[1]); \
    GAPA(C0=__builtin_amdgcn_mfma_f32_32x32x16_bf16(kf[0],qr[0],negm,0,0,0), P0[2],P0[3],P0[4],P0[5],     pw0[0]=PKW(P0,0), pw0[1]=PKW(P0,2), pw0); \
    VRD(4); SBAR(); GAPA(C1=__builtin_amdgcn_mfma_f32_32x32x16_bf16(kf[1],qr[0],negm,0,0,0), P0[6],P0[7],P0[8],P0[9],     pw0[2]=PKW(P0,4), pw0[3]=PKW(P0,6), pw0); \
    VRD(1); SBAR(); GAPA(C0=__builtin_amdgcn_mfma_f32_32x32x16_bf16(kf[2],qr[1],C0,0,0,0),   P0[10],P0[11],P0[12],P0[13], pw1[0]=PKW(P0,8), pw1[1]=PKW(P0,10), pw1); \
    VRD(5); SBAR(); GAPA(C1=__builtin_amdgcn_mfma_f32_32x32x16_bf16(kf[3],qr[1],C1,0,0,0),   P0[14],P0[15],P1[0],P1[1],   pw1[2]=PKW(P0,12),pw1[3]=PKW(P0,14), pw1); \
    VRD(2); SBAR(); GAPA(C0=__builtin_amdgcn_mfma_f32_32x32x16_bf16(kf[4],qr[2],C0,0,0,0),   P1[2],P1[3],P1[4],P1[5],     pw2[0]=PKW(P1,0), pw2[1]=PKW(P1,2), pw2); \
    VRD(6); SBAR(); GAPA(C1=__builtin_amdgcn_mfma_f32_32x32x16_bf16(kf[5],qr[2],C1,0,0,0),   P1[6],P1[7],P1[8],P1[9],     pw2[2]=PKW(P1,4), pw2[3]=PKW(P1,6), pw2); \
    VRD(3); SBAR(); GAPA(C0=__builtin_amdgcn_mfma_f32_32x32x16_bf16(kf[6],qr[3],C0,0,0,0),   P1[10],P1[11],P1[12],P1[13], pw3[0]=PKW(P1,8), pw3[1]=PKW(P1,10), pw3); \
    VRD(7); SBAR(); GAPA(C1=__builtin_amdgcn_mfma_f32_32x32x16_bf16(kf[7],qr[3],C1,0,0,0),   P1[14],P1[15],0.f,0.f,       pw3[2]=PKW(P1,12),pw3[3]=PKW(P1,14), pw3); \
    l_reg+=sacc; \
    if(GK){DMA_K((t)+3,sl_cur);} if(GV){DMA_V((t)+1,sl_next);} \
    CMASK(C0,C1,t); \
    { float a=MX3(C0[0],C0[1],C1[0]),b=MX3(C0[2],C0[3],C1[1]); a=MX3(a,C1[2],C1[3]); \
      _Pragma("unroll") for(int r=4;r<16;r+=4){a=MX3(a,C0[r],C0[r+1]);b=MX3(b,C0[r+2],C0[r+3]);a=MX3(a,C1[r],C1[r+1]);b=MX3(b,C1[r+2],C1[r+3]);} \
      float rm=__builtin_fmaxf(a,b); { auto rr=__builtin_amdgcn_permlane32_swap(__float_as_uint(rm),__float_as_uint(rm),false,false); rm=__builtin_fmaxf(__uint_as_float(rr[0]),__uint_as_float(rr[1])); } \
      resc=false; \
      if(__builtin_expect(__any(rm>(float)THRL),0)){ const float dl=__builtin_fmaxf(rm,0.f); mhat+=dl; \
        _Pragma("unroll") for(int r=0;r<16;++r){C0[r]-=dl;C1[r]-=dl;} \
        _Pragma("unroll") for(int r=0;r<16;++r)negm[r]=-mhat; asm volatile("":"+v"(negm)); \
        const float f=__builtin_amdgcn_exp2f(-dl); l_reg*=f; if(hi==0)wsf[r32]=f; resc=true; } } \
    SBAR(); \
    GAPB(o[0]=__builtin_amdgcn_mfma_f32_32x32x16_bf16(PAF(0),VFR(0),o[0],0,0,0), C0,0); \
    GAPB(o[1]=__builtin_amdgcn_mfma_f32_32x32x16_bf16(PAF(0),VFR(4),o[1],0,0,0), C0,4); \
    KRD(GL,0); GAPB(o[0]=__builtin_amdgcn_mfma_f32_32x32x16_bf16(PAF(1),VFR(1),o[0],0,0,0), C0,8); \
    KRD(GL,1); GAPB(o[1]=__builtin_amdgcn_mfma_f32_32x32x16_bf16(PAF(1),VFR(5),o[1],0,0,0), C0,12); \
    KRD(GL,2); GAPB(o[0]=__builtin_amdgcn_mfma_f32_32x32x16_bf16(PAF(2),VFR(2),o[0],0,0,0), C1,0); \
    KRD(GL,3); GAPB(o[1]=__builtin_amdgcn_mfma_f32_32x32x16_bf16(PAF(2),VFR(6),o[1],0,0,0), C1,4); \
    GAPB(o[0]=__builtin_amdgcn_mfma_f32_32x32x16_bf16(PAF(3),VFR(3),o[0],0,0,0), C1,8); \
    GAPB(o[1]=__builtin_amdgcn_mfma_f32_32x32x16_bf16(PAF(3),VFR(7),o[1],0,0,0), C1,12); \
    }while(0)
  int t=1;
  #undef CMASK
  #define CMASK(P0,P1,t) do{}while(0)
  for(;t+5<NT;t+=2){
    STEP(pB0,pB1,pA0,pA1,t,true,true,true);     WAIT_BAR(2); RESC(); ROT();
    STEP(pA0,pA1,pB0,pB1,t+1,true,true,true);   WAIT_BAR(2); RESC(); ROT();
  }
  #undef CMASK
  #define CMASK(P0,P1,t) do{}while(0)
  #define ENDW(tt) do{ if((tt)+3<NT){WAIT_BAR(2);} else if((tt)+2<NT){WAIT_BAR(1);} else {WAIT_BAR(0);} }while(0)
  for(;t+1<NT;t+=2){
    STEP(pB0,pB1,pA0,pA1,t,(t+3<NT),(t+1<NT),(t+1<NT));       ENDW(t);   RESC(); ROT();
    STEP(pA0,pA1,pB0,pB1,t+1,(t+4<NT),(t+2<NT),(t+2<NT));     ENDW(t+1); RESC(); ROT();
  }
  STEP(pB0,pB1,pA0,pA1,NT-1,false,false,false); RESC();
  { float sacc=pB0[0]+pB0[1]; _Pragma("unroll") for(int r=2;r<16;++r)sacc+=pB0[r]; _Pragma("unroll") for(int r=0;r<16;++r)sacc+=pB1[r]; l_reg+=sacc;
    pw0=(u32x4){PKW(pB0,0),PKW(pB0,2),PKW(pB0,4),PKW(pB0,6)};pw1=(u32x4){PKW(pB0,8),PKW(pB0,10),PKW(pB0,12),PKW(pB0,14)};pw2=(u32x4){PKW(pB1,0),PKW(pB1,2),PKW(pB1,4),PKW(pB1,6)};pw3=(u32x4){PKW(pB1,8),PKW(pB1,10),PKW(pB1,12),PKW(pB1,14)};
    SBAR(); pv(o,vb0+sl_cur,PAF(0),PAF(1),PAF(2),PAF(3)); }
  #undef PKW
  #undef PAF
  #undef VFR
  #undef PIN
  #undef MX3
  #undef GAPA
  #undef GAPB
  #undef EX
  #undef VRD
  #undef KRD
  #undef STEP
  #undef ENDW
  {auto rr=__builtin_amdgcn_permlane32_swap(__float_as_uint(l_reg),__float_as_uint(l_reg),false,false);l_reg=__uint_as_float(rr[0])+__uint_as_float(rr[1]);}
  if(hi==0)wsf[32+r32]=l_reg;asm volatile("s_waitcnt lgkmcnt(0)":::"memory");
  float rli[16];
  #pragma unroll
  for(int r=0;r<16;++r)rli[r]=__builtin_amdgcn_rcpf(wsf[32+crow(r,hi)]);
  if constexpr (O8) {
    unsigned char*Ow8=(unsigned char*)Ou+(long)(wid*QBLK)*OP; unsigned char*stg8=(unsigned char*)(shm+LDS_OST)+wid*2048;
    #pragma unroll
    for(int r=0;r<16;++r){const int orow=crow(r,hi);
      #pragma unroll
      for(int d0=0;d0<2;++d0)stg8[orow*64+d0*32+r32]=f2fp8(o[d0][r]*rli[r]);}
    asm volatile("s_waitcnt lgkmcnt(0)":::"memory");
    #pragma unroll
    for(int i=0;i<2;++i){const int row=i*16+(lane>>2),ch=lane&3; const u32x4 v=*(const u32x4*)(stg8+row*64+ch*16); ATTN_STORE16(Ow8+(long)row*OP+ch*16,v);}
  } else {
  bf16*Ow=Ou+(long)(wid*QBLK)*OP;
  { bf16*stg=(bf16*)(shm+LDS_OST)+wid*2048;
    #pragma unroll
    for(int r=0;r<16;++r){const int orow=crow(r,hi);
      #pragma unroll
      for(int d0=0;d0<2;++d0)stg[orow*64+d0*32+r32]=__float2bfloat16(o[d0][r]*rli[r]);}
    asm volatile("s_waitcnt lgkmcnt(0)":::"memory");
    #pragma unroll
    for(int i=0;i<4;++i){const int row=i*8+(lane>>3),ch=lane&7; const u32x4 v=*(const u32x4*)(stg+row*64+ch*8); ATTN_STORE16(Ow+(long)row*OP+ch*8,v);} }
  }
  asm volatile("s_waitcnt lgkmcnt(0)\n\ts_barrier":::"memory");
  #undef DMA_K
  #undef DMA_V
  #undef CMASK
  #undef START
  #undef RESC
  #undef ROT
}
constexpr int ATTN_LDS_BYTES=LDS_BYTES;
#undef SBAR
#undef WAIT_BAR
}

struct Args { const float* in[32]; float* out; unsigned char* ws; int ph_lo, ph_hi; };
struct Ctx {
    LAS unsigned char* lds;
    int vcu, G;
    unsigned char* ws;
};
constexpr int PTAB_OFF = MISC_OFF + 256;
__device__ __forceinline__ unsigned long long ptab_get(const Ctx& cx, int k) {
    const LAS unsigned* t = (const LAS unsigned*)(cx.lds + PTAB_OFF) + 2 * k; const unsigned lo = __builtin_amdgcn_readfirstlane(t[0]), hi = __builtin_amdgcn_readfirstlane(t[1]);
    return ((unsigned long long)hi << 32) | lo;
}
#define INP(k) ((const float*)(GAS const float*)ptab_get(cx, (k)))

template <bool F8> __device__ __forceinline__ void p0_transpose64(const float* W, int N, int KB, unsigned char* WT, int k0, int n0, int dst_row0, float scale, LAS float* scr, int lane) {
    f32x4 v[16];
    const float* src = W + (size_t)(k0 + (lane >> 4)) * N + n0 + (lane & 15) * 4;
#pragma unroll
    for (int i = 0; i < 16; ++i) v[i] = *(const f32x4*)(src + (size_t)(4 * i) * N);
#pragma unroll
    for (int i = 0; i < 16; ++i) { LAS float* p = scr + (4 * i + (lane >> 4)) * 65 + (lane & 15) * 4; p[0] = v[i][0]; p[1] = v[i][1]; p[2] = v[i][2]; p[3] = v[i][3]; }
    LDS_WAIT(); asm volatile("" ::: "memory");
    if constexpr (!F8) {
        const int ns = lane >> 3, ch = lane & 7;
#pragma unroll
        for (int r8 = 0; r8 < 8; ++r8) { const int n = r8 * 8 + ns; const LAS float* s = scr + (8 * ch) * 65 + n;
            u32x4 o; o.x = pk2(s[0 * 65], s[1 * 65]); o.y = pk2(s[2 * 65], s[3 * 65]); o.z = pk2(s[4 * 65], s[5 * 65]); o.w = pk2(s[6 * 65], s[7 * 65]);
            *(GAS u32x4*)(WT + (size_t)(dst_row0 + n) * KB + (k0 + 8 * ch) * 2) = o; }
    } else {
        const int ns = lane >> 2, ch = lane & 3;
#pragma unroll
        for (int r4 = 0; r4 < 4; ++r4) { const int n = r4 * 16 + ns; const LAS float* s = scr + (16 * ch) * 65 + n; unsigned w[4];
#pragma unroll
            for (int q = 0; q < 4; ++q) { int r = 0; r = __builtin_amdgcn_cvt_pk_fp8_f32(s[(4 * q) * 65] * scale, s[(4 * q + 1) * 65] * scale, r, false); r = __builtin_amdgcn_cvt_pk_fp8_f32(s[(4 * q + 2) * 65] * scale, s[(4 * q + 3) * 65] * scale, r, true); w[q] = (unsigned)r; }
            *(GAS u32x4*)(WT + (size_t)(dst_row0 + n) * KB + k0 + 16 * ch) = (u32x4){w[0], w[1], w[2], w[3]}; }
    }
    LDS_WAIT(); asm volatile("" ::: "memory");
}
__device__ __forceinline__ void p0_prologue(const Ctx& cx, const int tid) {
    const int lane = tid & 63, wave = __builtin_amdgcn_readfirstlane(tid >> 6);
    LAS float* scr = (LAS float*)(cx.lds + wave * 16896);
    const int gw = cx.vcu * 8 + wave, NGW = cx.G * 8;
    constexpr int I_WIN0 = 16 * 40, I_WIN1 = 16 * 24, I_WKV = 16 * 8, I_WOUT = 16 * 16, I_W1 = 16 * 32, I_W2 = 16 * 16;
    constexpr int T_WIN = 3 * I_WIN0 + I_WIN1, T_WKV = 4 * I_WKV, T_WOUT = 4 * I_WOUT, T_W1 = 128 * I_W1, T_W2 = 128 * I_W2;
    constexpr int NITEMS = T_WIN + T_WKV + T_WOUT + T_W1 + T_W2;
    for (int it = gw; it < NITEMS; it += NGW) {
        int r = it;
        const float* W; unsigned char* WT; int N, nb, kb, dst_row0; bool isout = false;
        if (r < T_W1) {
            const int mi = r / I_W1, q = r % I_W1; N = 2048; kb = q / 32; nb = q % 32;
            W = INP(28) + (size_t)mi * 1024 * 2048; WT = cx.ws + WS_W1 + (size_t)mi * 2048 * 1024 * MOE_EB;
            const int n0 = nb * 64, isu = n0 >= 1024, j = n0 - isu * 1024;
            dst_row0 = (j >> 7) * 256 + isu * 128 + (j & 127);
            p0_transpose64<MOE_F8>(W, N, 1024 * MOE_EB, WT, kb * 64, nb * 64, dst_row0, W1_SCALE, scr, lane); continue;
        } else if ((r -= T_W1) < T_W2) {
            const int mi = r / I_W2, q = r % I_W2; N = 1024; kb = q / 16; nb = q % 16;
            W = INP(30) + (size_t)mi * 1024 * 1024; WT = cx.ws + WS_W2 + (size_t)mi * 1024 * 1024 * MOE_EB; dst_row0 = nb * 64;
            p0_transpose64<MOE_F8>(W, N, 1024 * MOE_EB, WT, kb * 64, nb * 64, dst_row0, W2_SCALE, scr, lane); continue;
        } else if ((r -= T_W2) < T_WIN) {
            int l, q;
            if (r < I_WIN0) { l = 0; q = r; } else if (r < I_WIN0 + I_WIN1) { l = 1; q = r - I_WIN0; } else if (r < 2 * I_WIN0 + I_WIN1) { l = 2; q = r - I_WIN0 - I_WIN1; } else { l = 3; q = r - 2 * I_WIN0 - I_WIN1; }
            N = in_width(l); const int nbn = N / 64; kb = q / nbn; nb = q % nbn;
            const int kind = layer_kind(l), j = layer_j(l);
            W = (kind == 0 ? INP(2) : kind == 1 ? INP(4) : INP(7)) + (size_t)j * 1024 * N;
            WT = cx.ws + WS_WIN + (size_t)l * 5 * MiB; dst_row0 = nb * 64;
        } else if ((r -= T_WIN) < T_WKV) {
            const int l = r / I_WKV, q = r % I_WKV; N = 512; kb = q / 8; nb = q % 8;
            W = INP(20) + (size_t)l * 1024 * 512; WT = cx.ws + WS_WKV; dst_row0 = l * 512 + nb * 64;
        } else {
            r -= T_WKV; const int l = r / I_WOUT, q = r % I_WOUT; N = 1024; kb = q / 16; nb = q % 16;
            W = INP(21) + (size_t)l * 1024 * 1024; WT = cx.ws + WS_WOUT + (size_t)l * 2 * MiB; dst_row0 = nb * 64; isout = true;
        }
        if (isout) p0_transpose64<OUTP_F8 != 0>(W, N, 1024 * OUT_EB, WT, kb * 64, nb * 64, dst_row0, OUTP_F8 ? WOUT_SCALE : 1.0f, scr, lane);
        else p0_transpose64<INP_F8 != 0>(W, N, 1024 * INP_EB, WT, kb * 64, nb * 64, dst_row0, INP_F8 ? WIN_SCALE : 1.0f, scr, lane);
    }
    {
        const size_t gt = (size_t)cx.vcu * 512 + tid, NT_ = (size_t)cx.G * 512;
        for (int which = 0; which < 2; ++which) {
            const f32x4* xs = (const f32x4*)(which == 0 ? INP(0) : INP(1)); unsigned char* xd = cx.ws + (which == 0 ? WS_XB : WS_MEMB); const size_t n8 = (size_t)(which == 0 ? NTOK : NMEM) * DM / 8;
#pragma unroll 4
            for (size_t i = gt; i < n8; i += NT_) { const f32x4 a = xs[2 * i], b = xs[2 * i + 1];
                if constexpr (INP_F8) { int w0 = 0, w1 = 0; w0 = __builtin_amdgcn_cvt_pk_fp8_f32(a[0], a[1], w0, false); w0 = __builtin_amdgcn_cvt_pk_fp8_f32(a[2], a[3], w0, true); w1 = __builtin_amdgcn_cvt_pk_fp8_f32(b[0], b[1], w1, false); w1 = __builtin_amdgcn_cvt_pk_fp8_f32(b[2], b[3], w1, true);
                    *(u32x2*)(xd + i * 8) = (u32x2){(unsigned)w0, (unsigned)w1}; }
                else { u32x4 o; o.x = pk2(a[0], a[1]); o.y = pk2(a[2], a[3]); o.z = pk2(b[0], b[1]); o.w = pk2(b[2], b[3]); *(u32x4*)(xd + i * 16) = o; } }
        }
    }
    { const float* rwp = INP(26); unsigned short* RW = (unsigned short*)(cx.ws + WS_RW);
      for (int i = cx.vcu * 512 + tid; i < 4 * 32768; i += cx.G * 512) { const int l = i >> 15, r = i & 32767, k = r >> 5, e = r & 31; const float w = rwp[i]; const unsigned hi = f2bf(w); const float wl = w - bf2f((unsigned short)hi);
          RW[((size_t)(l * 2 + 0) * 32 + e) * 1024 + k] = (unsigned short)hi; RW[((size_t)(l * 2 + 1) * 32 + e) * 1024 + k] = (unsigned short)f2bf(wl); } }
    {
        const float *fw1 = INP(10), *fb1 = INP(11), *fw2 = INP(12), *fb2 = INP(13), *fw3 = INP(14), *fb3 = INP(15), *fw4 = INP(16), *fb4 = INP(17), *ffr = INP(18);
        LAS float* z = (LAS float*)cx.lds; LAS float* h1 = z + 16 * 33; LAS float* h2 = h1 + 1024; LAS float* h3 = h2 + 1024;
        float* HRAWT = (float*)(cx.ws + WS_HRAWT); float* HPART = (float*)(cx.ws + WS_HPART);
        for (int it = cx.vcu; it < 256; it += cx.G) {
            __syncthreads();
            const int pos0 = it * 16;
            for (int i = tid; i < 16 * 33; i += 512) { const int p = i / 33, f = i % 33; const float pos = (float)(pos0 + p); float v;
                if (f == 0) v = pos / 4095.0f;
                else { const int k = (f - 1) & 15; const float fb = 1e-4f + (float)k * ((15.0f - 1e-4f) / 15.0f); const float ang = (6.283185307179586f * pos / 4096.0f) * fb; v = (f <= 16) ? cosf(ang) : -sinf(ang); }
                z[i] = v; }
            __syncthreads();
            for (int i = tid; i < 1024; i += 512) { const int p = i >> 6, o = i & 63; float a = fb1[o]; for (int f = 0; f < 33; ++f) a += z[p * 33 + f] * fw1[f * 64 + o]; h1[i] = sinf(ffr[o] * a); }
            __syncthreads();
            for (int i = tid; i < 1024; i += 512) { const int p = i >> 6, o = i & 63; float a = fb2[o]; for (int k = 0; k < 64; ++k) a += h1[p * 64 + k] * fw2[k * 64 + o]; h2[i] = sinf(ffr[o] * a); }
            __syncthreads();
            for (int i = tid; i < 1024; i += 512) { const int p = i >> 6, o = i & 63; float a = fb3[o]; for (int k = 0; k < 64; ++k) a += h2[p * 64 + k] * fw3[k * 64 + o]; h3[i] = sinf(ffr[o] * a); }
            __syncthreads();
            for (int col = tid; col < 3072; col += 512) {
                float a[16]; const float bb = fb4[col];
#pragma unroll
                for (int p = 0; p < 16; ++p) a[p] = bb;
                for (int k = 0; k < 64; ++k) { const float w = fw4[(size_t)k * 3072 + col];
#pragma unroll
                    for (int p = 0; p < 16; ++p) a[p] += h3[p * 64 + k] * w; }
                const int c = col % 768; const float mind = -3.0701134573253945f, maxd = -15.350567286626972f;
                const float delta = fabsf(mind + (maxd - mind) * ((float)c / 767.0f)); float asum = 0.f;
#pragma unroll
                for (int p = 0; p < 16; ++p) { const float t = (float)(pos0 + p) / 4095.0f; a[p] *= expf(-t * delta); asum += fabsf(a[p]); }
                f32x4* dst = (f32x4*)(HRAWT + (size_t)col * 4096 + pos0);
#pragma unroll
                for (int q = 0; q < 4; ++q) dst[q] = (f32x4){a[4 * q], a[4 * q + 1], a[4 * q + 2], a[4 * q + 3]};
                HPART[(size_t)it * 3072 + col] = asum;
            }
        }
    }
}

__device__ __forceinline__ s16x4 vtr(const LAS unsigned char* p) { typedef short v4i16_t __attribute__((ext_vector_type(4))); return __builtin_bit_cast(s16x4, __builtin_amdgcn_ds_read_tr16_b64_v4i16((LAS v4i16_t*)p)); }
__device__ __forceinline__ void na_phase(const Ctx& cx, const bf16_t* PROJ, const float* rpb, bf16_t* CAT, const int tid) {
    const int lane = tid & 63, wid = __builtin_amdgcn_readfirstlane(tid >> 6), m16 = lane & 15, q4 = lane >> 4;
    LAS unsigned char* Kb = cx.lds; LAS unsigned char* Vb = cx.lds + 73728; LAS float* biasL = (LAS float*)(cx.lds + 147456);
    constexpr int PW = 2560;
    u32x4 kv[9], vv[9]; float bpre = 0.f;
#define NA_LOAD(unit_) do { const int b_ = __builtin_amdgcn_readfirstlane((unit_) / 384), rem_ = __builtin_amdgcn_readfirstlane((unit_) % 384), h_ = rem_ >> 5, rp_ = rem_ & 31; int bs_ = 2 * rp_ - 4; bs_ = bs_ < 0 ? 0 : (bs_ > 56 ? 56 : bs_); bs_ = __builtin_amdgcn_readfirstlane(bs_); \
        _Pragma("unroll") for (int it = 0; it < 9; ++it) { const int i = tid + it * 512; const int brow = i >> 9, col = (i >> 3) & 63, ch = i & 7; int grow = bs_ + brow; grow = grow > 63 ? 63 : grow; \
            const size_t tok = (size_t)b_ * 4096 + grow * 64 + col; \
            kv[it] = *(const u32x4*)(PROJ + tok * PW + 768 + h_ * 64 + ch * 8); vv[it] = *(const u32x4*)(PROJ + tok * PW + 1536 + h_ * 64 + ch * 8); } \
        if (tid < 465) bpre = rpb[h_ * 465 + tid] * LOG2E; } while (0)
    int u0 = cx.vcu; asm volatile("" : "+s"(u0));
    if (u0 < 6144) NA_LOAD(u0);
    for (int unit = u0; unit < 6144; unit += cx.G) {
        const int b = unit / 384, rem = unit % 384, h = rem >> 5, rp = rem & 31;
        int bs = 2 * rp - 4; bs = bs < 0 ? 0 : (bs > 56 ? 56 : bs);
        __syncthreads();
#pragma unroll
        for (int it = 0; it < 9; ++it) { const int i = tid + it * 512; const int brow = i >> 9, col = (i >> 3) & 63, ch = i & 7;
            *(LAS u32x4*)(Kb + (brow * 64 + col) * 128 + ((ch ^ ((col >> 1) & 7)) << 4)) = kv[it];
            *(LAS u32x4*)(Vb + (brow * 64 + col) * 128 + ((ch ^ (col & 7)) << 4)) = vv[it]; }
        if (tid < 465) biasL[tid] = bpre;
        __syncthreads();
        if (unit + cx.G < 6144) NA_LOAD(unit + cx.G);
        const int r = 2 * rp + (wid >> 2), g = wid & 3;
        const int wc0 = (g == 0) ? 0 : (g == 1) ? 8 : (g == 2) ? 24 : 32;
        int r0 = r - 4; r0 = r0 < 0 ? 0 : (r0 > 56 ? 56 : r0); const int ro = r0 - bs;
        const int c = 16 * g + m16;
        const size_t tq = (size_t)b * 4096 + r * 64 + c;
        bf16x8 qf[2];
#pragma unroll
        for (int kk = 0; kk < 2; ++kk) qf[kk] = *(const bf16x8*)(PROJ + tq * PW + h * 64 + 32 * kk + 8 * q4);
        f32x4 S[16];
#pragma unroll
        for (int i = 0; i < 8; ++i)
#pragma unroll
            for (int ct = 0; ct < 2; ++ct) { const int col = wc0 + 16 * ct + m16; const LAS unsigned char* kp = Kb + ((ro + i) * 64 + col) * 128; const int sw = (col >> 1) & 7;
                f32x4 a = (f32x4){0.f, 0.f, 0.f, 0.f};
#pragma unroll
                for (int kk = 0; kk < 2; ++kk) { const bf16x8 kf = *(const LAS bf16x8*)(kp + (((q4 + 4 * kk) ^ sw) << 4)); a = __builtin_amdgcn_mfma_f32_16x16x32_bf16(kf, qf[kk], a, 0, 0, 0); }
                S[2 * i + ct] = a; }
        int c0 = c - 8; c0 = c0 < 0 ? 0 : (c0 > 48 ? 48 : c0);
        float mx = -INFINITY;
#pragma unroll
        for (int i = 0; i < 8; ++i)
#pragma unroll
            for (int ct = 0; ct < 2; ++ct)
#pragma unroll
                for (int v = 0; v < 4; ++v) { const int kc = wc0 + 16 * ct + 4 * q4 + v; const bool valid = (kc >= c0) && (kc < c0 + 16);
                    const int bidx = valid ? (r0 + i - r + 7) * 31 + (kc - c + 15) : 0;
                    const float s = valid ? S[2 * i + ct][v] + biasL[bidx] : -INFINITY; S[2 * i + ct][v] = s; mx = fmaxf(mx, s); }
        mx = fmaxf(mx, shflx(mx, 16, lane)); mx = fmaxf(mx, shflx(mx, 32, lane));
        float l = 0.f;
#pragma unroll
        for (int t = 0; t < 16; ++t)
#pragma unroll
            for (int v = 0; v < 4; ++v) { const float p = __builtin_amdgcn_exp2f(S[t][v] - mx); S[t][v] = p; l += p; }
        l += shflx(l, 16, lane); l += shflx(l, 32, lane);
        f32x4 O[4];
#pragma unroll
        for (int dt = 0; dt < 4; ++dt) O[dt] = (f32x4){0.f, 0.f, 0.f, 0.f};
        const int qq = m16 >> 2, pp = m16 & 3, col1 = wc0 + 4 * q4 + qq;
#pragma unroll
        for (int i = 0; i < 8; ++i) {
            u32x4 pw; pw.x = pk2(S[2 * i][0], S[2 * i][1]); pw.y = pk2(S[2 * i][2], S[2 * i][3]); pw.z = pk2(S[2 * i + 1][0], S[2 * i + 1][1]); pw.w = pk2(S[2 * i + 1][2], S[2 * i + 1][3]);
            const bf16x8 pb = __builtin_bit_cast(bf16x8, pw);
            const LAS unsigned char* v1 = Vb + ((ro + i) * 64 + col1) * 128 + 8 * (pp & 1);
            const LAS unsigned char* v2 = v1 + 16 * 128;
#pragma unroll
            for (int dt = 0; dt < 4; ++dt) { const int chunk = 2 * dt + (pp >> 1);
                const s16x4 lo = vtr(v1 + ((chunk ^ (col1 & 7)) << 4)), hi = vtr(v2 + ((chunk ^ ((col1 + 16) & 7)) << 4));
                const bf16x8 vf = (bf16x8){lo[0], lo[1], lo[2], lo[3], hi[0], hi[1], hi[2], hi[3]};
                O[dt] = __builtin_amdgcn_mfma_f32_16x16x32_bf16(vf, pb, O[dt], 0, 0, 0); }
        }
        const float inv = 1.0f / l;
#pragma unroll
        for (int dt = 0; dt < 4; ++dt) {
            if constexpr (OUTP_F8) { int w = 0; w = __builtin_amdgcn_cvt_pk_fp8_f32(O[dt][0] * inv, O[dt][1] * inv, w, false); w = __builtin_amdgcn_cvt_pk_fp8_f32(O[dt][2] * inv, O[dt][3] * inv, w, true); *(int*)((unsigned char*)CAT + tq * 1024 + h * 64 + 16 * dt + 4 * q4) = w; }
            else { u32x2 w; w.x = pk2(O[dt][0] * inv, O[dt][1] * inv); w.y = pk2(O[dt][2] * inv, O[dt][3] * inv); *(u32x2*)(CAT + tq * 1024 + h * 64 + 16 * dt + 4 * q4) = w; } }
    }
    __syncthreads();
}

#undef NA_LOAD
__device__ __forceinline__ void rope_phase(const Ctx& cx, const bf16_t* PROJ, const float* qg, const float* kg, bf16_t* QKR, const int tid) {
    const int lane = tid & 63, wave = __builtin_amdgcn_readfirstlane(tid >> 6);
    const int gw = cx.vcu * 8 + wave, NGW = cx.G * 8;
    const int d0 = (lane & 7) * 8;
    float gq[8], gk[8], invf[4];
#pragma unroll
    for (int e = 0; e < 8; ++e) { gq[e] = qg[d0 + e]; gk[e] = kg[d0 + e]; }
#pragma unroll
    for (int p = 0; p < 4; ++p) { const int i = (d0 >> 1) + p, j = i & 15; invf[p] = exp2f(-(float)(2 * j) / 32.0f * 13.287712379549449f); }
    const bool isrow = (d0 >> 1) < 16;
    for (int pos = gw; pos < SEQ; pos += NGW) {
        const float pr = isrow ? (float)(pos >> 6) : (float)(pos & 63);
        float cs[4], sn[4];
#pragma unroll
        for (int p = 0; p < 4; ++p) { const float a = pr * invf[p]; cs[p] = cosf(a); sn[p] = sinf(a); }
#pragma unroll 4
        for (int bb = 0; bb < BATCH; ++bb) { const int tok = bb * SEQ + pos;
#pragma unroll
        for (int half = 0; half < 2; ++half) {
            const int e0 = half * 512 + lane * 8; const int head = e0 >> 6; const bool isq = head < 12;
            const u32x4 raw = *(const u32x4*)(PROJ + (size_t)tok * 1536 + e0);
            float x[8]; x[0] = bflo(raw.x); x[1] = bfhi(raw.x); x[2] = bflo(raw.y); x[3] = bfhi(raw.y); x[4] = bflo(raw.z); x[5] = bfhi(raw.z); x[6] = bflo(raw.w); x[7] = bfhi(raw.w);
            float ss = 0.f;
#pragma unroll
            for (int e = 0; e < 8; ++e) ss += x[e] * x[e];
            ss = group8_sum(ss);
            const float inv = rsqrtf(ss * (1.0f / 64.0f) + 1e-6f);
            float y[8];
#pragma unroll
            for (int e = 0; e < 8; ++e) y[e] = x[e] * inv * (isq ? gq[e] : gk[e]);
            const float sc = isq ? C2 : 1.0f;
            float o[8];
#pragma unroll
            for (int p = 0; p < 4; ++p) { o[2 * p] = (y[2 * p] * cs[p] - y[2 * p + 1] * sn[p]) * sc; o[2 * p + 1] = (y[2 * p] * sn[p] + y[2 * p + 1] * cs[p]) * sc; }
            u32x4 w; w.x = pk2(o[0], o[1]); w.y = pk2(o[2], o[3]); w.z = pk2(o[4], o[5]); w.w = pk2(o[6], o[7]);
            *(u32x4*)(QKR + (size_t)tok * 1024 + e0) = w;
        } }
    }
}

__device__ __forceinline__ void sconv_phase(const Ctx& cx, const bf16_t* PROJ, const float* cw, const float* cb, bf16_t* UT3, unsigned char* V8, const int tid) {
    const int lane = tid & 63, wave = __builtin_amdgcn_readfirstlane(tid >> 6);
    const int gw = cx.vcu * 8 + wave, NGW = cx.G * 8;
    LAS unsigned short* tile = (LAS unsigned short*)(cx.lds + wave * 9216);
    constexpr int PW = 2560;
    for (int it = gw; it < 16 * 64 * 36; it += NGW) {
        const int ct = it % 36, tt = (it / 36) & 63, b = it / (36 * 64);
        const int col = ct * 64 + lane, t0 = tt * 64;
        const float w0 = cw[col], w1 = cw[2304 + col], w2 = cw[4608 + col], bia = cb[col];
        const bf16_t* src = PROJ + ((size_t)b * 4096 + t0) * PW + col;
        unsigned short uu[66];
        uu[0] = (t0 > 0) ? src[-(long)PW] : (unsigned short)0;
#pragma unroll
        for (int k = 0; k < 64; ++k) uu[k + 1] = src[(size_t)k * PW];
        uu[65] = (t0 + 64 < 4096) ? src[(size_t)64 * PW] : (unsigned short)0;
#pragma unroll
        for (int k = 0; k < 64; ++k) { const float v = bf2f(uu[k]) * w0 + bf2f(uu[k + 1]) * w1 + bf2f(uu[k + 2]) * w2 + bia; tile[lane * 72 + k] = (unsigned short)f2bf(v); }
        LDS_WAIT(); asm volatile("" ::: "memory");
        const int part = (ct * 64) / 768, cbase = (ct * 64) % 768;
#pragma unroll
        for (int k = 0; k < 8; ++k) { const int row = k * 8 + (lane >> 3), chn = lane & 7;
            const u32x4 v = *(const LAS u32x4*)((const LAS unsigned char*)tile + row * 144 + chn * 16);
            *(u32x4*)(UT3 + (((size_t)part * 16 + b) * 768 + cbase + row) * 4096 + t0 + chn * 8) = v;
            if (TCONV_F8 && part == 0) { int w0 = 0, w1 = 0;
                w0 = __builtin_amdgcn_cvt_pk_fp8_f32(bflo(v.x), bfhi(v.x), w0, false); w0 = __builtin_amdgcn_cvt_pk_fp8_f32(bflo(v.y), bfhi(v.y), w0, true);
                w1 = __builtin_amdgcn_cvt_pk_fp8_f32(bflo(v.z), bfhi(v.z), w1, false); w1 = __builtin_amdgcn_cvt_pk_fp8_f32(bflo(v.w), bfhi(v.w), w1, true);
                *(u32x2*)(V8 + ((size_t)b * 768 + cbase + row) * 4096 + t0 + chn * 8) = (u32x2){(unsigned)w0, (unsigned)w1}; } }
        LDS_WAIT(); asm volatile("" ::: "memory");
    }
}

constexpr int TZ_CS = 16384 + 64;
__device__ __forceinline__ void tconv_phase(const Ctx& cx, const int o, const bf16_t* UT, const bf16_t* GT, bf16_t* ZT, const float* lbias  , const int tid) {
    const int lane = tid & 63, wid = __builtin_amdgcn_readfirstlane(tid >> 6), m16 = lane & 15, q4 = lane >> 4;
    const float* HRAWT = (const float*)(cx.ws + WS_HRAWT); const float* HPART = (const float*)(cx.ws + WS_HPART);
    LAS unsigned char* cp = cx.lds; LAS float* red = (LAS float*)(cx.lds + 8 * TZ_CS);
    for (int c = cx.vcu; c < 768; c += cx.G) {
        __syncthreads();
        { const int dir = tid >> 8, blk = tid & 255; float v = HPART[(size_t)blk * 3072 + dir * 1536 + o * 768 + c]; v = wave_sum(v, lane); if (lane == 0) red[wid] = v; }
        __syncthreads();
        float nrm = 0.f;
#pragma unroll
        for (int w = 0; w < 8; ++w) nrm += red[w];
        const float inv = 1.0f / nrm;
        const float* hf = HRAWT + (size_t)(o * 768 + c) * 4096; const float* hb = HRAWT + (size_t)(1536 + o * 768 + c) * 4096;
        for (int i = tid; i < 8192; i += 512) { float v; if (i < 4096) v = hf[4095 - i]; else if (i < 8191) v = hb[i - 4095]; else v = 0.f;
            *(LAS unsigned short*)(cp + 2 * i) = (unsigned short)f2bf(v * inv); }
        __syncthreads();
#pragma unroll
        for (int j = 1; j < 8; ++j)
            for (int n = tid; n < 1024; n += 512) {
                const u32x4 lo = *(const LAS u32x4*)(cp + n * 16); u32x4 hi = (u32x4){0u, 0u, 0u, 0u}; if (n + 1 < 1024) hi = *(const LAS u32x4*)(cp + (n + 1) * 16);
                const unsigned w[8] = {lo.x, lo.y, lo.z, lo.w, hi.x, hi.y, hi.z, hi.w}; u32x4 r;
                const int a = j >> 1;
                if (j & 1) { r.x = (w[a] >> 16) | (w[a + 1] << 16); r.y = (w[a + 1] >> 16) | (w[a + 2] << 16); r.z = (w[a + 2] >> 16) | (w[a + 3] << 16); r.w = (w[a + 3] >> 16) | (w[a + 4] << 16); }
                else { r.x = w[a]; r.y = w[a + 1]; r.z = w[a + 2]; r.w = w[a + 3]; }
                *(LAS u32x4*)(cp + j * TZ_CS + n * 16) = r;
            }
        __syncthreads();
        const int j = (7 - m16) & 7;
        const int nbase = (4095 - 512 * wid - m16 - j + 8 * q4) >> 3;
        const LAS unsigned char* ap = cp + j * TZ_CS + (nbase - 62) * 16;
        const bf16_t* up = UT + ((size_t)m16 * 768 + c) * 4096 + 8 * q4;
        f32x4 acc[32];
#pragma unroll
        for (int ti = 0; ti < 32; ++ti) acc[ti] = (f32x4){0.f, 0.f, 0.f, 0.f};
        bf16x8 bcur = *(const bf16x8*)(up);
        bf16x8 afA[8], afB[8];
#pragma unroll
        for (int i = 0; i < 8; ++i) afA[i] = *(const LAS bf16x8*)(ap + (31 - i) * 32);
        for (int ks = 0; ks < 128; ++ks) {
            const bf16x8 bnext = *(const bf16x8*)(up + ((ks + 1) & 127) * 32);
            const LAS unsigned char* a0 = ap + ks * 64;
            const LAS unsigned char* a1 = ap + ((ks + 1) & 127) * 64;
#define TZ_LD(dst, base, g) do { _Pragma("unroll") for (int i = 0; i < 8; ++i) dst[i] = *(const LAS bf16x8*)((base) + (31 - (8 * (g) + i)) * 32); } while (0)
#define TZ_MM(src, g) do { _Pragma("unroll") for (int i = 0; i < 8; ++i) acc[8 * (g) + i] = __builtin_amdgcn_mfma_f32_16x16x32_bf16(src[i], bcur, acc[8 * (g) + i], 0, 0, 0); } while (0)
            TZ_LD(afB, a0, 1); TZ_MM(afA, 0); __builtin_amdgcn_sched_barrier(0);
            TZ_LD(afA, a0, 2); TZ_MM(afB, 1); __builtin_amdgcn_sched_barrier(0);
            TZ_LD(afB, a0, 3); TZ_MM(afA, 2); __builtin_amdgcn_sched_barrier(0);
            TZ_LD(afA, a1, 0); TZ_MM(afB, 3); __builtin_amdgcn_sched_barrier(0);
#undef TZ_LD
#undef TZ_MM
            bcur = bnext;
        }
        const float lb = lbias[c];
        const size_t rowoff = ((size_t)m16 * 768 + c) * 4096 + 512 * wid + 4 * q4;
#pragma unroll
        for (int ti = 0; ti < 32; ++ti) {
            const u32x2 uu = *(const u32x2*)(UT + rowoff + 16 * ti), gg = *(const u32x2*)(GT + rowoff + 16 * ti);
            const float y0 = (acc[ti][0] + lb * bflo(uu.x)) * bflo(gg.x), y1 = (acc[ti][1] + lb * bfhi(uu.x)) * bfhi(gg.x), y2 = (acc[ti][2] + lb * bflo(uu.y)) * bflo(gg.y), y3 = (acc[ti][3] + lb * bfhi(uu.y)) * bfhi(gg.y);
            u32x2 w; w.x = pk2(y0, y1); w.y = pk2(y2, y3);
            *(u32x2*)(ZT + rowoff + 16 * ti) = w;
            if ((ti & 7) == 7) __builtin_amdgcn_sched_barrier(0);
        }
    }
    __syncthreads();
}

constexpr int T8_CS = 8192 + 256;
__host__ __device__ constexpr int t8_sig(int j) { return j < 4 ? 2 * j : (j >= 12 ? 2 * (j - 8) : 2 * (j - 4) + 1); }
__device__ __forceinline__ float wave_max_nn(float v) {
    v = fmaxf(v, dpp_x<0xB1>(v)); v = fmaxf(v, dpp_x<0x4E>(v)); v = fmaxf(v, dpp_x<0x141>(v)); v = fmaxf(v, dpp_x<0x140>(v));
    v = fmaxf(v, __builtin_bit_cast(float, __builtin_amdgcn_update_dpp(0, __builtin_bit_cast(int, v), 0x142, 0xA, 0xF, false)));
    v = fmaxf(v, __builtin_bit_cast(float, __builtin_amdgcn_update_dpp(0, __builtin_bit_cast(int, v), 0x143, 0xC, 0xF, false)));
    return __builtin_bit_cast(float, __builtin_amdgcn_readlane(__builtin_bit_cast(int, v), 63));
}
__device__ __forceinline__ void tconv8_phase(const Ctx& cx, const int o, const bf16_t* UT, const unsigned char* U8, const bf16_t* GT, bf16_t* ZT, unsigned char* Z8  ,
                                             const float* lbias, const int tid) {
    const int lane = tid & 63, wid = __builtin_amdgcn_readfirstlane(tid >> 6), m16 = lane & 15, q4 = lane >> 4;
    const float* HRAWT = (const float*)(cx.ws + WS_HRAWT); const float* HPART = (const float*)(cx.ws + WS_HPART);
    LAS unsigned char* cp = cx.lds; LAS float* red = (LAS float*)(cx.lds + 16 * T8_CS);
    for (int c = cx.vcu; c < 768; c += cx.G) {
        __syncthreads();
        const float* hf = HRAWT + (size_t)(o * 768 + c) * 4096; const float* hb = HRAWT + (size_t)(1536 + o * 768 + c) * 4096;
        float tap[16]; float mx = 0.f;
        int t3 = tid; asm volatile("" : "+v"(t3));
#pragma unroll
        for (int k = 0; k < 16; ++k) { const int i = t3 * 16 + k; float v; if (i < 4096) v = hf[4095 - i]; else if (i < 8191) v = hb[i - 4095]; else v = 0.f; tap[k] = v; mx = fmaxf(mx, fabsf(v)); }
        { const int dir = tid >> 8, blk = tid & 255; float v = HPART[(size_t)blk * 3072 + dir * 1536 + o * 768 + c]; v = wave_sum(v, lane); mx = wave_max_nn(mx); if (lane == 0) { red[wid] = v; red[8 + wid] = mx; } }
        __syncthreads();
        float nrm = 0.f, mall = 0.f;
#pragma unroll
        for (int w = 0; w < 8; ++w) { nrm += red[w]; mall = fmaxf(mall, red[8 + w]); }
        const float inv = 1.0f / nrm;
        int ex; (void)frexpf(fmaxf(mall * inv, 1e-30f), &ex);
        const float fsc = ldexpf(1.0f, 7 - ex), unsc = ldexpf(1.0f, ex - 7), tsc = inv * fsc;
        { unsigned w[4];
#pragma unroll
          for (int q = 0; q < 4; ++q) { int r = 0; r = __builtin_amdgcn_cvt_pk_fp8_f32(tap[4 * q] * tsc, tap[4 * q + 1] * tsc, r, false); r = __builtin_amdgcn_cvt_pk_fp8_f32(tap[4 * q + 2] * tsc, tap[4 * q + 3] * tsc, r, true); w[q] = (unsigned)r; }
          *(LAS u32x4*)(cp + tid * 16) = (u32x4){w[0], w[1], w[2], w[3]}; }
        __syncthreads();
        { const u32x4 lo = *(const LAS u32x4*)(cp + tid * 16); u32x4 hi = (u32x4){0u, 0u, 0u, 0u}; if (tid + 1 < 512) hi = *(const LAS u32x4*)(cp + (tid + 1) * 16);
          const unsigned w[8] = {lo.x, lo.y, lo.z, lo.w, hi.x, hi.y, hi.z, hi.w};
#pragma unroll
          for (int j = 1; j < 16; ++j) { u32x4 r; const int a = j >> 2, sh = j & 3;
              r.x = sh ? __builtin_amdgcn_alignbyte(w[a + 1], w[a], sh) : w[a]; r.y = sh ? __builtin_amdgcn_alignbyte(w[a + 2], w[a + 1], sh) : w[a + 1];
              r.z = sh ? __builtin_amdgcn_alignbyte(w[a + 3], w[a + 2], sh) : w[a + 2]; r.w = sh ? __builtin_amdgcn_alignbyte(w[a + 4], w[a + 3], sh) : w[a + 3];
              *(LAS u32x4*)(cp + j * T8_CS + t8_sig(j) * 16 + tid * 16) = r; } }
        __syncthreads();
        const int jc = 15 - m16;
        const int nbase = 255 - 32 * wid + 2 * q4;
        const LAS unsigned char* ap = cp + jc * T8_CS + t8_sig(jc) * 16 + (nbase - 31) * 16;
        const unsigned char* up = U8 + ((size_t)m16 * 768 + c) * 4096 + 32 * q4;
        f32x4 acc[32];
#pragma unroll
        for (int ti = 0; ti < 32; ++ti) acc[ti] = (f32x4){0.f, 0.f, 0.f, 0.f};
        typedef int v8i_t __attribute__((ext_vector_type(8))); typedef int v4i_t __attribute__((ext_vector_type(4)));
#define T8_FRAG(p) __builtin_shufflevector(*(const LAS v4i_t*)(p), *(const LAS v4i_t*)((p) + 16), 0, 1, 2, 3, 4, 5, 6, 7)
        v8i_t bcur = __builtin_shufflevector(*(const v4i_t*)(up), *(const v4i_t*)(up + 16), 0, 1, 2, 3, 4, 5, 6, 7);
        v8i_t afA[4], afB[4];
#pragma unroll
        for (int i = 0; i < 4; ++i) afA[i] = T8_FRAG(ap + (31 - i) * 16);
        for (int ks = 0; ks < 32; ++ks) {
            const unsigned char* un = up + ((ks + 1) & 31) * 128;
            const v8i_t bnext = __builtin_shufflevector(*(const v4i_t*)(un), *(const v4i_t*)(un + 16), 0, 1, 2, 3, 4, 5, 6, 7);
            const LAS unsigned char* a0 = ap + ks * 128;
            const LAS unsigned char* a1 = ap + ((ks + 1) & 31) * 128;
#define T8_LD(dst, base, g) do { _Pragma("unroll") for (int i = 0; i < 4; ++i) dst[i] = T8_FRAG((base) + (31 - (4 * (g) + i)) * 16); } while (0)
#define T8_MM(src, g) do { _Pragma("unroll") for (int i = 0; i < 4; ++i) acc[4 * (g) + i] = __builtin_amdgcn_mfma_scale_f32_16x16x128_f8f6f4(src[i], bcur, acc[4 * (g) + i], 0, 0, 0, 0, 0, 0); } while (0)
            T8_LD(afB, a0, 1); T8_MM(afA, 0); __builtin_amdgcn_sched_barrier(0);
            T8_LD(afA, a0, 2); T8_MM(afB, 1); __builtin_amdgcn_sched_barrier(0);
            T8_LD(afB, a0, 3); T8_MM(afA, 2); __builtin_amdgcn_sched_barrier(0);
            T8_LD(afA, a0, 4); T8_MM(afB, 3); __builtin_amdgcn_sched_barrier(0);
            T8_LD(afB, a0, 5); T8_MM(afA, 4); __builtin_amdgcn_sched_barrier(0);
            T8_LD(afA, a0, 6); T8_MM(afB, 5); __builtin_amdgcn_sched_barrier(0);
            T8_LD(afB, a0, 7); T8_MM(afA, 6); __builtin_amdgcn_sched_barrier(0);
            T8_LD(afA, a1, 0); T8_MM(afB, 7); __builtin_amdgcn_sched_barrier(0);
#undef T8_LD
#undef T8_MM
            bcur = bnext;
        }
#undef T8_FRAG
        const float lb = lbias[c];
        const size_t rowoff = ((size_t)m16 * 768 + c) * 4096 + 512 * wid + 4 * q4;
#pragma unroll
        for (int ti = 0; ti < 32; ++ti) {
            const u32x2 uu = *(const u32x2*)(UT + rowoff + 16 * ti), gg = *(const u32x2*)(GT + rowoff + 16 * ti);
            const float y0 = (acc[ti][0] * unsc + lb * bflo(uu.x)) * bflo(gg.x), y1 = (acc[ti][1] * unsc + lb * bfhi(uu.x)) * bfhi(gg.x), y2 = (acc[ti][2] * unsc + lb * bflo(uu.y)) * bflo(gg.y), y3 = (acc[ti][3] * unsc + lb * bfhi(uu.y)) * bfhi(gg.y);
            u32x2 w; w.x = pk2(y0, y1); w.y = pk2(y2, y3);
            *(u32x2*)(ZT + rowoff + 16 * ti) = w;
            if (Z8) { int w8 = 0; w8 = __builtin_amdgcn_cvt_pk_fp8_f32(fminf(fmaxf(y0, -440.f), 440.f), fminf(fmaxf(y1, -440.f), 440.f), w8, false); w8 = __builtin_amdgcn_cvt_pk_fp8_f32(fminf(fmaxf(y2, -440.f), 440.f), fminf(fmaxf(y3, -440.f), 440.f), w8, true);
                *(int*)(Z8 + rowoff + 16 * ti) = w8; }
            if ((ti & 7) == 7) __builtin_amdgcn_sched_barrier(0);
        }
    }
    __syncthreads();
}

__device__ __forceinline__ void tback_phase(const Ctx& cx, const bf16_t* ZT, bf16_t* CAT, const int tid) {
    const int lane = tid & 63, wave = __builtin_amdgcn_readfirstlane(tid >> 6);
    const int gw = cx.vcu * 8 + wave, NGW = cx.G * 8;
    LAS unsigned char* tile = cx.lds + wave * 9216;
    for (int it = gw; it < 16 * 12 * 64; it += NGW) {
        const int tt = it & 63, ct = (it >> 6) % 12, b = it / (64 * 12);
        const int c0 = ct * 64, t0 = tt * 64;
#pragma unroll
        for (int k = 0; k < 8; ++k) { const int row = k * 8 + (lane >> 3), chn = lane & 7;
            const u32x4 v = *(const u32x4*)(ZT + ((size_t)b * 768 + c0 + row) * 4096 + t0 + chn * 8);
            *(LAS u32x4*)(tile + row * 144 + chn * 16) = v; }
        LDS_WAIT(); asm volatile("" ::: "memory");
        if constexpr (OUTP_F8) { unsigned char* dst = (unsigned char*)CAT + ((size_t)b * 4096 + t0) * 1024 + c0 + lane;
#pragma unroll 8
            for (int k = 0; k < 64; ++k) { const float v = bf2f(*(const LAS unsigned short*)(tile + lane * 144 + k * 2)); dst[(size_t)k * 1024] = f2fp8(fminf(fmaxf(v, -440.0f), 440.0f)); }
        } else { bf16_t* dst = CAT + ((size_t)b * 4096 + t0) * 1024 + c0 + lane;
#pragma unroll 8
            for (int k = 0; k < 64; ++k) dst[(size_t)k * 1024] = *(const LAS unsigned short*)(tile + lane * 144 + k * 2); }
        LDS_WAIT(); asm volatile("" ::: "memory");
    }
}

__device__ __forceinline__ void ln1_group(const int bt, const int chunk, const int wave, const int lane, const int r16, const int q4, const bf16_t* XI, bf16_t* XO, bf16_t* XB, const float* g, const float* bta,
                                          const LAS unsigned char* Wh, const LAS unsigned char* Wl, LAS float* lg, LAS int* lcnt, const float rb0, const float rb1, float* gate, unsigned (&pk)[2], unsigned (&gp)[2], const LAS float* gl) {
    constexpr int WP = 2064;
            const size_t rowU = (size_t)chunk * 256 + wave * 32 + bt * 16;
            unsigned loff = (unsigned)(r16 * 1024 + 8 * q4); asm volatile("" : "+v"(loff));
            const GAS bf16_t* src = (const GAS bf16_t*)XI + rowU * 1024 + loff;
            constexpr int HOLD = LN1_HOLD;
            u32x4 raw[HOLD > 0 ? HOLD : 1], rawt[32 - HOLD]; float s = 0.f, ss = 0.f;
#pragma unroll
            for (int i = 0; i < 32; ++i) { if (i < HOLD) raw[i] = *(const GAS u32x4*)(src + 32 * i); else rawt[i - HOLD] = *(const GAS u32x4*)(src + 32 * i); }
#pragma unroll
            for (int i = 0; i < 32; ++i) { const u32x4 rr = (i < HOLD) ? raw[i < HOLD ? i : 0] : rawt[i < HOLD ? 0 : i - HOLD]; const float x0 = bflo(rr.x), x1 = bfhi(rr.x), x2 = bflo(rr.y), x3 = bfhi(rr.y), x4 = bflo(rr.z), x5 = bfhi(rr.z), x6 = bflo(rr.w), x7 = bfhi(rr.w);
                s += ((x0 + x1) + (x2 + x3)) + ((x4 + x5) + (x6 + x7)); ss += ((x0 * x0 + x1 * x1) + (x2 * x2 + x3 * x3)) + ((x4 * x4 + x5 * x5) + (x6 * x6 + x7 * x7)); }
            lg[2 * lane] = s; lg[2 * lane + 1] = ss; LDS_WAIT(); asm volatile("" ::: "memory");
            s = (lg[2 * r16] + lg[2 * (r16 + 16)]) + (lg[2 * (r16 + 32)] + lg[2 * (r16 + 48)]); ss = (lg[2 * r16 + 1] + lg[2 * (r16 + 16) + 1]) + (lg[2 * (r16 + 32) + 1] + lg[2 * (r16 + 48) + 1]);
            LDS_WAIT(); asm volatile("" ::: "memory");
            const float mean = s * (1.0f / 1024.0f), rstd = rsqrtf(fmaxf(ss * (1.0f / 1024.0f) - mean * mean, 0.f) + LN_EPS);
            f32x4 a0 = (f32x4){0.f, 0.f, 0.f, 0.f}, a1 = (f32x4){0.f, 0.f, 0.f, 0.f};
            const LAS unsigned char* wh0 = Wh + r16 * WP + 16 * q4; const LAS unsigned char* wl0 = Wl + r16 * WP + 16 * q4;
            GAS bf16_t* dsto = (GAS bf16_t*)XO + rowU * 1024 + loff; GAS unsigned char* dst8 = (GAS unsigned char*)XB + rowU * 1024 + loff;
            const LAS float* glq = gl + 8 * q4;
            u32x4 nx_ = (u32x4){0u, 0u, 0u, 0u}; if (HOLD == 0) nx_ = *(const GAS u32x4*)(src);
#pragma unroll
            for (int i = 0; i < 32; ++i) {
                u32x4 rw_; if (i < HOLD) rw_ = raw[i < HOLD ? i : 0]; else rw_ = nx_;
                if (i + 1 < 32 && i + 1 >= HOLD) nx_ = *(const GAS u32x4*)(src + 32 * (i + 1));
                asm volatile("" : "+v"(rw_));
                const f32x4 g0 = *(const LAS f32x4*)(glq + 32 * i), g1 = *(const LAS f32x4*)(glq + 32 * i + 4), b0 = *(const LAS f32x4*)(glq + 1024 + 32 * i), b1 = *(const LAS f32x4*)(glq + 1024 + 32 * i + 4);
                float y[8]; y[0] = bflo(rw_.x); y[1] = bfhi(rw_.x); y[2] = bflo(rw_.y); y[3] = bfhi(rw_.y); y[4] = bflo(rw_.z); y[5] = bfhi(rw_.z); y[6] = bflo(rw_.w); y[7] = bfhi(rw_.w);
#pragma unroll
                for (int q = 0; q < 8; ++q) y[q] = (y[q] - mean) * rstd * (q < 4 ? g0[q & 3] : g1[q & 3]) + (q < 4 ? b0[q & 3] : b1[q & 3]);
                u32x4 hi; hi.x = pk2(y[0], y[1]); hi.y = pk2(y[2], y[3]); hi.z = pk2(y[4], y[5]); hi.w = pk2(y[6], y[7]);
                *(GAS u32x4*)(dsto + 32 * i) = hi;
                if constexpr (MOE_F8) { int w0 = 0, w1 = 0; w0 = __builtin_amdgcn_cvt_pk_fp8_f32(y[0], y[1], w0, false); w0 = __builtin_amdgcn_cvt_pk_fp8_f32(y[2], y[3], w0, true); w1 = __builtin_amdgcn_cvt_pk_fp8_f32(y[4], y[5], w1, false); w1 = __builtin_amdgcn_cvt_pk_fp8_f32(y[6], y[7], w1, true);
                    *(GAS u32x2*)(dst8 + 32 * i) = (u32x2){(unsigned)w0, (unsigned)w1}; }
                else { *(u32x4*)((bf16_t*)XB + rowU * 1024 + loff + 32 * i) = hi; }
                u32x4 lo; lo.x = pk2(y[0] - bflo(hi.x), y[1] - bfhi(hi.x)); lo.y = pk2(y[2] - bflo(hi.y), y[3] - bfhi(hi.y)); lo.z = pk2(y[4] - bflo(hi.z), y[5] - bfhi(hi.z)); lo.w = pk2(y[6] - bflo(hi.w), y[7] - bfhi(hi.w));
                const bf16x8 ah = __builtin_bit_cast(bf16x8, hi), al = __builtin_bit_cast(bf16x8, lo);
                const bf16x8 wh_0 = *(const LAS bf16x8*)(wh0 + 64 * i), wh_1 = *(const LAS bf16x8*)(wh0 + 16 * WP + 64 * i), wl_0 = *(const LAS bf16x8*)(wl0 + 64 * i), wl_1 = *(const LAS bf16x8*)(wl0 + 16 * WP + 64 * i);
                a0 = __builtin_amdgcn_mfma_f32_16x16x32_bf16(ah, wh_0, a0, 0, 0, 0); a1 = __builtin_amdgcn_mfma_f32_16x16x32_bf16(ah, wh_1, a1, 0, 0, 0);
                a0 = __builtin_amdgcn_mfma_f32_16x16x32_bf16(al, wh_0, a0, 0, 0, 0); a1 = __builtin_amdgcn_mfma_f32_16x16x32_bf16(al, wh_1, a1, 0, 0, 0);
                a0 = __builtin_amdgcn_mfma_f32_16x16x32_bf16(ah, wl_0, a0, 0, 0, 0); a1 = __builtin_amdgcn_mfma_f32_16x16x32_bf16(ah, wl_1, a1, 0, 0, 0);
                asm volatile("" :: "v"(ah), "v"(al), "v"(wh_0), "v"(wh_1), "v"(wl_0), "v"(wl_1));
                __builtin_amdgcn_sched_barrier(0);
            }
#pragma unroll
            for (int v = 0; v < 4; ++v) { lg[(4 * q4 + v) * 33 + r16] = a0[v] + rb0; lg[(4 * q4 + v) * 33 + r16 + 16] = a1[v] + rb1; }
            LDS_WAIT(); asm volatile("" ::: "memory");
            if (lane < 16) {
                const LAS float* myl = lg + lane * 33; const size_t rowt = (size_t)chunk * 256 + wave * 32 + bt * 16 + lane;
                float tv[4]; int te[4]; int t0 = -1, t1 = -1, t2 = -1;
#pragma unroll
                for (int k = 0; k < 4; ++k) { float best = -INFINITY; int bi = 0;
                    for (int e = 0; e < 32; ++e) { const float v = myl[e]; const bool ok = (e != t0) && (e != t1) && (e != t2); if (ok && v > best) { best = v; bi = e; } }
                    tv[k] = best; te[k] = bi; if (k == 0) t0 = bi; else if (k == 1) t1 = bi; else if (k == 2) t2 = bi; }
                const float e1 = __expf(tv[1] - tv[0]), e2 = __expf(tv[2] - tv[0]), e3 = __expf(tv[3] - tv[0]); const float isum = 1.0f / (1.0f + e1 + e2 + e3);
                const float gk[4] = {isum, e1 * isum, e2 * isum, e3 * isum};
                pk[0] = 0u; pk[1] = 0u;
#pragma unroll
                for (int k = 0; k < 4; ++k) { const int rk = __hip_atomic_fetch_add(lcnt + te[k], 1, __ATOMIC_RELAXED, __HIP_MEMORY_SCOPE_WORKGROUP); pk[k >> 1] |= (unsigned)((te[k] << 11) | rk) << (16 * (k & 1)); }
                gp[0] = pk2(gk[0], gk[1]); gp[1] = pk2(gk[2], gk[3]); (void)rowt; (void)gate;
            }
            LDS_WAIT(); asm volatile("" ::: "memory");
}
__device__ __forceinline__ void ln1_router_phase(const Ctx& cx, const bf16_t* XI, bf16_t* XO, bf16_t* XB, const float* g, const float* bta, const float* rw, const float* rb,
                                                 unsigned* cnt, int* expid, float* gate, int* idx, float* gidx, const int tid) {
    const int lane = tid & 63, wave = __builtin_amdgcn_readfirstlane(tid >> 6), r16 = lane & 15, q4 = lane >> 4;
    constexpr int WP = 2064;
    LAS unsigned char* Wh = cx.lds; LAS unsigned char* Wl = cx.lds + 32 * WP; LAS int* lcnt = (LAS int*)(cx.lds + 64 * WP); LAS int* lbase = lcnt + 32; LAS float* lg = (LAS float*)(cx.lds + 64 * WP + 256 + wave * 2112);
    __syncthreads();
    { const u32x4* rsrc = (const u32x4*)rw; u32x4 wv[16];
#pragma unroll
      for (int u = 0; u < 16; ++u) wv[u] = rsrc[tid + 512 * u];
#pragma unroll
      for (int u = 0; u < 16; ++u) { const int idx = tid + 512 * u; *(LAS u32x4*)(Wh + (idx >> 7) * WP + (idx & 127) * 16) = wv[u]; } }
    if (tid < 256) { LAS float* gf = (LAS float*)(cx.lds + 151552); *(LAS f32x4*)(gf + 4 * tid) = *(const f32x4*)(g + 4 * tid); *(LAS f32x4*)(gf + 1024 + 4 * tid) = *(const f32x4*)(bta + 4 * tid); }
    if (tid < 32) lcnt[tid] = 0;
    LAS float* gl = (LAS float*)(cx.lds + 151552);
    const float rb0 = rb[r16], rb1 = rb[r16 + 16];
    __syncthreads();
    for (int chunk = cx.vcu; chunk < NTOK / 256; chunk += cx.G) {
        unsigned pk0[2] = {0u, 0u}, pk1[2] = {0u, 0u}, gp0[2] = {0u, 0u}, gp1[2] = {0u, 0u};
        ln1_group(0, chunk, wave, lane, r16, q4, XI, XO, XB, g, bta, Wh, Wl, lg, lcnt, rb0, rb1, gate, pk0, gp0, gl);
        ln1_group(1, chunk, wave, lane, r16, q4, XI, XO, XB, g, bta, Wh, Wl, lg, lcnt, rb0, rb1, gate, pk1, gp1, gl);
        __syncthreads();
        { const int t2 = wave * 64 + lane_id_volatile();
          if (t2 < 32) { lbase[t2] = (int)__hip_atomic_fetch_add(cnt + t2, (unsigned)lcnt[t2], __ATOMIC_RELAXED, __HIP_MEMORY_SCOPE_AGENT); } }
        __syncthreads();
        const int ln_ = lane_id_volatile();
        if (ln_ < 16) {
            { const int slot0 = (chunk * 256 + wave * 32 + ln_) * 4;
#pragma unroll
                for (int k = 0; k < 4; ++k) { const unsigned p = (pk0[k >> 1] >> (16 * (k & 1))) & 0xffffu; const int e = (int)(p >> 11), rk = (int)(p & 0x7ffu); const size_t o_ = (size_t)e * IDXCAP + lbase[e] + rk; idx[o_] = slot0 + k; gidx[o_] = (k & 1) ? bfhi(gp0[k >> 1]) : bflo(gp0[k >> 1]); } }
            { const int slot0 = (chunk * 256 + wave * 32 + 16 + ln_) * 4;
#pragma unroll
                for (int k = 0; k < 4; ++k) { const unsigned p = (pk1[k >> 1] >> (16 * (k & 1))) & 0xffffu; const int e = (int)(p >> 11), rk = (int)(p & 0x7ffu); const size_t o_ = (size_t)e * IDXCAP + lbase[e] + rk; idx[o_] = slot0 + k; gidx[o_] = (k & 1) ? bfhi(gp1[k >> 1]) : bflo(gp1[k >> 1]); } }
        }
        __syncthreads();
        { const int t3 = wave * 64 + lane_id_volatile(); if (t3 < 32) lcnt[t3] = 0; }
        __syncthreads();
    }
}

__device__ __forceinline__ void ln2_phase(const Ctx& cx, const bf16_t* X1, const bf16_t* Y, bf16_t* XO, bf16_t* XB, float* OUT, const float* g, const float* bta, const int tid) {
    const int lane = tid & 63, wave = __builtin_amdgcn_readfirstlane(tid >> 6);
    const int gw = cx.vcu * 8 + wave, NGW = cx.G * 8;
    if constexpr (Y_F8) {
        f32x4 gv[4], bv[4];
#pragma unroll
        for (int j = 0; j < 4; ++j) { gv[j] = *(const f32x4*)(g + 16 * lane + 4 * j); bv[j] = *(const f32x4*)(bta + 16 * lane + 4 * j); }
        for (int rp = gw; rp < NTOK / 2; rp += NGW) {
            u32x4 xa[2][2], ya[2][4];
#pragma unroll
            for (int r = 0; r < 2; ++r) { const size_t row = (size_t)rp * 2 + r;
                xa[r][0] = *(const u32x4*)(X1 + row * 1024 + 16 * lane); xa[r][1] = *(const u32x4*)(X1 + row * 1024 + 16 * lane + 8);
#pragma unroll
                for (int k = 0; k < 4; ++k) ya[r][k] = *(const u32x4*)((const unsigned char*)Y + (row * 4 + k) * 1024 + 16 * lane); }
            float v[2][16]; float s[2] = {0.f, 0.f};
#pragma unroll
            for (int r = 0; r < 2; ++r) {
#pragma unroll
                for (int i = 0; i < 4; ++i) { f32x2 lo = __builtin_amdgcn_cvt_pk_f32_fp8((int)ya[r][0][i], false), hi = __builtin_amdgcn_cvt_pk_f32_fp8((int)ya[r][0][i], true);
#pragma unroll
                    for (int k = 1; k < 4; ++k) { lo += __builtin_amdgcn_cvt_pk_f32_fp8((int)ya[r][k][i], false); hi += __builtin_amdgcn_cvt_pk_f32_fp8((int)ya[r][k][i], true); }
                    const unsigned xlo = xa[r][i >> 1][(i & 1) * 2], xhi = xa[r][i >> 1][(i & 1) * 2 + 1];
                    v[r][4 * i + 0] = bflo(xlo) * DN_ALPHA + lo[0] * (1.0f / Y_SCALE); v[r][4 * i + 1] = bfhi(xlo) * DN_ALPHA + lo[1] * (1.0f / Y_SCALE);
                    v[r][4 * i + 2] = bflo(xhi) * DN_ALPHA + hi[0] * (1.0f / Y_SCALE); v[r][4 * i + 3] = bfhi(xhi) * DN_ALPHA + hi[1] * (1.0f / Y_SCALE);
                    s[r] += (v[r][4 * i] + v[r][4 * i + 1]) + (v[r][4 * i + 2] + v[r][4 * i + 3]); } }
            const float mean0 = wave_sum(s[0], lane) * (1.0f / 1024.0f), mean1 = wave_sum(s[1], lane) * (1.0f / 1024.0f); float q[2] = {0.f, 0.f};
#pragma unroll
            for (int r = 0; r < 2; ++r)
#pragma unroll
                for (int e = 0; e < 16; ++e) { v[r][e] -= (r == 0 ? mean0 : mean1); q[r] += v[r][e] * v[r][e]; }
            const float rstd0 = rsqrtf(wave_sum(q[0], lane) * (1.0f / 1024.0f) + LN_EPS), rstd1 = rsqrtf(wave_sum(q[1], lane) * (1.0f / 1024.0f) + LN_EPS);
            unsigned wb[2][8]; unsigned w8[2][4];
#pragma unroll
            for (int j = 0; j < 4; ++j) { const f32x4 gvj = gv[j], bvj = bv[j];
#pragma unroll
                for (int r = 0; r < 2; ++r) { const size_t row = (size_t)rp * 2 + r; const float rs = (r == 0 ? rstd0 : rstd1);
                    const f32x4 o = (f32x4){v[r][4 * j], v[r][4 * j + 1], v[r][4 * j + 2], v[r][4 * j + 3]} * rs * gvj + bvj;
                    if (OUT) *(f32x4*)(OUT + row * 1024 + 16 * lane + 4 * j) = o;
                    else { wb[r][2 * j] = pk2(o[0], o[1]); wb[r][2 * j + 1] = pk2(o[2], o[3]);
                        int t8 = 0; t8 = __builtin_amdgcn_cvt_pk_fp8_f32(o[0], o[1], t8, false); t8 = __builtin_amdgcn_cvt_pk_fp8_f32(o[2], o[3], t8, true); w8[r][j] = (unsigned)t8; } } }
            if (!OUT) {
#pragma unroll
                for (int r = 0; r < 2; ++r) { const size_t row = (size_t)rp * 2 + r;
                    *(u32x4*)(XO + row * 1024 + 16 * lane) = (u32x4){wb[r][0], wb[r][1], wb[r][2], wb[r][3]}; *(u32x4*)(XO + row * 1024 + 16 * lane + 8) = (u32x4){wb[r][4], wb[r][5], wb[r][6], wb[r][7]};
                    if constexpr (INP_F8) *(u32x4*)((unsigned char*)XB + row * 1024 + 16 * lane) = (u32x4){w8[r][0], w8[r][1], w8[r][2], w8[r][3]};
                    else { *(u32x4*)(XB + row * 1024 + 16 * lane) = (u32x4){wb[r][0], wb[r][1], wb[r][2], wb[r][3]}; *(u32x4*)(XB + row * 1024 + 16 * lane + 8) = (u32x4){wb[r][4], wb[r][5], wb[r][6], wb[r][7]}; } } }
        }
        return;
    }
    for (int rp = gw; rp < NTOK / 2; rp += NGW) {
        f32x4 v[2][4]; float s[2] = {0.f, 0.f};
#pragma unroll
        for (int r = 0; r < 2; ++r) { const size_t row = (size_t)rp * 2 + r;
#pragma unroll
            for (int j = 0; j < 4; ++j) { const u32x2 a = *(const u32x2*)(X1 + row * 1024 + 4 * lane + 256 * j); v[r][j] = (f32x4){bflo(a.x), bfhi(a.x), bflo(a.y), bfhi(a.y)} * DN_ALPHA;
#pragma unroll
                for (int k = 0; k < 4; ++k) {
                    if constexpr (Y_F8) { const int y8 = *(const int*)((const unsigned char*)Y + (row * 4 + k) * 1024 + 4 * lane + 256 * j); const f32x2 lo = __builtin_amdgcn_cvt_pk_f32_fp8(y8, false), hi = __builtin_amdgcn_cvt_pk_f32_fp8(y8, true);
                        v[r][j][0] += lo[0] * (1.0f / Y_SCALE); v[r][j][1] += lo[1] * (1.0f / Y_SCALE); v[r][j][2] += hi[0] * (1.0f / Y_SCALE); v[r][j][3] += hi[1] * (1.0f / Y_SCALE); }
                    else { const u32x2 y = *(const u32x2*)(Y + (row * 4 + k) * 1024 + 4 * lane + 256 * j); v[r][j][0] += bflo(y.x); v[r][j][1] += bfhi(y.x); v[r][j][2] += bflo(y.y); v[r][j][3] += bfhi(y.y); } }
                s[r] += (v[r][j][0] + v[r][j][1]) + (v[r][j][2] + v[r][j][3]); } }
        const float mean0 = wave_sum(s[0], lane) * (1.0f / 1024.0f), mean1 = wave_sum(s[1], lane) * (1.0f / 1024.0f); float q[2] = {0.f, 0.f};
#pragma unroll
        for (int r = 0; r < 2; ++r)
#pragma unroll
            for (int j = 0; j < 4; ++j) { v[r][j] = v[r][j] - (r == 0 ? mean0 : mean1); q[r] += (v[r][j][0] * v[r][j][0] + v[r][j][1] * v[r][j][1]) + (v[r][j][2] * v[r][j][2] + v[r][j][3] * v[r][j][3]); }
        const float rstd0 = rsqrtf(wave_sum(q[0], lane) * (1.0f / 1024.0f) + LN_EPS), rstd1 = rsqrtf(wave_sum(q[1], lane) * (1.0f / 1024.0f) + LN_EPS);
#pragma unroll
        for (int j = 0; j < 4; ++j) { const f32x4 gvj = *(const f32x4*)(g + 4 * lane + 256 * j), bvj = *(const f32x4*)(bta + 4 * lane + 256 * j);
#pragma unroll
            for (int r = 0; r < 2; ++r) { const size_t row = (size_t)rp * 2 + r; const f32x4 o = v[r][j] * (r == 0 ? rstd0 : rstd1) * gvj + bvj;
                if (OUT) *(f32x4*)(OUT + row * 1024 + 4 * lane + 256 * j) = o;
                else { u32x2 w; w.x = pk2(o[0], o[1]); w.y = pk2(o[2], o[3]); *(u32x2*)(XO + row * 1024 + 4 * lane + 256 * j) = w;
                    if constexpr (INP_F8) { int w8 = 0; w8 = __builtin_amdgcn_cvt_pk_fp8_f32(o[0], o[1], w8, false); w8 = __builtin_amdgcn_cvt_pk_fp8_f32(o[2], o[3], w8, true); *(int*)((unsigned char*)XB + row * 1024 + 4 * lane + 256 * j) = w8; }
                    else { *(u32x2*)(XB + row * 1024 + 4 * lane + 256 * j) = w; } } } }
    }
}

constexpr int PH_PER_LAYER = 10, N_PHASES = 2 + PH_PER_LAYER * DEPTH;
__host__ __device__ constexpr bool phase_active(int p) {
    if (p < 2) return true;
    const int l = (p - 2) / PH_PER_LAYER, k = (p - 2) % PH_PER_LAYER, kind = l % 3;
    if (k == 1) return kind != 0;
    if (k == 3 || k == 4) return kind == 2;
    return true;
}

__global__ void __launch_bounds__(512, 2) fwd(Args args) {
    extern __shared__ __attribute__((aligned(16))) unsigned char lds_raw[];
    const int wave0 = __builtin_amdgcn_readfirstlane((int)threadIdx.x >> 6);
    Ctx cx; cx.lds = (LAS unsigned char*)lds_raw; cx.G = gridDim.x; { const int bx = blockIdx.x; cx.vcu = (cx.G % 8 == 0) ? (bx % 8) * (cx.G / 8) + bx / 8 : bx; } cx.ws = args.ws;
    volatile LAS unsigned* MISC = (volatile LAS unsigned*)(cx.lds + MISC_OFF);
    for (int u = threadIdx.x; u < (LDS_BYTES - MISC_OFF) / 4; u += 512) MISC[u] = 0u;
    __syncthreads();
    if (threadIdx.x == 0) { LAS unsigned long long* t = (LAS unsigned long long*)(cx.lds + PTAB_OFF);
#pragma unroll
        for (int k = 0; k < 32; ++k) t[k] = (unsigned long long)args.in[k];
        t[32] = (unsigned long long)args.out; t[33] = (unsigned long long)args.ws; }
    __syncthreads();
    const int lo = args.ph_lo, hi = args.ph_hi;
    XcdBarrier bar; bar.bar = (unsigned*)((gu32*)(args.ws + WS_CTL) + CW_BAR); bar.x = 0; bar.st = nullptr;
    if (hi - lo > 1) bar = xcd_barrier_post((unsigned*)((gu32*)(args.ws + WS_CTL) + CW_BAR), MISC + 8);
    int ran = 0;
#define XB ((bf16_t*)(ws + WS_XB))
#define PROJ ((bf16_t*)(ws + WS_PROJ))
#define CAT ((bf16_t*)(ws + WS_CAT))
#define KVM ((bf16_t*)(ws + WS_KVM))
#define HB ((bf16_t*)(ws + WS_H))
#define YB ((bf16_t*)(ws + WS_Y))
#define QKR ((bf16_t*)(ws + WS_QKR))
#define EXPID ((int*)(ws + WS_EXPID))
#define GATE ((float*)(ws + WS_GATE))
#define IDX ((int*)(ws + WS_IDX))
#define XF ((float*)(GAS float*)ptab_get(cx, 32))
#define SB ((bf16_t*)(ws + WS_SB))
#define SB2 ((bf16_t*)(ws + WS_PROJ))
#define TP_BAR_BEGIN() do {} while (0)
#define TP_BAR_END() do {} while (0)
#define TP_PH_BEGIN(p) do {} while (0)
#define TP_PH_END(p) do {} while (0)
#define PH_BEGIN(p) if (lo <= (p) && (p) < hi) { const int ph_ = (p); if (ran) { TP_BAR_BEGIN(); for (int rb_ = 0; rb_ < REP_BAR; ++rb_) xcd_barrier(bar, wave0); TP_BAR_END(); } ran = 1; const int tid = opaque_tid(wave0); (void)tid; unsigned char* const ws = (unsigned char*)(GAS unsigned char*)ptab_get(cx, 33); cx.ws = ws; TP_PH_BEGIN(ph_);
#define PH_END TP_PH_END(ph_); }

#if EN_P0
    PH_BEGIN(0) for (int rep_ = 0; rep_ < REP_P0; ++rep_) { p0_prologue(cx, tid); } PH_END
#endif

    for (int l = -1; l < DEPTH; ++l) {
        const int kind = (l < 0) ? 0 : l % 3, jj = (l < 0) ? 0 : l / 3, pw = (l < 0) ? 2048 : ((l % 3) == 1 ? 1536 : 2560), base = 2 + PH_PER_LAYER * l;
        PH_BEGIN(l < 0 ? 1 : base) {
            pg8::DenseOrder S;
            if (l < 0) S.init(ws + WS_MEMB, ws + WS_WKV, NMEM, 2048, 1024 * INP_EB, cx.G, (int)blockIdx.x);
            else S.init(XB, ws + WS_WIN + (size_t)l * 5 * MiB, NTOK, pw, 1024 * INP_EB, cx.G, (int)blockIdx.x);
            S.rep = REP_DENSE;
            const unsigned smask = (l < 0) ? 0u : (kind == 0 ? 0x207u : kind == 1 ? 0x20u : 0x200u);
            pg8::EpiBf16s E{l < 0 ? KVM : PROJ, pw, smask, C2, INP_F8 ? 1.0f / WIN_SCALE : 1.0f};
#if EN_G1
            pg8::gemm_phase<pg8::EpiBf16s, pg8::DenseOrder, false, INP_F8 != 0>(cx.lds, S, E, tid);
#endif
        } PH_END
        if (l < 0) continue;
#if EN_THIN
        if (kind == 1) { PH_BEGIN(base + 1) for (int rep_ = 0; rep_ < REP_THIN; ++rep_) { rope_phase(cx, PROJ, INP(5) + jj * 64, INP(6) + jj * 64, QKR, tid); } PH_END }
        if (kind == 2) { PH_BEGIN(base + 1) for (int rep_ = 0; rep_ < REP_THIN; ++rep_) { sconv_phase(cx, PROJ, INP(8) + (size_t)jj * 3 * 2304, INP(9) + (size_t)jj * 2304, (bf16_t*)(ws + WS_UT3), ws + WS_V8, tid); } PH_END }
#endif
        for (int o = 0; o < 2; ++o) {
            if (o == 1 && kind != 2) break;
            PH_BEGIN(base + 2 + o) {
                if (kind == 2) {
                    const bf16_t* UT3 = (const bf16_t*)(ws + WS_UT3); constexpr size_t PS = (size_t)16 * 768 * 4096;
#if EN_TCONV
                    for (int rep_ = 0; rep_ < REP_TCONV; ++rep_) {
#if TCONV_F8
                    tconv8_phase(cx, o, o == 0 ? UT3 : (const bf16_t*)(ws + WS_Z1T), ws + WS_V8 + (size_t)o * 48 * MiB, UT3 + (size_t)(1 + o) * PS, (bf16_t*)(ws + (o == 0 ? WS_Z1T : WS_Z2T)), o == 0 ? ws + WS_V8 + 48 * MiB : (unsigned char*)nullptr, INP(19) + (size_t)(jj * 2 + o) * 768, tid);
#else
                    tconv_phase(cx, o, o == 0 ? UT3 : (const bf16_t*)(ws + WS_Z1T), UT3 + (size_t)(1 + o) * PS, (bf16_t*)(ws + (o == 0 ? WS_Z1T : WS_Z2T)), INP(19) + (size_t)(jj * 2 + o) * 768, tid);
#endif
                    }
#endif
                }
                if (o == 0) {
#if EN_NA
                    for (int rep_ = 0; rep_ < REP_NA; ++rep_) { if (kind == 0) na_phase(cx, PROJ, INP(3) + (size_t)jj * 12 * 465, CAT, tid); }
#endif
                    const int ngqa = (kind == 1) ? 3072 : 0;
                    for (int rep_ = 0; rep_ < REP_ATTN; ++rep_)
                    for (int u = cx.vcu; u < ngqa + 1024; u += cx.G) {
                        const attn_body::bf16 *Q, *K, *V; attn_body::bf16* O; int QP, KP, VP, NT;
                        if (u < ngqa) { const int qb = u & 15, hq = (u >> 4) % 12, b = u / 192, kvh = hq / 3;
                            Q = (const attn_body::bf16*)QKR + ((size_t)b * 4096 + qb * 256) * 1024 + hq * 64; QP = 1024;
                            K = (const attn_body::bf16*)QKR + (size_t)b * 4096 * 1024 + 768 + kvh * 64; KP = 1024;
                            V = (const attn_body::bf16*)PROJ + (size_t)b * 4096 * 1536 + 1024 + kvh * 64; VP = 1536;
                            O = (attn_body::bf16*)((unsigned char*)CAT + (((size_t)b * 4096 + qb * 256) * 1024 + hq * 64) * OUT_EB); NT = 64;
                        } else { const int v = u - ngqa, qb = v & 15, h = (v >> 4) & 3, b = v >> 6;
                            Q = (const attn_body::bf16*)PROJ + ((size_t)b * 4096 + qb * 256) * pw + (pw - 256) + h * 64; QP = pw;
                            K = (const attn_body::bf16*)KVM + (size_t)b * 256 * 2048 + 512 * l + h * 64; KP = 2048;
                            V = K + 256; VP = 2048;
                            O = (attn_body::bf16*)((unsigned char*)CAT + (((size_t)b * 4096 + qb * 256) * 1024 + 768 + h * 64) * OUT_EB); NT = 4;
                        }
#if EN_ATTN
                        attn_body::attn_unit<8, OUTP_F8 != 0>(Q, K, V, O, QP, KP, VP, 1024, NT, (char*)lds_raw, tid);
#endif
                    }
                }
            } PH_END
        }
#if EN_THIN
        if (kind == 2) { PH_BEGIN(base + 4) for (int rep_ = 0; rep_ < REP_THIN; ++rep_) { tback_phase(cx, (const bf16_t*)(ws + WS_Z2T), CAT, tid); } PH_END }
#endif
        PH_BEGIN(base + 5) {
            pg8::DenseOrder S; S.init(CAT, ws + WS_WOUT + (size_t)l * 2 * MiB, NTOK, 1024, 1024 * OUT_EB, cx.G, (int)blockIdx.x);
            pg8::EpiResB E{SB, l == 0 ? (const void*)INP(0) : (const void*)SB, l == 0 ? 1 : 0, 1024, DN_ALPHA, OUTP_F8 ? 1.0f / WOUT_SCALE : 1.0f};
#if EN_G2
            pg8::gemm_phase<pg8::EpiResB, pg8::DenseOrder, false, OUTP_F8 != 0>(cx.lds, S, E, tid);
#endif
        } PH_END
#if EN_LN
#if REP_LN1 > 1
        PH_BEGIN(base + 6) ln1_router_phase(cx, SB, (bf16_t*)(ws + WS_PROJ), CAT, INP(22) + l * 1024, INP(23) + l * 1024, (const float*)(ws + WS_RW + (size_t)l * 131072), INP(27) + l * 32, (unsigned*)((gu32*)(ws + WS_CTL) + CW_DBG), EXPID, GATE, IDX, (float*)(ws + WS_GIDX), tid); PH_END
#endif
        PH_BEGIN(base + 6) ln1_router_phase(cx, SB, SB2, XB, INP(22) + l * 1024, INP(23) + l * 1024, (const float*)(ws + WS_RW + (size_t)l * 131072), INP(27) + l * 32, (unsigned*)((gu32*)(ws + WS_CTL) + CW_CNT + 32 * l), EXPID, GATE, IDX, (float*)(ws + WS_GIDX), tid); PH_END
#endif
        for (int half = 0; half < 2; ++half) {
            PH_BEGIN(base + 7 + half) {
                LAS int* pref = (LAS int*)(cx.lds + pg8::STAGE_BYTES); const unsigned* cntw = (const unsigned*)((gu32*)(ws + WS_CTL) + CW_CNT + 32 * l);
                __syncthreads();
                if (tid < NEXP) { const int c = (int)__hip_atomic_load(cntw + tid, __ATOMIC_RELAXED, __HIP_MEMORY_SCOPE_AGENT); pref[40 + tid] = c; pref[72 + tid] = (c + 255) >> 8; }
                __syncthreads();
                if (tid == 0) { int a = 0;
#pragma unroll 1
                    for (int e = 0; e < NEXP; ++e) { pref[e] = a; a += pref[72 + e]; } pref[NEXP] = a; }
                __syncthreads();
#if STAGGER
                if (cx.vcu & 1) { for (int s_ = 0; s_ < STAGGER; ++s_) __builtin_amdgcn_s_sleep(127); }
#endif
                if (half == 0) {
                    pg8::MoeOrder<2> S{(const char*)XB, (const char*)(ws + WS_W1 + (size_t)l * 32 * 2048 * 1024 * MOE_EB), 1024 * MOE_EB, 8, cx.G, cx.vcu, (size_t)2048 * 1024 * MOE_EB, pref, (const int*)cntw, IDX};
                    pg8::EpiSwiglu E{HB, INP(29) + (size_t)l * 32 * 2048};
#if EN_G3
                    for (int rep_ = 0; rep_ < REP_G3; ++rep_) { pg8::gemm_phase<pg8::EpiSwiglu, pg8::MoeOrder<2>, true, MOE_F8 != 0, (MOE_F8 != 0) && (DEFER_H != 0)>(cx.lds, S, E, tid); }
#endif
                } else {
                    pg8::MoeOrder<0> S{(const char*)HB, (const char*)(ws + WS_W2 + (size_t)l * 32 * 1024 * 1024 * MOE_EB), 1024 * MOE_EB, 4, cx.G, cx.vcu, (size_t)1024 * 1024 * MOE_EB, pref, (const int*)cntw, IDX};
                    pg8::EpiMoeOut E{YB, INP(31) + (size_t)l * 32 * 1024, (const float*)(ws + WS_GIDX)};
#if EN_G4
                    for (int rep_ = 0; rep_ < REP_G4; ++rep_) { pg8::gemm_phase<pg8::EpiMoeOut, pg8::MoeOrder<0>, true, MOE_F8 != 0>(cx.lds, S, E, tid); }
#endif
                }
            } PH_END
        }
#if EN_LN
#if REP_LN2 > 1
        PH_BEGIN(base + 9) ln2_phase(cx, SB, YB, (bf16_t*)(ws + WS_PROJ), CAT, (float*)nullptr, INP(24) + l * 1024, INP(25) + l * 1024, tid); PH_END
#endif
        PH_BEGIN(base + 9) ln2_phase(cx, SB2, YB, SB, XB, l == DEPTH - 1 ? XF : (float*)nullptr, INP(24) + l * 1024, INP(25) + l * 1024, tid); PH_END

#endif
    }
#undef PH_BEGIN
#undef PH_END
#undef XB
#undef PROJ
#undef CAT
#undef KVM
#undef HB
#undef YB
#undef QKR
#undef EXPID
#undef GATE
#undef IDX
#undef XF
#undef SB
#undef SB2
}

extern "C" void kernel_launch(void* const* d_in, const int* in_sizes, int n_in, void* d_out, int out_size, void* d_ws, size_t ws_size, hipStream_t stream) {
    static int grid = 0;
    if (grid == 0) {
        if (n_in != 32 || in_sizes[0] != NTOK * DM || out_size != NTOK * DM || ws_size < WS_END) { fprintf(stderr, "kernel_launch: unexpected problem (n_in %d, in0 %d, out %d, ws %zu < %zu); nothing launched\n", n_in, n_in > 0 ? in_sizes[0] : -1, out_size, ws_size, (size_t)WS_END); grid = -1; return; }
        int dev = 0, cus = 0, per_cu = 0;
        if (hipGetDevice(&dev) != hipSuccess || hipDeviceGetAttribute(&cus, hipDeviceAttributeMultiprocessorCount, dev) != hipSuccess) { fprintf(stderr, "kernel_launch: device query failed\n"); grid = -1; return; }
        if (hipFuncSetAttribute((const void*)fwd, hipFuncAttributeMaxDynamicSharedMemorySize, LDS_BYTES) != hipSuccess) { fprintf(stderr, "kernel_launch: hipFuncSetAttribute failed\n"); grid = -1; return; }
        if (hipOccupancyMaxActiveBlocksPerMultiprocessor(&per_cu, (const void*)fwd, 512, LDS_BYTES) != hipSuccess || per_cu < 1) fprintf(stderr, "kernel_launch: occupancy query reports %d blocks per CU\n", per_cu);
        (void)hipGetLastError();
        grid = cus;
    }
    if (grid < 0) return;
    if (hipMemsetAsync((char*)d_ws + WS_CTL, 0, CTL_ZERO_BYTES, stream) != hipSuccess) { fprintf(stderr, "kernel_launch: memset failed\n"); return; }
    Args a{};
    for (int i = 0; i < 32; ++i) a.in[i] = (const float*)d_in[i];
    a.out = (float*)d_out; a.ws = (unsigned char*)d_ws;
#if MK_MULTI
    for (int p = 0; p < N_PHASES && p <= DBG_LAST_PHASE; ++p) {
        if (!phase_active(p)) continue;
        a.ph_lo = p; a.ph_hi = p + 1;
        hipLaunchKernelGGL(fwd, dim3(grid), dim3(512), LDS_BYTES, stream, a);
#if DBG_CHECK
        dbg_after_phase(p, a, stream);
#endif
    }
#if DBG_CHECK
    hipLaunchKernelGGL(dbg_report, dim3(1024), dim3(256), 0, stream, (unsigned*)((char*)d_ws + WS_CTL) + CW_DBG, (float*)d_out);
#endif
#else
    a.ph_lo = 0; a.ph_hi = N_PHASES;
    hipLaunchKernelGGL(fwd, dim3(grid), dim3(512), LDS_BYTES, stream, a);
#endif
    const hipError_t le = hipPeekAtLastError();
    if (le != hipSuccess) fprintf(stderr, "kernel_launch: launch failed: %s\n", hipGetErrorName(le));
}
```

```cpp
#include <hip/hip_runtime.h>
#include <hip/hip_bf16.h>
#include <cstdio>
#include <cstdint>

#ifndef MK_MULTI
#define MK_MULTI 0
#endif
#ifndef DBG_CHECK
#define DBG_CHECK 0
#endif
#ifndef DBG_LAST_PHASE
#define DBG_LAST_PHASE 9999
#endif

#ifndef EN_P0
#define EN_P0 1
#define EN_G1 1
#define EN_THIN 1
#define EN_TCONV 1
#define EN_NA 1
#define EN_ATTN 1
#define EN_G2 1
#define EN_LN 1
#define EN_G3 1
#define EN_G4 1
#endif

#ifndef REP_P0
#define REP_P0 1
#endif
#ifndef REP_G1
#define REP_G1 1
#endif
#ifndef REP_NA
#define REP_NA 1
#endif
#ifndef REP_ATTN
#define REP_ATTN 1
#endif
#ifndef REP_TCONV
#define REP_TCONV 1
#endif
#ifndef REP_THIN
#define REP_THIN 1
#endif
#ifndef REP_G3
#define REP_G3 1
#endif
#ifndef REP_G4
#define REP_G4 1
#endif
#ifndef ALIGN_EPI
#define ALIGN_EPI 1
#endif
#ifndef NT_STORE
#define NT_STORE 0
#endif
#ifndef LN1_HOLD
#define LN1_HOLD 16
#endif
#ifndef DEFER_H
#define DEFER_H 0
#endif
#ifndef STAGGER
#define STAGGER 0
#endif
#ifndef REP_BAR
#define REP_BAR 1
#endif
#ifndef REP_DENSE
#define REP_DENSE 1
#endif
#ifndef REP_G2
#define REP_G2 1
#endif
#ifndef REP_LN1
#define REP_LN1 1
#endif
#ifndef REP_LN2
#define REP_LN2 1
#endif

#define GAS __attribute__((address_space(1)))
#define LAS __attribute__((address_space(3)))
typedef unsigned short bf16_t;
typedef short bf16x8 __attribute__((ext_vector_type(8)));
typedef short s16x4 __attribute__((ext_vector_type(4)));
typedef float f32x4 __attribute__((ext_vector_type(4)));
typedef float f32x2 __attribute__((ext_vector_type(2)));
typedef float f32x16 __attribute__((ext_vector_type(16)));
typedef unsigned u32x4 __attribute__((ext_vector_type(4)));
typedef unsigned u32x2 __attribute__((ext_vector_type(2)));
typedef GAS unsigned gu32;

constexpr int BATCH = 16, SEQ = 4096, DM = 1024, NTOK = BATCH * SEQ, DEPTH = 4;
constexpr int MEMLEN = 256, NMEM = BATCH * MEMLEN;
constexpr int NEXP = 32, NSLOT = NTOK * 4, IDXCAP = NTOK;
constexpr int GRIDW = 64;
constexpr float LN_EPS = 1e-5f;
constexpr float DN_ALPHA = 1.681792830507429f;
constexpr float LOG2E = 1.4426950408889634f;
constexpr float C2 = 0.125f * LOG2E;
__host__ __device__ constexpr int layer_kind(int l) { return l % 3; }
__host__ __device__ constexpr int layer_j(int l) { return l / 3; }
__host__ __device__ constexpr int in_width(int l) { return (l % 3) == 1 ? 1536 : 2560; }

#ifndef MOE_F8
#define MOE_F8 1
#endif
#ifndef INP_F8
#define INP_F8 1
#endif
constexpr int INP_EB = INP_F8 ? 1 : 2;
constexpr float WIN_SCALE = 32.0f;
#ifndef OUTP_F8
#define OUTP_F8 1
#endif
constexpr int OUT_EB = OUTP_F8 ? 1 : 2;
constexpr float WOUT_SCALE = 64.0f;
__device__ __forceinline__ unsigned char f2fp8(float x) { return (unsigned char)(__builtin_amdgcn_cvt_pk_fp8_f32(x, x, 0, false) & 0xff); }
#ifndef TCONV_F8
#define TCONV_F8 1
#endif
#ifndef Y_F8
#define Y_F8 1
#endif
constexpr float Y_SCALE = 64.0f;
constexpr int MOE_EB = MOE_F8 ? 1 : 2;
constexpr float W1_SCALE = 32.0f, W2_SCALE = 64.0f, H_SCALE = 4.0f;

constexpr size_t MiB = 1u << 20;
constexpr size_t WS_CTL = 0, CTL_ZERO_BYTES = 1 * MiB;
constexpr size_t WS_RW = 1 * MiB;
constexpr size_t WS_WIN = 2 * MiB;
constexpr size_t WS_WKV = 22 * MiB;
constexpr size_t WS_WOUT = 26 * MiB;
constexpr size_t WS_W1 = 34 * MiB;
constexpr size_t WS_W2 = 546 * MiB;
constexpr size_t WS_XB = 802 * MiB;
constexpr size_t WS_MEMB = 930 * MiB;
constexpr size_t WS_KVM = 938 * MiB;
constexpr size_t WS_PROJ = 954 * MiB;
constexpr size_t WS_CAT = 1274 * MiB;
constexpr size_t WS_H = 1402 * MiB;
constexpr size_t WS_Y = 1914 * MiB;
constexpr size_t WS_HRAWT = 2426 * MiB;
constexpr size_t WS_HPART = 2474 * MiB;
constexpr size_t WS_EXPID = 2478 * MiB;
constexpr size_t WS_GATE = 2479 * MiB;
constexpr size_t WS_IDX = 2480 * MiB;
constexpr size_t WS_SB = 2488 * MiB;
constexpr size_t WS_GIDX = 2616 * MiB;
constexpr size_t WS_END = 2624 * MiB;
constexpr size_t WS_UT3 = WS_H;
constexpr size_t WS_Z1T = WS_H + 288 * MiB;
constexpr size_t WS_Z2T = WS_H + 384 * MiB;
constexpr size_t WS_V8 = WS_Y;
constexpr size_t WS_QKR = WS_Y;
constexpr int CW_BAR = 4096;
constexpr int CW_CNT = 8192;
constexpr int CW_DBG = 12288;

constexpr int MISC_OFF = 150528;
constexpr int LDS_BYTES = 163840;

#define LDS_WAIT() asm volatile("s_waitcnt lgkmcnt(0)" ::: "memory")
#define VM_WAIT() asm volatile("s_waitcnt vmcnt(0)" ::: "memory")
__device__ __forceinline__ unsigned f2bf(float f) { unsigned u = __builtin_bit_cast(unsigned, f); return (u + 0x7fffu + ((u >> 16) & 1u)) >> 16; }
__device__ __forceinline__ unsigned pk2(float lo, float hi) { return f2bf(lo) | (f2bf(hi) << 16); }
__device__ __forceinline__ float bf2f(unsigned short b) { return __builtin_bit_cast(float, ((unsigned)b) << 16); }
__device__ __forceinline__ float bflo(unsigned w) { return __builtin_bit_cast(float, w << 16); }
__device__ __forceinline__ float bfhi(unsigned w) { return __builtin_bit_cast(float, w & 0xffff0000u); }
__device__ __forceinline__ float shflx(float v, int mask, int lane) { int t; asm volatile("v_mov_b32 %0, %1" : "=v"(t) : "v"(__builtin_bit_cast(int, v))); return __builtin_bit_cast(float, __builtin_amdgcn_ds_bpermute((lane ^ mask) << 2, t)); }
__device__ __forceinline__ int shflxi(int v, int mask, int lane) { return __builtin_amdgcn_ds_bpermute((lane ^ mask) << 2, v); }
template <int CTRL> __device__ __forceinline__ float dpp_x(float v) { return __builtin_bit_cast(float, __builtin_amdgcn_update_dpp(0, __builtin_bit_cast(int, v), CTRL, 0xF, 0xF, false)); }
__device__ __forceinline__ float group8_sum(float v) { v += dpp_x<0xB1>(v); v += dpp_x<0x4E>(v); v += dpp_x<0x141>(v); return v; }
__device__ __forceinline__ float wave_sum(float v, int  ) {
    v += dpp_x<0xB1>(v); v += dpp_x<0x4E>(v); v += dpp_x<0x141>(v); v += dpp_x<0x140>(v);
    v += __builtin_bit_cast(float, __builtin_amdgcn_update_dpp(0, __builtin_bit_cast(int, v), 0x142, 0xA, 0xF, false));
    v += __builtin_bit_cast(float, __builtin_amdgcn_update_dpp(0, __builtin_bit_cast(int, v), 0x143, 0xC, 0xF, false));
    return __builtin_bit_cast(float, __builtin_amdgcn_readlane(__builtin_bit_cast(int, v), 63));
}
__device__ __forceinline__ int lane_id_volatile() { int l; asm volatile("v_mbcnt_lo_u32_b32 %0, -1, 0\n\tv_mbcnt_hi_u32_b32 %0, -1, %0" : "=&v"(l)); return l; }
__device__ __forceinline__ int opaque_tid(int wave0) { return wave0 * 64 + lane_id_volatile(); }

#define XB_TMO      128
#define XB_XCNT(j)  (256  + 64 * (j))
#define XB_XSUB(j)  (1280 + 64 * (j))
#define XB_XGEN(j)  (2304 + 64 * (j))
#define XB_TOP      3328
#define XB_TOPGEN   3392
#define XCD_BAR_WORDS 3456
#define XB_SPIN_CAP (1u << 20)

__device__ __forceinline__ unsigned xb_ld(unsigned* p)              { return __hip_atomic_load(p, __ATOMIC_RELAXED, __HIP_MEMORY_SCOPE_AGENT); }
__device__ __forceinline__ unsigned xb_add(unsigned* p, unsigned v) { return __hip_atomic_fetch_add(p, v, __ATOMIC_RELAXED, __HIP_MEMORY_SCOPE_AGENT); }
__device__ __forceinline__ unsigned xb_xcc_id() { return (unsigned)__builtin_amdgcn_s_getreg((3 << 11) | 20) & 0xFu; }
#define XB_SPIN(cond, bar) do { unsigned _sp = 0; while (cond) { __builtin_amdgcn_s_sleep(1); \
    if ((++_sp & 255u) == 0u) { if (xb_ld(&(bar)[XB_TMO])) break; if (_sp > XB_SPIN_CAP) { atomicAdd(&(bar)[XB_TMO], 1u); break; } } } } while (0)

struct XcdBarrier {
    unsigned* bar; unsigned x;
    volatile LAS unsigned* st;
};
__device__ __forceinline__ XcdBarrier xcd_barrier_post(unsigned* bar, volatile LAS unsigned* st) {
    XcdBarrier b; b.bar = bar; b.x = xb_xcc_id(); b.st = st;
    if (threadIdx.x == 0) (void)xb_add(&bar[XB_XCNT(b.x)], 1u);
    return b;
}
__device__ __forceinline__ void xcd_barrier_complete(unsigned* bar, unsigned x, unsigned& nloc, unsigned& nx) {
    const unsigned G = gridDim.x * gridDim.y * gridDim.z;
    unsigned sum, cnt, mine, sp = 0u;
    for (;;) {
        sum = 0u; cnt = 0u; mine = 0u;
#pragma unroll 1
        for (unsigned j = 0; j < 16; ++j) { const unsigned c = xb_ld(&bar[XB_XCNT(j)]); sum += c; cnt += (c > 0u) ? 1u : 0u; mine = (j == x) ? c : mine; }
        if (sum == G) break;
        __builtin_amdgcn_s_sleep(1);
        if ((++sp & 255u) == 0u) { if (xb_ld(&bar[XB_TMO])) break; if (sp > XB_SPIN_CAP) { atomicAdd(&bar[XB_TMO], 1u); break; } }
    }
    nloc = mine > 0u ? mine : 1u; nx = cnt > 0u ? cnt : 1u;
}
__device__ __forceinline__ void xcd_barrier(const XcdBarrier& b, const int wave0) {
    asm volatile("s_waitcnt vmcnt(0)" ::: "memory");
    __syncthreads();
    if (wave0 == 0 && lane_id_volatile() == 0) {
        unsigned* bar = b.bar;
        __builtin_amdgcn_s_waitcnt(0);
        unsigned nloc = b.st[0], nx = b.st[1];
        if (nloc == 0u) { xcd_barrier_complete(bar, b.x, nloc, nx); b.st[0] = nloc; b.st[1] = nx; }
        const unsigned old = xb_add(&bar[XB_XSUB(b.x)], 1u);
        const unsigned gen = old / nloc;
        if (old + 1u == (gen + 1u) * nloc) {
            __builtin_amdgcn_fence(__ATOMIC_RELEASE, "agent");
            asm volatile("s_waitcnt vmcnt(0)" ::: "memory");
            const unsigned og = xb_add(&bar[XB_TOP], 1u);
            const unsigned tg = og / nx;
            if (og + 1u == (tg + 1u) * nx) xb_add(&bar[XB_TOPGEN], 1u);
            else XB_SPIN(xb_ld(&bar[XB_TOPGEN]) == tg, bar);
            __builtin_amdgcn_fence(__ATOMIC_ACQUIRE, "agent");
            xb_add(&bar[XB_XGEN(b.x)], 1u);
            asm volatile("s_waitcnt vmcnt(0)" ::: "memory");
        } else {
            XB_SPIN(xb_ld(&bar[XB_XGEN(b.x)]) == gen, bar);
            __builtin_amdgcn_fence(__ATOMIC_ACQUIRE, "agent");
            asm volatile("s_waitcnt vmcnt(0)" ::: "memory");
        }
    }
    __syncthreads();
}

namespace pg8 {
constexpr int BM = 256, BK = 64, HALF = 128, HTB = HALF * BK * 2  , STAGE_BYTES = 8 * HTB, NXCD = 8, WGM = 8;
__host__ __device__ __forceinline__ int lds_byte(int r, int c) { const int st = (r >> 4) * 2 + (c >> 5), rr = r & 15, cc = c & 31, ob = rr * 64 + cc * 2; return st * 1024 + (ob ^ (((ob >> 9) & 1) << 5)); }
__host__ __device__ __forceinline__ void stage_rc(int b, int& R, int& C) { const int st = b / 1024, sb = b % 1024, swz = sb ^ (((sb >> 9) & 1) << 5); R = (st >> 1) * 16 + swz / 64; C = (st & 1) * 32 + (swz % 64) / 2; }
__host__ __device__ __forceinline__ int perm32(int rho) { const int n = rho >> 4, i = rho & 15; return 8 * (i >> 2) + 4 * n + (i & 3); }

struct Unit { int pm, pn, e, p; };

struct DenseOrder {
    const char* A; const char* Bt; int KB; int nM, nN, nwg, G, c; int rep = 1;
    __device__ __forceinline__ void init(const void* A_, const void* Bt_, int M, int N, int KB_, int G_, int c_) { A = (const char*)A_; Bt = (const char*)Bt_; KB = KB_; nM = M / BM; nN = N / BM; nwg = nM * nN; G = G_; c = c_; }
    __device__ __forceinline__ bool next(int i, Unit& u) const {
        long L = (long)i * G + c; if (L >= (long)nwg * rep) return false;
        if (rep > 1) L %= nwg;
        int wgid = (int)L; { const int q = nwg / NXCD, r = nwg % NXCD, xcd = wgid % NXCD, off = wgid / NXCD; wgid = (xcd < r ? xcd * (q + 1) : r * (q + 1) + (xcd - r) * q) + off; }
        const int nig = WGM * nN, gid = wgid / nig, fm = gid * WGM, gsz = (nM - fm) < WGM ? (nM - fm) : WGM;
        u.pm = __builtin_amdgcn_readfirstlane(fm + ((wgid % nig) % gsz)); u.pn = __builtin_amdgcn_readfirstlane((wgid % nig) / gsz); u.e = 0; u.p = 0; return true;
    }
    __device__ __forceinline__ const char* a_base(const Unit& u) const { return A + (size_t)u.pm * BM * KB; }
    __device__ __forceinline__ const char* b_base(const Unit& u) const { return Bt + (size_t)u.pn * BM * KB; }
    __device__ __forceinline__ const int* idx_src(const Unit&) const { return nullptr; }
    __device__ __forceinline__ int nvalid(const Unit&) const { return BM; }
    static constexpr int ROW_SHIFT = 0;
};
template <int SHIFT  > struct MoeOrder {
    const char* A; const char* Bt; int KB; int nN; int G, c; size_t bstride; const LAS int* pref; const int* cnt; const int* idx;
    __device__ __forceinline__ bool next(int i, Unit& u) const {
        const long L = (long)i * G + c; const int tot = __builtin_amdgcn_readfirstlane(pref[NEXP]);
        if (L >= (long)tot * nN) return false;
        const int pg = __builtin_amdgcn_readfirstlane((int)(L / nN)); u.pn = __builtin_amdgcn_readfirstlane((int)(L % nN));
        int e = 0;
#pragma unroll
        for (int step = 16; step >= 1; step >>= 1) { const int v = __builtin_amdgcn_readfirstlane(pref[e + step]); e += (v <= pg) ? step : 0; }
        u.e = e; u.p = pg - __builtin_amdgcn_readfirstlane(pref[e]); u.pm = 0; return true;
    }
    __device__ __forceinline__ const char* a_base(const Unit&) const { return A; }
    __device__ __forceinline__ const char* b_base(const Unit& u) const { return Bt + (size_t)u.e * bstride + (size_t)u.pn * BM * KB; }
    __device__ __forceinline__ const int* idx_src(const Unit& u) const { return idx + (size_t)u.e * IDXCAP + u.p * BM; }
    __device__ __forceinline__ int nvalid(const Unit& u) const { const int n = __builtin_amdgcn_readfirstlane(pref[40 + u.e]) - u.p * BM; return n < BM ? n : BM; }
    static constexpr int ROW_SHIFT = SHIFT;
};

__device__ __forceinline__ unsigned cvt_pk_bf16(float lo, float hi) { unsigned r; asm volatile("v_cvt_pk_bf16_f32 %0, %1, %2" : "=v"(r) : "v"(lo), "v"(hi)); return r; }

struct EpiBf16s {
    static constexpr bool PERM = true; static constexpr bool HAS_BIAS = false;
    bf16_t* O; int ldc; unsigned smask; float scale; float base;
    __device__ __forceinline__ void operator()(const f32x4 (&acc)[2][2][4][2], const Unit& u, int wr, int wc, int fr, int fq) const {
        const int row0 = u.pm * BM + wr * 64 + fr, col0 = u.pn * BM + wc * 32 + 8 * fq;
        const float sc = (((smask >> u.pn) & 1u) ? scale : 1.f) * base;
#pragma unroll
        for (int ai = 0; ai < 2; ++ai)
#pragma unroll
            for (int m = 0; m < 4; ++m) { bf16_t* rowp = O + (size_t)(row0 + ai * HALF + m * 16) * ldc + col0;
#pragma unroll
                for (int bj = 0; bj < 2; ++bj) { const f32x4 v0 = acc[ai][bj][m][0] * sc, v1 = acc[ai][bj][m][1] * sc;
                    u32x4 w; w.x = cvt_pk_bf16(v0[0], v0[1]); w.y = cvt_pk_bf16(v0[2], v0[3]); w.z = cvt_pk_bf16(v1[0], v1[1]); w.w = cvt_pk_bf16(v1[2], v1[3]);
                    if (NT_STORE) __builtin_nontemporal_store(w, (u32x4*)(rowp + bj * HALF)); else *(u32x4*)(rowp + bj * HALF) = w; }
                asm volatile("" ::: "memory"); }
    }
};
struct EpiResB {
    static constexpr bool PERM = true; static constexpr bool HAS_BIAS = false;
    bf16_t* C; const void* res; int res_f32; int ldc; float alpha; float ascale;
    __device__ __forceinline__ void operator()(const f32x4 (&acc)[2][2][4][2], const Unit& u, int wr, int wc, int fr, int fq) const {
        const int row0 = u.pm * BM + wr * 64 + fr, col0 = u.pn * BM + wc * 32 + 8 * fq;
        if (res_f32) {
#pragma unroll
            for (int ai = 0; ai < 2; ++ai) { f32x4 r[4][2][2];
#pragma unroll
                for (int m = 0; m < 4; ++m)
#pragma unroll
                    for (int bj = 0; bj < 2; ++bj) { const float* rp = (const float*)res + (size_t)(row0 + ai * HALF + m * 16) * ldc + col0 + bj * HALF; r[m][bj][0] = *(const f32x4*)rp; r[m][bj][1] = *(const f32x4*)(rp + 4); }
#pragma unroll
                for (int m = 0; m < 4; ++m)
#pragma unroll
                    for (int bj = 0; bj < 2; ++bj) { const size_t off = (size_t)(row0 + ai * HALF + m * 16) * ldc + col0 + bj * HALF;
                        const f32x4 v0 = r[m][bj][0] * alpha + acc[ai][bj][m][0] * ascale, v1 = r[m][bj][1] * alpha + acc[ai][bj][m][1] * ascale;
                        u32x4 w; w.x = cvt_pk_bf16(v0[0], v0[1]); w.y = cvt_pk_bf16(v0[2], v0[3]); w.z = cvt_pk_bf16(v1[0], v1[1]); w.w = cvt_pk_bf16(v1[2], v1[3]);
                        *(u32x4*)(C + off) = w; }
                asm volatile("" ::: "memory"); }
        } else { u32x4 raw[2][4][2];
#pragma unroll
            for (int ai = 0; ai < 2; ++ai)
#pragma unroll
                for (int m = 0; m < 4; ++m)
#pragma unroll
                    for (int bj = 0; bj < 2; ++bj) raw[ai][m][bj] = *(const u32x4*)((const bf16_t*)res + (size_t)(row0 + ai * HALF + m * 16) * ldc + col0 + bj * HALF);
#pragma unroll
            for (int ai = 0; ai < 2; ++ai)
#pragma unroll
                for (int m = 0; m < 4; ++m)
#pragma unroll
                    for (int bj = 0; bj < 2; ++bj) { const size_t off = (size_t)(row0 + ai * HALF + m * 16) * ldc + col0 + bj * HALF; const u32x4 rw = raw[ai][m][bj];
                        const f32x4 r0 = (f32x4){bflo(rw.x), bfhi(rw.x), bflo(rw.y), bfhi(rw.y)}, r1 = (f32x4){bflo(rw.z), bfhi(rw.z), bflo(rw.w), bfhi(rw.w)};
                        const f32x4 v0 = r0 * alpha + acc[ai][bj][m][0] * ascale, v1 = r1 * alpha + acc[ai][bj][m][1] * ascale;
                        u32x4 w; w.x = cvt_pk_bf16(v0[0], v0[1]); w.y = cvt_pk_bf16(v0[2], v0[3]); w.z = cvt_pk_bf16(v1[0], v1[1]); w.w = cvt_pk_bf16(v1[2], v1[3]);
                        *(u32x4*)(C + off) = w; }
        }
    }
};
struct Pend { u32x2 val[8]; };
struct EpiSwiglu {
    static constexpr bool PERM = true; static constexpr bool HAS_GATE = false; static constexpr bool HAS_BIAS = true;
    __device__ __forceinline__ void load_bias(const Unit& u, int wc, int fq, f32x4 (&bp)[4]) const { const float* bg = b1 + (size_t)u.e * 2048 + u.pn * HALF + wc * 32 + 8 * fq; bp[0] = *(const f32x4*)bg; bp[1] = *(const f32x4*)(bg + 4); bp[2] = *(const f32x4*)(bg + 1024); bp[3] = *(const f32x4*)(bg + 1028); }
    bf16_t* H; const float* b1;
    __device__ __forceinline__ void prepare(const f32x4 (&acc)[2][2][4][2], const Unit& u, int wr, int wc, int fr, int fq, Pend& pd) const {
        constexpr float ASC = 1.0f / W1_SCALE;
        const int j0 = u.pn * HALF + wc * 32 + 8 * fq; const float* bg = b1 + (size_t)u.e * 2048 + j0; const float* bu = bg + 1024;
        const f32x4 bg0 = *(const f32x4*)bg, bg1 = *(const f32x4*)(bg + 4), bu0 = *(const f32x4*)bu, bu1 = *(const f32x4*)(bu + 4);
#pragma unroll
        for (int q8 = 0; q8 < 8; ++q8) { const int ai = q8 >> 2, m = q8 & 3;
            float o[8];
#pragma unroll
            for (int q = 0; q < 8; ++q) { const float gb = (q < 4 ? bg0[q & 3] : bg1[q & 3]), ub = (q < 4 ? bu0[q & 3] : bu1[q & 3]);
                float g = acc[ai][0][m][q >> 2][q & 3] * ASC + gb, uu = acc[ai][1][m][q >> 2][q & 3] * ASC + ub;
                g = fminf(g, 7.0f); uu = fminf(fmaxf(uu, -7.0f), 7.0f);
                const float sg = __builtin_amdgcn_rcpf(1.0f + __builtin_amdgcn_exp2f(-1.702f * LOG2E * g));
                o[q] = (uu + 1.0f) * (g * sg); }
            int w0 = 0, w1 = 0;
            w0 = __builtin_amdgcn_cvt_pk_fp8_f32(o[0] * H_SCALE, o[1] * H_SCALE, w0, false); w0 = __builtin_amdgcn_cvt_pk_fp8_f32(o[2] * H_SCALE, o[3] * H_SCALE, w0, true);
            w1 = __builtin_amdgcn_cvt_pk_fp8_f32(o[4] * H_SCALE, o[5] * H_SCALE, w1, false); w1 = __builtin_amdgcn_cvt_pk_fp8_f32(o[6] * H_SCALE, o[7] * H_SCALE, w1, true);
            pd.val[q8] = (u32x2){(unsigned)w0, (unsigned)w1}; }
    }
    __device__ __forceinline__ void store_one(const u32x2 v, const LAS int* ids, const int r, const int nv, const int j0) const { if (r < nv) { const int slot = ids[r]; *(u32x2*)((unsigned char*)H + (size_t)slot * 1024 + j0) = v; } }
    __device__ __forceinline__ void operator()(const f32x4 (&acc)[2][2][4][2], const Unit& u, int wr, int wc, int fr, int fq, const LAS int* ids, const int nv, const f32x4 (&bp)[4]) const {
        constexpr float ASC = MOE_F8 ? 1.0f / W1_SCALE : 1.0f;
        constexpr float HS = MOE_F8 ? H_SCALE : 1.0f, KK = -1.702f * LOG2E, GA = ASC * KK, UA = ASC * HS / KK, ULO = 8.0f * HS / KK, UHI = -6.0f * HS / KK, GLO = 7.0f * KK;
        const int j0 = u.pn * HALF + wc * 32 + 8 * fq;
        const f32x4 bg0 = bp[0] * KK, bg1 = bp[1] * KK; f32x4 bu0 = (bp[2] + 1.0f) * (HS / KK), bu1 = (bp[3] + 1.0f) * (HS / KK);
        asm volatile("" : "+v"(bu0), "+v"(bu1));
        int rb = wr * 64 + fr; asm volatile("" : "+v"(rb));
        const LAS int* idp = ids + rb; int slots[8];
#pragma unroll
        for (int q = 0; q < 8; ++q) slots[q] = idp[(q >> 2) * HALF + (q & 3) * 16];
#pragma unroll
        for (int ai = 0; ai < 2; ++ai)
#pragma unroll
            for (int m = 0; m < 4; ++m) { const int r = ai * HALF + m * 16 + rb;
                if (r < nv) { const int slot = slots[ai * 4 + m];
                    float o[8];
#pragma unroll
                    for (int q = 0; q < 8; ++q) { const float gb = (q < 4 ? bg0[q & 3] : bg1[q & 3]), ub = (q < 4 ? bu0[q & 3] : bu1[q & 3]);
                        const float gp = fmaxf(__builtin_fmaf(acc[ai][0][m][q >> 2][q & 3], GA, gb), GLO);
                        const float us = fminf(fmaxf(__builtin_fmaf(acc[ai][1][m][q >> 2][q & 3], UA, ub), ULO), UHI);
                        const float sg = __builtin_amdgcn_rcpf(1.0f + __builtin_amdgcn_exp2f(gp));
                        o[q] = us * (gp * sg); }
                    if constexpr (MOE_F8) { int w0 = 0, w1 = 0;
                        w0 = __builtin_amdgcn_cvt_pk_fp8_f32(o[0], o[1], w0, false); w0 = __builtin_amdgcn_cvt_pk_fp8_f32(o[2], o[3], w0, true);
                        w1 = __builtin_amdgcn_cvt_pk_fp8_f32(o[4], o[5], w1, false); w1 = __builtin_amdgcn_cvt_pk_fp8_f32(o[6], o[7], w1, true);
                        *(u32x2*)((unsigned char*)H + (size_t)slot * 1024 + j0) = (u32x2){(unsigned)w0, (unsigned)w1};
                    } else { u32x4 w; w.x = cvt_pk_bf16(o[0], o[1]); w.y = cvt_pk_bf16(o[2], o[3]); w.z = cvt_pk_bf16(o[4], o[5]); w.w = cvt_pk_bf16(o[6], o[7]);
                        *(u32x4*)(H + (size_t)slot * 1024 + j0) = w; } } }
    }
};
struct EpiMoeOut {
    static constexpr bool PERM = true; static constexpr bool HAS_GATE = true; static constexpr bool HAS_BIAS = true;
    __device__ __forceinline__ void load_bias(const Unit& u, int wc, int fq, f32x4 (&bp)[4]) const { const float* bb = b2 + (size_t)u.e * 1024 + u.pn * BM + wc * 32 + 8 * fq; bp[0] = *(const f32x4*)bb; bp[1] = *(const f32x4*)(bb + 4); bp[2] = *(const f32x4*)(bb + HALF); bp[3] = *(const f32x4*)(bb + HALF + 4); }
    bf16_t* Y; const float* b2;   const float* gidx;
    __device__ __forceinline__ void operator()(const f32x4 (&acc)[2][2][4][2], const Unit& u, int wr, int wc, int fr, int fq, const LAS int* ids, const int nv, const f32x4 (&bp)[4]) const {
        const LAS float* gts = (const LAS float*)(ids + 768);
        constexpr float OSC = MOE_F8 ? 1.0f / (H_SCALE * W2_SCALE) : 1.0f;
        const int c0 = u.pn * BM + wc * 32 + 8 * fq;
        f32x4 bv[2][2]; bv[0][0] = bp[0]; bv[0][1] = bp[1]; bv[1][0] = bp[2]; bv[1][1] = bp[3];
        int rb = wr * 64 + fr; asm volatile("" : "+v"(rb));
        const LAS int* idp = ids + rb; int slots[8];
#pragma unroll
        for (int q = 0; q < 8; ++q) slots[q] = idp[(q >> 2) * HALF + (q & 3) * 16];
#pragma unroll
        for (int ai = 0; ai < 2; ++ai)
#pragma unroll
            for (int m = 0; m < 4; ++m) { const int r = ai * HALF + m * 16 + rb;
                if (r < nv) { const int slot = slots[ai * 4 + m]; const float gt = gts[r];
                    if constexpr (Y_F8) {
                        unsigned pk[2][2];
#pragma unroll
                        for (int bj = 0; bj < 2; ++bj) { const f32x4 s0 = (acc[ai][bj][m][0] * OSC + bv[bj][0]) * (gt * Y_SCALE), s1 = (acc[ai][bj][m][1] * OSC + bv[bj][1]) * (gt * Y_SCALE); int w0 = 0, w1 = 0;
                            w0 = __builtin_amdgcn_cvt_pk_fp8_f32(s0[0], s0[1], w0, false); w0 = __builtin_amdgcn_cvt_pk_fp8_f32(s0[2], s0[3], w0, true); w1 = __builtin_amdgcn_cvt_pk_fp8_f32(s1[0], s1[1], w1, false); w1 = __builtin_amdgcn_cvt_pk_fp8_f32(s1[2], s1[3], w1, true);
                            pk[bj][0] = (unsigned)w0; pk[bj][1] = (unsigned)w1; }
                        const auto x0 = __builtin_amdgcn_permlane16_swap(pk[0][0], pk[1][0], false, false), x1 = __builtin_amdgcn_permlane16_swap(pk[0][1], pk[1][1], false, false);
                        *(u32x4*)((unsigned char*)Y + (size_t)slot * 1024 + c0 + ((fq & 1) ? 120 : 0)) = (u32x4){x0[0], x1[0], x0[1], x1[1]};
                    } else {
#pragma unroll
                    for (int bj = 0; bj < 2; ++bj) { const f32x4 v0 = (acc[ai][bj][m][0] * OSC + bv[bj][0]) * gt, v1 = (acc[ai][bj][m][1] * OSC + bv[bj][1]) * gt;
                        u32x4 w; w.x = cvt_pk_bf16(v0[0], v0[1]); w.y = cvt_pk_bf16(v0[2], v0[3]); w.z = cvt_pk_bf16(v1[0], v1[1]); w.w = cvt_pk_bf16(v1[2], v1[3]);
                        if (NT_STORE) __builtin_nontemporal_store(w, (u32x4*)(Y + (size_t)slot * 1024 + c0 + bj * HALF)); else *(u32x4*)(Y + (size_t)slot * 1024 + c0 + bj * HALF) = w; } } } }
    }
};

__device__ __forceinline__ const char* uni_ptr(const char* p) { const unsigned long long v = (unsigned long long)p; const unsigned lo = __builtin_amdgcn_readfirstlane((unsigned)v), hi = __builtin_amdgcn_readfirstlane((unsigned)(v >> 32)); return (const char*)(((unsigned long long)hi << 32) | lo); }
typedef int v4i_t __attribute__((ext_vector_type(4))); typedef int v8i_t __attribute__((ext_vector_type(8)));
__device__ __forceinline__ v8i_t cat8(const bf16x8 a, const bf16x8 b) { return __builtin_shufflevector(__builtin_bit_cast(v4i_t, a), __builtin_bit_cast(v4i_t, b), 0, 1, 2, 3, 4, 5, 6, 7); }
template <class Epi, class Sched, bool GATHER, bool F8 = false, bool DEFER = false>
__device__ __forceinline__ void gemm_phase(LAS unsigned char* lds, const Sched& S, const Epi& E, const int tid) {
    const int wid = __builtin_amdgcn_readfirstlane(tid >> 6), lane = tid & 63, wr = wid >> 2, wc = wid & 3, fr = lane & 15, fq = lane >> 4;
    const int KB = S.KB, nt = KB / 128;
    unsigned voffA[2], voffB[2];
#pragma unroll
    for (int i = 0; i < 2; ++i) { int R, C; stage_rc(tid * 16 + i * 8192, R, C); const int Rb = Epi::PERM ? ((R & ~31) + perm32(R & 31)) : R;
        voffA[i] = (unsigned)(R * KB + C * 2); voffB[i] = (unsigned)(Rb * KB + C * 2); }
    const size_t kstep = (size_t)(BK * 2);
    const size_t hstep = (size_t)HALF * KB;
    const unsigned ldsw = (unsigned)wid * 1024u;
    const int aoff = lds_byte(wr * 64 + fr, fq * 8), boff = lds_byte(wc * 32 + fr, fq * 8);
#define PG8_SA(b, h) (((b) * 2 + (h)) * HTB)
#define PG8_SB(b, h) ((4 + (b) * 2 + (h)) * HTB)
#define PG8_STAGE(bufoff, gbase, voff) do { const char* _gb = uni_ptr((const char*)(gbase)); _Pragma("unroll") for (int _i = 0; _i < 2; ++_i) \
        __builtin_amdgcn_global_load_lds((const unsigned*)(_gb + (voff)[_i]), (LAS unsigned*)(lds + (bufoff) + ldsw + _i * 8192), 16, 0, 0); } while (0)
#define PG8_STAGE_A(bufoff, kb, h, GO) do { if constexpr (GATHER) { PG8_STAGE(bufoff, kb, (GO)[h]); } else { PG8_STAGE(bufoff, (kb) + (h) * hstep, voffA); } } while (0)
#define PG8_LDA(dst, b, h) do { if constexpr (F8) { _Pragma("unroll") for (int m = 0; m < 4; ++m) dst##8[m] = cat8(*(const LAS bf16x8*)(lds + PG8_SA(b, h) + aoff + m * 2048), *(const LAS bf16x8*)(lds + PG8_SA(b, h) + aoff + m * 2048 + 1024)); } else { \
        _Pragma("unroll") for (int m = 0; m < 4; ++m) _Pragma("unroll") for (int k = 0; k < 2; ++k) dst[m][k] = *(const LAS bf16x8*)(lds + PG8_SA(b, h) + aoff + m * 2048 + k * 1024); } } while (0)
#define PG8_LDB(dst, b, h) do { if constexpr (F8) { _Pragma("unroll") for (int n = 0; n < 2; ++n) dst##8[n] = cat8(*(const LAS bf16x8*)(lds + PG8_SB(b, h) + boff + n * 2048), *(const LAS bf16x8*)(lds + PG8_SB(b, h) + boff + n * 2048 + 1024)); } else { \
        _Pragma("unroll") for (int n = 0; n < 2; ++n) _Pragma("unroll") for (int k = 0; k < 2; ++k) dst[n][k] = *(const LAS bf16x8*)(lds + PG8_SB(b, h) + boff + n * 2048 + k * 1024); } } while (0)
#define PG8_MMA(ai, bj, At, Bt) do { __builtin_amdgcn_s_setprio(1); if constexpr (F8) { _Pragma("unroll") for (int m = 0; m < 4; ++m) _Pragma("unroll") for (int n = 0; n < 2; ++n) \
        acc[ai][bj][m][n] = __builtin_amdgcn_mfma_scale_f32_16x16x128_f8f6f4(Bt##8[n], At##8[m], acc[ai][bj][m][n], 0, 0, 0, 0, 0, 0); } else { \
        _Pragma("unroll") for (int m = 0; m < 4; ++m) _Pragma("unroll") for (int n = 0; n < 2; ++n) _Pragma("unroll") for (int k = 0; k < 2; ++k) \
        acc[ai][bj][m][n] = __builtin_amdgcn_mfma_f32_16x16x32_bf16(Bt[n][k], At[m][k], acc[ai][bj][m][n], 0, 0, 0); } __builtin_amdgcn_s_setprio(0); } while (0)
#define PG8_WAIT_V(n) asm volatile("s_waitcnt vmcnt(" #n ")" ::: "memory")
#define PG8_WAIT_L(n) asm volatile("s_waitcnt lgkmcnt(" #n ")" ::: "memory")
#define PG8_BAR __builtin_amdgcn_s_barrier()
#define PG8_SCHED __builtin_amdgcn_sched_barrier(0)
    LAS int* const ibuf = (LAS int*)(lds + STAGE_BYTES + 512);
#define PG8_IDMA(u, b) do { if constexpr (GATHER) { __builtin_amdgcn_global_load_lds((const unsigned*)(S.idx_src(u) + 64 * (wid & 3) + lane), (LAS unsigned*)(ibuf + (b) * 256 + 64 * (wid & 3)), 4, 0, 0); \
        if constexpr (Epi::HAS_GATE) __builtin_amdgcn_global_load_lds((const unsigned*)(E.gidx + (S.idx_src(u) - S.idx) + 64 * (wid & 3) + lane), (LAS unsigned*)(ibuf + 768 + (b) * 256 + 64 * (wid & 3)), 4, 0, 0); } } while (0)
#define PG8_GOFF(dst, u, b) do { if constexpr (GATHER) { int _t = tid; asm volatile("" : "+v"(_t)); const int _nv = S.nvalid(u); _Pragma("unroll") for (int _i = 0; _i < 2; ++_i) { int _R, _C; stage_rc(_t * 16 + _i * 8192, _R, _C); \
        _Pragma("unroll") for (int _h = 0; _h < 2; ++_h) { const int _r = _R + _h * HALF; const unsigned _s = (unsigned)ibuf[(b) * 256 + (_r < _nv ? _r : 0)]; dst[_h][_i] = (_s >> Sched::ROW_SHIFT) * (unsigned)KB + (unsigned)_C * 2u; } } } } while (0)
    Unit cur, nxt; int ui = 0;
    if (!S.next(0, cur)) return;
    f32x4 acc[2][2][4][2];
#pragma unroll
    for (int a = 0; a < 2; ++a)
#pragma unroll
        for (int b = 0; b < 2; ++b)
#pragma unroll
            for (int m = 0; m < 4; ++m)
#pragma unroll
                for (int n = 0; n < 2; ++n) acc[a][b][m][n] = (f32x4){0.f, 0.f, 0.f, 0.f};
    bf16x8 At[4][2], B0[2][2], B1[2][2];
    v8i_t At8[4], B08[2], B18[2];
    unsigned gA[2][2] = {{0u, 0u}, {0u, 0u}}, gN[2][2] = {{0u, 0u}, {0u, 0u}};
    int bsel = 0;
    f32x4 bpre[4] = {(f32x4){0.f, 0.f, 0.f, 0.f}, (f32x4){0.f, 0.f, 0.f, 0.f}, (f32x4){0.f, 0.f, 0.f, 0.f}, (f32x4){0.f, 0.f, 0.f, 0.f}};
    Pend pend; int ppn = 0, pnv = 0, pq = 8, pbuf = 0;
    if constexpr (DEFER) {
#pragma unroll
        for (int q = 0; q < 8; ++q) pend.val[q] = (u32x2){0u, 0u}; }
#define PG8_PSTORE() do { if constexpr (DEFER) { const int _l3 = lane_id_volatile(); const int _nv = (pq < 8) ? pnv : 0; \
        E.store_one(pend.val[0], ibuf + pbuf * 256, ((pq >> 2) & 1) * HALF + (pq & 3) * 16 + wr * 64 + (_l3 & 15), _nv, ppn * HALF + wc * 32 + 8 * (_l3 >> 4)); \
        _Pragma("unroll") for (int _q = 0; _q < 7; ++_q) pend.val[_q] = pend.val[_q + 1]; ++pq; } } while (0)
    if constexpr (GATHER) { PG8_IDMA(cur, 0); PG8_WAIT_V(0); PG8_BAR; }
    PG8_GOFF(gA, cur, 0);
    const char* cA = S.a_base(cur); const char* cB = S.b_base(cur);
    PG8_STAGE(PG8_SB(0, 0), cB, voffB); PG8_STAGE(PG8_SB(0, 1), cB + hstep, voffB); PG8_STAGE_A(PG8_SA(0, 0), cA, 0, gA); PG8_STAGE_A(PG8_SA(0, 1), cA, 1, gA);
    if (wr == 1) PG8_BAR;
    PG8_WAIT_V(2); PG8_BAR;
    PG8_STAGE(PG8_SB(1, 0), cB + kstep, voffB); PG8_STAGE_A(PG8_SA(1, 0), cA + kstep, 0, gA); PG8_STAGE(PG8_SB(1, 1), cB + hstep + kstep, voffB);
    PG8_WAIT_V(6); PG8_BAR;
    for (;;) {
        const bool has_next = S.next(ui + 1, nxt);
        const char* nA = has_next ? S.a_base(nxt) : cA; const char* nB = has_next ? S.b_base(nxt) : cB;
        const int bnxt = (bsel == 2) ? 0 : bsel + 1;
        if constexpr (GATHER) { if (has_next) PG8_IDMA(nxt, bnxt); }
        for (int t = 0; t < nt; t += 2) {
            const bool last = (t == nt - 2);
            const char* a1 = cA + (size_t)(t + 1) * kstep;
            const char* a2 = last ? nA : cA + (size_t)(t + 2) * kstep; const char* b2 = last ? nB : cB + (size_t)(t + 2) * kstep;
            const char* a3 = a2 + kstep; const char* b3 = b2 + kstep;
            if constexpr (GATHER) { if (last && has_next) { PG8_GOFF(gN, nxt, bnxt); } }
            if constexpr (Epi::HAS_BIAS) { if (last) E.load_bias(cur, wc, lane_id_volatile() >> 4, bpre); }
            PG8_LDB(B0, 0, 0); PG8_LDB(B1, 0, 1); PG8_SCHED; PG8_LDA(At, 0, 0); PG8_STAGE_A(PG8_SA(1, 1), a1, 1, gA);
            if constexpr (GATHER) { if (last && has_next) { gA[0][0] = gN[0][0]; gA[0][1] = gN[0][1]; gA[1][0] = gN[1][0]; gA[1][1] = gN[1][1]; } }
            PG8_WAIT_V(8); PG8_WAIT_L(0); PG8_BAR; PG8_MMA(0, 0, At, B0); PG8_MMA(0, 1, At, B1); PG8_BAR; PG8_SCHED;
            PG8_LDA(At, 0, 1); PG8_STAGE(PG8_SB(0, 0), b2, voffB); PG8_STAGE(PG8_SB(0, 1), b2 + hstep, voffB); PG8_STAGE_A(PG8_SA(0, 0), a2, 0, gA);
            PG8_WAIT_V(8); PG8_WAIT_L(0); PG8_BAR; PG8_MMA(1, 0, At, B0); PG8_MMA(1, 1, At, B1); PG8_BAR; PG8_SCHED;
            PG8_PSTORE();
            PG8_LDB(B0, 1, 0); PG8_LDB(B1, 1, 1); PG8_SCHED; PG8_LDA(At, 1, 0); PG8_STAGE_A(PG8_SA(0, 1), a2, 1, gA);
            PG8_WAIT_V(8); PG8_WAIT_L(0); PG8_BAR; PG8_MMA(0, 0, At, B0); PG8_MMA(0, 1, At, B1); PG8_BAR; PG8_SCHED;
            PG8_LDA(At, 1, 1); PG8_STAGE(PG8_SB(1, 0), b3, voffB); PG8_STAGE(PG8_SB(1, 1), b3 + hstep, voffB); PG8_STAGE_A(PG8_SA(1, 0), a3, 0, gA);
            PG8_WAIT_V(8); PG8_WAIT_L(0); PG8_BAR; PG8_MMA(1, 0, At, B0); PG8_MMA(1, 1, At, B1); PG8_BAR; PG8_SCHED;
            PG8_PSTORE();
        }
        if (ALIGN_EPI) { if (wr == 0) PG8_BAR; }
        { const int l2 = lane_id_volatile(), fr2 = l2 & 15, fq2 = l2 >> 4;
          if constexpr (DEFER) { _Pragma("unroll") for (int _f = 0; _f < 8; ++_f) PG8_PSTORE();
              E.prepare(acc, cur, wr, wc, fr2, fq2, pend); ppn = cur.pn; pnv = S.nvalid(cur); pq = 0; pbuf = bsel; }
          else if constexpr (GATHER) E(acc, cur, wr, wc, fr2, fq2, ibuf + bsel * 256, S.nvalid(cur), bpre); else E(acc, cur, wr, wc, fr2, fq2); }
        if (!has_next) break;
#pragma unroll
        for (int a = 0; a < 2; ++a)
#pragma unroll
            for (int b = 0; b < 2; ++b)
#pragma unroll
                for (int m = 0; m < 4; ++m)
#pragma unroll
                    for (int n = 0; n < 2; ++n) acc[a][b][m][n] = (f32x4){0.f, 0.f, 0.f, 0.f};
        cur = nxt; cA = nA; cB = nB; ++ui; bsel = bnxt;
        if (ALIGN_EPI) { if (wr == 1) PG8_BAR; }
    }
    if constexpr (DEFER) { _Pragma("unroll") for (int _f = 0; _f < 8; ++_f) PG8_PSTORE(); }
    PG8_WAIT_V(0);
    if (!ALIGN_EPI) { if (wr == 0) PG8_BAR; }
    PG8_BAR;
#undef PG8_PSTORE
#undef PG8_SA
#undef PG8_SB
#undef PG8_STAGE
#undef PG8_STAGE_A
#undef PG8_LDA
#undef PG8_LDB
#undef PG8_MMA
#undef PG8_WAIT_V
#undef PG8_WAIT_L
#undef PG8_BAR
#undef PG8_SCHED
#undef PG8_GOFF
#undef PG8_IDMA
}
}

namespace attn_body {
using bf16=__hip_bfloat16;
using bf16x8=__attribute__((ext_vector_type(8)))short;
using s16x4=__attribute__((ext_vector_type(4)))short;
using f32x16=__attribute__((ext_vector_type(16)))float;
using u32x4=__attribute__((ext_vector_type(4)))unsigned;
constexpr int D=64;
constexpr int NW=8,QBLK=32,QB=QBLK*NW,KVBLK=64;
constexpr int ATTN_UNIT_ROWS=QB;
__device__ __forceinline__ int crow(int r,int hi){return (r&3)+8*(r>>2)+4*hi;}
#define SBAR() __builtin_amdgcn_sched_barrier(0)
__device__ __forceinline__ void cmask(f32x16&p0,f32x16&p1,int jb,int qrel,int hi){
  const float NEG=-INFINITY; int kb=64*jb+4*hi;
  #pragma unroll
  for(int r=0;r<16;++r){int kv=kb+(r&3)+8*(r>>2); if(kv>qrel)p0[r]=NEG; if(kv+32>qrel)p1[r]=NEG;}
}

constexpr int NSLOT=3, SLOTB=8192;
constexpr int LDS_K=0, LDS_V=NSLOT*SLOTB, LDS_WS=2*NSLOT*SLOTB, LDS_OST=LDS_WS+NW*64*4, LDS_BYTES=LDS_OST+NW*4096;
constexpr float C2=0.125f*1.4426950408889634f;
__device__ __forceinline__ void glds16(const void*gsrc,unsigned lds_dst){unsigned keep;
  asm volatile("s_mov_b32 %0, m0\n\ts_mov_b32 m0, %2\n\ts_nop 0\n\tglobal_load_lds_dwordx4 %1, off\n\ts_mov_b32 m0, %0":"=&s"(keep):"v"(gsrc),"s"(lds_dst):"memory");}
__device__ __forceinline__ float max3f(float a,float b,float c){float r;asm("v_max3_f32 %0, %1, %2, %3":"=v"(r):"v"(a),"v"(b),"v"(c));return r;}
__device__ __forceinline__ float max2f(float a,float b){float r;asm("v_max_f32_e32 %0, %1, %2":"=v"(r):"v"(a),"v"(b));return r;}
__device__ __forceinline__ float fadd_s(float a,float b){float r;asm("v_add_f32_e32 %0, %1, %2":"=v"(r):"v"(a),"v"(b));return r;}
__device__ __forceinline__ float fsub_s(float a,float b){float r;asm("v_sub_f32_e32 %0, %1, %2":"=v"(r):"v"(a),"v"(b));return r;}
typedef float f32x2_t __attribute__((ext_vector_type(2))); typedef __bf16 bf16x2_t __attribute__((ext_vector_type(2)));
__device__ __forceinline__ unsigned cvtpk_s(float lo,float hi){f32x2_t v={lo,hi};bf16x2_t b=__builtin_convertvector(v,bf16x2_t);return __builtin_bit_cast(unsigned,b);}
#define WAIT_BAR(N) asm volatile("s_waitcnt vmcnt(" #N ") lgkmcnt(0)\n\ts_barrier":::"memory")

__device__ __forceinline__ void qkt(f32x16&p0,f32x16&p1,const char*Kslot,const bf16x8*qr,const f32x16&negm,int r32,int hi){
  const char*kb=Kslot+hi*1024+r32*16;
  #pragma unroll
  for(int d0=0;d0<4;++d0){
    const bf16x8 b0=*reinterpret_cast<const bf16x8*>(kb+d0*2048);
    const bf16x8 b1=*reinterpret_cast<const bf16x8*>(kb+d0*2048+512);
    if(d0==0){p0=__builtin_amdgcn_mfma_f32_32x32x16_bf16(b0,qr[0],negm,0,0,0);p1=__builtin_amdgcn_mfma_f32_32x32x16_bf16(b1,qr[0],negm,0,0,0);}
    else{p0=__builtin_amdgcn_mfma_f32_32x32x16_bf16(b0,qr[d0],p0,0,0,0);p1=__builtin_amdgcn_mfma_f32_32x32x16_bf16(b1,qr[d0],p1,0,0,0);}}
}
typedef __attribute__((address_space(3))) const char* lds_cptr;
typedef short v4i16_t __attribute__((ext_vector_type(4)));
__device__ __forceinline__ void kload8(bf16x8*kf,lds_cptr kp){
  kf[0]=*(const __attribute__((address_space(3))) bf16x8*)(kp);      kf[1]=*(const __attribute__((address_space(3))) bf16x8*)(kp+512);
  kf[2]=*(const __attribute__((address_space(3))) bf16x8*)(kp+2048); kf[3]=*(const __attribute__((address_space(3))) bf16x8*)(kp+2560);
  kf[4]=*(const __attribute__((address_space(3))) bf16x8*)(kp+4096); kf[5]=*(const __attribute__((address_space(3))) bf16x8*)(kp+4608);
  kf[6]=*(const __attribute__((address_space(3))) bf16x8*)(kp+6144); kf[7]=*(const __attribute__((address_space(3))) bf16x8*)(kp+6656);
}
__device__ __forceinline__ void kload2(bf16x8*kf,lds_cptr kp,int j){ kf[2*j]=*(const __attribute__((address_space(3))) bf16x8*)(kp+j*2048); kf[2*j+1]=*(const __attribute__((address_space(3))) bf16x8*)(kp+j*2048+512); }
__device__ __forceinline__ s16x4 vtr(lds_cptr p){ return __builtin_bit_cast(s16x4,__builtin_amdgcn_ds_read_tr16_b64_v4i16((__attribute__((address_space(3))) v4i16_t*)p)); }
__device__ __forceinline__ float rowmax(const f32x16&p0,const f32x16&p1){
  float a=max3f(p0[0],p0[1],p1[0]),b=max3f(p0[2],p0[3],p1[1]);a=max3f(a,p1[2],p1[3]);
  #pragma unroll
  for(int r=4;r<16;r+=4){a=max3f(a,p0[r],p0[r+1]);b=max3f(b,p0[r+2],p0[r+3]);a=max3f(a,p1[r],p1[r+1]);b=max3f(b,p1[r+2],p1[r+3]);}
  const float m=max2f(a,b);
  auto rr=__builtin_amdgcn_permlane32_swap(__float_as_uint(m),__float_as_uint(m),false,false);
  return max2f(__uint_as_float(rr[0]),__uint_as_float(rr[1]));
}
__device__ __forceinline__ void pv(f32x16*o,int vb,bf16x8 pa0,bf16x8 pa1,bf16x8 pa2,bf16x8 pa3){
  #pragma unroll
  for(int d0=0;d0<2;++d0){s16x4 lo[4],hi[4];
    #pragma unroll
    for(int ks=0;ks<4;++ks){
      asm volatile("ds_read_b64_tr_b16 %0,%1 offset:%c2":"=&v"(lo[ks]):"v"(vb),"i"(d0*4096+ks*1024):"memory");
      asm volatile("ds_read_b64_tr_b16 %0,%1 offset:%c2":"=&v"(hi[ks]):"v"(vb),"i"(d0*4096+ks*1024+512):"memory");}
    asm volatile("s_waitcnt lgkmcnt(0)":::"memory");SBAR();
    #define PK(k) (bf16x8){lo[k][0],lo[k][1],lo[k][2],lo[k][3],hi[k][0],hi[k][1],hi[k][2],hi[k][3]}
    o[d0]=__builtin_amdgcn_mfma_f32_32x32x16_bf16(pa0,PK(0),o[d0],0,0,0);
    o[d0]=__builtin_amdgcn_mfma_f32_32x32x16_bf16(pa1,PK(1),o[d0],0,0,0);
    o[d0]=__builtin_amdgcn_mfma_f32_32x32x16_bf16(pa2,PK(2),o[d0],0,0,0);
    o[d0]=__builtin_amdgcn_mfma_f32_32x32x16_bf16(pa3,PK(3),o[d0],0,0,0);
    #undef PK
  }
}

#ifndef ATTN_STORE16
#define ATTN_STORE16(p,v) (*(u32x4*)(p)=(v))
#endif
template<int THRL, bool O8 = false> __device__ __forceinline__ void attn_unit(const bf16*Qu,const bf16*__restrict__ Kh,const bf16*__restrict__ Vh,bf16*Ou,const int QP,const int KP,const int VP,const int OP,const int NT,char*shm,const int tid){
  const int lane=tid&63,r32=lane&31,hi=lane>>5; const int wid=__builtin_amdgcn_readfirstlane(tid>>6);
  const bf16*Qw=Qu+(long)(wid*QBLK)*QP;
  const unsigned lds0=(unsigned)(uintptr_t)shm;
  float*wsf=(float*)(shm+LDS_WS)+wid*64;
  const bf16*ksrc=Kh+(long)lane*KP+wid*8;
  const bf16*vsrc=Vh+(long)(16*(wid&3)+(lane>>2))*VP+(wid>>2)*32+(lane&3)*8;
  const unsigned kdst=lds0+LDS_K+wid*1024, vdst=lds0+LDS_V+wid*1024;
  #define DMA_K(t,slot) glds16(ksrc+(long)(t)*KVBLK*KP,(unsigned)__builtin_amdgcn_readfirstlane(kdst+(slot)))
  #define DMA_V(t,slot) glds16(vsrc+(long)(t)*KVBLK*VP,(unsigned)__builtin_amdgcn_readfirstlane(vdst+(slot)))
  const int vb0=(int)(lds0+LDS_V)+((lane>>4)&1)*32+(lane&3)*8+(4*hi+((lane&15)>>2))*64;
  const char*Kbase=shm+LDS_K; bf16x8 kf[8];
  const lds_cptr shm3=(lds_cptr)shm; const lds_cptr kp0=shm3+LDS_K+hi*1024+r32*16; const lds_cptr vp0=shm3+LDS_V+((lane>>4)&1)*32+(lane&3)*8+(4*hi+((lane&15)>>2))*64;
  DMA_K(0,0);DMA_V(0,0);DMA_K(1,SLOTB);
  bf16x8 qr[4];
  #pragma unroll
  for(int d0=0;d0<4;++d0)qr[d0]=*reinterpret_cast<const bf16x8*>(&Qw[(long)r32*QP+d0*16+hi*8]);
  float mhat=0.f,l_reg=0.f;f32x16 o[2];f32x16 negm; { float z_=0.f; asm volatile("":"+v"(z_)); _Pragma("unroll") for(int r=0;r<16;++r){o[0][r]=z_;o[1][r]=z_;negm[r]=z_;} } asm volatile("":"+v"(negm));
  #define CMASK(P0,P1,t) do{}while(0)
  bool resc=false;
  #define START(P0,P1) do{ const float rm=rowmax(P0,P1); resc=false; \
    { const float dl=rm; mhat=fadd_s(mhat,dl); \
      _Pragma("unroll") for(int r=0;r<16;++r){P0[r]=fsub_s(P0[r],dl);P1[r]=fsub_s(P1[r],dl);} \
      _Pragma("unroll") for(int r=0;r<16;++r)negm[r]=-mhat; asm volatile("":"+v"(negm)); } \
    _Pragma("unroll") for(int r=0;r<16;++r)P0[r]=__builtin_amdgcn_exp2f(P0[r]); }while(0)
  #define RESC() do{ if(resc){ asm volatile("s_waitcnt lgkmcnt(0)":::"memory"); \
      _Pragma("unroll") for(int d_=0;d_<2;++d_) _Pragma("unroll") for(int r=0;r<16;++r)o[d_][r]*=wsf[crow(r,hi)]; } }while(0)
  f32x16 pA0,pA1,pB0,pB1;
  int sl_prev=0,sl_cur=0,sl_next=SLOTB;
  #define ROT() do{sl_prev=sl_cur;sl_cur=sl_next;sl_next=(sl_next==(NSLOT-1)*SLOTB)?0:sl_next+SLOTB;}while(0)
  DMA_K(2,2*SLOTB);
  WAIT_BAR(3);
  qkt(pA0,pA1,Kbase,qr,negm,r32,hi);asm volatile("s_nop 15\n\ts_nop 7":"+v"(pA0),"+v"(pA1));CMASK(pA0,pA1,0);
  START(pA0,pA1);
  _Pragma("unroll") for(int r=0;r<16;++r)pA1[r]=__builtin_amdgcn_exp2f(pA1[r]);
  WAIT_BAR(0);
  DMA_K(3,0);DMA_V(1,SLOTB);
  ROT();
  kload8(kf,kp0+sl_cur);
  WAIT_BAR(2);
  s16x4 vlo[8],vhi[8]; u32x4 pw0,pw1,pw2,pw3;
  #define PKW(P,B) cvtpk_s(P[B],P[B+1])
  #define PAF(k) __builtin_bit_cast(bf16x8,pw##k)
  #define VFR(i) (bf16x8){vlo[i][0],vlo[i][1],vlo[i][2],vlo[i][3],vhi[i][0],vhi[i][1],vhi[i][2],vhi[i][3]}
  #define PIN(x) asm volatile("":"+v"(x))
  #define MX3(a,b,c) __builtin_fmaxf(__builtin_fmaxf((a),(b)),(c))
  #define GAPA(MF,A0,A1,A2,A3,W0,W1,PW) do{ MF; sacc+=A0; sacc+=A1; sacc+=A2; sacc+=A3; PIN(sacc); W0; W1; PIN(PW); SBAR(); }while(0)
  #define EX(v) __builtin_amdgcn_exp2f(v)
  #define GAPB(MF,X,B) do{ MF; X[B]=EX(X[B]); X[B+1]=EX(X[B+1]); X[B+2]=EX(X[B+2]); X[B+3]=EX(X[B+3]); PIN(X); SBAR(); }while(0)
  #define VRD(i) do{ vlo[i]=vtr(vp_+(((i)>>2)*4096+((i)&3)*1024)); vhi[i]=vtr(vp_+(((i)>>2)*4096+((i)&3)*1024+512)); }while(0)
  #define KRD(G,j) do{ if(G){ kload2(kf,kp0+sl_next,j); SBAR(); } }while(0)
  #define STEP(C0,C1,P0,P1,t,GK,GV,GL) do{ SBAR(); \
    const lds_cptr vp_=vp0+sl_prev; \
    VRD(0); SBAR(); float sacc=(P0[0]+P0[1]); \
    GAPA(C0=__builtin_amdgcn_mfma_f32_32x32x16_bf16(kf[0],qr[0],negm,0,0,0), P0[2],P0[3],P0[4],P0[5],     pw0[0]=PKW(P0,0), pw0[1]=PKW(P0,2), pw0); \
    VRD(4); SBAR(); GAPA(C1=__builtin_amdgcn_mfma_f32_32x32x16_bf16(kf[1],qr[0],negm,0,0,0), P0[6],P0[7],P0[8],P0[9],     pw0[2]=PKW(P0,4), pw0[3]=PKW(P0,6), pw0); \
    VRD(1); SBAR(); GAPA(C0=__builtin_amdgcn_mfma_f32_32x32x16_bf16(kf[2],qr[1],C0,0,0,0),   P0[10],P0[11],P0[12],P0[13], pw1[0]=PKW(P0,8), pw1[1]=PKW(P0,10), pw1); \
    VRD(5); SBAR(); GAPA(C1=__builtin_amdgcn_mfma_f32_32x32x16_bf16(kf[3],qr[1],C1,0,0,0),   P0[14],P0[15],P1[0],P1[1],   pw1[2]=PKW(P0,12),pw1[3]=PKW(P0,14), pw1); \
    VRD(2); SBAR(); GAPA(C0=__builtin_amdgcn_mfma_f32_32x32x16_bf16(kf[4],qr[2],C0,0,0,0),   P1[2],P1[3],P1[4],P1[5],     pw2[0]=PKW(P1,0), pw2[1]=PKW(P1,2), pw2); \
    VRD(6); SBAR(); GAPA(C1=__builtin_amdgcn_mfma_f32_32x32x16_bf16(kf[5],qr[2],C1,0,0,0),   P1[6],P1[7],P1[8],P1[9],     pw2[2]=PKW(P1,4), pw2[3]=PKW(P1,6), pw2); \
    VRD(3); SBAR(); GAPA(C0=__builtin_amdgcn_mfma_f32_32x32x16_bf16(kf[6],qr[3],C0,0,0,0),   P1[10],P1[11],P1[12],P1[13], pw3[0]=PKW(P1,8), pw3[1]=PKW(P1,10), pw3); \
    VRD(7); SBAR(); GAPA(C1=__builtin_amdgcn_mfma_f32_32x32x16_bf16(kf[7],qr[3],C1,0,0,0),   P1[14],P1[15],0.f,0.f,       pw3[2]=PKW(P1,12),pw3[3]=PKW(P1,14), pw3); \
    l_reg+=sacc; \
    if(GK){DMA_K((t)+3,sl_cur);} if(GV){DMA_V((t)+1,sl_next);} \
    CMASK(C0,C1,t); \
    { float a=MX3(C0[0],C0[1],C1[0]),b=MX3(C0[2],C0[3],C1[1]); a=MX3(a,C1[2],C1[3]); \
      _Pragma("unroll") for(int r=4;r<16;r+=4){a=MX3(a,C0[r],C0[r+1]);b=MX3(b,C0[r+2],C0[r+3]);a=MX3(a,C1[r],C1[r+1]);b=MX3(b,C1[r+2],C1[r+3]);} \
      float rm=__builtin_fmaxf(a,b); { auto rr=__builtin_amdgcn_permlane32_swap(__float_as_uint(rm),__float_as_uint(rm),false,false); rm=__builtin_fmaxf(__uint_as_float(rr[0]),__uint_as_float(rr[1])); } \
      resc=false; \
      if(__builtin_expect(__any(rm>(float)THRL),0)){ const float dl=__builtin_fmaxf(rm,0.f); mhat+=dl; \
        _Pragma("unroll") for(int r=0;r<16;++r){C0[r]-=dl;C1[r]-=dl;} \
        _Pragma("unroll") for(int r=0;r<16;++r)negm[r]=-mhat; asm volatile("":"+v"(negm)); \
        const float f=__builtin_amdgcn_exp2f(-dl); l_reg*=f; if(hi==0)wsf[r32]=f; resc=true; } } \
    SBAR(); \
    GAPB(o[0]=__builtin_amdgcn_mfma_f32_32x32x16_bf16(PAF(0),VFR(0),o[0],0,0,0), C0,0); \
    GAPB(o[1]=__builtin_amdgcn_mfma_f32_32x32x16_bf16(PAF(0),VFR(4),o[1],0,0,0), C0,4); \
    KRD(GL,0); GAPB(o[0]=__builtin_amdgcn_mfma_f32_32x32x16_bf16(PAF(1),VFR(1),o[0],0,0,0), C0,8); \
    KRD(GL,1); GAPB(o[1]=__builtin_amdgcn_mfma_f32_32x32x16_bf16(PAF(1),VFR(5),o[1],0,0,0), C0,12); \
    KRD(GL,2); GAPB(o[0]=__builtin_amdgcn_mfma_f32_32x32x16_bf16(PAF(2),VFR(2),o[0],0,0,0), C1,0); \
    KRD(GL,3); GAPB(o[1]=__builtin_amdgcn_mfma_f32_32x32x16_bf16(PAF(2),VFR(6),o[1],0,0,0), C1,4); \
    GAPB(o[0]=__builtin_amdgcn_mfma_f32_32x32x16_bf16(PAF(3),VFR(3),o[0],0,0,0), C1,8); \
    GAPB(o[1]=__builtin_amdgcn_mfma_f32_32x32x16_bf16(PAF(3),VFR(7),o[1],0,0,0), C1,12); \
    }while(0)
  int t=1;
  #undef CMASK
  #define CMASK(P0,P1,t) do{}while(0)
  for(;t+5<NT;t+=2){
    STEP(pB0,pB1,pA0,pA1,t,true,true,true);     WAIT_BAR(2); RESC(); ROT();
    STEP(pA0,pA1,pB0,pB1,t+1,true,true,true);   WAIT_BAR(2); RESC(); ROT();
  }
  #undef CMASK
  #define CMASK(P0,P1,t) do{}while(0)
  #define ENDW(tt) do{ if((tt)+3<NT){WAIT_BAR(2);} else if((tt)+2<NT){WAIT_BAR(1);} else {WAIT_BAR(0);} }while(0)
  for(;t+1<NT;t+=2){
    STEP(pB0,pB1,pA0,pA1,t,(t+3<NT),(t+1<NT),(t+1<NT));       ENDW(t);   RESC(); ROT();
    STEP(pA0,pA1,pB0,pB1,t+1,(t+4<NT),(t+2<NT),(t+2<NT));     ENDW(t+1); RESC(); ROT();
  }
  STEP(pB0,pB1,pA0,pA1,NT-1,false,false,false); RESC();
  { float sacc=pB0[0]+pB0[1]; _Pragma("unroll") for(int r=2;r<16;++r)sacc+=pB0[r]; _Pragma("unroll") for(int r=0;r<16;++r)sacc+=pB1[r]; l_reg+=sacc;
    pw0=(u32x4){PKW(pB0,0),PKW(pB0,2),PKW(pB0,4),PKW(pB0,6)};pw1=(u32x4){PKW(pB0,8),PKW(pB0,10),PKW(pB0,12),PKW(pB0,14)};pw2=(u32x4){PKW(pB1,0),PKW(pB1,2),PKW(pB1,4),PKW(pB1,6)};pw3=(u32x4){PKW(pB1,8),PKW(pB1,10),PKW(pB1,12),PKW(pB1,14)};
    SBAR(); pv(o,vb0+sl_cur,PAF(0),PAF(1),PAF(2),PAF(3)); }
  #undef PKW
  #undef PAF
  #undef VFR
  #undef PIN
  #undef MX3
  #undef GAPA
  #undef GAPB
  #undef EX
  #undef VRD
  #undef KRD
  #undef STEP
  #undef ENDW
  {auto rr=__builtin_amdgcn_permlane32_swap(__float_as_uint(l_reg),__float_as_uint(l_reg),false,false);l_reg=__uint_as_float(rr[0])+__uint_as_float(rr[1]);}
  if(hi==0)wsf[32+r32]=l_reg;asm volatile("s_waitcnt lgkmcnt(0)":::"memory");
  float rli[16];
  #pragma unroll
  for(int r=0;r<16;++r)rli[r]=__builtin_amdgcn_rcpf(wsf[32+crow(r,hi)]);
  if constexpr (O8) {
    unsigned char*Ow8=(unsigned char*)Ou+(long)(wid*QBLK)*OP; unsigned char*stg8=(unsigned char*)(shm+LDS_OST)+wid*2048;
    #pragma unroll
    for(int r=0;r<16;++r){const int orow=crow(r,hi);
      #pragma unroll
      for(int d0=0;d0<2;++d0)stg8[orow*64+d0*32+r32]=f2fp8(o[d0][r]*rli[r]);}
    asm volatile("s_waitcnt lgkmcnt(0)":::"memory");
    #pragma unroll
    for(int i=0;i<2;++i){const int row=i*16+(lane>>2),ch=lane&3; const u32x4 v=*(const u32x4*)(stg8+row*64+ch*16); ATTN_STORE16(Ow8+(long)row*OP+ch*16,v);}
  } else {
  bf16*Ow=Ou+(long)(wid*QBLK)*OP;
  { bf16*stg=(bf16*)(shm+LDS_OST)+wid*2048;
    #pragma unroll
    for(int r=0;r<16;++r){const int orow=crow(r,hi);
      #pragma unroll
      for(int d0=0;d0<2;++d0)stg[orow*64+d0*32+r32]=__float2bfloat16(o[d0][r]*rli[r]);}
    asm volatile("s_waitcnt lgkmcnt(0)":::"memory");
    #pragma unroll
    for(int i=0;i<4;++i){const int row=i*8+(lane>>3),ch=lane&7; const u32x4 v=*(const u32x4*)(stg+row*64+ch*8); ATTN_STORE16(Ow+(long)row*OP+ch*8,v);} }
  }
  asm volatile("s_waitcnt lgkmcnt(0)\n\ts_barrier":::"memory");
  #undef DMA_K
  #undef DMA_V
  #undef CMASK
  #undef START
  #undef RESC
  #undef ROT
}
constexpr int ATTN_LDS_BYTES=LDS_BYTES;
#undef SBAR
#undef WAIT_BAR
}

struct Args { const float* in[32]; float* out; unsigned char* ws; int ph_lo, ph_hi; };
struct Ctx {
    LAS unsigned char* lds;
    int vcu, G;
    unsigned char* ws;
};
constexpr int PTAB_OFF = MISC_OFF + 256;
__device__ __forceinline__ unsigned long long ptab_get(const Ctx& cx, int k) {
    const LAS unsigned* t = (const LAS unsigned*)(cx.lds + PTAB_OFF) + 2 * k; const unsigned lo = __builtin_amdgcn_readfirstlane(t[0]), hi = __builtin_amdgcn_readfirstlane(t[1]);
    return ((unsigned long long)hi << 32) | lo;
}
#define INP(k) ((const float*)(GAS const float*)ptab_get(cx, (k)))

template <bool F8> __device__ __forceinline__ void p0_transpose64(const float* W, int N, int KB, unsigned char* WT, int k0, int n0, int dst_row0, float scale, LAS float* scr, int lane) {
    f32x4 v[16];
    const float* src = W + (size_t)(k0 + (lane >> 4)) * N + n0 + (lane & 15) * 4;
#pragma unroll
    for (int i = 0; i < 16; ++i) v[i] = *(const f32x4*)(src + (size_t)(4 * i) * N);
#pragma unroll
    for (int i = 0; i < 16; ++i) { LAS float* p = scr + (4 * i + (lane >> 4)) * 65 + (lane & 15) * 4; p[0] = v[i][0]; p[1] = v[i][1]; p[2] = v[i][2]; p[3] = v[i][3]; }
    LDS_WAIT(); asm volatile("" ::: "memory");
    if constexpr (!F8) {
        const int ns = lane >> 3, ch = lane & 7;
#pragma unroll
        for (int r8 = 0; r8 < 8; ++r8) { const int n = r8 * 8 + ns; const LAS float* s = scr + (8 * ch) * 65 + n;
            u32x4 o; o.x = pk2(s[0 * 65], s[1 * 65]); o.y = pk2(s[2 * 65], s[3 * 65]); o.z = pk2(s[4 * 65], s[5 * 65]); o.w = pk2(s[6 * 65], s[7 * 65]);
            *(GAS u32x4*)(WT + (size_t)(dst_row0 + n) * KB + (k0 + 8 * ch) * 2) = o; }
    } else {
        const int ns = lane >> 2, ch = lane & 3;
#pragma unroll
        for (int r4 = 0; r4 < 4; ++r4) { const int n = r4 * 16 + ns; const LAS float* s = scr + (16 * ch) * 65 + n; unsigned w[4];
#pragma unroll
            for (int q = 0; q < 4; ++q) { int r = 0; r = __builtin_amdgcn_cvt_pk_fp8_f32(s[(4 * q) * 65] * scale, s[(4 * q + 1) * 65] * scale, r, false); r = __builtin_amdgcn_cvt_pk_fp8_f32(s[(4 * q + 2) * 65] * scale, s[(4 * q + 3) * 65] * scale, r, true); w[q] = (unsigned)r; }
            *(GAS u32x4*)(WT + (size_t)(dst_row0 + n) * KB + k0 + 16 * ch) = (u32x4){w[0], w[1], w[2], w[3]}; }
    }
    LDS_WAIT(); asm volatile("" ::: "memory");
}
__device__ __forceinline__ void p0_prologue(const Ctx& cx, const int tid) {
    const int lane = tid & 63, wave = __builtin_amdgcn_readfirstlane(tid >> 6);
    LAS float* scr = (LAS float*)(cx.lds + wave * 16896);
    const int gw = cx.vcu * 8 + wave, NGW = cx.G * 8;
    constexpr int I_WIN0 = 16 * 40, I_WIN1 = 16 * 24, I_WKV = 16 * 8, I_WOUT = 16 * 16, I_W1 = 16 * 32, I_W2 = 16 * 16;
    constexpr int T_WIN = 3 * I_WIN0 + I_WIN1, T_WKV = 4 * I_WKV, T_WOUT = 4 * I_WOUT, T_W1 = 128 * I_W1, T_W2 = 128 * I_W2;
    constexpr int NITEMS = T_WIN + T_WKV + T_WOUT + T_W1 + T_W2;
    for (int it = gw; it < NITEMS; it += NGW) {
        int r = it;
        const float* W; unsigned char* WT; int N, nb, kb, dst_row0; bool isout = false;
        if (r < T_W1) {
            const int mi = r / I_W1, q = r % I_W1; N = 2048; kb = q / 32; nb = q % 32;
            W = INP(28) + (size_t)mi * 1024 * 2048; WT = cx.ws + WS_W1 + (size_t)mi * 2048 * 1024 * MOE_EB;
            const int n0 = nb * 64, isu = n0 >= 1024, j = n0 - isu * 1024;
            dst_row0 = (j >> 7) * 256 + isu * 128 + (j & 127);
            p0_transpose64<MOE_F8>(W, N, 1024 * MOE_EB, WT, kb * 64, nb * 64, dst_row0, W1_SCALE, scr, lane); continue;
        } else if ((r -= T_W1) < T_W2) {
            const int mi = r / I_W2, q = r % I_W2; N = 1024; kb = q / 16; nb = q % 16;
            W = INP(30) + (size_t)mi * 1024 * 1024; WT = cx.ws + WS_W2 + (size_t)mi * 1024 * 1024 * MOE_EB; dst_row0 = nb * 64;
            p0_transpose64<MOE_F8>(W, N, 1024 * MOE_EB, WT, kb * 64, nb * 64, dst_row0, W2_SCALE, scr, lane); continue;
        } else if ((r -= T_W2) < T_WIN) {
            int l, q;
            if (r < I_WIN0) { l = 0; q = r; } else if (r < I_WIN0 + I_WIN1) { l = 1; q = r - I_WIN0; } else if (r < 2 * I_WIN0 + I_WIN1) { l = 2; q = r - I_WIN0 - I_WIN1; } else { l = 3; q = r - 2 * I_WIN0 - I_WIN1; }
            N = in_width(l); const int nbn = N / 64; kb = q / nbn; nb = q % nbn;
            const int kind = layer_kind(l), j = layer_j(l);
            W = (kind == 0 ? INP(2) : kind == 1 ? INP(4) : INP(7)) + (size_t)j * 1024 * N;
            WT = cx.ws + WS_WIN + (size_t)l * 5 * MiB; dst_row0 = nb * 64;
        } else if ((r -= T_WIN) < T_WKV) {
            const int l = r / I_WKV, q = r % I_WKV; N = 512; kb = q / 8; nb = q % 8;
            W = INP(20) + (size_t)l * 1024 * 512; WT = cx.ws + WS_WKV; dst_row0 = l * 512 + nb * 64;
        } else {
            r -= T_WKV; const int l = r / I_WOUT, q = r % I_WOUT; N = 1024; kb = q / 16; nb = q % 16;
            W = INP(21) + (size_t)l * 1024 * 1024; WT = cx.ws + WS_WOUT + (size_t)l * 2 * MiB; dst_row0 = nb * 64; isout = true;
        }
        if (isout) p0_transpose64<OUTP_F8 != 0>(W, N, 1024 * OUT_EB, WT, kb * 64, nb * 64, dst_row0, OUTP_F8 ? WOUT_SCALE : 1.0f, scr, lane);
        else p0_transpose64<INP_F8 != 0>(W, N, 1024 * INP_EB, WT, kb * 64, nb * 64, dst_row0, INP_F8 ? WIN_SCALE : 1.0f, scr, lane);
    }
    {
        const size_t gt = (size_t)cx.vcu * 512 + tid, NT_ = (size_t)cx.G * 512;
        for (int which = 0; which < 2; ++which) {
            const f32x4* xs = (const f32x4*)(which == 0 ? INP(0) : INP(1)); unsigned char* xd = cx.ws + (which == 0 ? WS_XB : WS_MEMB); const size_t n8 = (size_t)(which == 0 ? NTOK : NMEM) * DM / 8;
#pragma unroll 4
            for (size_t i = gt; i < n8; i += NT_) { const f32x4 a = xs[2 * i], b = xs[2 * i + 1];
                if constexpr (INP_F8) { int w0 = 0, w1 = 0; w0 = __builtin_amdgcn_cvt_pk_fp8_f32(a[0], a[1], w0, false); w0 = __builtin_amdgcn_cvt_pk_fp8_f32(a[2], a[3], w0, true); w1 = __builtin_amdgcn_cvt_pk_fp8_f32(b[0], b[1], w1, false); w1 = __builtin_amdgcn_cvt_pk_fp8_f32(b[2], b[3], w1, true);
                    *(u32x2*)(xd + i * 8) = (u32x2){(unsigned)w0, (unsigned)w1}; }
                else { u32x4 o; o.x = pk2(a[0], a[1]); o.y = pk2(a[2], a[3]); o.z = pk2(b[0], b[1]); o.w = pk2(b[2], b[3]); *(u32x4*)(xd + i * 16) = o; } }
        }
    }
    { const float* rwp = INP(26); unsigned short* RW = (unsigned short*)(cx.ws + WS_RW);
      for (int i = cx.vcu * 512 + tid; i < 4 * 32768; i += cx.G * 512) { const int l = i >> 15, r = i & 32767, k = r >> 5, e = r & 31; const float w = rwp[i]; const unsigned hi = f2bf(w); const float wl = w - bf2f((unsigned short)hi);
          RW[((size_t)(l * 2 + 0) * 32 + e) * 1024 + k] = (unsigned short)hi; RW[((size_t)(l * 2 + 1) * 32 + e) * 1024 + k] = (unsigned short)f2bf(wl); } }
    {
        const float *fw1 = INP(10), *fb1 = INP(11), *fw2 = INP(12), *fb2 = INP(13), *fw3 = INP(14), *fb3 = INP(15), *fw4 = INP(16), *fb4 = INP(17), *ffr = INP(18);
        LAS float* z = (LAS float*)cx.lds; LAS float* h1 = z + 16 * 33; LAS float* h2 = h1 + 1024; LAS float* h3 = h2 + 1024;
        float* HRAWT = (float*)(cx.ws + WS_HRAWT); float* HPART = (float*)(cx.ws + WS_HPART);
        for (int it = cx.vcu; it < 256; it += cx.G) {
            __syncthreads();
            const int pos0 = it * 16;
            for (int i = tid; i < 16 * 33; i += 512) { const int p = i / 33, f = i % 33; const float pos = (float)(pos0 + p); float v;
                if (f == 0) v = pos / 4095.0f;
                else { const int k = (f - 1) & 15; const float fb = 1e-4f + (float)k * ((15.0f - 1e-4f) / 15.0f); const float ang = (6.283185307179586f * pos / 4096.0f) * fb; v = (f <= 16) ? cosf(ang) : -sinf(ang); }
                z[i] = v; }
            __syncthreads();
            for (int i = tid; i < 1024; i += 512) { const int p = i >> 6, o = i & 63; float a = fb1[o]; for (int f = 0; f < 33; ++f) a += z[p * 33 + f] * fw1[f * 64 + o]; h1[i] = sinf(ffr[o] * a); }
            __syncthreads();
            for (int i = tid; i < 1024; i += 512) { const int p = i >> 6, o = i & 63; float a = fb2[o]; for (int k = 0; k < 64; ++k) a += h1[p * 64 + k] * fw2[k * 64 + o]; h2[i] = sinf(ffr[o] * a); }
            __syncthreads();
            for (int i = tid; i < 1024; i += 512) { const int p = i >> 6, o = i & 63; float a = fb3[o]; for (int k = 0; k < 64; ++k) a += h2[p * 64 + k] * fw3[k * 64 + o]; h3[i] = sinf(ffr[o] * a); }
            __syncthreads();
            for (int col = tid; col < 3072; col += 512) {
                float a[16]; const float bb = fb4[col];
#pragma unroll
                for (int p = 0; p < 16; ++p) a[p] = bb;
                for (int k = 0; k < 64; ++k) { const float w = fw4[(size_t)k * 3072 + col];
#pragma unroll
                    for (int p = 0; p < 16; ++p) a[p] += h3[p * 64 + k] * w; }
                const int c = col % 768; const float mind = -3.0701134573253945f, maxd = -15.350567286626972f;
                const float delta = fabsf(mind + (maxd - mind) * ((float)c / 767.0f)); float asum = 0.f;
#pragma unroll
                for (int p = 0; p < 16; ++p) { const float t = (float)(pos0 + p) / 4095.0f; a[p] *= expf(-t * delta); asum += fabsf(a[p]); }
                f32x4* dst = (f32x4*)(HRAWT + (size_t)col * 4096 + pos0);
#pragma unroll
                for (int q = 0; q < 4; ++q) dst[q] = (f32x4){a[4 * q], a[4 * q + 1], a[4 * q + 2], a[4 * q + 3]};
                HPART[(size_t)it * 3072 + col] = asum;
            }
        }
    }
}

__device__ __forceinline__ s16x4 vtr(const LAS unsigned char* p) { typedef short v4i16_t __attribute__((ext_vector_type(4))); return __builtin_bit_cast(s16x4, __builtin_amdgcn_ds_read_tr16_b64_v4i16((LAS v4i16_t*)p)); }
__device__ __forceinline__ void na_phase(const Ctx& cx, const bf16_t* PROJ, const float* rpb, bf16_t* CAT, const int tid) {
    const int lane = tid & 63, wid = __builtin_amdgcn_readfirstlane(tid >> 6), m16 = lane & 15, q4 = lane >> 4;
    LAS unsigned char* Kb = cx.lds; LAS unsigned char* Vb = cx.lds + 73728; LAS float* biasL = (LAS float*)(cx.lds + 147456);
    constexpr int PW = 2560;
    u32x4 kv[9], vv[9]; float bpre = 0.f; bf16x8 qn[2];
#define NA_LOAD(unit_) do { const int b_ = __builtin_amdgcn_readfirstlane((unit_) / 384), rem_ = __builtin_amdgcn_readfirstlane((unit_) % 384), h_ = rem_ >> 5, rp_ = rem_ & 31; int bs_ = 2 * rp_ - 4; bs_ = bs_ < 0 ? 0 : (bs_ > 56 ? 56 : bs_); bs_ = __builtin_amdgcn_readfirstlane(bs_); \
        _Pragma("unroll") for (int it = 0; it < 9; ++it) { const int i = tid + it * 512; const int brow = i >> 9, col = (i >> 3) & 63, ch = i & 7; int grow = bs_ + brow; grow = grow > 63 ? 63 : grow; \
            const size_t tok = (size_t)b_ * 4096 + grow * 64 + col; \
            kv[it] = *(const u32x4*)(PROJ + tok * PW + 768 + h_ * 64 + ch * 8); vv[it] = *(const u32x4*)(PROJ + tok * PW + 1536 + h_ * 64 + ch * 8); } \
        if (tid < 465) bpre = rpb[h_ * 465 + tid];   \
        { const size_t tq_ = (size_t)b_ * 4096 + (2 * rp_ + (wid >> 2)) * 64 + 16 * (wid & 3) + m16; \
          _Pragma("unroll") for (int kk = 0; kk < 2; ++kk) qn[kk] = *(const bf16x8*)(PROJ + tq_ * PW + h_ * 64 + 32 * kk + 8 * q4); } } while (0)
    int u0 = cx.vcu; asm volatile("" : "+s"(u0));
    if (u0 < 6144) NA_LOAD(u0);
    for (int unit = u0; unit < 6144; unit += cx.G) {
        const int b = unit / 384, rem = unit % 384, h = rem >> 5, rp = rem & 31;
        int bs = 2 * rp - 4; bs = bs < 0 ? 0 : (bs > 56 ? 56 : bs);
        __syncthreads();
#pragma unroll
        for (int it = 0; it < 9; ++it) { const int i = tid + it * 512; const int brow = i >> 9, col = (i >> 3) & 63, ch = i & 7;
            *(LAS u32x4*)(Kb + (brow * 64 + col) * 128 + ((ch ^ ((col >> 1) & 7)) << 4)) = kv[it];
            *(LAS u32x4*)(Vb + (brow * 64 + col) * 128 + ((ch ^ (col & 7)) << 4)) = vv[it]; }
        if (tid < 465) biasL[tid] = bpre * LOG2E;
        __syncthreads();
        bf16x8 qf[2]; qf[0] = qn[0]; qf[1] = qn[1];
        { const int un_ = (unit + cx.G < 6144) ? unit + cx.G : unit; NA_LOAD(un_); }
        const int r = 2 * rp + (wid >> 2), g = wid & 3;
        const int wc0 = (g == 0) ? 0 : (g == 1) ? 8 : (g == 2) ? 24 : 32;
        int r0 = r - 4; r0 = r0 < 0 ? 0 : (r0 > 56 ? 56 : r0); const int ro = r0 - bs;
        const int c = 16 * g + m16;
        const size_t tq = (size_t)b * 4096 + r * 64 + c;
        f32x4 S[16];
#pragma unroll
        for (int i = 0; i < 8; ++i)
#pragma unroll
            for (int ct = 0; ct < 2; ++ct) { const int col = wc0 + 16 * ct + m16; const LAS unsigned char* kp = Kb + ((ro + i) * 64 + col) * 128; const int sw = (col >> 1) & 7;
                f32x4 a = (f32x4){0.f, 0.f, 0.f, 0.f};
#pragma unroll
                for (int kk = 0; kk < 2; ++kk) { const bf16x8 kf = *(const LAS bf16x8*)(kp + (((q4 + 4 * kk) ^ sw) << 4)); a = __builtin_amdgcn_mfma_f32_16x16x32_bf16(kf, qf[kk], a, 0, 0, 0); }
                S[2 * i + ct] = a; }
        int c0 = c - 8; c0 = c0 < 0 ? 0 : (c0 > 48 ? 48 : c0);
        float mx = -INFINITY;
#pragma unroll
        for (int i = 0; i < 8; ++i)
#pragma unroll
            for (int ct = 0; ct < 2; ++ct)
#pragma unroll
                for (int v = 0; v < 4; ++v) { const int kc = wc0 + 16 * ct + 4 * q4 + v; const bool valid = (kc >= c0) && (kc < c0 + 16);
                    const int bidx = valid ? (r0 + i - r + 7) * 31 + (kc - c + 15) : 0;
                    const float s = valid ? S[2 * i + ct][v] + biasL[bidx] : -INFINITY; S[2 * i + ct][v] = s; mx = fmaxf(mx, s); }
        mx = fmaxf(mx, shflx(mx, 16, lane)); mx = fmaxf(mx, shflx(mx, 32, lane));
        float l = 0.f;
#pragma unroll
        for (int t = 0; t < 16; ++t)
#pragma unroll
            for (int v = 0; v < 4; ++v) { const float p = __builtin_amdgcn_exp2f(S[t][v] - mx); S[t][v] = p; l += p; }
        l += shflx(l, 16, lane); l += shflx(l, 32, lane);
        f32x4 O[4];
#pragma unroll
        for (int dt = 0; dt < 4; ++dt) O[dt] = (f32x4){0.f, 0.f, 0.f, 0.f};
        const int qq = m16 >> 2, pp = m16 & 3, col1 = wc0 + 4 * q4 + qq;
#pragma unroll
        for (int i = 0; i < 8; ++i) {
            u32x4 pw; pw.x = pk2(S[2 * i][0], S[2 * i][1]); pw.y = pk2(S[2 * i][2], S[2 * i][3]); pw.z = pk2(S[2 * i + 1][0], S[2 * i + 1][1]); pw.w = pk2(S[2 * i + 1][2], S[2 * i + 1][3]);
            const bf16x8 pb = __builtin_bit_cast(bf16x8, pw);
            const LAS unsigned char* v1 = Vb + ((ro + i) * 64 + col1) * 128 + 8 * (pp & 1);
            const LAS unsigned char* v2 = v1 + 16 * 128;
#pragma unroll
            for (int dt = 0; dt < 4; ++dt) { const int chunk = 2 * dt + (pp >> 1);
                const s16x4 lo = vtr(v1 + ((chunk ^ (col1 & 7)) << 4)), hi = vtr(v2 + ((chunk ^ ((col1 + 16) & 7)) << 4));
                const bf16x8 vf = (bf16x8){lo[0], lo[1], lo[2], lo[3], hi[0], hi[1], hi[2], hi[3]};
                O[dt] = __builtin_amdgcn_mfma_f32_16x16x32_bf16(vf, pb, O[dt], 0, 0, 0); }
        }
        const float inv = 1.0f / l;
#pragma unroll
        for (int dt = 0; dt < 4; ++dt) {
            if constexpr (OUTP_F8) { int w = 0; w = __builtin_amdgcn_cvt_pk_fp8_f32(O[dt][0] * inv, O[dt][1] * inv, w, false); w = __builtin_amdgcn_cvt_pk_fp8_f32(O[dt][2] * inv, O[dt][3] * inv, w, true); *(int*)((unsigned char*)CAT + tq * 1024 + h * 64 + 16 * dt + 4 * q4) = w; }
            else { u32x2 w; w.x = pk2(O[dt][0] * inv, O[dt][1] * inv); w.y = pk2(O[dt][2] * inv, O[dt][3] * inv); *(u32x2*)(CAT + tq * 1024 + h * 64 + 16 * dt + 4 * q4) = w; } }
    }
    __syncthreads();
}

#undef NA_LOAD
__device__ __forceinline__ void rope_phase(const Ctx& cx, const bf16_t* PROJ, const float* qg, const float* kg, bf16_t* QKR, const int tid) {
    const int lane = tid & 63, wave = __builtin_amdgcn_readfirstlane(tid >> 6);
    const int gw = cx.vcu * 8 + wave, NGW = cx.G * 8;
    const int d0 = (lane & 7) * 8;
    float gq[8], gk[8], invf[4];
#pragma unroll
    for (int e = 0; e < 8; ++e) { gq[e] = qg[d0 + e]; gk[e] = kg[d0 + e]; }
#pragma unroll
    for (int p = 0; p < 4; ++p) { const int i = (d0 >> 1) + p, j = i & 15; invf[p] = exp2f(-(float)(2 * j) / 32.0f * 13.287712379549449f); }
    const bool isrow = (d0 >> 1) < 16;
    for (int pos = gw; pos < SEQ; pos += NGW) {
        const float pr = isrow ? (float)(pos >> 6) : (float)(pos & 63);
        float cs[4], sn[4];
#pragma unroll
        for (int p = 0; p < 4; ++p) { const float a = pr * invf[p]; cs[p] = cosf(a); sn[p] = sinf(a); }
#pragma unroll 4
        for (int bb = 0; bb < BATCH; ++bb) { const int tok = bb * SEQ + pos;
#pragma unroll
        for (int half = 0; half < 2; ++half) {
            const int e0 = half * 512 + lane * 8; const int head = e0 >> 6; const bool isq = head < 12;
            const u32x4 raw = *(const u32x4*)(PROJ + (size_t)tok * 1536 + e0);
            float x[8]; x[0] = bflo(raw.x); x[1] = bfhi(raw.x); x[2] = bflo(raw.y); x[3] = bfhi(raw.y); x[4] = bflo(raw.z); x[5] = bfhi(raw.z); x[6] = bflo(raw.w); x[7] = bfhi(raw.w);
            float ss = 0.f;
#pragma unroll
            for (int e = 0; e < 8; ++e) ss += x[e] * x[e];
            ss = group8_sum(ss);
            const float inv = rsqrtf(ss * (1.0f / 64.0f) + 1e-6f);
            float y[8];
#pragma unroll
            for (int e = 0; e < 8; ++e) y[e] = x[e] * inv * (isq ? gq[e] : gk[e]);
            const float sc = isq ? C2 : 1.0f;
            float o[8];
#pragma unroll
            for (int p = 0; p < 4; ++p) { o[2 * p] = (y[2 * p] * cs[p] - y[2 * p + 1] * sn[p]) * sc; o[2 * p + 1] = (y[2 * p] * sn[p] + y[2 * p + 1] * cs[p]) * sc; }
            u32x4 w; w.x = pk2(o[0], o[1]); w.y = pk2(o[2], o[3]); w.z = pk2(o[4], o[5]); w.w = pk2(o[6], o[7]);
            *(u32x4*)(QKR + (size_t)tok * 1024 + e0) = w;
        } }
    }
}

__device__ __forceinline__ void sconv_phase(const Ctx& cx, const bf16_t* PROJ, const float* cw, const float* cb, bf16_t* UT3, unsigned char* V8, const int tid) {
    const int lane = tid & 63, wave = __builtin_amdgcn_readfirstlane(tid >> 6);
    const int gw = cx.vcu * 8 + wave, NGW = cx.G * 8;
    LAS unsigned short* tile = (LAS unsigned short*)(cx.lds + wave * 9216);
    constexpr int PW = 2560;
    for (int it = gw; it < 16 * 64 * 36; it += NGW) {
        const int ct = it % 36, tt = (it / 36) & 63, b = it / (36 * 64);
        const int col = ct * 64 + lane, t0 = tt * 64;
        const float w0 = cw[col], w1 = cw[2304 + col], w2 = cw[4608 + col], bia = cb[col];
        const bf16_t* src = PROJ + ((size_t)b * 4096 + t0) * PW + col;
        unsigned short uu[66];
        uu[0] = (t0 > 0) ? src[-(long)PW] : (unsigned short)0;
#pragma unroll
        for (int k = 0; k < 64; ++k) uu[k + 1] = src[(size_t)k * PW];
        uu[65] = (t0 + 64 < 4096) ? src[(size_t)64 * PW] : (unsigned short)0;
#pragma unroll
        for (int k = 0; k < 64; ++k) { const float v = bf2f(uu[k]) * w0 + bf2f(uu[k + 1]) * w1 + bf2f(uu[k + 2]) * w2 + bia; tile[lane * 72 + k] = (unsigned short)f2bf(v); }
        LDS_WAIT(); asm volatile("" ::: "memory");
        const int part = (ct * 64) / 768, cbase = (ct * 64) % 768;
#pragma unroll
        for (int k = 0; k < 8; ++k) { const int row = k * 8 + (lane >> 3), chn = lane & 7;
            const u32x4 v = *(const LAS u32x4*)((const LAS unsigned char*)tile + row * 144 + chn * 16);
            *(u32x4*)(UT3 + (((size_t)part * 16 + b) * 768 + cbase + row) * 4096 + t0 + chn * 8) = v;
            if (TCONV_F8 && part == 0) { int w0 = 0, w1 = 0;
                w0 = __builtin_amdgcn_cvt_pk_fp8_f32(bflo(v.x), bfhi(v.x), w0, false); w0 = __builtin_amdgcn_cvt_pk_fp8_f32(bflo(v.y), bfhi(v.y), w0, true);
                w1 = __builtin_amdgcn_cvt_pk_fp8_f32(bflo(v.z), bfhi(v.z), w1, false); w1 = __builtin_amdgcn_cvt_pk_fp8_f32(bflo(v.w), bfhi(v.w), w1, true);
                *(u32x2*)(V8 + ((size_t)b * 768 + cbase + row) * 4096 + t0 + chn * 8) = (u32x2){(unsigned)w0, (unsigned)w1}; } }
        LDS_WAIT(); asm volatile("" ::: "memory");
    }
}

constexpr int TZ_CS = 16384 + 64;
__device__ __forceinline__ void tconv_phase(const Ctx& cx, const int o, const bf16_t* UT, const bf16_t* GT, bf16_t* ZT, const float* lbias  , const int tid) {
    const int lane = tid & 63, wid = __builtin_amdgcn_readfirstlane(tid >> 6), m16 = lane & 15, q4 = lane >> 4;
    const float* HRAWT = (const float*)(cx.ws + WS_HRAWT); const float* HPART = (const float*)(cx.ws + WS_HPART);
    LAS unsigned char* cp = cx.lds; LAS float* red = (LAS float*)(cx.lds + 8 * TZ_CS);
    for (int c = cx.vcu; c < 768; c += cx.G) {
        __syncthreads();
        { const int dir = tid >> 8, blk = tid & 255; float v = HPART[(size_t)blk * 3072 + dir * 1536 + o * 768 + c]; v = wave_sum(v, lane); if (lane == 0) red[wid] = v; }
        __syncthreads();
        float nrm = 0.f;
#pragma unroll
        for (int w = 0; w < 8; ++w) nrm += red[w];
        const float inv = 1.0f / nrm;
        const float* hf = HRAWT + (size_t)(o * 768 + c) * 4096; const float* hb = HRAWT + (size_t)(1536 + o * 768 + c) * 4096;
        for (int i = tid; i < 8192; i += 512) { float v; if (i < 4096) v = hf[4095 - i]; else if (i < 8191) v = hb[i - 4095]; else v = 0.f;
            *(LAS unsigned short*)(cp + 2 * i) = (unsigned short)f2bf(v * inv); }
        __syncthreads();
#pragma unroll
        for (int j = 1; j < 8; ++j)
            for (int n = tid; n < 1024; n += 512) {
                const u32x4 lo = *(const LAS u32x4*)(cp + n * 16); u32x4 hi = (u32x4){0u, 0u, 0u, 0u}; if (n + 1 < 1024) hi = *(const LAS u32x4*)(cp + (n + 1) * 16);
                const unsigned w[8] = {lo.x, lo.y, lo.z, lo.w, hi.x, hi.y, hi.z, hi.w}; u32x4 r;
                const int a = j >> 1;
                if (j & 1) { r.x = (w[a] >> 16) | (w[a + 1] << 16); r.y = (w[a + 1] >> 16) | (w[a + 2] << 16); r.z = (w[a + 2] >> 16) | (w[a + 3] << 16); r.w = (w[a + 3] >> 16) | (w[a + 4] << 16); }
                else { r.x = w[a]; r.y = w[a + 1]; r.z = w[a + 2]; r.w = w[a + 3]; }
                *(LAS u32x4*)(cp + j * TZ_CS + n * 16) = r;
            }
        __syncthreads();
        const int j = (7 - m16) & 7;
        const int nbase = (4095 - 512 * wid - m16 - j + 8 * q4) >> 3;
        const LAS unsigned char* ap = cp + j * TZ_CS + (nbase - 62) * 16;
        const bf16_t* up = UT + ((size_t)m16 * 768 + c) * 4096 + 8 * q4;
        f32x4 acc[32];
#pragma unroll
        for (int ti = 0; ti < 32; ++ti) acc[ti] = (f32x4){0.f, 0.f, 0.f, 0.f};
        bf16x8 bcur = *(const bf16x8*)(up);
        bf16x8 afA[8], afB[8];
#pragma unroll
        for (int i = 0; i < 8; ++i) afA[i] = *(const LAS bf16x8*)(ap + (31 - i) * 32);
        for (int ks = 0; ks < 128; ++ks) {
            const bf16x8 bnext = *(const bf16x8*)(up + ((ks + 1) & 127) * 32);
            const LAS unsigned char* a0 = ap + ks * 64;
            const LAS unsigned char* a1 = ap + ((ks + 1) & 127) * 64;
#define TZ_LD(dst, base, g) do { _Pragma("unroll") for (int i = 0; i < 8; ++i) dst[i] = *(const LAS bf16x8*)((base) + (31 - (8 * (g) + i)) * 32); } while (0)
#define TZ_MM(src, g) do { _Pragma("unroll") for (int i = 0; i < 8; ++i) acc[8 * (g) + i] = __builtin_amdgcn_mfma_f32_16x16x32_bf16(src[i], bcur, acc[8 * (g) + i], 0, 0, 0); } while (0)
            TZ_LD(afB, a0, 1); TZ_MM(afA, 0); __builtin_amdgcn_sched_barrier(0);
            TZ_LD(afA, a0, 2); TZ_MM(afB, 1); __builtin_amdgcn_sched_barrier(0);
            TZ_LD(afB, a0, 3); TZ_MM(afA, 2); __builtin_amdgcn_sched_barrier(0);
            TZ_LD(afA, a1, 0); TZ_MM(afB, 3); __builtin_amdgcn_sched_barrier(0);
#undef TZ_LD
#undef TZ_MM
            bcur = bnext;
        }
        const float lb = lbias[c];
        const size_t rowoff = ((size_t)m16 * 768 + c) * 4096 + 512 * wid + 4 * q4;
#pragma unroll
        for (int ti = 0; ti < 32; ++ti) {
            const u32x2 uu = *(const u32x2*)(UT + rowoff + 16 * ti), gg = *(const u32x2*)(GT + rowoff + 16 * ti);
            const float y0 = (acc[ti][0] + lb * bflo(uu.x)) * bflo(gg.x), y1 = (acc[ti][1] + lb * bfhi(uu.x)) * bfhi(gg.x), y2 = (acc[ti][2] + lb * bflo(uu.y)) * bflo(gg.y), y3 = (acc[ti][3] + lb * bfhi(uu.y)) * bfhi(gg.y);
            u32x2 w; w.x = pk2(y0, y1); w.y = pk2(y2, y3);
            *(u32x2*)(ZT + rowoff + 16 * ti) = w;
            if ((ti & 7) == 7) __builtin_amdgcn_sched_barrier(0);
        }
    }
    __syncthreads();
}

constexpr int T8_CS = 8192 + 256;
__host__ __device__ constexpr int t8_sig(int j) { return j < 4 ? 2 * j : (j >= 12 ? 2 * (j - 8) : 2 * (j - 4) + 1); }
__device__ __forceinline__ float wave_max_nn(float v) {
    v = fmaxf(v, dpp_x<0xB1>(v)); v = fmaxf(v, dpp_x<0x4E>(v)); v = fmaxf(v, dpp_x<0x141>(v)); v = fmaxf(v, dpp_x<0x140>(v));
    v = fmaxf(v, __builtin_bit_cast(float, __builtin_amdgcn_update_dpp(0, __builtin_bit_cast(int, v), 0x142, 0xA, 0xF, false)));
    v = fmaxf(v, __builtin_bit_cast(float, __builtin_amdgcn_update_dpp(0, __builtin_bit_cast(int, v), 0x143, 0xC, 0xF, false)));
    return __builtin_bit_cast(float, __builtin_amdgcn_readlane(__builtin_bit_cast(int, v), 63));
}
__device__ __forceinline__ void tconv8_phase(const Ctx& cx, const int o, const bf16_t* UT, const unsigned char* U8, const bf16_t* GT, bf16_t* ZT, unsigned char* Z8  ,
                                             const float* lbias, const int tid) {
    const int lane = tid & 63, wid = __builtin_amdgcn_readfirstlane(tid >> 6), m16 = lane & 15, q4 = lane >> 4;
    const float* HRAWT = (const float*)(cx.ws + WS_HRAWT); const float* HPART = (const float*)(cx.ws + WS_HPART);
    LAS unsigned char* cp = cx.lds; LAS float* red = (LAS float*)(cx.lds + 16 * T8_CS);
    for (int c = cx.vcu; c < 768; c += cx.G) {
        __syncthreads();
        const float* hf = HRAWT + (size_t)(o * 768 + c) * 4096; const float* hb = HRAWT + (size_t)(1536 + o * 768 + c) * 4096;
        float tap[16]; float mx = 0.f;
        int t3 = tid; asm volatile("" : "+v"(t3));
#pragma unroll
        for (int k = 0; k < 16; ++k) { const int i = t3 * 16 + k; float v; if (i < 4096) v = hf[4095 - i]; else if (i < 8191) v = hb[i - 4095]; else v = 0.f; tap[k] = v; mx = fmaxf(mx, fabsf(v)); }
        { const int dir = tid >> 8, blk = tid & 255; float v = HPART[(size_t)blk * 3072 + dir * 1536 + o * 768 + c]; v = wave_sum(v, lane); mx = wave_max_nn(mx); if (lane == 0) { red[wid] = v; red[8 + wid] = mx; } }
        __syncthreads();
        float nrm = 0.f, mall = 0.f;
#pragma unroll
        for (int w = 0; w < 8; ++w) { nrm += red[w]; mall = fmaxf(mall, red[8 + w]); }
        const float inv = 1.0f / nrm;
        int ex; (void)frexpf(fmaxf(mall * inv, 1e-30f), &ex);
        const float fsc = ldexpf(1.0f, 7 - ex), unsc = ldexpf(1.0f, ex - 7), tsc = inv * fsc;
        { unsigned w[4];
#pragma unroll
          for (int q = 0; q < 4; ++q) { int r = 0; r = __builtin_amdgcn_cvt_pk_fp8_f32(tap[4 * q] * tsc, tap[4 * q + 1] * tsc, r, false); r = __builtin_amdgcn_cvt_pk_fp8_f32(tap[4 * q + 2] * tsc, tap[4 * q + 3] * tsc, r, true); w[q] = (unsigned)r; }
          *(LAS u32x4*)(cp + tid * 16) = (u32x4){w[0], w[1], w[2], w[3]}; }
        __syncthreads();
        { const u32x4 lo = *(const LAS u32x4*)(cp + tid * 16); u32x4 hi = (u32x4){0u, 0u, 0u, 0u}; if (tid + 1 < 512) hi = *(const LAS u32x4*)(cp + (tid + 1) * 16);
          const unsigned w[8] = {lo.x, lo.y, lo.z, lo.w, hi.x, hi.y, hi.z, hi.w};
#pragma unroll
          for (int j = 1; j < 16; ++j) { u32x4 r; const int a = j >> 2, sh = j & 3;
              r.x = sh ? __builtin_amdgcn_alignbyte(w[a + 1], w[a], sh) : w[a]; r.y = sh ? __builtin_amdgcn_alignbyte(w[a + 2], w[a + 1], sh) : w[a + 1];
              r.z = sh ? __builtin_amdgcn_alignbyte(w[a + 3], w[a + 2], sh) : w[a + 2]; r.w = sh ? __builtin_amdgcn_alignbyte(w[a + 4], w[a + 3], sh) : w[a + 3];
              *(LAS u32x4*)(cp + j * T8_CS + t8_sig(j) * 16 + tid * 16) = r; } }
        __syncthreads();
        const int jc = 15 - m16;
        const int nbase = 255 - 32 * wid + 2 * q4;
        const LAS unsigned char* ap = cp + jc * T8_CS + t8_sig(jc) * 16 + (nbase - 31) * 16;
        const unsigned char* up = U8 + ((size_t)m16 * 768 + c) * 4096 + 32 * q4;
        f32x4 acc[32];
#pragma unroll
        for (int ti = 0; ti < 32; ++ti) acc[ti] = (f32x4){0.f, 0.f, 0.f, 0.f};
        typedef int v8i_t __attribute__((ext_vector_type(8))); typedef int v4i_t __attribute__((ext_vector_type(4)));
#define T8_FRAG(p) __builtin_shufflevector(*(const LAS v4i_t*)(p), *(const LAS v4i_t*)((p) + 16), 0, 1, 2, 3, 4, 5, 6, 7)
        v8i_t bcur = __builtin_shufflevector(*(const v4i_t*)(up), *(const v4i_t*)(up + 16), 0, 1, 2, 3, 4, 5, 6, 7);
        v8i_t afA[4], afB[4];
#pragma unroll
        for (int i = 0; i < 4; ++i) afA[i] = T8_FRAG(ap + (31 - i) * 16);
        for (int ks = 0; ks < 32; ++ks) {
            const unsigned char* un = up + ((ks + 1) & 31) * 128;
            const v8i_t bnext = __builtin_shufflevector(*(const v4i_t*)(un), *(const v4i_t*)(un + 16), 0, 1, 2, 3, 4, 5, 6, 7);
            const LAS unsigned char* a0 = ap + ks * 128;
            const LAS unsigned char* a1 = ap + ((ks + 1) & 31) * 128;
#define T8_LD(dst, base, g) do { _Pragma("unroll") for (int i = 0; i < 4; ++i) dst[i] = T8_FRAG((base) + (31 - (4 * (g) + i)) * 16); } while (0)
#define T8_MM(src, g) do { _Pragma("unroll") for (int i = 0; i < 4; ++i) acc[4 * (g) + i] = __builtin_amdgcn_mfma_scale_f32_16x16x128_f8f6f4(src[i], bcur, acc[4 * (g) + i], 0, 0, 0, 0, 0, 0); } while (0)
            T8_LD(afB, a0, 1); T8_MM(afA, 0); __builtin_amdgcn_sched_barrier(0);
            T8_LD(afA, a0, 2); T8_MM(afB, 1); __builtin_amdgcn_sched_barrier(0);
            T8_LD(afB, a0, 3); T8_MM(afA, 2); __builtin_amdgcn_sched_barrier(0);
            T8_LD(afA, a0, 4); T8_MM(afB, 3); __builtin_amdgcn_sched_barrier(0);
            T8_LD(afB, a0, 5); T8_MM(afA, 4); __builtin_amdgcn_sched_barrier(0);
            T8_LD(afA, a0, 6); T8_MM(afB, 5); __builtin_amdgcn_sched_barrier(0);
            T8_LD(afB, a0, 7); T8_MM(afA, 6); __builtin_amdgcn_sched_barrier(0);
            T8_LD(afA, a1, 0); T8_MM(afB, 7); __builtin_amdgcn_sched_barrier(0);
#undef T8_LD
#undef T8_MM
            bcur = bnext;
        }
#undef T8_FRAG
        const float lb = lbias[c];
        const size_t rowoff = ((size_t)m16 * 768 + c) * 4096 + 512 * wid + 4 * q4;
#pragma unroll
        for (int ti = 0; ti < 32; ++ti) {
            const u32x2 uu = *(const u32x2*)(UT + rowoff + 16 * ti), gg = *(const u32x2*)(GT + rowoff + 16 * ti);
            const float y0 = (acc[ti][0] * unsc + lb * bflo(uu.x)) * bflo(gg.x), y1 = (acc[ti][1] * unsc + lb * bfhi(uu.x)) * bfhi(gg.x), y2 = (acc[ti][2] * unsc + lb * bflo(uu.y)) * bflo(gg.y), y3 = (acc[ti][3] * unsc + lb * bfhi(uu.y)) * bfhi(gg.y);
            u32x2 w; w.x = pk2(y0, y1); w.y = pk2(y2, y3);
            *(u32x2*)(ZT + rowoff + 16 * ti) = w;
            if (Z8) { int w8 = 0; w8 = __builtin_amdgcn_cvt_pk_fp8_f32(fminf(fmaxf(y0, -440.f), 440.f), fminf(fmaxf(y1, -440.f), 440.f), w8, false); w8 = __builtin_amdgcn_cvt_pk_fp8_f32(fminf(fmaxf(y2, -440.f), 440.f), fminf(fmaxf(y3, -440.f), 440.f), w8, true);
                *(int*)(Z8 + rowoff + 16 * ti) = w8; }
            if ((ti & 7) == 7) __builtin_amdgcn_sched_barrier(0);
        }
    }
    __syncthreads();
}

__device__ __forceinline__ void tback_phase(const Ctx& cx, const bf16_t* ZT, bf16_t* CAT, const int tid) {
    const int lane = tid & 63, wave = __builtin_amdgcn_readfirstlane(tid >> 6);
    const int gw = cx.vcu * 8 + wave, NGW = cx.G * 8;
    LAS unsigned char* tile = cx.lds + wave * 9216;
    for (int it = gw; it < 16 * 12 * 64; it += NGW) {
        const int tt = it & 63, ct = (it >> 6) % 12, b = it / (64 * 12);
        const int c0 = ct * 64, t0 = tt * 64;
#pragma unroll
        for (int k = 0; k < 8; ++k) { const int row = k * 8 + (lane >> 3), chn = lane & 7;
            const u32x4 v = *(const u32x4*)(ZT + ((size_t)b * 768 + c0 + row) * 4096 + t0 + chn * 8);
            *(LAS u32x4*)(tile + row * 144 + chn * 16) = v; }
        LDS_WAIT(); asm volatile("" ::: "memory");
        if constexpr (OUTP_F8) { unsigned char* dst = (unsigned char*)CAT + ((size_t)b * 4096 + t0) * 1024 + c0 + lane;
#pragma unroll 8
            for (int k = 0; k < 64; ++k) { const float v = bf2f(*(const LAS unsigned short*)(tile + lane * 144 + k * 2)); dst[(size_t)k * 1024] = f2fp8(fminf(fmaxf(v, -440.0f), 440.0f)); }
        } else { bf16_t* dst = CAT + ((size_t)b * 4096 + t0) * 1024 + c0 + lane;
#pragma unroll 8
            for (int k = 0; k < 64; ++k) dst[(size_t)k * 1024] = *(const LAS unsigned short*)(tile + lane * 144 + k * 2); }
        LDS_WAIT(); asm volatile("" ::: "memory");
    }
}

__device__ __forceinline__ void ln1_group(const int bt, const int chunk, const int wave, const int lane, const int r16, const int q4, const bf16_t* XI, bf16_t* XO, bf16_t* XB, const float* g, const float* bta,
                                          const LAS unsigned char* Wh, const LAS unsigned char* Wl, LAS float* lg, LAS int* lcnt, const float rb0, const float rb1, float* gate, unsigned (&pk)[2], unsigned (&gp)[2], const LAS float* gl) {
    constexpr int WP = 2064;
            const size_t rowU = (size_t)chunk * 256 + wave * 32 + bt * 16;
            unsigned loff = (unsigned)(r16 * 1024 + 8 * q4); asm volatile("" : "+v"(loff));
            const GAS bf16_t* src = (const GAS bf16_t*)XI + rowU * 1024 + loff;
            constexpr int HOLD = LN1_HOLD;
            u32x4 raw[HOLD > 0 ? HOLD : 1], rawt[32 - HOLD]; float s = 0.f, ss = 0.f;
#pragma unroll
            for (int i = 0; i < 32; ++i) { if (i < HOLD) raw[i] = *(const GAS u32x4*)(src + 32 * i); else rawt[i - HOLD] = *(const GAS u32x4*)(src + 32 * i); }
#pragma unroll
            for (int i = 0; i < 32; ++i) { const u32x4 rr = (i < HOLD) ? raw[i < HOLD ? i : 0] : rawt[i < HOLD ? 0 : i - HOLD]; const float x0 = bflo(rr.x), x1 = bfhi(rr.x), x2 = bflo(rr.y), x3 = bfhi(rr.y), x4 = bflo(rr.z), x5 = bfhi(rr.z), x6 = bflo(rr.w), x7 = bfhi(rr.w);
                s += ((x0 + x1) + (x2 + x3)) + ((x4 + x5) + (x6 + x7)); ss += ((x0 * x0 + x1 * x1) + (x2 * x2 + x3 * x3)) + ((x4 * x4 + x5 * x5) + (x6 * x6 + x7 * x7)); }
            lg[2 * lane] = s; lg[2 * lane + 1] = ss; LDS_WAIT(); asm volatile("" ::: "memory");
            s = (lg[2 * r16] + lg[2 * (r16 + 16)]) + (lg[2 * (r16 + 32)] + lg[2 * (r16 + 48)]); ss = (lg[2 * r16 + 1] + lg[2 * (r16 + 16) + 1]) + (lg[2 * (r16 + 32) + 1] + lg[2 * (r16 + 48) + 1]);
            LDS_WAIT(); asm volatile("" ::: "memory");
            const float mean = s * (1.0f / 1024.0f), rstd = rsqrtf(fmaxf(ss * (1.0f / 1024.0f) - mean * mean, 0.f) + LN_EPS);
            f32x4 a0 = (f32x4){0.f, 0.f, 0.f, 0.f}, a1 = (f32x4){0.f, 0.f, 0.f, 0.f};
            const LAS unsigned char* wh0 = Wh + r16 * WP + 16 * q4; const LAS unsigned char* wl0 = Wl + r16 * WP + 16 * q4;
            GAS bf16_t* dsto = (GAS bf16_t*)XO + rowU * 1024 + loff; GAS unsigned char* dst8 = (GAS unsigned char*)XB + rowU * 1024 + loff;
            const LAS float* glq = gl + 8 * q4;
            u32x4 nx_ = (u32x4){0u, 0u, 0u, 0u}; if (HOLD == 0) nx_ = *(const GAS u32x4*)(src);
#pragma unroll
            for (int i = 0; i < 32; ++i) {
                u32x4 rw_; if (i < HOLD) rw_ = raw[i < HOLD ? i : 0]; else rw_ = nx_;
                if (i + 1 < 32 && i + 1 >= HOLD) nx_ = *(const GAS u32x4*)(src + 32 * (i + 1));
                asm volatile("" : "+v"(rw_));
                const f32x4 g0 = *(const LAS f32x4*)(glq + 32 * i), g1 = *(const LAS f32x4*)(glq + 32 * i + 4), b0 = *(const LAS f32x4*)(glq + 1024 + 32 * i), b1 = *(const LAS f32x4*)(glq + 1024 + 32 * i + 4);
                float y[8]; y[0] = bflo(rw_.x); y[1] = bfhi(rw_.x); y[2] = bflo(rw_.y); y[3] = bfhi(rw_.y); y[4] = bflo(rw_.z); y[5] = bfhi(rw_.z); y[6] = bflo(rw_.w); y[7] = bfhi(rw_.w);
#pragma unroll
                for (int q = 0; q < 8; ++q) y[q] = (y[q] - mean) * rstd * (q < 4 ? g0[q & 3] : g1[q & 3]) + (q < 4 ? b0[q & 3] : b1[q & 3]);
                u32x4 hi; hi.x = pk2(y[0], y[1]); hi.y = pk2(y[2], y[3]); hi.z = pk2(y[4], y[5]); hi.w = pk2(y[6], y[7]);
                *(GAS u32x4*)(dsto + 32 * i) = hi;
                if constexpr (MOE_F8) { int w0 = 0, w1 = 0; w0 = __builtin_amdgcn_cvt_pk_fp8_f32(y[0], y[1], w0, false); w0 = __builtin_amdgcn_cvt_pk_fp8_f32(y[2], y[3], w0, true); w1 = __builtin_amdgcn_cvt_pk_fp8_f32(y[4], y[5], w1, false); w1 = __builtin_amdgcn_cvt_pk_fp8_f32(y[6], y[7], w1, true);
                    *(GAS u32x2*)(dst8 + 32 * i) = (u32x2){(unsigned)w0, (unsigned)w1}; }
                else { *(u32x4*)((bf16_t*)XB + rowU * 1024 + loff + 32 * i) = hi; }
                u32x4 lo; lo.x = pk2(y[0] - bflo(hi.x), y[1] - bfhi(hi.x)); lo.y = pk2(y[2] - bflo(hi.y), y[3] - bfhi(hi.y)); lo.z = pk2(y[4] - bflo(hi.z), y[5] - bfhi(hi.z)); lo.w = pk2(y[6] - bflo(hi.w), y[7] - bfhi(hi.w));
                const bf16x8 ah = __builtin_bit_cast(bf16x8, hi), al = __builtin_bit_cast(bf16x8, lo);
                const bf16x8 wh_0 = *(const LAS bf16x8*)(wh0 + 64 * i), wh_1 = *(const LAS bf16x8*)(wh0 + 16 * WP + 64 * i), wl_0 = *(const LAS bf16x8*)(wl0 + 64 * i), wl_1 = *(const LAS bf16x8*)(wl0 + 16 * WP + 64 * i);
                a0 = __builtin_amdgcn_mfma_f32_16x16x32_bf16(ah, wh_0, a0, 0, 0, 0); a1 = __builtin_amdgcn_mfma_f32_16x16x32_bf16(ah, wh_1, a1, 0, 0, 0);
                a0 = __builtin_amdgcn_mfma_f32_16x16x32_bf16(al, wh_0, a0, 0, 0, 0); a1 = __builtin_amdgcn_mfma_f32_16x16x32_bf16(al, wh_1, a1, 0, 0, 0);
                a0 = __builtin_amdgcn_mfma_f32_16x16x32_bf16(ah, wl_0, a0, 0, 0, 0); a1 = __builtin_amdgcn_mfma_f32_16x16x32_bf16(ah, wl_1, a1, 0, 0, 0);
                asm volatile("" :: "v"(ah), "v"(al), "v"(wh_0), "v"(wh_1), "v"(wl_0), "v"(wl_1));
                __builtin_amdgcn_sched_barrier(0);
            }
#pragma unroll
            for (int v = 0; v < 4; ++v) { lg[(4 * q4 + v) * 33 + r16] = a0[v] + rb0; lg[(4 * q4 + v) * 33 + r16 + 16] = a1[v] + rb1; }
            LDS_WAIT(); asm volatile("" ::: "memory");
            if (lane < 16) {
                const LAS float* myl = lg + lane * 33; const size_t rowt = (size_t)chunk * 256 + wave * 32 + bt * 16 + lane;
                float tv[4]; int te[4]; int t0 = -1, t1 = -1, t2 = -1;
#pragma unroll
                for (int k = 0; k < 4; ++k) { float best = -INFINITY; int bi = 0;
                    for (int e = 0; e < 32; ++e) { const float v = myl[e]; const bool ok = (e != t0) && (e != t1) && (e != t2); if (ok && v > best) { best = v; bi = e; } }
                    tv[k] = best; te[k] = bi; if (k == 0) t0 = bi; else if (k == 1) t1 = bi; else if (k == 2) t2 = bi; }
                const float e1 = __expf(tv[1] - tv[0]), e2 = __expf(tv[2] - tv[0]), e3 = __expf(tv[3] - tv[0]); const float isum = 1.0f / (1.0f + e1 + e2 + e3);
                const float gk[4] = {isum, e1 * isum, e2 * isum, e3 * isum};
                pk[0] = 0u; pk[1] = 0u;
#pragma unroll
                for (int k = 0; k < 4; ++k) { const int rk = __hip_atomic_fetch_add(lcnt + te[k], 1, __ATOMIC_RELAXED, __HIP_MEMORY_SCOPE_WORKGROUP); pk[k >> 1] |= (unsigned)((te[k] << 11) | rk) << (16 * (k & 1)); }
                gp[0] = pk2(gk[0], gk[1]); gp[1] = pk2(gk[2], gk[3]); (void)rowt; (void)gate;
            }
            LDS_WAIT(); asm volatile("" ::: "memory");
}
__device__ __forceinline__ void ln1_router_phase(const Ctx& cx, const bf16_t* XI, bf16_t* XO, bf16_t* XB, const float* g, const float* bta, const float* rw, const float* rb,
                                                 unsigned* cnt, int* expid, float* gate, int* idx, float* gidx, const int tid) {
    const int lane = tid & 63, wave = __builtin_amdgcn_readfirstlane(tid >> 6), r16 = lane & 15, q4 = lane >> 4;
    constexpr int WP = 2064;
    LAS unsigned char* Wh = cx.lds; LAS unsigned char* Wl = cx.lds + 32 * WP; LAS int* lcnt = (LAS int*)(cx.lds + 64 * WP); LAS int* lbase = lcnt + 32; LAS float* lg = (LAS float*)(cx.lds + 64 * WP + 256 + wave * 2112);
    __syncthreads();
    { const u32x4* rsrc = (const u32x4*)rw; u32x4 wv[16];
#pragma unroll
      for (int u = 0; u < 16; ++u) wv[u] = rsrc[tid + 512 * u];
#pragma unroll
      for (int u = 0; u < 16; ++u) { const int idx = tid + 512 * u; *(LAS u32x4*)(Wh + (idx >> 7) * WP + (idx & 127) * 16) = wv[u]; } }
    if (tid < 256) { LAS float* gf = (LAS float*)(cx.lds + 151552); *(LAS f32x4*)(gf + 4 * tid) = *(const f32x4*)(g + 4 * tid); *(LAS f32x4*)(gf + 1024 + 4 * tid) = *(const f32x4*)(bta + 4 * tid); }
    if (tid < 32) lcnt[tid] = 0;
    LAS float* gl = (LAS float*)(cx.lds + 151552);
    const float rb0 = rb[r16], rb1 = rb[r16 + 16];
    __syncthreads();
    for (int chunk = cx.vcu; chunk < NTOK / 256; chunk += cx.G) {
        unsigned pk0[2] = {0u, 0u}, pk1[2] = {0u, 0u}, gp0[2] = {0u, 0u}, gp1[2] = {0u, 0u};
        ln1_group(0, chunk, wave, lane, r16, q4, XI, XO, XB, g, bta, Wh, Wl, lg, lcnt, rb0, rb1, gate, pk0, gp0, gl);
        ln1_group(1, chunk, wave, lane, r16, q4, XI, XO, XB, g, bta, Wh, Wl, lg, lcnt, rb0, rb1, gate, pk1, gp1, gl);
        __syncthreads();
        { const int t2 = wave * 64 + lane_id_volatile();
          if (t2 < 32) { lbase[t2] = (int)__hip_atomic_fetch_add(cnt + t2, (unsigned)lcnt[t2], __ATOMIC_RELAXED, __HIP_MEMORY_SCOPE_AGENT); } }
        __syncthreads();
        const int ln_ = lane_id_volatile();
        if (ln_ < 16) {
            { const int slot0 = (chunk * 256 + wave * 32 + ln_) * 4;
#pragma unroll
                for (int k = 0; k < 4; ++k) { const unsigned p = (pk0[k >> 1] >> (16 * (k & 1))) & 0xffffu; const int e = (int)(p >> 11), rk = (int)(p & 0x7ffu); const size_t o_ = (size_t)e * IDXCAP + lbase[e] + rk; idx[o_] = slot0 + k; gidx[o_] = (k & 1) ? bfhi(gp0[k >> 1]) : bflo(gp0[k >> 1]); } }
            { const int slot0 = (chunk * 256 + wave * 32 + 16 + ln_) * 4;
#pragma unroll
                for (int k = 0; k < 4; ++k) { const unsigned p = (pk1[k >> 1] >> (16 * (k & 1))) & 0xffffu; const int e = (int)(p >> 11), rk = (int)(p & 0x7ffu); const size_t o_ = (size_t)e * IDXCAP + lbase[e] + rk; idx[o_] = slot0 + k; gidx[o_] = (k & 1) ? bfhi(gp1[k >> 1]) : bflo(gp1[k >> 1]); } }
        }
        __syncthreads();
        { const int t3 = wave * 64 + lane_id_volatile(); if (t3 < 32) lcnt[t3] = 0; }
        __syncthreads();
    }
}

__device__ __forceinline__ void ln2_phase(const Ctx& cx, const bf16_t* X1, const bf16_t* Y, bf16_t* XO, bf16_t* XB, float* OUT, const float* g, const float* bta, const int tid) {
    const int lane = tid & 63, wave = __builtin_amdgcn_readfirstlane(tid >> 6);
    const int gw = cx.vcu * 8 + wave, NGW = cx.G * 8;
    if constexpr (Y_F8) {
        f32x4 gv[4], bv[4];
#pragma unroll
        for (int j = 0; j < 4; ++j) { gv[j] = *(const f32x4*)(g + 16 * lane + 4 * j); bv[j] = *(const f32x4*)(bta + 16 * lane + 4 * j); }
        for (int rp = gw; rp < NTOK / 2; rp += NGW) {
            u32x4 xa[2][2], ya[2][4];
#pragma unroll
            for (int r = 0; r < 2; ++r) { const size_t row = (size_t)rp * 2 + r;
                xa[r][0] = *(const u32x4*)(X1 + row * 1024 + 16 * lane); xa[r][1] = *(const u32x4*)(X1 + row * 1024 + 16 * lane + 8);
#pragma unroll
                for (int k = 0; k < 4; ++k) ya[r][k] = *(const u32x4*)((const unsigned char*)Y + (row * 4 + k) * 1024 + 16 * lane); }
            float v[2][16]; float s[2] = {0.f, 0.f};
#pragma unroll
            for (int r = 0; r < 2; ++r) {
#pragma unroll
                for (int i = 0; i < 4; ++i) { f32x2 lo = __builtin_amdgcn_cvt_pk_f32_fp8((int)ya[r][0][i], false), hi = __builtin_amdgcn_cvt_pk_f32_fp8((int)ya[r][0][i], true);
#pragma unroll
                    for (int k = 1; k < 4; ++k) { lo += __builtin_amdgcn_cvt_pk_f32_fp8((int)ya[r][k][i], false); hi += __builtin_amdgcn_cvt_pk_f32_fp8((int)ya[r][k][i], true); }
                    const unsigned xlo = xa[r][i >> 1][(i & 1) * 2], xhi = xa[r][i >> 1][(i & 1) * 2 + 1];
                    v[r][4 * i + 0] = bflo(xlo) * DN_ALPHA + lo[0] * (1.0f / Y_SCALE); v[r][4 * i + 1] = bfhi(xlo) * DN_ALPHA + lo[1] * (1.0f / Y_SCALE);
                    v[r][4 * i + 2] = bflo(xhi) * DN_ALPHA + hi[0] * (1.0f / Y_SCALE); v[r][4 * i + 3] = bfhi(xhi) * DN_ALPHA + hi[1] * (1.0f / Y_SCALE);
                    s[r] += (v[r][4 * i] + v[r][4 * i + 1]) + (v[r][4 * i + 2] + v[r][4 * i + 3]); } }
            const float mean0 = wave_sum(s[0], lane) * (1.0f / 1024.0f), mean1 = wave_sum(s[1], lane) * (1.0f / 1024.0f); float q[2] = {0.f, 0.f};
#pragma unroll
            for (int r = 0; r < 2; ++r)
#pragma unroll
                for (int e = 0; e < 16; ++e) { v[r][e] -= (r == 0 ? mean0 : mean1); q[r] += v[r][e] * v[r][e]; }
            const float rstd0 = rsqrtf(wave_sum(q[0], lane) * (1.0f / 1024.0f) + LN_EPS), rstd1 = rsqrtf(wave_sum(q[1], lane) * (1.0f / 1024.0f) + LN_EPS);
            unsigned wb[2][8]; unsigned w8[2][4];
#pragma unroll
            for (int j = 0; j < 4; ++j) { const f32x4 gvj = gv[j], bvj = bv[j];
#pragma unroll
                for (int r = 0; r < 2; ++r) { const size_t row = (size_t)rp * 2 + r; const float rs = (r == 0 ? rstd0 : rstd1);
                    const f32x4 o = (f32x4){v[r][4 * j], v[r][4 * j + 1], v[r][4 * j + 2], v[r][4 * j + 3]} * rs * gvj + bvj;
                    if (OUT) *(f32x4*)(OUT + row * 1024 + 16 * lane + 4 * j) = o;
                    else { wb[r][2 * j] = pk2(o[0], o[1]); wb[r][2 * j + 1] = pk2(o[2], o[3]);
                        int t8 = 0; t8 = __builtin_amdgcn_cvt_pk_fp8_f32(o[0], o[1], t8, false); t8 = __builtin_amdgcn_cvt_pk_fp8_f32(o[2], o[3], t8, true); w8[r][j] = (unsigned)t8; } } }
            if (!OUT) {
#pragma unroll
                for (int r = 0; r < 2; ++r) { const size_t row = (size_t)rp * 2 + r;
                    *(u32x4*)(XO + row * 1024 + 16 * lane) = (u32x4){wb[r][0], wb[r][1], wb[r][2], wb[r][3]}; *(u32x4*)(XO + row * 1024 + 16 * lane + 8) = (u32x4){wb[r][4], wb[r][5], wb[r][6], wb[r][7]};
                    if constexpr (INP_F8) *(u32x4*)((unsigned char*)XB + row * 1024 + 16 * lane) = (u32x4){w8[r][0], w8[r][1], w8[r][2], w8[r][3]};
                    else { *(u32x4*)(XB + row * 1024 + 16 * lane) = (u32x4){wb[r][0], wb[r][1], wb[r][2], wb[r][3]}; *(u32x4*)(XB + row * 1024 + 16 * lane + 8) = (u32x4){wb[r][4], wb[r][5], wb[r][6], wb[r][7]}; } } }
        }
        return;
    }
    for (int rp = gw; rp < NTOK / 2; rp += NGW) {
        f32x4 v[2][4]; float s[2] = {0.f, 0.f};
#pragma unroll
        for (int r = 0; r < 2; ++r) { const size_t row = (size_t)rp * 2 + r;
#pragma unroll
            for (int j = 0; j < 4; ++j) { const u32x2 a = *(const u32x2*)(X1 + row * 1024 + 4 * lane + 256 * j); v[r][j] = (f32x4){bflo(a.x), bfhi(a.x), bflo(a.y), bfhi(a.y)} * DN_ALPHA;
#pragma unroll
                for (int k = 0; k < 4; ++k) {
                    if constexpr (Y_F8) { const int y8 = *(const int*)((const unsigned char*)Y + (row * 4 + k) * 1024 + 4 * lane + 256 * j); const f32x2 lo = __builtin_amdgcn_cvt_pk_f32_fp8(y8, false), hi = __builtin_amdgcn_cvt_pk_f32_fp8(y8, true);
                        v[r][j][0] += lo[0] * (1.0f / Y_SCALE); v[r][j][1] += lo[1] * (1.0f / Y_SCALE); v[r][j][2] += hi[0] * (1.0f / Y_SCALE); v[r][j][3] += hi[1] * (1.0f / Y_SCALE); }
                    else { const u32x2 y = *(const u32x2*)(Y + (row * 4 + k) * 1024 + 4 * lane + 256 * j); v[r][j][0] += bflo(y.x); v[r][j][1] += bfhi(y.x); v[r][j][2] += bflo(y.y); v[r][j][3] += bfhi(y.y); } }
                s[r] += (v[r][j][0] + v[r][j][1]) + (v[r][j][2] + v[r][j][3]); } }
        const float mean0 = wave_sum(s[0], lane) * (1.0f / 1024.0f), mean1 = wave_sum(s[1], lane) * (1.0f / 1024.0f); float q[2] = {0.f, 0.f};
#pragma unroll
        for (int r = 0; r < 2; ++r)
#pragma unroll
            for (int j = 0; j < 4; ++j) { v[r][j] = v[r][j] - (r == 0 ? mean0 : mean1); q[r] += (v[r][j][0] * v[r][j][0] + v[r][j][1] * v[r][j][1]) + (v[r][j][2] * v[r][j][2] + v[r][j][3] * v[r][j][3]); }
        const float rstd0 = rsqrtf(wave_sum(q[0], lane) * (1.0f / 1024.0f) + LN_EPS), rstd1 = rsqrtf(wave_sum(q[1], lane) * (1.0f / 1024.0f) + LN_EPS);
#pragma unroll
        for (int j = 0; j < 4; ++j) { const f32x4 gvj = *(const f32x4*)(g + 4 * lane + 256 * j), bvj = *(const f32x4*)(bta + 4 * lane + 256 * j);
#pragma unroll
            for (int r = 0; r < 2; ++r) { const size_t row = (size_t)rp * 2 + r; const f32x4 o = v[r][j] * (r == 0 ? rstd0 : rstd1) * gvj + bvj;
                if (OUT) *(f32x4*)(OUT + row * 1024 + 4 * lane + 256 * j) = o;
                else { u32x2 w; w.x = pk2(o[0], o[1]); w.y = pk2(o[2], o[3]); *(u32x2*)(XO + row * 1024 + 4 * lane + 256 * j) = w;
                    if constexpr (INP_F8) { int w8 = 0; w8 = __builtin_amdgcn_cvt_pk_fp8_f32(o[0], o[1], w8, false); w8 = __builtin_amdgcn_cvt_pk_fp8_f32(o[2], o[3], w8, true); *(int*)((unsigned char*)XB + row * 1024 + 4 * lane + 256 * j) = w8; }
                    else { *(u32x2*)(XB + row * 1024 + 4 * lane + 256 * j) = w; } } } }
    }
}

constexpr int PH_PER_LAYER = 10, N_PHASES = 2 + PH_PER_LAYER * DEPTH;
__host__ __device__ constexpr bool phase_active(int p) {
    if (p < 2) return true;
    const int l = (p - 2) / PH_PER_LAYER, k = (p - 2) % PH_PER_LAYER, kind = l % 3;
    if (k == 1) return kind != 0;
    if (k == 3 || k == 4) return kind == 2;
    return true;
}

__global__ void __launch_bounds__(512, 2) fwd(Args args) {
    extern __shared__ __attribute__((aligned(16))) unsigned char lds_raw[];
    const int wave0 = __builtin_amdgcn_readfirstlane((int)threadIdx.x >> 6);
    Ctx cx; cx.lds = (LAS unsigned char*)lds_raw; cx.G = gridDim.x; { const int bx = blockIdx.x; cx.vcu = (cx.G % 8 == 0) ? (bx % 8) * (cx.G / 8) + bx / 8 : bx; } cx.ws = args.ws;
    volatile LAS unsigned* MISC = (volatile LAS unsigned*)(cx.lds + MISC_OFF);
    for (int u = threadIdx.x; u < (LDS_BYTES - MISC_OFF) / 4; u += 512) MISC[u] = 0u;
    __syncthreads();
    if (threadIdx.x == 0) { LAS unsigned long long* t = (LAS unsigned long long*)(cx.lds + PTAB_OFF);
#pragma unroll
        for (int k = 0; k < 32; ++k) t[k] = (unsigned long long)args.in[k];
        t[32] = (unsigned long long)args.out; t[33] = (unsigned long long)args.ws; }
    __syncthreads();
    const int lo = args.ph_lo, hi = args.ph_hi;
    XcdBarrier bar; bar.bar = (unsigned*)((gu32*)(args.ws + WS_CTL) + CW_BAR); bar.x = 0; bar.st = nullptr;
    if (hi - lo > 1) bar = xcd_barrier_post((unsigned*)((gu32*)(args.ws + WS_CTL) + CW_BAR), MISC + 8);
    int ran = 0;
#define XB ((bf16_t*)(ws + WS_XB))
#define PROJ ((bf16_t*)(ws + WS_PROJ))
#define CAT ((bf16_t*)(ws + WS_CAT))
#define KVM ((bf16_t*)(ws + WS_KVM))
#define HB ((bf16_t*)(ws + WS_H))
#define YB ((bf16_t*)(ws + WS_Y))
#define QKR ((bf16_t*)(ws + WS_QKR))
#define EXPID ((int*)(ws + WS_EXPID))
#define GATE ((float*)(ws + WS_GATE))
#define IDX ((int*)(ws + WS_IDX))
#define XF ((float*)(GAS float*)ptab_get(cx, 32))
#define SB ((bf16_t*)(ws + WS_SB))
#define SB2 ((bf16_t*)(ws + WS_PROJ))
#define TP_BAR_BEGIN() do {} while (0)
#define TP_BAR_END() do {} while (0)
#define TP_PH_BEGIN(p) do {} while (0)
#define TP_PH_END(p) do {} while (0)
#define PH_BEGIN(p) if (lo <= (p) && (p) < hi) { const int ph_ = (p); if (ran) { TP_BAR_BEGIN(); for (int rb_ = 0; rb_ < REP_BAR; ++rb_) xcd_barrier(bar, wave0); TP_BAR_END(); } ran = 1; const int tid = opaque_tid(wave0); (void)tid; unsigned char* const ws = (unsigned char*)(GAS unsigned char*)ptab_get(cx, 33); cx.ws = ws; TP_PH_BEGIN(ph_);
#define PH_END TP_PH_END(ph_); }

#if EN_P0
    PH_BEGIN(0) for (int rep_ = 0; rep_ < REP_P0; ++rep_) { p0_prologue(cx, tid); } PH_END
#endif

    for (int l = -1; l < DEPTH; ++l) {
        const int kind = (l < 0) ? 0 : l % 3, jj = (l < 0) ? 0 : l / 3, pw = (l < 0) ? 2048 : ((l % 3) == 1 ? 1536 : 2560), base = 2 + PH_PER_LAYER * l;
        PH_BEGIN(l < 0 ? 1 : base) {
            pg8::DenseOrder S;
            if (l < 0) S.init(ws + WS_MEMB, ws + WS_WKV, NMEM, 2048, 1024 * INP_EB, cx.G, (int)blockIdx.x);
            else S.init(XB, ws + WS_WIN + (size_t)l * 5 * MiB, NTOK, pw, 1024 * INP_EB, cx.G, (int)blockIdx.x);
            S.rep = REP_DENSE;
            const unsigned smask = (l < 0) ? 0u : (kind == 0 ? 0x207u : kind == 1 ? 0x20u : 0x200u);
            pg8::EpiBf16s E{l < 0 ? KVM : PROJ, pw, smask, C2, INP_F8 ? 1.0f / WIN_SCALE : 1.0f};
#if EN_G1
            pg8::gemm_phase<pg8::EpiBf16s, pg8::DenseOrder, false, INP_F8 != 0>(cx.lds, S, E, tid);
#endif
        } PH_END
        if (l < 0) continue;
#if EN_THIN
        if (kind == 1) { PH_BEGIN(base + 1) for (int rep_ = 0; rep_ < REP_THIN; ++rep_) { rope_phase(cx, PROJ, INP(5) + jj * 64, INP(6) + jj * 64, QKR, tid); } PH_END }
        if (kind == 2) { PH_BEGIN(base + 1) for (int rep_ = 0; rep_ < REP_THIN; ++rep_) { sconv_phase(cx, PROJ, INP(8) + (size_t)jj * 3 * 2304, INP(9) + (size_t)jj * 2304, (bf16_t*)(ws + WS_UT3), ws + WS_V8, tid); } PH_END }
#endif
        for (int o = 0; o < 2; ++o) {
            if (o == 1 && kind != 2) break;
            PH_BEGIN(base + 2 + o) {
                if (kind == 2) {
                    const bf16_t* UT3 = (const bf16_t*)(ws + WS_UT3); constexpr size_t PS = (size_t)16 * 768 * 4096;
#if EN_TCONV
                    for (int rep_ = 0; rep_ < REP_TCONV; ++rep_) {
#if TCONV_F8
                    tconv8_phase(cx, o, o == 0 ? UT3 : (const bf16_t*)(ws + WS_Z1T), ws + WS_V8 + (size_t)o * 48 * MiB, UT3 + (size_t)(1 + o) * PS, (bf16_t*)(ws + (o == 0 ? WS_Z1T : WS_Z2T)), o == 0 ? ws + WS_V8 + 48 * MiB : (unsigned char*)nullptr, INP(19) + (size_t)(jj * 2 + o) * 768, tid);
#else
                    tconv_phase(cx, o, o == 0 ? UT3 : (const bf16_t*)(ws + WS_Z1T), UT3 + (size_t)(1 + o) * PS, (bf16_t*)(ws + (o == 0 ? WS_Z1T : WS_Z2T)), INP(19) + (size_t)(jj * 2 + o) * 768, tid);
#endif
                    }
#endif
                }
                if (o == 0) {
#if EN_NA
                    for (int rep_ = 0; rep_ < REP_NA; ++rep_) { if (kind == 0) na_phase(cx, PROJ, INP(3) + (size_t)jj * 12 * 465, CAT, tid); }
#endif
                    const int ngqa = (kind == 1) ? 3072 : 0;
                    for (int rep_ = 0; rep_ < REP_ATTN; ++rep_)
                    for (int u = cx.vcu; u < ngqa + 1024; u += cx.G) {
                        const attn_body::bf16 *Q, *K, *V; attn_body::bf16* O; int QP, KP, VP, NT;
                        if (u < ngqa) { const int qb = u & 15, hq = (u >> 4) % 12, b = u / 192, kvh = hq / 3;
                            Q = (const attn_body::bf16*)QKR + ((size_t)b * 4096 + qb * 256) * 1024 + hq * 64; QP = 1024;
                            K = (const attn_body::bf16*)QKR + (size_t)b * 4096 * 1024 + 768 + kvh * 64; KP = 1024;
                            V = (const attn_body::bf16*)PROJ + (size_t)b * 4096 * 1536 + 1024 + kvh * 64; VP = 1536;
                            O = (attn_body::bf16*)((unsigned char*)CAT + (((size_t)b * 4096 + qb * 256) * 1024 + hq * 64) * OUT_EB); NT = 64;
                        } else { const int v = u - ngqa, qb = v & 15, h = (v >> 4) & 3, b = v >> 6;
                            Q = (const attn_body::bf16*)PROJ + ((size_t)b * 4096 + qb * 256) * pw + (pw - 256) + h * 64; QP = pw;
                            K = (const attn_body::bf16*)KVM + (size_t)b * 256 * 2048 + 512 * l + h * 64; KP = 2048;
                            V = K + 256; VP = 2048;
                            O = (attn_body::bf16*)((unsigned char*)CAT + (((size_t)b * 4096 + qb * 256) * 1024 + 768 + h * 64) * OUT_EB); NT = 4;
                        }
#if EN_ATTN
                        attn_body::attn_unit<8, OUTP_F8 != 0>(Q, K, V, O, QP, KP, VP, 1024, NT, (char*)lds_raw, tid);
#endif
                    }
                }
            } PH_END
        }
#if EN_THIN
        if (kind == 2) { PH_BEGIN(base + 4) for (int rep_ = 0; rep_ < REP_THIN; ++rep_) { tback_phase(cx, (const bf16_t*)(ws + WS_Z2T), CAT, tid); } PH_END }
#endif
        PH_BEGIN(base + 5) {
            pg8::DenseOrder S; S.init(CAT, ws + WS_WOUT + (size_t)l * 2 * MiB, NTOK, 1024, 1024 * OUT_EB, cx.G, (int)blockIdx.x);
            pg8::EpiResB E{SB, l == 0 ? (const void*)INP(0) : (const void*)SB, l == 0 ? 1 : 0, 1024, DN_ALPHA, OUTP_F8 ? 1.0f / WOUT_SCALE : 1.0f};
#if EN_G2
            pg8::gemm_phase<pg8::EpiResB, pg8::DenseOrder, false, OUTP_F8 != 0>(cx.lds, S, E, tid);
#endif
        } PH_END
#if EN_LN
#if REP_LN1 > 1
        PH_BEGIN(base + 6) ln1_router_phase(cx, SB, (bf16_t*)(ws + WS_PROJ), CAT, INP(22) + l * 1024, INP(23) + l * 1024, (const float*)(ws + WS_RW + (size_t)l * 131072), INP(27) + l * 32, (unsigned*)((gu32*)(ws + WS_CTL) + CW_DBG), EXPID, GATE, IDX, (float*)(ws + WS_GIDX), tid); PH_END
#endif
        PH_BEGIN(base + 6) ln1_router_phase(cx, SB, SB2, XB, INP(22) + l * 1024, INP(23) + l * 1024, (const float*)(ws + WS_RW + (size_t)l * 131072), INP(27) + l * 32, (unsigned*)((gu32*)(ws + WS_CTL) + CW_CNT + 32 * l), EXPID, GATE, IDX, (float*)(ws + WS_GIDX), tid); PH_END
#endif
        for (int half = 0; half < 2; ++half) {
            PH_BEGIN(base + 7 + half) {
                LAS int* pref = (LAS int*)(cx.lds + pg8::STAGE_BYTES); const unsigned* cntw = (const unsigned*)((gu32*)(ws + WS_CTL) + CW_CNT + 32 * l);
                __syncthreads();
                if (tid < NEXP) { const int c = (int)__hip_atomic_load(cntw + tid, __ATOMIC_RELAXED, __HIP_MEMORY_SCOPE_AGENT); pref[40 + tid] = c; pref[72 + tid] = (c + 255) >> 8; }
                __syncthreads();
                if (tid == 0) { int a = 0;
#pragma unroll 1
                    for (int e = 0; e < NEXP; ++e) { pref[e] = a; a += pref[72 + e]; } pref[NEXP] = a; }
                __syncthreads();
#if STAGGER
                if (cx.vcu & 1) { for (int s_ = 0; s_ < STAGGER; ++s_) __builtin_amdgcn_s_sleep(127); }
#endif
                if (half == 0) {
                    pg8::MoeOrder<2> S{(const char*)XB, (const char*)(ws + WS_W1 + (size_t)l * 32 * 2048 * 1024 * MOE_EB), 1024 * MOE_EB, 8, cx.G, cx.vcu, (size_t)2048 * 1024 * MOE_EB, pref, (const int*)cntw, IDX};
                    pg8::EpiSwiglu E{HB, INP(29) + (size_t)l * 32 * 2048};
#if EN_G3
                    for (int rep_ = 0; rep_ < REP_G3; ++rep_) { pg8::gemm_phase<pg8::EpiSwiglu, pg8::MoeOrder<2>, true, MOE_F8 != 0, (MOE_F8 != 0) && (DEFER_H != 0)>(cx.lds, S, E, tid); }
#endif
                } else {
                    pg8::MoeOrder<0> S{(const char*)HB, (const char*)(ws + WS_W2 + (size_t)l * 32 * 1024 * 1024 * MOE_EB), 1024 * MOE_EB, 4, cx.G, cx.vcu, (size_t)1024 * 1024 * MOE_EB, pref, (const int*)cntw, IDX};
                    pg8::EpiMoeOut E{YB, INP(31) + (size_t)l * 32 * 1024, (const float*)(ws + WS_GIDX)};
#if EN_G4
                    for (int rep_ = 0; rep_ < REP_G4; ++rep_) { pg8::gemm_phase<pg8::EpiMoeOut, pg8::MoeOrder<0>, true, MOE_F8 != 0>(cx.lds, S, E, tid); }
#endif
                }
            } PH_END
        }
#if EN_LN
#if REP_LN2 > 1
        PH_BEGIN(base + 9) ln2_phase(cx, SB, YB, (bf16_t*)(ws + WS_PROJ), CAT, (float*)nullptr, INP(24) + l * 1024, INP(25) + l * 1024, tid); PH_END
#endif
        PH_BEGIN(base + 9) ln2_phase(cx, SB2, YB, SB, XB, l == DEPTH - 1 ? XF : (float*)nullptr, INP(24) + l * 1024, INP(25) + l * 1024, tid); PH_END

#endif
    }
#undef PH_BEGIN
#undef PH_END
#undef XB
#undef PROJ
#undef CAT
#undef KVM
#undef HB
#undef YB
#undef QKR
#undef EXPID
#undef GATE
#undef IDX
#undef XF
#undef SB
#undef SB2
}

extern "C" void kernel_launch(void* const* d_in, const int* in_sizes, int n_in, void* d_out, int out_size, void* d_ws, size_t ws_size, hipStream_t stream) {
    static int grid = 0;
    if (grid == 0) {
        if (n_in != 32 || in_sizes[0] != NTOK * DM || out_size != NTOK * DM || ws_size < WS_END) { fprintf(stderr, "kernel_launch: unexpected problem (n_in %d, in0 %d, out %d, ws %zu < %zu); nothing launched\n", n_in, n_in > 0 ? in_sizes[0] : -1, out_size, ws_size, (size_t)WS_END); grid = -1; return; }
        int dev = 0, cus = 0, per_cu = 0;
        if (hipGetDevice(&dev) != hipSuccess || hipDeviceGetAttribute(&cus, hipDeviceAttributeMultiprocessorCount, dev) != hipSuccess) { fprintf(stderr, "kernel_launch: device query failed\n"); grid = -1; return; }
        if (hipFuncSetAttribute((const void*)fwd, hipFuncAttributeMaxDynamicSharedMemorySize, LDS_BYTES) != hipSuccess) { fprintf(stderr, "kernel_launch: hipFuncSetAttribute failed\n"); grid = -1; return; }
        if (hipOccupancyMaxActiveBlocksPerMultiprocessor(&per_cu, (const void*)fwd, 512, LDS_BYTES) != hipSuccess || per_cu < 1) fprintf(stderr, "kernel_launch: occupancy query reports %d blocks per CU\n", per_cu);
        (void)hipGetLastError();
        grid = cus;
    }
    if (grid < 0) return;
    if (hipMemsetAsync((char*)d_ws + WS_CTL, 0, CTL_ZERO_BYTES, stream) != hipSuccess) { fprintf(stderr, "kernel_launch: memset failed\n"); return; }
    Args a{};
    for (int i = 0; i < 32; ++i) a.in[i] = (const float*)d_in[i];
    a.out = (float*)d_out; a.ws = (unsigned char*)d_ws;
#if MK_MULTI
    for (int p = 0; p < N_PHASES && p <= DBG_LAST_PHASE; ++p) {
        if (!phase_active(p)) continue;
        a.ph_lo = p; a.ph_hi = p + 1;
        hipLaunchKernelGGL(fwd, dim3(grid), dim3(512), LDS_BYTES, stream, a);
#if DBG_CHECK
        dbg_after_phase(p, a, stream);
#endif
    }
#if DBG_CHECK
    hipLaunchKernelGGL(dbg_report, dim3(1024), dim3(256), 0, stream, (unsigned*)((char*)d_ws + WS_CTL) + CW_DBG, (float*)d_out);
#endif
#else
    a.ph_lo = 0; a.ph_hi = N_PHASES;
    hipLaunchKernelGGL(fwd, dim3(grid), dim3(512), LDS_BYTES, stream, a);
#endif
    const hipError_t le = hipPeekAtLastError();
    if (le != hipSuccess) fprintf(stderr, "kernel_launch: launch failed: %s\n", hipGetErrorName(le));
}
```

```cpp
#include <hip/hip_runtime.h>
#include <hip/hip_bf16.h>
#include <cstdio>
#include <cstdint>

#ifndef MK_MULTI
#define MK_MULTI 0
#endif
#ifndef DBG_CHECK
#define DBG_CHECK 0
#endif
#ifndef DBG_LAST_PHASE
#define DBG_LAST_PHASE 9999
#endif

#ifndef EN_P0
#define EN_P0 1
#define EN_G1 1
#define EN_THIN 1
#define EN_TCONV 1
#define EN_NA 1
#define EN_ATTN 1
#define EN_G2 1
#define EN_LN 1
#define EN_G3 1
#define EN_G4 1
#endif

#ifndef REP_P0
#define REP_P0 1
#endif
#ifndef REP_G1
#define REP_G1 1
#endif
#ifndef REP_NA
#define REP_NA 1
#endif
#ifndef REP_ATTN
#define REP_ATTN 1
#endif
#ifndef REP_TCONV
#define REP_TCONV 1
#endif
#ifndef REP_THIN
#define REP_THIN 1
#endif
#ifndef REP_G3
#define REP_G3 1
#endif
#ifndef REP_G4
#define REP_G4 1
#endif
#ifndef ALIGN_EPI
#define ALIGN_EPI 1
#endif
#ifndef NT_STORE
#define NT_STORE 0
#endif
#ifndef LN1_HOLD
#define LN1_HOLD 16
#endif
#ifndef DEFER_H
#define DEFER_H 0
#endif
#ifndef STAGGER
#define STAGGER 0
#endif
#ifndef REP_BAR
#define REP_BAR 1
#endif
#ifndef REP_DENSE
#define REP_DENSE 1
#endif
#ifndef REP_G2
#define REP_G2 1
#endif
#ifndef REP_LN1
#define REP_LN1 1
#endif
#ifndef REP_LN2
#define REP_LN2 1
#endif

#define GAS __attribute__((address_space(1)))
#define LAS __attribute__((address_space(3)))
typedef unsigned short bf16_t;
typedef short bf16x8 __attribute__((ext_vector_type(8)));
typedef short s16x4 __attribute__((ext_vector_type(4)));
typedef float f32x4 __attribute__((ext_vector_type(4)));
typedef float f32x2 __attribute__((ext_vector_type(2)));
typedef float f32x16 __attribute__((ext_vector_type(16)));
typedef unsigned u32x4 __attribute__((ext_vector_type(4)));
typedef unsigned u32x2 __attribute__((ext_vector_type(2)));
typedef GAS unsigned gu32;

constexpr int BATCH = 16, SEQ = 4096, DM = 1024, NTOK = BATCH * SEQ, DEPTH = 4;
constexpr int MEMLEN = 256, NMEM = BATCH * MEMLEN;
constexpr int NEXP = 32, NSLOT = NTOK * 4, IDXCAP = NTOK;
constexpr int GRIDW = 64;
constexpr float LN_EPS = 1e-5f;
constexpr float DN_ALPHA = 1.681792830507429f;
constexpr float LOG2E = 1.4426950408889634f;
constexpr float C2 = 0.125f * LOG2E;
__host__ __device__ constexpr int layer_kind(int l) { return l % 3; }
__host__ __device__ constexpr int layer_j(int l) { return l / 3; }
__host__ __device__ constexpr int in_width(int l) { return (l % 3) == 1 ? 1536 : 2560; }

#ifndef MOE_F8
#define MOE_F8 1
#endif
#ifndef INP_F8
#define INP_F8 1
#endif
constexpr int INP_EB = INP_F8 ? 1 : 2;
constexpr float WIN_SCALE = 32.0f;
#ifndef OUTP_F8
#define OUTP_F8 1
#endif
constexpr int OUT_EB = OUTP_F8 ? 1 : 2;
constexpr float WOUT_SCALE = 64.0f;
__device__ __forceinline__ unsigned char f2fp8(float x) { return (unsigned char)(__builtin_amdgcn_cvt_pk_fp8_f32(x, x, 0, false) & 0xff); }
#ifndef TCONV_F8
#define TCONV_F8 1
#endif
#ifndef Y_F8
#define Y_F8 1
#endif
constexpr float Y_SCALE = 64.0f;
constexpr int MOE_EB = MOE_F8 ? 1 : 2;
constexpr float W1_SCALE = 32.0f, W2_SCALE = 64.0f, H_SCALE = 4.0f;

constexpr size_t MiB = 1u << 20;
constexpr size_t WS_CTL = 0, CTL_ZERO_BYTES = 1 * MiB;
constexpr size_t WS_RW = 1 * MiB;
constexpr size_t WS_WIN = 2 * MiB;
constexpr size_t WS_WKV = 22 * MiB;
constexpr size_t WS_WOUT = 26 * MiB;
constexpr size_t WS_W1 = 34 * MiB;
constexpr size_t WS_W2 = 546 * MiB;
constexpr size_t WS_XB = 802 * MiB;
constexpr size_t WS_MEMB = 930 * MiB;
constexpr size_t WS_KVM = 938 * MiB;
constexpr size_t WS_PROJ = 954 * MiB;
constexpr size_t WS_CAT = 1274 * MiB;
constexpr size_t WS_H = 1402 * MiB;
constexpr size_t WS_Y = 1914 * MiB;
constexpr size_t WS_HRAWT = 2426 * MiB;
constexpr size_t WS_HPART = 2474 * MiB;
constexpr size_t WS_EXPID = 2478 * MiB;
constexpr size_t WS_GATE = 2479 * MiB;
constexpr size_t WS_IDX = 2480 * MiB;
constexpr size_t WS_SB = 2488 * MiB;
constexpr size_t WS_GIDX = 2616 * MiB;
constexpr size_t WS_END = 2624 * MiB;
constexpr size_t WS_UT3 = WS_H;
constexpr size_t WS_Z1T = WS_H + 288 * MiB;
constexpr size_t WS_Z2T = WS_H + 384 * MiB;
constexpr size_t WS_V8 = WS_Y;
constexpr size_t WS_QKR = WS_Y;
constexpr int CW_BAR = 4096;
constexpr int CW_CNT = 8192;
constexpr int CW_DBG = 12288;

constexpr int MISC_OFF = 150528;
constexpr int LDS_BYTES = 163840;

#define LDS_WAIT() asm volatile("s_waitcnt lgkmcnt(0)" ::: "memory")
#define VM_WAIT() asm volatile("s_waitcnt vmcnt(0)" ::: "memory")
__device__ __forceinline__ unsigned f2bf(float f) { unsigned u = __builtin_bit_cast(unsigned, f); return (u + 0x7fffu + ((u >> 16) & 1u)) >> 16; }
__device__ __forceinline__ unsigned pk2(float lo, float hi) { return f2bf(lo) | (f2bf(hi) << 16); }
__device__ __forceinline__ float bf2f(unsigned short b) { return __builtin_bit_cast(float, ((unsigned)b) << 16); }
__device__ __forceinline__ float bflo(unsigned w) { return __builtin_bit_cast(float, w << 16); }
__device__ __forceinline__ float bfhi(unsigned w) { return __builtin_bit_cast(float, w & 0xffff0000u); }
__device__ __forceinline__ float shflx(float v, int mask, int lane) { int t; asm volatile("v_mov_b32 %0, %1" : "=v"(t) : "v"(__builtin_bit_cast(int, v))); return __builtin_bit_cast(float, __builtin_amdgcn_ds_bpermute((lane ^ mask) << 2, t)); }
__device__ __forceinline__ int shflxi(int v, int mask, int lane) { return __builtin_amdgcn_ds_bpermute((lane ^ mask) << 2, v); }
template <int CTRL> __device__ __forceinline__ float dpp_x(float v) { return __builtin_bit_cast(float, __builtin_amdgcn_update_dpp(0, __builtin_bit_cast(int, v), CTRL, 0xF, 0xF, false)); }
__device__ __forceinline__ float group8_sum(float v) { v += dpp_x<0xB1>(v); v += dpp_x<0x4E>(v); v += dpp_x<0x141>(v); return v; }
__device__ __forceinline__ float wave_sum(float v, int  ) {
    v += dpp_x<0xB1>(v); v += dpp_x<0x4E>(v); v += dpp_x<0x141>(v); v += dpp_x<0x140>(v);
    v += __builtin_bit_cast(float, __builtin_amdgcn_update_dpp(0, __builtin_bit_cast(int, v), 0x142, 0xA, 0xF, false));
    v += __builtin_bit_cast(float, __builtin_amdgcn_update_dpp(0, __builtin_bit_cast(int, v), 0x143, 0xC, 0xF, false));
    return __builtin_bit_cast(float, __builtin_amdgcn_readlane(__builtin_bit_cast(int, v), 63));
}
__device__ __forceinline__ int lane_id_volatile() { int l; asm volatile("v_mbcnt_lo_u32_b32 %0, -1, 0\n\tv_mbcnt_hi_u32_b32 %0, -1, %0" : "=&v"(l)); return l; }
__device__ __forceinline__ int opaque_tid(int wave0) { return wave0 * 64 + lane_id_volatile(); }

#define XB_TMO      128
#define XB_XCNT(j)  (256  + 64 * (j))
#define XB_XSUB(j)  (1280 + 64 * (j))
#define XB_XGEN(j)  (2304 + 64 * (j))
#define XB_TOP      3328
#define XB_TOPGEN   3392
#define XCD_BAR_WORDS 3456
#define XB_SPIN_CAP (1u << 20)

__device__ __forceinline__ unsigned xb_ld(unsigned* p)              { return __hip_atomic_load(p, __ATOMIC_RELAXED, __HIP_MEMORY_SCOPE_AGENT); }
__device__ __forceinline__ unsigned xb_add(unsigned* p, unsigned v) { return __hip_atomic_fetch_add(p, v, __ATOMIC_RELAXED, __HIP_MEMORY_SCOPE_AGENT); }
__device__ __forceinline__ unsigned xb_xcc_id() { return (unsigned)__builtin_amdgcn_s_getreg((3 << 11) | 20) & 0xFu; }
#define XB_SPIN(cond, bar) do { unsigned _sp = 0; while (cond) { __builtin_amdgcn_s_sleep(1); \
    if ((++_sp & 255u) == 0u) { if (xb_ld(&(bar)[XB_TMO])) break; if (_sp > XB_SPIN_CAP) { atomicAdd(&(bar)[XB_TMO], 1u); break; } } } } while (0)

struct XcdBarrier {
    unsigned* bar; unsigned x;
    volatile LAS unsigned* st;
};
__device__ __forceinline__ XcdBarrier xcd_barrier_post(unsigned* bar, volatile LAS unsigned* st) {
    XcdBarrier b; b.bar = bar; b.x = xb_xcc_id(); b.st = st;
    if (threadIdx.x == 0) (void)xb_add(&bar[XB_XCNT(b.x)], 1u);
    return b;
}
__device__ __forceinline__ void xcd_barrier_complete(unsigned* bar, unsigned x, unsigned& nloc, unsigned& nx) {
    const unsigned G = gridDim.x * gridDim.y * gridDim.z;
    unsigned sum, cnt, mine, sp = 0u;
    for (;;) {
        sum = 0u; cnt = 0u; mine = 0u;
#pragma unroll 1
        for (unsigned j = 0; j < 16; ++j) { const unsigned c = xb_ld(&bar[XB_XCNT(j)]); sum += c; cnt += (c > 0u) ? 1u : 0u; mine = (j == x) ? c : mine; }
        if (sum == G) break;
        __builtin_amdgcn_s_sleep(1);
        if ((++sp & 255u) == 0u) { if (xb_ld(&bar[XB_TMO])) break; if (sp > XB_SPIN_CAP) { atomicAdd(&bar[XB_TMO], 1u); break; } }
    }
    nloc = mine > 0u ? mine : 1u; nx = cnt > 0u ? cnt : 1u;
}
__device__ __forceinline__ void xcd_barrier(const XcdBarrier& b, const int wave0) {
    asm volatile("s_waitcnt vmcnt(0)" ::: "memory");
    __syncthreads();
    if (wave0 == 0 && lane_id_volatile() == 0) {
        unsigned* bar = b.bar;
        __builtin_amdgcn_s_waitcnt(0);
        unsigned nloc = b.st[0], nx = b.st[1];
        if (nloc == 0u) { xcd_barrier_complete(bar, b.x, nloc, nx); b.st[0] = nloc; b.st[1] = nx; }
        const unsigned old = xb_add(&bar[XB_XSUB(b.x)], 1u);
        const unsigned gen = old / nloc;
        if (old + 1u == (gen + 1u) * nloc) {
            __builtin_amdgcn_fence(__ATOMIC_RELEASE, "agent");
            asm volatile("s_waitcnt vmcnt(0)" ::: "memory");
            const unsigned og = xb_add(&bar[XB_TOP], 1u);
            const unsigned tg = og / nx;
            if (og + 1u == (tg + 1u) * nx) xb_add(&bar[XB_TOPGEN], 1u);
            else XB_SPIN(xb_ld(&bar[XB_TOPGEN]) == tg, bar);
            __builtin_amdgcn_fence(__ATOMIC_ACQUIRE, "agent");
            xb_add(&bar[XB_XGEN(b.x)], 1u);
            asm volatile("s_waitcnt vmcnt(0)" ::: "memory");
        } else {
            XB_SPIN(xb_ld(&bar[XB_XGEN(b.x)]) == gen, bar);
            __builtin_amdgcn_fence(__ATOMIC_ACQUIRE, "agent");
            asm volatile("s_waitcnt vmcnt(0)" ::: "memory");
        }
    }
    __syncthreads();
}

namespace pg8 {
constexpr int BM = 256, BK = 64, HALF = 128, HTB = HALF * BK * 2  , STAGE_BYTES = 8 * HTB, NXCD = 8, WGM = 8;
__host__ __device__ __forceinline__ int lds_byte(int r, int c) { const int st = (r >> 4) * 2 + (c >> 5), rr = r & 15, cc = c & 31, ob = rr * 64 + cc * 2; return st * 1024 + (ob ^ (((ob >> 9) & 1) << 5)); }
__host__ __device__ __forceinline__ void stage_rc(int b, int& R, int& C) { const int st = b / 1024, sb = b % 1024, swz = sb ^ (((sb >> 9) & 1) << 5); R = (st >> 1) * 16 + swz / 64; C = (st & 1) * 32 + (swz % 64) / 2; }
__host__ __device__ __forceinline__ int perm32(int rho) { const int n = rho >> 4, i = rho & 15; return 8 * (i >> 2) + 4 * n + (i & 3); }

struct Unit { int pm, pn, e, p; };

struct DenseOrder {
    const char* A; const char* Bt; int KB; int nM, nN, nwg, G, c; int rep = 1;
    __device__ __forceinline__ void init(const void* A_, const void* Bt_, int M, int N, int KB_, int G_, int c_) { A = (const char*)A_; Bt = (const char*)Bt_; KB = KB_; nM = M / BM; nN = N / BM; nwg = nM * nN; G = G_; c = c_; }
    __device__ __forceinline__ bool next(int i, Unit& u) const {
        long L = (long)i * G + c; if (L >= (long)nwg * rep) return false;
        if (rep > 1) L %= nwg;
        int wgid = (int)L; { const int q = nwg / NXCD, r = nwg % NXCD, xcd = wgid % NXCD, off = wgid / NXCD; wgid = (xcd < r ? xcd * (q + 1) : r * (q + 1) + (xcd - r) * q) + off; }
        const int nig = WGM * nN, gid = wgid / nig, fm = gid * WGM, gsz = (nM - fm) < WGM ? (nM - fm) : WGM;
        u.pm = __builtin_amdgcn_readfirstlane(fm + ((wgid % nig) % gsz)); u.pn = __builtin_amdgcn_readfirstlane((wgid % nig) / gsz); u.e = 0; u.p = 0; return true;
    }
    __device__ __forceinline__ const char* a_base(const Unit& u) const { return A + (size_t)u.pm * BM * KB; }
    __device__ __forceinline__ const char* b_base(const Unit& u) const { return Bt + (size_t)u.pn * BM * KB; }
    __device__ __forceinline__ const int* idx_src(const Unit&) const { return nullptr; }
    __device__ __forceinline__ int nvalid(const Unit&) const { return BM; }
    static constexpr int ROW_SHIFT = 0;
};
template <int SHIFT  > struct MoeOrder {
    const char* A; const char* Bt; int KB; int nN; int G, c; size_t bstride; const LAS int* pref; const int* cnt; const int* idx;
    __device__ __forceinline__ bool next(int i, Unit& u) const {
        const long L = (long)i * G + c; const int tot = __builtin_amdgcn_readfirstlane(pref[NEXP]);
        if (L >= (long)tot * nN) return false;
        const int pg = __builtin_amdgcn_readfirstlane((int)(L / nN)); u.pn = __builtin_amdgcn_readfirstlane((int)(L % nN));
        int e = 0;
#pragma unroll
        for (int step = 16; step >= 1; step >>= 1) { const int v = __builtin_amdgcn_readfirstlane(pref[e + step]); e += (v <= pg) ? step : 0; }
        u.e = e; u.p = pg - __builtin_amdgcn_readfirstlane(pref[e]); u.pm = 0; return true;
    }
    __device__ __forceinline__ const char* a_base(const Unit&) const { return A; }
    __device__ __forceinline__ const char* b_base(const Unit& u) const { return Bt + (size_t)u.e * bstride + (size_t)u.pn * BM * KB; }
    __device__ __forceinline__ const int* idx_src(const Unit& u) const { return idx + (size_t)u.e * IDXCAP + u.p * BM; }
    __device__ __forceinline__ int nvalid(const Unit& u) const { const int n = __builtin_amdgcn_readfirstlane(pref[40 + u.e]) - u.p * BM; return n < BM ? n : BM; }
    static constexpr int ROW_SHIFT = SHIFT;
};

__device__ __forceinline__ unsigned cvt_pk_bf16(float lo, float hi) { unsigned r; asm volatile("v_cvt_pk_bf16_f32 %0, %1, %2" : "=v"(r) : "v"(lo), "v"(hi)); return r; }

struct EpiBf16s {
    static constexpr bool PERM = true; static constexpr bool HAS_BIAS = false;
    bf16_t* O; int ldc; unsigned smask; float scale; float base;
    __device__ __forceinline__ void operator()(const f32x4 (&acc)[2][2][4][2], const Unit& u, int wr, int wc, int fr, int fq) const {
        const int row0 = u.pm * BM + wr * 64 + fr, col0 = u.pn * BM + wc * 32 + 8 * fq;
        const float sc = (((smask >> u.pn) & 1u) ? scale : 1.f) * base;
#pragma unroll
        for (int ai = 0; ai < 2; ++ai)
#pragma unroll
            for (int m = 0; m < 4; ++m) { bf16_t* rowp = O + (size_t)(row0 + ai * HALF + m * 16) * ldc + col0;
#pragma unroll
                for (int bj = 0; bj < 2; ++bj) { const f32x4 v0 = acc[ai][bj][m][0] * sc, v1 = acc[ai][bj][m][1] * sc;
                    u32x4 w; w.x = cvt_pk_bf16(v0[0], v0[1]); w.y = cvt_pk_bf16(v0[2], v0[3]); w.z = cvt_pk_bf16(v1[0], v1[1]); w.w = cvt_pk_bf16(v1[2], v1[3]);
                    if (NT_STORE) __builtin_nontemporal_store(w, (u32x4*)(rowp + bj * HALF)); else *(u32x4*)(rowp + bj * HALF) = w; }
                asm volatile("" ::: "memory"); }
    }
};
struct EpiResB {
    static constexpr bool PERM = true; static constexpr bool HAS_BIAS = false;
    bf16_t* C; const void* res; int res_f32; int ldc; float alpha; float ascale;
    __device__ __forceinline__ void operator()(const f32x4 (&acc)[2][2][4][2], const Unit& u, int wr, int wc, int fr, int fq) const {
        const int row0 = u.pm * BM + wr * 64 + fr, col0 = u.pn * BM + wc * 32 + 8 * fq;
        if (res_f32) {
#pragma unroll
            for (int ai = 0; ai < 2; ++ai) { f32x4 r[4][2][2];
#pragma unroll
                for (int m = 0; m < 4; ++m)
#pragma unroll
                    for (int bj = 0; bj < 2; ++bj) { const float* rp = (const float*)res + (size_t)(row0 + ai * HALF + m * 16) * ldc + col0 + bj * HALF; r[m][bj][0] = *(const f32x4*)rp; r[m][bj][1] = *(const f32x4*)(rp + 4); }
#pragma unroll
                for (int m = 0; m < 4; ++m)
#pragma unroll
                    for (int bj = 0; bj < 2; ++bj) { const size_t off = (size_t)(row0 + ai * HALF + m * 16) * ldc + col0 + bj * HALF;
                        const f32x4 v0 = r[m][bj][0] * alpha + acc[ai][bj][m][0] * ascale, v1 = r[m][bj][1] * alpha + acc[ai][bj][m][1] * ascale;
                        u32x4 w; w.x = cvt_pk_bf16(v0[0], v0[1]); w.y = cvt_pk_bf16(v0[2], v0[3]); w.z = cvt_pk_bf16(v1[0], v1[1]); w.w = cvt_pk_bf16(v1[2], v1[3]);
                        *(u32x4*)(C + off) = w; }
                asm volatile("" ::: "memory"); }
        } else { u32x4 raw[2][4][2];
#pragma unroll
            for (int ai = 0; ai < 2; ++ai)
#pragma unroll
                for (int m = 0; m < 4; ++m)
#pragma unroll
                    for (int bj = 0; bj < 2; ++bj) raw[ai][m][bj] = *(const u32x4*)((const bf16_t*)res + (size_t)(row0 + ai * HALF + m * 16) * ldc + col0 + bj * HALF);
#pragma unroll
            for (int ai = 0; ai < 2; ++ai)
#pragma unroll
                for (int m = 0; m < 4; ++m)
#pragma unroll
                    for (int bj = 0; bj < 2; ++bj) { const size_t off = (size_t)(row0 + ai * HALF + m * 16) * ldc + col0 + bj * HALF; const u32x4 rw = raw[ai][m][bj];
                        const f32x4 r0 = (f32x4){bflo(rw.x), bfhi(rw.x), bflo(rw.y), bfhi(rw.y)}, r1 = (f32x4){bflo(rw.z), bfhi(rw.z), bflo(rw.w), bfhi(rw.w)};
                        const f32x4 v0 = r0 * alpha + acc[ai][bj][m][0] * ascale, v1 = r1 * alpha + acc[ai][bj][m][1] * ascale;
                        u32x4 w; w.x = cvt_pk_bf16(v0[0], v0[1]); w.y = cvt_pk_bf16(v0[2], v0[3]); w.z = cvt_pk_bf16(v1[0], v1[1]); w.w = cvt_pk_bf16(v1[2], v1[3]);
                        *(u32x4*)(C + off) = w; }
        }
    }
};
struct Pend { u32x2 val[8]; };
struct EpiSwiglu {
    static constexpr bool PERM = true; static constexpr bool HAS_GATE = false; static constexpr bool HAS_BIAS = true;
    __device__ __forceinline__ void load_bias(const Unit& u, int wc, int fq, f32x4 (&bp)[4]) const { const float* bg = b1 + (size_t)u.e * 2048 + u.pn * HALF + wc * 32 + 8 * fq; bp[0] = *(const f32x4*)bg; bp[1] = *(const f32x4*)(bg + 4); bp[2] = *(const f32x4*)(bg + 1024); bp[3] = *(const f32x4*)(bg + 1028); }
    bf16_t* H; const float* b1;
    __device__ __forceinline__ void prepare(const f32x4 (&acc)[2][2][4][2], const Unit& u, int wr, int wc, int fr, int fq, Pend& pd) const {
        constexpr float ASC = 1.0f / W1_SCALE;
        const int j0 = u.pn * HALF + wc * 32 + 8 * fq; const float* bg = b1 + (size_t)u.e * 2048 + j0; const float* bu = bg + 1024;
        const f32x4 bg0 = *(const f32x4*)bg, bg1 = *(const f32x4*)(bg + 4), bu0 = *(const f32x4*)bu, bu1 = *(const f32x4*)(bu + 4);
#pragma unroll
        for (int q8 = 0; q8 < 8; ++q8) { const int ai = q8 >> 2, m = q8 & 3;
            float o[8];
#pragma unroll
            for (int q = 0; q < 8; ++q) { const float gb = (q < 4 ? bg0[q & 3] : bg1[q & 3]), ub = (q < 4 ? bu0[q & 3] : bu1[q & 3]);
                float g = acc[ai][0][m][q >> 2][q & 3] * ASC + gb, uu = acc[ai][1][m][q >> 2][q & 3] * ASC + ub;
                g = fminf(g, 7.0f); uu = fminf(fmaxf(uu, -7.0f), 7.0f);
                const float sg = __builtin_amdgcn_rcpf(1.0f + __builtin_amdgcn_exp2f(-1.702f * LOG2E * g));
                o[q] = (uu + 1.0f) * (g * sg); }
            int w0 = 0, w1 = 0;
            w0 = __builtin_amdgcn_cvt_pk_fp8_f32(o[0] * H_SCALE, o[1] * H_SCALE, w0, false); w0 = __builtin_amdgcn_cvt_pk_fp8_f32(o[2] * H_SCALE, o[3] * H_SCALE, w0, true);
            w1 = __builtin_amdgcn_cvt_pk_fp8_f32(o[4] * H_SCALE, o[5] * H_SCALE, w1, false); w1 = __builtin_amdgcn_cvt_pk_fp8_f32(o[6] * H_SCALE, o[7] * H_SCALE, w1, true);
            pd.val[q8] = (u32x2){(unsigned)w0, (unsigned)w1}; }
    }
    __device__ __forceinline__ void store_one(const u32x2 v, const LAS int* ids, const int r, const int nv, const int j0) const { if (r < nv) { const int slot = ids[r]; *(u32x2*)((unsigned char*)H + (size_t)slot * 1024 + j0) = v; } }
    __device__ __forceinline__ void operator()(const f32x4 (&acc)[2][2][4][2], const Unit& u, int wr, int wc, int fr, int fq, const LAS int* ids, const int nv, const f32x4 (&bp)[4]) const {
        constexpr float ASC = MOE_F8 ? 1.0f / W1_SCALE : 1.0f;
        constexpr float HS = MOE_F8 ? H_SCALE : 1.0f, KK = -1.702f * LOG2E, GA = ASC * KK, UA = ASC * HS / KK, ULO = 8.0f * HS / KK, UHI = -6.0f * HS / KK, GLO = 7.0f * KK;
        const int j0 = u.pn * HALF + wc * 32 + 8 * fq;
        const f32x4 bg0 = bp[0] * KK, bg1 = bp[1] * KK; f32x4 bu0 = (bp[2] + 1.0f) * (HS / KK), bu1 = (bp[3] + 1.0f) * (HS / KK);
        asm volatile("" : "+v"(bu0), "+v"(bu1));
        int rb = wr * 64 + fr; asm volatile("" : "+v"(rb));
        const LAS int* idp = ids + rb; int slots[8];
#pragma unroll
        for (int q = 0; q < 8; ++q) slots[q] = idp[(q >> 2) * HALF + (q & 3) * 16];
#pragma unroll
        for (int ai = 0; ai < 2; ++ai)
#pragma unroll
            for (int m = 0; m < 4; ++m) { const int r = ai * HALF + m * 16 + rb;
                if (r < nv) { const int slot = slots[ai * 4 + m];
                    float o[8];
#pragma unroll
                    for (int q = 0; q < 8; ++q) { const float gb = (q < 4 ? bg0[q & 3] : bg1[q & 3]), ub = (q < 4 ? bu0[q & 3] : bu1[q & 3]);
                        const float gp = fmaxf(__builtin_fmaf(acc[ai][0][m][q >> 2][q & 3], GA, gb), GLO);
                        const float us = fminf(fmaxf(__builtin_fmaf(acc[ai][1][m][q >> 2][q & 3], UA, ub), ULO), UHI);
                        const float sg = __builtin_amdgcn_rcpf(1.0f + __builtin_amdgcn_exp2f(gp));
                        o[q] = us * (gp * sg); }
                    if constexpr (MOE_F8) { int w0 = 0, w1 = 0;
                        w0 = __builtin_amdgcn_cvt_pk_fp8_f32(o[0], o[1], w0, false); w0 = __builtin_amdgcn_cvt_pk_fp8_f32(o[2], o[3], w0, true);
                        w1 = __builtin_amdgcn_cvt_pk_fp8_f32(o[4], o[5], w1, false); w1 = __builtin_amdgcn_cvt_pk_fp8_f32(o[6], o[7], w1, true);
                        *(u32x2*)((unsigned char*)H + (size_t)slot * 1024 + j0) = (u32x2){(unsigned)w0, (unsigned)w1};
                    } else { u32x4 w; w.x = cvt_pk_bf16(o[0], o[1]); w.y = cvt_pk_bf16(o[2], o[3]); w.z = cvt_pk_bf16(o[4], o[5]); w.w = cvt_pk_bf16(o[6], o[7]);
                        *(u32x4*)(H + (size_t)slot * 1024 + j0) = w; } } }
    }
};
struct EpiMoeOut {
    static constexpr bool PERM = true; static constexpr bool HAS_GATE = true; static constexpr bool HAS_BIAS = true;
    __device__ __forceinline__ void load_bias(const Unit& u, int wc, int fq, f32x4 (&bp)[4]) const { const float* bb = b2 + (size_t)u.e * 1024 + u.pn * BM + wc * 32 + 8 * fq; bp[0] = *(const f32x4*)bb; bp[1] = *(const f32x4*)(bb + 4); bp[2] = *(const f32x4*)(bb + HALF); bp[3] = *(const f32x4*)(bb + HALF + 4); }
    bf16_t* Y; const float* b2;   const float* gidx;
    __device__ __forceinline__ void operator()(const f32x4 (&acc)[2][2][4][2], const Unit& u, int wr, int wc, int fr, int fq, const LAS int* ids, const int nv, const f32x4 (&bp)[4]) const {
        const LAS float* gts = (const LAS float*)(ids + 768);
        constexpr float OSC = MOE_F8 ? 1.0f / (H_SCALE * W2_SCALE) : 1.0f;
        const int c0 = u.pn * BM + wc * 32 + 8 * fq;
        f32x4 bv[2][2]; bv[0][0] = bp[0]; bv[0][1] = bp[1]; bv[1][0] = bp[2]; bv[1][1] = bp[3];
        int rb = wr * 64 + fr; asm volatile("" : "+v"(rb));
        const LAS int* idp = ids + rb; int slots[8];
#pragma unroll
        for (int q = 0; q < 8; ++q) slots[q] = idp[(q >> 2) * HALF + (q & 3) * 16];
#pragma unroll
        for (int ai = 0; ai < 2; ++ai)
#pragma unroll
            for (int m = 0; m < 4; ++m) { const int r = ai * HALF + m * 16 + rb;
                if (r < nv) { const int slot = slots[ai * 4 + m]; const float gt = gts[r];
                    if constexpr (Y_F8) {
                        unsigned pk[2][2];
#pragma unroll
                        for (int bj = 0; bj < 2; ++bj) { const f32x4 s0 = (acc[ai][bj][m][0] * OSC + bv[bj][0]) * (gt * Y_SCALE), s1 = (acc[ai][bj][m][1] * OSC + bv[bj][1]) * (gt * Y_SCALE); int w0 = 0, w1 = 0;
                            w0 = __builtin_amdgcn_cvt_pk_fp8_f32(s0[0], s0[1], w0, false); w0 = __builtin_amdgcn_cvt_pk_fp8_f32(s0[2], s0[3], w0, true); w1 = __builtin_amdgcn_cvt_pk_fp8_f32(s1[0], s1[1], w1, false); w1 = __builtin_amdgcn_cvt_pk_fp8_f32(s1[2], s1[3], w1, true);
                            pk[bj][0] = (unsigned)w0; pk[bj][1] = (unsigned)w1; }
                        const auto x0 = __builtin_amdgcn_permlane16_swap(pk[0][0], pk[1][0], false, false), x1 = __builtin_amdgcn_permlane16_swap(pk[0][1], pk[1][1], false, false);
                        *(u32x4*)((unsigned char*)Y + (size_t)slot * 1024 + c0 + ((fq & 1) ? 120 : 0)) = (u32x4){x0[0], x1[0], x0[1], x1[1]};
                    } else {
#pragma unroll
                    for (int bj = 0; bj < 2; ++bj) { const f32x4 v0 = (acc[ai][bj][m][0] * OSC + bv[bj][0]) * gt, v1 = (acc[ai][bj][m][1] * OSC + bv[bj][1]) * gt;
                        u32x4 w; w.x = cvt_pk_bf16(v0[0], v0[1]); w.y = cvt_pk_bf16(v0[2], v0[3]); w.z = cvt_pk_bf16(v1[0], v1[1]); w.w = cvt_pk_bf16(v1[2], v1[3]);
                        if (NT_STORE) __builtin_nontemporal_store(w, (u32x4*)(Y + (size_t)slot * 1024 + c0 + bj * HALF)); else *(u32x4*)(Y + (size_t)slot * 1024 + c0 + bj * HALF) = w; } } } }
    }
};

__device__ __forceinline__ const char* uni_ptr(const char* p) { const unsigned long long v = (unsigned long long)p; const unsigned lo = __builtin_amdgcn_readfirstlane((unsigned)v), hi = __builtin_amdgcn_readfirstlane((unsigned)(v >> 32)); return (const char*)(((unsigned long long)hi << 32) | lo); }
typedef int v4i_t __attribute__((ext_vector_type(4))); typedef int v8i_t __attribute__((ext_vector_type(8)));
__device__ __forceinline__ v8i_t cat8(const bf16x8 a, const bf16x8 b) { return __builtin_shufflevector(__builtin_bit_cast(v4i_t, a), __builtin_bit_cast(v4i_t, b), 0, 1, 2, 3, 4, 5, 6, 7); }
template <class Epi, class Sched, bool GATHER, bool F8 = false, bool DEFER = false>
__device__ __forceinline__ void gemm_phase(LAS unsigned char* lds, const Sched& S, const Epi& E, const int tid) {
    const int wid = __builtin_amdgcn_readfirstlane(tid >> 6), lane = tid & 63, wr = wid >> 2, wc = wid & 3, fr = lane & 15, fq = lane >> 4;
    const int KB = S.KB, nt = KB / 128;
    unsigned voffA[2], voffB[2];
#pragma unroll
    for (int i = 0; i < 2; ++i) { int R, C; stage_rc(tid * 16 + i * 8192, R, C); const int Rb = Epi::PERM ? ((R & ~31) + perm32(R & 31)) : R;
        voffA[i] = (unsigned)(R * KB + C * 2); voffB[i] = (unsigned)(Rb * KB + C * 2); }
    const size_t kstep = (size_t)(BK * 2);
    const size_t hstep = (size_t)HALF * KB;
    const unsigned ldsw = (unsigned)wid * 1024u;
    const int aoff = lds_byte(wr * 64 + fr, fq * 8), boff = lds_byte(wc * 32 + fr, fq * 8);
#define PG8_SA(b, h) (((b) * 2 + (h)) * HTB)
#define PG8_SB(b, h) ((4 + (b) * 2 + (h)) * HTB)
#define PG8_STAGE(bufoff, gbase, voff) do { const char* _gb = uni_ptr((const char*)(gbase)); _Pragma("unroll") for (int _i = 0; _i < 2; ++_i) \
        __builtin_amdgcn_global_load_lds((const unsigned*)(_gb + (voff)[_i]), (LAS unsigned*)(lds + (bufoff) + ldsw + _i * 8192), 16, 0, 0); } while (0)
#define PG8_STAGE_A(bufoff, kb, h, GO) do { if constexpr (GATHER) { PG8_STAGE(bufoff, kb, (GO)[h]); } else { PG8_STAGE(bufoff, (kb) + (h) * hstep, voffA); } } while (0)
#define PG8_LDA(dst, b, h) do { if constexpr (F8) { _Pragma("unroll") for (int m = 0; m < 4; ++m) dst##8[m] = cat8(*(const LAS bf16x8*)(lds + PG8_SA(b, h) + aoff + m * 2048), *(const LAS bf16x8*)(lds + PG8_SA(b, h) + aoff + m * 2048 + 1024)); } else { \
        _Pragma("unroll") for (int m = 0; m < 4; ++m) _Pragma("unroll") for (int k = 0; k < 2; ++k) dst[m][k] = *(const LAS bf16x8*)(lds + PG8_SA(b, h) + aoff + m * 2048 + k * 1024); } } while (0)
#define PG8_LDB(dst, b, h) do { if constexpr (F8) { _Pragma("unroll") for (int n = 0; n < 2; ++n) dst##8[n] = cat8(*(const LAS bf16x8*)(lds + PG8_SB(b, h) + boff + n * 2048), *(const LAS bf16x8*)(lds + PG8_SB(b, h) + boff + n * 2048 + 1024)); } else { \
        _Pragma("unroll") for (int n = 0; n < 2; ++n) _Pragma("unroll") for (int k = 0; k < 2; ++k) dst[n][k] = *(const LAS bf16x8*)(lds + PG8_SB(b, h) + boff + n * 2048 + k * 1024); } } while (0)
#define PG8_MMA(ai, bj, At, Bt) do { __builtin_amdgcn_s_setprio(1); if constexpr (F8) { _Pragma("unroll") for (int m = 0; m < 4; ++m) _Pragma("unroll") for (int n = 0; n < 2; ++n) \
        acc[ai][bj][m][n] = __builtin_amdgcn_mfma_scale_f32_16x16x128_f8f6f4(Bt##8[n], At##8[m], acc[ai][bj][m][n], 0, 0, 0, 0, 0, 0); } else { \
        _Pragma("unroll") for (int m = 0; m < 4; ++m) _Pragma("unroll") for (int n = 0; n < 2; ++n) _Pragma("unroll") for (int k = 0; k < 2; ++k) \
        acc[ai][bj][m][n] = __builtin_amdgcn_mfma_f32_16x16x32_bf16(Bt[n][k], At[m][k], acc[ai][bj][m][n], 0, 0, 0); } __builtin_amdgcn_s_setprio(0); } while (0)
#define PG8_WAIT_V(n) asm volatile("s_waitcnt vmcnt(" #n ")" ::: "memory")
#define PG8_WAIT_L(n) asm volatile("s_waitcnt lgkmcnt(" #n ")" ::: "memory")
#define PG8_BAR __builtin_amdgcn_s_barrier()
#define PG8_SCHED __builtin_amdgcn_sched_barrier(0)
    LAS int* const ibuf = (LAS int*)(lds + STAGE_BYTES + 512);
#define PG8_IDMA(u, b) do { if constexpr (GATHER) { __builtin_amdgcn_global_load_lds((const unsigned*)(S.idx_src(u) + 64 * (wid & 3) + lane), (LAS unsigned*)(ibuf + (b) * 256 + 64 * (wid & 3)), 4, 0, 0); \
        if constexpr (Epi::HAS_GATE) __builtin_amdgcn_global_load_lds((const unsigned*)(E.gidx + (S.idx_src(u) - S.idx) + 64 * (wid & 3) + lane), (LAS unsigned*)(ibuf + 768 + (b) * 256 + 64 * (wid & 3)), 4, 0, 0); } } while (0)
#define PG8_GOFF(dst, u, b) do { if constexpr (GATHER) { int _t = tid; asm volatile("" : "+v"(_t)); const int _nv = S.nvalid(u); _Pragma("unroll") for (int _i = 0; _i < 2; ++_i) { int _R, _C; stage_rc(_t * 16 + _i * 8192, _R, _C); \
        _Pragma("unroll") for (int _h = 0; _h < 2; ++_h) { const int _r = _R + _h * HALF; const unsigned _s = (unsigned)ibuf[(b) * 256 + (_r < _nv ? _r : 0)]; dst[_h][_i] = (_s >> Sched::ROW_SHIFT) * (unsigned)KB + (unsigned)_C * 2u; } } } } while (0)
    Unit cur, nxt; int ui = 0;
    if (!S.next(0, cur)) return;
    f32x4 acc[2][2][4][2];
#pragma unroll
    for (int a = 0; a < 2; ++a)
#pragma unroll
        for (int b = 0; b < 2; ++b)
#pragma unroll
            for (int m = 0; m < 4; ++m)
#pragma unroll
                for (int n = 0; n < 2; ++n) acc[a][b][m][n] = (f32x4){0.f, 0.f, 0.f, 0.f};
    bf16x8 At[4][2], B0[2][2], B1[2][2];
    v8i_t At8[4], B08[2], B18[2];
    unsigned gA[2][2] = {{0u, 0u}, {0u, 0u}}, gN[2][2] = {{0u, 0u}, {0u, 0u}};
    int bsel = 0;
    f32x4 bpre[4] = {(f32x4){0.f, 0.f, 0.f, 0.f}, (f32x4){0.f, 0.f, 0.f, 0.f}, (f32x4){0.f, 0.f, 0.f, 0.f}, (f32x4){0.f, 0.f, 0.f, 0.f}};
    Pend pend; int ppn = 0, pnv = 0, pq = 8, pbuf = 0;
    if constexpr (DEFER) {
#pragma unroll
        for (int q = 0; q < 8; ++q) pend.val[q] = (u32x2){0u, 0u}; }
#define PG8_PSTORE() do { if constexpr (DEFER) { const int _l3 = lane_id_volatile(); const int _nv = (pq < 8) ? pnv : 0; \
        E.store_one(pend.val[0], ibuf + pbuf * 256, ((pq >> 2) & 1) * HALF + (pq & 3) * 16 + wr * 64 + (_l3 & 15), _nv, ppn * HALF + wc * 32 + 8 * (_l3 >> 4)); \
        _Pragma("unroll") for (int _q = 0; _q < 7; ++_q) pend.val[_q] = pend.val[_q + 1]; ++pq; } } while (0)
    if constexpr (GATHER) { PG8_IDMA(cur, 0); PG8_WAIT_V(0); PG8_BAR; }
    PG8_GOFF(gA, cur, 0);
    const char* cA = S.a_base(cur); const char* cB = S.b_base(cur);
    PG8_STAGE(PG8_SB(0, 0), cB, voffB); PG8_STAGE(PG8_SB(0, 1), cB + hstep, voffB); PG8_STAGE_A(PG8_SA(0, 0), cA, 0, gA); PG8_STAGE_A(PG8_SA(0, 1), cA, 1, gA);
    if (wr == 1) PG8_BAR;
    PG8_WAIT_V(2); PG8_BAR;
    PG8_STAGE(PG8_SB(1, 0), cB + kstep, voffB); PG8_STAGE_A(PG8_SA(1, 0), cA + kstep, 0, gA); PG8_STAGE(PG8_SB(1, 1), cB + hstep + kstep, voffB);
    PG8_WAIT_V(6); PG8_BAR;
    for (;;) {
        const bool has_next = S.next(ui + 1, nxt);
        const char* nA = has_next ? S.a_base(nxt) : cA; const char* nB = has_next ? S.b_base(nxt) : cB;
        const int bnxt = (bsel == 2) ? 0 : bsel + 1;
        if constexpr (GATHER) { if (has_next) PG8_IDMA(nxt, bnxt); }
        for (int t = 0; t < nt; t += 2) {
            const bool last = (t == nt - 2);
            const char* a1 = cA + (size_t)(t + 1) * kstep;
            const char* a2 = last ? nA : cA + (size_t)(t + 2) * kstep; const char* b2 = last ? nB : cB + (size_t)(t + 2) * kstep;
            const char* a3 = a2 + kstep; const char* b3 = b2 + kstep;
            if constexpr (GATHER) { if (last && has_next) { PG8_GOFF(gN, nxt, bnxt); } }
            if constexpr (Epi::HAS_BIAS) { if (last) E.load_bias(cur, wc, lane_id_volatile() >> 4, bpre); }
            PG8_LDB(B0, 0, 0); PG8_LDB(B1, 0, 1); PG8_SCHED; PG8_LDA(At, 0, 0); PG8_STAGE_A(PG8_SA(1, 1), a1, 1, gA);
            if constexpr (GATHER) { if (last && has_next) { gA[0][0] = gN[0][0]; gA[0][1] = gN[0][1]; gA[1][0] = gN[1][0]; gA[1][1] = gN[1][1]; } }
            PG8_WAIT_V(8); PG8_WAIT_L(0); PG8_BAR; PG8_MMA(0, 0, At, B0); PG8_MMA(0, 1, At, B1); PG8_BAR; PG8_SCHED;
            PG8_LDA(At, 0, 1); PG8_STAGE(PG8_SB(0, 0), b2, voffB); PG8_STAGE(PG8_SB(0, 1), b2 + hstep, voffB); PG8_STAGE_A(PG8_SA(0, 0), a2, 0, gA);
            PG8_WAIT_V(8); PG8_WAIT_L(0); PG8_BAR; PG8_MMA(1, 0, At, B0); PG8_MMA(1, 1, At, B1); PG8_BAR; PG8_SCHED;
            PG8_PSTORE();
            PG8_LDB(B0, 1, 0); PG8_LDB(B1, 1, 1); PG8_SCHED; PG8_LDA(At, 1, 0); PG8_STAGE_A(PG8_SA(0, 1), a2, 1, gA);
            PG8_WAIT_V(8); PG8_WAIT_L(0); PG8_BAR; PG8_MMA(0, 0, At, B0); PG8_MMA(0, 1, At, B1); PG8_BAR; PG8_SCHED;
            PG8_LDA(At, 1, 1); PG8_STAGE(PG8_SB(1, 0), b3, voffB); PG8_STAGE(PG8_SB(1, 1), b3 + hstep, voffB); PG8_STAGE_A(PG8_SA(1, 0), a3, 0, gA);
            PG8_WAIT_V(8); PG8_WAIT_L(0); PG8_BAR; PG8_MMA(1, 0, At, B0); PG8_MMA(1, 1, At, B1); PG8_BAR; PG8_SCHED;
            PG8_PSTORE();
        }
        if (ALIGN_EPI) { if (wr == 0) PG8_BAR; }
        { const int l2 = lane_id_volatile(), fr2 = l2 & 15, fq2 = l2 >> 4;
          if constexpr (DEFER) { _Pragma("unroll") for (int _f = 0; _f < 8; ++_f) PG8_PSTORE();
              E.prepare(acc, cur, wr, wc, fr2, fq2, pend); ppn = cur.pn; pnv = S.nvalid(cur); pq = 0; pbuf = bsel; }
          else if constexpr (GATHER) E(acc, cur, wr, wc, fr2, fq2, ibuf + bsel * 256, S.nvalid(cur), bpre); else E(acc, cur, wr, wc, fr2, fq2); }
        if (!has_next) break;
#pragma unroll
        for (int a = 0; a < 2; ++a)
#pragma unroll
            for (int b = 0; b < 2; ++b)
#pragma unroll
                for (int m = 0; m < 4; ++m)
#pragma unroll
                    for (int n = 0; n < 2; ++n) acc[a][b][m][n] = (f32x4){0.f, 0.f, 0.f, 0.f};
        cur = nxt; cA = nA; cB = nB; ++ui; bsel = bnxt;
        if (ALIGN_EPI) { if (wr == 1) PG8_BAR; }
    }
    if constexpr (DEFER) { _Pragma("unroll") for (int _f = 0; _f < 8; ++_f) PG8_PSTORE(); }
    PG8_WAIT_V(0);
    if (!ALIGN_EPI) { if (wr == 0) PG8_BAR; }
    PG8_BAR;
#undef PG8_PSTORE
#undef PG8_SA
#undef PG8_SB
#undef PG8_STAGE
#undef PG8_STAGE_A
#undef PG8_LDA
#undef PG8_LDB
#undef PG8_MMA
#undef PG8_WAIT_V
#undef PG8_WAIT_L
#undef PG8_BAR
#undef PG8_SCHED
#undef PG8_GOFF
#undef PG8_IDMA
}
}

namespace attn_body {
using bf16=__hip_bfloat16;
using bf16x8=__attribute__((ext_vector_type(8)))short;
using s16x4=__attribute__((ext_vector_type(4)))short;
using f32x16=__attribute__((ext_vector_type(16)))float;
using u32x4=__attribute__((ext_vector_type(4)))unsigned;
constexpr int D=64;
constexpr int NW=8,QBLK=32,QB=QBLK*NW,KVBLK=64;
constexpr int ATTN_UNIT_ROWS=QB;
__device__ __forceinline__ int crow(int r,int hi){return (r&3)+8*(r>>2)+4*hi;}
#define SBAR() __builtin_amdgcn_sched_barrier(0)
__device__ __forceinline__ void cmask(f32x16&p0,f32x16&p1,int jb,int qrel,int hi){
  const float NEG=-INFINITY; int kb=64*jb+4*hi;
  #pragma unroll
  for(int r=0;r<16;++r){int kv=kb+(r&3)+8*(r>>2); if(kv>qrel)p0[r]=NEG; if(kv+32>qrel)p1[r]=NEG;}
}

constexpr int NSLOT=3, SLOTB=8192;
constexpr int LDS_K=0, LDS_V=NSLOT*SLOTB, LDS_WS=2*NSLOT*SLOTB, LDS_OST=LDS_WS+NW*64*4, LDS_BYTES=LDS_OST+NW*4096;
constexpr float C2=0.125f*1.4426950408889634f;
__device__ __forceinline__ void glds16(const void*gsrc,unsigned lds_dst){unsigned keep;
  asm volatile("s_mov_b32 %0, m0\n\ts_mov_b32 m0, %2\n\ts_nop 0\n\tglobal_load_lds_dwordx4 %1, off\n\ts_mov_b32 m0, %0":"=&s"(keep):"v"(gsrc),"s"(lds_dst):"memory");}
__device__ __forceinline__ float max3f(float a,float b,float c){float r;asm("v_max3_f32 %0, %1, %2, %3":"=v"(r):"v"(a),"v"(b),"v"(c));return r;}
__device__ __forceinline__ float max2f(float a,float b){float r;asm("v_max_f32_e32 %0, %1, %2":"=v"(r):"v"(a),"v"(b));return r;}
__device__ __forceinline__ float fadd_s(float a,float b){float r;asm("v_add_f32_e32 %0, %1, %2":"=v"(r):"v"(a),"v"(b));return r;}
__device__ __forceinline__ float fsub_s(float a,float b){float r;asm("v_sub_f32_e32 %0, %1, %2":"=v"(r):"v"(a),"v"(b));return r;}
typedef float f32x2_t __attribute__((ext_vector_type(2))); typedef __bf16 bf16x2_t __attribute__((ext_vector_type(2)));
__device__ __forceinline__ unsigned cvtpk_s(float lo,float hi){f32x2_t v={lo,hi};bf16x2_t b=__builtin_convertvector(v,bf16x2_t);return __builtin_bit_cast(unsigned,b);}
#define WAIT_BAR(N) asm volatile("s_waitcnt vmcnt(" #N ") lgkmcnt(0)\n\ts_barrier":::"memory")

__device__ __forceinline__ void qkt(f32x16&p0,f32x16&p1,const char*Kslot,const bf16x8*qr,const f32x16&negm,int r32,int hi){
  const char*kb=Kslot+hi*1024+r32*16;
  #pragma unroll
  for(int d0=0;d0<4;++d0){
    const bf16x8 b0=*reinterpret_cast<const bf16x8*>(kb+d0*2048);
    const bf16x8 b1=*reinterpret_cast<const bf16x8*>(kb+d0*2048+512);
    if(d0==0){p0=__builtin_amdgcn_mfma_f32_32x32x16_bf16(b0,qr[0],negm,0,0,0);p1=__builtin_amdgcn_mfma_f32_32x32x16_bf16(b1,qr[0],negm,0,0,0);}
    else{p0=__builtin_amdgcn_mfma_f32_32x32x16_bf16(b0,qr[d0],p0,0,0,0);p1=__builtin_amdgcn_mfma_f32_32x32x16_bf16(b1,qr[d0],p1,0,0,0);}}
}
typedef __attribute__((address_space(3))) const char* lds_cptr;
typedef short v4i16_t __attribute__((ext_vector_type(4)));
__device__ __forceinline__ void kload8(bf16x8*kf,lds_cptr kp){
  kf[0]=*(const __attribute__((address_space(3))) bf16x8*)(kp);      kf[1]=*(const __attribute__((address_space(3))) bf16x8*)(kp+512);
  kf[2]=*(const __attribute__((address_space(3))) bf16x8*)(kp+2048); kf[3]=*(const __attribute__((address_space(3))) bf16x8*)(kp+2560);
  kf[4]=*(const __attribute__((address_space(3))) bf16x8*)(kp+4096); kf[5]=*(const __attribute__((address_space(3))) bf16x8*)(kp+4608);
  kf[6]=*(const __attribute__((address_space(3))) bf16x8*)(kp+6144); kf[7]=*(const __attribute__((address_space(3))) bf16x8*)(kp+6656);
}
__device__ __forceinline__ void kload2(bf16x8*kf,lds_cptr kp,int j){ kf[2*j]=*(const __attribute__((address_space(3))) bf16x8*)(kp+j*2048); kf[2*j+1]=*(const __attribute__((address_space(3))) bf16x8*)(kp+j*2048+512); }
__device__ __forceinline__ s16x4 vtr(lds_cptr p){ return __builtin_bit_cast(s16x4,__builtin_amdgcn_ds_read_tr16_b64_v4i16((__attribute__((address_space(3))) v4i16_t*)p)); }
__device__ __forceinline__ float rowmax(const f32x16&p0,const f32x16&p1){
  float a=max3f(p0[0],p0[1],p1[0]),b=max3f(p0[2],p0[3],p1[1]);a=max3f(a,p1[2],p1[3]);
  #pragma unroll
  for(int r=4;r<16;r+=4){a=max3f(a,p0[r],p0[r+1]);b=max3f(b,p0[r+2],p0[r+3]);a=max3f(a,p1[r],p1[r+1]);b=max3f(b,p1[r+2],p1[r+3]);}
  const float m=max2f(a,b);
  auto rr=__builtin_amdgcn_permlane32_swap(__float_as_uint(m),__float_as_uint(m),false,false);
  return max2f(__uint_as_float(rr[0]),__uint_as_float(rr[1]));
}
__device__ __forceinline__ void pv(f32x16*o,int vb,bf16x8 pa0,bf16x8 pa1,bf16x8 pa2,bf16x8 pa3){
  #pragma unroll
  for(int d0=0;d0<2;++d0){s16x4 lo[4],hi[4];
    #pragma unroll
    for(int ks=0;ks<4;++ks){
      asm volatile("ds_read_b64_tr_b16 %0,%1 offset:%c2":"=&v"(lo[ks]):"v"(vb),"i"(d0*4096+ks*1024):"memory");
      asm volatile("ds_read_b64_tr_b16 %0,%1 offset:%c2":"=&v"(hi[ks]):"v"(vb),"i"(d0*4096+ks*1024+512):"memory");}
    asm volatile("s_waitcnt lgkmcnt(0)":::"memory");SBAR();
    #define PK(k) (bf16x8){lo[k][0],lo[k][1],lo[k][2],lo[k][3],hi[k][0],hi[k][1],hi[k][2],hi[k][3]}
    o[d0]=__builtin_amdgcn_mfma_f32_32x32x16_bf16(pa0,PK(0),o[d0],0,0,0);
    o[d0]=__builtin_amdgcn_mfma_f32_32x32x16_bf16(pa1,PK(1),o[d0],0,0,0);
    o[d0]=__builtin_amdgcn_mfma_f32_32x32x16_bf16(pa2,PK(2),o[d0],0,0,0);
    o[d0]=__builtin_amdgcn_mfma_f32_32x32x16_bf16(pa3,PK(3),o[d0],0,0,0);
    #undef PK
  }
}

#ifndef ATTN_STORE16
#define ATTN_STORE16(p,v) (*(u32x4*)(p)=(v))
#endif
template<int THRL, bool O8 = false> __device__ __forceinline__ void attn_unit(const bf16*Qu,const bf16*__restrict__ Kh,const bf16*__restrict__ Vh,bf16*Ou,const int QP,const int KP,const int VP,const int OP,const int NT,char*shm,const int tid){
  const int lane=tid&63,r32=lane&31,hi=lane>>5; const int wid=__builtin_amdgcn_readfirstlane(tid>>6);
  const bf16*Qw=Qu+(long)(wid*QBLK)*QP;
  const unsigned lds0=(unsigned)(uintptr_t)shm;
  float*wsf=(float*)(shm+LDS_WS)+wid*64;
  const bf16*ksrc=Kh+(long)lane*KP+wid*8;
  const bf16*vsrc=Vh+(long)(16*(wid&3)+(lane>>2))*VP+(wid>>2)*32+(lane&3)*8;
  const unsigned kdst=lds0+LDS_K+wid*1024, vdst=lds0+LDS_V+wid*1024;
  #define DMA_K(t,slot) glds16(ksrc+(long)(t)*KVBLK*KP,(unsigned)__builtin_amdgcn_readfirstlane(kdst+(slot)))
  #define DMA_V(t,slot) glds16(vsrc+(long)(t)*KVBLK*VP,(unsigned)__builtin_amdgcn_readfirstlane(vdst+(slot)))
  const int vb0=(int)(lds0+LDS_V)+((lane>>4)&1)*32+(lane&3)*8+(4*hi+((lane&15)>>2))*64;
  const char*Kbase=shm+LDS_K; bf16x8 kf[8];
  const lds_cptr shm3=(lds_cptr)shm; const lds_cptr kp0=shm3+LDS_K+hi*1024+r32*16; const lds_cptr vp0=shm3+LDS_V+((lane>>4)&1)*32+(lane&3)*8+(4*hi+((lane&15)>>2))*64;
  DMA_K(0,0);DMA_V(0,0);DMA_K(1,SLOTB);
  bf16x8 qr[4];
  #pragma unroll
  for(int d0=0;d0<4;++d0)qr[d0]=*reinterpret_cast<const bf16x8*>(&Qw[(long)r32*QP+d0*16+hi*8]);
  float mhat=0.f,l_reg=0.f;f32x16 o[2];f32x16 negm; { float z_=0.f; asm volatile("":"+v"(z_)); _Pragma("unroll") for(int r=0;r<16;++r){o[0][r]=z_;o[1][r]=z_;negm[r]=z_;} } asm volatile("":"+v"(negm));
  #define CMASK(P0,P1,t) do{}while(0)
  bool resc=false;
  #define START(P0,P1) do{ const float rm=rowmax(P0,P1); resc=false; \
    { const float dl=rm; mhat=fadd_s(mhat,dl); \
      _Pragma("unroll") for(int r=0;r<16;++r){P0[r]=fsub_s(P0[r],dl);P1[r]=fsub_s(P1[r],dl);} \
      _Pragma("unroll") for(int r=0;r<16;++r)negm[r]=-mhat; asm volatile("":"+v"(negm)); } \
    _Pragma("unroll") for(int r=0;r<16;++r)P0[r]=__builtin_amdgcn_exp2f(P0[r]); }while(0)
  #define RESC() do{ if(resc){ asm volatile("s_waitcnt lgkmcnt(0)":::"memory"); \
      _Pragma("unroll") for(int d_=0;d_<2;++d_) _Pragma("unroll") for(int r=0;r<16;++r)o[d_][r]*=wsf[crow(r,hi)]; } }while(0)
  f32x16 pA0,pA1,pB0,pB1;
  int sl_prev=0,sl_cur=0,sl_next=SLOTB;
  #define ROT() do{sl_prev=sl_cur;sl_cur=sl_next;sl_next=(sl_next==(NSLOT-1)*SLOTB)?0:sl_next+SLOTB;}while(0)
  DMA_K(2,2*SLOTB);
  WAIT_BAR(3);
  qkt(pA0,pA1,Kbase,qr,negm,r32,hi);asm volatile("s_nop 15\n\ts_nop 7":"+v"(pA0),"+v"(pA1));CMASK(pA0,pA1,0);
  START(pA0,pA1);
  _Pragma("unroll") for(int r=0;r<16;++r)pA1[r]=__builtin_amdgcn_exp2f(pA1[r]);
  WAIT_BAR(0);
  DMA_K(3,0);DMA_V(1,SLOTB);
  ROT();
  kload8(kf,kp0+sl_cur);
  WAIT_BAR(2);
  s16x4 vlo[8],vhi[8]; u32x4 pw0,pw1,pw2,pw3;
  #define PKW(P,B) cvtpk_s(P[B],P[B+1])
  #define PAF(k) __builtin_bit_cast(bf16x8,pw##k)
  #define VFR(i) (bf16x8){vlo[i][0],vlo[i][1],vlo[i][2],vlo[i][3],vhi[i][0],vhi[i][1],vhi[i][2],vhi[i][3]}
  #define PIN(x) asm volatile("":"+v"(x))
  #define MX3(a,b,c) __builtin_fmaxf(__builtin_fmaxf((a),(b)),(c))
  #define GAPA(MF,A0,A1,A2,A3,W0,W1,PW) do{ MF; sacc+=A0; sacc+=A1; sacc+=A2; sacc+=A3; PIN(sacc); W0; W1; PIN(PW); SBAR(); }while(0)
  #define EX(v) __builtin_amdgcn_exp2f(v)
  #define GAPB(MF,X,B) do{ MF; X[B]=EX(X[B]); X[B+1]=EX(X[B+1]); X[B+2]=EX(X[B+2]); X[B+3]=EX(X[B+3]); PIN(X); SBAR(); }while(0)
  #define VRD(i) do{ vlo[i]=vtr(vp_+(((i)>>2)*4096+((i)&3)*1024)); vhi[i]=vtr(vp_+(((i)>>2)*4096+((i)&3)*1024+512)); }while(0)
  #define KRD(G,j) do{ if(G){ kload2(kf,kp0+sl_next,j); SBAR(); } }while(0)
  #define STEP(C0,C1,P0,P1,t,GK,GV,GL) do{ SBAR(); \
    const lds_cptr vp_=vp0+sl_prev; \
    VRD(0); SBAR(); float sacc=(P0[0]+P0[1]); \
    GAPA(C0=__builtin_amdgcn_mfma_f32_32x32x16_bf16(kf[0],qr[0],negm,0,0,0), P0[2],P0[3],P0[4],P0[5],     pw0[0]=PKW(P0,0), pw0[1]=PKW(P0,2), pw0); \
    VRD(4); SBAR(); GAPA(C1=__builtin_amdgcn_mfma_f32_32x32x16_bf16(kf[1],qr[0],negm,0,0,0), P0[6],P0[7],P0[8],P0[9],     pw0[2]=PKW(P0,4), pw0[3]=PKW(P0,6), pw0); \
    VRD(1); SBAR(); GAPA(C0=__builtin_amdgcn_mfma_f32_32x32x16_bf16(kf[2],qr[1],C0,0,0,0),   P0[10],P0[11],P0[12],P0[13], pw1[0]=PKW(P0,8), pw1[1]=PKW(P0,10), pw1); \
    VRD(5); SBAR(); GAPA(C1=__builtin_amdgcn_mfma_f32_32x32x16_bf16(kf[3],qr[1],C1,0,0,0),   P0[14],P0[15],P1[0],P1[1],   pw1[2]=PKW(P0,12),pw1[3]=PKW(P0,14), pw1); \
    VRD(2); SBAR(); GAPA(C0=__builtin_amdgcn_mfma_f32_32x32x16_bf16(kf[4],qr[2],C0,0,0,0),   P1[2],P1[3],P1[4],P1[5],     pw2[0]=PKW(P1,0), pw2[1]=PKW(P1,2), pw2); \
    VRD(6); SBAR(); GAPA(C1=__builtin_amdgcn_mfma_f32_32x32x16_bf16(kf[5],qr[2],C1,0,0,0),   P1[6],P1[7],P1[8],P1[9],     pw2[2]=PKW(P1,4), pw2[3]=PKW(P1,6), pw2); \
    VRD(3); SBAR(); GAPA(C0=__builtin_amdgcn_mfma_f32_32x32x16_bf16(kf[6],qr[3],C0,0,0,0),   P1[10],P1[11],P1[12],P1[13], pw3[0]=PKW(P1,8), pw3[1]=PKW(P1,10), pw3); \
    VRD(7); SBAR(); GAPA(C1=__builtin_amdgcn_mfma_f32_32x32x16_bf16(kf[7],qr[3],C1,0,0,0),   P1[14],P1[15],0.f,0.f,       pw3[2]=PKW(P1,12),pw3[3]=PKW(P1,14), pw3); \
    l_reg+=sacc; \
    if(GK){DMA_K((t)+3,sl_cur);} if(GV){DMA_V((t)+1,sl_next);} \
    CMASK(C0,C1,t); \
    { float a=MX3(C0[0],C0[1],C1[0]),b=MX3(C0[2],C0[3],C1[1]); a=MX3(a,C1[2],C1[3]); \
      _Pragma("unroll") for(int r=4;r<16;r+=4){a=MX3(a,C0[r],C0[r+1]);b=MX3(b,C0[r+2],C0[r+3]);a=MX3(a,C1[r],C1[r+1]);b=MX3(b,C1[r+2],C1[r+3]);} \
      float rm=__builtin_fmaxf(a,b); { auto rr=__builtin_amdgcn_permlane32_swap(__float_as_uint(rm),__float_as_uint(rm),false,false); rm=__builtin_fmaxf(__uint_as_float(rr[0]),__uint_as_float(rr[1])); } \
      resc=false; \
      if(__builtin_expect(__any(rm>(float)THRL),0)){ const float dl=__builtin_fmaxf(rm,0.f); mhat+=dl; \
        _Pragma("unroll") for(int r=0;r<16;++r){C0[r]-=dl;C1[r]-=dl;} \
        _Pragma("unroll") for(int r=0;r<16;++r)negm[r]=-mhat; asm volatile("":"+v"(negm)); \
        const float f=__builtin_amdgcn_exp2f(-dl); l_reg*=f; if(hi==0)wsf[r32]=f; resc=true; } } \
    SBAR(); \
    GAPB(o[0]=__builtin_amdgcn_mfma_f32_32x32x16_bf16(PAF(0),VFR(0),o[0],0,0,0), C0,0); \
    GAPB(o[1]=__builtin_amdgcn_mfma_f32_32x32x16_bf16(PAF(0),VFR(4),o[1],0,0,0), C0,4); \
    KRD(GL,0); GAPB(o[0]=__builtin_amdgcn_mfma_f32_32x32x16_bf16(PAF(1),VFR(1),o[0],0,0,0), C0,8); \
    KRD(GL,1); GAPB(o[1]=__builtin_amdgcn_mfma_f32_32x32x16_bf16(PAF(1),VFR(5),o[1],0,0,0), C0,12); \
    KRD(GL,2); GAPB(o[0]=__builtin_amdgcn_mfma_f32_32x32x16_bf16(PAF(2),VFR(2),o[0],0,0,0), C1,0); \
    KRD(GL,3); GAPB(o[1]=__builtin_amdgcn_mfma_f32_32x32x16_bf16(PAF(2),VFR(6),o[1],0,0,0), C1,4); \
    GAPB(o[0]=__builtin_amdgcn_mfma_f32_32x32x16_bf16(PAF(3),VFR(3),o[0],0,0,0), C1,8); \
    GAPB(o[1]=__builtin_amdgcn_mfma_f32_32x32x16_bf16(PAF(3),VFR(7),o[1],0,0,0), C1,12); \
    }while(0)
  int t=1;
  #undef CMASK
  #define CMASK(P0,P1,t) do{}while(0)
  for(;t+5<NT;t+=2){
    STEP(pB0,pB1,pA0,pA1,t,true,true,true);     WAIT_BAR(2); RESC(); ROT();
    STEP(pA0,pA1,pB0,pB1,t+1,true,true,true);   WAIT_BAR(2); RESC(); ROT();
  }
  #undef CMASK
  #define CMASK(P0,P1,t) do{}while(0)
  #define ENDW(tt) do{ if((tt)+3<NT){WAIT_BAR(2);} else if((tt)+2<NT){WAIT_BAR(1);} else {WAIT_BAR(0);} }while(0)
  for(;t+1<NT;t+=2){
    STEP(pB0,pB1,pA0,pA1,t,(t+3<NT),(t+1<NT),(t+1<NT));       ENDW(t);   RESC(); ROT();
    STEP(pA0,pA1,pB0,pB1,t+1,(t+4<NT),(t+2<NT),(t+2<NT));     ENDW(t+1); RESC(); ROT();
  }
  STEP(pB0,pB1,pA0,pA1,NT-1,false,false,false); RESC();
  { float sacc=pB0[0]+pB0[1]; _Pragma("unroll") for(int r=2;r<16;++r)sacc+=pB0[r]; _Pragma("unroll") for(int r=0;r<16;++r)sacc+=pB1[r]; l_reg+=sacc;
    pw0=(u32x4){PKW(pB0,0),PKW(pB0,2),PKW(pB0,4),PKW(pB0,6)};pw1=(u32x4){PKW(pB0,8),PKW(pB0,10),PKW(pB0,12),PKW(pB0,14)};pw2=(u32x4){PKW(pB1,0),PKW(pB1,2),PKW(pB1,4),PKW(pB1,6)};pw3=(u32x4){PKW(pB1,8),PKW(pB1,10),PKW(pB1,12),PKW(pB1,14)};
    SBAR(); pv(o,vb0+sl_cur,PAF(0),PAF(1),PAF(2),PAF(3)); }
  #undef PKW
  #undef PAF
  #undef VFR
  #undef PIN
  #undef MX3
  #undef GAPA
  #undef GAPB
  #undef EX
  #undef VRD
  #undef KRD
  #undef STEP
  #undef ENDW
  {auto rr=__builtin_amdgcn_permlane32_swap(__float_as_uint(l_reg),__float_as_uint(l_reg),false,false);l_reg=__uint_as_float(rr[0])+__uint_as_float(rr[1]);}
  if(hi==0)wsf[32+r32]=l_reg;asm volatile("s_waitcnt lgkmcnt(0)":::"memory");
  float rli[16];
  #pragma unroll
  for(int r=0;r<16;++r)rli[r]=__builtin_amdgcn_rcpf(wsf[32+crow(r,hi)]);
  if constexpr (O8) {
    unsigned char*Ow8=(unsigned char*)Ou+(long)(wid*QBLK)*OP; unsigned char*stg8=(unsigned char*)(shm+LDS_OST)+wid*2048;
    #pragma unroll
    for(int r=0;r<16;++r){const int orow=crow(r,hi);
      #pragma unroll
      for(int d0=0;d0<2;++d0)stg8[orow*64+d0*32+r32]=f2fp8(o[d0][r]*rli[r]);}
    asm volatile("s_waitcnt lgkmcnt(0)":::"memory");
    #pragma unroll
    for(int i=0;i<2;++i){const int row=i*16+(lane>>2),ch=lane&3; const u32x4 v=*(const u32x4*)(stg8+row*64+ch*16); ATTN_STORE16(Ow8+(long)row*OP+ch*16,v);}
  } else {
  bf16*Ow=Ou+(long)(wid*QBLK)*OP;
  { bf16*stg=(bf16*)(shm+LDS_OST)+wid*2048;
    #pragma unroll
    for(int r=0;r<16;++r){const int orow=crow(r,hi);
      #pragma unroll
      for(int d0=0;d0<2;++d0)stg[orow*64+d0*32+r32]=__float2bfloat16(o[d0][r]*rli[r]);}
    asm volatile("s_waitcnt lgkmcnt(0)":::"memory");
    #pragma unroll
    for(int i=0;i<4;++i){const int row=i*8+(lane>>3),ch=lane&7; const u32x4 v=*(const u32x4*)(stg+row*64+ch*8); ATTN_STORE16(Ow+(long)row*OP+ch*8,v);} }
  }
  asm volatile("s_waitcnt lgkmcnt(0)\n\ts_barrier":::"memory");
  #undef DMA_K
  #undef DMA_V
  #undef CMASK
  #undef START
  #undef RESC
  #undef ROT
}
constexpr int ATTN_LDS_BYTES=LDS_BYTES;
#undef SBAR
#undef WAIT_BAR
}

struct Args { const float* in[32]; float* out; unsigned char* ws; int ph_lo, ph_hi; };
struct Ctx {
    LAS unsigned char* lds;
    int vcu, G;
    unsigned char* ws;
};
constexpr int PTAB_OFF = MISC_OFF + 256;
__device__ __forceinline__ unsigned long long ptab_get(const Ctx& cx, int k) {
    const LAS unsigned* t = (const LAS unsigned*)(cx.lds + PTAB_OFF) + 2 * k; const unsigned lo = __builtin_amdgcn_readfirstlane(t[0]), hi = __builtin_amdgcn_readfirstlane(t[1]);
    return ((unsigned long long)hi << 32) | lo;
}
#define INP(k) ((const float*)(GAS const float*)ptab_get(cx, (k)))

template <bool F8> __device__ __forceinline__ void p0_transpose64(const float* W, int N, int KB, unsigned char* WT, int k0, int n0, int dst_row0, float scale, LAS float* scr, int lane) {
    f32x4 v[16];
    const float* src = W + (size_t)(k0 + (lane >> 4)) * N + n0 + (lane & 15) * 4;
#pragma unroll
    for (int i = 0; i < 16; ++i) v[i] = *(const f32x4*)(src + (size_t)(4 * i) * N);
#pragma unroll
    for (int i = 0; i < 16; ++i) { LAS float* p = scr + (4 * i + (lane >> 4)) * 65 + (lane & 15) * 4; p[0] = v[i][0]; p[1] = v[i][1]; p[2] = v[i][2]; p[3] = v[i][3]; }
    LDS_WAIT(); asm volatile("" ::: "memory");
    if constexpr (!F8) {
        const int ns = lane >> 3, ch = lane & 7;
#pragma unroll
        for (int r8 = 0; r8 < 8; ++r8) { const int n = r8 * 8 + ns; const LAS float* s = scr + (8 * ch) * 65 + n;
            u32x4 o; o.x = pk2(s[0 * 65], s[1 * 65]); o.y = pk2(s[2 * 65], s[3 * 65]); o.z = pk2(s[4 * 65], s[5 * 65]); o.w = pk2(s[6 * 65], s[7 * 65]);
            *(GAS u32x4*)(WT + (size_t)(dst_row0 + n) * KB + (k0 + 8 * ch) * 2) = o; }
    } else {
        const int ns = lane >> 2, ch = lane & 3;
#pragma unroll
        for (int r4 = 0; r4 < 4; ++r4) { const int n = r4 * 16 + ns; const LAS float* s = scr + (16 * ch) * 65 + n; unsigned w[4];
#pragma unroll
            for (int q = 0; q < 4; ++q) { int r = 0; r = __builtin_amdgcn_cvt_pk_fp8_f32(s[(4 * q) * 65] * scale, s[(4 * q + 1) * 65] * scale, r, false); r = __builtin_amdgcn_cvt_pk_fp8_f32(s[(4 * q + 2) * 65] * scale, s[(4 * q + 3) * 65] * scale, r, true); w[q] = (unsigned)r; }
            *(GAS u32x4*)(WT + (size_t)(dst_row0 + n) * KB + k0 + 16 * ch) = (u32x4){w[0], w[1], w[2], w[3]}; }
    }
    LDS_WAIT(); asm volatile("" ::: "memory");
}
__device__ __forceinline__ void p0_prologue(const Ctx& cx, const int tid) {
    const int lane = tid & 63, wave = __builtin_amdgcn_readfirstlane(tid >> 6);
    LAS float* scr = (LAS float*)(cx.lds + wave * 16896);
    const int gw = cx.vcu * 8 + wave, NGW = cx.G * 8;
    constexpr int I_WIN0 = 16 * 40, I_WIN1 = 16 * 24, I_WKV = 16 * 8, I_WOUT = 16 * 16, I_W1 = 16 * 32, I_W2 = 16 * 16;
    constexpr int T_WIN = 3 * I_WIN0 + I_WIN1, T_WKV = 4 * I_WKV, T_WOUT = 4 * I_WOUT, T_W1 = 128 * I_W1, T_W2 = 128 * I_W2;
    constexpr int NITEMS = T_WIN + T_WKV + T_WOUT + T_W1 + T_W2;
    for (int it = gw; it < NITEMS; it += NGW) {
        int r = it;
        const float* W; unsigned char* WT; int N, nb, kb, dst_row0; bool isout = false;
        if (r < T_W1) {
            const int mi = r / I_W1, q = r % I_W1; N = 2048; kb = q / 32; nb = q % 32;
            W = INP(28) + (size_t)mi * 1024 * 2048; WT = cx.ws + WS_W1 + (size_t)mi * 2048 * 1024 * MOE_EB;
            const int n0 = nb * 64, isu = n0 >= 1024, j = n0 - isu * 1024;
            dst_row0 = (j >> 7) * 256 + isu * 128 + (j & 127);
            p0_transpose64<MOE_F8>(W, N, 1024 * MOE_EB, WT, kb * 64, nb * 64, dst_row0, W1_SCALE, scr, lane); continue;
        } else if ((r -= T_W1) < T_W2) {
            const int mi = r / I_W2, q = r % I_W2; N = 1024; kb = q / 16; nb = q % 16;
            W = INP(30) + (size_t)mi * 1024 * 1024; WT = cx.ws + WS_W2 + (size_t)mi * 1024 * 1024 * MOE_EB; dst_row0 = nb * 64;
            p0_transpose64<MOE_F8>(W, N, 1024 * MOE_EB, WT, kb * 64, nb * 64, dst_row0, W2_SCALE, scr, lane); continue;
        } else if ((r -= T_W2) < T_WIN) {
            int l, q;
            if (r < I_WIN0) { l = 0; q = r; } else if (r < I_WIN0 + I_WIN1) { l = 1; q = r - I_WIN0; } else if (r < 2 * I_WIN0 + I_WIN1) { l = 2; q = r - I_WIN0 - I_WIN1; } else { l = 3; q = r - 2 * I_WIN0 - I_WIN1; }
            N = in_width(l); const int nbn = N / 64; kb = q / nbn; nb = q % nbn;
            const int kind = layer_kind(l), j = layer_j(l);
            W = (kind == 0 ? INP(2) : kind == 1 ? INP(4) : INP(7)) + (size_t)j * 1024 * N;
            WT = cx.ws + WS_WIN + (size_t)l * 5 * MiB; dst_row0 = nb * 64;
        } else if ((r -= T_WIN) < T_WKV) {
            const int l = r / I_WKV, q = r % I_WKV; N = 512; kb = q / 8; nb = q % 8;
            W = INP(20) + (size_t)l * 1024 * 512; WT = cx.ws + WS_WKV; dst_row0 = l * 512 + nb * 64;
        } else {
            r -= T_WKV; const int l = r / I_WOUT, q = r % I_WOUT; N = 1024; kb = q / 16; nb = q % 16;
            W = INP(21) + (size_t)l * 1024 * 1024; WT = cx.ws + WS_WOUT + (size_t)l * 2 * MiB; dst_row0 = nb * 64; isout = true;
        }
        if (isout) p0_transpose64<OUTP_F8 != 0>(W, N, 1024 * OUT_EB, WT, kb * 64, nb * 64, dst_row0, OUTP_F8 ? WOUT_SCALE : 1.0f, scr, lane);
        else p0_transpose64<INP_F8 != 0>(W, N, 1024 * INP_EB, WT, kb * 64, nb * 64, dst_row0, INP_F8 ? WIN_SCALE : 1.0f, scr, lane);
    }
    {
        const size_t gt = (size_t)cx.vcu * 512 + tid, NT_ = (size_t)cx.G * 512;
        for (int which = 0; which < 2; ++which) {
            const f32x4* xs = (const f32x4*)(which == 0 ? INP(0) : INP(1)); unsigned char* xd = cx.ws + (which == 0 ? WS_XB : WS_MEMB); const size_t n8 = (size_t)(which == 0 ? NTOK : NMEM) * DM / 8;
#pragma unroll 4
            for (size_t i = gt; i < n8; i += NT_) { const f32x4 a = xs[2 * i], b = xs[2 * i + 1];
                if constexpr (INP_F8) { int w0 = 0, w1 = 0; w0 = __builtin_amdgcn_cvt_pk_fp8_f32(a[0], a[1], w0, false); w0 = __builtin_amdgcn_cvt_pk_fp8_f32(a[2], a[3], w0, true); w1 = __builtin_amdgcn_cvt_pk_fp8_f32(b[0], b[1], w1, false); w1 = __builtin_amdgcn_cvt_pk_fp8_f32(b[2], b[3], w1, true);
                    *(u32x2*)(xd + i * 8) = (u32x2){(unsigned)w0, (unsigned)w1}; }
                else { u32x4 o; o.x = pk2(a[0], a[1]); o.y = pk2(a[2], a[3]); o.z = pk2(b[0], b[1]); o.w = pk2(b[2], b[3]); *(u32x4*)(xd + i * 16) = o; } }
        }
    }
    { const float* rwp = INP(26); unsigned short* RW = (unsigned short*)(cx.ws + WS_RW);
      for (int i = cx.vcu * 512 + tid; i < 4 * 32768; i += cx.G * 512) { const int l = i >> 15, r = i & 32767, k = r >> 5, e = r & 31; const float w = rwp[i]; const unsigned hi = f2bf(w); const float wl = w - bf2f((unsigned short)hi);
          RW[((size_t)(l * 2 + 0) * 32 + e) * 1024 + k] = (unsigned short)hi; RW[((size_t)(l * 2 + 1) * 32 + e) * 1024 + k] = (unsigned short)f2bf(wl); } }
    {
        const float *fw1 = INP(10), *fb1 = INP(11), *fw2 = INP(12), *fb2 = INP(13), *fw3 = INP(14), *fb3 = INP(15), *fw4 = INP(16), *fb4 = INP(17), *ffr = INP(18);
        LAS float* z = (LAS float*)cx.lds; LAS float* h1 = z + 16 * 33; LAS float* h2 = h1 + 1024; LAS float* h3 = h2 + 1024;
        float* HRAWT = (float*)(cx.ws + WS_HRAWT); float* HPART = (float*)(cx.ws + WS_HPART);
        for (int it = cx.vcu; it < 256; it += cx.G) {
            __syncthreads();
            const int pos0 = it * 16;
            for (int i = tid; i < 16 * 33; i += 512) { const int p = i / 33, f = i % 33; const float pos = (float)(pos0 + p); float v;
                if (f == 0) v = pos / 4095.0f;
                else { const int k = (f - 1) & 15; const float fb = 1e-4f + (float)k * ((15.0f - 1e-4f) / 15.0f); const float ang = (6.283185307179586f * pos / 4096.0f) * fb; v = (f <= 16) ? cosf(ang) : -sinf(ang); }
                z[i] = v; }
            __syncthreads();
            for (int i = tid; i < 1024; i += 512) { const int p = i >> 6, o = i & 63; float a = fb1[o]; for (int f = 0; f < 33; ++f) a += z[p * 33 + f] * fw1[f * 64 + o]; h1[i] = sinf(ffr[o] * a); }
            __syncthreads();
            for (int i = tid; i < 1024; i += 512) { const int p = i >> 6, o = i & 63; float a = fb2[o]; for (int k = 0; k < 64; ++k) a += h1[p * 64 + k] * fw2[k * 64 + o]; h2[i] = sinf(ffr[o] * a); }
            __syncthreads();
            for (int i = tid; i < 1024; i += 512) { const int p = i >> 6, o = i & 63; float a = fb3[o]; for (int k = 0; k < 64; ++k) a += h2[p * 64 + k] * fw3[k * 64 + o]; h3[i] = sinf(ffr[o] * a); }
            __syncthreads();
            for (int col = tid; col < 3072; col += 512) {
                float a[16]; const float bb = fb4[col];
#pragma unroll
                for (int p = 0; p < 16; ++p) a[p] = bb;
                for (int k = 0; k < 64; ++k) { const float w = fw4[(size_t)k * 3072 + col];
#pragma unroll
                    for (int p = 0; p < 16; ++p) a[p] += h3[p * 64 + k] * w; }
                const int c = col % 768; const float mind = -3.0701134573253945f, maxd = -15.350567286626972f;
                const float delta = fabsf(mind + (maxd - mind) * ((float)c / 767.0f)); float asum = 0.f;
#pragma unroll
                for (int p = 0; p < 16; ++p) { const float t = (float)(pos0 + p) / 4095.0f; a[p] *= expf(-t * delta); asum += fabsf(a[p]); }
                f32x4* dst = (f32x4*)(HRAWT + (size_t)col * 4096 + pos0);
#pragma unroll
                for (int q = 0; q < 4; ++q) dst[q] = (f32x4){a[4 * q], a[4 * q + 1], a[4 * q + 2], a[4 * q + 3]};
                HPART[(size_t)it * 3072 + col] = asum;
            }
        }
    }
}

__device__ __forceinline__ s16x4 vtr(const LAS unsigned char* p) { typedef short v4i16_t __attribute__((ext_vector_type(4))); return __builtin_bit_cast(s16x4, __builtin_amdgcn_ds_read_tr16_b64_v4i16((LAS v4i16_t*)p)); }
__device__ __forceinline__ void na_phase(const Ctx& cx, const bf16_t* PROJ, const float* rpb, bf16_t* CAT, const int tid) {
    const int lane = tid & 63, wid = __builtin_amdgcn_readfirstlane(tid >> 6), m16 = lane & 15, q4 = lane >> 4;
    LAS unsigned char* Kb = cx.lds; LAS unsigned char* Vb = cx.lds + 73728; LAS float* biasL = (LAS float*)(cx.lds + 147456);
    constexpr int PW = 2560;
    u32x4 kv[9], vv[9]; float bpre = 0.f; bf16x8 qn[2];
#define NA_LOAD(unit_) do { const int b_ = __builtin_amdgcn_readfirstlane((unit_) / 384), rem_ = __builtin_amdgcn_readfirstlane((unit_) % 384), h_ = rem_ >> 5, rp_ = rem_ & 31; int bs_ = 2 * rp_ - 4; bs_ = bs_ < 0 ? 0 : (bs_ > 56 ? 56 : bs_); bs_ = __builtin_amdgcn_readfirstlane(bs_); \
        _Pragma("unroll") for (int it = 0; it < 9; ++it) { const int i = tid + it * 512; const int brow = i >> 9, col = (i >> 3) & 63, ch = i & 7; int grow = bs_ + brow; grow = grow > 63 ? 63 : grow; \
            const size_t tok = (size_t)b_ * 4096 + grow * 64 + col; \
            kv[it] = *(const u32x4*)(PROJ + tok * PW + 768 + h_ * 64 + ch * 8); vv[it] = *(const u32x4*)(PROJ + tok * PW + 1536 + h_ * 64 + ch * 8); } \
        if (tid < 465) bpre = rpb[h_ * 465 + tid];   \
        { const size_t tq_ = (size_t)b_ * 4096 + (2 * rp_ + (wid >> 2)) * 64 + 16 * (wid & 3) + m16; \
          _Pragma("unroll") for (int kk = 0; kk < 2; ++kk) qn[kk] = *(const bf16x8*)(PROJ + tq_ * PW + h_ * 64 + 32 * kk + 8 * q4); } } while (0)
    int u0 = cx.vcu; asm volatile("" : "+s"(u0));
    if (u0 < 6144) NA_LOAD(u0);
    for (int unit = u0; unit < 6144; unit += cx.G) {
        const int b = unit / 384, rem = unit % 384, h = rem >> 5, rp = rem & 31;
        int bs = 2 * rp - 4; bs = bs < 0 ? 0 : (bs > 56 ? 56 : bs);
        __syncthreads();
#pragma unroll
        for (int it = 0; it < 9; ++it) { const int i = tid + it * 512; const int brow = i >> 9, col = (i >> 3) & 63, ch = i & 7;
            *(LAS u32x4*)(Kb + (brow * 64 + col) * 128 + ((ch ^ ((col >> 1) & 7)) << 4)) = kv[it];
            *(LAS u32x4*)(Vb + (brow * 64 + col) * 128 + ((ch ^ (col & 7)) << 4)) = vv[it]; }
        if (tid < 465) biasL[tid] = bpre * LOG2E;
        __syncthreads();
        bf16x8 qf[2]; qf[0] = qn[0]; qf[1] = qn[1];
        { const int un_ = (unit + cx.G < 6144) ? unit + cx.G : unit; NA_LOAD(un_); }
        const int r = 2 * rp + (wid >> 2), g = wid & 3;
        const int wc0 = (g == 0) ? 0 : (g == 1) ? 8 : (g == 2) ? 24 : 32;
        int r0 = r - 4; r0 = r0 < 0 ? 0 : (r0 > 56 ? 56 : r0); const int ro = r0 - bs;
        const int c = 16 * g + m16;
        const size_t tq = (size_t)b * 4096 + r * 64 + c;
        f32x4 S[16];
#pragma unroll
        for (int i = 0; i < 8; ++i)
#pragma unroll
            for (int ct = 0; ct < 2; ++ct) { const int col = wc0 + 16 * ct + m16; const LAS unsigned char* kp = Kb + ((ro + i) * 64 + col) * 128; const int sw = (col >> 1) & 7;
                f32x4 a = (f32x4){0.f, 0.f, 0.f, 0.f};
#pragma unroll
                for (int kk = 0; kk < 2; ++kk) { const bf16x8 kf = *(const LAS bf16x8*)(kp + (((q4 + 4 * kk) ^ sw) << 4)); a = __builtin_amdgcn_mfma_f32_16x16x32_bf16(kf, qf[kk], a, 0, 0, 0); }
                S[2 * i + ct] = a; }
        int c0 = c - 8; c0 = c0 < 0 ? 0 : (c0 > 48 ? 48 : c0);
        float mx = -INFINITY;
#pragma unroll
        for (int i = 0; i < 8; ++i)
#pragma unroll
            for (int ct = 0; ct < 2; ++ct)
#pragma unroll
                for (int v = 0; v < 4; ++v) { const int kc = wc0 + 16 * ct + 4 * q4 + v; const bool valid = (kc >= c0) && (kc < c0 + 16);
                    const int bidx = valid ? (r0 + i - r + 7) * 31 + (kc - c + 15) : 0;
                    const float s = valid ? S[2 * i + ct][v] + biasL[bidx] : -INFINITY; S[2 * i + ct][v] = s; mx = fmaxf(mx, s); }
        mx = fmaxf(mx, shflx(mx, 16, lane)); mx = fmaxf(mx, shflx(mx, 32, lane));
        float l = 0.f;
#pragma unroll
        for (int t = 0; t < 16; ++t)
#pragma unroll
            for (int v = 0; v < 4; ++v) { const float p = __builtin_amdgcn_exp2f(S[t][v] - mx); S[t][v] = p; l += p; }
        l += shflx(l, 16, lane); l += shflx(l, 32, lane);
        f32x4 O[4];
#pragma unroll
        for (int dt = 0; dt < 4; ++dt) O[dt] = (f32x4){0.f, 0.f, 0.f, 0.f};
        const int qq = m16 >> 2, pp = m16 & 3, col1 = wc0 + 4 * q4 + qq;
#pragma unroll
        for (int i = 0; i < 8; ++i) {
            u32x4 pw; pw.x = pk2(S[2 * i][0], S[2 * i][1]); pw.y = pk2(S[2 * i][2], S[2 * i][3]); pw.z = pk2(S[2 * i + 1][0], S[2 * i + 1][1]); pw.w = pk2(S[2 * i + 1][2], S[2 * i + 1][3]);
            const bf16x8 pb = __builtin_bit_cast(bf16x8, pw);
            const LAS unsigned char* v1 = Vb + ((ro + i) * 64 + col1) * 128 + 8 * (pp & 1);
            const LAS unsigned char* v2 = v1 + 16 * 128;
#pragma unroll
            for (int dt = 0; dt < 4; ++dt) { const int chunk = 2 * dt + (pp >> 1);
                const s16x4 lo = vtr(v1 + ((chunk ^ (col1 & 7)) << 4)), hi = vtr(v2 + ((chunk ^ ((col1 + 16) & 7)) << 4));
                const bf16x8 vf = (bf16x8){lo[0], lo[1], lo[2], lo[3], hi[0], hi[1], hi[2], hi[3]};
                O[dt] = __builtin_amdgcn_mfma_f32_16x16x32_bf16(vf, pb, O[dt], 0, 0, 0); }
        }
        const float inv = 1.0f / l;
#pragma unroll
        for (int dt = 0; dt < 4; ++dt) {
            if constexpr (OUTP_F8) { int w = 0; w = __builtin_amdgcn_cvt_pk_fp8_f32(O[dt][0] * inv, O[dt][1] * inv, w, false); w = __builtin_amdgcn_cvt_pk_fp8_f32(O[dt][2] * inv, O[dt][3] * inv, w, true); *(int*)((unsigned char*)CAT + tq * 1024 + h * 64 + 16 * dt + 4 * q4) = w; }
            else { u32x2 w; w.x = pk2(O[dt][0] * inv, O[dt][1] * inv); w.y = pk2(O[dt][2] * inv, O[dt][3] * inv); *(u32x2*)(CAT + tq * 1024 + h * 64 + 16 * dt + 4 * q4) = w; } }
    }
    __syncthreads();
}

#undef NA_LOAD
__device__ __forceinline__ void rope_phase(const Ctx& cx, const bf16_t* PROJ, const float* qg, const float* kg, bf16_t* QKR, const int tid) {
    const int lane = tid & 63, wave = __builtin_amdgcn_readfirstlane(tid >> 6);
    const int gw = cx.vcu * 8 + wave, NGW = cx.G * 8;
    const int d0 = (lane & 7) * 8;
    float gq[8], gk[8], invf[4];
#pragma unroll
    for (int e = 0; e < 8; ++e) { gq[e] = qg[d0 + e]; gk[e] = kg[d0 + e]; }
#pragma unroll
    for (int p = 0; p < 4; ++p) { const int i = (d0 >> 1) + p, j = i & 15; invf[p] = exp2f(-(float)(2 * j) / 32.0f * 13.287712379549449f); }
    const bool isrow = (d0 >> 1) < 16;
    for (int pos = gw; pos < SEQ; pos += NGW) {
        const float pr = isrow ? (float)(pos >> 6) : (float)(pos & 63);
        float cs[4], sn[4];
#pragma unroll
        for (int p = 0; p < 4; ++p) { const float a = pr * invf[p]; cs[p] = cosf(a); sn[p] = sinf(a); }
#pragma unroll 1
        for (int bg = 0; bg < BATCH; bg += 4) {
        u32x4 rawv[4][2];
#pragma unroll
        for (int bq = 0; bq < 4; ++bq)
#pragma unroll
            for (int half = 0; half < 2; ++half) rawv[bq][half] = *(const u32x4*)(PROJ + (size_t)((bg + bq) * SEQ + pos) * 1536 + half * 512 + lane * 8);
        __builtin_amdgcn_sched_barrier(0);
#pragma unroll
        for (int bq = 0; bq < 4; ++bq) { const int tok = (bg + bq) * SEQ + pos;
#pragma unroll
        for (int half = 0; half < 2; ++half) {
            const int e0 = half * 512 + lane * 8; const int head = e0 >> 6; const bool isq = head < 12;
            const u32x4 raw = rawv[bq][half];
            float x[8]; x[0] = bflo(raw.x); x[1] = bfhi(raw.x); x[2] = bflo(raw.y); x[3] = bfhi(raw.y); x[4] = bflo(raw.z); x[5] = bfhi(raw.z); x[6] = bflo(raw.w); x[7] = bfhi(raw.w);
            float ss = 0.f;
#pragma unroll
            for (int e = 0; e < 8; ++e) ss += x[e] * x[e];
            ss = group8_sum(ss);
            const float inv = rsqrtf(ss * (1.0f / 64.0f) + 1e-6f);
            float y[8];
#pragma unroll
            for (int e = 0; e < 8; ++e) y[e] = x[e] * inv * (isq ? gq[e] : gk[e]);
            const float sc = isq ? C2 : 1.0f;
            float o[8];
#pragma unroll
            for (int p = 0; p < 4; ++p) { o[2 * p] = (y[2 * p] * cs[p] - y[2 * p + 1] * sn[p]) * sc; o[2 * p + 1] = (y[2 * p] * sn[p] + y[2 * p + 1] * cs[p]) * sc; }
            u32x4 w; w.x = pk2(o[0], o[1]); w.y = pk2(o[2], o[3]); w.z = pk2(o[4], o[5]); w.w = pk2(o[6], o[7]);
            *(u32x4*)(QKR + (size_t)tok * 1024 + e0) = w;
        } } }
    }
}

__device__ __forceinline__ void sconv_phase(const Ctx& cx, const bf16_t* PROJ, const float* cw, const float* cb, bf16_t* UT3, unsigned char* V8, const int tid) {
    const int lane = tid & 63, wave = __builtin_amdgcn_readfirstlane(tid >> 6);
    const int gw = cx.vcu * 8 + wave, NGW = cx.G * 8;
    LAS unsigned short* tile = (LAS unsigned short*)(cx.lds + wave * 9216);
    constexpr int PW = 2560;
    for (int it = gw; it < 16 * 64 * 36; it += NGW) {
        const int ct = it % 36, tt = (it / 36) & 63, b = it / (36 * 64);
        const int col = ct * 64 + lane, t0 = tt * 64;
        const float w0 = cw[col], w1 = cw[2304 + col], w2 = cw[4608 + col], bia = cb[col];
        const bf16_t* src = PROJ + ((size_t)b * 4096 + t0) * PW + col;
        unsigned short uu[66];
        uu[0] = (t0 > 0) ? src[-(long)PW] : (unsigned short)0;
#pragma unroll
        for (int k = 0; k < 64; ++k) uu[k + 1] = src[(size_t)k * PW];
        uu[65] = (t0 + 64 < 4096) ? src[(size_t)64 * PW] : (unsigned short)0;
#pragma unroll
        for (int k = 0; k < 64; ++k) { const float v = bf2f(uu[k]) * w0 + bf2f(uu[k + 1]) * w1 + bf2f(uu[k + 2]) * w2 + bia; tile[lane * 72 + k] = (unsigned short)f2bf(v); }
        LDS_WAIT(); asm volatile("" ::: "memory");
        const int part = (ct * 64) / 768, cbase = (ct * 64) % 768;
#pragma unroll
        for (int k = 0; k < 8; ++k) { const int row = k * 8 + (lane >> 3), chn = lane & 7;
            const u32x4 v = *(const LAS u32x4*)((const LAS unsigned char*)tile + row * 144 + chn * 16);
            *(u32x4*)(UT3 + (((size_t)part * 16 + b) * 768 + cbase + row) * 4096 + t0 + chn * 8) = v;
            if (TCONV_F8 && part == 0) { int w0 = 0, w1 = 0;
                w0 = __builtin_amdgcn_cvt_pk_fp8_f32(bflo(v.x), bfhi(v.x), w0, false); w0 = __builtin_amdgcn_cvt_pk_fp8_f32(bflo(v.y), bfhi(v.y), w0, true);
                w1 = __builtin_amdgcn_cvt_pk_fp8_f32(bflo(v.z), bfhi(v.z), w1, false); w1 = __builtin_amdgcn_cvt_pk_fp8_f32(bflo(v.w), bfhi(v.w), w1, true);
                *(u32x2*)(V8 + ((size_t)b * 768 + cbase + row) * 4096 + t0 + chn * 8) = (u32x2){(unsigned)w0, (unsigned)w1}; } }
        LDS_WAIT(); asm volatile("" ::: "memory");
    }
}

constexpr int TZ_CS = 16384 + 64;
__device__ __forceinline__ void tconv_phase(const Ctx& cx, const int o, const bf16_t* UT, const bf16_t* GT, bf16_t* ZT, const float* lbias  , const int tid) {
    const int lane = tid & 63, wid = __builtin_amdgcn_readfirstlane(tid >> 6), m16 = lane & 15, q4 = lane >> 4;
    const float* HRAWT = (const float*)(cx.ws + WS_HRAWT); const float* HPART = (const float*)(cx.ws + WS_HPART);
    LAS unsigned char* cp = cx.lds; LAS float* red = (LAS float*)(cx.lds + 8 * TZ_CS);
    for (int c = cx.vcu; c < 768; c += cx.G) {
        __syncthreads();
        { const int dir = tid >> 8, blk = tid & 255; float v = HPART[(size_t)blk * 3072 + dir * 1536 + o * 768 + c]; v = wave_sum(v, lane); if (lane == 0) red[wid] = v; }
        __syncthreads();
        float nrm = 0.f;
#pragma unroll
        for (int w = 0; w < 8; ++w) nrm += red[w];
        const float inv = 1.0f / nrm;
        const float* hf = HRAWT + (size_t)(o * 768 + c) * 4096; const float* hb = HRAWT + (size_t)(1536 + o * 768 + c) * 4096;
        for (int i = tid; i < 8192; i += 512) { float v; if (i < 4096) v = hf[4095 - i]; else if (i < 8191) v = hb[i - 4095]; else v = 0.f;
            *(LAS unsigned short*)(cp + 2 * i) = (unsigned short)f2bf(v * inv); }
        __syncthreads();
#pragma unroll
        for (int j = 1; j < 8; ++j)
            for (int n = tid; n < 1024; n += 512) {
                const u32x4 lo = *(const LAS u32x4*)(cp + n * 16); u32x4 hi = (u32x4){0u, 0u, 0u, 0u}; if (n + 1 < 1024) hi = *(const LAS u32x4*)(cp + (n + 1) * 16);
                const unsigned w[8] = {lo.x, lo.y, lo.z, lo.w, hi.x, hi.y, hi.z, hi.w}; u32x4 r;
                const int a = j >> 1;
                if (j & 1) { r.x = (w[a] >> 16) | (w[a + 1] << 16); r.y = (w[a + 1] >> 16) | (w[a + 2] << 16); r.z = (w[a + 2] >> 16) | (w[a + 3] << 16); r.w = (w[a + 3] >> 16) | (w[a + 4] << 16); }
                else { r.x = w[a]; r.y = w[a + 1]; r.z = w[a + 2]; r.w = w[a + 3]; }
                *(LAS u32x4*)(cp + j * TZ_CS + n * 16) = r;
            }
        __syncthreads();
        const int j = (7 - m16) & 7;
        const int nbase = (4095 - 512 * wid - m16 - j + 8 * q4) >> 3;
        const LAS unsigned char* ap = cp + j * TZ_CS + (nbase - 62) * 16;
        const bf16_t* up = UT + ((size_t)m16 * 768 + c) * 4096 + 8 * q4;
        f32x4 acc[32];
#pragma unroll
        for (int ti = 0; ti < 32; ++ti) acc[ti] = (f32x4){0.f, 0.f, 0.f, 0.f};
        bf16x8 bcur = *(const bf16x8*)(up);
        bf16x8 afA[8], afB[8];
#pragma unroll
        for (int i = 0; i < 8; ++i) afA[i] = *(const LAS bf16x8*)(ap + (31 - i) * 32);
        for (int ks = 0; ks < 128; ++ks) {
            const bf16x8 bnext = *(const bf16x8*)(up + ((ks + 1) & 127) * 32);
            const LAS unsigned char* a0 = ap + ks * 64;
            const LAS unsigned char* a1 = ap + ((ks + 1) & 127) * 64;
#define TZ_LD(dst, base, g) do { _Pragma("unroll") for (int i = 0; i < 8; ++i) dst[i] = *(const LAS bf16x8*)((base) + (31 - (8 * (g) + i)) * 32); } while (0)
#define TZ_MM(src, g) do { _Pragma("unroll") for (int i = 0; i < 8; ++i) acc[8 * (g) + i] = __builtin_amdgcn_mfma_f32_16x16x32_bf16(src[i], bcur, acc[8 * (g) + i], 0, 0, 0); } while (0)
            TZ_LD(afB, a0, 1); TZ_MM(afA, 0); __builtin_amdgcn_sched_barrier(0);
            TZ_LD(afA, a0, 2); TZ_MM(afB, 1); __builtin_amdgcn_sched_barrier(0);
            TZ_LD(afB, a0, 3); TZ_MM(afA, 2); __builtin_amdgcn_sched_barrier(0);
            TZ_LD(afA, a1, 0); TZ_MM(afB, 3); __builtin_amdgcn_sched_barrier(0);
#undef TZ_LD
#undef TZ_MM
            bcur = bnext;
        }
        const float lb = lbias[c];
        const size_t rowoff = ((size_t)m16 * 768 + c) * 4096 + 512 * wid + 4 * q4;
#pragma unroll
        for (int ti = 0; ti < 32; ++ti) {
            const u32x2 uu = *(const u32x2*)(UT + rowoff + 16 * ti), gg = *(const u32x2*)(GT + rowoff + 16 * ti);
            const float y0 = (acc[ti][0] + lb * bflo(uu.x)) * bflo(gg.x), y1 = (acc[ti][1] + lb * bfhi(uu.x)) * bfhi(gg.x), y2 = (acc[ti][2] + lb * bflo(uu.y)) * bflo(gg.y), y3 = (acc[ti][3] + lb * bfhi(uu.y)) * bfhi(gg.y);
            u32x2 w; w.x = pk2(y0, y1); w.y = pk2(y2, y3);
            *(u32x2*)(ZT + rowoff + 16 * ti) = w;
            if ((ti & 7) == 7) __builtin_amdgcn_sched_barrier(0);
        }
    }
    __syncthreads();
}

constexpr int T8_CS = 8192 + 256;
__host__ __device__ constexpr int t8_sig(int j) { return j < 4 ? 2 * j : (j >= 12 ? 2 * (j - 8) : 2 * (j - 4) + 1); }
__device__ __forceinline__ float wave_max_nn(float v) {
    v = fmaxf(v, dpp_x<0xB1>(v)); v = fmaxf(v, dpp_x<0x4E>(v)); v = fmaxf(v, dpp_x<0x141>(v)); v = fmaxf(v, dpp_x<0x140>(v));
    v = fmaxf(v, __builtin_bit_cast(float, __builtin_amdgcn_update_dpp(0, __builtin_bit_cast(int, v), 0x142, 0xA, 0xF, false)));
    v = fmaxf(v, __builtin_bit_cast(float, __builtin_amdgcn_update_dpp(0, __builtin_bit_cast(int, v), 0x143, 0xC, 0xF, false)));
    return __builtin_bit_cast(float, __builtin_amdgcn_readlane(__builtin_bit_cast(int, v), 63));
}
__device__ __forceinline__ void tconv8_phase(const Ctx& cx, const int o, const bf16_t* UT, const unsigned char* U8, const bf16_t* GT, bf16_t* ZT, unsigned char* Z8  ,
                                             const float* lbias, const int tid) {
    const int lane = tid & 63, wid = __builtin_amdgcn_readfirstlane(tid >> 6), m16 = lane & 15, q4 = lane >> 4;
    const float* HRAWT = (const float*)(cx.ws + WS_HRAWT); const float* HPART = (const float*)(cx.ws + WS_HPART);
    LAS unsigned char* cp = cx.lds; LAS float* red = (LAS float*)(cx.lds + 16 * T8_CS);
    for (int c = cx.vcu; c < 768; c += cx.G) {
        __syncthreads();
        const float* hf = HRAWT + (size_t)(o * 768 + c) * 4096; const float* hb = HRAWT + (size_t)(1536 + o * 768 + c) * 4096;
        float tap[16]; float mx = 0.f;
        int t3 = tid; asm volatile("" : "+v"(t3));
#pragma unroll
        for (int k = 0; k < 16; ++k) { const int i = t3 * 16 + k; float v; if (i < 4096) v = hf[4095 - i]; else if (i < 8191) v = hb[i - 4095]; else v = 0.f; tap[k] = v; mx = fmaxf(mx, fabsf(v)); }
        { const int dir = tid >> 8, blk = tid & 255; float v = HPART[(size_t)blk * 3072 + dir * 1536 + o * 768 + c]; v = wave_sum(v, lane); mx = wave_max_nn(mx); if (lane == 0) { red[wid] = v; red[8 + wid] = mx; } }
        __syncthreads();
        float nrm = 0.f, mall = 0.f;
#pragma unroll
        for (int w = 0; w < 8; ++w) { nrm += red[w]; mall = fmaxf(mall, red[8 + w]); }
        const float inv = 1.0f / nrm;
        int ex; (void)frexpf(fmaxf(mall * inv, 1e-30f), &ex);
        const float fsc = ldexpf(1.0f, 7 - ex), unsc = ldexpf(1.0f, ex - 7), tsc = inv * fsc;
        { unsigned w[4];
#pragma unroll
          for (int q = 0; q < 4; ++q) { int r = 0; r = __builtin_amdgcn_cvt_pk_fp8_f32(tap[4 * q] * tsc, tap[4 * q + 1] * tsc, r, false); r = __builtin_amdgcn_cvt_pk_fp8_f32(tap[4 * q + 2] * tsc, tap[4 * q + 3] * tsc, r, true); w[q] = (unsigned)r; }
          *(LAS u32x4*)(cp + tid * 16) = (u32x4){w[0], w[1], w[2], w[3]}; }
        __syncthreads();
        { const u32x4 lo = *(const LAS u32x4*)(cp + tid * 16); u32x4 hi = (u32x4){0u, 0u, 0u, 0u}; if (tid + 1 < 512) hi = *(const LAS u32x4*)(cp + (tid + 1) * 16);
          const unsigned w[8] = {lo.x, lo.y, lo.z, lo.w, hi.x, hi.y, hi.z, hi.w};
#pragma unroll
          for (int j = 1; j < 16; ++j) { u32x4 r; const int a = j >> 2, sh = j & 3;
              r.x = sh ? __builtin_amdgcn_alignbyte(w[a + 1], w[a], sh) : w[a]; r.y = sh ? __builtin_amdgcn_alignbyte(w[a + 2], w[a + 1], sh) : w[a + 1];
              r.z = sh ? __builtin_amdgcn_alignbyte(w[a + 3], w[a + 2], sh) : w[a + 2]; r.w = sh ? __builtin_amdgcn_alignbyte(w[a + 4], w[a + 3], sh) : w[a + 3];
              *(LAS u32x4*)(cp + j * T8_CS + t8_sig(j) * 16 + tid * 16) = r; } }
        __syncthreads();
        const int jc = 15 - m16;
        const int nbase = 255 - 32 * wid + 2 * q4;
        const LAS unsigned char* ap = cp + jc * T8_CS + t8_sig(jc) * 16 + (nbase - 31) * 16;
        const unsigned char* up = U8 + ((size_t)m16 * 768 + c) * 4096 + 32 * q4;
        f32x4 acc[32];
#pragma unroll
        for (int ti = 0; ti < 32; ++ti) acc[ti] = (f32x4){0.f, 0.f, 0.f, 0.f};
        typedef int v8i_t __attribute__((ext_vector_type(8))); typedef int v4i_t __attribute__((ext_vector_type(4)));
#define T8_FRAG(p) __builtin_shufflevector(*(const LAS v4i_t*)(p), *(const LAS v4i_t*)((p) + 16), 0, 1, 2, 3, 4, 5, 6, 7)
        v8i_t bcur = __builtin_shufflevector(*(const v4i_t*)(up), *(const v4i_t*)(up + 16), 0, 1, 2, 3, 4, 5, 6, 7);
        v8i_t afA[4], afB[4];
#pragma unroll
        for (int i = 0; i < 4; ++i) afA[i] = T8_FRAG(ap + (31 - i) * 16);
        for (int ks = 0; ks < 32; ++ks) {
            const unsigned char* un = up + ((ks + 1) & 31) * 128;
            const v8i_t bnext = __builtin_shufflevector(*(const v4i_t*)(un), *(const v4i_t*)(un + 16), 0, 1, 2, 3, 4, 5, 6, 7);
            const LAS unsigned char* a0 = ap + ks * 128;
            const LAS unsigned char* a1 = ap + ((ks + 1) & 31) * 128;
#define T8_LD(dst, base, g) do { _Pragma("unroll") for (int i = 0; i < 4; ++i) dst[i] = T8_FRAG((base) + (31 - (4 * (g) + i)) * 16); } while (0)
#define T8_MM(src, g) do { _Pragma("unroll") for (int i = 0; i < 4; ++i) acc[4 * (g) + i] = __builtin_amdgcn_mfma_scale_f32_16x16x128_f8f6f4(src[i], bcur, acc[4 * (g) + i], 0, 0, 0, 0, 0, 0); } while (0)
            T8_LD(afB, a0, 1); T8_MM(afA, 0); __builtin_amdgcn_sched_barrier(0);
            T8_LD(afA, a0, 2); T8_MM(afB, 1); __builtin_amdgcn_sched_barrier(0);
            T8_LD(afB, a0, 3); T8_MM(afA, 2); __builtin_amdgcn_sched_barrier(0);
            T8_LD(afA, a0, 4); T8_MM(afB, 3); __builtin_amdgcn_sched_barrier(0);
            T8_LD(afB, a0, 5); T8_MM(afA, 4); __builtin_amdgcn_sched_barrier(0);
            T8_LD(afA, a0, 6); T8_MM(afB, 5); __builtin_amdgcn_sched_barrier(0);
            T8_LD(afB, a0, 7); T8_MM(afA, 6); __builtin_amdgcn_sched_barrier(0);
            T8_LD(afA, a1, 0); T8_MM(afB, 7); __builtin_amdgcn_sched_barrier(0);
#undef T8_LD
#undef T8_MM
            bcur = bnext;
        }
#undef T8_FRAG
        const float lb = lbias[c];
        const size_t rowoff = ((size_t)m16 * 768 + c) * 4096 + 512 * wid + 4 * q4;
#pragma unroll
        for (int ti = 0; ti < 32; ++ti) {
            const u32x2 uu = *(const u32x2*)(UT + rowoff + 16 * ti), gg = *(const u32x2*)(GT + rowoff + 16 * ti);
            const float y0 = (acc[ti][0] * unsc + lb * bflo(uu.x)) * bflo(gg.x), y1 = (acc[ti][1] * unsc + lb * bfhi(uu.x)) * bfhi(gg.x), y2 = (acc[ti][2] * unsc + lb * bflo(uu.y)) * bflo(gg.y), y3 = (acc[ti][3] * unsc + lb * bfhi(uu.y)) * bfhi(gg.y);
            u32x2 w; w.x = pk2(y0, y1); w.y = pk2(y2, y3);
            *(u32x2*)(ZT + rowoff + 16 * ti) = w;
            if (Z8) { int w8 = 0; w8 = __builtin_amdgcn_cvt_pk_fp8_f32(fminf(fmaxf(y0, -440.f), 440.f), fminf(fmaxf(y1, -440.f), 440.f), w8, false); w8 = __builtin_amdgcn_cvt_pk_fp8_f32(fminf(fmaxf(y2, -440.f), 440.f), fminf(fmaxf(y3, -440.f), 440.f), w8, true);
                *(int*)(Z8 + rowoff + 16 * ti) = w8; }
            if ((ti & 7) == 7) __builtin_amdgcn_sched_barrier(0);
        }
    }
    __syncthreads();
}

__device__ __forceinline__ void tback_phase(const Ctx& cx, const bf16_t* ZT, bf16_t* CAT, const int tid) {
    const int lane = tid & 63, wave = __builtin_amdgcn_readfirstlane(tid >> 6);
    const int gw = cx.vcu * 8 + wave, NGW = cx.G * 8;
    LAS unsigned char* tile = cx.lds + wave * 9216;
    for (int it = gw; it < 16 * 12 * 64; it += NGW) {
        const int tt = it & 63, ct = (it >> 6) % 12, b = it / (64 * 12);
        const int c0 = ct * 64, t0 = tt * 64;
        u32x4 vv[8];
#pragma unroll
        for (int k = 0; k < 8; ++k) { const int row = k * 8 + (lane >> 3), chn = lane & 7; vv[k] = *(const u32x4*)(ZT + ((size_t)b * 768 + c0 + row) * 4096 + t0 + chn * 8); }
        __builtin_amdgcn_sched_barrier(0);
#pragma unroll
        for (int k = 0; k < 8; ++k) { const int row = k * 8 + (lane >> 3), chn = lane & 7; *(LAS u32x4*)(tile + row * 144 + chn * 16) = vv[k]; }
        LDS_WAIT(); asm volatile("" ::: "memory");
        if constexpr (OUTP_F8) { unsigned char* dst = (unsigned char*)CAT + ((size_t)b * 4096 + t0) * 1024 + c0 + lane;
#pragma unroll 8
            for (int k = 0; k < 64; ++k) { const float v = bf2f(*(const LAS unsigned short*)(tile + lane * 144 + k * 2)); dst[(size_t)k * 1024] = f2fp8(fminf(fmaxf(v, -440.0f), 440.0f)); }
        } else { bf16_t* dst = CAT + ((size_t)b * 4096 + t0) * 1024 + c0 + lane;
#pragma unroll 8
            for (int k = 0; k < 64; ++k) dst[(size_t)k * 1024] = *(const LAS unsigned short*)(tile + lane * 144 + k * 2); }
        LDS_WAIT(); asm volatile("" ::: "memory");
    }
}

__device__ __forceinline__ void ln1_group(const int bt, const int chunk, const int wave, const int lane, const int r16, const int q4, const bf16_t* XI, bf16_t* XO, bf16_t* XB, const float* g, const float* bta,
                                          const LAS unsigned char* Wh, const LAS unsigned char* Wl, LAS float* lg, LAS int* lcnt, const float rb0, const float rb1, float* gate, unsigned (&pk)[2], unsigned (&gp)[2], const LAS float* gl) {
    constexpr int WP = 2064;
            const size_t rowU = (size_t)chunk * 256 + wave * 32 + bt * 16;
            unsigned loff = (unsigned)(r16 * 1024 + 8 * q4); asm volatile("" : "+v"(loff));
            const GAS bf16_t* src = (const GAS bf16_t*)XI + rowU * 1024 + loff;
            constexpr int HOLD = LN1_HOLD;
            u32x4 raw[HOLD > 0 ? HOLD : 1], rawt[32 - HOLD]; float s = 0.f, ss = 0.f;
#pragma unroll
            for (int i = 0; i < 32; ++i) { if (i < HOLD) raw[i] = *(const GAS u32x4*)(src + 32 * i); else rawt[i - HOLD] = *(const GAS u32x4*)(src + 32 * i); }
#pragma unroll
            for (int i = 0; i < 32; ++i) { const u32x4 rr = (i < HOLD) ? raw[i < HOLD ? i : 0] : rawt[i < HOLD ? 0 : i - HOLD]; const float x0 = bflo(rr.x), x1 = bfhi(rr.x), x2 = bflo(rr.y), x3 = bfhi(rr.y), x4 = bflo(rr.z), x5 = bfhi(rr.z), x6 = bflo(rr.w), x7 = bfhi(rr.w);
                s += ((x0 + x1) + (x2 + x3)) + ((x4 + x5) + (x6 + x7)); ss += ((x0 * x0 + x1 * x1) + (x2 * x2 + x3 * x3)) + ((x4 * x4 + x5 * x5) + (x6 * x6 + x7 * x7)); }
            lg[2 * lane] = s; lg[2 * lane + 1] = ss; LDS_WAIT(); asm volatile("" ::: "memory");
            s = (lg[2 * r16] + lg[2 * (r16 + 16)]) + (lg[2 * (r16 + 32)] + lg[2 * (r16 + 48)]); ss = (lg[2 * r16 + 1] + lg[2 * (r16 + 16) + 1]) + (lg[2 * (r16 + 32) + 1] + lg[2 * (r16 + 48) + 1]);
            LDS_WAIT(); asm volatile("" ::: "memory");
            const float mean = s * (1.0f / 1024.0f), rstd = rsqrtf(fmaxf(ss * (1.0f / 1024.0f) - mean * mean, 0.f) + LN_EPS);
            f32x4 a0 = (f32x4){0.f, 0.f, 0.f, 0.f}, a1 = (f32x4){0.f, 0.f, 0.f, 0.f};
            const LAS unsigned char* wh0 = Wh + r16 * WP + 16 * q4; const LAS unsigned char* wl0 = Wl + r16 * WP + 16 * q4;
            GAS bf16_t* dsto = (GAS bf16_t*)XO + rowU * 1024 + loff; GAS unsigned char* dst8 = (GAS unsigned char*)XB + rowU * 1024 + loff;
            const LAS float* glq = gl + 8 * q4;
            u32x4 nx_ = (u32x4){0u, 0u, 0u, 0u}; if (HOLD == 0) nx_ = *(const GAS u32x4*)(src);
#pragma unroll
            for (int i = 0; i < 32; ++i) {
                u32x4 rw_; if (i < HOLD) rw_ = raw[i < HOLD ? i : 0]; else rw_ = nx_;
                if (i + 1 < 32 && i + 1 >= HOLD) nx_ = *(const GAS u32x4*)(src + 32 * (i + 1));
                asm volatile("" : "+v"(rw_));
                const f32x4 g0 = *(const LAS f32x4*)(glq + 32 * i), g1 = *(const LAS f32x4*)(glq + 32 * i + 4), b0 = *(const LAS f32x4*)(glq + 1024 + 32 * i), b1 = *(const LAS f32x4*)(glq + 1024 + 32 * i + 4);
                float y[8]; y[0] = bflo(rw_.x); y[1] = bfhi(rw_.x); y[2] = bflo(rw_.y); y[3] = bfhi(rw_.y); y[4] = bflo(rw_.z); y[5] = bfhi(rw_.z); y[6] = bflo(rw_.w); y[7] = bfhi(rw_.w);
#pragma unroll
                for (int q = 0; q < 8; ++q) y[q] = (y[q] - mean) * rstd * (q < 4 ? g0[q & 3] : g1[q & 3]) + (q < 4 ? b0[q & 3] : b1[q & 3]);
                u32x4 hi; hi.x = pk2(y[0], y[1]); hi.y = pk2(y[2], y[3]); hi.z = pk2(y[4], y[5]); hi.w = pk2(y[6], y[7]);
                *(GAS u32x4*)(dsto + 32 * i) = hi;
                if constexpr (MOE_F8) { int w0 = 0, w1 = 0; w0 = __builtin_amdgcn_cvt_pk_fp8_f32(y[0], y[1], w0, false); w0 = __builtin_amdgcn_cvt_pk_fp8_f32(y[2], y[3], w0, true); w1 = __builtin_amdgcn_cvt_pk_fp8_f32(y[4], y[5], w1, false); w1 = __builtin_amdgcn_cvt_pk_fp8_f32(y[6], y[7], w1, true);
                    *(GAS u32x2*)(dst8 + 32 * i) = (u32x2){(unsigned)w0, (unsigned)w1}; }
                else { *(u32x4*)((bf16_t*)XB + rowU * 1024 + loff + 32 * i) = hi; }
                u32x4 lo; lo.x = pk2(y[0] - bflo(hi.x), y[1] - bfhi(hi.x)); lo.y = pk2(y[2] - bflo(hi.y), y[3] - bfhi(hi.y)); lo.z = pk2(y[4] - bflo(hi.z), y[5] - bfhi(hi.z)); lo.w = pk2(y[6] - bflo(hi.w), y[7] - bfhi(hi.w));
                const bf16x8 ah = __builtin_bit_cast(bf16x8, hi), al = __builtin_bit_cast(bf16x8, lo);
                const bf16x8 wh_0 = *(const LAS bf16x8*)(wh0 + 64 * i), wh_1 = *(const LAS bf16x8*)(wh0 + 16 * WP + 64 * i), wl_0 = *(const LAS bf16x8*)(wl0 + 64 * i), wl_1 = *(const LAS bf16x8*)(wl0 + 16 * WP + 64 * i);
                a0 = __builtin_amdgcn_mfma_f32_16x16x32_bf16(ah, wh_0, a0, 0, 0, 0); a1 = __builtin_amdgcn_mfma_f32_16x16x32_bf16(ah, wh_1, a1, 0, 0, 0);
                a0 = __builtin_amdgcn_mfma_f32_16x16x32_bf16(al, wh_0, a0, 0, 0, 0); a1 = __builtin_amdgcn_mfma_f32_16x16x32_bf16(al, wh_1, a1, 0, 0, 0);
                a0 = __builtin_amdgcn_mfma_f32_16x16x32_bf16(ah, wl_0, a0, 0, 0, 0); a1 = __builtin_amdgcn_mfma_f32_16x16x32_bf16(ah, wl_1, a1, 0, 0, 0);
                asm volatile("" :: "v"(ah), "v"(al), "v"(wh_0), "v"(wh_1), "v"(wl_0), "v"(wl_1));
                __builtin_amdgcn_sched_barrier(0);
            }
#pragma unroll
            for (int v = 0; v < 4; ++v) { lg[(4 * q4 + v) * 33 + r16] = a0[v] + rb0; lg[(4 * q4 + v) * 33 + r16 + 16] = a1[v] + rb1; }
            LDS_WAIT(); asm volatile("" ::: "memory");
            if (lane < 16) {
                const LAS float* myl = lg + lane * 33; const size_t rowt = (size_t)chunk * 256 + wave * 32 + bt * 16 + lane;
                float tv[4]; int te[4]; int t0 = -1, t1 = -1, t2 = -1;
#pragma unroll
                for (int k = 0; k < 4; ++k) { float best = -INFINITY; int bi = 0;
                    for (int e = 0; e < 32; ++e) { const float v = myl[e]; const bool ok = (e != t0) && (e != t1) && (e != t2); if (ok && v > best) { best = v; bi = e; } }
                    tv[k] = best; te[k] = bi; if (k == 0) t0 = bi; else if (k == 1) t1 = bi; else if (k == 2) t2 = bi; }
                const float e1 = __expf(tv[1] - tv[0]), e2 = __expf(tv[2] - tv[0]), e3 = __expf(tv[3] - tv[0]); const float isum = 1.0f / (1.0f + e1 + e2 + e3);
                const float gk[4] = {isum, e1 * isum, e2 * isum, e3 * isum};
                pk[0] = 0u; pk[1] = 0u;
#pragma unroll
                for (int k = 0; k < 4; ++k) { const int rk = __hip_atomic_fetch_add(lcnt + te[k], 1, __ATOMIC_RELAXED, __HIP_MEMORY_SCOPE_WORKGROUP); pk[k >> 1] |= (unsigned)((te[k] << 11) | rk) << (16 * (k & 1)); }
                gp[0] = pk2(gk[0], gk[1]); gp[1] = pk2(gk[2], gk[3]); (void)rowt; (void)gate;
            }
            LDS_WAIT(); asm volatile("" ::: "memory");
}
__device__ __forceinline__ void ln1_router_phase(const Ctx& cx, const bf16_t* XI, bf16_t* XO, bf16_t* XB, const float* g, const float* bta, const float* rw, const float* rb,
                                                 unsigned* cnt, int* expid, float* gate, int* idx, float* gidx, const int tid) {
    const int lane = tid & 63, wave = __builtin_amdgcn_readfirstlane(tid >> 6), r16 = lane & 15, q4 = lane >> 4;
    constexpr int WP = 2064;
    LAS unsigned char* Wh = cx.lds; LAS unsigned char* Wl = cx.lds + 32 * WP; LAS int* lcnt = (LAS int*)(cx.lds + 64 * WP); LAS int* lbase = lcnt + 32; LAS float* lg = (LAS float*)(cx.lds + 64 * WP + 256 + wave * 2112);
    __syncthreads();
    { const u32x4* rsrc = (const u32x4*)rw; u32x4 wv[16];
#pragma unroll
      for (int u = 0; u < 16; ++u) wv[u] = rsrc[tid + 512 * u];
#pragma unroll
      for (int u = 0; u < 16; ++u) { const int idx = tid + 512 * u; *(LAS u32x4*)(Wh + (idx >> 7) * WP + (idx & 127) * 16) = wv[u]; } }
    if (tid < 256) { LAS float* gf = (LAS float*)(cx.lds + 151552); *(LAS f32x4*)(gf + 4 * tid) = *(const f32x4*)(g + 4 * tid); *(LAS f32x4*)(gf + 1024 + 4 * tid) = *(const f32x4*)(bta + 4 * tid); }
    if (tid < 32) lcnt[tid] = 0;
    LAS float* gl = (LAS float*)(cx.lds + 151552);
    const float rb0 = rb[r16], rb1 = rb[r16 + 16];
    __syncthreads();
    for (int chunk = cx.vcu; chunk < NTOK / 256; chunk += cx.G) {
        unsigned pk0[2] = {0u, 0u}, pk1[2] = {0u, 0u}, gp0[2] = {0u, 0u}, gp1[2] = {0u, 0u};
        ln1_group(0, chunk, wave, lane, r16, q4, XI, XO, XB, g, bta, Wh, Wl, lg, lcnt, rb0, rb1, gate, pk0, gp0, gl);
        ln1_group(1, chunk, wave, lane, r16, q4, XI, XO, XB, g, bta, Wh, Wl, lg, lcnt, rb0, rb1, gate, pk1, gp1, gl);
        __syncthreads();
        { const int t2 = wave * 64 + lane_id_volatile();
          if (t2 < 32) { lbase[t2] = (int)__hip_atomic_fetch_add(cnt + t2, (unsigned)lcnt[t2], __ATOMIC_RELAXED, __HIP_MEMORY_SCOPE_AGENT); } }
        __syncthreads();
        const int ln_ = lane_id_volatile();
        if (ln_ < 16) {
            { const int slot0 = (chunk * 256 + wave * 32 + ln_) * 4;
#pragma unroll
                for (int k = 0; k < 4; ++k) { const unsigned p = (pk0[k >> 1] >> (16 * (k & 1))) & 0xffffu; const int e = (int)(p >> 11), rk = (int)(p & 0x7ffu); const size_t o_ = (size_t)e * IDXCAP + lbase[e] + rk; idx[o_] = slot0 + k; gidx[o_] = (k & 1) ? bfhi(gp0[k >> 1]) : bflo(gp0[k >> 1]); } }
            { const int slot0 = (chunk * 256 + wave * 32 + 16 + ln_) * 4;
#pragma unroll
                for (int k = 0; k < 4; ++k) { const unsigned p = (pk1[k >> 1] >> (16 * (k & 1))) & 0xffffu; const int e = (int)(p >> 11), rk = (int)(p & 0x7ffu); const size_t o_ = (size_t)e * IDXCAP + lbase[e] + rk; idx[o_] = slot0 + k; gidx[o_] = (k & 1) ? bfhi(gp1[k >> 1]) : bflo(gp1[k >> 1]); } }
        }
        __syncthreads();
        { const int t3 = wave * 64 + lane_id_volatile(); if (t3 < 32) lcnt[t3] = 0; }
        __syncthreads();
    }
}

__device__ __forceinline__ void ln2_phase(const Ctx& cx, const bf16_t* X1, const bf16_t* Y, bf16_t* XO, bf16_t* XB, float* OUT, const float* g, const float* bta, const int tid) {
    const int lane = tid & 63, wave = __builtin_amdgcn_readfirstlane(tid >> 6);
    const int gw = cx.vcu * 8 + wave, NGW = cx.G * 8;
    if constexpr (Y_F8) {
        f32x4 gv[4], bv[4];
#pragma unroll
        for (int j = 0; j < 4; ++j) { gv[j] = *(const f32x4*)(g + 16 * lane + 4 * j); bv[j] = *(const f32x4*)(bta + 16 * lane + 4 * j); }
        for (int rp = gw; rp < NTOK / 2; rp += NGW) {
            u32x4 xa[2][2], ya[2][4];
#pragma unroll
            for (int r = 0; r < 2; ++r) { const size_t row = (size_t)rp * 2 + r;
                xa[r][0] = *(const u32x4*)(X1 + row * 1024 + 16 * lane); xa[r][1] = *(const u32x4*)(X1 + row * 1024 + 16 * lane + 8);
#pragma unroll
                for (int k = 0; k < 4; ++k) ya[r][k] = *(const u32x4*)((const unsigned char*)Y + (row * 4 + k) * 1024 + 16 * lane); }
            float v[2][16]; float s[2] = {0.f, 0.f};
#pragma unroll
            for (int r = 0; r < 2; ++r) {
#pragma unroll
                for (int i = 0; i < 4; ++i) { f32x2 lo = __builtin_amdgcn_cvt_pk_f32_fp8((int)ya[r][0][i], false), hi = __builtin_amdgcn_cvt_pk_f32_fp8((int)ya[r][0][i], true);
#pragma unroll
                    for (int k = 1; k < 4; ++k) { lo += __builtin_amdgcn_cvt_pk_f32_fp8((int)ya[r][k][i], false); hi += __builtin_amdgcn_cvt_pk_f32_fp8((int)ya[r][k][i], true); }
                    const unsigned xlo = xa[r][i >> 1][(i & 1) * 2], xhi = xa[r][i >> 1][(i & 1) * 2 + 1];
                    v[r][4 * i + 0] = bflo(xlo) * DN_ALPHA + lo[0] * (1.0f / Y_SCALE); v[r][4 * i + 1] = bfhi(xlo) * DN_ALPHA + lo[1] * (1.0f / Y_SCALE);
                    v[r][4 * i + 2] = bflo(xhi) * DN_ALPHA + hi[0] * (1.0f / Y_SCALE); v[r][4 * i + 3] = bfhi(xhi) * DN_ALPHA + hi[1] * (1.0f / Y_SCALE);
                    s[r] += (v[r][4 * i] + v[r][4 * i + 1]) + (v[r][4 * i + 2] + v[r][4 * i + 3]); } }
            const float mean0 = wave_sum(s[0], lane) * (1.0f / 1024.0f), mean1 = wave_sum(s[1], lane) * (1.0f / 1024.0f); float q[2] = {0.f, 0.f};
#pragma unroll
            for (int r = 0; r < 2; ++r)
#pragma unroll
                for (int e = 0; e < 16; ++e) { v[r][e] -= (r == 0 ? mean0 : mean1); q[r] += v[r][e] * v[r][e]; }
            const float rstd0 = rsqrtf(wave_sum(q[0], lane) * (1.0f / 1024.0f) + LN_EPS), rstd1 = rsqrtf(wave_sum(q[1], lane) * (1.0f / 1024.0f) + LN_EPS);
            unsigned wb[2][8]; unsigned w8[2][4];
#pragma unroll
            for (int j = 0; j < 4; ++j) { const f32x4 gvj = gv[j], bvj = bv[j];
#pragma unroll
                for (int r = 0; r < 2; ++r) { const size_t row = (size_t)rp * 2 + r; const float rs = (r == 0 ? rstd0 : rstd1);
                    const f32x4 o = (f32x4){v[r][4 * j], v[r][4 * j + 1], v[r][4 * j + 2], v[r][4 * j + 3]} * rs * gvj + bvj;
                    if (OUT) *(f32x4*)(OUT + row * 1024 + 16 * lane + 4 * j) = o;
                    else { wb[r][2 * j] = pk2(o[0], o[1]); wb[r][2 * j + 1] = pk2(o[2], o[3]);
                        int t8 = 0; t8 = __builtin_amdgcn_cvt_pk_fp8_f32(o[0], o[1], t8, false); t8 = __builtin_amdgcn_cvt_pk_fp8_f32(o[2], o[3], t8, true); w8[r][j] = (unsigned)t8; } } }
            if (!OUT) {
#pragma unroll
                for (int r = 0; r < 2; ++r) { const size_t row = (size_t)rp * 2 + r;
                    *(u32x4*)(XO + row * 1024 + 16 * lane) = (u32x4){wb[r][0], wb[r][1], wb[r][2], wb[r][3]}; *(u32x4*)(XO + row * 1024 + 16 * lane + 8) = (u32x4){wb[r][4], wb[r][5], wb[r][6], wb[r][7]};
                    if constexpr (INP_F8) *(u32x4*)((unsigned char*)XB + row * 1024 + 16 * lane) = (u32x4){w8[r][0], w8[r][1], w8[r][2], w8[r][3]};
                    else { *(u32x4*)(XB + row * 1024 + 16 * lane) = (u32x4){wb[r][0], wb[r][1], wb[r][2], wb[r][3]}; *(u32x4*)(XB + row * 1024 + 16 * lane + 8) = (u32x4){wb[r][4], wb[r][5], wb[r][6], wb[r][7]}; } } }
        }
        return;
    }
    for (int rp = gw; rp < NTOK / 2; rp += NGW) {
        f32x4 v[2][4]; float s[2] = {0.f, 0.f};
#pragma unroll
        for (int r = 0; r < 2; ++r) { const size_t row = (size_t)rp * 2 + r;
#pragma unroll
            for (int j = 0; j < 4; ++j) { const u32x2 a = *(const u32x2*)(X1 + row * 1024 + 4 * lane + 256 * j); v[r][j] = (f32x4){bflo(a.x), bfhi(a.x), bflo(a.y), bfhi(a.y)} * DN_ALPHA;
#pragma unroll
                for (int k = 0; k < 4; ++k) {
                    if constexpr (Y_F8) { const int y8 = *(const int*)((const unsigned char*)Y + (row * 4 + k) * 1024 + 4 * lane + 256 * j); const f32x2 lo = __builtin_amdgcn_cvt_pk_f32_fp8(y8, false), hi = __builtin_amdgcn_cvt_pk_f32_fp8(y8, true);
                        v[r][j][0] += lo[0] * (1.0f / Y_SCALE); v[r][j][1] += lo[1] * (1.0f / Y_SCALE); v[r][j][2] += hi[0] * (1.0f / Y_SCALE); v[r][j][3] += hi[1] * (1.0f / Y_SCALE); }
                    else { const u32x2 y = *(const u32x2*)(Y + (row * 4 + k) * 1024 + 4 * lane + 256 * j); v[r][j][0] += bflo(y.x); v[r][j][1] += bfhi(y.x); v[r][j][2] += bflo(y.y); v[r][j][3] += bfhi(y.y); } }
                s[r] += (v[r][j][0] + v[r][j][1]) + (v[r][j][2] + v[r][j][3]); } }
        const float mean0 = wave_sum(s[0], lane) * (1.0f / 1024.0f), mean1 = wave_sum(s[1], lane) * (1.0f / 1024.0f); float q[2] = {0.f, 0.f};
#pragma unroll
        for (int r = 0; r < 2; ++r)
#pragma unroll
            for (int j = 0; j < 4; ++j) { v[r][j] = v[r][j] - (r == 0 ? mean0 : mean1); q[r] += (v[r][j][0] * v[r][j][0] + v[r][j][1] * v[r][j][1]) + (v[r][j][2] * v[r][j][2] + v[r][j][3] * v[r][j][3]); }
        const float rstd0 = rsqrtf(wave_sum(q[0], lane) * (1.0f / 1024.0f) + LN_EPS), rstd1 = rsqrtf(wave_sum(q[1], lane) * (1.0f / 1024.0f) + LN_EPS);
#pragma unroll
        for (int j = 0; j < 4; ++j) { const f32x4 gvj = *(const f32x4*)(g + 4 * lane + 256 * j), bvj = *(const f32x4*)(bta + 4 * lane + 256 * j);
#pragma unroll
            for (int r = 0; r < 2; ++r) { const size_t row = (size_t)rp * 2 + r; const f32x4 o = v[r][j] * (r == 0 ? rstd0 : rstd1) * gvj + bvj;
                if (OUT) *(f32x4*)(OUT + row * 1024 + 4 * lane + 256 * j) = o;
                else { u32x2 w; w.x = pk2(o[0], o[1]); w.y = pk2(o[2], o[3]); *(u32x2*)(XO + row * 1024 + 4 * lane + 256 * j) = w;
                    if constexpr (INP_F8) { int w8 = 0; w8 = __builtin_amdgcn_cvt_pk_fp8_f32(o[0], o[1], w8, false); w8 = __builtin_amdgcn_cvt_pk_fp8_f32(o[2], o[3], w8, true); *(int*)((unsigned char*)XB + row * 1024 + 4 * lane + 256 * j) = w8; }
                    else { *(u32x2*)(XB + row * 1024 + 4 * lane + 256 * j) = w; } } } }
    }
}

constexpr int PH_PER_LAYER = 10, N_PHASES = 2 + PH_PER_LAYER * DEPTH;
__host__ __device__ constexpr bool phase_active(int p) {
    if (p < 2) return true;
    const int l = (p - 2) / PH_PER_LAYER, k = (p - 2) % PH_PER_LAYER, kind = l % 3;
    if (k == 1) return kind != 0;
    if (k == 3 || k == 4) return kind == 2;
    return true;
}

__global__ void __launch_bounds__(512, 2) fwd(Args args) {
    extern __shared__ __attribute__((aligned(16))) unsigned char lds_raw[];
    const int wave0 = __builtin_amdgcn_readfirstlane((int)threadIdx.x >> 6);
    Ctx cx; cx.lds = (LAS unsigned char*)lds_raw; cx.G = gridDim.x; { const int bx = blockIdx.x; cx.vcu = (cx.G % 8 == 0) ? (bx % 8) * (cx.G / 8) + bx / 8 : bx; } cx.ws = args.ws;
    volatile LAS unsigned* MISC = (volatile LAS unsigned*)(cx.lds + MISC_OFF);
    for (int u = threadIdx.x; u < (LDS_BYTES - MISC_OFF) / 4; u += 512) MISC[u] = 0u;
    __syncthreads();
    if (threadIdx.x == 0) { LAS unsigned long long* t = (LAS unsigned long long*)(cx.lds + PTAB_OFF);
#pragma unroll
        for (int k = 0; k < 32; ++k) t[k] = (unsigned long long)args.in[k];
        t[32] = (unsigned long long)args.out; t[33] = (unsigned long long)args.ws; }
    __syncthreads();
    const int lo = args.ph_lo, hi = args.ph_hi;
    XcdBarrier bar; bar.bar = (unsigned*)((gu32*)(args.ws + WS_CTL) + CW_BAR); bar.x = 0; bar.st = nullptr;
    if (hi - lo > 1) bar = xcd_barrier_post((unsigned*)((gu32*)(args.ws + WS_CTL) + CW_BAR), MISC + 8);
    int ran = 0;
#define XB ((bf16_t*)(ws + WS_XB))
#define PROJ ((bf16_t*)(ws + WS_PROJ))
#define CAT ((bf16_t*)(ws + WS_CAT))
#define KVM ((bf16_t*)(ws + WS_KVM))
#define HB ((bf16_t*)(ws + WS_H))
#define YB ((bf16_t*)(ws + WS_Y))
#define QKR ((bf16_t*)(ws + WS_QKR))
#define EXPID ((int*)(ws + WS_EXPID))
#define GATE ((float*)(ws + WS_GATE))
#define IDX ((int*)(ws + WS_IDX))
#define XF ((float*)(GAS float*)ptab_get(cx, 32))
#define SB ((bf16_t*)(ws + WS_SB))
#define SB2 ((bf16_t*)(ws + WS_PROJ))
#define TP_BAR_BEGIN() do {} while (0)
#define TP_BAR_END() do {} while (0)
#define TP_PH_BEGIN(p) do {} while (0)
#define TP_PH_END(p) do {} while (0)
#define PH_BEGIN(p) if (lo <= (p) && (p) < hi) { const int ph_ = (p); if (ran) { TP_BAR_BEGIN(); for (int rb_ = 0; rb_ < REP_BAR; ++rb_) xcd_barrier(bar, wave0); TP_BAR_END(); } ran = 1; const int tid = opaque_tid(wave0); (void)tid; unsigned char* const ws = (unsigned char*)(GAS unsigned char*)ptab_get(cx, 33); cx.ws = ws; TP_PH_BEGIN(ph_);
#define PH_END TP_PH_END(ph_); }

#if EN_P0
    PH_BEGIN(0) for (int rep_ = 0; rep_ < REP_P0; ++rep_) { p0_prologue(cx, tid); } PH_END
#endif

    for (int l = -1; l < DEPTH; ++l) {
        const int kind = (l < 0) ? 0 : l % 3, jj = (l < 0) ? 0 : l / 3, pw = (l < 0) ? 2048 : ((l % 3) == 1 ? 1536 : 2560), base = 2 + PH_PER_LAYER * l;
        PH_BEGIN(l < 0 ? 1 : base) {
            pg8::DenseOrder S;
            if (l < 0) S.init(ws + WS_MEMB, ws + WS_WKV, NMEM, 2048, 1024 * INP_EB, cx.G, (int)blockIdx.x);
            else S.init(XB, ws + WS_WIN + (size_t)l * 5 * MiB, NTOK, pw, 1024 * INP_EB, cx.G, (int)blockIdx.x);
            S.rep = REP_DENSE;
            const unsigned smask = (l < 0) ? 0u : (kind == 0 ? 0x207u : kind == 1 ? 0x20u : 0x200u);
            pg8::EpiBf16s E{l < 0 ? KVM : PROJ, pw, smask, C2, INP_F8 ? 1.0f / WIN_SCALE : 1.0f};
#if EN_G1
            pg8::gemm_phase<pg8::EpiBf16s, pg8::DenseOrder, false, INP_F8 != 0>(cx.lds, S, E, tid);
#endif
        } PH_END
        if (l < 0) continue;
#if EN_THIN
        if (kind == 1) { PH_BEGIN(base + 1) for (int rep_ = 0; rep_ < REP_THIN; ++rep_) { rope_phase(cx, PROJ, INP(5) + jj * 64, INP(6) + jj * 64, QKR, tid); } PH_END }
        if (kind == 2) { PH_BEGIN(base + 1) for (int rep_ = 0; rep_ < REP_THIN; ++rep_) { sconv_phase(cx, PROJ, INP(8) + (size_t)jj * 3 * 2304, INP(9) + (size_t)jj * 2304, (bf16_t*)(ws + WS_UT3), ws + WS_V8, tid); } PH_END }
#endif
        for (int o = 0; o < 2; ++o) {
            if (o == 1 && kind != 2) break;
            PH_BEGIN(base + 2 + o) {
                if (kind == 2) {
                    const bf16_t* UT3 = (const bf16_t*)(ws + WS_UT3); constexpr size_t PS = (size_t)16 * 768 * 4096;
#if EN_TCONV
                    for (int rep_ = 0; rep_ < REP_TCONV; ++rep_) {
#if TCONV_F8
                    tconv8_phase(cx, o, o == 0 ? UT3 : (const bf16_t*)(ws + WS_Z1T), ws + WS_V8 + (size_t)o * 48 * MiB, UT3 + (size_t)(1 + o) * PS, (bf16_t*)(ws + (o == 0 ? WS_Z1T : WS_Z2T)), o == 0 ? ws + WS_V8 + 48 * MiB : (unsigned char*)nullptr, INP(19) + (size_t)(jj * 2 + o) * 768, tid);
#else
                    tconv_phase(cx, o, o == 0 ? UT3 : (const bf16_t*)(ws + WS_Z1T), UT3 + (size_t)(1 + o) * PS, (bf16_t*)(ws + (o == 0 ? WS_Z1T : WS_Z2T)), INP(19) + (size_t)(jj * 2 + o) * 768, tid);
#endif
                    }
#endif
                }
                if (o == 0) {
#if EN_NA
                    for (int rep_ = 0; rep_ < REP_NA; ++rep_) { if (kind == 0) na_phase(cx, PROJ, INP(3) + (size_t)jj * 12 * 465, CAT, tid); }
#endif
                    const int ngqa = (kind == 1) ? 3072 : 0;
                    for (int rep_ = 0; rep_ < REP_ATTN; ++rep_)
                    for (int u = cx.vcu; u < ngqa + 1024; u += cx.G) {
                        const attn_body::bf16 *Q, *K, *V; attn_body::bf16* O; int QP, KP, VP, NT;
                        if (u < ngqa) { const int qb = u & 15, hq = (u >> 4) % 12, b = u / 192, kvh = hq / 3;
                            Q = (const attn_body::bf16*)QKR + ((size_t)b * 4096 + qb * 256) * 1024 + hq * 64; QP = 1024;
                            K = (const attn_body::bf16*)QKR + (size_t)b * 4096 * 1024 + 768 + kvh * 64; KP = 1024;
                            V = (const attn_body::bf16*)PROJ + (size_t)b * 4096 * 1536 + 1024 + kvh * 64; VP = 1536;
                            O = (attn_body::bf16*)((unsigned char*)CAT + (((size_t)b * 4096 + qb * 256) * 1024 + hq * 64) * OUT_EB); NT = 64;
                        } else { const int v = u - ngqa, qb = v & 15, h = (v >> 4) & 3, b = v >> 6;
                            Q = (const attn_body::bf16*)PROJ + ((size_t)b * 4096 + qb * 256) * pw + (pw - 256) + h * 64; QP = pw;
                            K = (const attn_body::bf16*)KVM + (size_t)b * 256 * 2048 + 512 * l + h * 64; KP = 2048;
                            V = K + 256; VP = 2048;
                            O = (attn_body::bf16*)((unsigned char*)CAT + (((size_t)b * 4096 + qb * 256) * 1024 + 768 + h * 64) * OUT_EB); NT = 4;
                        }
#if EN_ATTN
                        attn_body::attn_unit<8, OUTP_F8 != 0>(Q, K, V, O, QP, KP, VP, 1024, NT, (char*)lds_raw, tid);
#endif
                    }
                }
            } PH_END
        }
#if EN_THIN
        if (kind == 2) { PH_BEGIN(base + 4) for (int rep_ = 0; rep_ < REP_THIN; ++rep_) { tback_phase(cx, (const bf16_t*)(ws + WS_Z2T), CAT, tid); } PH_END }
#endif
        PH_BEGIN(base + 5) {
            pg8::DenseOrder S; S.init(CAT, ws + WS_WOUT + (size_t)l * 2 * MiB, NTOK, 1024, 1024 * OUT_EB, cx.G, (int)blockIdx.x);
            pg8::EpiResB E{SB, l == 0 ? (const void*)INP(0) : (const void*)SB, l == 0 ? 1 : 0, 1024, DN_ALPHA, OUTP_F8 ? 1.0f / WOUT_SCALE : 1.0f};
#if EN_G2
            pg8::gemm_phase<pg8::EpiResB, pg8::DenseOrder, false, OUTP_F8 != 0>(cx.lds, S, E, tid);
#endif
        } PH_END
#if EN_LN
#if REP_LN1 > 1
        PH_BEGIN(base + 6) ln1_router_phase(cx, SB, (bf16_t*)(ws + WS_PROJ), CAT, INP(22) + l * 1024, INP(23) + l * 1024, (const float*)(ws + WS_RW + (size_t)l * 131072), INP(27) + l * 32, (unsigned*)((gu32*)(ws + WS_CTL) + CW_DBG), EXPID, GATE, IDX, (float*)(ws + WS_GIDX), tid); PH_END
#endif
        PH_BEGIN(base + 6) ln1_router_phase(cx, SB, SB2, XB, INP(22) + l * 1024, INP(23) + l * 1024, (const float*)(ws + WS_RW + (size_t)l * 131072), INP(27) + l * 32, (unsigned*)((gu32*)(ws + WS_CTL) + CW_CNT + 32 * l), EXPID, GATE, IDX, (float*)(ws + WS_GIDX), tid); PH_END
#endif
        for (int half = 0; half < 2; ++half) {
            PH_BEGIN(base + 7 + half) {
                LAS int* pref = (LAS int*)(cx.lds + pg8::STAGE_BYTES); const unsigned* cntw = (const unsigned*)((gu32*)(ws + WS_CTL) + CW_CNT + 32 * l);
                __syncthreads();
                if (tid < NEXP) { const int c = (int)__hip_atomic_load(cntw + tid, __ATOMIC_RELAXED, __HIP_MEMORY_SCOPE_AGENT); pref[40 + tid] = c; pref[72 + tid] = (c + 255) >> 8; }
                __syncthreads();
                if (tid == 0) { int a = 0;
#pragma unroll 1
                    for (int e = 0; e < NEXP; ++e) { pref[e] = a; a += pref[72 + e]; } pref[NEXP] = a; }
                __syncthreads();
#if STAGGER
                if (cx.vcu & 1) { for (int s_ = 0; s_ < STAGGER; ++s_) __builtin_amdgcn_s_sleep(127); }
#endif
                if (half == 0) {
                    pg8::MoeOrder<2> S{(const char*)XB, (const char*)(ws + WS_W1 + (size_t)l * 32 * 2048 * 1024 * MOE_EB), 1024 * MOE_EB, 8, cx.G, cx.vcu, (size_t)2048 * 1024 * MOE_EB, pref, (const int*)cntw, IDX};
                    pg8::EpiSwiglu E{HB, INP(29) + (size_t)l * 32 * 2048};
#if EN_G3
                    for (int rep_ = 0; rep_ < REP_G3; ++rep_) { pg8::gemm_phase<pg8::EpiSwiglu, pg8::MoeOrder<2>, true, MOE_F8 != 0, (MOE_F8 != 0) && (DEFER_H != 0)>(cx.lds, S, E, tid); }
#endif
                } else {
                    pg8::MoeOrder<0> S{(const char*)HB, (const char*)(ws + WS_W2 + (size_t)l * 32 * 1024 * 1024 * MOE_EB), 1024 * MOE_EB, 4, cx.G, cx.vcu, (size_t)1024 * 1024 * MOE_EB, pref, (const int*)cntw, IDX};
                    pg8::EpiMoeOut E{YB, INP(31) + (size_t)l * 32 * 1024, (const float*)(ws + WS_GIDX)};
#if EN_G4
                    for (int rep_ = 0; rep_ < REP_G4; ++rep_) { pg8::gemm_phase<pg8::EpiMoeOut, pg8::MoeOrder<0>, true, MOE_F8 != 0>(cx.lds, S, E, tid); }
#endif
                }
            } PH_END
        }
#if EN_LN
#if REP_LN2 > 1
        PH_BEGIN(base + 9) ln2_phase(cx, SB, YB, (bf16_t*)(ws + WS_PROJ), CAT, (float*)nullptr, INP(24) + l * 1024, INP(25) + l * 1024, tid); PH_END
#endif
        PH_BEGIN(base + 9) ln2_phase(cx, SB2, YB, SB, XB, l == DEPTH - 1 ? XF : (float*)nullptr, INP(24) + l * 1024, INP(25) + l * 1024, tid); PH_END

#endif
    }
#undef PH_BEGIN
#undef PH_END
#undef XB
#undef PROJ
#undef CAT
#undef KVM
#undef HB
#undef YB
#undef QKR
#undef EXPID
#undef GATE
#undef IDX
#undef XF
#undef SB
#undef SB2
}

extern "C" void kernel_launch(void* const* d_in, const int* in_sizes, int n_in, void* d_out, int out_size, void* d_ws, size_t ws_size, hipStream_t stream) {
    static int grid = 0;
    if (grid == 0) {
        if (n_in != 32 || in_sizes[0] != NTOK * DM || out_size != NTOK * DM || ws_size < WS_END) { fprintf(stderr, "kernel_launch: unexpected problem (n_in %d, in0 %d, out %d, ws %zu < %zu); nothing launched\n", n_in, n_in > 0 ? in_sizes[0] : -1, out_size, ws_size, (size_t)WS_END); grid = -1; return; }
        int dev = 0, cus = 0, per_cu = 0;
        if (hipGetDevice(&dev) != hipSuccess || hipDeviceGetAttribute(&cus, hipDeviceAttributeMultiprocessorCount, dev) != hipSuccess) { fprintf(stderr, "kernel_launch: device query failed\n"); grid = -1; return; }
        if (hipFuncSetAttribute((const void*)fwd, hipFuncAttributeMaxDynamicSharedMemorySize, LDS_BYTES) != hipSuccess) { fprintf(stderr, "kernel_launch: hipFuncSetAttribute failed\n"); grid = -1; return; }
        if (hipOccupancyMaxActiveBlocksPerMultiprocessor(&per_cu, (const void*)fwd, 512, LDS_BYTES) != hipSuccess || per_cu < 1) fprintf(stderr, "kernel_launch: occupancy query reports %d blocks per CU\n", per_cu);
        (void)hipGetLastError();
        grid = cus;
    }
    if (grid < 0) return;
    if (hipMemsetAsync((char*)d_ws + WS_CTL, 0, CTL_ZERO_BYTES, stream) != hipSuccess) { fprintf(stderr, "kernel_launch: memset failed\n"); return; }
    Args a{};
    for (int i = 0; i < 32; ++i) a.in[i] = (const float*)d_in[i];
    a.out = (float*)d_out; a.ws = (unsigned char*)d_ws;
#if MK_MULTI
    for (int p = 0; p < N_PHASES && p <= DBG_LAST_PHASE; ++p) {
        if (!phase_active(p)) continue;
        a.ph_lo = p; a.ph_hi = p + 1;
        hipLaunchKernelGGL(fwd, dim3(grid), dim3(512), LDS_BYTES, stream, a);
#if DBG_CHECK
        dbg_after_phase(p, a, stream);
#endif
    }
#if DBG_CHECK
    hipLaunchKernelGGL(dbg_report, dim3(1024), dim3(256), 0, stream, (unsigned*)((char*)d_ws + WS_CTL) + CW_DBG, (float*)d_out);
#endif
#else
    a.ph_lo = 0; a.ph_hi = N_PHASES;
    hipLaunchKernelGGL(fwd, dim3(grid), dim3(512), LDS_BYTES, stream, a);
#endif
    const hipError_t le = hipPeekAtLastError();
    if (le != hipSuccess) fprintf(stderr, "kernel_launch: launch failed: %s\n", hipGetErrorName(le));
}
```

```cpp
#include <hip/hip_runtime.h>
#include <hip/hip_bf16.h>
#include <cstdio>
#include <cstdint>

#ifndef MK_MULTI
#define MK_MULTI 0
#endif
#ifndef DBG_CHECK
#define DBG_CHECK 0
#endif
#ifndef DBG_LAST_PHASE
#define DBG_LAST_PHASE 9999
#endif

#ifndef EN_P0
#define EN_P0 1
#define EN_G1 1
#define EN_THIN 1
#define EN_TCONV 1
#define EN_NA 1
#define EN_ATTN 1
#define EN_G2 1
#define EN_LN 1
#define EN_G3 1
#define EN_G4 1
#endif

#ifndef REP_P0
#define REP_P0 1
#endif
#ifndef REP_G1
#define REP_G1 1
#endif
#ifndef REP_NA
#define REP_NA 1
#endif
#ifndef REP_ATTN
#define REP_ATTN 1
#endif
#ifndef REP_TCONV
#define REP_TCONV 1
#endif
#ifndef REP_THIN
#define REP_THIN 1
#endif
#ifndef REP_G3
#define REP_G3 1
#endif
#ifndef REP_G4
#define REP_G4 1
#endif
#ifndef ALIGN_EPI
#define ALIGN_EPI 1
#endif
#ifndef NT_STORE
#define NT_STORE 0
#endif
#ifndef X1_RECOMP
#define X1_RECOMP 1
#endif
#ifndef LN1_HOLD
#define LN1_HOLD 16
#endif
#ifndef DEFER_H
#define DEFER_H 0
#endif
#ifndef STAGGER
#define STAGGER 0
#endif
#ifndef REP_BAR
#define REP_BAR 1
#endif
#ifndef REP_DENSE
#define REP_DENSE 1
#endif
#ifndef REP_G2
#define REP_G2 1
#endif
#ifndef REP_LN1
#define REP_LN1 1
#endif
#ifndef REP_LN2
#define REP_LN2 1
#endif

#define GAS __attribute__((address_space(1)))
#define LAS __attribute__((address_space(3)))
typedef unsigned short bf16_t;
typedef short bf16x8 __attribute__((ext_vector_type(8)));
typedef short s16x4 __attribute__((ext_vector_type(4)));
typedef float f32x4 __attribute__((ext_vector_type(4)));
typedef float f32x2 __attribute__((ext_vector_type(2)));
typedef float f32x16 __attribute__((ext_vector_type(16)));
typedef unsigned u32x4 __attribute__((ext_vector_type(4)));
typedef unsigned u32x2 __attribute__((ext_vector_type(2)));
typedef GAS unsigned gu32;

constexpr int BATCH = 16, SEQ = 4096, DM = 1024, NTOK = BATCH * SEQ, DEPTH = 4;
constexpr int MEMLEN = 256, NMEM = BATCH * MEMLEN;
constexpr int NEXP = 32, NSLOT = NTOK * 4, IDXCAP = NTOK;
constexpr int GRIDW = 64;
constexpr float LN_EPS = 1e-5f;
constexpr float DN_ALPHA = 1.681792830507429f;
constexpr float LOG2E = 1.4426950408889634f;
constexpr float C2 = 0.125f * LOG2E;
__host__ __device__ constexpr int layer_kind(int l) { return l % 3; }
__host__ __device__ constexpr int layer_j(int l) { return l / 3; }
__host__ __device__ constexpr int in_width(int l) { return (l % 3) == 1 ? 1536 : 2560; }

#ifndef MOE_F8
#define MOE_F8 1
#endif
#ifndef INP_F8
#define INP_F8 1
#endif
constexpr int INP_EB = INP_F8 ? 1 : 2;
constexpr float WIN_SCALE = 32.0f;
#ifndef OUTP_F8
#define OUTP_F8 1
#endif
constexpr int OUT_EB = OUTP_F8 ? 1 : 2;
constexpr float WOUT_SCALE = 64.0f;
__device__ __forceinline__ unsigned char f2fp8(float x) { return (unsigned char)(__builtin_amdgcn_cvt_pk_fp8_f32(x, x, 0, false) & 0xff); }
#ifndef TCONV_F8
#define TCONV_F8 1
#endif
#ifndef Y_F8
#define Y_F8 1
#endif
constexpr float Y_SCALE = 64.0f;
constexpr int MOE_EB = MOE_F8 ? 1 : 2;
constexpr float W1_SCALE = 32.0f, W2_SCALE = 64.0f, H_SCALE = 4.0f;

constexpr size_t MiB = 1u << 20;
constexpr size_t WS_CTL = 0, CTL_ZERO_BYTES = 1 * MiB;
constexpr size_t WS_RW = 1 * MiB;
constexpr size_t WS_WIN = 2 * MiB;
constexpr size_t WS_WKV = 22 * MiB;
constexpr size_t WS_WOUT = 26 * MiB;
constexpr size_t WS_W1 = 34 * MiB;
constexpr size_t WS_W2 = 546 * MiB;
constexpr size_t WS_XB = 802 * MiB;
constexpr size_t WS_MEMB = 930 * MiB;
constexpr size_t WS_KVM = 938 * MiB;
constexpr size_t WS_PROJ = 954 * MiB;
constexpr size_t WS_CAT = 1274 * MiB;
constexpr size_t WS_H = 1402 * MiB;
constexpr size_t WS_Y = 1914 * MiB;
constexpr size_t WS_HRAWT = 2426 * MiB;
constexpr size_t WS_HPART = 2474 * MiB;
constexpr size_t WS_EXPID = 2478 * MiB;
constexpr size_t WS_GATE = 2479 * MiB;
constexpr size_t WS_IDX = 2480 * MiB;
constexpr size_t WS_SB = 2488 * MiB;
constexpr size_t WS_GIDX = 2616 * MiB;
constexpr size_t WS_END = 2624 * MiB;
constexpr size_t WS_UT3 = WS_H;
constexpr size_t WS_Z1T = WS_H + 288 * MiB;
constexpr size_t WS_Z2T = WS_H + 384 * MiB;
constexpr size_t WS_V8 = WS_Y;
constexpr size_t WS_QKR = WS_Y;
constexpr int CW_BAR = 4096;
constexpr int CW_CNT = 8192;
constexpr int CW_DBG = 12288;

constexpr int MISC_OFF = 150528;
constexpr int LDS_BYTES = 163840;

#define LDS_WAIT() asm volatile("s_waitcnt lgkmcnt(0)" ::: "memory")
#define VM_WAIT() asm volatile("s_waitcnt vmcnt(0)" ::: "memory")
__device__ __forceinline__ unsigned f2bf(float f) { unsigned u = __builtin_bit_cast(unsigned, f); return (u + 0x7fffu + ((u >> 16) & 1u)) >> 16; }
__device__ __forceinline__ unsigned pk2(float lo, float hi) { return f2bf(lo) | (f2bf(hi) << 16); }
__device__ __forceinline__ float bf2f(unsigned short b) { return __builtin_bit_cast(float, ((unsigned)b) << 16); }
__device__ __forceinline__ float bflo(unsigned w) { return __builtin_bit_cast(float, w << 16); }
__device__ __forceinline__ float bfhi(unsigned w) { return __builtin_bit_cast(float, w & 0xffff0000u); }
__device__ __forceinline__ float shflx(float v, int mask, int lane) { int t; asm volatile("v_mov_b32 %0, %1" : "=v"(t) : "v"(__builtin_bit_cast(int, v))); return __builtin_bit_cast(float, __builtin_amdgcn_ds_bpermute((lane ^ mask) << 2, t)); }
__device__ __forceinline__ int shflxi(int v, int mask, int lane) { return __builtin_amdgcn_ds_bpermute((lane ^ mask) << 2, v); }
template <int CTRL> __device__ __forceinline__ float dpp_x(float v) { return __builtin_bit_cast(float, __builtin_amdgcn_update_dpp(0, __builtin_bit_cast(int, v), CTRL, 0xF, 0xF, false)); }
__device__ __forceinline__ float group8_sum(float v) { v += dpp_x<0xB1>(v); v += dpp_x<0x4E>(v); v += dpp_x<0x141>(v); return v; }
__device__ __forceinline__ float wave_sum(float v, int  ) {
    v += dpp_x<0xB1>(v); v += dpp_x<0x4E>(v); v += dpp_x<0x141>(v); v += dpp_x<0x140>(v);
    v += __builtin_bit_cast(float, __builtin_amdgcn_update_dpp(0, __builtin_bit_cast(int, v), 0x142, 0xA, 0xF, false));
    v += __builtin_bit_cast(float, __builtin_amdgcn_update_dpp(0, __builtin_bit_cast(int, v), 0x143, 0xC, 0xF, false));
    return __builtin_bit_cast(float, __builtin_amdgcn_readlane(__builtin_bit_cast(int, v), 63));
}
__device__ __forceinline__ int lane_id_volatile() { int l; asm volatile("v_mbcnt_lo_u32_b32 %0, -1, 0\n\tv_mbcnt_hi_u32_b32 %0, -1, %0" : "=&v"(l)); return l; }
__device__ __forceinline__ int opaque_tid(int wave0) { return wave0 * 64 + lane_id_volatile(); }

#define XB_TMO      128
#define XB_XCNT(j)  (256  + 64 * (j))
#define XB_XSUB(j)  (1280 + 64 * (j))
#define XB_XGEN(j)  (2304 + 64 * (j))
#define XB_TOP      3328
#define XB_TOPGEN   3392
#define XCD_BAR_WORDS 3456
#define XB_SPIN_CAP (1u << 20)

__device__ __forceinline__ unsigned xb_ld(unsigned* p)              { return __hip_atomic_load(p, __ATOMIC_RELAXED, __HIP_MEMORY_SCOPE_AGENT); }
__device__ __forceinline__ unsigned xb_add(unsigned* p, unsigned v) { return __hip_atomic_fetch_add(p, v, __ATOMIC_RELAXED, __HIP_MEMORY_SCOPE_AGENT); }
__device__ __forceinline__ unsigned xb_xcc_id() { return (unsigned)__builtin_amdgcn_s_getreg((3 << 11) | 20) & 0xFu; }
#define XB_SPIN(cond, bar) do { unsigned _sp = 0; while (cond) { __builtin_amdgcn_s_sleep(1); \
    if ((++_sp & 255u) == 0u) { if (xb_ld(&(bar)[XB_TMO])) break; if (_sp > XB_SPIN_CAP) { atomicAdd(&(bar)[XB_TMO], 1u); break; } } } } while (0)

struct XcdBarrier {
    unsigned* bar; unsigned x;
    volatile LAS unsigned* st;
};
__device__ __forceinline__ XcdBarrier xcd_barrier_post(unsigned* bar, volatile LAS unsigned* st) {
    XcdBarrier b; b.bar = bar; b.x = xb_xcc_id(); b.st = st;
    if (threadIdx.x == 0) (void)xb_add(&bar[XB_XCNT(b.x)], 1u);
    return b;
}
__device__ __forceinline__ void xcd_barrier_complete(unsigned* bar, unsigned x, unsigned& nloc, unsigned& nx) {
    const unsigned G = gridDim.x * gridDim.y * gridDim.z;
    unsigned sum, cnt, mine, sp = 0u;
    for (;;) {
        sum = 0u; cnt = 0u; mine = 0u;
#pragma unroll 1
        for (unsigned j = 0; j < 16; ++j) { const unsigned c = xb_ld(&bar[XB_XCNT(j)]); sum += c; cnt += (c > 0u) ? 1u : 0u; mine = (j == x) ? c : mine; }
        if (sum == G) break;
        __builtin_amdgcn_s_sleep(1);
        if ((++sp & 255u) == 0u) { if (xb_ld(&bar[XB_TMO])) break; if (sp > XB_SPIN_CAP) { atomicAdd(&bar[XB_TMO], 1u); break; } }
    }
    nloc = mine > 0u ? mine : 1u; nx = cnt > 0u ? cnt : 1u;
}
__device__ __forceinline__ void xcd_barrier(const XcdBarrier& b, const int wave0) {
    asm volatile("s_waitcnt vmcnt(0)" ::: "memory");
    __syncthreads();
    if (wave0 == 0 && lane_id_volatile() == 0) {
        unsigned* bar = b.bar;
        __builtin_amdgcn_s_waitcnt(0);
        unsigned nloc = b.st[0], nx = b.st[1];
        if (nloc == 0u) { xcd_barrier_complete(bar, b.x, nloc, nx); b.st[0] = nloc; b.st[1] = nx; }
        const unsigned old = xb_add(&bar[XB_XSUB(b.x)], 1u);
        const unsigned gen = old / nloc;
        if (old + 1u == (gen + 1u) * nloc) {
            __builtin_amdgcn_fence(__ATOMIC_RELEASE, "agent");
            asm volatile("s_waitcnt vmcnt(0)" ::: "memory");
            const unsigned og = xb_add(&bar[XB_TOP], 1u);
            const unsigned tg = og / nx;
            if (og + 1u == (tg + 1u) * nx) xb_add(&bar[XB_TOPGEN], 1u);
            else XB_SPIN(xb_ld(&bar[XB_TOPGEN]) == tg, bar);
            __builtin_amdgcn_fence(__ATOMIC_ACQUIRE, "agent");
            xb_add(&bar[XB_XGEN(b.x)], 1u);
            asm volatile("s_waitcnt vmcnt(0)" ::: "memory");
        } else {
            XB_SPIN(xb_ld(&bar[XB_XGEN(b.x)]) == gen, bar);
            __builtin_amdgcn_fence(__ATOMIC_ACQUIRE, "agent");
            asm volatile("s_waitcnt vmcnt(0)" ::: "memory");
        }
    }
    __syncthreads();
}

namespace pg8 {
constexpr int BM = 256, BK = 64, HALF = 128, HTB = HALF * BK * 2  , STAGE_BYTES = 8 * HTB, NXCD = 8, WGM = 8;
__host__ __device__ __forceinline__ int lds_byte(int r, int c) { const int st = (r >> 4) * 2 + (c >> 5), rr = r & 15, cc = c & 31, ob = rr * 64 + cc * 2; return st * 1024 + (ob ^ (((ob >> 9) & 1) << 5)); }
__host__ __device__ __forceinline__ void stage_rc(int b, int& R, int& C) { const int st = b / 1024, sb = b % 1024, swz = sb ^ (((sb >> 9) & 1) << 5); R = (st >> 1) * 16 + swz / 64; C = (st & 1) * 32 + (swz % 64) / 2; }
__host__ __device__ __forceinline__ int perm32(int rho) { const int n = rho >> 4, i = rho & 15; return 8 * (i >> 2) + 4 * n + (i & 3); }

struct Unit { int pm, pn, e, p; };

struct DenseOrder {
    const char* A; const char* Bt; int KB; int nM, nN, nwg, G, c; int rep = 1;
    __device__ __forceinline__ void init(const void* A_, const void* Bt_, int M, int N, int KB_, int G_, int c_) { A = (const char*)A_; Bt = (const char*)Bt_; KB = KB_; nM = M / BM; nN = N / BM; nwg = nM * nN; G = G_; c = c_; }
    __device__ __forceinline__ bool next(int i, Unit& u) const {
        long L = (long)i * G + c; if (L >= (long)nwg * rep) return false;
        if (rep > 1) L %= nwg;
        int wgid = (int)L; { const int q = nwg / NXCD, r = nwg % NXCD, xcd = wgid % NXCD, off = wgid / NXCD; wgid = (xcd < r ? xcd * (q + 1) : r * (q + 1) + (xcd - r) * q) + off; }
        const int nig = WGM * nN, gid = wgid / nig, fm = gid * WGM, gsz = (nM - fm) < WGM ? (nM - fm) : WGM;
        u.pm = __builtin_amdgcn_readfirstlane(fm + ((wgid % nig) % gsz)); u.pn = __builtin_amdgcn_readfirstlane((wgid % nig) / gsz); u.e = 0; u.p = 0; return true;
    }
    __device__ __forceinline__ const char* a_base(const Unit& u) const { return A + (size_t)u.pm * BM * KB; }
    __device__ __forceinline__ const char* b_base(const Unit& u) const { return Bt + (size_t)u.pn * BM * KB; }
    __device__ __forceinline__ const int* idx_src(const Unit&) const { return nullptr; }
    __device__ __forceinline__ int nvalid(const Unit&) const { return BM; }
    static constexpr int ROW_SHIFT = 0;
};
template <int SHIFT  > struct MoeOrder {
    const char* A; const char* Bt; int KB; int nN; int G, c; size_t bstride; const LAS int* pref; const int* cnt; const int* idx;
    __device__ __forceinline__ bool next(int i, Unit& u) const {
        const long L = (long)i * G + c; const int tot = __builtin_amdgcn_readfirstlane(pref[NEXP]);
        if (L >= (long)tot * nN) return false;
        const int pg = __builtin_amdgcn_readfirstlane((int)(L / nN)); u.pn = __builtin_amdgcn_readfirstlane((int)(L % nN));
        int e = 0;
#pragma unroll
        for (int step = 16; step >= 1; step >>= 1) { const int v = __builtin_amdgcn_readfirstlane(pref[e + step]); e += (v <= pg) ? step : 0; }
        u.e = e; u.p = pg - __builtin_amdgcn_readfirstlane(pref[e]); u.pm = 0; return true;
    }
    __device__ __forceinline__ const char* a_base(const Unit&) const { return A; }
    __device__ __forceinline__ const char* b_base(const Unit& u) const { return Bt + (size_t)u.e * bstride + (size_t)u.pn * BM * KB; }
    __device__ __forceinline__ const int* idx_src(const Unit& u) const { return idx + (size_t)u.e * IDXCAP + u.p * BM; }
    __device__ __forceinline__ int nvalid(const Unit& u) const { const int n = __builtin_amdgcn_readfirstlane(pref[40 + u.e]) - u.p * BM; return n < BM ? n : BM; }
    static constexpr int ROW_SHIFT = SHIFT;
};

__device__ __forceinline__ unsigned cvt_pk_bf16(float lo, float hi) { unsigned r; asm volatile("v_cvt_pk_bf16_f32 %0, %1, %2" : "=v"(r) : "v"(lo), "v"(hi)); return r; }

struct EpiBf16s {
    static constexpr bool PERM = true; static constexpr bool HAS_BIAS = false;
    bf16_t* O; int ldc; unsigned smask; float scale; float base;
    __device__ __forceinline__ void operator()(const f32x4 (&acc)[2][2][4][2], const Unit& u, int wr, int wc, int fr, int fq) const {
        const int row0 = u.pm * BM + wr * 64 + fr, col0 = u.pn * BM + wc * 32 + 8 * fq;
        const float sc = (((smask >> u.pn) & 1u) ? scale : 1.f) * base;
#pragma unroll
        for (int ai = 0; ai < 2; ++ai)
#pragma unroll
            for (int m = 0; m < 4; ++m) { bf16_t* rowp = O + (size_t)(row0 + ai * HALF + m * 16) * ldc + col0;
#pragma unroll
                for (int bj = 0; bj < 2; ++bj) { const f32x4 v0 = acc[ai][bj][m][0] * sc, v1 = acc[ai][bj][m][1] * sc;
                    u32x4 w; w.x = cvt_pk_bf16(v0[0], v0[1]); w.y = cvt_pk_bf16(v0[2], v0[3]); w.z = cvt_pk_bf16(v1[0], v1[1]); w.w = cvt_pk_bf16(v1[2], v1[3]);
                    if (NT_STORE) __builtin_nontemporal_store(w, (u32x4*)(rowp + bj * HALF)); else *(u32x4*)(rowp + bj * HALF) = w; }
                asm volatile("" ::: "memory"); }
    }
};
struct EpiResB {
    static constexpr bool PERM = true; static constexpr bool HAS_BIAS = false;
    bf16_t* C; const void* res; int res_f32; int ldc; float alpha; float ascale;
    __device__ __forceinline__ void operator()(const f32x4 (&acc)[2][2][4][2], const Unit& u, int wr, int wc, int fr, int fq) const {
        const int row0 = u.pm * BM + wr * 64 + fr, col0 = u.pn * BM + wc * 32 + 8 * fq;
        if (res_f32) {
#pragma unroll
            for (int ai = 0; ai < 2; ++ai) { f32x4 r[4][2][2];
#pragma unroll
                for (int m = 0; m < 4; ++m)
#pragma unroll
                    for (int bj = 0; bj < 2; ++bj) { const float* rp = (const float*)res + (size_t)(row0 + ai * HALF + m * 16) * ldc + col0 + bj * HALF; r[m][bj][0] = *(const f32x4*)rp; r[m][bj][1] = *(const f32x4*)(rp + 4); }
#pragma unroll
                for (int m = 0; m < 4; ++m)
#pragma unroll
                    for (int bj = 0; bj < 2; ++bj) { const size_t off = (size_t)(row0 + ai * HALF + m * 16) * ldc + col0 + bj * HALF;
                        const f32x4 v0 = r[m][bj][0] * alpha + acc[ai][bj][m][0] * ascale, v1 = r[m][bj][1] * alpha + acc[ai][bj][m][1] * ascale;
                        u32x4 w; w.x = cvt_pk_bf16(v0[0], v0[1]); w.y = cvt_pk_bf16(v0[2], v0[3]); w.z = cvt_pk_bf16(v1[0], v1[1]); w.w = cvt_pk_bf16(v1[2], v1[3]);
                        *(u32x4*)(C + off) = w; }
                asm volatile("" ::: "memory"); }
        } else { u32x4 raw[2][4][2];
#pragma unroll
            for (int ai = 0; ai < 2; ++ai)
#pragma unroll
                for (int m = 0; m < 4; ++m)
#pragma unroll
                    for (int bj = 0; bj < 2; ++bj) raw[ai][m][bj] = *(const u32x4*)((const bf16_t*)res + (size_t)(row0 + ai * HALF + m * 16) * ldc + col0 + bj * HALF);
#pragma unroll
            for (int ai = 0; ai < 2; ++ai)
#pragma unroll
                for (int m = 0; m < 4; ++m)
#pragma unroll
                    for (int bj = 0; bj < 2; ++bj) { const size_t off = (size_t)(row0 + ai * HALF + m * 16) * ldc + col0 + bj * HALF; const u32x4 rw = raw[ai][m][bj];
                        const f32x4 r0 = (f32x4){bflo(rw.x), bfhi(rw.x), bflo(rw.y), bfhi(rw.y)}, r1 = (f32x4){bflo(rw.z), bfhi(rw.z), bflo(rw.w), bfhi(rw.w)};
                        const f32x4 v0 = r0 * alpha + acc[ai][bj][m][0] * ascale, v1 = r1 * alpha + acc[ai][bj][m][1] * ascale;
                        u32x4 w; w.x = cvt_pk_bf16(v0[0], v0[1]); w.y = cvt_pk_bf16(v0[2], v0[3]); w.z = cvt_pk_bf16(v1[0], v1[1]); w.w = cvt_pk_bf16(v1[2], v1[3]);
                        *(u32x4*)(C + off) = w; }
        }
    }
};
struct Pend { u32x2 val[8]; };
struct EpiSwiglu {
    static constexpr bool PERM = true; static constexpr bool HAS_GATE = false; static constexpr bool HAS_BIAS = true;
    __device__ __forceinline__ void load_bias(const Unit& u, int wc, int fq, f32x4 (&bp)[4]) const { const float* bg = b1 + (size_t)u.e * 2048 + u.pn * HALF + wc * 32 + 8 * fq; bp[0] = *(const f32x4*)bg; bp[1] = *(const f32x4*)(bg + 4); bp[2] = *(const f32x4*)(bg + 1024); bp[3] = *(const f32x4*)(bg + 1028); }
    bf16_t* H; const float* b1;
    __device__ __forceinline__ void prepare(const f32x4 (&acc)[2][2][4][2], const Unit& u, int wr, int wc, int fr, int fq, Pend& pd) const {
        constexpr float ASC = 1.0f / W1_SCALE;
        const int j0 = u.pn * HALF + wc * 32 + 8 * fq; const float* bg = b1 + (size_t)u.e * 2048 + j0; const float* bu = bg + 1024;
        const f32x4 bg0 = *(const f32x4*)bg, bg1 = *(const f32x4*)(bg + 4), bu0 = *(const f32x4*)bu, bu1 = *(const f32x4*)(bu + 4);
#pragma unroll
        for (int q8 = 0; q8 < 8; ++q8) { const int ai = q8 >> 2, m = q8 & 3;
            float o[8];
#pragma unroll
            for (int q = 0; q < 8; ++q) { const float gb = (q < 4 ? bg0[q & 3] : bg1[q & 3]), ub = (q < 4 ? bu0[q & 3] : bu1[q & 3]);
                float g = acc[ai][0][m][q >> 2][q & 3] * ASC + gb, uu = acc[ai][1][m][q >> 2][q & 3] * ASC + ub;
                g = fminf(g, 7.0f); uu = fminf(fmaxf(uu, -7.0f), 7.0f);
                const float sg = __builtin_amdgcn_rcpf(1.0f + __builtin_amdgcn_exp2f(-1.702f * LOG2E * g));
                o[q] = (uu + 1.0f) * (g * sg); }
            int w0 = 0, w1 = 0;
            w0 = __builtin_amdgcn_cvt_pk_fp8_f32(o[0] * H_SCALE, o[1] * H_SCALE, w0, false); w0 = __builtin_amdgcn_cvt_pk_fp8_f32(o[2] * H_SCALE, o[3] * H_SCALE, w0, true);
            w1 = __builtin_amdgcn_cvt_pk_fp8_f32(o[4] * H_SCALE, o[5] * H_SCALE, w1, false); w1 = __builtin_amdgcn_cvt_pk_fp8_f32(o[6] * H_SCALE, o[7] * H_SCALE, w1, true);
            pd.val[q8] = (u32x2){(unsigned)w0, (unsigned)w1}; }
    }
    __device__ __forceinline__ void store_one(const u32x2 v, const LAS int* ids, const int r, const int nv, const int j0) const { if (r < nv) { const int slot = ids[r]; *(u32x2*)((unsigned char*)H + (size_t)slot * 1024 + j0) = v; } }
    __device__ __forceinline__ void operator()(const f32x4 (&acc)[2][2][4][2], const Unit& u, int wr, int wc, int fr, int fq, const LAS int* ids, const int nv, const f32x4 (&bp)[4]) const {
        constexpr float ASC = MOE_F8 ? 1.0f / W1_SCALE : 1.0f;
        constexpr float HS = MOE_F8 ? H_SCALE : 1.0f, KK = -1.702f * LOG2E, GA = ASC * KK, UA = ASC * HS / KK, ULO = 8.0f * HS / KK, UHI = -6.0f * HS / KK, GLO = 7.0f * KK;
        const int j0 = u.pn * HALF + wc * 32 + 8 * fq;
        const f32x4 bg0 = bp[0] * KK, bg1 = bp[1] * KK; f32x4 bu0 = (bp[2] + 1.0f) * (HS / KK), bu1 = (bp[3] + 1.0f) * (HS / KK);
        asm volatile("" : "+v"(bu0), "+v"(bu1));
        int rb = wr * 64 + fr; asm volatile("" : "+v"(rb));
        const LAS int* idp = ids + rb; int slots[8];
#pragma unroll
        for (int q = 0; q < 8; ++q) slots[q] = idp[(q >> 2) * HALF + (q & 3) * 16];
#pragma unroll
        for (int ai = 0; ai < 2; ++ai)
#pragma unroll
            for (int m = 0; m < 4; ++m) { const int r = ai * HALF + m * 16 + rb;
                if (r < nv) { const int slot = slots[ai * 4 + m];
                    float o[8];
#pragma unroll
                    for (int q = 0; q < 8; ++q) { const float gb = (q < 4 ? bg0[q & 3] : bg1[q & 3]), ub = (q < 4 ? bu0[q & 3] : bu1[q & 3]);
                        const float gp = fmaxf(__builtin_fmaf(acc[ai][0][m][q >> 2][q & 3], GA, gb), GLO);
                        const float us = fminf(fmaxf(__builtin_fmaf(acc[ai][1][m][q >> 2][q & 3], UA, ub), ULO), UHI);
                        const float sg = __builtin_amdgcn_rcpf(1.0f + __builtin_amdgcn_exp2f(gp));
                        o[q] = us * (gp * sg); }
                    if constexpr (MOE_F8) { int w0 = 0, w1 = 0;
                        w0 = __builtin_amdgcn_cvt_pk_fp8_f32(o[0], o[1], w0, false); w0 = __builtin_amdgcn_cvt_pk_fp8_f32(o[2], o[3], w0, true);
                        w1 = __builtin_amdgcn_cvt_pk_fp8_f32(o[4], o[5], w1, false); w1 = __builtin_amdgcn_cvt_pk_fp8_f32(o[6], o[7], w1, true);
                        *(u32x2*)((unsigned char*)H + (size_t)slot * 1024 + j0) = (u32x2){(unsigned)w0, (unsigned)w1};
                    } else { u32x4 w; w.x = cvt_pk_bf16(o[0], o[1]); w.y = cvt_pk_bf16(o[2], o[3]); w.z = cvt_pk_bf16(o[4], o[5]); w.w = cvt_pk_bf16(o[6], o[7]);
                        *(u32x4*)(H + (size_t)slot * 1024 + j0) = w; } } }
    }
};
struct EpiMoeOut {
    static constexpr bool PERM = true; static constexpr bool HAS_GATE = true; static constexpr bool HAS_BIAS = true;
    __device__ __forceinline__ void load_bias(const Unit& u, int wc, int fq, f32x4 (&bp)[4]) const { const float* bb = b2 + (size_t)u.e * 1024 + u.pn * BM + wc * 32 + 8 * fq; bp[0] = *(const f32x4*)bb; bp[1] = *(const f32x4*)(bb + 4); bp[2] = *(const f32x4*)(bb + HALF); bp[3] = *(const f32x4*)(bb + HALF + 4); }
    bf16_t* Y; const float* b2;   const float* gidx;
    __device__ __forceinline__ void operator()(const f32x4 (&acc)[2][2][4][2], const Unit& u, int wr, int wc, int fr, int fq, const LAS int* ids, const int nv, const f32x4 (&bp)[4]) const {
        const LAS float* gts = (const LAS float*)(ids + 768);
        constexpr float OSC = MOE_F8 ? 1.0f / (H_SCALE * W2_SCALE) : 1.0f;
        const int c0 = u.pn * BM + wc * 32 + 8 * fq;
        f32x4 bv[2][2]; bv[0][0] = bp[0]; bv[0][1] = bp[1]; bv[1][0] = bp[2]; bv[1][1] = bp[3];
        int rb = wr * 64 + fr; asm volatile("" : "+v"(rb));
        const LAS int* idp = ids + rb; int slots[8];
#pragma unroll
        for (int q = 0; q < 8; ++q) slots[q] = idp[(q >> 2) * HALF + (q & 3) * 16];
#pragma unroll
        for (int ai = 0; ai < 2; ++ai)
#pragma unroll
            for (int m = 0; m < 4; ++m) { const int r = ai * HALF + m * 16 + rb;
                if (r < nv) { const int slot = slots[ai * 4 + m]; const float gt = gts[r];
                    if constexpr (Y_F8) {
                        unsigned pk[2][2];
#pragma unroll
                        for (int bj = 0; bj < 2; ++bj) { const f32x4 s0 = (acc[ai][bj][m][0] * OSC + bv[bj][0]) * (gt * Y_SCALE), s1 = (acc[ai][bj][m][1] * OSC + bv[bj][1]) * (gt * Y_SCALE); int w0 = 0, w1 = 0;
                            w0 = __builtin_amdgcn_cvt_pk_fp8_f32(s0[0], s0[1], w0, false); w0 = __builtin_amdgcn_cvt_pk_fp8_f32(s0[2], s0[3], w0, true); w1 = __builtin_amdgcn_cvt_pk_fp8_f32(s1[0], s1[1], w1, false); w1 = __builtin_amdgcn_cvt_pk_fp8_f32(s1[2], s1[3], w1, true);
                            pk[bj][0] = (unsigned)w0; pk[bj][1] = (unsigned)w1; }
                        const auto x0 = __builtin_amdgcn_permlane16_swap(pk[0][0], pk[1][0], false, false), x1 = __builtin_amdgcn_permlane16_swap(pk[0][1], pk[1][1], false, false);
                        *(u32x4*)((unsigned char*)Y + (size_t)slot * 1024 + c0 + ((fq & 1) ? 120 : 0)) = (u32x4){x0[0], x1[0], x0[1], x1[1]};
                    } else {
#pragma unroll
                    for (int bj = 0; bj < 2; ++bj) { const f32x4 v0 = (acc[ai][bj][m][0] * OSC + bv[bj][0]) * gt, v1 = (acc[ai][bj][m][1] * OSC + bv[bj][1]) * gt;
                        u32x4 w; w.x = cvt_pk_bf16(v0[0], v0[1]); w.y = cvt_pk_bf16(v0[2], v0[3]); w.z = cvt_pk_bf16(v1[0], v1[1]); w.w = cvt_pk_bf16(v1[2], v1[3]);
                        if (NT_STORE) __builtin_nontemporal_store(w, (u32x4*)(Y + (size_t)slot * 1024 + c0 + bj * HALF)); else *(u32x4*)(Y + (size_t)slot * 1024 + c0 + bj * HALF) = w; } } } }
    }
};

__device__ __forceinline__ const char* uni_ptr(const char* p) { const unsigned long long v = (unsigned long long)p; const unsigned lo = __builtin_amdgcn_readfirstlane((unsigned)v), hi = __builtin_amdgcn_readfirstlane((unsigned)(v >> 32)); return (const char*)(((unsigned long long)hi << 32) | lo); }
typedef int v4i_t __attribute__((ext_vector_type(4))); typedef int v8i_t __attribute__((ext_vector_type(8)));
__device__ __forceinline__ v8i_t cat8(const bf16x8 a, const bf16x8 b) { return __builtin_shufflevector(__builtin_bit_cast(v4i_t, a), __builtin_bit_cast(v4i_t, b), 0, 1, 2, 3, 4, 5, 6, 7); }
template <class Epi, class Sched, bool GATHER, bool F8 = false, bool DEFER = false>
__device__ __forceinline__ void gemm_phase(LAS unsigned char* lds, const Sched& S, const Epi& E, const int tid) {
    const int wid = __builtin_amdgcn_readfirstlane(tid >> 6), lane = tid & 63, wr = wid >> 2, wc = wid & 3, fr = lane & 15, fq = lane >> 4;
    const int KB = S.KB, nt = KB / 128;
    unsigned voffA[2], voffB[2];
#pragma unroll
    for (int i = 0; i < 2; ++i) { int R, C; stage_rc(tid * 16 + i * 8192, R, C); const int Rb = Epi::PERM ? ((R & ~31) + perm32(R & 31)) : R;
        voffA[i] = (unsigned)(R * KB + C * 2); voffB[i] = (unsigned)(Rb * KB + C * 2); }
    const size_t kstep = (size_t)(BK * 2);
    const size_t hstep = (size_t)HALF * KB;
    const unsigned ldsw = (unsigned)wid * 1024u;
    const int aoff = lds_byte(wr * 64 + fr, fq * 8), boff = lds_byte(wc * 32 + fr, fq * 8);
#define PG8_SA(b, h) (((b) * 2 + (h)) * HTB)
#define PG8_SB(b, h) ((4 + (b) * 2 + (h)) * HTB)
#define PG8_STAGE(bufoff, gbase, voff) do { const char* _gb = uni_ptr((const char*)(gbase)); _Pragma("unroll") for (int _i = 0; _i < 2; ++_i) \
        __builtin_amdgcn_global_load_lds((const unsigned*)(_gb + (voff)[_i]), (LAS unsigned*)(lds + (bufoff) + ldsw + _i * 8192), 16, 0, 0); } while (0)
#define PG8_STAGE_A(bufoff, kb, h, GO) do { if constexpr (GATHER) { PG8_STAGE(bufoff, kb, (GO)[h]); } else { PG8_STAGE(bufoff, (kb) + (h) * hstep, voffA); } } while (0)
#define PG8_LDA(dst, b, h) do { if constexpr (F8) { _Pragma("unroll") for (int m = 0; m < 4; ++m) dst##8[m] = cat8(*(const LAS bf16x8*)(lds + PG8_SA(b, h) + aoff + m * 2048), *(const LAS bf16x8*)(lds + PG8_SA(b, h) + aoff + m * 2048 + 1024)); } else { \
        _Pragma("unroll") for (int m = 0; m < 4; ++m) _Pragma("unroll") for (int k = 0; k < 2; ++k) dst[m][k] = *(const LAS bf16x8*)(lds + PG8_SA(b, h) + aoff + m * 2048 + k * 1024); } } while (0)
#define PG8_LDB(dst, b, h) do { if constexpr (F8) { _Pragma("unroll") for (int n = 0; n < 2; ++n) dst##8[n] = cat8(*(const LAS bf16x8*)(lds + PG8_SB(b, h) + boff + n * 2048), *(const LAS bf16x8*)(lds + PG8_SB(b, h) + boff + n * 2048 + 1024)); } else { \
        _Pragma("unroll") for (int n = 0; n < 2; ++n) _Pragma("unroll") for (int k = 0; k < 2; ++k) dst[n][k] = *(const LAS bf16x8*)(lds + PG8_SB(b, h) + boff + n * 2048 + k * 1024); } } while (0)
#define PG8_MMA(ai, bj, At, Bt) do { __builtin_amdgcn_s_setprio(1); if constexpr (F8) { _Pragma("unroll") for (int m = 0; m < 4; ++m) _Pragma("unroll") for (int n = 0; n < 2; ++n) \
        acc[ai][bj][m][n] = __builtin_amdgcn_mfma_scale_f32_16x16x128_f8f6f4(Bt##8[n], At##8[m], acc[ai][bj][m][n], 0, 0, 0, 0, 0, 0); } else { \
        _Pragma("unroll") for (int m = 0; m < 4; ++m) _Pragma("unroll") for (int n = 0; n < 2; ++n) _Pragma("unroll") for (int k = 0; k < 2; ++k) \
        acc[ai][bj][m][n] = __builtin_amdgcn_mfma_f32_16x16x32_bf16(Bt[n][k], At[m][k], acc[ai][bj][m][n], 0, 0, 0); } __builtin_amdgcn_s_setprio(0); } while (0)
#define PG8_WAIT_V(n) asm volatile("s_waitcnt vmcnt(" #n ")" ::: "memory")
#define PG8_WAIT_L(n) asm volatile("s_waitcnt lgkmcnt(" #n ")" ::: "memory")
#define PG8_BAR __builtin_amdgcn_s_barrier()
#define PG8_SCHED __builtin_amdgcn_sched_barrier(0)
    LAS int* const ibuf = (LAS int*)(lds + STAGE_BYTES + 512);
#define PG8_IDMA(u, b) do { if constexpr (GATHER) { __builtin_amdgcn_global_load_lds((const unsigned*)(S.idx_src(u) + 64 * (wid & 3) + lane), (LAS unsigned*)(ibuf + (b) * 256 + 64 * (wid & 3)), 4, 0, 0); \
        if constexpr (Epi::HAS_GATE) __builtin_amdgcn_global_load_lds((const unsigned*)(E.gidx + (S.idx_src(u) - S.idx) + 64 * (wid & 3) + lane), (LAS unsigned*)(ibuf + 768 + (b) * 256 + 64 * (wid & 3)), 4, 0, 0); } } while (0)
#define PG8_GOFF(dst, u, b) do { if constexpr (GATHER) { int _t = tid; asm volatile("" : "+v"(_t)); const int _nv = S.nvalid(u); _Pragma("unroll") for (int _i = 0; _i < 2; ++_i) { int _R, _C; stage_rc(_t * 16 + _i * 8192, _R, _C); \
        _Pragma("unroll") for (int _h = 0; _h < 2; ++_h) { const int _r = _R + _h * HALF; const unsigned _s = (unsigned)ibuf[(b) * 256 + (_r < _nv ? _r : 0)]; dst[_h][_i] = (_s >> Sched::ROW_SHIFT) * (unsigned)KB + (unsigned)_C * 2u; } } } } while (0)
    Unit cur, nxt; int ui = 0;
    if (!S.next(0, cur)) return;
    f32x4 acc[2][2][4][2];
#pragma unroll
    for (int a = 0; a < 2; ++a)
#pragma unroll
        for (int b = 0; b < 2; ++b)
#pragma unroll
            for (int m = 0; m < 4; ++m)
#pragma unroll
                for (int n = 0; n < 2; ++n) acc[a][b][m][n] = (f32x4){0.f, 0.f, 0.f, 0.f};
    bf16x8 At[4][2], B0[2][2], B1[2][2];
    v8i_t At8[4], B08[2], B18[2];
    unsigned gA[2][2] = {{0u, 0u}, {0u, 0u}}, gN[2][2] = {{0u, 0u}, {0u, 0u}};
    int bsel = 0;
    f32x4 bpre[4] = {(f32x4){0.f, 0.f, 0.f, 0.f}, (f32x4){0.f, 0.f, 0.f, 0.f}, (f32x4){0.f, 0.f, 0.f, 0.f}, (f32x4){0.f, 0.f, 0.f, 0.f}};
    Pend pend; int ppn = 0, pnv = 0, pq = 8, pbuf = 0;
    if constexpr (DEFER) {
#pragma unroll
        for (int q = 0; q < 8; ++q) pend.val[q] = (u32x2){0u, 0u}; }
#define PG8_PSTORE() do { if constexpr (DEFER) { const int _l3 = lane_id_volatile(); const int _nv = (pq < 8) ? pnv : 0; \
        E.store_one(pend.val[0], ibuf + pbuf * 256, ((pq >> 2) & 1) * HALF + (pq & 3) * 16 + wr * 64 + (_l3 & 15), _nv, ppn * HALF + wc * 32 + 8 * (_l3 >> 4)); \
        _Pragma("unroll") for (int _q = 0; _q < 7; ++_q) pend.val[_q] = pend.val[_q + 1]; ++pq; } } while (0)
    if constexpr (GATHER) { PG8_IDMA(cur, 0); PG8_WAIT_V(0); PG8_BAR; }
    PG8_GOFF(gA, cur, 0);
    const char* cA = S.a_base(cur); const char* cB = S.b_base(cur);
    PG8_STAGE(PG8_SB(0, 0), cB, voffB); PG8_STAGE(PG8_SB(0, 1), cB + hstep, voffB); PG8_STAGE_A(PG8_SA(0, 0), cA, 0, gA); PG8_STAGE_A(PG8_SA(0, 1), cA, 1, gA);
    if (wr == 1) PG8_BAR;
    PG8_WAIT_V(2); PG8_BAR;
    PG8_STAGE(PG8_SB(1, 0), cB + kstep, voffB); PG8_STAGE_A(PG8_SA(1, 0), cA + kstep, 0, gA); PG8_STAGE(PG8_SB(1, 1), cB + hstep + kstep, voffB);
    PG8_WAIT_V(6); PG8_BAR;
    for (;;) {
        const bool has_next = S.next(ui + 1, nxt);
        const char* nA = has_next ? S.a_base(nxt) : cA; const char* nB = has_next ? S.b_base(nxt) : cB;
        const int bnxt = (bsel == 2) ? 0 : bsel + 1;
        if constexpr (GATHER) { if (has_next) PG8_IDMA(nxt, bnxt); }
        for (int t = 0; t < nt; t += 2) {
            const bool last = (t == nt - 2);
            const char* a1 = cA + (size_t)(t + 1) * kstep;
            const char* a2 = last ? nA : cA + (size_t)(t + 2) * kstep; const char* b2 = last ? nB : cB + (size_t)(t + 2) * kstep;
            const char* a3 = a2 + kstep; const char* b3 = b2 + kstep;
            if constexpr (GATHER) { if (last && has_next) { PG8_GOFF(gN, nxt, bnxt); } }
            if constexpr (Epi::HAS_BIAS) { if (last) E.load_bias(cur, wc, lane_id_volatile() >> 4, bpre); }
            PG8_LDB(B0, 0, 0); PG8_LDB(B1, 0, 1); PG8_SCHED; PG8_LDA(At, 0, 0); PG8_STAGE_A(PG8_SA(1, 1), a1, 1, gA);
            if constexpr (GATHER) { if (last && has_next) { gA[0][0] = gN[0][0]; gA[0][1] = gN[0][1]; gA[1][0] = gN[1][0]; gA[1][1] = gN[1][1]; } }
            PG8_WAIT_V(8); PG8_WAIT_L(0); PG8_BAR; PG8_MMA(0, 0, At, B0); PG8_MMA(0, 1, At, B1); PG8_BAR; PG8_SCHED;
            PG8_LDA(At, 0, 1); PG8_STAGE(PG8_SB(0, 0), b2, voffB); PG8_STAGE(PG8_SB(0, 1), b2 + hstep, voffB); PG8_STAGE_A(PG8_SA(0, 0), a2, 0, gA);
            PG8_WAIT_V(8); PG8_WAIT_L(0); PG8_BAR; PG8_MMA(1, 0, At, B0); PG8_MMA(1, 1, At, B1); PG8_BAR; PG8_SCHED;
            PG8_PSTORE();
            PG8_LDB(B0, 1, 0); PG8_LDB(B1, 1, 1); PG8_SCHED; PG8_LDA(At, 1, 0); PG8_STAGE_A(PG8_SA(0, 1), a2, 1, gA);
            PG8_WAIT_V(8); PG8_WAIT_L(0); PG8_BAR; PG8_MMA(0, 0, At, B0); PG8_MMA(0, 1, At, B1); PG8_BAR; PG8_SCHED;
            PG8_LDA(At, 1, 1); PG8_STAGE(PG8_SB(1, 0), b3, voffB); PG8_STAGE(PG8_SB(1, 1), b3 + hstep, voffB); PG8_STAGE_A(PG8_SA(1, 0), a3, 0, gA);
            PG8_WAIT_V(8); PG8_WAIT_L(0); PG8_BAR; PG8_MMA(1, 0, At, B0); PG8_MMA(1, 1, At, B1); PG8_BAR; PG8_SCHED;
            PG8_PSTORE();
        }
        if (ALIGN_EPI) { if (wr == 0) PG8_BAR; }
        { const int l2 = lane_id_volatile(), fr2 = l2 & 15, fq2 = l2 >> 4;
          if constexpr (DEFER) { _Pragma("unroll") for (int _f = 0; _f < 8; ++_f) PG8_PSTORE();
              E.prepare(acc, cur, wr, wc, fr2, fq2, pend); ppn = cur.pn; pnv = S.nvalid(cur); pq = 0; pbuf = bsel; }
          else if constexpr (GATHER) E(acc, cur, wr, wc, fr2, fq2, ibuf + bsel * 256, S.nvalid(cur), bpre); else E(acc, cur, wr, wc, fr2, fq2); }
        if (!has_next) break;
#pragma unroll
        for (int a = 0; a < 2; ++a)
#pragma unroll
            for (int b = 0; b < 2; ++b)
#pragma unroll
                for (int m = 0; m < 4; ++m)
#pragma unroll
                    for (int n = 0; n < 2; ++n) acc[a][b][m][n] = (f32x4){0.f, 0.f, 0.f, 0.f};
        cur = nxt; cA = nA; cB = nB; ++ui; bsel = bnxt;
        if (ALIGN_EPI) { if (wr == 1) PG8_BAR; }
    }
    if constexpr (DEFER) { _Pragma("unroll") for (int _f = 0; _f < 8; ++_f) PG8_PSTORE(); }
    PG8_WAIT_V(0);
    if (!ALIGN_EPI) { if (wr == 0) PG8_BAR; }
    PG8_BAR;
#undef PG8_PSTORE
#undef PG8_SA
#undef PG8_SB
#undef PG8_STAGE
#undef PG8_STAGE_A
#undef PG8_LDA
#undef PG8_LDB
#undef PG8_MMA
#undef PG8_WAIT_V
#undef PG8_WAIT_L
#undef PG8_BAR
#undef PG8_SCHED
#undef PG8_GOFF
#undef PG8_IDMA
}
}

namespace attn_body {
using bf16=__hip_bfloat16;
using bf16x8=__attribute__((ext_vector_type(8)))short;
using s16x4=__attribute__((ext_vector_type(4)))short;
using f32x16=__attribute__((ext_vector_type(16)))float;
using u32x4=__attribute__((ext_vector_type(4)))unsigned;
constexpr int D=64;
constexpr int NW=8,QBLK=32,QB=QBLK*NW,KVBLK=64;
constexpr int ATTN_UNIT_ROWS=QB;
__device__ __forceinline__ int crow(int r,int hi){return (r&3)+8*(r>>2)+4*hi;}
#define SBAR() __builtin_amdgcn_sched_barrier(0)
__device__ __forceinline__ void cmask(f32x16&p0,f32x16&p1,int jb,int qrel,int hi){
  const float NEG=-INFINITY; int kb=64*jb+4*hi;
  #pragma unroll
  for(int r=0;r<16;++r){int kv=kb+(r&3)+8*(r>>2); if(kv>qrel)p0[r]=NEG; if(kv+32>qrel)p1[r]=NEG;}
}

constexpr int NSLOT=3, SLOTB=8192;
constexpr int LDS_K=0, LDS_V=NSLOT*SLOTB, LDS_WS=2*NSLOT*SLOTB, LDS_OST=LDS_WS+NW*64*4, LDS_BYTES=LDS_OST+NW*4096;
constexpr float C2=0.125f*1.4426950408889634f;
__device__ __forceinline__ void glds16(const void*gsrc,unsigned lds_dst){unsigned keep;
  asm volatile("s_mov_b32 %0, m0\n\ts_mov_b32 m0, %2\n\ts_nop 0\n\tglobal_load_lds_dwordx4 %1, off\n\ts_mov_b32 m0, %0":"=&s"(keep):"v"(gsrc),"s"(lds_dst):"memory");}
__device__ __forceinline__ float max3f(float a,float b,float c){float r;asm("v_max3_f32 %0, %1, %2, %3":"=v"(r):"v"(a),"v"(b),"v"(c));return r;}
__device__ __forceinline__ float max2f(float a,float b){float r;asm("v_max_f32_e32 %0, %1, %2":"=v"(r):"v"(a),"v"(b));return r;}
__device__ __forceinline__ float fadd_s(float a,float b){float r;asm("v_add_f32_e32 %0, %1, %2":"=v"(r):"v"(a),"v"(b));return r;}
__device__ __forceinline__ float fsub_s(float a,float b){float r;asm("v_sub_f32_e32 %0, %1, %2":"=v"(r):"v"(a),"v"(b));return r;}
typedef float f32x2_t __attribute__((ext_vector_type(2))); typedef __bf16 bf16x2_t __attribute__((ext_vector_type(2)));
__device__ __forceinline__ unsigned cvtpk_s(float lo,float hi){f32x2_t v={lo,hi};bf16x2_t b=__builtin_convertvector(v,bf16x2_t);return __builtin_bit_cast(unsigned,b);}
#define WAIT_BAR(N) asm volatile("s_waitcnt vmcnt(" #N ") lgkmcnt(0)\n\ts_barrier":::"memory")

__device__ __forceinline__ void qkt(f32x16&p0,f32x16&p1,const char*Kslot,const bf16x8*qr,const f32x16&negm,int r32,int hi){
  const char*kb=Kslot+hi*1024+r32*16;
  #pragma unroll
  for(int d0=0;d0<4;++d0){
    const bf16x8 b0=*reinterpret_cast<const bf16x8*>(kb+d0*2048);
    const bf16x8 b1=*reinterpret_cast<const bf16x8*>(kb+d0*2048+512);
    if(d0==0){p0=__builtin_amdgcn_mfma_f32_32x32x16_bf16(b0,qr[0],negm,0,0,0);p1=__builtin_amdgcn_mfma_f32_32x32x16_bf16(b1,qr[0],negm,0,0,0);}
    else{p0=__builtin_amdgcn_mfma_f32_32x32x16_bf16(b0,qr[d0],p0,0,0,0);p1=__builtin_amdgcn_mfma_f32_32x32x16_bf16(b1,qr[d0],p1,0,0,0);}}
}
typedef __attribute__((address_space(3))) const char* lds_cptr;
typedef short v4i16_t __attribute__((ext_vector_type(4)));
__device__ __forceinline__ void kload8(bf16x8*kf,lds_cptr kp){
  kf[0]=*(const __attribute__((address_space(3))) bf16x8*)(kp);      kf[1]=*(const __attribute__((address_space(3))) bf16x8*)(kp+512);
  kf[2]=*(const __attribute__((address_space(3))) bf16x8*)(kp+2048); kf[3]=*(const __attribute__((address_space(3))) bf16x8*)(kp+2560);
  kf[4]=*(const __attribute__((address_space(3))) bf16x8*)(kp+4096); kf[5]=*(const __attribute__((address_space(3))) bf16x8*)(kp+4608);
  kf[6]=*(const __attribute__((address_space(3))) bf16x8*)(kp+6144); kf[7]=*(const __attribute__((address_space(3))) bf16x8*)(kp+6656);
}
__device__ __forceinline__ void kload2(bf16x8*kf,lds_cptr kp,int j){ kf[2*j]=*(const __attribute__((address_space(3))) bf16x8*)(kp+j*2048); kf[2*j+1]=*(const __attribute__((address_space(3))) bf16x8*)(kp+j*2048+512); }
__device__ __forceinline__ s16x4 vtr(lds_cptr p){ return __builtin_bit_cast(s16x4,__builtin_amdgcn_ds_read_tr16_b64_v4i16((__attribute__((address_space(3))) v4i16_t*)p)); }
__device__ __forceinline__ float rowmax(const f32x16&p0,const f32x16&p1){
  float a=max3f(p0[0],p0[1],p1[0]),b=max3f(p0[2],p0[3],p1[1]);a=max3f(a,p1[2],p1[3]);
  #pragma unroll
  for(int r=4;r<16;r+=4){a=max3f(a,p0[r],p0[r+1]);b=max3f(b,p0[r+2],p0[r+3]);a=max3f(a,p1[r],p1[r+1]);b=max3f(b,p1[r+2],p1[r+3]);}
  const float m=max2f(a,b);
  auto rr=__builtin_amdgcn_permlane32_swap(__float_as_uint(m),__float_as_uint(m),false,false);
  return max2f(__uint_as_float(rr[0]),__uint_as_float(rr[1]));
}
__device__ __forceinline__ void pv(f32x16*o,int vb,bf16x8 pa0,bf16x8 pa1,bf16x8 pa2,bf16x8 pa3){
  #pragma unroll
  for(int d0=0;d0<2;++d0){s16x4 lo[4],hi[4];
    #pragma unroll
    for(int ks=0;ks<4;++ks){
      asm volatile("ds_read_b64_tr_b16 %0,%1 offset:%c2":"=&v"(lo[ks]):"v"(vb),"i"(d0*4096+ks*1024):"memory");
      asm volatile("ds_read_b64_tr_b16 %0,%1 offset:%c2":"=&v"(hi[ks]):"v"(vb),"i"(d0*4096+ks*1024+512):"memory");}
    asm volatile("s_waitcnt lgkmcnt(0)":::"memory");SBAR();
    #define PK(k) (bf16x8){lo[k][0],lo[k][1],lo[k][2],lo[k][3],hi[k][0],hi[k][1],hi[k][2],hi[k][3]}
    o[d0]=__builtin_amdgcn_mfma_f32_32x32x16_bf16(pa0,PK(0),o[d0],0,0,0);
    o[d0]=__builtin_amdgcn_mfma_f32_32x32x16_bf16(pa1,PK(1),o[d0],0,0,0);
    o[d0]=__builtin_amdgcn_mfma_f32_32x32x16_bf16(pa2,PK(2),o[d0],0,0,0);
    o[d0]=__builtin_amdgcn_mfma_f32_32x32x16_bf16(pa3,PK(3),o[d0],0,0,0);
    #undef PK
  }
}

#ifndef ATTN_STORE16
#define ATTN_STORE16(p,v) (*(u32x4*)(p)=(v))
#endif
template<int THRL, bool O8 = false> __device__ __forceinline__ void attn_unit(const bf16*Qu,const bf16*__restrict__ Kh,const bf16*__restrict__ Vh,bf16*Ou,const int QP,const int KP,const int VP,const int OP,const int NT,char*shm,const int tid){
  const int lane=tid&63,r32=lane&31,hi=lane>>5; const int wid=__builtin_amdgcn_readfirstlane(tid>>6);
  const bf16*Qw=Qu+(long)(wid*QBLK)*QP;
  const unsigned lds0=(unsigned)(uintptr_t)shm;
  float*wsf=(float*)(shm+LDS_WS)+wid*64;
  const bf16*ksrc=Kh+(long)lane*KP+wid*8;
  const bf16*vsrc=Vh+(long)(16*(wid&3)+(lane>>2))*VP+(wid>>2)*32+(lane&3)*8;
  const unsigned kdst=lds0+LDS_K+wid*1024, vdst=lds0+LDS_V+wid*1024;
  #define DMA_K(t,slot) glds16(ksrc+(long)(t)*KVBLK*KP,(unsigned)__builtin_amdgcn_readfirstlane(kdst+(slot)))
  #define DMA_V(t,slot) glds16(vsrc+(long)(t)*KVBLK*VP,(unsigned)__builtin_amdgcn_readfirstlane(vdst+(slot)))
  const int vb0=(int)(lds0+LDS_V)+((lane>>4)&1)*32+(lane&3)*8+(4*hi+((lane&15)>>2))*64;
  const char*Kbase=shm+LDS_K; bf16x8 kf[8];
  const lds_cptr shm3=(lds_cptr)shm; const lds_cptr kp0=shm3+LDS_K+hi*1024+r32*16; const lds_cptr vp0=shm3+LDS_V+((lane>>4)&1)*32+(lane&3)*8+(4*hi+((lane&15)>>2))*64;
  DMA_K(0,0);DMA_V(0,0);DMA_K(1,SLOTB);
  bf16x8 qr[4];
  #pragma unroll
  for(int d0=0;d0<4;++d0)qr[d0]=*reinterpret_cast<const bf16x8*>(&Qw[(long)r32*QP+d0*16+hi*8]);
  float mhat=0.f,l_reg=0.f;f32x16 o[2];f32x16 negm; { float z_=0.f; asm volatile("":"+v"(z_)); _Pragma("unroll") for(int r=0;r<16;++r){o[0][r]=z_;o[1][r]=z_;negm[r]=z_;} } asm volatile("":"+v"(negm));
  #define CMASK(P0,P1,t) do{}while(0)
  bool resc=false;
  #define START(P0,P1) do{ const float rm=rowmax(P0,P1); resc=false; \
    { const float dl=rm; mhat=fadd_s(mhat,dl); \
      _Pragma("unroll") for(int r=0;r<16;++r){P0[r]=fsub_s(P0[r],dl);P1[r]=fsub_s(P1[r],dl);} \
      _Pragma("unroll") for(int r=0;r<16;++r)negm[r]=-mhat; asm volatile("":"+v"(negm)); } \
    _Pragma("unroll") for(int r=0;r<16;++r)P0[r]=__builtin_amdgcn_exp2f(P0[r]); }while(0)
  #define RESC() do{ if(resc){ asm volatile("s_waitcnt lgkmcnt(0)":::"memory"); \
      _Pragma("unroll") for(int d_=0;d_<2;++d_) _Pragma("unroll") for(int r=0;r<16;++r)o[d_][r]*=wsf[crow(r,hi)]; } }while(0)
  f32x16 pA0,pA1,pB0,pB1;
  int sl_prev=0,sl_cur=0,sl_next=SLOTB;
  #define ROT() do{sl_prev=sl_cur;sl_cur=sl_next;sl_next=(sl_next==(NSLOT-1)*SLOTB)?0:sl_next+SLOTB;}while(0)
  DMA_K(2,2*SLOTB);
  WAIT_BAR(3);
  qkt(pA0,pA1,Kbase,qr,negm,r32,hi);asm volatile("s_nop 15\n\ts_nop 7":"+v"(pA0),"+v"(pA1));CMASK(pA0,pA1,0);
  START(pA0,pA1);
  _Pragma("unroll") for(int r=0;r<16;++r)pA1[r]=__builtin_amdgcn_exp2f(pA1[r]);
  WAIT_BAR(0);
  DMA_K(3,0);DMA_V(1,SLOTB);
  ROT();
  kload8(kf,kp0+sl_cur);
  WAIT_BAR(2);
  s16x4 vlo[8],vhi[8]; u32x4 pw0,pw1,pw2,pw3;
  #define PKW(P,B) cvtpk_s(P[B],P[B+1])
  #define PAF(k) __builtin_bit_cast(bf16x8,pw##k)
  #define VFR(i) (bf16x8){vlo[i][0],vlo[i][1],vlo[i][2],vlo[i][3],vhi[i][0],vhi[i][1],vhi[i][2],vhi[i][3]}
  #define PIN(x) asm volatile("":"+v"(x))
  #define MX3(a,b,c) __builtin_fmaxf(__builtin_fmaxf((a),(b)),(c))
  #define GAPA(MF,A0,A1,A2,A3,W0,W1,PW) do{ MF; sacc+=A0; sacc+=A1; sacc+=A2; sacc+=A3; PIN(sacc); W0; W1; PIN(PW); SBAR(); }while(0)
  #define EX(v) __builtin_amdgcn_exp2f(v)
  #define GAPB(MF,X,B) do{ MF; X[B]=EX(X[B]); X[B+1]=EX(X[B+1]); X[B+2]=EX(X[B+2]); X[B+3]=EX(X[B+3]); PIN(X); SBAR(); }while(0)
  #define VRD(i) do{ vlo[i]=vtr(vp_+(((i)>>2)*4096+((i)&3)*1024)); vhi[i]=vtr(vp_+(((i)>>2)*4096+((i)&3)*1024+512)); }while(0)
  #define KRD(G,j) do{ if(G){ kload2(kf,kp0+sl_next,j); SBAR(); } }while(0)
  #define STEP(C0,C1,P0,P1,t,GK,GV,GL) do{ SBAR(); \
    const lds_cptr vp_=vp0+sl_prev; \
    VRD(0); SBAR(); float sacc=(P0[0]+P0[1]); \
    GAPA(C0=__builtin_amdgcn_mfma_f32_32x32x16_bf16(kf[0],qr[0],negm,0,0,0), P0[2],P0[3],P0[4],P0[5],     pw0[0]=PKW(P0,0), pw0[1]=PKW(P0,2), pw0); \
    VRD(4); SBAR(); GAPA(C1=__builtin_amdgcn_mfma_f32_32x32x16_bf16(kf[1],qr[0],negm,0,0,0), P0[6],P0[7],P0[8],P0[9],     pw0[2]=PKW(P0,4), pw0[3]=PKW(P0,6), pw0); \
    VRD(1); SBAR(); GAPA(C0=__builtin_amdgcn_mfma_f32_32x32x16_bf16(kf[2],qr[1],C0,0,0,0),   P0[10],P0[11],P0[12],P0[13], pw1[0]=PKW(P0,8), pw1[1]=PKW(P0,10), pw1); \
    VRD(5); SBAR(); GAPA(C1=__builtin_amdgcn_mfma_f32_32x32x16_bf16(kf[3],qr[1],C1,0,0,0),   P0[14],P0[15],P1[0],P1[1],   pw1[2]=PKW(P0,12),pw1[3]=PKW(P0,14), pw1); \
    VRD(2); SBAR(); GAPA(C0=__builtin_amdgcn_mfma_f32_32x32x16_bf16(kf[4],qr[2],C0,0,0,0),   P1[2],P1[3],P1[4],P1[5],     pw2[0]=PKW(P1,0), pw2[1]=PKW(P1,2), pw2); \
    VRD(6); SBAR(); GAPA(C1=__builtin_amdgcn_mfma_f32_32x32x16_bf16(kf[5],qr[2],C1,0,0,0),   P1[6],P1[7],P1[8],P1[9],     pw2[2]=PKW(P1,4), pw2[3]=PKW(P1,6), pw2); \
    VRD(3); SBAR(); GAPA(C0=__builtin_amdgcn_mfma_f32_32x32x16_bf16(kf[6],qr[3],C0,0,0,0),   P1[10],P1[11],P1[12],P1[13], pw3[0]=PKW(P1,8), pw3[1]=PKW(P1,10), pw3); \
    VRD(7); SBAR(); GAPA(C1=__builtin_amdgcn_mfma_f32_32x32x16_bf16(kf[7],qr[3],C1,0,0,0),   P1[14],P1[15],0.f,0.f,       pw3[2]=PKW(P1,12),pw3[3]=PKW(P1,14), pw3); \
    l_reg+=sacc; \
    if(GK){DMA_K((t)+3,sl_cur);} if(GV){DMA_V((t)+1,sl_next);} \
    CMASK(C0,C1,t); \
    { float a=MX3(C0[0],C0[1],C1[0]),b=MX3(C0[2],C0[3],C1[1]); a=MX3(a,C1[2],C1[3]); \
      _Pragma("unroll") for(int r=4;r<16;r+=4){a=MX3(a,C0[r],C0[r+1]);b=MX3(b,C0[r+2],C0[r+3]);a=MX3(a,C1[r],C1[r+1]);b=MX3(b,C1[r+2],C1[r+3]);} \
      float rm=__builtin_fmaxf(a,b); { auto rr=__builtin_amdgcn_permlane32_swap(__float_as_uint(rm),__float_as_uint(rm),false,false); rm=__builtin_fmaxf(__uint_as_float(rr[0]),__uint_as_float(rr[1])); } \
      resc=false; \
      if(__builtin_expect(__any(rm>(float)THRL),0)){ const float dl=__builtin_fmaxf(rm,0.f); mhat+=dl; \
        _Pragma("unroll") for(int r=0;r<16;++r){C0[r]-=dl;C1[r]-=dl;} \
        _Pragma("unroll") for(int r=0;r<16;++r)negm[r]=-mhat; asm volatile("":"+v"(negm)); \
        const float f=__builtin_amdgcn_exp2f(-dl); l_reg*=f; if(hi==0)wsf[r32]=f; resc=true; } } \
    SBAR(); \
    GAPB(o[0]=__builtin_amdgcn_mfma_f32_32x32x16_bf16(PAF(0),VFR(0),o[0],0,0,0), C0,0); \
    GAPB(o[1]=__builtin_amdgcn_mfma_f32_32x32x16_bf16(PAF(0),VFR(4),o[1],0,0,0), C0,4); \
    KRD(GL,0); GAPB(o[0]=__builtin_amdgcn_mfma_f32_32x32x16_bf16(PAF(1),VFR(1),o[0],0,0,0), C0,8); \
    KRD(GL,1); GAPB(o[1]=__builtin_amdgcn_mfma_f32_32x32x16_bf16(PAF(1),VFR(5),o[1],0,0,0), C0,12); \
    KRD(GL,2); GAPB(o[0]=__builtin_amdgcn_mfma_f32_32x32x16_bf16(PAF(2),VFR(2),o[0],0,0,0), C1,0); \
    KRD(GL,3); GAPB(o[1]=__builtin_amdgcn_mfma_f32_32x32x16_bf16(PAF(2),VFR(6),o[1],0,0,0), C1,4); \
    GAPB(o[0]=__builtin_amdgcn_mfma_f32_32x32x16_bf16(PAF(3),VFR(3),o[0],0,0,0), C1,8); \
    GAPB(o[1]=__builtin_amdgcn_mfma_f32_32x32x16_bf16(PAF(3),VFR(7),o[1],0,0,0), C1,12); \
    }while(0)
  int t=1;
  #undef CMASK
  #define CMASK(P0,P1,t) do{}while(0)
  for(;t+5<NT;t+=2){
    STEP(pB0,pB1,pA0,pA1,t,true,true,true);     WAIT_BAR(2); RESC(); ROT();
    STEP(pA0,pA1,pB0,pB1,t+1,true,true,true);   WAIT_BAR(2); RESC(); ROT();
  }
  #undef CMASK
  #define CMASK(P0,P1,t) do{}while(0)
  #define ENDW(tt) do{ if((tt)+3<NT){WAIT_BAR(2);} else if((tt)+2<NT){WAIT_BAR(1);} else {WAIT_BAR(0);} }while(0)
  for(;t+1<NT;t+=2){
    STEP(pB0,pB1,pA0,pA1,t,(t+3<NT),(t+1<NT),(t+1<NT));       ENDW(t);   RESC(); ROT();
    STEP(pA0,pA1,pB0,pB1,t+1,(t+4<NT),(t+2<NT),(t+2<NT));     ENDW(t+1); RESC(); ROT();
  }
  STEP(pB0,pB1,pA0,pA1,NT-1,false,false,false); RESC();
  { float sacc=pB0[0]+pB0[1]; _Pragma("unroll") for(int r=2;r<16;++r)sacc+=pB0[r]; _Pragma("unroll") for(int r=0;r<16;++r)sacc+=pB1[r]; l_reg+=sacc;
    pw0=(u32x4){PKW(pB0,0),PKW(pB0,2),PKW(pB0,4),PKW(pB0,6)};pw1=(u32x4){PKW(pB0,8),PKW(pB0,10),PKW(pB0,12),PKW(pB0,14)};pw2=(u32x4){PKW(pB1,0),PKW(pB1,2),PKW(pB1,4),PKW(pB1,6)};pw3=(u32x4){PKW(pB1,8),PKW(pB1,10),PKW(pB1,12),PKW(pB1,14)};
    SBAR(); pv(o,vb0+sl_cur,PAF(0),PAF(1),PAF(2),PAF(3)); }
  #undef PKW
  #undef PAF
  #undef VFR
  #undef PIN
  #undef MX3
  #undef GAPA
  #undef GAPB
  #undef EX
  #undef VRD
  #undef KRD
  #undef STEP
  #undef ENDW
  {auto rr=__builtin_amdgcn_permlane32_swap(__float_as_uint(l_reg),__float_as_uint(l_reg),false,false);l_reg=__uint_as_float(rr[0])+__uint_as_float(rr[1]);}
  if(hi==0)wsf[32+r32]=l_reg;asm volatile("s_waitcnt lgkmcnt(0)":::"memory");
  float rli[16];
  #pragma unroll
  for(int r=0;r<16;++r)rli[r]=__builtin_amdgcn_rcpf(wsf[32+crow(r,hi)]);
  if constexpr (O8) {
    unsigned char*Ow8=(unsigned char*)Ou+(long)(wid*QBLK)*OP; unsigned char*stg8=(unsigned char*)(shm+LDS_OST)+wid*2048;
    #pragma unroll
    for(int r=0;r<16;++r){const int orow=crow(r,hi);
      #pragma unroll
      for(int d0=0;d0<2;++d0)stg8[orow*64+d0*32+r32]=f2fp8(o[d0][r]*rli[r]);}
    asm volatile("s_waitcnt lgkmcnt(0)":::"memory");
    #pragma unroll
    for(int i=0;i<2;++i){const int row=i*16+(lane>>2),ch=lane&3; const u32x4 v=*(const u32x4*)(stg8+row*64+ch*16); ATTN_STORE16(Ow8+(long)row*OP+ch*16,v);}
  } else {
  bf16*Ow=Ou+(long)(wid*QBLK)*OP;
  { bf16*stg=(bf16*)(shm+LDS_OST)+wid*2048;
    #pragma unroll
    for(int r=0;r<16;++r){const int orow=crow(r,hi);
      #pragma unroll
      for(int d0=0;d0<2;++d0)stg[orow*64+d0*32+r32]=__float2bfloat16(o[d0][r]*rli[r]);}
    asm volatile("s_waitcnt lgkmcnt(0)":::"memory");
    #pragma unroll
    for(int i=0;i<4;++i){const int row=i*8+(lane>>3),ch=lane&7; const u32x4 v=*(const u32x4*)(stg+row*64+ch*8); ATTN_STORE16(Ow+(long)row*OP+ch*8,v);} }
  }
  asm volatile("s_waitcnt lgkmcnt(0)\n\ts_barrier":::"memory");
  #undef DMA_K
  #undef DMA_V
  #undef CMASK
  #undef START
  #undef RESC
  #undef ROT
}
constexpr int ATTN_LDS_BYTES=LDS_BYTES;
#undef SBAR
#undef WAIT_BAR
}

struct Args { const float* in[32]; float* out; unsigned char* ws; int ph_lo, ph_hi; };
struct Ctx {
    LAS unsigned char* lds;
    int vcu, G;
    unsigned char* ws;
};
constexpr int PTAB_OFF = MISC_OFF + 256;
__device__ __forceinline__ unsigned long long ptab_get(const Ctx& cx, int k) {
    const LAS unsigned* t = (const LAS unsigned*)(cx.lds + PTAB_OFF) + 2 * k; const unsigned lo = __builtin_amdgcn_readfirstlane(t[0]), hi = __builtin_amdgcn_readfirstlane(t[1]);
    return ((unsigned long long)hi << 32) | lo;
}
#define INP(k) ((const float*)(GAS const float*)ptab_get(cx, (k)))

template <bool F8> __device__ __forceinline__ void p0_transpose64(const float* W, int N, int KB, unsigned char* WT, int k0, int n0, int dst_row0, float scale, LAS float* scr, int lane) {
    f32x4 v[16];
    const float* src = W + (size_t)(k0 + (lane >> 4)) * N + n0 + (lane & 15) * 4;
#pragma unroll
    for (int i = 0; i < 16; ++i) v[i] = *(const f32x4*)(src + (size_t)(4 * i) * N);
#pragma unroll
    for (int i = 0; i < 16; ++i) { LAS float* p = scr + (4 * i + (lane >> 4)) * 65 + (lane & 15) * 4; p[0] = v[i][0]; p[1] = v[i][1]; p[2] = v[i][2]; p[3] = v[i][3]; }
    LDS_WAIT(); asm volatile("" ::: "memory");
    if constexpr (!F8) {
        const int ns = lane >> 3, ch = lane & 7;
#pragma unroll
        for (int r8 = 0; r8 < 8; ++r8) { const int n = r8 * 8 + ns; const LAS float* s = scr + (8 * ch) * 65 + n;
            u32x4 o; o.x = pk2(s[0 * 65], s[1 * 65]); o.y = pk2(s[2 * 65], s[3 * 65]); o.z = pk2(s[4 * 65], s[5 * 65]); o.w = pk2(s[6 * 65], s[7 * 65]);
            *(GAS u32x4*)(WT + (size_t)(dst_row0 + n) * KB + (k0 + 8 * ch) * 2) = o; }
    } else {
        const int ns = lane >> 2, ch = lane & 3;
#pragma unroll
        for (int r4 = 0; r4 < 4; ++r4) { const int n = r4 * 16 + ns; const LAS float* s = scr + (16 * ch) * 65 + n; unsigned w[4];
#pragma unroll
            for (int q = 0; q < 4; ++q) { int r = 0; r = __builtin_amdgcn_cvt_pk_fp8_f32(s[(4 * q) * 65] * scale, s[(4 * q + 1) * 65] * scale, r, false); r = __builtin_amdgcn_cvt_pk_fp8_f32(s[(4 * q + 2) * 65] * scale, s[(4 * q + 3) * 65] * scale, r, true); w[q] = (unsigned)r; }
            *(GAS u32x4*)(WT + (size_t)(dst_row0 + n) * KB + k0 + 16 * ch) = (u32x4){w[0], w[1], w[2], w[3]}; }
    }
    LDS_WAIT(); asm volatile("" ::: "memory");
}
__device__ __forceinline__ void p0_prologue(const Ctx& cx, const int tid) {
    const int lane = tid & 63, wave = __builtin_amdgcn_readfirstlane(tid >> 6);
    LAS float* scr = (LAS float*)(cx.lds + wave * 16896);
    const int gw = cx.vcu * 8 + wave, NGW = cx.G * 8;
    constexpr int I_WIN0 = 16 * 40, I_WIN1 = 16 * 24, I_WKV = 16 * 8, I_WOUT = 16 * 16, I_W1 = 16 * 32, I_W2 = 16 * 16;
    constexpr int T_WIN = 3 * I_WIN0 + I_WIN1, T_WKV = 4 * I_WKV, T_WOUT = 4 * I_WOUT, T_W1 = 128 * I_W1, T_W2 = 128 * I_W2;
    constexpr int NITEMS = T_WIN + T_WKV + T_WOUT + T_W1 + T_W2;
    for (int it = gw; it < NITEMS; it += NGW) {
        int r = it;
        const float* W; unsigned char* WT; int N, nb, kb, dst_row0; bool isout = false;
        if (r < T_W1) {
            const int mi = r / I_W1, q = r % I_W1; N = 2048; kb = q / 32; nb = q % 32;
            W = INP(28) + (size_t)mi * 1024 * 2048; WT = cx.ws + WS_W1 + (size_t)mi * 2048 * 1024 * MOE_EB;
            const int n0 = nb * 64, isu = n0 >= 1024, j = n0 - isu * 1024;
            dst_row0 = (j >> 7) * 256 + isu * 128 + (j & 127);
            p0_transpose64<MOE_F8>(W, N, 1024 * MOE_EB, WT, kb * 64, nb * 64, dst_row0, W1_SCALE, scr, lane); continue;
        } else if ((r -= T_W1) < T_W2) {
            const int mi = r / I_W2, q = r % I_W2; N = 1024; kb = q / 16; nb = q % 16;
            W = INP(30) + (size_t)mi * 1024 * 1024; WT = cx.ws + WS_W2 + (size_t)mi * 1024 * 1024 * MOE_EB; dst_row0 = nb * 64;
            p0_transpose64<MOE_F8>(W, N, 1024 * MOE_EB, WT, kb * 64, nb * 64, dst_row0, W2_SCALE, scr, lane); continue;
        } else if ((r -= T_W2) < T_WIN) {
            int l, q;
            if (r < I_WIN0) { l = 0; q = r; } else if (r < I_WIN0 + I_WIN1) { l = 1; q = r - I_WIN0; } else if (r < 2 * I_WIN0 + I_WIN1) { l = 2; q = r - I_WIN0 - I_WIN1; } else { l = 3; q = r - 2 * I_WIN0 - I_WIN1; }
            N = in_width(l); const int nbn = N / 64; kb = q / nbn; nb = q % nbn;
            const int kind = layer_kind(l), j = layer_j(l);
            W = (kind == 0 ? INP(2) : kind == 1 ? INP(4) : INP(7)) + (size_t)j * 1024 * N;
            WT = cx.ws + WS_WIN + (size_t)l * 5 * MiB; dst_row0 = nb * 64;
        } else if ((r -= T_WIN) < T_WKV) {
            const int l = r / I_WKV, q = r % I_WKV; N = 512; kb = q / 8; nb = q % 8;
            W = INP(20) + (size_t)l * 1024 * 512; WT = cx.ws + WS_WKV; dst_row0 = l * 512 + nb * 64;
        } else {
            r -= T_WKV; const int l = r / I_WOUT, q = r % I_WOUT; N = 1024; kb = q / 16; nb = q % 16;
            W = INP(21) + (size_t)l * 1024 * 1024; WT = cx.ws + WS_WOUT + (size_t)l * 2 * MiB; dst_row0 = nb * 64; isout = true;
        }
        if (isout) p0_transpose64<OUTP_F8 != 0>(W, N, 1024 * OUT_EB, WT, kb * 64, nb * 64, dst_row0, OUTP_F8 ? WOUT_SCALE : 1.0f, scr, lane);
        else p0_transpose64<INP_F8 != 0>(W, N, 1024 * INP_EB, WT, kb * 64, nb * 64, dst_row0, INP_F8 ? WIN_SCALE : 1.0f, scr, lane);
    }
    {
        const size_t gt = (size_t)cx.vcu * 512 + tid, NT_ = (size_t)cx.G * 512;
        for (int which = 0; which < 2; ++which) {
            const f32x4* xs = (const f32x4*)(which == 0 ? INP(0) : INP(1)); unsigned char* xd = cx.ws + (which == 0 ? WS_XB : WS_MEMB); const size_t n8 = (size_t)(which == 0 ? NTOK : NMEM) * DM / 8;
#pragma unroll 4
            for (size_t i = gt; i < n8; i += NT_) { const f32x4 a = xs[2 * i], b = xs[2 * i + 1];
                if constexpr (INP_F8) { int w0 = 0, w1 = 0; w0 = __builtin_amdgcn_cvt_pk_fp8_f32(a[0], a[1], w0, false); w0 = __builtin_amdgcn_cvt_pk_fp8_f32(a[2], a[3], w0, true); w1 = __builtin_amdgcn_cvt_pk_fp8_f32(b[0], b[1], w1, false); w1 = __builtin_amdgcn_cvt_pk_fp8_f32(b[2], b[3], w1, true);
                    *(u32x2*)(xd + i * 8) = (u32x2){(unsigned)w0, (unsigned)w1}; }
                else { u32x4 o; o.x = pk2(a[0], a[1]); o.y = pk2(a[2], a[3]); o.z = pk2(b[0], b[1]); o.w = pk2(b[2], b[3]); *(u32x4*)(xd + i * 16) = o; } }
        }
    }
    { const float* rwp = INP(26); unsigned short* RW = (unsigned short*)(cx.ws + WS_RW);
      for (int i = cx.vcu * 512 + tid; i < 4 * 32768; i += cx.G * 512) { const int l = i >> 15, r = i & 32767, k = r >> 5, e = r & 31; const float w = rwp[i]; const unsigned hi = f2bf(w); const float wl = w - bf2f((unsigned short)hi);
          RW[((size_t)(l * 2 + 0) * 32 + e) * 1024 + k] = (unsigned short)hi; RW[((size_t)(l * 2 + 1) * 32 + e) * 1024 + k] = (unsigned short)f2bf(wl); } }
    {
        const float *fw1 = INP(10), *fb1 = INP(11), *fw2 = INP(12), *fb2 = INP(13), *fw3 = INP(14), *fb3 = INP(15), *fw4 = INP(16), *fb4 = INP(17), *ffr = INP(18);
        LAS float* z = (LAS float*)cx.lds; LAS float* h1 = z + 16 * 33; LAS float* h2 = h1 + 1024; LAS float* h3 = h2 + 1024;
        float* HRAWT = (float*)(cx.ws + WS_HRAWT); float* HPART = (float*)(cx.ws + WS_HPART);
        for (int it = cx.vcu; it < 256; it += cx.G) {
            __syncthreads();
            const int pos0 = it * 16;
            for (int i = tid; i < 16 * 33; i += 512) { const int p = i / 33, f = i % 33; const float pos = (float)(pos0 + p); float v;
                if (f == 0) v = pos / 4095.0f;
                else { const int k = (f - 1) & 15; const float fb = 1e-4f + (float)k * ((15.0f - 1e-4f) / 15.0f); const float ang = (6.283185307179586f * pos / 4096.0f) * fb; v = (f <= 16) ? cosf(ang) : -sinf(ang); }
                z[i] = v; }
            __syncthreads();
            for (int i = tid; i < 1024; i += 512) { const int p = i >> 6, o = i & 63; float a = fb1[o]; for (int f = 0; f < 33; ++f) a += z[p * 33 + f] * fw1[f * 64 + o]; h1[i] = sinf(ffr[o] * a); }
            __syncthreads();
            for (int i = tid; i < 1024; i += 512) { const int p = i >> 6, o = i & 63; float a = fb2[o]; for (int k = 0; k < 64; ++k) a += h1[p * 64 + k] * fw2[k * 64 + o]; h2[i] = sinf(ffr[o] * a); }
            __syncthreads();
            for (int i = tid; i < 1024; i += 512) { const int p = i >> 6, o = i & 63; float a = fb3[o]; for (int k = 0; k < 64; ++k) a += h2[p * 64 + k] * fw3[k * 64 + o]; h3[i] = sinf(ffr[o] * a); }
            __syncthreads();
            for (int col = tid; col < 3072; col += 512) {
                float a[16]; const float bb = fb4[col];
#pragma unroll
                for (int p = 0; p < 16; ++p) a[p] = bb;
                for (int k = 0; k < 64; ++k) { const float w = fw4[(size_t)k * 3072 + col];
#pragma unroll
                    for (int p = 0; p < 16; ++p) a[p] += h3[p * 64 + k] * w; }
                const int c = col % 768; const float mind = -3.0701134573253945f, maxd = -15.350567286626972f;
                const float delta = fabsf(mind + (maxd - mind) * ((float)c / 767.0f)); float asum = 0.f;
#pragma unroll
                for (int p = 0; p < 16; ++p) { const float t = (float)(pos0 + p) / 4095.0f; a[p] *= expf(-t * delta); asum += fabsf(a[p]); }
                f32x4* dst = (f32x4*)(HRAWT + (size_t)col * 4096 + pos0);
#pragma unroll
                for (int q = 0; q < 4; ++q) dst[q] = (f32x4){a[4 * q], a[4 * q + 1], a[4 * q + 2], a[4 * q + 3]};
                HPART[(size_t)it * 3072 + col] = asum;
            }
        }
    }
}

__device__ __forceinline__ s16x4 vtr(const LAS unsigned char* p) { typedef short v4i16_t __attribute__((ext_vector_type(4))); return __builtin_bit_cast(s16x4, __builtin_amdgcn_ds_read_tr16_b64_v4i16((LAS v4i16_t*)p)); }
__device__ __forceinline__ void na_phase(const Ctx& cx, const bf16_t* PROJ, const float* rpb, bf16_t* CAT, const int tid) {
    const int lane = tid & 63, wid = __builtin_amdgcn_readfirstlane(tid >> 6), m16 = lane & 15, q4 = lane >> 4;
    LAS unsigned char* Kb = cx.lds; LAS unsigned char* Vb = cx.lds + 73728; LAS float* biasL = (LAS float*)(cx.lds + 147456);
    constexpr int PW = 2560;
    u32x4 kv[9], vv[9]; float bpre = 0.f; bf16x8 qn[2];
#define NA_LOAD(unit_) do { const int b_ = __builtin_amdgcn_readfirstlane((unit_) / 384), rem_ = __builtin_amdgcn_readfirstlane((unit_) % 384), h_ = rem_ >> 5, rp_ = rem_ & 31; int bs_ = 2 * rp_ - 4; bs_ = bs_ < 0 ? 0 : (bs_ > 56 ? 56 : bs_); bs_ = __builtin_amdgcn_readfirstlane(bs_); \
        _Pragma("unroll") for (int it = 0; it < 9; ++it) { const int i = tid + it * 512; const int brow = i >> 9, col = (i >> 3) & 63, ch = i & 7; int grow = bs_ + brow; grow = grow > 63 ? 63 : grow; \
            const size_t tok = (size_t)b_ * 4096 + grow * 64 + col; \
            kv[it] = *(const u32x4*)(PROJ + tok * PW + 768 + h_ * 64 + ch * 8); vv[it] = *(const u32x4*)(PROJ + tok * PW + 1536 + h_ * 64 + ch * 8); } \
        if (tid < 465) bpre = rpb[h_ * 465 + tid];   \
        { const size_t tq_ = (size_t)b_ * 4096 + (2 * rp_ + (wid >> 2)) * 64 + 16 * (wid & 3) + m16; \
          _Pragma("unroll") for (int kk = 0; kk < 2; ++kk) qn[kk] = *(const bf16x8*)(PROJ + tq_ * PW + h_ * 64 + 32 * kk + 8 * q4); } } while (0)
    int u0 = cx.vcu; asm volatile("" : "+s"(u0));
    if (u0 < 6144) NA_LOAD(u0);
    for (int unit = u0; unit < 6144; unit += cx.G) {
        const int b = unit / 384, rem = unit % 384, h = rem >> 5, rp = rem & 31;
        int bs = 2 * rp - 4; bs = bs < 0 ? 0 : (bs > 56 ? 56 : bs);
        __syncthreads();
#pragma unroll
        for (int it = 0; it < 9; ++it) { const int i = tid + it * 512; const int brow = i >> 9, col = (i >> 3) & 63, ch = i & 7;
            *(LAS u32x4*)(Kb + (brow * 64 + col) * 128 + ((ch ^ ((col >> 1) & 7)) << 4)) = kv[it];
            *(LAS u32x4*)(Vb + (brow * 64 + col) * 128 + ((ch ^ (col & 7)) << 4)) = vv[it]; }
        if (tid < 465) biasL[tid] = bpre * LOG2E;
        __syncthreads();
        bf16x8 qf[2]; qf[0] = qn[0]; qf[1] = qn[1];
        { const int un_ = (unit + cx.G < 6144) ? unit + cx.G : unit; NA_LOAD(un_); }
        const int r = 2 * rp + (wid >> 2), g = wid & 3;
        const int wc0 = (g == 0) ? 0 : (g == 1) ? 8 : (g == 2) ? 24 : 32;
        int r0 = r - 4; r0 = r0 < 0 ? 0 : (r0 > 56 ? 56 : r0); const int ro = r0 - bs;
        const int c = 16 * g + m16;
        const size_t tq = (size_t)b * 4096 + r * 64 + c;
        f32x4 S[16];
#pragma unroll
        for (int i = 0; i < 8; ++i)
#pragma unroll
            for (int ct = 0; ct < 2; ++ct) { const int col = wc0 + 16 * ct + m16; const LAS unsigned char* kp = Kb + ((ro + i) * 64 + col) * 128; const int sw = (col >> 1) & 7;
                f32x4 a = (f32x4){0.f, 0.f, 0.f, 0.f};
#pragma unroll
                for (int kk = 0; kk < 2; ++kk) { const bf16x8 kf = *(const LAS bf16x8*)(kp + (((q4 + 4 * kk) ^ sw) << 4)); a = __builtin_amdgcn_mfma_f32_16x16x32_bf16(kf, qf[kk], a, 0, 0, 0); }
                S[2 * i + ct] = a; }
        int c0 = c - 8; c0 = c0 < 0 ? 0 : (c0 > 48 ? 48 : c0);
        float mx = -INFINITY;
#pragma unroll
        for (int i = 0; i < 8; ++i)
#pragma unroll
            for (int ct = 0; ct < 2; ++ct)
#pragma unroll
                for (int v = 0; v < 4; ++v) { const int kc = wc0 + 16 * ct + 4 * q4 + v; const bool valid = (kc >= c0) && (kc < c0 + 16);
                    const int bidx = valid ? (r0 + i - r + 7) * 31 + (kc - c + 15) : 0;
                    const float s = valid ? S[2 * i + ct][v] + biasL[bidx] : -INFINITY; S[2 * i + ct][v] = s; mx = fmaxf(mx, s); }
        mx = fmaxf(mx, shflx(mx, 16, lane)); mx = fmaxf(mx, shflx(mx, 32, lane));
        float l = 0.f;
#pragma unroll
        for (int t = 0; t < 16; ++t)
#pragma unroll
            for (int v = 0; v < 4; ++v) { const float p = __builtin_amdgcn_exp2f(S[t][v] - mx); S[t][v] = p; l += p; }
        l += shflx(l, 16, lane); l += shflx(l, 32, lane);
        f32x4 O[4];
#pragma unroll
        for (int dt = 0; dt < 4; ++dt) O[dt] = (f32x4){0.f, 0.f, 0.f, 0.f};
        const int qq = m16 >> 2, pp = m16 & 3, col1 = wc0 + 4 * q4 + qq;
#pragma unroll
        for (int i = 0; i < 8; ++i) {
            u32x4 pw; pw.x = pk2(S[2 * i][0], S[2 * i][1]); pw.y = pk2(S[2 * i][2], S[2 * i][3]); pw.z = pk2(S[2 * i + 1][0], S[2 * i + 1][1]); pw.w = pk2(S[2 * i + 1][2], S[2 * i + 1][3]);
            const bf16x8 pb = __builtin_bit_cast(bf16x8, pw);
            const LAS unsigned char* v1 = Vb + ((ro + i) * 64 + col1) * 128 + 8 * (pp & 1);
            const LAS unsigned char* v2 = v1 + 16 * 128;
#pragma unroll
            for (int dt = 0; dt < 4; ++dt) { const int chunk = 2 * dt + (pp >> 1);
                const s16x4 lo = vtr(v1 + ((chunk ^ (col1 & 7)) << 4)), hi = vtr(v2 + ((chunk ^ ((col1 + 16) & 7)) << 4));
                const bf16x8 vf = (bf16x8){lo[0], lo[1], lo[2], lo[3], hi[0], hi[1], hi[2], hi[3]};
                O[dt] = __builtin_amdgcn_mfma_f32_16x16x32_bf16(vf, pb, O[dt], 0, 0, 0); }
        }
        const float inv = 1.0f / l;
#pragma unroll
        for (int dt = 0; dt < 4; ++dt) {
            if constexpr (OUTP_F8) { int w = 0; w = __builtin_amdgcn_cvt_pk_fp8_f32(O[dt][0] * inv, O[dt][1] * inv, w, false); w = __builtin_amdgcn_cvt_pk_fp8_f32(O[dt][2] * inv, O[dt][3] * inv, w, true); *(int*)((unsigned char*)CAT + tq * 1024 + h * 64 + 16 * dt + 4 * q4) = w; }
            else { u32x2 w; w.x = pk2(O[dt][0] * inv, O[dt][1] * inv); w.y = pk2(O[dt][2] * inv, O[dt][3] * inv); *(u32x2*)(CAT + tq * 1024 + h * 64 + 16 * dt + 4 * q4) = w; } }
    }
    __syncthreads();
}

#undef NA_LOAD
__device__ __forceinline__ void rope_phase(const Ctx& cx, const bf16_t* PROJ, const float* qg, const float* kg, bf16_t* QKR, const int tid) {
    const int lane = tid & 63, wave = __builtin_amdgcn_readfirstlane(tid >> 6);
    const int gw = cx.vcu * 8 + wave, NGW = cx.G * 8;
    const int d0 = (lane & 7) * 8;
    float gq[8], gk[8], invf[4];
#pragma unroll
    for (int e = 0; e < 8; ++e) { gq[e] = qg[d0 + e]; gk[e] = kg[d0 + e]; }
#pragma unroll
    for (int p = 0; p < 4; ++p) { const int i = (d0 >> 1) + p, j = i & 15; invf[p] = exp2f(-(float)(2 * j) / 32.0f * 13.287712379549449f); }
    const bool isrow = (d0 >> 1) < 16;
    for (int pos = gw; pos < SEQ; pos += NGW) {
        const float pr = isrow ? (float)(pos >> 6) : (float)(pos & 63);
        float cs[4], sn[4];
#pragma unroll
        for (int p = 0; p < 4; ++p) { const float a = pr * invf[p]; cs[p] = cosf(a); sn[p] = sinf(a); }
#pragma unroll 1
        for (int bg = 0; bg < BATCH; bg += 4) {
        u32x4 rawv[4][2];
#pragma unroll
        for (int bq = 0; bq < 4; ++bq)
#pragma unroll
            for (int half = 0; half < 2; ++half) rawv[bq][half] = *(const u32x4*)(PROJ + (size_t)((bg + bq) * SEQ + pos) * 1536 + half * 512 + lane * 8);
        __builtin_amdgcn_sched_barrier(0);
#pragma unroll
        for (int bq = 0; bq < 4; ++bq) { const int tok = (bg + bq) * SEQ + pos;
#pragma unroll
        for (int half = 0; half < 2; ++half) {
            const int e0 = half * 512 + lane * 8; const int head = e0 >> 6; const bool isq = head < 12;
            const u32x4 raw = rawv[bq][half];
            float x[8]; x[0] = bflo(raw.x); x[1] = bfhi(raw.x); x[2] = bflo(raw.y); x[3] = bfhi(raw.y); x[4] = bflo(raw.z); x[5] = bfhi(raw.z); x[6] = bflo(raw.w); x[7] = bfhi(raw.w);
            float ss = 0.f;
#pragma unroll
            for (int e = 0; e < 8; ++e) ss += x[e] * x[e];
            ss = group8_sum(ss);
            const float inv = rsqrtf(ss * (1.0f / 64.0f) + 1e-6f);
            float y[8];
#pragma unroll
            for (int e = 0; e < 8; ++e) y[e] = x[e] * inv * (isq ? gq[e] : gk[e]);
            const float sc = isq ? C2 : 1.0f;
            float o[8];
#pragma unroll
            for (int p = 0; p < 4; ++p) { o[2 * p] = (y[2 * p] * cs[p] - y[2 * p + 1] * sn[p]) * sc; o[2 * p + 1] = (y[2 * p] * sn[p] + y[2 * p + 1] * cs[p]) * sc; }
            u32x4 w; w.x = pk2(o[0], o[1]); w.y = pk2(o[2], o[3]); w.z = pk2(o[4], o[5]); w.w = pk2(o[6], o[7]);
            *(u32x4*)(QKR + (size_t)tok * 1024 + e0) = w;
        } } }
    }
}

__device__ __forceinline__ void sconv_phase(const Ctx& cx, const bf16_t* PROJ, const float* cw, const float* cb, bf16_t* UT3, unsigned char* V8, const int tid) {
    const int lane = tid & 63, wave = __builtin_amdgcn_readfirstlane(tid >> 6);
    const int gw = cx.vcu * 8 + wave, NGW = cx.G * 8;
    LAS unsigned short* tile = (LAS unsigned short*)(cx.lds + wave * 9216);
    constexpr int PW = 2560;
    for (int it = gw; it < 16 * 64 * 36; it += NGW) {
        const int ct = it % 36, tt = (it / 36) & 63, b = it / (36 * 64);
        const int col = ct * 64 + lane, t0 = tt * 64;
        const float w0 = cw[col], w1 = cw[2304 + col], w2 = cw[4608 + col], bia = cb[col];
        const bf16_t* src = PROJ + ((size_t)b * 4096 + t0) * PW + col;
        unsigned short uu[66];
        uu[0] = (t0 > 0) ? src[-(long)PW] : (unsigned short)0;
#pragma unroll
        for (int k = 0; k < 64; ++k) uu[k + 1] = src[(size_t)k * PW];
        uu[65] = (t0 + 64 < 4096) ? src[(size_t)64 * PW] : (unsigned short)0;
#pragma unroll
        for (int k = 0; k < 64; ++k) { const float v = bf2f(uu[k]) * w0 + bf2f(uu[k + 1]) * w1 + bf2f(uu[k + 2]) * w2 + bia; tile[lane * 72 + k] = (unsigned short)f2bf(v); }
        LDS_WAIT(); asm volatile("" ::: "memory");
        const int part = (ct * 64) / 768, cbase = (ct * 64) % 768;
#pragma unroll
        for (int k = 0; k < 8; ++k) { const int row = k * 8 + (lane >> 3), chn = lane & 7;
            const u32x4 v = *(const LAS u32x4*)((const LAS unsigned char*)tile + row * 144 + chn * 16);
            *(u32x4*)(UT3 + (((size_t)part * 16 + b) * 768 + cbase + row) * 4096 + t0 + chn * 8) = v;
            if (TCONV_F8 && part == 0) { int w0 = 0, w1 = 0;
                w0 = __builtin_amdgcn_cvt_pk_fp8_f32(bflo(v.x), bfhi(v.x), w0, false); w0 = __builtin_amdgcn_cvt_pk_fp8_f32(bflo(v.y), bfhi(v.y), w0, true);
                w1 = __builtin_amdgcn_cvt_pk_fp8_f32(bflo(v.z), bfhi(v.z), w1, false); w1 = __builtin_amdgcn_cvt_pk_fp8_f32(bflo(v.w), bfhi(v.w), w1, true);
                *(u32x2*)(V8 + ((size_t)b * 768 + cbase + row) * 4096 + t0 + chn * 8) = (u32x2){(unsigned)w0, (unsigned)w1}; } }
        LDS_WAIT(); asm volatile("" ::: "memory");
    }
}

constexpr int TZ_CS = 16384 + 64;
__device__ __forceinline__ void tconv_phase(const Ctx& cx, const int o, const bf16_t* UT, const bf16_t* GT, bf16_t* ZT, const float* lbias  , const int tid) {
    const int lane = tid & 63, wid = __builtin_amdgcn_readfirstlane(tid >> 6), m16 = lane & 15, q4 = lane >> 4;
    const float* HRAWT = (const float*)(cx.ws + WS_HRAWT); const float* HPART = (const float*)(cx.ws + WS_HPART);
    LAS unsigned char* cp = cx.lds; LAS float* red = (LAS float*)(cx.lds + 8 * TZ_CS);
    for (int c = cx.vcu; c < 768; c += cx.G) {
        __syncthreads();
        { const int dir = tid >> 8, blk = tid & 255; float v = HPART[(size_t)blk * 3072 + dir * 1536 + o * 768 + c]; v = wave_sum(v, lane); if (lane == 0) red[wid] = v; }
        __syncthreads();
        float nrm = 0.f;
#pragma unroll
        for (int w = 0; w < 8; ++w) nrm += red[w];
        const float inv = 1.0f / nrm;
        const float* hf = HRAWT + (size_t)(o * 768 + c) * 4096; const float* hb = HRAWT + (size_t)(1536 + o * 768 + c) * 4096;
        for (int i = tid; i < 8192; i += 512) { float v; if (i < 4096) v = hf[4095 - i]; else if (i < 8191) v = hb[i - 4095]; else v = 0.f;
            *(LAS unsigned short*)(cp + 2 * i) = (unsigned short)f2bf(v * inv); }
        __syncthreads();
#pragma unroll
        for (int j = 1; j < 8; ++j)
            for (int n = tid; n < 1024; n += 512) {
                const u32x4 lo = *(const LAS u32x4*)(cp + n * 16); u32x4 hi = (u32x4){0u, 0u, 0u, 0u}; if (n + 1 < 1024) hi = *(const LAS u32x4*)(cp + (n + 1) * 16);
                const unsigned w[8] = {lo.x, lo.y, lo.z, lo.w, hi.x, hi.y, hi.z, hi.w}; u32x4 r;
                const int a = j >> 1;
                if (j & 1) { r.x = (w[a] >> 16) | (w[a + 1] << 16); r.y = (w[a + 1] >> 16) | (w[a + 2] << 16); r.z = (w[a + 2] >> 16) | (w[a + 3] << 16); r.w = (w[a + 3] >> 16) | (w[a + 4] << 16); }
                else { r.x = w[a]; r.y = w[a + 1]; r.z = w[a + 2]; r.w = w[a + 3]; }
                *(LAS u32x4*)(cp + j * TZ_CS + n * 16) = r;
            }
        __syncthreads();
        const int j = (7 - m16) & 7;
        const int nbase = (4095 - 512 * wid - m16 - j + 8 * q4) >> 3;
        const LAS unsigned char* ap = cp + j * TZ_CS + (nbase - 62) * 16;
        const bf16_t* up = UT + ((size_t)m16 * 768 + c) * 4096 + 8 * q4;
        f32x4 acc[32];
#pragma unroll
        for (int ti = 0; ti < 32; ++ti) acc[ti] = (f32x4){0.f, 0.f, 0.f, 0.f};
        bf16x8 bcur = *(const bf16x8*)(up);
        bf16x8 afA[8], afB[8];
#pragma unroll
        for (int i = 0; i < 8; ++i) afA[i] = *(const LAS bf16x8*)(ap + (31 - i) * 32);
        for (int ks = 0; ks < 128; ++ks) {
            const bf16x8 bnext = *(const bf16x8*)(up + ((ks + 1) & 127) * 32);
            const LAS unsigned char* a0 = ap + ks * 64;
            const LAS unsigned char* a1 = ap + ((ks + 1) & 127) * 64;
#define TZ_LD(dst, base, g) do { _Pragma("unroll") for (int i = 0; i < 8; ++i) dst[i] = *(const LAS bf16x8*)((base) + (31 - (8 * (g) + i)) * 32); } while (0)
#define TZ_MM(src, g) do { _Pragma("unroll") for (int i = 0; i < 8; ++i) acc[8 * (g) + i] = __builtin_amdgcn_mfma_f32_16x16x32_bf16(src[i], bcur, acc[8 * (g) + i], 0, 0, 0); } while (0)
            TZ_LD(afB, a0, 1); TZ_MM(afA, 0); __builtin_amdgcn_sched_barrier(0);
            TZ_LD(afA, a0, 2); TZ_MM(afB, 1); __builtin_amdgcn_sched_barrier(0);
            TZ_LD(afB, a0, 3); TZ_MM(afA, 2); __builtin_amdgcn_sched_barrier(0);
            TZ_LD(afA, a1, 0); TZ_MM(afB, 3); __builtin_amdgcn_sched_barrier(0);
#undef TZ_LD
#undef TZ_MM
            bcur = bnext;
        }
        const float lb = lbias[c];
        const size_t rowoff = ((size_t)m16 * 768 + c) * 4096 + 512 * wid + 4 * q4;
#pragma unroll
        for (int ti = 0; ti < 32; ++ti) {
            const u32x2 uu = *(const u32x2*)(UT + rowoff + 16 * ti), gg = *(const u32x2*)(GT + rowoff + 16 * ti);
            const float y0 = (acc[ti][0] + lb * bflo(uu.x)) * bflo(gg.x), y1 = (acc[ti][1] + lb * bfhi(uu.x)) * bfhi(gg.x), y2 = (acc[ti][2] + lb * bflo(uu.y)) * bflo(gg.y), y3 = (acc[ti][3] + lb * bfhi(uu.y)) * bfhi(gg.y);
            u32x2 w; w.x = pk2(y0, y1); w.y = pk2(y2, y3);
            *(u32x2*)(ZT + rowoff + 16 * ti) = w;
            if ((ti & 7) == 7) __builtin_amdgcn_sched_barrier(0);
        }
    }
    __syncthreads();
}

constexpr int T8_CS = 8192 + 256;
__host__ __device__ constexpr int t8_sig(int j) { return j < 4 ? 2 * j : (j >= 12 ? 2 * (j - 8) : 2 * (j - 4) + 1); }
__device__ __forceinline__ float wave_max_nn(float v) {
    v = fmaxf(v, dpp_x<0xB1>(v)); v = fmaxf(v, dpp_x<0x4E>(v)); v = fmaxf(v, dpp_x<0x141>(v)); v = fmaxf(v, dpp_x<0x140>(v));
    v = fmaxf(v, __builtin_bit_cast(float, __builtin_amdgcn_update_dpp(0, __builtin_bit_cast(int, v), 0x142, 0xA, 0xF, false)));
    v = fmaxf(v, __builtin_bit_cast(float, __builtin_amdgcn_update_dpp(0, __builtin_bit_cast(int, v), 0x143, 0xC, 0xF, false)));
    return __builtin_bit_cast(float, __builtin_amdgcn_readlane(__builtin_bit_cast(int, v), 63));
}
__device__ __forceinline__ void tconv8_phase(const Ctx& cx, const int o, const bf16_t* UT, const unsigned char* U8, const bf16_t* GT, bf16_t* ZT, unsigned char* Z8  ,
                                             const float* lbias, const int tid) {
    const int lane = tid & 63, wid = __builtin_amdgcn_readfirstlane(tid >> 6), m16 = lane & 15, q4 = lane >> 4;
    const float* HRAWT = (const float*)(cx.ws + WS_HRAWT); const float* HPART = (const float*)(cx.ws + WS_HPART);
    LAS unsigned char* cp = cx.lds; LAS float* red = (LAS float*)(cx.lds + 16 * T8_CS);
    for (int c = cx.vcu; c < 768; c += cx.G) {
        __syncthreads();
        const float* hf = HRAWT + (size_t)(o * 768 + c) * 4096; const float* hb = HRAWT + (size_t)(1536 + o * 768 + c) * 4096;
        float tap[16]; float mx = 0.f;
        int t3 = tid; asm volatile("" : "+v"(t3));
#pragma unroll
        for (int k = 0; k < 16; ++k) { const int i = t3 * 16 + k; float v; if (i < 4096) v = hf[4095 - i]; else if (i < 8191) v = hb[i - 4095]; else v = 0.f; tap[k] = v; mx = fmaxf(mx, fabsf(v)); }
        { const int dir = tid >> 8, blk = tid & 255; float v = HPART[(size_t)blk * 3072 + dir * 1536 + o * 768 + c]; v = wave_sum(v, lane); mx = wave_max_nn(mx); if (lane == 0) { red[wid] = v; red[8 + wid] = mx; } }
        __syncthreads();
        float nrm = 0.f, mall = 0.f;
#pragma unroll
        for (int w = 0; w < 8; ++w) { nrm += red[w]; mall = fmaxf(mall, red[8 + w]); }
        const float inv = 1.0f / nrm;
        int ex; (void)frexpf(fmaxf(mall * inv, 1e-30f), &ex);
        const float fsc = ldexpf(1.0f, 7 - ex), unsc = ldexpf(1.0f, ex - 7), tsc = inv * fsc;
        { unsigned w[4];
#pragma unroll
          for (int q = 0; q < 4; ++q) { int r = 0; r = __builtin_amdgcn_cvt_pk_fp8_f32(tap[4 * q] * tsc, tap[4 * q + 1] * tsc, r, false); r = __builtin_amdgcn_cvt_pk_fp8_f32(tap[4 * q + 2] * tsc, tap[4 * q + 3] * tsc, r, true); w[q] = (unsigned)r; }
          *(LAS u32x4*)(cp + tid * 16) = (u32x4){w[0], w[1], w[2], w[3]}; }
        __syncthreads();
        { const u32x4 lo = *(const LAS u32x4*)(cp + tid * 16); u32x4 hi = (u32x4){0u, 0u, 0u, 0u}; if (tid + 1 < 512) hi = *(const LAS u32x4*)(cp + (tid + 1) * 16);
          const unsigned w[8] = {lo.x, lo.y, lo.z, lo.w, hi.x, hi.y, hi.z, hi.w};
#pragma unroll
          for (int j = 1; j < 16; ++j) { u32x4 r; const int a = j >> 2, sh = j & 3;
              r.x = sh ? __builtin_amdgcn_alignbyte(w[a + 1], w[a], sh) : w[a]; r.y = sh ? __builtin_amdgcn_alignbyte(w[a + 2], w[a + 1], sh) : w[a + 1];
              r.z = sh ? __builtin_amdgcn_alignbyte(w[a + 3], w[a + 2], sh) : w[a + 2]; r.w = sh ? __builtin_amdgcn_alignbyte(w[a + 4], w[a + 3], sh) : w[a + 3];
              *(LAS u32x4*)(cp + j * T8_CS + t8_sig(j) * 16 + tid * 16) = r; } }
        __syncthreads();
        const int jc = 15 - m16;
        const int nbase = 255 - 32 * wid + 2 * q4;
        const LAS unsigned char* ap = cp + jc * T8_CS + t8_sig(jc) * 16 + (nbase - 31) * 16;
        const unsigned char* up = U8 + ((size_t)m16 * 768 + c) * 4096 + 32 * q4;
        f32x4 acc[32];
#pragma unroll
        for (int ti = 0; ti < 32; ++ti) acc[ti] = (f32x4){0.f, 0.f, 0.f, 0.f};
        typedef int v8i_t __attribute__((ext_vector_type(8))); typedef int v4i_t __attribute__((ext_vector_type(4)));
#define T8_FRAG(p) __builtin_shufflevector(*(const LAS v4i_t*)(p), *(const LAS v4i_t*)((p) + 16), 0, 1, 2, 3, 4, 5, 6, 7)
        v8i_t bcur = __builtin_shufflevector(*(const v4i_t*)(up), *(const v4i_t*)(up + 16), 0, 1, 2, 3, 4, 5, 6, 7);
        v8i_t afA[4], afB[4];
#pragma unroll
        for (int i = 0; i < 4; ++i) afA[i] = T8_FRAG(ap + (31 - i) * 16);
        for (int ks = 0; ks < 32; ++ks) {
            const unsigned char* un = up + ((ks + 1) & 31) * 128;
            const v8i_t bnext = __builtin_shufflevector(*(const v4i_t*)(un), *(const v4i_t*)(un + 16), 0, 1, 2, 3, 4, 5, 6, 7);
            const LAS unsigned char* a0 = ap + ks * 128;
            const LAS unsigned char* a1 = ap + ((ks + 1) & 31) * 128;
#define T8_LD(dst, base, g) do { _Pragma("unroll") for (int i = 0; i < 4; ++i) dst[i] = T8_FRAG((base) + (31 - (4 * (g) + i)) * 16); } while (0)
#define T8_MM(src, g) do { _Pragma("unroll") for (int i = 0; i < 4; ++i) acc[4 * (g) + i] = __builtin_amdgcn_mfma_scale_f32_16x16x128_f8f6f4(src[i], bcur, acc[4 * (g) + i], 0, 0, 0, 0, 0, 0); } while (0)
            T8_LD(afB, a0, 1); T8_MM(afA, 0); __builtin_amdgcn_sched_barrier(0);
            T8_LD(afA, a0, 2); T8_MM(afB, 1); __builtin_amdgcn_sched_barrier(0);
            T8_LD(afB, a0, 3); T8_MM(afA, 2); __builtin_amdgcn_sched_barrier(0);
            T8_LD(afA, a0, 4); T8_MM(afB, 3); __builtin_amdgcn_sched_barrier(0);
            T8_LD(afB, a0, 5); T8_MM(afA, 4); __builtin_amdgcn_sched_barrier(0);
            T8_LD(afA, a0, 6); T8_MM(afB, 5); __builtin_amdgcn_sched_barrier(0);
            T8_LD(afB, a0, 7); T8_MM(afA, 6); __builtin_amdgcn_sched_barrier(0);
            T8_LD(afA, a1, 0); T8_MM(afB, 7); __builtin_amdgcn_sched_barrier(0);
#undef T8_LD
#undef T8_MM
            bcur = bnext;
        }
#undef T8_FRAG
        const float lb = lbias[c];
        const size_t rowoff = ((size_t)m16 * 768 + c) * 4096 + 512 * wid + 4 * q4;
#pragma unroll
        for (int ti = 0; ti < 32; ++ti) {
            const u32x2 uu = *(const u32x2*)(UT + rowoff + 16 * ti), gg = *(const u32x2*)(GT + rowoff + 16 * ti);
            const float y0 = (acc[ti][0] * unsc + lb * bflo(uu.x)) * bflo(gg.x), y1 = (acc[ti][1] * unsc + lb * bfhi(uu.x)) * bfhi(gg.x), y2 = (acc[ti][2] * unsc + lb * bflo(uu.y)) * bflo(gg.y), y3 = (acc[ti][3] * unsc + lb * bfhi(uu.y)) * bfhi(gg.y);
            u32x2 w; w.x = pk2(y0, y1); w.y = pk2(y2, y3);
            *(u32x2*)(ZT + rowoff + 16 * ti) = w;
            if (Z8) { int w8 = 0; w8 = __builtin_amdgcn_cvt_pk_fp8_f32(fminf(fmaxf(y0, -440.f), 440.f), fminf(fmaxf(y1, -440.f), 440.f), w8, false); w8 = __builtin_amdgcn_cvt_pk_fp8_f32(fminf(fmaxf(y2, -440.f), 440.f), fminf(fmaxf(y3, -440.f), 440.f), w8, true);
                *(int*)(Z8 + rowoff + 16 * ti) = w8; }
            if ((ti & 7) == 7) __builtin_amdgcn_sched_barrier(0);
        }
    }
    __syncthreads();
}

__device__ __forceinline__ void tback_phase(const Ctx& cx, const bf16_t* ZT, bf16_t* CAT, const int tid) {
    const int lane = tid & 63, wave = __builtin_amdgcn_readfirstlane(tid >> 6);
    const int gw = cx.vcu * 8 + wave, NGW = cx.G * 8;
    LAS unsigned char* tile = cx.lds + wave * 9216;
    for (int it = gw; it < 16 * 12 * 64; it += NGW) {
        const int tt = it & 63, ct = (it >> 6) % 12, b = it / (64 * 12);
        const int c0 = ct * 64, t0 = tt * 64;
        u32x4 vv[8];
#pragma unroll
        for (int k = 0; k < 8; ++k) { const int row = k * 8 + (lane >> 3), chn = lane & 7; vv[k] = *(const u32x4*)(ZT + ((size_t)b * 768 + c0 + row) * 4096 + t0 + chn * 8); }
        __builtin_amdgcn_sched_barrier(0);
#pragma unroll
        for (int k = 0; k < 8; ++k) { const int row = k * 8 + (lane >> 3), chn = lane & 7; *(LAS u32x4*)(tile + row * 144 + chn * 16) = vv[k]; }
        LDS_WAIT(); asm volatile("" ::: "memory");
        if constexpr (OUTP_F8) { unsigned char* dst = (unsigned char*)CAT + ((size_t)b * 4096 + t0) * 1024 + c0 + lane;
#pragma unroll 8
            for (int k = 0; k < 64; ++k) { const float v = bf2f(*(const LAS unsigned short*)(tile + lane * 144 + k * 2)); dst[(size_t)k * 1024] = f2fp8(fminf(fmaxf(v, -440.0f), 440.0f)); }
        } else { bf16_t* dst = CAT + ((size_t)b * 4096 + t0) * 1024 + c0 + lane;
#pragma unroll 8
            for (int k = 0; k < 64; ++k) dst[(size_t)k * 1024] = *(const LAS unsigned short*)(tile + lane * 144 + k * 2); }
        LDS_WAIT(); asm volatile("" ::: "memory");
    }
}

__device__ __forceinline__ void ln1_group(const int bt, const int chunk, const int wave, const int lane, const int r16, const int q4, const bf16_t* XI, bf16_t* XO, bf16_t* XB, const float* g, const float* bta,
                                          const LAS unsigned char* Wh, const LAS unsigned char* Wl, LAS float* lg, LAS int* lcnt, const float rb0, const float rb1, float* gate, unsigned (&pk)[2], unsigned (&gp)[2], const LAS float* gl) {
    constexpr int WP = 2064;
            const size_t rowU = (size_t)chunk * 256 + wave * 32 + bt * 16;
            unsigned loff = (unsigned)(r16 * 1024 + 8 * q4); asm volatile("" : "+v"(loff));
            const GAS bf16_t* src = (const GAS bf16_t*)XI + rowU * 1024 + loff;
            constexpr int HOLD = LN1_HOLD;
            u32x4 raw[HOLD > 0 ? HOLD : 1], rawt[32 - HOLD]; float s = 0.f, ss = 0.f;
#pragma unroll
            for (int i = 0; i < 32; ++i) { if (i < HOLD) raw[i] = *(const GAS u32x4*)(src + 32 * i); else rawt[i - HOLD] = *(const GAS u32x4*)(src + 32 * i); }
#pragma unroll
            for (int i = 0; i < 32; ++i) { const u32x4 rr = (i < HOLD) ? raw[i < HOLD ? i : 0] : rawt[i < HOLD ? 0 : i - HOLD]; const float x0 = bflo(rr.x), x1 = bfhi(rr.x), x2 = bflo(rr.y), x3 = bfhi(rr.y), x4 = bflo(rr.z), x5 = bfhi(rr.z), x6 = bflo(rr.w), x7 = bfhi(rr.w);
                s += ((x0 + x1) + (x2 + x3)) + ((x4 + x5) + (x6 + x7)); ss += ((x0 * x0 + x1 * x1) + (x2 * x2 + x3 * x3)) + ((x4 * x4 + x5 * x5) + (x6 * x6 + x7 * x7)); }
            lg[2 * lane] = s; lg[2 * lane + 1] = ss; LDS_WAIT(); asm volatile("" ::: "memory");
            s = (lg[2 * r16] + lg[2 * (r16 + 16)]) + (lg[2 * (r16 + 32)] + lg[2 * (r16 + 48)]); ss = (lg[2 * r16 + 1] + lg[2 * (r16 + 16) + 1]) + (lg[2 * (r16 + 32) + 1] + lg[2 * (r16 + 48) + 1]);
            LDS_WAIT(); asm volatile("" ::: "memory");
            const float mean = s * (1.0f / 1024.0f), rstd = rsqrtf(fmaxf(ss * (1.0f / 1024.0f) - mean * mean, 0.f) + LN_EPS);
            f32x4 a0 = (f32x4){0.f, 0.f, 0.f, 0.f}, a1 = (f32x4){0.f, 0.f, 0.f, 0.f};
            const LAS unsigned char* wh0 = Wh + r16 * WP + 16 * q4; const LAS unsigned char* wl0 = Wl + r16 * WP + 16 * q4;
            GAS bf16_t* dsto = (GAS bf16_t*)XO + ((X1_RECOMP && Y_F8) ? (size_t)(wave * 32 + bt * 16) : rowU) * 1024 + loff; GAS unsigned char* dst8 = (GAS unsigned char*)XB + rowU * 1024 + loff;
            const LAS float* glq = gl + 8 * q4;
            u32x4 nx_ = (u32x4){0u, 0u, 0u, 0u}; if (HOLD == 0) nx_ = *(const GAS u32x4*)(src);
#pragma unroll
            for (int i = 0; i < 32; ++i) {
                u32x4 rw_; if (i < HOLD) rw_ = raw[i < HOLD ? i : 0]; else rw_ = nx_;
                if (i + 1 < 32 && i + 1 >= HOLD) nx_ = *(const GAS u32x4*)(src + 32 * (i + 1));
                asm volatile("" : "+v"(rw_));
                const f32x4 g0 = *(const LAS f32x4*)(glq + 32 * i), g1 = *(const LAS f32x4*)(glq + 32 * i + 4), b0 = *(const LAS f32x4*)(glq + 1024 + 32 * i), b1 = *(const LAS f32x4*)(glq + 1024 + 32 * i + 4);
                float y[8]; y[0] = bflo(rw_.x); y[1] = bfhi(rw_.x); y[2] = bflo(rw_.y); y[3] = bfhi(rw_.y); y[4] = bflo(rw_.z); y[5] = bfhi(rw_.z); y[6] = bflo(rw_.w); y[7] = bfhi(rw_.w);
#pragma unroll
                for (int q = 0; q < 8; ++q) y[q] = (y[q] - mean) * rstd * (q < 4 ? g0[q & 3] : g1[q & 3]) + (q < 4 ? b0[q & 3] : b1[q & 3]);
                u32x4 hi; hi.x = pk2(y[0], y[1]); hi.y = pk2(y[2], y[3]); hi.z = pk2(y[4], y[5]); hi.w = pk2(y[6], y[7]);
                *(GAS u32x4*)(dsto + 32 * i) = hi;
                if constexpr (MOE_F8) { int w0 = 0, w1 = 0; w0 = __builtin_amdgcn_cvt_pk_fp8_f32(y[0], y[1], w0, false); w0 = __builtin_amdgcn_cvt_pk_fp8_f32(y[2], y[3], w0, true); w1 = __builtin_amdgcn_cvt_pk_fp8_f32(y[4], y[5], w1, false); w1 = __builtin_amdgcn_cvt_pk_fp8_f32(y[6], y[7], w1, true);
                    *(GAS u32x2*)(dst8 + 32 * i) = (u32x2){(unsigned)w0, (unsigned)w1}; }
                else { *(u32x4*)((bf16_t*)XB + rowU * 1024 + loff + 32 * i) = hi; }
                u32x4 lo; lo.x = pk2(y[0] - bflo(hi.x), y[1] - bfhi(hi.x)); lo.y = pk2(y[2] - bflo(hi.y), y[3] - bfhi(hi.y)); lo.z = pk2(y[4] - bflo(hi.z), y[5] - bfhi(hi.z)); lo.w = pk2(y[6] - bflo(hi.w), y[7] - bfhi(hi.w));
                const bf16x8 ah = __builtin_bit_cast(bf16x8, hi), al = __builtin_bit_cast(bf16x8, lo);
                const bf16x8 wh_0 = *(const LAS bf16x8*)(wh0 + 64 * i), wh_1 = *(const LAS bf16x8*)(wh0 + 16 * WP + 64 * i), wl_0 = *(const LAS bf16x8*)(wl0 + 64 * i), wl_1 = *(const LAS bf16x8*)(wl0 + 16 * WP + 64 * i);
                a0 = __builtin_amdgcn_mfma_f32_16x16x32_bf16(ah, wh_0, a0, 0, 0, 0); a1 = __builtin_amdgcn_mfma_f32_16x16x32_bf16(ah, wh_1, a1, 0, 0, 0);
                a0 = __builtin_amdgcn_mfma_f32_16x16x32_bf16(al, wh_0, a0, 0, 0, 0); a1 = __builtin_amdgcn_mfma_f32_16x16x32_bf16(al, wh_1, a1, 0, 0, 0);
                a0 = __builtin_amdgcn_mfma_f32_16x16x32_bf16(ah, wl_0, a0, 0, 0, 0); a1 = __builtin_amdgcn_mfma_f32_16x16x32_bf16(ah, wl_1, a1, 0, 0, 0);
                asm volatile("" :: "v"(ah), "v"(al), "v"(wh_0), "v"(wh_1), "v"(wl_0), "v"(wl_1));
                __builtin_amdgcn_sched_barrier(0);
            }
#pragma unroll
            for (int v = 0; v < 4; ++v) { lg[(4 * q4 + v) * 33 + r16] = a0[v] + rb0; lg[(4 * q4 + v) * 33 + r16 + 16] = a1[v] + rb1; }
            LDS_WAIT(); asm volatile("" ::: "memory");
            if (lane < 16) {
                const LAS float* myl = lg + lane * 33; const size_t rowt = (size_t)chunk * 256 + wave * 32 + bt * 16 + lane;
                float tv[4]; int te[4]; int t0 = -1, t1 = -1, t2 = -1;
#pragma unroll
                for (int k = 0; k < 4; ++k) { float best = -INFINITY; int bi = 0;
                    for (int e = 0; e < 32; ++e) { const float v = myl[e]; const bool ok = (e != t0) && (e != t1) && (e != t2); if (ok && v > best) { best = v; bi = e; } }
                    tv[k] = best; te[k] = bi; if (k == 0) t0 = bi; else if (k == 1) t1 = bi; else if (k == 2) t2 = bi; }
                const float e1 = __expf(tv[1] - tv[0]), e2 = __expf(tv[2] - tv[0]), e3 = __expf(tv[3] - tv[0]); const float isum = 1.0f / (1.0f + e1 + e2 + e3);
                const float gk[4] = {isum, e1 * isum, e2 * isum, e3 * isum};
                pk[0] = 0u; pk[1] = 0u;
#pragma unroll
                for (int k = 0; k < 4; ++k) { const int rk = __hip_atomic_fetch_add(lcnt + te[k], 1, __ATOMIC_RELAXED, __HIP_MEMORY_SCOPE_WORKGROUP); pk[k >> 1] |= (unsigned)((te[k] << 11) | rk) << (16 * (k & 1)); }
                gp[0] = pk2(gk[0], gk[1]); gp[1] = pk2(gk[2], gk[3]); (void)rowt; (void)gate;
            }
            LDS_WAIT(); asm volatile("" ::: "memory");
}
__device__ __forceinline__ void ln1_router_phase(const Ctx& cx, const bf16_t* XI, bf16_t* XO, bf16_t* XB, const float* g, const float* bta, const float* rw, const float* rb,
                                                 unsigned* cnt, int* expid, float* gate, int* idx, float* gidx, const int tid) {
    const int lane = tid & 63, wave = __builtin_amdgcn_readfirstlane(tid >> 6), r16 = lane & 15, q4 = lane >> 4;
    constexpr int WP = 2064;
    LAS unsigned char* Wh = cx.lds; LAS unsigned char* Wl = cx.lds + 32 * WP; LAS int* lcnt = (LAS int*)(cx.lds + 64 * WP); LAS int* lbase = lcnt + 32; LAS float* lg = (LAS float*)(cx.lds + 64 * WP + 256 + wave * 2112);
    __syncthreads();
    { const u32x4* rsrc = (const u32x4*)rw; u32x4 wv[16];
#pragma unroll
      for (int u = 0; u < 16; ++u) wv[u] = rsrc[tid + 512 * u];
#pragma unroll
      for (int u = 0; u < 16; ++u) { const int idx = tid + 512 * u; *(LAS u32x4*)(Wh + (idx >> 7) * WP + (idx & 127) * 16) = wv[u]; } }
    if (tid < 256) { LAS float* gf = (LAS float*)(cx.lds + 151552); *(LAS f32x4*)(gf + 4 * tid) = *(const f32x4*)(g + 4 * tid); *(LAS f32x4*)(gf + 1024 + 4 * tid) = *(const f32x4*)(bta + 4 * tid); }
    if (tid < 32) lcnt[tid] = 0;
    LAS float* gl = (LAS float*)(cx.lds + 151552);
    const float rb0 = rb[r16], rb1 = rb[r16 + 16];
    __syncthreads();
    for (int chunk = cx.vcu; chunk < NTOK / 256; chunk += cx.G) {
        unsigned pk0[2] = {0u, 0u}, pk1[2] = {0u, 0u}, gp0[2] = {0u, 0u}, gp1[2] = {0u, 0u};
        ln1_group(0, chunk, wave, lane, r16, q4, XI, XO, XB, g, bta, Wh, Wl, lg, lcnt, rb0, rb1, gate, pk0, gp0, gl);
        ln1_group(1, chunk, wave, lane, r16, q4, XI, XO, XB, g, bta, Wh, Wl, lg, lcnt, rb0, rb1, gate, pk1, gp1, gl);
        __syncthreads();
        { const int t2 = wave * 64 + lane_id_volatile();
          if (t2 < 32) { lbase[t2] = (int)__hip_atomic_fetch_add(cnt + t2, (unsigned)lcnt[t2], __ATOMIC_RELAXED, __HIP_MEMORY_SCOPE_AGENT); } }
        __syncthreads();
        const int ln_ = lane_id_volatile();
        if (ln_ < 16) {
            { const int slot0 = (chunk * 256 + wave * 32 + ln_) * 4;
#pragma unroll
                for (int k = 0; k < 4; ++k) { const unsigned p = (pk0[k >> 1] >> (16 * (k & 1))) & 0xffffu; const int e = (int)(p >> 11), rk = (int)(p & 0x7ffu); const size_t o_ = (size_t)e * IDXCAP + lbase[e] + rk; idx[o_] = slot0 + k; gidx[o_] = (k & 1) ? bfhi(gp0[k >> 1]) : bflo(gp0[k >> 1]); } }
            { const int slot0 = (chunk * 256 + wave * 32 + 16 + ln_) * 4;
#pragma unroll
                for (int k = 0; k < 4; ++k) { const unsigned p = (pk1[k >> 1] >> (16 * (k & 1))) & 0xffffu; const int e = (int)(p >> 11), rk = (int)(p & 0x7ffu); const size_t o_ = (size_t)e * IDXCAP + lbase[e] + rk; idx[o_] = slot0 + k; gidx[o_] = (k & 1) ? bfhi(gp1[k >> 1]) : bflo(gp1[k >> 1]); } }
        }
        __syncthreads();
        { const int t3 = wave * 64 + lane_id_volatile(); if (t3 < 32) lcnt[t3] = 0; }
        __syncthreads();
    }
}

__device__ __forceinline__ void ln2_phase(const Ctx& cx, const bf16_t* X1, const bf16_t* Y, bf16_t* XO, bf16_t* XB, float* OUT, const float* g, const float* bta, const float* g1, const float* b1, const int tid) {
    const int lane = tid & 63, wave = __builtin_amdgcn_readfirstlane(tid >> 6);
    const int gw = cx.vcu * 8 + wave, NGW = cx.G * 8;
    if constexpr (Y_F8) {
        f32x4 gv[4], bv[4];
#pragma unroll
        for (int j = 0; j < 4; ++j) { gv[j] = *(const f32x4*)(g + 16 * lane + 4 * j); bv[j] = *(const f32x4*)(bta + 16 * lane + 4 * j); }
        f32x4 g1v[4], b1v[4];
        if (X1_RECOMP) {
#pragma unroll
            for (int j = 0; j < 4; ++j) { g1v[j] = *(const f32x4*)(g1 + 16 * lane + 4 * j); b1v[j] = *(const f32x4*)(b1 + 16 * lane + 4 * j); } }
        for (int rp = gw; rp < NTOK / 2; rp += NGW) {
            u32x4 xa[2][2], ya[2][4];
#pragma unroll
            for (int r = 0; r < 2; ++r) { const size_t row = (size_t)rp * 2 + r;
                xa[r][0] = *(const u32x4*)(X1 + row * 1024 + 16 * lane); xa[r][1] = *(const u32x4*)(X1 + row * 1024 + 16 * lane + 8);
#pragma unroll
                for (int k = 0; k < 4; ++k) ya[r][k] = *(const u32x4*)((const unsigned char*)Y + (row * 4 + k) * 1024 + 16 * lane); }
            float v[2][16]; float s[2] = {0.f, 0.f};
            float m1[2] = {0.f, 0.f}, r1[2] = {1.f, 1.f};
            if (X1_RECOMP) {
                float s1[2] = {0.f, 0.f}, q1[2] = {0.f, 0.f};
#pragma unroll
                for (int r = 0; r < 2; ++r)
#pragma unroll
                    for (int d = 0; d < 8; ++d) { const unsigned w = xa[r][d >> 2][d & 3]; const float t0 = bflo(w), t1 = bfhi(w); s1[r] += t0 + t1; q1[r] += t0 * t0 + t1 * t1; }
#pragma unroll
                for (int r = 0; r < 2; ++r) { m1[r] = wave_sum(s1[r], lane) * (1.0f / 1024.0f); r1[r] = rsqrtf(fmaxf(wave_sum(q1[r], lane) * (1.0f / 1024.0f) - m1[r] * m1[r], 0.f) + LN_EPS); } }
#pragma unroll
            for (int r = 0; r < 2; ++r) {
#pragma unroll
                for (int i = 0; i < 4; ++i) { f32x2 lo = __builtin_amdgcn_cvt_pk_f32_fp8((int)ya[r][0][i], false), hi = __builtin_amdgcn_cvt_pk_f32_fp8((int)ya[r][0][i], true);
#pragma unroll
                    for (int k = 1; k < 4; ++k) { lo += __builtin_amdgcn_cvt_pk_f32_fp8((int)ya[r][k][i], false); hi += __builtin_amdgcn_cvt_pk_f32_fp8((int)ya[r][k][i], true); }
                    const unsigned xlo = xa[r][i >> 1][(i & 1) * 2], xhi = xa[r][i >> 1][(i & 1) * 2 + 1];
                    f32x4 x1v = (f32x4){bflo(xlo), bfhi(xlo), bflo(xhi), bfhi(xhi)};
                    if (X1_RECOMP) x1v = (x1v - m1[r]) * r1[r] * g1v[i] + b1v[i];
                    v[r][4 * i + 0] = x1v[0] * DN_ALPHA + lo[0] * (1.0f / Y_SCALE); v[r][4 * i + 1] = x1v[1] * DN_ALPHA + lo[1] * (1.0f / Y_SCALE);
                    v[r][4 * i + 2] = x1v[2] * DN_ALPHA + hi[0] * (1.0f / Y_SCALE); v[r][4 * i + 3] = x1v[3] * DN_ALPHA + hi[1] * (1.0f / Y_SCALE);
                    s[r] += (v[r][4 * i] + v[r][4 * i + 1]) + (v[r][4 * i + 2] + v[r][4 * i + 3]); } }
            const float mean0 = wave_sum(s[0], lane) * (1.0f / 1024.0f), mean1 = wave_sum(s[1], lane) * (1.0f / 1024.0f); float q[2] = {0.f, 0.f};
#pragma unroll
            for (int r = 0; r < 2; ++r)
#pragma unroll
                for (int e = 0; e < 16; ++e) { v[r][e] -= (r == 0 ? mean0 : mean1); q[r] += v[r][e] * v[r][e]; }
            const float rstd0 = rsqrtf(wave_sum(q[0], lane) * (1.0f / 1024.0f) + LN_EPS), rstd1 = rsqrtf(wave_sum(q[1], lane) * (1.0f / 1024.0f) + LN_EPS);
            unsigned wb[2][8]; unsigned w8[2][4];
#pragma unroll
            for (int j = 0; j < 4; ++j) { const f32x4 gvj = gv[j], bvj = bv[j];
#pragma unroll
                for (int r = 0; r < 2; ++r) { const size_t row = (size_t)rp * 2 + r; const float rs = (r == 0 ? rstd0 : rstd1);
                    const f32x4 o = (f32x4){v[r][4 * j], v[r][4 * j + 1], v[r][4 * j + 2], v[r][4 * j + 3]} * rs * gvj + bvj;
                    if (OUT) *(f32x4*)(OUT + row * 1024 + 16 * lane + 4 * j) = o;
                    else { wb[r][2 * j] = pk2(o[0], o[1]); wb[r][2 * j + 1] = pk2(o[2], o[3]);
                        int t8 = 0; t8 = __builtin_amdgcn_cvt_pk_fp8_f32(o[0], o[1], t8, false); t8 = __builtin_amdgcn_cvt_pk_fp8_f32(o[2], o[3], t8, true); w8[r][j] = (unsigned)t8; } } }
            if (!OUT) {
#pragma unroll
                for (int r = 0; r < 2; ++r) { const size_t row = (size_t)rp * 2 + r;
                    *(u32x4*)(XO + row * 1024 + 16 * lane) = (u32x4){wb[r][0], wb[r][1], wb[r][2], wb[r][3]}; *(u32x4*)(XO + row * 1024 + 16 * lane + 8) = (u32x4){wb[r][4], wb[r][5], wb[r][6], wb[r][7]};
                    if constexpr (INP_F8) *(u32x4*)((unsigned char*)XB + row * 1024 + 16 * lane) = (u32x4){w8[r][0], w8[r][1], w8[r][2], w8[r][3]};
                    else { *(u32x4*)(XB + row * 1024 + 16 * lane) = (u32x4){wb[r][0], wb[r][1], wb[r][2], wb[r][3]}; *(u32x4*)(XB + row * 1024 + 16 * lane + 8) = (u32x4){wb[r][4], wb[r][5], wb[r][6], wb[r][7]}; } } }
        }
        return;
    }
    for (int rp = gw; rp < NTOK / 2; rp += NGW) {
        f32x4 v[2][4]; float s[2] = {0.f, 0.f};
#pragma unroll
        for (int r = 0; r < 2; ++r) { const size_t row = (size_t)rp * 2 + r;
#pragma unroll
            for (int j = 0; j < 4; ++j) { const u32x2 a = *(const u32x2*)(X1 + row * 1024 + 4 * lane + 256 * j); v[r][j] = (f32x4){bflo(a.x), bfhi(a.x), bflo(a.y), bfhi(a.y)} * DN_ALPHA;
#pragma unroll
                for (int k = 0; k < 4; ++k) {
                    if constexpr (Y_F8) { const int y8 = *(const int*)((const unsigned char*)Y + (row * 4 + k) * 1024 + 4 * lane + 256 * j); const f32x2 lo = __builtin_amdgcn_cvt_pk_f32_fp8(y8, false), hi = __builtin_amdgcn_cvt_pk_f32_fp8(y8, true);
                        v[r][j][0] += lo[0] * (1.0f / Y_SCALE); v[r][j][1] += lo[1] * (1.0f / Y_SCALE); v[r][j][2] += hi[0] * (1.0f / Y_SCALE); v[r][j][3] += hi[1] * (1.0f / Y_SCALE); }
                    else { const u32x2 y = *(const u32x2*)(Y + (row * 4 + k) * 1024 + 4 * lane + 256 * j); v[r][j][0] += bflo(y.x); v[r][j][1] += bfhi(y.x); v[r][j][2] += bflo(y.y); v[r][j][3] += bfhi(y.y); } }
                s[r] += (v[r][j][0] + v[r][j][1]) + (v[r][j][2] + v[r][j][3]); } }
        const float mean0 = wave_sum(s[0], lane) * (1.0f / 1024.0f), mean1 = wave_sum(s[1], lane) * (1.0f / 1024.0f); float q[2] = {0.f, 0.f};
#pragma unroll
        for (int r = 0; r < 2; ++r)
#pragma unroll
            for (int j = 0; j < 4; ++j) { v[r][j] = v[r][j] - (r == 0 ? mean0 : mean1); q[r] += (v[r][j][0] * v[r][j][0] + v[r][j][1] * v[r][j][1]) + (v[r][j][2] * v[r][j][2] + v[r][j][3] * v[r][j][3]); }
        const float rstd0 = rsqrtf(wave_sum(q[0], lane) * (1.0f / 1024.0f) + LN_EPS), rstd1 = rsqrtf(wave_sum(q[1], lane) * (1.0f / 1024.0f) + LN_EPS);
#pragma unroll
        for (int j = 0; j < 4; ++j) { const f32x4 gvj = *(const f32x4*)(g + 4 * lane + 256 * j), bvj = *(const f32x4*)(bta + 4 * lane + 256 * j);
#pragma unroll
            for (int r = 0; r < 2; ++r) { const size_t row = (size_t)rp * 2 + r; const f32x4 o = v[r][j] * (r == 0 ? rstd0 : rstd1) * gvj + bvj;
                if (OUT) *(f32x4*)(OUT + row * 1024 + 4 * lane + 256 * j) = o;
                else { u32x2 w; w.x = pk2(o[0], o[1]); w.y = pk2(o[2], o[3]); *(u32x2*)(XO + row * 1024 + 4 * lane + 256 * j) = w;
                    if constexpr (INP_F8) { int w8 = 0; w8 = __builtin_amdgcn_cvt_pk_fp8_f32(o[0], o[1], w8, false); w8 = __builtin_amdgcn_cvt_pk_fp8_f32(o[2], o[3], w8, true); *(int*)((unsigned char*)XB + row * 1024 + 4 * lane + 256 * j) = w8; }
                    else { *(u32x2*)(XB + row * 1024 + 4 * lane + 256 * j) = w; } } } }
    }
}

constexpr int PH_PER_LAYER = 10, N_PHASES = 2 + PH_PER_LAYER * DEPTH;
__host__ __device__ constexpr bool phase_active(int p) {
    if (p < 2) return true;
    const int l = (p - 2) / PH_PER_LAYER, k = (p - 2) % PH_PER_LAYER, kind = l % 3;
    if (k == 1) return kind != 0;
    if (k == 3 || k == 4) return kind == 2;
    return true;
}

__global__ void __launch_bounds__(512, 2) fwd(Args args) {
    extern __shared__ __attribute__((aligned(16))) unsigned char lds_raw[];
    const int wave0 = __builtin_amdgcn_readfirstlane((int)threadIdx.x >> 6);
    Ctx cx; cx.lds = (LAS unsigned char*)lds_raw; cx.G = gridDim.x; { const int bx = blockIdx.x; cx.vcu = (cx.G % 8 == 0) ? (bx % 8) * (cx.G / 8) + bx / 8 : bx; } cx.ws = args.ws;
    volatile LAS unsigned* MISC = (volatile LAS unsigned*)(cx.lds + MISC_OFF);
    for (int u = threadIdx.x; u < (LDS_BYTES - MISC_OFF) / 4; u += 512) MISC[u] = 0u;
    __syncthreads();
    if (threadIdx.x == 0) { LAS unsigned long long* t = (LAS unsigned long long*)(cx.lds + PTAB_OFF);
#pragma unroll
        for (int k = 0; k < 32; ++k) t[k] = (unsigned long long)args.in[k];
        t[32] = (unsigned long long)args.out; t[33] = (unsigned long long)args.ws; }
    __syncthreads();
    const int lo = args.ph_lo, hi = args.ph_hi;
    XcdBarrier bar; bar.bar = (unsigned*)((gu32*)(args.ws + WS_CTL) + CW_BAR); bar.x = 0; bar.st = nullptr;
    if (hi - lo > 1) bar = xcd_barrier_post((unsigned*)((gu32*)(args.ws + WS_CTL) + CW_BAR), MISC + 8);
    int ran = 0;
#define XB ((bf16_t*)(ws + WS_XB))
#define PROJ ((bf16_t*)(ws + WS_PROJ))
#define CAT ((bf16_t*)(ws + WS_CAT))
#define KVM ((bf16_t*)(ws + WS_KVM))
#define HB ((bf16_t*)(ws + WS_H))
#define YB ((bf16_t*)(ws + WS_Y))
#define QKR ((bf16_t*)(ws + WS_QKR))
#define EXPID ((int*)(ws + WS_EXPID))
#define GATE ((float*)(ws + WS_GATE))
#define IDX ((int*)(ws + WS_IDX))
#define XF ((float*)(GAS float*)ptab_get(cx, 32))
#define SB ((bf16_t*)(ws + WS_SB))
#define SB2 ((bf16_t*)(ws + WS_PROJ))
#define TP_BAR_BEGIN() do {} while (0)
#define TP_BAR_END() do {} while (0)
#define TP_PH_BEGIN(p) do {} while (0)
#define TP_PH_END(p) do {} while (0)
#define PH_BEGIN(p) if (lo <= (p) && (p) < hi) { const int ph_ = (p); if (ran) { TP_BAR_BEGIN(); for (int rb_ = 0; rb_ < REP_BAR; ++rb_) xcd_barrier(bar, wave0); TP_BAR_END(); } ran = 1; const int tid = opaque_tid(wave0); (void)tid; unsigned char* const ws = (unsigned char*)(GAS unsigned char*)ptab_get(cx, 33); cx.ws = ws; TP_PH_BEGIN(ph_);
#define PH_END TP_PH_END(ph_); }

#if EN_P0
    PH_BEGIN(0) for (int rep_ = 0; rep_ < REP_P0; ++rep_) { p0_prologue(cx, tid); } PH_END
#endif

    for (int l = -1; l < DEPTH; ++l) {
        const int kind = (l < 0) ? 0 : l % 3, jj = (l < 0) ? 0 : l / 3, pw = (l < 0) ? 2048 : ((l % 3) == 1 ? 1536 : 2560), base = 2 + PH_PER_LAYER * l;
        PH_BEGIN(l < 0 ? 1 : base) {
            pg8::DenseOrder S;
            if (l < 0) S.init(ws + WS_MEMB, ws + WS_WKV, NMEM, 2048, 1024 * INP_EB, cx.G, (int)blockIdx.x);
            else S.init(XB, ws + WS_WIN + (size_t)l * 5 * MiB, NTOK, pw, 1024 * INP_EB, cx.G, (int)blockIdx.x);
            S.rep = REP_DENSE;
            const unsigned smask = (l < 0) ? 0u : (kind == 0 ? 0x207u : kind == 1 ? 0x20u : 0x200u);
            pg8::EpiBf16s E{l < 0 ? KVM : PROJ, pw, smask, C2, INP_F8 ? 1.0f / WIN_SCALE : 1.0f};
#if EN_G1
            pg8::gemm_phase<pg8::EpiBf16s, pg8::DenseOrder, false, INP_F8 != 0>(cx.lds, S, E, tid);
#endif
        } PH_END
        if (l < 0) continue;
#if EN_THIN
        if (kind == 1) { PH_BEGIN(base + 1) for (int rep_ = 0; rep_ < REP_THIN; ++rep_) { rope_phase(cx, PROJ, INP(5) + jj * 64, INP(6) + jj * 64, QKR, tid); } PH_END }
        if (kind == 2) { PH_BEGIN(base + 1) for (int rep_ = 0; rep_ < REP_THIN; ++rep_) { sconv_phase(cx, PROJ, INP(8) + (size_t)jj * 3 * 2304, INP(9) + (size_t)jj * 2304, (bf16_t*)(ws + WS_UT3), ws + WS_V8, tid); } PH_END }
#endif
        for (int o = 0; o < 2; ++o) {
            if (o == 1 && kind != 2) break;
            PH_BEGIN(base + 2 + o) {
                if (kind == 2) {
                    const bf16_t* UT3 = (const bf16_t*)(ws + WS_UT3); constexpr size_t PS = (size_t)16 * 768 * 4096;
#if EN_TCONV
                    for (int rep_ = 0; rep_ < REP_TCONV; ++rep_) {
#if TCONV_F8
                    tconv8_phase(cx, o, o == 0 ? UT3 : (const bf16_t*)(ws + WS_Z1T), ws + WS_V8 + (size_t)o * 48 * MiB, UT3 + (size_t)(1 + o) * PS, (bf16_t*)(ws + (o == 0 ? WS_Z1T : WS_Z2T)), o == 0 ? ws + WS_V8 + 48 * MiB : (unsigned char*)nullptr, INP(19) + (size_t)(jj * 2 + o) * 768, tid);
#else
                    tconv_phase(cx, o, o == 0 ? UT3 : (const bf16_t*)(ws + WS_Z1T), UT3 + (size_t)(1 + o) * PS, (bf16_t*)(ws + (o == 0 ? WS_Z1T : WS_Z2T)), INP(19) + (size_t)(jj * 2 + o) * 768, tid);
#endif
                    }
#endif
                }
                if (o == 0) {
#if EN_NA
                    for (int rep_ = 0; rep_ < REP_NA; ++rep_) { if (kind == 0) na_phase(cx, PROJ, INP(3) + (size_t)jj * 12 * 465, CAT, tid); }
#endif
                    const int ngqa = (kind == 1) ? 3072 : 0;
                    for (int rep_ = 0; rep_ < REP_ATTN; ++rep_)
                    for (int u = cx.vcu; u < ngqa + 1024; u += cx.G) {
                        const attn_body::bf16 *Q, *K, *V; attn_body::bf16* O; int QP, KP, VP, NT;
                        if (u < ngqa) { const int qb = u & 15, hq = (u >> 4) % 12, b = u / 192, kvh = hq / 3;
                            Q = (const attn_body::bf16*)QKR + ((size_t)b * 4096 + qb * 256) * 1024 + hq * 64; QP = 1024;
                            K = (const attn_body::bf16*)QKR + (size_t)b * 4096 * 1024 + 768 + kvh * 64; KP = 1024;
                            V = (const attn_body::bf16*)PROJ + (size_t)b * 4096 * 1536 + 1024 + kvh * 64; VP = 1536;
                            O = (attn_body::bf16*)((unsigned char*)CAT + (((size_t)b * 4096 + qb * 256) * 1024 + hq * 64) * OUT_EB); NT = 64;
                        } else { const int v = u - ngqa, qb = v & 15, h = (v >> 4) & 3, b = v >> 6;
                            Q = (const attn_body::bf16*)PROJ + ((size_t)b * 4096 + qb * 256) * pw + (pw - 256) + h * 64; QP = pw;
                            K = (const attn_body::bf16*)KVM + (size_t)b * 256 * 2048 + 512 * l + h * 64; KP = 2048;
                            V = K + 256; VP = 2048;
                            O = (attn_body::bf16*)((unsigned char*)CAT + (((size_t)b * 4096 + qb * 256) * 1024 + 768 + h * 64) * OUT_EB); NT = 4;
                        }
#if EN_ATTN
                        attn_body::attn_unit<8, OUTP_F8 != 0>(Q, K, V, O, QP, KP, VP, 1024, NT, (char*)lds_raw, tid);
#endif
                    }
                }
            } PH_END
        }
#if EN_THIN
        if (kind == 2) { PH_BEGIN(base + 4) for (int rep_ = 0; rep_ < REP_THIN; ++rep_) { tback_phase(cx, (const bf16_t*)(ws + WS_Z2T), CAT, tid); } PH_END }
#endif
        PH_BEGIN(base + 5) {
            pg8::DenseOrder S; S.init(CAT, ws + WS_WOUT + (size_t)l * 2 * MiB, NTOK, 1024, 1024 * OUT_EB, cx.G, (int)blockIdx.x);
            pg8::EpiResB E{SB, l == 0 ? (const void*)INP(0) : (const void*)SB, l == 0 ? 1 : 0, 1024, DN_ALPHA, OUTP_F8 ? 1.0f / WOUT_SCALE : 1.0f};
#if EN_G2
            pg8::gemm_phase<pg8::EpiResB, pg8::DenseOrder, false, OUTP_F8 != 0>(cx.lds, S, E, tid);
#endif
        } PH_END
#if EN_LN
#if REP_LN1 > 1
        PH_BEGIN(base + 6) ln1_router_phase(cx, SB, (bf16_t*)(ws + WS_PROJ), CAT, INP(22) + l * 1024, INP(23) + l * 1024, (const float*)(ws + WS_RW + (size_t)l * 131072), INP(27) + l * 32, (unsigned*)((gu32*)(ws + WS_CTL) + CW_DBG), EXPID, GATE, IDX, (float*)(ws + WS_GIDX), tid); PH_END
#endif
        PH_BEGIN(base + 6) ln1_router_phase(cx, SB, SB2, XB, INP(22) + l * 1024, INP(23) + l * 1024, (const float*)(ws + WS_RW + (size_t)l * 131072), INP(27) + l * 32, (unsigned*)((gu32*)(ws + WS_CTL) + CW_CNT + 32 * l), EXPID, GATE, IDX, (float*)(ws + WS_GIDX), tid); PH_END
#endif
        for (int half = 0; half < 2; ++half) {
            PH_BEGIN(base + 7 + half) {
                LAS int* pref = (LAS int*)(cx.lds + pg8::STAGE_BYTES); const unsigned* cntw = (const unsigned*)((gu32*)(ws + WS_CTL) + CW_CNT + 32 * l);
                __syncthreads();
                if (tid < NEXP) { const int c = (int)__hip_atomic_load(cntw + tid, __ATOMIC_RELAXED, __HIP_MEMORY_SCOPE_AGENT); pref[40 + tid] = c; pref[72 + tid] = (c + 255) >> 8; }
                __syncthreads();
                if (tid == 0) { int a = 0;
#pragma unroll 1
                    for (int e = 0; e < NEXP; ++e) { pref[e] = a; a += pref[72 + e]; } pref[NEXP] = a; }
                __syncthreads();
#if STAGGER
                if (cx.vcu & 1) { for (int s_ = 0; s_ < STAGGER; ++s_) __builtin_amdgcn_s_sleep(127); }
#endif
                if (half == 0) {
                    pg8::MoeOrder<2> S{(const char*)XB, (const char*)(ws + WS_W1 + (size_t)l * 32 * 2048 * 1024 * MOE_EB), 1024 * MOE_EB, 8, cx.G, cx.vcu, (size_t)2048 * 1024 * MOE_EB, pref, (const int*)cntw, IDX};
                    pg8::EpiSwiglu E{HB, INP(29) + (size_t)l * 32 * 2048};
#if EN_G3
                    for (int rep_ = 0; rep_ < REP_G3; ++rep_) { pg8::gemm_phase<pg8::EpiSwiglu, pg8::MoeOrder<2>, true, MOE_F8 != 0, (MOE_F8 != 0) && (DEFER_H != 0)>(cx.lds, S, E, tid); }
#endif
                } else {
                    pg8::MoeOrder<0> S{(const char*)HB, (const char*)(ws + WS_W2 + (size_t)l * 32 * 1024 * 1024 * MOE_EB), 1024 * MOE_EB, 4, cx.G, cx.vcu, (size_t)1024 * 1024 * MOE_EB, pref, (const int*)cntw, IDX};
                    pg8::EpiMoeOut E{YB, INP(31) + (size_t)l * 32 * 1024, (const float*)(ws + WS_GIDX)};
#if EN_G4
                    for (int rep_ = 0; rep_ < REP_G4; ++rep_) { pg8::gemm_phase<pg8::EpiMoeOut, pg8::MoeOrder<0>, true, MOE_F8 != 0>(cx.lds, S, E, tid); }
#endif
                }
            } PH_END
        }
#if EN_LN
#if REP_LN2 > 1
        PH_BEGIN(base + 9) ln2_phase(cx, SB, YB, (bf16_t*)(ws + WS_PROJ), CAT, (float*)nullptr, INP(24) + l * 1024, INP(25) + l * 1024, INP(22) + l * 1024, INP(23) + l * 1024, tid); PH_END
#endif
        PH_BEGIN(base + 9) ln2_phase(cx, (X1_RECOMP && Y_F8) ? SB : SB2, YB, SB, XB, l == DEPTH - 1 ? XF : (float*)nullptr, INP(24) + l * 1024, INP(25) + l * 1024, INP(22) + l * 1024, INP(23) + l * 1024, tid); PH_END

#endif
    }
#undef PH_BEGIN
#undef PH_END
#undef XB
#undef PROJ
#undef CAT
#undef KVM
#undef HB
#undef YB
#undef QKR
#undef EXPID
#undef GATE
#undef IDX
#undef XF
#undef SB
#undef SB2
}

extern "C" void kernel_launch(void* const* d_in, const int* in_sizes, int n_in, void* d_out, int out_size, void* d_ws, size_t ws_size, hipStream_t stream) {
    static int grid = 0;
    if (grid == 0) {
        if (n_in != 32 || in_sizes[0] != NTOK * DM || out_size != NTOK * DM || ws_size < WS_END) { fprintf(stderr, "kernel_launch: unexpected problem (n_in %d, in0 %d, out %d, ws %zu < %zu); nothing launched\n", n_in, n_in > 0 ? in_sizes[0] : -1, out_size, ws_size, (size_t)WS_END); grid = -1; return; }
        int dev = 0, cus = 0, per_cu = 0;
        if (hipGetDevice(&dev) != hipSuccess || hipDeviceGetAttribute(&cus, hipDeviceAttributeMultiprocessorCount, dev) != hipSuccess) { fprintf(stderr, "kernel_launch: device query failed\n"); grid = -1; return; }
        if (hipFuncSetAttribute((const void*)fwd, hipFuncAttributeMaxDynamicSharedMemorySize, LDS_BYTES) != hipSuccess) { fprintf(stderr, "kernel_launch: hipFuncSetAttribute failed\n"); grid = -1; return; }
        if (hipOccupancyMaxActiveBlocksPerMultiprocessor(&per_cu, (const void*)fwd, 512, LDS_BYTES) != hipSuccess || per_cu < 1) fprintf(stderr, "kernel_launch: occupancy query reports %d blocks per CU\n", per_cu);
        (void)hipGetLastError();
        grid = cus;
    }
    if (grid < 0) return;
    if (hipMemsetAsync((char*)d_ws + WS_CTL, 0, CTL_ZERO_BYTES, stream) != hipSuccess) { fprintf(stderr, "kernel_launch: memset failed\n"); return; }
    Args a{};
    for (int i = 0; i < 32; ++i) a.in[i] = (const float*)d_in[i];
    a.out = (float*)d_out; a.ws = (unsigned char*)d_ws;
#if MK_MULTI
    for (int p = 0; p < N_PHASES && p <= DBG_LAST_PHASE; ++p) {
        if (!phase_active(p)) continue;
        a.ph_lo = p; a.ph_hi = p + 1;
        hipLaunchKernelGGL(fwd, dim3(grid), dim3(512), LDS_BYTES, stream, a);
#if DBG_CHECK
        dbg_after_phase(p, a, stream);
#endif
    }
#if DBG_CHECK
    hipLaunchKernelGGL(dbg_report, dim3(1024), dim3(256), 0, stream, (unsigned*)((char*)d_ws + WS_CTL) + CW_DBG, (float*)d_out);
#endif
#else
    a.ph_lo = 0; a.ph_hi = N_PHASES;
    hipLaunchKernelGGL(fwd, dim3(grid), dim3(512), LDS_BYTES, stream, a);
#endif
    const hipError_t le = hipPeekAtLastError();
    if (le != hipSuccess) fprintf(stderr, "kernel_launch: launch failed: %s\n", hipGetErrorName(le));
}
```

```cpp
#include <hip/hip_runtime.h>
#include <hip/hip_bf16.h>
#include <cstdio>
#include <cstdint>

#ifndef MK_MULTI
#define MK_MULTI 0
#endif
#ifndef DBG_CHECK
#define DBG_CHECK 0
#endif
#ifndef DBG_LAST_PHASE
#define DBG_LAST_PHASE 9999
#endif

#ifndef EN_P0
#define EN_P0 1
#define EN_G1 1
#define EN_THIN 1
#define EN_TCONV 1
#define EN_NA 1
#define EN_ATTN 1
#define EN_G2 1
#define EN_LN 1
#define EN_G3 1
#define EN_G4 1
#endif

#ifndef REP_P0
#define REP_P0 1
#endif
#ifndef REP_G1
#define REP_G1 1
#endif
#ifndef REP_NA
#define REP_NA 1
#endif
#ifndef REP_ATTN
#define REP_ATTN 1
#endif
#ifndef REP_TCONV
#define REP_TCONV 1
#endif
#ifndef REP_THIN
#define REP_THIN 1
#endif
#ifndef REP_G3
#define REP_G3 1
#endif
#ifndef REP_G4
#define REP_G4 1
#endif
#ifndef ALIGN_EPI
#define ALIGN_EPI 1
#endif
#ifndef NT_STORE
#define NT_STORE 0
#endif
#ifndef X1_RECOMP
#define X1_RECOMP 1
#endif
#ifndef LN1_HOLD
#define LN1_HOLD 16
#endif
#ifndef DEFER_H
#define DEFER_H 0
#endif
#ifndef STAGGER
#define STAGGER 0
#endif
#ifndef REP_BAR
#define REP_BAR 1
#endif
#ifndef REP_DENSE
#define REP_DENSE 1
#endif
#ifndef REP_G2
#define REP_G2 1
#endif
#ifndef REP_LN1
#define REP_LN1 1
#endif
#ifndef REP_LN2
#define REP_LN2 1
#endif

#define GAS __attribute__((address_space(1)))
#define LAS __attribute__((address_space(3)))
typedef unsigned short bf16_t;
typedef short bf16x8 __attribute__((ext_vector_type(8)));
typedef short s16x4 __attribute__((ext_vector_type(4)));
typedef float f32x4 __attribute__((ext_vector_type(4)));
typedef float f32x2 __attribute__((ext_vector_type(2)));
typedef float f32x16 __attribute__((ext_vector_type(16)));
typedef unsigned u32x4 __attribute__((ext_vector_type(4)));
typedef unsigned u32x2 __attribute__((ext_vector_type(2)));
typedef GAS unsigned gu32;

constexpr int BATCH = 16, SEQ = 4096, DM = 1024, NTOK = BATCH * SEQ, DEPTH = 4;
constexpr int MEMLEN = 256, NMEM = BATCH * MEMLEN;
constexpr int NEXP = 32, NSLOT = NTOK * 4, IDXCAP = NTOK;
constexpr int GRIDW = 64;
constexpr float LN_EPS = 1e-5f;
constexpr float DN_ALPHA = 1.681792830507429f;
constexpr float LOG2E = 1.4426950408889634f;
constexpr float C2 = 0.125f * LOG2E;
__host__ __device__ constexpr int layer_kind(int l) { return l % 3; }
__host__ __device__ constexpr int layer_j(int l) { return l / 3; }
__host__ __device__ constexpr int in_width(int l) { return (l % 3) == 1 ? 1536 : 2560; }

#ifndef MOE_F8
#define MOE_F8 1
#endif
#ifndef INP_F8
#define INP_F8 1
#endif
constexpr int INP_EB = INP_F8 ? 1 : 2;
constexpr float WIN_SCALE = 32.0f;
#ifndef OUTP_F8
#define OUTP_F8 1
#endif
constexpr int OUT_EB = OUTP_F8 ? 1 : 2;
constexpr float WOUT_SCALE = 64.0f;
__device__ __forceinline__ unsigned char f2fp8(float x) { return (unsigned char)(__builtin_amdgcn_cvt_pk_fp8_f32(x, x, 0, false) & 0xff); }
#ifndef TCONV_F8
#define TCONV_F8 1
#endif
#ifndef Y_F8
#define Y_F8 1
#endif
constexpr float Y_SCALE = 64.0f;
constexpr int MOE_EB = MOE_F8 ? 1 : 2;
constexpr float W1_SCALE = 32.0f, W2_SCALE = 64.0f, H_SCALE = 4.0f;

constexpr size_t MiB = 1u << 20;
constexpr size_t WS_CTL = 0, CTL_ZERO_BYTES = 1 * MiB;
constexpr size_t WS_RW = 1 * MiB;
constexpr size_t WS_WIN = 2 * MiB;
constexpr size_t WS_WKV = 22 * MiB;
constexpr size_t WS_WOUT = 26 * MiB;
constexpr size_t WS_W1 = 34 * MiB;
constexpr size_t WS_W2 = 546 * MiB;
constexpr size_t WS_XB = 802 * MiB;
constexpr size_t WS_MEMB = 930 * MiB;
constexpr size_t WS_KVM = 938 * MiB;
constexpr size_t WS_PROJ = 954 * MiB;
constexpr size_t WS_CAT = 1274 * MiB;
constexpr size_t WS_H = 1402 * MiB;
constexpr size_t WS_Y = 1914 * MiB;
constexpr size_t WS_HRAWT = 2426 * MiB;
constexpr size_t WS_HPART = 2474 * MiB;
constexpr size_t WS_EXPID = 2478 * MiB;
constexpr size_t WS_GATE = 2479 * MiB;
constexpr size_t WS_IDX = 2480 * MiB;
constexpr size_t WS_SB = 2488 * MiB;
constexpr size_t WS_GIDX = 2616 * MiB;
constexpr size_t WS_END = 2624 * MiB;
constexpr size_t WS_UT3 = WS_H;
constexpr size_t WS_Z1T = WS_H + 288 * MiB;
constexpr size_t WS_Z2T = WS_H + 384 * MiB;
constexpr size_t WS_V8 = WS_Y;
constexpr size_t WS_QKR = WS_Y;
constexpr int CW_BAR = 4096;
constexpr int CW_CNT = 8192;
constexpr int CW_DBG = 12288;

constexpr int MISC_OFF = 150528;
constexpr int LDS_BYTES = 163840;

#define LDS_WAIT() asm volatile("s_waitcnt lgkmcnt(0)" ::: "memory")
#define VM_WAIT() asm volatile("s_waitcnt vmcnt(0)" ::: "memory")
__device__ __forceinline__ unsigned f2bf(float f) { unsigned u = __builtin_bit_cast(unsigned, f); return (u + 0x7fffu + ((u >> 16) & 1u)) >> 16; }
__device__ __forceinline__ unsigned pk2(float lo, float hi) { return f2bf(lo) | (f2bf(hi) << 16); }
__device__ __forceinline__ float bf2f(unsigned short b) { return __builtin_bit_cast(float, ((unsigned)b) << 16); }
__device__ __forceinline__ float bflo(unsigned w) { return __builtin_bit_cast(float, w << 16); }
__device__ __forceinline__ float bfhi(unsigned w) { return __builtin_bit_cast(float, w & 0xffff0000u); }
__device__ __forceinline__ float shflx(float v, int mask, int lane) { int t; asm volatile("v_mov_b32 %0, %1" : "=v"(t) : "v"(__builtin_bit_cast(int, v))); return __builtin_bit_cast(float, __builtin_amdgcn_ds_bpermute((lane ^ mask) << 2, t)); }
__device__ __forceinline__ int shflxi(int v, int mask, int lane) { return __builtin_amdgcn_ds_bpermute((lane ^ mask) << 2, v); }
template <int CTRL> __device__ __forceinline__ float dpp_x(float v) { return __builtin_bit_cast(float, __builtin_amdgcn_update_dpp(0, __builtin_bit_cast(int, v), CTRL, 0xF, 0xF, false)); }
__device__ __forceinline__ float group8_sum(float v) { v += dpp_x<0xB1>(v); v += dpp_x<0x4E>(v); v += dpp_x<0x141>(v); return v; }
__device__ __forceinline__ float wave_sum(float v, int  ) {
    v += dpp_x<0xB1>(v); v += dpp_x<0x4E>(v); v += dpp_x<0x141>(v); v += dpp_x<0x140>(v);
    v += __builtin_bit_cast(float, __builtin_amdgcn_update_dpp(0, __builtin_bit_cast(int, v), 0x142, 0xA, 0xF, false));
    v += __builtin_bit_cast(float, __builtin_amdgcn_update_dpp(0, __builtin_bit_cast(int, v), 0x143, 0xC, 0xF, false));
    return __builtin_bit_cast(float, __builtin_amdgcn_readlane(__builtin_bit_cast(int, v), 63));
}
__device__ __forceinline__ int lane_id_volatile() { int l; asm volatile("v_mbcnt_lo_u32_b32 %0, -1, 0\n\tv_mbcnt_hi_u32_b32 %0, -1, %0" : "=&v"(l)); return l; }
__device__ __forceinline__ int opaque_tid(int wave0) { return wave0 * 64 + lane_id_volatile(); }

#define XB_TMO      128
#define XB_XCNT(j)  (256  + 64 * (j))
#define XB_XSUB(j)  (1280 + 64 * (j))
#define XB_XGEN(j)  (2304 + 64 * (j))
#define XB_TOP      3328
#define XB_TOPGEN   3392
#define XCD_BAR_WORDS 3456
#define XB_SPIN_CAP (1u << 20)

__device__ __forceinline__ unsigned xb_ld(unsigned* p)              { return __hip_atomic_load(p, __ATOMIC_RELAXED, __HIP_MEMORY_SCOPE_AGENT); }
__device__ __forceinline__ unsigned xb_add(unsigned* p, unsigned v) { return __hip_atomic_fetch_add(p, v, __ATOMIC_RELAXED, __HIP_MEMORY_SCOPE_AGENT); }
__device__ __forceinline__ unsigned xb_xcc_id() { return (unsigned)__builtin_amdgcn_s_getreg((3 << 11) | 20) & 0xFu; }
#define XB_SPIN(cond, bar) do { unsigned _sp = 0; while (cond) { __builtin_amdgcn_s_sleep(1); \
    if ((++_sp & 255u) == 0u) { if (xb_ld(&(bar)[XB_TMO])) break; if (_sp > XB_SPIN_CAP) { atomicAdd(&(bar)[XB_TMO], 1u); break; } } } } while (0)

struct XcdBarrier {
    unsigned* bar; unsigned x;
    volatile LAS unsigned* st;
};
__device__ __forceinline__ XcdBarrier xcd_barrier_post(unsigned* bar, volatile LAS unsigned* st) {
    XcdBarrier b; b.bar = bar; b.x = xb_xcc_id(); b.st = st;
    if (threadIdx.x == 0) (void)xb_add(&bar[XB_XCNT(b.x)], 1u);
    return b;
}
__device__ __forceinline__ void xcd_barrier_complete(unsigned* bar, unsigned x, unsigned& nloc, unsigned& nx) {
    const unsigned G = gridDim.x * gridDim.y * gridDim.z;
    unsigned sum, cnt, mine, sp = 0u;
    for (;;) {
        sum = 0u; cnt = 0u; mine = 0u;
#pragma unroll 1
        for (unsigned j = 0; j < 16; ++j) { const unsigned c = xb_ld(&bar[XB_XCNT(j)]); sum += c; cnt += (c > 0u) ? 1u : 0u; mine = (j == x) ? c : mine; }
        if (sum == G) break;
        __builtin_amdgcn_s_sleep(1);
        if ((++sp & 255u) == 0u) { if (xb_ld(&bar[XB_TMO])) break; if (sp > XB_SPIN_CAP) { atomicAdd(&bar[XB_TMO], 1u); break; } }
    }
    nloc = mine > 0u ? mine : 1u; nx = cnt > 0u ? cnt : 1u;
}
__device__ __forceinline__ void xcd_barrier(const XcdBarrier& b, const int wave0) {
    asm volatile("s_waitcnt vmcnt(0)" ::: "memory");
    __syncthreads();
    if (wave0 == 0 && lane_id_volatile() == 0) {
        unsigned* bar = b.bar;
        __builtin_amdgcn_s_waitcnt(0);
        unsigned nloc = b.st[0], nx = b.st[1];
        if (nloc == 0u) { xcd_barrier_complete(bar, b.x, nloc, nx); b.st[0] = nloc; b.st[1] = nx; }
        const unsigned old = xb_add(&bar[XB_XSUB(b.x)], 1u);
        const unsigned gen = old / nloc;
        if (old + 1u == (gen + 1u) * nloc) {
            __builtin_amdgcn_fence(__ATOMIC_RELEASE, "agent");
            asm volatile("s_waitcnt vmcnt(0)" ::: "memory");
            const unsigned og = xb_add(&bar[XB_TOP], 1u);
            const unsigned tg = og / nx;
            if (og + 1u == (tg + 1u) * nx) xb_add(&bar[XB_TOPGEN], 1u);
            else XB_SPIN(xb_ld(&bar[XB_TOPGEN]) == tg, bar);
            __builtin_amdgcn_fence(__ATOMIC_ACQUIRE, "agent");
            xb_add(&bar[XB_XGEN(b.x)], 1u);
            asm volatile("s_waitcnt vmcnt(0)" ::: "memory");
        } else {
            XB_SPIN(xb_ld(&bar[XB_XGEN(b.x)]) == gen, bar);
            __builtin_amdgcn_fence(__ATOMIC_ACQUIRE, "agent");
            asm volatile("s_waitcnt vmcnt(0)" ::: "memory");
        }
    }
    __syncthreads();
}

namespace pg8 {
constexpr int BM = 256, BK = 64, HALF = 128, HTB = HALF * BK * 2  , STAGE_BYTES = 8 * HTB, NXCD = 8, WGM = 8;
__host__ __device__ __forceinline__ int lds_byte(int r, int c) { const int st = (r >> 4) * 2 + (c >> 5), rr = r & 15, cc = c & 31, ob = rr * 64 + cc * 2; return st * 1024 + (ob ^ (((ob >> 9) & 1) << 5)); }
__host__ __device__ __forceinline__ void stage_rc(int b, int& R, int& C) { const int st = b / 1024, sb = b % 1024, swz = sb ^ (((sb >> 9) & 1) << 5); R = (st >> 1) * 16 + swz / 64; C = (st & 1) * 32 + (swz % 64) / 2; }
__host__ __device__ __forceinline__ int perm32(int rho) { const int n = rho >> 4, i = rho & 15; return 8 * (i >> 2) + 4 * n + (i & 3); }

struct Unit { int pm, pn, e, p; };

struct DenseOrder {
    const char* A; const char* Bt; int KB; int nM, nN, nwg, G, c; int rep = 1;
    __device__ __forceinline__ void init(const void* A_, const void* Bt_, int M, int N, int KB_, int G_, int c_) { A = (const char*)A_; Bt = (const char*)Bt_; KB = KB_; nM = M / BM; nN = N / BM; nwg = nM * nN; G = G_; c = c_; }
    __device__ __forceinline__ bool next(int i, Unit& u) const {
        long L = (long)i * G + c; if (L >= (long)nwg * rep) return false;
        if (rep > 1) L %= nwg;
        int wgid = (int)L; { const int q = nwg / NXCD, r = nwg % NXCD, xcd = wgid % NXCD, off = wgid / NXCD; wgid = (xcd < r ? xcd * (q + 1) : r * (q + 1) + (xcd - r) * q) + off; }
        const int nig = WGM * nN, gid = wgid / nig, fm = gid * WGM, gsz = (nM - fm) < WGM ? (nM - fm) : WGM;
        u.pm = __builtin_amdgcn_readfirstlane(fm + ((wgid % nig) % gsz)); u.pn = __builtin_amdgcn_readfirstlane((wgid % nig) / gsz); u.e = 0; u.p = 0; return true;
    }
    __device__ __forceinline__ const char* a_base(const Unit& u) const { return A + (size_t)u.pm * BM * KB; }
    __device__ __forceinline__ const char* b_base(const Unit& u) const { return Bt + (size_t)u.pn * BM * KB; }
    __device__ __forceinline__ const int* idx_src(const Unit&) const { return nullptr; }
    __device__ __forceinline__ int nvalid(const Unit&) const { return BM; }
    static constexpr int ROW_SHIFT = 0;
};
template <int SHIFT  > struct MoeOrder {
    const char* A; const char* Bt; int KB; int nN; int G, c; size_t bstride; const LAS int* pref; const int* cnt; const int* idx;
    __device__ __forceinline__ bool next(int i, Unit& u) const {
        const long L = (long)i * G + c; const int tot = __builtin_amdgcn_readfirstlane(pref[NEXP]);
        if (L >= (long)tot * nN) return false;
        const int pg = __builtin_amdgcn_readfirstlane((int)(L / nN)); u.pn = __builtin_amdgcn_readfirstlane((int)(L % nN));
        int e = 0;
#pragma unroll
        for (int step = 16; step >= 1; step >>= 1) { const int v = __builtin_amdgcn_readfirstlane(pref[e + step]); e += (v <= pg) ? step : 0; }
        u.e = e; u.p = pg - __builtin_amdgcn_readfirstlane(pref[e]); u.pm = 0; return true;
    }
    __device__ __forceinline__ const char* a_base(const Unit&) const { return A; }
    __device__ __forceinline__ const char* b_base(const Unit& u) const { return Bt + (size_t)u.e * bstride + (size_t)u.pn * BM * KB; }
    __device__ __forceinline__ const int* idx_src(const Unit& u) const { return idx + (size_t)u.e * IDXCAP + u.p * BM; }
    __device__ __forceinline__ int nvalid(const Unit& u) const { const int n = __builtin_amdgcn_readfirstlane(pref[40 + u.e]) - u.p * BM; return n < BM ? n : BM; }
    static constexpr int ROW_SHIFT = SHIFT;
};

__device__ __forceinline__ unsigned cvt_pk_bf16(float lo, float hi) { unsigned r; asm volatile("v_cvt_pk_bf16_f32 %0, %1, %2" : "=v"(r) : "v"(lo), "v"(hi)); return r; }

struct EpiBf16s {
    static constexpr bool PERM = true; static constexpr bool HAS_BIAS = false;
    bf16_t* O; int ldc; unsigned smask; float scale; float base;
    __device__ __forceinline__ void operator()(const f32x4 (&acc)[2][2][4][2], const Unit& u, int wr, int wc, int fr, int fq) const {
        const int row0 = u.pm * BM + wr * 64 + fr, col0 = u.pn * BM + wc * 32 + 8 * fq;
        const float sc = (((smask >> u.pn) & 1u) ? scale : 1.f) * base;
#pragma unroll
        for (int ai = 0; ai < 2; ++ai)
#pragma unroll
            for (int m = 0; m < 4; ++m) { bf16_t* rowp = O + (size_t)(row0 + ai * HALF + m * 16) * ldc + col0;
#pragma unroll
                for (int bj = 0; bj < 2; ++bj) { const f32x4 v0 = acc[ai][bj][m][0] * sc, v1 = acc[ai][bj][m][1] * sc;
                    u32x4 w; w.x = cvt_pk_bf16(v0[0], v0[1]); w.y = cvt_pk_bf16(v0[2], v0[3]); w.z = cvt_pk_bf16(v1[0], v1[1]); w.w = cvt_pk_bf16(v1[2], v1[3]);
                    if (NT_STORE) __builtin_nontemporal_store(w, (u32x4*)(rowp + bj * HALF)); else *(u32x4*)(rowp + bj * HALF) = w; }
                asm volatile("" ::: "memory"); }
    }
};
struct EpiResB {
    static constexpr bool PERM = true; static constexpr bool HAS_BIAS = false;
    bf16_t* C; const void* res; int res_f32; int ldc; float alpha; float ascale;
    __device__ __forceinline__ void operator()(const f32x4 (&acc)[2][2][4][2], const Unit& u, int wr, int wc, int fr, int fq) const {
        const int row0 = u.pm * BM + wr * 64 + fr, col0 = u.pn * BM + wc * 32 + 8 * fq;
        if (res_f32) {
#pragma unroll
            for (int ai = 0; ai < 2; ++ai) { f32x4 r[4][2][2];
#pragma unroll
                for (int m = 0; m < 4; ++m)
#pragma unroll
                    for (int bj = 0; bj < 2; ++bj) { const float* rp = (const float*)res + (size_t)(row0 + ai * HALF + m * 16) * ldc + col0 + bj * HALF; r[m][bj][0] = *(const f32x4*)rp; r[m][bj][1] = *(const f32x4*)(rp + 4); }
#pragma unroll
                for (int m = 0; m < 4; ++m)
#pragma unroll
                    for (int bj = 0; bj < 2; ++bj) { const size_t off = (size_t)(row0 + ai * HALF + m * 16) * ldc + col0 + bj * HALF;
                        const f32x4 v0 = r[m][bj][0] * alpha + acc[ai][bj][m][0] * ascale, v1 = r[m][bj][1] * alpha + acc[ai][bj][m][1] * ascale;
                        u32x4 w; w.x = cvt_pk_bf16(v0[0], v0[1]); w.y = cvt_pk_bf16(v0[2], v0[3]); w.z = cvt_pk_bf16(v1[0], v1[1]); w.w = cvt_pk_bf16(v1[2], v1[3]);
                        *(u32x4*)(C + off) = w; }
                asm volatile("" ::: "memory"); }
        } else { u32x4 raw[2][4][2];
#pragma unroll
            for (int ai = 0; ai < 2; ++ai)
#pragma unroll
                for (int m = 0; m < 4; ++m)
#pragma unroll
                    for (int bj = 0; bj < 2; ++bj) raw[ai][m][bj] = *(const u32x4*)((const bf16_t*)res + (size_t)(row0 + ai * HALF + m * 16) * ldc + col0 + bj * HALF);
#pragma unroll
            for (int ai = 0; ai < 2; ++ai)
#pragma unroll
                for (int m = 0; m < 4; ++m)
#pragma unroll
                    for (int bj = 0; bj < 2; ++bj) { const size_t off = (size_t)(row0 + ai * HALF + m * 16) * ldc + col0 + bj * HALF; const u32x4 rw = raw[ai][m][bj];
                        const f32x4 r0 = (f32x4){bflo(rw.x), bfhi(rw.x), bflo(rw.y), bfhi(rw.y)}, r1 = (f32x4){bflo(rw.z), bfhi(rw.z), bflo(rw.w), bfhi(rw.w)};
                        const f32x4 v0 = r0 * alpha + acc[ai][bj][m][0] * ascale, v1 = r1 * alpha + acc[ai][bj][m][1] * ascale;
                        u32x4 w; w.x = cvt_pk_bf16(v0[0], v0[1]); w.y = cvt_pk_bf16(v0[2], v0[3]); w.z = cvt_pk_bf16(v1[0], v1[1]); w.w = cvt_pk_bf16(v1[2], v1[3]);
                        *(u32x4*)(C + off) = w; }
        }
    }
};
struct Pend { u32x2 val[8]; };
struct EpiSwiglu {
    static constexpr bool PERM = true; static constexpr bool HAS_GATE = false; static constexpr bool HAS_BIAS = true;
    __device__ __forceinline__ void load_bias(const Unit& u, int wc, int fq, f32x4 (&bp)[4]) const { const float* bg = b1 + (size_t)u.e * 2048 + u.pn * HALF + wc * 32 + 8 * fq; bp[0] = *(const f32x4*)bg; bp[1] = *(const f32x4*)(bg + 4); bp[2] = *(const f32x4*)(bg + 1024); bp[3] = *(const f32x4*)(bg + 1028); }
    bf16_t* H; const float* b1;
    __device__ __forceinline__ void prepare(const f32x4 (&acc)[2][2][4][2], const Unit& u, int wr, int wc, int fr, int fq, Pend& pd) const {
        constexpr float ASC = 1.0f / W1_SCALE;
        const int j0 = u.pn * HALF + wc * 32 + 8 * fq; const float* bg = b1 + (size_t)u.e * 2048 + j0; const float* bu = bg + 1024;
        const f32x4 bg0 = *(const f32x4*)bg, bg1 = *(const f32x4*)(bg + 4), bu0 = *(const f32x4*)bu, bu1 = *(const f32x4*)(bu + 4);
#pragma unroll
        for (int q8 = 0; q8 < 8; ++q8) { const int ai = q8 >> 2, m = q8 & 3;
            float o[8];
#pragma unroll
            for (int q = 0; q < 8; ++q) { const float gb = (q < 4 ? bg0[q & 3] : bg1[q & 3]), ub = (q < 4 ? bu0[q & 3] : bu1[q & 3]);
                float g = acc[ai][0][m][q >> 2][q & 3] * ASC + gb, uu = acc[ai][1][m][q >> 2][q & 3] * ASC + ub;
                g = fminf(g, 7.0f); uu = fminf(fmaxf(uu, -7.0f), 7.0f);
                const float sg = __builtin_amdgcn_rcpf(1.0f + __builtin_amdgcn_exp2f(-1.702f * LOG2E * g));
                o[q] = (uu + 1.0f) * (g * sg); }
            int w0 = 0, w1 = 0;
            w0 = __builtin_amdgcn_cvt_pk_fp8_f32(o[0] * H_SCALE, o[1] * H_SCALE, w0, false); w0 = __builtin_amdgcn_cvt_pk_fp8_f32(o[2] * H_SCALE, o[3] * H_SCALE, w0, true);
            w1 = __builtin_amdgcn_cvt_pk_fp8_f32(o[4] * H_SCALE, o[5] * H_SCALE, w1, false); w1 = __builtin_amdgcn_cvt_pk_fp8_f32(o[6] * H_SCALE, o[7] * H_SCALE, w1, true);
            pd.val[q8] = (u32x2){(unsigned)w0, (unsigned)w1}; }
    }
    __device__ __forceinline__ void store_one(const u32x2 v, const LAS int* ids, const int r, const int nv, const int j0) const { if (r < nv) { const int slot = ids[r]; *(u32x2*)((unsigned char*)H + (size_t)slot * 1024 + j0) = v; } }
    __device__ __forceinline__ void operator()(const f32x4 (&acc)[2][2][4][2], const Unit& u, int wr, int wc, int fr, int fq, const LAS int* ids, const int nv, const f32x4 (&bp)[4]) const {
        constexpr float ASC = MOE_F8 ? 1.0f / W1_SCALE : 1.0f;
        constexpr float HS = MOE_F8 ? H_SCALE : 1.0f, KK = -1.702f * LOG2E, GA = ASC * KK, UA = ASC * HS / KK, ULO = 8.0f * HS / KK, UHI = -6.0f * HS / KK, GLO = 7.0f * KK;
        const int j0 = u.pn * HALF + wc * 32 + 8 * fq;
        const f32x4 bg0 = bp[0] * KK, bg1 = bp[1] * KK; f32x4 bu0 = (bp[2] + 1.0f) * (HS / KK), bu1 = (bp[3] + 1.0f) * (HS / KK);
        asm volatile("" : "+v"(bu0), "+v"(bu1));
        int rb = wr * 64 + fr; asm volatile("" : "+v"(rb));
        const LAS int* idp = ids + rb; int slots[8];
#pragma unroll
        for (int q = 0; q < 8; ++q) slots[q] = idp[(q >> 2) * HALF + (q & 3) * 16];
#pragma unroll
        for (int ai = 0; ai < 2; ++ai)
#pragma unroll
            for (int m = 0; m < 4; ++m) { const int r = ai * HALF + m * 16 + rb;
                if (r < nv) { const int slot = slots[ai * 4 + m];
                    float o[8];
#pragma unroll
                    for (int q = 0; q < 8; ++q) { const float gb = (q < 4 ? bg0[q & 3] : bg1[q & 3]), ub = (q < 4 ? bu0[q & 3] : bu1[q & 3]);
                        const float gp = fmaxf(__builtin_fmaf(acc[ai][0][m][q >> 2][q & 3], GA, gb), GLO);
                        const float us = fminf(fmaxf(__builtin_fmaf(acc[ai][1][m][q >> 2][q & 3], UA, ub), ULO), UHI);
                        const float sg = __builtin_amdgcn_rcpf(1.0f + __builtin_amdgcn_exp2f(gp));
                        o[q] = us * (gp * sg); }
                    if constexpr (MOE_F8) { int w0 = 0, w1 = 0;
                        w0 = __builtin_amdgcn_cvt_pk_fp8_f32(o[0], o[1], w0, false); w0 = __builtin_amdgcn_cvt_pk_fp8_f32(o[2], o[3], w0, true);
                        w1 = __builtin_amdgcn_cvt_pk_fp8_f32(o[4], o[5], w1, false); w1 = __builtin_amdgcn_cvt_pk_fp8_f32(o[6], o[7], w1, true);
                        *(u32x2*)((unsigned char*)H + (size_t)slot * 1024 + j0) = (u32x2){(unsigned)w0, (unsigned)w1};
                    } else { u32x4 w; w.x = cvt_pk_bf16(o[0], o[1]); w.y = cvt_pk_bf16(o[2], o[3]); w.z = cvt_pk_bf16(o[4], o[5]); w.w = cvt_pk_bf16(o[6], o[7]);
                        *(u32x4*)(H + (size_t)slot * 1024 + j0) = w; } } }
    }
};
struct EpiMoeOut {
    static constexpr bool PERM = true; static constexpr bool HAS_GATE = true; static constexpr bool HAS_BIAS = true;
    __device__ __forceinline__ void load_bias(const Unit& u, int wc, int fq, f32x4 (&bp)[4]) const { const float* bb = b2 + (size_t)u.e * 1024 + u.pn * BM + wc * 32 + 8 * fq; bp[0] = *(const f32x4*)bb; bp[1] = *(const f32x4*)(bb + 4); bp[2] = *(const f32x4*)(bb + HALF); bp[3] = *(const f32x4*)(bb + HALF + 4); }
    bf16_t* Y; const float* b2;   const float* gidx;
    __device__ __forceinline__ void operator()(const f32x4 (&acc)[2][2][4][2], const Unit& u, int wr, int wc, int fr, int fq, const LAS int* ids, const int nv, const f32x4 (&bp)[4]) const {
        const LAS float* gts = (const LAS float*)(ids + 768);
        constexpr float OSC = MOE_F8 ? 1.0f / (H_SCALE * W2_SCALE) : 1.0f;
        const int c0 = u.pn * BM + wc * 32 + 8 * fq;
        f32x4 bv[2][2]; bv[0][0] = bp[0]; bv[0][1] = bp[1]; bv[1][0] = bp[2]; bv[1][1] = bp[3];
        int rb = wr * 64 + fr; asm volatile("" : "+v"(rb));
        const LAS int* idp = ids + rb; int slots[8];
#pragma unroll
        for (int q = 0; q < 8; ++q) slots[q] = idp[(q >> 2) * HALF + (q & 3) * 16];
#pragma unroll
        for (int ai = 0; ai < 2; ++ai)
#pragma unroll
            for (int m = 0; m < 4; ++m) { const int r = ai * HALF + m * 16 + rb;
                if (r < nv) { const int slot = slots[ai * 4 + m]; const float gt = gts[r];
                    if constexpr (Y_F8) {
                        unsigned pk[2][2];
#pragma unroll
                        for (int bj = 0; bj < 2; ++bj) { const f32x4 s0 = (acc[ai][bj][m][0] * OSC + bv[bj][0]) * (gt * Y_SCALE), s1 = (acc[ai][bj][m][1] * OSC + bv[bj][1]) * (gt * Y_SCALE); int w0 = 0, w1 = 0;
                            w0 = __builtin_amdgcn_cvt_pk_fp8_f32(s0[0], s0[1], w0, false); w0 = __builtin_amdgcn_cvt_pk_fp8_f32(s0[2], s0[3], w0, true); w1 = __builtin_amdgcn_cvt_pk_fp8_f32(s1[0], s1[1], w1, false); w1 = __builtin_amdgcn_cvt_pk_fp8_f32(s1[2], s1[3], w1, true);
                            pk[bj][0] = (unsigned)w0; pk[bj][1] = (unsigned)w1; }
                        const auto x0 = __builtin_amdgcn_permlane16_swap(pk[0][0], pk[1][0], false, false), x1 = __builtin_amdgcn_permlane16_swap(pk[0][1], pk[1][1], false, false);
                        *(u32x4*)((unsigned char*)Y + (size_t)slot * 1024 + c0 + ((fq & 1) ? 120 : 0)) = (u32x4){x0[0], x1[0], x0[1], x1[1]};
                    } else {
#pragma unroll
                    for (int bj = 0; bj < 2; ++bj) { const f32x4 v0 = (acc[ai][bj][m][0] * OSC + bv[bj][0]) * gt, v1 = (acc[ai][bj][m][1] * OSC + bv[bj][1]) * gt;
                        u32x4 w; w.x = cvt_pk_bf16(v0[0], v0[1]); w.y = cvt_pk_bf16(v0[2], v0[3]); w.z = cvt_pk_bf16(v1[0], v1[1]); w.w = cvt_pk_bf16(v1[2], v1[3]);
                        if (NT_STORE) __builtin_nontemporal_store(w, (u32x4*)(Y + (size_t)slot * 1024 + c0 + bj * HALF)); else *(u32x4*)(Y + (size_t)slot * 1024 + c0 + bj * HALF) = w; } } } }
    }
};

__device__ __forceinline__ const char* uni_ptr(const char* p) { const unsigned long long v = (unsigned long long)p; const unsigned lo = __builtin_amdgcn_readfirstlane((unsigned)v), hi = __builtin_amdgcn_readfirstlane((unsigned)(v >> 32)); return (const char*)(((unsigned long long)hi << 32) | lo); }
typedef int v4i_t __attribute__((ext_vector_type(4))); typedef int v8i_t __attribute__((ext_vector_type(8)));
__device__ __forceinline__ v8i_t cat8(const bf16x8 a, const bf16x8 b) { return __builtin_shufflevector(__builtin_bit_cast(v4i_t, a), __builtin_bit_cast(v4i_t, b), 0, 1, 2, 3, 4, 5, 6, 7); }
template <class Epi, class Sched, bool GATHER, bool F8 = false, bool DEFER = false>
__device__ __forceinline__ void gemm_phase(LAS unsigned char* lds, const Sched& S, const Epi& E, const int tid) {
    const int wid = __builtin_amdgcn_readfirstlane(tid >> 6), lane = tid & 63, wr = wid >> 2, wc = wid & 3, fr = lane & 15, fq = lane >> 4;
    const int KB = S.KB, nt = KB / 128;
    unsigned voffA[2], voffB[2];
#pragma unroll
    for (int i = 0; i < 2; ++i) { int R, C; stage_rc(tid * 16 + i * 8192, R, C); const int Rb = Epi::PERM ? ((R & ~31) + perm32(R & 31)) : R;
        voffA[i] = (unsigned)(R * KB + C * 2); voffB[i] = (unsigned)(Rb * KB + C * 2); }
    const size_t kstep = (size_t)(BK * 2);
    const size_t hstep = (size_t)HALF * KB;
    const unsigned ldsw = (unsigned)wid * 1024u;
    const int aoff = lds_byte(wr * 64 + fr, fq * 8), boff = lds_byte(wc * 32 + fr, fq * 8);
#define PG8_SA(b, h) (((b) * 2 + (h)) * HTB)
#define PG8_SB(b, h) ((4 + (b) * 2 + (h)) * HTB)
#define PG8_STAGE(bufoff, gbase, voff) do { const char* _gb = uni_ptr((const char*)(gbase)); _Pragma("unroll") for (int _i = 0; _i < 2; ++_i) \
        __builtin_amdgcn_global_load_lds((const unsigned*)(_gb + (voff)[_i]), (LAS unsigned*)(lds + (bufoff) + ldsw + _i * 8192), 16, 0, 0); } while (0)
#define PG8_STAGE_A(bufoff, kb, h, GO) do { if constexpr (GATHER) { PG8_STAGE(bufoff, kb, (GO)[h]); } else { PG8_STAGE(bufoff, (kb) + (h) * hstep, voffA); } } while (0)
#define PG8_LDA(dst, b, h) do { if constexpr (F8) { _Pragma("unroll") for (int m = 0; m < 4; ++m) dst##8[m] = cat8(*(const LAS bf16x8*)(lds + PG8_SA(b, h) + aoff + m * 2048), *(const LAS bf16x8*)(lds + PG8_SA(b, h) + aoff + m * 2048 + 1024)); } else { \
        _Pragma("unroll") for (int m = 0; m < 4; ++m) _Pragma("unroll") for (int k = 0; k < 2; ++k) dst[m][k] = *(const LAS bf16x8*)(lds + PG8_SA(b, h) + aoff + m * 2048 + k * 1024); } } while (0)
#define PG8_LDB(dst, b, h) do { if constexpr (F8) { _Pragma("unroll") for (int n = 0; n < 2; ++n) dst##8[n] = cat8(*(const LAS bf16x8*)(lds + PG8_SB(b, h) + boff + n * 2048), *(const LAS bf16x8*)(lds + PG8_SB(b, h) + boff + n * 2048 + 1024)); } else { \
        _Pragma("unroll") for (int n = 0; n < 2; ++n) _Pragma("unroll") for (int k = 0; k < 2; ++k) dst[n][k] = *(const LAS bf16x8*)(lds + PG8_SB(b, h) + boff + n * 2048 + k * 1024); } } while (0)
#define PG8_MMA(ai, bj, At, Bt) do { __builtin_amdgcn_s_setprio(1); if constexpr (F8) { _Pragma("unroll") for (int m = 0; m < 4; ++m) _Pragma("unroll") for (int n = 0; n < 2; ++n) \
        acc[ai][bj][m][n] = __builtin_amdgcn_mfma_scale_f32_16x16x128_f8f6f4(Bt##8[n], At##8[m], acc[ai][bj][m][n], 0, 0, 0, 0, 0, 0); } else { \
        _Pragma("unroll") for (int m = 0; m < 4; ++m) _Pragma("unroll") for (int n = 0; n < 2; ++n) _Pragma("unroll") for (int k = 0; k < 2; ++k) \
        acc[ai][bj][m][n] = __builtin_amdgcn_mfma_f32_16x16x32_bf16(Bt[n][k], At[m][k], acc[ai][bj][m][n], 0, 0, 0); } __builtin_amdgcn_s_setprio(0); } while (0)
#define PG8_WAIT_V(n) asm volatile("s_waitcnt vmcnt(" #n ")" ::: "memory")
#define PG8_WAIT_L(n) asm volatile("s_waitcnt lgkmcnt(" #n ")" ::: "memory")
#define PG8_BAR __builtin_amdgcn_s_barrier()
#define PG8_SCHED __builtin_amdgcn_sched_barrier(0)
    LAS int* const ibuf = (LAS int*)(lds + STAGE_BYTES + 512);
#define PG8_IDMA(u, b) do { if constexpr (GATHER) { __builtin_amdgcn_global_load_lds((const unsigned*)(S.idx_src(u) + 64 * (wid & 3) + lane), (LAS unsigned*)(ibuf + (b) * 256 + 64 * (wid & 3)), 4, 0, 0); \
        if constexpr (Epi::HAS_GATE) __builtin_amdgcn_global_load_lds((const unsigned*)(E.gidx + (S.idx_src(u) - S.idx) + 64 * (wid & 3) + lane), (LAS unsigned*)(ibuf + 768 + (b) * 256 + 64 * (wid & 3)), 4, 0, 0); } } while (0)
#define PG8_GOFF(dst, u, b) do { if constexpr (GATHER) { int _t = tid; asm volatile("" : "+v"(_t)); const int _nv = S.nvalid(u); _Pragma("unroll") for (int _i = 0; _i < 2; ++_i) { int _R, _C; stage_rc(_t * 16 + _i * 8192, _R, _C); \
        _Pragma("unroll") for (int _h = 0; _h < 2; ++_h) { const int _r = _R + _h * HALF; const unsigned _s = (unsigned)ibuf[(b) * 256 + (_r < _nv ? _r : 0)]; dst[_h][_i] = (_s >> Sched::ROW_SHIFT) * (unsigned)KB + (unsigned)_C * 2u; } } } } while (0)
    Unit cur, nxt; int ui = 0;
    if (!S.next(0, cur)) return;
    f32x4 acc[2][2][4][2];
#pragma unroll
    for (int a = 0; a < 2; ++a)
#pragma unroll
        for (int b = 0; b < 2; ++b)
#pragma unroll
            for (int m = 0; m < 4; ++m)
#pragma unroll
                for (int n = 0; n < 2; ++n) acc[a][b][m][n] = (f32x4){0.f, 0.f, 0.f, 0.f};
    bf16x8 At[4][2], B0[2][2], B1[2][2];
    v8i_t At8[4], B08[2], B18[2];
    unsigned gA[2][2] = {{0u, 0u}, {0u, 0u}}, gN[2][2] = {{0u, 0u}, {0u, 0u}};
    int bsel = 0;
    f32x4 bpre[4] = {(f32x4){0.f, 0.f, 0.f, 0.f}, (f32x4){0.f, 0.f, 0.f, 0.f}, (f32x4){0.f, 0.f, 0.f, 0.f}, (f32x4){0.f, 0.f, 0.f, 0.f}};
    Pend pend; int ppn = 0, pnv = 0, pq = 8, pbuf = 0;
    if constexpr (DEFER) {
#pragma unroll
        for (int q = 0; q < 8; ++q) pend.val[q] = (u32x2){0u, 0u}; }
#define PG8_PSTORE() do { if constexpr (DEFER) { const int _l3 = lane_id_volatile(); const int _nv = (pq < 8) ? pnv : 0; \
        E.store_one(pend.val[0], ibuf + pbuf * 256, ((pq >> 2) & 1) * HALF + (pq & 3) * 16 + wr * 64 + (_l3 & 15), _nv, ppn * HALF + wc * 32 + 8 * (_l3 >> 4)); \
        _Pragma("unroll") for (int _q = 0; _q < 7; ++_q) pend.val[_q] = pend.val[_q + 1]; ++pq; } } while (0)
    if constexpr (GATHER) { PG8_IDMA(cur, 0); PG8_WAIT_V(0); PG8_BAR; }
    PG8_GOFF(gA, cur, 0);
    const char* cA = S.a_base(cur); const char* cB = S.b_base(cur);
    PG8_STAGE(PG8_SB(0, 0), cB, voffB); PG8_STAGE(PG8_SB(0, 1), cB + hstep, voffB); PG8_STAGE_A(PG8_SA(0, 0), cA, 0, gA); PG8_STAGE_A(PG8_SA(0, 1), cA, 1, gA);
    if (wr == 1) PG8_BAR;
    PG8_WAIT_V(2); PG8_BAR;
    PG8_STAGE(PG8_SB(1, 0), cB + kstep, voffB); PG8_STAGE_A(PG8_SA(1, 0), cA + kstep, 0, gA); PG8_STAGE(PG8_SB(1, 1), cB + hstep + kstep, voffB);
    PG8_WAIT_V(6); PG8_BAR;
    for (;;) {
        const bool has_next = S.next(ui + 1, nxt);
        const char* nA = has_next ? S.a_base(nxt) : cA; const char* nB = has_next ? S.b_base(nxt) : cB;
        const int bnxt = (bsel == 2) ? 0 : bsel + 1;
        if constexpr (GATHER) { if (has_next) PG8_IDMA(nxt, bnxt); }
        for (int t = 0; t < nt; t += 2) {
            const bool last = (t == nt - 2);
            const char* a1 = cA + (size_t)(t + 1) * kstep;
            const char* a2 = last ? nA : cA + (size_t)(t + 2) * kstep; const char* b2 = last ? nB : cB + (size_t)(t + 2) * kstep;
            const char* a3 = a2 + kstep; const char* b3 = b2 + kstep;
            if constexpr (GATHER) { if (last && has_next) { PG8_GOFF(gN, nxt, bnxt); } }
            if constexpr (Epi::HAS_BIAS) { if (last) E.load_bias(cur, wc, lane_id_volatile() >> 4, bpre); }
            PG8_LDB(B0, 0, 0); PG8_LDB(B1, 0, 1); PG8_SCHED; PG8_LDA(At, 0, 0); PG8_STAGE_A(PG8_SA(1, 1), a1, 1, gA);
            if constexpr (GATHER) { if (last && has_next) { gA[0][0] = gN[0][0]; gA[0][1] = gN[0][1]; gA[1][0] = gN[1][0]; gA[1][1] = gN[1][1]; } }
            PG8_WAIT_V(8); PG8_WAIT_L(0); PG8_BAR; PG8_MMA(0, 0, At, B0); PG8_MMA(0, 1, At, B1); PG8_BAR; PG8_SCHED;
            PG8_LDA(At, 0, 1); PG8_STAGE(PG8_SB(0, 0), b2, voffB); PG8_STAGE(PG8_SB(0, 1), b2 + hstep, voffB); PG8_STAGE_A(PG8_SA(0, 0), a2, 0, gA);
            PG8_WAIT_V(8); PG8_WAIT_L(0); PG8_BAR; PG8_MMA(1, 0, At, B0); PG8_MMA(1, 1, At, B1); PG8_BAR; PG8_SCHED;
            PG8_PSTORE();
            PG8_LDB(B0, 1, 0); PG8_LDB(B1, 1, 1); PG8_SCHED; PG8_LDA(At, 1, 0); PG8_STAGE_A(PG8_SA(0, 1), a2, 1, gA);
            PG8_WAIT_V(8); PG8_WAIT_L(0); PG8_BAR; PG8_MMA(0, 0, At, B0); PG8_MMA(0, 1, At, B1); PG8_BAR; PG8_SCHED;
            PG8_LDA(At, 1, 1); PG8_STAGE(PG8_SB(1, 0), b3, voffB); PG8_STAGE(PG8_SB(1, 1), b3 + hstep, voffB); PG8_STAGE_A(PG8_SA(1, 0), a3, 0, gA);
            PG8_WAIT_V(8); PG8_WAIT_L(0); PG8_BAR; PG8_MMA(1, 0, At, B0); PG8_MMA(1, 1, At, B1); PG8_BAR; PG8_SCHED;
            PG8_PSTORE();
        }
        if (ALIGN_EPI) { if (wr == 0) PG8_BAR; }
        { const int l2 = lane_id_volatile(), fr2 = l2 & 15, fq2 = l2 >> 4;
          if constexpr (DEFER) { _Pragma("unroll") for (int _f = 0; _f < 8; ++_f) PG8_PSTORE();
              E.prepare(acc, cur, wr, wc, fr2, fq2, pend); ppn = cur.pn; pnv = S.nvalid(cur); pq = 0; pbuf = bsel; }
          else if constexpr (GATHER) E(acc, cur, wr, wc, fr2, fq2, ibuf + bsel * 256, S.nvalid(cur), bpre); else E(acc, cur, wr, wc, fr2, fq2); }
        if (!has_next) break;
#pragma unroll
        for (int a = 0; a < 2; ++a)
#pragma unroll
            for (int b = 0; b < 2; ++b)
#pragma unroll
                for (int m = 0; m < 4; ++m)
#pragma unroll
                    for (int n = 0; n < 2; ++n) acc[a][b][m][n] = (f32x4){0.f, 0.f, 0.f, 0.f};
        cur = nxt; cA = nA; cB = nB; ++ui; bsel = bnxt;
        if (ALIGN_EPI) { if (wr == 1) PG8_BAR; }
    }
    if constexpr (DEFER) { _Pragma("unroll") for (int _f = 0; _f < 8; ++_f) PG8_PSTORE(); }
    PG8_WAIT_V(0);
    if (!ALIGN_EPI) { if (wr == 0) PG8_BAR; }
    PG8_BAR;
#undef PG8_PSTORE
#undef PG8_SA
#undef PG8_SB
#undef PG8_STAGE
#undef PG8_STAGE_A
#undef PG8_LDA
#undef PG8_LDB
#undef PG8_MMA
#undef PG8_WAIT_V
#undef PG8_WAIT_L
#undef PG8_BAR
#undef PG8_SCHED
#undef PG8_GOFF
#undef PG8_IDMA
}
}

namespace attn_body {
using bf16=__hip_bfloat16;
using bf16x8=__attribute__((ext_vector_type(8)))short;
using s16x4=__attribute__((ext_vector_type(4)))short;
using f32x16=__attribute__((ext_vector_type(16)))float;
using u32x4=__attribute__((ext_vector_type(4)))unsigned;
constexpr int D=64;
constexpr int NW=8,QBLK=32,QB=QBLK*NW,KVBLK=64;
constexpr int ATTN_UNIT_ROWS=QB;
__device__ __forceinline__ int crow(int r,int hi){return (r&3)+8*(r>>2)+4*hi;}
#define SBAR() __builtin_amdgcn_sched_barrier(0)
__device__ __forceinline__ void cmask(f32x16&p0,f32x16&p1,int jb,int qrel,int hi){
  const float NEG=-INFINITY; int kb=64*jb+4*hi;
  #pragma unroll
  for(int r=0;r<16;++r){int kv=kb+(r&3)+8*(r>>2); if(kv>qrel)p0[r]=NEG; if(kv+32>qrel)p1[r]=NEG;}
}

constexpr int NSLOT=3, SLOTB=8192;
constexpr int LDS_K=0, LDS_V=NSLOT*SLOTB, LDS_WS=2*NSLOT*SLOTB, LDS_OST=LDS_WS+NW*64*4, LDS_BYTES=LDS_OST+NW*4096;
constexpr float C2=0.125f*1.4426950408889634f;
__device__ __forceinline__ void glds16(const void*gsrc,unsigned lds_dst){unsigned keep;
  asm volatile("s_mov_b32 %0, m0\n\ts_mov_b32 m0, %2\n\ts_nop 0\n\tglobal_load_lds_dwordx4 %1, off\n\ts_mov_b32 m0, %0":"=&s"(keep):"v"(gsrc),"s"(lds_dst):"memory");}
__device__ __forceinline__ float max3f(float a,float b,float c){float r;asm("v_max3_f32 %0, %1, %2, %3":"=v"(r):"v"(a),"v"(b),"v"(c));return r;}
__device__ __forceinline__ float max2f(float a,float b){float r;asm("v_max_f32_e32 %0, %1, %2":"=v"(r):"v"(a),"v"(b));return r;}
__device__ __forceinline__ float fadd_s(float a,float b){float r;asm("v_add_f32_e32 %0, %1, %2":"=v"(r):"v"(a),"v"(b));return r;}
__device__ __forceinline__ float fsub_s(float a,float b){float r;asm("v_sub_f32_e32 %0, %1, %2":"=v"(r):"v"(a),"v"(b));return r;}
typedef float f32x2_t __attribute__((ext_vector_type(2))); typedef __bf16 bf16x2_t __attribute__((ext_vector_type(2)));
__device__ __forceinline__ unsigned cvtpk_s(float lo,float hi){f32x2_t v={lo,hi};bf16x2_t b=__builtin_convertvector(v,bf16x2_t);return __builtin_bit_cast(unsigned,b);}
#define WAIT_BAR(N) asm volatile("s_waitcnt vmcnt(" #N ") lgkmcnt(0)\n\ts_barrier":::"memory")

__device__ __forceinline__ void qkt(f32x16&p0,f32x16&p1,const char*Kslot,const bf16x8*qr,const f32x16&negm,int r32,int hi){
  const char*kb=Kslot+hi*1024+r32*16;
  #pragma unroll
  for(int d0=0;d0<4;++d0){
    const bf16x8 b0=*reinterpret_cast<const bf16x8*>(kb+d0*2048);
    const bf16x8 b1=*reinterpret_cast<const bf16x8*>(kb+d0*2048+512);
    if(d0==0){p0=__builtin_amdgcn_mfma_f32_32x32x16_bf16(b0,qr[0],negm,0,0,0);p1=__builtin_amdgcn_mfma_f32_32x32x16_bf16(b1,qr[0],negm,0,0,0);}
    else{p0=__builtin_amdgcn_mfma_f32_32x32x16_bf16(b0,qr[d0],p0,0,0,0);p1=__builtin_amdgcn_mfma_f32_32x32x16_bf16(b1,qr[d0],p1,0,0,0);}}
}
typedef __attribute__((address_space(3))) const char* lds_cptr;
typedef short v4i16_t __attribute__((ext_vector_type(4)));
__device__ __forceinline__ void kload8(bf16x8*kf,lds_cptr kp){
  kf[0]=*(const __attribute__((address_space(3))) bf16x8*)(kp);      kf[1]=*(const __attribute__((address_space(3))) bf16x8*)(kp+512);
  kf[2]=*(const __attribute__((address_space(3))) bf16x8*)(kp+2048); kf[3]=*(const __attribute__((address_space(3))) bf16x8*)(kp+2560);
  kf[4]=*(const __attribute__((address_space(3))) bf16x8*)(kp+4096); kf[5]=*(const __attribute__((address_space(3))) bf16x8*)(kp+4608);
  kf[6]=*(const __attribute__((address_space(3))) bf16x8*)(kp+6144); kf[7]=*(const __attribute__((address_space(3))) bf16x8*)(kp+6656);
}
__device__ __forceinline__ void kload2(bf16x8*kf,lds_cptr kp,int j){ kf[2*j]=*(const __attribute__((address_space(3))) bf16x8*)(kp+j*2048); kf[2*j+1]=*(const __attribute__((address_space(3))) bf16x8*)(kp+j*2048+512); }
__device__ __forceinline__ s16x4 vtr(lds_cptr p){ return __builtin_bit_cast(s16x4,__builtin_amdgcn_ds_read_tr16_b64_v4i16((__attribute__((address_space(3))) v4i16_t*)p)); }
__device__ __forceinline__ float rowmax(const f32x16&p0,const f32x16&p1){
  float a=max3f(p0[0],p0[1],p1[0]),b=max3f(p0[2],p0[3],p1[1]);a=max3f(a,p1[2],p1[3]);
  #pragma unroll
  for(int r=4;r<16;r+=4){a=max3f(a,p0[r],p0[r+1]);b=max3f(b,p0[r+2],p0[r+3]);a=max3f(a,p1[r],p1[r+1]);b=max3f(b,p1[r+2],p1[r+3]);}
  const float m=max2f(a,b);
  auto rr=__builtin_amdgcn_permlane32_swap(__float_as_uint(m),__float_as_uint(m),false,false);
  return max2f(__uint_as_float(rr[0]),__uint_as_float(rr[1]));
}
__device__ __forceinline__ void pv(f32x16*o,int vb,bf16x8 pa0,bf16x8 pa1,bf16x8 pa2,bf16x8 pa3){
  #pragma unroll
  for(int d0=0;d0<2;++d0){s16x4 lo[4],hi[4];
    #pragma unroll
    for(int ks=0;ks<4;++ks){
      asm volatile("ds_read_b64_tr_b16 %0,%1 offset:%c2":"=&v"(lo[ks]):"v"(vb),"i"(d0*4096+ks*1024):"memory");
      asm volatile("ds_read_b64_tr_b16 %0,%1 offset:%c2":"=&v"(hi[ks]):"v"(vb),"i"(d0*4096+ks*1024+512):"memory");}
    asm volatile("s_waitcnt lgkmcnt(0)":::"memory");SBAR();
    #define PK(k) (bf16x8){lo[k][0],lo[k][1],lo[k][2],lo[k][3],hi[k][0],hi[k][1],hi[k][2],hi[k][3]}
    o[d0]=__builtin_amdgcn_mfma_f32_32x32x16_bf16(pa0,PK(0),o[d0],0,0,0);
    o[d0]=__builtin_amdgcn_mfma_f32_32x32x16_bf16(pa1,PK(1),o[d0],0,0,0);
    o[d0]=__builtin_amdgcn_mfma_f32_32x32x16_bf16(pa2,PK(2),o[d0],0,0,0);
    o[d0]=__builtin_amdgcn_mfma_f32_32x32x16_bf16(pa3,PK(3),o[d0],0,0,0);
    #undef PK
  }
}

#ifndef ATTN_STORE16
#define ATTN_STORE16(p,v) (*(u32x4*)(p)=(v))
#endif
template<int THRL, bool O8 = false> __device__ __forceinline__ void attn_unit(const bf16*Qu,const bf16*__restrict__ Kh,const bf16*__restrict__ Vh,bf16*Ou,const int QP,const int KP,const int VP,const int OP,const int NT,char*shm,const int tid){
  const int lane=tid&63,r32=lane&31,hi=lane>>5; const int wid=__builtin_amdgcn_readfirstlane(tid>>6);
  const bf16*Qw=Qu+(long)(wid*QBLK)*QP;
  const unsigned lds0=(unsigned)(uintptr_t)shm;
  float*wsf=(float*)(shm+LDS_WS)+wid*64;
  const bf16*ksrc=Kh+(long)lane*KP+wid*8;
  const bf16*vsrc=Vh+(long)(16*(wid&3)+(lane>>2))*VP+(wid>>2)*32+(lane&3)*8;
  const unsigned kdst=lds0+LDS_K+wid*1024, vdst=lds0+LDS_V+wid*1024;
  #define DMA_K(t,slot) glds16(ksrc+(long)(t)*KVBLK*KP,(unsigned)__builtin_amdgcn_readfirstlane(kdst+(slot)))
  #define DMA_V(t,slot) glds16(vsrc+(long)(t)*KVBLK*VP,(unsigned)__builtin_amdgcn_readfirstlane(vdst+(slot)))
  const int vb0=(int)(lds0+LDS_V)+((lane>>4)&1)*32+(lane&3)*8+(4*hi+((lane&15)>>2))*64;
  const char*Kbase=shm+LDS_K; bf16x8 kf[8];
  const lds_cptr shm3=(lds_cptr)shm; const lds_cptr kp0=shm3+LDS_K+hi*1024+r32*16; const lds_cptr vp0=shm3+LDS_V+((lane>>4)&1)*32+(lane&3)*8+(4*hi+((lane&15)>>2))*64;
  DMA_K(0,0);DMA_V(0,0);DMA_K(1,SLOTB);
  bf16x8 qr[4];
  #pragma unroll
  for(int d0=0;d0<4;++d0)qr[d0]=*reinterpret_cast<const bf16x8*>(&Qw[(long)r32*QP+d0*16+hi*8]);
  float mhat=0.f,l_reg=0.f;f32x16 o[2];f32x16 negm; { float z_=0.f; asm volatile("":"+v"(z_)); _Pragma("unroll") for(int r=0;r<16;++r){o[0][r]=z_;o[1][r]=z_;negm[r]=z_;} } asm volatile("":"+v"(negm));
  #define CMASK(P0,P1,t) do{}while(0)
  bool resc=false;
  #define START(P0,P1) do{ const float rm=rowmax(P0,P1); resc=false; \
    { const float dl=rm; mhat=fadd_s(mhat,dl); \
      _Pragma("unroll") for(int r=0;r<16;++r){P0[r]=fsub_s(P0[r],dl);P1[r]=fsub_s(P1[r],dl);} \
      _Pragma("unroll") for(int r=0;r<16;++r)negm[r]=-mhat; asm volatile("":"+v"(negm)); } \
    _Pragma("unroll") for(int r=0;r<16;++r)P0[r]=__builtin_amdgcn_exp2f(P0[r]); }while(0)
  #define RESC() do{ if(resc){ asm volatile("s_waitcnt lgkmcnt(0)":::"memory"); \
      _Pragma("unroll") for(int d_=0;d_<2;++d_) _Pragma("unroll") for(int r=0;r<16;++r)o[d_][r]*=wsf[crow(r,hi)]; } }while(0)
  f32x16 pA0,pA1,pB0,pB1;
  int sl_prev=0,sl_cur=0,sl_next=SLOTB;
  #define ROT() do{sl_prev=sl_cur;sl_cur=sl_next;sl_next=(sl_next==(NSLOT-1)*SLOTB)?0:sl_next+SLOTB;}while(0)
  DMA_K(2,2*SLOTB);
  WAIT_BAR(3);
  qkt(pA0,pA1,Kbase,qr,negm,r32,hi);asm volatile("s_nop 15\n\ts_nop 7":"+v"(pA0),"+v"(pA1));CMASK(pA0,pA1,0);
  START(pA0,pA1);
  _Pragma("unroll") for(int r=0;r<16;++r)pA1[r]=__builtin_amdgcn_exp2f(pA1[r]);
  WAIT_BAR(0);
  DMA_K(3,0);DMA_V(1,SLOTB);
  ROT();
  kload8(kf,kp0+sl_cur);
  WAIT_BAR(2);
  s16x4 vlo[8],vhi[8]; u32x4 pw0,pw1,pw2,pw3;
  #define PKW(P,B) cvtpk_s(P[B],P[B+1])
  #define PAF(k) __builtin_bit_cast(bf16x8,pw##k)
  #define VFR(i) (bf16x8){vlo[i][0],vlo[i][1],vlo[i][2],vlo[i][3],vhi[i][0],vhi[i][1],vhi[i][2],vhi[i][3]}
  #define PIN(x) asm volatile("":"+v"(x))
  #define MX3(a,b,c) __builtin_fmaxf(__builtin_fmaxf((a),(b)),(c))
  #define GAPA(MF,A0,A1,A2,A3,W0,W1,PW) do{ MF; sacc+=A0; sacc+=A1; sacc+=A2; sacc+=A3; PIN(sacc); W0; W1; PIN(PW); SBAR(); }while(0)
  #define EX(v) __builtin_amdgcn_exp2f(v)
  #define GAPB(MF,X,B) do{ MF; X[B]=EX(X[B]); X[B+1]=EX(X[B+1]); X[B+2]=EX(X[B+2]); X[B+3]=EX(X[B+3]); PIN(X); SBAR(); }while(0)
  #define VRD(i) do{ vlo[i]=vtr(vp_+(((i)>>2)*4096+((i)&3)*1024)); vhi[i]=vtr(vp_+(((i)>>2)*4096+((i)&3)*1024+512)); }while(0)
  #define KRD(G,j) do{ if(G){ kload2(kf,kp0+sl_next,j); SBAR(); } }while(0)
  #define STEP(C0,C1,P0,P1,t,GK,GV,GL) do{ SBAR(); \
    const lds_cptr vp_=vp0+sl_prev; \
    VRD(0); SBAR(); float sacc=(P0[0]+P0[1]); \
    GAPA(C0=__builtin_amdgcn_mfma_f32_32x32x16_bf16(kf[0],qr[0],negm,0,0,0), P0[2],P0[3],P0[4],P0[5],     pw0[0]=PKW(P0,0), pw0[1]=PKW(P0,2), pw0); \
    VRD(4); SBAR(); GAPA(C1=__builtin_amdgcn_mfma_f32_32x32x16_bf16(kf[1],qr[0],negm,0,0,0), P0[6],P0[7],P0[8],P0[9],     pw0[2]=PKW(P0,4), pw0[3]=PKW(P0,6), pw0); \
    VRD(1); SBAR(); GAPA(C0=__builtin_amdgcn_mfma_f32_32x32x16_bf16(kf[2],qr[1],C0,0,0,0),   P0[10],P0[11],P0[12],P0[13], pw1[0]=PKW(P0,8), pw1[1]=PKW(P0,10), pw1); \
    VRD(5); SBAR(); GAPA(C1=__builtin_amdgcn_mfma_f32_32x32x16_bf16(kf[3],qr[1],C1,0,0,0),   P0[14],P0[15],P1[0],P1[1],   pw1[2]=PKW(P0,12),pw1[3]=PKW(P0,14), pw1); \
    VRD(2); SBAR(); GAPA(C0=__builtin_amdgcn_mfma_f32_32x32x16_bf16(kf[4],qr[2],C0,0,0,0),   P1[2],P1[3],P1[4],P1[5],     pw2[0]=PKW(P1,0), pw2[1]=PKW(P1,2), pw2); \
    VRD(6); SBAR(); GAPA(C1=__builtin_amdgcn_mfma_f32_32x32x16_bf16(kf[5],qr[2],C1,0,0,0),   P1[6],P1[7],P1[8],P1[9],     pw2[2]=PKW(P1,4), pw2[3]=PKW(P1,6), pw2); \
    VRD(3); SBAR(); GAPA(C0=__builtin_amdgcn_mfma_f32_32x32x16_bf16(kf[6],qr[3],C0,0,0,0),   P1[10],P1[11],P1[12],P1[13], pw3[0]=PKW(P1,8), pw3[1]=PKW(P1,10), pw3); \
    VRD(7); SBAR(); GAPA(C1=__builtin_amdgcn_mfma_f32_32x32x16_bf16(kf[7],qr[3],C1,0,0,0),   P1[14],P1[15],0.f,0.f,       pw3[2]=PKW(P1,12),pw3[3]=PKW(P1,14), pw3); \
    l_reg+=sacc; \
    if(GK){DMA_K((t)+3,sl_cur);} if(GV){DMA_V((t)+1,sl_next);} \
    CMASK(C0,C1,t); \
    { float a=MX3(C0[0],C0[1],C1[0]),b=MX3(C0[2],C0[3],C1[1]); a=MX3(a,C1[2],C1[3]); \
      _Pragma("unroll") for(int r=4;r<16;r+=4){a=MX3(a,C0[r],C0[r+1]);b=MX3(b,C0[r+2],C0[r+3]);a=MX3(a,C1[r],C1[r+1]);b=MX3(b,C1[r+2],C1[r+3]);} \
      float rm=__builtin_fmaxf(a,b); { auto rr=__builtin_amdgcn_permlane32_swap(__float_as_uint(rm),__float_as_uint(rm),false,false); rm=__builtin_fmaxf(__uint_as_float(rr[0]),__uint_as_float(rr[1])); } \
      resc=false; \
      if(__builtin_expect(__any(rm>(float)THRL),0)){ const float dl=__builtin_fmaxf(rm,0.f); mhat+=dl; \
        _Pragma("unroll") for(int r=0;r<16;++r){C0[r]-=dl;C1[r]-=dl;} \
        _Pragma("unroll") for(int r=0;r<16;++r)negm[r]=-mhat; asm volatile("":"+v"(negm)); \
        const float f=__builtin_amdgcn_exp2f(-dl); l_reg*=f; if(hi==0)wsf[r32]=f; resc=true; } } \
    SBAR(); \
    GAPB(o[0]=__builtin_amdgcn_mfma_f32_32x32x16_bf16(PAF(0),VFR(0),o[0],0,0,0), C0,0); \
    GAPB(o[1]=__builtin_amdgcn_mfma_f32_32x32x16_bf16(PAF(0),VFR(4),o[1],0,0,0), C0,4); \
    KRD(GL,0); GAPB(o[0]=__builtin_amdgcn_mfma_f32_32x32x16_bf16(PAF(1),VFR(1),o[0],0,0,0), C0,8); \
    KRD(GL,1); GAPB(o[1]=__builtin_amdgcn_mfma_f32_32x32x16_bf16(PAF(1),VFR(5),o[1],0,0,0), C0,12); \
    KRD(GL,2); GAPB(o[0]=__builtin_amdgcn_mfma_f32_32x32x16_bf16(PAF(2),VFR(2),o[0],0,0,0), C1,0); \
    KRD(GL,3); GAPB(o[1]=__builtin_amdgcn_mfma_f32_32x32x16_bf16(PAF(2),VFR(6),o[1],0,0,0), C1,4); \
    GAPB(o[0]=__builtin_amdgcn_mfma_f32_32x32x16_bf16(PAF(3),VFR(3),o[0],0,0,0), C1,8); \
    GAPB(o[1]=__builtin_amdgcn_mfma_f32_32x32x16_bf16(PAF(3),VFR(7),o[1],0,0,0), C1,12); \
    }while(0)
  int t=1;
  #undef CMASK
  #define CMASK(P0,P1,t) do{}while(0)
  for(;t+5<NT;t+=2){
    STEP(pB0,pB1,pA0,pA1,t,true,true,true);     WAIT_BAR(2); RESC(); ROT();
    STEP(pA0,pA1,pB0,pB1,t+1,true,true,true);   WAIT_BAR(2); RESC(); ROT();
  }
  #undef CMASK
  #define CMASK(P0,P1,t) do{}while(0)
  #define ENDW(tt) do{ if((tt)+3<NT){WAIT_BAR(2);} else if((tt)+2<NT){WAIT_BAR(1);} else {WAIT_BAR(0);} }while(0)
  for(;t+1<NT;t+=2){
    STEP(pB0,pB1,pA0,pA1,t,(t+3<NT),(t+1<NT),(t+1<NT));       ENDW(t);   RESC(); ROT();
    STEP(pA0,pA1,pB0,pB1,t+1,(t+4<NT),(t+2<NT),(t+2<NT));     ENDW(t+1); RESC(); ROT();
  }
  STEP(pB0,pB1,pA0,pA1,NT-1,false,false,false); RESC();
  { float sacc=pB0[0]+pB0[1]; _Pragma("unroll") for(int r=2;r<16;++r)sacc+=pB0[r]; _Pragma("unroll") for(int r=0;r<16;++r)sacc+=pB1[r]; l_reg+=sacc;
    pw0=(u32x4){PKW(pB0,0),PKW(pB0,2),PKW(pB0,4),PKW(pB0,6)};pw1=(u32x4){PKW(pB0,8),PKW(pB0,10),PKW(pB0,12),PKW(pB0,14)};pw2=(u32x4){PKW(pB1,0),PKW(pB1,2),PKW(pB1,4),PKW(pB1,6)};pw3=(u32x4){PKW(pB1,8),PKW(pB1,10),PKW(pB1,12),PKW(pB1,14)};
    SBAR(); pv(o,vb0+sl_cur,PAF(0),PAF(1),PAF(2),PAF(3)); }
  #undef PKW
  #undef PAF
  #undef VFR
  #undef PIN
  #undef MX3
  #undef GAPA
  #undef GAPB
  #undef EX
  #undef VRD
  #undef KRD
  #undef STEP
  #undef ENDW
  {auto rr=__builtin_amdgcn_permlane32_swap(__float_as_uint(l_reg),__float_as_uint(l_reg),false,false);l_reg=__uint_as_float(rr[0])+__uint_as_float(rr[1]);}
  if(hi==0)wsf[32+r32]=l_reg;asm volatile("s_waitcnt lgkmcnt(0)":::"memory");
  float rli[16];
  #pragma unroll
  for(int r=0;r<16;++r)rli[r]=__builtin_amdgcn_rcpf(wsf[32+crow(r,hi)]);
  if constexpr (O8) {
    unsigned char*Ow8=(unsigned char*)Ou+(long)(wid*QBLK)*OP; unsigned char*stg8=(unsigned char*)(shm+LDS_OST)+wid*2048;
    #pragma unroll
    for(int r=0;r<16;++r){const int orow=crow(r,hi);
      #pragma unroll
      for(int d0=0;d0<2;++d0)stg8[orow*64+d0*32+r32]=f2fp8(o[d0][r]*rli[r]);}
    asm volatile("s_waitcnt lgkmcnt(0)":::"memory");
    #pragma unroll
    for(int i=0;i<2;++i){const int row=i*16+(lane>>2),ch=lane&3; const u32x4 v=*(const u32x4*)(stg8+row*64+ch*16); ATTN_STORE16(Ow8+(long)row*OP+ch*16,v);}
  } else {
  bf16*Ow=Ou+(long)(wid*QBLK)*OP;
  { bf16*stg=(bf16*)(shm+LDS_OST)+wid*2048;
    #pragma unroll
    for(int r=0;r<16;++r){const int orow=crow(r,hi);
      #pragma unroll
      for(int d0=0;d0<2;++d0)stg[orow*64+d0*32+r32]=__float2bfloat16(o[d0][r]*rli[r]);}
    asm volatile("s_waitcnt lgkmcnt(0)":::"memory");
    #pragma unroll
    for(int i=0;i<4;++i){const int row=i*8+(lane>>3),ch=lane&7; const u32x4 v=*(const u32x4*)(stg+row*64+ch*8); ATTN_STORE16(Ow+(long)row*OP+ch*8,v);} }
  }
  asm volatile("s_waitcnt lgkmcnt(0)\n\ts_barrier":::"memory");
  #undef DMA_K
  #undef DMA_V
  #undef CMASK
  #undef START
  #undef RESC
  #undef ROT
}
constexpr int ATTN_LDS_BYTES=LDS_BYTES;
#undef SBAR
#undef WAIT_BAR
}

struct Args { const float* in[32]; float* out; unsigned char* ws; int ph_lo, ph_hi; };
struct Ctx {
    LAS unsigned char* lds;
    int vcu, G;
    unsigned char* ws;
};
constexpr int PTAB_OFF = MISC_OFF + 256;
__device__ __forceinline__ unsigned long long ptab_get(const Ctx& cx, int k) {
    const LAS unsigned* t = (const LAS unsigned*)(cx.lds + PTAB_OFF) + 2 * k; const unsigned lo = __builtin_amdgcn_readfirstlane(t[0]), hi = __builtin_amdgcn_readfirstlane(t[1]);
    return ((unsigned long long)hi << 32) | lo;
}
#define INP(k) ((const float*)(GAS const float*)ptab_get(cx, (k)))

template <bool F8> __device__ __forceinline__ void p0_transpose64(const float* W, int N, int KB, unsigned char* WT, int k0, int n0, int dst_row0, float scale, LAS float* scr, int lane) {
    f32x4 v[16];
    const float* src = W + (size_t)(k0 + (lane >> 4)) * N + n0 + (lane & 15) * 4;
#pragma unroll
    for (int i = 0; i < 16; ++i) v[i] = *(const f32x4*)(src + (size_t)(4 * i) * N);
#pragma unroll
    for (int i = 0; i < 16; ++i) { LAS float* p = scr + (4 * i + (lane >> 4)) * 65 + (lane & 15) * 4; p[0] = v[i][0]; p[1] = v[i][1]; p[2] = v[i][2]; p[3] = v[i][3]; }
    LDS_WAIT(); asm volatile("" ::: "memory");
    if constexpr (!F8) {
        const int ns = lane >> 3, ch = lane & 7;
#pragma unroll
        for (int r8 = 0; r8 < 8; ++r8) { const int n = r8 * 8 + ns; const LAS float* s = scr + (8 * ch) * 65 + n;
            u32x4 o; o.x = pk2(s[0 * 65], s[1 * 65]); o.y = pk2(s[2 * 65], s[3 * 65]); o.z = pk2(s[4 * 65], s[5 * 65]); o.w = pk2(s[6 * 65], s[7 * 65]);
            *(GAS u32x4*)(WT + (size_t)(dst_row0 + n) * KB + (k0 + 8 * ch) * 2) = o; }
    } else {
        const int ns = lane >> 2, ch = lane & 3;
#pragma unroll
        for (int r4 = 0; r4 < 4; ++r4) { const int n = r4 * 16 + ns; const LAS float* s = scr + (16 * ch) * 65 + n; unsigned w[4];
#pragma unroll
            for (int q = 0; q < 4; ++q) { int r = 0; r = __builtin_amdgcn_cvt_pk_fp8_f32(s[(4 * q) * 65] * scale, s[(4 * q + 1) * 65] * scale, r, false); r = __builtin_amdgcn_cvt_pk_fp8_f32(s[(4 * q + 2) * 65] * scale, s[(4 * q + 3) * 65] * scale, r, true); w[q] = (unsigned)r; }
            *(GAS u32x4*)(WT + (size_t)(dst_row0 + n) * KB + k0 + 16 * ch) = (u32x4){w[0], w[1], w[2], w[3]}; }
    }
    LDS_WAIT(); asm volatile("" ::: "memory");
}
__device__ __forceinline__ void p0_prologue(const Ctx& cx, const int tid) {
    const int lane = tid & 63, wave = __builtin_amdgcn_readfirstlane(tid >> 6);
    LAS float* scr = (LAS float*)(cx.lds + wave * 16896);
    const int gw = cx.vcu * 8 + wave, NGW = cx.G * 8;
    constexpr int I_WIN0 = 16 * 40, I_WIN1 = 16 * 24, I_WKV = 16 * 8, I_WOUT = 16 * 16, I_W1 = 16 * 32, I_W2 = 16 * 16;
    constexpr int T_WIN = 3 * I_WIN0 + I_WIN1, T_WKV = 4 * I_WKV, T_WOUT = 4 * I_WOUT, T_W1 = 128 * I_W1, T_W2 = 128 * I_W2;
    constexpr int NITEMS = T_WIN + T_WKV + T_WOUT + T_W1 + T_W2;
    for (int it = gw; it < NITEMS; it += NGW) {
        int r = it;
        const float* W; unsigned char* WT; int N, nb, kb, dst_row0; bool isout = false;
        if (r < T_W1) {
            const int mi = r / I_W1, q = r % I_W1; N = 2048; kb = q / 32; nb = q % 32;
            W = INP(28) + (size_t)mi * 1024 * 2048; WT = cx.ws + WS_W1 + (size_t)mi * 2048 * 1024 * MOE_EB;
            const int n0 = nb * 64, isu = n0 >= 1024, j = n0 - isu * 1024;
            dst_row0 = (j >> 7) * 256 + isu * 128 + (j & 127);
            p0_transpose64<MOE_F8>(W, N, 1024 * MOE_EB, WT, kb * 64, nb * 64, dst_row0, W1_SCALE, scr, lane); continue;
        } else if ((r -= T_W1) < T_W2) {
            const int mi = r / I_W2, q = r % I_W2; N = 1024; kb = q / 16; nb = q % 16;
            W = INP(30) + (size_t)mi * 1024 * 1024; WT = cx.ws + WS_W2 + (size_t)mi * 1024 * 1024 * MOE_EB; dst_row0 = nb * 64;
            p0_transpose64<MOE_F8>(W, N, 1024 * MOE_EB, WT, kb * 64, nb * 64, dst_row0, W2_SCALE, scr, lane); continue;
        } else if ((r -= T_W2) < T_WIN) {
            int l, q;
            if (r < I_WIN0) { l = 0; q = r; } else if (r < I_WIN0 + I_WIN1) { l = 1; q = r - I_WIN0; } else if (r < 2 * I_WIN0 + I_WIN1) { l = 2; q = r - I_WIN0 - I_WIN1; } else { l = 3; q = r - 2 * I_WIN0 - I_WIN1; }
            N = in_width(l); const int nbn = N / 64; kb = q / nbn; nb = q % nbn;
            const int kind = layer_kind(l), j = layer_j(l);
            W = (kind == 0 ? INP(2) : kind == 1 ? INP(4) : INP(7)) + (size_t)j * 1024 * N;
            WT = cx.ws + WS_WIN + (size_t)l * 5 * MiB; dst_row0 = nb * 64;
        } else if ((r -= T_WIN) < T_WKV) {
            const int l = r / I_WKV, q = r % I_WKV; N = 512; kb = q / 8; nb = q % 8;
            W = INP(20) + (size_t)l * 1024 * 512; WT = cx.ws + WS_WKV; dst_row0 = l * 512 + nb * 64;
        } else {
            r -= T_WKV; const int l = r / I_WOUT, q = r % I_WOUT; N = 1024; kb = q / 16; nb = q % 16;
            W = INP(21) + (size_t)l * 1024 * 1024; WT = cx.ws + WS_WOUT + (size_t)l * 2 * MiB; dst_row0 = nb * 64; isout = true;
        }
        if (isout) p0_transpose64<OUTP_F8 != 0>(W, N, 1024 * OUT_EB, WT, kb * 64, nb * 64, dst_row0, OUTP_F8 ? WOUT_SCALE : 1.0f, scr, lane);
        else p0_transpose64<INP_F8 != 0>(W, N, 1024 * INP_EB, WT, kb * 64, nb * 64, dst_row0, INP_F8 ? WIN_SCALE : 1.0f, scr, lane);
    }
    {
        const size_t gt = (size_t)cx.vcu * 512 + tid, NT_ = (size_t)cx.G * 512;
        for (int which = 0; which < 2; ++which) {
            const f32x4* xs = (const f32x4*)(which == 0 ? INP(0) : INP(1)); unsigned char* xd = cx.ws + (which == 0 ? WS_XB : WS_MEMB); const size_t n8 = (size_t)(which == 0 ? NTOK : NMEM) * DM / 8;
#pragma unroll 4
            for (size_t i = gt; i < n8; i += NT_) { const f32x4 a = xs[2 * i], b = xs[2 * i + 1];
                if constexpr (INP_F8) { int w0 = 0, w1 = 0; w0 = __builtin_amdgcn_cvt_pk_fp8_f32(a[0], a[1], w0, false); w0 = __builtin_amdgcn_cvt_pk_fp8_f32(a[2], a[3], w0, true); w1 = __builtin_amdgcn_cvt_pk_fp8_f32(b[0], b[1], w1, false); w1 = __builtin_amdgcn_cvt_pk_fp8_f32(b[2], b[3], w1, true);
                    *(u32x2*)(xd + i * 8) = (u32x2){(unsigned)w0, (unsigned)w1}; }
                else { u32x4 o; o.x = pk2(a[0], a[1]); o.y = pk2(a[2], a[3]); o.z = pk2(b[0], b[1]); o.w = pk2(b[2], b[3]); *(u32x4*)(xd + i * 16) = o; } }
        }
    }
    { const float* rwp = INP(26); unsigned short* RW = (unsigned short*)(cx.ws + WS_RW);
      for (int i = cx.vcu * 512 + tid; i < 4 * 32768; i += cx.G * 512) { const int l = i >> 15, r = i & 32767, k = r >> 5, e = r & 31; const float w = rwp[i]; const unsigned hi = f2bf(w); const float wl = w - bf2f((unsigned short)hi);
          RW[((size_t)(l * 2 + 0) * 32 + e) * 1024 + k] = (unsigned short)hi; RW[((size_t)(l * 2 + 1) * 32 + e) * 1024 + k] = (unsigned short)f2bf(wl); } }
    {
        const float *fw1 = INP(10), *fb1 = INP(11), *fw2 = INP(12), *fb2 = INP(13), *fw3 = INP(14), *fb3 = INP(15), *fw4 = INP(16), *fb4 = INP(17), *ffr = INP(18);
        LAS float* z = (LAS float*)cx.lds; LAS float* h1 = z + 16 * 33; LAS float* h2 = h1 + 1024; LAS float* h3 = h2 + 1024;
        float* HRAWT = (float*)(cx.ws + WS_HRAWT); float* HPART = (float*)(cx.ws + WS_HPART);
        for (int it = cx.vcu; it < 256; it += cx.G) {
            __syncthreads();
            const int pos0 = it * 16;
            for (int i = tid; i < 16 * 33; i += 512) { const int p = i / 33, f = i % 33; const float pos = (float)(pos0 + p); float v;
                if (f == 0) v = pos / 4095.0f;
                else { const int k = (f - 1) & 15; const float fb = 1e-4f + (float)k * ((15.0f - 1e-4f) / 15.0f); const float ang = (6.283185307179586f * pos / 4096.0f) * fb; v = (f <= 16) ? cosf(ang) : -sinf(ang); }
                z[i] = v; }
            __syncthreads();
            for (int i = tid; i < 1024; i += 512) { const int p = i >> 6, o = i & 63; float a = fb1[o]; for (int f = 0; f < 33; ++f) a += z[p * 33 + f] * fw1[f * 64 + o]; h1[i] = sinf(ffr[o] * a); }
            __syncthreads();
            for (int i = tid; i < 1024; i += 512) { const int p = i >> 6, o = i & 63; float a = fb2[o]; for (int k = 0; k < 64; ++k) a += h1[p * 64 + k] * fw2[k * 64 + o]; h2[i] = sinf(ffr[o] * a); }
            __syncthreads();
            for (int i = tid; i < 1024; i += 512) { const int p = i >> 6, o = i & 63; float a = fb3[o]; for (int k = 0; k < 64; ++k) a += h2[p * 64 + k] * fw3[k * 64 + o]; h3[i] = sinf(ffr[o] * a); }
            __syncthreads();
            for (int col = tid; col < 3072; col += 512) {
                float a[16]; const float bb = fb4[col];
#pragma unroll
                for (int p = 0; p < 16; ++p) a[p] = bb;
                for (int k = 0; k < 64; ++k) { const float w = fw4[(size_t)k * 3072 + col];
#pragma unroll
                    for (int p = 0; p < 16; ++p) a[p] += h3[p * 64 + k] * w; }
                const int c = col % 768; const float mind = -3.0701134573253945f, maxd = -15.350567286626972f;
                const float delta = fabsf(mind + (maxd - mind) * ((float)c / 767.0f)); float asum = 0.f;
#pragma unroll
                for (int p = 0; p < 16; ++p) { const float t = (float)(pos0 + p) / 4095.0f; a[p] *= expf(-t * delta); asum += fabsf(a[p]); }
                f32x4* dst = (f32x4*)(HRAWT + (size_t)col * 4096 + pos0);
#pragma unroll
                for (int q = 0; q < 4; ++q) dst[q] = (f32x4){a[4 * q], a[4 * q + 1], a[4 * q + 2], a[4 * q + 3]};
                HPART[(size_t)it * 3072 + col] = asum;
            }
        }
    }
}

__device__ __forceinline__ s16x4 vtr(const LAS unsigned char* p) { typedef short v4i16_t __attribute__((ext_vector_type(4))); return __builtin_bit_cast(s16x4, __builtin_amdgcn_ds_read_tr16_b64_v4i16((LAS v4i16_t*)p)); }
__device__ __forceinline__ void na_phase(const Ctx& cx, const bf16_t* PROJ, const float* rpb, bf16_t* CAT, const int tid) {
    const int lane = tid & 63, wid = __builtin_amdgcn_readfirstlane(tid >> 6), m16 = lane & 15, q4 = lane >> 4;
    LAS unsigned char* Kb = cx.lds; LAS unsigned char* Vb = cx.lds + 73728; LAS float* biasL = (LAS float*)(cx.lds + 147456);
    constexpr int PW = 2560;
    u32x4 kv[9], vv[9]; float bpre = 0.f; bf16x8 qn[2];
#define NA_LOAD(unit_) do { const int b_ = __builtin_amdgcn_readfirstlane((unit_) / 384), rem_ = __builtin_amdgcn_readfirstlane((unit_) % 384), h_ = rem_ >> 5, rp_ = rem_ & 31; int bs_ = 2 * rp_ - 4; bs_ = bs_ < 0 ? 0 : (bs_ > 56 ? 56 : bs_); bs_ = __builtin_amdgcn_readfirstlane(bs_); \
        _Pragma("unroll") for (int it = 0; it < 9; ++it) { const int i = tid + it * 512; const int brow = i >> 9, col = (i >> 3) & 63, ch = i & 7; int grow = bs_ + brow; grow = grow > 63 ? 63 : grow; \
            const size_t tok = (size_t)b_ * 4096 + grow * 64 + col; \
            kv[it] = *(const u32x4*)(PROJ + tok * PW + 768 + h_ * 64 + ch * 8); vv[it] = *(const u32x4*)(PROJ + tok * PW + 1536 + h_ * 64 + ch * 8); } \
        if (tid < 465) bpre = rpb[h_ * 465 + tid];   \
        { const size_t tq_ = (size_t)b_ * 4096 + (2 * rp_ + (wid >> 2)) * 64 + 16 * (wid & 3) + m16; \
          _Pragma("unroll") for (int kk = 0; kk < 2; ++kk) qn[kk] = *(const bf16x8*)(PROJ + tq_ * PW + h_ * 64 + 32 * kk + 8 * q4); } } while (0)
    int u0 = cx.vcu; asm volatile("" : "+s"(u0));
    if (u0 < 6144) NA_LOAD(u0);
    for (int unit = u0; unit < 6144; unit += cx.G) {
        const int b = unit / 384, rem = unit % 384, h = rem >> 5, rp = rem & 31;
        int bs = 2 * rp - 4; bs = bs < 0 ? 0 : (bs > 56 ? 56 : bs);
        __syncthreads();
#pragma unroll
        for (int it = 0; it < 9; ++it) { const int i = tid + it * 512; const int brow = i >> 9, col = (i >> 3) & 63, ch = i & 7;
            *(LAS u32x4*)(Kb + (brow * 64 + col) * 128 + ((ch ^ ((col >> 1) & 7)) << 4)) = kv[it];
            *(LAS u32x4*)(Vb + (brow * 64 + col) * 128 + ((ch ^ (col & 7)) << 4)) = vv[it]; }
        if (tid < 465) biasL[tid] = bpre * LOG2E;
        __syncthreads();
        bf16x8 qf[2]; qf[0] = qn[0]; qf[1] = qn[1];
        { const int un_ = (unit + cx.G < 6144) ? unit + cx.G : unit; NA_LOAD(un_); }
        const int r = 2 * rp + (wid >> 2), g = wid & 3;
        const int wc0 = (g == 0) ? 0 : (g == 1) ? 8 : (g == 2) ? 24 : 32;
        int r0 = r - 4; r0 = r0 < 0 ? 0 : (r0 > 56 ? 56 : r0); const int ro = r0 - bs;
        const int c = 16 * g + m16;
        const size_t tq = (size_t)b * 4096 + r * 64 + c;
        f32x4 S[16];
#pragma unroll
        for (int i = 0; i < 8; ++i)
#pragma unroll
            for (int ct = 0; ct < 2; ++ct) { const int col = wc0 + 16 * ct + m16; const LAS unsigned char* kp = Kb + ((ro + i) * 64 + col) * 128; const int sw = (col >> 1) & 7;
                f32x4 a = (f32x4){0.f, 0.f, 0.f, 0.f};
#pragma unroll
                for (int kk = 0; kk < 2; ++kk) { const bf16x8 kf = *(const LAS bf16x8*)(kp + (((q4 + 4 * kk) ^ sw) << 4)); a = __builtin_amdgcn_mfma_f32_16x16x32_bf16(kf, qf[kk], a, 0, 0, 0); }
                S[2 * i + ct] = a; }
        int c0 = c - 8; c0 = c0 < 0 ? 0 : (c0 > 48 ? 48 : c0);
        float mx = -INFINITY;
#pragma unroll
        for (int i = 0; i < 8; ++i)
#pragma unroll
            for (int ct = 0; ct < 2; ++ct)
#pragma unroll
                for (int v = 0; v < 4; ++v) { const int kc = wc0 + 16 * ct + 4 * q4 + v; const bool valid = (kc >= c0) && (kc < c0 + 16);
                    const int bidx = valid ? (r0 + i - r + 7) * 31 + (kc - c + 15) : 0;
                    const float s = valid ? S[2 * i + ct][v] + biasL[bidx] : -INFINITY; S[2 * i + ct][v] = s; mx = fmaxf(mx, s); }
        mx = fmaxf(mx, shflx(mx, 16, lane)); mx = fmaxf(mx, shflx(mx, 32, lane));
        float l = 0.f;
#pragma unroll
        for (int t = 0; t < 16; ++t)
#pragma unroll
            for (int v = 0; v < 4; ++v) { const float p = __builtin_amdgcn_exp2f(S[t][v] - mx); S[t][v] = p; l += p; }
        l += shflx(l, 16, lane); l += shflx(l, 32, lane);
        f32x4 O[4];
#pragma unroll
        for (int dt = 0; dt < 4; ++dt) O[dt] = (f32x4){0.f, 0.f, 0.f, 0.f};
        const int qq = m16 >> 2, pp = m16 & 3, col1 = wc0 + 4 * q4 + qq;
#pragma unroll
        for (int i = 0; i < 8; ++i) {
            u32x4 pw; pw.x = pk2(S[2 * i][0], S[2 * i][1]); pw.y = pk2(S[2 * i][2], S[2 * i][3]); pw.z = pk2(S[2 * i + 1][0], S[2 * i + 1][1]); pw.w = pk2(S[2 * i + 1][2], S[2 * i + 1][3]);
            const bf16x8 pb = __builtin_bit_cast(bf16x8, pw);
            const LAS unsigned char* v1 = Vb + ((ro + i) * 64 + col1) * 128 + 8 * (pp & 1);
            const LAS unsigned char* v2 = v1 + 16 * 128;
#pragma unroll
            for (int dt = 0; dt < 4; ++dt) { const int chunk = 2 * dt + (pp >> 1);
                const s16x4 lo = vtr(v1 + ((chunk ^ (col1 & 7)) << 4)), hi = vtr(v2 + ((chunk ^ ((col1 + 16) & 7)) << 4));
                const bf16x8 vf = (bf16x8){lo[0], lo[1], lo[2], lo[3], hi[0], hi[1], hi[2], hi[3]};
                O[dt] = __builtin_amdgcn_mfma_f32_16x16x32_bf16(vf, pb, O[dt], 0, 0, 0); }
        }
        const float inv = 1.0f / l;
#pragma unroll
        for (int dt = 0; dt < 4; ++dt) {
            if constexpr (OUTP_F8) { int w = 0; w = __builtin_amdgcn_cvt_pk_fp8_f32(O[dt][0] * inv, O[dt][1] * inv, w, false); w = __builtin_amdgcn_cvt_pk_fp8_f32(O[dt][2] * inv, O[dt][3] * inv, w, true); *(int*)((unsigned char*)CAT + tq * 1024 + h * 64 + 16 * dt + 4 * q4) = w; }
            else { u32x2 w; w.x = pk2(O[dt][0] * inv, O[dt][1] * inv); w.y = pk2(O[dt][2] * inv, O[dt][3] * inv); *(u32x2*)(CAT + tq * 1024 + h * 64 + 16 * dt + 4 * q4) = w; } }
    }
    __syncthreads();
}

#undef NA_LOAD
__device__ __forceinline__ void rope_phase(const Ctx& cx, const bf16_t* PROJ, const float* qg, const float* kg, bf16_t* QKR, const int tid) {
    const int lane = tid & 63, wave = __builtin_amdgcn_readfirstlane(tid >> 6);
    const int gw = cx.vcu * 8 + wave, NGW = cx.G * 8;
    const int d0 = (lane & 7) * 8;
    float gq[8], gk[8], invf[4];
#pragma unroll
    for (int e = 0; e < 8; ++e) { gq[e] = qg[d0 + e]; gk[e] = kg[d0 + e]; }
#pragma unroll
    for (int p = 0; p < 4; ++p) { const int i = (d0 >> 1) + p, j = i & 15; invf[p] = exp2f(-(float)(2 * j) / 32.0f * 13.287712379549449f); }
    const bool isrow = (d0 >> 1) < 16;
    for (int pos = gw; pos < SEQ; pos += NGW) {
        const float pr = isrow ? (float)(pos >> 6) : (float)(pos & 63);
        float cs[4], sn[4];
#pragma unroll
        for (int p = 0; p < 4; ++p) { const float a = pr * invf[p]; cs[p] = cosf(a); sn[p] = sinf(a); }
#pragma unroll 1
        for (int bg = 0; bg < BATCH; bg += 4) {
        u32x4 rawv[4][2];
#pragma unroll
        for (int bq = 0; bq < 4; ++bq)
#pragma unroll
            for (int half = 0; half < 2; ++half) rawv[bq][half] = *(const u32x4*)(PROJ + (size_t)((bg + bq) * SEQ + pos) * 1536 + half * 512 + lane * 8);
        __builtin_amdgcn_sched_barrier(0);
#pragma unroll
        for (int bq = 0; bq < 4; ++bq) { const int tok = (bg + bq) * SEQ + pos;
#pragma unroll
        for (int half = 0; half < 2; ++half) {
            const int e0 = half * 512 + lane * 8; const int head = e0 >> 6; const bool isq = head < 12;
            const u32x4 raw = rawv[bq][half];
            float x[8]; x[0] = bflo(raw.x); x[1] = bfhi(raw.x); x[2] = bflo(raw.y); x[3] = bfhi(raw.y); x[4] = bflo(raw.z); x[5] = bfhi(raw.z); x[6] = bflo(raw.w); x[7] = bfhi(raw.w);
            float ss = 0.f;
#pragma unroll
            for (int e = 0; e < 8; ++e) ss += x[e] * x[e];
            ss = group8_sum(ss);
            const float inv = rsqrtf(ss * (1.0f / 64.0f) + 1e-6f);
            float y[8];
#pragma unroll
            for (int e = 0; e < 8; ++e) y[e] = x[e] * inv * (isq ? gq[e] : gk[e]);
            const float sc = isq ? C2 : 1.0f;
            float o[8];
#pragma unroll
            for (int p = 0; p < 4; ++p) { o[2 * p] = (y[2 * p] * cs[p] - y[2 * p + 1] * sn[p]) * sc; o[2 * p + 1] = (y[2 * p] * sn[p] + y[2 * p + 1] * cs[p]) * sc; }
            u32x4 w; w.x = pk2(o[0], o[1]); w.y = pk2(o[2], o[3]); w.z = pk2(o[4], o[5]); w.w = pk2(o[6], o[7]);
            *(u32x4*)(QKR + (size_t)tok * 1024 + e0) = w;
        } } }
    }
}

__device__ __forceinline__ void sconv_phase(const Ctx& cx, const bf16_t* PROJ, const float* cw, const float* cb, bf16_t* UT3, unsigned char* V8, const int tid) {
    const int lane = tid & 63, wave = __builtin_amdgcn_readfirstlane(tid >> 6);
    const int gw = cx.vcu * 8 + wave, NGW = cx.G * 8;
    LAS unsigned short* tile = (LAS unsigned short*)(cx.lds + wave * 9216);
    constexpr int PW = 2560;
    for (int it = gw; it < 16 * 64 * 36; it += NGW) {
        const int ct = it % 36, tt = (it / 36) & 63, b = it / (36 * 64);
        const int col = ct * 64 + lane, t0 = tt * 64;
        const float w0 = cw[col], w1 = cw[2304 + col], w2 = cw[4608 + col], bia = cb[col];
        const bf16_t* src = PROJ + ((size_t)b * 4096 + t0) * PW + col;
        unsigned short uu[66];
        uu[0] = (t0 > 0) ? src[-(long)PW] : (unsigned short)0;
#pragma unroll
        for (int k = 0; k < 64; ++k) uu[k + 1] = src[(size_t)k * PW];
        uu[65] = (t0 + 64 < 4096) ? src[(size_t)64 * PW] : (unsigned short)0;
#pragma unroll
        for (int k = 0; k < 64; ++k) { const float v = bf2f(uu[k]) * w0 + bf2f(uu[k + 1]) * w1 + bf2f(uu[k + 2]) * w2 + bia; tile[lane * 72 + k] = (unsigned short)f2bf(v); }
        LDS_WAIT(); asm volatile("" ::: "memory");
        const int part = (ct * 64) / 768, cbase = (ct * 64) % 768;
#pragma unroll
        for (int k = 0; k < 8; ++k) { const int row = k * 8 + (lane >> 3), chn = lane & 7;
            const u32x4 v = *(const LAS u32x4*)((const LAS unsigned char*)tile + row * 144 + chn * 16);
            *(u32x4*)(UT3 + (((size_t)part * 16 + b) * 768 + cbase + row) * 4096 + t0 + chn * 8) = v;
            if (TCONV_F8 && part == 0) { int w0 = 0, w1 = 0;
                w0 = __builtin_amdgcn_cvt_pk_fp8_f32(bflo(v.x), bfhi(v.x), w0, false); w0 = __builtin_amdgcn_cvt_pk_fp8_f32(bflo(v.y), bfhi(v.y), w0, true);
                w1 = __builtin_amdgcn_cvt_pk_fp8_f32(bflo(v.z), bfhi(v.z), w1, false); w1 = __builtin_amdgcn_cvt_pk_fp8_f32(bflo(v.w), bfhi(v.w), w1, true);
                *(u32x2*)(V8 + ((size_t)b * 768 + cbase + row) * 4096 + t0 + chn * 8) = (u32x2){(unsigned)w0, (unsigned)w1}; } }
        LDS_WAIT(); asm volatile("" ::: "memory");
    }
}

constexpr int TZ_CS = 16384 + 64;
__device__ __forceinline__ void tconv_phase(const Ctx& cx, const int o, const bf16_t* UT, const bf16_t* GT, bf16_t* ZT, const float* lbias  , const int tid) {
    const int lane = tid & 63, wid = __builtin_amdgcn_readfirstlane(tid >> 6), m16 = lane & 15, q4 = lane >> 4;
    const float* HRAWT = (const float*)(cx.ws + WS_HRAWT); const float* HPART = (const float*)(cx.ws + WS_HPART);
    LAS unsigned char* cp = cx.lds; LAS float* red = (LAS float*)(cx.lds + 8 * TZ_CS);
    for (int c = cx.vcu; c < 768; c += cx.G) {
        __syncthreads();
        { const int dir = tid >> 8, blk = tid & 255; float v = HPART[(size_t)blk * 3072 + dir * 1536 + o * 768 + c]; v = wave_sum(v, lane); if (lane == 0) red[wid] = v; }
        __syncthreads();
        float nrm = 0.f;
#pragma unroll
        for (int w = 0; w < 8; ++w) nrm += red[w];
        const float inv = 1.0f / nrm;
        const float* hf = HRAWT + (size_t)(o * 768 + c) * 4096; const float* hb = HRAWT + (size_t)(1536 + o * 768 + c) * 4096;
        for (int i = tid; i < 8192; i += 512) { float v; if (i < 4096) v = hf[4095 - i]; else if (i < 8191) v = hb[i - 4095]; else v = 0.f;
            *(LAS unsigned short*)(cp + 2 * i) = (unsigned short)f2bf(v * inv); }
        __syncthreads();
#pragma unroll
        for (int j = 1; j < 8; ++j)
            for (int n = tid; n < 1024; n += 512) {
                const u32x4 lo = *(const LAS u32x4*)(cp + n * 16); u32x4 hi = (u32x4){0u, 0u, 0u, 0u}; if (n + 1 < 1024) hi = *(const LAS u32x4*)(cp + (n + 1) * 16);
                const unsigned w[8] = {lo.x, lo.y, lo.z, lo.w, hi.x, hi.y, hi.z, hi.w}; u32x4 r;
                const int a = j >> 1;
                if (j & 1) { r.x = (w[a] >> 16) | (w[a + 1] << 16); r.y = (w[a + 1] >> 16) | (w[a + 2] << 16); r.z = (w[a + 2] >> 16) | (w[a + 3] << 16); r.w = (w[a + 3] >> 16) | (w[a + 4] << 16); }
                else { r.x = w[a]; r.y = w[a + 1]; r.z = w[a + 2]; r.w = w[a + 3]; }
                *(LAS u32x4*)(cp + j * TZ_CS + n * 16) = r;
            }
        __syncthreads();
        const int j = (7 - m16) & 7;
        const int nbase = (4095 - 512 * wid - m16 - j + 8 * q4) >> 3;
        const LAS unsigned char* ap = cp + j * TZ_CS + (nbase - 62) * 16;
        const bf16_t* up = UT + ((size_t)m16 * 768 + c) * 4096 + 8 * q4;
        f32x4 acc[32];
#pragma unroll
        for (int ti = 0; ti < 32; ++ti) acc[ti] = (f32x4){0.f, 0.f, 0.f, 0.f};
        bf16x8 bcur = *(const bf16x8*)(up);
        bf16x8 afA[8], afB[8];
#pragma unroll
        for (int i = 0; i < 8; ++i) afA[i] = *(const LAS bf16x8*)(ap + (31 - i) * 32);
        for (int ks = 0; ks < 128; ++ks) {
            const bf16x8 bnext = *(const bf16x8*)(up + ((ks + 1) & 127) * 32);
            const LAS unsigned char* a0 = ap + ks * 64;
            const LAS unsigned char* a1 = ap + ((ks + 1) & 127) * 64;
#define TZ_LD(dst, base, g) do { _Pragma("unroll") for (int i = 0; i < 8; ++i) dst[i] = *(const LAS bf16x8*)((base) + (31 - (8 * (g) + i)) * 32); } while (0)
#define TZ_MM(src, g) do { _Pragma("unroll") for (int i = 0; i < 8; ++i) acc[8 * (g) + i] = __builtin_amdgcn_mfma_f32_16x16x32_bf16(src[i], bcur, acc[8 * (g) + i], 0, 0, 0); } while (0)
            TZ_LD(afB, a0, 1); TZ_MM(afA, 0); __builtin_amdgcn_sched_barrier(0);
            TZ_LD(afA, a0, 2); TZ_MM(afB, 1); __builtin_amdgcn_sched_barrier(0);
            TZ_LD(afB, a0, 3); TZ_MM(afA, 2); __builtin_amdgcn_sched_barrier(0);
            TZ_LD(afA, a1, 0); TZ_MM(afB, 3); __builtin_amdgcn_sched_barrier(0);
#undef TZ_LD
#undef TZ_MM
            bcur = bnext;
        }
        const float lb = lbias[c];
        const size_t rowoff = ((size_t)m16 * 768 + c) * 4096 + 512 * wid + 4 * q4;
#pragma unroll
        for (int ti = 0; ti < 32; ++ti) {
            const u32x2 uu = *(const u32x2*)(UT + rowoff + 16 * ti), gg = *(const u32x2*)(GT + rowoff + 16 * ti);
            const float y0 = (acc[ti][0] + lb * bflo(uu.x)) * bflo(gg.x), y1 = (acc[ti][1] + lb * bfhi(uu.x)) * bfhi(gg.x), y2 = (acc[ti][2] + lb * bflo(uu.y)) * bflo(gg.y), y3 = (acc[ti][3] + lb * bfhi(uu.y)) * bfhi(gg.y);
            u32x2 w; w.x = pk2(y0, y1); w.y = pk2(y2, y3);
            *(u32x2*)(ZT + rowoff + 16 * ti) = w;
            if ((ti & 7) == 7) __builtin_amdgcn_sched_barrier(0);
        }
    }
    __syncthreads();
}

constexpr int T8_CS = 8192 + 256;
__host__ __device__ constexpr int t8_sig(int j) { return j < 4 ? 2 * j : (j >= 12 ? 2 * (j - 8) : 2 * (j - 4) + 1); }
__device__ __forceinline__ float wave_max_nn(float v) {
    v = fmaxf(v, dpp_x<0xB1>(v)); v = fmaxf(v, dpp_x<0x4E>(v)); v = fmaxf(v, dpp_x<0x141>(v)); v = fmaxf(v, dpp_x<0x140>(v));
    v = fmaxf(v, __builtin_bit_cast(float, __builtin_amdgcn_update_dpp(0, __builtin_bit_cast(int, v), 0x142, 0xA, 0xF, false)));
    v = fmaxf(v, __builtin_bit_cast(float, __builtin_amdgcn_update_dpp(0, __builtin_bit_cast(int, v), 0x143, 0xC, 0xF, false)));
    return __builtin_bit_cast(float, __builtin_amdgcn_readlane(__builtin_bit_cast(int, v), 63));
}
__device__ __forceinline__ void tconv8_phase(const Ctx& cx, const int o, const bf16_t* UT, const unsigned char* U8, const bf16_t* GT, bf16_t* ZT, unsigned char* Z8  ,
                                             const float* lbias, const int tid) {
    const int lane = tid & 63, wid = __builtin_amdgcn_readfirstlane(tid >> 6), m16 = lane & 15, q4 = lane >> 4;
    const float* HRAWT = (const float*)(cx.ws + WS_HRAWT); const float* HPART = (const float*)(cx.ws + WS_HPART);
    LAS unsigned char* cp = cx.lds; LAS float* red = (LAS float*)(cx.lds + 16 * T8_CS);
    for (int c = cx.vcu; c < 768; c += cx.G) {
        __syncthreads();
        const float* hf = HRAWT + (size_t)(o * 768 + c) * 4096; const float* hb = HRAWT + (size_t)(1536 + o * 768 + c) * 4096;
        float tap[16]; float mx = 0.f;
        int t3 = tid; asm volatile("" : "+v"(t3));
#pragma unroll
        for (int k = 0; k < 16; ++k) { const int i = t3 * 16 + k; float v; if (i < 4096) v = hf[4095 - i]; else if (i < 8191) v = hb[i - 4095]; else v = 0.f; tap[k] = v; mx = fmaxf(mx, fabsf(v)); }
        { const int dir = tid >> 8, blk = tid & 255; float v = HPART[(size_t)blk * 3072 + dir * 1536 + o * 768 + c]; v = wave_sum(v, lane); mx = wave_max_nn(mx); if (lane == 0) { red[wid] = v; red[8 + wid] = mx; } }
        __syncthreads();
        float nrm = 0.f, mall = 0.f;
#pragma unroll
        for (int w = 0; w < 8; ++w) { nrm += red[w]; mall = fmaxf(mall, red[8 + w]); }
        const float inv = 1.0f / nrm;
        int ex; (void)frexpf(fmaxf(mall * inv, 1e-30f), &ex);
        const float fsc = ldexpf(1.0f, 7 - ex), unsc = ldexpf(1.0f, ex - 7), tsc = inv * fsc;
        { unsigned w[4];
#pragma unroll
          for (int q = 0; q < 4; ++q) { int r = 0; r = __builtin_amdgcn_cvt_pk_fp8_f32(tap[4 * q] * tsc, tap[4 * q + 1] * tsc, r, false); r = __builtin_amdgcn_cvt_pk_fp8_f32(tap[4 * q + 2] * tsc, tap[4 * q + 3] * tsc, r, true); w[q] = (unsigned)r; }
          *(LAS u32x4*)(cp + tid * 16) = (u32x4){w[0], w[1], w[2], w[3]}; }
        __syncthreads();
        { const u32x4 lo = *(const LAS u32x4*)(cp + tid * 16); u32x4 hi = (u32x4){0u, 0u, 0u, 0u}; if (tid + 1 < 512) hi = *(const LAS u32x4*)(cp + (tid + 1) * 16);
          const unsigned w[8] = {lo.x, lo.y, lo.z, lo.w, hi.x, hi.y, hi.z, hi.w};
#pragma unroll
          for (int j = 1; j < 16; ++j) { u32x4 r; const int a = j >> 2, sh = j & 3;
              r.x = sh ? __builtin_amdgcn_alignbyte(w[a + 1], w[a], sh) : w[a]; r.y = sh ? __builtin_amdgcn_alignbyte(w[a + 2], w[a + 1], sh) : w[a + 1];
              r.z = sh ? __builtin_amdgcn_alignbyte(w[a + 3], w[a + 2], sh) : w[a + 2]; r.w = sh ? __builtin_amdgcn_alignbyte(w[a + 4], w[a + 3], sh) : w[a + 3];
              *(LAS u32x4*)(cp + j * T8_CS + t8_sig(j) * 16 + tid * 16) = r; } }
        __syncthreads();
        const int jc = 15 - m16;
        const int nbase = 255 - 32 * wid + 2 * q4;
        const LAS unsigned char* ap = cp + jc * T8_CS + t8_sig(jc) * 16 + (nbase - 31) * 16;
        const unsigned char* up = U8 + ((size_t)m16 * 768 + c) * 4096 + 32 * q4;
        f32x4 acc[32];
#pragma unroll
        for (int ti = 0; ti < 32; ++ti) acc[ti] = (f32x4){0.f, 0.f, 0.f, 0.f};
        typedef int v8i_t __attribute__((ext_vector_type(8))); typedef int v4i_t __attribute__((ext_vector_type(4)));
#define T8_FRAG(p) __builtin_shufflevector(*(const LAS v4i_t*)(p), *(const LAS v4i_t*)((p) + 16), 0, 1, 2, 3, 4, 5, 6, 7)
        v8i_t bcur = __builtin_shufflevector(*(const v4i_t*)(up), *(const v4i_t*)(up + 16), 0, 1, 2, 3, 4, 5, 6, 7);
        v8i_t afA[4], afB[4];
#pragma unroll
        for (int i = 0; i < 4; ++i) afA[i] = T8_FRAG(ap + (31 - i) * 16);
        for (int ks = 0; ks < 32; ++ks) {
            const unsigned char* un = up + ((ks + 1) & 31) * 128;
            const v8i_t bnext = __builtin_shufflevector(*(const v4i_t*)(un), *(const v4i_t*)(un + 16), 0, 1, 2, 3, 4, 5, 6, 7);
            const LAS unsigned char* a0 = ap + ks * 128;
            const LAS unsigned char* a1 = ap + ((ks + 1) & 31) * 128;
#define T8_LD(dst, base, g) do { _Pragma("unroll") for (int i = 0; i < 4; ++i) dst[i] = T8_FRAG((base) + (31 - (4 * (g) + i)) * 16); } while (0)
#define T8_MM(src, g) do { _Pragma("unroll") for (int i = 0; i < 4; ++i) acc[4 * (g) + i] = __builtin_amdgcn_mfma_scale_f32_16x16x128_f8f6f4(src[i], bcur, acc[4 * (g) + i], 0, 0, 0, 0, 0, 0); } while (0)
            T8_LD(afB, a0, 1); T8_MM(afA, 0); __builtin_amdgcn_sched_barrier(0);
            T8_LD(afA, a0, 2); T8_MM(afB, 1); __builtin_amdgcn_sched_barrier(0);
            T8_LD(afB, a0, 3); T8_MM(afA, 2); __builtin_amdgcn_sched_barrier(0);
            T8_LD(afA, a0, 4); T8_MM(afB, 3); __builtin_amdgcn_sched_barrier(0);
            T8_LD(afB, a0, 5); T8_MM(afA, 4); __builtin_amdgcn_sched_barrier(0);
            T8_LD(afA, a0, 6); T8_MM(afB, 5); __builtin_amdgcn_sched_barrier(0);
            T8_LD(afB, a0, 7); T8_MM(afA, 6); __builtin_amdgcn_sched_barrier(0);
            T8_LD(afA, a1, 0); T8_MM(afB, 7); __builtin_amdgcn_sched_barrier(0);
#undef T8_LD
#undef T8_MM
            bcur = bnext;
        }
#undef T8_FRAG
        const float lb = lbias[c];
        const size_t rowoff = ((size_t)m16 * 768 + c) * 4096 + 512 * wid + 4 * q4;
#pragma unroll
        for (int tg = 0; tg < 32; tg += 8) {
            u32x2 uu8[8], gg8[8];
#pragma unroll
            for (int j = 0; j < 8; ++j) { uu8[j] = *(const u32x2*)(UT + rowoff + 16 * (tg + j)); gg8[j] = *(const u32x2*)(GT + rowoff + 16 * (tg + j)); }
#pragma unroll
            for (int j = 0; j < 8; ++j) { const int ti = tg + j; const u32x2 uu = uu8[j], gg = gg8[j];
                const float y0 = (acc[ti][0] * unsc + lb * bflo(uu.x)) * bflo(gg.x), y1 = (acc[ti][1] * unsc + lb * bfhi(uu.x)) * bfhi(gg.x), y2 = (acc[ti][2] * unsc + lb * bflo(uu.y)) * bflo(gg.y), y3 = (acc[ti][3] * unsc + lb * bfhi(uu.y)) * bfhi(gg.y);
                u32x2 w; w.x = pk2(y0, y1); w.y = pk2(y2, y3);
                *(u32x2*)(ZT + rowoff + 16 * ti) = w;
                if (Z8) { int w8 = 0; w8 = __builtin_amdgcn_cvt_pk_fp8_f32(fminf(fmaxf(y0, -440.f), 440.f), fminf(fmaxf(y1, -440.f), 440.f), w8, false); w8 = __builtin_amdgcn_cvt_pk_fp8_f32(fminf(fmaxf(y2, -440.f), 440.f), fminf(fmaxf(y3, -440.f), 440.f), w8, true);
                    *(int*)(Z8 + rowoff + 16 * ti) = w8; } }
            __builtin_amdgcn_sched_barrier(0);
        }
    }
    __syncthreads();
}

__device__ __forceinline__ void tback_phase(const Ctx& cx, const bf16_t* ZT, bf16_t* CAT, const int tid) {
    const int lane = tid & 63, wave = __builtin_amdgcn_readfirstlane(tid >> 6);
    const int gw = cx.vcu * 8 + wave, NGW = cx.G * 8;
    LAS unsigned char* tile = cx.lds + wave * 9216;
    for (int it = gw; it < 16 * 12 * 64; it += NGW) {
        const int tt = it & 63, ct = (it >> 6) % 12, b = it / (64 * 12);
        const int c0 = ct * 64, t0 = tt * 64;
        u32x4 vv[8];
#pragma unroll
        for (int k = 0; k < 8; ++k) { const int row = k * 8 + (lane >> 3), chn = lane & 7; vv[k] = *(const u32x4*)(ZT + ((size_t)b * 768 + c0 + row) * 4096 + t0 + chn * 8); }
        __builtin_amdgcn_sched_barrier(0);
#pragma unroll
        for (int k = 0; k < 8; ++k) { const int row = k * 8 + (lane >> 3), chn = lane & 7; *(LAS u32x4*)(tile + row * 144 + chn * 16) = vv[k]; }
        LDS_WAIT(); asm volatile("" ::: "memory");
        if constexpr (OUTP_F8) { unsigned char* dst = (unsigned char*)CAT + ((size_t)b * 4096 + t0) * 1024 + c0 + lane;
#pragma unroll 8
            for (int k = 0; k < 64; ++k) { const float v = bf2f(*(const LAS unsigned short*)(tile + lane * 144 + k * 2)); dst[(size_t)k * 1024] = f2fp8(fminf(fmaxf(v, -440.0f), 440.0f)); }
        } else { bf16_t* dst = CAT + ((size_t)b * 4096 + t0) * 1024 + c0 + lane;
#pragma unroll 8
            for (int k = 0; k < 64; ++k) dst[(size_t)k * 1024] = *(const LAS unsigned short*)(tile + lane * 144 + k * 2); }
        LDS_WAIT(); asm volatile("" ::: "memory");
    }
}

__device__ __forceinline__ void ln1_group(const int bt, const int chunk, const int wave, const int lane, const int r16, const int q4, const bf16_t* XI, bf16_t* XO, bf16_t* XB, const float* g, const float* bta,
                                          const LAS unsigned char* Wh, const LAS unsigned char* Wl, LAS float* lg, LAS int* lcnt, const float rb0, const float rb1, float* gate, unsigned (&pk)[2], unsigned (&gp)[2], const LAS float* gl) {
    constexpr int WP = 2064;
            const size_t rowU = (size_t)chunk * 256 + wave * 32 + bt * 16;
            unsigned loff = (unsigned)(r16 * 1024 + 8 * q4); asm volatile("" : "+v"(loff));
            const GAS bf16_t* src = (const GAS bf16_t*)XI + rowU * 1024 + loff;
            constexpr int HOLD = LN1_HOLD;
            u32x4 raw[HOLD > 0 ? HOLD : 1], rawt[32 - HOLD]; float s = 0.f, ss = 0.f;
#pragma unroll
            for (int i = 0; i < 32; ++i) { if (i < HOLD) raw[i] = *(const GAS u32x4*)(src + 32 * i); else rawt[i - HOLD] = *(const GAS u32x4*)(src + 32 * i); }
#pragma unroll
            for (int i = 0; i < 32; ++i) { const u32x4 rr = (i < HOLD) ? raw[i < HOLD ? i : 0] : rawt[i < HOLD ? 0 : i - HOLD]; const float x0 = bflo(rr.x), x1 = bfhi(rr.x), x2 = bflo(rr.y), x3 = bfhi(rr.y), x4 = bflo(rr.z), x5 = bfhi(rr.z), x6 = bflo(rr.w), x7 = bfhi(rr.w);
                s += ((x0 + x1) + (x2 + x3)) + ((x4 + x5) + (x6 + x7)); ss += ((x0 * x0 + x1 * x1) + (x2 * x2 + x3 * x3)) + ((x4 * x4 + x5 * x5) + (x6 * x6 + x7 * x7)); }
            lg[2 * lane] = s; lg[2 * lane + 1] = ss; LDS_WAIT(); asm volatile("" ::: "memory");
            s = (lg[2 * r16] + lg[2 * (r16 + 16)]) + (lg[2 * (r16 + 32)] + lg[2 * (r16 + 48)]); ss = (lg[2 * r16 + 1] + lg[2 * (r16 + 16) + 1]) + (lg[2 * (r16 + 32) + 1] + lg[2 * (r16 + 48) + 1]);
            LDS_WAIT(); asm volatile("" ::: "memory");
            const float mean = s * (1.0f / 1024.0f), rstd = rsqrtf(fmaxf(ss * (1.0f / 1024.0f) - mean * mean, 0.f) + LN_EPS);
            f32x4 a0 = (f32x4){0.f, 0.f, 0.f, 0.f}, a1 = (f32x4){0.f, 0.f, 0.f, 0.f};
            const LAS unsigned char* wh0 = Wh + r16 * WP + 16 * q4; const LAS unsigned char* wl0 = Wl + r16 * WP + 16 * q4;
            GAS bf16_t* dsto = (GAS bf16_t*)XO + ((X1_RECOMP && Y_F8) ? (size_t)(wave * 32 + bt * 16) : rowU) * 1024 + loff; GAS unsigned char* dst8 = (GAS unsigned char*)XB + rowU * 1024 + loff;
            const LAS float* glq = gl + 8 * q4;
            u32x4 nx_ = (u32x4){0u, 0u, 0u, 0u}; if (HOLD == 0) nx_ = *(const GAS u32x4*)(src);
#pragma unroll
            for (int i = 0; i < 32; ++i) {
                u32x4 rw_; if (i < HOLD) rw_ = raw[i < HOLD ? i : 0]; else rw_ = nx_;
                if (i + 1 < 32 && i + 1 >= HOLD) nx_ = *(const GAS u32x4*)(src + 32 * (i + 1));
                asm volatile("" : "+v"(rw_));
                const f32x4 g0 = *(const LAS f32x4*)(glq + 32 * i), g1 = *(const LAS f32x4*)(glq + 32 * i + 4), b0 = *(const LAS f32x4*)(glq + 1024 + 32 * i), b1 = *(const LAS f32x4*)(glq + 1024 + 32 * i + 4);
                float y[8]; y[0] = bflo(rw_.x); y[1] = bfhi(rw_.x); y[2] = bflo(rw_.y); y[3] = bfhi(rw_.y); y[4] = bflo(rw_.z); y[5] = bfhi(rw_.z); y[6] = bflo(rw_.w); y[7] = bfhi(rw_.w);
#pragma unroll
                for (int q = 0; q < 8; ++q) y[q] = (y[q] - mean) * rstd * (q < 4 ? g0[q & 3] : g1[q & 3]) + (q < 4 ? b0[q & 3] : b1[q & 3]);
                u32x4 hi; hi.x = pk2(y[0], y[1]); hi.y = pk2(y[2], y[3]); hi.z = pk2(y[4], y[5]); hi.w = pk2(y[6], y[7]);
                *(GAS u32x4*)(dsto + 32 * i) = hi;
                if constexpr (MOE_F8) { int w0 = 0, w1 = 0; w0 = __builtin_amdgcn_cvt_pk_fp8_f32(y[0], y[1], w0, false); w0 = __builtin_amdgcn_cvt_pk_fp8_f32(y[2], y[3], w0, true); w1 = __builtin_amdgcn_cvt_pk_fp8_f32(y[4], y[5], w1, false); w1 = __builtin_amdgcn_cvt_pk_fp8_f32(y[6], y[7], w1, true);
                    *(GAS u32x2*)(dst8 + 32 * i) = (u32x2){(unsigned)w0, (unsigned)w1}; }
                else { *(u32x4*)((bf16_t*)XB + rowU * 1024 + loff + 32 * i) = hi; }
                u32x4 lo; lo.x = pk2(y[0] - bflo(hi.x), y[1] - bfhi(hi.x)); lo.y = pk2(y[2] - bflo(hi.y), y[3] - bfhi(hi.y)); lo.z = pk2(y[4] - bflo(hi.z), y[5] - bfhi(hi.z)); lo.w = pk2(y[6] - bflo(hi.w), y[7] - bfhi(hi.w));
                const bf16x8 ah = __builtin_bit_cast(bf16x8, hi), al = __builtin_bit_cast(bf16x8, lo);
                const bf16x8 wh_0 = *(const LAS bf16x8*)(wh0 + 64 * i), wh_1 = *(const LAS bf16x8*)(wh0 + 16 * WP + 64 * i), wl_0 = *(const LAS bf16x8*)(wl0 + 64 * i), wl_1 = *(const LAS bf16x8*)(wl0 + 16 * WP + 64 * i);
                a0 = __builtin_amdgcn_mfma_f32_16x16x32_bf16(ah, wh_0, a0, 0, 0, 0); a1 = __builtin_amdgcn_mfma_f32_16x16x32_bf16(ah, wh_1, a1, 0, 0, 0);
                a0 = __builtin_amdgcn_mfma_f32_16x16x32_bf16(al, wh_0, a0, 0, 0, 0); a1 = __builtin_amdgcn_mfma_f32_16x16x32_bf16(al, wh_1, a1, 0, 0, 0);
                a0 = __builtin_amdgcn_mfma_f32_16x16x32_bf16(ah, wl_0, a0, 0, 0, 0); a1 = __builtin_amdgcn_mfma_f32_16x16x32_bf16(ah, wl_1, a1, 0, 0, 0);
                asm volatile("" :: "v"(ah), "v"(al), "v"(wh_0), "v"(wh_1), "v"(wl_0), "v"(wl_1));
                __builtin_amdgcn_sched_barrier(0);
            }
#pragma unroll
            for (int v = 0; v < 4; ++v) { lg[(4 * q4 + v) * 33 + r16] = a0[v] + rb0; lg[(4 * q4 + v) * 33 + r16 + 16] = a1[v] + rb1; }
            LDS_WAIT(); asm volatile("" ::: "memory");
            if (lane < 16) {
                const LAS float* myl = lg + lane * 33; const size_t rowt = (size_t)chunk * 256 + wave * 32 + bt * 16 + lane;
                float tv[4]; int te[4]; int t0 = -1, t1 = -1, t2 = -1;
#pragma unroll
                for (int k = 0; k < 4; ++k) { float best = -INFINITY; int bi = 0;
                    for (int e = 0; e < 32; ++e) { const float v = myl[e]; const bool ok = (e != t0) && (e != t1) && (e != t2); if (ok && v > best) { best = v; bi = e; } }
                    tv[k] = best; te[k] = bi; if (k == 0) t0 = bi; else if (k == 1) t1 = bi; else if (k == 2) t2 = bi; }
                const float e1 = __expf(tv[1] - tv[0]), e2 = __expf(tv[2] - tv[0]), e3 = __expf(tv[3] - tv[0]); const float isum = 1.0f / (1.0f + e1 + e2 + e3);
                const float gk[4] = {isum, e1 * isum, e2 * isum, e3 * isum};
                pk[0] = 0u; pk[1] = 0u;
#pragma unroll
                for (int k = 0; k < 4; ++k) { const int rk = __hip_atomic_fetch_add(lcnt + te[k], 1, __ATOMIC_RELAXED, __HIP_MEMORY_SCOPE_WORKGROUP); pk[k >> 1] |= (unsigned)((te[k] << 11) | rk) << (16 * (k & 1)); }
                gp[0] = pk2(gk[0], gk[1]); gp[1] = pk2(gk[2], gk[3]); (void)rowt; (void)gate;
            }
            LDS_WAIT(); asm volatile("" ::: "memory");
}
__device__ __forceinline__ void ln1_router_phase(const Ctx& cx, const bf16_t* XI, bf16_t* XO, bf16_t* XB, const float* g, const float* bta, const float* rw, const float* rb,
                                                 unsigned* cnt, int* expid, float* gate, int* idx, float* gidx, const int tid) {
    const int lane = tid & 63, wave = __builtin_amdgcn_readfirstlane(tid >> 6), r16 = lane & 15, q4 = lane >> 4;
    constexpr int WP = 2064;
    LAS unsigned char* Wh = cx.lds; LAS unsigned char* Wl = cx.lds + 32 * WP; LAS int* lcnt = (LAS int*)(cx.lds + 64 * WP); LAS int* lbase = lcnt + 32; LAS float* lg = (LAS float*)(cx.lds + 64 * WP + 256 + wave * 2112);
    __syncthreads();
    { const u32x4* rsrc = (const u32x4*)rw; u32x4 wv[16];
#pragma unroll
      for (int u = 0; u < 16; ++u) wv[u] = rsrc[tid + 512 * u];
#pragma unroll
      for (int u = 0; u < 16; ++u) { const int idx = tid + 512 * u; *(LAS u32x4*)(Wh + (idx >> 7) * WP + (idx & 127) * 16) = wv[u]; } }
    if (tid < 256) { LAS float* gf = (LAS float*)(cx.lds + 151552); *(LAS f32x4*)(gf + 4 * tid) = *(const f32x4*)(g + 4 * tid); *(LAS f32x4*)(gf + 1024 + 4 * tid) = *(const f32x4*)(bta + 4 * tid); }
    if (tid < 32) lcnt[tid] = 0;
    LAS float* gl = (LAS float*)(cx.lds + 151552);
    const float rb0 = rb[r16], rb1 = rb[r16 + 16];
    __syncthreads();
    for (int chunk = cx.vcu; chunk < NTOK / 256; chunk += cx.G) {
        unsigned pk0[2] = {0u, 0u}, pk1[2] = {0u, 0u}, gp0[2] = {0u, 0u}, gp1[2] = {0u, 0u};
        ln1_group(0, chunk, wave, lane, r16, q4, XI, XO, XB, g, bta, Wh, Wl, lg, lcnt, rb0, rb1, gate, pk0, gp0, gl);
        ln1_group(1, chunk, wave, lane, r16, q4, XI, XO, XB, g, bta, Wh, Wl, lg, lcnt, rb0, rb1, gate, pk1, gp1, gl);
        __syncthreads();
        { const int t2 = wave * 64 + lane_id_volatile();
          if (t2 < 32) { lbase[t2] = (int)__hip_atomic_fetch_add(cnt + t2, (unsigned)lcnt[t2], __ATOMIC_RELAXED, __HIP_MEMORY_SCOPE_AGENT); } }
        __syncthreads();
        const int ln_ = lane_id_volatile();
        if (ln_ < 16) {
            { const int slot0 = (chunk * 256 + wave * 32 + ln_) * 4;
#pragma unroll
                for (int k = 0; k < 4; ++k) { const unsigned p = (pk0[k >> 1] >> (16 * (k & 1))) & 0xffffu; const int e = (int)(p >> 11), rk = (int)(p & 0x7ffu); const size_t o_ = (size_t)e * IDXCAP + lbase[e] + rk; idx[o_] = slot0 + k; gidx[o_] = (k & 1) ? bfhi(gp0[k >> 1]) : bflo(gp0[k >> 1]); } }
            { const int slot0 = (chunk * 256 + wave * 32 + 16 + ln_) * 4;
#pragma unroll
                for (int k = 0; k < 4; ++k) { const unsigned p = (pk1[k >> 1] >> (16 * (k & 1))) & 0xffffu; const int e = (int)(p >> 11), rk = (int)(p & 0x7ffu); const size_t o_ = (size_t)e * IDXCAP + lbase[e] + rk; idx[o_] = slot0 + k; gidx[o_] = (k & 1) ? bfhi(gp1[k >> 1]) : bflo(gp1[k >> 1]); } }
        }
        __syncthreads();
        { const int t3 = wave * 64 + lane_id_volatile(); if (t3 < 32) lcnt[t3] = 0; }
        __syncthreads();
    }
}

__device__ __forceinline__ void ln2_phase(const Ctx& cx, const bf16_t* X1, const bf16_t* Y, bf16_t* XO, bf16_t* XB, float* OUT, const float* g, const float* bta, const float* g1, const float* b1, const int tid) {
    const int lane = tid & 63, wave = __builtin_amdgcn_readfirstlane(tid >> 6);
    const int gw = cx.vcu * 8 + wave, NGW = cx.G * 8;
    if constexpr (Y_F8) {
        f32x4 gv[4], bv[4];
#pragma unroll
        for (int j = 0; j < 4; ++j) { gv[j] = *(const f32x4*)(g + 16 * lane + 4 * j); bv[j] = *(const f32x4*)(bta + 16 * lane + 4 * j); }
        f32x4 g1v[4], b1v[4];
        if (X1_RECOMP) {
#pragma unroll
            for (int j = 0; j < 4; ++j) { g1v[j] = *(const f32x4*)(g1 + 16 * lane + 4 * j); b1v[j] = *(const f32x4*)(b1 + 16 * lane + 4 * j); } }
        for (int rp = gw; rp < NTOK / 2; rp += NGW) {
            u32x4 xa[2][2], ya[2][4];
#pragma unroll
            for (int r = 0; r < 2; ++r) { const size_t row = (size_t)rp * 2 + r;
                xa[r][0] = *(const u32x4*)(X1 + row * 1024 + 16 * lane); xa[r][1] = *(const u32x4*)(X1 + row * 1024 + 16 * lane + 8);
#pragma unroll
                for (int k = 0; k < 4; ++k) ya[r][k] = *(const u32x4*)((const unsigned char*)Y + (row * 4 + k) * 1024 + 16 * lane); }
            float v[2][16]; float s[2] = {0.f, 0.f};
            float m1[2] = {0.f, 0.f}, r1[2] = {1.f, 1.f};
            if (X1_RECOMP) {
                float s1[2] = {0.f, 0.f}, q1[2] = {0.f, 0.f};
#pragma unroll
                for (int r = 0; r < 2; ++r)
#pragma unroll
                    for (int d = 0; d < 8; ++d) { const unsigned w = xa[r][d >> 2][d & 3]; const float t0 = bflo(w), t1 = bfhi(w); s1[r] += t0 + t1; q1[r] += t0 * t0 + t1 * t1; }
#pragma unroll
                for (int r = 0; r < 2; ++r) { m1[r] = wave_sum(s1[r], lane) * (1.0f / 1024.0f); r1[r] = rsqrtf(fmaxf(wave_sum(q1[r], lane) * (1.0f / 1024.0f) - m1[r] * m1[r], 0.f) + LN_EPS); } }
#pragma unroll
            for (int r = 0; r < 2; ++r) {
#pragma unroll
                for (int i = 0; i < 4; ++i) { f32x2 lo = __builtin_amdgcn_cvt_pk_f32_fp8((int)ya[r][0][i], false), hi = __builtin_amdgcn_cvt_pk_f32_fp8((int)ya[r][0][i], true);
#pragma unroll
                    for (int k = 1; k < 4; ++k) { lo += __builtin_amdgcn_cvt_pk_f32_fp8((int)ya[r][k][i], false); hi += __builtin_amdgcn_cvt_pk_f32_fp8((int)ya[r][k][i], true); }
                    const unsigned xlo = xa[r][i >> 1][(i & 1) * 2], xhi = xa[r][i >> 1][(i & 1) * 2 + 1];
                    f32x4 x1v = (f32x4){bflo(xlo), bfhi(xlo), bflo(xhi), bfhi(xhi)};
                    if (X1_RECOMP) x1v = (x1v - m1[r]) * r1[r] * g1v[i] + b1v[i];
                    v[r][4 * i + 0] = x1v[0] * DN_ALPHA + lo[0] * (1.0f / Y_SCALE); v[r][4 * i + 1] = x1v[1] * DN_ALPHA + lo[1] * (1.0f / Y_SCALE);
                    v[r][4 * i + 2] = x1v[2] * DN_ALPHA + hi[0] * (1.0f / Y_SCALE); v[r][4 * i + 3] = x1v[3] * DN_ALPHA + hi[1] * (1.0f / Y_SCALE);
                    s[r] += (v[r][4 * i] + v[r][4 * i + 1]) + (v[r][4 * i + 2] + v[r][4 * i + 3]); } }
            const float mean0 = wave_sum(s[0], lane) * (1.0f / 1024.0f), mean1 = wave_sum(s[1], lane) * (1.0f / 1024.0f); float q[2] = {0.f, 0.f};
#pragma unroll
            for (int r = 0; r < 2; ++r)
#pragma unroll
                for (int e = 0; e < 16; ++e) { v[r][e] -= (r == 0 ? mean0 : mean1); q[r] += v[r][e] * v[r][e]; }
            const float rstd0 = rsqrtf(wave_sum(q[0], lane) * (1.0f / 1024.0f) + LN_EPS), rstd1 = rsqrtf(wave_sum(q[1], lane) * (1.0f / 1024.0f) + LN_EPS);
            unsigned wb[2][8]; unsigned w8[2][4];
#pragma unroll
            for (int j = 0; j < 4; ++j) { const f32x4 gvj = gv[j], bvj = bv[j];
#pragma unroll
                for (int r = 0; r < 2; ++r) { const size_t row = (size_t)rp * 2 + r; const float rs = (r == 0 ? rstd0 : rstd1);
                    const f32x4 o = (f32x4){v[r][4 * j], v[r][4 * j + 1], v[r][4 * j + 2], v[r][4 * j + 3]} * rs * gvj + bvj;
                    if (OUT) *(f32x4*)(OUT + row * 1024 + 16 * lane + 4 * j) = o;
                    else { wb[r][2 * j] = pk2(o[0], o[1]); wb[r][2 * j + 1] = pk2(o[2], o[3]);
                        int t8 = 0; t8 = __builtin_amdgcn_cvt_pk_fp8_f32(o[0], o[1], t8, false); t8 = __builtin_amdgcn_cvt_pk_fp8_f32(o[2], o[3], t8, true); w8[r][j] = (unsigned)t8; } } }
            if (!OUT) {
#pragma unroll
                for (int r = 0; r < 2; ++r) { const size_t row = (size_t)rp * 2 + r;
                    *(u32x4*)(XO + row * 1024 + 16 * lane) = (u32x4){wb[r][0], wb[r][1], wb[r][2], wb[r][3]}; *(u32x4*)(XO + row * 1024 + 16 * lane + 8) = (u32x4){wb[r][4], wb[r][5], wb[r][6], wb[r][7]};
                    if constexpr (INP_F8) *(u32x4*)((unsigned char*)XB + row * 1024 + 16 * lane) = (u32x4){w8[r][0], w8[r][1], w8[r][2], w8[r][3]};
                    else { *(u32x4*)(XB + row * 1024 + 16 * lane) = (u32x4){wb[r][0], wb[r][1], wb[r][2], wb[r][3]}; *(u32x4*)(XB + row * 1024 + 16 * lane + 8) = (u32x4){wb[r][4], wb[r][5], wb[r][6], wb[r][7]}; } } }
        }
        return;
    }
    for (int rp = gw; rp < NTOK / 2; rp += NGW) {
        f32x4 v[2][4]; float s[2] = {0.f, 0.f};
#pragma unroll
        for (int r = 0; r < 2; ++r) { const size_t row = (size_t)rp * 2 + r;
#pragma unroll
            for (int j = 0; j < 4; ++j) { const u32x2 a = *(const u32x2*)(X1 + row * 1024 + 4 * lane + 256 * j); v[r][j] = (f32x4){bflo(a.x), bfhi(a.x), bflo(a.y), bfhi(a.y)} * DN_ALPHA;
#pragma unroll
                for (int k = 0; k < 4; ++k) {
                    if constexpr (Y_F8) { const int y8 = *(const int*)((const unsigned char*)Y + (row * 4 + k) * 1024 + 4 * lane + 256 * j); const f32x2 lo = __builtin_amdgcn_cvt_pk_f32_fp8(y8, false), hi = __builtin_amdgcn_cvt_pk_f32_fp8(y8, true);
                        v[r][j][0] += lo[0] * (1.0f / Y_SCALE); v[r][j][1] += lo[1] * (1.0f / Y_SCALE); v[r][j][2] += hi[0] * (1.0f / Y_SCALE); v[r][j][3] += hi[1] * (1.0f / Y_SCALE); }
                    else { const u32x2 y = *(const u32x2*)(Y + (row * 4 + k) * 1024 + 4 * lane + 256 * j); v[r][j][0] += bflo(y.x); v[r][j][1] += bfhi(y.x); v[r][j][2] += bflo(y.y); v[r][j][3] += bfhi(y.y); } }
                s[r] += (v[r][j][0] + v[r][j][1]) + (v[r][j][2] + v[r][j][3]); } }
        const float mean0 = wave_sum(s[0], lane) * (1.0f / 1024.0f), mean1 = wave_sum(s[1], lane) * (1.0f / 1024.0f); float q[2] = {0.f, 0.f};
#pragma unroll
        for (int r = 0; r < 2; ++r)
#pragma unroll
            for (int j = 0; j < 4; ++j) { v[r][j] = v[r][j] - (r == 0 ? mean0 : mean1); q[r] += (v[r][j][0] * v[r][j][0] + v[r][j][1] * v[r][j][1]) + (v[r][j][2] * v[r][j][2] + v[r][j][3] * v[r][j][3]); }
        const float rstd0 = rsqrtf(wave_sum(q[0], lane) * (1.0f / 1024.0f) + LN_EPS), rstd1 = rsqrtf(wave_sum(q[1], lane) * (1.0f / 1024.0f) + LN_EPS);
#pragma unroll
        for (int j = 0; j < 4; ++j) { const f32x4 gvj = *(const f32x4*)(g + 4 * lane + 256 * j), bvj = *(const f32x4*)(bta + 4 * lane + 256 * j);
#pragma unroll
            for (int r = 0; r < 2; ++r) { const size_t row = (size_t)rp * 2 + r; const f32x4 o = v[r][j] * (r == 0 ? rstd0 : rstd1) * gvj + bvj;
                if (OUT) *(f32x4*)(OUT + row * 1024 + 4 * lane + 256 * j) = o;
                else { u32x2 w; w.x = pk2(o[0], o[1]); w.y = pk2(o[2], o[3]); *(u32x2*)(XO + row * 1024 + 4 * lane + 256 * j) = w;
                    if constexpr (INP_F8) { int w8 = 0; w8 = __builtin_amdgcn_cvt_pk_fp8_f32(o[0], o[1], w8, false); w8 = __builtin_amdgcn_cvt_pk_fp8_f32(o[2], o[3], w8, true); *(int*)((unsigned char*)XB + row * 1024 + 4 * lane + 256 * j) = w8; }
                    else { *(u32x2*)(XB + row * 1024 + 4 * lane + 256 * j) = w; } } } }
    }
}

constexpr int PH_PER_LAYER = 10, N_PHASES = 2 + PH_PER_LAYER * DEPTH;
__host__ __device__ constexpr bool phase_active(int p) {
    if (p < 2) return true;
    const int l = (p - 2) / PH_PER_LAYER, k = (p - 2) % PH_PER_LAYER, kind = l % 3;
    if (k == 1) return kind != 0;
    if (k == 3 || k == 4) return kind == 2;
    return true;
}

__global__ void __launch_bounds__(512, 2) fwd(Args args) {
    extern __shared__ __attribute__((aligned(16))) unsigned char lds_raw[];
    const int wave0 = __builtin_amdgcn_readfirstlane((int)threadIdx.x >> 6);
    Ctx cx; cx.lds = (LAS unsigned char*)lds_raw; cx.G = gridDim.x; { const int bx = blockIdx.x; cx.vcu = (cx.G % 8 == 0) ? (bx % 8) * (cx.G / 8) + bx / 8 : bx; } cx.ws = args.ws;
    volatile LAS unsigned* MISC = (volatile LAS unsigned*)(cx.lds + MISC_OFF);
    for (int u = threadIdx.x; u < (LDS_BYTES - MISC_OFF) / 4; u += 512) MISC[u] = 0u;
    __syncthreads();
    if (threadIdx.x == 0) { LAS unsigned long long* t = (LAS unsigned long long*)(cx.lds + PTAB_OFF);
#pragma unroll
        for (int k = 0; k < 32; ++k) t[k] = (unsigned long long)args.in[k];
        t[32] = (unsigned long long)args.out; t[33] = (unsigned long long)args.ws; }
    __syncthreads();
    const int lo = args.ph_lo, hi = args.ph_hi;
    XcdBarrier bar; bar.bar = (unsigned*)((gu32*)(args.ws + WS_CTL) + CW_BAR); bar.x = 0; bar.st = nullptr;
    if (hi - lo > 1) bar = xcd_barrier_post((unsigned*)((gu32*)(args.ws + WS_CTL) + CW_BAR), MISC + 8);
    int ran = 0, nobar = 0;
#define XB ((bf16_t*)(ws + WS_XB))
#define PROJ ((bf16_t*)(ws + WS_PROJ))
#define CAT ((bf16_t*)(ws + WS_CAT))
#define KVM ((bf16_t*)(ws + WS_KVM))
#define HB ((bf16_t*)(ws + WS_H))
#define YB ((bf16_t*)(ws + WS_Y))
#define QKR ((bf16_t*)(ws + WS_QKR))
#define EXPID ((int*)(ws + WS_EXPID))
#define GATE ((float*)(ws + WS_GATE))
#define IDX ((int*)(ws + WS_IDX))
#define XF ((float*)(GAS float*)ptab_get(cx, 32))
#define SB ((bf16_t*)(ws + WS_SB))
#define SB2 ((bf16_t*)(ws + WS_PROJ))
#define TP_BAR_BEGIN() do {} while (0)
#define TP_BAR_END() do {} while (0)
#define TP_PH_BEGIN(p) do {} while (0)
#define TP_PH_END(p) do {} while (0)
#define PH_BEGIN(p) if (lo <= (p) && (p) < hi) { const int ph_ = (p); if (ran && !nobar) { TP_BAR_BEGIN(); for (int rb_ = 0; rb_ < REP_BAR; ++rb_) xcd_barrier(bar, wave0); TP_BAR_END(); } ran = 1; nobar = 0; const int tid = opaque_tid(wave0); (void)tid; unsigned char* const ws = (unsigned char*)(GAS unsigned char*)ptab_get(cx, 33); cx.ws = ws; TP_PH_BEGIN(ph_);
#define PH_END TP_PH_END(ph_); }

#if EN_P0
    PH_BEGIN(0) for (int rep_ = 0; rep_ < REP_P0; ++rep_) { p0_prologue(cx, tid); } PH_END
#endif

    for (int l = -1; l < DEPTH; ++l) {
        const int kind = (l < 0) ? 0 : l % 3, jj = (l < 0) ? 0 : l / 3, pw = (l < 0) ? 2048 : ((l % 3) == 1 ? 1536 : 2560), base = 2 + PH_PER_LAYER * l;
        nobar = (l == 0 && hi - lo > 1) ? 1 : 0;
        PH_BEGIN(l < 0 ? 1 : base) {
            pg8::DenseOrder S;
            if (l < 0) S.init(ws + WS_MEMB, ws + WS_WKV, NMEM, 2048, 1024 * INP_EB, cx.G, (int)blockIdx.x);
            else S.init(XB, ws + WS_WIN + (size_t)l * 5 * MiB, NTOK, pw, 1024 * INP_EB, cx.G, (int)blockIdx.x);
            S.rep = REP_DENSE;
            const unsigned smask = (l < 0) ? 0u : (kind == 0 ? 0x207u : kind == 1 ? 0x20u : 0x200u);
            pg8::EpiBf16s E{l < 0 ? KVM : PROJ, pw, smask, C2, INP_F8 ? 1.0f / WIN_SCALE : 1.0f};
#if EN_G1
            pg8::gemm_phase<pg8::EpiBf16s, pg8::DenseOrder, false, INP_F8 != 0>(cx.lds, S, E, tid);
#endif
        } PH_END
        if (l < 0) continue;
#if EN_THIN
        if (kind == 1) { PH_BEGIN(base + 1) for (int rep_ = 0; rep_ < REP_THIN; ++rep_) { rope_phase(cx, PROJ, INP(5) + jj * 64, INP(6) + jj * 64, QKR, tid); } PH_END }
        if (kind == 2) { PH_BEGIN(base + 1) for (int rep_ = 0; rep_ < REP_THIN; ++rep_) { sconv_phase(cx, PROJ, INP(8) + (size_t)jj * 3 * 2304, INP(9) + (size_t)jj * 2304, (bf16_t*)(ws + WS_UT3), ws + WS_V8, tid); } PH_END }
#endif
        for (int o = 0; o < 2; ++o) {
            if (o == 1 && kind != 2) break;
            PH_BEGIN(base + 2 + o) {
                if (kind == 2) {
                    const bf16_t* UT3 = (const bf16_t*)(ws + WS_UT3); constexpr size_t PS = (size_t)16 * 768 * 4096;
#if EN_TCONV
                    for (int rep_ = 0; rep_ < REP_TCONV; ++rep_) {
#if TCONV_F8
                    tconv8_phase(cx, o, o == 0 ? UT3 : (const bf16_t*)(ws + WS_Z1T), ws + WS_V8 + (size_t)o * 48 * MiB, UT3 + (size_t)(1 + o) * PS, (bf16_t*)(ws + (o == 0 ? WS_Z1T : WS_Z2T)), o == 0 ? ws + WS_V8 + 48 * MiB : (unsigned char*)nullptr, INP(19) + (size_t)(jj * 2 + o) * 768, tid);
#else
                    tconv_phase(cx, o, o == 0 ? UT3 : (const bf16_t*)(ws + WS_Z1T), UT3 + (size_t)(1 + o) * PS, (bf16_t*)(ws + (o == 0 ? WS_Z1T : WS_Z2T)), INP(19) + (size_t)(jj * 2 + o) * 768, tid);
#endif
                    }
#endif
                }
                if (o == 0) {
#if EN_NA
                    for (int rep_ = 0; rep_ < REP_NA; ++rep_) { if (kind == 0) na_phase(cx, PROJ, INP(3) + (size_t)jj * 12 * 465, CAT, tid); }
#endif
                    const int ngqa = (kind == 1) ? 3072 : 0;
                    for (int rep_ = 0; rep_ < REP_ATTN; ++rep_)
                    for (int u = cx.vcu; u < ngqa + 1024; u += cx.G) {
                        const attn_body::bf16 *Q, *K, *V; attn_body::bf16* O; int QP, KP, VP, NT;
                        if (u < ngqa) { const int qb = u & 15, hq = (u >> 4) % 12, b = u / 192, kvh = hq / 3;
                            Q = (const attn_body::bf16*)QKR + ((size_t)b * 4096 + qb * 256) * 1024 + hq * 64; QP = 1024;
                            K = (const attn_body::bf16*)QKR + (size_t)b * 4096 * 1024 + 768 + kvh * 64; KP = 1024;
                            V = (const attn_body::bf16*)PROJ + (size_t)b * 4096 * 1536 + 1024 + kvh * 64; VP = 1536;
                            O = (attn_body::bf16*)((unsigned char*)CAT + (((size_t)b * 4096 + qb * 256) * 1024 + hq * 64) * OUT_EB); NT = 64;
                        } else { const int v = u - ngqa, qb = v & 15, h = (v >> 4) & 3, b = v >> 6;
                            Q = (const attn_body::bf16*)PROJ + ((size_t)b * 4096 + qb * 256) * pw + (pw - 256) + h * 64; QP = pw;
                            K = (const attn_body::bf16*)KVM + (size_t)b * 256 * 2048 + 512 * l + h * 64; KP = 2048;
                            V = K + 256; VP = 2048;
                            O = (attn_body::bf16*)((unsigned char*)CAT + (((size_t)b * 4096 + qb * 256) * 1024 + 768 + h * 64) * OUT_EB); NT = 4;
                        }
#if EN_ATTN
                        attn_body::attn_unit<8, OUTP_F8 != 0>(Q, K, V, O, QP, KP, VP, 1024, NT, (char*)lds_raw, tid);
#endif
                    }
                }
            } PH_END
        }
#if EN_THIN
        if (kind == 2) { PH_BEGIN(base + 4) for (int rep_ = 0; rep_ < REP_THIN; ++rep_) { tback_phase(cx, (const bf16_t*)(ws + WS_Z2T), CAT, tid); } PH_END }
#endif
        PH_BEGIN(base + 5) {
            pg8::DenseOrder S; S.init(CAT, ws + WS_WOUT + (size_t)l * 2 * MiB, NTOK, 1024, 1024 * OUT_EB, cx.G, (int)blockIdx.x);
            pg8::EpiResB E{SB, l == 0 ? (const void*)INP(0) : (const void*)SB, l == 0 ? 1 : 0, 1024, DN_ALPHA, OUTP_F8 ? 1.0f / WOUT_SCALE : 1.0f};
#if EN_G2
            pg8::gemm_phase<pg8::EpiResB, pg8::DenseOrder, false, OUTP_F8 != 0>(cx.lds, S, E, tid);
#endif
        } PH_END
#if EN_LN
#if REP_LN1 > 1
        PH_BEGIN(base + 6) ln1_router_phase(cx, SB, (bf16_t*)(ws + WS_PROJ), CAT, INP(22) + l * 1024, INP(23) + l * 1024, (const float*)(ws + WS_RW + (size_t)l * 131072), INP(27) + l * 32, (unsigned*)((gu32*)(ws + WS_CTL) + CW_DBG), EXPID, GATE, IDX, (float*)(ws + WS_GIDX), tid); PH_END
#endif
        PH_BEGIN(base + 6) ln1_router_phase(cx, SB, SB2, XB, INP(22) + l * 1024, INP(23) + l * 1024, (const float*)(ws + WS_RW + (size_t)l * 131072), INP(27) + l * 32, (unsigned*)((gu32*)(ws + WS_CTL) + CW_CNT + 32 * l), EXPID, GATE, IDX, (float*)(ws + WS_GIDX), tid); PH_END
#endif
        for (int half = 0; half < 2; ++half) {
            PH_BEGIN(base + 7 + half) {
                LAS int* pref = (LAS int*)(cx.lds + pg8::STAGE_BYTES); const unsigned* cntw = (const unsigned*)((gu32*)(ws + WS_CTL) + CW_CNT + 32 * l);
                __syncthreads();
                if (tid < NEXP) { const int c = (int)__hip_atomic_load(cntw + tid, __ATOMIC_RELAXED, __HIP_MEMORY_SCOPE_AGENT); pref[40 + tid] = c; pref[72 + tid] = (c + 255) >> 8; }
                __syncthreads();
                if (tid == 0) { int a = 0;
#pragma unroll 1
                    for (int e = 0; e < NEXP; ++e) { pref[e] = a; a += pref[72 + e]; } pref[NEXP] = a; }
                __syncthreads();
#if STAGGER
                if (cx.vcu & 1) { for (int s_ = 0; s_ < STAGGER; ++s_) __builtin_amdgcn_s_sleep(127); }
#endif
                if (half == 0) {
                    pg8::MoeOrder<2> S{(const char*)XB, (const char*)(ws + WS_W1 + (size_t)l * 32 * 2048 * 1024 * MOE_EB), 1024 * MOE_EB, 8, cx.G, cx.vcu, (size_t)2048 * 1024 * MOE_EB, pref, (const int*)cntw, IDX};
                    pg8::EpiSwiglu E{HB, INP(29) + (size_t)l * 32 * 2048};
#if EN_G3
                    for (int rep_ = 0; rep_ < REP_G3; ++rep_) { pg8::gemm_phase<pg8::EpiSwiglu, pg8::MoeOrder<2>, true, MOE_F8 != 0, (MOE_F8 != 0) && (DEFER_H != 0)>(cx.lds, S, E, tid); }
#endif
                } else {
                    pg8::MoeOrder<0> S{(const char*)HB, (const char*)(ws + WS_W2 + (size_t)l * 32 * 1024 * 1024 * MOE_EB), 1024 * MOE_EB, 4, cx.G, cx.vcu, (size_t)1024 * 1024 * MOE_EB, pref, (const int*)cntw, IDX};
                    pg8::EpiMoeOut E{YB, INP(31) + (size_t)l * 32 * 1024, (const float*)(ws + WS_GIDX)};
#if EN_G4
                    for (int rep_ = 0; rep_ < REP_G4; ++rep_) { pg8::gemm_phase<pg8::EpiMoeOut, pg8::MoeOrder<0>, true, MOE_F8 != 0>(cx.lds, S, E, tid); }
#endif
                }
            } PH_END
        }
#if EN_LN
#if REP_LN2 > 1
        PH_BEGIN(base + 9) ln2_phase(cx, SB, YB, (bf16_t*)(ws + WS_PROJ), CAT, (float*)nullptr, INP(24) + l * 1024, INP(25) + l * 1024, INP(22) + l * 1024, INP(23) + l * 1024, tid); PH_END
#endif
        PH_BEGIN(base + 9) ln2_phase(cx, (X1_RECOMP && Y_F8) ? SB : SB2, YB, SB, XB, l == DEPTH - 1 ? XF : (float*)nullptr, INP(24) + l * 1024, INP(25) + l * 1024, INP(22) + l * 1024, INP(23) + l * 1024, tid); PH_END

#endif
    }
#undef PH_BEGIN
#undef PH_END
#undef XB
#undef PROJ
#undef CAT
#undef KVM
#undef HB
#undef YB
#undef QKR
#undef EXPID
#undef GATE
#undef IDX
#undef XF
#undef SB
#undef SB2
}

extern "C" void kernel_launch(void* const* d_in, const int* in_sizes, int n_in, void* d_out, int out_size, void* d_ws, size_t ws_size, hipStream_t stream) {
    static int grid = 0;
    if (grid == 0) {
        if (n_in != 32 || in_sizes[0] != NTOK * DM || out_size != NTOK * DM || ws_size < WS_END) { fprintf(stderr, "kernel_launch: unexpected problem (n_in %d, in0 %d, out %d, ws %zu < %zu); nothing launched\n", n_in, n_in > 0 ? in_sizes[0] : -1, out_size, ws_size, (size_t)WS_END); grid = -1; return; }
        int dev = 0, cus = 0, per_cu = 0;
        if (hipGetDevice(&dev) != hipSuccess || hipDeviceGetAttribute(&cus, hipDeviceAttributeMultiprocessorCount, dev) != hipSuccess) { fprintf(stderr, "kernel_launch: device query failed\n"); grid = -1; return; }
        if (hipFuncSetAttribute((const void*)fwd, hipFuncAttributeMaxDynamicSharedMemorySize, LDS_BYTES) != hipSuccess) { fprintf(stderr, "kernel_launch: hipFuncSetAttribute failed\n"); grid = -1; return; }
        if (hipOccupancyMaxActiveBlocksPerMultiprocessor(&per_cu, (const void*)fwd, 512, LDS_BYTES) != hipSuccess || per_cu < 1) fprintf(stderr, "kernel_launch: occupancy query reports %d blocks per CU\n", per_cu);
        (void)hipGetLastError();
        grid = cus;
    }
    if (grid < 0) return;
    if (hipMemsetAsync((char*)d_ws + WS_CTL, 0, CTL_ZERO_BYTES, stream) != hipSuccess) { fprintf(stderr, "kernel_launch: memset failed\n"); return; }
    Args a{};
    for (int i = 0; i < 32; ++i) a.in[i] = (const float*)d_in[i];
    a.out = (float*)d_out; a.ws = (unsigned char*)d_ws;
#if MK_MULTI
    for (int p = 0; p < N_PHASES && p <= DBG_LAST_PHASE; ++p) {
        if (!phase_active(p)) continue;
        a.ph_lo = p; a.ph_hi = p + 1;
        hipLaunchKernelGGL(fwd, dim3(grid), dim3(512), LDS_BYTES, stream, a);
#if DBG_CHECK
        dbg_after_phase(p, a, stream);
#endif
    }
#if DBG_CHECK
    hipLaunchKernelGGL(dbg_report, dim3(1024), dim3(256), 0, stream, (unsigned*)((char*)d_ws + WS_CTL) + CW_DBG, (float*)d_out);
#endif
#else
    a.ph_lo = 0; a.ph_hi = N_PHASES;
    hipLaunchKernelGGL(fwd, dim3(grid), dim3(512), LDS_BYTES, stream, a);
#endif
    const hipError_t le = hipPeekAtLastError();
    if (le != hipSuccess) fprintf(stderr, "kernel_launch: launch failed: %s\n", hipGetErrorName(le));
}
```

```cpp
#include <hip/hip_runtime.h>
#include <hip/hip_bf16.h>
#include <cstdio>
#include <cstdint>

#ifndef MK_MULTI
#define MK_MULTI 0
#endif
#ifndef DBG_CHECK
#define DBG_CHECK 0
#endif
#ifndef DBG_LAST_PHASE
#define DBG_LAST_PHASE 9999
#endif

#ifndef EN_P0
#define EN_P0 1
#define EN_G1 1
#define EN_THIN 1
#define EN_TCONV 1
#define EN_NA 1
#define EN_ATTN 1
#define EN_G2 1
#define EN_LN 1
#define EN_G3 1
#define EN_G4 1
#endif

#ifndef REP_P0
#define REP_P0 1
#endif
#ifndef REP_G1
#define REP_G1 1
#endif
#ifndef REP_NA
#define REP_NA 1
#endif
#ifndef REP_ATTN
#define REP_ATTN 1
#endif
#ifndef REP_TCONV
#define REP_TCONV 1
#endif
#ifndef REP_THIN
#define REP_THIN 1
#endif
#ifndef REP_G3
#define REP_G3 1
#endif
#ifndef REP_G4
#define REP_G4 1
#endif
#ifndef ALIGN_EPI
#define ALIGN_EPI 1
#endif
#ifndef NT_STORE
#define NT_STORE 0
#endif
#ifndef X1_RECOMP
#define X1_RECOMP 1
#endif
#ifndef LN1_HOLD
#define LN1_HOLD 16
#endif
#ifndef DEFER_H
#define DEFER_H 0
#endif
#ifndef STAGGER
#define STAGGER 0
#endif
#ifndef REP_BAR
#define REP_BAR 1
#endif
#ifndef REP_DENSE
#define REP_DENSE 1
#endif
#ifndef REP_G2
#define REP_G2 1
#endif
#ifndef REP_LN1
#define REP_LN1 1
#endif
#ifndef REP_LN2
#define REP_LN2 1
#endif

#define GAS __attribute__((address_space(1)))
#define LAS __attribute__((address_space(3)))
typedef unsigned short bf16_t;
typedef short bf16x8 __attribute__((ext_vector_type(8)));
typedef short s16x4 __attribute__((ext_vector_type(4)));
typedef float f32x4 __attribute__((ext_vector_type(4)));
typedef float f32x2 __attribute__((ext_vector_type(2)));
typedef float f32x16 __attribute__((ext_vector_type(16)));
typedef unsigned u32x4 __attribute__((ext_vector_type(4)));
typedef unsigned u32x2 __attribute__((ext_vector_type(2)));
typedef GAS unsigned gu32;

constexpr int BATCH = 16, SEQ = 4096, DM = 1024, NTOK = BATCH * SEQ, DEPTH = 4;
constexpr int MEMLEN = 256, NMEM = BATCH * MEMLEN;
constexpr int NEXP = 32, NSLOT = NTOK * 4, IDXCAP = NTOK;
constexpr int GRIDW = 64;
constexpr float LN_EPS = 1e-5f;
constexpr float DN_ALPHA = 1.681792830507429f;
constexpr float LOG2E = 1.4426950408889634f;
constexpr float C2 = 0.125f * LOG2E;
__host__ __device__ constexpr int layer_kind(int l) { return l % 3; }
__host__ __device__ constexpr int layer_j(int l) { return l / 3; }
__host__ __device__ constexpr int in_width(int l) { return (l % 3) == 1 ? 1536 : 2560; }

#ifndef MOE_F8
#define MOE_F8 1
#endif
#ifndef INP_F8
#define INP_F8 1
#endif
constexpr int INP_EB = INP_F8 ? 1 : 2;
constexpr float WIN_SCALE = 32.0f;
#ifndef OUTP_F8
#define OUTP_F8 1
#endif
constexpr int OUT_EB = OUTP_F8 ? 1 : 2;
constexpr float WOUT_SCALE = 64.0f;
__device__ __forceinline__ unsigned char f2fp8(float x) { return (unsigned char)(__builtin_amdgcn_cvt_pk_fp8_f32(x, x, 0, false) & 0xff); }
#ifndef TCONV_F8
#define TCONV_F8 1
#endif
#ifndef Y_F8
#define Y_F8 1
#endif
constexpr float Y_SCALE = 64.0f;
constexpr int MOE_EB = MOE_F8 ? 1 : 2;
constexpr float W1_SCALE = 32.0f, W2_SCALE = 64.0f, H_SCALE = 4.0f;

constexpr size_t MiB = 1u << 20;
constexpr size_t WS_CTL = 0, CTL_ZERO_BYTES = 1 * MiB;
constexpr size_t WS_RW = 1 * MiB;
constexpr size_t WS_WIN = 2 * MiB;
constexpr size_t WS_WKV = 22 * MiB;
constexpr size_t WS_WOUT = 26 * MiB;
constexpr size_t WS_W1 = 34 * MiB;
constexpr size_t WS_W2 = 546 * MiB;
constexpr size_t WS_XB = 802 * MiB;
constexpr size_t WS_MEMB = 930 * MiB;
constexpr size_t WS_KVM = 938 * MiB;
constexpr size_t WS_PROJ = 954 * MiB;
constexpr size_t WS_CAT = 1274 * MiB;
constexpr size_t WS_H = 1402 * MiB;
constexpr size_t WS_Y = 1914 * MiB;
constexpr size_t WS_HRAWT = 2426 * MiB;
constexpr size_t WS_HPART = 2474 * MiB;
constexpr size_t WS_EXPID = 2478 * MiB;
constexpr size_t WS_GATE = 2479 * MiB;
constexpr size_t WS_IDX = 2480 * MiB;
constexpr size_t WS_SB = 2488 * MiB;
constexpr size_t WS_GIDX = 2616 * MiB;
constexpr size_t WS_END = 2624 * MiB;
constexpr size_t WS_UT3 = WS_H;
constexpr size_t WS_Z1T = WS_H + 288 * MiB;
constexpr size_t WS_Z2T = WS_H + 384 * MiB;
constexpr size_t WS_V8 = WS_Y;
constexpr size_t WS_QKR = WS_Y;
constexpr int CW_BAR = 4096;
constexpr int CW_CNT = 8192;
constexpr int CW_DBG = 12288;

constexpr int MISC_OFF = 150528;
constexpr int LDS_BYTES = 163840;

#define LDS_WAIT() asm volatile("s_waitcnt lgkmcnt(0)" ::: "memory")
#define VM_WAIT() asm volatile("s_waitcnt vmcnt(0)" ::: "memory")
__device__ __forceinline__ unsigned f2bf(float f) { unsigned u = __builtin_bit_cast(unsigned, f); return (u + 0x7fffu + ((u >> 16) & 1u)) >> 16; }
__device__ __forceinline__ unsigned pk2(float lo, float hi) { return f2bf(lo) | (f2bf(hi) << 16); }
__device__ __forceinline__ float bf2f(unsigned short b) { return __builtin_bit_cast(float, ((unsigned)b) << 16); }
__device__ __forceinline__ float bflo(unsigned w) { return __builtin_bit_cast(float, w << 16); }
__device__ __forceinline__ float bfhi(unsigned w) { return __builtin_bit_cast(float, w & 0xffff0000u); }
__device__ __forceinline__ float shflx(float v, int mask, int lane) { int t; asm volatile("v_mov_b32 %0, %1" : "=v"(t) : "v"(__builtin_bit_cast(int, v))); return __builtin_bit_cast(float, __builtin_amdgcn_ds_bpermute((lane ^ mask) << 2, t)); }
__device__ __forceinline__ int shflxi(int v, int mask, int lane) { return __builtin_amdgcn_ds_bpermute((lane ^ mask) << 2, v); }
template <int CTRL> __device__ __forceinline__ float dpp_x(float v) { return __builtin_bit_cast(float, __builtin_amdgcn_update_dpp(0, __builtin_bit_cast(int, v), CTRL, 0xF, 0xF, false)); }
__device__ __forceinline__ float group8_sum(float v) { v += dpp_x<0xB1>(v); v += dpp_x<0x4E>(v); v += dpp_x<0x141>(v); return v; }
__device__ __forceinline__ float wave_sum(float v, int  ) {
    v += dpp_x<0xB1>(v); v += dpp_x<0x4E>(v); v += dpp_x<0x141>(v); v += dpp_x<0x140>(v);
    v += __builtin_bit_cast(float, __builtin_amdgcn_update_dpp(0, __builtin_bit_cast(int, v), 0x142, 0xA, 0xF, false));
    v += __builtin_bit_cast(float, __builtin_amdgcn_update_dpp(0, __builtin_bit_cast(int, v), 0x143, 0xC, 0xF, false));
    return __builtin_bit_cast(float, __builtin_amdgcn_readlane(__builtin_bit_cast(int, v), 63));
}
__device__ __forceinline__ int lane_id_volatile() { int l; asm volatile("v_mbcnt_lo_u32_b32 %0, -1, 0\n\tv_mbcnt_hi_u32_b32 %0, -1, %0" : "=&v"(l)); return l; }
__device__ __forceinline__ int opaque_tid(int wave0) { return wave0 * 64 + lane_id_volatile(); }

#define XB_TMO      128
#define XB_XCNT(j)  (256  + 64 * (j))
#define XB_XSUB(j)  (1280 + 64 * (j))
#define XB_XGEN(j)  (2304 + 64 * (j))
#define XB_TOP      3328
#define XB_TOPGEN   3392
#define XCD_BAR_WORDS 3456
#define XB_SPIN_CAP (1u << 20)

__device__ __forceinline__ unsigned xb_ld(unsigned* p)              { return __hip_atomic_load(p, __ATOMIC_RELAXED, __HIP_MEMORY_SCOPE_AGENT); }
__device__ __forceinline__ unsigned xb_add(unsigned* p, unsigned v) { return __hip_atomic_fetch_add(p, v, __ATOMIC_RELAXED, __HIP_MEMORY_SCOPE_AGENT); }
__device__ __forceinline__ unsigned xb_xcc_id() { return (unsigned)__builtin_amdgcn_s_getreg((3 << 11) | 20) & 0xFu; }
#define XB_SPIN(cond, bar) do { unsigned _sp = 0; while (cond) { __builtin_amdgcn_s_sleep(1); \
    if ((++_sp & 255u) == 0u) { if (xb_ld(&(bar)[XB_TMO])) break; if (_sp > XB_SPIN_CAP) { atomicAdd(&(bar)[XB_TMO], 1u); break; } } } } while (0)

struct XcdBarrier {
    unsigned* bar; unsigned x;
    volatile LAS unsigned* st;
};
__device__ __forceinline__ XcdBarrier xcd_barrier_post(unsigned* bar, volatile LAS unsigned* st) {
    XcdBarrier b; b.bar = bar; b.x = xb_xcc_id(); b.st = st;
    if (threadIdx.x == 0) (void)xb_add(&bar[XB_XCNT(b.x)], 1u);
    return b;
}
__device__ __forceinline__ void xcd_barrier_complete(unsigned* bar, unsigned x, unsigned& nloc, unsigned& nx) {
    const unsigned G = gridDim.x * gridDim.y * gridDim.z;
    unsigned sum, cnt, mine, sp = 0u;
    for (;;) {
        sum = 0u; cnt = 0u; mine = 0u;
#pragma unroll 1
        for (unsigned j = 0; j < 16; ++j) { const unsigned c = xb_ld(&bar[XB_XCNT(j)]); sum += c; cnt += (c > 0u) ? 1u : 0u; mine = (j == x) ? c : mine; }
        if (sum == G) break;
        __builtin_amdgcn_s_sleep(1);
        if ((++sp & 255u) == 0u) { if (xb_ld(&bar[XB_TMO])) break; if (sp > XB_SPIN_CAP) { atomicAdd(&bar[XB_TMO], 1u); break; } }
    }
    nloc = mine > 0u ? mine : 1u; nx = cnt > 0u ? cnt : 1u;
}
__device__ __forceinline__ void xcd_barrier(const XcdBarrier& b, const int wave0) {
    asm volatile("s_waitcnt vmcnt(0)" ::: "memory");
    __syncthreads();
    if (wave0 == 0 && lane_id_volatile() == 0) {
        unsigned* bar = b.bar;
        __builtin_amdgcn_s_waitcnt(0);
        unsigned nloc = b.st[0], nx = b.st[1];
        if (nloc == 0u) { xcd_barrier_complete(bar, b.x, nloc, nx); b.st[0] = nloc; b.st[1] = nx; }
        const unsigned old = xb_add(&bar[XB_XSUB(b.x)], 1u);
        const unsigned gen = old / nloc;
        if (old + 1u == (gen + 1u) * nloc) {
            __builtin_amdgcn_fence(__ATOMIC_RELEASE, "agent");
            asm volatile("s_waitcnt vmcnt(0)" ::: "memory");
            const unsigned og = xb_add(&bar[XB_TOP], 1u);
            const unsigned tg = og / nx;
            if (og + 1u == (tg + 1u) * nx) xb_add(&bar[XB_TOPGEN], 1u);
            else XB_SPIN(xb_ld(&bar[XB_TOPGEN]) == tg, bar);
            __builtin_amdgcn_fence(__ATOMIC_ACQUIRE, "agent");
            xb_add(&bar[XB_XGEN(b.x)], 1u);
            asm volatile("s_waitcnt vmcnt(0)" ::: "memory");
        } else {
            XB_SPIN(xb_ld(&bar[XB_XGEN(b.x)]) == gen, bar);
            __builtin_amdgcn_fence(__ATOMIC_ACQUIRE, "agent");
            asm volatile("s_waitcnt vmcnt(0)" ::: "memory");
        }
    }
    __syncthreads();
}

namespace pg8 {
constexpr int BM = 256, BK = 64, HALF = 128, HTB = HALF * BK * 2  , STAGE_BYTES = 8 * HTB, NXCD = 8, WGM = 8;
__host__ __device__ __forceinline__ int lds_byte(int r, int c) { const int st = (r >> 4) * 2 + (c >> 5), rr = r & 15, cc = c & 31, ob = rr * 64 + cc * 2; return st * 1024 + (ob ^ (((ob >> 9) & 1) << 5)); }
__host__ __device__ __forceinline__ void stage_rc(int b, int& R, int& C) { const int st = b / 1024, sb = b % 1024, swz = sb ^ (((sb >> 9) & 1) << 5); R = (st >> 1) * 16 + swz / 64; C = (st & 1) * 32 + (swz % 64) / 2; }
__host__ __device__ __forceinline__ int perm32(int rho) { const int n = rho >> 4, i = rho & 15; return 8 * (i >> 2) + 4 * n + (i & 3); }

struct Unit { int pm, pn, e, p; };

struct DenseOrder {
    const char* A; const char* Bt; int KB; int nM, nN, nwg, G, c; int rep = 1;
    __device__ __forceinline__ void init(const void* A_, const void* Bt_, int M, int N, int KB_, int G_, int c_) { A = (const char*)A_; Bt = (const char*)Bt_; KB = KB_; nM = M / BM; nN = N / BM; nwg = nM * nN; G = G_; c = c_; }
    __device__ __forceinline__ bool next(int i, Unit& u) const {
        long L = (long)i * G + c; if (L >= (long)nwg * rep) return false;
        if (rep > 1) L %= nwg;
        int wgid = (int)L; { const int q = nwg / NXCD, r = nwg % NXCD, xcd = wgid % NXCD, off = wgid / NXCD; wgid = (xcd < r ? xcd * (q + 1) : r * (q + 1) + (xcd - r) * q) + off; }
        const int nig = WGM * nN, gid = wgid / nig, fm = gid * WGM, gsz = (nM - fm) < WGM ? (nM - fm) : WGM;
        u.pm = __builtin_amdgcn_readfirstlane(fm + ((wgid % nig) % gsz)); u.pn = __builtin_amdgcn_readfirstlane((wgid % nig) / gsz); u.e = 0; u.p = 0; return true;
    }
    __device__ __forceinline__ const char* a_base(const Unit& u) const { return A + (size_t)u.pm * BM * KB; }
    __device__ __forceinline__ const char* b_base(const Unit& u) const { return Bt + (size_t)u.pn * BM * KB; }
    __device__ __forceinline__ const int* idx_src(const Unit&) const { return nullptr; }
    __device__ __forceinline__ int nvalid(const Unit&) const { return BM; }
    static constexpr int ROW_SHIFT = 0;
};
template <int SHIFT  > struct MoeOrder {
    const char* A; const char* Bt; int KB; int nN; int G, c; size_t bstride; const LAS int* pref; const int* cnt; const int* idx;
    __device__ __forceinline__ bool next(int i, Unit& u) const {
        const long L = (long)i * G + c; const int tot = __builtin_amdgcn_readfirstlane(pref[NEXP]);
        if (L >= (long)tot * nN) return false;
        const int pg = __builtin_amdgcn_readfirstlane((int)(L / nN)); u.pn = __builtin_amdgcn_readfirstlane((int)(L % nN));
        int e = 0;
#pragma unroll
        for (int step = 16; step >= 1; step >>= 1) { const int v = __builtin_amdgcn_readfirstlane(pref[e + step]); e += (v <= pg) ? step : 0; }
        u.e = e; u.p = pg - __builtin_amdgcn_readfirstlane(pref[e]); u.pm = 0; return true;
    }
    __device__ __forceinline__ const char* a_base(const Unit&) const { return A; }
    __device__ __forceinline__ const char* b_base(const Unit& u) const { return Bt + (size_t)u.e * bstride + (size_t)u.pn * BM * KB; }
    __device__ __forceinline__ const int* idx_src(const Unit& u) const { return idx + (size_t)u.e * IDXCAP + u.p * BM; }
    __device__ __forceinline__ int nvalid(const Unit& u) const { const int n = __builtin_amdgcn_readfirstlane(pref[40 + u.e]) - u.p * BM; return n < BM ? n : BM; }
    static constexpr int ROW_SHIFT = SHIFT;
};

__device__ __forceinline__ unsigned cvt_pk_bf16(float lo, float hi) { unsigned r; asm volatile("v_cvt_pk_bf16_f32 %0, %1, %2" : "=v"(r) : "v"(lo), "v"(hi)); return r; }

struct EpiBf16s {
    static constexpr bool PERM = true; static constexpr bool HAS_BIAS = false;
    bf16_t* O; int ldc; unsigned smask; float scale; float base;
    __device__ __forceinline__ void operator()(const f32x4 (&acc)[2][2][4][2], const Unit& u, int wr, int wc, int fr, int fq) const {
        const int row0 = u.pm * BM + wr * 64 + fr, col0 = u.pn * BM + wc * 32 + 8 * fq;
        const float sc = (((smask >> u.pn) & 1u) ? scale : 1.f) * base;
#pragma unroll
        for (int ai = 0; ai < 2; ++ai)
#pragma unroll
            for (int m = 0; m < 4; ++m) { bf16_t* rowp = O + (size_t)(row0 + ai * HALF + m * 16) * ldc + col0;
#pragma unroll
                for (int bj = 0; bj < 2; ++bj) { const f32x4 v0 = acc[ai][bj][m][0] * sc, v1 = acc[ai][bj][m][1] * sc;
                    u32x4 w; w.x = cvt_pk_bf16(v0[0], v0[1]); w.y = cvt_pk_bf16(v0[2], v0[3]); w.z = cvt_pk_bf16(v1[0], v1[1]); w.w = cvt_pk_bf16(v1[2], v1[3]);
                    if (NT_STORE) __builtin_nontemporal_store(w, (u32x4*)(rowp + bj * HALF)); else *(u32x4*)(rowp + bj * HALF) = w; }
                asm volatile("" ::: "memory"); }
    }
};
struct EpiResB {
    static constexpr bool PERM = true; static constexpr bool HAS_BIAS = false;
    bf16_t* C; const void* res; int res_f32; int ldc; float alpha; float ascale;
    __device__ __forceinline__ void operator()(const f32x4 (&acc)[2][2][4][2], const Unit& u, int wr, int wc, int fr, int fq) const {
        const int row0 = u.pm * BM + wr * 64 + fr, col0 = u.pn * BM + wc * 32 + 8 * fq;
        if (res_f32) {
#pragma unroll
            for (int ai = 0; ai < 2; ++ai) { f32x4 r[4][2][2];
#pragma unroll
                for (int m = 0; m < 4; ++m)
#pragma unroll
                    for (int bj = 0; bj < 2; ++bj) { const float* rp = (const float*)res + (size_t)(row0 + ai * HALF + m * 16) * ldc + col0 + bj * HALF; r[m][bj][0] = *(const f32x4*)rp; r[m][bj][1] = *(const f32x4*)(rp + 4); }
#pragma unroll
                for (int m = 0; m < 4; ++m)
#pragma unroll
                    for (int bj = 0; bj < 2; ++bj) { const size_t off = (size_t)(row0 + ai * HALF + m * 16) * ldc + col0 + bj * HALF;
                        const f32x4 v0 = r[m][bj][0] * alpha + acc[ai][bj][m][0] * ascale, v1 = r[m][bj][1] * alpha + acc[ai][bj][m][1] * ascale;
                        u32x4 w; w.x = cvt_pk_bf16(v0[0], v0[1]); w.y = cvt_pk_bf16(v0[2], v0[3]); w.z = cvt_pk_bf16(v1[0], v1[1]); w.w = cvt_pk_bf16(v1[2], v1[3]);
                        *(u32x4*)(C + off) = w; }
                asm volatile("" ::: "memory"); }
        } else { u32x4 raw[2][4][2];
#pragma unroll
            for (int ai = 0; ai < 2; ++ai)
#pragma unroll
                for (int m = 0; m < 4; ++m)
#pragma unroll
                    for (int bj = 0; bj < 2; ++bj) raw[ai][m][bj] = *(const u32x4*)((const bf16_t*)res + (size_t)(row0 + ai * HALF + m * 16) * ldc + col0 + bj * HALF);
#pragma unroll
            for (int ai = 0; ai < 2; ++ai)
#pragma unroll
                for (int m = 0; m < 4; ++m)
#pragma unroll
                    for (int bj = 0; bj < 2; ++bj) { const size_t off = (size_t)(row0 + ai * HALF + m * 16) * ldc + col0 + bj * HALF; const u32x4 rw = raw[ai][m][bj];
                        const f32x4 r0 = (f32x4){bflo(rw.x), bfhi(rw.x), bflo(rw.y), bfhi(rw.y)}, r1 = (f32x4){bflo(rw.z), bfhi(rw.z), bflo(rw.w), bfhi(rw.w)};
                        const f32x4 v0 = r0 * alpha + acc[ai][bj][m][0] * ascale, v1 = r1 * alpha + acc[ai][bj][m][1] * ascale;
                        u32x4 w; w.x = cvt_pk_bf16(v0[0], v0[1]); w.y = cvt_pk_bf16(v0[2], v0[3]); w.z = cvt_pk_bf16(v1[0], v1[1]); w.w = cvt_pk_bf16(v1[2], v1[3]);
                        *(u32x4*)(C + off) = w; }
        }
    }
};
struct Pend { u32x2 val[8]; };
struct EpiSwiglu {
    static constexpr bool PERM = true; static constexpr bool HAS_GATE = false; static constexpr bool HAS_BIAS = true;
    __device__ __forceinline__ void load_bias(const Unit& u, int wc, int fq, f32x4 (&bp)[4]) const { const float* bg = b1 + (size_t)u.e * 2048 + u.pn * HALF + wc * 32 + 8 * fq; bp[0] = *(const f32x4*)bg; bp[1] = *(const f32x4*)(bg + 4); bp[2] = *(const f32x4*)(bg + 1024); bp[3] = *(const f32x4*)(bg + 1028); }
    bf16_t* H; const float* b1;
    __device__ __forceinline__ void prepare(const f32x4 (&acc)[2][2][4][2], const Unit& u, int wr, int wc, int fr, int fq, Pend& pd) const {
        constexpr float ASC = 1.0f / W1_SCALE;
        const int j0 = u.pn * HALF + wc * 32 + 8 * fq; const float* bg = b1 + (size_t)u.e * 2048 + j0; const float* bu = bg + 1024;
        const f32x4 bg0 = *(const f32x4*)bg, bg1 = *(const f32x4*)(bg + 4), bu0 = *(const f32x4*)bu, bu1 = *(const f32x4*)(bu + 4);
#pragma unroll
        for (int q8 = 0; q8 < 8; ++q8) { const int ai = q8 >> 2, m = q8 & 3;
            float o[8];
#pragma unroll
            for (int q = 0; q < 8; ++q) { const float gb = (q < 4 ? bg0[q & 3] : bg1[q & 3]), ub = (q < 4 ? bu0[q & 3] : bu1[q & 3]);
                float g = acc[ai][0][m][q >> 2][q & 3] * ASC + gb, uu = acc[ai][1][m][q >> 2][q & 3] * ASC + ub;
                g = fminf(g, 7.0f); uu = fminf(fmaxf(uu, -7.0f), 7.0f);
                const float sg = __builtin_amdgcn_rcpf(1.0f + __builtin_amdgcn_exp2f(-1.702f * LOG2E * g));
                o[q] = (uu + 1.0f) * (g * sg); }
            int w0 = 0, w1 = 0;
            w0 = __builtin_amdgcn_cvt_pk_fp8_f32(o[0] * H_SCALE, o[1] * H_SCALE, w0, false); w0 = __builtin_amdgcn_cvt_pk_fp8_f32(o[2] * H_SCALE, o[3] * H_SCALE, w0, true);
            w1 = __builtin_amdgcn_cvt_pk_fp8_f32(o[4] * H_SCALE, o[5] * H_SCALE, w1, false); w1 = __builtin_amdgcn_cvt_pk_fp8_f32(o[6] * H_SCALE, o[7] * H_SCALE, w1, true);
            pd.val[q8] = (u32x2){(unsigned)w0, (unsigned)w1}; }
    }
    __device__ __forceinline__ void store_one(const u32x2 v, const LAS int* ids, const int r, const int nv, const int j0) const { if (r < nv) { const int slot = ids[r]; *(u32x2*)((unsigned char*)H + (size_t)slot * 1024 + j0) = v; } }
    __device__ __forceinline__ void operator()(const f32x4 (&acc)[2][2][4][2], const Unit& u, int wr, int wc, int fr, int fq, const LAS int* ids, const int nv, const f32x4 (&bp)[4]) const {
        constexpr float ASC = MOE_F8 ? 1.0f / W1_SCALE : 1.0f;
        constexpr float HS = MOE_F8 ? H_SCALE : 1.0f, KK = -1.702f * LOG2E, GA = ASC * KK, UA = ASC * HS / KK, ULO = 8.0f * HS / KK, UHI = -6.0f * HS / KK, GLO = 7.0f * KK;
        const int j0 = u.pn * HALF + wc * 32 + 8 * fq;
        const f32x4 bg0 = bp[0] * KK, bg1 = bp[1] * KK; f32x4 bu0 = (bp[2] + 1.0f) * (HS / KK), bu1 = (bp[3] + 1.0f) * (HS / KK);
        asm volatile("" : "+v"(bu0), "+v"(bu1));
        int rb = wr * 64 + fr; asm volatile("" : "+v"(rb));
        const LAS int* idp = ids + rb; int slots[8];
#pragma unroll
        for (int q = 0; q < 8; ++q) slots[q] = idp[(q >> 2) * HALF + (q & 3) * 16];
#pragma unroll
        for (int ai = 0; ai < 2; ++ai)
#pragma unroll
            for (int m = 0; m < 4; ++m) { const int r = ai * HALF + m * 16 + rb;
                if (r < nv) { const int slot = slots[ai * 4 + m];
                    float o[8];
#pragma unroll
                    for (int q = 0; q < 8; ++q) { const float gb = (q < 4 ? bg0[q & 3] : bg1[q & 3]), ub = (q < 4 ? bu0[q & 3] : bu1[q & 3]);
                        const float gp = fmaxf(__builtin_fmaf(acc[ai][0][m][q >> 2][q & 3], GA, gb), GLO);
                        const float us = fminf(fmaxf(__builtin_fmaf(acc[ai][1][m][q >> 2][q & 3], UA, ub), ULO), UHI);
                        const float sg = __builtin_amdgcn_rcpf(1.0f + __builtin_amdgcn_exp2f(gp));
                        o[q] = us * (gp * sg); }
                    if constexpr (MOE_F8) { int w0 = 0, w1 = 0;
                        w0 = __builtin_amdgcn_cvt_pk_fp8_f32(o[0], o[1], w0, false); w0 = __builtin_amdgcn_cvt_pk_fp8_f32(o[2], o[3], w0, true);
                        w1 = __builtin_amdgcn_cvt_pk_fp8_f32(o[4], o[5], w1, false); w1 = __builtin_amdgcn_cvt_pk_fp8_f32(o[6], o[7], w1, true);
                        *(u32x2*)((unsigned char*)H + (size_t)slot * 1024 + j0) = (u32x2){(unsigned)w0, (unsigned)w1};
                    } else { u32x4 w; w.x = cvt_pk_bf16(o[0], o[1]); w.y = cvt_pk_bf16(o[2], o[3]); w.z = cvt_pk_bf16(o[4], o[5]); w.w = cvt_pk_bf16(o[6], o[7]);
                        *(u32x4*)(H + (size_t)slot * 1024 + j0) = w; } } }
    }
};
struct EpiMoeOut {
    static constexpr bool PERM = true; static constexpr bool HAS_GATE = true; static constexpr bool HAS_BIAS = true;
    __device__ __forceinline__ void load_bias(const Unit& u, int wc, int fq, f32x4 (&bp)[4]) const { const float* bb = b2 + (size_t)u.e * 1024 + u.pn * BM + wc * 32 + 8 * fq; bp[0] = *(const f32x4*)bb; bp[1] = *(const f32x4*)(bb + 4); bp[2] = *(const f32x4*)(bb + HALF); bp[3] = *(const f32x4*)(bb + HALF + 4); }
    bf16_t* Y; const float* b2;   const float* gidx;
    __device__ __forceinline__ void operator()(const f32x4 (&acc)[2][2][4][2], const Unit& u, int wr, int wc, int fr, int fq, const LAS int* ids, const int nv, const f32x4 (&bp)[4]) const {
        const LAS float* gts = (const LAS float*)(ids + 768);
        constexpr float OSC = MOE_F8 ? 1.0f / (H_SCALE * W2_SCALE) : 1.0f;
        const int c0 = u.pn * BM + wc * 32 + 8 * fq;
        f32x4 bv[2][2]; bv[0][0] = bp[0]; bv[0][1] = bp[1]; bv[1][0] = bp[2]; bv[1][1] = bp[3];
        int rb = wr * 64 + fr; asm volatile("" : "+v"(rb));
        const LAS int* idp = ids + rb; int slots[8];
#pragma unroll
        for (int q = 0; q < 8; ++q) slots[q] = idp[(q >> 2) * HALF + (q & 3) * 16];
#pragma unroll
        for (int ai = 0; ai < 2; ++ai)
#pragma unroll
            for (int m = 0; m < 4; ++m) { const int r = ai * HALF + m * 16 + rb;
                if (r < nv) { const int slot = slots[ai * 4 + m]; const float gt = gts[r];
                    if constexpr (Y_F8) {
                        unsigned pk[2][2];
#pragma unroll
                        for (int bj = 0; bj < 2; ++bj) { const f32x4 s0 = (acc[ai][bj][m][0] * OSC + bv[bj][0]) * (gt * Y_SCALE), s1 = (acc[ai][bj][m][1] * OSC + bv[bj][1]) * (gt * Y_SCALE); int w0 = 0, w1 = 0;
                            w0 = __builtin_amdgcn_cvt_pk_fp8_f32(s0[0], s0[1], w0, false); w0 = __builtin_amdgcn_cvt_pk_fp8_f32(s0[2], s0[3], w0, true); w1 = __builtin_amdgcn_cvt_pk_fp8_f32(s1[0], s1[1], w1, false); w1 = __builtin_amdgcn_cvt_pk_fp8_f32(s1[2], s1[3], w1, true);
                            pk[bj][0] = (unsigned)w0; pk[bj][1] = (unsigned)w1; }
                        const auto x0 = __builtin_amdgcn_permlane16_swap(pk[0][0], pk[1][0], false, false), x1 = __builtin_amdgcn_permlane16_swap(pk[0][1], pk[1][1], false, false);
                        *(u32x4*)((unsigned char*)Y + (size_t)slot * 1024 + c0 + ((fq & 1) ? 120 : 0)) = (u32x4){x0[0], x1[0], x0[1], x1[1]};
                    } else {
#pragma unroll
                    for (int bj = 0; bj < 2; ++bj) { const f32x4 v0 = (acc[ai][bj][m][0] * OSC + bv[bj][0]) * gt, v1 = (acc[ai][bj][m][1] * OSC + bv[bj][1]) * gt;
                        u32x4 w; w.x = cvt_pk_bf16(v0[0], v0[1]); w.y = cvt_pk_bf16(v0[2], v0[3]); w.z = cvt_pk_bf16(v1[0], v1[1]); w.w = cvt_pk_bf16(v1[2], v1[3]);
                        if (NT_STORE) __builtin_nontemporal_store(w, (u32x4*)(Y + (size_t)slot * 1024 + c0 + bj * HALF)); else *(u32x4*)(Y + (size_t)slot * 1024 + c0 + bj * HALF) = w; } } } }
    }
};

__device__ __forceinline__ const char* uni_ptr(const char* p) { const unsigned long long v = (unsigned long long)p; const unsigned lo = __builtin_amdgcn_readfirstlane((unsigned)v), hi = __builtin_amdgcn_readfirstlane((unsigned)(v >> 32)); return (const char*)(((unsigned long long)hi << 32) | lo); }
typedef int v4i_t __attribute__((ext_vector_type(4))); typedef int v8i_t __attribute__((ext_vector_type(8)));
__device__ __forceinline__ v8i_t cat8(const bf16x8 a, const bf16x8 b) { return __builtin_shufflevector(__builtin_bit_cast(v4i_t, a), __builtin_bit_cast(v4i_t, b), 0, 1, 2, 3, 4, 5, 6, 7); }
template <class Epi, class Sched, bool GATHER, bool F8 = false, bool DEFER = false>
__device__ __forceinline__ void gemm_phase(LAS unsigned char* lds, const Sched& S, const Epi& E, const int tid) {
    const int wid = __builtin_amdgcn_readfirstlane(tid >> 6), lane = tid & 63, wr = wid >> 2, wc = wid & 3, fr = lane & 15, fq = lane >> 4;
    const int KB = S.KB, nt = KB / 128;
    unsigned voffA[2], voffB[2];
#pragma unroll
    for (int i = 0; i < 2; ++i) { int R, C; stage_rc(tid * 16 + i * 8192, R, C); const int Rb = Epi::PERM ? ((R & ~31) + perm32(R & 31)) : R;
        voffA[i] = (unsigned)(R * KB + C * 2); voffB[i] = (unsigned)(Rb * KB + C * 2); }
    const size_t kstep = (size_t)(BK * 2);
    const size_t hstep = (size_t)HALF * KB;
    const unsigned ldsw = (unsigned)wid * 1024u;
    const int aoff = lds_byte(wr * 64 + fr, fq * 8), boff = lds_byte(wc * 32 + fr, fq * 8);
#define PG8_SA(b, h) (((b) * 2 + (h)) * HTB)
#define PG8_SB(b, h) ((4 + (b) * 2 + (h)) * HTB)
#define PG8_STAGE(bufoff, gbase, voff) do { const char* _gb = uni_ptr((const char*)(gbase)); _Pragma("unroll") for (int _i = 0; _i < 2; ++_i) \
        __builtin_amdgcn_global_load_lds((const unsigned*)(_gb + (voff)[_i]), (LAS unsigned*)(lds + (bufoff) + ldsw + _i * 8192), 16, 0, 0); } while (0)
#define PG8_STAGE_A(bufoff, kb, h, GO) do { if constexpr (GATHER) { PG8_STAGE(bufoff, kb, (GO)[h]); } else { PG8_STAGE(bufoff, (kb) + (h) * hstep, voffA); } } while (0)
#define PG8_LDA(dst, b, h) do { if constexpr (F8) { _Pragma("unroll") for (int m = 0; m < 4; ++m) dst##8[m] = cat8(*(const LAS bf16x8*)(lds + PG8_SA(b, h) + aoff + m * 2048), *(const LAS bf16x8*)(lds + PG8_SA(b, h) + aoff + m * 2048 + 1024)); } else { \
        _Pragma("unroll") for (int m = 0; m < 4; ++m) _Pragma("unroll") for (int k = 0; k < 2; ++k) dst[m][k] = *(const LAS bf16x8*)(lds + PG8_SA(b, h) + aoff + m * 2048 + k * 1024); } } while (0)
#define PG8_LDB(dst, b, h) do { if constexpr (F8) { _Pragma("unroll") for (int n = 0; n < 2; ++n) dst##8[n] = cat8(*(const LAS bf16x8*)(lds + PG8_SB(b, h) + boff + n * 2048), *(const LAS bf16x8*)(lds + PG8_SB(b, h) + boff + n * 2048 + 1024)); } else { \
        _Pragma("unroll") for (int n = 0; n < 2; ++n) _Pragma("unroll") for (int k = 0; k < 2; ++k) dst[n][k] = *(const LAS bf16x8*)(lds + PG8_SB(b, h) + boff + n * 2048 + k * 1024); } } while (0)
#define PG8_MMA(ai, bj, At, Bt) do { __builtin_amdgcn_s_setprio(1); if constexpr (F8) { _Pragma("unroll") for (int m = 0; m < 4; ++m) _Pragma("unroll") for (int n = 0; n < 2; ++n) \
        acc[ai][bj][m][n] = __builtin_amdgcn_mfma_scale_f32_16x16x128_f8f6f4(Bt##8[n], At##8[m], acc[ai][bj][m][n], 0, 0, 0, 0, 0, 0); } else { \
        _Pragma("unroll") for (int m = 0; m < 4; ++m) _Pragma("unroll") for (int n = 0; n < 2; ++n) _Pragma("unroll") for (int k = 0; k < 2; ++k) \
        acc[ai][bj][m][n] = __builtin_amdgcn_mfma_f32_16x16x32_bf16(Bt[n][k], At[m][k], acc[ai][bj][m][n], 0, 0, 0); } __builtin_amdgcn_s_setprio(0); } while (0)
#define PG8_WAIT_V(n) asm volatile("s_waitcnt vmcnt(" #n ")" ::: "memory")
#define PG8_WAIT_L(n) asm volatile("s_waitcnt lgkmcnt(" #n ")" ::: "memory")
#define PG8_BAR __builtin_amdgcn_s_barrier()
#define PG8_SCHED __builtin_amdgcn_sched_barrier(0)
    LAS int* const ibuf = (LAS int*)(lds + STAGE_BYTES + 512);
#define PG8_IDMA(u, b) do { if constexpr (GATHER) { __builtin_amdgcn_global_load_lds((const unsigned*)(S.idx_src(u) + 64 * (wid & 3) + lane), (LAS unsigned*)(ibuf + (b) * 256 + 64 * (wid & 3)), 4, 0, 0); \
        if constexpr (Epi::HAS_GATE) __builtin_amdgcn_global_load_lds((const unsigned*)(E.gidx + (S.idx_src(u) - S.idx) + 64 * (wid & 3) + lane), (LAS unsigned*)(ibuf + 768 + (b) * 256 + 64 * (wid & 3)), 4, 0, 0); } } while (0)
#define PG8_GOFF(dst, u, b) do { if constexpr (GATHER) { int _t = tid; asm volatile("" : "+v"(_t)); const int _nv = S.nvalid(u); _Pragma("unroll") for (int _i = 0; _i < 2; ++_i) { int _R, _C; stage_rc(_t * 16 + _i * 8192, _R, _C); \
        _Pragma("unroll") for (int _h = 0; _h < 2; ++_h) { const int _r = _R + _h * HALF; const unsigned _s = (unsigned)ibuf[(b) * 256 + (_r < _nv ? _r : 0)]; dst[_h][_i] = (_s >> Sched::ROW_SHIFT) * (unsigned)KB + (unsigned)_C * 2u; } } } } while (0)
    Unit cur, nxt; int ui = 0;
    if (!S.next(0, cur)) return;
    f32x4 acc[2][2][4][2];
#pragma unroll
    for (int a = 0; a < 2; ++a)
#pragma unroll
        for (int b = 0; b < 2; ++b)
#pragma unroll
            for (int m = 0; m < 4; ++m)
#pragma unroll
                for (int n = 0; n < 2; ++n) acc[a][b][m][n] = (f32x4){0.f, 0.f, 0.f, 0.f};
    bf16x8 At[4][2], B0[2][2], B1[2][2];
    v8i_t At8[4], B08[2], B18[2];
    unsigned gA[2][2] = {{0u, 0u}, {0u, 0u}}, gN[2][2] = {{0u, 0u}, {0u, 0u}};
    int bsel = 0;
    f32x4 bpre[4] = {(f32x4){0.f, 0.f, 0.f, 0.f}, (f32x4){0.f, 0.f, 0.f, 0.f}, (f32x4){0.f, 0.f, 0.f, 0.f}, (f32x4){0.f, 0.f, 0.f, 0.f}};
    Pend pend; int ppn = 0, pnv = 0, pq = 8, pbuf = 0;
    if constexpr (DEFER) {
#pragma unroll
        for (int q = 0; q < 8; ++q) pend.val[q] = (u32x2){0u, 0u}; }
#define PG8_PSTORE() do { if constexpr (DEFER) { const int _l3 = lane_id_volatile(); const int _nv = (pq < 8) ? pnv : 0; \
        E.store_one(pend.val[0], ibuf + pbuf * 256, ((pq >> 2) & 1) * HALF + (pq & 3) * 16 + wr * 64 + (_l3 & 15), _nv, ppn * HALF + wc * 32 + 8 * (_l3 >> 4)); \
        _Pragma("unroll") for (int _q = 0; _q < 7; ++_q) pend.val[_q] = pend.val[_q + 1]; ++pq; } } while (0)
    if constexpr (GATHER) { PG8_IDMA(cur, 0); PG8_WAIT_V(0); PG8_BAR; }
    PG8_GOFF(gA, cur, 0);
    const char* cA = S.a_base(cur); const char* cB = S.b_base(cur);
    PG8_STAGE(PG8_SB(0, 0), cB, voffB); PG8_STAGE(PG8_SB(0, 1), cB + hstep, voffB); PG8_STAGE_A(PG8_SA(0, 0), cA, 0, gA); PG8_STAGE_A(PG8_SA(0, 1), cA, 1, gA);
    if (wr == 1) PG8_BAR;
    PG8_WAIT_V(2); PG8_BAR;
    PG8_STAGE(PG8_SB(1, 0), cB + kstep, voffB); PG8_STAGE_A(PG8_SA(1, 0), cA + kstep, 0, gA); PG8_STAGE(PG8_SB(1, 1), cB + hstep + kstep, voffB);
    PG8_WAIT_V(6); PG8_BAR;
    for (;;) {
        const bool has_next = S.next(ui + 1, nxt);
        const char* nA = has_next ? S.a_base(nxt) : cA; const char* nB = has_next ? S.b_base(nxt) : cB;
        const int bnxt = (bsel == 2) ? 0 : bsel + 1;
        if constexpr (GATHER) { if (has_next) PG8_IDMA(nxt, bnxt); }
        for (int t = 0; t < nt; t += 2) {
            const bool last = (t == nt - 2);
            const char* a1 = cA + (size_t)(t + 1) * kstep;
            const char* a2 = last ? nA : cA + (size_t)(t + 2) * kstep; const char* b2 = last ? nB : cB + (size_t)(t + 2) * kstep;
            const char* a3 = a2 + kstep; const char* b3 = b2 + kstep;
            if constexpr (GATHER) { if (last && has_next) { PG8_GOFF(gN, nxt, bnxt); } }
            if constexpr (Epi::HAS_BIAS) { if (last) E.load_bias(cur, wc, lane_id_volatile() >> 4, bpre); }
            PG8_LDB(B0, 0, 0); PG8_LDB(B1, 0, 1); PG8_SCHED; PG8_LDA(At, 0, 0); PG8_STAGE_A(PG8_SA(1, 1), a1, 1, gA);
            if constexpr (GATHER) { if (last && has_next) { gA[0][0] = gN[0][0]; gA[0][1] = gN[0][1]; gA[1][0] = gN[1][0]; gA[1][1] = gN[1][1]; } }
            PG8_WAIT_V(8); PG8_WAIT_L(0); PG8_BAR; PG8_MMA(0, 0, At, B0); PG8_MMA(0, 1, At, B1); PG8_BAR; PG8_SCHED;
            PG8_LDA(At, 0, 1); PG8_STAGE(PG8_SB(0, 0), b2, voffB); PG8_STAGE(PG8_SB(0, 1), b2 + hstep, voffB); PG8_STAGE_A(PG8_SA(0, 0), a2, 0, gA);
            PG8_WAIT_V(8); PG8_WAIT_L(0); PG8_BAR; PG8_MMA(1, 0, At, B0); PG8_MMA(1, 1, At, B1); PG8_BAR; PG8_SCHED;
            PG8_PSTORE();
            PG8_LDB(B0, 1, 0); PG8_LDB(B1, 1, 1); PG8_SCHED; PG8_LDA(At, 1, 0); PG8_STAGE_A(PG8_SA(0, 1), a2, 1, gA);
            PG8_WAIT_V(8); PG8_WAIT_L(0); PG8_BAR; PG8_MMA(0, 0, At, B0); PG8_MMA(0, 1, At, B1); PG8_BAR; PG8_SCHED;
            PG8_LDA(At, 1, 1); PG8_STAGE(PG8_SB(1, 0), b3, voffB); PG8_STAGE(PG8_SB(1, 1), b3 + hstep, voffB); PG8_STAGE_A(PG8_SA(1, 0), a3, 0, gA);
            PG8_WAIT_V(8); PG8_WAIT_L(0); PG8_BAR; PG8_MMA(1, 0, At, B0); PG8_MMA(1, 1, At, B1); PG8_BAR; PG8_SCHED;
            PG8_PSTORE();
        }
        if (ALIGN_EPI) { if (wr == 0) PG8_BAR; }
        { const int l2 = lane_id_volatile(), fr2 = l2 & 15, fq2 = l2 >> 4;
          if constexpr (DEFER) { _Pragma("unroll") for (int _f = 0; _f < 8; ++_f) PG8_PSTORE();
              E.prepare(acc, cur, wr, wc, fr2, fq2, pend); ppn = cur.pn; pnv = S.nvalid(cur); pq = 0; pbuf = bsel; }
          else if constexpr (GATHER) E(acc, cur, wr, wc, fr2, fq2, ibuf + bsel * 256, S.nvalid(cur), bpre); else E(acc, cur, wr, wc, fr2, fq2); }
        if (!has_next) break;
#pragma unroll
        for (int a = 0; a < 2; ++a)
#pragma unroll
            for (int b = 0; b < 2; ++b)
#pragma unroll
                for (int m = 0; m < 4; ++m)
#pragma unroll
                    for (int n = 0; n < 2; ++n) acc[a][b][m][n] = (f32x4){0.f, 0.f, 0.f, 0.f};
        cur = nxt; cA = nA; cB = nB; ++ui; bsel = bnxt;
        if (ALIGN_EPI) { if (wr == 1) PG8_BAR; }
    }
    if constexpr (DEFER) { _Pragma("unroll") for (int _f = 0; _f < 8; ++_f) PG8_PSTORE(); }
    PG8_WAIT_V(0);
    if (!ALIGN_EPI) { if (wr == 0) PG8_BAR; }
    PG8_BAR;
#undef PG8_PSTORE
#undef PG8_SA
#undef PG8_SB
#undef PG8_STAGE
#undef PG8_STAGE_A
#undef PG8_LDA
#undef PG8_LDB
#undef PG8_MMA
#undef PG8_WAIT_V
#undef PG8_WAIT_L
#undef PG8_BAR
#undef PG8_SCHED
#undef PG8_GOFF
#undef PG8_IDMA
}
}

namespace attn_body {
using bf16=__hip_bfloat16;
using bf16x8=__attribute__((ext_vector_type(8)))short;
using s16x4=__attribute__((ext_vector_type(4)))short;
using f32x16=__attribute__((ext_vector_type(16)))float;
using u32x4=__attribute__((ext_vector_type(4)))unsigned;
constexpr int D=64;
constexpr int NW=8,QBLK=32,QB=QBLK*NW,KVBLK=64;
constexpr int ATTN_UNIT_ROWS=QB;
__device__ __forceinline__ int crow(int r,int hi){return (r&3)+8*(r>>2)+4*hi;}
#define SBAR() __builtin_amdgcn_sched_barrier(0)
__device__ __forceinline__ void cmask(f32x16&p0,f32x16&p1,int jb,int qrel,int hi){
  const float NEG=-INFINITY; int kb=64*jb+4*hi;
  #pragma unroll
  for(int r=0;r<16;++r){int kv=kb+(r&3)+8*(r>>2); if(kv>qrel)p0[r]=NEG; if(kv+32>qrel)p1[r]=NEG;}
}

constexpr int NSLOT=3, SLOTB=8192;
constexpr int LDS_K=0, LDS_V=NSLOT*SLOTB, LDS_WS=2*NSLOT*SLOTB, LDS_OST=LDS_WS+NW*64*4, LDS_BYTES=LDS_OST+NW*4096;
constexpr float C2=0.125f*1.4426950408889634f;
__device__ __forceinline__ void glds16(const void*gsrc,unsigned lds_dst){unsigned keep;
  asm volatile("s_mov_b32 %0, m0\n\ts_mov_b32 m0, %2\n\ts_nop 0\n\tglobal_load_lds_dwordx4 %1, off\n\ts_mov_b32 m0, %0":"=&s"(keep):"v"(gsrc),"s"(lds_dst):"memory");}
__device__ __forceinline__ float max3f(float a,float b,float c){float r;asm("v_max3_f32 %0, %1, %2, %3":"=v"(r):"v"(a),"v"(b),"v"(c));return r;}
__device__ __forceinline__ float max2f(float a,float b){float r;asm("v_max_f32_e32 %0, %1, %2":"=v"(r):"v"(a),"v"(b));return r;}
__device__ __forceinline__ float fadd_s(float a,float b){float r;asm("v_add_f32_e32 %0, %1, %2":"=v"(r):"v"(a),"v"(b));return r;}
__device__ __forceinline__ float fsub_s(float a,float b){float r;asm("v_sub_f32_e32 %0, %1, %2":"=v"(r):"v"(a),"v"(b));return r;}
typedef float f32x2_t __attribute__((ext_vector_type(2))); typedef __bf16 bf16x2_t __attribute__((ext_vector_type(2)));
__device__ __forceinline__ unsigned cvtpk_s(float lo,float hi){f32x2_t v={lo,hi};bf16x2_t b=__builtin_convertvector(v,bf16x2_t);return __builtin_bit_cast(unsigned,b);}
#define WAIT_BAR(N) asm volatile("s_waitcnt vmcnt(" #N ") lgkmcnt(0)\n\ts_barrier":::"memory")

__device__ __forceinline__ void qkt(f32x16&p0,f32x16&p1,const char*Kslot,const bf16x8*qr,const f32x16&negm,int r32,int hi){
  const char*kb=Kslot+hi*1024+r32*16;
  #pragma unroll
  for(int d0=0;d0<4;++d0){
    const bf16x8 b0=*reinterpret_cast<const bf16x8*>(kb+d0*2048);
    const bf16x8 b1=*reinterpret_cast<const bf16x8*>(kb+d0*2048+512);
    if(d0==0){p0=__builtin_amdgcn_mfma_f32_32x32x16_bf16(b0,qr[0],negm,0,0,0);p1=__builtin_amdgcn_mfma_f32_32x32x16_bf16(b1,qr[0],negm,0,0,0);}
    else{p0=__builtin_amdgcn_mfma_f32_32x32x16_bf16(b0,qr[d0],p0,0,0,0);p1=__builtin_amdgcn_mfma_f32_32x32x16_bf16(b1,qr[d0],p1,0,0,0);}}
}
typedef __attribute__((address_space(3))) const char* lds_cptr;
typedef short v4i16_t __attribute__((ext_vector_type(4)));
__device__ __forceinline__ void kload8(bf16x8*kf,lds_cptr kp){
  kf[0]=*(const __attribute__((address_space(3))) bf16x8*)(kp);      kf[1]=*(const __attribute__((address_space(3))) bf16x8*)(kp+512);
  kf[2]=*(const __attribute__((address_space(3))) bf16x8*)(kp+2048); kf[3]=*(const __attribute__((address_space(3))) bf16x8*)(kp+2560);
  kf[4]=*(const __attribute__((address_space(3))) bf16x8*)(kp+4096); kf[5]=*(const __attribute__((address_space(3))) bf16x8*)(kp+4608);
  kf[6]=*(const __attribute__((address_space(3))) bf16x8*)(kp+6144); kf[7]=*(const __attribute__((address_space(3))) bf16x8*)(kp+6656);
}
__device__ __forceinline__ void kload2(bf16x8*kf,lds_cptr kp,int j){ kf[2*j]=*(const __attribute__((address_space(3))) bf16x8*)(kp+j*2048); kf[2*j+1]=*(const __attribute__((address_space(3))) bf16x8*)(kp+j*2048+512); }
__device__ __forceinline__ s16x4 vtr(lds_cptr p){ return __builtin_bit_cast(s16x4,__builtin_amdgcn_ds_read_tr16_b64_v4i16((__attribute__((address_space(3))) v4i16_t*)p)); }
__device__ __forceinline__ float rowmax(const f32x16&p0,const f32x16&p1){
  float a=max3f(p0[0],p0[1],p1[0]),b=max3f(p0[2],p0[3],p1[1]);a=max3f(a,p1[2],p1[3]);
  #pragma unroll
  for(int r=4;r<16;r+=4){a=max3f(a,p0[r],p0[r+1]);b=max3f(b,p0[r+2],p0[r+3]);a=max3f(a,p1[r],p1[r+1]);b=max3f(b,p1[r+2],p1[r+3]);}
  const float m=max2f(a,b);
  auto rr=__builtin_amdgcn_permlane32_swap(__float_as_uint(m),__float_as_uint(m),false,false);
  return max2f(__uint_as_float(rr[0]),__uint_as_float(rr[1]));
}
__device__ __forceinline__ void pv(f32x16*o,int vb,bf16x8 pa0,bf16x8 pa1,bf16x8 pa2,bf16x8 pa3){
  #pragma unroll
  for(int d0=0;d0<2;++d0){s16x4 lo[4],hi[4];
    #pragma unroll
    for(int ks=0;ks<4;++ks){
      asm volatile("ds_read_b64_tr_b16 %0,%1 offset:%c2":"=&v"(lo[ks]):"v"(vb),"i"(d0*4096+ks*1024):"memory");
      asm volatile("ds_read_b64_tr_b16 %0,%1 offset:%c2":"=&v"(hi[ks]):"v"(vb),"i"(d0*4096+ks*1024+512):"memory");}
    asm volatile("s_waitcnt lgkmcnt(0)":::"memory");SBAR();
    #define PK(k) (bf16x8){lo[k][0],lo[k][1],lo[k][2],lo[k][3],hi[k][0],hi[k][1],hi[k][2],hi[k][3]}
    o[d0]=__builtin_amdgcn_mfma_f32_32x32x16_bf16(pa0,PK(0),o[d0],0,0,0);
    o[d0]=__builtin_amdgcn_mfma_f32_32x32x16_bf16(pa1,PK(1),o[d0],0,0,0);
    o[d0]=__builtin_amdgcn_mfma_f32_32x32x16_bf16(pa2,PK(2),o[d0],0,0,0);
    o[d0]=__builtin_amdgcn_mfma_f32_32x32x16_bf16(pa3,PK(3),o[d0],0,0,0);
    #undef PK
  }
}

#ifndef ATTN_STORE16
#define ATTN_STORE16(p,v) (*(u32x4*)(p)=(v))
#endif
template<int THRL, bool O8 = false> __device__ __forceinline__ void attn_unit(const bf16*Qu,const bf16*__restrict__ Kh,const bf16*__restrict__ Vh,bf16*Ou,const int QP,const int KP,const int VP,const int OP,const int NT,char*shm,const int tid){
  const int lane=tid&63,r32=lane&31,hi=lane>>5; const int wid=__builtin_amdgcn_readfirstlane(tid>>6);
  const bf16*Qw=Qu+(long)(wid*QBLK)*QP;
  const unsigned lds0=(unsigned)(uintptr_t)shm;
  float*wsf=(float*)(shm+LDS_WS)+wid*64;
  const bf16*ksrc=Kh+(long)lane*KP+wid*8;
  const bf16*vsrc=Vh+(long)(16*(wid&3)+(lane>>2))*VP+(wid>>2)*32+(lane&3)*8;
  const unsigned kdst=lds0+LDS_K+wid*1024, vdst=lds0+LDS_V+wid*1024;
  #define DMA_K(t,slot) glds16(ksrc+(long)(t)*KVBLK*KP,(unsigned)__builtin_amdgcn_readfirstlane(kdst+(slot)))
  #define DMA_V(t,slot) glds16(vsrc+(long)(t)*KVBLK*VP,(unsigned)__builtin_amdgcn_readfirstlane(vdst+(slot)))
  const int vb0=(int)(lds0+LDS_V)+((lane>>4)&1)*32+(lane&3)*8+(4*hi+((lane&15)>>2))*64;
  const char*Kbase=shm+LDS_K; bf16x8 kf[8];
  const lds_cptr shm3=(lds_cptr)shm; const lds_cptr kp0=shm3+LDS_K+hi*1024+r32*16; const lds_cptr vp0=shm3+LDS_V+((lane>>4)&1)*32+(lane&3)*8+(4*hi+((lane&15)>>2))*64;
  DMA_K(0,0);DMA_V(0,0);DMA_K(1,SLOTB);
  bf16x8 qr[4];
  #pragma unroll
  for(int d0=0;d0<4;++d0)qr[d0]=*reinterpret_cast<const bf16x8*>(&Qw[(long)r32*QP+d0*16+hi*8]);
  float mhat=0.f,l_reg=0.f;f32x16 o[2];f32x16 negm; { float z_=0.f; asm volatile("":"+v"(z_)); _Pragma("unroll") for(int r=0;r<16;++r){o[0][r]=z_;o[1][r]=z_;negm[r]=z_;} } asm volatile("":"+v"(negm));
  #define CMASK(P0,P1,t) do{}while(0)
  bool resc=false;
  #define START(P0,P1) do{ const float rm=rowmax(P0,P1); resc=false; \
    { const float dl=rm; mhat=fadd_s(mhat,dl); \
      _Pragma("unroll") for(int r=0;r<16;++r){P0[r]=fsub_s(P0[r],dl);P1[r]=fsub_s(P1[r],dl);} \
      _Pragma("unroll") for(int r=0;r<16;++r)negm[r]=-mhat; asm volatile("":"+v"(negm)); } \
    _Pragma("unroll") for(int r=0;r<16;++r)P0[r]=__builtin_amdgcn_exp2f(P0[r]); }while(0)
  #define RESC() do{ if(resc){ asm volatile("s_waitcnt lgkmcnt(0)":::"memory"); \
      _Pragma("unroll") for(int d_=0;d_<2;++d_) _Pragma("unroll") for(int r=0;r<16;++r)o[d_][r]*=wsf[crow(r,hi)]; } }while(0)
  f32x16 pA0,pA1,pB0,pB1;
  int sl_prev=0,sl_cur=0,sl_next=SLOTB;
  #define ROT() do{sl_prev=sl_cur;sl_cur=sl_next;sl_next=(sl_next==(NSLOT-1)*SLOTB)?0:sl_next+SLOTB;}while(0)
  DMA_K(2,2*SLOTB);
  WAIT_BAR(3);
  qkt(pA0,pA1,Kbase,qr,negm,r32,hi);asm volatile("s_nop 15\n\ts_nop 7":"+v"(pA0),"+v"(pA1));CMASK(pA0,pA1,0);
  START(pA0,pA1);
  _Pragma("unroll") for(int r=0;r<16;++r)pA1[r]=__builtin_amdgcn_exp2f(pA1[r]);
  WAIT_BAR(0);
  DMA_K(3,0);DMA_V(1,SLOTB);
  ROT();
  kload8(kf,kp0+sl_cur);
  WAIT_BAR(2);
  s16x4 vlo[8],vhi[8]; u32x4 pw0,pw1,pw2,pw3;
  #define PKW(P,B) cvtpk_s(P[B],P[B+1])
  #define PAF(k) __builtin_bit_cast(bf16x8,pw##k)
  #define VFR(i) (bf16x8){vlo[i][0],vlo[i][1],vlo[i][2],vlo[i][3],vhi[i][0],vhi[i][1],vhi[i][2],vhi[i][3]}
  #define PIN(x) asm volatile("":"+v"(x))
  #define MX3(a,b,c) __builtin_fmaxf(__builtin_fmaxf((a),(b)),(c))
  #define GAPA(MF,A0,A1,A2,A3,W0,W1,PW) do{ MF; sacc+=A0; sacc+=A1; sacc+=A2; sacc+=A3; PIN(sacc); W0; W1; PIN(PW); SBAR(); }while(0)
  #define EX(v) __builtin_amdgcn_exp2f(v)
  #define GAPB(MF,X,B) do{ MF; X[B]=EX(X[B]); X[B+1]=EX(X[B+1]); X[B+2]=EX(X[B+2]); X[B+3]=EX(X[B+3]); PIN(X); SBAR(); }while(0)
  #define VRD(i) do{ vlo[i]=vtr(vp_+(((i)>>2)*4096+((i)&3)*1024)); vhi[i]=vtr(vp_+(((i)>>2)*4096+((i)&3)*1024+512)); }while(0)
  #define KRD(G,j) do{ if(G){ kload2(kf,kp0+sl_next,j); SBAR(); } }while(0)
  #define STEP(C0,C1,P0,P1,t,GK,GV,GL) do{ SBAR(); \
    const lds_cptr vp_=vp0+sl_prev; \
    VRD(0); SBAR(); float sacc=(P0[0]+P0[1]); \
    GAPA(C0=__builtin_amdgcn_mfma_f32_32x32x16_bf16(kf[0],qr[0],negm,0,0,0), P0[2],P0[3],P0[4],P0[5],     pw0[0]=PKW(P0,0), pw0[1]=PKW(P0,2), pw0); \
    VRD(4); SBAR(); GAPA(C1=__builtin_amdgcn_mfma_f32_32x32x16_bf16(kf[1],qr[0],negm,0,0,0), P0[6],P0[7],P0[8],P0[9],     pw0[2]=PKW(P0,4), pw0[3]=PKW(P0,6), pw0); \
    VRD(1); SBAR(); GAPA(C0=__builtin_amdgcn_mfma_f32_32x32x16_bf16(kf[2],qr[1],C0,0,0,0),   P0[10],P0[11],P0[12],P0[13], pw1[0]=PKW(P0,8), pw1[1]=PKW(P0,10), pw1); \
    VRD(5); SBAR(); GAPA(C1=__builtin_amdgcn_mfma_f32_32x32x16_bf16(kf[3],qr[1],C1,0,0,0),   P0[14],P0[15],P1[0],P1[1],   pw1[2]=PKW(P0,12),pw1[3]=PKW(P0,14), pw1); \
    VRD(2); SBAR(); GAPA(C0=__builtin_amdgcn_mfma_f32_32x32x16_bf16(kf[4],qr[2],C0,0,0,0),   P1[2],P1[3],P1[4],P1[5],     pw2[0]=PKW(P1,0), pw2[1]=PKW(P1,2), pw2); \
    VRD(6); SBAR(); GAPA(C1=__builtin_amdgcn_mfma_f32_32x32x16_bf16(kf[5],qr[2],C1,0,0,0),   P1[6],P1[7],P1[8],P1[9],     pw2[2]=PKW(P1,4), pw2[3]=PKW(P1,6), pw2); \
    VRD(3); SBAR(); GAPA(C0=__builtin_amdgcn_mfma_f32_32x32x16_bf16(kf[6],qr[3],C0,0,0,0),   P1[10],P1[11],P1[12],P1[13], pw3[0]=PKW(P1,8), pw3[1]=PKW(P1,10), pw3); \
    VRD(7); SBAR(); GAPA(C1=__builtin_amdgcn_mfma_f32_32x32x16_bf16(kf[7],qr[3],C1,0,0,0),   P1[14],P1[15],0.f,0.f,       pw3[2]=PKW(P1,12),pw3[3]=PKW(P1,14), pw3); \
    l_reg+=sacc; \
    if(GK){DMA_K((t)+3,sl_cur);} if(GV){DMA_V((t)+1,sl_next);} \
    CMASK(C0,C1,t); \
    { float a=MX3(C0[0],C0[1],C1[0]),b=MX3(C0[2],C0[3],C1[1]); a=MX3(a,C1[2],C1[3]); \
      _Pragma("unroll") for(int r=4;r<16;r+=4){a=MX3(a,C0[r],C0[r+1]);b=MX3(b,C0[r+2],C0[r+3]);a=MX3(a,C1[r],C1[r+1]);b=MX3(b,C1[r+2],C1[r+3]);} \
      float rm=__builtin_fmaxf(a,b); { auto rr=__builtin_amdgcn_permlane32_swap(__float_as_uint(rm),__float_as_uint(rm),false,false); rm=__builtin_fmaxf(__uint_as_float(rr[0]),__uint_as_float(rr[1])); } \
      resc=false; \
      if(__builtin_expect(__any(rm>(float)THRL),0)){ const float dl=__builtin_fmaxf(rm,0.f); mhat+=dl; \
        _Pragma("unroll") for(int r=0;r<16;++r){C0[r]-=dl;C1[r]-=dl;} \
        _Pragma("unroll") for(int r=0;r<16;++r)negm[r]=-mhat; asm volatile("":"+v"(negm)); \
        const float f=__builtin_amdgcn_exp2f(-dl); l_reg*=f; if(hi==0)wsf[r32]=f; resc=true; } } \
    SBAR(); \
    GAPB(o[0]=__builtin_amdgcn_mfma_f32_32x32x16_bf16(PAF(0),VFR(0),o[0],0,0,0), C0,0); \
    GAPB(o[1]=__builtin_amdgcn_mfma_f32_32x32x16_bf16(PAF(0),VFR(4),o[1],0,0,0), C0,4); \
    KRD(GL,0); GAPB(o[0]=__builtin_amdgcn_mfma_f32_32x32x16_bf16(PAF(1),VFR(1),o[0],0,0,0), C0,8); \
    KRD(GL,1); GAPB(o[1]=__builtin_amdgcn_mfma_f32_32x32x16_bf16(PAF(1),VFR(5),o[1],0,0,0), C0,12); \
    KRD(GL,2); GAPB(o[0]=__builtin_amdgcn_mfma_f32_32x32x16_bf16(PAF(2),VFR(2),o[0],0,0,0), C1,0); \
    KRD(GL,3); GAPB(o[1]=__builtin_amdgcn_mfma_f32_32x32x16_bf16(PAF(2),VFR(6),o[1],0,0,0), C1,4); \
    GAPB(o[0]=__builtin_amdgcn_mfma_f32_32x32x16_bf16(PAF(3),VFR(3),o[0],0,0,0), C1,8); \
    GAPB(o[1]=__builtin_amdgcn_mfma_f32_32x32x16_bf16(PAF(3),VFR(7),o[1],0,0,0), C1,12); \
    }while(0)
  int t=1;
  #undef CMASK
  #define CMASK(P0,P1,t) do{}while(0)
  for(;t+5<NT;t+=2){
    STEP(pB0,pB1,pA0,pA1,t,true,true,true);     WAIT_BAR(2); RESC(); ROT();
    STEP(pA0,pA1,pB0,pB1,t+1,true,true,true);   WAIT_BAR(2); RESC(); ROT();
  }
  #undef CMASK
  #define CMASK(P0,P1,t) do{}while(0)
  #define ENDW(tt) do{ if((tt)+3<NT){WAIT_BAR(2);} else if((tt)+2<NT){WAIT_BAR(1);} else {WAIT_BAR(0);} }while(0)
  for(;t+1<NT;t+=2){
    STEP(pB0,pB1,pA0,pA1,t,(t+3<NT),(t+1<NT),(t+1<NT));       ENDW(t);   RESC(); ROT();
    STEP(pA0,pA1,pB0,pB1,t+1,(t+4<NT),(t+2<NT),(t+2<NT));     ENDW(t+1); RESC(); ROT();
  }
  STEP(pB0,pB1,pA0,pA1,NT-1,false,false,false); RESC();
  { float sacc=pB0[0]+pB0[1]; _Pragma("unroll") for(int r=2;r<16;++r)sacc+=pB0[r]; _Pragma("unroll") for(int r=0;r<16;++r)sacc+=pB1[r]; l_reg+=sacc;
    pw0=(u32x4){PKW(pB0,0),PKW(pB0,2),PKW(pB0,4),PKW(pB0,6)};pw1=(u32x4){PKW(pB0,8),PKW(pB0,10),PKW(pB0,12),PKW(pB0,14)};pw2=(u32x4){PKW(pB1,0),PKW(pB1,2),PKW(pB1,4),PKW(pB1,6)};pw3=(u32x4){PKW(pB1,8),PKW(pB1,10),PKW(pB1,12),PKW(pB1,14)};
    SBAR(); pv(o,vb0+sl_cur,PAF(0),PAF(1),PAF(2),PAF(3)); }
  #undef PKW
  #undef PAF
  #undef VFR
  #undef PIN
  #undef MX3
  #undef GAPA
  #undef GAPB
  #undef EX
  #undef VRD
  #undef KRD
  #undef STEP
  #undef ENDW
  {auto rr=__builtin_amdgcn_permlane32_swap(__float_as_uint(l_reg),__float_as_uint(l_reg),false,false);l_reg=__uint_as_float(rr[0])+__uint_as_float(rr[1]);}
  if(hi==0)wsf[32+r32]=l_reg;asm volatile("s_waitcnt lgkmcnt(0)":::"memory");
  float rli[16];
  #pragma unroll
  for(int r=0;r<16;++r)rli[r]=__builtin_amdgcn_rcpf(wsf[32+crow(r,hi)]);
  if constexpr (O8) {
    unsigned char*Ow8=(unsigned char*)Ou+(long)(wid*QBLK)*OP; unsigned char*stg8=(unsigned char*)(shm+LDS_OST)+wid*2048;
    #pragma unroll
    for(int r=0;r<16;++r){const int orow=crow(r,hi);
      #pragma unroll
      for(int d0=0;d0<2;++d0)stg8[orow*64+d0*32+r32]=f2fp8(o[d0][r]*rli[r]);}
    asm volatile("s_waitcnt lgkmcnt(0)":::"memory");
    #pragma unroll
    for(int i=0;i<2;++i){const int row=i*16+(lane>>2),ch=lane&3; const u32x4 v=*(const u32x4*)(stg8+row*64+ch*16); ATTN_STORE16(Ow8+(long)row*OP+ch*16,v);}
  } else {
  bf16*Ow=Ou+(long)(wid*QBLK)*OP;
  { bf16*stg=(bf16*)(shm+LDS_OST)+wid*2048;
    #pragma unroll
    for(int r=0;r<16;++r){const int orow=crow(r,hi);
      #pragma unroll
      for(int d0=0;d0<2;++d0)stg[orow*64+d0*32+r32]=__float2bfloat16(o[d0][r]*rli[r]);}
    asm volatile("s_waitcnt lgkmcnt(0)":::"memory");
    #pragma unroll
    for(int i=0;i<4;++i){const int row=i*8+(lane>>3),ch=lane&7; const u32x4 v=*(const u32x4*)(stg+row*64+ch*8); ATTN_STORE16(Ow+(long)row*OP+ch*8,v);} }
  }
  asm volatile("s_waitcnt lgkmcnt(0)\n\ts_barrier":::"memory");
  #undef DMA_K
  #undef DMA_V
  #undef CMASK
  #undef START
  #undef RESC
  #undef ROT
}
constexpr int ATTN_LDS_BYTES=LDS_BYTES;
#undef SBAR
#undef WAIT_BAR
}

struct Args { const float* in[32]; float* out; unsigned char* ws; int ph_lo, ph_hi; };
struct Ctx {
    LAS unsigned char* lds;
    int vcu, G;
    unsigned char* ws;
};
constexpr int PTAB_OFF = MISC_OFF + 256;
__device__ __forceinline__ unsigned long long ptab_get(const Ctx& cx, int k) {
    const LAS unsigned* t = (const LAS unsigned*)(cx.lds + PTAB_OFF) + 2 * k; const unsigned lo = __builtin_amdgcn_readfirstlane(t[0]), hi = __builtin_amdgcn_readfirstlane(t[1]);
    return ((unsigned long long)hi << 32) | lo;
}
#define INP(k) ((const float*)(GAS const float*)ptab_get(cx, (k)))

template <bool F8> __device__ __forceinline__ void p0_transpose64(const float* W, int N, int KB, unsigned char* WT, int k0, int n0, int dst_row0, float scale, LAS float* scr, int lane) {
    f32x4 v[16];
    const float* src = W + (size_t)(k0 + (lane >> 4)) * N + n0 + (lane & 15) * 4;
#pragma unroll
    for (int i = 0; i < 16; ++i) v[i] = __builtin_nontemporal_load((const f32x4*)(src + (size_t)(4 * i) * N));
#pragma unroll
    for (int i = 0; i < 16; ++i) { LAS float* p = scr + (4 * i + (lane >> 4)) * 65 + (lane & 15) * 4; p[0] = v[i][0]; p[1] = v[i][1]; p[2] = v[i][2]; p[3] = v[i][3]; }
    LDS_WAIT(); asm volatile("" ::: "memory");
    if constexpr (!F8) {
        const int ns = lane >> 3, ch = lane & 7;
#pragma unroll
        for (int r8 = 0; r8 < 8; ++r8) { const int n = r8 * 8 + ns; const LAS float* s = scr + (8 * ch) * 65 + n;
            u32x4 o; o.x = pk2(s[0 * 65], s[1 * 65]); o.y = pk2(s[2 * 65], s[3 * 65]); o.z = pk2(s[4 * 65], s[5 * 65]); o.w = pk2(s[6 * 65], s[7 * 65]);
            *(GAS u32x4*)(WT + (size_t)(dst_row0 + n) * KB + (k0 + 8 * ch) * 2) = o; }
    } else {
        const int ns = lane >> 2, ch = lane & 3;
#pragma unroll
        for (int r4 = 0; r4 < 4; ++r4) { const int n = r4 * 16 + ns; const LAS float* s = scr + (16 * ch) * 65 + n; unsigned w[4];
#pragma unroll
            for (int q = 0; q < 4; ++q) { int r = 0; r = __builtin_amdgcn_cvt_pk_fp8_f32(s[(4 * q) * 65] * scale, s[(4 * q + 1) * 65] * scale, r, false); r = __builtin_amdgcn_cvt_pk_fp8_f32(s[(4 * q + 2) * 65] * scale, s[(4 * q + 3) * 65] * scale, r, true); w[q] = (unsigned)r; }
            *(GAS u32x4*)(WT + (size_t)(dst_row0 + n) * KB + k0 + 16 * ch) = (u32x4){w[0], w[1], w[2], w[3]}; }
    }
    LDS_WAIT(); asm volatile("" ::: "memory");
}
__device__ __forceinline__ void p0_prologue(const Ctx& cx, const int tid) {
    const int lane = tid & 63, wave = __builtin_amdgcn_readfirstlane(tid >> 6);
    LAS float* scr = (LAS float*)(cx.lds + wave * 16896);
    const int gw = cx.vcu * 8 + wave, NGW = cx.G * 8;
    constexpr int I_WIN0 = 16 * 40, I_WIN1 = 16 * 24, I_WKV = 16 * 8, I_WOUT = 16 * 16, I_W1 = 16 * 32, I_W2 = 16 * 16;
    constexpr int T_WIN = 3 * I_WIN0 + I_WIN1, T_WKV = 4 * I_WKV, T_WOUT = 4 * I_WOUT, T_W1 = 128 * I_W1, T_W2 = 128 * I_W2;
    constexpr int NITEMS = T_WIN + T_WKV + T_WOUT + T_W1 + T_W2;
    for (int it = gw; it < NITEMS; it += NGW) {
        int r = it;
        const float* W; unsigned char* WT; int N, nb, kb, dst_row0; bool isout = false;
        if (r < T_W1) {
            const int mi = r / I_W1, q = r % I_W1; N = 2048; kb = q / 32; nb = q % 32;
            W = INP(28) + (size_t)mi * 1024 * 2048; WT = cx.ws + WS_W1 + (size_t)mi * 2048 * 1024 * MOE_EB;
            const int n0 = nb * 64, isu = n0 >= 1024, j = n0 - isu * 1024;
            dst_row0 = (j >> 7) * 256 + isu * 128 + (j & 127);
            p0_transpose64<MOE_F8>(W, N, 1024 * MOE_EB, WT, kb * 64, nb * 64, dst_row0, W1_SCALE, scr, lane); continue;
        } else if ((r -= T_W1) < T_W2) {
            const int mi = r / I_W2, q = r % I_W2; N = 1024; kb = q / 16; nb = q % 16;
            W = INP(30) + (size_t)mi * 1024 * 1024; WT = cx.ws + WS_W2 + (size_t)mi * 1024 * 1024 * MOE_EB; dst_row0 = nb * 64;
            p0_transpose64<MOE_F8>(W, N, 1024 * MOE_EB, WT, kb * 64, nb * 64, dst_row0, W2_SCALE, scr, lane); continue;
        } else if ((r -= T_W2) < T_WIN) {
            int l, q;
            if (r < I_WIN0) { l = 0; q = r; } else if (r < I_WIN0 + I_WIN1) { l = 1; q = r - I_WIN0; } else if (r < 2 * I_WIN0 + I_WIN1) { l = 2; q = r - I_WIN0 - I_WIN1; } else { l = 3; q = r - 2 * I_WIN0 - I_WIN1; }
            N = in_width(l); const int nbn = N / 64; kb = q / nbn; nb = q % nbn;
            const int kind = layer_kind(l), j = layer_j(l);
            W = (kind == 0 ? INP(2) : kind == 1 ? INP(4) : INP(7)) + (size_t)j * 1024 * N;
            WT = cx.ws + WS_WIN + (size_t)l * 5 * MiB; dst_row0 = nb * 64;
        } else if ((r -= T_WIN) < T_WKV) {
            const int l = r / I_WKV, q = r % I_WKV; N = 512; kb = q / 8; nb = q % 8;
            W = INP(20) + (size_t)l * 1024 * 512; WT = cx.ws + WS_WKV; dst_row0 = l * 512 + nb * 64;
        } else {
            r -= T_WKV; const int l = r / I_WOUT, q = r % I_WOUT; N = 1024; kb = q / 16; nb = q % 16;
            W = INP(21) + (size_t)l * 1024 * 1024; WT = cx.ws + WS_WOUT + (size_t)l * 2 * MiB; dst_row0 = nb * 64; isout = true;
        }
        if (isout) p0_transpose64<OUTP_F8 != 0>(W, N, 1024 * OUT_EB, WT, kb * 64, nb * 64, dst_row0, OUTP_F8 ? WOUT_SCALE : 1.0f, scr, lane);
        else p0_transpose64<INP_F8 != 0>(W, N, 1024 * INP_EB, WT, kb * 64, nb * 64, dst_row0, INP_F8 ? WIN_SCALE : 1.0f, scr, lane);
    }
    {
        const size_t gt = (size_t)cx.vcu * 512 + tid, NT_ = (size_t)cx.G * 512;
        for (int which = 0; which < 2; ++which) {
            const f32x4* xs = (const f32x4*)(which == 0 ? INP(0) : INP(1)); unsigned char* xd = cx.ws + (which == 0 ? WS_XB : WS_MEMB); const size_t n8 = (size_t)(which == 0 ? NTOK : NMEM) * DM / 8;
#pragma unroll 4
            for (size_t i = gt; i < n8; i += NT_) { const f32x4 a = __builtin_nontemporal_load(xs + 2 * i), b = __builtin_nontemporal_load(xs + 2 * i + 1);
                if constexpr (INP_F8) { int w0 = 0, w1 = 0; w0 = __builtin_amdgcn_cvt_pk_fp8_f32(a[0], a[1], w0, false); w0 = __builtin_amdgcn_cvt_pk_fp8_f32(a[2], a[3], w0, true); w1 = __builtin_amdgcn_cvt_pk_fp8_f32(b[0], b[1], w1, false); w1 = __builtin_amdgcn_cvt_pk_fp8_f32(b[2], b[3], w1, true);
                    *(u32x2*)(xd + i * 8) = (u32x2){(unsigned)w0, (unsigned)w1}; }
                else { u32x4 o; o.x = pk2(a[0], a[1]); o.y = pk2(a[2], a[3]); o.z = pk2(b[0], b[1]); o.w = pk2(b[2], b[3]); *(u32x4*)(xd + i * 16) = o; } }
        }
    }
    { const float* rwp = INP(26); unsigned short* RW = (unsigned short*)(cx.ws + WS_RW);
      for (int i = cx.vcu * 512 + tid; i < 4 * 32768; i += cx.G * 512) { const int l = i >> 15, r = i & 32767, k = r >> 5, e = r & 31; const float w = rwp[i]; const unsigned hi = f2bf(w); const float wl = w - bf2f((unsigned short)hi);
          RW[((size_t)(l * 2 + 0) * 32 + e) * 1024 + k] = (unsigned short)hi; RW[((size_t)(l * 2 + 1) * 32 + e) * 1024 + k] = (unsigned short)f2bf(wl); } }
    {
        const float *fw1 = INP(10), *fb1 = INP(11), *fw2 = INP(12), *fb2 = INP(13), *fw3 = INP(14), *fb3 = INP(15), *fw4 = INP(16), *fb4 = INP(17), *ffr = INP(18);
        LAS float* z = (LAS float*)cx.lds; LAS float* h1 = z + 16 * 33; LAS float* h2 = h1 + 1024; LAS float* h3 = h2 + 1024;
        float* HRAWT = (float*)(cx.ws + WS_HRAWT); float* HPART = (float*)(cx.ws + WS_HPART);
        for (int it = cx.vcu; it < 256; it += cx.G) {
            __syncthreads();
            const int pos0 = it * 16;
            for (int i = tid; i < 16 * 33; i += 512) { const int p = i / 33, f = i % 33; const float pos = (float)(pos0 + p); float v;
                if (f == 0) v = pos / 4095.0f;
                else { const int k = (f - 1) & 15; const float fb = 1e-4f + (float)k * ((15.0f - 1e-4f) / 15.0f); const float ang = (6.283185307179586f * pos / 4096.0f) * fb; v = (f <= 16) ? cosf(ang) : -sinf(ang); }
                z[i] = v; }
            __syncthreads();
            for (int i = tid; i < 1024; i += 512) { const int p = i >> 6, o = i & 63; float a = fb1[o]; for (int f = 0; f < 33; ++f) a += z[p * 33 + f] * fw1[f * 64 + o]; h1[i] = sinf(ffr[o] * a); }
            __syncthreads();
            for (int i = tid; i < 1024; i += 512) { const int p = i >> 6, o = i & 63; float a = fb2[o]; for (int k = 0; k < 64; ++k) a += h1[p * 64 + k] * fw2[k * 64 + o]; h2[i] = sinf(ffr[o] * a); }
            __syncthreads();
            for (int i = tid; i < 1024; i += 512) { const int p = i >> 6, o = i & 63; float a = fb3[o]; for (int k = 0; k < 64; ++k) a += h2[p * 64 + k] * fw3[k * 64 + o]; h3[i] = sinf(ffr[o] * a); }
            __syncthreads();
            for (int col = tid; col < 3072; col += 512) {
                float a[16]; const float bb = fb4[col];
#pragma unroll
                for (int p = 0; p < 16; ++p) a[p] = bb;
                for (int k = 0; k < 64; ++k) { const float w = fw4[(size_t)k * 3072 + col];
#pragma unroll
                    for (int p = 0; p < 16; ++p) a[p] += h3[p * 64 + k] * w; }
                const int c = col % 768; const float mind = -3.0701134573253945f, maxd = -15.350567286626972f;
                const float delta = fabsf(mind + (maxd - mind) * ((float)c / 767.0f)); float asum = 0.f;
#pragma unroll
                for (int p = 0; p < 16; ++p) { const float t = (float)(pos0 + p) / 4095.0f; a[p] *= expf(-t * delta); asum += fabsf(a[p]); }
                f32x4* dst = (f32x4*)(HRAWT + (size_t)col * 4096 + pos0);
#pragma unroll
                for (int q = 0; q < 4; ++q) dst[q] = (f32x4){a[4 * q], a[4 * q + 1], a[4 * q + 2], a[4 * q + 3]};
                HPART[(size_t)it * 3072 + col] = asum;
            }
        }
    }
}

__device__ __forceinline__ s16x4 vtr(const LAS unsigned char* p) { typedef short v4i16_t __attribute__((ext_vector_type(4))); return __builtin_bit_cast(s16x4, __builtin_amdgcn_ds_read_tr16_b64_v4i16((LAS v4i16_t*)p)); }
__device__ __forceinline__ void na_phase(const Ctx& cx, const bf16_t* PROJ, const float* rpb, bf16_t* CAT, const int tid) {
    const int lane = tid & 63, wid = __builtin_amdgcn_readfirstlane(tid >> 6), m16 = lane & 15, q4 = lane >> 4;
    LAS unsigned char* Kb = cx.lds; LAS unsigned char* Vb = cx.lds + 73728; LAS float* biasL = (LAS float*)(cx.lds + 147456);
    constexpr int PW = 2560;
    u32x4 kv[9], vv[9]; float bpre = 0.f; bf16x8 qn[2];
#define NA_LOAD(unit_) do { const int b_ = __builtin_amdgcn_readfirstlane((unit_) / 384), rem_ = __builtin_amdgcn_readfirstlane((unit_) % 384), h_ = rem_ >> 5, rp_ = rem_ & 31; int bs_ = 2 * rp_ - 4; bs_ = bs_ < 0 ? 0 : (bs_ > 56 ? 56 : bs_); bs_ = __builtin_amdgcn_readfirstlane(bs_); \
        _Pragma("unroll") for (int it = 0; it < 9; ++it) { const int i = tid + it * 512; const int brow = i >> 9, col = (i >> 3) & 63, ch = i & 7; int grow = bs_ + brow; grow = grow > 63 ? 63 : grow; \
            const size_t tok = (size_t)b_ * 4096 + grow * 64 + col; \
            kv[it] = *(const u32x4*)(PROJ + tok * PW + 768 + h_ * 64 + ch * 8); vv[it] = *(const u32x4*)(PROJ + tok * PW + 1536 + h_ * 64 + ch * 8); } \
        if (tid < 465) bpre = rpb[h_ * 465 + tid];   \
        { const size_t tq_ = (size_t)b_ * 4096 + (2 * rp_ + (wid >> 2)) * 64 + 16 * (wid & 3) + m16; \
          _Pragma("unroll") for (int kk = 0; kk < 2; ++kk) qn[kk] = *(const bf16x8*)(PROJ + tq_ * PW + h_ * 64 + 32 * kk + 8 * q4); } } while (0)
    int u0 = cx.vcu; asm volatile("" : "+s"(u0));
    if (u0 < 6144) NA_LOAD(u0);
    for (int unit = u0; unit < 6144; unit += cx.G) {
        const int b = unit / 384, rem = unit % 384, h = rem >> 5, rp = rem & 31;
        int bs = 2 * rp - 4; bs = bs < 0 ? 0 : (bs > 56 ? 56 : bs);
        __syncthreads();
#pragma unroll
        for (int it = 0; it < 9; ++it) { const int i = tid + it * 512; const int brow = i >> 9, col = (i >> 3) & 63, ch = i & 7;
            *(LAS u32x4*)(Kb + (brow * 64 + col) * 128 + ((ch ^ ((col >> 1) & 7)) << 4)) = kv[it];
            *(LAS u32x4*)(Vb + (brow * 64 + col) * 128 + ((ch ^ (col & 7)) << 4)) = vv[it]; }
        if (tid < 465) biasL[tid] = bpre * LOG2E;
        __syncthreads();
        bf16x8 qf[2]; qf[0] = qn[0]; qf[1] = qn[1];
        { const int un_ = (unit + cx.G < 6144) ? unit + cx.G : unit; NA_LOAD(un_); }
        const int r = 2 * rp + (wid >> 2), g = wid & 3;
        const int wc0 = (g == 0) ? 0 : (g == 1) ? 8 : (g == 2) ? 24 : 32;
        int r0 = r - 4; r0 = r0 < 0 ? 0 : (r0 > 56 ? 56 : r0); const int ro = r0 - bs;
        const int c = 16 * g + m16;
        const size_t tq = (size_t)b * 4096 + r * 64 + c;
        f32x4 S[16];
#pragma unroll
        for (int i = 0; i < 8; ++i)
#pragma unroll
            for (int ct = 0; ct < 2; ++ct) { const int col = wc0 + 16 * ct + m16; const LAS unsigned char* kp = Kb + ((ro + i) * 64 + col) * 128; const int sw = (col >> 1) & 7;
                f32x4 a = (f32x4){0.f, 0.f, 0.f, 0.f};
#pragma unroll
                for (int kk = 0; kk < 2; ++kk) { const bf16x8 kf = *(const LAS bf16x8*)(kp + (((q4 + 4 * kk) ^ sw) << 4)); a = __builtin_amdgcn_mfma_f32_16x16x32_bf16(kf, qf[kk], a, 0, 0, 0); }
                S[2 * i + ct] = a; }
        int c0 = c - 8; c0 = c0 < 0 ? 0 : (c0 > 48 ? 48 : c0);
        float mx = -INFINITY;
#pragma unroll
        for (int i = 0; i < 8; ++i)
#pragma unroll
            for (int ct = 0; ct < 2; ++ct)
#pragma unroll
                for (int v = 0; v < 4; ++v) { const int kc = wc0 + 16 * ct + 4 * q4 + v; const bool valid = (kc >= c0) && (kc < c0 + 16);
                    const int bidx = valid ? (r0 + i - r + 7) * 31 + (kc - c + 15) : 0;
                    const float s = valid ? S[2 * i + ct][v] + biasL[bidx] : -INFINITY; S[2 * i + ct][v] = s; mx = fmaxf(mx, s); }
        mx = fmaxf(mx, shflx(mx, 16, lane)); mx = fmaxf(mx, shflx(mx, 32, lane));
        float l = 0.f;
#pragma unroll
        for (int t = 0; t < 16; ++t)
#pragma unroll
            for (int v = 0; v < 4; ++v) { const float p = __builtin_amdgcn_exp2f(S[t][v] - mx); S[t][v] = p; l += p; }
        l += shflx(l, 16, lane); l += shflx(l, 32, lane);
        f32x4 O[4];
#pragma unroll
        for (int dt = 0; dt < 4; ++dt) O[dt] = (f32x4){0.f, 0.f, 0.f, 0.f};
        const int qq = m16 >> 2, pp = m16 & 3, col1 = wc0 + 4 * q4 + qq;
#pragma unroll
        for (int i = 0; i < 8; ++i) {
            u32x4 pw; pw.x = pk2(S[2 * i][0], S[2 * i][1]); pw.y = pk2(S[2 * i][2], S[2 * i][3]); pw.z = pk2(S[2 * i + 1][0], S[2 * i + 1][1]); pw.w = pk2(S[2 * i + 1][2], S[2 * i + 1][3]);
            const bf16x8 pb = __builtin_bit_cast(bf16x8, pw);
            const LAS unsigned char* v1 = Vb + ((ro + i) * 64 + col1) * 128 + 8 * (pp & 1);
            const LAS unsigned char* v2 = v1 + 16 * 128;
#pragma unroll
            for (int dt = 0; dt < 4; ++dt) { const int chunk = 2 * dt + (pp >> 1);
                const s16x4 lo = vtr(v1 + ((chunk ^ (col1 & 7)) << 4)), hi = vtr(v2 + ((chunk ^ ((col1 + 16) & 7)) << 4));
                const bf16x8 vf = (bf16x8){lo[0], lo[1], lo[2], lo[3], hi[0], hi[1], hi[2], hi[3]};
                O[dt] = __builtin_amdgcn_mfma_f32_16x16x32_bf16(vf, pb, O[dt], 0, 0, 0); }
        }
        const float inv = 1.0f / l;
#pragma unroll
        for (int dt = 0; dt < 4; ++dt) {
            if constexpr (OUTP_F8) { int w = 0; w = __builtin_amdgcn_cvt_pk_fp8_f32(O[dt][0] * inv, O[dt][1] * inv, w, false); w = __builtin_amdgcn_cvt_pk_fp8_f32(O[dt][2] * inv, O[dt][3] * inv, w, true); *(int*)((unsigned char*)CAT + tq * 1024 + h * 64 + 16 * dt + 4 * q4) = w; }
            else { u32x2 w; w.x = pk2(O[dt][0] * inv, O[dt][1] * inv); w.y = pk2(O[dt][2] * inv, O[dt][3] * inv); *(u32x2*)(CAT + tq * 1024 + h * 64 + 16 * dt + 4 * q4) = w; } }
    }
    __syncthreads();
}

#undef NA_LOAD
__device__ __forceinline__ void rope_phase(const Ctx& cx, const bf16_t* PROJ, const float* qg, const float* kg, bf16_t* QKR, const int tid) {
    const int lane = tid & 63, wave = __builtin_amdgcn_readfirstlane(tid >> 6);
    const int gw = cx.vcu * 8 + wave, NGW = cx.G * 8;
    const int d0 = (lane & 7) * 8;
    float gq[8], gk[8], invf[4];
#pragma unroll
    for (int e = 0; e < 8; ++e) { gq[e] = qg[d0 + e]; gk[e] = kg[d0 + e]; }
#pragma unroll
    for (int p = 0; p < 4; ++p) { const int i = (d0 >> 1) + p, j = i & 15; invf[p] = exp2f(-(float)(2 * j) / 32.0f * 13.287712379549449f); }
    const bool isrow = (d0 >> 1) < 16;
    for (int pos = gw; pos < SEQ; pos += NGW) {
        const float pr = isrow ? (float)(pos >> 6) : (float)(pos & 63);
        float cs[4], sn[4];
#pragma unroll
        for (int p = 0; p < 4; ++p) { const float a = pr * invf[p]; cs[p] = cosf(a); sn[p] = sinf(a); }
#pragma unroll 1
        for (int bg = 0; bg < BATCH; bg += 4) {
        u32x4 rawv[4][2];
#pragma unroll
        for (int bq = 0; bq < 4; ++bq)
#pragma unroll
            for (int half = 0; half < 2; ++half) rawv[bq][half] = *(const u32x4*)(PROJ + (size_t)((bg + bq) * SEQ + pos) * 1536 + half * 512 + lane * 8);
        __builtin_amdgcn_sched_barrier(0);
#pragma unroll
        for (int bq = 0; bq < 4; ++bq) { const int tok = (bg + bq) * SEQ + pos;
#pragma unroll
        for (int half = 0; half < 2; ++half) {
            const int e0 = half * 512 + lane * 8; const int head = e0 >> 6; const bool isq = head < 12;
            const u32x4 raw = rawv[bq][half];
            float x[8]; x[0] = bflo(raw.x); x[1] = bfhi(raw.x); x[2] = bflo(raw.y); x[3] = bfhi(raw.y); x[4] = bflo(raw.z); x[5] = bfhi(raw.z); x[6] = bflo(raw.w); x[7] = bfhi(raw.w);
            float ss = 0.f;
#pragma unroll
            for (int e = 0; e < 8; ++e) ss += x[e] * x[e];
            ss = group8_sum(ss);
            const float inv = rsqrtf(ss * (1.0f / 64.0f) + 1e-6f);
            float y[8];
#pragma unroll
            for (int e = 0; e < 8; ++e) y[e] = x[e] * inv * (isq ? gq[e] : gk[e]);
            const float sc = isq ? C2 : 1.0f;
            float o[8];
#pragma unroll
            for (int p = 0; p < 4; ++p) { o[2 * p] = (y[2 * p] * cs[p] - y[2 * p + 1] * sn[p]) * sc; o[2 * p + 1] = (y[2 * p] * sn[p] + y[2 * p + 1] * cs[p]) * sc; }
            u32x4 w; w.x = pk2(o[0], o[1]); w.y = pk2(o[2], o[3]); w.z = pk2(o[4], o[5]); w.w = pk2(o[6], o[7]);
            *(u32x4*)(QKR + (size_t)tok * 1024 + e0) = w;
        } } }
    }
}

__device__ __forceinline__ void sconv_phase(const Ctx& cx, const bf16_t* PROJ, const float* cw, const float* cb, bf16_t* UT3, unsigned char* V8, const int tid) {
    const int lane = tid & 63, wave = __builtin_amdgcn_readfirstlane(tid >> 6);
    const int gw = cx.vcu * 8 + wave, NGW = cx.G * 8;
    LAS unsigned short* tile = (LAS unsigned short*)(cx.lds + wave * 9216);
    constexpr int PW = 2560;
    for (int it = gw; it < 16 * 64 * 36; it += NGW) {
        const int ct = it % 36, tt = (it / 36) & 63, b = it / (36 * 64);
        const int col = ct * 64 + lane, t0 = tt * 64;
        const float w0 = cw[col], w1 = cw[2304 + col], w2 = cw[4608 + col], bia = cb[col];
        const bf16_t* src = PROJ + ((size_t)b * 4096 + t0) * PW + col;
        unsigned short uu[66];
        uu[0] = (t0 > 0) ? src[-(long)PW] : (unsigned short)0;
#pragma unroll
        for (int k = 0; k < 64; ++k) uu[k + 1] = src[(size_t)k * PW];
        uu[65] = (t0 + 64 < 4096) ? src[(size_t)64 * PW] : (unsigned short)0;
#pragma unroll
        for (int k = 0; k < 64; ++k) { const float v = bf2f(uu[k]) * w0 + bf2f(uu[k + 1]) * w1 + bf2f(uu[k + 2]) * w2 + bia; tile[lane * 72 + k] = (unsigned short)f2bf(v); }
        LDS_WAIT(); asm volatile("" ::: "memory");
        const int part = (ct * 64) / 768, cbase = (ct * 64) % 768;
#pragma unroll
        for (int k = 0; k < 8; ++k) { const int row = k * 8 + (lane >> 3), chn = lane & 7;
            const u32x4 v = *(const LAS u32x4*)((const LAS unsigned char*)tile + row * 144 + chn * 16);
            *(u32x4*)(UT3 + (((size_t)part * 16 + b) * 768 + cbase + row) * 4096 + t0 + chn * 8) = v;
            if (TCONV_F8 && part == 0) { int w0 = 0, w1 = 0;
                w0 = __builtin_amdgcn_cvt_pk_fp8_f32(bflo(v.x), bfhi(v.x), w0, false); w0 = __builtin_amdgcn_cvt_pk_fp8_f32(bflo(v.y), bfhi(v.y), w0, true);
                w1 = __builtin_amdgcn_cvt_pk_fp8_f32(bflo(v.z), bfhi(v.z), w1, false); w1 = __builtin_amdgcn_cvt_pk_fp8_f32(bflo(v.w), bfhi(v.w), w1, true);
                *(u32x2*)(V8 + ((size_t)b * 768 + cbase + row) * 4096 + t0 + chn * 8) = (u32x2){(unsigned)w0, (unsigned)w1}; } }
        LDS_WAIT(); asm volatile("" ::: "memory");
    }
}

constexpr int TZ_CS = 16384 + 64;
__device__ __forceinline__ void tconv_phase(const Ctx& cx, const int o, const bf16_t* UT, const bf16_t* GT, bf16_t* ZT, const float* lbias  , const int tid) {
    const int lane = tid & 63, wid = __builtin_amdgcn_readfirstlane(tid >> 6), m16 = lane & 15, q4 = lane >> 4;
    const float* HRAWT = (const float*)(cx.ws + WS_HRAWT); const float* HPART = (const float*)(cx.ws + WS_HPART);
    LAS unsigned char* cp = cx.lds; LAS float* red = (LAS float*)(cx.lds + 8 * TZ_CS);
    for (int c = cx.vcu; c < 768; c += cx.G) {
        __syncthreads();
        { const int dir = tid >> 8, blk = tid & 255; float v = HPART[(size_t)blk * 3072 + dir * 1536 + o * 768 + c]; v = wave_sum(v, lane); if (lane == 0) red[wid] = v; }
        __syncthreads();
        float nrm = 0.f;
#pragma unroll
        for (int w = 0; w < 8; ++w) nrm += red[w];
        const float inv = 1.0f / nrm;
        const float* hf = HRAWT + (size_t)(o * 768 + c) * 4096; const float* hb = HRAWT + (size_t)(1536 + o * 768 + c) * 4096;
        for (int i = tid; i < 8192; i += 512) { float v; if (i < 4096) v = hf[4095 - i]; else if (i < 8191) v = hb[i - 4095]; else v = 0.f;
            *(LAS unsigned short*)(cp + 2 * i) = (unsigned short)f2bf(v * inv); }
        __syncthreads();
#pragma unroll
        for (int j = 1; j < 8; ++j)
            for (int n = tid; n < 1024; n += 512) {
                const u32x4 lo = *(const LAS u32x4*)(cp + n * 16); u32x4 hi = (u32x4){0u, 0u, 0u, 0u}; if (n + 1 < 1024) hi = *(const LAS u32x4*)(cp + (n + 1) * 16);
                const unsigned w[8] = {lo.x, lo.y, lo.z, lo.w, hi.x, hi.y, hi.z, hi.w}; u32x4 r;
                const int a = j >> 1;
                if (j & 1) { r.x = (w[a] >> 16) | (w[a + 1] << 16); r.y = (w[a + 1] >> 16) | (w[a + 2] << 16); r.z = (w[a + 2] >> 16) | (w[a + 3] << 16); r.w = (w[a + 3] >> 16) | (w[a + 4] << 16); }
                else { r.x = w[a]; r.y = w[a + 1]; r.z = w[a + 2]; r.w = w[a + 3]; }
                *(LAS u32x4*)(cp + j * TZ_CS + n * 16) = r;
            }
        __syncthreads();
        const int j = (7 - m16) & 7;
        const int nbase = (4095 - 512 * wid - m16 - j + 8 * q4) >> 3;
        const LAS unsigned char* ap = cp + j * TZ_CS + (nbase - 62) * 16;
        const bf16_t* up = UT + ((size_t)m16 * 768 + c) * 4096 + 8 * q4;
        f32x4 acc[32];
#pragma unroll
        for (int ti = 0; ti < 32; ++ti) acc[ti] = (f32x4){0.f, 0.f, 0.f, 0.f};
        bf16x8 bcur = *(const bf16x8*)(up);
        bf16x8 afA[8], afB[8];
#pragma unroll
        for (int i = 0; i < 8; ++i) afA[i] = *(const LAS bf16x8*)(ap + (31 - i) * 32);
        for (int ks = 0; ks < 128; ++ks) {
            const bf16x8 bnext = *(const bf16x8*)(up + ((ks + 1) & 127) * 32);
            const LAS unsigned char* a0 = ap + ks * 64;
            const LAS unsigned char* a1 = ap + ((ks + 1) & 127) * 64;
#define TZ_LD(dst, base, g) do { _Pragma("unroll") for (int i = 0; i < 8; ++i) dst[i] = *(const LAS bf16x8*)((base) + (31 - (8 * (g) + i)) * 32); } while (0)
#define TZ_MM(src, g) do { _Pragma("unroll") for (int i = 0; i < 8; ++i) acc[8 * (g) + i] = __builtin_amdgcn_mfma_f32_16x16x32_bf16(src[i], bcur, acc[8 * (g) + i], 0, 0, 0); } while (0)
            TZ_LD(afB, a0, 1); TZ_MM(afA, 0); __builtin_amdgcn_sched_barrier(0);
            TZ_LD(afA, a0, 2); TZ_MM(afB, 1); __builtin_amdgcn_sched_barrier(0);
            TZ_LD(afB, a0, 3); TZ_MM(afA, 2); __builtin_amdgcn_sched_barrier(0);
            TZ_LD(afA, a1, 0); TZ_MM(afB, 3); __builtin_amdgcn_sched_barrier(0);
#undef TZ_LD
#undef TZ_MM
            bcur = bnext;
        }
        const float lb = lbias[c];
        const size_t rowoff = ((size_t)m16 * 768 + c) * 4096 + 512 * wid + 4 * q4;
#pragma unroll
        for (int ti = 0; ti < 32; ++ti) {
            const u32x2 uu = *(const u32x2*)(UT + rowoff + 16 * ti), gg = *(const u32x2*)(GT + rowoff + 16 * ti);
            const float y0 = (acc[ti][0] + lb * bflo(uu.x)) * bflo(gg.x), y1 = (acc[ti][1] + lb * bfhi(uu.x)) * bfhi(gg.x), y2 = (acc[ti][2] + lb * bflo(uu.y)) * bflo(gg.y), y3 = (acc[ti][3] + lb * bfhi(uu.y)) * bfhi(gg.y);
            u32x2 w; w.x = pk2(y0, y1); w.y = pk2(y2, y3);
            *(u32x2*)(ZT + rowoff + 16 * ti) = w;
            if ((ti & 7) == 7) __builtin_amdgcn_sched_barrier(0);
        }
    }
    __syncthreads();
}

constexpr int T8_CS = 8192 + 256;
__host__ __device__ constexpr int t8_sig(int j) { return j < 4 ? 2 * j : (j >= 12 ? 2 * (j - 8) : 2 * (j - 4) + 1); }
__device__ __forceinline__ float wave_max_nn(float v) {
    v = fmaxf(v, dpp_x<0xB1>(v)); v = fmaxf(v, dpp_x<0x4E>(v)); v = fmaxf(v, dpp_x<0x141>(v)); v = fmaxf(v, dpp_x<0x140>(v));
    v = fmaxf(v, __builtin_bit_cast(float, __builtin_amdgcn_update_dpp(0, __builtin_bit_cast(int, v), 0x142, 0xA, 0xF, false)));
    v = fmaxf(v, __builtin_bit_cast(float, __builtin_amdgcn_update_dpp(0, __builtin_bit_cast(int, v), 0x143, 0xC, 0xF, false)));
    return __builtin_bit_cast(float, __builtin_amdgcn_readlane(__builtin_bit_cast(int, v), 63));
}
__device__ __forceinline__ void tconv8_phase(const Ctx& cx, const int o, const bf16_t* UT, const unsigned char* U8, const bf16_t* GT, bf16_t* ZT, unsigned char* Z8  ,
                                             const float* lbias, const int tid) {
    const int lane = tid & 63, wid = __builtin_amdgcn_readfirstlane(tid >> 6), m16 = lane & 15, q4 = lane >> 4;
    const float* HRAWT = (const float*)(cx.ws + WS_HRAWT); const float* HPART = (const float*)(cx.ws + WS_HPART);
    LAS unsigned char* cp = cx.lds; LAS float* red = (LAS float*)(cx.lds + 16 * T8_CS);
    for (int c = cx.vcu; c < 768; c += cx.G) {
        __syncthreads();
        const float* hf = HRAWT + (size_t)(o * 768 + c) * 4096; const float* hb = HRAWT + (size_t)(1536 + o * 768 + c) * 4096;
        float tap[16]; float mx = 0.f;
        int t3 = tid; asm volatile("" : "+v"(t3));
#pragma unroll
        for (int k = 0; k < 16; ++k) { const int i = t3 * 16 + k; float v; if (i < 4096) v = hf[4095 - i]; else if (i < 8191) v = hb[i - 4095]; else v = 0.f; tap[k] = v; mx = fmaxf(mx, fabsf(v)); }
        { const int dir = tid >> 8, blk = tid & 255; float v = HPART[(size_t)blk * 3072 + dir * 1536 + o * 768 + c]; v = wave_sum(v, lane); mx = wave_max_nn(mx); if (lane == 0) { red[wid] = v; red[8 + wid] = mx; } }
        __syncthreads();
        float nrm = 0.f, mall = 0.f;
#pragma unroll
        for (int w = 0; w < 8; ++w) { nrm += red[w]; mall = fmaxf(mall, red[8 + w]); }
        const float inv = 1.0f / nrm;
        int ex; (void)frexpf(fmaxf(mall * inv, 1e-30f), &ex);
        const float fsc = ldexpf(1.0f, 7 - ex), unsc = ldexpf(1.0f, ex - 7), tsc = inv * fsc;
        { unsigned w[4];
#pragma unroll
          for (int q = 0; q < 4; ++q) { int r = 0; r = __builtin_amdgcn_cvt_pk_fp8_f32(tap[4 * q] * tsc, tap[4 * q + 1] * tsc, r, false); r = __builtin_amdgcn_cvt_pk_fp8_f32(tap[4 * q + 2] * tsc, tap[4 * q + 3] * tsc, r, true); w[q] = (unsigned)r; }
          *(LAS u32x4*)(cp + tid * 16) = (u32x4){w[0], w[1], w[2], w[3]}; }
        __syncthreads();
        { const u32x4 lo = *(const LAS u32x4*)(cp + tid * 16); u32x4 hi = (u32x4){0u, 0u, 0u, 0u}; if (tid + 1 < 512) hi = *(const LAS u32x4*)(cp + (tid + 1) * 16);
          const unsigned w[8] = {lo.x, lo.y, lo.z, lo.w, hi.x, hi.y, hi.z, hi.w};
#pragma unroll
          for (int j = 1; j < 16; ++j) { u32x4 r; const int a = j >> 2, sh = j & 3;
              r.x = sh ? __builtin_amdgcn_alignbyte(w[a + 1], w[a], sh) : w[a]; r.y = sh ? __builtin_amdgcn_alignbyte(w[a + 2], w[a + 1], sh) : w[a + 1];
              r.z = sh ? __builtin_amdgcn_alignbyte(w[a + 3], w[a + 2], sh) : w[a + 2]; r.w = sh ? __builtin_amdgcn_alignbyte(w[a + 4], w[a + 3], sh) : w[a + 3];
              *(LAS u32x4*)(cp + j * T8_CS + t8_sig(j) * 16 + tid * 16) = r; } }
        __syncthreads();
        const int jc = 15 - m16;
        const int nbase = 255 - 32 * wid + 2 * q4;
        const LAS unsigned char* ap = cp + jc * T8_CS + t8_sig(jc) * 16 + (nbase - 31) * 16;
        const unsigned char* up = U8 + ((size_t)m16 * 768 + c) * 4096 + 32 * q4;
        f32x4 acc[32];
#pragma unroll
        for (int ti = 0; ti < 32; ++ti) acc[ti] = (f32x4){0.f, 0.f, 0.f, 0.f};
        typedef int v8i_t __attribute__((ext_vector_type(8))); typedef int v4i_t __attribute__((ext_vector_type(4)));
#define T8_FRAG(p) __builtin_shufflevector(*(const LAS v4i_t*)(p), *(const LAS v4i_t*)((p) + 16), 0, 1, 2, 3, 4, 5, 6, 7)
        v8i_t bcur = __builtin_shufflevector(*(const v4i_t*)(up), *(const v4i_t*)(up + 16), 0, 1, 2, 3, 4, 5, 6, 7);
        v8i_t afA[4], afB[4];
#pragma unroll
        for (int i = 0; i < 4; ++i) afA[i] = T8_FRAG(ap + (31 - i) * 16);
        for (int ks = 0; ks < 32; ++ks) {
            const unsigned char* un = up + ((ks + 1) & 31) * 128;
            const v8i_t bnext = __builtin_shufflevector(*(const v4i_t*)(un), *(const v4i_t*)(un + 16), 0, 1, 2, 3, 4, 5, 6, 7);
            const LAS unsigned char* a0 = ap + ks * 128;
            const LAS unsigned char* a1 = ap + ((ks + 1) & 31) * 128;
#define T8_LD(dst, base, g) do { _Pragma("unroll") for (int i = 0; i < 4; ++i) dst[i] = T8_FRAG((base) + (31 - (4 * (g) + i)) * 16); } while (0)
#define T8_MM(src, g) do { _Pragma("unroll") for (int i = 0; i < 4; ++i) acc[4 * (g) + i] = __builtin_amdgcn_mfma_scale_f32_16x16x128_f8f6f4(src[i], bcur, acc[4 * (g) + i], 0, 0, 0, 0, 0, 0); } while (0)
            T8_LD(afB, a0, 1); T8_MM(afA, 0); __builtin_amdgcn_sched_barrier(0);
            T8_LD(afA, a0, 2); T8_MM(afB, 1); __builtin_amdgcn_sched_barrier(0);
            T8_LD(afB, a0, 3); T8_MM(afA, 2); __builtin_amdgcn_sched_barrier(0);
            T8_LD(afA, a0, 4); T8_MM(afB, 3); __builtin_amdgcn_sched_barrier(0);
            T8_LD(afB, a0, 5); T8_MM(afA, 4); __builtin_amdgcn_sched_barrier(0);
            T8_LD(afA, a0, 6); T8_MM(afB, 5); __builtin_amdgcn_sched_barrier(0);
            T8_LD(afB, a0, 7); T8_MM(afA, 6); __builtin_amdgcn_sched_barrier(0);
            T8_LD(afA, a1, 0); T8_MM(afB, 7); __builtin_amdgcn_sched_barrier(0);
#undef T8_LD
#undef T8_MM
            bcur = bnext;
        }
#undef T8_FRAG
        const float lb = lbias[c];
        const size_t rowoff = ((size_t)m16 * 768 + c) * 4096 + 512 * wid + 4 * q4;
#pragma unroll
        for (int tg = 0; tg < 32; tg += 8) {
            u32x2 uu8[8], gg8[8];
#pragma unroll
            for (int j = 0; j < 8; ++j) { uu8[j] = *(const u32x2*)(UT + rowoff + 16 * (tg + j)); gg8[j] = *(const u32x2*)(GT + rowoff + 16 * (tg + j)); }
#pragma unroll
            for (int j = 0; j < 8; ++j) { const int ti = tg + j; const u32x2 uu = uu8[j], gg = gg8[j];
                const float y0 = (acc[ti][0] * unsc + lb * bflo(uu.x)) * bflo(gg.x), y1 = (acc[ti][1] * unsc + lb * bfhi(uu.x)) * bfhi(gg.x), y2 = (acc[ti][2] * unsc + lb * bflo(uu.y)) * bflo(gg.y), y3 = (acc[ti][3] * unsc + lb * bfhi(uu.y)) * bfhi(gg.y);
                u32x2 w; w.x = pk2(y0, y1); w.y = pk2(y2, y3);
                *(u32x2*)(ZT + rowoff + 16 * ti) = w;
                if (Z8) { int w8 = 0; w8 = __builtin_amdgcn_cvt_pk_fp8_f32(fminf(fmaxf(y0, -440.f), 440.f), fminf(fmaxf(y1, -440.f), 440.f), w8, false); w8 = __builtin_amdgcn_cvt_pk_fp8_f32(fminf(fmaxf(y2, -440.f), 440.f), fminf(fmaxf(y3, -440.f), 440.f), w8, true);
                    *(int*)(Z8 + rowoff + 16 * ti) = w8; } }
            __builtin_amdgcn_sched_barrier(0);
        }
    }
    __syncthreads();
}

__device__ __forceinline__ void tback_phase(const Ctx& cx, const bf16_t* ZT, bf16_t* CAT, const int tid) {
    const int lane = tid & 63, wave = __builtin_amdgcn_readfirstlane(tid >> 6);
    const int gw = cx.vcu * 8 + wave, NGW = cx.G * 8;
    LAS unsigned char* tile = cx.lds + wave * 9216;
    for (int it = gw; it < 16 * 12 * 64; it += NGW) {
        const int tt = it & 63, ct = (it >> 6) % 12, b = it / (64 * 12);
        const int c0 = ct * 64, t0 = tt * 64;
        u32x4 vv[8];
#pragma unroll
        for (int k = 0; k < 8; ++k) { const int row = k * 8 + (lane >> 3), chn = lane & 7; vv[k] = *(const u32x4*)(ZT + ((size_t)b * 768 + c0 + row) * 4096 + t0 + chn * 8); }
        __builtin_amdgcn_sched_barrier(0);
#pragma unroll
        for (int k = 0; k < 8; ++k) { const int row = k * 8 + (lane >> 3), chn = lane & 7; *(LAS u32x4*)(tile + row * 144 + chn * 16) = vv[k]; }
        LDS_WAIT(); asm volatile("" ::: "memory");
        if constexpr (OUTP_F8) { unsigned char* dst = (unsigned char*)CAT + ((size_t)b * 4096 + t0) * 1024 + c0 + lane;
#pragma unroll 8
            for (int k = 0; k < 64; ++k) { const float v = bf2f(*(const LAS unsigned short*)(tile + lane * 144 + k * 2)); dst[(size_t)k * 1024] = f2fp8(fminf(fmaxf(v, -440.0f), 440.0f)); }
        } else { bf16_t* dst = CAT + ((size_t)b * 4096 + t0) * 1024 + c0 + lane;
#pragma unroll 8
            for (int k = 0; k < 64; ++k) dst[(size_t)k * 1024] = *(const LAS unsigned short*)(tile + lane * 144 + k * 2); }
        LDS_WAIT(); asm volatile("" ::: "memory");
    }
}

__device__ __forceinline__ void ln1_group(const int bt, const int chunk, const int wave, const int lane, const int r16, const int q4, const bf16_t* XI, bf16_t* XO, bf16_t* XB, const float* g, const float* bta,
                                          const LAS unsigned char* Wh, const LAS unsigned char* Wl, LAS float* lg, LAS int* lcnt, const float rb0, const float rb1, float* gate, unsigned (&pk)[2], unsigned (&gp)[2], const LAS float* gl) {
    constexpr int WP = 2064;
            const size_t rowU = (size_t)chunk * 256 + wave * 32 + bt * 16;
            unsigned loff = (unsigned)(r16 * 1024 + 8 * q4); asm volatile("" : "+v"(loff));
            const GAS bf16_t* src = (const GAS bf16_t*)XI + rowU * 1024 + loff;
            constexpr int HOLD = LN1_HOLD;
            u32x4 raw[HOLD > 0 ? HOLD : 1], rawt[32 - HOLD]; float s = 0.f, ss = 0.f;
#pragma unroll
            for (int i = 0; i < 32; ++i) { if (i < HOLD) raw[i] = *(const GAS u32x4*)(src + 32 * i); else rawt[i - HOLD] = *(const GAS u32x4*)(src + 32 * i); }
#pragma unroll
            for (int i = 0; i < 32; ++i) { const u32x4 rr = (i < HOLD) ? raw[i < HOLD ? i : 0] : rawt[i < HOLD ? 0 : i - HOLD]; const float x0 = bflo(rr.x), x1 = bfhi(rr.x), x2 = bflo(rr.y), x3 = bfhi(rr.y), x4 = bflo(rr.z), x5 = bfhi(rr.z), x6 = bflo(rr.w), x7 = bfhi(rr.w);
                s += ((x0 + x1) + (x2 + x3)) + ((x4 + x5) + (x6 + x7)); ss += ((x0 * x0 + x1 * x1) + (x2 * x2 + x3 * x3)) + ((x4 * x4 + x5 * x5) + (x6 * x6 + x7 * x7)); }
            lg[2 * lane] = s; lg[2 * lane + 1] = ss; LDS_WAIT(); asm volatile("" ::: "memory");
            s = (lg[2 * r16] + lg[2 * (r16 + 16)]) + (lg[2 * (r16 + 32)] + lg[2 * (r16 + 48)]); ss = (lg[2 * r16 + 1] + lg[2 * (r16 + 16) + 1]) + (lg[2 * (r16 + 32) + 1] + lg[2 * (r16 + 48) + 1]);
            LDS_WAIT(); asm volatile("" ::: "memory");
            const float mean = s * (1.0f / 1024.0f), rstd = rsqrtf(fmaxf(ss * (1.0f / 1024.0f) - mean * mean, 0.f) + LN_EPS);
            f32x4 a0 = (f32x4){0.f, 0.f, 0.f, 0.f}, a1 = (f32x4){0.f, 0.f, 0.f, 0.f};
            const LAS unsigned char* wh0 = Wh + r16 * WP + 16 * q4; const LAS unsigned char* wl0 = Wl + r16 * WP + 16 * q4;
            GAS bf16_t* dsto = (GAS bf16_t*)XO + ((X1_RECOMP && Y_F8) ? (size_t)(wave * 32 + bt * 16) : rowU) * 1024 + loff; GAS unsigned char* dst8 = (GAS unsigned char*)XB + rowU * 1024 + loff;
            const LAS float* glq = gl + 8 * q4;
            u32x4 nx_ = (u32x4){0u, 0u, 0u, 0u}; if (HOLD == 0) nx_ = *(const GAS u32x4*)(src);
#pragma unroll
            for (int i = 0; i < 32; ++i) {
                u32x4 rw_; if (i < HOLD) rw_ = raw[i < HOLD ? i : 0]; else rw_ = nx_;
                if (i + 1 < 32 && i + 1 >= HOLD) nx_ = *(const GAS u32x4*)(src + 32 * (i + 1));
                asm volatile("" : "+v"(rw_));
                const f32x4 g0 = *(const LAS f32x4*)(glq + 32 * i), g1 = *(const LAS f32x4*)(glq + 32 * i + 4), b0 = *(const LAS f32x4*)(glq + 1024 + 32 * i), b1 = *(const LAS f32x4*)(glq + 1024 + 32 * i + 4);
                float y[8]; y[0] = bflo(rw_.x); y[1] = bfhi(rw_.x); y[2] = bflo(rw_.y); y[3] = bfhi(rw_.y); y[4] = bflo(rw_.z); y[5] = bfhi(rw_.z); y[6] = bflo(rw_.w); y[7] = bfhi(rw_.w);
#pragma unroll
                for (int q = 0; q < 8; ++q) y[q] = (y[q] - mean) * rstd * (q < 4 ? g0[q & 3] : g1[q & 3]) + (q < 4 ? b0[q & 3] : b1[q & 3]);
                u32x4 hi; hi.x = pk2(y[0], y[1]); hi.y = pk2(y[2], y[3]); hi.z = pk2(y[4], y[5]); hi.w = pk2(y[6], y[7]);
                *(GAS u32x4*)(dsto + 32 * i) = hi;
                if constexpr (MOE_F8) { int w0 = 0, w1 = 0; w0 = __builtin_amdgcn_cvt_pk_fp8_f32(y[0], y[1], w0, false); w0 = __builtin_amdgcn_cvt_pk_fp8_f32(y[2], y[3], w0, true); w1 = __builtin_amdgcn_cvt_pk_fp8_f32(y[4], y[5], w1, false); w1 = __builtin_amdgcn_cvt_pk_fp8_f32(y[6], y[7], w1, true);
                    *(GAS u32x2*)(dst8 + 32 * i) = (u32x2){(unsigned)w0, (unsigned)w1}; }
                else { *(u32x4*)((bf16_t*)XB + rowU * 1024 + loff + 32 * i) = hi; }
                u32x4 lo; lo.x = pk2(y[0] - bflo(hi.x), y[1] - bfhi(hi.x)); lo.y = pk2(y[2] - bflo(hi.y), y[3] - bfhi(hi.y)); lo.z = pk2(y[4] - bflo(hi.z), y[5] - bfhi(hi.z)); lo.w = pk2(y[6] - bflo(hi.w), y[7] - bfhi(hi.w));
                const bf16x8 ah = __builtin_bit_cast(bf16x8, hi), al = __builtin_bit_cast(bf16x8, lo);
                const bf16x8 wh_0 = *(const LAS bf16x8*)(wh0 + 64 * i), wh_1 = *(const LAS bf16x8*)(wh0 + 16 * WP + 64 * i), wl_0 = *(const LAS bf16x8*)(wl0 + 64 * i), wl_1 = *(const LAS bf16x8*)(wl0 + 16 * WP + 64 * i);
                a0 = __builtin_amdgcn_mfma_f32_16x16x32_bf16(ah, wh_0, a0, 0, 0, 0); a1 = __builtin_amdgcn_mfma_f32_16x16x32_bf16(ah, wh_1, a1, 0, 0, 0);
                a0 = __builtin_amdgcn_mfma_f32_16x16x32_bf16(al, wh_0, a0, 0, 0, 0); a1 = __builtin_amdgcn_mfma_f32_16x16x32_bf16(al, wh_1, a1, 0, 0, 0);
                a0 = __builtin_amdgcn_mfma_f32_16x16x32_bf16(ah, wl_0, a0, 0, 0, 0); a1 = __builtin_amdgcn_mfma_f32_16x16x32_bf16(ah, wl_1, a1, 0, 0, 0);
                asm volatile("" :: "v"(ah), "v"(al), "v"(wh_0), "v"(wh_1), "v"(wl_0), "v"(wl_1));
                __builtin_amdgcn_sched_barrier(0);
            }
#pragma unroll
            for (int v = 0; v < 4; ++v) { lg[(4 * q4 + v) * 33 + r16] = a0[v] + rb0; lg[(4 * q4 + v) * 33 + r16 + 16] = a1[v] + rb1; }
            LDS_WAIT(); asm volatile("" ::: "memory");
            if (lane < 16) {
                const LAS float* myl = lg + lane * 33; const size_t rowt = (size_t)chunk * 256 + wave * 32 + bt * 16 + lane;
                float tv[4]; int te[4]; int t0 = -1, t1 = -1, t2 = -1;
#pragma unroll
                for (int k = 0; k < 4; ++k) { float best = -INFINITY; int bi = 0;
                    for (int e = 0; e < 32; ++e) { const float v = myl[e]; const bool ok = (e != t0) && (e != t1) && (e != t2); if (ok && v > best) { best = v; bi = e; } }
                    tv[k] = best; te[k] = bi; if (k == 0) t0 = bi; else if (k == 1) t1 = bi; else if (k == 2) t2 = bi; }
                const float e1 = __expf(tv[1] - tv[0]), e2 = __expf(tv[2] - tv[0]), e3 = __expf(tv[3] - tv[0]); const float isum = 1.0f / (1.0f + e1 + e2 + e3);
                const float gk[4] = {isum, e1 * isum, e2 * isum, e3 * isum};
                pk[0] = 0u; pk[1] = 0u;
#pragma unroll
                for (int k = 0; k < 4; ++k) { const int rk = __hip_atomic_fetch_add(lcnt + te[k], 1, __ATOMIC_RELAXED, __HIP_MEMORY_SCOPE_WORKGROUP); pk[k >> 1] |= (unsigned)((te[k] << 11) | rk) << (16 * (k & 1)); }
                gp[0] = pk2(gk[0], gk[1]); gp[1] = pk2(gk[2], gk[3]); (void)rowt; (void)gate;
            }
            LDS_WAIT(); asm volatile("" ::: "memory");
}
__device__ __forceinline__ void ln1_router_phase(const Ctx& cx, const bf16_t* XI, bf16_t* XO, bf16_t* XB, const float* g, const float* bta, const float* rw, const float* rb,
                                                 unsigned* cnt, int* expid, float* gate, int* idx, float* gidx, const int tid) {
    const int lane = tid & 63, wave = __builtin_amdgcn_readfirstlane(tid >> 6), r16 = lane & 15, q4 = lane >> 4;
    constexpr int WP = 2064;
    LAS unsigned char* Wh = cx.lds; LAS unsigned char* Wl = cx.lds + 32 * WP; LAS int* lcnt = (LAS int*)(cx.lds + 64 * WP); LAS int* lbase = lcnt + 32; LAS float* lg = (LAS float*)(cx.lds + 64 * WP + 256 + wave * 2112);
    __syncthreads();
    { const u32x4* rsrc = (const u32x4*)rw; u32x4 wv[16];
#pragma unroll
      for (int u = 0; u < 16; ++u) wv[u] = rsrc[tid + 512 * u];
#pragma unroll
      for (int u = 0; u < 16; ++u) { const int idx = tid + 512 * u; *(LAS u32x4*)(Wh + (idx >> 7) * WP + (idx & 127) * 16) = wv[u]; } }
    if (tid < 256) { LAS float* gf = (LAS float*)(cx.lds + 151552); *(LAS f32x4*)(gf + 4 * tid) = *(const f32x4*)(g + 4 * tid); *(LAS f32x4*)(gf + 1024 + 4 * tid) = *(const f32x4*)(bta + 4 * tid); }
    if (tid < 32) lcnt[tid] = 0;
    LAS float* gl = (LAS float*)(cx.lds + 151552);
    const float rb0 = rb[r16], rb1 = rb[r16 + 16];
    __syncthreads();
    for (int chunk = cx.vcu; chunk < NTOK / 256; chunk += cx.G) {
        unsigned pk0[2] = {0u, 0u}, pk1[2] = {0u, 0u}, gp0[2] = {0u, 0u}, gp1[2] = {0u, 0u};
        ln1_group(0, chunk, wave, lane, r16, q4, XI, XO, XB, g, bta, Wh, Wl, lg, lcnt, rb0, rb1, gate, pk0, gp0, gl);
        ln1_group(1, chunk, wave, lane, r16, q4, XI, XO, XB, g, bta, Wh, Wl, lg, lcnt, rb0, rb1, gate, pk1, gp1, gl);
        __syncthreads();
        { const int t2 = wave * 64 + lane_id_volatile();
          if (t2 < 32) { lbase[t2] = (int)__hip_atomic_fetch_add(cnt + t2, (unsigned)lcnt[t2], __ATOMIC_RELAXED, __HIP_MEMORY_SCOPE_AGENT); } }
        __syncthreads();
        const int ln_ = lane_id_volatile();
        if (ln_ < 16) {
            { const int slot0 = (chunk * 256 + wave * 32 + ln_) * 4;
#pragma unroll
                for (int k = 0; k < 4; ++k) { const unsigned p = (pk0[k >> 1] >> (16 * (k & 1))) & 0xffffu; const int e = (int)(p >> 11), rk = (int)(p & 0x7ffu); const size_t o_ = (size_t)e * IDXCAP + lbase[e] + rk; idx[o_] = slot0 + k; gidx[o_] = (k & 1) ? bfhi(gp0[k >> 1]) : bflo(gp0[k >> 1]); } }
            { const int slot0 = (chunk * 256 + wave * 32 + 16 + ln_) * 4;
#pragma unroll
                for (int k = 0; k < 4; ++k) { const unsigned p = (pk1[k >> 1] >> (16 * (k & 1))) & 0xffffu; const int e = (int)(p >> 11), rk = (int)(p & 0x7ffu); const size_t o_ = (size_t)e * IDXCAP + lbase[e] + rk; idx[o_] = slot0 + k; gidx[o_] = (k & 1) ? bfhi(gp1[k >> 1]) : bflo(gp1[k >> 1]); } }
        }
        __syncthreads();
        { const int t3 = wave * 64 + lane_id_volatile(); if (t3 < 32) lcnt[t3] = 0; }
        __syncthreads();
    }
}

__device__ __forceinline__ void ln2_phase(const Ctx& cx, const bf16_t* X1, const bf16_t* Y, bf16_t* XO, bf16_t* XB, float* OUT, const float* g, const float* bta, const float* g1, const float* b1, const int tid) {
    const int lane = tid & 63, wave = __builtin_amdgcn_readfirstlane(tid >> 6);
    const int gw = cx.vcu * 8 + wave, NGW = cx.G * 8;
    if constexpr (Y_F8) {
        f32x4 gv[4], bv[4];
#pragma unroll
        for (int j = 0; j < 4; ++j) { gv[j] = *(const f32x4*)(g + 16 * lane + 4 * j); bv[j] = *(const f32x4*)(bta + 16 * lane + 4 * j); }
        f32x4 g1v[4], b1v[4];
        if (X1_RECOMP) {
#pragma unroll
            for (int j = 0; j < 4; ++j) { g1v[j] = *(const f32x4*)(g1 + 16 * lane + 4 * j); b1v[j] = *(const f32x4*)(b1 + 16 * lane + 4 * j); } }
        for (int rp = gw; rp < NTOK / 2; rp += NGW) {
            u32x4 xa[2][2], ya[2][4];
#pragma unroll
            for (int r = 0; r < 2; ++r) { const size_t row = (size_t)rp * 2 + r;
                xa[r][0] = *(const u32x4*)(X1 + row * 1024 + 16 * lane); xa[r][1] = *(const u32x4*)(X1 + row * 1024 + 16 * lane + 8);
#pragma unroll
                for (int k = 0; k < 4; ++k) ya[r][k] = __builtin_nontemporal_load((const u32x4*)((const unsigned char*)Y + (row * 4 + k) * 1024 + 16 * lane)); }
            float v[2][16]; float s[2] = {0.f, 0.f};
            float m1[2] = {0.f, 0.f}, r1[2] = {1.f, 1.f};
            if (X1_RECOMP) {
                float s1[2] = {0.f, 0.f}, q1[2] = {0.f, 0.f};
#pragma unroll
                for (int r = 0; r < 2; ++r)
#pragma unroll
                    for (int d = 0; d < 8; ++d) { const unsigned w = xa[r][d >> 2][d & 3]; const float t0 = bflo(w), t1 = bfhi(w); s1[r] += t0 + t1; q1[r] += t0 * t0 + t1 * t1; }
#pragma unroll
                for (int r = 0; r < 2; ++r) { m1[r] = wave_sum(s1[r], lane) * (1.0f / 1024.0f); r1[r] = rsqrtf(fmaxf(wave_sum(q1[r], lane) * (1.0f / 1024.0f) - m1[r] * m1[r], 0.f) + LN_EPS); } }
#pragma unroll
            for (int r = 0; r < 2; ++r) {
#pragma unroll
                for (int i = 0; i < 4; ++i) { f32x2 lo = __builtin_amdgcn_cvt_pk_f32_fp8((int)ya[r][0][i], false), hi = __builtin_amdgcn_cvt_pk_f32_fp8((int)ya[r][0][i], true);
#pragma unroll
                    for (int k = 1; k < 4; ++k) { lo += __builtin_amdgcn_cvt_pk_f32_fp8((int)ya[r][k][i], false); hi += __builtin_amdgcn_cvt_pk_f32_fp8((int)ya[r][k][i], true); }
                    const unsigned xlo = xa[r][i >> 1][(i & 1) * 2], xhi = xa[r][i >> 1][(i & 1) * 2 + 1];
                    f32x4 x1v = (f32x4){bflo(xlo), bfhi(xlo), bflo(xhi), bfhi(xhi)};
                    if (X1_RECOMP) x1v = (x1v - m1[r]) * r1[r] * g1v[i] + b1v[i];
                    v[r][4 * i + 0] = x1v[0] * DN_ALPHA + lo[0] * (1.0f / Y_SCALE); v[r][4 * i + 1] = x1v[1] * DN_ALPHA + lo[1] * (1.0f / Y_SCALE);
                    v[r][4 * i + 2] = x1v[2] * DN_ALPHA + hi[0] * (1.0f / Y_SCALE); v[r][4 * i + 3] = x1v[3] * DN_ALPHA + hi[1] * (1.0f / Y_SCALE);
                    s[r] += (v[r][4 * i] + v[r][4 * i + 1]) + (v[r][4 * i + 2] + v[r][4 * i + 3]); } }
            const float mean0 = wave_sum(s[0], lane) * (1.0f / 1024.0f), mean1 = wave_sum(s[1], lane) * (1.0f / 1024.0f); float q[2] = {0.f, 0.f};
#pragma unroll
            for (int r = 0; r < 2; ++r)
#pragma unroll
                for (int e = 0; e < 16; ++e) { v[r][e] -= (r == 0 ? mean0 : mean1); q[r] += v[r][e] * v[r][e]; }
            const float rstd0 = rsqrtf(wave_sum(q[0], lane) * (1.0f / 1024.0f) + LN_EPS), rstd1 = rsqrtf(wave_sum(q[1], lane) * (1.0f / 1024.0f) + LN_EPS);
            unsigned wb[2][8]; unsigned w8[2][4];
#pragma unroll
            for (int j = 0; j < 4; ++j) { const f32x4 gvj = gv[j], bvj = bv[j];
#pragma unroll
                for (int r = 0; r < 2; ++r) { const size_t row = (size_t)rp * 2 + r; const float rs = (r == 0 ? rstd0 : rstd1);
                    const f32x4 o = (f32x4){v[r][4 * j], v[r][4 * j + 1], v[r][4 * j + 2], v[r][4 * j + 3]} * rs * gvj + bvj;
                    if (OUT) *(f32x4*)(OUT + row * 1024 + 16 * lane + 4 * j) = o;
                    else { wb[r][2 * j] = pk2(o[0], o[1]); wb[r][2 * j + 1] = pk2(o[2], o[3]);
                        int t8 = 0; t8 = __builtin_amdgcn_cvt_pk_fp8_f32(o[0], o[1], t8, false); t8 = __builtin_amdgcn_cvt_pk_fp8_f32(o[2], o[3], t8, true); w8[r][j] = (unsigned)t8; } } }
            if (!OUT) {
#pragma unroll
                for (int r = 0; r < 2; ++r) { const size_t row = (size_t)rp * 2 + r;
                    *(u32x4*)(XO + row * 1024 + 16 * lane) = (u32x4){wb[r][0], wb[r][1], wb[r][2], wb[r][3]}; *(u32x4*)(XO + row * 1024 + 16 * lane + 8) = (u32x4){wb[r][4], wb[r][5], wb[r][6], wb[r][7]};
                    if constexpr (INP_F8) *(u32x4*)((unsigned char*)XB + row * 1024 + 16 * lane) = (u32x4){w8[r][0], w8[r][1], w8[r][2], w8[r][3]};
                    else { *(u32x4*)(XB + row * 1024 + 16 * lane) = (u32x4){wb[r][0], wb[r][1], wb[r][2], wb[r][3]}; *(u32x4*)(XB + row * 1024 + 16 * lane + 8) = (u32x4){wb[r][4], wb[r][5], wb[r][6], wb[r][7]}; } } }
        }
        return;
    }
    for (int rp = gw; rp < NTOK / 2; rp += NGW) {
        f32x4 v[2][4]; float s[2] = {0.f, 0.f};
#pragma unroll
        for (int r = 0; r < 2; ++r) { const size_t row = (size_t)rp * 2 + r;
#pragma unroll
            for (int j = 0; j < 4; ++j) { const u32x2 a = *(const u32x2*)(X1 + row * 1024 + 4 * lane + 256 * j); v[r][j] = (f32x4){bflo(a.x), bfhi(a.x), bflo(a.y), bfhi(a.y)} * DN_ALPHA;
#pragma unroll
                for (int k = 0; k < 4; ++k) {
                    if constexpr (Y_F8) { const int y8 = *(const int*)((const unsigned char*)Y + (row * 4 + k) * 1024 + 4 * lane + 256 * j); const f32x2 lo = __builtin_amdgcn_cvt_pk_f32_fp8(y8, false), hi = __builtin_amdgcn_cvt_pk_f32_fp8(y8, true);
                        v[r][j][0] += lo[0] * (1.0f / Y_SCALE); v[r][j][1] += lo[1] * (1.0f / Y_SCALE); v[r][j][2] += hi[0] * (1.0f / Y_SCALE); v[r][j][3] += hi[1] * (1.0f / Y_SCALE); }
                    else { const u32x2 y = *(const u32x2*)(Y + (row * 4 + k) * 1024 + 4 * lane + 256 * j); v[r][j][0] += bflo(y.x); v[r][j][1] += bfhi(y.x); v[r][j][2] += bflo(y.y); v[r][j][3] += bfhi(y.y); } }
                s[r] += (v[r][j][0] + v[r][j][1]) + (v[r][j][2] + v[r][j][3]); } }
        const float mean0 = wave_sum(s[0], lane) * (1.0f / 1024.0f), mean1 = wave_sum(s[1], lane) * (1.0f / 1024.0f); float q[2] = {0.f, 0.f};
#pragma unroll
        for (int r = 0; r < 2; ++r)
#pragma unroll
            for (int j = 0; j < 4; ++j) { v[r][j] = v[r][j] - (r == 0 ? mean0 : mean1); q[r] += (v[r][j][0] * v[r][j][0] + v[r][j][1] * v[r][j][1]) + (v[r][j][2] * v[r][j][2] + v[r][j][3] * v[r][j][3]); }
        const float rstd0 = rsqrtf(wave_sum(q[0], lane) * (1.0f / 1024.0f) + LN_EPS), rstd1 = rsqrtf(wave_sum(q[1], lane) * (1.0f / 1024.0f) + LN_EPS);
#pragma unroll
        for (int j = 0; j < 4; ++j) { const f32x4 gvj = *(const f32x4*)(g + 4 * lane + 256 * j), bvj = *(const f32x4*)(bta + 4 * lane + 256 * j);
#pragma unroll
            for (int r = 0; r < 2; ++r) { const size_t row = (size_t)rp * 2 + r; const f32x4 o = v[r][j] * (r == 0 ? rstd0 : rstd1) * gvj + bvj;
                if (OUT) *(f32x4*)(OUT + row * 1024 + 4 * lane + 256 * j) = o;
                else { u32x2 w; w.x = pk2(o[0], o[1]); w.y = pk2(o[2], o[3]); *(u32x2*)(XO + row * 1024 + 4 * lane + 256 * j) = w;
                    if constexpr (INP_F8) { int w8 = 0; w8 = __builtin_amdgcn_cvt_pk_fp8_f32(o[0], o[1], w8, false); w8 = __builtin_amdgcn_cvt_pk_fp8_f32(o[2], o[3], w8, true); *(int*)((unsigned char*)XB + row * 1024 + 4 * lane + 256 * j) = w8; }
                    else { *(u32x2*)(XB + row * 1024 + 4 * lane + 256 * j) = w; } } } }
    }
}

constexpr int PH_PER_LAYER = 10, N_PHASES = 2 + PH_PER_LAYER * DEPTH;
__host__ __device__ constexpr bool phase_active(int p) {
    if (p < 2) return true;
    const int l = (p - 2) / PH_PER_LAYER, k = (p - 2) % PH_PER_LAYER, kind = l % 3;
    if (k == 1) return kind != 0;
    if (k == 3 || k == 4) return kind == 2;
    return true;
}

__global__ void __launch_bounds__(512, 2) fwd(Args args) {
    extern __shared__ __attribute__((aligned(16))) unsigned char lds_raw[];
    const int wave0 = __builtin_amdgcn_readfirstlane((int)threadIdx.x >> 6);
    Ctx cx; cx.lds = (LAS unsigned char*)lds_raw; cx.G = gridDim.x; { const int bx = blockIdx.x; cx.vcu = (cx.G % 8 == 0) ? (bx % 8) * (cx.G / 8) + bx / 8 : bx; } cx.ws = args.ws;
    volatile LAS unsigned* MISC = (volatile LAS unsigned*)(cx.lds + MISC_OFF);
    for (int u = threadIdx.x; u < (LDS_BYTES - MISC_OFF) / 4; u += 512) MISC[u] = 0u;
    __syncthreads();
    if (threadIdx.x == 0) { LAS unsigned long long* t = (LAS unsigned long long*)(cx.lds + PTAB_OFF);
#pragma unroll
        for (int k = 0; k < 32; ++k) t[k] = (unsigned long long)args.in[k];
        t[32] = (unsigned long long)args.out; t[33] = (unsigned long long)args.ws; }
    __syncthreads();
    const int lo = args.ph_lo, hi = args.ph_hi;
    XcdBarrier bar; bar.bar = (unsigned*)((gu32*)(args.ws + WS_CTL) + CW_BAR); bar.x = 0; bar.st = nullptr;
    if (hi - lo > 1) bar = xcd_barrier_post((unsigned*)((gu32*)(args.ws + WS_CTL) + CW_BAR), MISC + 8);
    int ran = 0, nobar = 0;
#define XB ((bf16_t*)(ws + WS_XB))
#define PROJ ((bf16_t*)(ws + WS_PROJ))
#define CAT ((bf16_t*)(ws + WS_CAT))
#define KVM ((bf16_t*)(ws + WS_KVM))
#define HB ((bf16_t*)(ws + WS_H))
#define YB ((bf16_t*)(ws + WS_Y))
#define QKR ((bf16_t*)(ws + WS_QKR))
#define EXPID ((int*)(ws + WS_EXPID))
#define GATE ((float*)(ws + WS_GATE))
#define IDX ((int*)(ws + WS_IDX))
#define XF ((float*)(GAS float*)ptab_get(cx, 32))
#define SB ((bf16_t*)(ws + WS_SB))
#define SB2 ((bf16_t*)(ws + WS_PROJ))
#define TP_BAR_BEGIN() do {} while (0)
#define TP_BAR_END() do {} while (0)
#define TP_PH_BEGIN(p) do {} while (0)
#define TP_PH_END(p) do {} while (0)
#define PH_BEGIN(p) if (lo <= (p) && (p) < hi) { const int ph_ = (p); if (ran && !nobar) { TP_BAR_BEGIN(); for (int rb_ = 0; rb_ < REP_BAR; ++rb_) xcd_barrier(bar, wave0); TP_BAR_END(); } ran = 1; nobar = 0; const int tid = opaque_tid(wave0); (void)tid; unsigned char* const ws = (unsigned char*)(GAS unsigned char*)ptab_get(cx, 33); cx.ws = ws; TP_PH_BEGIN(ph_);
#define PH_END TP_PH_END(ph_); }

#if EN_P0
    PH_BEGIN(0) for (int rep_ = 0; rep_ < REP_P0; ++rep_) { p0_prologue(cx, tid); } PH_END
#endif

    for (int l = -1; l < DEPTH; ++l) {
        const int kind = (l < 0) ? 0 : l % 3, jj = (l < 0) ? 0 : l / 3, pw = (l < 0) ? 2048 : ((l % 3) == 1 ? 1536 : 2560), base = 2 + PH_PER_LAYER * l;
        nobar = (l == 0 && hi - lo > 1) ? 1 : 0;
        PH_BEGIN(l < 0 ? 1 : base) {
            pg8::DenseOrder S;
            if (l < 0) S.init(ws + WS_MEMB, ws + WS_WKV, NMEM, 2048, 1024 * INP_EB, cx.G, (int)blockIdx.x);
            else S.init(XB, ws + WS_WIN + (size_t)l * 5 * MiB, NTOK, pw, 1024 * INP_EB, cx.G, (int)blockIdx.x);
            S.rep = REP_DENSE;
            const unsigned smask = (l < 0) ? 0u : (kind == 0 ? 0x207u : kind == 1 ? 0x20u : 0x200u);
            pg8::EpiBf16s E{l < 0 ? KVM : PROJ, pw, smask, C2, INP_F8 ? 1.0f / WIN_SCALE : 1.0f};
#if EN_G1
            pg8::gemm_phase<pg8::EpiBf16s, pg8::DenseOrder, false, INP_F8 != 0>(cx.lds, S, E, tid);
#endif
        } PH_END
        if (l < 0) continue;
#if EN_THIN
        if (kind == 1) { PH_BEGIN(base + 1) for (int rep_ = 0; rep_ < REP_THIN; ++rep_) { rope_phase(cx, PROJ, INP(5) + jj * 64, INP(6) + jj * 64, QKR, tid); } PH_END }
        if (kind == 2) { PH_BEGIN(base + 1) for (int rep_ = 0; rep_ < REP_THIN; ++rep_) { sconv_phase(cx, PROJ, INP(8) + (size_t)jj * 3 * 2304, INP(9) + (size_t)jj * 2304, (bf16_t*)(ws + WS_UT3), ws + WS_V8, tid); } PH_END }
#endif
        for (int o = 0; o < 2; ++o) {
            if (o == 1 && kind != 2) break;
            PH_BEGIN(base + 2 + o) {
                if (kind == 2) {
                    const bf16_t* UT3 = (const bf16_t*)(ws + WS_UT3); constexpr size_t PS = (size_t)16 * 768 * 4096;
#if EN_TCONV
                    for (int rep_ = 0; rep_ < REP_TCONV; ++rep_) {
#if TCONV_F8
                    tconv8_phase(cx, o, o == 0 ? UT3 : (const bf16_t*)(ws + WS_Z1T), ws + WS_V8 + (size_t)o * 48 * MiB, UT3 + (size_t)(1 + o) * PS, (bf16_t*)(ws + (o == 0 ? WS_Z1T : WS_Z2T)), o == 0 ? ws + WS_V8 + 48 * MiB : (unsigned char*)nullptr, INP(19) + (size_t)(jj * 2 + o) * 768, tid);
#else
                    tconv_phase(cx, o, o == 0 ? UT3 : (const bf16_t*)(ws + WS_Z1T), UT3 + (size_t)(1 + o) * PS, (bf16_t*)(ws + (o == 0 ? WS_Z1T : WS_Z2T)), INP(19) + (size_t)(jj * 2 + o) * 768, tid);
#endif
                    }
#endif
                }
                if (o == 0) {
#if EN_NA
                    for (int rep_ = 0; rep_ < REP_NA; ++rep_) { if (kind == 0) na_phase(cx, PROJ, INP(3) + (size_t)jj * 12 * 465, CAT, tid); }
#endif
                    const int ngqa = (kind == 1) ? 3072 : 0;
                    for (int rep_ = 0; rep_ < REP_ATTN; ++rep_)
                    for (int u = cx.vcu; u < ngqa + 1024; u += cx.G) {
                        const attn_body::bf16 *Q, *K, *V; attn_body::bf16* O; int QP, KP, VP, NT;
                        if (u < ngqa) { const int qb = u & 15, hq = (u >> 4) % 12, b = u / 192, kvh = hq / 3;
                            Q = (const attn_body::bf16*)QKR + ((size_t)b * 4096 + qb * 256) * 1024 + hq * 64; QP = 1024;
                            K = (const attn_body::bf16*)QKR + (size_t)b * 4096 * 1024 + 768 + kvh * 64; KP = 1024;
                            V = (const attn_body::bf16*)PROJ + (size_t)b * 4096 * 1536 + 1024 + kvh * 64; VP = 1536;
                            O = (attn_body::bf16*)((unsigned char*)CAT + (((size_t)b * 4096 + qb * 256) * 1024 + hq * 64) * OUT_EB); NT = 64;
                        } else { const int v = u - ngqa, qb = v & 15, h = (v >> 4) & 3, b = v >> 6;
                            Q = (const attn_body::bf16*)PROJ + ((size_t)b * 4096 + qb * 256) * pw + (pw - 256) + h * 64; QP = pw;
                            K = (const attn_body::bf16*)KVM + (size_t)b * 256 * 2048 + 512 * l + h * 64; KP = 2048;
                            V = K + 256; VP = 2048;
                            O = (attn_body::bf16*)((unsigned char*)CAT + (((size_t)b * 4096 + qb * 256) * 1024 + 768 + h * 64) * OUT_EB); NT = 4;
                        }
#if EN_ATTN
                        attn_body::attn_unit<8, OUTP_F8 != 0>(Q, K, V, O, QP, KP, VP, 1024, NT, (char*)lds_raw, tid);
#endif
                    }
                }
            } PH_END
        }
#if EN_THIN
        if (kind == 2) { PH_BEGIN(base + 4) for (int rep_ = 0; rep_ < REP_THIN; ++rep_) { tback_phase(cx, (const bf16_t*)(ws + WS_Z2T), CAT, tid); } PH_END }
#endif
        PH_BEGIN(base + 5) {
            pg8::DenseOrder S; S.init(CAT, ws + WS_WOUT + (size_t)l * 2 * MiB, NTOK, 1024, 1024 * OUT_EB, cx.G, (int)blockIdx.x);
            pg8::EpiResB E{SB, l == 0 ? (const void*)INP(0) : (const void*)SB, l == 0 ? 1 : 0, 1024, DN_ALPHA, OUTP_F8 ? 1.0f / WOUT_SCALE : 1.0f};
#if EN_G2
            pg8::gemm_phase<pg8::EpiResB, pg8::DenseOrder, false, OUTP_F8 != 0>(cx.lds, S, E, tid);
#endif
        } PH_END
#if EN_LN
#if REP_LN1 > 1
        PH_BEGIN(base + 6) ln1_router_phase(cx, SB, (bf16_t*)(ws + WS_PROJ), CAT, INP(22) + l * 1024, INP(23) + l * 1024, (const float*)(ws + WS_RW + (size_t)l * 131072), INP(27) + l * 32, (unsigned*)((gu32*)(ws + WS_CTL) + CW_DBG), EXPID, GATE, IDX, (float*)(ws + WS_GIDX), tid); PH_END
#endif
        PH_BEGIN(base + 6) ln1_router_phase(cx, SB, SB2, XB, INP(22) + l * 1024, INP(23) + l * 1024, (const float*)(ws + WS_RW + (size_t)l * 131072), INP(27) + l * 32, (unsigned*)((gu32*)(ws + WS_CTL) + CW_CNT + 32 * l), EXPID, GATE, IDX, (float*)(ws + WS_GIDX), tid); PH_END
#endif
        for (int half = 0; half < 2; ++half) {
            PH_BEGIN(base + 7 + half) {
                LAS int* pref = (LAS int*)(cx.lds + pg8::STAGE_BYTES); const unsigned* cntw = (const unsigned*)((gu32*)(ws + WS_CTL) + CW_CNT + 32 * l);
                __syncthreads();
                if (tid < NEXP) { const int c = (int)__hip_atomic_load(cntw + tid, __ATOMIC_RELAXED, __HIP_MEMORY_SCOPE_AGENT); pref[40 + tid] = c; pref[72 + tid] = (c + 255) >> 8; }
                __syncthreads();
                if (tid == 0) { int a = 0;
#pragma unroll 1
                    for (int e = 0; e < NEXP; ++e) { pref[e] = a; a += pref[72 + e]; } pref[NEXP] = a; }
                __syncthreads();
#if STAGGER
                if (cx.vcu & 1) { for (int s_ = 0; s_ < STAGGER; ++s_) __builtin_amdgcn_s_sleep(127); }
#endif
                if (half == 0) {
                    pg8::MoeOrder<2> S{(const char*)XB, (const char*)(ws + WS_W1 + (size_t)l * 32 * 2048 * 1024 * MOE_EB), 1024 * MOE_EB, 8, cx.G, cx.vcu, (size_t)2048 * 1024 * MOE_EB, pref, (const int*)cntw, IDX};
                    pg8::EpiSwiglu E{HB, INP(29) + (size_t)l * 32 * 2048};
#if EN_G3
                    for (int rep_ = 0; rep_ < REP_G3; ++rep_) { pg8::gemm_phase<pg8::EpiSwiglu, pg8::MoeOrder<2>, true, MOE_F8 != 0, (MOE_F8 != 0) && (DEFER_H != 0)>(cx.lds, S, E, tid); }
#endif
                } else {
                    pg8::MoeOrder<0> S{(const char*)HB, (const char*)(ws + WS_W2 + (size_t)l * 32 * 1024 * 1024 * MOE_EB), 1024 * MOE_EB, 4, cx.G, cx.vcu, (size_t)1024 * 1024 * MOE_EB, pref, (const int*)cntw, IDX};
                    pg8::EpiMoeOut E{YB, INP(31) + (size_t)l * 32 * 1024, (const float*)(ws + WS_GIDX)};
#if EN_G4
                    for (int rep_ = 0; rep_ < REP_G4; ++rep_) { pg8::gemm_phase<pg8::EpiMoeOut, pg8::MoeOrder<0>, true, MOE_F8 != 0>(cx.lds, S, E, tid); }
#endif
                }
            } PH_END
        }
#if EN_LN
#if REP_LN2 > 1
        PH_BEGIN(base + 9) ln2_phase(cx, SB, YB, (bf16_t*)(ws + WS_PROJ), CAT, (float*)nullptr, INP(24) + l * 1024, INP(25) + l * 1024, INP(22) + l * 1024, INP(23) + l * 1024, tid); PH_END
#endif
        PH_BEGIN(base + 9) ln2_phase(cx, (X1_RECOMP && Y_F8) ? SB : SB2, YB, SB, XB, l == DEPTH - 1 ? XF : (float*)nullptr, INP(24) + l * 1024, INP(25) + l * 1024, INP(22) + l * 1024, INP(23) + l * 1024, tid); PH_END

#endif
    }
#undef PH_BEGIN
#undef PH_END
#undef XB
#undef PROJ
#undef CAT
#undef KVM
#undef HB
#undef YB
#undef QKR
#undef EXPID
#undef GATE
#undef IDX
#undef XF
#undef SB
#undef SB2
}

extern "C" void kernel_launch(void* const* d_in, const int* in_sizes, int n_in, void* d_out, int out_size, void* d_ws, size_t ws_size, hipStream_t stream) {
    static int grid = 0;
    if (grid == 0) {
        if (n_in != 32 || in_sizes[0] != NTOK * DM || out_size != NTOK * DM || ws_size < WS_END) { fprintf(stderr, "kernel_launch: unexpected problem (n_in %d, in0 %d, out %d, ws %zu < %zu); nothing launched\n", n_in, n_in > 0 ? in_sizes[0] : -1, out_size, ws_size, (size_t)WS_END); grid = -1; return; }
        int dev = 0, cus = 0, per_cu = 0;
        if (hipGetDevice(&dev) != hipSuccess || hipDeviceGetAttribute(&cus, hipDeviceAttributeMultiprocessorCount, dev) != hipSuccess) { fprintf(stderr, "kernel_launch: device query failed\n"); grid = -1; return; }
        if (hipFuncSetAttribute((const void*)fwd, hipFuncAttributeMaxDynamicSharedMemorySize, LDS_BYTES) != hipSuccess) { fprintf(stderr, "kernel_launch: hipFuncSetAttribute failed\n"); grid = -1; return; }
        if (hipOccupancyMaxActiveBlocksPerMultiprocessor(&per_cu, (const void*)fwd, 512, LDS_BYTES) != hipSuccess || per_cu < 1) fprintf(stderr, "kernel_launch: occupancy query reports %d blocks per CU\n", per_cu);
        (void)hipGetLastError();
        grid = cus;
    }
    if (grid < 0) return;
    if (hipMemsetAsync((char*)d_ws + WS_CTL, 0, CTL_ZERO_BYTES, stream) != hipSuccess) { fprintf(stderr, "kernel_launch: memset failed\n"); return; }
    Args a{};
    for (int i = 0; i < 32; ++i) a.in[i] = (const float*)d_in[i];
    a.out = (float*)d_out; a.ws = (unsigned char*)d_ws;
#if MK_MULTI
    for (int p = 0; p < N_PHASES && p <= DBG_LAST_PHASE; ++p) {
        if (!phase_active(p)) continue;
        a.ph_lo = p; a.ph_hi = p + 1;
        hipLaunchKernelGGL(fwd, dim3(grid), dim3(512), LDS_BYTES, stream, a);
#if DBG_CHECK
        dbg_after_phase(p, a, stream);
#endif
    }
#if DBG_CHECK
    hipLaunchKernelGGL(dbg_report, dim3(1024), dim3(256), 0, stream, (unsigned*)((char*)d_ws + WS_CTL) + CW_DBG, (float*)d_out);
#endif
#else
    a.ph_lo = 0; a.ph_hi = N_PHASES;
    hipLaunchKernelGGL(fwd, dim3(grid), dim3(512), LDS_BYTES, stream, a);
#endif
    const hipError_t le = hipPeekAtLastError();
    if (le != hipSuccess) fprintf(stderr, "kernel_launch: launch failed: %s\n", hipGetErrorName(le));
}
```

```cpp
#include <hip/hip_runtime.h>
#include <hip/hip_bf16.h>
#include <cstdio>
#include <cstdint>

#ifndef MK_MULTI
#define MK_MULTI 0
#endif
#ifndef DBG_CHECK
#define DBG_CHECK 0
#endif
#ifndef DBG_LAST_PHASE
#define DBG_LAST_PHASE 9999
#endif

#ifndef EN_P0
#define EN_P0 1
#define EN_G1 1
#define EN_THIN 1
#define EN_TCONV 1
#define EN_NA 1
#define EN_ATTN 1
#define EN_G2 1
#define EN_LN 1
#define EN_G3 1
#define EN_G4 1
#endif

#ifndef REP_P0
#define REP_P0 1
#endif
#ifndef REP_G1
#define REP_G1 1
#endif
#ifndef REP_NA
#define REP_NA 1
#endif
#ifndef REP_ATTN
#define REP_ATTN 1
#endif
#ifndef REP_TCONV
#define REP_TCONV 1
#endif
#ifndef REP_THIN
#define REP_THIN 1
#endif
#ifndef REP_G3
#define REP_G3 1
#endif
#ifndef REP_G4
#define REP_G4 1
#endif
#ifndef ALIGN_EPI
#define ALIGN_EPI 1
#endif
#ifndef NT_STORE
#define NT_STORE 0
#endif
#ifndef X1_RECOMP
#define X1_RECOMP 1
#endif
#ifndef LN1_HOLD
#define LN1_HOLD 16
#endif
#ifndef DEFER_H
#define DEFER_H 0
#endif
#ifndef STAGGER
#define STAGGER 0
#endif
#ifndef REP_BAR
#define REP_BAR 1
#endif
#ifndef REP_DENSE
#define REP_DENSE 1
#endif
#ifndef REP_G2
#define REP_G2 1
#endif
#ifndef REP_LN1
#define REP_LN1 1
#endif
#ifndef REP_LN2
#define REP_LN2 1
#endif

#define GAS __attribute__((address_space(1)))
#define LAS __attribute__((address_space(3)))
typedef unsigned short bf16_t;
typedef short bf16x8 __attribute__((ext_vector_type(8)));
typedef short s16x4 __attribute__((ext_vector_type(4)));
typedef float f32x4 __attribute__((ext_vector_type(4)));
typedef float f32x2 __attribute__((ext_vector_type(2)));
typedef float f32x16 __attribute__((ext_vector_type(16)));
typedef unsigned u32x4 __attribute__((ext_vector_type(4)));
typedef unsigned u32x2 __attribute__((ext_vector_type(2)));
typedef GAS unsigned gu32;

constexpr int BATCH = 16, SEQ = 4096, DM = 1024, NTOK = BATCH * SEQ, DEPTH = 4;
constexpr int MEMLEN = 256, NMEM = BATCH * MEMLEN;
constexpr int NEXP = 32, NSLOT = NTOK * 4, IDXCAP = NTOK;
constexpr int GRIDW = 64;
constexpr float LN_EPS = 1e-5f;
constexpr float DN_ALPHA = 1.681792830507429f;
constexpr float LOG2E = 1.4426950408889634f;
constexpr float C2 = 0.125f * LOG2E;
__host__ __device__ constexpr int layer_kind(int l) { return l % 3; }
__host__ __device__ constexpr int layer_j(int l) { return l / 3; }
__host__ __device__ constexpr int in_width(int l) { return (l % 3) == 1 ? 1536 : 2560; }

#ifndef MOE_F8
#define MOE_F8 1
#endif
#ifndef INP_F8
#define INP_F8 1
#endif
constexpr int INP_EB = INP_F8 ? 1 : 2;
constexpr float WIN_SCALE = 32.0f;
#ifndef OUTP_F8
#define OUTP_F8 1
#endif
constexpr int OUT_EB = OUTP_F8 ? 1 : 2;
constexpr float WOUT_SCALE = 64.0f;
__device__ __forceinline__ unsigned char f2fp8(float x) { return (unsigned char)(__builtin_amdgcn_cvt_pk_fp8_f32(x, x, 0, false) & 0xff); }
#ifndef TCONV_F8
#define TCONV_F8 1
#endif
#ifndef Y_F8
#define Y_F8 1
#endif
constexpr float Y_SCALE = 64.0f;
constexpr int MOE_EB = MOE_F8 ? 1 : 2;
constexpr float W1_SCALE = 32.0f, W2_SCALE = 64.0f, H_SCALE = 4.0f;

constexpr size_t MiB = 1u << 20;
constexpr size_t WS_CTL = 0, CTL_ZERO_BYTES = 1 * MiB;
constexpr size_t WS_RW = 1 * MiB;
constexpr size_t WS_WIN = 2 * MiB;
constexpr size_t WS_WKV = 22 * MiB;
constexpr size_t WS_WOUT = 26 * MiB;
constexpr size_t WS_W1 = 34 * MiB;
constexpr size_t WS_W2 = 546 * MiB;
constexpr size_t WS_XB = 802 * MiB;
constexpr size_t WS_MEMB = 930 * MiB;
constexpr size_t WS_KVM = 938 * MiB;
constexpr size_t WS_PROJ = 954 * MiB;
constexpr size_t WS_CAT = 1274 * MiB;
constexpr size_t WS_H = 1402 * MiB;
constexpr size_t WS_Y = 1914 * MiB;
constexpr size_t WS_HRAWT = 2426 * MiB;
constexpr size_t WS_HPART = 2474 * MiB;
constexpr size_t WS_EXPID = 2478 * MiB;
constexpr size_t WS_GATE = 2479 * MiB;
constexpr size_t WS_IDX = 2480 * MiB;
constexpr size_t WS_SB = 2488 * MiB;
constexpr size_t WS_GIDX = 2616 * MiB;
constexpr size_t WS_END = 2624 * MiB;
constexpr size_t WS_UT3 = WS_H;
constexpr size_t WS_Z1T = WS_H + 288 * MiB;
constexpr size_t WS_Z2T = WS_H + 384 * MiB;
constexpr size_t WS_V8 = WS_Y;
constexpr size_t WS_QKR = WS_Y;
constexpr int CW_BAR = 4096;
constexpr int CW_CNT = 8192;
constexpr int CW_DBG = 12288;

constexpr int MISC_OFF = 150528;
constexpr int LDS_BYTES = 163840;

#define LDS_WAIT() asm volatile("s_waitcnt lgkmcnt(0)" ::: "memory")
#define VM_WAIT() asm volatile("s_waitcnt vmcnt(0)" ::: "memory")
__device__ __forceinline__ unsigned f2bf(float f) { unsigned u = __builtin_bit_cast(unsigned, f); return (u + 0x7fffu + ((u >> 16) & 1u)) >> 16; }
__device__ __forceinline__ unsigned pk2(float lo, float hi) { return f2bf(lo) | (f2bf(hi) << 16); }
__device__ __forceinline__ float bf2f(unsigned short b) { return __builtin_bit_cast(float, ((unsigned)b) << 16); }
__device__ __forceinline__ float bflo(unsigned w) { return __builtin_bit_cast(float, w << 16); }
__device__ __forceinline__ float bfhi(unsigned w) { return __builtin_bit_cast(float, w & 0xffff0000u); }
__device__ __forceinline__ float shflx(float v, int mask, int lane) { int t; asm volatile("v_mov_b32 %0, %1" : "=v"(t) : "v"(__builtin_bit_cast(int, v))); return __builtin_bit_cast(float, __builtin_amdgcn_ds_bpermute((lane ^ mask) << 2, t)); }
__device__ __forceinline__ int shflxi(int v, int mask, int lane) { return __builtin_amdgcn_ds_bpermute((lane ^ mask) << 2, v); }
template <int CTRL> __device__ __forceinline__ float dpp_x(float v) { return __builtin_bit_cast(float, __builtin_amdgcn_update_dpp(0, __builtin_bit_cast(int, v), CTRL, 0xF, 0xF, false)); }
__device__ __forceinline__ float group8_sum(float v) { v += dpp_x<0xB1>(v); v += dpp_x<0x4E>(v); v += dpp_x<0x141>(v); return v; }
__device__ __forceinline__ float wave_sum(float v, int  ) {
    v += dpp_x<0xB1>(v); v += dpp_x<0x4E>(v); v += dpp_x<0x141>(v); v += dpp_x<0x140>(v);
    v += __builtin_bit_cast(float, __builtin_amdgcn_update_dpp(0, __builtin_bit_cast(int, v), 0x142, 0xA, 0xF, false));
    v += __builtin_bit_cast(float, __builtin_amdgcn_update_dpp(0, __builtin_bit_cast(int, v), 0x143, 0xC, 0xF, false));
    return __builtin_bit_cast(float, __builtin_amdgcn_readlane(__builtin_bit_cast(int, v), 63));
}
__device__ __forceinline__ int lane_id_volatile() { int l; asm volatile("v_mbcnt_lo_u32_b32 %0, -1, 0\n\tv_mbcnt_hi_u32_b32 %0, -1, %0" : "=&v"(l)); return l; }
__device__ __forceinline__ int opaque_tid(int wave0) { return wave0 * 64 + lane_id_volatile(); }

#define XB_TMO      128
#define XB_XCNT(j)  (256  + 64 * (j))
#define XB_XSUB(j)  (1280 + 64 * (j))
#define XB_XGEN(j)  (2304 + 64 * (j))
#define XB_TOP      3328
#define XB_TOPGEN   3392
#define XCD_BAR_WORDS 3456
#define XB_SPIN_CAP (1u << 20)

__device__ __forceinline__ unsigned xb_ld(unsigned* p)              { return __hip_atomic_load(p, __ATOMIC_RELAXED, __HIP_MEMORY_SCOPE_AGENT); }
__device__ __forceinline__ unsigned xb_add(unsigned* p, unsigned v) { return __hip_atomic_fetch_add(p, v, __ATOMIC_RELAXED, __HIP_MEMORY_SCOPE_AGENT); }
__device__ __forceinline__ unsigned xb_xcc_id() { return (unsigned)__builtin_amdgcn_s_getreg((3 << 11) | 20) & 0xFu; }
#define XB_SPIN(cond, bar) do { unsigned _sp = 0; while (cond) { __builtin_amdgcn_s_sleep(1); \
    if ((++_sp & 255u) == 0u) { if (xb_ld(&(bar)[XB_TMO])) break; if (_sp > XB_SPIN_CAP) { atomicAdd(&(bar)[XB_TMO], 1u); break; } } } } while (0)

struct XcdBarrier {
    unsigned* bar; unsigned x;
    volatile LAS unsigned* st;
};
__device__ __forceinline__ XcdBarrier xcd_barrier_post(unsigned* bar, volatile LAS unsigned* st) {
    XcdBarrier b; b.bar = bar; b.x = xb_xcc_id(); b.st = st;
    if (threadIdx.x == 0) (void)xb_add(&bar[XB_XCNT(b.x)], 1u);
    return b;
}
__device__ __forceinline__ void xcd_barrier_complete(unsigned* bar, unsigned x, unsigned& nloc, unsigned& nx) {
    const unsigned G = gridDim.x * gridDim.y * gridDim.z;
    unsigned sum, cnt, mine, sp = 0u;
    for (;;) {
        sum = 0u; cnt = 0u; mine = 0u;
#pragma unroll 1
        for (unsigned j = 0; j < 16; ++j) { const unsigned c = xb_ld(&bar[XB_XCNT(j)]); sum += c; cnt += (c > 0u) ? 1u : 0u; mine = (j == x) ? c : mine; }
        if (sum == G) break;
        __builtin_amdgcn_s_sleep(1);
        if ((++sp & 255u) == 0u) { if (xb_ld(&bar[XB_TMO])) break; if (sp > XB_SPIN_CAP) { atomicAdd(&bar[XB_TMO], 1u); break; } }
    }
    nloc = mine > 0u ? mine : 1u; nx = cnt > 0u ? cnt : 1u;
}
__device__ __forceinline__ void xcd_barrier(const XcdBarrier& b, const int wave0) {
    asm volatile("s_waitcnt vmcnt(0)" ::: "memory");
    __syncthreads();
    if (wave0 == 0 && lane_id_volatile() == 0) {
        unsigned* bar = b.bar;
        __builtin_amdgcn_s_waitcnt(0);
        unsigned nloc = b.st[0], nx = b.st[1];
        if (nloc == 0u) { xcd_barrier_complete(bar, b.x, nloc, nx); b.st[0] = nloc; b.st[1] = nx; }
        const unsigned old = xb_add(&bar[XB_XSUB(b.x)], 1u);
        const unsigned gen = old / nloc;
        if (old + 1u == (gen + 1u) * nloc) {
            __builtin_amdgcn_fence(__ATOMIC_RELEASE, "agent");
            asm volatile("s_waitcnt vmcnt(0)" ::: "memory");
            const unsigned og = xb_add(&bar[XB_TOP], 1u);
            const unsigned tg = og / nx;
            if (og + 1u == (tg + 1u) * nx) xb_add(&bar[XB_TOPGEN], 1u);
            else XB_SPIN(xb_ld(&bar[XB_TOPGEN]) == tg, bar);
            __builtin_amdgcn_fence(__ATOMIC_ACQUIRE, "agent");
            xb_add(&bar[XB_XGEN(b.x)], 1u);
            asm volatile("s_waitcnt vmcnt(0)" ::: "memory");
        } else {
            XB_SPIN(xb_ld(&bar[XB_XGEN(b.x)]) == gen, bar);
            __builtin_amdgcn_fence(__ATOMIC_ACQUIRE, "agent");
            asm volatile("s_waitcnt vmcnt(0)" ::: "memory");
        }
    }
    __syncthreads();
}

namespace pg8 {
constexpr int BM = 256, BK = 64, HALF = 128, HTB = HALF * BK * 2  , STAGE_BYTES = 8 * HTB, NXCD = 8, WGM = 8;
__host__ __device__ __forceinline__ int lds_byte(int r, int c) { const int st = (r >> 4) * 2 + (c >> 5), rr = r & 15, cc = c & 31, ob = rr * 64 + cc * 2; return st * 1024 + (ob ^ (((ob >> 9) & 1) << 5)); }
__host__ __device__ __forceinline__ void stage_rc(int b, int& R, int& C) { const int st = b / 1024, sb = b % 1024, swz = sb ^ (((sb >> 9) & 1) << 5); R = (st >> 1) * 16 + swz / 64; C = (st & 1) * 32 + (swz % 64) / 2; }
__host__ __device__ __forceinline__ int perm32(int rho) { const int n = rho >> 4, i = rho & 15; return 8 * (i >> 2) + 4 * n + (i & 3); }

struct Unit { int pm, pn, e, p; };

struct DenseOrder {
    const char* A; const char* Bt; int KB; int nM, nN, nwg, G, c; int rep = 1;
    __device__ __forceinline__ void init(const void* A_, const void* Bt_, int M, int N, int KB_, int G_, int c_) { A = (const char*)A_; Bt = (const char*)Bt_; KB = KB_; nM = M / BM; nN = N / BM; nwg = nM * nN; G = G_; c = c_; }
    __device__ __forceinline__ bool next(int i, Unit& u) const {
        long L = (long)i * G + c; if (L >= (long)nwg * rep) return false;
        if (rep > 1) L %= nwg;
        int wgid = (int)L; { const int q = nwg / NXCD, r = nwg % NXCD, xcd = wgid % NXCD, off = wgid / NXCD; wgid = (xcd < r ? xcd * (q + 1) : r * (q + 1) + (xcd - r) * q) + off; }
        const int nig = WGM * nN, gid = wgid / nig, fm = gid * WGM, gsz = (nM - fm) < WGM ? (nM - fm) : WGM;
        u.pm = __builtin_amdgcn_readfirstlane(fm + ((wgid % nig) % gsz)); u.pn = __builtin_amdgcn_readfirstlane((wgid % nig) / gsz); u.e = 0; u.p = 0; return true;
    }
    __device__ __forceinline__ const char* a_base(const Unit& u) const { return A + (size_t)u.pm * BM * KB; }
    __device__ __forceinline__ const char* b_base(const Unit& u) const { return Bt + (size_t)u.pn * BM * KB; }
    __device__ __forceinline__ const int* idx_src(const Unit&) const { return nullptr; }
    __device__ __forceinline__ int nvalid(const Unit&) const { return BM; }
    static constexpr int ROW_SHIFT = 0;
};
template <int SHIFT  > struct MoeOrder {
    const char* A; const char* Bt; int KB; int nN; int G, c; size_t bstride; const LAS int* pref; const int* cnt; const int* idx;
    __device__ __forceinline__ bool next(int i, Unit& u) const {
        const long L = (long)i * G + c; const int tot = __builtin_amdgcn_readfirstlane(pref[NEXP]);
        if (L >= (long)tot * nN) return false;
        const int pg = __builtin_amdgcn_readfirstlane((int)(L / nN)); u.pn = __builtin_amdgcn_readfirstlane((int)(L % nN));
        int e = 0;
#pragma unroll
        for (int step = 16; step >= 1; step >>= 1) { const int v = __builtin_amdgcn_readfirstlane(pref[e + step]); e += (v <= pg) ? step : 0; }
        u.e = e; u.p = pg - __builtin_amdgcn_readfirstlane(pref[e]); u.pm = 0; return true;
    }
    __device__ __forceinline__ const char* a_base(const Unit&) const { return A; }
    __device__ __forceinline__ const char* b_base(const Unit& u) const { return Bt + (size_t)u.e * bstride + (size_t)u.pn * BM * KB; }
    __device__ __forceinline__ const int* idx_src(const Unit& u) const { return idx + (size_t)u.e * IDXCAP + u.p * BM; }
    __device__ __forceinline__ int nvalid(const Unit& u) const { const int n = __builtin_amdgcn_readfirstlane(pref[40 + u.e]) - u.p * BM; return n < BM ? n : BM; }
    static constexpr int ROW_SHIFT = SHIFT;
};

__device__ __forceinline__ unsigned cvt_pk_bf16(float lo, float hi) { unsigned r; asm volatile("v_cvt_pk_bf16_f32 %0, %1, %2" : "=v"(r) : "v"(lo), "v"(hi)); return r; }

struct EpiBf16s {
    static constexpr bool PERM = true; static constexpr bool HAS_BIAS = false;
    bf16_t* O; int ldc; unsigned smask; float scale; float base;
    __device__ __forceinline__ void operator()(const f32x4 (&acc)[2][2][4][2], const Unit& u, int wr, int wc, int fr, int fq) const {
        const int row0 = u.pm * BM + wr * 64 + fr, col0 = u.pn * BM + wc * 32 + 8 * fq;
        const float sc = (((smask >> u.pn) & 1u) ? scale : 1.f) * base;
#pragma unroll
        for (int ai = 0; ai < 2; ++ai)
#pragma unroll
            for (int m = 0; m < 4; ++m) { bf16_t* rowp = O + (size_t)(row0 + ai * HALF + m * 16) * ldc + col0;
#pragma unroll
                for (int bj = 0; bj < 2; ++bj) { const f32x4 v0 = acc[ai][bj][m][0] * sc, v1 = acc[ai][bj][m][1] * sc;
                    u32x4 w; w.x = cvt_pk_bf16(v0[0], v0[1]); w.y = cvt_pk_bf16(v0[2], v0[3]); w.z = cvt_pk_bf16(v1[0], v1[1]); w.w = cvt_pk_bf16(v1[2], v1[3]);
                    if (NT_STORE) __builtin_nontemporal_store(w, (u32x4*)(rowp + bj * HALF)); else *(u32x4*)(rowp + bj * HALF) = w; }
                asm volatile("" ::: "memory"); }
    }
};
struct EpiResB {
    static constexpr bool PERM = true; static constexpr bool HAS_BIAS = false;
    bf16_t* C; const void* res; int res_f32; int ldc; float alpha; float ascale;
    __device__ __forceinline__ void operator()(const f32x4 (&acc)[2][2][4][2], const Unit& u, int wr, int wc, int fr, int fq) const {
        const int row0 = u.pm * BM + wr * 64 + fr, col0 = u.pn * BM + wc * 32 + 8 * fq;
        if (res_f32) {
#pragma unroll
            for (int ai = 0; ai < 2; ++ai) { f32x4 r[4][2][2];
#pragma unroll
                for (int m = 0; m < 4; ++m)
#pragma unroll
                    for (int bj = 0; bj < 2; ++bj) { const float* rp = (const float*)res + (size_t)(row0 + ai * HALF + m * 16) * ldc + col0 + bj * HALF; r[m][bj][0] = *(const f32x4*)rp; r[m][bj][1] = *(const f32x4*)(rp + 4); }
#pragma unroll
                for (int m = 0; m < 4; ++m)
#pragma unroll
                    for (int bj = 0; bj < 2; ++bj) { const size_t off = (size_t)(row0 + ai * HALF + m * 16) * ldc + col0 + bj * HALF;
                        const f32x4 v0 = r[m][bj][0] * alpha + acc[ai][bj][m][0] * ascale, v1 = r[m][bj][1] * alpha + acc[ai][bj][m][1] * ascale;
                        u32x4 w; w.x = cvt_pk_bf16(v0[0], v0[1]); w.y = cvt_pk_bf16(v0[2], v0[3]); w.z = cvt_pk_bf16(v1[0], v1[1]); w.w = cvt_pk_bf16(v1[2], v1[3]);
                        *(u32x4*)(C + off) = w; }
                asm volatile("" ::: "memory"); }
        } else { u32x4 raw[2][4][2];
#pragma unroll
            for (int ai = 0; ai < 2; ++ai)
#pragma unroll
                for (int m = 0; m < 4; ++m)
#pragma unroll
                    for (int bj = 0; bj < 2; ++bj) raw[ai][m][bj] = __builtin_nontemporal_load((const u32x4*)((const bf16_t*)res + (size_t)(row0 + ai * HALF + m * 16) * ldc + col0 + bj * HALF));
#pragma unroll
            for (int ai = 0; ai < 2; ++ai)
#pragma unroll
                for (int m = 0; m < 4; ++m)
#pragma unroll
                    for (int bj = 0; bj < 2; ++bj) { const size_t off = (size_t)(row0 + ai * HALF + m * 16) * ldc + col0 + bj * HALF; const u32x4 rw = raw[ai][m][bj];
                        const f32x4 r0 = (f32x4){bflo(rw.x), bfhi(rw.x), bflo(rw.y), bfhi(rw.y)}, r1 = (f32x4){bflo(rw.z), bfhi(rw.z), bflo(rw.w), bfhi(rw.w)};
                        const f32x4 v0 = r0 * alpha + acc[ai][bj][m][0] * ascale, v1 = r1 * alpha + acc[ai][bj][m][1] * ascale;
                        u32x4 w; w.x = cvt_pk_bf16(v0[0], v0[1]); w.y = cvt_pk_bf16(v0[2], v0[3]); w.z = cvt_pk_bf16(v1[0], v1[1]); w.w = cvt_pk_bf16(v1[2], v1[3]);
                        *(u32x4*)(C + off) = w; }
        }
    }
};
struct Pend { u32x2 val[8]; };
struct EpiSwiglu {
    static constexpr bool PERM = true; static constexpr bool HAS_GATE = false; static constexpr bool HAS_BIAS = true;
    __device__ __forceinline__ void load_bias(const Unit& u, int wc, int fq, f32x4 (&bp)[4]) const { const float* bg = b1 + (size_t)u.e * 2048 + u.pn * HALF + wc * 32 + 8 * fq; bp[0] = *(const f32x4*)bg; bp[1] = *(const f32x4*)(bg + 4); bp[2] = *(const f32x4*)(bg + 1024); bp[3] = *(const f32x4*)(bg + 1028); }
    bf16_t* H; const float* b1;
    __device__ __forceinline__ void prepare(const f32x4 (&acc)[2][2][4][2], const Unit& u, int wr, int wc, int fr, int fq, Pend& pd) const {
        constexpr float ASC = 1.0f / W1_SCALE;
        const int j0 = u.pn * HALF + wc * 32 + 8 * fq; const float* bg = b1 + (size_t)u.e * 2048 + j0; const float* bu = bg + 1024;
        const f32x4 bg0 = *(const f32x4*)bg, bg1 = *(const f32x4*)(bg + 4), bu0 = *(const f32x4*)bu, bu1 = *(const f32x4*)(bu + 4);
#pragma unroll
        for (int q8 = 0; q8 < 8; ++q8) { const int ai = q8 >> 2, m = q8 & 3;
            float o[8];
#pragma unroll
            for (int q = 0; q < 8; ++q) { const float gb = (q < 4 ? bg0[q & 3] : bg1[q & 3]), ub = (q < 4 ? bu0[q & 3] : bu1[q & 3]);
                float g = acc[ai][0][m][q >> 2][q & 3] * ASC + gb, uu = acc[ai][1][m][q >> 2][q & 3] * ASC + ub;
                g = fminf(g, 7.0f); uu = fminf(fmaxf(uu, -7.0f), 7.0f);
                const float sg = __builtin_amdgcn_rcpf(1.0f + __builtin_amdgcn_exp2f(-1.702f * LOG2E * g));
                o[q] = (uu + 1.0f) * (g * sg); }
            int w0 = 0, w1 = 0;
            w0 = __builtin_amdgcn_cvt_pk_fp8_f32(o[0] * H_SCALE, o[1] * H_SCALE, w0, false); w0 = __builtin_amdgcn_cvt_pk_fp8_f32(o[2] * H_SCALE, o[3] * H_SCALE, w0, true);
            w1 = __builtin_amdgcn_cvt_pk_fp8_f32(o[4] * H_SCALE, o[5] * H_SCALE, w1, false); w1 = __builtin_amdgcn_cvt_pk_fp8_f32(o[6] * H_SCALE, o[7] * H_SCALE, w1, true);
            pd.val[q8] = (u32x2){(unsigned)w0, (unsigned)w1}; }
    }
    __device__ __forceinline__ void store_one(const u32x2 v, const LAS int* ids, const int r, const int nv, const int j0) const { if (r < nv) { const int slot = ids[r]; *(u32x2*)((unsigned char*)H + (size_t)slot * 1024 + j0) = v; } }
    __device__ __forceinline__ void operator()(const f32x4 (&acc)[2][2][4][2], const Unit& u, int wr, int wc, int fr, int fq, const LAS int* ids, const int nv, const f32x4 (&bp)[4]) const {
        constexpr float ASC = MOE_F8 ? 1.0f / W1_SCALE : 1.0f;
        constexpr float HS = MOE_F8 ? H_SCALE : 1.0f, KK = -1.702f * LOG2E, GA = ASC * KK, UA = ASC * HS / KK, ULO = 8.0f * HS / KK, UHI = -6.0f * HS / KK, GLO = 7.0f * KK;
        const int j0 = u.pn * HALF + wc * 32 + 8 * fq;
        const f32x4 bg0 = bp[0] * KK, bg1 = bp[1] * KK; f32x4 bu0 = (bp[2] + 1.0f) * (HS / KK), bu1 = (bp[3] + 1.0f) * (HS / KK);
        asm volatile("" : "+v"(bu0), "+v"(bu1));
        int rb = wr * 64 + fr; asm volatile("" : "+v"(rb));
        const LAS int* idp = ids + rb; int slots[8];
#pragma unroll
        for (int q = 0; q < 8; ++q) slots[q] = idp[(q >> 2) * HALF + (q & 3) * 16];
#pragma unroll
        for (int ai = 0; ai < 2; ++ai)
#pragma unroll
            for (int m = 0; m < 4; ++m) { const int r = ai * HALF + m * 16 + rb;
                if (r < nv) { const int slot = slots[ai * 4 + m];
                    float o[8];
#pragma unroll
                    for (int q = 0; q < 8; ++q) { const float gb = (q < 4 ? bg0[q & 3] : bg1[q & 3]), ub = (q < 4 ? bu0[q & 3] : bu1[q & 3]);
                        const float gp = fmaxf(__builtin_fmaf(acc[ai][0][m][q >> 2][q & 3], GA, gb), GLO);
                        const float us = fminf(fmaxf(__builtin_fmaf(acc[ai][1][m][q >> 2][q & 3], UA, ub), ULO), UHI);
                        const float sg = __builtin_amdgcn_rcpf(1.0f + __builtin_amdgcn_exp2f(gp));
                        o[q] = us * (gp * sg); }
                    if constexpr (MOE_F8) { int w0 = 0, w1 = 0;
                        w0 = __builtin_amdgcn_cvt_pk_fp8_f32(o[0], o[1], w0, false); w0 = __builtin_amdgcn_cvt_pk_fp8_f32(o[2], o[3], w0, true);
                        w1 = __builtin_amdgcn_cvt_pk_fp8_f32(o[4], o[5], w1, false); w1 = __builtin_amdgcn_cvt_pk_fp8_f32(o[6], o[7], w1, true);
                        *(u32x2*)((unsigned char*)H + (size_t)slot * 1024 + j0) = (u32x2){(unsigned)w0, (unsigned)w1};
                    } else { u32x4 w; w.x = cvt_pk_bf16(o[0], o[1]); w.y = cvt_pk_bf16(o[2], o[3]); w.z = cvt_pk_bf16(o[4], o[5]); w.w = cvt_pk_bf16(o[6], o[7]);
                        *(u32x4*)(H + (size_t)slot * 1024 + j0) = w; } } }
    }
};
struct EpiMoeOut {
    static constexpr bool PERM = true; static constexpr bool HAS_GATE = true; static constexpr bool HAS_BIAS = true;
    __device__ __forceinline__ void load_bias(const Unit& u, int wc, int fq, f32x4 (&bp)[4]) const { const float* bb = b2 + (size_t)u.e * 1024 + u.pn * BM + wc * 32 + 8 * fq; bp[0] = *(const f32x4*)bb; bp[1] = *(const f32x4*)(bb + 4); bp[2] = *(const f32x4*)(bb + HALF); bp[3] = *(const f32x4*)(bb + HALF + 4); }
    bf16_t* Y; const float* b2;   const float* gidx;
    __device__ __forceinline__ void operator()(const f32x4 (&acc)[2][2][4][2], const Unit& u, int wr, int wc, int fr, int fq, const LAS int* ids, const int nv, const f32x4 (&bp)[4]) const {
        const LAS float* gts = (const LAS float*)(ids + 768);
        constexpr float OSC = MOE_F8 ? 1.0f / (H_SCALE * W2_SCALE) : 1.0f;
        const int c0 = u.pn * BM + wc * 32 + 8 * fq;
        f32x4 bv[2][2]; bv[0][0] = bp[0]; bv[0][1] = bp[1]; bv[1][0] = bp[2]; bv[1][1] = bp[3];
        int rb = wr * 64 + fr; asm volatile("" : "+v"(rb));
        const LAS int* idp = ids + rb; int slots[8];
#pragma unroll
        for (int q = 0; q < 8; ++q) slots[q] = idp[(q >> 2) * HALF + (q & 3) * 16];
#pragma unroll
        for (int ai = 0; ai < 2; ++ai)
#pragma unroll
            for (int m = 0; m < 4; ++m) { const int r = ai * HALF + m * 16 + rb;
                if (r < nv) { const int slot = slots[ai * 4 + m]; const float gt = gts[r];
                    if constexpr (Y_F8) {
                        unsigned pk[2][2];
#pragma unroll
                        for (int bj = 0; bj < 2; ++bj) { const f32x4 s0 = (acc[ai][bj][m][0] * OSC + bv[bj][0]) * (gt * Y_SCALE), s1 = (acc[ai][bj][m][1] * OSC + bv[bj][1]) * (gt * Y_SCALE); int w0 = 0, w1 = 0;
                            w0 = __builtin_amdgcn_cvt_pk_fp8_f32(s0[0], s0[1], w0, false); w0 = __builtin_amdgcn_cvt_pk_fp8_f32(s0[2], s0[3], w0, true); w1 = __builtin_amdgcn_cvt_pk_fp8_f32(s1[0], s1[1], w1, false); w1 = __builtin_amdgcn_cvt_pk_fp8_f32(s1[2], s1[3], w1, true);
                            pk[bj][0] = (unsigned)w0; pk[bj][1] = (unsigned)w1; }
                        const auto x0 = __builtin_amdgcn_permlane16_swap(pk[0][0], pk[1][0], false, false), x1 = __builtin_amdgcn_permlane16_swap(pk[0][1], pk[1][1], false, false);
                        *(u32x4*)((unsigned char*)Y + (size_t)slot * 1024 + c0 + ((fq & 1) ? 120 : 0)) = (u32x4){x0[0], x1[0], x0[1], x1[1]};
                    } else {
#pragma unroll
                    for (int bj = 0; bj < 2; ++bj) { const f32x4 v0 = (acc[ai][bj][m][0] * OSC + bv[bj][0]) * gt, v1 = (acc[ai][bj][m][1] * OSC + bv[bj][1]) * gt;
                        u32x4 w; w.x = cvt_pk_bf16(v0[0], v0[1]); w.y = cvt_pk_bf16(v0[2], v0[3]); w.z = cvt_pk_bf16(v1[0], v1[1]); w.w = cvt_pk_bf16(v1[2], v1[3]);
                        if (NT_STORE) __builtin_nontemporal_store(w, (u32x4*)(Y + (size_t)slot * 1024 + c0 + bj * HALF)); else *(u32x4*)(Y + (size_t)slot * 1024 + c0 + bj * HALF) = w; } } } }
    }
};

__device__ __forceinline__ const char* uni_ptr(const char* p) { const unsigned long long v = (unsigned long long)p; const unsigned lo = __builtin_amdgcn_readfirstlane((unsigned)v), hi = __builtin_amdgcn_readfirstlane((unsigned)(v >> 32)); return (const char*)(((unsigned long long)hi << 32) | lo); }
typedef int v4i_t __attribute__((ext_vector_type(4))); typedef int v8i_t __attribute__((ext_vector_type(8)));
__device__ __forceinline__ v8i_t cat8(const bf16x8 a, const bf16x8 b) { return __builtin_shufflevector(__builtin_bit_cast(v4i_t, a), __builtin_bit_cast(v4i_t, b), 0, 1, 2, 3, 4, 5, 6, 7); }
template <class Epi, class Sched, bool GATHER, bool F8 = false, bool DEFER = false>
__device__ __forceinline__ void gemm_phase(LAS unsigned char* lds, const Sched& S, const Epi& E, const int tid) {
    const int wid = __builtin_amdgcn_readfirstlane(tid >> 6), lane = tid & 63, wr = wid >> 2, wc = wid & 3, fr = lane & 15, fq = lane >> 4;
    const int KB = S.KB, nt = KB / 128;
    unsigned voffA[2], voffB[2];
#pragma unroll
    for (int i = 0; i < 2; ++i) { int R, C; stage_rc(tid * 16 + i * 8192, R, C); const int Rb = Epi::PERM ? ((R & ~31) + perm32(R & 31)) : R;
        voffA[i] = (unsigned)(R * KB + C * 2); voffB[i] = (unsigned)(Rb * KB + C * 2); }
    const size_t kstep = (size_t)(BK * 2);
    const size_t hstep = (size_t)HALF * KB;
    const unsigned ldsw = (unsigned)wid * 1024u;
    const int aoff = lds_byte(wr * 64 + fr, fq * 8), boff = lds_byte(wc * 32 + fr, fq * 8);
#define PG8_SA(b, h) (((b) * 2 + (h)) * HTB)
#define PG8_SB(b, h) ((4 + (b) * 2 + (h)) * HTB)
#define PG8_STAGE(bufoff, gbase, voff) do { const char* _gb = uni_ptr((const char*)(gbase)); _Pragma("unroll") for (int _i = 0; _i < 2; ++_i) \
        __builtin_amdgcn_global_load_lds((const unsigned*)(_gb + (voff)[_i]), (LAS unsigned*)(lds + (bufoff) + ldsw + _i * 8192), 16, 0, 0); } while (0)
#define PG8_STAGE_A(bufoff, kb, h, GO) do { if constexpr (GATHER) { PG8_STAGE(bufoff, kb, (GO)[h]); } else { PG8_STAGE(bufoff, (kb) + (h) * hstep, voffA); } } while (0)
#define PG8_LDA(dst, b, h) do { if constexpr (F8) { _Pragma("unroll") for (int m = 0; m < 4; ++m) dst##8[m] = cat8(*(const LAS bf16x8*)(lds + PG8_SA(b, h) + aoff + m * 2048), *(const LAS bf16x8*)(lds + PG8_SA(b, h) + aoff + m * 2048 + 1024)); } else { \
        _Pragma("unroll") for (int m = 0; m < 4; ++m) _Pragma("unroll") for (int k = 0; k < 2; ++k) dst[m][k] = *(const LAS bf16x8*)(lds + PG8_SA(b, h) + aoff + m * 2048 + k * 1024); } } while (0)
#define PG8_LDB(dst, b, h) do { if constexpr (F8) { _Pragma("unroll") for (int n = 0; n < 2; ++n) dst##8[n] = cat8(*(const LAS bf16x8*)(lds + PG8_SB(b, h) + boff + n * 2048), *(const LAS bf16x8*)(lds + PG8_SB(b, h) + boff + n * 2048 + 1024)); } else { \
        _Pragma("unroll") for (int n = 0; n < 2; ++n) _Pragma("unroll") for (int k = 0; k < 2; ++k) dst[n][k] = *(const LAS bf16x8*)(lds + PG8_SB(b, h) + boff + n * 2048 + k * 1024); } } while (0)
#define PG8_MMA(ai, bj, At, Bt) do { __builtin_amdgcn_s_setprio(1); if constexpr (F8) { _Pragma("unroll") for (int m = 0; m < 4; ++m) _Pragma("unroll") for (int n = 0; n < 2; ++n) \
        acc[ai][bj][m][n] = __builtin_amdgcn_mfma_scale_f32_16x16x128_f8f6f4(Bt##8[n], At##8[m], acc[ai][bj][m][n], 0, 0, 0, 0, 0, 0); } else { \
        _Pragma("unroll") for (int m = 0; m < 4; ++m) _Pragma("unroll") for (int n = 0; n < 2; ++n) _Pragma("unroll") for (int k = 0; k < 2; ++k) \
        acc[ai][bj][m][n] = __builtin_amdgcn_mfma_f32_16x16x32_bf16(Bt[n][k], At[m][k], acc[ai][bj][m][n], 0, 0, 0); } __builtin_amdgcn_s_setprio(0); } while (0)
#define PG8_WAIT_V(n) asm volatile("s_waitcnt vmcnt(" #n ")" ::: "memory")
#define PG8_WAIT_L(n) asm volatile("s_waitcnt lgkmcnt(" #n ")" ::: "memory")
#define PG8_BAR __builtin_amdgcn_s_barrier()
#define PG8_SCHED __builtin_amdgcn_sched_barrier(0)
    LAS int* const ibuf = (LAS int*)(lds + STAGE_BYTES + 512);
#define PG8_IDMA(u, b) do { if constexpr (GATHER) { __builtin_amdgcn_global_load_lds((const unsigned*)(S.idx_src(u) + 64 * (wid & 3) + lane), (LAS unsigned*)(ibuf + (b) * 256 + 64 * (wid & 3)), 4, 0, 0); \
        if constexpr (Epi::HAS_GATE) __builtin_amdgcn_global_load_lds((const unsigned*)(E.gidx + (S.idx_src(u) - S.idx) + 64 * (wid & 3) + lane), (LAS unsigned*)(ibuf + 768 + (b) * 256 + 64 * (wid & 3)), 4, 0, 0); } } while (0)
#define PG8_GOFF(dst, u, b) do { if constexpr (GATHER) { int _t = tid; asm volatile("" : "+v"(_t)); const int _nv = S.nvalid(u); _Pragma("unroll") for (int _i = 0; _i < 2; ++_i) { int _R, _C; stage_rc(_t * 16 + _i * 8192, _R, _C); \
        _Pragma("unroll") for (int _h = 0; _h < 2; ++_h) { const int _r = _R + _h * HALF; const unsigned _s = (unsigned)ibuf[(b) * 256 + (_r < _nv ? _r : 0)]; dst[_h][_i] = (_s >> Sched::ROW_SHIFT) * (unsigned)KB + (unsigned)_C * 2u; } } } } while (0)
    Unit cur, nxt; int ui = 0;
    if (!S.next(0, cur)) return;
    f32x4 acc[2][2][4][2];
#pragma unroll
    for (int a = 0; a < 2; ++a)
#pragma unroll
        for (int b = 0; b < 2; ++b)
#pragma unroll
            for (int m = 0; m < 4; ++m)
#pragma unroll
                for (int n = 0; n < 2; ++n) acc[a][b][m][n] = (f32x4){0.f, 0.f, 0.f, 0.f};
    bf16x8 At[4][2], B0[2][2], B1[2][2];
    v8i_t At8[4], B08[2], B18[2];
    unsigned gA[2][2] = {{0u, 0u}, {0u, 0u}}, gN[2][2] = {{0u, 0u}, {0u, 0u}};
    int bsel = 0;
    f32x4 bpre[4] = {(f32x4){0.f, 0.f, 0.f, 0.f}, (f32x4){0.f, 0.f, 0.f, 0.f}, (f32x4){0.f, 0.f, 0.f, 0.f}, (f32x4){0.f, 0.f, 0.f, 0.f}};
    Pend pend; int ppn = 0, pnv = 0, pq = 8, pbuf = 0;
    if constexpr (DEFER) {
#pragma unroll
        for (int q = 0; q < 8; ++q) pend.val[q] = (u32x2){0u, 0u}; }
#define PG8_PSTORE() do { if constexpr (DEFER) { const int _l3 = lane_id_volatile(); const int _nv = (pq < 8) ? pnv : 0; \
        E.store_one(pend.val[0], ibuf + pbuf * 256, ((pq >> 2) & 1) * HALF + (pq & 3) * 16 + wr * 64 + (_l3 & 15), _nv, ppn * HALF + wc * 32 + 8 * (_l3 >> 4)); \
        _Pragma("unroll") for (int _q = 0; _q < 7; ++_q) pend.val[_q] = pend.val[_q + 1]; ++pq; } } while (0)
    if constexpr (GATHER) { PG8_IDMA(cur, 0); PG8_WAIT_V(0); PG8_BAR; }
    PG8_GOFF(gA, cur, 0);
    const char* cA = S.a_base(cur); const char* cB = S.b_base(cur);
    PG8_STAGE(PG8_SB(0, 0), cB, voffB); PG8_STAGE(PG8_SB(0, 1), cB + hstep, voffB); PG8_STAGE_A(PG8_SA(0, 0), cA, 0, gA); PG8_STAGE_A(PG8_SA(0, 1), cA, 1, gA);
    if (wr == 1) PG8_BAR;
    PG8_WAIT_V(2); PG8_BAR;
    PG8_STAGE(PG8_SB(1, 0), cB + kstep, voffB); PG8_STAGE_A(PG8_SA(1, 0), cA + kstep, 0, gA); PG8_STAGE(PG8_SB(1, 1), cB + hstep + kstep, voffB);
    PG8_WAIT_V(6); PG8_BAR;
    for (;;) {
        const bool has_next = S.next(ui + 1, nxt);
        const char* nA = has_next ? S.a_base(nxt) : cA; const char* nB = has_next ? S.b_base(nxt) : cB;
        const int bnxt = (bsel == 2) ? 0 : bsel + 1;
        if constexpr (GATHER) { if (has_next) PG8_IDMA(nxt, bnxt); }
        for (int t = 0; t < nt; t += 2) {
            const bool last = (t == nt - 2);
            const char* a1 = cA + (size_t)(t + 1) * kstep;
            const char* a2 = last ? nA : cA + (size_t)(t + 2) * kstep; const char* b2 = last ? nB : cB + (size_t)(t + 2) * kstep;
            const char* a3 = a2 + kstep; const char* b3 = b2 + kstep;
            if constexpr (GATHER) { if (last && has_next) { PG8_GOFF(gN, nxt, bnxt); } }
            if constexpr (Epi::HAS_BIAS) { if (last) E.load_bias(cur, wc, lane_id_volatile() >> 4, bpre); }
            PG8_LDB(B0, 0, 0); PG8_LDB(B1, 0, 1); PG8_SCHED; PG8_LDA(At, 0, 0); PG8_STAGE_A(PG8_SA(1, 1), a1, 1, gA);
            if constexpr (GATHER) { if (last && has_next) { gA[0][0] = gN[0][0]; gA[0][1] = gN[0][1]; gA[1][0] = gN[1][0]; gA[1][1] = gN[1][1]; } }
            PG8_WAIT_V(8); PG8_WAIT_L(0); PG8_BAR; PG8_MMA(0, 0, At, B0); PG8_MMA(0, 1, At, B1); PG8_BAR; PG8_SCHED;
            PG8_LDA(At, 0, 1); PG8_STAGE(PG8_SB(0, 0), b2, voffB); PG8_STAGE(PG8_SB(0, 1), b2 + hstep, voffB); PG8_STAGE_A(PG8_SA(0, 0), a2, 0, gA);
            PG8_WAIT_V(8); PG8_WAIT_L(0); PG8_BAR; PG8_MMA(1, 0, At, B0); PG8_MMA(1, 1, At, B1); PG8_BAR; PG8_SCHED;
            PG8_PSTORE();
            PG8_LDB(B0, 1, 0); PG8_LDB(B1, 1, 1); PG8_SCHED; PG8_LDA(At, 1, 0); PG8_STAGE_A(PG8_SA(0, 1), a2, 1, gA);
            PG8_WAIT_V(8); PG8_WAIT_L(0); PG8_BAR; PG8_MMA(0, 0, At, B0); PG8_MMA(0, 1, At, B1); PG8_BAR; PG8_SCHED;
            PG8_LDA(At, 1, 1); PG8_STAGE(PG8_SB(1, 0), b3, voffB); PG8_STAGE(PG8_SB(1, 1), b3 + hstep, voffB); PG8_STAGE_A(PG8_SA(1, 0), a3, 0, gA);
            PG8_WAIT_V(8); PG8_WAIT_L(0); PG8_BAR; PG8_MMA(1, 0, At, B0); PG8_MMA(1, 1, At, B1); PG8_BAR; PG8_SCHED;
            PG8_PSTORE();
        }
        if (ALIGN_EPI) { if (wr == 0) PG8_BAR; }
        { const int l2 = lane_id_volatile(), fr2 = l2 & 15, fq2 = l2 >> 4;
          if constexpr (DEFER) { _Pragma("unroll") for (int _f = 0; _f < 8; ++_f) PG8_PSTORE();
              E.prepare(acc, cur, wr, wc, fr2, fq2, pend); ppn = cur.pn; pnv = S.nvalid(cur); pq = 0; pbuf = bsel; }
          else if constexpr (GATHER) E(acc, cur, wr, wc, fr2, fq2, ibuf + bsel * 256, S.nvalid(cur), bpre); else E(acc, cur, wr, wc, fr2, fq2); }
        if (!has_next) break;
#pragma unroll
        for (int a = 0; a < 2; ++a)
#pragma unroll
            for (int b = 0; b < 2; ++b)
#pragma unroll
                for (int m = 0; m < 4; ++m)
#pragma unroll
                    for (int n = 0; n < 2; ++n) acc[a][b][m][n] = (f32x4){0.f, 0.f, 0.f, 0.f};
        cur = nxt; cA = nA; cB = nB; ++ui; bsel = bnxt;
        if (ALIGN_EPI) { if (wr == 1) PG8_BAR; }
    }
    if constexpr (DEFER) { _Pragma("unroll") for (int _f = 0; _f < 8; ++_f) PG8_PSTORE(); }
    PG8_WAIT_V(0);
    if (!ALIGN_EPI) { if (wr == 0) PG8_BAR; }
    PG8_BAR;
#undef PG8_PSTORE
#undef PG8_SA
#undef PG8_SB
#undef PG8_STAGE
#undef PG8_STAGE_A
#undef PG8_LDA
#undef PG8_LDB
#undef PG8_MMA
#undef PG8_WAIT_V
#undef PG8_WAIT_L
#undef PG8_BAR
#undef PG8_SCHED
#undef PG8_GOFF
#undef PG8_IDMA
}
}

namespace attn_body {
using bf16=__hip_bfloat16;
using bf16x8=__attribute__((ext_vector_type(8)))short;
using s16x4=__attribute__((ext_vector_type(4)))short;
using f32x16=__attribute__((ext_vector_type(16)))float;
using u32x4=__attribute__((ext_vector_type(4)))unsigned;
constexpr int D=64;
constexpr int NW=8,QBLK=32,QB=QBLK*NW,KVBLK=64;
constexpr int ATTN_UNIT_ROWS=QB;
__device__ __forceinline__ int crow(int r,int hi){return (r&3)+8*(r>>2)+4*hi;}
#define SBAR() __builtin_amdgcn_sched_barrier(0)
__device__ __forceinline__ void cmask(f32x16&p0,f32x16&p1,int jb,int qrel,int hi){
  const float NEG=-INFINITY; int kb=64*jb+4*hi;
  #pragma unroll
  for(int r=0;r<16;++r){int kv=kb+(r&3)+8*(r>>2); if(kv>qrel)p0[r]=NEG; if(kv+32>qrel)p1[r]=NEG;}
}

constexpr int NSLOT=3, SLOTB=8192;
constexpr int LDS_K=0, LDS_V=NSLOT*SLOTB, LDS_WS=2*NSLOT*SLOTB, LDS_OST=LDS_WS+NW*64*4, LDS_BYTES=LDS_OST+NW*4096;
constexpr float C2=0.125f*1.4426950408889634f;
__device__ __forceinline__ void glds16(const void*gsrc,unsigned lds_dst){unsigned keep;
  asm volatile("s_mov_b32 %0, m0\n\ts_mov_b32 m0, %2\n\ts_nop 0\n\tglobal_load_lds_dwordx4 %1, off\n\ts_mov_b32 m0, %0":"=&s"(keep):"v"(gsrc),"s"(lds_dst):"memory");}
__device__ __forceinline__ float max3f(float a,float b,float c){float r;asm("v_max3_f32 %0, %1, %2, %3":"=v"(r):"v"(a),"v"(b),"v"(c));return r;}
__device__ __forceinline__ float max2f(float a,float b){float r;asm("v_max_f32_e32 %0, %1, %2":"=v"(r):"v"(a),"v"(b));return r;}
__device__ __forceinline__ float fadd_s(float a,float b){float r;asm("v_add_f32_e32 %0, %1, %2":"=v"(r):"v"(a),"v"(b));return r;}
__device__ __forceinline__ float fsub_s(float a,float b){float r;asm("v_sub_f32_e32 %0, %1, %2":"=v"(r):"v"(a),"v"(b));return r;}
typedef float f32x2_t __attribute__((ext_vector_type(2))); typedef __bf16 bf16x2_t __attribute__((ext_vector_type(2)));
__device__ __forceinline__ unsigned cvtpk_s(float lo,float hi){f32x2_t v={lo,hi};bf16x2_t b=__builtin_convertvector(v,bf16x2_t);return __builtin_bit_cast(unsigned,b);}
#define WAIT_BAR(N) asm volatile("s_waitcnt vmcnt(" #N ") lgkmcnt(0)\n\ts_barrier":::"memory")

__device__ __forceinline__ void qkt(f32x16&p0,f32x16&p1,const char*Kslot,const bf16x8*qr,const f32x16&negm,int r32,int hi){
  const char*kb=Kslot+hi*1024+r32*16;
  #pragma unroll
  for(int d0=0;d0<4;++d0){
    const bf16x8 b0=*reinterpret_cast<const bf16x8*>(kb+d0*2048);
    const bf16x8 b1=*reinterpret_cast<const bf16x8*>(kb+d0*2048+512);
    if(d0==0){p0=__builtin_amdgcn_mfma_f32_32x32x16_bf16(b0,qr[0],negm,0,0,0);p1=__builtin_amdgcn_mfma_f32_32x32x16_bf16(b1,qr[0],negm,0,0,0);}
    else{p0=__builtin_amdgcn_mfma_f32_32x32x16_bf16(b0,qr[d0],p0,0,0,0);p1=__builtin_amdgcn_mfma_f32_32x32x16_bf16(b1,qr[d0],p1,0,0,0);}}
}
typedef __attribute__((address_space(3))) const char* lds_cptr;
typedef short v4i16_t __attribute__((ext_vector_type(4)));
__device__ __forceinline__ void kload8(bf16x8*kf,lds_cptr kp){
  kf[0]=*(const __attribute__((address_space(3))) bf16x8*)(kp);      kf[1]=*(const __attribute__((address_space(3))) bf16x8*)(kp+512);
  kf[2]=*(const __attribute__((address_space(3))) bf16x8*)(kp+2048); kf[3]=*(const __attribute__((address_space(3))) bf16x8*)(kp+2560);
  kf[4]=*(const __attribute__((address_space(3))) bf16x8*)(kp+4096); kf[5]=*(const __attribute__((address_space(3))) bf16x8*)(kp+4608);
  kf[6]=*(const __attribute__((address_space(3))) bf16x8*)(kp+6144); kf[7]=*(const __attribute__((address_space(3))) bf16x8*)(kp+6656);
}
__device__ __forceinline__ void kload2(bf16x8*kf,lds_cptr kp,int j){ kf[2*j]=*(const __attribute__((address_space(3))) bf16x8*)(kp+j*2048); kf[2*j+1]=*(const __attribute__((address_space(3))) bf16x8*)(kp+j*2048+512); }
__device__ __forceinline__ s16x4 vtr(lds_cptr p){ return __builtin_bit_cast(s16x4,__builtin_amdgcn_ds_read_tr16_b64_v4i16((__attribute__((address_space(3))) v4i16_t*)p)); }
__device__ __forceinline__ float rowmax(const f32x16&p0,const f32x16&p1){
  float a=max3f(p0[0],p0[1],p1[0]),b=max3f(p0[2],p0[3],p1[1]);a=max3f(a,p1[2],p1[3]);
  #pragma unroll
  for(int r=4;r<16;r+=4){a=max3f(a,p0[r],p0[r+1]);b=max3f(b,p0[r+2],p0[r+3]);a=max3f(a,p1[r],p1[r+1]);b=max3f(b,p1[r+2],p1[r+3]);}
  const float m=max2f(a,b);
  auto rr=__builtin_amdgcn_permlane32_swap(__float_as_uint(m),__float_as_uint(m),false,false);
  return max2f(__uint_as_float(rr[0]),__uint_as_float(rr[1]));
}
__device__ __forceinline__ void pv(f32x16*o,int vb,bf16x8 pa0,bf16x8 pa1,bf16x8 pa2,bf16x8 pa3){
  #pragma unroll
  for(int d0=0;d0<2;++d0){s16x4 lo[4],hi[4];
    #pragma unroll
    for(int ks=0;ks<4;++ks){
      asm volatile("ds_read_b64_tr_b16 %0,%1 offset:%c2":"=&v"(lo[ks]):"v"(vb),"i"(d0*4096+ks*1024):"memory");
      asm volatile("ds_read_b64_tr_b16 %0,%1 offset:%c2":"=&v"(hi[ks]):"v"(vb),"i"(d0*4096+ks*1024+512):"memory");}
    asm volatile("s_waitcnt lgkmcnt(0)":::"memory");SBAR();
    #define PK(k) (bf16x8){lo[k][0],lo[k][1],lo[k][2],lo[k][3],hi[k][0],hi[k][1],hi[k][2],hi[k][3]}
    o[d0]=__builtin_amdgcn_mfma_f32_32x32x16_bf16(pa0,PK(0),o[d0],0,0,0);
    o[d0]=__builtin_amdgcn_mfma_f32_32x32x16_bf16(pa1,PK(1),o[d0],0,0,0);
    o[d0]=__builtin_amdgcn_mfma_f32_32x32x16_bf16(pa2,PK(2),o[d0],0,0,0);
    o[d0]=__builtin_amdgcn_mfma_f32_32x32x16_bf16(pa3,PK(3),o[d0],0,0,0);
    #undef PK
  }
}

#ifndef ATTN_STORE16
#define ATTN_STORE16(p,v) (*(u32x4*)(p)=(v))
#endif
template<int THRL, bool O8 = false> __device__ __forceinline__ void attn_unit(const bf16*Qu,const bf16*__restrict__ Kh,const bf16*__restrict__ Vh,bf16*Ou,const int QP,const int KP,const int VP,const int OP,const int NT,char*shm,const int tid){
  const int lane=tid&63,r32=lane&31,hi=lane>>5; const int wid=__builtin_amdgcn_readfirstlane(tid>>6);
  const bf16*Qw=Qu+(long)(wid*QBLK)*QP;
  const unsigned lds0=(unsigned)(uintptr_t)shm;
  float*wsf=(float*)(shm+LDS_WS)+wid*64;
  const bf16*ksrc=Kh+(long)lane*KP+wid*8;
  const bf16*vsrc=Vh+(long)(16*(wid&3)+(lane>>2))*VP+(wid>>2)*32+(lane&3)*8;
  const unsigned kdst=lds0+LDS_K+wid*1024, vdst=lds0+LDS_V+wid*1024;
  #define DMA_K(t,slot) glds16(ksrc+(long)(t)*KVBLK*KP,(unsigned)__builtin_amdgcn_readfirstlane(kdst+(slot)))
  #define DMA_V(t,slot) glds16(vsrc+(long)(t)*KVBLK*VP,(unsigned)__builtin_amdgcn_readfirstlane(vdst+(slot)))
  const int vb0=(int)(lds0+LDS_V)+((lane>>4)&1)*32+(lane&3)*8+(4*hi+((lane&15)>>2))*64;
  const char*Kbase=shm+LDS_K; bf16x8 kf[8];
  const lds_cptr shm3=(lds_cptr)shm; const lds_cptr kp0=shm3+LDS_K+hi*1024+r32*16; const lds_cptr vp0=shm3+LDS_V+((lane>>4)&1)*32+(lane&3)*8+(4*hi+((lane&15)>>2))*64;
  DMA_K(0,0);DMA_V(0,0);DMA_K(1,SLOTB);
  bf16x8 qr[4];
  #pragma unroll
  for(int d0=0;d0<4;++d0)qr[d0]=*reinterpret_cast<const bf16x8*>(&Qw[(long)r32*QP+d0*16+hi*8]);
  float mhat=0.f,l_reg=0.f;f32x16 o[2];f32x16 negm; { float z_=0.f; asm volatile("":"+v"(z_)); _Pragma("unroll") for(int r=0;r<16;++r){o[0][r]=z_;o[1][r]=z_;negm[r]=z_;} } asm volatile("":"+v"(negm));
  #define CMASK(P0,P1,t) do{}while(0)
  bool resc=false;
  #define START(P0,P1) do{ const float rm=rowmax(P0,P1); resc=false; \
    { const float dl=rm; mhat=fadd_s(mhat,dl); \
      _Pragma("unroll") for(int r=0;r<16;++r){P0[r]=fsub_s(P0[r],dl);P1[r]=fsub_s(P1[r],dl);} \
      _Pragma("unroll") for(int r=0;r<16;++r)negm[r]=-mhat; asm volatile("":"+v"(negm)); } \
    _Pragma("unroll") for(int r=0;r<16;++r)P0[r]=__builtin_amdgcn_exp2f(P0[r]); }while(0)
  #define RESC() do{ if(resc){ asm volatile("s_waitcnt lgkmcnt(0)":::"memory"); \
      _Pragma("unroll") for(int d_=0;d_<2;++d_) _Pragma("unroll") for(int r=0;r<16;++r)o[d_][r]*=wsf[crow(r,hi)]; } }while(0)
  f32x16 pA0,pA1,pB0,pB1;
  int sl_prev=0,sl_cur=0,sl_next=SLOTB;
  #define ROT() do{sl_prev=sl_cur;sl_cur=sl_next;sl_next=(sl_next==(NSLOT-1)*SLOTB)?0:sl_next+SLOTB;}while(0)
  DMA_K(2,2*SLOTB);
  WAIT_BAR(3);
  qkt(pA0,pA1,Kbase,qr,negm,r32,hi);asm volatile("s_nop 15\n\ts_nop 7":"+v"(pA0),"+v"(pA1));CMASK(pA0,pA1,0);
  START(pA0,pA1);
  _Pragma("unroll") for(int r=0;r<16;++r)pA1[r]=__builtin_amdgcn_exp2f(pA1[r]);
  WAIT_BAR(0);
  DMA_K(3,0);DMA_V(1,SLOTB);
  ROT();
  kload8(kf,kp0+sl_cur);
  WAIT_BAR(2);
  s16x4 vlo[8],vhi[8]; u32x4 pw0,pw1,pw2,pw3;
  #define PKW(P,B) cvtpk_s(P[B],P[B+1])
  #define PAF(k) __builtin_bit_cast(bf16x8,pw##k)
  #define VFR(i) (bf16x8){vlo[i][0],vlo[i][1],vlo[i][2],vlo[i][3],vhi[i][0],vhi[i][1],vhi[i][2],vhi[i][3]}
  #define PIN(x) asm volatile("":"+v"(x))
  #define MX3(a,b,c) __builtin_fmaxf(__builtin_fmaxf((a),(b)),(c))
  #define GAPA(MF,A0,A1,A2,A3,W0,W1,PW) do{ MF; sacc+=A0; sacc+=A1; sacc+=A2; sacc+=A3; PIN(sacc); W0; W1; PIN(PW); SBAR(); }while(0)
  #define EX(v) __builtin_amdgcn_exp2f(v)
  #define GAPB(MF,X,B) do{ MF; X[B]=EX(X[B]); X[B+1]=EX(X[B+1]); X[B+2]=EX(X[B+2]); X[B+3]=EX(X[B+3]); PIN(X); SBAR(); }while(0)
  #define VRD(i) do{ vlo[i]=vtr(vp_+(((i)>>2)*4096+((i)&3)*1024)); vhi[i]=vtr(vp_+(((i)>>2)*4096+((i)&3)*1024+512)); }while(0)
  #define KRD(G,j) do{ if(G){ kload2(kf,kp0+sl_next,j); SBAR(); } }while(0)
  #define STEP(C0,C1,P0,P1,t,GK,GV,GL) do{ SBAR(); \
    const lds_cptr vp_=vp0+sl_prev; \
    VRD(0); SBAR(); float sacc=(P0[0]+P0[1]); \
    GAPA(C0=__builtin_amdgcn_mfma_f32_32x32x16_bf16(kf[0],qr[0],negm,0,0,0), P0[2],P0[3],P0[4],P0[5],     pw0[0]=PKW(P0,0), pw0[1]=PKW(P0,2), pw0); \
    VRD(4); SBAR(); GAPA(C1=__builtin_amdgcn_mfma_f32_32x32x16_bf16(kf[1],qr[0],negm,0,0,0), P0[6],P0[7],P0[8],P0[9],     pw0[2]=PKW(P0,4), pw0[3]=PKW(P0,6), pw0); \
    VRD(1); SBAR(); GAPA(C0=__builtin_amdgcn_mfma_f32_32x32x16_bf16(kf[2],qr[1],C0,0,0,0),   P0[10],P0[11],P0[12],P0[13], pw1[0]=PKW(P0,8), pw1[1]=PKW(P0,10), pw1); \
    VRD(5); SBAR(); GAPA(C1=__builtin_amdgcn_mfma_f32_32x32x16_bf16(kf[3],qr[1],C1,0,0,0),   P0[14],P0[15],P1[0],P1[1],   pw1[2]=PKW(P0,12),pw1[3]=PKW(P0,14), pw1); \
    VRD(2); SBAR(); GAPA(C0=__builtin_amdgcn_mfma_f32_32x32x16_bf16(kf[4],qr[2],C0,0,0,0),   P1[2],P1[3],P1[4],P1[5],     pw2[0]=PKW(P1,0), pw2[1]=PKW(P1,2), pw2); \
    VRD(6); SBAR(); GAPA(C1=__builtin_amdgcn_mfma_f32_32x32x16_bf16(kf[5],qr[2],C1,0,0,0),   P1[6],P1[7],P1[8],P1[9],     pw2[2]=PKW(P1,4), pw2[3]=PKW(P1,6), pw2); \
    VRD(3); SBAR(); GAPA(C0=__builtin_amdgcn_mfma_f32_32x32x16_bf16(kf[6],qr[3],C0,0,0,0),   P1[10],P1[11],P1[12],P1[13], pw3[0]=PKW(P1,8), pw3[1]=PKW(P1,10), pw3); \
    VRD(7); SBAR(); GAPA(C1=__builtin_amdgcn_mfma_f32_32x32x16_bf16(kf[7],qr[3],C1,0,0,0),   P1[14],P1[15],0.f,0.f,       pw3[2]=PKW(P1,12),pw3[3]=PKW(P1,14), pw3); \
    l_reg+=sacc; \
    if(GK){DMA_K((t)+3,sl_cur);} if(GV){DMA_V((t)+1,sl_next);} \
    CMASK(C0,C1,t); \
    { float a=MX3(C0[0],C0[1],C1[0]),b=MX3(C0[2],C0[3],C1[1]); a=MX3(a,C1[2],C1[3]); \
      _Pragma("unroll") for(int r=4;r<16;r+=4){a=MX3(a,C0[r],C0[r+1]);b=MX3(b,C0[r+2],C0[r+3]);a=MX3(a,C1[r],C1[r+1]);b=MX3(b,C1[r+2],C1[r+3]);} \
      float rm=__builtin_fmaxf(a,b); { auto rr=__builtin_amdgcn_permlane32_swap(__float_as_uint(rm),__float_as_uint(rm),false,false); rm=__builtin_fmaxf(__uint_as_float(rr[0]),__uint_as_float(rr[1])); } \
      resc=false; \
      if(__builtin_expect(__any(rm>(float)THRL),0)){ const float dl=__builtin_fmaxf(rm,0.f); mhat+=dl; \
        _Pragma("unroll") for(int r=0;r<16;++r){C0[r]-=dl;C1[r]-=dl;} \
        _Pragma("unroll") for(int r=0;r<16;++r)negm[r]=-mhat; asm volatile("":"+v"(negm)); \
        const float f=__builtin_amdgcn_exp2f(-dl); l_reg*=f; if(hi==0)wsf[r32]=f; resc=true; } } \
    SBAR(); \
    GAPB(o[0]=__builtin_amdgcn_mfma_f32_32x32x16_bf16(PAF(0),VFR(0),o[0],0,0,0), C0,0); \
    GAPB(o[1]=__builtin_amdgcn_mfma_f32_32x32x16_bf16(PAF(0),VFR(4),o[1],0,0,0), C0,4); \
    KRD(GL,0); GAPB(o[0]=__builtin_amdgcn_mfma_f32_32x32x16_bf16(PAF(1),VFR(1),o[0],0,0,0), C0,8); \
    KRD(GL,1); GAPB(o[1]=__builtin_amdgcn_mfma_f32_32x32x16_bf16(PAF(1),VFR(5),o[1],0,0,0), C0,12); \
    KRD(GL,2); GAPB(o[0]=__builtin_amdgcn_mfma_f32_32x32x16_bf16(PAF(2),VFR(2),o[0],0,0,0), C1,0); \
    KRD(GL,3); GAPB(o[1]=__builtin_amdgcn_mfma_f32_32x32x16_bf16(PAF(2),VFR(6),o[1],0,0,0), C1,4); \
    GAPB(o[0]=__builtin_amdgcn_mfma_f32_32x32x16_bf16(PAF(3),VFR(3),o[0],0,0,0), C1,8); \
    GAPB(o[1]=__builtin_amdgcn_mfma_f32_32x32x16_bf16(PAF(3),VFR(7),o[1],0,0,0), C1,12); \
    }while(0)
  int t=1;
  #undef CMASK
  #define CMASK(P0,P1,t) do{}while(0)
  for(;t+5<NT;t+=2){
    STEP(pB0,pB1,pA0,pA1,t,true,true,true);     WAIT_BAR(2); RESC(); ROT();
    STEP(pA0,pA1,pB0,pB1,t+1,true,true,true);   WAIT_BAR(2); RESC(); ROT();
  }
  #undef CMASK
  #define CMASK(P0,P1,t) do{}while(0)
  #define ENDW(tt) do{ if((tt)+3<NT){WAIT_BAR(2);} else if((tt)+2<NT){WAIT_BAR(1);} else {WAIT_BAR(0);} }while(0)
  for(;t+1<NT;t+=2){
    STEP(pB0,pB1,pA0,pA1,t,(t+3<NT),(t+1<NT),(t+1<NT));       ENDW(t);   RESC(); ROT();
    STEP(pA0,pA1,pB0,pB1,t+1,(t+4<NT),(t+2<NT),(t+2<NT));     ENDW(t+1); RESC(); ROT();
  }
  STEP(pB0,pB1,pA0,pA1,NT-1,false,false,false); RESC();
  { float sacc=pB0[0]+pB0[1]; _Pragma("unroll") for(int r=2;r<16;++r)sacc+=pB0[r]; _Pragma("unroll") for(int r=0;r<16;++r)sacc+=pB1[r]; l_reg+=sacc;
    pw0=(u32x4){PKW(pB0,0),PKW(pB0,2),PKW(pB0,4),PKW(pB0,6)};pw1=(u32x4){PKW(pB0,8),PKW(pB0,10),PKW(pB0,12),PKW(pB0,14)};pw2=(u32x4){PKW(pB1,0),PKW(pB1,2),PKW(pB1,4),PKW(pB1,6)};pw3=(u32x4){PKW(pB1,8),PKW(pB1,10),PKW(pB1,12),PKW(pB1,14)};
    SBAR(); pv(o,vb0+sl_cur,PAF(0),PAF(1),PAF(2),PAF(3)); }
  #undef PKW
  #undef PAF
  #undef VFR
  #undef PIN
  #undef MX3
  #undef GAPA
  #undef GAPB
  #undef EX
  #undef VRD
  #undef KRD
  #undef STEP
  #undef ENDW
  {auto rr=__builtin_amdgcn_permlane32_swap(__float_as_uint(l_reg),__float_as_uint(l_reg),false,false);l_reg=__uint_as_float(rr[0])+__uint_as_float(rr[1]);}
  if(hi==0)wsf[32+r32]=l_reg;asm volatile("s_waitcnt lgkmcnt(0)":::"memory");
  float rli[16];
  #pragma unroll
  for(int r=0;r<16;++r)rli[r]=__builtin_amdgcn_rcpf(wsf[32+crow(r,hi)]);
  if constexpr (O8) {
    unsigned char*Ow8=(unsigned char*)Ou+(long)(wid*QBLK)*OP; unsigned char*stg8=(unsigned char*)(shm+LDS_OST)+wid*2048;
    #pragma unroll
    for(int r=0;r<16;++r){const int orow=crow(r,hi);
      #pragma unroll
      for(int d0=0;d0<2;++d0)stg8[orow*64+d0*32+r32]=f2fp8(o[d0][r]*rli[r]);}
    asm volatile("s_waitcnt lgkmcnt(0)":::"memory");
    #pragma unroll
    for(int i=0;i<2;++i){const int row=i*16+(lane>>2),ch=lane&3; const u32x4 v=*(const u32x4*)(stg8+row*64+ch*16); ATTN_STORE16(Ow8+(long)row*OP+ch*16,v);}
  } else {
  bf16*Ow=Ou+(long)(wid*QBLK)*OP;
  { bf16*stg=(bf16*)(shm+LDS_OST)+wid*2048;
    #pragma unroll
    for(int r=0;r<16;++r){const int orow=crow(r,hi);
      #pragma unroll
      for(int d0=0;d0<2;++d0)stg[orow*64+d0*32+r32]=__float2bfloat16(o[d0][r]*rli[r]);}
    asm volatile("s_waitcnt lgkmcnt(0)":::"memory");
    #pragma unroll
    for(int i=0;i<4;++i){const int row=i*8+(lane>>3),ch=lane&7; const u32x4 v=*(const u32x4*)(stg+row*64+ch*8); ATTN_STORE16(Ow+(long)row*OP+ch*8,v);} }
  }
  asm volatile("s_waitcnt lgkmcnt(0)\n\ts_barrier":::"memory");
  #undef DMA_K
  #undef DMA_V
  #undef CMASK
  #undef START
  #undef RESC
  #undef ROT
}
constexpr int ATTN_LDS_BYTES=LDS_BYTES;
#undef SBAR
#undef WAIT_BAR
}

struct Args { const float* in[32]; float* out; unsigned char* ws; int ph_lo, ph_hi; };
struct Ctx {
    LAS unsigned char* lds;
    int vcu, G;
    unsigned char* ws;
};
constexpr int PTAB_OFF = MISC_OFF + 256;
__device__ __forceinline__ unsigned long long ptab_get(const Ctx& cx, int k) {
    const LAS unsigned* t = (const LAS unsigned*)(cx.lds + PTAB_OFF) + 2 * k; const unsigned lo = __builtin_amdgcn_readfirstlane(t[0]), hi = __builtin_amdgcn_readfirstlane(t[1]);
    return ((unsigned long long)hi << 32) | lo;
}
#define INP(k) ((const float*)(GAS const float*)ptab_get(cx, (k)))

template <bool F8> __device__ __forceinline__ void p0_transpose64(const float* W, int N, int KB, unsigned char* WT, int k0, int n0, int dst_row0, float scale, LAS float* scr, int lane) {
    f32x4 v[16];
    const float* src = W + (size_t)(k0 + (lane >> 4)) * N + n0 + (lane & 15) * 4;
#pragma unroll
    for (int i = 0; i < 16; ++i) v[i] = __builtin_nontemporal_load((const f32x4*)(src + (size_t)(4 * i) * N));
#pragma unroll
    for (int i = 0; i < 16; ++i) { LAS float* p = scr + (4 * i + (lane >> 4)) * 65 + (lane & 15) * 4; p[0] = v[i][0]; p[1] = v[i][1]; p[2] = v[i][2]; p[3] = v[i][3]; }
    LDS_WAIT(); asm volatile("" ::: "memory");
    if constexpr (!F8) {
        const int ns = lane >> 3, ch = lane & 7;
#pragma unroll
        for (int r8 = 0; r8 < 8; ++r8) { const int n = r8 * 8 + ns; const LAS float* s = scr + (8 * ch) * 65 + n;
            u32x4 o; o.x = pk2(s[0 * 65], s[1 * 65]); o.y = pk2(s[2 * 65], s[3 * 65]); o.z = pk2(s[4 * 65], s[5 * 65]); o.w = pk2(s[6 * 65], s[7 * 65]);
            *(GAS u32x4*)(WT + (size_t)(dst_row0 + n) * KB + (k0 + 8 * ch) * 2) = o; }
    } else {
        const int ns = lane >> 2, ch = lane & 3;
#pragma unroll
        for (int r4 = 0; r4 < 4; ++r4) { const int n = r4 * 16 + ns; const LAS float* s = scr + (16 * ch) * 65 + n; unsigned w[4];
#pragma unroll
            for (int q = 0; q < 4; ++q) { int r = 0; r = __builtin_amdgcn_cvt_pk_fp8_f32(s[(4 * q) * 65] * scale, s[(4 * q + 1) * 65] * scale, r, false); r = __builtin_amdgcn_cvt_pk_fp8_f32(s[(4 * q + 2) * 65] * scale, s[(4 * q + 3) * 65] * scale, r, true); w[q] = (unsigned)r; }
            *(GAS u32x4*)(WT + (size_t)(dst_row0 + n) * KB + k0 + 16 * ch) = (u32x4){w[0], w[1], w[2], w[3]}; }
    }
    LDS_WAIT(); asm volatile("" ::: "memory");
}
__device__ __forceinline__ void p0_prologue(const Ctx& cx, const int tid) {
    const int lane = tid & 63, wave = __builtin_amdgcn_readfirstlane(tid >> 6);
    LAS float* scr = (LAS float*)(cx.lds + wave * 16896);
    const int gw = cx.vcu * 8 + wave, NGW = cx.G * 8;
    constexpr int I_WIN0 = 16 * 40, I_WIN1 = 16 * 24, I_WKV = 16 * 8, I_WOUT = 16 * 16, I_W1 = 16 * 32, I_W2 = 16 * 16;
    constexpr int T_WIN = 3 * I_WIN0 + I_WIN1, T_WKV = 4 * I_WKV, T_WOUT = 4 * I_WOUT, T_W1 = 128 * I_W1, T_W2 = 128 * I_W2;
    constexpr int NITEMS = T_WIN + T_WKV + T_WOUT + T_W1 + T_W2;
    for (int it = gw; it < NITEMS; it += NGW) {
        int r = it;
        const float* W; unsigned char* WT; int N, nb, kb, dst_row0; bool isout = false;
        if (r < T_W1) {
            const int mi = r / I_W1, q = r % I_W1; N = 2048; kb = q / 32; nb = q % 32;
            W = INP(28) + (size_t)mi * 1024 * 2048; WT = cx.ws + WS_W1 + (size_t)mi * 2048 * 1024 * MOE_EB;
            const int n0 = nb * 64, isu = n0 >= 1024, j = n0 - isu * 1024;
            dst_row0 = (j >> 7) * 256 + isu * 128 + (j & 127);
            p0_transpose64<MOE_F8>(W, N, 1024 * MOE_EB, WT, kb * 64, nb * 64, dst_row0, W1_SCALE, scr, lane); continue;
        } else if ((r -= T_W1) < T_W2) {
            const int mi = r / I_W2, q = r % I_W2; N = 1024; kb = q / 16; nb = q % 16;
            W = INP(30) + (size_t)mi * 1024 * 1024; WT = cx.ws + WS_W2 + (size_t)mi * 1024 * 1024 * MOE_EB; dst_row0 = nb * 64;
            p0_transpose64<MOE_F8>(W, N, 1024 * MOE_EB, WT, kb * 64, nb * 64, dst_row0, W2_SCALE, scr, lane); continue;
        } else if ((r -= T_W2) < T_WIN) {
            int l, q;
            if (r < I_WIN0) { l = 0; q = r; } else if (r < I_WIN0 + I_WIN1) { l = 1; q = r - I_WIN0; } else if (r < 2 * I_WIN0 + I_WIN1) { l = 2; q = r - I_WIN0 - I_WIN1; } else { l = 3; q = r - 2 * I_WIN0 - I_WIN1; }
            N = in_width(l); const int nbn = N / 64; kb = q / nbn; nb = q % nbn;
            const int kind = layer_kind(l), j = layer_j(l);
            W = (kind == 0 ? INP(2) : kind == 1 ? INP(4) : INP(7)) + (size_t)j * 1024 * N;
            WT = cx.ws + WS_WIN + (size_t)l * 5 * MiB; dst_row0 = nb * 64;
        } else if ((r -= T_WIN) < T_WKV) {
            const int l = r / I_WKV, q = r % I_WKV; N = 512; kb = q / 8; nb = q % 8;
            W = INP(20) + (size_t)l * 1024 * 512; WT = cx.ws + WS_WKV; dst_row0 = l * 512 + nb * 64;
        } else {
            r -= T_WKV; const int l = r / I_WOUT, q = r % I_WOUT; N = 1024; kb = q / 16; nb = q % 16;
            W = INP(21) + (size_t)l * 1024 * 1024; WT = cx.ws + WS_WOUT + (size_t)l * 2 * MiB; dst_row0 = nb * 64; isout = true;
        }
        if (isout) p0_transpose64<OUTP_F8 != 0>(W, N, 1024 * OUT_EB, WT, kb * 64, nb * 64, dst_row0, OUTP_F8 ? WOUT_SCALE : 1.0f, scr, lane);
        else p0_transpose64<INP_F8 != 0>(W, N, 1024 * INP_EB, WT, kb * 64, nb * 64, dst_row0, INP_F8 ? WIN_SCALE : 1.0f, scr, lane);
    }
    {
        const size_t gt = (size_t)cx.vcu * 512 + tid, NT_ = (size_t)cx.G * 512;
        for (int which = 0; which < 2; ++which) {
            const f32x4* xs = (const f32x4*)(which == 0 ? INP(0) : INP(1)); unsigned char* xd = cx.ws + (which == 0 ? WS_XB : WS_MEMB); const size_t n8 = (size_t)(which == 0 ? NTOK : NMEM) * DM / 8;
#pragma unroll 4
            for (size_t i = gt; i < n8; i += NT_) { const f32x4 a = __builtin_nontemporal_load(xs + 2 * i), b = __builtin_nontemporal_load(xs + 2 * i + 1);
                if constexpr (INP_F8) { int w0 = 0, w1 = 0; w0 = __builtin_amdgcn_cvt_pk_fp8_f32(a[0], a[1], w0, false); w0 = __builtin_amdgcn_cvt_pk_fp8_f32(a[2], a[3], w0, true); w1 = __builtin_amdgcn_cvt_pk_fp8_f32(b[0], b[1], w1, false); w1 = __builtin_amdgcn_cvt_pk_fp8_f32(b[2], b[3], w1, true);
                    *(u32x2*)(xd + i * 8) = (u32x2){(unsigned)w0, (unsigned)w1}; }
                else { u32x4 o; o.x = pk2(a[0], a[1]); o.y = pk2(a[2], a[3]); o.z = pk2(b[0], b[1]); o.w = pk2(b[2], b[3]); *(u32x4*)(xd + i * 16) = o; } }
        }
    }
    { const float* rwp = INP(26); unsigned short* RW = (unsigned short*)(cx.ws + WS_RW);
      for (int i = cx.vcu * 512 + tid; i < 4 * 32768; i += cx.G * 512) { const int l = i >> 15, r = i & 32767, k = r >> 5, e = r & 31; const float w = rwp[i]; const unsigned hi = f2bf(w); const float wl = w - bf2f((unsigned short)hi);
          RW[((size_t)(l * 2 + 0) * 32 + e) * 1024 + k] = (unsigned short)hi; RW[((size_t)(l * 2 + 1) * 32 + e) * 1024 + k] = (unsigned short)f2bf(wl); } }
    {
        const float *fw1 = INP(10), *fb1 = INP(11), *fw2 = INP(12), *fb2 = INP(13), *fw3 = INP(14), *fb3 = INP(15), *fw4 = INP(16), *fb4 = INP(17), *ffr = INP(18);
        LAS float* z = (LAS float*)cx.lds; LAS float* h1 = z + 16 * 33; LAS float* h2 = h1 + 1024; LAS float* h3 = h2 + 1024;
        float* HRAWT = (float*)(cx.ws + WS_HRAWT); float* HPART = (float*)(cx.ws + WS_HPART);
        for (int it = cx.vcu; it < 256; it += cx.G) {
            __syncthreads();
            const int pos0 = it * 16;
            for (int i = tid; i < 16 * 33; i += 512) { const int p = i / 33, f = i % 33; const float pos = (float)(pos0 + p); float v;
                if (f == 0) v = pos / 4095.0f;
                else { const int k = (f - 1) & 15; const float fb = 1e-4f + (float)k * ((15.0f - 1e-4f) / 15.0f); const float ang = (6.283185307179586f * pos / 4096.0f) * fb; v = (f <= 16) ? cosf(ang) : -sinf(ang); }
                z[i] = v; }
            __syncthreads();
            for (int i = tid; i < 1024; i += 512) { const int p = i >> 6, o = i & 63; float a = fb1[o]; for (int f = 0; f < 33; ++f) a += z[p * 33 + f] * fw1[f * 64 + o]; h1[i] = sinf(ffr[o] * a); }
            __syncthreads();
            for (int i = tid; i < 1024; i += 512) { const int p = i >> 6, o = i & 63; float a = fb2[o]; for (int k = 0; k < 64; ++k) a += h1[p * 64 + k] * fw2[k * 64 + o]; h2[i] = sinf(ffr[o] * a); }
            __syncthreads();
            for (int i = tid; i < 1024; i += 512) { const int p = i >> 6, o = i & 63; float a = fb3[o]; for (int k = 0; k < 64; ++k) a += h2[p * 64 + k] * fw3[k * 64 + o]; h3[i] = sinf(ffr[o] * a); }
            __syncthreads();
            for (int col = tid; col < 3072; col += 512) {
                float a[16]; const float bb = fb4[col];
#pragma unroll
                for (int p = 0; p < 16; ++p) a[p] = bb;
                for (int k = 0; k < 64; ++k) { const float w = fw4[(size_t)k * 3072 + col];
#pragma unroll
                    for (int p = 0; p < 16; ++p) a[p] += h3[p * 64 + k] * w; }
                const int c = col % 768; const float mind = -3.0701134573253945f, maxd = -15.350567286626972f;
                const float delta = fabsf(mind + (maxd - mind) * ((float)c / 767.0f)); float asum = 0.f;
#pragma unroll
                for (int p = 0; p < 16; ++p) { const float t = (float)(pos0 + p) / 4095.0f; a[p] *= expf(-t * delta); asum += fabsf(a[p]); }
                f32x4* dst = (f32x4*)(HRAWT + (size_t)col * 4096 + pos0);
#pragma unroll
                for (int q = 0; q < 4; ++q) dst[q] = (f32x4){a[4 * q], a[4 * q + 1], a[4 * q + 2], a[4 * q + 3]};
                HPART[(size_t)it * 3072 + col] = asum;
            }
        }
    }
}

__device__ __forceinline__ s16x4 vtr(const LAS unsigned char* p) { typedef short v4i16_t __attribute__((ext_vector_type(4))); return __builtin_bit_cast(s16x4, __builtin_amdgcn_ds_read_tr16_b64_v4i16((LAS v4i16_t*)p)); }
__device__ __forceinline__ void na_phase(const Ctx& cx, const bf16_t* PROJ, const float* rpb, bf16_t* CAT, const int tid) {
    const int lane = tid & 63, wid = __builtin_amdgcn_readfirstlane(tid >> 6), m16 = lane & 15, q4 = lane >> 4;
    LAS unsigned char* Kb = cx.lds; LAS unsigned char* Vb = cx.lds + 73728; LAS float* biasL = (LAS float*)(cx.lds + 147456);
    constexpr int PW = 2560;
    u32x4 kv[9], vv[9]; float bpre = 0.f; bf16x8 qn[2];
#define NA_LOAD(unit_) do { const int b_ = __builtin_amdgcn_readfirstlane((unit_) / 384), rem_ = __builtin_amdgcn_readfirstlane((unit_) % 384), h_ = rem_ >> 5, rp_ = rem_ & 31; int bs_ = 2 * rp_ - 4; bs_ = bs_ < 0 ? 0 : (bs_ > 56 ? 56 : bs_); bs_ = __builtin_amdgcn_readfirstlane(bs_); \
        _Pragma("unroll") for (int it = 0; it < 9; ++it) { const int i = tid + it * 512; const int brow = i >> 9, col = (i >> 3) & 63, ch = i & 7; int grow = bs_ + brow; grow = grow > 63 ? 63 : grow; \
            const size_t tok = (size_t)b_ * 4096 + grow * 64 + col; \
            kv[it] = *(const u32x4*)(PROJ + tok * PW + 768 + h_ * 64 + ch * 8); vv[it] = *(const u32x4*)(PROJ + tok * PW + 1536 + h_ * 64 + ch * 8); } \
        if (tid < 465) bpre = rpb[h_ * 465 + tid];   \
        { const size_t tq_ = (size_t)b_ * 4096 + (2 * rp_ + (wid >> 2)) * 64 + 16 * (wid & 3) + m16; \
          _Pragma("unroll") for (int kk = 0; kk < 2; ++kk) qn[kk] = *(const bf16x8*)(PROJ + tq_ * PW + h_ * 64 + 32 * kk + 8 * q4); } } while (0)
    int u0 = cx.vcu; asm volatile("" : "+s"(u0));
    if (u0 < 6144) NA_LOAD(u0);
    for (int unit = u0; unit < 6144; unit += cx.G) {
        const int b = unit / 384, rem = unit % 384, h = rem >> 5, rp = rem & 31;
        int bs = 2 * rp - 4; bs = bs < 0 ? 0 : (bs > 56 ? 56 : bs);
        __syncthreads();
#pragma unroll
        for (int it = 0; it < 9; ++it) { const int i = tid + it * 512; const int brow = i >> 9, col = (i >> 3) & 63, ch = i & 7;
            *(LAS u32x4*)(Kb + (brow * 64 + col) * 128 + ((ch ^ ((col >> 1) & 7)) << 4)) = kv[it];
            *(LAS u32x4*)(Vb + (brow * 64 + col) * 128 + ((ch ^ (col & 7)) << 4)) = vv[it]; }
        if (tid < 465) biasL[tid] = bpre * LOG2E;
        __syncthreads();
        bf16x8 qf[2]; qf[0] = qn[0]; qf[1] = qn[1];
        { const int un_ = (unit + cx.G < 6144) ? unit + cx.G : unit; NA_LOAD(un_); }
        const int r = 2 * rp + (wid >> 2), g = wid & 3;
        const int wc0 = (g == 0) ? 0 : (g == 1) ? 8 : (g == 2) ? 24 : 32;
        int r0 = r - 4; r0 = r0 < 0 ? 0 : (r0 > 56 ? 56 : r0); const int ro = r0 - bs;
        const int c = 16 * g + m16;
        const size_t tq = (size_t)b * 4096 + r * 64 + c;
        f32x4 S[16];
#pragma unroll
        for (int i = 0; i < 8; ++i)
#pragma unroll
            for (int ct = 0; ct < 2; ++ct) { const int col = wc0 + 16 * ct + m16; const LAS unsigned char* kp = Kb + ((ro + i) * 64 + col) * 128; const int sw = (col >> 1) & 7;
                f32x4 a = (f32x4){0.f, 0.f, 0.f, 0.f};
#pragma unroll
                for (int kk = 0; kk < 2; ++kk) { const bf16x8 kf = *(const LAS bf16x8*)(kp + (((q4 + 4 * kk) ^ sw) << 4)); a = __builtin_amdgcn_mfma_f32_16x16x32_bf16(kf, qf[kk], a, 0, 0, 0); }
                S[2 * i + ct] = a; }
        int c0 = c - 8; c0 = c0 < 0 ? 0 : (c0 > 48 ? 48 : c0);
        float mx = -INFINITY;
#pragma unroll
        for (int i = 0; i < 8; ++i)
#pragma unroll
            for (int ct = 0; ct < 2; ++ct)
#pragma unroll
                for (int v = 0; v < 4; ++v) { const int kc = wc0 + 16 * ct + 4 * q4 + v; const bool valid = (kc >= c0) && (kc < c0 + 16);
                    const int bidx = valid ? (r0 + i - r + 7) * 31 + (kc - c + 15) : 0;
                    const float s = valid ? S[2 * i + ct][v] + biasL[bidx] : -INFINITY; S[2 * i + ct][v] = s; mx = fmaxf(mx, s); }
        mx = fmaxf(mx, shflx(mx, 16, lane)); mx = fmaxf(mx, shflx(mx, 32, lane));
        float l = 0.f;
#pragma unroll
        for (int t = 0; t < 16; ++t)
#pragma unroll
            for (int v = 0; v < 4; ++v) { const float p = __builtin_amdgcn_exp2f(S[t][v] - mx); S[t][v] = p; l += p; }
        l += shflx(l, 16, lane); l += shflx(l, 32, lane);
        f32x4 O[4];
#pragma unroll
        for (int dt = 0; dt < 4; ++dt) O[dt] = (f32x4){0.f, 0.f, 0.f, 0.f};
        const int qq = m16 >> 2, pp = m16 & 3, col1 = wc0 + 4 * q4 + qq;
#pragma unroll
        for (int i = 0; i < 8; ++i) {
            u32x4 pw; pw.x = pk2(S[2 * i][0], S[2 * i][1]); pw.y = pk2(S[2 * i][2], S[2 * i][3]); pw.z = pk2(S[2 * i + 1][0], S[2 * i + 1][1]); pw.w = pk2(S[2 * i + 1][2], S[2 * i + 1][3]);
            const bf16x8 pb = __builtin_bit_cast(bf16x8, pw);
            const LAS unsigned char* v1 = Vb + ((ro + i) * 64 + col1) * 128 + 8 * (pp & 1);
            const LAS unsigned char* v2 = v1 + 16 * 128;
#pragma unroll
            for (int dt = 0; dt < 4; ++dt) { const int chunk = 2 * dt + (pp >> 1);
                const s16x4 lo = vtr(v1 + ((chunk ^ (col1 & 7)) << 4)), hi = vtr(v2 + ((chunk ^ ((col1 + 16) & 7)) << 4));
                const bf16x8 vf = (bf16x8){lo[0], lo[1], lo[2], lo[3], hi[0], hi[1], hi[2], hi[3]};
                O[dt] = __builtin_amdgcn_mfma_f32_16x16x32_bf16(vf, pb, O[dt], 0, 0, 0); }
        }
        const float inv = 1.0f / l;
#pragma unroll
        for (int dt = 0; dt < 4; ++dt) {
            if constexpr (OUTP_F8) { int w = 0; w = __builtin_amdgcn_cvt_pk_fp8_f32(O[dt][0] * inv, O[dt][1] * inv, w, false); w = __builtin_amdgcn_cvt_pk_fp8_f32(O[dt][2] * inv, O[dt][3] * inv, w, true); *(int*)((unsigned char*)CAT + tq * 1024 + h * 64 + 16 * dt + 4 * q4) = w; }
            else { u32x2 w; w.x = pk2(O[dt][0] * inv, O[dt][1] * inv); w.y = pk2(O[dt][2] * inv, O[dt][3] * inv); *(u32x2*)(CAT + tq * 1024 + h * 64 + 16 * dt + 4 * q4) = w; } }
    }
    __syncthreads();
}

#undef NA_LOAD
__device__ __forceinline__ void rope_phase(const Ctx& cx, const bf16_t* PROJ, const float* qg, const float* kg, bf16_t* QKR, const int tid) {
    const int lane = tid & 63, wave = __builtin_amdgcn_readfirstlane(tid >> 6);
    const int gw = cx.vcu * 8 + wave, NGW = cx.G * 8;
    const int d0 = (lane & 7) * 8;
    float gq[8], gk[8], invf[4];
#pragma unroll
    for (int e = 0; e < 8; ++e) { gq[e] = qg[d0 + e]; gk[e] = kg[d0 + e]; }
#pragma unroll
    for (int p = 0; p < 4; ++p) { const int i = (d0 >> 1) + p, j = i & 15; invf[p] = exp2f(-(float)(2 * j) / 32.0f * 13.287712379549449f); }
    const bool isrow = (d0 >> 1) < 16;
    for (int pos = gw; pos < SEQ; pos += NGW) {
        const float pr = isrow ? (float)(pos >> 6) : (float)(pos & 63);
        float cs[4], sn[4];
#pragma unroll
        for (int p = 0; p < 4; ++p) { const float a = pr * invf[p]; cs[p] = cosf(a); sn[p] = sinf(a); }
#pragma unroll 1
        for (int bg = 0; bg < BATCH; bg += 4) {
        u32x4 rawv[4][2];
#pragma unroll
        for (int bq = 0; bq < 4; ++bq)
#pragma unroll
            for (int half = 0; half < 2; ++half) rawv[bq][half] = __builtin_nontemporal_load((const u32x4*)(PROJ + (size_t)((bg + bq) * SEQ + pos) * 1536 + half * 512 + lane * 8));
        __builtin_amdgcn_sched_barrier(0);
#pragma unroll
        for (int bq = 0; bq < 4; ++bq) { const int tok = (bg + bq) * SEQ + pos;
#pragma unroll
        for (int half = 0; half < 2; ++half) {
            const int e0 = half * 512 + lane * 8; const int head = e0 >> 6; const bool isq = head < 12;
            const u32x4 raw = rawv[bq][half];
            float x[8]; x[0] = bflo(raw.x); x[1] = bfhi(raw.x); x[2] = bflo(raw.y); x[3] = bfhi(raw.y); x[4] = bflo(raw.z); x[5] = bfhi(raw.z); x[6] = bflo(raw.w); x[7] = bfhi(raw.w);
            float ss = 0.f;
#pragma unroll
            for (int e = 0; e < 8; ++e) ss += x[e] * x[e];
            ss = group8_sum(ss);
            const float inv = rsqrtf(ss * (1.0f / 64.0f) + 1e-6f);
            float y[8];
#pragma unroll
            for (int e = 0; e < 8; ++e) y[e] = x[e] * inv * (isq ? gq[e] : gk[e]);
            const float sc = isq ? C2 : 1.0f;
            float o[8];
#pragma unroll
            for (int p = 0; p < 4; ++p) { o[2 * p] = (y[2 * p] * cs[p] - y[2 * p + 1] * sn[p]) * sc; o[2 * p + 1] = (y[2 * p] * sn[p] + y[2 * p + 1] * cs[p]) * sc; }
            u32x4 w; w.x = pk2(o[0], o[1]); w.y = pk2(o[2], o[3]); w.z = pk2(o[4], o[5]); w.w = pk2(o[6], o[7]);
            *(u32x4*)(QKR + (size_t)tok * 1024 + e0) = w;
        } } }
    }
}

__device__ __forceinline__ void sconv_phase(const Ctx& cx, const bf16_t* PROJ, const float* cw, const float* cb, bf16_t* UT3, unsigned char* V8, const int tid) {
    const int lane = tid & 63, wave = __builtin_amdgcn_readfirstlane(tid >> 6);
    const int gw = cx.vcu * 8 + wave, NGW = cx.G * 8;
    LAS unsigned short* tile = (LAS unsigned short*)(cx.lds + wave * 9216);
    constexpr int PW = 2560;
    for (int it = gw; it < 16 * 64 * 36; it += NGW) {
        const int ct = it % 36, tt = (it / 36) & 63, b = it / (36 * 64);
        const int col = ct * 64 + lane, t0 = tt * 64;
        const float w0 = cw[col], w1 = cw[2304 + col], w2 = cw[4608 + col], bia = cb[col];
        const bf16_t* src = PROJ + ((size_t)b * 4096 + t0) * PW + col;
        unsigned short uu[66];
        uu[0] = (t0 > 0) ? src[-(long)PW] : (unsigned short)0;
#pragma unroll
        for (int k = 0; k < 64; ++k) uu[k + 1] = __builtin_nontemporal_load(src + (size_t)k * PW);
        uu[65] = (t0 + 64 < 4096) ? src[(size_t)64 * PW] : (unsigned short)0;
#pragma unroll
        for (int k = 0; k < 64; ++k) { const float v = bf2f(uu[k]) * w0 + bf2f(uu[k + 1]) * w1 + bf2f(uu[k + 2]) * w2 + bia; tile[lane * 72 + k] = (unsigned short)f2bf(v); }
        LDS_WAIT(); asm volatile("" ::: "memory");
        const int part = (ct * 64) / 768, cbase = (ct * 64) % 768;
#pragma unroll
        for (int k = 0; k < 8; ++k) { const int row = k * 8 + (lane >> 3), chn = lane & 7;
            const u32x4 v = *(const LAS u32x4*)((const LAS unsigned char*)tile + row * 144 + chn * 16);
            *(u32x4*)(UT3 + (((size_t)part * 16 + b) * 768 + cbase + row) * 4096 + t0 + chn * 8) = v;
            if (TCONV_F8 && part == 0) { int w0 = 0, w1 = 0;
                w0 = __builtin_amdgcn_cvt_pk_fp8_f32(bflo(v.x), bfhi(v.x), w0, false); w0 = __builtin_amdgcn_cvt_pk_fp8_f32(bflo(v.y), bfhi(v.y), w0, true);
                w1 = __builtin_amdgcn_cvt_pk_fp8_f32(bflo(v.z), bfhi(v.z), w1, false); w1 = __builtin_amdgcn_cvt_pk_fp8_f32(bflo(v.w), bfhi(v.w), w1, true);
                *(u32x2*)(V8 + ((size_t)b * 768 + cbase + row) * 4096 + t0 + chn * 8) = (u32x2){(unsigned)w0, (unsigned)w1}; } }
        LDS_WAIT(); asm volatile("" ::: "memory");
    }
}

constexpr int TZ_CS = 16384 + 64;
__device__ __forceinline__ void tconv_phase(const Ctx& cx, const int o, const bf16_t* UT, const bf16_t* GT, bf16_t* ZT, const float* lbias  , const int tid) {
    const int lane = tid & 63, wid = __builtin_amdgcn_readfirstlane(tid >> 6), m16 = lane & 15, q4 = lane >> 4;
    const float* HRAWT = (const float*)(cx.ws + WS_HRAWT); const float* HPART = (const float*)(cx.ws + WS_HPART);
    LAS unsigned char* cp = cx.lds; LAS float* red = (LAS float*)(cx.lds + 8 * TZ_CS);
    for (int c = cx.vcu; c < 768; c += cx.G) {
        __syncthreads();
        { const int dir = tid >> 8, blk = tid & 255; float v = HPART[(size_t)blk * 3072 + dir * 1536 + o * 768 + c]; v = wave_sum(v, lane); if (lane == 0) red[wid] = v; }
        __syncthreads();
        float nrm = 0.f;
#pragma unroll
        for (int w = 0; w < 8; ++w) nrm += red[w];
        const float inv = 1.0f / nrm;
        const float* hf = HRAWT + (size_t)(o * 768 + c) * 4096; const float* hb = HRAWT + (size_t)(1536 + o * 768 + c) * 4096;
        for (int i = tid; i < 8192; i += 512) { float v; if (i < 4096) v = hf[4095 - i]; else if (i < 8191) v = hb[i - 4095]; else v = 0.f;
            *(LAS unsigned short*)(cp + 2 * i) = (unsigned short)f2bf(v * inv); }
        __syncthreads();
#pragma unroll
        for (int j = 1; j < 8; ++j)
            for (int n = tid; n < 1024; n += 512) {
                const u32x4 lo = *(const LAS u32x4*)(cp + n * 16); u32x4 hi = (u32x4){0u, 0u, 0u, 0u}; if (n + 1 < 1024) hi = *(const LAS u32x4*)(cp + (n + 1) * 16);
                const unsigned w[8] = {lo.x, lo.y, lo.z, lo.w, hi.x, hi.y, hi.z, hi.w}; u32x4 r;
                const int a = j >> 1;
                if (j & 1) { r.x = (w[a] >> 16) | (w[a + 1] << 16); r.y = (w[a + 1] >> 16) | (w[a + 2] << 16); r.z = (w[a + 2] >> 16) | (w[a + 3] << 16); r.w = (w[a + 3] >> 16) | (w[a + 4] << 16); }
                else { r.x = w[a]; r.y = w[a + 1]; r.z = w[a + 2]; r.w = w[a + 3]; }
                *(LAS u32x4*)(cp + j * TZ_CS + n * 16) = r;
            }
        __syncthreads();
        const int j = (7 - m16) & 7;
        const int nbase = (4095 - 512 * wid - m16 - j + 8 * q4) >> 3;
        const LAS unsigned char* ap = cp + j * TZ_CS + (nbase - 62) * 16;
        const bf16_t* up = UT + ((size_t)m16 * 768 + c) * 4096 + 8 * q4;
        f32x4 acc[32];
#pragma unroll
        for (int ti = 0; ti < 32; ++ti) acc[ti] = (f32x4){0.f, 0.f, 0.f, 0.f};
        bf16x8 bcur = *(const bf16x8*)(up);
        bf16x8 afA[8], afB[8];
#pragma unroll
        for (int i = 0; i < 8; ++i) afA[i] = *(const LAS bf16x8*)(ap + (31 - i) * 32);
        for (int ks = 0; ks < 128; ++ks) {
            const bf16x8 bnext = *(const bf16x8*)(up + ((ks + 1) & 127) * 32);
            const LAS unsigned char* a0 = ap + ks * 64;
            const LAS unsigned char* a1 = ap + ((ks + 1) & 127) * 64;
#define TZ_LD(dst, base, g) do { _Pragma("unroll") for (int i = 0; i < 8; ++i) dst[i] = *(const LAS bf16x8*)((base) + (31 - (8 * (g) + i)) * 32); } while (0)
#define TZ_MM(src, g) do { _Pragma("unroll") for (int i = 0; i < 8; ++i) acc[8 * (g) + i] = __builtin_amdgcn_mfma_f32_16x16x32_bf16(src[i], bcur, acc[8 * (g) + i], 0, 0, 0); } while (0)
            TZ_LD(afB, a0, 1); TZ_MM(afA, 0); __builtin_amdgcn_sched_barrier(0);
            TZ_LD(afA, a0, 2); TZ_MM(afB, 1); __builtin_amdgcn_sched_barrier(0);
            TZ_LD(afB, a0, 3); TZ_MM(afA, 2); __builtin_amdgcn_sched_barrier(0);
            TZ_LD(afA, a1, 0); TZ_MM(afB, 3); __builtin_amdgcn_sched_barrier(0);
#undef TZ_LD
#undef TZ_MM
            bcur = bnext;
        }
        const float lb = lbias[c];
        const size_t rowoff = ((size_t)m16 * 768 + c) * 4096 + 512 * wid + 4 * q4;
#pragma unroll
        for (int ti = 0; ti < 32; ++ti) {
            const u32x2 uu = *(const u32x2*)(UT + rowoff + 16 * ti), gg = *(const u32x2*)(GT + rowoff + 16 * ti);
            const float y0 = (acc[ti][0] + lb * bflo(uu.x)) * bflo(gg.x), y1 = (acc[ti][1] + lb * bfhi(uu.x)) * bfhi(gg.x), y2 = (acc[ti][2] + lb * bflo(uu.y)) * bflo(gg.y), y3 = (acc[ti][3] + lb * bfhi(uu.y)) * bfhi(gg.y);
            u32x2 w; w.x = pk2(y0, y1); w.y = pk2(y2, y3);
            *(u32x2*)(ZT + rowoff + 16 * ti) = w;
            if ((ti & 7) == 7) __builtin_amdgcn_sched_barrier(0);
        }
    }
    __syncthreads();
}

constexpr int T8_CS = 8192 + 256;
__host__ __device__ constexpr int t8_sig(int j) { return j < 4 ? 2 * j : (j >= 12 ? 2 * (j - 8) : 2 * (j - 4) + 1); }
__device__ __forceinline__ float wave_max_nn(float v) {
    v = fmaxf(v, dpp_x<0xB1>(v)); v = fmaxf(v, dpp_x<0x4E>(v)); v = fmaxf(v, dpp_x<0x141>(v)); v = fmaxf(v, dpp_x<0x140>(v));
    v = fmaxf(v, __builtin_bit_cast(float, __builtin_amdgcn_update_dpp(0, __builtin_bit_cast(int, v), 0x142, 0xA, 0xF, false)));
    v = fmaxf(v, __builtin_bit_cast(float, __builtin_amdgcn_update_dpp(0, __builtin_bit_cast(int, v), 0x143, 0xC, 0xF, false)));
    return __builtin_bit_cast(float, __builtin_amdgcn_readlane(__builtin_bit_cast(int, v), 63));
}
__device__ __forceinline__ void tconv8_phase(const Ctx& cx, const int o, const bf16_t* UT, const unsigned char* U8, const bf16_t* GT, bf16_t* ZT, unsigned char* Z8  ,
                                             const float* lbias, const int tid) {
    const int lane = tid & 63, wid = __builtin_amdgcn_readfirstlane(tid >> 6), m16 = lane & 15, q4 = lane >> 4;
    const float* HRAWT = (const float*)(cx.ws + WS_HRAWT); const float* HPART = (const float*)(cx.ws + WS_HPART);
    LAS unsigned char* cp = cx.lds; LAS float* red = (LAS float*)(cx.lds + 16 * T8_CS);
    for (int c = cx.vcu; c < 768; c += cx.G) {
        __syncthreads();
        const float* hf = HRAWT + (size_t)(o * 768 + c) * 4096; const float* hb = HRAWT + (size_t)(1536 + o * 768 + c) * 4096;
        float tap[16]; float mx = 0.f;
        int t3 = tid; asm volatile("" : "+v"(t3));
#pragma unroll
        for (int k = 0; k < 16; ++k) { const int i = t3 * 16 + k; float v; if (i < 4096) v = hf[4095 - i]; else if (i < 8191) v = hb[i - 4095]; else v = 0.f; tap[k] = v; mx = fmaxf(mx, fabsf(v)); }
        { const int dir = tid >> 8, blk = tid & 255; float v = HPART[(size_t)blk * 3072 + dir * 1536 + o * 768 + c]; v = wave_sum(v, lane); mx = wave_max_nn(mx); if (lane == 0) { red[wid] = v; red[8 + wid] = mx; } }
        __syncthreads();
        float nrm = 0.f, mall = 0.f;
#pragma unroll
        for (int w = 0; w < 8; ++w) { nrm += red[w]; mall = fmaxf(mall, red[8 + w]); }
        const float inv = 1.0f / nrm;
        int ex; (void)frexpf(fmaxf(mall * inv, 1e-30f), &ex);
        const float fsc = ldexpf(1.0f, 7 - ex), unsc = ldexpf(1.0f, ex - 7), tsc = inv * fsc;
        { unsigned w[4];
#pragma unroll
          for (int q = 0; q < 4; ++q) { int r = 0; r = __builtin_amdgcn_cvt_pk_fp8_f32(tap[4 * q] * tsc, tap[4 * q + 1] * tsc, r, false); r = __builtin_amdgcn_cvt_pk_fp8_f32(tap[4 * q + 2] * tsc, tap[4 * q + 3] * tsc, r, true); w[q] = (unsigned)r; }
          *(LAS u32x4*)(cp + tid * 16) = (u32x4){w[0], w[1], w[2], w[3]}; }
        __syncthreads();
        { const u32x4 lo = *(const LAS u32x4*)(cp + tid * 16); u32x4 hi = (u32x4){0u, 0u, 0u, 0u}; if (tid + 1 < 512) hi = *(const LAS u32x4*)(cp + (tid + 1) * 16);
          const unsigned w[8] = {lo.x, lo.y, lo.z, lo.w, hi.x, hi.y, hi.z, hi.w};
#pragma unroll
          for (int j = 1; j < 16; ++j) { u32x4 r; const int a = j >> 2, sh = j & 3;
              r.x = sh ? __builtin_amdgcn_alignbyte(w[a + 1], w[a], sh) : w[a]; r.y = sh ? __builtin_amdgcn_alignbyte(w[a + 2], w[a + 1], sh) : w[a + 1];
              r.z = sh ? __builtin_amdgcn_alignbyte(w[a + 3], w[a + 2], sh) : w[a + 2]; r.w = sh ? __builtin_amdgcn_alignbyte(w[a + 4], w[a + 3], sh) : w[a + 3];
              *(LAS u32x4*)(cp + j * T8_CS + t8_sig(j) * 16 + tid * 16) = r; } }
        __syncthreads();
        const int jc = 15 - m16;
        const int nbase = 255 - 32 * wid + 2 * q4;
        const LAS unsigned char* ap = cp + jc * T8_CS + t8_sig(jc) * 16 + (nbase - 31) * 16;
        const unsigned char* up = U8 + ((size_t)m16 * 768 + c) * 4096 + 32 * q4;
        f32x4 acc[32];
#pragma unroll
        for (int ti = 0; ti < 32; ++ti) acc[ti] = (f32x4){0.f, 0.f, 0.f, 0.f};
        typedef int v8i_t __attribute__((ext_vector_type(8))); typedef int v4i_t __attribute__((ext_vector_type(4)));
#define T8_FRAG(p) __builtin_shufflevector(*(const LAS v4i_t*)(p), *(const LAS v4i_t*)((p) + 16), 0, 1, 2, 3, 4, 5, 6, 7)
        v8i_t bcur = __builtin_shufflevector(*(const v4i_t*)(up), *(const v4i_t*)(up + 16), 0, 1, 2, 3, 4, 5, 6, 7);
        v8i_t afA[4], afB[4];
#pragma unroll
        for (int i = 0; i < 4; ++i) afA[i] = T8_FRAG(ap + (31 - i) * 16);
        for (int ks = 0; ks < 32; ++ks) {
            const unsigned char* un = up + ((ks + 1) & 31) * 128;
            const v8i_t bnext = __builtin_shufflevector(*(const v4i_t*)(un), *(const v4i_t*)(un + 16), 0, 1, 2, 3, 4, 5, 6, 7);
            const LAS unsigned char* a0 = ap + ks * 128;
            const LAS unsigned char* a1 = ap + ((ks + 1) & 31) * 128;
#define T8_LD(dst, base, g) do { _Pragma("unroll") for (int i = 0; i < 4; ++i) dst[i] = T8_FRAG((base) + (31 - (4 * (g) + i)) * 16); } while (0)
#define T8_MM(src, g) do { _Pragma("unroll") for (int i = 0; i < 4; ++i) acc[4 * (g) + i] = __builtin_amdgcn_mfma_scale_f32_16x16x128_f8f6f4(src[i], bcur, acc[4 * (g) + i], 0, 0, 0, 0, 0, 0); } while (0)
            T8_LD(afB, a0, 1); T8_MM(afA, 0); __builtin_amdgcn_sched_barrier(0);
            T8_LD(afA, a0, 2); T8_MM(afB, 1); __builtin_amdgcn_sched_barrier(0);
            T8_LD(afB, a0, 3); T8_MM(afA, 2); __builtin_amdgcn_sched_barrier(0);
            T8_LD(afA, a0, 4); T8_MM(afB, 3); __builtin_amdgcn_sched_barrier(0);
            T8_LD(afB, a0, 5); T8_MM(afA, 4); __builtin_amdgcn_sched_barrier(0);
            T8_LD(afA, a0, 6); T8_MM(afB, 5); __builtin_amdgcn_sched_barrier(0);
            T8_LD(afB, a0, 7); T8_MM(afA, 6); __builtin_amdgcn_sched_barrier(0);
            T8_LD(afA, a1, 0); T8_MM(afB, 7); __builtin_amdgcn_sched_barrier(0);
#undef T8_LD
#undef T8_MM
            bcur = bnext;
        }
#undef T8_FRAG
        const float lb = lbias[c];
        const size_t rowoff = ((size_t)m16 * 768 + c) * 4096 + 512 * wid + 4 * q4;
#pragma unroll
        for (int tg = 0; tg < 32; tg += 8) {
            u32x2 uu8[8], gg8[8];
#pragma unroll
            for (int j = 0; j < 8; ++j) { uu8[j] = *(const u32x2*)(UT + rowoff + 16 * (tg + j)); gg8[j] = *(const u32x2*)(GT + rowoff + 16 * (tg + j)); }
#pragma unroll
            for (int j = 0; j < 8; ++j) { const int ti = tg + j; const u32x2 uu = uu8[j], gg = gg8[j];
                const float y0 = (acc[ti][0] * unsc + lb * bflo(uu.x)) * bflo(gg.x), y1 = (acc[ti][1] * unsc + lb * bfhi(uu.x)) * bfhi(gg.x), y2 = (acc[ti][2] * unsc + lb * bflo(uu.y)) * bflo(gg.y), y3 = (acc[ti][3] * unsc + lb * bfhi(uu.y)) * bfhi(gg.y);
                u32x2 w; w.x = pk2(y0, y1); w.y = pk2(y2, y3);
                *(u32x2*)(ZT + rowoff + 16 * ti) = w;
                if (Z8) { int w8 = 0; w8 = __builtin_amdgcn_cvt_pk_fp8_f32(fminf(fmaxf(y0, -440.f), 440.f), fminf(fmaxf(y1, -440.f), 440.f), w8, false); w8 = __builtin_amdgcn_cvt_pk_fp8_f32(fminf(fmaxf(y2, -440.f), 440.f), fminf(fmaxf(y3, -440.f), 440.f), w8, true);
                    *(int*)(Z8 + rowoff + 16 * ti) = w8; } }
            __builtin_amdgcn_sched_barrier(0);
        }
    }
    __syncthreads();
}

__device__ __forceinline__ void tback_phase(const Ctx& cx, const bf16_t* ZT, bf16_t* CAT, const int tid) {
    const int lane = tid & 63, wave = __builtin_amdgcn_readfirstlane(tid >> 6);
    const int gw = cx.vcu * 8 + wave, NGW = cx.G * 8;
    LAS unsigned char* tile = cx.lds + wave * 9216;
    for (int it = gw; it < 16 * 12 * 64; it += NGW) {
        const int tt = it & 63, ct = (it >> 6) % 12, b = it / (64 * 12);
        const int c0 = ct * 64, t0 = tt * 64;
        u32x4 vv[8];
#pragma unroll
        for (int k = 0; k < 8; ++k) { const int row = k * 8 + (lane >> 3), chn = lane & 7; vv[k] = __builtin_nontemporal_load((const u32x4*)(ZT + ((size_t)b * 768 + c0 + row) * 4096 + t0 + chn * 8)); }
        __builtin_amdgcn_sched_barrier(0);
#pragma unroll
        for (int k = 0; k < 8; ++k) { const int row = k * 8 + (lane >> 3), chn = lane & 7; *(LAS u32x4*)(tile + row * 144 + chn * 16) = vv[k]; }
        LDS_WAIT(); asm volatile("" ::: "memory");
        if constexpr (OUTP_F8) { unsigned char* dst = (unsigned char*)CAT + ((size_t)b * 4096 + t0) * 1024 + c0 + lane;
#pragma unroll 8
            for (int k = 0; k < 64; ++k) { const float v = bf2f(*(const LAS unsigned short*)(tile + lane * 144 + k * 2)); dst[(size_t)k * 1024] = f2fp8(fminf(fmaxf(v, -440.0f), 440.0f)); }
        } else { bf16_t* dst = CAT + ((size_t)b * 4096 + t0) * 1024 + c0 + lane;
#pragma unroll 8
            for (int k = 0; k < 64; ++k) dst[(size_t)k * 1024] = *(const LAS unsigned short*)(tile + lane * 144 + k * 2); }
        LDS_WAIT(); asm volatile("" ::: "memory");
    }
}

__device__ __forceinline__ void ln1_group(const int bt, const int chunk, const int wave, const int lane, const int r16, const int q4, const bf16_t* XI, bf16_t* XO, bf16_t* XB, const float* g, const float* bta,
                                          const LAS unsigned char* Wh, const LAS unsigned char* Wl, LAS float* lg, LAS int* lcnt, const float rb0, const float rb1, float* gate, unsigned (&pk)[2], unsigned (&gp)[2], const LAS float* gl) {
    constexpr int WP = 2064;
            const size_t rowU = (size_t)chunk * 256 + wave * 32 + bt * 16;
            unsigned loff = (unsigned)(r16 * 1024 + 8 * q4); asm volatile("" : "+v"(loff));
            const GAS bf16_t* src = (const GAS bf16_t*)XI + rowU * 1024 + loff;
            constexpr int HOLD = LN1_HOLD;
            u32x4 raw[HOLD > 0 ? HOLD : 1], rawt[32 - HOLD]; float s = 0.f, ss = 0.f;
#pragma unroll
            for (int i = 0; i < 32; ++i) { if (i < HOLD) raw[i] = *(const GAS u32x4*)(src + 32 * i); else rawt[i - HOLD] = *(const GAS u32x4*)(src + 32 * i); }
#pragma unroll
            for (int i = 0; i < 32; ++i) { const u32x4 rr = (i < HOLD) ? raw[i < HOLD ? i : 0] : rawt[i < HOLD ? 0 : i - HOLD]; const float x0 = bflo(rr.x), x1 = bfhi(rr.x), x2 = bflo(rr.y), x3 = bfhi(rr.y), x4 = bflo(rr.z), x5 = bfhi(rr.z), x6 = bflo(rr.w), x7 = bfhi(rr.w);
                s += ((x0 + x1) + (x2 + x3)) + ((x4 + x5) + (x6 + x7)); ss += ((x0 * x0 + x1 * x1) + (x2 * x2 + x3 * x3)) + ((x4 * x4 + x5 * x5) + (x6 * x6 + x7 * x7)); }
            lg[2 * lane] = s; lg[2 * lane + 1] = ss; LDS_WAIT(); asm volatile("" ::: "memory");
            s = (lg[2 * r16] + lg[2 * (r16 + 16)]) + (lg[2 * (r16 + 32)] + lg[2 * (r16 + 48)]); ss = (lg[2 * r16 + 1] + lg[2 * (r16 + 16) + 1]) + (lg[2 * (r16 + 32) + 1] + lg[2 * (r16 + 48) + 1]);
            LDS_WAIT(); asm volatile("" ::: "memory");
            const float mean = s * (1.0f / 1024.0f), rstd = rsqrtf(fmaxf(ss * (1.0f / 1024.0f) - mean * mean, 0.f) + LN_EPS);
            f32x4 a0 = (f32x4){0.f, 0.f, 0.f, 0.f}, a1 = (f32x4){0.f, 0.f, 0.f, 0.f};
            const LAS unsigned char* wh0 = Wh + r16 * WP + 16 * q4; const LAS unsigned char* wl0 = Wl + r16 * WP + 16 * q4;
            GAS bf16_t* dsto = (GAS bf16_t*)XO + ((X1_RECOMP && Y_F8) ? (size_t)(wave * 32 + bt * 16) : rowU) * 1024 + loff; GAS unsigned char* dst8 = (GAS unsigned char*)XB + rowU * 1024 + loff;
            const LAS float* glq = gl + 8 * q4;
            u32x4 nx_ = (u32x4){0u, 0u, 0u, 0u}; if (HOLD == 0) nx_ = *(const GAS u32x4*)(src);
#pragma unroll
            for (int i = 0; i < 32; ++i) {
                u32x4 rw_; if (i < HOLD) rw_ = raw[i < HOLD ? i : 0]; else rw_ = nx_;
                if (i + 1 < 32 && i + 1 >= HOLD) nx_ = *(const GAS u32x4*)(src + 32 * (i + 1));
                asm volatile("" : "+v"(rw_));
                const f32x4 g0 = *(const LAS f32x4*)(glq + 32 * i), g1 = *(const LAS f32x4*)(glq + 32 * i + 4), b0 = *(const LAS f32x4*)(glq + 1024 + 32 * i), b1 = *(const LAS f32x4*)(glq + 1024 + 32 * i + 4);
                float y[8]; y[0] = bflo(rw_.x); y[1] = bfhi(rw_.x); y[2] = bflo(rw_.y); y[3] = bfhi(rw_.y); y[4] = bflo(rw_.z); y[5] = bfhi(rw_.z); y[6] = bflo(rw_.w); y[7] = bfhi(rw_.w);
#pragma unroll
                for (int q = 0; q < 8; ++q) y[q] = (y[q] - mean) * rstd * (q < 4 ? g0[q & 3] : g1[q & 3]) + (q < 4 ? b0[q & 3] : b1[q & 3]);
                u32x4 hi; hi.x = pk2(y[0], y[1]); hi.y = pk2(y[2], y[3]); hi.z = pk2(y[4], y[5]); hi.w = pk2(y[6], y[7]);
                *(GAS u32x4*)(dsto + 32 * i) = hi;
                if constexpr (MOE_F8) { int w0 = 0, w1 = 0; w0 = __builtin_amdgcn_cvt_pk_fp8_f32(y[0], y[1], w0, false); w0 = __builtin_amdgcn_cvt_pk_fp8_f32(y[2], y[3], w0, true); w1 = __builtin_amdgcn_cvt_pk_fp8_f32(y[4], y[5], w1, false); w1 = __builtin_amdgcn_cvt_pk_fp8_f32(y[6], y[7], w1, true);
                    *(GAS u32x2*)(dst8 + 32 * i) = (u32x2){(unsigned)w0, (unsigned)w1}; }
                else { *(u32x4*)((bf16_t*)XB + rowU * 1024 + loff + 32 * i) = hi; }
                u32x4 lo; lo.x = pk2(y[0] - bflo(hi.x), y[1] - bfhi(hi.x)); lo.y = pk2(y[2] - bflo(hi.y), y[3] - bfhi(hi.y)); lo.z = pk2(y[4] - bflo(hi.z), y[5] - bfhi(hi.z)); lo.w = pk2(y[6] - bflo(hi.w), y[7] - bfhi(hi.w));
                const bf16x8 ah = __builtin_bit_cast(bf16x8, hi), al = __builtin_bit_cast(bf16x8, lo);
                const bf16x8 wh_0 = *(const LAS bf16x8*)(wh0 + 64 * i), wh_1 = *(const LAS bf16x8*)(wh0 + 16 * WP + 64 * i), wl_0 = *(const LAS bf16x8*)(wl0 + 64 * i), wl_1 = *(const LAS bf16x8*)(wl0 + 16 * WP + 64 * i);
                a0 = __builtin_amdgcn_mfma_f32_16x16x32_bf16(ah, wh_0, a0, 0, 0, 0); a1 = __builtin_amdgcn_mfma_f32_16x16x32_bf16(ah, wh_1, a1, 0, 0, 0);
                a0 = __builtin_amdgcn_mfma_f32_16x16x32_bf16(al, wh_0, a0, 0, 0, 0); a1 = __builtin_amdgcn_mfma_f32_16x16x32_bf16(al, wh_1, a1, 0, 0, 0);
                a0 = __builtin_amdgcn_mfma_f32_16x16x32_bf16(ah, wl_0, a0, 0, 0, 0); a1 = __builtin_amdgcn_mfma_f32_16x16x32_bf16(ah, wl_1, a1, 0, 0, 0);
                asm volatile("" :: "v"(ah), "v"(al), "v"(wh_0), "v"(wh_1), "v"(wl_0), "v"(wl_1));
                __builtin_amdgcn_sched_barrier(0);
            }
#pragma unroll
            for (int v = 0; v < 4; ++v) { lg[(4 * q4 + v) * 33 + r16] = a0[v] + rb0; lg[(4 * q4 + v) * 33 + r16 + 16] = a1[v] + rb1; }
            LDS_WAIT(); asm volatile("" ::: "memory");
            if (lane < 16) {
                const LAS float* myl = lg + lane * 33; const size_t rowt = (size_t)chunk * 256 + wave * 32 + bt * 16 + lane;
                float tv[4]; int te[4]; int t0 = -1, t1 = -1, t2 = -1;
#pragma unroll
                for (int k = 0; k < 4; ++k) { float best = -INFINITY; int bi = 0;
                    for (int e = 0; e < 32; ++e) { const float v = myl[e]; const bool ok = (e != t0) && (e != t1) && (e != t2); if (ok && v > best) { best = v; bi = e; } }
                    tv[k] = best; te[k] = bi; if (k == 0) t0 = bi; else if (k == 1) t1 = bi; else if (k == 2) t2 = bi; }
                const float e1 = __expf(tv[1] - tv[0]), e2 = __expf(tv[2] - tv[0]), e3 = __expf(tv[3] - tv[0]); const float isum = 1.0f / (1.0f + e1 + e2 + e3);
                const float gk[4] = {isum, e1 * isum, e2 * isum, e3 * isum};
                pk[0] = 0u; pk[1] = 0u;
#pragma unroll
                for (int k = 0; k < 4; ++k) { const int rk = __hip_atomic_fetch_add(lcnt + te[k], 1, __ATOMIC_RELAXED, __HIP_MEMORY_SCOPE_WORKGROUP); pk[k >> 1] |= (unsigned)((te[k] << 11) | rk) << (16 * (k & 1)); }
                gp[0] = pk2(gk[0], gk[1]); gp[1] = pk2(gk[2], gk[3]); (void)rowt; (void)gate;
            }
            LDS_WAIT(); asm volatile("" ::: "memory");
}
__device__ __forceinline__ void ln1_router_phase(const Ctx& cx, const bf16_t* XI, bf16_t* XO, bf16_t* XB, const float* g, const float* bta, const float* rw, const float* rb,
                                                 unsigned* cnt, int* expid, float* gate, int* idx, float* gidx, const int tid) {
    const int lane = tid & 63, wave = __builtin_amdgcn_readfirstlane(tid >> 6), r16 = lane & 15, q4 = lane >> 4;
    constexpr int WP = 2064;
    LAS unsigned char* Wh = cx.lds; LAS unsigned char* Wl = cx.lds + 32 * WP; LAS int* lcnt = (LAS int*)(cx.lds + 64 * WP); LAS int* lbase = lcnt + 32; LAS float* lg = (LAS float*)(cx.lds + 64 * WP + 256 + wave * 2112);
    __syncthreads();
    { const u32x4* rsrc = (const u32x4*)rw; u32x4 wv[16];
#pragma unroll
      for (int u = 0; u < 16; ++u) wv[u] = rsrc[tid + 512 * u];
#pragma unroll
      for (int u = 0; u < 16; ++u) { const int idx = tid + 512 * u; *(LAS u32x4*)(Wh + (idx >> 7) * WP + (idx & 127) * 16) = wv[u]; } }
    if (tid < 256) { LAS float* gf = (LAS float*)(cx.lds + 151552); *(LAS f32x4*)(gf + 4 * tid) = *(const f32x4*)(g + 4 * tid); *(LAS f32x4*)(gf + 1024 + 4 * tid) = *(const f32x4*)(bta + 4 * tid); }
    if (tid < 32) lcnt[tid] = 0;
    LAS float* gl = (LAS float*)(cx.lds + 151552);
    const float rb0 = rb[r16], rb1 = rb[r16 + 16];
    __syncthreads();
    for (int chunk = cx.vcu; chunk < NTOK / 256; chunk += cx.G) {
        unsigned pk0[2] = {0u, 0u}, pk1[2] = {0u, 0u}, gp0[2] = {0u, 0u}, gp1[2] = {0u, 0u};
        ln1_group(0, chunk, wave, lane, r16, q4, XI, XO, XB, g, bta, Wh, Wl, lg, lcnt, rb0, rb1, gate, pk0, gp0, gl);
        ln1_group(1, chunk, wave, lane, r16, q4, XI, XO, XB, g, bta, Wh, Wl, lg, lcnt, rb0, rb1, gate, pk1, gp1, gl);
        __syncthreads();
        { const int t2 = wave * 64 + lane_id_volatile();
          if (t2 < 32) { lbase[t2] = (int)__hip_atomic_fetch_add(cnt + t2, (unsigned)lcnt[t2], __ATOMIC_RELAXED, __HIP_MEMORY_SCOPE_AGENT); } }
        __syncthreads();
        const int ln_ = lane_id_volatile();
        if (ln_ < 16) {
            { const int slot0 = (chunk * 256 + wave * 32 + ln_) * 4;
#pragma unroll
                for (int k = 0; k < 4; ++k) { const unsigned p = (pk0[k >> 1] >> (16 * (k & 1))) & 0xffffu; const int e = (int)(p >> 11), rk = (int)(p & 0x7ffu); const size_t o_ = (size_t)e * IDXCAP + lbase[e] + rk; idx[o_] = slot0 + k; gidx[o_] = (k & 1) ? bfhi(gp0[k >> 1]) : bflo(gp0[k >> 1]); } }
            { const int slot0 = (chunk * 256 + wave * 32 + 16 + ln_) * 4;
#pragma unroll
                for (int k = 0; k < 4; ++k) { const unsigned p = (pk1[k >> 1] >> (16 * (k & 1))) & 0xffffu; const int e = (int)(p >> 11), rk = (int)(p & 0x7ffu); const size_t o_ = (size_t)e * IDXCAP + lbase[e] + rk; idx[o_] = slot0 + k; gidx[o_] = (k & 1) ? bfhi(gp1[k >> 1]) : bflo(gp1[k >> 1]); } }
        }
        __syncthreads();
        { const int t3 = wave * 64 + lane_id_volatile(); if (t3 < 32) lcnt[t3] = 0; }
        __syncthreads();
    }
}

__device__ __forceinline__ void ln2_phase(const Ctx& cx, const bf16_t* X1, const bf16_t* Y, bf16_t* XO, bf16_t* XB, float* OUT, const float* g, const float* bta, const float* g1, const float* b1, const int tid) {
    const int lane = tid & 63, wave = __builtin_amdgcn_readfirstlane(tid >> 6);
    const int gw = cx.vcu * 8 + wave, NGW = cx.G * 8;
    if constexpr (Y_F8) {
        f32x4 gv[4], bv[4];
#pragma unroll
        for (int j = 0; j < 4; ++j) { gv[j] = *(const f32x4*)(g + 16 * lane + 4 * j); bv[j] = *(const f32x4*)(bta + 16 * lane + 4 * j); }
        f32x4 g1v[4], b1v[4];
        if (X1_RECOMP) {
#pragma unroll
            for (int j = 0; j < 4; ++j) { g1v[j] = *(const f32x4*)(g1 + 16 * lane + 4 * j); b1v[j] = *(const f32x4*)(b1 + 16 * lane + 4 * j); } }
        for (int rp = gw; rp < NTOK / 2; rp += NGW) {
            u32x4 xa[2][2], ya[2][4];
#pragma unroll
            for (int r = 0; r < 2; ++r) { const size_t row = (size_t)rp * 2 + r;
                xa[r][0] = __builtin_nontemporal_load((const u32x4*)(X1 + row * 1024 + 16 * lane)); xa[r][1] = __builtin_nontemporal_load((const u32x4*)(X1 + row * 1024 + 16 * lane + 8));
#pragma unroll
                for (int k = 0; k < 4; ++k) ya[r][k] = __builtin_nontemporal_load((const u32x4*)((const unsigned char*)Y + (row * 4 + k) * 1024 + 16 * lane)); }
            float v[2][16]; float s[2] = {0.f, 0.f};
            float m1[2] = {0.f, 0.f}, r1[2] = {1.f, 1.f};
            if (X1_RECOMP) {
                float s1[2] = {0.f, 0.f}, q1[2] = {0.f, 0.f};
#pragma unroll
                for (int r = 0; r < 2; ++r)
#pragma unroll
                    for (int d = 0; d < 8; ++d) { const unsigned w = xa[r][d >> 2][d & 3]; const float t0 = bflo(w), t1 = bfhi(w); s1[r] += t0 + t1; q1[r] += t0 * t0 + t1 * t1; }
#pragma unroll
                for (int r = 0; r < 2; ++r) { m1[r] = wave_sum(s1[r], lane) * (1.0f / 1024.0f); r1[r] = rsqrtf(fmaxf(wave_sum(q1[r], lane) * (1.0f / 1024.0f) - m1[r] * m1[r], 0.f) + LN_EPS); } }
#pragma unroll
            for (int r = 0; r < 2; ++r) {
#pragma unroll
                for (int i = 0; i < 4; ++i) { f32x2 lo = __builtin_amdgcn_cvt_pk_f32_fp8((int)ya[r][0][i], false), hi = __builtin_amdgcn_cvt_pk_f32_fp8((int)ya[r][0][i], true);
#pragma unroll
                    for (int k = 1; k < 4; ++k) { lo += __builtin_amdgcn_cvt_pk_f32_fp8((int)ya[r][k][i], false); hi += __builtin_amdgcn_cvt_pk_f32_fp8((int)ya[r][k][i], true); }
                    const unsigned xlo = xa[r][i >> 1][(i & 1) * 2], xhi = xa[r][i >> 1][(i & 1) * 2 + 1];
                    f32x4 x1v = (f32x4){bflo(xlo), bfhi(xlo), bflo(xhi), bfhi(xhi)};
                    if (X1_RECOMP) x1v = (x1v - m1[r]) * r1[r] * g1v[i] + b1v[i];
                    v[r][4 * i + 0] = x1v[0] * DN_ALPHA + lo[0] * (1.0f / Y_SCALE); v[r][4 * i + 1] = x1v[1] * DN_ALPHA + lo[1] * (1.0f / Y_SCALE);
                    v[r][4 * i + 2] = x1v[2] * DN_ALPHA + hi[0] * (1.0f / Y_SCALE); v[r][4 * i + 3] = x1v[3] * DN_ALPHA + hi[1] * (1.0f / Y_SCALE);
                    s[r] += (v[r][4 * i] + v[r][4 * i + 1]) + (v[r][4 * i + 2] + v[r][4 * i + 3]); } }
            const float mean0 = wave_sum(s[0], lane) * (1.0f / 1024.0f), mean1 = wave_sum(s[1], lane) * (1.0f / 1024.0f); float q[2] = {0.f, 0.f};
#pragma unroll
            for (int r = 0; r < 2; ++r)
#pragma unroll
                for (int e = 0; e < 16; ++e) { v[r][e] -= (r == 0 ? mean0 : mean1); q[r] += v[r][e] * v[r][e]; }
            const float rstd0 = rsqrtf(wave_sum(q[0], lane) * (1.0f / 1024.0f) + LN_EPS), rstd1 = rsqrtf(wave_sum(q[1], lane) * (1.0f / 1024.0f) + LN_EPS);
            unsigned wb[2][8]; unsigned w8[2][4];
#pragma unroll
            for (int j = 0; j < 4; ++j) { const f32x4 gvj = gv[j], bvj = bv[j];
#pragma unroll
                for (int r = 0; r < 2; ++r) { const size_t row = (size_t)rp * 2 + r; const float rs = (r == 0 ? rstd0 : rstd1);
                    const f32x4 o = (f32x4){v[r][4 * j], v[r][4 * j + 1], v[r][4 * j + 2], v[r][4 * j + 3]} * rs * gvj + bvj;
                    if (OUT) *(f32x4*)(OUT + row * 1024 + 16 * lane + 4 * j) = o;
                    else { wb[r][2 * j] = pk2(o[0], o[1]); wb[r][2 * j + 1] = pk2(o[2], o[3]);
                        int t8 = 0; t8 = __builtin_amdgcn_cvt_pk_fp8_f32(o[0], o[1], t8, false); t8 = __builtin_amdgcn_cvt_pk_fp8_f32(o[2], o[3], t8, true); w8[r][j] = (unsigned)t8; } } }
            if (!OUT) {
#pragma unroll
                for (int r = 0; r < 2; ++r) { const size_t row = (size_t)rp * 2 + r;
                    *(u32x4*)(XO + row * 1024 + 16 * lane) = (u32x4){wb[r][0], wb[r][1], wb[r][2], wb[r][3]}; *(u32x4*)(XO + row * 1024 + 16 * lane + 8) = (u32x4){wb[r][4], wb[r][5], wb[r][6], wb[r][7]};
                    if constexpr (INP_F8) *(u32x4*)((unsigned char*)XB + row * 1024 + 16 * lane) = (u32x4){w8[r][0], w8[r][1], w8[r][2], w8[r][3]};
                    else { *(u32x4*)(XB + row * 1024 + 16 * lane) = (u32x4){wb[r][0], wb[r][1], wb[r][2], wb[r][3]}; *(u32x4*)(XB + row * 1024 + 16 * lane + 8) = (u32x4){wb[r][4], wb[r][5], wb[r][6], wb[r][7]}; } } }
        }
        return;
    }
    for (int rp = gw; rp < NTOK / 2; rp += NGW) {
        f32x4 v[2][4]; float s[2] = {0.f, 0.f};
#pragma unroll
        for (int r = 0; r < 2; ++r) { const size_t row = (size_t)rp * 2 + r;
#pragma unroll
            for (int j = 0; j < 4; ++j) { const u32x2 a = *(const u32x2*)(X1 + row * 1024 + 4 * lane + 256 * j); v[r][j] = (f32x4){bflo(a.x), bfhi(a.x), bflo(a.y), bfhi(a.y)} * DN_ALPHA;
#pragma unroll
                for (int k = 0; k < 4; ++k) {
                    if constexpr (Y_F8) { const int y8 = *(const int*)((const unsigned char*)Y + (row * 4 + k) * 1024 + 4 * lane + 256 * j); const f32x2 lo = __builtin_amdgcn_cvt_pk_f32_fp8(y8, false), hi = __builtin_amdgcn_cvt_pk_f32_fp8(y8, true);
                        v[r][j][0] += lo[0] * (1.0f / Y_SCALE); v[r][j][1] += lo[1] * (1.0f / Y_SCALE); v[r][j][2] += hi[0] * (1.0f / Y_SCALE); v[r][j][3] += hi[1] * (1.0f / Y_SCALE); }
                    else { const u32x2 y = *(const u32x2*)(Y + (row * 4 + k) * 1024 + 4 * lane + 256 * j); v[r][j][0] += bflo(y.x); v[r][j][1] += bfhi(y.x); v[r][j][2] += bflo(y.y); v[r][j][3] += bfhi(y.y); } }
                s[r] += (v[r][j][0] + v[r][j][1]) + (v[r][j][2] + v[r][j][3]); } }
        const float mean0 = wave_sum(s[0], lane) * (1.0f / 1024.0f), mean1 = wave_sum(s[1], lane) * (1.0f / 1024.0f); float q[2] = {0.f, 0.f};
#pragma unroll
        for (int r = 0; r < 2; ++r)
#pragma unroll
            for (int j = 0; j < 4; ++j) { v[r][j] = v[r][j] - (r == 0 ? mean0 : mean1); q[r] += (v[r][j][0] * v[r][j][0] + v[r][j][1] * v[r][j][1]) + (v[r][j][2] * v[r][j][2] + v[r][j][3] * v[r][j][3]); }
        const float rstd0 = rsqrtf(wave_sum(q[0], lane) * (1.0f / 1024.0f) + LN_EPS), rstd1 = rsqrtf(wave_sum(q[1], lane) * (1.0f / 1024.0f) + LN_EPS);
#pragma unroll
        for (int j = 0; j < 4; ++j) { const f32x4 gvj = *(const f32x4*)(g + 4 * lane + 256 * j), bvj = *(const f32x4*)(bta + 4 * lane + 256 * j);
#pragma unroll
            for (int r = 0; r < 2; ++r) { const size_t row = (size_t)rp * 2 + r; const f32x4 o = v[r][j] * (r == 0 ? rstd0 : rstd1) * gvj + bvj;
                if (OUT) *(f32x4*)(OUT + row * 1024 + 4 * lane + 256 * j) = o;
                else { u32x2 w; w.x = pk2(o[0], o[1]); w.y = pk2(o[2], o[3]); *(u32x2*)(XO + row * 1024 + 4 * lane + 256 * j) = w;
                    if constexpr (INP_F8) { int w8 = 0; w8 = __builtin_amdgcn_cvt_pk_fp8_f32(o[0], o[1], w8, false); w8 = __builtin_amdgcn_cvt_pk_fp8_f32(o[2], o[3], w8, true); *(int*)((unsigned char*)XB + row * 1024 + 4 * lane + 256 * j) = w8; }
                    else { *(u32x2*)(XB + row * 1024 + 4 * lane + 256 * j) = w; } } } }
    }
}

constexpr int PH_PER_LAYER = 10, N_PHASES = 2 + PH_PER_LAYER * DEPTH;
__host__ __device__ constexpr bool phase_active(int p) {
    if (p < 2) return true;
    const int l = (p - 2) / PH_PER_LAYER, k = (p - 2) % PH_PER_LAYER, kind = l % 3;
    if (k == 1) return kind != 0;
    if (k == 3 || k == 4) return kind == 2;
    return true;
}

__global__ void __launch_bounds__(512, 2) fwd(Args args) {
    extern __shared__ __attribute__((aligned(16))) unsigned char lds_raw[];
    const int wave0 = __builtin_amdgcn_readfirstlane((int)threadIdx.x >> 6);
    Ctx cx; cx.lds = (LAS unsigned char*)lds_raw; cx.G = gridDim.x; { const int bx = blockIdx.x; cx.vcu = (cx.G % 8 == 0) ? (bx % 8) * (cx.G / 8) + bx / 8 : bx; } cx.ws = args.ws;
    volatile LAS unsigned* MISC = (volatile LAS unsigned*)(cx.lds + MISC_OFF);
    for (int u = threadIdx.x; u < (LDS_BYTES - MISC_OFF) / 4; u += 512) MISC[u] = 0u;
    __syncthreads();
    if (threadIdx.x == 0) { LAS unsigned long long* t = (LAS unsigned long long*)(cx.lds + PTAB_OFF);
#pragma unroll
        for (int k = 0; k < 32; ++k) t[k] = (unsigned long long)args.in[k];
        t[32] = (unsigned long long)args.out; t[33] = (unsigned long long)args.ws; }
    __syncthreads();
    const int lo = args.ph_lo, hi = args.ph_hi;
    XcdBarrier bar; bar.bar = (unsigned*)((gu32*)(args.ws + WS_CTL) + CW_BAR); bar.x = 0; bar.st = nullptr;
    if (hi - lo > 1) bar = xcd_barrier_post((unsigned*)((gu32*)(args.ws + WS_CTL) + CW_BAR), MISC + 8);
    int ran = 0, nobar = 0;
#define XB ((bf16_t*)(ws + WS_XB))
#define PROJ ((bf16_t*)(ws + WS_PROJ))
#define CAT ((bf16_t*)(ws + WS_CAT))
#define KVM ((bf16_t*)(ws + WS_KVM))
#define HB ((bf16_t*)(ws + WS_H))
#define YB ((bf16_t*)(ws + WS_Y))
#define QKR ((bf16_t*)(ws + WS_QKR))
#define EXPID ((int*)(ws + WS_EXPID))
#define GATE ((float*)(ws + WS_GATE))
#define IDX ((int*)(ws + WS_IDX))
#define XF ((float*)(GAS float*)ptab_get(cx, 32))
#define SB ((bf16_t*)(ws + WS_SB))
#define SB2 ((bf16_t*)(ws + WS_PROJ))
#define TP_BAR_BEGIN() do {} while (0)
#define TP_BAR_END() do {} while (0)
#define TP_PH_BEGIN(p) do {} while (0)
#define TP_PH_END(p) do {} while (0)
#define PH_BEGIN(p) if (lo <= (p) && (p) < hi) { const int ph_ = (p); if (ran && !nobar) { TP_BAR_BEGIN(); for (int rb_ = 0; rb_ < REP_BAR; ++rb_) xcd_barrier(bar, wave0); TP_BAR_END(); } ran = 1; nobar = 0; const int tid = opaque_tid(wave0); (void)tid; unsigned char* const ws = (unsigned char*)(GAS unsigned char*)ptab_get(cx, 33); cx.ws = ws; TP_PH_BEGIN(ph_);
#define PH_END TP_PH_END(ph_); }

#if EN_P0
    PH_BEGIN(0) for (int rep_ = 0; rep_ < REP_P0; ++rep_) { p0_prologue(cx, tid); } PH_END
#endif

    for (int l = -1; l < DEPTH; ++l) {
        const int kind = (l < 0) ? 0 : l % 3, jj = (l < 0) ? 0 : l / 3, pw = (l < 0) ? 2048 : ((l % 3) == 1 ? 1536 : 2560), base = 2 + PH_PER_LAYER * l;
        nobar = (l == 0 && hi - lo > 1) ? 1 : 0;
        PH_BEGIN(l < 0 ? 1 : base) {
            pg8::DenseOrder S;
            if (l < 0) S.init(ws + WS_MEMB, ws + WS_WKV, NMEM, 2048, 1024 * INP_EB, cx.G, (int)blockIdx.x);
            else S.init(XB, ws + WS_WIN + (size_t)l * 5 * MiB, NTOK, pw, 1024 * INP_EB, cx.G, (int)blockIdx.x);
            S.rep = REP_DENSE;
            const unsigned smask = (l < 0) ? 0u : (kind == 0 ? 0x207u : kind == 1 ? 0x20u : 0x200u);
            pg8::EpiBf16s E{l < 0 ? KVM : PROJ, pw, smask, C2, INP_F8 ? 1.0f / WIN_SCALE : 1.0f};
#if EN_G1
            pg8::gemm_phase<pg8::EpiBf16s, pg8::DenseOrder, false, INP_F8 != 0>(cx.lds, S, E, tid);
#endif
        } PH_END
        if (l < 0) continue;
#if EN_THIN
        if (kind == 1) { PH_BEGIN(base + 1) for (int rep_ = 0; rep_ < REP_THIN; ++rep_) { rope_phase(cx, PROJ, INP(5) + jj * 64, INP(6) + jj * 64, QKR, tid); } PH_END }
        if (kind == 2) { PH_BEGIN(base + 1) for (int rep_ = 0; rep_ < REP_THIN; ++rep_) { sconv_phase(cx, PROJ, INP(8) + (size_t)jj * 3 * 2304, INP(9) + (size_t)jj * 2304, (bf16_t*)(ws + WS_UT3), ws + WS_V8, tid); } PH_END }
#endif
        for (int o = 0; o < 2; ++o) {
            if (o == 1 && kind != 2) break;
            PH_BEGIN(base + 2 + o) {
                if (kind == 2) {
                    const bf16_t* UT3 = (const bf16_t*)(ws + WS_UT3); constexpr size_t PS = (size_t)16 * 768 * 4096;
#if EN_TCONV
                    for (int rep_ = 0; rep_ < REP_TCONV; ++rep_) {
#if TCONV_F8
                    tconv8_phase(cx, o, o == 0 ? UT3 : (const bf16_t*)(ws + WS_Z1T), ws + WS_V8 + (size_t)o * 48 * MiB, UT3 + (size_t)(1 + o) * PS, (bf16_t*)(ws + (o == 0 ? WS_Z1T : WS_Z2T)), o == 0 ? ws + WS_V8 + 48 * MiB : (unsigned char*)nullptr, INP(19) + (size_t)(jj * 2 + o) * 768, tid);
#else
                    tconv_phase(cx, o, o == 0 ? UT3 : (const bf16_t*)(ws + WS_Z1T), UT3 + (size_t)(1 + o) * PS, (bf16_t*)(ws + (o == 0 ? WS_Z1T : WS_Z2T)), INP(19) + (size_t)(jj * 2 + o) * 768, tid);
#endif
                    }
#endif
                }
                if (o == 0) {
#if EN_NA
                    for (int rep_ = 0; rep_ < REP_NA; ++rep_) { if (kind == 0) na_phase(cx, PROJ, INP(3) + (size_t)jj * 12 * 465, CAT, tid); }
#endif
                    const int ngqa = (kind == 1) ? 3072 : 0;
                    for (int rep_ = 0; rep_ < REP_ATTN; ++rep_)
                    for (int u = cx.vcu; u < ngqa + 1024; u += cx.G) {
                        const attn_body::bf16 *Q, *K, *V; attn_body::bf16* O; int QP, KP, VP, NT;
                        if (u < ngqa) { const int qb = u & 15, hq = (u >> 4) % 12, b = u / 192, kvh = hq / 3;
                            Q = (const attn_body::bf16*)QKR + ((size_t)b * 4096 + qb * 256) * 1024 + hq * 64; QP = 1024;
                            K = (const attn_body::bf16*)QKR + (size_t)b * 4096 * 1024 + 768 + kvh * 64; KP = 1024;
                            V = (const attn_body::bf16*)PROJ + (size_t)b * 4096 * 1536 + 1024 + kvh * 64; VP = 1536;
                            O = (attn_body::bf16*)((unsigned char*)CAT + (((size_t)b * 4096 + qb * 256) * 1024 + hq * 64) * OUT_EB); NT = 64;
                        } else { const int v = u - ngqa, qb = v & 15, h = (v >> 4) & 3, b = v >> 6;
                            Q = (const attn_body::bf16*)PROJ + ((size_t)b * 4096 + qb * 256) * pw + (pw - 256) + h * 64; QP = pw;
                            K = (const attn_body::bf16*)KVM + (size_t)b * 256 * 2048 + 512 * l + h * 64; KP = 2048;
                            V = K + 256; VP = 2048;
                            O = (attn_body::bf16*)((unsigned char*)CAT + (((size_t)b * 4096 + qb * 256) * 1024 + 768 + h * 64) * OUT_EB); NT = 4;
                        }
#if EN_ATTN
                        attn_body::attn_unit<8, OUTP_F8 != 0>(Q, K, V, O, QP, KP, VP, 1024, NT, (char*)lds_raw, tid);
#endif
                    }
                }
            } PH_END
        }
#if EN_THIN
        if (kind == 2) { PH_BEGIN(base + 4) for (int rep_ = 0; rep_ < REP_THIN; ++rep_) { tback_phase(cx, (const bf16_t*)(ws + WS_Z2T), CAT, tid); } PH_END }
#endif
        PH_BEGIN(base + 5) {
            pg8::DenseOrder S; S.init(CAT, ws + WS_WOUT + (size_t)l * 2 * MiB, NTOK, 1024, 1024 * OUT_EB, cx.G, (int)blockIdx.x);
            pg8::EpiResB E{SB, l == 0 ? (const void*)INP(0) : (const void*)SB, l == 0 ? 1 : 0, 1024, DN_ALPHA, OUTP_F8 ? 1.0f / WOUT_SCALE : 1.0f};
#if EN_G2
            pg8::gemm_phase<pg8::EpiResB, pg8::DenseOrder, false, OUTP_F8 != 0>(cx.lds, S, E, tid);
#endif
        } PH_END
#if EN_LN
#if REP_LN1 > 1
        PH_BEGIN(base + 6) ln1_router_phase(cx, SB, (bf16_t*)(ws + WS_PROJ), CAT, INP(22) + l * 1024, INP(23) + l * 1024, (const float*)(ws + WS_RW + (size_t)l * 131072), INP(27) + l * 32, (unsigned*)((gu32*)(ws + WS_CTL) + CW_DBG), EXPID, GATE, IDX, (float*)(ws + WS_GIDX), tid); PH_END
#endif
        PH_BEGIN(base + 6) ln1_router_phase(cx, SB, SB2, XB, INP(22) + l * 1024, INP(23) + l * 1024, (const float*)(ws + WS_RW + (size_t)l * 131072), INP(27) + l * 32, (unsigned*)((gu32*)(ws + WS_CTL) + CW_CNT + 32 * l), EXPID, GATE, IDX, (float*)(ws + WS_GIDX), tid); PH_END
#endif
        for (int half = 0; half < 2; ++half) {
            PH_BEGIN(base + 7 + half) {
                LAS int* pref = (LAS int*)(cx.lds + pg8::STAGE_BYTES); const unsigned* cntw = (const unsigned*)((gu32*)(ws + WS_CTL) + CW_CNT + 32 * l);
                __syncthreads();
                if (tid < NEXP) { const int c = (int)__hip_atomic_load(cntw + tid, __ATOMIC_RELAXED, __HIP_MEMORY_SCOPE_AGENT); pref[40 + tid] = c; pref[72 + tid] = (c + 255) >> 8; }
                __syncthreads();
                if (tid == 0) { int a = 0;
#pragma unroll 1
                    for (int e = 0; e < NEXP; ++e) { pref[e] = a; a += pref[72 + e]; } pref[NEXP] = a; }
                __syncthreads();
#if STAGGER
                if (cx.vcu & 1) { for (int s_ = 0; s_ < STAGGER; ++s_) __builtin_amdgcn_s_sleep(127); }
#endif
                if (half == 0) {
                    pg8::MoeOrder<2> S{(const char*)XB, (const char*)(ws + WS_W1 + (size_t)l * 32 * 2048 * 1024 * MOE_EB), 1024 * MOE_EB, 8, cx.G, cx.vcu, (size_t)2048 * 1024 * MOE_EB, pref, (const int*)cntw, IDX};
                    pg8::EpiSwiglu E{HB, INP(29) + (size_t)l * 32 * 2048};
#if EN_G3
                    for (int rep_ = 0; rep_ < REP_G3; ++rep_) { pg8::gemm_phase<pg8::EpiSwiglu, pg8::MoeOrder<2>, true, MOE_F8 != 0, (MOE_F8 != 0) && (DEFER_H != 0)>(cx.lds, S, E, tid); }
#endif
                } else {
                    pg8::MoeOrder<0> S{(const char*)HB, (const char*)(ws + WS_W2 + (size_t)l * 32 * 1024 * 1024 * MOE_EB), 1024 * MOE_EB, 4, cx.G, cx.vcu, (size_t)1024 * 1024 * MOE_EB, pref, (const int*)cntw, IDX};
                    pg8::EpiMoeOut E{YB, INP(31) + (size_t)l * 32 * 1024, (const float*)(ws + WS_GIDX)};
#if EN_G4
                    for (int rep_ = 0; rep_ < REP_G4; ++rep_) { pg8::gemm_phase<pg8::EpiMoeOut, pg8::MoeOrder<0>, true, MOE_F8 != 0>(cx.lds, S, E, tid); }
#endif
                }
            } PH_END
        }
#if EN_LN
#if REP_LN2 > 1
        PH_BEGIN(base + 9) ln2_phase(cx, SB, YB, (bf16_t*)(ws + WS_PROJ), CAT, (float*)nullptr, INP(24) + l * 1024, INP(25) + l * 1024, INP(22) + l * 1024, INP(23) + l * 1024, tid); PH_END
#endif
        PH_BEGIN(base + 9) ln2_phase(cx, (X1_RECOMP && Y_F8) ? SB : SB2, YB, SB, XB, l == DEPTH - 1 ? XF : (float*)nullptr, INP(24) + l * 1024, INP(25) + l * 1024, INP(22) + l * 1024, INP(23) + l * 1024, tid); PH_END

#endif
    }
#undef PH_BEGIN
#undef PH_END
#undef XB
#undef PROJ
#undef CAT
#undef KVM
#undef HB
#undef YB
#undef QKR
#undef EXPID
#undef GATE
#undef IDX
#undef XF
#undef SB
#undef SB2
}

extern "C" void kernel_launch(void* const* d_in, const int* in_sizes, int n_in, void* d_out, int out_size, void* d_ws, size_t ws_size, hipStream_t stream) {
    static int grid = 0;
    if (grid == 0) {
        if (n_in != 32 || in_sizes[0] != NTOK * DM || out_size != NTOK * DM || ws_size < WS_END) { fprintf(stderr, "kernel_launch: unexpected problem (n_in %d, in0 %d, out %d, ws %zu < %zu); nothing launched\n", n_in, n_in > 0 ? in_sizes[0] : -1, out_size, ws_size, (size_t)WS_END); grid = -1; return; }
        int dev = 0, cus = 0, per_cu = 0;
        if (hipGetDevice(&dev) != hipSuccess || hipDeviceGetAttribute(&cus, hipDeviceAttributeMultiprocessorCount, dev) != hipSuccess) { fprintf(stderr, "kernel_launch: device query failed\n"); grid = -1; return; }
        if (hipFuncSetAttribute((const void*)fwd, hipFuncAttributeMaxDynamicSharedMemorySize, LDS_BYTES) != hipSuccess) { fprintf(stderr, "kernel_launch: hipFuncSetAttribute failed\n"); grid = -1; return; }
        if (hipOccupancyMaxActiveBlocksPerMultiprocessor(&per_cu, (const void*)fwd, 512, LDS_BYTES) != hipSuccess || per_cu < 1) fprintf(stderr, "kernel_launch: occupancy query reports %d blocks per CU\n", per_cu);
        (void)hipGetLastError();
        grid = cus;
    }
    if (grid < 0) return;
    if (hipMemsetAsync((char*)d_ws + WS_CTL, 0, CTL_ZERO_BYTES, stream) != hipSuccess) { fprintf(stderr, "kernel_launch: memset failed\n"); return; }
    Args a{};
    for (int i = 0; i < 32; ++i) a.in[i] = (const float*)d_in[i];
    a.out = (float*)d_out; a.ws = (unsigned char*)d_ws;
#if MK_MULTI
    for (int p = 0; p < N_PHASES && p <= DBG_LAST_PHASE; ++p) {
        if (!phase_active(p)) continue;
        a.ph_lo = p; a.ph_hi = p + 1;
        hipLaunchKernelGGL(fwd, dim3(grid), dim3(512), LDS_BYTES, stream, a);
#if DBG_CHECK
        dbg_after_phase(p, a, stream);
#endif
    }
#if DBG_CHECK
    hipLaunchKernelGGL(dbg_report, dim3(1024), dim3(256), 0, stream, (unsigned*)((char*)d_ws + WS_CTL) + CW_DBG, (float*)d_out);
#endif
#else
    a.ph_lo = 0; a.ph_hi = N_PHASES;
    hipLaunchKernelGGL(fwd, dim3(grid), dim3(512), LDS_BYTES, stream, a);
#endif
    const hipError_t le = hipPeekAtLastError();
    if (le != hipSuccess) fprintf(stderr, "kernel_launch: launch failed: %s\n", hipGetErrorName(le));
}
```

```cpp
#include <hip/hip_runtime.h>
#include <hip/hip_bf16.h>
#include <cstdio>
#include <cstdint>

#ifndef MK_MULTI
#define MK_MULTI 0
#endif
#ifndef DBG_CHECK
#define DBG_CHECK 0
#endif
#ifndef DBG_LAST_PHASE
#define DBG_LAST_PHASE 9999
#endif

#ifndef EN_P0
#define EN_P0 1
#define EN_G1 1
#define EN_THIN 1
#define EN_TCONV 1
#define EN_NA 1
#define EN_ATTN 1
#define EN_G2 1
#define EN_LN 1
#define EN_G3 1
#define EN_G4 1
#endif

#ifndef REP_P0
#define REP_P0 1
#endif
#ifndef REP_G1
#define REP_G1 1
#endif
#ifndef REP_NA
#define REP_NA 1
#endif
#ifndef REP_ATTN
#define REP_ATTN 1
#endif
#ifndef REP_TCONV
#define REP_TCONV 1
#endif
#ifndef REP_THIN
#define REP_THIN 1
#endif
#ifndef REP_G3
#define REP_G3 1
#endif
#ifndef REP_G4
#define REP_G4 1
#endif
#ifndef ALIGN_EPI
#define ALIGN_EPI 1
#endif
#ifndef NT_STORE
#define NT_STORE 0
#endif
#ifndef X1_RECOMP
#define X1_RECOMP 1
#endif
#ifndef LN1_HOLD
#define LN1_HOLD 16
#endif
#ifndef DEFER_H
#define DEFER_H 0
#endif
#ifndef STAGGER
#define STAGGER 0
#endif
#ifndef REP_BAR
#define REP_BAR 1
#endif
#ifndef REP_DENSE
#define REP_DENSE 1
#endif
#ifndef REP_G2
#define REP_G2 1
#endif
#ifndef REP_LN1
#define REP_LN1 1
#endif
#ifndef REP_LN2
#define REP_LN2 1
#endif

#define GAS __attribute__((address_space(1)))
#define LAS __attribute__((address_space(3)))
typedef unsigned short bf16_t;
typedef short bf16x8 __attribute__((ext_vector_type(8)));
typedef short s16x4 __attribute__((ext_vector_type(4)));
typedef float f32x4 __attribute__((ext_vector_type(4)));
typedef float f32x2 __attribute__((ext_vector_type(2)));
typedef float f32x16 __attribute__((ext_vector_type(16)));
typedef unsigned u32x4 __attribute__((ext_vector_type(4)));
typedef unsigned u32x2 __attribute__((ext_vector_type(2)));
typedef GAS unsigned gu32;

constexpr int BATCH = 16, SEQ = 4096, DM = 1024, NTOK = BATCH * SEQ, DEPTH = 4;
constexpr int MEMLEN = 256, NMEM = BATCH * MEMLEN;
constexpr int NEXP = 32, NSLOT = NTOK * 4, IDXCAP = NTOK;
constexpr int GRIDW = 64;
constexpr float LN_EPS = 1e-5f;
constexpr float DN_ALPHA = 1.681792830507429f;
constexpr float LOG2E = 1.4426950408889634f;
constexpr float C2 = 0.125f * LOG2E;
__host__ __device__ constexpr int layer_kind(int l) { return l % 3; }
__host__ __device__ constexpr int layer_j(int l) { return l / 3; }
__host__ __device__ constexpr int in_width(int l) { return (l % 3) == 1 ? 1536 : 2560; }

#ifndef MOE_F8
#define MOE_F8 1
#endif
#ifndef INP_F8
#define INP_F8 1
#endif
constexpr int INP_EB = INP_F8 ? 1 : 2;
constexpr float WIN_SCALE = 32.0f;
#ifndef OUTP_F8
#define OUTP_F8 1
#endif
constexpr int OUT_EB = OUTP_F8 ? 1 : 2;
constexpr float WOUT_SCALE = 64.0f;
__device__ __forceinline__ unsigned char f2fp8(float x) { return (unsigned char)(__builtin_amdgcn_cvt_pk_fp8_f32(x, x, 0, false) & 0xff); }
#ifndef TCONV_F8
#define TCONV_F8 1
#endif
#ifndef Y_F8
#define Y_F8 1
#endif
constexpr float Y_SCALE = 64.0f;
constexpr int MOE_EB = MOE_F8 ? 1 : 2;
constexpr float W1_SCALE = 32.0f, W2_SCALE = 64.0f, H_SCALE = 4.0f;

constexpr size_t MiB = 1u << 20;
constexpr size_t WS_CTL = 0, CTL_ZERO_BYTES = 64 * 1024;
constexpr size_t WS_RW = 1 * MiB;
constexpr size_t WS_WIN = 2 * MiB;
constexpr size_t WS_WKV = 22 * MiB;
constexpr size_t WS_WOUT = 26 * MiB;
constexpr size_t WS_W1 = 34 * MiB;
constexpr size_t WS_W2 = 546 * MiB;
constexpr size_t WS_XB = 802 * MiB;
constexpr size_t WS_MEMB = 930 * MiB;
constexpr size_t WS_KVM = 938 * MiB;
constexpr size_t WS_PROJ = 954 * MiB;
constexpr size_t WS_CAT = 1274 * MiB;
constexpr size_t WS_H = 1402 * MiB;
constexpr size_t WS_Y = 1914 * MiB;
constexpr size_t WS_HRAWT = 2426 * MiB;
constexpr size_t WS_HPART = 2474 * MiB;
constexpr size_t WS_EXPID = 2478 * MiB;
constexpr size_t WS_GATE = 2479 * MiB;
constexpr size_t WS_IDX = 2480 * MiB;
constexpr size_t WS_SB = 2488 * MiB;
constexpr size_t WS_GIDX = 2616 * MiB;
constexpr size_t WS_END = 2624 * MiB;
constexpr size_t WS_UT3 = WS_H;
constexpr size_t WS_Z1T = WS_H + 288 * MiB;
constexpr size_t WS_Z2T = WS_H + 384 * MiB;
constexpr size_t WS_V8 = WS_Y;
constexpr size_t WS_QKR = WS_Y;
constexpr int CW_BAR = 4096;
constexpr int CW_CNT = 8192;
constexpr int CW_DBG = 12288;

constexpr int MISC_OFF = 150528;
constexpr int LDS_BYTES = 163840;

#define LDS_WAIT() asm volatile("s_waitcnt lgkmcnt(0)" ::: "memory")
#define VM_WAIT() asm volatile("s_waitcnt vmcnt(0)" ::: "memory")
__device__ __forceinline__ unsigned f2bf(float f) { unsigned u = __builtin_bit_cast(unsigned, f); return (u + 0x7fffu + ((u >> 16) & 1u)) >> 16; }
__device__ __forceinline__ unsigned pk2(float lo, float hi) { return f2bf(lo) | (f2bf(hi) << 16); }
__device__ __forceinline__ float bf2f(unsigned short b) { return __builtin_bit_cast(float, ((unsigned)b) << 16); }
__device__ __forceinline__ float bflo(unsigned w) { return __builtin_bit_cast(float, w << 16); }
__device__ __forceinline__ float bfhi(unsigned w) { return __builtin_bit_cast(float, w & 0xffff0000u); }
__device__ __forceinline__ float shflx(float v, int mask, int lane) { int t; asm volatile("v_mov_b32 %0, %1" : "=v"(t) : "v"(__builtin_bit_cast(int, v))); return __builtin_bit_cast(float, __builtin_amdgcn_ds_bpermute((lane ^ mask) << 2, t)); }
__device__ __forceinline__ int shflxi(int v, int mask, int lane) { return __builtin_amdgcn_ds_bpermute((lane ^ mask) << 2, v); }
template <int CTRL> __device__ __forceinline__ float dpp_x(float v) { return __builtin_bit_cast(float, __builtin_amdgcn_update_dpp(0, __builtin_bit_cast(int, v), CTRL, 0xF, 0xF, false)); }
__device__ __forceinline__ float group8_sum(float v) { v += dpp_x<0xB1>(v); v += dpp_x<0x4E>(v); v += dpp_x<0x141>(v); return v; }
__device__ __forceinline__ float wave_sum(float v, int  ) {
    v += dpp_x<0xB1>(v); v += dpp_x<0x4E>(v); v += dpp_x<0x141>(v); v += dpp_x<0x140>(v);
    v += __builtin_bit_cast(float, __builtin_amdgcn_update_dpp(0, __builtin_bit_cast(int, v), 0x142, 0xA, 0xF, false));
    v += __builtin_bit_cast(float, __builtin_amdgcn_update_dpp(0, __builtin_bit_cast(int, v), 0x143, 0xC, 0xF, false));
    return __builtin_bit_cast(float, __builtin_amdgcn_readlane(__builtin_bit_cast(int, v), 63));
}
__device__ __forceinline__ int lane_id_volatile() { int l; asm volatile("v_mbcnt_lo_u32_b32 %0, -1, 0\n\tv_mbcnt_hi_u32_b32 %0, -1, %0" : "=&v"(l)); return l; }
__device__ __forceinline__ int opaque_tid(int wave0) { return wave0 * 64 + lane_id_volatile(); }

#define XB_TMO      128
#define XB_XCNT(j)  (256  + 64 * (j))
#define XB_XSUB(j)  (1280 + 64 * (j))
#define XB_XGEN(j)  (2304 + 64 * (j))
#define XB_TOP      3328
#define XB_TOPGEN   3392
#define XCD_BAR_WORDS 3456
#define XB_SPIN_CAP (1u << 20)

__device__ __forceinline__ unsigned xb_ld(unsigned* p)              { return __hip_atomic_load(p, __ATOMIC_RELAXED, __HIP_MEMORY_SCOPE_AGENT); }
__device__ __forceinline__ unsigned xb_add(unsigned* p, unsigned v) { return __hip_atomic_fetch_add(p, v, __ATOMIC_RELAXED, __HIP_MEMORY_SCOPE_AGENT); }
__device__ __forceinline__ unsigned xb_xcc_id() { return (unsigned)__builtin_amdgcn_s_getreg((3 << 11) | 20) & 0xFu; }
#define XB_SPIN(cond, bar) do { unsigned _sp = 0; while (cond) { __builtin_amdgcn_s_sleep(1); \
    if ((++_sp & 255u) == 0u) { if (xb_ld(&(bar)[XB_TMO])) break; if (_sp > XB_SPIN_CAP) { atomicAdd(&(bar)[XB_TMO], 1u); break; } } } } while (0)

struct XcdBarrier {
    unsigned* bar; unsigned x;
    volatile LAS unsigned* st;
};
__device__ __forceinline__ XcdBarrier xcd_barrier_post(unsigned* bar, volatile LAS unsigned* st) {
    XcdBarrier b; b.bar = bar; b.x = xb_xcc_id(); b.st = st;
    if (threadIdx.x == 0) (void)xb_add(&bar[XB_XCNT(b.x)], 1u);
    return b;
}
__device__ __forceinline__ void xcd_barrier_complete(unsigned* bar, unsigned x, unsigned& nloc, unsigned& nx) {
    const unsigned G = gridDim.x * gridDim.y * gridDim.z;
    unsigned sum, cnt, mine, sp = 0u;
    for (;;) {
        sum = 0u; cnt = 0u; mine = 0u;
#pragma unroll 1
        for (unsigned j = 0; j < 16; ++j) { const unsigned c = xb_ld(&bar[XB_XCNT(j)]); sum += c; cnt += (c > 0u) ? 1u : 0u; mine = (j == x) ? c : mine; }
        if (sum == G) break;
        __builtin_amdgcn_s_sleep(1);
        if ((++sp & 255u) == 0u) { if (xb_ld(&bar[XB_TMO])) break; if (sp > XB_SPIN_CAP) { atomicAdd(&bar[XB_TMO], 1u); break; } }
    }
    nloc = mine > 0u ? mine : 1u; nx = cnt > 0u ? cnt : 1u;
}
__device__ __forceinline__ void xcd_barrier(const XcdBarrier& b, const int wave0) {
    asm volatile("s_waitcnt vmcnt(0)" ::: "memory");
    __syncthreads();
    if (wave0 == 0 && lane_id_volatile() == 0) {
        unsigned* bar = b.bar;
        __builtin_amdgcn_s_waitcnt(0);
        unsigned nloc = b.st[0], nx = b.st[1];
        if (nloc == 0u) { xcd_barrier_complete(bar, b.x, nloc, nx); b.st[0] = nloc; b.st[1] = nx; }
        const unsigned old = xb_add(&bar[XB_XSUB(b.x)], 1u);
        const unsigned gen = old / nloc;
        if (old + 1u == (gen + 1u) * nloc) {
            __builtin_amdgcn_fence(__ATOMIC_RELEASE, "agent");
            asm volatile("s_waitcnt vmcnt(0)" ::: "memory");
            const unsigned og = xb_add(&bar[XB_TOP], 1u);
            const unsigned tg = og / nx;
            if (og + 1u == (tg + 1u) * nx) xb_add(&bar[XB_TOPGEN], 1u);
            else XB_SPIN(xb_ld(&bar[XB_TOPGEN]) == tg, bar);
            __builtin_amdgcn_fence(__ATOMIC_ACQUIRE, "agent");
            xb_add(&bar[XB_XGEN(b.x)], 1u);
            asm volatile("s_waitcnt vmcnt(0)" ::: "memory");
        } else {
            XB_SPIN(xb_ld(&bar[XB_XGEN(b.x)]) == gen, bar);
            __builtin_amdgcn_fence(__ATOMIC_ACQUIRE, "agent");
            asm volatile("s_waitcnt vmcnt(0)" ::: "memory");
        }
    }
    __syncthreads();
}

namespace pg8 {
constexpr int BM = 256, BK = 64, HALF = 128, HTB = HALF * BK * 2  , STAGE_BYTES = 8 * HTB, NXCD = 8, WGM = 8;
__host__ __device__ __forceinline__ int lds_byte(int r, int c) { const int st = (r >> 4) * 2 + (c >> 5), rr = r & 15, cc = c & 31, ob = rr * 64 + cc * 2; return st * 1024 + (ob ^ (((ob >> 9) & 1) << 5)); }
__host__ __device__ __forceinline__ void stage_rc(int b, int& R, int& C) { const int st = b / 1024, sb = b % 1024, swz = sb ^ (((sb >> 9) & 1) << 5); R = (st >> 1) * 16 + swz / 64; C = (st & 1) * 32 + (swz % 64) / 2; }
__host__ __device__ __forceinline__ int perm32(int rho) { const int n = rho >> 4, i = rho & 15; return 8 * (i >> 2) + 4 * n + (i & 3); }

struct Unit { int pm, pn, e, p; };

struct DenseOrder {
    const char* A; const char* Bt; int KB; int nM, nN, nwg, G, c; int rep = 1;
    __device__ __forceinline__ void init(const void* A_, const void* Bt_, int M, int N, int KB_, int G_, int c_) { A = (const char*)A_; Bt = (const char*)Bt_; KB = KB_; nM = M / BM; nN = N / BM; nwg = nM * nN; G = G_; c = c_; }
    __device__ __forceinline__ bool next(int i, Unit& u) const {
        long L = (long)i * G + c; if (L >= (long)nwg * rep) return false;
        if (rep > 1) L %= nwg;
        int wgid = (int)L; { const int q = nwg / NXCD, r = nwg % NXCD, xcd = wgid % NXCD, off = wgid / NXCD; wgid = (xcd < r ? xcd * (q + 1) : r * (q + 1) + (xcd - r) * q) + off; }
        const int nig = WGM * nN, gid = wgid / nig, fm = gid * WGM, gsz = (nM - fm) < WGM ? (nM - fm) : WGM;
        u.pm = __builtin_amdgcn_readfirstlane(fm + ((wgid % nig) % gsz)); u.pn = __builtin_amdgcn_readfirstlane((wgid % nig) / gsz); u.e = 0; u.p = 0; return true;
    }
    __device__ __forceinline__ const char* a_base(const Unit& u) const { return A + (size_t)u.pm * BM * KB; }
    __device__ __forceinline__ const char* b_base(const Unit& u) const { return Bt + (size_t)u.pn * BM * KB; }
    __device__ __forceinline__ const int* idx_src(const Unit&) const { return nullptr; }
    __device__ __forceinline__ int nvalid(const Unit&) const { return BM; }
    static constexpr int ROW_SHIFT = 0;
};
template <int SHIFT  > struct MoeOrder {
    const char* A; const char* Bt; int KB; int nN; int G, c; size_t bstride; const LAS int* pref; const int* cnt; const int* idx;
    __device__ __forceinline__ bool next(int i, Unit& u) const {
        const long L = (long)i * G + c; const int tot = __builtin_amdgcn_readfirstlane(pref[NEXP]);
        if (L >= (long)tot * nN) return false;
        const int pg = __builtin_amdgcn_readfirstlane((int)(L / nN)); u.pn = __builtin_amdgcn_readfirstlane((int)(L % nN));
        int e = 0;
#pragma unroll
        for (int step = 16; step >= 1; step >>= 1) { const int v = __builtin_amdgcn_readfirstlane(pref[e + step]); e += (v <= pg) ? step : 0; }
        u.e = e; u.p = pg - __builtin_amdgcn_readfirstlane(pref[e]); u.pm = 0; return true;
    }
    __device__ __forceinline__ const char* a_base(const Unit&) const { return A; }
    __device__ __forceinline__ const char* b_base(const Unit& u) const { return Bt + (size_t)u.e * bstride + (size_t)u.pn * BM * KB; }
    __device__ __forceinline__ const int* idx_src(const Unit& u) const { return idx + (size_t)u.e * IDXCAP + u.p * BM; }
    __device__ __forceinline__ int nvalid(const Unit& u) const { const int n = __builtin_amdgcn_readfirstlane(pref[40 + u.e]) - u.p * BM; return n < BM ? n : BM; }
    static constexpr int ROW_SHIFT = SHIFT;
};

__device__ __forceinline__ unsigned cvt_pk_bf16(float lo, float hi) { unsigned r; asm volatile("v_cvt_pk_bf16_f32 %0, %1, %2" : "=v"(r) : "v"(lo), "v"(hi)); return r; }

struct EpiBf16s {
    static constexpr bool PERM = true; static constexpr bool HAS_BIAS = false;
    bf16_t* O; int ldc; unsigned smask; float scale; float base;
    __device__ __forceinline__ void operator()(const f32x4 (&acc)[2][2][4][2], const Unit& u, int wr, int wc, int fr, int fq) const {
        const int row0 = u.pm * BM + wr * 64 + fr, col0 = u.pn * BM + wc * 32 + 8 * fq;
        const float sc = (((smask >> u.pn) & 1u) ? scale : 1.f) * base;
#pragma unroll
        for (int ai = 0; ai < 2; ++ai)
#pragma unroll
            for (int m = 0; m < 4; ++m) { bf16_t* rowp = O + (size_t)(row0 + ai * HALF + m * 16) * ldc + col0;
#pragma unroll
                for (int bj = 0; bj < 2; ++bj) { const f32x4 v0 = acc[ai][bj][m][0] * sc, v1 = acc[ai][bj][m][1] * sc;
                    u32x4 w; w.x = cvt_pk_bf16(v0[0], v0[1]); w.y = cvt_pk_bf16(v0[2], v0[3]); w.z = cvt_pk_bf16(v1[0], v1[1]); w.w = cvt_pk_bf16(v1[2], v1[3]);
                    if (NT_STORE) __builtin_nontemporal_store(w, (u32x4*)(rowp + bj * HALF)); else *(u32x4*)(rowp + bj * HALF) = w; }
                asm volatile("" ::: "memory"); }
    }
};
struct EpiResB {
    static constexpr bool PERM = true; static constexpr bool HAS_BIAS = false;
    bf16_t* C; const void* res; int res_f32; int ldc; float alpha; float ascale;
    __device__ __forceinline__ void operator()(const f32x4 (&acc)[2][2][4][2], const Unit& u, int wr, int wc, int fr, int fq) const {
        const int row0 = u.pm * BM + wr * 64 + fr, col0 = u.pn * BM + wc * 32 + 8 * fq;
        if (res_f32) {
#pragma unroll
            for (int ai = 0; ai < 2; ++ai) { f32x4 r[4][2][2];
#pragma unroll
                for (int m = 0; m < 4; ++m)
#pragma unroll
                    for (int bj = 0; bj < 2; ++bj) { const float* rp = (const float*)res + (size_t)(row0 + ai * HALF + m * 16) * ldc + col0 + bj * HALF; r[m][bj][0] = *(const f32x4*)rp; r[m][bj][1] = *(const f32x4*)(rp + 4); }
#pragma unroll
                for (int m = 0; m < 4; ++m)
#pragma unroll
                    for (int bj = 0; bj < 2; ++bj) { const size_t off = (size_t)(row0 + ai * HALF + m * 16) * ldc + col0 + bj * HALF;
                        const f32x4 v0 = r[m][bj][0] * alpha + acc[ai][bj][m][0] * ascale, v1 = r[m][bj][1] * alpha + acc[ai][bj][m][1] * ascale;
                        u32x4 w; w.x = cvt_pk_bf16(v0[0], v0[1]); w.y = cvt_pk_bf16(v0[2], v0[3]); w.z = cvt_pk_bf16(v1[0], v1[1]); w.w = cvt_pk_bf16(v1[2], v1[3]);
                        *(u32x4*)(C + off) = w; }
                asm volatile("" ::: "memory"); }
        } else { u32x4 raw[2][4][2];
#pragma unroll
            for (int ai = 0; ai < 2; ++ai)
#pragma unroll
                for (int m = 0; m < 4; ++m)
#pragma unroll
                    for (int bj = 0; bj < 2; ++bj) raw[ai][m][bj] = __builtin_nontemporal_load((const u32x4*)((const bf16_t*)res + (size_t)(row0 + ai * HALF + m * 16) * ldc + col0 + bj * HALF));
#pragma unroll
            for (int ai = 0; ai < 2; ++ai)
#pragma unroll
                for (int m = 0; m < 4; ++m)
#pragma unroll
                    for (int bj = 0; bj < 2; ++bj) { const size_t off = (size_t)(row0 + ai * HALF + m * 16) * ldc + col0 + bj * HALF; const u32x4 rw = raw[ai][m][bj];
                        const f32x4 r0 = (f32x4){bflo(rw.x), bfhi(rw.x), bflo(rw.y), bfhi(rw.y)}, r1 = (f32x4){bflo(rw.z), bfhi(rw.z), bflo(rw.w), bfhi(rw.w)};
                        const f32x4 v0 = r0 * alpha + acc[ai][bj][m][0] * ascale, v1 = r1 * alpha + acc[ai][bj][m][1] * ascale;
                        u32x4 w; w.x = cvt_pk_bf16(v0[0], v0[1]); w.y = cvt_pk_bf16(v0[2], v0[3]); w.z = cvt_pk_bf16(v1[0], v1[1]); w.w = cvt_pk_bf16(v1[2], v1[3]);
                        *(u32x4*)(C + off) = w; }
        }
    }
};
struct Pend { u32x2 val[8]; };
struct EpiSwiglu {
    static constexpr bool PERM = true; static constexpr bool HAS_GATE = false; static constexpr bool HAS_BIAS = true;
    __device__ __forceinline__ void load_bias(const Unit& u, int wc, int fq, f32x4 (&bp)[4]) const { const float* bg = b1 + (size_t)u.e * 2048 + u.pn * HALF + wc * 32 + 8 * fq; bp[0] = *(const f32x4*)bg; bp[1] = *(const f32x4*)(bg + 4); bp[2] = *(const f32x4*)(bg + 1024); bp[3] = *(const f32x4*)(bg + 1028); }
    bf16_t* H; const float* b1;
    __device__ __forceinline__ void prepare(const f32x4 (&acc)[2][2][4][2], const Unit& u, int wr, int wc, int fr, int fq, Pend& pd) const {
        constexpr float ASC = 1.0f / W1_SCALE;
        const int j0 = u.pn * HALF + wc * 32 + 8 * fq; const float* bg = b1 + (size_t)u.e * 2048 + j0; const float* bu = bg + 1024;
        const f32x4 bg0 = *(const f32x4*)bg, bg1 = *(const f32x4*)(bg + 4), bu0 = *(const f32x4*)bu, bu1 = *(const f32x4*)(bu + 4);
#pragma unroll
        for (int q8 = 0; q8 < 8; ++q8) { const int ai = q8 >> 2, m = q8 & 3;
            float o[8];
#pragma unroll
            for (int q = 0; q < 8; ++q) { const float gb = (q < 4 ? bg0[q & 3] : bg1[q & 3]), ub = (q < 4 ? bu0[q & 3] : bu1[q & 3]);
                float g = acc[ai][0][m][q >> 2][q & 3] * ASC + gb, uu = acc[ai][1][m][q >> 2][q & 3] * ASC + ub;
                g = fminf(g, 7.0f); uu = fminf(fmaxf(uu, -7.0f), 7.0f);
                const float sg = __builtin_amdgcn_rcpf(1.0f + __builtin_amdgcn_exp2f(-1.702f * LOG2E * g));
                o[q] = (uu + 1.0f) * (g * sg); }
            int w0 = 0, w1 = 0;
            w0 = __builtin_amdgcn_cvt_pk_fp8_f32(o[0] * H_SCALE, o[1] * H_SCALE, w0, false); w0 = __builtin_amdgcn_cvt_pk_fp8_f32(o[2] * H_SCALE, o[3] * H_SCALE, w0, true);
            w1 = __builtin_amdgcn_cvt_pk_fp8_f32(o[4] * H_SCALE, o[5] * H_SCALE, w1, false); w1 = __builtin_amdgcn_cvt_pk_fp8_f32(o[6] * H_SCALE, o[7] * H_SCALE, w1, true);
            pd.val[q8] = (u32x2){(unsigned)w0, (unsigned)w1}; }
    }
    __device__ __forceinline__ void store_one(const u32x2 v, const LAS int* ids, const int r, const int nv, const int j0) const { if (r < nv) { const int slot = ids[r]; *(u32x2*)((unsigned char*)H + (size_t)slot * 1024 + j0) = v; } }
    __device__ __forceinline__ void operator()(const f32x4 (&acc)[2][2][4][2], const Unit& u, int wr, int wc, int fr, int fq, const LAS int* ids, const int nv, const f32x4 (&bp)[4]) const {
        constexpr float ASC = MOE_F8 ? 1.0f / W1_SCALE : 1.0f;
        constexpr float HS = MOE_F8 ? H_SCALE : 1.0f, KK = -1.702f * LOG2E, GA = ASC * KK, UA = ASC * HS / KK, ULO = 8.0f * HS / KK, UHI = -6.0f * HS / KK, GLO = 7.0f * KK;
        const int j0 = u.pn * HALF + wc * 32 + 8 * fq;
        const f32x4 bg0 = bp[0] * KK, bg1 = bp[1] * KK; f32x4 bu0 = (bp[2] + 1.0f) * (HS / KK), bu1 = (bp[3] + 1.0f) * (HS / KK);
        asm volatile("" : "+v"(bu0), "+v"(bu1));
        int rb = wr * 64 + fr; asm volatile("" : "+v"(rb));
        const LAS int* idp = ids + rb; int slots[8];
#pragma unroll
        for (int q = 0; q < 8; ++q) slots[q] = idp[(q >> 2) * HALF + (q & 3) * 16];
#pragma unroll
        for (int ai = 0; ai < 2; ++ai)
#pragma unroll
            for (int m = 0; m < 4; ++m) { const int r = ai * HALF + m * 16 + rb;
                if (r < nv) { const int slot = slots[ai * 4 + m];
                    float o[8];
#pragma unroll
                    for (int q = 0; q < 8; ++q) { const float gb = (q < 4 ? bg0[q & 3] : bg1[q & 3]), ub = (q < 4 ? bu0[q & 3] : bu1[q & 3]);
                        const float gp = fmaxf(__builtin_fmaf(acc[ai][0][m][q >> 2][q & 3], GA, gb), GLO);
                        const float us = fminf(fmaxf(__builtin_fmaf(acc[ai][1][m][q >> 2][q & 3], UA, ub), ULO), UHI);
                        const float sg = __builtin_amdgcn_rcpf(1.0f + __builtin_amdgcn_exp2f(gp));
                        o[q] = us * (gp * sg); }
                    if constexpr (MOE_F8) { int w0 = 0, w1 = 0;
                        w0 = __builtin_amdgcn_cvt_pk_fp8_f32(o[0], o[1], w0, false); w0 = __builtin_amdgcn_cvt_pk_fp8_f32(o[2], o[3], w0, true);
                        w1 = __builtin_amdgcn_cvt_pk_fp8_f32(o[4], o[5], w1, false); w1 = __builtin_amdgcn_cvt_pk_fp8_f32(o[6], o[7], w1, true);
                        *(u32x2*)((unsigned char*)H + (size_t)slot * 1024 + j0) = (u32x2){(unsigned)w0, (unsigned)w1};
                    } else { u32x4 w; w.x = cvt_pk_bf16(o[0], o[1]); w.y = cvt_pk_bf16(o[2], o[3]); w.z = cvt_pk_bf16(o[4], o[5]); w.w = cvt_pk_bf16(o[6], o[7]);
                        *(u32x4*)(H + (size_t)slot * 1024 + j0) = w; } } }
    }
};
struct EpiMoeOut {
    static constexpr bool PERM = true; static constexpr bool HAS_GATE = true; static constexpr bool HAS_BIAS = true;
    __device__ __forceinline__ void load_bias(const Unit& u, int wc, int fq, f32x4 (&bp)[4]) const { const float* bb = b2 + (size_t)u.e * 1024 + u.pn * BM + wc * 32 + 8 * fq; bp[0] = *(const f32x4*)bb; bp[1] = *(const f32x4*)(bb + 4); bp[2] = *(const f32x4*)(bb + HALF); bp[3] = *(const f32x4*)(bb + HALF + 4); }
    bf16_t* Y; const float* b2;   const float* gidx;
    __device__ __forceinline__ void operator()(const f32x4 (&acc)[2][2][4][2], const Unit& u, int wr, int wc, int fr, int fq, const LAS int* ids, const int nv, const f32x4 (&bp)[4]) const {
        const LAS float* gts = (const LAS float*)(ids + 768);
        constexpr float OSC = MOE_F8 ? 1.0f / (H_SCALE * W2_SCALE) : 1.0f;
        const int c0 = u.pn * BM + wc * 32 + 8 * fq;
        f32x4 bv[2][2]; bv[0][0] = bp[0]; bv[0][1] = bp[1]; bv[1][0] = bp[2]; bv[1][1] = bp[3];
        int rb = wr * 64 + fr; asm volatile("" : "+v"(rb));
        const LAS int* idp = ids + rb; int slots[8];
#pragma unroll
        for (int q = 0; q < 8; ++q) slots[q] = idp[(q >> 2) * HALF + (q & 3) * 16];
#pragma unroll
        for (int ai = 0; ai < 2; ++ai)
#pragma unroll
            for (int m = 0; m < 4; ++m) { const int r = ai * HALF + m * 16 + rb;
                if (r < nv) { const int slot = slots[ai * 4 + m]; const float gt = gts[r];
                    if constexpr (Y_F8) {
                        unsigned pk[2][2];
#pragma unroll
                        for (int bj = 0; bj < 2; ++bj) { const f32x4 s0 = (acc[ai][bj][m][0] * OSC + bv[bj][0]) * (gt * Y_SCALE), s1 = (acc[ai][bj][m][1] * OSC + bv[bj][1]) * (gt * Y_SCALE); int w0 = 0, w1 = 0;
                            w0 = __builtin_amdgcn_cvt_pk_fp8_f32(s0[0], s0[1], w0, false); w0 = __builtin_amdgcn_cvt_pk_fp8_f32(s0[2], s0[3], w0, true); w1 = __builtin_amdgcn_cvt_pk_fp8_f32(s1[0], s1[1], w1, false); w1 = __builtin_amdgcn_cvt_pk_fp8_f32(s1[2], s1[3], w1, true);
                            pk[bj][0] = (unsigned)w0; pk[bj][1] = (unsigned)w1; }
                        const auto x0 = __builtin_amdgcn_permlane16_swap(pk[0][0], pk[1][0], false, false), x1 = __builtin_amdgcn_permlane16_swap(pk[0][1], pk[1][1], false, false);
                        *(u32x4*)((unsigned char*)Y + (size_t)slot * 1024 + c0 + ((fq & 1) ? 120 : 0)) = (u32x4){x0[0], x1[0], x0[1], x1[1]};
                    } else {
#pragma unroll
                    for (int bj = 0; bj < 2; ++bj) { const f32x4 v0 = (acc[ai][bj][m][0] * OSC + bv[bj][0]) * gt, v1 = (acc[ai][bj][m][1] * OSC + bv[bj][1]) * gt;
                        u32x4 w; w.x = cvt_pk_bf16(v0[0], v0[1]); w.y = cvt_pk_bf16(v0[2], v0[3]); w.z = cvt_pk_bf16(v1[0], v1[1]); w.w = cvt_pk_bf16(v1[2], v1[3]);
                        if (NT_STORE) __builtin_nontemporal_store(w, (u32x4*)(Y + (size_t)slot * 1024 + c0 + bj * HALF)); else *(u32x4*)(Y + (size_t)slot * 1024 + c0 + bj * HALF) = w; } } } }
    }
};

__device__ __forceinline__ const char* uni_ptr(const char* p) { const unsigned long long v = (unsigned long long)p; const unsigned lo = __builtin_amdgcn_readfirstlane((unsigned)v), hi = __builtin_amdgcn_readfirstlane((unsigned)(v >> 32)); return (const char*)(((unsigned long long)hi << 32) | lo); }
typedef int v4i_t __attribute__((ext_vector_type(4))); typedef int v8i_t __attribute__((ext_vector_type(8)));
__device__ __forceinline__ v8i_t cat8(const bf16x8 a, const bf16x8 b) { return __builtin_shufflevector(__builtin_bit_cast(v4i_t, a), __builtin_bit_cast(v4i_t, b), 0, 1, 2, 3, 4, 5, 6, 7); }
template <class Epi, class Sched, bool GATHER, bool F8 = false, bool DEFER = false>
__device__ __forceinline__ void gemm_phase(LAS unsigned char* lds, const Sched& S, const Epi& E, const int tid) {
    const int wid = __builtin_amdgcn_readfirstlane(tid >> 6), lane = tid & 63, wr = wid >> 2, wc = wid & 3, fr = lane & 15, fq = lane >> 4;
    const int KB = S.KB, nt = KB / 128;
    unsigned voffA[2], voffB[2];
#pragma unroll
    for (int i = 0; i < 2; ++i) { int R, C; stage_rc(tid * 16 + i * 8192, R, C); const int Rb = Epi::PERM ? ((R & ~31) + perm32(R & 31)) : R;
        voffA[i] = (unsigned)(R * KB + C * 2); voffB[i] = (unsigned)(Rb * KB + C * 2); }
    const size_t kstep = (size_t)(BK * 2);
    const size_t hstep = (size_t)HALF * KB;
    const unsigned ldsw = (unsigned)wid * 1024u;
    const int aoff = lds_byte(wr * 64 + fr, fq * 8), boff = lds_byte(wc * 32 + fr, fq * 8);
#define PG8_SA(b, h) (((b) * 2 + (h)) * HTB)
#define PG8_SB(b, h) ((4 + (b) * 2 + (h)) * HTB)
#define PG8_STAGE(bufoff, gbase, voff) do { const char* _gb = uni_ptr((const char*)(gbase)); _Pragma("unroll") for (int _i = 0; _i < 2; ++_i) \
        __builtin_amdgcn_global_load_lds((const unsigned*)(_gb + (voff)[_i]), (LAS unsigned*)(lds + (bufoff) + ldsw + _i * 8192), 16, 0, 0); } while (0)
#define PG8_STAGE_A(bufoff, kb, h, GO) do { if constexpr (GATHER) { PG8_STAGE(bufoff, kb, (GO)[h]); } else { PG8_STAGE(bufoff, (kb) + (h) * hstep, voffA); } } while (0)
#define PG8_LDA(dst, b, h) do { if constexpr (F8) { _Pragma("unroll") for (int m = 0; m < 4; ++m) dst##8[m] = cat8(*(const LAS bf16x8*)(lds + PG8_SA(b, h) + aoff + m * 2048), *(const LAS bf16x8*)(lds + PG8_SA(b, h) + aoff + m * 2048 + 1024)); } else { \
        _Pragma("unroll") for (int m = 0; m < 4; ++m) _Pragma("unroll") for (int k = 0; k < 2; ++k) dst[m][k] = *(const LAS bf16x8*)(lds + PG8_SA(b, h) + aoff + m * 2048 + k * 1024); } } while (0)
#define PG8_LDB(dst, b, h) do { if constexpr (F8) { _Pragma("unroll") for (int n = 0; n < 2; ++n) dst##8[n] = cat8(*(const LAS bf16x8*)(lds + PG8_SB(b, h) + boff + n * 2048), *(const LAS bf16x8*)(lds + PG8_SB(b, h) + boff + n * 2048 + 1024)); } else { \
        _Pragma("unroll") for (int n = 0; n < 2; ++n) _Pragma("unroll") for (int k = 0; k < 2; ++k) dst[n][k] = *(const LAS bf16x8*)(lds + PG8_SB(b, h) + boff + n * 2048 + k * 1024); } } while (0)
#define PG8_MMA(ai, bj, At, Bt) do { __builtin_amdgcn_s_setprio(1); if constexpr (F8) { _Pragma("unroll") for (int m = 0; m < 4; ++m) _Pragma("unroll") for (int n = 0; n < 2; ++n) \
        acc[ai][bj][m][n] = __builtin_amdgcn_mfma_scale_f32_16x16x128_f8f6f4(Bt##8[n], At##8[m], acc[ai][bj][m][n], 0, 0, 0, 0, 0, 0); } else { \
        _Pragma("unroll") for (int m = 0; m < 4; ++m) _Pragma("unroll") for (int n = 0; n < 2; ++n) _Pragma("unroll") for (int k = 0; k < 2; ++k) \
        acc[ai][bj][m][n] = __builtin_amdgcn_mfma_f32_16x16x32_bf16(Bt[n][k], At[m][k], acc[ai][bj][m][n], 0, 0, 0); } __builtin_amdgcn_s_setprio(0); } while (0)
#define PG8_WAIT_V(n) asm volatile("s_waitcnt vmcnt(" #n ")" ::: "memory")
#define PG8_WAIT_L(n) asm volatile("s_waitcnt lgkmcnt(" #n ")" ::: "memory")
#define PG8_BAR __builtin_amdgcn_s_barrier()
#define PG8_SCHED __builtin_amdgcn_sched_barrier(0)
    LAS int* const ibuf = (LAS int*)(lds + STAGE_BYTES + 512);
#define PG8_IDMA(u, b) do { if constexpr (GATHER) { __builtin_amdgcn_global_load_lds((const unsigned*)(S.idx_src(u) + 64 * (wid & 3) + lane), (LAS unsigned*)(ibuf + (b) * 256 + 64 * (wid & 3)), 4, 0, 0); \
        if constexpr (Epi::HAS_GATE) __builtin_amdgcn_global_load_lds((const unsigned*)(E.gidx + (S.idx_src(u) - S.idx) + 64 * (wid & 3) + lane), (LAS unsigned*)(ibuf + 768 + (b) * 256 + 64 * (wid & 3)), 4, 0, 0); } } while (0)
#define PG8_GOFF(dst, u, b) do { if constexpr (GATHER) { int _t = tid; asm volatile("" : "+v"(_t)); const int _nv = S.nvalid(u); _Pragma("unroll") for (int _i = 0; _i < 2; ++_i) { int _R, _C; stage_rc(_t * 16 + _i * 8192, _R, _C); \
        _Pragma("unroll") for (int _h = 0; _h < 2; ++_h) { const int _r = _R + _h * HALF; const unsigned _s = (unsigned)ibuf[(b) * 256 + (_r < _nv ? _r : 0)]; dst[_h][_i] = (_s >> Sched::ROW_SHIFT) * (unsigned)KB + (unsigned)_C * 2u; } } } } while (0)
    Unit cur, nxt; int ui = 0;
    if (!S.next(0, cur)) return;
    f32x4 acc[2][2][4][2];
#pragma unroll
    for (int a = 0; a < 2; ++a)
#pragma unroll
        for (int b = 0; b < 2; ++b)
#pragma unroll
            for (int m = 0; m < 4; ++m)
#pragma unroll
                for (int n = 0; n < 2; ++n) acc[a][b][m][n] = (f32x4){0.f, 0.f, 0.f, 0.f};
    bf16x8 At[4][2], B0[2][2], B1[2][2];
    v8i_t At8[4], B08[2], B18[2];
    unsigned gA[2][2] = {{0u, 0u}, {0u, 0u}}, gN[2][2] = {{0u, 0u}, {0u, 0u}};
    int bsel = 0;
    f32x4 bpre[4] = {(f32x4){0.f, 0.f, 0.f, 0.f}, (f32x4){0.f, 0.f, 0.f, 0.f}, (f32x4){0.f, 0.f, 0.f, 0.f}, (f32x4){0.f, 0.f, 0.f, 0.f}};
    Pend pend; int ppn = 0, pnv = 0, pq = 8, pbuf = 0;
    if constexpr (DEFER) {
#pragma unroll
        for (int q = 0; q < 8; ++q) pend.val[q] = (u32x2){0u, 0u}; }
#define PG8_PSTORE() do { if constexpr (DEFER) { const int _l3 = lane_id_volatile(); const int _nv = (pq < 8) ? pnv : 0; \
        E.store_one(pend.val[0], ibuf + pbuf * 256, ((pq >> 2) & 1) * HALF + (pq & 3) * 16 + wr * 64 + (_l3 & 15), _nv, ppn * HALF + wc * 32 + 8 * (_l3 >> 4)); \
        _Pragma("unroll") for (int _q = 0; _q < 7; ++_q) pend.val[_q] = pend.val[_q + 1]; ++pq; } } while (0)
    if constexpr (GATHER) { PG8_IDMA(cur, 0); PG8_WAIT_V(0); PG8_BAR; }
    PG8_GOFF(gA, cur, 0);
    const char* cA = S.a_base(cur); const char* cB = S.b_base(cur);
    PG8_STAGE(PG8_SB(0, 0), cB, voffB); PG8_STAGE(PG8_SB(0, 1), cB + hstep, voffB); PG8_STAGE_A(PG8_SA(0, 0), cA, 0, gA); PG8_STAGE_A(PG8_SA(0, 1), cA, 1, gA);
    if (wr == 1) PG8_BAR;
    PG8_WAIT_V(2); PG8_BAR;
    PG8_STAGE(PG8_SB(1, 0), cB + kstep, voffB); PG8_STAGE_A(PG8_SA(1, 0), cA + kstep, 0, gA); PG8_STAGE(PG8_SB(1, 1), cB + hstep + kstep, voffB);
    PG8_WAIT_V(6); PG8_BAR;
    for (;;) {
        const bool has_next = S.next(ui + 1, nxt);
        const char* nA = has_next ? S.a_base(nxt) : cA; const char* nB = has_next ? S.b_base(nxt) : cB;
        const int bnxt = (bsel == 2) ? 0 : bsel + 1;
        if constexpr (GATHER) { if (has_next) PG8_IDMA(nxt, bnxt); }
        for (int t = 0; t < nt; t += 2) {
            const bool last = (t == nt - 2);
            const char* a1 = cA + (size_t)(t + 1) * kstep;
            const char* a2 = last ? nA : cA + (size_t)(t + 2) * kstep; const char* b2 = last ? nB : cB + (size_t)(t + 2) * kstep;
            const char* a3 = a2 + kstep; const char* b3 = b2 + kstep;
            if constexpr (GATHER) { if (last && has_next) { PG8_GOFF(gN, nxt, bnxt); } }
            if constexpr (Epi::HAS_BIAS) { if (last) E.load_bias(cur, wc, lane_id_volatile() >> 4, bpre); }
            PG8_LDB(B0, 0, 0); PG8_LDB(B1, 0, 1); PG8_SCHED; PG8_LDA(At, 0, 0); PG8_STAGE_A(PG8_SA(1, 1), a1, 1, gA);
            if constexpr (GATHER) { if (last && has_next) { gA[0][0] = gN[0][0]; gA[0][1] = gN[0][1]; gA[1][0] = gN[1][0]; gA[1][1] = gN[1][1]; } }
            PG8_WAIT_V(8); PG8_WAIT_L(0); PG8_BAR; PG8_MMA(0, 0, At, B0); PG8_MMA(0, 1, At, B1); PG8_BAR; PG8_SCHED;
            PG8_LDA(At, 0, 1); PG8_STAGE(PG8_SB(0, 0), b2, voffB); PG8_STAGE(PG8_SB(0, 1), b2 + hstep, voffB); PG8_STAGE_A(PG8_SA(0, 0), a2, 0, gA);
            PG8_WAIT_V(8); PG8_WAIT_L(0); PG8_BAR; PG8_MMA(1, 0, At, B0); PG8_MMA(1, 1, At, B1); PG8_BAR; PG8_SCHED;
            PG8_PSTORE();
            PG8_LDB(B0, 1, 0); PG8_LDB(B1, 1, 1); PG8_SCHED; PG8_LDA(At, 1, 0); PG8_STAGE_A(PG8_SA(0, 1), a2, 1, gA);
            PG8_WAIT_V(8); PG8_WAIT_L(0); PG8_BAR; PG8_MMA(0, 0, At, B0); PG8_MMA(0, 1, At, B1); PG8_BAR; PG8_SCHED;
            PG8_LDA(At, 1, 1); PG8_STAGE(PG8_SB(1, 0), b3, voffB); PG8_STAGE(PG8_SB(1, 1), b3 + hstep, voffB); PG8_STAGE_A(PG8_SA(1, 0), a3, 0, gA);
            PG8_WAIT_V(8); PG8_WAIT_L(0); PG8_BAR; PG8_MMA(1, 0, At, B0); PG8_MMA(1, 1, At, B1); PG8_BAR; PG8_SCHED;
            PG8_PSTORE();
        }
        if (ALIGN_EPI) { if (wr == 0) PG8_BAR; }
        { const int l2 = lane_id_volatile(), fr2 = l2 & 15, fq2 = l2 >> 4;
          if constexpr (DEFER) { _Pragma("unroll") for (int _f = 0; _f < 8; ++_f) PG8_PSTORE();
              E.prepare(acc, cur, wr, wc, fr2, fq2, pend); ppn = cur.pn; pnv = S.nvalid(cur); pq = 0; pbuf = bsel; }
          else if constexpr (GATHER) E(acc, cur, wr, wc, fr2, fq2, ibuf + bsel * 256, S.nvalid(cur), bpre); else E(acc, cur, wr, wc, fr2, fq2); }
        if (!has_next) break;
#pragma unroll
        for (int a = 0; a < 2; ++a)
#pragma unroll
            for (int b = 0; b < 2; ++b)
#pragma unroll
                for (int m = 0; m < 4; ++m)
#pragma unroll
                    for (int n = 0; n < 2; ++n) acc[a][b][m][n] = (f32x4){0.f, 0.f, 0.f, 0.f};
        cur = nxt; cA = nA; cB = nB; ++ui; bsel = bnxt;
        if (ALIGN_EPI) { if (wr == 1) PG8_BAR; }
    }
    if constexpr (DEFER) { _Pragma("unroll") for (int _f = 0; _f < 8; ++_f) PG8_PSTORE(); }
    PG8_WAIT_V(0);
    if (!ALIGN_EPI) { if (wr == 0) PG8_BAR; }
    PG8_BAR;
#undef PG8_PSTORE
#undef PG8_SA
#undef PG8_SB
#undef PG8_STAGE
#undef PG8_STAGE_A
#undef PG8_LDA
#undef PG8_LDB
#undef PG8_MMA
#undef PG8_WAIT_V
#undef PG8_WAIT_L
#undef PG8_BAR
#undef PG8_SCHED
#undef PG8_GOFF
#undef PG8_IDMA
}
}

namespace attn_body {
using bf16=__hip_bfloat16;
using bf16x8=__attribute__((ext_vector_type(8)))short;
using s16x4=__attribute__((ext_vector_type(4)))short;
using f32x16=__attribute__((ext_vector_type(16)))float;
using u32x4=__attribute__((ext_vector_type(4)))unsigned;
constexpr int D=64;
constexpr int NW=8,QBLK=32,QB=QBLK*NW,KVBLK=64;
constexpr int ATTN_UNIT_ROWS=QB;
__device__ __forceinline__ int crow(int r,int hi){return (r&3)+8*(r>>2)+4*hi;}
#define SBAR() __builtin_amdgcn_sched_barrier(0)
__device__ __forceinline__ void cmask(f32x16&p0,f32x16&p1,int jb,int qrel,int hi){
  const float NEG=-INFINITY; int kb=64*jb+4*hi;
  #pragma unroll
  for(int r=0;r<16;++r){int kv=kb+(r&3)+8*(r>>2); if(kv>qrel)p0[r]=NEG; if(kv+32>qrel)p1[r]=NEG;}
}

constexpr int NSLOT=3, SLOTB=8192;
constexpr int LDS_K=0, LDS_V=NSLOT*SLOTB, LDS_WS=2*NSLOT*SLOTB, LDS_OST=LDS_WS+NW*64*4, LDS_BYTES=LDS_OST+NW*4096;
constexpr float C2=0.125f*1.4426950408889634f;
__device__ __forceinline__ void glds16(const void*gsrc,unsigned lds_dst){unsigned keep;
  asm volatile("s_mov_b32 %0, m0\n\ts_mov_b32 m0, %2\n\ts_nop 0\n\tglobal_load_lds_dwordx4 %1, off\n\ts_mov_b32 m0, %0":"=&s"(keep):"v"(gsrc),"s"(lds_dst):"memory");}
__device__ __forceinline__ float max3f(float a,float b,float c){float r;asm("v_max3_f32 %0, %1, %2, %3":"=v"(r):"v"(a),"v"(b),"v"(c));return r;}
__device__ __forceinline__ float max2f(float a,float b){float r;asm("v_max_f32_e32 %0, %1, %2":"=v"(r):"v"(a),"v"(b));return r;}
__device__ __forceinline__ float fadd_s(float a,float b){float r;asm("v_add_f32_e32 %0, %1, %2":"=v"(r):"v"(a),"v"(b));return r;}
__device__ __forceinline__ float fsub_s(float a,float b){float r;asm("v_sub_f32_e32 %0, %1, %2":"=v"(r):"v"(a),"v"(b));return r;}
typedef float f32x2_t __attribute__((ext_vector_type(2))); typedef __bf16 bf16x2_t __attribute__((ext_vector_type(2)));
__device__ __forceinline__ unsigned cvtpk_s(float lo,float hi){f32x2_t v={lo,hi};bf16x2_t b=__builtin_convertvector(v,bf16x2_t);return __builtin_bit_cast(unsigned,b);}
#define WAIT_BAR(N) asm volatile("s_waitcnt vmcnt(" #N ") lgkmcnt(0)\n\ts_barrier":::"memory")

__device__ __forceinline__ void qkt(f32x16&p0,f32x16&p1,const char*Kslot,const bf16x8*qr,const f32x16&negm,int r32,int hi){
  const char*kb=Kslot+hi*1024+r32*16;
  #pragma unroll
  for(int d0=0;d0<4;++d0){
    const bf16x8 b0=*reinterpret_cast<const bf16x8*>(kb+d0*2048);
    const bf16x8 b1=*reinterpret_cast<const bf16x8*>(kb+d0*2048+512);
    if(d0==0){p0=__builtin_amdgcn_mfma_f32_32x32x16_bf16(b0,qr[0],negm,0,0,0);p1=__builtin_amdgcn_mfma_f32_32x32x16_bf16(b1,qr[0],negm,0,0,0);}
    else{p0=__builtin_amdgcn_mfma_f32_32x32x16_bf16(b0,qr[d0],p0,0,0,0);p1=__builtin_amdgcn_mfma_f32_32x32x16_bf16(b1,qr[d0],p1,0,0,0);}}
}
typedef __attribute__((address_space(3))) const char* lds_cptr;
typedef short v4i16_t __attribute__((ext_vector_type(4)));
__device__ __forceinline__ void kload8(bf16x8*kf,lds_cptr kp){
  kf[0]=*(const __attribute__((address_space(3))) bf16x8*)(kp);      kf[1]=*(const __attribute__((address_space(3))) bf16x8*)(kp+512);
  kf[2]=*(const __attribute__((address_space(3))) bf16x8*)(kp+2048); kf[3]=*(const __attribute__((address_space(3))) bf16x8*)(kp+2560);
  kf[4]=*(const __attribute__((address_space(3))) bf16x8*)(kp+4096); kf[5]=*(const __attribute__((address_space(3))) bf16x8*)(kp+4608);
  kf[6]=*(const __attribute__((address_space(3))) bf16x8*)(kp+6144); kf[7]=*(const __attribute__((address_space(3))) bf16x8*)(kp+6656);
}
__device__ __forceinline__ void kload2(bf16x8*kf,lds_cptr kp,int j){ kf[2*j]=*(const __attribute__((address_space(3))) bf16x8*)(kp+j*2048); kf[2*j+1]=*(const __attribute__((address_space(3))) bf16x8*)(kp+j*2048+512); }
__device__ __forceinline__ s16x4 vtr(lds_cptr p){ return __builtin_bit_cast(s16x4,__builtin_amdgcn_ds_read_tr16_b64_v4i16((__attribute__((address_space(3))) v4i16_t*)p)); }
__device__ __forceinline__ float rowmax(const f32x16&p0,const f32x16&p1){
  float a=max3f(p0[0],p0[1],p1[0]),b=max3f(p0[2],p0[3],p1[1]);a=max3f(a,p1[2],p1[3]);
  #pragma unroll
  for(int r=4;r<16;r+=4){a=max3f(a,p0[r],p0[r+1]);b=max3f(b,p0[r+2],p0[r+3]);a=max3f(a,p1[r],p1[r+1]);b=max3f(b,p1[r+2],p1[r+3]);}
  const float m=max2f(a,b);
  auto rr=__builtin_amdgcn_permlane32_swap(__float_as_uint(m),__float_as_uint(m),false,false);
  return max2f(__uint_as_float(rr[0]),__uint_as_float(rr[1]));
}
__device__ __forceinline__ void pv(f32x16*o,int vb,bf16x8 pa0,bf16x8 pa1,bf16x8 pa2,bf16x8 pa3){
  #pragma unroll
  for(int d0=0;d0<2;++d0){s16x4 lo[4],hi[4];
    #pragma unroll
    for(int ks=0;ks<4;++ks){
      asm volatile("ds_read_b64_tr_b16 %0,%1 offset:%c2":"=&v"(lo[ks]):"v"(vb),"i"(d0*4096+ks*1024):"memory");
      asm volatile("ds_read_b64_tr_b16 %0,%1 offset:%c2":"=&v"(hi[ks]):"v"(vb),"i"(d0*4096+ks*1024+512):"memory");}
    asm volatile("s_waitcnt lgkmcnt(0)":::"memory");SBAR();
    #define PK(k) (bf16x8){lo[k][0],lo[k][1],lo[k][2],lo[k][3],hi[k][0],hi[k][1],hi[k][2],hi[k][3]}
    o[d0]=__builtin_amdgcn_mfma_f32_32x32x16_bf16(pa0,PK(0),o[d0],0,0,0);
    o[d0]=__builtin_amdgcn_mfma_f32_32x32x16_bf16(pa1,PK(1),o[d0],0,0,0);
    o[d0]=__builtin_amdgcn_mfma_f32_32x32x16_bf16(pa2,PK(2),o[d0],0,0,0);
    o[d0]=__builtin_amdgcn_mfma_f32_32x32x16_bf16(pa3,PK(3),o[d0],0,0,0);
    #undef PK
  }
}

#ifndef ATTN_STORE16
#define ATTN_STORE16(p,v) (*(u32x4*)(p)=(v))
#endif
template<int THRL, bool O8 = false> __device__ __forceinline__ void attn_unit(const bf16*Qu,const bf16*__restrict__ Kh,const bf16*__restrict__ Vh,bf16*Ou,const int QP,const int KP,const int VP,const int OP,const int NT,char*shm,const int tid){
  const int lane=tid&63,r32=lane&31,hi=lane>>5; const int wid=__builtin_amdgcn_readfirstlane(tid>>6);
  const bf16*Qw=Qu+(long)(wid*QBLK)*QP;
  const unsigned lds0=(unsigned)(uintptr_t)shm;
  float*wsf=(float*)(shm+LDS_WS)+wid*64;
  const bf16*ksrc=Kh+(long)lane*KP+wid*8;
  const bf16*vsrc=Vh+(long)(16*(wid&3)+(lane>>2))*VP+(wid>>2)*32+(lane&3)*8;
  const unsigned kdst=lds0+LDS_K+wid*1024, vdst=lds0+LDS_V+wid*1024;
  #define DMA_K(t,slot) glds16(ksrc+(long)(t)*KVBLK*KP,(unsigned)__builtin_amdgcn_readfirstlane(kdst+(slot)))
  #define DMA_V(t,slot) glds16(vsrc+(long)(t)*KVBLK*VP,(unsigned)__builtin_amdgcn_readfirstlane(vdst+(slot)))
  const int vb0=(int)(lds0+LDS_V)+((lane>>4)&1)*32+(lane&3)*8+(4*hi+((lane&15)>>2))*64;
  const char*Kbase=shm+LDS_K; bf16x8 kf[8];
  const lds_cptr shm3=(lds_cptr)shm; const lds_cptr kp0=shm3+LDS_K+hi*1024+r32*16; const lds_cptr vp0=shm3+LDS_V+((lane>>4)&1)*32+(lane&3)*8+(4*hi+((lane&15)>>2))*64;
  DMA_K(0,0);DMA_V(0,0);DMA_K(1,SLOTB);
  bf16x8 qr[4];
  #pragma unroll
  for(int d0=0;d0<4;++d0)qr[d0]=*reinterpret_cast<const bf16x8*>(&Qw[(long)r32*QP+d0*16+hi*8]);
  float mhat=0.f,l_reg=0.f;f32x16 o[2];f32x16 negm; { float z_=0.f; asm volatile("":"+v"(z_)); _Pragma("unroll") for(int r=0;r<16;++r){o[0][r]=z_;o[1][r]=z_;negm[r]=z_;} } asm volatile("":"+v"(negm));
  #define CMASK(P0,P1,t) do{}while(0)
  bool resc=false;
  #define START(P0,P1) do{ const float rm=rowmax(P0,P1); resc=false; \
    { const float dl=rm; mhat=fadd_s(mhat,dl); \
      _Pragma("unroll") for(int r=0;r<16;++r){P0[r]=fsub_s(P0[r],dl);P1[r]=fsub_s(P1[r],dl);} \
      _Pragma("unroll") for(int r=0;r<16;++r)negm[r]=-mhat; asm volatile("":"+v"(negm)); } \
    _Pragma("unroll") for(int r=0;r<16;++r)P0[r]=__builtin_amdgcn_exp2f(P0[r]); }while(0)
  #define RESC() do{ if(resc){ asm volatile("s_waitcnt lgkmcnt(0)":::"memory"); \
      _Pragma("unroll") for(int d_=0;d_<2;++d_) _Pragma("unroll") for(int r=0;r<16;++r)o[d_][r]*=wsf[crow(r,hi)]; } }while(0)
  f32x16 pA0,pA1,pB0,pB1;
  int sl_prev=0,sl_cur=0,sl_next=SLOTB;
  #define ROT() do{sl_prev=sl_cur;sl_cur=sl_next;sl_next=(sl_next==(NSLOT-1)*SLOTB)?0:sl_next+SLOTB;}while(0)
  DMA_K(2,2*SLOTB);
  WAIT_BAR(3);
  qkt(pA0,pA1,Kbase,qr,negm,r32,hi);asm volatile("s_nop 15\n\ts_nop 7":"+v"(pA0),"+v"(pA1));CMASK(pA0,pA1,0);
  START(pA0,pA1);
  _Pragma("unroll") for(int r=0;r<16;++r)pA1[r]=__builtin_amdgcn_exp2f(pA1[r]);
  WAIT_BAR(0);
  DMA_K(3,0);DMA_V(1,SLOTB);
  ROT();
  kload8(kf,kp0+sl_cur);
  WAIT_BAR(2);
  s16x4 vlo[8],vhi[8]; u32x4 pw0,pw1,pw2,pw3;
  #define PKW(P,B) cvtpk_s(P[B],P[B+1])
  #define PAF(k) __builtin_bit_cast(bf16x8,pw##k)
  #define VFR(i) (bf16x8){vlo[i][0],vlo[i][1],vlo[i][2],vlo[i][3],vhi[i][0],vhi[i][1],vhi[i][2],vhi[i][3]}
  #define PIN(x) asm volatile("":"+v"(x))
  #define MX3(a,b,c) __builtin_fmaxf(__builtin_fmaxf((a),(b)),(c))
  #define GAPA(MF,A0,A1,A2,A3,W0,W1,PW) do{ MF; sacc+=A0; sacc+=A1; sacc+=A2; sacc+=A3; PIN(sacc); W0; W1; PIN(PW); SBAR(); }while(0)
  #define EX(v) __builtin_amdgcn_exp2f(v)
  #define GAPB(MF,X,B) do{ MF; X[B]=EX(X[B]); X[B+1]=EX(X[B+1]); X[B+2]=EX(X[B+2]); X[B+3]=EX(X[B+3]); PIN(X); SBAR(); }while(0)
  #define VRD(i) do{ vlo[i]=vtr(vp_+(((i)>>2)*4096+((i)&3)*1024)); vhi[i]=vtr(vp_+(((i)>>2)*4096+((i)&3)*1024+512)); }while(0)
  #define KRD(G,j) do{ if(G){ kload2(kf,kp0+sl_next,j); SBAR(); } }while(0)
  #define STEP(C0,C1,P0,P1,t,GK,GV,GL) do{ SBAR(); \
    const lds_cptr vp_=vp0+sl_prev; \
    VRD(0); SBAR(); float sacc=(P0[0]+P0[1]); \
    GAPA(C0=__builtin_amdgcn_mfma_f32_32x32x16_bf16(kf[0],qr[0],negm,0,0,0), P0[2],P0[3],P0[4],P0[5],     pw0[0]=PKW(P0,0), pw0[1]=PKW(P0,2), pw0); \
    VRD(4); SBAR(); GAPA(C1=__builtin_amdgcn_mfma_f32_32x32x16_bf16(kf[1],qr[0],negm,0,0,0), P0[6],P0[7],P0[8],P0[9],     pw0[2]=PKW(P0,4), pw0[3]=PKW(P0,6), pw0); \
    VRD(1); SBAR(); GAPA(C0=__builtin_amdgcn_mfma_f32_32x32x16_bf16(kf[2],qr[1],C0,0,0,0),   P0[10],P0[11],P0[12],P0[13], pw1[0]=PKW(P0,8), pw1[1]=PKW(P0,10), pw1); \
    VRD(5); SBAR(); GAPA(C1=__builtin_amdgcn_mfma_f32_32x32x16_bf16(kf[3],qr[1],C1,0,0,0),   P0[14],P0[15],P1[0],P1[1],   pw1[2]=PKW(P0,12),pw1[3]=PKW(P0,14), pw1); \
    VRD(2); SBAR(); GAPA(C0=__builtin_amdgcn_mfma_f32_32x32x16_bf16(kf[4],qr[2],C0,0,0,0),   P1[2],P1[3],P1[4],P1[5],     pw2[0]=PKW(P1,0), pw2[1]=PKW(P1,2), pw2); \
    VRD(6); SBAR(); GAPA(C1=__builtin_amdgcn_mfma_f32_32x32x16_bf16(kf[5],qr[2],C1,0,0,0),   P1[6],P1[7],P1[8],P1[9],     pw2[2]=PKW(P1,4), pw2[3]=PKW(P1,6), pw2); \
    VRD(3); SBAR(); GAPA(C0=__builtin_amdgcn_mfma_f32_32x32x16_bf16(kf[6],qr[3],C0,0,0,0),   P1[10],P1[11],P1[12],P1[13], pw3[0]=PKW(P1,8), pw3[1]=PKW(P1,10), pw3); \
    VRD(7); SBAR(); GAPA(C1=__builtin_amdgcn_mfma_f32_32x32x16_bf16(kf[7],qr[3],C1,0,0,0),   P1[14],P1[15],0.f,0.f,       pw3[2]=PKW(P1,12),pw3[3]=PKW(P1,14), pw3); \
    l_reg+=sacc; \
    if(GK){DMA_K((t)+3,sl_cur);} if(GV){DMA_V((t)+1,sl_next);} \
    CMASK(C0,C1,t); \
    { float a=MX3(C0[0],C0[1],C1[0]),b=MX3(C0[2],C0[3],C1[1]); a=MX3(a,C1[2],C1[3]); \
      _Pragma("unroll") for(int r=4;r<16;r+=4){a=MX3(a,C0[r],C0[r+1]);b=MX3(b,C0[r+2],C0[r+3]);a=MX3(a,C1[r],C1[r+1]);b=MX3(b,C1[r+2],C1[r+3]);} \
      float rm=__builtin_fmaxf(a,b); { auto rr=__builtin_amdgcn_permlane32_swap(__float_as_uint(rm),__float_as_uint(rm),false,false); rm=__builtin_fmaxf(__uint_as_float(rr[0]),__uint_as_float(rr[1])); } \
      resc=false; \
      if(__builtin_expect(__any(rm>(float)THRL),0)){ const float dl=__builtin_fmaxf(rm,0.f); mhat+=dl; \
        _Pragma("unroll") for(int r=0;r<16;++r){C0[r]-=dl;C1[r]-=dl;} \
        _Pragma("unroll") for(int r=0;r<16;++r)negm[r]=-mhat; asm volatile("":"+v"(negm)); \
        const float f=__builtin_amdgcn_exp2f(-dl); l_reg*=f; if(hi==0)wsf[r32]=f; resc=true; } } \
    SBAR(); \
    GAPB(o[0]=__builtin_amdgcn_mfma_f32_32x32x16_bf16(PAF(0),VFR(0),o[0],0,0,0), C0,0); \
    GAPB(o[1]=__builtin_amdgcn_mfma_f32_32x32x16_bf16(PAF(0),VFR(4),o[1],0,0,0), C0,4); \
    KRD(GL,0); GAPB(o[0]=__builtin_amdgcn_mfma_f32_32x32x16_bf16(PAF(1),VFR(1),o[0],0,0,0), C0,8); \
    KRD(GL,1); GAPB(o[1]=__builtin_amdgcn_mfma_f32_32x32x16_bf16(PAF(1),VFR(5),o[1],0,0,0), C0,12); \
    KRD(GL,2); GAPB(o[0]=__builtin_amdgcn_mfma_f32_32x32x16_bf16(PAF(2),VFR(2),o[0],0,0,0), C1,0); \
    KRD(GL,3); GAPB(o[1]=__builtin_amdgcn_mfma_f32_32x32x16_bf16(PAF(2),VFR(6),o[1],0,0,0), C1,4); \
    GAPB(o[0]=__builtin_amdgcn_mfma_f32_32x32x16_bf16(PAF(3),VFR(3),o[0],0,0,0), C1,8); \
    GAPB(o[1]=__builtin_amdgcn_mfma_f32_32x32x16_bf16(PAF(3),VFR(7),o[1],0,0,0), C1,12); \
    }while(0)
  int t=1;
  #undef CMASK
  #define CMASK(P0,P1,t) do{}while(0)
  for(;t+5<NT;t+=2){
    STEP(pB0,pB1,pA0,pA1,t,true,true,true);     WAIT_BAR(2); RESC(); ROT();
    STEP(pA0,pA1,pB0,pB1,t+1,true,true,true);   WAIT_BAR(2); RESC(); ROT();
  }
  #undef CMASK
  #define CMASK(P0,P1,t) do{}while(0)
  #define ENDW(tt) do{ if((tt)+3<NT){WAIT_BAR(2);} else if((tt)+2<NT){WAIT_BAR(1);} else {WAIT_BAR(0);} }while(0)
  for(;t+1<NT;t+=2){
    STEP(pB0,pB1,pA0,pA1,t,(t+3<NT),(t+1<NT),(t+1<NT));       ENDW(t);   RESC(); ROT();
    STEP(pA0,pA1,pB0,pB1,t+1,(t+4<NT),(t+2<NT),(t+2<NT));     ENDW(t+1); RESC(); ROT();
  }
  STEP(pB0,pB1,pA0,pA1,NT-1,false,false,false); RESC();
  { float sacc=pB0[0]+pB0[1]; _Pragma("unroll") for(int r=2;r<16;++r)sacc+=pB0[r]; _Pragma("unroll") for(int r=0;r<16;++r)sacc+=pB1[r]; l_reg+=sacc;
    pw0=(u32x4){PKW(pB0,0),PKW(pB0,2),PKW(pB0,4),PKW(pB0,6)};pw1=(u32x4){PKW(pB0,8),PKW(pB0,10),PKW(pB0,12),PKW(pB0,14)};pw2=(u32x4){PKW(pB1,0),PKW(pB1,2),PKW(pB1,4),PKW(pB1,6)};pw3=(u32x4){PKW(pB1,8),PKW(pB1,10),PKW(pB1,12),PKW(pB1,14)};
    SBAR(); pv(o,vb0+sl_cur,PAF(0),PAF(1),PAF(2),PAF(3)); }
  #undef PKW
  #undef PAF
  #undef VFR
  #undef PIN
  #undef MX3
  #undef GAPA
  #undef GAPB
  #undef EX
  #undef VRD
  #undef KRD
  #undef STEP
  #undef ENDW
  {auto rr=__builtin_amdgcn_permlane32_swap(__float_as_uint(l_reg),__float_as_uint(l_reg),false,false);l_reg=__uint_as_float(rr[0])+__uint_as_float(rr[1]);}
  if(hi==0)wsf[32+r32]=l_reg;asm volatile("s_waitcnt lgkmcnt(0)":::"memory");
  float rli[16];
  #pragma unroll
  for(int r=0;r<16;++r)rli[r]=__builtin_amdgcn_rcpf(wsf[32+crow(r,hi)]);
  if constexpr (O8) {
    unsigned char*Ow8=(unsigned char*)Ou+(long)(wid*QBLK)*OP; unsigned char*stg8=(unsigned char*)(shm+LDS_OST)+wid*2048;
    #pragma unroll
    for(int r=0;r<16;++r){const int orow=crow(r,hi);
      #pragma unroll
      for(int d0=0;d0<2;++d0)stg8[orow*64+d0*32+r32]=f2fp8(o[d0][r]*rli[r]);}
    asm volatile("s_waitcnt lgkmcnt(0)":::"memory");
    #pragma unroll
    for(int i=0;i<2;++i){const int row=i*16+(lane>>2),ch=lane&3; const u32x4 v=*(const u32x4*)(stg8+row*64+ch*16); ATTN_STORE16(Ow8+(long)row*OP+ch*16,v);}
  } else {
  bf16*Ow=Ou+(long)(wid*QBLK)*OP;
  { bf16*stg=(bf16*)(shm+LDS_OST)+wid*2048;
    #pragma unroll
    for(int r=0;r<16;++r){const int orow=crow(r,hi);
      #pragma unroll
      for(int d0=0;d0<2;++d0)stg[orow*64+d0*32+r32]=__float2bfloat16(o[d0][r]*rli[r]);}
    asm volatile("s_waitcnt lgkmcnt(0)":::"memory");
    #pragma unroll
    for(int i=0;i<4;++i){const int row=i*8+(lane>>3),ch=lane&7; const u32x4 v=*(const u32x4*)(stg+row*64+ch*8); ATTN_STORE16(Ow+(long)row*OP+ch*8,v);} }
  }
  asm volatile("s_waitcnt lgkmcnt(0)\n\ts_barrier":::"memory");
  #undef DMA_K
  #undef DMA_V
  #undef CMASK
  #undef START
  #undef RESC
  #undef ROT
}
constexpr int ATTN_LDS_BYTES=LDS_BYTES;
#undef SBAR
#undef WAIT_BAR
}

struct Args { const float* in[32]; float* out; unsigned char* ws; int ph_lo, ph_hi; };
struct Ctx {
    LAS unsigned char* lds;
    int vcu, G;
    unsigned char* ws;
};
constexpr int PTAB_OFF = MISC_OFF + 256;
__device__ __forceinline__ unsigned long long ptab_get(const Ctx& cx, int k) {
    const LAS unsigned* t = (const LAS unsigned*)(cx.lds + PTAB_OFF) + 2 * k; const unsigned lo = __builtin_amdgcn_readfirstlane(t[0]), hi = __builtin_amdgcn_readfirstlane(t[1]);
    return ((unsigned long long)hi << 32) | lo;
}
#define INP(k) ((const float*)(GAS const float*)ptab_get(cx, (k)))

template <bool F8> __device__ __forceinline__ void p0_transpose64(const float* W, int N, int KB, unsigned char* WT, int k0, int n0, int dst_row0, float scale, LAS float* scr, int lane) {
    f32x4 v[16];
    const float* src = W + (size_t)(k0 + (lane >> 4)) * N + n0 + (lane & 15) * 4;
#pragma unroll
    for (int i = 0; i < 16; ++i) v[i] = __builtin_nontemporal_load((const f32x4*)(src + (size_t)(4 * i) * N));
#pragma unroll
    for (int i = 0; i < 16; ++i) { LAS float* p = scr + (4 * i + (lane >> 4)) * 65 + (lane & 15) * 4; p[0] = v[i][0]; p[1] = v[i][1]; p[2] = v[i][2]; p[3] = v[i][3]; }
    LDS_WAIT(); asm volatile("" ::: "memory");
    if constexpr (!F8) {
        const int ns = lane >> 3, ch = lane & 7;
#pragma unroll
        for (int r8 = 0; r8 < 8; ++r8) { const int n = r8 * 8 + ns; const LAS float* s = scr + (8 * ch) * 65 + n;
            u32x4 o; o.x = pk2(s[0 * 65], s[1 * 65]); o.y = pk2(s[2 * 65], s[3 * 65]); o.z = pk2(s[4 * 65], s[5 * 65]); o.w = pk2(s[6 * 65], s[7 * 65]);
            *(GAS u32x4*)(WT + (size_t)(dst_row0 + n) * KB + (k0 + 8 * ch) * 2) = o; }
    } else {
        const int ns = lane >> 2, ch = lane & 3;
#pragma unroll
        for (int r4 = 0; r4 < 4; ++r4) { const int n = r4 * 16 + ns; const LAS float* s = scr + (16 * ch) * 65 + n; unsigned w[4];
#pragma unroll
            for (int q = 0; q < 4; ++q) { int r = 0; r = __builtin_amdgcn_cvt_pk_fp8_f32(s[(4 * q) * 65] * scale, s[(4 * q + 1) * 65] * scale, r, false); r = __builtin_amdgcn_cvt_pk_fp8_f32(s[(4 * q + 2) * 65] * scale, s[(4 * q + 3) * 65] * scale, r, true); w[q] = (unsigned)r; }
            *(GAS u32x4*)(WT + (size_t)(dst_row0 + n) * KB + k0 + 16 * ch) = (u32x4){w[0], w[1], w[2], w[3]}; }
    }
    LDS_WAIT(); asm volatile("" ::: "memory");
}
__device__ __forceinline__ void p0_prologue(const Ctx& cx, const int tid) {
    const int lane = tid & 63, wave = __builtin_amdgcn_readfirstlane(tid >> 6);
    LAS float* scr = (LAS float*)(cx.lds + wave * 16896);
    const int gw = cx.vcu * 8 + wave, NGW = cx.G * 8;
    constexpr int I_WIN0 = 16 * 40, I_WIN1 = 16 * 24, I_WKV = 16 * 8, I_WOUT = 16 * 16, I_W1 = 16 * 32, I_W2 = 16 * 16;
    constexpr int T_WIN = 3 * I_WIN0 + I_WIN1, T_WKV = 4 * I_WKV, T_WOUT = 4 * I_WOUT, T_W1 = 128 * I_W1, T_W2 = 128 * I_W2;
    constexpr int NITEMS = T_WIN + T_WKV + T_WOUT + T_W1 + T_W2;
    for (int it = gw; it < NITEMS; it += NGW) {
        int r = it;
        const float* W; unsigned char* WT; int N, nb, kb, dst_row0; bool isout = false;
        if (r < T_W1) {
            const int mi = r / I_W1, q = r % I_W1; N = 2048; kb = q / 32; nb = q % 32;
            W = INP(28) + (size_t)mi * 1024 * 2048; WT = cx.ws + WS_W1 + (size_t)mi * 2048 * 1024 * MOE_EB;
            const int n0 = nb * 64, isu = n0 >= 1024, j = n0 - isu * 1024;
            dst_row0 = (j >> 7) * 256 + isu * 128 + (j & 127);
            p0_transpose64<MOE_F8>(W, N, 1024 * MOE_EB, WT, kb * 64, nb * 64, dst_row0, W1_SCALE, scr, lane); continue;
        } else if ((r -= T_W1) < T_W2) {
            const int mi = r / I_W2, q = r % I_W2; N = 1024; kb = q / 16; nb = q % 16;
            W = INP(30) + (size_t)mi * 1024 * 1024; WT = cx.ws + WS_W2 + (size_t)mi * 1024 * 1024 * MOE_EB; dst_row0 = nb * 64;
            p0_transpose64<MOE_F8>(W, N, 1024 * MOE_EB, WT, kb * 64, nb * 64, dst_row0, W2_SCALE, scr, lane); continue;
        } else if ((r -= T_W2) < T_WIN) {
            int l, q;
            if (r < I_WIN0) { l = 0; q = r; } else if (r < I_WIN0 + I_WIN1) { l = 1; q = r - I_WIN0; } else if (r < 2 * I_WIN0 + I_WIN1) { l = 2; q = r - I_WIN0 - I_WIN1; } else { l = 3; q = r - 2 * I_WIN0 - I_WIN1; }
            N = in_width(l); const int nbn = N / 64; kb = q / nbn; nb = q % nbn;
            const int kind = layer_kind(l), j = layer_j(l);
            W = (kind == 0 ? INP(2) : kind == 1 ? INP(4) : INP(7)) + (size_t)j * 1024 * N;
            WT = cx.ws + WS_WIN + (size_t)l * 5 * MiB; dst_row0 = nb * 64;
        } else if ((r -= T_WIN) < T_WKV) {
            const int l = r / I_WKV, q = r % I_WKV; N = 512; kb = q / 8; nb = q % 8;
            W = INP(20) + (size_t)l * 1024 * 512; WT = cx.ws + WS_WKV; dst_row0 = l * 512 + nb * 64;
        } else {
            r -= T_WKV; const int l = r / I_WOUT, q = r % I_WOUT; N = 1024; kb = q / 16; nb = q % 16;
            W = INP(21) + (size_t)l * 1024 * 1024; WT = cx.ws + WS_WOUT + (size_t)l * 2 * MiB; dst_row0 = nb * 64; isout = true;
        }
        if (isout) p0_transpose64<OUTP_F8 != 0>(W, N, 1024 * OUT_EB, WT, kb * 64, nb * 64, dst_row0, OUTP_F8 ? WOUT_SCALE : 1.0f, scr, lane);
        else p0_transpose64<INP_F8 != 0>(W, N, 1024 * INP_EB, WT, kb * 64, nb * 64, dst_row0, INP_F8 ? WIN_SCALE : 1.0f, scr, lane);
    }
    {
        const size_t gt = (size_t)cx.vcu * 512 + tid, NT_ = (size_t)cx.G * 512;
        for (int which = 0; which < 2; ++which) {
            const f32x4* xs = (const f32x4*)(which == 0 ? INP(0) : INP(1)); unsigned char* xd = cx.ws + (which == 0 ? WS_XB : WS_MEMB); const size_t n8 = (size_t)(which == 0 ? NTOK : NMEM) * DM / 8;
#pragma unroll 4
            for (size_t i = gt; i < n8; i += NT_) { const f32x4 a = __builtin_nontemporal_load(xs + 2 * i), b = __builtin_nontemporal_load(xs + 2 * i + 1);
                if constexpr (INP_F8) { int w0 = 0, w1 = 0; w0 = __builtin_amdgcn_cvt_pk_fp8_f32(a[0], a[1], w0, false); w0 = __builtin_amdgcn_cvt_pk_fp8_f32(a[2], a[3], w0, true); w1 = __builtin_amdgcn_cvt_pk_fp8_f32(b[0], b[1], w1, false); w1 = __builtin_amdgcn_cvt_pk_fp8_f32(b[2], b[3], w1, true);
                    *(u32x2*)(xd + i * 8) = (u32x2){(unsigned)w0, (unsigned)w1}; }
                else { u32x4 o; o.x = pk2(a[0], a[1]); o.y = pk2(a[2], a[3]); o.z = pk2(b[0], b[1]); o.w = pk2(b[2], b[3]); *(u32x4*)(xd + i * 16) = o; } }
        }
    }
    { const float* rwp = INP(26); unsigned short* RW = (unsigned short*)(cx.ws + WS_RW);
      for (int i = cx.vcu * 512 + tid; i < 4 * 32768; i += cx.G * 512) { const int l = i >> 15, r = i & 32767, k = r >> 5, e = r & 31; const float w = rwp[i]; const unsigned hi = f2bf(w); const float wl = w - bf2f((unsigned short)hi);
          RW[((size_t)(l * 2 + 0) * 32 + e) * 1024 + k] = (unsigned short)hi; RW[((size_t)(l * 2 + 1) * 32 + e) * 1024 + k] = (unsigned short)f2bf(wl); } }
    {
        const float *fw1 = INP(10), *fb1 = INP(11), *fw2 = INP(12), *fb2 = INP(13), *fw3 = INP(14), *fb3 = INP(15), *fw4 = INP(16), *fb4 = INP(17), *ffr = INP(18);
        LAS float* z = (LAS float*)cx.lds; LAS float* h1 = z + 16 * 33; LAS float* h2 = h1 + 1024; LAS float* h3 = h2 + 1024;
        float* HRAWT = (float*)(cx.ws + WS_HRAWT); float* HPART = (float*)(cx.ws + WS_HPART);
        for (int it = cx.vcu; it < 256; it += cx.G) {
            __syncthreads();
            const int pos0 = it * 16;
            for (int i = tid; i < 16 * 33; i += 512) { const int p = i / 33, f = i % 33; const float pos = (float)(pos0 + p); float v;
                if (f == 0) v = pos / 4095.0f;
                else { const int k = (f - 1) & 15; const float fb = 1e-4f + (float)k * ((15.0f - 1e-4f) / 15.0f); const float ang = (6.283185307179586f * pos / 4096.0f) * fb; v = (f <= 16) ? cosf(ang) : -sinf(ang); }
                z[i] = v; }
            __syncthreads();
            for (int i = tid; i < 1024; i += 512) { const int p = i >> 6, o = i & 63; float a = fb1[o]; for (int f = 0; f < 33; ++f) a += z[p * 33 + f] * fw1[f * 64 + o]; h1[i] = sinf(ffr[o] * a); }
            __syncthreads();
            for (int i = tid; i < 1024; i += 512) { const int p = i >> 6, o = i & 63; float a = fb2[o]; for (int k = 0; k < 64; ++k) a += h1[p * 64 + k] * fw2[k * 64 + o]; h2[i] = sinf(ffr[o] * a); }
            __syncthreads();
            for (int i = tid; i < 1024; i += 512) { const int p = i >> 6, o = i & 63; float a = fb3[o]; for (int k = 0; k < 64; ++k) a += h2[p * 64 + k] * fw3[k * 64 + o]; h3[i] = sinf(ffr[o] * a); }
            __syncthreads();
            for (int col = tid; col < 3072; col += 512) {
                float a[16]; const float bb = fb4[col];
#pragma unroll
                for (int p = 0; p < 16; ++p) a[p] = bb;
                for (int k = 0; k < 64; ++k) { const float w = fw4[(size_t)k * 3072 + col];
#pragma unroll
                    for (int p = 0; p < 16; ++p) a[p] += h3[p * 64 + k] * w; }
                const int c = col % 768; const float mind = -3.0701134573253945f, maxd = -15.350567286626972f;
                const float delta = fabsf(mind + (maxd - mind) * ((float)c / 767.0f)); float asum = 0.f;
#pragma unroll
                for (int p = 0; p < 16; ++p) { const float t = (float)(pos0 + p) / 4095.0f; a[p] *= expf(-t * delta); asum += fabsf(a[p]); }
                f32x4* dst = (f32x4*)(HRAWT + (size_t)col * 4096 + pos0);
#pragma unroll
                for (int q = 0; q < 4; ++q) dst[q] = (f32x4){a[4 * q], a[4 * q + 1], a[4 * q + 2], a[4 * q + 3]};
                HPART[(size_t)it * 3072 + col] = asum;
            }
        }
    }
}

__device__ __forceinline__ s16x4 vtr(const LAS unsigned char* p) { typedef short v4i16_t __attribute__((ext_vector_type(4))); return __builtin_bit_cast(s16x4, __builtin_amdgcn_ds_read_tr16_b64_v4i16((LAS v4i16_t*)p)); }
__device__ __forceinline__ void na_phase(const Ctx& cx, const bf16_t* PROJ, const float* rpb, bf16_t* CAT, const int tid) {
    const int lane = tid & 63, wid = __builtin_amdgcn_readfirstlane(tid >> 6), m16 = lane & 15, q4 = lane >> 4;
    LAS unsigned char* Kb = cx.lds; LAS unsigned char* Vb = cx.lds + 73728; LAS float* biasL = (LAS float*)(cx.lds + 147456);
    constexpr int PW = 2560;
    u32x4 kv[9], vv[9]; float bpre = 0.f; bf16x8 qn[2];
#define NA_LOAD(unit_) do { const int b_ = __builtin_amdgcn_readfirstlane((unit_) / 384), rem_ = __builtin_amdgcn_readfirstlane((unit_) % 384), h_ = rem_ >> 5, rp_ = rem_ & 31; int bs_ = 2 * rp_ - 4; bs_ = bs_ < 0 ? 0 : (bs_ > 56 ? 56 : bs_); bs_ = __builtin_amdgcn_readfirstlane(bs_); \
        _Pragma("unroll") for (int it = 0; it < 9; ++it) { const int i = tid + it * 512; const int brow = i >> 9, col = (i >> 3) & 63, ch = i & 7; int grow = bs_ + brow; grow = grow > 63 ? 63 : grow; \
            const size_t tok = (size_t)b_ * 4096 + grow * 64 + col; \
            kv[it] = *(const u32x4*)(PROJ + tok * PW + 768 + h_ * 64 + ch * 8); vv[it] = *(const u32x4*)(PROJ + tok * PW + 1536 + h_ * 64 + ch * 8); } \
        if (tid < 465) bpre = rpb[h_ * 465 + tid];   \
        { const size_t tq_ = (size_t)b_ * 4096 + (2 * rp_ + (wid >> 2)) * 64 + 16 * (wid & 3) + m16; \
          _Pragma("unroll") for (int kk = 0; kk < 2; ++kk) qn[kk] = *(const bf16x8*)(PROJ + tq_ * PW + h_ * 64 + 32 * kk + 8 * q4); } } while (0)
    int u0 = cx.vcu; asm volatile("" : "+s"(u0));
    if (u0 < 6144) NA_LOAD(u0);
    for (int unit = u0; unit < 6144; unit += cx.G) {
        const int b = unit / 384, rem = unit % 384, h = rem >> 5, rp = rem & 31;
        int bs = 2 * rp - 4; bs = bs < 0 ? 0 : (bs > 56 ? 56 : bs);
        __syncthreads();
#pragma unroll
        for (int it = 0; it < 9; ++it) { const int i = tid + it * 512; const int brow = i >> 9, col = (i >> 3) & 63, ch = i & 7;
            *(LAS u32x4*)(Kb + (brow * 64 + col) * 128 + ((ch ^ ((col >> 1) & 7)) << 4)) = kv[it];
            *(LAS u32x4*)(Vb + (brow * 64 + col) * 128 + ((ch ^ (col & 7)) << 4)) = vv[it]; }
        if (tid < 465) biasL[tid] = bpre * LOG2E;
        __syncthreads();
        bf16x8 qf[2]; qf[0] = qn[0]; qf[1] = qn[1];
        { const int un_ = (unit + cx.G < 6144) ? unit + cx.G : unit; NA_LOAD(un_); }
        const int r = 2 * rp + (wid >> 2), g = wid & 3;
        const int wc0 = (g == 0) ? 0 : (g == 1) ? 8 : (g == 2) ? 24 : 32;
        int r0 = r - 4; r0 = r0 < 0 ? 0 : (r0 > 56 ? 56 : r0); const int ro = r0 - bs;
        const int c = 16 * g + m16;
        const size_t tq = (size_t)b * 4096 + r * 64 + c;
        f32x4 S[16];
#pragma unroll
        for (int i = 0; i < 8; ++i)
#pragma unroll
            for (int ct = 0; ct < 2; ++ct) { const int col = wc0 + 16 * ct + m16; const LAS unsigned char* kp = Kb + ((ro + i) * 64 + col) * 128; const int sw = (col >> 1) & 7;
                f32x4 a = (f32x4){0.f, 0.f, 0.f, 0.f};
#pragma unroll
                for (int kk = 0; kk < 2; ++kk) { const bf16x8 kf = *(const LAS bf16x8*)(kp + (((q4 + 4 * kk) ^ sw) << 4)); a = __builtin_amdgcn_mfma_f32_16x16x32_bf16(kf, qf[kk], a, 0, 0, 0); }
                S[2 * i + ct] = a; }
        int c0 = c - 8; c0 = c0 < 0 ? 0 : (c0 > 48 ? 48 : c0);
        float mx = -INFINITY;
#pragma unroll
        for (int i = 0; i < 8; ++i)
#pragma unroll
            for (int ct = 0; ct < 2; ++ct)
#pragma unroll
                for (int v = 0; v < 4; ++v) { const int kc = wc0 + 16 * ct + 4 * q4 + v; const bool valid = (kc >= c0) && (kc < c0 + 16);
                    const int bidx = valid ? (r0 + i - r + 7) * 31 + (kc - c + 15) : 0;
                    const float s = valid ? S[2 * i + ct][v] + biasL[bidx] : -INFINITY; S[2 * i + ct][v] = s; mx = fmaxf(mx, s); }
        mx = fmaxf(mx, shflx(mx, 16, lane)); mx = fmaxf(mx, shflx(mx, 32, lane));
        float l = 0.f;
#pragma unroll
        for (int t = 0; t < 16; ++t)
#pragma unroll
            for (int v = 0; v < 4; ++v) { const float p = __builtin_amdgcn_exp2f(S[t][v] - mx); S[t][v] = p; l += p; }
        l += shflx(l, 16, lane); l += shflx(l, 32, lane);
        f32x4 O[4];
#pragma unroll
        for (int dt = 0; dt < 4; ++dt) O[dt] = (f32x4){0.f, 0.f, 0.f, 0.f};
        const int qq = m16 >> 2, pp = m16 & 3, col1 = wc0 + 4 * q4 + qq;
#pragma unroll
        for (int i = 0; i < 8; ++i) {
            u32x4 pw; pw.x = pk2(S[2 * i][0], S[2 * i][1]); pw.y = pk2(S[2 * i][2], S[2 * i][3]); pw.z = pk2(S[2 * i + 1][0], S[2 * i + 1][1]); pw.w = pk2(S[2 * i + 1][2], S[2 * i + 1][3]);
            const bf16x8 pb = __builtin_bit_cast(bf16x8, pw);
            const LAS unsigned char* v1 = Vb + ((ro + i) * 64 + col1) * 128 + 8 * (pp & 1);
            const LAS unsigned char* v2 = v1 + 16 * 128;
#pragma unroll
            for (int dt = 0; dt < 4; ++dt) { const int chunk = 2 * dt + (pp >> 1);
                const s16x4 lo = vtr(v1 + ((chunk ^ (col1 & 7)) << 4)), hi = vtr(v2 + ((chunk ^ ((col1 + 16) & 7)) << 4));
                const bf16x8 vf = (bf16x8){lo[0], lo[1], lo[2], lo[3], hi[0], hi[1], hi[2], hi[3]};
                O[dt] = __builtin_amdgcn_mfma_f32_16x16x32_bf16(vf, pb, O[dt], 0, 0, 0); }
        }
        const float inv = 1.0f / l;
#pragma unroll
        for (int dt = 0; dt < 4; ++dt) {
            if constexpr (OUTP_F8) { int w = 0; w = __builtin_amdgcn_cvt_pk_fp8_f32(O[dt][0] * inv, O[dt][1] * inv, w, false); w = __builtin_amdgcn_cvt_pk_fp8_f32(O[dt][2] * inv, O[dt][3] * inv, w, true); *(int*)((unsigned char*)CAT + tq * 1024 + h * 64 + 16 * dt + 4 * q4) = w; }
            else { u32x2 w; w.x = pk2(O[dt][0] * inv, O[dt][1] * inv); w.y = pk2(O[dt][2] * inv, O[dt][3] * inv); *(u32x2*)(CAT + tq * 1024 + h * 64 + 16 * dt + 4 * q4) = w; } }
    }
    __syncthreads();
}

#undef NA_LOAD
__device__ __forceinline__ void rope_phase(const Ctx& cx, const bf16_t* PROJ, const float* qg, const float* kg, bf16_t* QKR, const int tid) {
    const int lane = tid & 63, wave = __builtin_amdgcn_readfirstlane(tid >> 6);
    const int gw = cx.vcu * 8 + wave, NGW = cx.G * 8;
    const int d0 = (lane & 7) * 8;
    float gq[8], gk[8], invf[4];
#pragma unroll
    for (int e = 0; e < 8; ++e) { gq[e] = qg[d0 + e]; gk[e] = kg[d0 + e]; }
#pragma unroll
    for (int p = 0; p < 4; ++p) { const int i = (d0 >> 1) + p, j = i & 15; invf[p] = exp2f(-(float)(2 * j) / 32.0f * 13.287712379549449f); }
    const bool isrow = (d0 >> 1) < 16;
    for (int pos = gw; pos < SEQ; pos += NGW) {
        const float pr = isrow ? (float)(pos >> 6) : (float)(pos & 63);
        float cs[4], sn[4];
#pragma unroll
        for (int p = 0; p < 4; ++p) { const float a = pr * invf[p]; cs[p] = cosf(a); sn[p] = sinf(a); }
#pragma unroll 1
        for (int bg = 0; bg < BATCH; bg += 4) {
        u32x4 rawv[4][2];
#pragma unroll
        for (int bq = 0; bq < 4; ++bq)
#pragma unroll
            for (int half = 0; half < 2; ++half) rawv[bq][half] = __builtin_nontemporal_load((const u32x4*)(PROJ + (size_t)((bg + bq) * SEQ + pos) * 1536 + half * 512 + lane * 8));
        __builtin_amdgcn_sched_barrier(0);
#pragma unroll
        for (int bq = 0; bq < 4; ++bq) { const int tok = (bg + bq) * SEQ + pos;
#pragma unroll
        for (int half = 0; half < 2; ++half) {
            const int e0 = half * 512 + lane * 8; const int head = e0 >> 6; const bool isq = head < 12;
            const u32x4 raw = rawv[bq][half];
            float x[8]; x[0] = bflo(raw.x); x[1] = bfhi(raw.x); x[2] = bflo(raw.y); x[3] = bfhi(raw.y); x[4] = bflo(raw.z); x[5] = bfhi(raw.z); x[6] = bflo(raw.w); x[7] = bfhi(raw.w);
            float ss = 0.f;
#pragma unroll
            for (int e = 0; e < 8; ++e) ss += x[e] * x[e];
            ss = group8_sum(ss);
            const float inv = rsqrtf(ss * (1.0f / 64.0f) + 1e-6f);
            float y[8];
#pragma unroll
            for (int e = 0; e < 8; ++e) y[e] = x[e] * inv * (isq ? gq[e] : gk[e]);
            const float sc = isq ? C2 : 1.0f;
            float o[8];
#pragma unroll
            for (int p = 0; p < 4; ++p) { o[2 * p] = (y[2 * p] * cs[p] - y[2 * p + 1] * sn[p]) * sc; o[2 * p + 1] = (y[2 * p] * sn[p] + y[2 * p + 1] * cs[p]) * sc; }
            u32x4 w; w.x = pk2(o[0], o[1]); w.y = pk2(o[2], o[3]); w.z = pk2(o[4], o[5]); w.w = pk2(o[6], o[7]);
            *(u32x4*)(QKR + (size_t)tok * 1024 + e0) = w;
        } } }
    }
}

__device__ __forceinline__ void sconv_phase(const Ctx& cx, const bf16_t* PROJ, const float* cw, const float* cb, bf16_t* UT3, unsigned char* V8, const int tid) {
    const int lane = tid & 63, wave = __builtin_amdgcn_readfirstlane(tid >> 6);
    const int gw = cx.vcu * 8 + wave, NGW = cx.G * 8;
    LAS unsigned short* tile = (LAS unsigned short*)(cx.lds + wave * 9216);
    constexpr int PW = 2560;
    for (int it = gw; it < 16 * 64 * 36; it += NGW) {
        const int ct = it % 36, tt = (it / 36) & 63, b = it / (36 * 64);
        const int col = ct * 64 + lane, t0 = tt * 64;
        const float w0 = cw[col], w1 = cw[2304 + col], w2 = cw[4608 + col], bia = cb[col];
        const bf16_t* src = PROJ + ((size_t)b * 4096 + t0) * PW + col;
        unsigned short uu[66];
        uu[0] = (t0 > 0) ? src[-(long)PW] : (unsigned short)0;
#pragma unroll
        for (int k = 0; k < 64; ++k) uu[k + 1] = __builtin_nontemporal_load(src + (size_t)k * PW);
        uu[65] = (t0 + 64 < 4096) ? src[(size_t)64 * PW] : (unsigned short)0;
#pragma unroll
        for (int k = 0; k < 64; ++k) { const float v = bf2f(uu[k]) * w0 + bf2f(uu[k + 1]) * w1 + bf2f(uu[k + 2]) * w2 + bia; tile[lane * 72 + k] = (unsigned short)f2bf(v); }
        LDS_WAIT(); asm volatile("" ::: "memory");
        const int part = (ct * 64) / 768, cbase = (ct * 64) % 768;
#pragma unroll
        for (int k = 0; k < 8; ++k) { const int row = k * 8 + (lane >> 3), chn = lane & 7;
            const u32x4 v = *(const LAS u32x4*)((const LAS unsigned char*)tile + row * 144 + chn * 16);
            *(u32x4*)(UT3 + (((size_t)part * 16 + b) * 768 + cbase + row) * 4096 + t0 + chn * 8) = v;
            if (TCONV_F8 && part == 0) { int w0 = 0, w1 = 0;
                w0 = __builtin_amdgcn_cvt_pk_fp8_f32(bflo(v.x), bfhi(v.x), w0, false); w0 = __builtin_amdgcn_cvt_pk_fp8_f32(bflo(v.y), bfhi(v.y), w0, true);
                w1 = __builtin_amdgcn_cvt_pk_fp8_f32(bflo(v.z), bfhi(v.z), w1, false); w1 = __builtin_amdgcn_cvt_pk_fp8_f32(bflo(v.w), bfhi(v.w), w1, true);
                *(u32x2*)(V8 + ((size_t)b * 768 + cbase + row) * 4096 + t0 + chn * 8) = (u32x2){(unsigned)w0, (unsigned)w1}; } }
        LDS_WAIT(); asm volatile("" ::: "memory");
    }
}

constexpr int TZ_CS = 16384 + 64;
__device__ __forceinline__ void tconv_phase(const Ctx& cx, const int o, const bf16_t* UT, const bf16_t* GT, bf16_t* ZT, const float* lbias  , const int tid) {
    const int lane = tid & 63, wid = __builtin_amdgcn_readfirstlane(tid >> 6), m16 = lane & 15, q4 = lane >> 4;
    const float* HRAWT = (const float*)(cx.ws + WS_HRAWT); const float* HPART = (const float*)(cx.ws + WS_HPART);
    LAS unsigned char* cp = cx.lds; LAS float* red = (LAS float*)(cx.lds + 8 * TZ_CS);
    for (int c = cx.vcu; c < 768; c += cx.G) {
        __syncthreads();
        { const int dir = tid >> 8, blk = tid & 255; float v = HPART[(size_t)blk * 3072 + dir * 1536 + o * 768 + c]; v = wave_sum(v, lane); if (lane == 0) red[wid] = v; }
        __syncthreads();
        float nrm = 0.f;
#pragma unroll
        for (int w = 0; w < 8; ++w) nrm += red[w];
        const float inv = 1.0f / nrm;
        const float* hf = HRAWT + (size_t)(o * 768 + c) * 4096; const float* hb = HRAWT + (size_t)(1536 + o * 768 + c) * 4096;
        for (int i = tid; i < 8192; i += 512) { float v; if (i < 4096) v = hf[4095 - i]; else if (i < 8191) v = hb[i - 4095]; else v = 0.f;
            *(LAS unsigned short*)(cp + 2 * i) = (unsigned short)f2bf(v * inv); }
        __syncthreads();
#pragma unroll
        for (int j = 1; j < 8; ++j)
            for (int n = tid; n < 1024; n += 512) {
                const u32x4 lo = *(const LAS u32x4*)(cp + n * 16); u32x4 hi = (u32x4){0u, 0u, 0u, 0u}; if (n + 1 < 1024) hi = *(const LAS u32x4*)(cp + (n + 1) * 16);
                const unsigned w[8] = {lo.x, lo.y, lo.z, lo.w, hi.x, hi.y, hi.z, hi.w}; u32x4 r;
                const int a = j >> 1;
                if (j & 1) { r.x = (w[a] >> 16) | (w[a + 1] << 16); r.y = (w[a + 1] >> 16) | (w[a + 2] << 16); r.z = (w[a + 2] >> 16) | (w[a + 3] << 16); r.w = (w[a + 3] >> 16) | (w[a + 4] << 16); }
                else { r.x = w[a]; r.y = w[a + 1]; r.z = w[a + 2]; r.w = w[a + 3]; }
                *(LAS u32x4*)(cp + j * TZ_CS + n * 16) = r;
            }
        __syncthreads();
        const int j = (7 - m16) & 7;
        const int nbase = (4095 - 512 * wid - m16 - j + 8 * q4) >> 3;
        const LAS unsigned char* ap = cp + j * TZ_CS + (nbase - 62) * 16;
        const bf16_t* up = UT + ((size_t)m16 * 768 + c) * 4096 + 8 * q4;
        f32x4 acc[32];
#pragma unroll
        for (int ti = 0; ti < 32; ++ti) acc[ti] = (f32x4){0.f, 0.f, 0.f, 0.f};
        bf16x8 bcur = *(const bf16x8*)(up);
        bf16x8 afA[8], afB[8];
#pragma unroll
        for (int i = 0; i < 8; ++i) afA[i] = *(const LAS bf16x8*)(ap + (31 - i) * 32);
        for (int ks = 0; ks < 128; ++ks) {
            const bf16x8 bnext = *(const bf16x8*)(up + ((ks + 1) & 127) * 32);
            const LAS unsigned char* a0 = ap + ks * 64;
            const LAS unsigned char* a1 = ap + ((ks + 1) & 127) * 64;
#define TZ_LD(dst, base, g) do { _Pragma("unroll") for (int i = 0; i < 8; ++i) dst[i] = *(const LAS bf16x8*)((base) + (31 - (8 * (g) + i)) * 32); } while (0)
#define TZ_MM(src, g) do { _Pragma("unroll") for (int i = 0; i < 8; ++i) acc[8 * (g) + i] = __builtin_amdgcn_mfma_f32_16x16x32_bf16(src[i], bcur, acc[8 * (g) + i], 0, 0, 0); } while (0)
            TZ_LD(afB, a0, 1); TZ_MM(afA, 0); __builtin_amdgcn_sched_barrier(0);
            TZ_LD(afA, a0, 2); TZ_MM(afB, 1); __builtin_amdgcn_sched_barrier(0);
            TZ_LD(afB, a0, 3); TZ_MM(afA, 2); __builtin_amdgcn_sched_barrier(0);
            TZ_LD(afA, a1, 0); TZ_MM(afB, 3); __builtin_amdgcn_sched_barrier(0);
#undef TZ_LD
#undef TZ_MM
            bcur = bnext;
        }
        const float lb = lbias[c];
        const size_t rowoff = ((size_t)m16 * 768 + c) * 4096 + 512 * wid + 4 * q4;
#pragma unroll
        for (int ti = 0; ti < 32; ++ti) {
            const u32x2 uu = *(const u32x2*)(UT + rowoff + 16 * ti), gg = *(const u32x2*)(GT + rowoff + 16 * ti);
            const float y0 = (acc[ti][0] + lb * bflo(uu.x)) * bflo(gg.x), y1 = (acc[ti][1] + lb * bfhi(uu.x)) * bfhi(gg.x), y2 = (acc[ti][2] + lb * bflo(uu.y)) * bflo(gg.y), y3 = (acc[ti][3] + lb * bfhi(uu.y)) * bfhi(gg.y);
            u32x2 w; w.x = pk2(y0, y1); w.y = pk2(y2, y3);
            *(u32x2*)(ZT + rowoff + 16 * ti) = w;
            if ((ti & 7) == 7) __builtin_amdgcn_sched_barrier(0);
        }
    }
    __syncthreads();
}

constexpr int T8_CS = 8192 + 256;
__host__ __device__ constexpr int t8_sig(int j) { return j < 4 ? 2 * j : (j >= 12 ? 2 * (j - 8) : 2 * (j - 4) + 1); }
__device__ __forceinline__ float wave_max_nn(float v) {
    v = fmaxf(v, dpp_x<0xB1>(v)); v = fmaxf(v, dpp_x<0x4E>(v)); v = fmaxf(v, dpp_x<0x141>(v)); v = fmaxf(v, dpp_x<0x140>(v));
    v = fmaxf(v, __builtin_bit_cast(float, __builtin_amdgcn_update_dpp(0, __builtin_bit_cast(int, v), 0x142, 0xA, 0xF, false)));
    v = fmaxf(v, __builtin_bit_cast(float, __builtin_amdgcn_update_dpp(0, __builtin_bit_cast(int, v), 0x143, 0xC, 0xF, false)));
    return __builtin_bit_cast(float, __builtin_amdgcn_readlane(__builtin_bit_cast(int, v), 63));
}
__device__ __forceinline__ void tconv8_phase(const Ctx& cx, const int o, const bf16_t* UT, const unsigned char* U8, const bf16_t* GT, bf16_t* ZT, unsigned char* Z8  ,
                                             const float* lbias, const int tid) {
    const int lane = tid & 63, wid = __builtin_amdgcn_readfirstlane(tid >> 6), m16 = lane & 15, q4 = lane >> 4;
    const float* HRAWT = (const float*)(cx.ws + WS_HRAWT); const float* HPART = (const float*)(cx.ws + WS_HPART);
    LAS unsigned char* cp = cx.lds; LAS float* red = (LAS float*)(cx.lds + 16 * T8_CS);
    for (int c = cx.vcu; c < 768; c += cx.G) {
        __syncthreads();
        const float* hf = HRAWT + (size_t)(o * 768 + c) * 4096; const float* hb = HRAWT + (size_t)(1536 + o * 768 + c) * 4096;
        float tap[16]; float mx = 0.f;
        int t3 = tid; asm volatile("" : "+v"(t3));
#pragma unroll
        for (int k = 0; k < 16; ++k) { const int i = t3 * 16 + k; float v; if (i < 4096) v = hf[4095 - i]; else if (i < 8191) v = hb[i - 4095]; else v = 0.f; tap[k] = v; mx = fmaxf(mx, fabsf(v)); }
        { const int dir = tid >> 8, blk = tid & 255; float v = HPART[(size_t)blk * 3072 + dir * 1536 + o * 768 + c]; v = wave_sum(v, lane); mx = wave_max_nn(mx); if (lane == 0) { red[wid] = v; red[8 + wid] = mx; } }
        __syncthreads();
        float nrm = 0.f, mall = 0.f;
#pragma unroll
        for (int w = 0; w < 8; ++w) { nrm += red[w]; mall = fmaxf(mall, red[8 + w]); }
        const float inv = 1.0f / nrm;
        int ex; (void)frexpf(fmaxf(mall * inv, 1e-30f), &ex);
        const float fsc = ldexpf(1.0f, 7 - ex), unsc = ldexpf(1.0f, ex - 7), tsc = inv * fsc;
        { unsigned w[4];
#pragma unroll
          for (int q = 0; q < 4; ++q) { int r = 0; r = __builtin_amdgcn_cvt_pk_fp8_f32(tap[4 * q] * tsc, tap[4 * q + 1] * tsc, r, false); r = __builtin_amdgcn_cvt_pk_fp8_f32(tap[4 * q + 2] * tsc, tap[4 * q + 3] * tsc, r, true); w[q] = (unsigned)r; }
          *(LAS u32x4*)(cp + tid * 16) = (u32x4){w[0], w[1], w[2], w[3]}; }
        __syncthreads();
        { const u32x4 lo = *(const LAS u32x4*)(cp + tid * 16); u32x4 hi = (u32x4){0u, 0u, 0u, 0u}; if (tid + 1 < 512) hi = *(const LAS u32x4*)(cp + (tid + 1) * 16);
          const unsigned w[8] = {lo.x, lo.y, lo.z, lo.w, hi.x, hi.y, hi.z, hi.w};
#pragma unroll
          for (int j = 1; j < 16; ++j) { u32x4 r; const int a = j >> 2, sh = j & 3;
              r.x = sh ? __builtin_amdgcn_alignbyte(w[a + 1], w[a], sh) : w[a]; r.y = sh ? __builtin_amdgcn_alignbyte(w[a + 2], w[a + 1], sh) : w[a + 1];
              r.z = sh ? __builtin_amdgcn_alignbyte(w[a + 3], w[a + 2], sh) : w[a + 2]; r.w = sh ? __builtin_amdgcn_alignbyte(w[a + 4], w[a + 3], sh) : w[a + 3];
              *(LAS u32x4*)(cp + j * T8_CS + t8_sig(j) * 16 + tid * 16) = r; } }
        __syncthreads();
        const int jc = 15 - m16;
        const int nbase = 255 - 32 * wid + 2 * q4;
        const LAS unsigned char* ap = cp + jc * T8_CS + t8_sig(jc) * 16 + (nbase - 31) * 16;
        const unsigned char* up = U8 + ((size_t)m16 * 768 + c) * 4096 + 32 * q4;
        f32x4 acc[32];
#pragma unroll
        for (int ti = 0; ti < 32; ++ti) acc[ti] = (f32x4){0.f, 0.f, 0.f, 0.f};
        typedef int v8i_t __attribute__((ext_vector_type(8))); typedef int v4i_t __attribute__((ext_vector_type(4)));
#define T8_FRAG(p) __builtin_shufflevector(*(const LAS v4i_t*)(p), *(const LAS v4i_t*)((p) + 16), 0, 1, 2, 3, 4, 5, 6, 7)
        v8i_t bcur = __builtin_shufflevector(*(const v4i_t*)(up), *(const v4i_t*)(up + 16), 0, 1, 2, 3, 4, 5, 6, 7);
        v8i_t afA[4], afB[4];
#pragma unroll
        for (int i = 0; i < 4; ++i) afA[i] = T8_FRAG(ap + (31 - i) * 16);
        for (int ks = 0; ks < 32; ++ks) {
            const unsigned char* un = up + ((ks + 1) & 31) * 128;
            const v8i_t bnext = __builtin_shufflevector(*(const v4i_t*)(un), *(const v4i_t*)(un + 16), 0, 1, 2, 3, 4, 5, 6, 7);
            const LAS unsigned char* a0 = ap + ks * 128;
            const LAS unsigned char* a1 = ap + ((ks + 1) & 31) * 128;
#define T8_LD(dst, base, g) do { _Pragma("unroll") for (int i = 0; i < 4; ++i) dst[i] = T8_FRAG((base) + (31 - (4 * (g) + i)) * 16); } while (0)
#define T8_MM(src, g) do { _Pragma("unroll") for (int i = 0; i < 4; ++i) acc[4 * (g) + i] = __builtin_amdgcn_mfma_scale_f32_16x16x128_f8f6f4(src[i], bcur, acc[4 * (g) + i], 0, 0, 0, 0, 0, 0); } while (0)
            T8_LD(afB, a0, 1); T8_MM(afA, 0); __builtin_amdgcn_sched_barrier(0);
            T8_LD(afA, a0, 2); T8_MM(afB, 1); __builtin_amdgcn_sched_barrier(0);
            T8_LD(afB, a0, 3); T8_MM(afA, 2); __builtin_amdgcn_sched_barrier(0);
            T8_LD(afA, a0, 4); T8_MM(afB, 3); __builtin_amdgcn_sched_barrier(0);
            T8_LD(afB, a0, 5); T8_MM(afA, 4); __builtin_amdgcn_sched_barrier(0);
            T8_LD(afA, a0, 6); T8_MM(afB, 5); __builtin_amdgcn_sched_barrier(0);
            T8_LD(afB, a0, 7); T8_MM(afA, 6); __builtin_amdgcn_sched_barrier(0);
            T8_LD(afA, a1, 0); T8_MM(afB, 7); __builtin_amdgcn_sched_barrier(0);
#undef T8_LD
#undef T8_MM
            bcur = bnext;
        }
#undef T8_FRAG
        const float lb = lbias[c];
        const size_t rowoff = ((size_t)m16 * 768 + c) * 4096 + 512 * wid + 4 * q4;
#pragma unroll
        for (int tg = 0; tg < 32; tg += 8) {
            u32x2 uu8[8], gg8[8];
#pragma unroll
            for (int j = 0; j < 8; ++j) { uu8[j] = *(const u32x2*)(UT + rowoff + 16 * (tg + j)); gg8[j] = *(const u32x2*)(GT + rowoff + 16 * (tg + j)); }
#pragma unroll
            for (int j = 0; j < 8; ++j) { const int ti = tg + j; const u32x2 uu = uu8[j], gg = gg8[j];
                const float y0 = (acc[ti][0] * unsc + lb * bflo(uu.x)) * bflo(gg.x), y1 = (acc[ti][1] * unsc + lb * bfhi(uu.x)) * bfhi(gg.x), y2 = (acc[ti][2] * unsc + lb * bflo(uu.y)) * bflo(gg.y), y3 = (acc[ti][3] * unsc + lb * bfhi(uu.y)) * bfhi(gg.y);
                u32x2 w; w.x = pk2(y0, y1); w.y = pk2(y2, y3);
                *(u32x2*)(ZT + rowoff + 16 * ti) = w;
                if (Z8) { int w8 = 0; w8 = __builtin_amdgcn_cvt_pk_fp8_f32(fminf(fmaxf(y0, -440.f), 440.f), fminf(fmaxf(y1, -440.f), 440.f), w8, false); w8 = __builtin_amdgcn_cvt_pk_fp8_f32(fminf(fmaxf(y2, -440.f), 440.f), fminf(fmaxf(y3, -440.f), 440.f), w8, true);
                    *(int*)(Z8 + rowoff + 16 * ti) = w8; } }
            __builtin_amdgcn_sched_barrier(0);
        }
    }
    __syncthreads();
}

__device__ __forceinline__ void tback_phase(const Ctx& cx, const bf16_t* ZT, bf16_t* CAT, const int tid) {
    const int lane = tid & 63, wave = __builtin_amdgcn_readfirstlane(tid >> 6);
    const int gw = cx.vcu * 8 + wave, NGW = cx.G * 8;
    LAS unsigned char* tile = cx.lds + wave * 9216;
    for (int it = gw; it < 16 * 12 * 64; it += NGW) {
        const int tt = it & 63, ct = (it >> 6) % 12, b = it / (64 * 12);
        const int c0 = ct * 64, t0 = tt * 64;
        u32x4 vv[8];
#pragma unroll
        for (int k = 0; k < 8; ++k) { const int row = k * 8 + (lane >> 3), chn = lane & 7; vv[k] = __builtin_nontemporal_load((const u32x4*)(ZT + ((size_t)b * 768 + c0 + row) * 4096 + t0 + chn * 8)); }
        __builtin_amdgcn_sched_barrier(0);
#pragma unroll
        for (int k = 0; k < 8; ++k) { const int row = k * 8 + (lane >> 3), chn = lane & 7; *(LAS u32x4*)(tile + row * 144 + chn * 16) = vv[k]; }
        LDS_WAIT(); asm volatile("" ::: "memory");
        if constexpr (OUTP_F8) { unsigned char* dst = (unsigned char*)CAT + ((size_t)b * 4096 + t0) * 1024 + c0 + lane;
#pragma unroll 8
            for (int k = 0; k < 64; ++k) { const float v = bf2f(*(const LAS unsigned short*)(tile + lane * 144 + k * 2)); dst[(size_t)k * 1024] = f2fp8(fminf(fmaxf(v, -440.0f), 440.0f)); }
        } else { bf16_t* dst = CAT + ((size_t)b * 4096 + t0) * 1024 + c0 + lane;
#pragma unroll 8
            for (int k = 0; k < 64; ++k) dst[(size_t)k * 1024] = *(const LAS unsigned short*)(tile + lane * 144 + k * 2); }
        LDS_WAIT(); asm volatile("" ::: "memory");
    }
}

__device__ __forceinline__ void ln1_group(const int bt, const int chunk, const int wave, const int lane, const int r16, const int q4, const bf16_t* XI, bf16_t* XO, bf16_t* XB, const float* g, const float* bta,
                                          const LAS unsigned char* Wh, const LAS unsigned char* Wl, LAS float* lg, LAS int* lcnt, const float rb0, const float rb1, float* gate, unsigned (&pk)[2], unsigned (&gp)[2], const LAS float* gl) {
    constexpr int WP = 2064;
            const size_t rowU = (size_t)chunk * 256 + wave * 32 + bt * 16;
            unsigned loff = (unsigned)(r16 * 1024 + 8 * q4); asm volatile("" : "+v"(loff));
            const GAS bf16_t* src = (const GAS bf16_t*)XI + rowU * 1024 + loff;
            constexpr int HOLD = LN1_HOLD;
            u32x4 raw[HOLD > 0 ? HOLD : 1], rawt[32 - HOLD]; float s = 0.f, ss = 0.f;
#pragma unroll
            for (int i = 0; i < 32; ++i) { if (i < HOLD) raw[i] = *(const GAS u32x4*)(src + 32 * i); else rawt[i - HOLD] = *(const GAS u32x4*)(src + 32 * i); }
#pragma unroll
            for (int i = 0; i < 32; ++i) { const u32x4 rr = (i < HOLD) ? raw[i < HOLD ? i : 0] : rawt[i < HOLD ? 0 : i - HOLD]; const float x0 = bflo(rr.x), x1 = bfhi(rr.x), x2 = bflo(rr.y), x3 = bfhi(rr.y), x4 = bflo(rr.z), x5 = bfhi(rr.z), x6 = bflo(rr.w), x7 = bfhi(rr.w);
                s += ((x0 + x1) + (x2 + x3)) + ((x4 + x5) + (x6 + x7)); ss += ((x0 * x0 + x1 * x1) + (x2 * x2 + x3 * x3)) + ((x4 * x4 + x5 * x5) + (x6 * x6 + x7 * x7)); }
            lg[2 * lane] = s; lg[2 * lane + 1] = ss; LDS_WAIT(); asm volatile("" ::: "memory");
            s = (lg[2 * r16] + lg[2 * (r16 + 16)]) + (lg[2 * (r16 + 32)] + lg[2 * (r16 + 48)]); ss = (lg[2 * r16 + 1] + lg[2 * (r16 + 16) + 1]) + (lg[2 * (r16 + 32) + 1] + lg[2 * (r16 + 48) + 1]);
            LDS_WAIT(); asm volatile("" ::: "memory");
            const float mean = s * (1.0f / 1024.0f), rstd = rsqrtf(fmaxf(ss * (1.0f / 1024.0f) - mean * mean, 0.f) + LN_EPS);
            f32x4 a0 = (f32x4){0.f, 0.f, 0.f, 0.f}, a1 = (f32x4){0.f, 0.f, 0.f, 0.f};
            const LAS unsigned char* wh0 = Wh + r16 * WP + 16 * q4; const LAS unsigned char* wl0 = Wl + r16 * WP + 16 * q4;
            GAS bf16_t* dsto = (GAS bf16_t*)XO + ((X1_RECOMP && Y_F8) ? (size_t)(wave * 32 + bt * 16) : rowU) * 1024 + loff; GAS unsigned char* dst8 = (GAS unsigned char*)XB + rowU * 1024 + loff;
            const LAS float* glq = gl + 8 * q4;
            u32x4 nx_ = (u32x4){0u, 0u, 0u, 0u}; if (HOLD == 0) nx_ = *(const GAS u32x4*)(src);
#pragma unroll
            for (int i = 0; i < 32; ++i) {
                u32x4 rw_; if (i < HOLD) rw_ = raw[i < HOLD ? i : 0]; else rw_ = nx_;
                if (i + 1 < 32 && i + 1 >= HOLD) nx_ = *(const GAS u32x4*)(src + 32 * (i + 1));
                asm volatile("" : "+v"(rw_));
                const f32x4 g0 = *(const LAS f32x4*)(glq + 32 * i), g1 = *(const LAS f32x4*)(glq + 32 * i + 4), b0 = *(const LAS f32x4*)(glq + 1024 + 32 * i), b1 = *(const LAS f32x4*)(glq + 1024 + 32 * i + 4);
                float y[8]; y[0] = bflo(rw_.x); y[1] = bfhi(rw_.x); y[2] = bflo(rw_.y); y[3] = bfhi(rw_.y); y[4] = bflo(rw_.z); y[5] = bfhi(rw_.z); y[6] = bflo(rw_.w); y[7] = bfhi(rw_.w);
#pragma unroll
                for (int q = 0; q < 8; ++q) y[q] = (y[q] - mean) * rstd * (q < 4 ? g0[q & 3] : g1[q & 3]) + (q < 4 ? b0[q & 3] : b1[q & 3]);
                u32x4 hi; hi.x = pk2(y[0], y[1]); hi.y = pk2(y[2], y[3]); hi.z = pk2(y[4], y[5]); hi.w = pk2(y[6], y[7]);
                *(GAS u32x4*)(dsto + 32 * i) = hi;
                if constexpr (MOE_F8) { int w0 = 0, w1 = 0; w0 = __builtin_amdgcn_cvt_pk_fp8_f32(y[0], y[1], w0, false); w0 = __builtin_amdgcn_cvt_pk_fp8_f32(y[2], y[3], w0, true); w1 = __builtin_amdgcn_cvt_pk_fp8_f32(y[4], y[5], w1, false); w1 = __builtin_amdgcn_cvt_pk_fp8_f32(y[6], y[7], w1, true);
                    *(GAS u32x2*)(dst8 + 32 * i) = (u32x2){(unsigned)w0, (unsigned)w1}; }
                else { *(u32x4*)((bf16_t*)XB + rowU * 1024 + loff + 32 * i) = hi; }
                u32x4 lo; lo.x = pk2(y[0] - bflo(hi.x), y[1] - bfhi(hi.x)); lo.y = pk2(y[2] - bflo(hi.y), y[3] - bfhi(hi.y)); lo.z = pk2(y[4] - bflo(hi.z), y[5] - bfhi(hi.z)); lo.w = pk2(y[6] - bflo(hi.w), y[7] - bfhi(hi.w));
                const bf16x8 ah = __builtin_bit_cast(bf16x8, hi), al = __builtin_bit_cast(bf16x8, lo);
                const bf16x8 wh_0 = *(const LAS bf16x8*)(wh0 + 64 * i), wh_1 = *(const LAS bf16x8*)(wh0 + 16 * WP + 64 * i), wl_0 = *(const LAS bf16x8*)(wl0 + 64 * i), wl_1 = *(const LAS bf16x8*)(wl0 + 16 * WP + 64 * i);
                a0 = __builtin_amdgcn_mfma_f32_16x16x32_bf16(ah, wh_0, a0, 0, 0, 0); a1 = __builtin_amdgcn_mfma_f32_16x16x32_bf16(ah, wh_1, a1, 0, 0, 0);
                a0 = __builtin_amdgcn_mfma_f32_16x16x32_bf16(al, wh_0, a0, 0, 0, 0); a1 = __builtin_amdgcn_mfma_f32_16x16x32_bf16(al, wh_1, a1, 0, 0, 0);
                a0 = __builtin_amdgcn_mfma_f32_16x16x32_bf16(ah, wl_0, a0, 0, 0, 0); a1 = __builtin_amdgcn_mfma_f32_16x16x32_bf16(ah, wl_1, a1, 0, 0, 0);
                asm volatile("" :: "v"(ah), "v"(al), "v"(wh_0), "v"(wh_1), "v"(wl_0), "v"(wl_1));
                __builtin_amdgcn_sched_barrier(0);
            }
#pragma unroll
            for (int v = 0; v < 4; ++v) { lg[(4 * q4 + v) * 33 + r16] = a0[v] + rb0; lg[(4 * q4 + v) * 33 + r16 + 16] = a1[v] + rb1; }
            LDS_WAIT(); asm volatile("" ::: "memory");
            if (lane < 16) {
                const LAS float* myl = lg + lane * 33; const size_t rowt = (size_t)chunk * 256 + wave * 32 + bt * 16 + lane;
                float tv[4]; int te[4]; int t0 = -1, t1 = -1, t2 = -1;
#pragma unroll
                for (int k = 0; k < 4; ++k) { float best = -INFINITY; int bi = 0;
                    for (int e = 0; e < 32; ++e) { const float v = myl[e]; const bool ok = (e != t0) && (e != t1) && (e != t2); if (ok && v > best) { best = v; bi = e; } }
                    tv[k] = best; te[k] = bi; if (k == 0) t0 = bi; else if (k == 1) t1 = bi; else if (k == 2) t2 = bi; }
                const float e1 = __expf(tv[1] - tv[0]), e2 = __expf(tv[2] - tv[0]), e3 = __expf(tv[3] - tv[0]); const float isum = 1.0f / (1.0f + e1 + e2 + e3);
                const float gk[4] = {isum, e1 * isum, e2 * isum, e3 * isum};
                pk[0] = 0u; pk[1] = 0u;
#pragma unroll
                for (int k = 0; k < 4; ++k) { const int rk = __hip_atomic_fetch_add(lcnt + te[k], 1, __ATOMIC_RELAXED, __HIP_MEMORY_SCOPE_WORKGROUP); pk[k >> 1] |= (unsigned)((te[k] << 11) | rk) << (16 * (k & 1)); }
                gp[0] = pk2(gk[0], gk[1]); gp[1] = pk2(gk[2], gk[3]); (void)rowt; (void)gate;
            }
            LDS_WAIT(); asm volatile("" ::: "memory");
}
__device__ __forceinline__ void ln1_router_phase(const Ctx& cx, const bf16_t* XI, bf16_t* XO, bf16_t* XB, const float* g, const float* bta, const float* rw, const float* rb,
                                                 unsigned* cnt, int* expid, float* gate, int* idx, float* gidx, const int tid) {
    const int lane = tid & 63, wave = __builtin_amdgcn_readfirstlane(tid >> 6), r16 = lane & 15, q4 = lane >> 4;
    constexpr int WP = 2064;
    LAS unsigned char* Wh = cx.lds; LAS unsigned char* Wl = cx.lds + 32 * WP; LAS int* lcnt = (LAS int*)(cx.lds + 64 * WP); LAS int* lbase = lcnt + 32; LAS float* lg = (LAS float*)(cx.lds + 64 * WP + 256 + wave * 2112);
    __syncthreads();
    { const u32x4* rsrc = (const u32x4*)rw; u32x4 wv[16];
#pragma unroll
      for (int u = 0; u < 16; ++u) wv[u] = rsrc[tid + 512 * u];
#pragma unroll
      for (int u = 0; u < 16; ++u) { const int idx = tid + 512 * u; *(LAS u32x4*)(Wh + (idx >> 7) * WP + (idx & 127) * 16) = wv[u]; } }
    if (tid < 256) { LAS float* gf = (LAS float*)(cx.lds + 151552); *(LAS f32x4*)(gf + 4 * tid) = *(const f32x4*)(g + 4 * tid); *(LAS f32x4*)(gf + 1024 + 4 * tid) = *(const f32x4*)(bta + 4 * tid); }
    if (tid < 32) lcnt[tid] = 0;
    LAS float* gl = (LAS float*)(cx.lds + 151552);
    const float rb0 = rb[r16], rb1 = rb[r16 + 16];
    __syncthreads();
    for (int chunk = cx.vcu; chunk < NTOK / 256; chunk += cx.G) {
        unsigned pk0[2] = {0u, 0u}, pk1[2] = {0u, 0u}, gp0[2] = {0u, 0u}, gp1[2] = {0u, 0u};
        ln1_group(0, chunk, wave, lane, r16, q4, XI, XO, XB, g, bta, Wh, Wl, lg, lcnt, rb0, rb1, gate, pk0, gp0, gl);
        ln1_group(1, chunk, wave, lane, r16, q4, XI, XO, XB, g, bta, Wh, Wl, lg, lcnt, rb0, rb1, gate, pk1, gp1, gl);
        __syncthreads();
        { const int t2 = wave * 64 + lane_id_volatile();
          if (t2 < 32) { lbase[t2] = (int)__hip_atomic_fetch_add(cnt + t2, (unsigned)lcnt[t2], __ATOMIC_RELAXED, __HIP_MEMORY_SCOPE_AGENT); } }
        __syncthreads();
        const int ln_ = lane_id_volatile();
        if (ln_ < 16) {
            { const int slot0 = (chunk * 256 + wave * 32 + ln_) * 4;
#pragma unroll
                for (int k = 0; k < 4; ++k) { const unsigned p = (pk0[k >> 1] >> (16 * (k & 1))) & 0xffffu; const int e = (int)(p >> 11), rk = (int)(p & 0x7ffu); const size_t o_ = (size_t)e * IDXCAP + lbase[e] + rk; idx[o_] = slot0 + k; gidx[o_] = (k & 1) ? bfhi(gp0[k >> 1]) : bflo(gp0[k >> 1]); } }
            { const int slot0 = (chunk * 256 + wave * 32 + 16 + ln_) * 4;
#pragma unroll
                for (int k = 0; k < 4; ++k) { const unsigned p = (pk1[k >> 1] >> (16 * (k & 1))) & 0xffffu; const int e = (int)(p >> 11), rk = (int)(p & 0x7ffu); const size_t o_ = (size_t)e * IDXCAP + lbase[e] + rk; idx[o_] = slot0 + k; gidx[o_] = (k & 1) ? bfhi(gp1[k >> 1]) : bflo(gp1[k >> 1]); } }
        }
        __syncthreads();
        { const int t3 = wave * 64 + lane_id_volatile(); if (t3 < 32) lcnt[t3] = 0; }
        __syncthreads();
    }
}

__device__ __forceinline__ void ln2_phase(const Ctx& cx, const bf16_t* X1, const bf16_t* Y, bf16_t* XO, bf16_t* XB, float* OUT, const float* g, const float* bta, const float* g1, const float* b1, const int tid) {
    const int lane = tid & 63, wave = __builtin_amdgcn_readfirstlane(tid >> 6);
    const int gw = cx.vcu * 8 + wave, NGW = cx.G * 8;
    if constexpr (Y_F8) {
        f32x4 gv[4], bv[4];
#pragma unroll
        for (int j = 0; j < 4; ++j) { gv[j] = *(const f32x4*)(g + 16 * lane + 4 * j); bv[j] = *(const f32x4*)(bta + 16 * lane + 4 * j); }
        f32x4 g1v[4], b1v[4];
        if (X1_RECOMP) {
#pragma unroll
            for (int j = 0; j < 4; ++j) { g1v[j] = *(const f32x4*)(g1 + 16 * lane + 4 * j); b1v[j] = *(const f32x4*)(b1 + 16 * lane + 4 * j); } }
        for (int rp = gw; rp < NTOK / 2; rp += NGW) {
            u32x4 xa[2][2], ya[2][4];
#pragma unroll
            for (int r = 0; r < 2; ++r) { const size_t row = (size_t)rp * 2 + r;
                xa[r][0] = __builtin_nontemporal_load((const u32x4*)(X1 + row * 1024 + 16 * lane)); xa[r][1] = __builtin_nontemporal_load((const u32x4*)(X1 + row * 1024 + 16 * lane + 8));
#pragma unroll
                for (int k = 0; k < 4; ++k) ya[r][k] = __builtin_nontemporal_load((const u32x4*)((const unsigned char*)Y + (row * 4 + k) * 1024 + 16 * lane)); }
            float v[2][16]; float s[2] = {0.f, 0.f};
            float m1[2] = {0.f, 0.f}, r1[2] = {1.f, 1.f};
            if (X1_RECOMP) {
                float s1[2] = {0.f, 0.f}, q1[2] = {0.f, 0.f};
#pragma unroll
                for (int r = 0; r < 2; ++r)
#pragma unroll
                    for (int d = 0; d < 8; ++d) { const unsigned w = xa[r][d >> 2][d & 3]; const float t0 = bflo(w), t1 = bfhi(w); s1[r] += t0 + t1; q1[r] += t0 * t0 + t1 * t1; }
#pragma unroll
                for (int r = 0; r < 2; ++r) { m1[r] = wave_sum(s1[r], lane) * (1.0f / 1024.0f); r1[r] = rsqrtf(fmaxf(wave_sum(q1[r], lane) * (1.0f / 1024.0f) - m1[r] * m1[r], 0.f) + LN_EPS); } }
#pragma unroll
            for (int r = 0; r < 2; ++r) {
#pragma unroll
                for (int i = 0; i < 4; ++i) { f32x2 lo = __builtin_amdgcn_cvt_pk_f32_fp8((int)ya[r][0][i], false), hi = __builtin_amdgcn_cvt_pk_f32_fp8((int)ya[r][0][i], true);
#pragma unroll
                    for (int k = 1; k < 4; ++k) { lo += __builtin_amdgcn_cvt_pk_f32_fp8((int)ya[r][k][i], false); hi += __builtin_amdgcn_cvt_pk_f32_fp8((int)ya[r][k][i], true); }
                    const unsigned xlo = xa[r][i >> 1][(i & 1) * 2], xhi = xa[r][i >> 1][(i & 1) * 2 + 1];
                    f32x4 x1v = (f32x4){bflo(xlo), bfhi(xlo), bflo(xhi), bfhi(xhi)};
                    if (X1_RECOMP) x1v = (x1v - m1[r]) * r1[r] * g1v[i] + b1v[i];
                    v[r][4 * i + 0] = x1v[0] * DN_ALPHA + lo[0] * (1.0f / Y_SCALE); v[r][4 * i + 1] = x1v[1] * DN_ALPHA + lo[1] * (1.0f / Y_SCALE);
                    v[r][4 * i + 2] = x1v[2] * DN_ALPHA + hi[0] * (1.0f / Y_SCALE); v[r][4 * i + 3] = x1v[3] * DN_ALPHA + hi[1] * (1.0f / Y_SCALE);
                    s[r] += (v[r][4 * i] + v[r][4 * i + 1]) + (v[r][4 * i + 2] + v[r][4 * i + 3]); } }
            const float mean0 = wave_sum(s[0], lane) * (1.0f / 1024.0f), mean1 = wave_sum(s[1], lane) * (1.0f / 1024.0f); float q[2] = {0.f, 0.f};
#pragma unroll
            for (int r = 0; r < 2; ++r)
#pragma unroll
                for (int e = 0; e < 16; ++e) { v[r][e] -= (r == 0 ? mean0 : mean1); q[r] += v[r][e] * v[r][e]; }
            const float rstd0 = rsqrtf(wave_sum(q[0], lane) * (1.0f / 1024.0f) + LN_EPS), rstd1 = rsqrtf(wave_sum(q[1], lane) * (1.0f / 1024.0f) + LN_EPS);
            unsigned wb[2][8]; unsigned w8[2][4];
#pragma unroll
            for (int j = 0; j < 4; ++j) { const f32x4 gvj = gv[j], bvj = bv[j];
#pragma unroll
                for (int r = 0; r < 2; ++r) { const size_t row = (size_t)rp * 2 + r; const float rs = (r == 0 ? rstd0 : rstd1);
                    const f32x4 o = (f32x4){v[r][4 * j], v[r][4 * j + 1], v[r][4 * j + 2], v[r][4 * j + 3]} * rs * gvj + bvj;
                    if (OUT) *(f32x4*)(OUT + row * 1024 + 16 * lane + 4 * j) = o;
                    else { wb[r][2 * j] = pk2(o[0], o[1]); wb[r][2 * j + 1] = pk2(o[2], o[3]);
                        int t8 = 0; t8 = __builtin_amdgcn_cvt_pk_fp8_f32(o[0], o[1], t8, false); t8 = __builtin_amdgcn_cvt_pk_fp8_f32(o[2], o[3], t8, true); w8[r][j] = (unsigned)t8; } } }
            if (!OUT) {
#pragma unroll
                for (int r = 0; r < 2; ++r) { const size_t row = (size_t)rp * 2 + r;
                    *(u32x4*)(XO + row * 1024 + 16 * lane) = (u32x4){wb[r][0], wb[r][1], wb[r][2], wb[r][3]}; *(u32x4*)(XO + row * 1024 + 16 * lane + 8) = (u32x4){wb[r][4], wb[r][5], wb[r][6], wb[r][7]};
                    if constexpr (INP_F8) *(u32x4*)((unsigned char*)XB + row * 1024 + 16 * lane) = (u32x4){w8[r][0], w8[r][1], w8[r][2], w8[r][3]};
                    else { *(u32x4*)(XB + row * 1024 + 16 * lane) = (u32x4){wb[r][0], wb[r][1], wb[r][2], wb[r][3]}; *(u32x4*)(XB + row * 1024 + 16 * lane + 8) = (u32x4){wb[r][4], wb[r][5], wb[r][6], wb[r][7]}; } } }
        }
        return;
    }
    for (int rp = gw; rp < NTOK / 2; rp += NGW) {
        f32x4 v[2][4]; float s[2] = {0.f, 0.f};
#pragma unroll
        for (int r = 0; r < 2; ++r) { const size_t row = (size_t)rp * 2 + r;
#pragma unroll
            for (int j = 0; j < 4; ++j) { const u32x2 a = *(const u32x2*)(X1 + row * 1024 + 4 * lane + 256 * j); v[r][j] = (f32x4){bflo(a.x), bfhi(a.x), bflo(a.y), bfhi(a.y)} * DN_ALPHA;
#pragma unroll
                for (int k = 0; k < 4; ++k) {
                    if constexpr (Y_F8) { const int y8 = *(const int*)((const unsigned char*)Y + (row * 4 + k) * 1024 + 4 * lane + 256 * j); const f32x2 lo = __builtin_amdgcn_cvt_pk_f32_fp8(y8, false), hi = __builtin_amdgcn_cvt_pk_f32_fp8(y8, true);
                        v[r][j][0] += lo[0] * (1.0f / Y_SCALE); v[r][j][1] += lo[1] * (1.0f / Y_SCALE); v[r][j][2] += hi[0] * (1.0f / Y_SCALE); v[r][j][3] += hi[1] * (1.0f / Y_SCALE); }
                    else { const u32x2 y = *(const u32x2*)(Y + (row * 4 + k) * 1024 + 4 * lane + 256 * j); v[r][j][0] += bflo(y.x); v[r][j][1] += bfhi(y.x); v[r][j][2] += bflo(y.y); v[r][j][3] += bfhi(y.y); } }
                s[r] += (v[r][j][0] + v[r][j][1]) + (v[r][j][2] + v[r][j][3]); } }
        const float mean0 = wave_sum(s[0], lane) * (1.0f / 1024.0f), mean1 = wave_sum(s[1], lane) * (1.0f / 1024.0f); float q[2] = {0.f, 0.f};
#pragma unroll
        for (int r = 0; r < 2; ++r)
#pragma unroll
            for (int j = 0; j < 4; ++j) { v[r][j] = v[r][j] - (r == 0 ? mean0 : mean1); q[r] += (v[r][j][0] * v[r][j][0] + v[r][j][1] * v[r][j][1]) + (v[r][j][2] * v[r][j][2] + v[r][j][3] * v[r][j][3]); }
        const float rstd0 = rsqrtf(wave_sum(q[0], lane) * (1.0f / 1024.0f) + LN_EPS), rstd1 = rsqrtf(wave_sum(q[1], lane) * (1.0f / 1024.0f) + LN_EPS);
#pragma unroll
        for (int j = 0; j < 4; ++j) { const f32x4 gvj = *(const f32x4*)(g + 4 * lane + 256 * j), bvj = *(const f32x4*)(bta + 4 * lane + 256 * j);
#pragma unroll
            for (int r = 0; r < 2; ++r) { const size_t row = (size_t)rp * 2 + r; const f32x4 o = v[r][j] * (r == 0 ? rstd0 : rstd1) * gvj + bvj;
                if (OUT) *(f32x4*)(OUT + row * 1024 + 4 * lane + 256 * j) = o;
                else { u32x2 w; w.x = pk2(o[0], o[1]); w.y = pk2(o[2], o[3]); *(u32x2*)(XO + row * 1024 + 4 * lane + 256 * j) = w;
                    if constexpr (INP_F8) { int w8 = 0; w8 = __builtin_amdgcn_cvt_pk_fp8_f32(o[0], o[1], w8, false); w8 = __builtin_amdgcn_cvt_pk_fp8_f32(o[2], o[3], w8, true); *(int*)((unsigned char*)XB + row * 1024 + 4 * lane + 256 * j) = w8; }
                    else { *(u32x2*)(XB + row * 1024 + 4 * lane + 256 * j) = w; } } } }
    }
}

constexpr int PH_PER_LAYER = 10, N_PHASES = 2 + PH_PER_LAYER * DEPTH;
__host__ __device__ constexpr bool phase_active(int p) {
    if (p < 2) return true;
    const int l = (p - 2) / PH_PER_LAYER, k = (p - 2) % PH_PER_LAYER, kind = l % 3;
    if (k == 1) return kind != 0;
    if (k == 3 || k == 4) return kind == 2;
    return true;
}

__global__ void __launch_bounds__(512, 2) fwd(Args args) {
    extern __shared__ __attribute__((aligned(16))) unsigned char lds_raw[];
    const int wave0 = __builtin_amdgcn_readfirstlane((int)threadIdx.x >> 6);
    Ctx cx; cx.lds = (LAS unsigned char*)lds_raw; cx.G = gridDim.x; { const int bx = blockIdx.x; cx.vcu = (cx.G % 8 == 0) ? (bx % 8) * (cx.G / 8) + bx / 8 : bx; } cx.ws = args.ws;
    volatile LAS unsigned* MISC = (volatile LAS unsigned*)(cx.lds + MISC_OFF);
    for (int u = threadIdx.x; u < (LDS_BYTES - MISC_OFF) / 4; u += 512) MISC[u] = 0u;
    __syncthreads();
    if (threadIdx.x == 0) { LAS unsigned long long* t = (LAS unsigned long long*)(cx.lds + PTAB_OFF);
#pragma unroll
        for (int k = 0; k < 32; ++k) t[k] = (unsigned long long)args.in[k];
        t[32] = (unsigned long long)args.out; t[33] = (unsigned long long)args.ws; }
    __syncthreads();
    const int lo = args.ph_lo, hi = args.ph_hi;
    XcdBarrier bar; bar.bar = (unsigned*)((gu32*)(args.ws + WS_CTL) + CW_BAR); bar.x = 0; bar.st = nullptr;
    if (hi - lo > 1) bar = xcd_barrier_post((unsigned*)((gu32*)(args.ws + WS_CTL) + CW_BAR), MISC + 8);
    int ran = 0, nobar = 0;
#define XB ((bf16_t*)(ws + WS_XB))
#define PROJ ((bf16_t*)(ws + WS_PROJ))
#define CAT ((bf16_t*)(ws + WS_CAT))
#define KVM ((bf16_t*)(ws + WS_KVM))
#define HB ((bf16_t*)(ws + WS_H))
#define YB ((bf16_t*)(ws + WS_Y))
#define QKR ((bf16_t*)(ws + WS_QKR))
#define EXPID ((int*)(ws + WS_EXPID))
#define GATE ((float*)(ws + WS_GATE))
#define IDX ((int*)(ws + WS_IDX))
#define XF ((float*)(GAS float*)ptab_get(cx, 32))
#define SB ((bf16_t*)(ws + WS_SB))
#define SB2 ((bf16_t*)(ws + WS_PROJ))
#define TP_BAR_BEGIN() do {} while (0)
#define TP_BAR_END() do {} while (0)
#define TP_PH_BEGIN(p) do {} while (0)
#define TP_PH_END(p) do {} while (0)
#define PH_BEGIN(p) if (lo <= (p) && (p) < hi) { const int ph_ = (p); if (ran && !nobar) { TP_BAR_BEGIN(); for (int rb_ = 0; rb_ < REP_BAR; ++rb_) xcd_barrier(bar, wave0); TP_BAR_END(); } ran = 1; nobar = 0; const int tid = opaque_tid(wave0); (void)tid; unsigned char* const ws = (unsigned char*)(GAS unsigned char*)ptab_get(cx, 33); cx.ws = ws; TP_PH_BEGIN(ph_);
#define PH_END TP_PH_END(ph_); }

#if EN_P0
    PH_BEGIN(0) for (int rep_ = 0; rep_ < REP_P0; ++rep_) { p0_prologue(cx, tid); } PH_END
#endif

    for (int l = -1; l < DEPTH; ++l) {
        const int kind = (l < 0) ? 0 : l % 3, jj = (l < 0) ? 0 : l / 3, pw = (l < 0) ? 2048 : ((l % 3) == 1 ? 1536 : 2560), base = 2 + PH_PER_LAYER * l;
        nobar = (l == 0 && hi - lo > 1) ? 1 : 0;
        PH_BEGIN(l < 0 ? 1 : base) {
            pg8::DenseOrder S;
            if (l < 0) S.init(ws + WS_MEMB, ws + WS_WKV, NMEM, 2048, 1024 * INP_EB, cx.G, (int)blockIdx.x);
            else S.init(XB, ws + WS_WIN + (size_t)l * 5 * MiB, NTOK, pw, 1024 * INP_EB, cx.G, (int)blockIdx.x);
            S.rep = REP_DENSE;
            const unsigned smask = (l < 0) ? 0u : (kind == 0 ? 0x207u : kind == 1 ? 0x20u : 0x200u);
            pg8::EpiBf16s E{l < 0 ? KVM : PROJ, pw, smask, C2, INP_F8 ? 1.0f / WIN_SCALE : 1.0f};
#if EN_G1
            pg8::gemm_phase<pg8::EpiBf16s, pg8::DenseOrder, false, INP_F8 != 0>(cx.lds, S, E, tid);
#endif
        } PH_END
        if (l < 0) continue;
#if EN_THIN
        if (kind == 1) { PH_BEGIN(base + 1) for (int rep_ = 0; rep_ < REP_THIN; ++rep_) { rope_phase(cx, PROJ, INP(5) + jj * 64, INP(6) + jj * 64, QKR, tid); } PH_END }
        if (kind == 2) { PH_BEGIN(base + 1) for (int rep_ = 0; rep_ < REP_THIN; ++rep_) { sconv_phase(cx, PROJ, INP(8) + (size_t)jj * 3 * 2304, INP(9) + (size_t)jj * 2304, (bf16_t*)(ws + WS_UT3), ws + WS_V8, tid); } PH_END }
#endif
        for (int o = 0; o < 2; ++o) {
            if (o == 1 && kind != 2) break;
            PH_BEGIN(base + 2 + o) {
                if (kind == 2) {
                    const bf16_t* UT3 = (const bf16_t*)(ws + WS_UT3); constexpr size_t PS = (size_t)16 * 768 * 4096;
#if EN_TCONV
                    for (int rep_ = 0; rep_ < REP_TCONV; ++rep_) {
#if TCONV_F8
                    tconv8_phase(cx, o, o == 0 ? UT3 : (const bf16_t*)(ws + WS_Z1T), ws + WS_V8 + (size_t)o * 48 * MiB, UT3 + (size_t)(1 + o) * PS, (bf16_t*)(ws + (o == 0 ? WS_Z1T : WS_Z2T)), o == 0 ? ws + WS_V8 + 48 * MiB : (unsigned char*)nullptr, INP(19) + (size_t)(jj * 2 + o) * 768, tid);
#else
                    tconv_phase(cx, o, o == 0 ? UT3 : (const bf16_t*)(ws + WS_Z1T), UT3 + (size_t)(1 + o) * PS, (bf16_t*)(ws + (o == 0 ? WS_Z1T : WS_Z2T)), INP(19) + (size_t)(jj * 2 + o) * 768, tid);
#endif
                    }
#endif
                }
                if (o == 0) {
#if EN_NA
                    for (int rep_ = 0; rep_ < REP_NA; ++rep_) { if (kind == 0) na_phase(cx, PROJ, INP(3) + (size_t)jj * 12 * 465, CAT, tid); }
#endif
                    const int ngqa = (kind == 1) ? 3072 : 0;
                    for (int rep_ = 0; rep_ < REP_ATTN; ++rep_)
                    for (int u = cx.vcu; u < ngqa + 1024; u += cx.G) {
                        const attn_body::bf16 *Q, *K, *V; attn_body::bf16* O; int QP, KP, VP, NT;
                        if (u < ngqa) { const int qb = u & 15, hq = (u >> 4) % 12, b = u / 192, kvh = hq / 3;
                            Q = (const attn_body::bf16*)QKR + ((size_t)b * 4096 + qb * 256) * 1024 + hq * 64; QP = 1024;
                            K = (const attn_body::bf16*)QKR + (size_t)b * 4096 * 1024 + 768 + kvh * 64; KP = 1024;
                            V = (const attn_body::bf16*)PROJ + (size_t)b * 4096 * 1536 + 1024 + kvh * 64; VP = 1536;
                            O = (attn_body::bf16*)((unsigned char*)CAT + (((size_t)b * 4096 + qb * 256) * 1024 + hq * 64) * OUT_EB); NT = 64;
                        } else { const int v = u - ngqa, qb = v & 15, h = (v >> 4) & 3, b = v >> 6;
                            Q = (const attn_body::bf16*)PROJ + ((size_t)b * 4096 + qb * 256) * pw + (pw - 256) + h * 64; QP = pw;
                            K = (const attn_body::bf16*)KVM + (size_t)b * 256 * 2048 + 512 * l + h * 64; KP = 2048;
                            V = K + 256; VP = 2048;
                            O = (attn_body::bf16*)((unsigned char*)CAT + (((size_t)b * 4096 + qb * 256) * 1024 + 768 + h * 64) * OUT_EB); NT = 4;
                        }
#if EN_ATTN
                        attn_body::attn_unit<8, OUTP_F8 != 0>(Q, K, V, O, QP, KP, VP, 1024, NT, (char*)lds_raw, tid);
#endif
                    }
                }
            } PH_END
        }
#if EN_THIN
        if (kind == 2) { PH_BEGIN(base + 4) for (int rep_ = 0; rep_ < REP_THIN; ++rep_) { tback_phase(cx, (const bf16_t*)(ws + WS_Z2T), CAT, tid); } PH_END }
#endif
        PH_BEGIN(base + 5) {
            pg8::DenseOrder S; S.init(CAT, ws + WS_WOUT + (size_t)l * 2 * MiB, NTOK, 1024, 1024 * OUT_EB, cx.G, (int)blockIdx.x);
            pg8::EpiResB E{SB, l == 0 ? (const void*)INP(0) : (const void*)SB, l == 0 ? 1 : 0, 1024, DN_ALPHA, OUTP_F8 ? 1.0f / WOUT_SCALE : 1.0f};
#if EN_G2
            pg8::gemm_phase<pg8::EpiResB, pg8::DenseOrder, false, OUTP_F8 != 0>(cx.lds, S, E, tid);
#endif
        } PH_END
#if EN_LN
#if REP_LN1 > 1
        PH_BEGIN(base + 6) ln1_router_phase(cx, SB, (bf16_t*)(ws + WS_PROJ), CAT, INP(22) + l * 1024, INP(23) + l * 1024, (const float*)(ws + WS_RW + (size_t)l * 131072), INP(27) + l * 32, (unsigned*)((gu32*)(ws + WS_CTL) + CW_DBG), EXPID, GATE, IDX, (float*)(ws + WS_GIDX), tid); PH_END
#endif
        PH_BEGIN(base + 6) ln1_router_phase(cx, SB, SB2, XB, INP(22) + l * 1024, INP(23) + l * 1024, (const float*)(ws + WS_RW + (size_t)l * 131072), INP(27) + l * 32, (unsigned*)((gu32*)(ws + WS_CTL) + CW_CNT + 32 * l), EXPID, GATE, IDX, (float*)(ws + WS_GIDX), tid); PH_END
#endif
        for (int half = 0; half < 2; ++half) {
            PH_BEGIN(base + 7 + half) {
                LAS int* pref = (LAS int*)(cx.lds + pg8::STAGE_BYTES); const unsigned* cntw = (const unsigned*)((gu32*)(ws + WS_CTL) + CW_CNT + 32 * l);
                if (half == 0 || hi - lo == 1) {
                __syncthreads();
                if (tid < NEXP) { const int c = (int)__hip_atomic_load(cntw + tid, __ATOMIC_RELAXED, __HIP_MEMORY_SCOPE_AGENT); pref[40 + tid] = c; pref[72 + tid] = (c + 255) >> 8; }
                __syncthreads();
                if (tid == 0) { int a = 0;
#pragma unroll 1
                    for (int e = 0; e < NEXP; ++e) { pref[e] = a; a += pref[72 + e]; } pref[NEXP] = a; }
                __syncthreads();
                }
#if STAGGER
                if (cx.vcu & 1) { for (int s_ = 0; s_ < STAGGER; ++s_) __builtin_amdgcn_s_sleep(127); }
#endif
                if (half == 0) {
                    pg8::MoeOrder<2> S{(const char*)XB, (const char*)(ws + WS_W1 + (size_t)l * 32 * 2048 * 1024 * MOE_EB), 1024 * MOE_EB, 8, cx.G, cx.vcu, (size_t)2048 * 1024 * MOE_EB, pref, (const int*)cntw, IDX};
                    pg8::EpiSwiglu E{HB, INP(29) + (size_t)l * 32 * 2048};
#if EN_G3
                    for (int rep_ = 0; rep_ < REP_G3; ++rep_) { pg8::gemm_phase<pg8::EpiSwiglu, pg8::MoeOrder<2>, true, MOE_F8 != 0, (MOE_F8 != 0) && (DEFER_H != 0)>(cx.lds, S, E, tid); }
#endif
                } else {
                    pg8::MoeOrder<0> S{(const char*)HB, (const char*)(ws + WS_W2 + (size_t)l * 32 * 1024 * 1024 * MOE_EB), 1024 * MOE_EB, 4, cx.G, cx.vcu, (size_t)1024 * 1024 * MOE_EB, pref, (const int*)cntw, IDX};
                    pg8::EpiMoeOut E{YB, INP(31) + (size_t)l * 32 * 1024, (const float*)(ws + WS_GIDX)};
#if EN_G4
                    for (int rep_ = 0; rep_ < REP_G4; ++rep_) { pg8::gemm_phase<pg8::EpiMoeOut, pg8::MoeOrder<0>, true, MOE_F8 != 0>(cx.lds, S, E, tid); }
#endif
                }
            } PH_END
        }
#if EN_LN
#if REP_LN2 > 1
        PH_BEGIN(base + 9) ln2_phase(cx, SB, YB, (bf16_t*)(ws + WS_PROJ), CAT, (float*)nullptr, INP(24) + l * 1024, INP(25) + l * 1024, INP(22) + l * 1024, INP(23) + l * 1024, tid); PH_END
#endif
        PH_BEGIN(base + 9) ln2_phase(cx, (X1_RECOMP && Y_F8) ? SB : SB2, YB, SB, XB, l == DEPTH - 1 ? XF : (float*)nullptr, INP(24) + l * 1024, INP(25) + l * 1024, INP(22) + l * 1024, INP(23) + l * 1024, tid); PH_END

#endif
    }
#undef PH_BEGIN
#undef PH_END
#undef XB
#undef PROJ
#undef CAT
#undef KVM
#undef HB
#undef YB
#undef QKR
#undef EXPID
#undef GATE
#undef IDX
#undef XF
#undef SB
#undef SB2
}

extern "C" void kernel_launch(void* const* d_in, const int* in_sizes, int n_in, void* d_out, int out_size, void* d_ws, size_t ws_size, hipStream_t stream) {
    static int grid = 0;
    if (grid == 0) {
        if (n_in != 32 || in_sizes[0] != NTOK * DM || out_size != NTOK * DM || ws_size < WS_END) { fprintf(stderr, "kernel_launch: unexpected problem (n_in %d, in0 %d, out %d, ws %zu < %zu); nothing launched\n", n_in, n_in > 0 ? in_sizes[0] : -1, out_size, ws_size, (size_t)WS_END); grid = -1; return; }
        int dev = 0, cus = 0, per_cu = 0;
        if (hipGetDevice(&dev) != hipSuccess || hipDeviceGetAttribute(&cus, hipDeviceAttributeMultiprocessorCount, dev) != hipSuccess) { fprintf(stderr, "kernel_launch: device query failed\n"); grid = -1; return; }
        if (hipFuncSetAttribute((const void*)fwd, hipFuncAttributeMaxDynamicSharedMemorySize, LDS_BYTES) != hipSuccess) { fprintf(stderr, "kernel_launch: hipFuncSetAttribute failed\n"); grid = -1; return; }
        if (hipOccupancyMaxActiveBlocksPerMultiprocessor(&per_cu, (const void*)fwd, 512, LDS_BYTES) != hipSuccess || per_cu < 1) fprintf(stderr, "kernel_launch: occupancy query reports %d blocks per CU\n", per_cu);
        (void)hipGetLastError();
        grid = cus;
    }
    if (grid < 0) return;
    if (hipMemsetAsync((char*)d_ws + WS_CTL, 0, CTL_ZERO_BYTES, stream) != hipSuccess) { fprintf(stderr, "kernel_launch: memset failed\n"); return; }
    Args a{};
    for (int i = 0; i < 32; ++i) a.in[i] = (const float*)d_in[i];
    a.out = (float*)d_out; a.ws = (unsigned char*)d_ws;
#if MK_MULTI
    for (int p = 0; p < N_PHASES && p <= DBG_LAST_PHASE; ++p) {
        if (!phase_active(p)) continue;
        a.ph_lo = p; a.ph_hi = p + 1;
        hipLaunchKernelGGL(fwd, dim3(grid), dim3(512), LDS_BYTES, stream, a);
#if DBG_CHECK
        dbg_after_phase(p, a, stream);
#endif
    }
#if DBG_CHECK
    hipLaunchKernelGGL(dbg_report, dim3(1024), dim3(256), 0, stream, (unsigned*)((char*)d_ws + WS_CTL) + CW_DBG, (float*)d_out);
#endif
#else
    a.ph_lo = 0; a.ph_hi = N_PHASES;
    hipLaunchKernelGGL(fwd, dim3(grid), dim3(512), LDS_BYTES, stream, a);
#endif
    const hipError_t le = hipPeekAtLastError();
    if (le != hipSuccess) fprintf(stderr, "kernel_launch: launch failed: %s\n", hipGetErrorName(le));
}
```
